# Optimizing an MI355X kernel written in HIP

```python
import functools
import jax, jax.numpy as jnp
from jax import lax
import numpy as np

D_MODEL = 1024
BATCH = 32
SEQ = 256
DEPTH = 1
DEC_BATCH = 8
DEC_SEQ = 1024
PAST_LEN = 256

GRID_W = 64
N_HEADS = 8
N_KV_HEADS = 2
HEAD_DIM = 64
GROUP = N_HEADS // N_KV_HEADS
ATTN_W = N_HEADS * HEAD_DIM
KV_W = N_KV_HEADS * HEAD_DIM
WINDOW = 128
ATTN_SCALE = HEAD_DIM ** -0.5
ROPE_BASE = 10000.0
ROPE_PAIRS_AXIS = HEAD_DIM // 4
D_RNN = 512
N_RNN_BLOCKS = 8
RNN_BLOCK = D_RNN // N_RNN_BLOCKS
CONV_W = 4
CONV_LEFT = 2
RG_C = 8.0
D_MIX = ATTN_W + D_RNN
D_IN = ATTN_W + 2 * KV_W + 2 * D_RNN
N_MOD = 6
PEER_HEADS = 8
N_KEYS = 128
N_EXPERTS = N_KEYS * N_KEYS
PEER_DQ = 256
PEER_TOPK = 16
PEER_BLOCK = 128
EPS = 1e-6

kernel_name = "hymba_rglru_swa_peer_diffusion_step"


def rms_norm(x, g):
    xf = x.astype(jnp.float32)
    y = xf * lax.rsqrt(jnp.mean(xf * xf, axis=-1, keepdims=True) + EPS)
    return (y * g.astype(jnp.float32)).astype(x.dtype)


def modulated_norm(x, g, shift, scale):
    return rms_norm(x, g) * (1 + scale) + shift


def adaln_mods(cvec, w_mod, b_mod):
    m = jnp.einsum('...d,de->...e', jax.nn.silu(cvec), w_mod) + b_mod
    return jnp.split(m, N_MOD, axis=-1)


def centred_dwconv(x, conv_w, conv_b):
    S = x.shape[1]
    xp = jnp.pad(x, ((0, 0), (CONV_LEFT, CONV_W - 1 - CONV_LEFT), (0, 0)))
    y = conv_b
    for j in range(CONV_W):
        y = y + xp[:, j:j + S] * conv_w[j]
    return y


def mixer_inputs(h, w_in, conv_w, conv_b):
    B, S = h.shape[:2]
    p = jnp.einsum('bsd,dp->bsp', h, w_in)
    q, k, v, xr, yg = jnp.split(p, [ATTN_W, ATTN_W + KV_W, ATTN_W + 2 * KV_W, ATTN_W + 2 * KV_W + D_RNN], axis=-1)
    q = q.reshape(B, S, N_HEADS, HEAD_DIM)
    k = k.reshape(B, S, N_KV_HEADS, HEAD_DIM)
    v = v.reshape(B, S, N_KV_HEADS, HEAD_DIM)
    xr = centred_dwconv(xr, conv_w, conv_b)
    return q, k, v, xr, yg


def block_diag(x, w):
    xb = x.reshape(x.shape[:-1] + (N_RNN_BLOCKS, RNN_BLOCK))
    return jnp.einsum('bsnc,ncd->bsnd', xb, w).reshape(x.shape)


def _lin_combine(left, right):
    a1, b1 = left
    a2, b2 = right
    return (a1 * a2, a2 * b1 + b2)


def rglru_direction(xr, w_a, b_a, w_i, b_i, lam, h0, reverse):
    xf = xr.astype(jnp.float32)
    r = jax.nn.sigmoid(block_diag(xf, w_a) + b_a)
    gi = jax.nn.sigmoid(block_diag(xf, w_i) + b_i)
    log_a = -RG_C * r * jax.nn.softplus(-lam.astype(jnp.float32))
    a = jnp.exp(log_a)
    b = jnp.sqrt(-jnp.expm1(2.0 * log_a)) * gi * xf
    a_cum, b_cum = lax.associative_scan(_lin_combine, (a, b), reverse=reverse, axis=1)
    return a_cum * h0[:, None, :].astype(jnp.float32) + b_cum


def rglru_mixer(xr, yg, rg_w_a, rg_b_a, rg_w_i, rg_b_i, rg_lambda, h0_f, h0_b):
    hf = rglru_direction(xr, rg_w_a[0], rg_b_a[0], rg_w_i[0], rg_b_i[0], rg_lambda[0], h0_f, False)
    hb = rglru_direction(xr, rg_w_a[1], rg_b_a[1], rg_w_i[1], rg_b_i[1], rg_lambda[1], h0_b, True)
    o = ((hf + hb) * jax.nn.gelu(yg.astype(jnp.float32))).astype(xr.dtype)
    return o, hf[:, -1], hb[:, 0]


def axial_rope(rows):
    row = jnp.repeat(jnp.arange(rows, dtype=jnp.float32), GRID_W)
    col = jnp.tile(jnp.arange(GRID_W, dtype=jnp.float32), rows)
    inv = ROPE_BASE ** (-jnp.arange(ROPE_PAIRS_AXIS, dtype=jnp.float32) / ROPE_PAIRS_AXIS)
    ang = jnp.concatenate([row[:, None] * inv, col[:, None] * inv], axis=-1)
    return jnp.cos(ang), jnp.sin(ang)


def apply_rope(x, cos, sin):
    xf = x.astype(jnp.float32)
    c = cos[None, :, None, :]
    s = sin[None, :, None, :]
    x1, x2 = xf[..., :HEAD_DIM // 2], xf[..., HEAD_DIM // 2:]
    return jnp.concatenate([x1 * c - x2 * s, x2 * c + x1 * s], axis=-1).astype(x.dtype)


def context_attention(q, k, v, sink):
    B, S = q.shape[:2]
    qg = q.reshape(B, S, N_KV_HEADS, GROUP, HEAD_DIM)
    s = jnp.einsum('bqkgd,bckd->bkgqc', qg, k).astype(jnp.float32) * ATTN_SCALE
    sk = jnp.broadcast_to(sink.astype(jnp.float32).reshape(1, N_KV_HEADS, GROUP, 1, 1), s.shape[:-1] + (1,))
    p = jax.nn.softmax(jnp.concatenate([s, sk], axis=-1), axis=-1)[..., :-1]
    o = jnp.einsum('bkgqc,bckd->bqkgd', p.astype(v.dtype), v)
    return o.reshape(B, S, ATTN_W)


def band_blocks(t, nb):
    B = t.shape[0]
    tp = jnp.pad(t, ((0, 0), (WINDOW, WINDOW), (0, 0), (0, 0))).reshape(B, nb + 2, WINDOW, N_KV_HEADS, HEAD_DIM)
    return jnp.concatenate([tp[:, :-2], tp[:, 1:-1], tp[:, 2:]], axis=2)


def latent_attention(q, k, v, sink, *, cos, sin, k_ctx, v_ctx):
    B, S = q.shape[:2]
    nb = S // WINDOW
    q = apply_rope(q, cos, sin)
    k = apply_rope(k, cos, sin)
    qb = q.reshape(B, nb, WINDOW, N_KV_HEADS, GROUP, HEAD_DIM)
    k_band = band_blocks(k, nb)
    v_band = band_blocks(v, nb)
    s_band = jnp.einsum('bnqkgd,bnckd->bkgnqc', qb, k_band).astype(jnp.float32) * ATTN_SCALE
    s_ctx = jnp.einsum('bnqkgd,bckd->bkgnqc', qb, k_ctx).astype(jnp.float32) * ATTN_SCALE
    blk = jnp.arange(nb)[:, None, None]
    qpos = blk * WINDOW + jnp.arange(WINDOW)[None, :, None]
    kpos = (blk - 1) * WINDOW + jnp.arange(3 * WINDOW)[None, None, :]
    mask = (jnp.abs(qpos - kpos) <= WINDOW) & (kpos >= 0) & (kpos < S)
    s_band = jnp.where(mask, s_band, -jnp.inf)
    sk = jnp.broadcast_to(sink.astype(jnp.float32).reshape(1, N_KV_HEADS, GROUP, 1, 1, 1), s_ctx.shape[:-1] + (1,))
    p = jax.nn.softmax(jnp.concatenate([s_band, s_ctx, sk], axis=-1), axis=-1)
    n_band = 3 * WINDOW
    n_ctx = k_ctx.shape[1]
    p_band = p[..., :n_band].astype(v.dtype)
    p_ctx = p[..., n_band:n_band + n_ctx].astype(v.dtype)
    o = (jnp.einsum('bkgnqc,bnckd->bnqkgd', p_band, v_band)
         + jnp.einsum('bkgnqc,bckd->bnqkgd', p_ctx, v_ctx))
    return o.reshape(B, S, ATTN_W)


def peer(h, w_query, sub_keys, u_tab, v_tab):
    B, S, D = h.shape
    xt = h.reshape((B * S) // PEER_BLOCK, PEER_BLOCK, D)

    def retrieve(xb):
        q = jnp.einsum('td,dhq->thq', xb, w_query)
        q1, q2 = jnp.split(q, 2, axis=-1)
        s1 = jnp.einsum('thq,hkq->thk', q1, sub_keys[:, 0]).astype(jnp.float32)
        s2 = jnp.einsum('thq,hkq->thk', q2, sub_keys[:, 1]).astype(jnp.float32)
        v1, i1 = lax.top_k(s1, PEER_TOPK)
        v2, i2 = lax.top_k(s2, PEER_TOPK)
        cand = (v1[..., :, None] + v2[..., None, :]).reshape(PEER_BLOCK, PEER_HEADS, PEER_TOPK * PEER_TOPK)
        cid = (i1[..., :, None] * N_KEYS + i2[..., None, :]).reshape(PEER_BLOCK, PEER_HEADS, PEER_TOPK * PEER_TOPK)
        best, pos = lax.top_k(cand, PEER_TOPK)
        eid = jnp.take_along_axis(cid, pos, axis=-1)
        g = jax.nn.softmax(best, axis=-1)
        u = jnp.take(u_tab, eid, axis=0)
        act = jax.nn.gelu(jnp.einsum('td,thkd->thk', xb, u).astype(jnp.float32))
        vv = jnp.take(v_tab, eid, axis=0)
        return jnp.einsum('thk,thkd->td', (g * act).astype(vv.dtype), vv)

    return lax.map(retrieve, xt).reshape(B, S, D)


def trunk_layer(x, mods, lw, attend, h0_f, h0_b):
    (g_mix, g_ffn, w_in, conv_w, conv_b, rg_w_a, rg_b_a, rg_w_i, rg_b_i, rg_lambda,
     attn_sink, w_out, pq, psk, pu, pv) = lw
    sh1, sc1, ga1, sh2, sc2, ga2 = mods
    h = modulated_norm(x, g_mix, sh1, sc1)
    q, k, v, xr, yg = mixer_inputs(h, w_in, conv_w, conv_b)
    o_att = attend(q, k, v, attn_sink)
    o_rnn, hf, hb = rglru_mixer(xr, yg, rg_w_a, rg_b_a, rg_w_i, rg_b_i, rg_lambda, h0_f, h0_b)
    mix = jnp.concatenate([o_att, o_rnn.astype(o_att.dtype)], axis=-1)
    x = x + ga1 * jnp.einsum('bsm,md->bsd', mix, w_out)
    h2 = modulated_norm(x, g_ffn, sh2, sc2)
    x = x + ga2 * peer(h2, pq, psk, pu, pv)
    return x, k, v, hf, hb


def setup_inputs(seed: int = 0) -> dict:
    key = jax.random.key(seed)
    ks = jax.random.split(key, 32)
    f32 = jnp.float32
    nrm = lambda k, shape, s: jax.random.normal(k, shape, f32) * s
    a0 = jax.random.uniform(ks[13], (DEPTH, 2, D_RNN), f32, 0.9, 0.999)
    sig = a0 ** (1.0 / RG_C)
    rg_lambda = jnp.log(sig) - jnp.log1p(-sig)
    return {
        "x_prompt": nrm(ks[0], (BATCH, SEQ, D_MODEL), 1.0),
        "x_sample": nrm(ks[1], (DEC_BATCH, DEC_SEQ, D_MODEL), 1.0),
        "cache_k": nrm(ks[2], (DEC_BATCH, DEPTH, PAST_LEN, N_KV_HEADS, HEAD_DIM), 1.0),
        "cache_v": nrm(ks[3], (DEC_BATCH, DEPTH, PAST_LEN, N_KV_HEADS, HEAD_DIM), 1.0),
        "state_rnn": nrm(ks[4], (DEC_BATCH, DEPTH, 2, D_RNN), 0.5),
        "c": nrm(ks[5], (DEC_BATCH, D_MODEL), 1.0),
        "c_ctx": nrm(ks[6], (D_MODEL,), 1.0),
        "w_mod": nrm(ks[7], (DEPTH, D_MODEL, N_MOD * D_MODEL), 0.5 * D_MODEL ** -0.5),
        "b_mod": nrm(ks[8], (DEPTH, N_MOD * D_MODEL), 0.02),
        "g_norm_mix": 1.0 + nrm(ks[9], (DEPTH, D_MODEL), 0.1),
        "g_norm_ffn": 1.0 + nrm(ks[10], (DEPTH, D_MODEL), 0.1),
        "w_in": nrm(ks[11], (DEPTH, D_MODEL, D_IN), D_MODEL ** -0.5),
        "conv_w": nrm(ks[12], (DEPTH, CONV_W, D_RNN), CONV_W ** -0.5),
        "conv_b": nrm(ks[14], (DEPTH, D_RNN), 0.02),
        "rg_w_a": nrm(ks[15], (DEPTH, 2, N_RNN_BLOCKS, RNN_BLOCK, RNN_BLOCK), RNN_BLOCK ** -0.5),
        "rg_b_a": nrm(ks[16], (DEPTH, 2, D_RNN), 0.02),
        "rg_w_i": nrm(ks[17], (DEPTH, 2, N_RNN_BLOCKS, RNN_BLOCK, RNN_BLOCK), RNN_BLOCK ** -0.5),
        "rg_b_i": nrm(ks[18], (DEPTH, 2, D_RNN), 0.02),
        "rg_lambda": rg_lambda,
        "attn_sink": nrm(ks[19], (DEPTH, N_HEADS), 0.5),
        "w_out": nrm(ks[20], (DEPTH, D_MIX, D_MODEL), D_MIX ** -0.5),
        "peer_w_query": nrm(ks[21], (DEPTH, D_MODEL, PEER_HEADS, PEER_DQ), D_MODEL ** -0.5),
        "peer_sub_keys": nrm(ks[22], (DEPTH, PEER_HEADS, 2, N_KEYS, PEER_DQ // 2), (PEER_DQ // 2) ** -0.5),
        "peer_u": nrm(ks[23], (DEPTH, N_EXPERTS, D_MODEL), D_MODEL ** -0.5),
        "peer_v": nrm(ks[24], (DEPTH, N_EXPERTS, D_MODEL), PEER_HEADS ** -0.5),
        "g_final": 1.0 + nrm(ks[25], (D_MODEL,), 0.1),
    }


def reference(x_prompt, x_sample, cache_k, cache_v, state_rnn, c, c_ctx, w_mod, b_mod,
              g_norm_mix, g_norm_ffn, w_in, conv_w, conv_b, rg_w_a, rg_b_a, rg_w_i, rg_b_i,
              rg_lambda, attn_sink, w_out, peer_w_query, peer_sub_keys, peer_u, peer_v, g_final):
    n_lat = x_sample.shape[1]
    rows = n_lat // GRID_W
    cos, sin = axial_rope(rows)
    xp, xs = x_prompt, x_sample
    h_zero = jnp.zeros((x_prompt.shape[0], D_RNN), jnp.float32)
    ks_out, vs_out, hs_out = [], [], []
    for l in range(DEPTH):
        lw = (g_norm_mix[l], g_norm_ffn[l], w_in[l], conv_w[l], conv_b[l], rg_w_a[l], rg_b_a[l],
              rg_w_i[l], rg_b_i[l], rg_lambda[l], attn_sink[l], w_out[l], peer_w_query[l],
              peer_sub_keys[l], peer_u[l], peer_v[l])
        mods_ctx = adaln_mods(c_ctx, w_mod[l], b_mod[l])
        mods_lat = [m[:, None, :] for m in adaln_mods(c, w_mod[l], b_mod[l])]
        xp, k_l, v_l, hf_l, hb_l = trunk_layer(xp, mods_ctx, lw, context_attention, h_zero, h_zero)
        ks_out.append(k_l)
        vs_out.append(v_l)
        hs_out.append(jnp.stack([hf_l, hb_l], axis=1))
        lat_attend = functools.partial(latent_attention, cos=cos, sin=sin,
                                       k_ctx=cache_k[:, l], v_ctx=cache_v[:, l])
        xs, _, _, _, _ = trunk_layer(xs, mods_lat, lw, lat_attend, state_rnn[:, l, 0], state_rnn[:, l, 1])
    y_prompt = rms_norm(xp, g_final)
    y_sample = rms_norm(xs, g_final)
    new_k = jnp.stack(ks_out, axis=1)
    new_v = jnp.stack(vs_out, axis=1)
    new_rnn = jnp.stack(hs_out, axis=1)
    return (y_prompt, y_sample, new_k, new_v, new_rnn)
```

```cpp
#include <hip/hip_runtime.h>
#include <cstdio>
#include <cstdint>

#ifndef MK_N_LAUNCHES
#define MK_N_LAUNCHES 1
#endif

namespace pg8 {
#define PG8_LAS __attribute__((address_space(3)))
typedef unsigned short bf16_t;
typedef short bf16x8 __attribute__((ext_vector_type(8)));
typedef float f32x4 __attribute__((ext_vector_type(4)));
typedef unsigned u32x4 __attribute__((ext_vector_type(4)));
typedef unsigned u32x2 __attribute__((ext_vector_type(2)));
constexpr int BM = 256, BK = 64, HALF = 128, HTB = HALF * BK * 2, STAGE_BYTES = 8 * HTB, NXCD = 8, WGM = 8;

__host__ __device__ __forceinline__ int lds_byte(int r, int c) { const int st = (r >> 4) * 2 + (c >> 5), rr = r & 15, cc = c & 31, ob = rr * 64 + cc * 2; return st * 1024 + (ob ^ (((ob >> 9) & 1) << 5)); }
__host__ __device__ __forceinline__ void stage_rc(int b, int& R, int& C) { const int st = b / 1024, sb = b % 1024, swz = sb ^ (((sb >> 9) & 1) << 5); R = (st >> 1) * 16 + swz / 64; C = (st & 1) * 32 + (swz % 64) / 2; }
__host__ __device__ __forceinline__ int perm32(int rho) { const int n = rho >> 4, i = rho & 15; return 8 * (i >> 2) + 4 * n + (i & 3); }

struct Unit { int pm, pn; };
struct Gemm { const bf16_t* A; const bf16_t* Bt; int M, N, K; };

struct StaticOrder {
    int nM, nN, nwg, G, c;
    __host__ __device__ void init(int M, int N, int G_, int c_) { nM = M / BM; nN = N / BM; nwg = nM * nN; G = G_; c = c_; }
    __host__ __device__ bool next(int i, Unit& u) const {
        const long L = (long)i * G + c; if (L >= nwg) return false;
        int wgid = (int)L; { const int q = nwg / NXCD, r = nwg % NXCD, xcd = wgid % NXCD, off = wgid / NXCD; wgid = (xcd < r ? xcd * (q + 1) : r * (q + 1) + (xcd - r) * q) + off; }
        const int nig = WGM * nN, gid = wgid / nig, fm = gid * WGM, gsz = (nM - fm) < WGM ? (nM - fm) : WGM;
        u.pm = fm + ((wgid % nig) % gsz); u.pn = (wgid % nig) / gsz; return true;
    }
    __device__ __forceinline__ void a_ready(const Unit&) const {}
    __device__ __forceinline__ void done(const Unit&) const {}
};

__device__ __forceinline__ unsigned cvt_pk_bf16(float lo, float hi) { unsigned r; asm volatile("v_cvt_pk_bf16_f32 %0, %1, %2" : "=v"(r) : "v"(lo), "v"(hi)); return r; }

template <class Epi, class Sched, bool ALIGN_EPI = false, bool SP2 = false>
__device__ __forceinline__ void gemm_phase(PG8_LAS unsigned char* lds, const Gemm g, const Sched& S, const Epi& E) {
    const int tid = threadIdx.x, wid = __builtin_amdgcn_readfirstlane(tid >> 6), lane = tid & 63, wr = wid >> 2, wc = wid & 3, fr = lane & 15, fq = lane >> 4;
    const int K = g.K, nt = K / BK;
    unsigned voffA[2], voffB[2];
#pragma unroll
    for (int i = 0; i < 2; ++i) { int R, C; stage_rc(tid * 16 + i * 8192, R, C); const int Rb = Epi::PERM ? ((R & ~31) + perm32(R & 31)) : R;
        voffA[i] = (unsigned)(R * K + C) * 2u; voffB[i] = (unsigned)(Rb * K + C) * 2u; }
    const size_t kstep = (size_t)(BK * 2);
    const size_t hstep = (size_t)HALF * K * 2;
    const size_t tstep = 2 * hstep;
    const unsigned ldsw = (unsigned)wid * 1024u;
    const int aoff = lds_byte(wr * 64 + fr, fq * 8), boff = lds_byte(wc * 32 + fr, fq * 8);
#define PG8_SA(b, h) (((b) * 2 + (h)) * HTB)
#define PG8_SB(b, h) ((4 + (b) * 2 + (h)) * HTB)
#define PG8_STAGE(bufoff, gbase, voff) do { _Pragma("unroll") for (int _i = 0; _i < 2; ++_i) \
        __builtin_amdgcn_global_load_lds((const unsigned*)((const char*)(gbase) + (voff)[_i]), (PG8_LAS unsigned*)(lds + (bufoff) + ldsw + _i * 8192), 16, 0, 0); } while (0)
#define PG8_LDA(dst, b, h) do { _Pragma("unroll") for (int m = 0; m < 4; ++m) _Pragma("unroll") for (int k = 0; k < 2; ++k) dst[m][k] = *(const PG8_LAS bf16x8*)(lds + PG8_SA(b, h) + aoff + m * 2048 + k * 1024); } while (0)
#define PG8_LDB(dst, b, h) do { _Pragma("unroll") for (int n = 0; n < 2; ++n) _Pragma("unroll") for (int k = 0; k < 2; ++k) dst[n][k] = *(const PG8_LAS bf16x8*)(lds + PG8_SB(b, h) + boff + n * 2048 + k * 1024); } while (0)
#define PG8_MMA(ai, bj, At, Bt) do { __builtin_amdgcn_s_setprio(1); _Pragma("unroll") for (int m = 0; m < 4; ++m) _Pragma("unroll") for (int n = 0; n < 2; ++n) _Pragma("unroll") for (int k = 0; k < 2; ++k) \
        acc[ai][bj][m][n] = __builtin_amdgcn_mfma_f32_16x16x32_bf16(Bt[n][k], At[m][k], acc[ai][bj][m][n], 0, 0, 0); __builtin_amdgcn_s_setprio(0); } while (0)
#define PG8_WAIT_V(n) asm volatile("s_waitcnt vmcnt(" #n ")" ::: "memory")
#define PG8_WAIT_L(n) asm volatile("s_waitcnt lgkmcnt(" #n ")" ::: "memory")
#define PG8_BAR __builtin_amdgcn_s_barrier()
#define PG8_SCHED __builtin_amdgcn_sched_barrier(0)
    Unit cur, nxt; int ui = 0;
    if (!S.next(0, cur)) return;
    f32x4 acc[2][2][4][2];
#pragma unroll
    for (int a = 0; a < 2; ++a)
#pragma unroll
        for (int b = 0; b < 2; ++b)
#pragma unroll
            for (int m = 0; m < 4; ++m)
#pragma unroll
                for (int n = 0; n < 2; ++n) acc[a][b][m][n] = (f32x4){0.f, 0.f, 0.f, 0.f};
    bf16x8 At[4][2], B0[2][2], B1[2][2];
    const char* cA = (const char*)g.A + (size_t)cur.pm * tstep; const char* cB = (const char*)g.Bt + (size_t)cur.pn * tstep;
    S.a_ready(cur);
    if constexpr (SP2) {
        PG8_STAGE(PG8_SB(0, 0), cB, voffB); PG8_STAGE(PG8_SB(0, 1), cB + hstep, voffB); PG8_STAGE(PG8_SA(0, 0), cA, voffA); PG8_STAGE(PG8_SA(0, 1), cA + hstep, voffA);
        if (wr == 1) PG8_BAR;
        PG8_WAIT_V(2); PG8_BAR;
        PG8_STAGE(PG8_SB(1, 0), cB + kstep, voffB); PG8_STAGE(PG8_SA(1, 0), cA + kstep, voffA); PG8_STAGE(PG8_SB(1, 1), cB + hstep + kstep, voffB);
        PG8_WAIT_V(6); PG8_BAR;
    } else {
        PG8_STAGE(PG8_SB(0, 0), cB, voffB); PG8_STAGE(PG8_SA(0, 0), cA, voffA); PG8_STAGE(PG8_SB(0, 1), cB + hstep, voffB); PG8_STAGE(PG8_SA(0, 1), cA + hstep, voffA);
        if (wr == 1) PG8_BAR;
        PG8_WAIT_V(4); PG8_BAR;
        PG8_STAGE(PG8_SB(1, 0), cB + kstep, voffB); PG8_STAGE(PG8_SA(1, 0), cA + kstep, voffA); PG8_STAGE(PG8_SB(1, 1), cB + hstep + kstep, voffB);
        PG8_WAIT_V(6); PG8_BAR;
    }
    for (;;) {
        const bool has_next = S.next(ui + 1, nxt);
        const char* nA = has_next ? (const char*)g.A + (size_t)nxt.pm * tstep : cA; const char* nB = has_next ? (const char*)g.Bt + (size_t)nxt.pn * tstep : cB;
        for (int t = 0; t < nt; t += 2) {
            const bool last = (t == nt - 2);
            const char* a1 = cA + (size_t)(t + 1) * kstep;
            const char* a2 = last ? nA : cA + (size_t)(t + 2) * kstep; const char* b2 = last ? nB : cB + (size_t)(t + 2) * kstep;
            const char* a3 = a2 + kstep; const char* b3 = b2 + kstep;
            if (last && has_next) S.a_ready(nxt);
            if constexpr (SP2) {
            PG8_LDB(B0, 0, 0); PG8_LDB(B1, 0, 1); PG8_SCHED; PG8_LDA(At, 0, 0); PG8_STAGE(PG8_SA(1, 1), a1 + hstep, voffA);
            PG8_WAIT_V(8); PG8_WAIT_L(0); PG8_BAR; PG8_MMA(0, 0, At, B0); PG8_MMA(0, 1, At, B1); PG8_BAR; PG8_SCHED;
            PG8_LDA(At, 0, 1); PG8_STAGE(PG8_SB(0, 0), b2, voffB); PG8_STAGE(PG8_SB(0, 1), b2 + hstep, voffB); PG8_STAGE(PG8_SA(0, 0), a2, voffA);
            PG8_WAIT_V(8); PG8_WAIT_L(0); PG8_BAR; PG8_MMA(1, 0, At, B0); PG8_MMA(1, 1, At, B1); PG8_BAR; PG8_SCHED;
            PG8_LDB(B0, 1, 0); PG8_LDB(B1, 1, 1); PG8_SCHED; PG8_LDA(At, 1, 0); PG8_STAGE(PG8_SA(0, 1), a2 + hstep, voffA);
            PG8_WAIT_V(8); PG8_WAIT_L(0); PG8_BAR; PG8_MMA(0, 0, At, B0); PG8_MMA(0, 1, At, B1); PG8_BAR; PG8_SCHED;
            PG8_LDA(At, 1, 1); PG8_STAGE(PG8_SB(1, 0), b3, voffB); PG8_STAGE(PG8_SB(1, 1), b3 + hstep, voffB); PG8_STAGE(PG8_SA(1, 0), a3, voffA);
            PG8_WAIT_V(8); PG8_WAIT_L(0); PG8_BAR; PG8_MMA(1, 0, At, B0); PG8_MMA(1, 1, At, B1); PG8_BAR; PG8_SCHED;
            } else {
            PG8_LDB(B0, 0, 0); PG8_SCHED; PG8_LDA(At, 0, 0); PG8_STAGE(PG8_SA(1, 1), a1 + hstep, voffA);
            PG8_WAIT_L(8); PG8_BAR; PG8_WAIT_L(0); PG8_MMA(0, 0, At, B0); PG8_BAR; PG8_SCHED;
            PG8_LDB(B1, 0, 1); PG8_STAGE(PG8_SB(0, 0), b2, voffB);
            PG8_BAR; PG8_WAIT_L(0); PG8_MMA(0, 1, At, B1); PG8_BAR;
            PG8_LDA(At, 0, 1); PG8_STAGE(PG8_SA(0, 0), a2, voffA);
            PG8_BAR; PG8_WAIT_L(0); PG8_MMA(1, 0, At, B0); PG8_BAR; PG8_SCHED;
            PG8_STAGE(PG8_SB(0, 1), b2 + hstep, voffB);
            PG8_WAIT_V(6); PG8_BAR; PG8_MMA(1, 1, At, B1); PG8_BAR;
            PG8_LDB(B0, 1, 0); PG8_SCHED; PG8_LDA(At, 1, 0); PG8_STAGE(PG8_SA(0, 1), a2 + hstep, voffA);
            PG8_WAIT_L(8); PG8_BAR; PG8_WAIT_L(0); PG8_MMA(0, 0, At, B0); PG8_BAR; PG8_SCHED;
            PG8_LDB(B1, 1, 1); PG8_STAGE(PG8_SB(1, 0), b3, voffB);
            PG8_BAR; PG8_WAIT_L(0); PG8_MMA(0, 1, At, B1); PG8_BAR;
            PG8_LDA(At, 1, 1); PG8_STAGE(PG8_SA(1, 0), a3, voffA);
            PG8_BAR; PG8_WAIT_L(0); PG8_MMA(1, 0, At, B0); PG8_BAR; PG8_SCHED;
            PG8_STAGE(PG8_SB(1, 1), b3 + hstep, voffB);
            PG8_WAIT_V(6); PG8_BAR; PG8_MMA(1, 1, At, B1); PG8_BAR;
            }
        }
        if constexpr (ALIGN_EPI) { if (wr == 0) PG8_BAR; }
        E(acc, cur, wr, wc, fr, fq); S.done(cur);
        if (!has_next) break;
#pragma unroll
        for (int a = 0; a < 2; ++a)
#pragma unroll
            for (int b = 0; b < 2; ++b)
#pragma unroll
                for (int m = 0; m < 4; ++m)
#pragma unroll
                    for (int n = 0; n < 2; ++n) acc[a][b][m][n] = (f32x4){0.f, 0.f, 0.f, 0.f};
        cur = nxt; cA = nA; cB = nB; ++ui;
        if constexpr (ALIGN_EPI) { if (wr == 1) PG8_BAR; }
    }
    PG8_WAIT_V(0);
    if constexpr (!ALIGN_EPI) { if (wr == 0) PG8_BAR; }
    PG8_BAR;
#undef PG8_SA
#undef PG8_SB
#undef PG8_STAGE
#undef PG8_LDA
#undef PG8_LDB
#undef PG8_MMA
#undef PG8_WAIT_V
#undef PG8_WAIT_L
#undef PG8_BAR
#undef PG8_SCHED
}
}

constexpr int NWAVES = 8;
constexpr int DM = 1024, NTOK = 16384, NCTX = 8192, D_IN = 1792, NMODV = 9, MODW = 6144;
constexpr int SEQ_C = 256, SEQ_L = 1024, NSEQ_C = 32, NSEQ_L = 8;
constexpr int N_PHASES = 8;
constexpr float LOG2E = 1.4426950408889634f;
constexpr float QSCALE = 0.125f * LOG2E;
constexpr float EPS = 1e-6f;

constexpr size_t MiB = 1u << 20, KiB = 1u << 10;
constexpr size_t WS_CTL = 0, CTL_ZERO_BYTES = 64 * KiB;
constexpr size_t WS_MODS = 1 * MiB;
constexpr size_t WS_ROPE = 1 * MiB + 256 * KiB;
constexpr size_t WS_RGW  = 1 * MiB + 512 * KiB;
constexpr size_t WS_CK   = 1 * MiB + 768 * KiB;
constexpr size_t WS_CVT  = 2 * MiB + 256 * KiB;
constexpr size_t WS_WIN  = 3 * MiB;
constexpr size_t WS_WOUT = 7 * MiB;
constexpr size_t WS_WC   = 9 * MiB;
constexpr size_t WS_U    = 16 * MiB;
constexpr size_t WS_V    = 48 * MiB;
constexpr size_t WS_H    = 80 * MiB;
constexpr size_t WS_MIX  = 112 * MiB;
constexpr size_t WS_Q    = 144 * MiB;
constexpr size_t WS_K    = 160 * MiB;
constexpr size_t WS_VT   = 164 * MiB;
constexpr size_t WS_XR   = 168 * MiB;
constexpr size_t WS_YG   = 184 * MiB;
constexpr size_t WS_HF   = 200 * MiB;
constexpr size_t WS_SC   = 144 * MiB;
constexpr size_t WS_END  = 232 * MiB;
constexpr int VT_LAT_OFF = NSEQ_C * 2 * 64 * SEQ_C;

constexpr int CW_BAR = 4096;

constexpr int RING_BYTES = 131072;
constexpr int LDSCTL_OFF = RING_BYTES, MISC_OFF = LDSCTL_OFF + 320;
constexpr int LDS_BYTES = 147456;

#define GAS __attribute__((address_space(1)))
#define LAS __attribute__((address_space(3)))
typedef unsigned short bf16;
typedef unsigned v4u __attribute__((ext_vector_type(4)));
typedef unsigned v2u __attribute__((ext_vector_type(2)));
typedef float f32x4 __attribute__((ext_vector_type(4)));
typedef float f32x2 __attribute__((ext_vector_type(2)));
typedef float f32x16 __attribute__((ext_vector_type(16)));
typedef short bf16x8 __attribute__((ext_vector_type(8)));
typedef GAS unsigned gu32;
#define RLX_AGENT __ATOMIC_RELAXED, __HIP_MEMORY_SCOPE_AGENT

__device__ __forceinline__ unsigned f2bf(float f) { unsigned u = __builtin_bit_cast(unsigned, f); return (u + 0x7fffu + ((u >> 16) & 1u)) >> 16; }
__device__ __forceinline__ unsigned pk2(float lo, float hi) { return f2bf(lo) | (f2bf(hi) << 16); }
__device__ __forceinline__ float bf2f(unsigned b) { return __builtin_bit_cast(float, b << 16); }
__device__ __forceinline__ float bflo(unsigned w) { return __builtin_bit_cast(float, w << 16); }
__device__ __forceinline__ float bfhi(unsigned w) { return __builtin_bit_cast(float, w & 0xffff0000u); }
__device__ __forceinline__ float sigmoidf_(float x) { return 1.f / (1.f + __expf(-x)); }
__device__ __forceinline__ float gelu_tanh(float x) { const float y = 0.7978845608028654f * (x + 0.044715f * x * x * x); const float e = __expf(2.f * y); return 0.5f * x * (2.f - 2.f / (1.f + e)); }
__device__ __forceinline__ float wave_sum(float v) {
#pragma unroll
    for (int o = 1; o < 64; o <<= 1) v += __shfl_xor(v, o);
    return v;
}
__device__ __forceinline__ unsigned wave_max_u32(unsigned v) {
#pragma unroll
    for (int o = 1; o < 64; o <<= 1) { const unsigned t = (unsigned)__shfl_xor((int)v, o); v = t > v ? t : v; }
    return v;
}
__device__ __forceinline__ int crow(int r, int hi) { return (r & 3) + 8 * (r >> 2) + 4 * hi; }

#define XB_TMO      128
#define XB_XCNT(j)  (256  + 64 * (j))
#define XB_XSUB(j)  (1280 + 64 * (j))
#define XB_XGEN(j)  (2304 + 64 * (j))
#define XB_TOP      3328
#define XB_TOPGEN   3392
#define XCD_BAR_WORDS 3456
#define XB_SPIN_CAP (1u << 18)
__device__ __forceinline__ unsigned xb_ld(unsigned* p)              { return __hip_atomic_load(p, __ATOMIC_RELAXED, __HIP_MEMORY_SCOPE_AGENT); }
__device__ __forceinline__ unsigned xb_add(unsigned* p, unsigned v) { return __hip_atomic_fetch_add(p, v, __ATOMIC_RELAXED, __HIP_MEMORY_SCOPE_AGENT); }
__device__ __forceinline__ unsigned xb_xcc_id() { return (unsigned)__builtin_amdgcn_s_getreg((3 << 11) | 20) & 0xFu; }
#define XB_SPIN(cond, bar) do { unsigned _sp = 0; while (cond) { __builtin_amdgcn_s_sleep(1); \
    if ((++_sp & 255u) == 0u) { if (xb_ld(&(bar)[XB_TMO])) break; if (_sp > XB_SPIN_CAP) { atomicAdd(&(bar)[XB_TMO], 1u); break; } } } } while (0)
struct XcdBarrier { unsigned* bar; unsigned x; volatile LAS unsigned* st; };
__device__ __forceinline__ XcdBarrier xcd_barrier_post(unsigned* bar, volatile LAS unsigned* st) {
    XcdBarrier b; b.bar = bar; b.x = xb_xcc_id(); b.st = st;
    if (threadIdx.x == 0) (void)xb_add(&bar[XB_XCNT(b.x)], 1u);
    return b;
}
__device__ __forceinline__ void xcd_barrier_complete(unsigned* bar, unsigned x, unsigned& nloc, unsigned& nx) {
    const unsigned G = gridDim.x * gridDim.y * gridDim.z;
    unsigned sum, cnt, mine, sp = 0u;
    for (;;) {
        sum = 0u; cnt = 0u; mine = 0u;
#pragma unroll
        for (unsigned j = 0; j < 16; ++j) { const unsigned c = xb_ld(&bar[XB_XCNT(j)]); sum += c; cnt += (c > 0u) ? 1u : 0u; mine = (j == x) ? c : mine; }
        if (sum == G) break;
        __builtin_amdgcn_s_sleep(1);
        if ((++sp & 255u) == 0u) { if (xb_ld(&bar[XB_TMO])) break; if (sp > XB_SPIN_CAP) { atomicAdd(&bar[XB_TMO], 1u); break; } }
    }
    nloc = mine > 0u ? mine : 1u; nx = cnt > 0u ? cnt : 1u;
}
__device__ __forceinline__ void xcd_barrier(const XcdBarrier& b) {
    asm volatile("s_waitcnt vmcnt(0)" ::: "memory");
    __syncthreads();
    if (threadIdx.x == 0) {
        unsigned* bar = b.bar;
        __builtin_amdgcn_s_waitcnt(0);
        unsigned nloc = b.st[0], nx = b.st[1];
        if (nloc == 0u) { xcd_barrier_complete(bar, b.x, nloc, nx); b.st[0] = nloc; b.st[1] = nx; }
        const unsigned old = xb_add(&bar[XB_XSUB(b.x)], 1u);
        const unsigned gen = old / nloc;
        if (old + 1u == (gen + 1u) * nloc) {
            __builtin_amdgcn_fence(__ATOMIC_RELEASE, "agent");
            asm volatile("s_waitcnt vmcnt(0)" ::: "memory");
            const unsigned og = xb_add(&bar[XB_TOP], 1u);
            const unsigned tg = og / nx;
            if (og + 1u == (tg + 1u) * nx) xb_add(&bar[XB_TOPGEN], 1u);
            else XB_SPIN(xb_ld(&bar[XB_TOPGEN]) == tg, bar);
            __builtin_amdgcn_fence(__ATOMIC_ACQUIRE, "agent");
            xb_add(&bar[XB_XGEN(b.x)], 1u);
            asm volatile("s_waitcnt vmcnt(0)" ::: "memory");
        } else {
            XB_SPIN(xb_ld(&bar[XB_XGEN(b.x)]) == gen, bar);
            __builtin_amdgcn_fence(__ATOMIC_ACQUIRE, "agent");
            asm volatile("s_waitcnt vmcnt(0)" ::: "memory");
        }
    }
    __syncthreads();
}

struct Args { const float* in[26]; float* out; unsigned char* ws; int ph_lo, ph_hi, li, pad; };

struct Frame {
    unsigned char* lds;
    int tid, lane, wave, vcu, G;
    const float* const* in;
    float* out; unsigned char* ws;
};
enum { I_XP = 0, I_XS, I_CK, I_CV, I_SRNN, I_C, I_CCTX, I_WMOD, I_BMOD, I_GMIX, I_GFFN, I_WIN, I_CONVW, I_CONVB, I_RGWA, I_RGBA, I_RGWI, I_RGBI, I_RGLAM, I_SINK, I_WOUT, I_PWQ, I_PSK, I_PU, I_PV, I_GFINAL };
constexpr size_t O_Y = 0, O_NEWK = (size_t)NTOK * DM, O_NEWV = O_NEWK + (size_t)NCTX * 128, O_NEWRNN = O_NEWV + (size_t)NCTX * 128;

__device__ __forceinline__ int mod_index(int tok) { return tok < NCTX ? 0 : 1 + ((tok - NCTX) >> 10); }
__device__ __forceinline__ const float* x_row(const Frame& F, int tok) { return tok < NCTX ? F.in[I_XP] + (size_t)tok * DM : F.in[I_XS] + (size_t)(tok - NCTX) * DM; }

template <class RowMap>
__device__ __forceinline__ void p0_transpose_item(const float* W, int K, int N, bf16* WT, float* scr, int item, int lane, RowMap rowmap) {
    const int nblk = N / 32, kb = item / nblk, nb = item % nblk, k0 = 64 * kb, n0 = 32 * nb;
#pragma unroll 8
    for (int i = 0; i < 32; ++i) { const int kk = 2 * i + (lane >> 5); scr[kk * 33 + (lane & 31)] = W[(size_t)(k0 + kk) * N + n0 + (lane & 31)]; }
    __builtin_amdgcn_s_waitcnt(0xC07F); asm volatile("" ::: "memory");
    const int c = lane & 7;
#pragma unroll
    for (int j = 0; j < 4; ++j) { const int n = (lane >> 3) + 8 * j; const float* s = scr + (8 * c) * 33 + n;
        v4u o; o.x = pk2(s[0 * 33], s[1 * 33]); o.y = pk2(s[2 * 33], s[3 * 33]); o.z = pk2(s[4 * 33], s[5 * 33]); o.w = pk2(s[6 * 33], s[7 * 33]);
        *(v4u*)(WT + (size_t)rowmap(n0 + n) * K + k0 + 8 * c) = o; }
    __builtin_amdgcn_s_waitcnt(0xC07F); asm volatile("" ::: "memory");
}
struct MapId { __device__ __forceinline__ int operator()(int n) const { return n; } };
struct MapWin { __device__ __forceinline__ int operator()(int n) const { if (n >= 640) return n; const int hb = n & ~63, o = n & 63; return hb + ((o & 31) << 1) + (o >> 5); } };

__device__ __forceinline__ void p0_phase(Frame& F) {
    float* ldsf = (float*)F.lds;
    const int tid = F.tid, lane = F.lane, wave = F.wave, v = F.vcu;
    if (v < 192) {
        for (int i = tid; i < NMODV * DM; i += 512) { const int j = i >> 10, d = i & 1023; const float c = (j == 0) ? F.in[I_CCTX][d] : F.in[I_C][(j - 1) * DM + d]; ldsf[i] = c * sigmoidf_(c); }
        __syncthreads();
        const int e0 = 32 * v, c4 = tid & 7, kq = tid >> 3;
        float acc[NMODV][4];
#pragma unroll
        for (int j = 0; j < NMODV; ++j) { acc[j][0] = 0.f; acc[j][1] = 0.f; acc[j][2] = 0.f; acc[j][3] = 0.f; }
        const float* wm = F.in[I_WMOD] + e0 + 4 * c4;
#pragma unroll 4
        for (int kk = 0; kk < 16; ++kk) { const int k = kq * 16 + kk; const f32x4 w = *(const f32x4*)(wm + (size_t)k * MODW);
#pragma unroll
            for (int j = 0; j < NMODV; ++j) { const float s = ldsf[j * DM + k]; acc[j][0] += s * w[0]; acc[j][1] += s * w[1]; acc[j][2] += s * w[2]; acc[j][3] += s * w[3]; } }
#pragma unroll
        for (int j = 0; j < NMODV; ++j)
#pragma unroll
            for (int i = 0; i < 4; ++i) { float a = acc[j][i]; a += __shfl_xor(a, 8); a += __shfl_xor(a, 16); a += __shfl_xor(a, 32); acc[j][i] = a; }
        float* red = ldsf + NMODV * DM;
        if (lane < 8) {
#pragma unroll
            for (int j = 0; j < NMODV; ++j)
#pragma unroll
                for (int i = 0; i < 4; ++i) red[(wave * NMODV + j) * 32 + 4 * c4 + i] = acc[j][i];
        }
        __syncthreads();
        if (tid < NMODV * 32) { const int j = tid >> 5, col = tid & 31; float s = F.in[I_BMOD][e0 + col];
#pragma unroll
            for (int w = 0; w < 8; ++w) s += red[(w * NMODV + j) * 32 + col];
            ((float*)(F.ws + WS_MODS))[j * MODW + e0 + col] = s; }
        __syncthreads();
    }
    if (v < 256) {
        const int hh = v >> 4, dt = v & 15, d0 = 64 * dt;
        float* At = ldsf;
        float* Bkt = ldsf + 128 * 64;
        const float* wq = F.in[I_PWQ] + hh * 128;
        const float* sk = F.in[I_PSK] + (size_t)hh * 128 * 128;
#pragma unroll
        for (int i = 0; i < 4; ++i) { const int f = tid + 512 * i, d = f & 63, q4 = f >> 6; const f32x4 a = *(const f32x4*)(wq + (size_t)(d0 + d) * 2048 + 4 * q4);
            At[(4 * q4 + 0) * 64 + d] = a[0]; At[(4 * q4 + 1) * 64 + d] = a[1]; At[(4 * q4 + 2) * 64 + d] = a[2]; At[(4 * q4 + 3) * 64 + d] = a[3]; }
#pragma unroll
        for (int i = 0; i < 8; ++i) { const int f = tid + 512 * i, key = f & 127, q4 = f >> 7; const f32x4 b = *(const f32x4*)(sk + (size_t)key * 128 + 4 * q4);
            Bkt[(4 * q4 + 0) * 128 + key] = b[0]; Bkt[(4 * q4 + 1) * 128 + key] = b[1]; Bkt[(4 * q4 + 2) * 128 + key] = b[2]; Bkt[(4 * q4 + 3) * 128 + key] = b[3]; }
        __syncthreads();
        const int dg = tid & 15, kg = tid >> 4;
        float acc[4][4];
#pragma unroll
        for (int i = 0; i < 4; ++i)
#pragma unroll
            for (int j = 0; j < 4; ++j) acc[i][j] = 0.f;
#pragma unroll 4
        for (int q = 0; q < 128; ++q) { const f32x4 a = *(const f32x4*)(At + q * 64 + 4 * dg); const f32x4 b = *(const f32x4*)(Bkt + q * 128 + 4 * kg);
#pragma unroll
            for (int i = 0; i < 4; ++i)
#pragma unroll
                for (int j = 0; j < 4; ++j) acc[i][j] += a[i] * b[j]; }
        bf16* WcT = (bf16*)(F.ws + WS_WC);
#pragma unroll
        for (int j = 0; j < 4; ++j) { v2u o; o.x = pk2(acc[0][j], acc[1][j]); o.y = pk2(acc[2][j], acc[3][j]);
            *(v2u*)(WcT + (size_t)(hh * 128 + 4 * kg + j) * DM + d0 + 4 * dg) = o; }
        __syncthreads();
    }
    const int gw = v * NWAVES + wave, NGW = F.G * NWAVES;
    float* scr = ldsf + wave * 4096;
    {
        constexpr int I_IN = (DM / 64) * (D_IN / 32), I_OUT = (DM / 64) * (DM / 32), I_RG = 32 * 2;
        constexpr int NIT = I_IN + I_OUT + I_RG;
        for (int it = gw; it < NIT; it += NGW) {
            int r = it;
            if (r < I_IN) { p0_transpose_item(F.in[I_WIN], DM, D_IN, (bf16*)(F.ws + WS_WIN), scr, r, lane, MapWin()); continue; } r -= I_IN;
            if (r < I_OUT) { p0_transpose_item(F.in[I_WOUT], DM, DM, (bf16*)(F.ws + WS_WOUT), scr, r, lane, MapId()); continue; } r -= I_OUT;
            { const int mm = r >> 1, sub = r & 1, dir = mm >> 4, n = (mm >> 1) & 7, gate = mm & 1;
              const float* src = (gate ? F.in[I_RGWI] : F.in[I_RGWA]) + (size_t)(dir * 8 + n) * 4096;
              bf16* dst = (bf16*)(F.ws + WS_RGW) + (size_t)((dir * 8 + n) * 2 + gate) * 4096;
              p0_transpose_item(src, 64, 64, dst, scr, sub, lane, MapId()); }
        }
    }
    for (int it = gw; it < 2 * 16384; it += NGW) {
        const int tb = it >> 14, row = it & 16383;
        const float* src = (tb ? F.in[I_PV] : F.in[I_PU]) + (size_t)row * DM;
        bf16* dst = (bf16*)(F.ws + (tb ? WS_V : WS_U)) + (size_t)row * DM;
#pragma unroll
        for (int j = 0; j < 2; ++j) { const int e = j * 512 + lane * 8; const f32x4 a = *(const f32x4*)(src + e), b = *(const f32x4*)(src + e + 4);
            v4u o; o.x = pk2(a[0], a[1]); o.y = pk2(a[2], a[3]); o.z = pk2(b[0], b[1]); o.w = pk2(b[2], b[3]); *(v4u*)(dst + e) = o; }
    }
    const int gt = v * 512 + tid, NGT = F.G * 512;
    for (int e = gt; e < 8 * 256 * 128; e += NGT) {
        const int c = e & 127, bp = e >> 7, kvh = c >> 6, p = c & 63, old = (p & 1) ? 32 + (p >> 1) : (p >> 1);
        ((bf16*)(F.ws + WS_CK))[e] = (bf16)f2bf(F.in[I_CK][(size_t)bp * 128 + kvh * 64 + old]);
    }
    for (int e = gt; e < 8 * 256 * 128; e += NGT) {
        const int pos = e & 255, d = (e >> 8) & 63, kvh = (e >> 14) & 1, b = e >> 15;
        ((bf16*)(F.ws + WS_CVT))[e] = (bf16)f2bf(F.in[I_CV][(size_t)(b * 256 + pos) * 128 + kvh * 64 + d]);
    }
    for (int e = gt; e < 1024 * 32; e += NGT) {
        const int s = e >> 5, i = e & 31, row = s >> 6, col = s & 63;
        const float inv = powf(10000.0f, -(float)(i & 15) / 16.0f);
        const float ang = (i < 16 ? (float)row : (float)col) * inv;
        f32x2 cs; cs.x = cosf(ang); cs.y = sinf(ang);
        ((f32x2*)(F.ws + WS_ROPE))[e] = cs;
    }
}

__device__ __forceinline__ void norm_phase(Frame& F, int which) {
    const int gw = F.vcu * NWAVES + F.wave, NGW = F.G * NWAVES, lane = F.lane;
    const float* mods = (const float*)(F.ws + WS_MODS);
    const float* g = F.in[which ? I_GFFN : I_GMIX];
    bf16* H = (bf16*)(F.ws + WS_H);
    for (int tok = gw; tok < NTOK; tok += NGW) {
        const float* xr = which ? F.out + O_Y + (size_t)tok * DM : x_row(F, tok);
        const float* mv = mods + (size_t)mod_index(tok) * MODW + (which ? 3 * DM : 0);
        f32x4 v[4]; float ss = 0.f;
#pragma unroll
        for (int j = 0; j < 4; ++j) { v[j] = *(const f32x4*)(xr + 256 * j + 4 * lane); ss += (v[j][0] * v[j][0] + v[j][1] * v[j][1]) + (v[j][2] * v[j][2] + v[j][3] * v[j][3]); }
        const float rstd = 1.f / sqrtf(wave_sum(ss) * (1.f / DM) + EPS);
#pragma unroll
        for (int j = 0; j < 4; ++j) { const int e = 256 * j + 4 * lane;
            const f32x4 gg = *(const f32x4*)(g + e), sh = *(const f32x4*)(mv + e), sc = *(const f32x4*)(mv + DM + e);
            f32x4 o;
#pragma unroll
            for (int i = 0; i < 4; ++i) o[i] = v[j][i] * rstd * gg[i] * (1.f + sc[i]) + sh[i];
            v2u w; w.x = pk2(o[0], o[1]); w.y = pk2(o[2], o[3]); *(v2u*)(H + (size_t)tok * DM + e) = w; }
    }
}

struct EpiInProj {
    static constexpr bool PERM = false;
    bf16 *q, *k, *vT, *xr, *yg; float *newk, *newv; const f32x4* rope4;
    __device__ __forceinline__ void operator()(const f32x4 (&acc)[2][2][4][2], const pg8::Unit& u, int wr, int wc, int fr, int fq) const {
        const bool lat = u.pm >= 32;
        const int pn = u.pn;
#pragma unroll
        for (int ai = 0; ai < 2; ++ai)
#pragma unroll
            for (int m = 0; m < 4; ++m) {
                const int row = u.pm * 256 + ai * 128 + wr * 64 + m * 16 + fr;
                const int pos = lat ? ((row - NCTX) & 1023) : (row & 255);
#pragma unroll
                for (int bj = 0; bj < 2; ++bj)
#pragma unroll
                    for (int n = 0; n < 2; ++n) {
                        const int c = pn * 256 + bj * 128 + wc * 32 + n * 16 + 4 * fq;
                        f32x4 v = acc[ai][bj][m][n];
                        if (pn < 2 || (pn == 2 && bj == 0)) {
                            const int i = (c & 63) >> 1;
                            if (lat) { const f32x4 cs = rope4[(pos * 32 + i) >> 1];
                                const float a0 = v[0] * cs[0] - v[1] * cs[1], a1 = v[1] * cs[0] + v[0] * cs[1];
                                const float b0 = v[2] * cs[2] - v[3] * cs[3], b1 = v[3] * cs[2] + v[2] * cs[3];
                                v[0] = a0; v[1] = a1; v[2] = b0; v[3] = b1; }
                            if (pn < 2) { v2u w; w.x = pk2(v[0] * QSCALE, v[1] * QSCALE); w.y = pk2(v[2] * QSCALE, v[3] * QSCALE); *(v2u*)(q + (size_t)row * 512 + c) = w; }
                            else { const int kc = c - 512; v2u w; w.x = pk2(v[0], v[1]); w.y = pk2(v[2], v[3]); *(v2u*)(k + (size_t)row * 128 + kc) = w;
                                if (!lat) { float* nk = newk + (size_t)row * 128 + (kc & 64) + i; f32x2 lo; lo.x = v[0]; lo.y = v[2]; f32x2 hi; hi.x = v[1]; hi.y = v[3]; *(f32x2*)nk = lo; *(f32x2*)(nk + 32) = hi; } }
                        } else if (pn == 2) {
                            const int vc = c - 640, kvh = vc >> 6, d = vc & 63;
                            if (!lat) *(f32x4*)(newv + (size_t)row * 128 + vc) = v;
                            bf16* vp; int S;
                            if (!lat) { S = SEQ_C; vp = vT + ((size_t)((row >> 8) * 2 + kvh) * 64 + d) * SEQ_C + pos; }
                            else { S = SEQ_L; vp = vT + VT_LAT_OFF + ((size_t)(((row - NCTX) >> 10) * 2 + kvh) * 64 + d) * SEQ_L + pos; }
                            vp[0] = (bf16)f2bf(v[0]); vp[S] = (bf16)f2bf(v[1]); vp[2 * S] = (bf16)f2bf(v[2]); vp[3 * S] = (bf16)f2bf(v[3]);
                        } else if (pn < 5) {
                            v2u w; w.x = pk2(v[0], v[1]); w.y = pk2(v[2], v[3]); *(v2u*)(xr + (size_t)row * 512 + (c - 768)) = w;
                        } else {
                            v2u w; w.x = pk2(v[0], v[1]); w.y = pk2(v[2], v[3]); *(v2u*)(yg + (size_t)row * 512 + (c - 1280)) = w;
                        }
                    }
            }
    }
};
struct EpiOutProj {
    static constexpr bool PERM = false;
    const float *xp, *xs, *mods; float* x1;
    __device__ __forceinline__ void operator()(const f32x4 (&acc)[2][2][4][2], const pg8::Unit& u, int wr, int wc, int fr, int fq) const {
        const int mi = u.pm < 32 ? 0 : 1 + ((u.pm - 32) >> 2);
        const float* ga = mods + (size_t)mi * MODW + 2 * DM;
#pragma unroll
        for (int ai = 0; ai < 2; ++ai)
#pragma unroll
            for (int m = 0; m < 4; ++m) {
                const int row = u.pm * 256 + ai * 128 + wr * 64 + m * 16 + fr;
                const float* xrow = row < NCTX ? xp + (size_t)row * DM : xs + (size_t)(row - NCTX) * DM;
#pragma unroll
                for (int bj = 0; bj < 2; ++bj)
#pragma unroll
                    for (int n = 0; n < 2; ++n) {
                        const int c = u.pn * 256 + bj * 128 + wc * 32 + n * 16 + 4 * fq;
                        const f32x4 xv = *(const f32x4*)(xrow + c), gv = *(const f32x4*)(ga + c);
                        *(f32x4*)(x1 + (size_t)row * DM + c) = xv + gv * acc[ai][bj][m][n];
                    }
            }
    }
};
struct EpiScores {
    static constexpr bool PERM = true;
    bf16* sc;
    __device__ __forceinline__ void operator()(const f32x4 (&acc)[2][2][4][2], const pg8::Unit& u, int wr, int wc, int fr, int fq) const {
#pragma unroll
        for (int ai = 0; ai < 2; ++ai)
#pragma unroll
            for (int m = 0; m < 4; ++m) {
                const int row = u.pm * 256 + ai * 128 + wr * 64 + m * 16 + fr;
#pragma unroll
                for (int bj = 0; bj < 2; ++bj) {
                    const int c = u.pn * 256 + bj * 128 + wc * 32 + 8 * fq;
                    const f32x4 v0 = acc[ai][bj][m][0], v1 = acc[ai][bj][m][1];
                    v4u w; w.x = pk2(v0[0], v0[1]); w.y = pk2(v0[2], v0[3]); w.z = pk2(v1[0], v1[1]); w.w = pk2(v1[2], v1[3]);
                    *(v4u*)(sc + (size_t)row * 2048 + c) = w;
                }
            }
    }
};

__device__ __forceinline__ void attn_unit(Frame& F, bool lat, int seq, int kvh, int qt) {
    const int tid = F.tid, lane = F.lane, wave = F.wave, r32 = lane & 31, hi = lane >> 5;
    const int g = wave >> 1, qs = wave & 1, head = kvh * 4 + g;
    const int S = lat ? SEQ_L : SEQ_C, tokbase = lat ? NCTX + seq * SEQ_L : seq * SEQ_C;
    const int q0 = qt * 64, qpos = q0 + 32 * qs + r32;
    const bf16* Q = (const bf16*)(F.ws + WS_Q); const bf16* Kb = (const bf16*)(F.ws + WS_K); const bf16* VT = (const bf16*)(F.ws + WS_VT);
    const bf16* CK = (const bf16*)(F.ws + WS_CK); const bf16* CVT = (const bf16*)(F.ws + WS_CVT);
    unsigned char* ldsK = F.lds; unsigned char* ldsV = F.lds + 8192;
    bf16x8 qf[4];
    { const bf16* qp = Q + (size_t)(tokbase + qpos) * 512 + head * 64;
#pragma unroll
      for (int ks = 0; ks < 4; ++ks) qf[ks] = *(const bf16x8*)(qp + 16 * ks + 8 * hi); }
    const float sinkl = F.in[I_SINK][head] * LOG2E;
    float mrun = sinkl, lrun = (hi == 0) ? 1.f : 0.f;
    f32x16 o0, o1;
#pragma unroll
    for (int r = 0; r < 16; ++r) { o0[r] = 0.f; o1[r] = 0.f; }
    int tlo, thi;
    if (lat) { tlo = (q0 >= 128 ? q0 - 128 : 0) >> 6; thi = ((q0 + 192 < S ? q0 + 192 : S)) >> 6; } else { tlo = 0; thi = 4; }
    const int nband = thi - tlo, ntile = nband + (lat ? 4 : 0);
    const int key_t = tid >> 3, ch_t = tid & 7;
    for (int t = 0; t < ntile; ++t) {
        const bool band = t < nband;
        const bf16* kptr; const bf16* vptr; int vstride; int kbase = 0;
        if (band) { const int tile = tlo + t; kbase = tile * 64;
            kptr = Kb + (size_t)(tokbase + kbase) * 128 + kvh * 64;
            vptr = VT + (lat ? (size_t)VT_LAT_OFF + (size_t)((seq * 2 + kvh) * 64) * SEQ_L : (size_t)((seq * 2 + kvh) * 64) * SEQ_C) + kbase; vstride = S;
        } else { const int tc = t - nband;
            kptr = CK + (size_t)(seq * 256 + tc * 64) * 128 + kvh * 64;
            vptr = CVT + (size_t)((seq * 2 + kvh) * 64) * 256 + tc * 64; vstride = 256; }
        const v4u kv = *(const v4u*)(kptr + (size_t)key_t * 128 + ch_t * 8);
        const v4u vv = *(const v4u*)(vptr + (size_t)key_t * vstride + ch_t * 8);
        __syncthreads();
        *(v4u*)(ldsK + key_t * 128 + ((ch_t ^ (key_t & 7)) * 16)) = kv;
        *(v4u*)(ldsV + key_t * 128 + ((ch_t ^ (key_t & 7)) * 16)) = vv;
        __syncthreads();
        f32x16 p0, p1;
#pragma unroll
        for (int r = 0; r < 16; ++r) { p0[r] = 0.f; p1[r] = 0.f; }
#pragma unroll
        for (int ks = 0; ks < 4; ++ks) {
            const int sw = ((2 * ks + hi) ^ (r32 & 7)) * 16;
            const bf16x8 a0 = *(const bf16x8*)(ldsK + r32 * 128 + sw);
            const bf16x8 a1 = *(const bf16x8*)(ldsK + (32 + r32) * 128 + sw);
            p0 = __builtin_amdgcn_mfma_f32_32x32x16_bf16(a0, qf[ks], p0, 0, 0, 0);
            p1 = __builtin_amdgcn_mfma_f32_32x32x16_bf16(a1, qf[ks], p1, 0, 0, 0);
        }
        if (band && lat) {
#pragma unroll
            for (int r = 0; r < 16; ++r) { const int kp = kbase + crow(r, hi); int d0 = qpos - kp; d0 = d0 < 0 ? -d0 : d0; int d1 = qpos - kp - 32; d1 = d1 < 0 ? -d1 : d1;
                if (d0 > 128) p0[r] = -INFINITY; if (d1 > 128) p1[r] = -INFINITY; }
        }
        float tm = p0[0];
#pragma unroll
        for (int r = 1; r < 16; ++r) tm = fmaxf(tm, p0[r]);
#pragma unroll
        for (int r = 0; r < 16; ++r) tm = fmaxf(tm, p1[r]);
        tm = fmaxf(tm, __shfl_xor(tm, 32));
        const float mn = fmaxf(mrun, tm), alpha = exp2f(mrun - mn); mrun = mn;
        float ls = 0.f;
#pragma unroll
        for (int r = 0; r < 16; ++r) { p0[r] = exp2f(p0[r] - mn); p1[r] = exp2f(p1[r] - mn); ls += p0[r] + p1[r]; o0[r] *= alpha; o1[r] *= alpha; }
        lrun = lrun * alpha + ls;
        bf16x8 pf[4];
#pragma unroll
        for (int s = 0; s < 2; ++s) {
            v4u w0, w1;
            w0.x = pk2(p0[8 * s + 0], p0[8 * s + 1]); w0.y = pk2(p0[8 * s + 2], p0[8 * s + 3]); w0.z = pk2(p0[8 * s + 4], p0[8 * s + 5]); w0.w = pk2(p0[8 * s + 6], p0[8 * s + 7]);
            w1.x = pk2(p1[8 * s + 0], p1[8 * s + 1]); w1.y = pk2(p1[8 * s + 2], p1[8 * s + 3]); w1.z = pk2(p1[8 * s + 4], p1[8 * s + 5]); w1.w = pk2(p1[8 * s + 6], p1[8 * s + 7]);
            pf[s] = __builtin_bit_cast(bf16x8, w0); pf[2 + s] = __builtin_bit_cast(bf16x8, w1);
        }
#pragma unroll
        for (int s4 = 0; s4 < 4; ++s4) {
#pragma unroll
            for (int dt = 0; dt < 2; ++dt) {
                const int d = 32 * dt + r32;
                const v2u lo = *(const v2u*)(ldsV + d * 128 + (((2 * s4) ^ (d & 7)) * 16) + 8 * hi);
                const v2u hi2 = *(const v2u*)(ldsV + d * 128 + (((2 * s4 + 1) ^ (d & 7)) * 16) + 8 * hi);
                v4u vf4; vf4.x = lo.x; vf4.y = lo.y; vf4.z = hi2.x; vf4.w = hi2.y;
                const bf16x8 vf = __builtin_bit_cast(bf16x8, vf4);
                if (dt == 0) o0 = __builtin_amdgcn_mfma_f32_32x32x16_bf16(vf, pf[s4], o0, 0, 0, 0);
                else o1 = __builtin_amdgcn_mfma_f32_32x32x16_bf16(vf, pf[s4], o1, 0, 0, 0);
            }
        }
    }
    const float ltot = lrun + __shfl_xor(lrun, 32), inv = 1.f / ltot;
    bf16* mix = (bf16*)(F.ws + WS_MIX) + (size_t)(tokbase + qpos) * DM + head * 64;
#pragma unroll
    for (int g4 = 0; g4 < 4; ++g4) {
        v2u w; w.x = pk2(o0[4 * g4] * inv, o0[4 * g4 + 1] * inv); w.y = pk2(o0[4 * g4 + 2] * inv, o0[4 * g4 + 3] * inv);
        *(v2u*)(mix + 8 * g4 + 4 * hi) = w;
        v2u w2; w2.x = pk2(o1[4 * g4] * inv, o1[4 * g4 + 1] * inv); w2.y = pk2(o1[4 * g4 + 2] * inv, o1[4 * g4 + 3] * inv);
        *(v2u*)(mix + 32 + 8 * g4 + 4 * hi) = w2;
    }
    __syncthreads();
}

constexpr int RL_XC32 = 0, RL_XCB = 32768, RL_LA = 49152, RL_LB = 81920, RL_SEGA = 114688, RL_SEGB = 116736, RL_CARRY = 118784;
__device__ __forceinline__ void rnn_unit(Frame& F, bool lat, int seq, int n) {
    const int lane = F.lane, wave = F.wave, r32 = lane & 31, hi = lane >> 5;
    const int S = lat ? SEQ_L : SEQ_C, tokbase = lat ? NCTX + seq * SEQ_L : seq * SEQ_C, nchunk = S / 128;
    float* XC32 = (float*)(F.lds + RL_XC32); unsigned char* XCB = F.lds + RL_XCB; float* LA = (float*)(F.lds + RL_LA); float* LB = (float*)(F.lds + RL_LB);
    float* SEGA = (float*)(F.lds + RL_SEGA); float* SEGB = (float*)(F.lds + RL_SEGB); float* CARRY = (float*)(F.lds + RL_CARRY);
    const bf16* XR = (const bf16*)(F.ws + WS_XR) + (size_t)tokbase * 512 + n * 64 + lane;
    const bf16* YG = (const bf16*)(F.ws + WS_YG) + (size_t)tokbase * 512 + n * 64 + lane;
    float* HF = (float*)(F.ws + WS_HF) + (size_t)tokbase * 512 + n * 64 + lane;
    bf16* MIX = (bf16*)(F.ws + WS_MIX) + (size_t)tokbase * DM + 512 + n * 64 + lane;
    const int chc = n * 64 + lane;
    const float cw0 = F.in[I_CONVW][chc], cw1 = F.in[I_CONVW][512 + chc], cw2 = F.in[I_CONVW][1024 + chc], cw3 = F.in[I_CONVW][1536 + chc], cb = F.in[I_CONVB][chc];
    const int tt = wave >> 1, chh = wave & 1, che = chh * 32 + r32;
    const int seg = wave;
#pragma unroll 1
    for (int dir = 0; dir < 2; ++dir) {
        bf16x8 wf[2][4];
        { const bf16* wg = (const bf16*)(F.ws + WS_RGW) + (size_t)((dir * 8 + n) * 2) * 4096 + (size_t)che * 64 + 8 * hi;
#pragma unroll
          for (int gt = 0; gt < 2; ++gt)
#pragma unroll
            for (int ks = 0; ks < 4; ++ks) wf[gt][ks] = *(const bf16x8*)(wg + gt * 4096 + 16 * ks); }
        const int pe = dir * 512 + n * 64 + che;
        const float ba = F.in[I_RGBA][pe], bi = F.in[I_RGBI][pe];
        float sp8; { const float nl = -F.in[I_RGLAM][pe]; sp8 = 8.f * (nl > 20.f ? nl : log1pf(__expf(nl))); }
        __syncthreads();
        if (wave == 0) CARRY[lane] = lat ? F.in[I_SRNN][(size_t)(seq * 2 + dir) * 512 + chc] : 0.f;
#pragma unroll 1
        for (int ci = 0; ci < nchunk; ++ci) {
            const int c0 = (dir == 0 ? ci : nchunk - 1 - ci) * 128;
            __syncthreads();
            {
                float xv[19];
#pragma unroll
                for (int i = 0; i < 19; ++i) { const int pos = c0 + seg * 16 - 2 + i; xv[i] = (pos >= 0 && pos < S) ? bf2f(XR[(size_t)pos * 512]) : 0.f; }
#pragma unroll
                for (int i = 0; i < 16; ++i) { const float y = cb + cw0 * xv[i] + cw1 * xv[i + 1] + cw2 * xv[i + 2] + cw3 * xv[i + 3];
                    const int tk = seg * 16 + i; XC32[tk * 64 + lane] = y;
                    *(bf16*)(XCB + tk * 128 + (((lane >> 3) ^ (tk & 7)) * 16) + (lane & 7) * 2) = (bf16)f2bf(y); }
            }
            __syncthreads();
            {
                f32x16 ga, gi;
#pragma unroll
                for (int r = 0; r < 16; ++r) { ga[r] = 0.f; gi[r] = 0.f; }
                const int tk = tt * 32 + r32;
#pragma unroll
                for (int ks = 0; ks < 4; ++ks) {
                    const bf16x8 af = *(const bf16x8*)(XCB + tk * 128 + (((2 * ks + hi) ^ (tk & 7)) * 16));
                    ga = __builtin_amdgcn_mfma_f32_32x32x16_bf16(af, wf[0][ks], ga, 0, 0, 0);
                    gi = __builtin_amdgcn_mfma_f32_32x32x16_bf16(af, wf[1][ks], gi, 0, 0, 0);
                }
#pragma unroll
                for (int r = 0; r < 16; ++r) { const int tk2 = tt * 32 + crow(r, hi); const float x = XC32[tk2 * 64 + che];
                    const float rg = sigmoidf_(ga[r] + ba), ig = sigmoidf_(gi[r] + bi), la = -rg * sp8, a = __expf(la);
                    const float b = sqrtf(fmaxf(-expm1f(2.f * la), 0.f)) * ig * x;
                    LA[tk2 * 64 + che] = a; LB[tk2 * 64 + che] = b; }
            }
            __syncthreads();
            {
                float A = 1.f, B = 0.f;
#pragma unroll
                for (int i = 0; i < 16; ++i) { const int tk = seg * 16 + (dir == 0 ? i : 15 - i); const float a = LA[tk * 64 + lane], b = LB[tk * 64 + lane]; B = a * B + b; A = a * A; }
                SEGA[seg * 64 + lane] = A; SEGB[seg * 64 + lane] = B;
            }
            __syncthreads();
            {
                float h = CARRY[lane];
                if (dir == 0) { for (int s2 = 0; s2 < seg; ++s2) h = SEGA[s2 * 64 + lane] * h + SEGB[s2 * 64 + lane]; }
                else { for (int s2 = 7; s2 > seg; --s2) h = SEGA[s2 * 64 + lane] * h + SEGB[s2 * 64 + lane]; }
#pragma unroll
                for (int i = 0; i < 16; ++i) { const int tk = seg * 16 + (dir == 0 ? i : 15 - i); const float a = LA[tk * 64 + lane], b = LB[tk * 64 + lane]; h = a * h + b;
                    const int pos = c0 + tk;
                    if (dir == 0) { HF[(size_t)pos * 512] = h;
                        if (!lat && pos == S - 1) F.out[O_NEWRNN + (size_t)(seq * 2 + 0) * 512 + chc] = h; }
                    else { const float hf = HF[(size_t)pos * 512]; const float y = bf2f(YG[(size_t)pos * 512]);
                        MIX[(size_t)pos * DM] = (bf16)f2bf((hf + h) * gelu_tanh(y));
                        if (!lat && pos == 0) F.out[O_NEWRNN + (size_t)(seq * 2 + 1) * 512 + chc] = h; } }
                __syncthreads();
                if ((dir == 0 && seg == 7) || (dir == 1 && seg == 0)) CARRY[lane] = h;
            }
        }
    }
    __syncthreads();
}

__device__ __forceinline__ void p3_phase(Frame& F) {
    for (int it = F.vcu; it < 832; it += F.G) {
        bool lat; int a;
        if (it < 64 || (it >= 320 && it < 576)) { lat = it < 64; a = lat ? it : it - 320; rnn_unit(F, lat, a >> 3, a & 7); }
        else { lat = it < 320; a = lat ? it - 64 : it - 576;
            if (lat) attn_unit(F, true, a >> 5, (a >> 4) & 1, a & 15); else attn_unit(F, false, a >> 3, (a >> 2) & 1, a & 3); }
    }
}

__device__ __forceinline__ unsigned key16(unsigned b, unsigned idx) { const unsigned s = (b & 0x8000u) ? (~b & 0xffffu) : (b | 0x8000u); return (s << 16) | idx; }
__device__ __forceinline__ float keyval16(unsigned k) { const unsigned s = k >> 16; const unsigned b = (s & 0x8000u) ? (s & 0x7fffu) : (~s & 0xffffu); return bf2f(b); }
__device__ __forceinline__ unsigned sortable32(float f) { const unsigned u = __builtin_bit_cast(unsigned, f); return (u & 0x80000000u) ? ~u : (u | 0x80000000u); }

__device__ __forceinline__ void p7_phase(Frame& F) {
    const int gw = F.vcu * NWAVES + F.wave, NGW = F.G * NWAVES, lane = F.lane;
    const bf16* SC = (const bf16*)(F.ws + WS_SC); const bf16* H2 = (const bf16*)(F.ws + WS_H);
    const bf16* U = (const bf16*)(F.ws + WS_U); const bf16* V = (const bf16*)(F.ws + WS_V);
    const float* mods = (const float*)(F.ws + WS_MODS);
    for (int tok = gw; tok < NTOK; tok += NGW) {
        const bf16* sc = SC + (size_t)tok * 2048;
        int e0 = 0, e1 = 0; float g0 = 0.f, g1 = 0.f;
#pragma unroll 1
        for (int h = 0; h < 8; ++h) {
            float va = 0.f, vb = 0.f; int ia = 0, ib = 0;
#pragma unroll 1
            for (int half = 0; half < 2; ++half) {
                const bf16* sp = sc + h * 256 + half * 128;
                unsigned k0 = key16(sp[lane], lane), k1 = key16(sp[64 + lane], 64 + lane), keep = 0;
#pragma unroll 1
                for (int it = 0; it < 16; ++it) { const unsigned best = wave_max_u32(k0 > k1 ? k0 : k1); if (k0 == best) k0 = 0; if (k1 == best) k1 = 0; if (lane == it) keep = best; }
                if (half == 0) { va = keyval16(keep); ia = keep & 127; } else { vb = keyval16(keep); ib = keep & 127; }
            }
            const float a = __shfl(va, lane >> 2);
            unsigned ck[4];
#pragma unroll
            for (int jj = 0; jj < 4; ++jj) { const int j = 4 * (lane & 3) + jj; const float b = __shfl(vb, j); ck[jj] = (sortable32(a + b) & 0xffffff00u) | (unsigned)((lane >> 2) * 16 + j); }
            unsigned keep = 0;
#pragma unroll 1
            for (int it = 0; it < 16; ++it) { unsigned m = ck[0] > ck[1] ? ck[0] : ck[1]; const unsigned m2 = ck[2] > ck[3] ? ck[2] : ck[3]; m = m > m2 ? m : m2; const unsigned best = wave_max_u32(m);
#pragma unroll
                for (int jj = 0; jj < 4; ++jj) if (ck[jj] == best) ck[jj] = 0;
                if (lane == it) keep = best; }
            const int ci = (keep >> 4) & 15, cj = keep & 15;
            const float bv = __shfl(va, ci) + __shfl(vb, cj);
            const int eid = __shfl(ia, ci) * 128 + __shfl(ib, cj);
            float mx = bv;
#pragma unroll
            for (int o = 1; o < 16; o <<= 1) mx = fmaxf(mx, __shfl_xor(mx, o));
            const float ex = __expf(bv - mx); float sm = ex;
#pragma unroll
            for (int o = 1; o < 16; o <<= 1) sm += __shfl_xor(sm, o);
            const float gg = ex / sm;
            const int te = __shfl(eid, lane & 15); const float tg = __shfl(gg, lane & 15);
            const bool sel = (lane >> 4) == (h & 3);
            if (h < 4) { e0 = sel ? te : e0; g0 = sel ? tg : g0; } else { e1 = sel ? te : e1; g1 = sel ? tg : g1; }
        }
        float hv[16];
        { const v4u a = *(const v4u*)(H2 + (size_t)tok * DM + 8 * lane), b = *(const v4u*)(H2 + (size_t)tok * DM + 512 + 8 * lane);
          hv[0] = bflo(a.x); hv[1] = bfhi(a.x); hv[2] = bflo(a.y); hv[3] = bfhi(a.y); hv[4] = bflo(a.z); hv[5] = bfhi(a.z); hv[6] = bflo(a.w); hv[7] = bfhi(a.w);
          hv[8] = bflo(b.x); hv[9] = bfhi(b.x); hv[10] = bflo(b.y); hv[11] = bfhi(b.y); hv[12] = bflo(b.z); hv[13] = bfhi(b.z); hv[14] = bflo(b.w); hv[15] = bfhi(b.w); }
        float acc[16];
#pragma unroll
        for (int i = 0; i < 16; ++i) acc[i] = 0.f;
#pragma unroll 1
        for (int L0 = 0; L0 < 128; L0 += 4) {
            int eid[4]; float gg[4]; v4u ua[4], ub[4];
#pragma unroll
            for (int x = 0; x < 4; ++x) { const int L = L0 + x; eid[x] = __builtin_amdgcn_readfirstlane(__shfl(L0 < 64 ? e0 : e1, L & 63)); gg[x] = __builtin_bit_cast(float, __builtin_amdgcn_readfirstlane(__builtin_bit_cast(int, __shfl(L0 < 64 ? g0 : g1, L & 63))));
                const bf16* up = U + (size_t)eid[x] * DM; ua[x] = *(const v4u*)(up + 8 * lane); ub[x] = *(const v4u*)(up + 512 + 8 * lane); }
            float coef[4];
#pragma unroll
            for (int x = 0; x < 4; ++x) {
                float d = hv[0] * bflo(ua[x].x) + hv[1] * bfhi(ua[x].x) + hv[2] * bflo(ua[x].y) + hv[3] * bfhi(ua[x].y) + hv[4] * bflo(ua[x].z) + hv[5] * bfhi(ua[x].z) + hv[6] * bflo(ua[x].w) + hv[7] * bfhi(ua[x].w)
                        + hv[8] * bflo(ub[x].x) + hv[9] * bfhi(ub[x].x) + hv[10] * bflo(ub[x].y) + hv[11] * bfhi(ub[x].y) + hv[12] * bflo(ub[x].z) + hv[13] * bfhi(ub[x].z) + hv[14] * bflo(ub[x].w) + hv[15] * bfhi(ub[x].w);
                d = wave_sum(d);
                coef[x] = gg[x] * gelu_tanh(d);
            }
#pragma unroll
            for (int x = 0; x < 4; ++x) { const bf16* vp = V + (size_t)eid[x] * DM; const v4u a = *(const v4u*)(vp + 8 * lane), b = *(const v4u*)(vp + 512 + 8 * lane); const float c = coef[x];
                acc[0] += c * bflo(a.x); acc[1] += c * bfhi(a.x); acc[2] += c * bflo(a.y); acc[3] += c * bfhi(a.y); acc[4] += c * bflo(a.z); acc[5] += c * bfhi(a.z); acc[6] += c * bflo(a.w); acc[7] += c * bfhi(a.w);
                acc[8] += c * bflo(b.x); acc[9] += c * bfhi(b.x); acc[10] += c * bflo(b.y); acc[11] += c * bfhi(b.y); acc[12] += c * bflo(b.z); acc[13] += c * bfhi(b.z); acc[14] += c * bflo(b.w); acc[15] += c * bfhi(b.w); }
        }
        float* xrow = F.out + O_Y + (size_t)tok * DM;
        const float* ga2 = mods + (size_t)mod_index(tok) * MODW + 5 * DM;
        const float* gf = F.in[I_GFINAL];
        float x2[16]; float ss = 0.f;
#pragma unroll
        for (int j = 0; j < 2; ++j)
#pragma unroll
            for (int q = 0; q < 2; ++q) { const int e = j * 512 + 8 * lane + 4 * q; const f32x4 xv = *(const f32x4*)(xrow + e), gv = *(const f32x4*)(ga2 + e);
#pragma unroll
                for (int i = 0; i < 4; ++i) { const float t = xv[i] + gv[i] * acc[j * 8 + q * 4 + i]; x2[j * 8 + q * 4 + i] = t; ss += t * t; } }
        const float rstd = 1.f / sqrtf(wave_sum(ss) * (1.f / DM) + EPS);
#pragma unroll
        for (int j = 0; j < 2; ++j)
#pragma unroll
            for (int q = 0; q < 2; ++q) { const int e = j * 512 + 8 * lane + 4 * q; const f32x4 gv = *(const f32x4*)(gf + e); f32x4 o;
#pragma unroll
                for (int i = 0; i < 4; ++i) o[i] = x2[j * 8 + q * 4 + i] * rstd * gv[i];
                *(f32x4*)(xrow + e) = o; }
    }
}

__global__ void __launch_bounds__(NWAVES * 64, 2) mk_fwd(Args args) {
    extern __shared__ __attribute__((aligned(16))) unsigned char lds[];
    Frame F;
    F.lds = lds;
    F.tid = threadIdx.x; F.lane = F.tid & 63; F.wave = __builtin_amdgcn_readfirstlane(F.tid >> 6);
    F.G = gridDim.x; { const int bx = blockIdx.x; F.vcu = (F.G % 8 == 0) ? (bx % 8) * (F.G / 8) + bx / 8 : bx; }
    F.in = args.in; F.out = args.out; F.ws = args.ws;
    LAS unsigned char* lds3 = (LAS unsigned char*)lds;
    volatile LAS unsigned* MISC = (volatile LAS unsigned*)(lds3 + MISC_OFF);
    for (int u = F.tid; u < (LDS_BYTES - LDSCTL_OFF) / 4; u += NWAVES * 64) ((LAS unsigned*)(lds3 + LDSCTL_OFF))[u] = 0u;
    __syncthreads();
    unsigned* ctl = (unsigned*)(args.ws + WS_CTL);
    XcdBarrier bar; bar.bar = ctl + CW_BAR; bar.x = 0; bar.st = nullptr;
    const bool one_launch = (args.ph_hi - args.ph_lo) > 1;
    if (one_launch) bar = xcd_barrier_post(ctl + CW_BAR, MISC + 8);
    const int lo = args.ph_lo, hi = args.ph_hi;
#ifndef MK_PHASE_MASK
#define MK_PHASE_MASK 0xff
#endif
#define IN(k) (((MK_PHASE_MASK >> (k)) & 1) && lo <= (k) && (k) < hi)
#define SEAM(k) do { if (IN(k) && IN((k) + 1)) xcd_barrier(bar); } while (0)

    if (IN(0)) { p0_phase(F); SEAM(0); }
    if (IN(1)) { norm_phase(F, 0); SEAM(1); }
    if (IN(2)) {
        pg8::Gemm g{(const pg8::bf16_t*)(F.ws + WS_H), (const pg8::bf16_t*)(F.ws + WS_WIN), NTOK, D_IN, DM}; pg8::StaticOrder S; S.init(NTOK, D_IN, F.G, (int)blockIdx.x);
        EpiInProj E{(bf16*)(F.ws + WS_Q), (bf16*)(F.ws + WS_K), (bf16*)(F.ws + WS_VT), (bf16*)(F.ws + WS_XR), (bf16*)(F.ws + WS_YG), F.out + O_NEWK, F.out + O_NEWV, (const f32x4*)(F.ws + WS_ROPE)};
        pg8::gemm_phase<EpiInProj, pg8::StaticOrder, true, true>(lds3, g, S, E);
        SEAM(2);
    }
    if (IN(3)) { p3_phase(F); SEAM(3); }
    if (IN(4)) {
        pg8::Gemm g{(const pg8::bf16_t*)(F.ws + WS_MIX), (const pg8::bf16_t*)(F.ws + WS_WOUT), NTOK, DM, DM}; pg8::StaticOrder S; S.init(NTOK, DM, F.G, (int)blockIdx.x);
        EpiOutProj E{F.in[I_XP], F.in[I_XS], (const float*)(F.ws + WS_MODS), F.out + O_Y};
        pg8::gemm_phase<EpiOutProj, pg8::StaticOrder, true, true>(lds3, g, S, E);
        SEAM(4);
    }
    if (IN(5)) { norm_phase(F, 1); SEAM(5); }
    if (IN(6)) {
        pg8::Gemm g{(const pg8::bf16_t*)(F.ws + WS_H), (const pg8::bf16_t*)(F.ws + WS_WC), NTOK, 2048, DM}; pg8::StaticOrder S; S.init(NTOK, 2048, F.G, (int)blockIdx.x);
        EpiScores E{(bf16*)(F.ws + WS_SC)};
        pg8::gemm_phase<EpiScores, pg8::StaticOrder, true, true>(lds3, g, S, E);
        SEAM(6);
    }
    if (IN(7)) { p7_phase(F); }
#undef IN
#undef SEAM
}

extern "C" void kernel_launch(void* const* d_in, const int* in_sizes, int n_in, void* d_out, int out_size, void* d_ws, size_t ws_size, hipStream_t stream) {
    static int grid = 0;
    if (grid == 0) {
        if (n_in != 26 || ws_size < WS_END) { fprintf(stderr, "kernel_launch: unexpected n_in %d / ws %zu\n", n_in, ws_size); grid = -1; return; }
        int dev = 0, cus = 0, per_cu = 0;
        if (hipGetDevice(&dev) != hipSuccess || hipDeviceGetAttribute(&cus, hipDeviceAttributeMultiprocessorCount, dev) != hipSuccess) { grid = -1; return; }
        if (hipFuncSetAttribute((const void*)mk_fwd, hipFuncAttributeMaxDynamicSharedMemorySize, LDS_BYTES) != hipSuccess) { fprintf(stderr, "kernel_launch: hipFuncSetAttribute failed\n"); grid = -1; return; }
        if (hipOccupancyMaxActiveBlocksPerMultiprocessor(&per_cu, (const void*)mk_fwd, NWAVES * 64, LDS_BYTES) != hipSuccess || per_cu < 1)
            fprintf(stderr, "kernel_launch: occupancy query reports %d blocks per CU\n", per_cu);
        (void)hipGetLastError();
        grid = cus;
        if (grid != 256) fprintf(stderr, "kernel_launch: note: %d CUs\n", grid);
    }
    if (grid < 0) return;
    (void)hipMemsetAsync((char*)d_ws + WS_CTL, 0, CTL_ZERO_BYTES, stream);
    Args a{};
    for (int i = 0; i < 26; ++i) a.in[i] = (const float*)d_in[i];
    a.out = (float*)d_out; a.ws = (unsigned char*)d_ws;
    if (MK_N_LAUNCHES == 1) {
        a.ph_lo = 0; a.ph_hi = N_PHASES; a.li = 0;
        hipLaunchKernelGGL(mk_fwd, dim3(grid), dim3(NWAVES * 64), LDS_BYTES, stream, a);
    } else {
        for (int li = 0; li < N_PHASES; ++li) { a.ph_lo = li; a.ph_hi = li + 1; a.li = li;
            hipLaunchKernelGGL(mk_fwd, dim3(grid), dim3(NWAVES * 64), LDS_BYTES, stream, a); }
    }
}
```

```cpp
#include <hip/hip_runtime.h>
#include <cstdio>
#include <cstdint>

#ifndef MK_DUP
#define MK_DUP -1
#endif
#ifndef MK_N_LAUNCHES
#define MK_N_LAUNCHES 1
#endif

namespace pg8 {
#define PG8_LAS __attribute__((address_space(3)))
typedef unsigned short bf16_t;
typedef short bf16x8 __attribute__((ext_vector_type(8)));
typedef float f32x4 __attribute__((ext_vector_type(4)));
typedef unsigned u32x4 __attribute__((ext_vector_type(4)));
typedef unsigned u32x2 __attribute__((ext_vector_type(2)));
constexpr int BM = 256, BK = 64, HALF = 128, HTB = HALF * BK * 2, STAGE_BYTES = 8 * HTB, NXCD = 8, WGM = 8;

__host__ __device__ __forceinline__ int lds_byte(int r, int c) { const int st = (r >> 4) * 2 + (c >> 5), rr = r & 15, cc = c & 31, ob = rr * 64 + cc * 2; return st * 1024 + (ob ^ (((ob >> 9) & 1) << 5)); }
__host__ __device__ __forceinline__ void stage_rc(int b, int& R, int& C) { const int st = b / 1024, sb = b % 1024, swz = sb ^ (((sb >> 9) & 1) << 5); R = (st >> 1) * 16 + swz / 64; C = (st & 1) * 32 + (swz % 64) / 2; }
__host__ __device__ __forceinline__ int perm32(int rho) { const int n = rho >> 4, i = rho & 15; return 8 * (i >> 2) + 4 * n + (i & 3); }

struct Unit { int pm, pn; };
struct Gemm { const bf16_t* A; const bf16_t* Bt; int M, N, K; };

struct StaticOrder {
    int nM, nN, nwg, G, c;
    __host__ __device__ void init(int M, int N, int G_, int c_) { nM = M / BM; nN = N / BM; nwg = nM * nN; G = G_; c = c_; }
    __host__ __device__ bool next(int i, Unit& u) const {
        const long L = (long)i * G + c; if (L >= nwg) return false;
        int wgid = (int)L; { const int q = nwg / NXCD, r = nwg % NXCD, xcd = wgid % NXCD, off = wgid / NXCD; wgid = (xcd < r ? xcd * (q + 1) : r * (q + 1) + (xcd - r) * q) + off; }
        const int nig = WGM * nN, gid = wgid / nig, fm = gid * WGM, gsz = (nM - fm) < WGM ? (nM - fm) : WGM;
        u.pm = fm + ((wgid % nig) % gsz); u.pn = (wgid % nig) / gsz; return true;
    }
    __device__ __forceinline__ void a_ready(const Unit&) const {}
    __device__ __forceinline__ void done(const Unit&) const {}
};

__device__ __forceinline__ unsigned cvt_pk_bf16(float lo, float hi) { unsigned r; asm volatile("v_cvt_pk_bf16_f32 %0, %1, %2" : "=v"(r) : "v"(lo), "v"(hi)); return r; }

template <class Epi, class Sched, bool ALIGN_EPI = false, bool SP2 = false>
__device__ __forceinline__ void gemm_phase(PG8_LAS unsigned char* lds, const Gemm g, const Sched& S, const Epi& E) {
    const int tid = threadIdx.x, wid = __builtin_amdgcn_readfirstlane(tid >> 6), lane = tid & 63, wr = wid >> 2, wc = wid & 3, fr = lane & 15, fq = lane >> 4;
    const int K = g.K, nt = K / BK;
    unsigned voffA[2], voffB[2];
#pragma unroll
    for (int i = 0; i < 2; ++i) { int R, C; stage_rc(tid * 16 + i * 8192, R, C); const int Rb = Epi::PERM ? ((R & ~31) + perm32(R & 31)) : R;
        voffA[i] = (unsigned)(R * K + C) * 2u; voffB[i] = (unsigned)(Rb * K + C) * 2u; }
    const size_t kstep = (size_t)(BK * 2);
    const size_t hstep = (size_t)HALF * K * 2;
    const size_t tstep = 2 * hstep;
    const unsigned ldsw = (unsigned)wid * 1024u;
    const int aoff = lds_byte(wr * 64 + fr, fq * 8), boff = lds_byte(wc * 32 + fr, fq * 8);
#define PG8_SA(b, h) (((b) * 2 + (h)) * HTB)
#define PG8_SB(b, h) ((4 + (b) * 2 + (h)) * HTB)
#define PG8_STAGE(bufoff, gbase, voff) do { _Pragma("unroll") for (int _i = 0; _i < 2; ++_i) \
        __builtin_amdgcn_global_load_lds((const unsigned*)((const char*)(gbase) + (voff)[_i]), (PG8_LAS unsigned*)(lds + (bufoff) + ldsw + _i * 8192), 16, 0, 0); } while (0)
#define PG8_LDA(dst, b, h) do { _Pragma("unroll") for (int m = 0; m < 4; ++m) _Pragma("unroll") for (int k = 0; k < 2; ++k) dst[m][k] = *(const PG8_LAS bf16x8*)(lds + PG8_SA(b, h) + aoff + m * 2048 + k * 1024); } while (0)
#define PG8_LDB(dst, b, h) do { _Pragma("unroll") for (int n = 0; n < 2; ++n) _Pragma("unroll") for (int k = 0; k < 2; ++k) dst[n][k] = *(const PG8_LAS bf16x8*)(lds + PG8_SB(b, h) + boff + n * 2048 + k * 1024); } while (0)
#define PG8_MMA(ai, bj, At, Bt) do { __builtin_amdgcn_s_setprio(1); _Pragma("unroll") for (int m = 0; m < 4; ++m) _Pragma("unroll") for (int n = 0; n < 2; ++n) _Pragma("unroll") for (int k = 0; k < 2; ++k) \
        acc[ai][bj][m][n] = __builtin_amdgcn_mfma_f32_16x16x32_bf16(Bt[n][k], At[m][k], acc[ai][bj][m][n], 0, 0, 0); __builtin_amdgcn_s_setprio(0); } while (0)
#define PG8_WAIT_V(n) asm volatile("s_waitcnt vmcnt(" #n ")" ::: "memory")
#define PG8_WAIT_L(n) asm volatile("s_waitcnt lgkmcnt(" #n ")" ::: "memory")
#define PG8_BAR __builtin_amdgcn_s_barrier()
#define PG8_SCHED __builtin_amdgcn_sched_barrier(0)
    Unit cur, nxt; int ui = 0;
    if (!S.next(0, cur)) return;
    f32x4 acc[2][2][4][2];
#pragma unroll
    for (int a = 0; a < 2; ++a)
#pragma unroll
        for (int b = 0; b < 2; ++b)
#pragma unroll
            for (int m = 0; m < 4; ++m)
#pragma unroll
                for (int n = 0; n < 2; ++n) acc[a][b][m][n] = (f32x4){0.f, 0.f, 0.f, 0.f};
    bf16x8 At[4][2], B0[2][2], B1[2][2];
    const char* cA = (const char*)g.A + (size_t)cur.pm * tstep; const char* cB = (const char*)g.Bt + (size_t)cur.pn * tstep;
    S.a_ready(cur);
    if constexpr (SP2) {
        PG8_STAGE(PG8_SB(0, 0), cB, voffB); PG8_STAGE(PG8_SB(0, 1), cB + hstep, voffB); PG8_STAGE(PG8_SA(0, 0), cA, voffA); PG8_STAGE(PG8_SA(0, 1), cA + hstep, voffA);
        if (wr == 1) PG8_BAR;
        PG8_WAIT_V(2); PG8_BAR;
        PG8_STAGE(PG8_SB(1, 0), cB + kstep, voffB); PG8_STAGE(PG8_SA(1, 0), cA + kstep, voffA); PG8_STAGE(PG8_SB(1, 1), cB + hstep + kstep, voffB);
        PG8_WAIT_V(6); PG8_BAR;
    } else {
        PG8_STAGE(PG8_SB(0, 0), cB, voffB); PG8_STAGE(PG8_SA(0, 0), cA, voffA); PG8_STAGE(PG8_SB(0, 1), cB + hstep, voffB); PG8_STAGE(PG8_SA(0, 1), cA + hstep, voffA);
        if (wr == 1) PG8_BAR;
        PG8_WAIT_V(4); PG8_BAR;
        PG8_STAGE(PG8_SB(1, 0), cB + kstep, voffB); PG8_STAGE(PG8_SA(1, 0), cA + kstep, voffA); PG8_STAGE(PG8_SB(1, 1), cB + hstep + kstep, voffB);
        PG8_WAIT_V(6); PG8_BAR;
    }
    for (;;) {
        const bool has_next = S.next(ui + 1, nxt);
        const char* nA = has_next ? (const char*)g.A + (size_t)nxt.pm * tstep : cA; const char* nB = has_next ? (const char*)g.Bt + (size_t)nxt.pn * tstep : cB;
        for (int t = 0; t < nt; t += 2) {
            const bool last = (t == nt - 2);
            const char* a1 = cA + (size_t)(t + 1) * kstep;
            const char* a2 = last ? nA : cA + (size_t)(t + 2) * kstep; const char* b2 = last ? nB : cB + (size_t)(t + 2) * kstep;
            const char* a3 = a2 + kstep; const char* b3 = b2 + kstep;
            if (last && has_next) S.a_ready(nxt);
            if constexpr (SP2) {
            PG8_LDB(B0, 0, 0); PG8_LDB(B1, 0, 1); PG8_SCHED; PG8_LDA(At, 0, 0); PG8_STAGE(PG8_SA(1, 1), a1 + hstep, voffA);
            PG8_WAIT_V(8); PG8_WAIT_L(0); PG8_BAR; PG8_MMA(0, 0, At, B0); PG8_MMA(0, 1, At, B1); PG8_BAR; PG8_SCHED;
            PG8_LDA(At, 0, 1); PG8_STAGE(PG8_SB(0, 0), b2, voffB); PG8_STAGE(PG8_SB(0, 1), b2 + hstep, voffB); PG8_STAGE(PG8_SA(0, 0), a2, voffA);
            PG8_WAIT_V(8); PG8_WAIT_L(0); PG8_BAR; PG8_MMA(1, 0, At, B0); PG8_MMA(1, 1, At, B1); PG8_BAR; PG8_SCHED;
            PG8_LDB(B0, 1, 0); PG8_LDB(B1, 1, 1); PG8_SCHED; PG8_LDA(At, 1, 0); PG8_STAGE(PG8_SA(0, 1), a2 + hstep, voffA);
            PG8_WAIT_V(8); PG8_WAIT_L(0); PG8_BAR; PG8_MMA(0, 0, At, B0); PG8_MMA(0, 1, At, B1); PG8_BAR; PG8_SCHED;
            PG8_LDA(At, 1, 1); PG8_STAGE(PG8_SB(1, 0), b3, voffB); PG8_STAGE(PG8_SB(1, 1), b3 + hstep, voffB); PG8_STAGE(PG8_SA(1, 0), a3, voffA);
            PG8_WAIT_V(8); PG8_WAIT_L(0); PG8_BAR; PG8_MMA(1, 0, At, B0); PG8_MMA(1, 1, At, B1); PG8_BAR; PG8_SCHED;
            } else {
            PG8_LDB(B0, 0, 0); PG8_SCHED; PG8_LDA(At, 0, 0); PG8_STAGE(PG8_SA(1, 1), a1 + hstep, voffA);
            PG8_WAIT_L(8); PG8_BAR; PG8_WAIT_L(0); PG8_MMA(0, 0, At, B0); PG8_BAR; PG8_SCHED;
            PG8_LDB(B1, 0, 1); PG8_STAGE(PG8_SB(0, 0), b2, voffB);
            PG8_BAR; PG8_WAIT_L(0); PG8_MMA(0, 1, At, B1); PG8_BAR;
            PG8_LDA(At, 0, 1); PG8_STAGE(PG8_SA(0, 0), a2, voffA);
            PG8_BAR; PG8_WAIT_L(0); PG8_MMA(1, 0, At, B0); PG8_BAR; PG8_SCHED;
            PG8_STAGE(PG8_SB(0, 1), b2 + hstep, voffB);
            PG8_WAIT_V(6); PG8_BAR; PG8_MMA(1, 1, At, B1); PG8_BAR;
            PG8_LDB(B0, 1, 0); PG8_SCHED; PG8_LDA(At, 1, 0); PG8_STAGE(PG8_SA(0, 1), a2 + hstep, voffA);
            PG8_WAIT_L(8); PG8_BAR; PG8_WAIT_L(0); PG8_MMA(0, 0, At, B0); PG8_BAR; PG8_SCHED;
            PG8_LDB(B1, 1, 1); PG8_STAGE(PG8_SB(1, 0), b3, voffB);
            PG8_BAR; PG8_WAIT_L(0); PG8_MMA(0, 1, At, B1); PG8_BAR;
            PG8_LDA(At, 1, 1); PG8_STAGE(PG8_SA(1, 0), a3, voffA);
            PG8_BAR; PG8_WAIT_L(0); PG8_MMA(1, 0, At, B0); PG8_BAR; PG8_SCHED;
            PG8_STAGE(PG8_SB(1, 1), b3 + hstep, voffB);
            PG8_WAIT_V(6); PG8_BAR; PG8_MMA(1, 1, At, B1); PG8_BAR;
            }
        }
        if constexpr (ALIGN_EPI) { if (wr == 0) PG8_BAR; }
        E(acc, cur, wr, wc, fr, fq); S.done(cur);
        if (!has_next) break;
#pragma unroll
        for (int a = 0; a < 2; ++a)
#pragma unroll
            for (int b = 0; b < 2; ++b)
#pragma unroll
                for (int m = 0; m < 4; ++m)
#pragma unroll
                    for (int n = 0; n < 2; ++n) acc[a][b][m][n] = (f32x4){0.f, 0.f, 0.f, 0.f};
        cur = nxt; cA = nA; cB = nB; ++ui;
        if constexpr (ALIGN_EPI) { if (wr == 1) PG8_BAR; }
    }
    PG8_WAIT_V(0);
    if constexpr (!ALIGN_EPI) { if (wr == 0) PG8_BAR; }
    PG8_BAR;
#undef PG8_SA
#undef PG8_SB
#undef PG8_STAGE
#undef PG8_LDA
#undef PG8_LDB
#undef PG8_MMA
#undef PG8_WAIT_V
#undef PG8_WAIT_L
#undef PG8_BAR
#undef PG8_SCHED
}
}

constexpr int NWAVES = 8;
constexpr int DM = 1024, NTOK = 16384, NCTX = 8192, D_IN = 1792, NMODV = 9, MODW = 6144;
constexpr int SEQ_C = 256, SEQ_L = 1024, NSEQ_C = 32, NSEQ_L = 8;
constexpr int N_PHASES = 8;
constexpr float LOG2E = 1.4426950408889634f;
constexpr float QSCALE = 0.125f * LOG2E;
constexpr float EPS = 1e-6f;

constexpr size_t MiB = 1u << 20, KiB = 1u << 10;
constexpr size_t WS_CTL = 0, CTL_ZERO_BYTES = 64 * KiB;
constexpr size_t WS_MODS = 1 * MiB;
constexpr size_t WS_ROPE = 1 * MiB + 256 * KiB;
constexpr size_t WS_RGW  = 1 * MiB + 512 * KiB;
constexpr size_t WS_CK   = 1 * MiB + 768 * KiB;
constexpr size_t WS_CVT  = 2 * MiB + 256 * KiB;
constexpr size_t WS_WIN  = 3 * MiB;
constexpr size_t WS_WOUT = 7 * MiB;
constexpr size_t WS_WC   = 9 * MiB;
constexpr size_t WS_U    = 16 * MiB;
constexpr size_t WS_SU   = 13 * MiB;
constexpr size_t WS_SV   = 13 * MiB + 64 * KiB;
constexpr size_t WS_V    = 48 * MiB;
constexpr size_t WS_H    = 80 * MiB;
constexpr size_t WS_MIX  = 112 * MiB;
constexpr size_t WS_Q    = 144 * MiB;
constexpr size_t WS_K    = 160 * MiB;
constexpr size_t WS_VT   = 164 * MiB;
constexpr size_t WS_XR   = 168 * MiB;
constexpr size_t WS_YG   = 184 * MiB;
constexpr size_t WS_HF   = 200 * MiB;
constexpr size_t WS_SC   = 144 * MiB;
constexpr size_t WS_END  = 232 * MiB;
constexpr int VT_LAT_OFF = NSEQ_C * 2 * 64 * SEQ_C;

constexpr int CW_BAR = 4096;

constexpr int RING_BYTES = 131072;
constexpr int LDSCTL_OFF = RING_BYTES, MISC_OFF = LDSCTL_OFF + 320;
constexpr int LDS_BYTES = 147456;

#define GAS __attribute__((address_space(1)))
#define LAS __attribute__((address_space(3)))
typedef unsigned short bf16;
typedef unsigned v4u __attribute__((ext_vector_type(4)));
typedef unsigned v2u __attribute__((ext_vector_type(2)));
typedef float f32x4 __attribute__((ext_vector_type(4)));
typedef float f32x2 __attribute__((ext_vector_type(2)));
typedef float f32x16 __attribute__((ext_vector_type(16)));
typedef short bf16x8 __attribute__((ext_vector_type(8)));
typedef GAS unsigned gu32;
#define RLX_AGENT __ATOMIC_RELAXED, __HIP_MEMORY_SCOPE_AGENT

__device__ __forceinline__ unsigned f2bf(float f) { unsigned u = __builtin_bit_cast(unsigned, f); return (u + 0x7fffu + ((u >> 16) & 1u)) >> 16; }
__device__ __forceinline__ unsigned pk2(float lo, float hi) { return f2bf(lo) | (f2bf(hi) << 16); }
__device__ __forceinline__ float bf2f(unsigned b) { return __builtin_bit_cast(float, b << 16); }
__device__ __forceinline__ float bflo(unsigned w) { return __builtin_bit_cast(float, w << 16); }
__device__ __forceinline__ float bfhi(unsigned w) { return __builtin_bit_cast(float, w & 0xffff0000u); }
__device__ __forceinline__ float sigmoidf_(float x) { return 1.f / (1.f + __expf(-x)); }
__device__ __forceinline__ float gelu_tanh(float x) { const float y = 0.7978845608028654f * (x + 0.044715f * x * x * x); const float e = __expf(2.f * y); return 0.5f * x * (2.f - 2.f / (1.f + e)); }
__device__ __forceinline__ float wave_sum(float v) {
#pragma unroll
    for (int o = 1; o < 64; o <<= 1) v += __shfl_xor(v, o);
    return v;
}
__device__ __forceinline__ unsigned wave_max_u32(unsigned v) {
#pragma unroll
    for (int o = 1; o < 64; o <<= 1) { const unsigned t = (unsigned)__shfl_xor((int)v, o); v = t > v ? t : v; }
    return v;
}
__device__ __forceinline__ int crow(int r, int hi) { return (r & 3) + 8 * (r >> 2) + 4 * hi; }

#define XB_TMO      128
#define XB_XCNT(j)  (256  + 64 * (j))
#define XB_XSUB(j)  (1280 + 64 * (j))
#define XB_XGEN(j)  (2304 + 64 * (j))
#define XB_TOP      3328
#define XB_TOPGEN   3392
#define XCD_BAR_WORDS 3456
#define XB_SPIN_CAP (1u << 18)
__device__ __forceinline__ unsigned xb_ld(unsigned* p)              { return __hip_atomic_load(p, __ATOMIC_RELAXED, __HIP_MEMORY_SCOPE_AGENT); }
__device__ __forceinline__ unsigned xb_add(unsigned* p, unsigned v) { return __hip_atomic_fetch_add(p, v, __ATOMIC_RELAXED, __HIP_MEMORY_SCOPE_AGENT); }
__device__ __forceinline__ unsigned xb_xcc_id() { return (unsigned)__builtin_amdgcn_s_getreg((3 << 11) | 20) & 0xFu; }
#define XB_SPIN(cond, bar) do { unsigned _sp = 0; while (cond) { __builtin_amdgcn_s_sleep(1); \
    if ((++_sp & 255u) == 0u) { if (xb_ld(&(bar)[XB_TMO])) break; if (_sp > XB_SPIN_CAP) { atomicAdd(&(bar)[XB_TMO], 1u); break; } } } } while (0)
struct XcdBarrier { unsigned* bar; unsigned x; volatile LAS unsigned* st; };
__device__ __forceinline__ XcdBarrier xcd_barrier_post(unsigned* bar, volatile LAS unsigned* st) {
    XcdBarrier b; b.bar = bar; b.x = xb_xcc_id(); b.st = st;
    if (threadIdx.x == 0) (void)xb_add(&bar[XB_XCNT(b.x)], 1u);
    return b;
}
__device__ __forceinline__ void xcd_barrier_complete(unsigned* bar, unsigned x, unsigned& nloc, unsigned& nx) {
    const unsigned G = gridDim.x * gridDim.y * gridDim.z;
    unsigned sum, cnt, mine, sp = 0u;
    for (;;) {
        sum = 0u; cnt = 0u; mine = 0u;
#pragma unroll
        for (unsigned j = 0; j < 16; ++j) { const unsigned c = xb_ld(&bar[XB_XCNT(j)]); sum += c; cnt += (c > 0u) ? 1u : 0u; mine = (j == x) ? c : mine; }
        if (sum == G) break;
        __builtin_amdgcn_s_sleep(1);
        if ((++sp & 255u) == 0u) { if (xb_ld(&bar[XB_TMO])) break; if (sp > XB_SPIN_CAP) { atomicAdd(&bar[XB_TMO], 1u); break; } }
    }
    nloc = mine > 0u ? mine : 1u; nx = cnt > 0u ? cnt : 1u;
}
__device__ __forceinline__ void xcd_barrier(const XcdBarrier& b) {
    asm volatile("s_waitcnt vmcnt(0)" ::: "memory");
    __syncthreads();
    if (threadIdx.x == 0) {
        unsigned* bar = b.bar;
        __builtin_amdgcn_s_waitcnt(0);
        unsigned nloc = b.st[0], nx = b.st[1];
        if (nloc == 0u) { xcd_barrier_complete(bar, b.x, nloc, nx); b.st[0] = nloc; b.st[1] = nx; }
        const unsigned old = xb_add(&bar[XB_XSUB(b.x)], 1u);
        const unsigned gen = old / nloc;
        if (old + 1u == (gen + 1u) * nloc) {
            __builtin_amdgcn_fence(__ATOMIC_RELEASE, "agent");
            asm volatile("s_waitcnt vmcnt(0)" ::: "memory");
            const unsigned og = xb_add(&bar[XB_TOP], 1u);
            const unsigned tg = og / nx;
            if (og + 1u == (tg + 1u) * nx) xb_add(&bar[XB_TOPGEN], 1u);
            else XB_SPIN(xb_ld(&bar[XB_TOPGEN]) == tg, bar);
            __builtin_amdgcn_fence(__ATOMIC_ACQUIRE, "agent");
            xb_add(&bar[XB_XGEN(b.x)], 1u);
            asm volatile("s_waitcnt vmcnt(0)" ::: "memory");
        } else {
            XB_SPIN(xb_ld(&bar[XB_XGEN(b.x)]) == gen, bar);
            __builtin_amdgcn_fence(__ATOMIC_ACQUIRE, "agent");
            asm volatile("s_waitcnt vmcnt(0)" ::: "memory");
        }
    }
    __syncthreads();
}

struct Args { const float* in[26]; float* out; unsigned char* ws; int ph_lo, ph_hi, li, pad; };

struct Frame {
    unsigned char* lds;
    int tid, lane, wave, vcu, G;
    const float* const* in;
    float* out; unsigned char* ws;
};
enum { I_XP = 0, I_XS, I_CK, I_CV, I_SRNN, I_C, I_CCTX, I_WMOD, I_BMOD, I_GMIX, I_GFFN, I_WIN, I_CONVW, I_CONVB, I_RGWA, I_RGBA, I_RGWI, I_RGBI, I_RGLAM, I_SINK, I_WOUT, I_PWQ, I_PSK, I_PU, I_PV, I_GFINAL };
constexpr size_t O_Y = 0, O_NEWK = (size_t)NTOK * DM, O_NEWV = O_NEWK + (size_t)NCTX * 128, O_NEWRNN = O_NEWV + (size_t)NCTX * 128;

__device__ __forceinline__ int mod_index(int tok) { return tok < NCTX ? 0 : 1 + ((tok - NCTX) >> 10); }
__device__ __forceinline__ const float* x_row(const Frame& F, int tok) { return tok < NCTX ? F.in[I_XP] + (size_t)tok * DM : F.in[I_XS] + (size_t)(tok - NCTX) * DM; }

template <class RowMap>
__device__ __forceinline__ void p0_transpose_item(const float* W, int K, int N, bf16* WT, float* scr, int item, int lane, RowMap rowmap) {
    const int nblk = N / 32, kb = item / nblk, nb = item % nblk, k0 = 64 * kb, n0 = 32 * nb;
#pragma unroll 8
    for (int i = 0; i < 32; ++i) { const int kk = 2 * i + (lane >> 5); scr[kk * 33 + (lane & 31)] = W[(size_t)(k0 + kk) * N + n0 + (lane & 31)]; }
    __builtin_amdgcn_s_waitcnt(0xC07F); asm volatile("" ::: "memory");
    const int c = lane & 7;
#pragma unroll
    for (int j = 0; j < 4; ++j) { const int n = (lane >> 3) + 8 * j; const float* s = scr + (8 * c) * 33 + n;
        v4u o; o.x = pk2(s[0 * 33], s[1 * 33]); o.y = pk2(s[2 * 33], s[3 * 33]); o.z = pk2(s[4 * 33], s[5 * 33]); o.w = pk2(s[6 * 33], s[7 * 33]);
        *(v4u*)(WT + (size_t)rowmap(n0 + n) * K + k0 + 8 * c) = o; }
    __builtin_amdgcn_s_waitcnt(0xC07F); asm volatile("" ::: "memory");
}
struct MapId { __device__ __forceinline__ int operator()(int n) const { return n; } };
struct MapWin { __device__ __forceinline__ int operator()(int n) const { if (n >= 640) return n; const int hb = n & ~63, o = n & 63; return hb + ((o & 31) << 1) + (o >> 5); } };

__device__ __forceinline__ void p0_phase(Frame& F) {
    float* ldsf = (float*)F.lds;
    const int tid = F.tid, lane = F.lane, wave = F.wave, v = F.vcu;
    if (v < 192) {
        for (int i = tid; i < NMODV * DM; i += 512) { const int j = i >> 10, d = i & 1023; const float c = (j == 0) ? F.in[I_CCTX][d] : F.in[I_C][(j - 1) * DM + d]; ldsf[i] = c * sigmoidf_(c); }
        __syncthreads();
        const int e0 = 32 * v, c4 = tid & 7, kq = tid >> 3;
        float acc[NMODV][4];
#pragma unroll
        for (int j = 0; j < NMODV; ++j) { acc[j][0] = 0.f; acc[j][1] = 0.f; acc[j][2] = 0.f; acc[j][3] = 0.f; }
        const float* wm = F.in[I_WMOD] + e0 + 4 * c4;
#pragma unroll 4
        for (int kk = 0; kk < 16; ++kk) { const int k = kq * 16 + kk; const f32x4 w = *(const f32x4*)(wm + (size_t)k * MODW);
#pragma unroll
            for (int j = 0; j < NMODV; ++j) { const float s = ldsf[j * DM + k]; acc[j][0] += s * w[0]; acc[j][1] += s * w[1]; acc[j][2] += s * w[2]; acc[j][3] += s * w[3]; } }
#pragma unroll
        for (int j = 0; j < NMODV; ++j)
#pragma unroll
            for (int i = 0; i < 4; ++i) { float a = acc[j][i]; a += __shfl_xor(a, 8); a += __shfl_xor(a, 16); a += __shfl_xor(a, 32); acc[j][i] = a; }
        float* red = ldsf + NMODV * DM;
        if (lane < 8) {
#pragma unroll
            for (int j = 0; j < NMODV; ++j)
#pragma unroll
                for (int i = 0; i < 4; ++i) red[(wave * NMODV + j) * 32 + 4 * c4 + i] = acc[j][i];
        }
        __syncthreads();
        if (tid < NMODV * 32) { const int j = tid >> 5, col = tid & 31; float s = F.in[I_BMOD][e0 + col];
#pragma unroll
            for (int w = 0; w < 8; ++w) s += red[(w * NMODV + j) * 32 + col];
            ((float*)(F.ws + WS_MODS))[j * MODW + e0 + col] = s; }
        __syncthreads();
    }
    if (v < 256) {
        const int hh = v >> 4, dt = v & 15, d0 = 64 * dt;
        float* At = ldsf;
        float* Bkt = ldsf + 128 * 64;
        const float* wq = F.in[I_PWQ] + hh * 128;
        const float* sk = F.in[I_PSK] + (size_t)hh * 128 * 128;
#pragma unroll
        for (int i = 0; i < 4; ++i) { const int f = tid + 512 * i, d = f & 63, q4 = f >> 6; const f32x4 a = *(const f32x4*)(wq + (size_t)(d0 + d) * 2048 + 4 * q4);
            At[(4 * q4 + 0) * 64 + d] = a[0]; At[(4 * q4 + 1) * 64 + d] = a[1]; At[(4 * q4 + 2) * 64 + d] = a[2]; At[(4 * q4 + 3) * 64 + d] = a[3]; }
#pragma unroll
        for (int i = 0; i < 8; ++i) { const int f = tid + 512 * i, key = f & 127, q4 = f >> 7; const f32x4 b = *(const f32x4*)(sk + (size_t)key * 128 + 4 * q4);
            Bkt[(4 * q4 + 0) * 128 + key] = b[0]; Bkt[(4 * q4 + 1) * 128 + key] = b[1]; Bkt[(4 * q4 + 2) * 128 + key] = b[2]; Bkt[(4 * q4 + 3) * 128 + key] = b[3]; }
        __syncthreads();
        const int dg = tid & 15, kg = tid >> 4;
        float acc[4][4];
#pragma unroll
        for (int i = 0; i < 4; ++i)
#pragma unroll
            for (int j = 0; j < 4; ++j) acc[i][j] = 0.f;
#pragma unroll 4
        for (int q = 0; q < 128; ++q) { const f32x4 a = *(const f32x4*)(At + q * 64 + 4 * dg); const f32x4 b = *(const f32x4*)(Bkt + q * 128 + 4 * kg);
#pragma unroll
            for (int i = 0; i < 4; ++i)
#pragma unroll
                for (int j = 0; j < 4; ++j) acc[i][j] += a[i] * b[j]; }
        bf16* WcT = (bf16*)(F.ws + WS_WC);
#pragma unroll
        for (int j = 0; j < 4; ++j) { v2u o; o.x = pk2(acc[0][j], acc[1][j]); o.y = pk2(acc[2][j], acc[3][j]);
            *(v2u*)(WcT + (size_t)(hh * 128 + 4 * kg + j) * DM + d0 + 4 * dg) = o; }
        __syncthreads();
    }
    const int gw = v * NWAVES + wave, NGW = F.G * NWAVES;
    float* scr = ldsf + wave * 4096;
    {
        constexpr int I_IN = (DM / 64) * (D_IN / 32), I_OUT = (DM / 64) * (DM / 32), I_RG = 32 * 2;
        constexpr int NIT = I_IN + I_OUT + I_RG;
        for (int it = gw; it < NIT; it += NGW) {
            int r = it;
            if (r < I_IN) { p0_transpose_item(F.in[I_WIN], DM, D_IN, (bf16*)(F.ws + WS_WIN), scr, r, lane, MapWin()); continue; } r -= I_IN;
            if (r < I_OUT) { p0_transpose_item(F.in[I_WOUT], DM, DM, (bf16*)(F.ws + WS_WOUT), scr, r, lane, MapId()); continue; } r -= I_OUT;
            { const int mm = r >> 1, sub = r & 1, dir = mm >> 4, n = (mm >> 1) & 7, gate = mm & 1;
              const float* src = (gate ? F.in[I_RGWI] : F.in[I_RGWA]) + (size_t)(dir * 8 + n) * 4096;
              bf16* dst = (bf16*)(F.ws + WS_RGW) + (size_t)((dir * 8 + n) * 2 + gate) * 4096;
              p0_transpose_item(src, 64, 64, dst, scr, sub, lane, MapId()); }
        }
    }
    for (int it = gw; it < 2 * 16384; it += NGW) {
        const int tb = it >> 14, row = it & 16383;
        const float* src = (tb ? F.in[I_PV] : F.in[I_PU]) + (size_t)row * DM + 16 * lane;
        f32x4 a[4]; float am = 0.f;
#pragma unroll
        for (int j = 0; j < 4; ++j) { a[j] = *(const f32x4*)(src + 4 * j); am = fmaxf(am, fmaxf(fmaxf(fabsf(a[j][0]), fabsf(a[j][1])), fmaxf(fabsf(a[j][2]), fabsf(a[j][3])))); }
#pragma unroll
        for (int o = 1; o < 64; o <<= 1) am = fmaxf(am, __shfl_xor(am, o));
        const float inv = am > 0.f ? 127.f / am : 0.f;
        v4u o4;
#pragma unroll
        for (int j = 0; j < 4; ++j) { unsigned w = 0;
#pragma unroll
            for (int i = 0; i < 4; ++i) { int q = (int)rintf(a[j][i] * inv); q = q > 127 ? 127 : (q < -127 ? -127 : q); if (tb) q += 128; w |= ((unsigned)q & 0xffu) << (8 * i); }
            o4[j] = w; }
        *(v4u*)(F.ws + (tb ? WS_V : WS_U) + (size_t)row * DM + 16 * lane) = o4;
        if (lane == 0) ((float*)(F.ws + (tb ? WS_SV : WS_SU)))[row] = am * (1.f / 127.f);
    }
    const int gt = v * 512 + tid, NGT = F.G * 512;
    for (int e = gt; e < 8 * 256 * 128; e += NGT) {
        const int c = e & 127, bp = e >> 7, kvh = c >> 6, p = c & 63, old = (p & 1) ? 32 + (p >> 1) : (p >> 1);
        ((bf16*)(F.ws + WS_CK))[e] = (bf16)f2bf(F.in[I_CK][(size_t)bp * 128 + kvh * 64 + old]);
    }
    for (int e = gt; e < 8 * 256 * 128; e += NGT) {
        const int pos = e & 255, d = (e >> 8) & 63, kvh = (e >> 14) & 1, b = e >> 15;
        ((bf16*)(F.ws + WS_CVT))[e] = (bf16)f2bf(F.in[I_CV][(size_t)(b * 256 + pos) * 128 + kvh * 64 + d]);
    }
    for (int e = gt; e < 1024 * 32; e += NGT) {
        const int s = e >> 5, i = e & 31, row = s >> 6, col = s & 63;
        const float inv = powf(10000.0f, -(float)(i & 15) / 16.0f);
        const float ang = (i < 16 ? (float)row : (float)col) * inv;
        f32x2 cs; cs.x = cosf(ang); cs.y = sinf(ang);
        ((f32x2*)(F.ws + WS_ROPE))[e] = cs;
    }
}

__device__ __forceinline__ void norm_phase(Frame& F, int which) {
    const int gw = F.vcu * NWAVES + F.wave, NGW = F.G * NWAVES, lane = F.lane;
    const float* mods = (const float*)(F.ws + WS_MODS);
    const float* g = F.in[which ? I_GFFN : I_GMIX];
    bf16* H = (bf16*)(F.ws + WS_H);
    for (int tok = gw; tok < NTOK; tok += NGW) {
        const float* xr = which ? F.out + O_Y + (size_t)tok * DM : x_row(F, tok);
        const float* mv = mods + (size_t)mod_index(tok) * MODW + (which ? 3 * DM : 0);
        f32x4 v[4]; float ss = 0.f;
#pragma unroll
        for (int j = 0; j < 4; ++j) { v[j] = *(const f32x4*)(xr + 256 * j + 4 * lane); ss += (v[j][0] * v[j][0] + v[j][1] * v[j][1]) + (v[j][2] * v[j][2] + v[j][3] * v[j][3]); }
        const float rstd = 1.f / sqrtf(wave_sum(ss) * (1.f / DM) + EPS);
#pragma unroll
        for (int j = 0; j < 4; ++j) { const int e = 256 * j + 4 * lane;
            const f32x4 gg = *(const f32x4*)(g + e), sh = *(const f32x4*)(mv + e), sc = *(const f32x4*)(mv + DM + e);
            f32x4 o;
#pragma unroll
            for (int i = 0; i < 4; ++i) o[i] = v[j][i] * rstd * gg[i] * (1.f + sc[i]) + sh[i];
            v2u w; w.x = pk2(o[0], o[1]); w.y = pk2(o[2], o[3]); *(v2u*)(H + (size_t)tok * DM + e) = w; }
    }
}

struct EpiInProj {
    static constexpr bool PERM = false;
    bf16 *q, *k, *vT, *xr, *yg; float *newk, *newv; const f32x4* rope4;
    __device__ __forceinline__ void operator()(const f32x4 (&acc)[2][2][4][2], const pg8::Unit& u, int wr, int wc, int fr, int fq) const {
        const bool lat = u.pm >= 32;
        const int pn = u.pn;
#pragma unroll
        for (int ai = 0; ai < 2; ++ai)
#pragma unroll
            for (int m = 0; m < 4; ++m) {
                const int row = u.pm * 256 + ai * 128 + wr * 64 + m * 16 + fr;
                const int pos = lat ? ((row - NCTX) & 1023) : (row & 255);
#pragma unroll
                for (int bj = 0; bj < 2; ++bj)
#pragma unroll
                    for (int n = 0; n < 2; ++n) {
                        const int c = pn * 256 + bj * 128 + wc * 32 + n * 16 + 4 * fq;
                        f32x4 v = acc[ai][bj][m][n];
                        if (pn < 2 || (pn == 2 && bj == 0)) {
                            const int i = (c & 63) >> 1;
                            if (lat) { const f32x4 cs = rope4[(pos * 32 + i) >> 1];
                                const float a0 = v[0] * cs[0] - v[1] * cs[1], a1 = v[1] * cs[0] + v[0] * cs[1];
                                const float b0 = v[2] * cs[2] - v[3] * cs[3], b1 = v[3] * cs[2] + v[2] * cs[3];
                                v[0] = a0; v[1] = a1; v[2] = b0; v[3] = b1; }
                            if (pn < 2) { v2u w; w.x = pk2(v[0] * QSCALE, v[1] * QSCALE); w.y = pk2(v[2] * QSCALE, v[3] * QSCALE); *(v2u*)(q + (size_t)row * 512 + c) = w; }
                            else { const int kc = c - 512; v2u w; w.x = pk2(v[0], v[1]); w.y = pk2(v[2], v[3]); *(v2u*)(k + (size_t)row * 128 + kc) = w;
                                if (!lat) { float* nk = newk + (size_t)row * 128 + (kc & 64) + i; f32x2 lo; lo.x = v[0]; lo.y = v[2]; f32x2 hi; hi.x = v[1]; hi.y = v[3]; *(f32x2*)nk = lo; *(f32x2*)(nk + 32) = hi; } }
                        } else if (pn == 2) {
                            const int vc = c - 640, kvh = vc >> 6, d = vc & 63;
                            if (!lat) *(f32x4*)(newv + (size_t)row * 128 + vc) = v;
                            bf16* vp; int S;
                            if (!lat) { S = SEQ_C; vp = vT + ((size_t)((row >> 8) * 2 + kvh) * 64 + d) * SEQ_C + pos; }
                            else { S = SEQ_L; vp = vT + VT_LAT_OFF + ((size_t)(((row - NCTX) >> 10) * 2 + kvh) * 64 + d) * SEQ_L + pos; }
                            vp[0] = (bf16)f2bf(v[0]); vp[S] = (bf16)f2bf(v[1]); vp[2 * S] = (bf16)f2bf(v[2]); vp[3 * S] = (bf16)f2bf(v[3]);
                        } else if (pn < 5) {
                            v2u w; w.x = pk2(v[0], v[1]); w.y = pk2(v[2], v[3]); *(v2u*)(xr + (size_t)row * 512 + (c - 768)) = w;
                        } else {
                            v2u w; w.x = pk2(v[0], v[1]); w.y = pk2(v[2], v[3]); *(v2u*)(yg + (size_t)row * 512 + (c - 1280)) = w;
                        }
                    }
            }
    }
};
struct EpiOutProj {
    static constexpr bool PERM = false;
    const float *xp, *xs, *mods; float* x1;
    __device__ __forceinline__ void operator()(const f32x4 (&acc)[2][2][4][2], const pg8::Unit& u, int wr, int wc, int fr, int fq) const {
        const int mi = u.pm < 32 ? 0 : 1 + ((u.pm - 32) >> 2);
        const float* ga = mods + (size_t)mi * MODW + 2 * DM;
#pragma unroll
        for (int ai = 0; ai < 2; ++ai)
#pragma unroll
            for (int m = 0; m < 4; ++m) {
                const int row = u.pm * 256 + ai * 128 + wr * 64 + m * 16 + fr;
                const float* xrow = row < NCTX ? xp + (size_t)row * DM : xs + (size_t)(row - NCTX) * DM;
#pragma unroll
                for (int bj = 0; bj < 2; ++bj)
#pragma unroll
                    for (int n = 0; n < 2; ++n) {
                        const int c = u.pn * 256 + bj * 128 + wc * 32 + n * 16 + 4 * fq;
                        const f32x4 xv = *(const f32x4*)(xrow + c), gv = *(const f32x4*)(ga + c);
                        *(f32x4*)(x1 + (size_t)row * DM + c) = xv + gv * acc[ai][bj][m][n];
                    }
            }
    }
};
struct EpiScores {
    static constexpr bool PERM = true;
    bf16* sc;
    __device__ __forceinline__ void operator()(const f32x4 (&acc)[2][2][4][2], const pg8::Unit& u, int wr, int wc, int fr, int fq) const {
#pragma unroll
        for (int ai = 0; ai < 2; ++ai)
#pragma unroll
            for (int m = 0; m < 4; ++m) {
                const int row = u.pm * 256 + ai * 128 + wr * 64 + m * 16 + fr;
#pragma unroll
                for (int bj = 0; bj < 2; ++bj) {
                    const int c = u.pn * 256 + bj * 128 + wc * 32 + 8 * fq;
                    const f32x4 v0 = acc[ai][bj][m][0], v1 = acc[ai][bj][m][1];
                    v4u w; w.x = pk2(v0[0], v0[1]); w.y = pk2(v0[2], v0[3]); w.z = pk2(v1[0], v1[1]); w.w = pk2(v1[2], v1[3]);
                    *(v4u*)(sc + (size_t)row * 2048 + c) = w;
                }
            }
    }
};

__device__ __forceinline__ void attn_unit(Frame& F, bool lat, int seq, int kvh, int qt) {
    const int tid = F.tid, lane = F.lane, wave = F.wave, r32 = lane & 31, hi = lane >> 5;
    const int g = wave >> 1, qs = wave & 1, head = kvh * 4 + g;
    const int S = lat ? SEQ_L : SEQ_C, tokbase = lat ? NCTX + seq * SEQ_L : seq * SEQ_C;
    const int q0 = qt * 64, qpos = q0 + 32 * qs + r32;
    const bf16* Q = (const bf16*)(F.ws + WS_Q); const bf16* Kb = (const bf16*)(F.ws + WS_K); const bf16* VT = (const bf16*)(F.ws + WS_VT);
    const bf16* CK = (const bf16*)(F.ws + WS_CK); const bf16* CVT = (const bf16*)(F.ws + WS_CVT);
    unsigned char* ldsK = F.lds; unsigned char* ldsV = F.lds + 8192;
    bf16x8 qf[4];
    { const bf16* qp = Q + (size_t)(tokbase + qpos) * 512 + head * 64;
#pragma unroll
      for (int ks = 0; ks < 4; ++ks) qf[ks] = *(const bf16x8*)(qp + 16 * ks + 8 * hi); }
    const float sinkl = F.in[I_SINK][head] * LOG2E;
    float mrun = sinkl, lrun = (hi == 0) ? 1.f : 0.f;
    f32x16 o0, o1;
#pragma unroll
    for (int r = 0; r < 16; ++r) { o0[r] = 0.f; o1[r] = 0.f; }
    int tlo, thi;
    if (lat) { tlo = (q0 >= 128 ? q0 - 128 : 0) >> 6; thi = ((q0 + 192 < S ? q0 + 192 : S)) >> 6; } else { tlo = 0; thi = 4; }
    const int nband = thi - tlo, ntile = nband + (lat ? 4 : 0);
    const int key_t = tid >> 3, ch_t = tid & 7;
    for (int t = 0; t < ntile; ++t) {
        const bool band = t < nband;
        const bf16* kptr; const bf16* vptr; int vstride; int kbase = 0;
        if (band) { const int tile = tlo + t; kbase = tile * 64;
            kptr = Kb + (size_t)(tokbase + kbase) * 128 + kvh * 64;
            vptr = VT + (lat ? (size_t)VT_LAT_OFF + (size_t)((seq * 2 + kvh) * 64) * SEQ_L : (size_t)((seq * 2 + kvh) * 64) * SEQ_C) + kbase; vstride = S;
        } else { const int tc = t - nband;
            kptr = CK + (size_t)(seq * 256 + tc * 64) * 128 + kvh * 64;
            vptr = CVT + (size_t)((seq * 2 + kvh) * 64) * 256 + tc * 64; vstride = 256; }
        const v4u kv = *(const v4u*)(kptr + (size_t)key_t * 128 + ch_t * 8);
        const v4u vv = *(const v4u*)(vptr + (size_t)key_t * vstride + ch_t * 8);
        __syncthreads();
        *(v4u*)(ldsK + key_t * 128 + ((ch_t ^ (key_t & 7)) * 16)) = kv;
        *(v4u*)(ldsV + key_t * 128 + ((ch_t ^ (key_t & 7)) * 16)) = vv;
        __syncthreads();
        f32x16 p0, p1;
#pragma unroll
        for (int r = 0; r < 16; ++r) { p0[r] = 0.f; p1[r] = 0.f; }
#pragma unroll
        for (int ks = 0; ks < 4; ++ks) {
            const int sw = ((2 * ks + hi) ^ (r32 & 7)) * 16;
            const bf16x8 a0 = *(const bf16x8*)(ldsK + r32 * 128 + sw);
            const bf16x8 a1 = *(const bf16x8*)(ldsK + (32 + r32) * 128 + sw);
            p0 = __builtin_amdgcn_mfma_f32_32x32x16_bf16(a0, qf[ks], p0, 0, 0, 0);
            p1 = __builtin_amdgcn_mfma_f32_32x32x16_bf16(a1, qf[ks], p1, 0, 0, 0);
        }
        if (band && lat) {
#pragma unroll
            for (int r = 0; r < 16; ++r) { const int kp = kbase + crow(r, hi); int d0 = qpos - kp; d0 = d0 < 0 ? -d0 : d0; int d1 = qpos - kp - 32; d1 = d1 < 0 ? -d1 : d1;
                if (d0 > 128) p0[r] = -INFINITY; if (d1 > 128) p1[r] = -INFINITY; }
        }
        float tm = p0[0];
#pragma unroll
        for (int r = 1; r < 16; ++r) tm = fmaxf(tm, p0[r]);
#pragma unroll
        for (int r = 0; r < 16; ++r) tm = fmaxf(tm, p1[r]);
        tm = fmaxf(tm, __shfl_xor(tm, 32));
        const float mn = fmaxf(mrun, tm), alpha = exp2f(mrun - mn); mrun = mn;
        float ls = 0.f;
#pragma unroll
        for (int r = 0; r < 16; ++r) { p0[r] = exp2f(p0[r] - mn); p1[r] = exp2f(p1[r] - mn); ls += p0[r] + p1[r]; o0[r] *= alpha; o1[r] *= alpha; }
        lrun = lrun * alpha + ls;
        bf16x8 pf[4];
#pragma unroll
        for (int s = 0; s < 2; ++s) {
            v4u w0, w1;
            w0.x = pk2(p0[8 * s + 0], p0[8 * s + 1]); w0.y = pk2(p0[8 * s + 2], p0[8 * s + 3]); w0.z = pk2(p0[8 * s + 4], p0[8 * s + 5]); w0.w = pk2(p0[8 * s + 6], p0[8 * s + 7]);
            w1.x = pk2(p1[8 * s + 0], p1[8 * s + 1]); w1.y = pk2(p1[8 * s + 2], p1[8 * s + 3]); w1.z = pk2(p1[8 * s + 4], p1[8 * s + 5]); w1.w = pk2(p1[8 * s + 6], p1[8 * s + 7]);
            pf[s] = __builtin_bit_cast(bf16x8, w0); pf[2 + s] = __builtin_bit_cast(bf16x8, w1);
        }
#pragma unroll
        for (int s4 = 0; s4 < 4; ++s4) {
#pragma unroll
            for (int dt = 0; dt < 2; ++dt) {
                const int d = 32 * dt + r32;
                const v2u lo = *(const v2u*)(ldsV + d * 128 + (((2 * s4) ^ (d & 7)) * 16) + 8 * hi);
                const v2u hi2 = *(const v2u*)(ldsV + d * 128 + (((2 * s4 + 1) ^ (d & 7)) * 16) + 8 * hi);
                v4u vf4; vf4.x = lo.x; vf4.y = lo.y; vf4.z = hi2.x; vf4.w = hi2.y;
                const bf16x8 vf = __builtin_bit_cast(bf16x8, vf4);
                if (dt == 0) o0 = __builtin_amdgcn_mfma_f32_32x32x16_bf16(vf, pf[s4], o0, 0, 0, 0);
                else o1 = __builtin_amdgcn_mfma_f32_32x32x16_bf16(vf, pf[s4], o1, 0, 0, 0);
            }
        }
    }
    const float ltot = lrun + __shfl_xor(lrun, 32), inv = 1.f / ltot;
    bf16* mix = (bf16*)(F.ws + WS_MIX) + (size_t)(tokbase + qpos) * DM + head * 64;
#pragma unroll
    for (int g4 = 0; g4 < 4; ++g4) {
        v2u w; w.x = pk2(o0[4 * g4] * inv, o0[4 * g4 + 1] * inv); w.y = pk2(o0[4 * g4 + 2] * inv, o0[4 * g4 + 3] * inv);
        *(v2u*)(mix + 8 * g4 + 4 * hi) = w;
        v2u w2; w2.x = pk2(o1[4 * g4] * inv, o1[4 * g4 + 1] * inv); w2.y = pk2(o1[4 * g4 + 2] * inv, o1[4 * g4 + 3] * inv);
        *(v2u*)(mix + 32 + 8 * g4 + 4 * hi) = w2;
    }
    __syncthreads();
}

constexpr int RL_XC32 = 0, RL_XCB = 32768, RL_LA = 49152, RL_LB = 81920, RL_SEGA = 114688, RL_SEGB = 116736, RL_CARRY = 118784;
__device__ __forceinline__ void rnn_unit(Frame& F, bool lat, int seq, int n) {
    const int lane = F.lane, wave = F.wave, r32 = lane & 31, hi = lane >> 5;
    const int S = lat ? SEQ_L : SEQ_C, tokbase = lat ? NCTX + seq * SEQ_L : seq * SEQ_C, nchunk = S / 128;
    float* XC32 = (float*)(F.lds + RL_XC32); unsigned char* XCB = F.lds + RL_XCB; float* LA = (float*)(F.lds + RL_LA); float* LB = (float*)(F.lds + RL_LB);
    float* SEGA = (float*)(F.lds + RL_SEGA); float* SEGB = (float*)(F.lds + RL_SEGB); float* CARRY = (float*)(F.lds + RL_CARRY);
    const bf16* XR = (const bf16*)(F.ws + WS_XR) + (size_t)tokbase * 512 + n * 64 + lane;
    const bf16* YG = (const bf16*)(F.ws + WS_YG) + (size_t)tokbase * 512 + n * 64 + lane;
    float* HF = (float*)(F.ws + WS_HF) + (size_t)tokbase * 512 + n * 64 + lane;
    bf16* MIX = (bf16*)(F.ws + WS_MIX) + (size_t)tokbase * DM + 512 + n * 64 + lane;
    const int chc = n * 64 + lane;
    const float cw0 = F.in[I_CONVW][chc], cw1 = F.in[I_CONVW][512 + chc], cw2 = F.in[I_CONVW][1024 + chc], cw3 = F.in[I_CONVW][1536 + chc], cb = F.in[I_CONVB][chc];
    const int tt = wave >> 1, chh = wave & 1, che = chh * 32 + r32;
    const int seg = wave;
#pragma unroll 1
    for (int dir = 0; dir < 2; ++dir) {
        bf16x8 wf[2][4];
        { const bf16* wg = (const bf16*)(F.ws + WS_RGW) + (size_t)((dir * 8 + n) * 2) * 4096 + (size_t)che * 64 + 8 * hi;
#pragma unroll
          for (int gt = 0; gt < 2; ++gt)
#pragma unroll
            for (int ks = 0; ks < 4; ++ks) wf[gt][ks] = *(const bf16x8*)(wg + gt * 4096 + 16 * ks); }
        const int pe = dir * 512 + n * 64 + che;
        const float ba = F.in[I_RGBA][pe], bi = F.in[I_RGBI][pe];
        float sp8; { const float nl = -F.in[I_RGLAM][pe]; sp8 = 8.f * (nl > 20.f ? nl : log1pf(__expf(nl))); }
        __syncthreads();
        if (wave == 0) CARRY[lane] = lat ? F.in[I_SRNN][(size_t)(seq * 2 + dir) * 512 + chc] : 0.f;
#pragma unroll 1
        for (int ci = 0; ci < nchunk; ++ci) {
            const int c0 = (dir == 0 ? ci : nchunk - 1 - ci) * 128;
            __syncthreads();
            {
                float xv[19];
#pragma unroll
                for (int i = 0; i < 19; ++i) { const int pos = c0 + seg * 16 - 2 + i; xv[i] = (pos >= 0 && pos < S) ? bf2f(XR[(size_t)pos * 512]) : 0.f; }
#pragma unroll
                for (int i = 0; i < 16; ++i) { const float y = cb + cw0 * xv[i] + cw1 * xv[i + 1] + cw2 * xv[i + 2] + cw3 * xv[i + 3];
                    const int tk = seg * 16 + i; XC32[tk * 64 + lane] = y;
                    *(bf16*)(XCB + tk * 128 + (((lane >> 3) ^ (tk & 7)) * 16) + (lane & 7) * 2) = (bf16)f2bf(y); }
            }
            __syncthreads();
            {
                f32x16 ga, gi;
#pragma unroll
                for (int r = 0; r < 16; ++r) { ga[r] = 0.f; gi[r] = 0.f; }
                const int tk = tt * 32 + r32;
#pragma unroll
                for (int ks = 0; ks < 4; ++ks) {
                    const bf16x8 af = *(const bf16x8*)(XCB + tk * 128 + (((2 * ks + hi) ^ (tk & 7)) * 16));
                    ga = __builtin_amdgcn_mfma_f32_32x32x16_bf16(af, wf[0][ks], ga, 0, 0, 0);
                    gi = __builtin_amdgcn_mfma_f32_32x32x16_bf16(af, wf[1][ks], gi, 0, 0, 0);
                }
#pragma unroll
                for (int r = 0; r < 16; ++r) { const int tk2 = tt * 32 + crow(r, hi); const float x = XC32[tk2 * 64 + che];
                    const float rg = sigmoidf_(ga[r] + ba), ig = sigmoidf_(gi[r] + bi), la = -rg * sp8, a = __expf(la);
                    const float b = sqrtf(fmaxf(-expm1f(2.f * la), 0.f)) * ig * x;
                    LA[tk2 * 64 + che] = a; LB[tk2 * 64 + che] = b; }
            }
            __syncthreads();
            {
                float A = 1.f, B = 0.f;
#pragma unroll
                for (int i = 0; i < 16; ++i) { const int tk = seg * 16 + (dir == 0 ? i : 15 - i); const float a = LA[tk * 64 + lane], b = LB[tk * 64 + lane]; B = a * B + b; A = a * A; }
                SEGA[seg * 64 + lane] = A; SEGB[seg * 64 + lane] = B;
            }
            __syncthreads();
            {
                float h = CARRY[lane];
                if (dir == 0) { for (int s2 = 0; s2 < seg; ++s2) h = SEGA[s2 * 64 + lane] * h + SEGB[s2 * 64 + lane]; }
                else { for (int s2 = 7; s2 > seg; --s2) h = SEGA[s2 * 64 + lane] * h + SEGB[s2 * 64 + lane]; }
#pragma unroll
                for (int i = 0; i < 16; ++i) { const int tk = seg * 16 + (dir == 0 ? i : 15 - i); const float a = LA[tk * 64 + lane], b = LB[tk * 64 + lane]; h = a * h + b;
                    const int pos = c0 + tk;
                    if (dir == 0) { HF[(size_t)pos * 512] = h;
                        if (!lat && pos == S - 1) F.out[O_NEWRNN + (size_t)(seq * 2 + 0) * 512 + chc] = h; }
                    else { const float hf = HF[(size_t)pos * 512]; const float y = bf2f(YG[(size_t)pos * 512]);
                        MIX[(size_t)pos * DM] = (bf16)f2bf((hf + h) * gelu_tanh(y));
                        if (!lat && pos == 0) F.out[O_NEWRNN + (size_t)(seq * 2 + 1) * 512 + chc] = h; } }
                __syncthreads();
                if ((dir == 0 && seg == 7) || (dir == 1 && seg == 0)) CARRY[lane] = h;
            }
        }
    }
    __syncthreads();
}

__device__ __forceinline__ void p3_phase(Frame& F) {
    for (int it = F.vcu; it < 832; it += F.G) {
        bool lat; int a;
        if (it < 64 || (it >= 320 && it < 576)) { lat = it < 64; a = lat ? it : it - 320; rnn_unit(F, lat, a >> 3, a & 7); }
        else { lat = it < 320; a = lat ? it - 64 : it - 576;
            if (lat) attn_unit(F, true, a >> 5, (a >> 4) & 1, a & 15); else attn_unit(F, false, a >> 3, (a >> 2) & 1, a & 3); }
    }
}

__device__ __forceinline__ unsigned key16(unsigned b, unsigned idx) { const unsigned s = (b & 0x8000u) ? (~b & 0xffffu) : (b | 0x8000u); return (s << 16) | idx; }
__device__ __forceinline__ float keyval16(unsigned k) { const unsigned s = k >> 16; const unsigned b = (s & 0x8000u) ? (s & 0x7fffu) : (~s & 0xffffu); return bf2f(b); }
__device__ __forceinline__ unsigned sortable32(float f) { const unsigned u = __builtin_bit_cast(unsigned, f); return (u & 0x80000000u) ? ~u : (u | 0x80000000u); }
template <int CTRL> __device__ __forceinline__ unsigned dppu(unsigned v) { return (unsigned)__builtin_amdgcn_update_dpp(0, (int)v, CTRL, 0xf, 0xf, true); }
template <int CTRL> __device__ __forceinline__ float dppf(float v) { return __builtin_bit_cast(float, __builtin_amdgcn_update_dpp(0, __builtin_bit_cast(int, v), CTRL, 0xf, 0xf, true)); }
__device__ __forceinline__ unsigned umax_(unsigned a, unsigned b) { return a > b ? a : b; }
__device__ __forceinline__ unsigned umin_(unsigned a, unsigned b) { return a < b ? a : b; }
__device__ __forceinline__ unsigned rowmax16u(unsigned x) { x = umax_(x, dppu<0xB1>(x)); x = umax_(x, dppu<0x4E>(x)); x = umax_(x, dppu<0x141>(x)); x = umax_(x, dppu<0x140>(x)); return x; }
__device__ __forceinline__ float rowmax16f(float x) { x = fmaxf(x, dppf<0xB1>(x)); x = fmaxf(x, dppf<0x4E>(x)); x = fmaxf(x, dppf<0x141>(x)); x = fmaxf(x, dppf<0x140>(x)); return x; }
__device__ __forceinline__ float rowsum16f(float x) { x += dppf<0xB1>(x); x += dppf<0x4E>(x); x += dppf<0x141>(x); x += dppf<0x140>(x); return x; }
__device__ __forceinline__ int rowsum16i(int x) { x += (int)dppu<0xB1>((unsigned)x); x += (int)dppu<0x4E>((unsigned)x); x += (int)dppu<0x141>((unsigned)x); x += (int)dppu<0x140>((unsigned)x); return x; }
#define CEX(a, b) do { const unsigned _h = umax_(a, b), _l = umin_(a, b); a = _h; b = _l; } while (0)

constexpr int P7_WL = 16384;
constexpr int P7_TL = 0, P7_TE = 1024, P7_TG = 3072, P7_LE = 5120, P7_LG = 7552, P7_LS = 9984, P7_H2Q = 10624, P7_HST = 14720;
static_assert(P7_LS + 608 <= P7_H2Q && P7_HST + 16 <= P7_WL && P7_WL * 8 <= RING_BYTES, "P7 LDS map");

__device__ __forceinline__ void topk_token(const bf16* sc, unsigned* TL, int lane, const int (&ctab)[4], int* oute, float* outg) {
    const int k = lane & 15, row = lane >> 4;
#pragma unroll 1
    for (int pass = 0; pass < 4; ++pass) {
        const int gidx = pass * 4 + row;
        const v4u raw = *(const v4u*)(sc + gidx * 128 + k * 8);
        unsigned r0 = key16(raw.x & 0xffffu, k * 8 + 0), r1 = key16(raw.x >> 16, k * 8 + 1), r2 = key16(raw.y & 0xffffu, k * 8 + 2), r3 = key16(raw.y >> 16, k * 8 + 3);
        unsigned r4 = key16(raw.z & 0xffffu, k * 8 + 4), r5 = key16(raw.z >> 16, k * 8 + 5), r6 = key16(raw.w & 0xffffu, k * 8 + 6), r7 = key16(raw.w >> 16, k * 8 + 7);
        CEX(r0, r1); CEX(r2, r3); CEX(r4, r5); CEX(r6, r7);
        CEX(r0, r2); CEX(r1, r3); CEX(r4, r6); CEX(r5, r7);
        CEX(r1, r2); CEX(r5, r6);
        CEX(r0, r4); CEX(r1, r5); CEX(r2, r6); CEX(r3, r7);
        CEX(r2, r4); CEX(r3, r5);
        CEX(r1, r2); CEX(r3, r4); CEX(r5, r6);
        unsigned keep = 0;
#pragma unroll
        for (int it = 0; it < 16; ++it) {
            const unsigned m = rowmax16u(r0); const bool win = r0 == m;
            r0 = win ? r1 : r0; r1 = win ? r2 : r1; r2 = win ? r3 : r2; r3 = win ? r4 : r3; r4 = win ? r5 : r4; r5 = win ? r6 : r5; r6 = win ? r7 : r6; r7 = win ? 0u : r7;
            keep = (k == it) ? m : keep;
        }
        TL[gidx * 16 + k] = keep;
    }
#pragma unroll 1
    for (int q = 0; q < 2; ++q) {
        const int hh = 4 * q + row;
        const unsigned* LA = TL + (2 * hh) * 16; const unsigned* LB = TL + (2 * hh + 1) * 16;
        unsigned c[4];
#pragma unroll
        for (int s = 0; s < 4; ++s) { const int ij = ctab[s]; const bool valid = ij >= 0; const int i = (ij >> 4) & 15, j = ij & 15;
            const float sum = keyval16(LA[i]) + keyval16(LB[j]);
            c[s] = valid ? ((sortable32(sum) & 0xffffff00u) | (unsigned)(i * 16 + j)) : 0u; }
        CEX(c[0], c[1]); CEX(c[2], c[3]); CEX(c[0], c[2]); CEX(c[1], c[3]); CEX(c[1], c[2]);
        unsigned keep = 0;
#pragma unroll
        for (int it = 0; it < 16; ++it) {
            const unsigned m = rowmax16u(c[0]); const bool win = c[0] == m;
            c[0] = win ? c[1] : c[0]; c[1] = win ? c[2] : c[1]; c[2] = win ? c[3] : c[2]; c[3] = win ? 0u : c[3];
            keep = (k == it) ? m : keep;
        }
        const int i = (keep >> 4) & 15, j = keep & 15; const unsigned ka = LA[i], kb = LB[j];
        const float bv = keyval16(ka) + keyval16(kb);
        const float mx = rowmax16f(bv); const float ex = __expf(bv - mx); const float sm = rowsum16f(ex);
        oute[q * 64 + lane] = (int)((ka & 127u) * 128u + (kb & 127u)); outg[q * 64 + lane] = ex / sm;
    }
}

__device__ __forceinline__ int mbcnt64(unsigned long long m) { return (int)__builtin_amdgcn_mbcnt_hi((unsigned)(m >> 32), __builtin_amdgcn_mbcnt_lo((unsigned)m, 0u)); }
__device__ __forceinline__ int rfl(int v) { return __builtin_amdgcn_readfirstlane(v); }
__device__ __forceinline__ float rflf(float v) { return __builtin_bit_cast(float, __builtin_amdgcn_readfirstlane(__builtin_bit_cast(int, v))); }

__device__ __forceinline__ void p7_phase(Frame& F, bool dry) {
    const int lane0 = F.lane, wave = F.wave;
    unsigned char* wl = F.lds + wave * P7_WL;
    unsigned* TL = (unsigned*)(wl + P7_TL); int* TE = (int*)(wl + P7_TE); float* TG = (float*)(wl + P7_TG);
    int* LE = (int*)(wl + P7_LE); float* LG = (float*)(wl + P7_LG); unsigned char* LS = wl + P7_LS; unsigned char* H2Q = wl + P7_H2Q; float* HST = (float*)(wl + P7_HST);
    const bf16* SC = (const bf16*)(F.ws + WS_SC); const bf16* H2 = (const bf16*)(F.ws + WS_H);
    const unsigned char* U8 = F.ws + WS_U; const unsigned char* V8 = F.ws + WS_V;
    const float* SU = (const float*)(F.ws + WS_SU); const float* SV = (const float*)(F.ws + WS_SV);
    const float* mods = (const float*)(F.ws + WS_MODS);
    int ctab[4];
#pragma unroll
    for (int s = 0; s < 4; ++s) { const int c = 16 * s + (lane0 & 15); int i, j;
        if (c < 16) { i = 0; j = c; } else if (c < 24) { i = 1; j = c - 16; } else if (c < 29) { i = 2; j = c - 24; } else if (c < 33) { i = 3; j = c - 29; } else if (c < 36) { i = 4; j = c - 33; }
        else if (c < 38) { i = 5; j = c - 36; } else if (c < 40) { i = 6; j = c - 38; } else if (c < 42) { i = 7; j = c - 40; } else if (c < 50) { i = c - 34; j = 0; } else { i = -1; j = 0; }
        ctab[s] = i < 0 ? -1 : i * 16 + j; }
    const int ntg = NTOK / (F.G * NWAVES * 4);
#pragma unroll 1
    for (int tg = 0; tg < ntg; ++tg) {
        const int tok0 = (F.vcu * ntg + tg) * (NWAVES * 4) + wave * 4;
        int lane = F.lane; asm volatile("" : "+v"(lane));
#pragma unroll 1
        for (int s = 0; s < 4; ++s) {
            topk_token(SC + (size_t)(tok0 + s) * 2048, TL, lane, ctab, TE + s * 128, TG + s * 128);
            const v4u a = *(const v4u*)(H2 + (size_t)(tok0 + s) * DM + 16 * lane), b = *(const v4u*)(H2 + (size_t)(tok0 + s) * DM + 16 * lane + 8);
            float hv[16];
            hv[0] = bflo(a.x); hv[1] = bfhi(a.x); hv[2] = bflo(a.y); hv[3] = bfhi(a.y); hv[4] = bflo(a.z); hv[5] = bfhi(a.z); hv[6] = bflo(a.w); hv[7] = bfhi(a.w);
            hv[8] = bflo(b.x); hv[9] = bfhi(b.x); hv[10] = bflo(b.y); hv[11] = bfhi(b.y); hv[12] = bflo(b.z); hv[13] = bfhi(b.z); hv[14] = bflo(b.w); hv[15] = bfhi(b.w);
            float am = 0.f;
#pragma unroll
            for (int i = 0; i < 16; ++i) am = fmaxf(am, fabsf(hv[i]));
#pragma unroll
            for (int o = 1; o < 64; o <<= 1) am = fmaxf(am, __shfl_xor(am, o));
            const float inv = am > 0.f ? 127.f / am : 0.f;
            if (lane == 0) HST[s] = am * (1.f / 127.f);
            v4u qv;
#pragma unroll
            for (int j = 0; j < 4; ++j) { unsigned w = 0;
#pragma unroll
                for (int i = 0; i < 4; ++i) { int q = (int)rintf(hv[4 * j + i] * inv); w |= ((unsigned)q & 0xffu) << (8 * i); }
                qv[j] = w; }
            *(v4u*)(H2Q + s * 1024 + 16 * lane) = qv;
        }
        int nb;
        {
            int tot[8];
#pragma unroll
            for (int c = 0; c < 8; ++c) tot[c] = 0;
#pragma unroll 1
            for (int s = 0; s < 4; ++s) { const int c0 = TE[s * 128 + lane] >> 11, c1 = TE[s * 128 + 64 + lane] >> 11;
#pragma unroll
                for (int c = 0; c < 8; ++c) { const int n = __popcll(__ballot(c0 == c)) + __popcll(__ballot(c1 == c)); tot[c] += (n + 3) & ~3; } }
            int off[8]; { int base = 0;
#pragma unroll
                for (int c = 0; c < 8; ++c) { off[c] = base; base += tot[c]; }
                nb = base >> 2; }
#pragma unroll 1
            for (int s = 0; s < 4; ++s) { const int e0 = TE[s * 128 + lane], e1 = TE[s * 128 + 64 + lane]; const float g0 = TG[s * 128 + lane], g1 = TG[s * 128 + 64 + lane]; const int c0 = e0 >> 11, c1 = e1 >> 11;
#pragma unroll
                for (int c = 0; c < 8; ++c) {
                    const unsigned long long m0 = __ballot(c0 == c), m1 = __ballot(c1 == c);
                    const int n0 = __popcll(m0), n = n0 + __popcll(m1), np = (n + 3) & ~3, base = off[c];
                    if (c0 == c) { const int p = base + mbcnt64(m0); LE[p] = e0; LG[p] = g0; LS[p] = (unsigned char)s; }
                    if (c1 == c) { const int p = base + n0 + mbcnt64(m1); LE[p] = e1; LG[p] = g1; LS[p] = (unsigned char)s; }
                    if (lane < np - n) { const int p = base + n + lane; LE[p] = c * 2048; LG[p] = 0.f; LS[p] = (unsigned char)s; }
                    off[c] = base + np;
                } }
        }
        {
            int lane_u = F.lane; asm volatile("" : "+v"(lane_u));
            const bool hi32 = lane_u >= 32, b16 = (lane_u & 16) != 0;
            const int xr = ((lane_u >> 5) & 1) | ((lane_u >> 3) & 2);
            v4u ra[4], rb[4];
#define P7_ULOAD(R, b) do { _Pragma("unroll") for (int x = 0; x < 4; ++x) { const int e = rfl(LE[4 * (b) + x]); R[x] = *(const v4u*)(U8 + (size_t)e * DM + 16 * lane_u); } } while (0)
#define P7_UCOMP(R, b) do { const int sl = rfl(LS[4 * (b)]); const v4u hq = *(const v4u*)(H2Q + sl * 1024 + 16 * lane_u); int p[4]; \
            _Pragma("unroll") for (int x = 0; x < 4; ++x) { int d = __builtin_amdgcn_sdot4((int)hq.x, (int)R[x].x, 0, false); d = __builtin_amdgcn_sdot4((int)hq.y, (int)R[x].y, d, false); \
                d = __builtin_amdgcn_sdot4((int)hq.z, (int)R[x].z, d, false); d = __builtin_amdgcn_sdot4((int)hq.w, (int)R[x].w, d, false); p[x] = d; } \
            const int t01 = (hi32 ? p[1] : p[0]) + __shfl_xor(hi32 ? p[0] : p[1], 32); const int t23 = (hi32 ? p[3] : p[2]) + __shfl_xor(hi32 ? p[2] : p[3], 32); \
            int t = (b16 ? t23 : t01) + __shfl_xor(b16 ? t01 : t23, 16); t = rowsum16i(t); \
            const int idx = 4 * (b) + xr; const int e = LE[idx]; const float g = LG[idx]; \
            const float hs = HST[sl]; \
            const float dotf = (float)t * (hs * SU[e]); const float cf = g * gelu_tanh(dotf) * SV[e]; \
            if ((lane_u & 15) == 0) LG[idx] = cf; } while (0)
            P7_ULOAD(ra, 0);
#pragma unroll 1
            for (int b = 0; b < nb; b += 2) {
                if (b + 1 < nb) P7_ULOAD(rb, b + 1);
                P7_UCOMP(ra, b);
                if (b + 1 < nb) { if (b + 2 < nb) P7_ULOAD(ra, b + 2); P7_UCOMP(rb, b + 1); }
            }
#undef P7_ULOAD
#undef P7_UCOMP
        }
        float acc[4][16]; float sumc[4];
#pragma unroll
        for (int s = 0; s < 4; ++s) { sumc[s] = 0.f;
#pragma unroll
            for (int i = 0; i < 16; ++i) acc[s][i] = 0.f; }
        {
            int lane_v = F.lane; asm volatile("" : "+v"(lane_v));
            v4u ra[4], rb[4];
#define P7_VLOAD(R, b) do { _Pragma("unroll") for (int x = 0; x < 4; ++x) { const int e = rfl(LE[4 * (b) + x]); R[x] = *(const v4u*)(V8 + (size_t)e * DM + 16 * lane_v); } } while (0)
#define P7_VACC(S, R, b) do { _Pragma("unroll") for (int x = 0; x < 4; ++x) { const float cf = rflf(LG[4 * (b) + x]); sumc[S] += cf; \
                _Pragma("unroll") for (int d = 0; d < 4; ++d) { const unsigned w = R[x][d]; acc[S][4 * d + 0] += cf * (float)(w & 0xffu); acc[S][4 * d + 1] += cf * (float)((w >> 8) & 0xffu); \
                    acc[S][4 * d + 2] += cf * (float)((w >> 16) & 0xffu); acc[S][4 * d + 3] += cf * (float)(w >> 24); } } } while (0)
#define P7_VCOMP(R, b) do { const int sl = rfl(LS[4 * (b)]); if (sl == 0) P7_VACC(0, R, b); else if (sl == 1) P7_VACC(1, R, b); else if (sl == 2) P7_VACC(2, R, b); else P7_VACC(3, R, b); } while (0)
            P7_VLOAD(ra, 0);
#pragma unroll 1
            for (int b = 0; b < nb; b += 2) {
                if (b + 1 < nb) P7_VLOAD(rb, b + 1);
                P7_VCOMP(ra, b);
                if (b + 1 < nb) { if (b + 2 < nb) P7_VLOAD(ra, b + 2); P7_VCOMP(rb, b + 1); }
            }
#undef P7_VLOAD
#undef P7_VACC
#undef P7_VCOMP
        }
#pragma unroll
        for (int s = 0; s < 4; ++s) {
            const int tok = tok0 + s;
            int lane_f = F.lane; asm volatile("" : "+v"(lane_f));
            float* xrow = F.out + O_Y + (size_t)tok * DM + 16 * lane_f;
            float* yrow = dry ? (float*)(F.ws + WS_MIX) + (size_t)(tok & 8191) * DM + 16 * lane_f : xrow;
            const float* ga2 = mods + (size_t)mod_index(tok) * MODW + 5 * DM + 16 * lane_f;
            const float* gf = F.in[I_GFINAL] + 16 * lane_f;
            float x2[16]; float ss = 0.f; const float off = 128.f * sumc[s];
#pragma unroll
            for (int j = 0; j < 4; ++j) { const f32x4 xv = *(const f32x4*)(xrow + 4 * j), gv = *(const f32x4*)(ga2 + 4 * j);
#pragma unroll
                for (int i = 0; i < 4; ++i) { const float t = xv[i] + gv[i] * (acc[s][4 * j + i] - off); x2[4 * j + i] = t; ss += t * t; } }
            const float rstd = 1.f / sqrtf(wave_sum(ss) * (1.f / DM) + EPS);
#pragma unroll
            for (int j = 0; j < 4; ++j) { const f32x4 gv = *(const f32x4*)(gf + 4 * j); f32x4 o;
#pragma unroll
                for (int i = 0; i < 4; ++i) o[i] = x2[4 * j + i] * rstd * gv[i];
                *(f32x4*)(yrow + 4 * j) = o; }
        }
    }
}

__global__ void __launch_bounds__(NWAVES * 64, 2) mk_fwd(Args args) {
    extern __shared__ __attribute__((aligned(16))) unsigned char lds[];
    Frame F;
    F.lds = lds;
    F.tid = threadIdx.x; F.lane = F.tid & 63; F.wave = __builtin_amdgcn_readfirstlane(F.tid >> 6);
    F.G = gridDim.x; { const int bx = blockIdx.x; F.vcu = (F.G % 8 == 0) ? (bx % 8) * (F.G / 8) + bx / 8 : bx; }
    F.in = args.in; F.out = args.out; F.ws = args.ws;
    LAS unsigned char* lds3 = (LAS unsigned char*)lds;
    volatile LAS unsigned* MISC = (volatile LAS unsigned*)(lds3 + MISC_OFF);
    for (int u = F.tid; u < (LDS_BYTES - LDSCTL_OFF) / 4; u += NWAVES * 64) ((LAS unsigned*)(lds3 + LDSCTL_OFF))[u] = 0u;
    __syncthreads();
    unsigned* ctl = (unsigned*)(args.ws + WS_CTL);
    XcdBarrier bar; bar.bar = ctl + CW_BAR; bar.x = 0; bar.st = nullptr;
    const bool one_launch = (args.ph_hi - args.ph_lo) > 1;
    if (one_launch) bar = xcd_barrier_post(ctl + CW_BAR, MISC + 8);
    const int lo = args.ph_lo, hi = args.ph_hi;
#ifndef MK_PHASE_MASK
#define MK_PHASE_MASK 0xff
#endif
#define IN(k) (((MK_PHASE_MASK >> (k)) & 1) && lo <= (k) && (k) < hi)
#define SEAM(k) do { if (IN(k) && IN((k) + 1)) xcd_barrier(bar); } while (0)

    if (IN(0)) { if (MK_DUP == 0) { p0_phase(F); xcd_barrier(bar); } p0_phase(F); SEAM(0); }
    if (IN(1)) { norm_phase(F, 0); SEAM(1); }
    if (IN(2)) {
        pg8::Gemm g{(const pg8::bf16_t*)(F.ws + WS_H), (const pg8::bf16_t*)(F.ws + WS_WIN), NTOK, D_IN, DM}; pg8::StaticOrder S; S.init(NTOK, D_IN, F.G, (int)blockIdx.x);
        EpiInProj E{(bf16*)(F.ws + WS_Q), (bf16*)(F.ws + WS_K), (bf16*)(F.ws + WS_VT), (bf16*)(F.ws + WS_XR), (bf16*)(F.ws + WS_YG), F.out + O_NEWK, F.out + O_NEWV, (const f32x4*)(F.ws + WS_ROPE)};
        pg8::gemm_phase<EpiInProj, pg8::StaticOrder, true, true>(lds3, g, S, E);
        SEAM(2);
    }
    if (IN(3)) { if (MK_DUP == 3) { p3_phase(F); xcd_barrier(bar); } p3_phase(F); SEAM(3); }
    if (IN(4)) {
        pg8::Gemm g{(const pg8::bf16_t*)(F.ws + WS_MIX), (const pg8::bf16_t*)(F.ws + WS_WOUT), NTOK, DM, DM}; pg8::StaticOrder S; S.init(NTOK, DM, F.G, (int)blockIdx.x);
        EpiOutProj E{F.in[I_XP], F.in[I_XS], (const float*)(F.ws + WS_MODS), F.out + O_Y};
        pg8::gemm_phase<EpiOutProj, pg8::StaticOrder, true, true>(lds3, g, S, E);
        SEAM(4);
    }
    if (IN(5)) { norm_phase(F, 1); SEAM(5); }
    if (IN(6)) {
        pg8::Gemm g{(const pg8::bf16_t*)(F.ws + WS_H), (const pg8::bf16_t*)(F.ws + WS_WC), NTOK, 2048, DM}; pg8::StaticOrder S; S.init(NTOK, 2048, F.G, (int)blockIdx.x);
        EpiScores E{(bf16*)(F.ws + WS_SC)};
        pg8::gemm_phase<EpiScores, pg8::StaticOrder, true, true>(lds3, g, S, E);
        SEAM(6);
    }
    if (IN(7)) { if (MK_DUP == 7) { p7_phase(F, true); xcd_barrier(bar); } p7_phase(F, false); }
#undef IN
#undef SEAM
}

extern "C" void kernel_launch(void* const* d_in, const int* in_sizes, int n_in, void* d_out, int out_size, void* d_ws, size_t ws_size, hipStream_t stream) {
    static int grid = 0;
    if (grid == 0) {
        if (n_in != 26 || ws_size < WS_END) { fprintf(stderr, "kernel_launch: unexpected n_in %d / ws %zu\n", n_in, ws_size); grid = -1; return; }
        int dev = 0, cus = 0, per_cu = 0;
        if (hipGetDevice(&dev) != hipSuccess || hipDeviceGetAttribute(&cus, hipDeviceAttributeMultiprocessorCount, dev) != hipSuccess) { grid = -1; return; }
        if (hipFuncSetAttribute((const void*)mk_fwd, hipFuncAttributeMaxDynamicSharedMemorySize, LDS_BYTES) != hipSuccess) { fprintf(stderr, "kernel_launch: hipFuncSetAttribute failed\n"); grid = -1; return; }
        if (hipOccupancyMaxActiveBlocksPerMultiprocessor(&per_cu, (const void*)mk_fwd, NWAVES * 64, LDS_BYTES) != hipSuccess || per_cu < 1)
            fprintf(stderr, "kernel_launch: occupancy query reports %d blocks per CU\n", per_cu);
        (void)hipGetLastError();
        grid = cus;
        if (grid != 256) fprintf(stderr, "kernel_launch: note: %d CUs\n", grid);
    }
    if (grid < 0) return;
    (void)hipMemsetAsync((char*)d_ws + WS_CTL, 0, CTL_ZERO_BYTES, stream);
    Args a{};
    for (int i = 0; i < 26; ++i) a.in[i] = (const float*)d_in[i];
    a.out = (float*)d_out; a.ws = (unsigned char*)d_ws;
    if (MK_N_LAUNCHES == 1) {
        a.ph_lo = 0; a.ph_hi = N_PHASES; a.li = 0;
        hipLaunchKernelGGL(mk_fwd, dim3(grid), dim3(NWAVES * 64), LDS_BYTES, stream, a);
    } else {
        for (int li = 0; li < N_PHASES; ++li) { a.ph_lo = li; a.ph_hi = li + 1; a.li = li;
            hipLaunchKernelGGL(mk_fwd, dim3(grid), dim3(NWAVES * 64), LDS_BYTES, stream, a); }
    }
}
```

```cpp
#include <hip/hip_runtime.h>
#include <cstdio>
#include <cstdint>

#ifndef MK_DUP
#define MK_DUP -1
#endif
#ifndef MK_N_LAUNCHES
#define MK_N_LAUNCHES 1
#endif

namespace pg8 {
#define PG8_LAS __attribute__((address_space(3)))
typedef unsigned short bf16_t;
typedef short bf16x8 __attribute__((ext_vector_type(8)));
typedef float f32x4 __attribute__((ext_vector_type(4)));
typedef unsigned u32x4 __attribute__((ext_vector_type(4)));
typedef unsigned u32x2 __attribute__((ext_vector_type(2)));
constexpr int BM = 256, BK = 64, HALF = 128, HTB = HALF * BK * 2, STAGE_BYTES = 8 * HTB, NXCD = 8, WGM = 8;

__host__ __device__ __forceinline__ int lds_byte(int r, int c) { const int st = (r >> 4) * 2 + (c >> 5), rr = r & 15, cc = c & 31, ob = rr * 64 + cc * 2; return st * 1024 + (ob ^ (((ob >> 9) & 1) << 5)); }
__host__ __device__ __forceinline__ void stage_rc(int b, int& R, int& C) { const int st = b / 1024, sb = b % 1024, swz = sb ^ (((sb >> 9) & 1) << 5); R = (st >> 1) * 16 + swz / 64; C = (st & 1) * 32 + (swz % 64) / 2; }
__host__ __device__ __forceinline__ int perm32(int rho) { const int n = rho >> 4, i = rho & 15; return 8 * (i >> 2) + 4 * n + (i & 3); }

struct Unit { int pm, pn; };
struct Gemm { const bf16_t* A; const bf16_t* Bt; int M, N, K; };

struct StaticOrder {
    int nM, nN, nwg, G, c;
    __host__ __device__ void init(int M, int N, int G_, int c_) { nM = M / BM; nN = N / BM; nwg = nM * nN; G = G_; c = c_; }
    __host__ __device__ bool next(int i, Unit& u) const {
        const long L = (long)i * G + c; if (L >= nwg) return false;
        int wgid = (int)L; { const int q = nwg / NXCD, r = nwg % NXCD, xcd = wgid % NXCD, off = wgid / NXCD; wgid = (xcd < r ? xcd * (q + 1) : r * (q + 1) + (xcd - r) * q) + off; }
        const int nig = WGM * nN, gid = wgid / nig, fm = gid * WGM, gsz = (nM - fm) < WGM ? (nM - fm) : WGM;
        u.pm = fm + ((wgid % nig) % gsz); u.pn = (wgid % nig) / gsz; return true;
    }
    __device__ __forceinline__ void a_ready(const Unit&) const {}
    __device__ __forceinline__ void done(const Unit&) const {}
};

__device__ __forceinline__ unsigned cvt_pk_bf16(float lo, float hi) { unsigned r; asm volatile("v_cvt_pk_bf16_f32 %0, %1, %2" : "=v"(r) : "v"(lo), "v"(hi)); return r; }

template <class Epi, class Sched, bool ALIGN_EPI = false, bool SP2 = false>
__device__ __forceinline__ void gemm_phase(PG8_LAS unsigned char* lds, const Gemm g, const Sched& S, const Epi& E) {
    const int tid = threadIdx.x, wid = __builtin_amdgcn_readfirstlane(tid >> 6), lane = tid & 63, wr = wid >> 2, wc = wid & 3, fr = lane & 15, fq = lane >> 4;
    const int K = g.K, nt = K / BK;
    unsigned voffA[2], voffB[2];
#pragma unroll
    for (int i = 0; i < 2; ++i) { int R, C; stage_rc(tid * 16 + i * 8192, R, C); const int Rb = Epi::PERM ? ((R & ~31) + perm32(R & 31)) : R;
        voffA[i] = (unsigned)(R * K + C) * 2u; voffB[i] = (unsigned)(Rb * K + C) * 2u; }
    const size_t kstep = (size_t)(BK * 2);
    const size_t hstep = (size_t)HALF * K * 2;
    const size_t tstep = 2 * hstep;
    const unsigned ldsw = (unsigned)wid * 1024u;
    const int aoff = lds_byte(wr * 64 + fr, fq * 8), boff = lds_byte(wc * 32 + fr, fq * 8);
#define PG8_SA(b, h) (((b) * 2 + (h)) * HTB)
#define PG8_SB(b, h) ((4 + (b) * 2 + (h)) * HTB)
#define PG8_STAGE(bufoff, gbase, voff) do { _Pragma("unroll") for (int _i = 0; _i < 2; ++_i) \
        __builtin_amdgcn_global_load_lds((const unsigned*)((const char*)(gbase) + (voff)[_i]), (PG8_LAS unsigned*)(lds + (bufoff) + ldsw + _i * 8192), 16, 0, 0); } while (0)
#define PG8_LDA(dst, b, h) do { _Pragma("unroll") for (int m = 0; m < 4; ++m) _Pragma("unroll") for (int k = 0; k < 2; ++k) dst[m][k] = *(const PG8_LAS bf16x8*)(lds + PG8_SA(b, h) + aoff + m * 2048 + k * 1024); } while (0)
#define PG8_LDB(dst, b, h) do { _Pragma("unroll") for (int n = 0; n < 2; ++n) _Pragma("unroll") for (int k = 0; k < 2; ++k) dst[n][k] = *(const PG8_LAS bf16x8*)(lds + PG8_SB(b, h) + boff + n * 2048 + k * 1024); } while (0)
#define PG8_MMA(ai, bj, At, Bt) do { __builtin_amdgcn_s_setprio(1); _Pragma("unroll") for (int m = 0; m < 4; ++m) _Pragma("unroll") for (int n = 0; n < 2; ++n) _Pragma("unroll") for (int k = 0; k < 2; ++k) \
        acc[ai][bj][m][n] = __builtin_amdgcn_mfma_f32_16x16x32_bf16(Bt[n][k], At[m][k], acc[ai][bj][m][n], 0, 0, 0); __builtin_amdgcn_s_setprio(0); } while (0)
#define PG8_WAIT_V(n) asm volatile("s_waitcnt vmcnt(" #n ")" ::: "memory")
#define PG8_WAIT_L(n) asm volatile("s_waitcnt lgkmcnt(" #n ")" ::: "memory")
#define PG8_BAR __builtin_amdgcn_s_barrier()
#define PG8_SCHED __builtin_amdgcn_sched_barrier(0)
    Unit cur, nxt; int ui = 0;
    if (!S.next(0, cur)) return;
    f32x4 acc[2][2][4][2];
#pragma unroll
    for (int a = 0; a < 2; ++a)
#pragma unroll
        for (int b = 0; b < 2; ++b)
#pragma unroll
            for (int m = 0; m < 4; ++m)
#pragma unroll
                for (int n = 0; n < 2; ++n) acc[a][b][m][n] = (f32x4){0.f, 0.f, 0.f, 0.f};
    bf16x8 At[4][2], B0[2][2], B1[2][2];
    const char* cA = (const char*)g.A + (size_t)cur.pm * tstep; const char* cB = (const char*)g.Bt + (size_t)cur.pn * tstep;
    S.a_ready(cur);
    if constexpr (SP2) {
        PG8_STAGE(PG8_SB(0, 0), cB, voffB); PG8_STAGE(PG8_SB(0, 1), cB + hstep, voffB); PG8_STAGE(PG8_SA(0, 0), cA, voffA); PG8_STAGE(PG8_SA(0, 1), cA + hstep, voffA);
        if (wr == 1) PG8_BAR;
        PG8_WAIT_V(2); PG8_BAR;
        PG8_STAGE(PG8_SB(1, 0), cB + kstep, voffB); PG8_STAGE(PG8_SA(1, 0), cA + kstep, voffA); PG8_STAGE(PG8_SB(1, 1), cB + hstep + kstep, voffB);
        PG8_WAIT_V(6); PG8_BAR;
    } else {
        PG8_STAGE(PG8_SB(0, 0), cB, voffB); PG8_STAGE(PG8_SA(0, 0), cA, voffA); PG8_STAGE(PG8_SB(0, 1), cB + hstep, voffB); PG8_STAGE(PG8_SA(0, 1), cA + hstep, voffA);
        if (wr == 1) PG8_BAR;
        PG8_WAIT_V(4); PG8_BAR;
        PG8_STAGE(PG8_SB(1, 0), cB + kstep, voffB); PG8_STAGE(PG8_SA(1, 0), cA + kstep, voffA); PG8_STAGE(PG8_SB(1, 1), cB + hstep + kstep, voffB);
        PG8_WAIT_V(6); PG8_BAR;
    }
    for (;;) {
        const bool has_next = S.next(ui + 1, nxt);
        const char* nA = has_next ? (const char*)g.A + (size_t)nxt.pm * tstep : cA; const char* nB = has_next ? (const char*)g.Bt + (size_t)nxt.pn * tstep : cB;
        for (int t = 0; t < nt; t += 2) {
            const bool last = (t == nt - 2);
            const char* a1 = cA + (size_t)(t + 1) * kstep;
            const char* a2 = last ? nA : cA + (size_t)(t + 2) * kstep; const char* b2 = last ? nB : cB + (size_t)(t + 2) * kstep;
            const char* a3 = a2 + kstep; const char* b3 = b2 + kstep;
            if (last && has_next) S.a_ready(nxt);
            if constexpr (SP2) {
            PG8_LDB(B0, 0, 0); PG8_LDB(B1, 0, 1); PG8_SCHED; PG8_LDA(At, 0, 0); PG8_STAGE(PG8_SA(1, 1), a1 + hstep, voffA);
            PG8_WAIT_V(8); PG8_WAIT_L(0); PG8_BAR; PG8_MMA(0, 0, At, B0); PG8_MMA(0, 1, At, B1); PG8_BAR; PG8_SCHED;
            PG8_LDA(At, 0, 1); PG8_STAGE(PG8_SB(0, 0), b2, voffB); PG8_STAGE(PG8_SB(0, 1), b2 + hstep, voffB); PG8_STAGE(PG8_SA(0, 0), a2, voffA);
            PG8_WAIT_V(8); PG8_WAIT_L(0); PG8_BAR; PG8_MMA(1, 0, At, B0); PG8_MMA(1, 1, At, B1); PG8_BAR; PG8_SCHED;
            PG8_LDB(B0, 1, 0); PG8_LDB(B1, 1, 1); PG8_SCHED; PG8_LDA(At, 1, 0); PG8_STAGE(PG8_SA(0, 1), a2 + hstep, voffA);
            PG8_WAIT_V(8); PG8_WAIT_L(0); PG8_BAR; PG8_MMA(0, 0, At, B0); PG8_MMA(0, 1, At, B1); PG8_BAR; PG8_SCHED;
            PG8_LDA(At, 1, 1); PG8_STAGE(PG8_SB(1, 0), b3, voffB); PG8_STAGE(PG8_SB(1, 1), b3 + hstep, voffB); PG8_STAGE(PG8_SA(1, 0), a3, voffA);
            PG8_WAIT_V(8); PG8_WAIT_L(0); PG8_BAR; PG8_MMA(1, 0, At, B0); PG8_MMA(1, 1, At, B1); PG8_BAR; PG8_SCHED;
            } else {
            PG8_LDB(B0, 0, 0); PG8_SCHED; PG8_LDA(At, 0, 0); PG8_STAGE(PG8_SA(1, 1), a1 + hstep, voffA);
            PG8_WAIT_L(8); PG8_BAR; PG8_WAIT_L(0); PG8_MMA(0, 0, At, B0); PG8_BAR; PG8_SCHED;
            PG8_LDB(B1, 0, 1); PG8_STAGE(PG8_SB(0, 0), b2, voffB);
            PG8_BAR; PG8_WAIT_L(0); PG8_MMA(0, 1, At, B1); PG8_BAR;
            PG8_LDA(At, 0, 1); PG8_STAGE(PG8_SA(0, 0), a2, voffA);
            PG8_BAR; PG8_WAIT_L(0); PG8_MMA(1, 0, At, B0); PG8_BAR; PG8_SCHED;
            PG8_STAGE(PG8_SB(0, 1), b2 + hstep, voffB);
            PG8_WAIT_V(6); PG8_BAR; PG8_MMA(1, 1, At, B1); PG8_BAR;
            PG8_LDB(B0, 1, 0); PG8_SCHED; PG8_LDA(At, 1, 0); PG8_STAGE(PG8_SA(0, 1), a2 + hstep, voffA);
            PG8_WAIT_L(8); PG8_BAR; PG8_WAIT_L(0); PG8_MMA(0, 0, At, B0); PG8_BAR; PG8_SCHED;
            PG8_LDB(B1, 1, 1); PG8_STAGE(PG8_SB(1, 0), b3, voffB);
            PG8_BAR; PG8_WAIT_L(0); PG8_MMA(0, 1, At, B1); PG8_BAR;
            PG8_LDA(At, 1, 1); PG8_STAGE(PG8_SA(1, 0), a3, voffA);
            PG8_BAR; PG8_WAIT_L(0); PG8_MMA(1, 0, At, B0); PG8_BAR; PG8_SCHED;
            PG8_STAGE(PG8_SB(1, 1), b3 + hstep, voffB);
            PG8_WAIT_V(6); PG8_BAR; PG8_MMA(1, 1, At, B1); PG8_BAR;
            }
        }
        if constexpr (ALIGN_EPI) { if (wr == 0) PG8_BAR; }
        E(acc, cur, wr, wc, fr, fq); S.done(cur);
        if (!has_next) break;
#pragma unroll
        for (int a = 0; a < 2; ++a)
#pragma unroll
            for (int b = 0; b < 2; ++b)
#pragma unroll
                for (int m = 0; m < 4; ++m)
#pragma unroll
                    for (int n = 0; n < 2; ++n) acc[a][b][m][n] = (f32x4){0.f, 0.f, 0.f, 0.f};
        cur = nxt; cA = nA; cB = nB; ++ui;
        if constexpr (ALIGN_EPI) { if (wr == 1) PG8_BAR; }
    }
    PG8_WAIT_V(0);
    if constexpr (!ALIGN_EPI) { if (wr == 0) PG8_BAR; }
    PG8_BAR;
#undef PG8_SA
#undef PG8_SB
#undef PG8_STAGE
#undef PG8_LDA
#undef PG8_LDB
#undef PG8_MMA
#undef PG8_WAIT_V
#undef PG8_WAIT_L
#undef PG8_BAR
#undef PG8_SCHED
}
}

constexpr int NWAVES = 8;
constexpr int DM = 1024, NTOK = 16384, NCTX = 8192, D_IN = 1792, NMODV = 9, MODW = 6144;
constexpr int SEQ_C = 256, SEQ_L = 1024, NSEQ_C = 32, NSEQ_L = 8;
constexpr int N_PHASES = 8;
constexpr float LOG2E = 1.4426950408889634f;
constexpr float QSCALE = 0.125f * LOG2E;
constexpr float EPS = 1e-6f;

constexpr size_t MiB = 1u << 20, KiB = 1u << 10;
constexpr size_t WS_CTL = 0, CTL_ZERO_BYTES = 64 * KiB;
constexpr size_t WS_MODS = 1 * MiB;
constexpr size_t WS_ROPE = 1 * MiB + 256 * KiB;
constexpr size_t WS_RGW  = 1 * MiB + 512 * KiB;
constexpr size_t WS_CK   = 1 * MiB + 768 * KiB;
constexpr size_t WS_CVT  = 2 * MiB + 256 * KiB;
constexpr size_t WS_WIN  = 3 * MiB;
constexpr size_t WS_WOUT = 7 * MiB;
constexpr size_t WS_WC   = 9 * MiB;
constexpr size_t WS_U    = 16 * MiB;
constexpr size_t WS_SU   = 13 * MiB;
constexpr size_t WS_SV   = 13 * MiB + 64 * KiB;
constexpr size_t WS_V    = 48 * MiB;
constexpr size_t WS_H    = 80 * MiB;
constexpr size_t WS_MIX  = 112 * MiB;
constexpr size_t WS_Q    = 144 * MiB;
constexpr size_t WS_K    = 160 * MiB;
constexpr size_t WS_VT   = 164 * MiB;
constexpr size_t WS_XR   = 168 * MiB;
constexpr size_t WS_YG   = 184 * MiB;
constexpr size_t WS_HF   = 200 * MiB;
constexpr size_t WS_SC   = 144 * MiB;
constexpr size_t WS_END  = 232 * MiB;
constexpr int VT_LAT_OFF = NSEQ_C * 2 * 64 * SEQ_C;

constexpr int CW_BAR = 4096;

constexpr int RING_BYTES = 131072;
constexpr int LDSCTL_OFF = RING_BYTES, MISC_OFF = LDSCTL_OFF + 320;
constexpr int LDS_BYTES = 147456;

#define GAS __attribute__((address_space(1)))
#define LAS __attribute__((address_space(3)))
typedef unsigned short bf16;
typedef unsigned v4u __attribute__((ext_vector_type(4)));
typedef unsigned v2u __attribute__((ext_vector_type(2)));
typedef float f32x4 __attribute__((ext_vector_type(4)));
typedef float f32x2 __attribute__((ext_vector_type(2)));
typedef float f32x16 __attribute__((ext_vector_type(16)));
typedef short bf16x8 __attribute__((ext_vector_type(8)));
typedef GAS unsigned gu32;
#define RLX_AGENT __ATOMIC_RELAXED, __HIP_MEMORY_SCOPE_AGENT

__device__ __forceinline__ unsigned f2bf(float f) { unsigned u = __builtin_bit_cast(unsigned, f); return (u + 0x7fffu + ((u >> 16) & 1u)) >> 16; }
__device__ __forceinline__ unsigned pk2(float lo, float hi) { return f2bf(lo) | (f2bf(hi) << 16); }
__device__ __forceinline__ float bf2f(unsigned b) { return __builtin_bit_cast(float, b << 16); }
__device__ __forceinline__ float bflo(unsigned w) { return __builtin_bit_cast(float, w << 16); }
__device__ __forceinline__ float bfhi(unsigned w) { return __builtin_bit_cast(float, w & 0xffff0000u); }
__device__ __forceinline__ float sigmoidf_(float x) { return 1.f / (1.f + __expf(-x)); }
__device__ __forceinline__ float gelu_tanh(float x) { const float y = 0.7978845608028654f * (x + 0.044715f * x * x * x); const float e = __expf(2.f * y); return 0.5f * x * (2.f - 2.f / (1.f + e)); }
__device__ __forceinline__ float wave_sum(float v) {
#pragma unroll
    for (int o = 1; o < 64; o <<= 1) v += __shfl_xor(v, o);
    return v;
}
__device__ __forceinline__ unsigned wave_max_u32(unsigned v) {
#pragma unroll
    for (int o = 1; o < 64; o <<= 1) { const unsigned t = (unsigned)__shfl_xor((int)v, o); v = t > v ? t : v; }
    return v;
}
__device__ __forceinline__ int crow(int r, int hi) { return (r & 3) + 8 * (r >> 2) + 4 * hi; }

#define XB_TMO      128
#define XB_XCNT(j)  (256  + 64 * (j))
#define XB_XSUB(j)  (1280 + 64 * (j))
#define XB_XGEN(j)  (2304 + 64 * (j))
#define XB_TOP      3328
#define XB_TOPGEN   3392
#define XCD_BAR_WORDS 3456
#define XB_SPIN_CAP (1u << 18)
__device__ __forceinline__ unsigned xb_ld(unsigned* p)              { return __hip_atomic_load(p, __ATOMIC_RELAXED, __HIP_MEMORY_SCOPE_AGENT); }
__device__ __forceinline__ unsigned xb_add(unsigned* p, unsigned v) { return __hip_atomic_fetch_add(p, v, __ATOMIC_RELAXED, __HIP_MEMORY_SCOPE_AGENT); }
__device__ __forceinline__ unsigned xb_xcc_id() { return (unsigned)__builtin_amdgcn_s_getreg((3 << 11) | 20) & 0xFu; }
#define XB_SPIN(cond, bar) do { unsigned _sp = 0; while (cond) { __builtin_amdgcn_s_sleep(1); \
    if ((++_sp & 255u) == 0u) { if (xb_ld(&(bar)[XB_TMO])) break; if (_sp > XB_SPIN_CAP) { atomicAdd(&(bar)[XB_TMO], 1u); break; } } } } while (0)
struct XcdBarrier { unsigned* bar; unsigned x; volatile LAS unsigned* st; };
__device__ __forceinline__ XcdBarrier xcd_barrier_post(unsigned* bar, volatile LAS unsigned* st) {
    XcdBarrier b; b.bar = bar; b.x = xb_xcc_id(); b.st = st;
    if (threadIdx.x == 0) (void)xb_add(&bar[XB_XCNT(b.x)], 1u);
    return b;
}
__device__ __forceinline__ void xcd_barrier_complete(unsigned* bar, unsigned x, unsigned& nloc, unsigned& nx) {
    const unsigned G = gridDim.x * gridDim.y * gridDim.z;
    unsigned sum, cnt, mine, sp = 0u;
    for (;;) {
        sum = 0u; cnt = 0u; mine = 0u;
#pragma unroll
        for (unsigned j = 0; j < 16; ++j) { const unsigned c = xb_ld(&bar[XB_XCNT(j)]); sum += c; cnt += (c > 0u) ? 1u : 0u; mine = (j == x) ? c : mine; }
        if (sum == G) break;
        __builtin_amdgcn_s_sleep(1);
        if ((++sp & 255u) == 0u) { if (xb_ld(&bar[XB_TMO])) break; if (sp > XB_SPIN_CAP) { atomicAdd(&bar[XB_TMO], 1u); break; } }
    }
    nloc = mine > 0u ? mine : 1u; nx = cnt > 0u ? cnt : 1u;
}
__device__ __forceinline__ void xcd_barrier(const XcdBarrier& b) {
    asm volatile("s_waitcnt vmcnt(0)" ::: "memory");
    __syncthreads();
    if (threadIdx.x == 0) {
        unsigned* bar = b.bar;
        __builtin_amdgcn_s_waitcnt(0);
        unsigned nloc = b.st[0], nx = b.st[1];
        if (nloc == 0u) { xcd_barrier_complete(bar, b.x, nloc, nx); b.st[0] = nloc; b.st[1] = nx; }
        const unsigned old = xb_add(&bar[XB_XSUB(b.x)], 1u);
        const unsigned gen = old / nloc;
        if (old + 1u == (gen + 1u) * nloc) {
            __builtin_amdgcn_fence(__ATOMIC_RELEASE, "agent");
            asm volatile("s_waitcnt vmcnt(0)" ::: "memory");
            const unsigned og = xb_add(&bar[XB_TOP], 1u);
            const unsigned tg = og / nx;
            if (og + 1u == (tg + 1u) * nx) xb_add(&bar[XB_TOPGEN], 1u);
            else XB_SPIN(xb_ld(&bar[XB_TOPGEN]) == tg, bar);
            __builtin_amdgcn_fence(__ATOMIC_ACQUIRE, "agent");
            xb_add(&bar[XB_XGEN(b.x)], 1u);
            asm volatile("s_waitcnt vmcnt(0)" ::: "memory");
        } else {
            XB_SPIN(xb_ld(&bar[XB_XGEN(b.x)]) == gen, bar);
            __builtin_amdgcn_fence(__ATOMIC_ACQUIRE, "agent");
            asm volatile("s_waitcnt vmcnt(0)" ::: "memory");
        }
    }
    __syncthreads();
}

struct Args { const float* in[26]; float* out; unsigned char* ws; int ph_lo, ph_hi, li, pad; };

struct Frame {
    unsigned char* lds;
    int tid, lane, wave, vcu, G;
    const float* const* in;
    float* out; unsigned char* ws;
};
enum { I_XP = 0, I_XS, I_CK, I_CV, I_SRNN, I_C, I_CCTX, I_WMOD, I_BMOD, I_GMIX, I_GFFN, I_WIN, I_CONVW, I_CONVB, I_RGWA, I_RGBA, I_RGWI, I_RGBI, I_RGLAM, I_SINK, I_WOUT, I_PWQ, I_PSK, I_PU, I_PV, I_GFINAL };
constexpr size_t O_Y = 0, O_NEWK = (size_t)NTOK * DM, O_NEWV = O_NEWK + (size_t)NCTX * 128, O_NEWRNN = O_NEWV + (size_t)NCTX * 128;

__device__ __forceinline__ int mod_index(int tok) { return tok < NCTX ? 0 : 1 + ((tok - NCTX) >> 10); }
__device__ __forceinline__ const float* x_row(const Frame& F, int tok) { return tok < NCTX ? F.in[I_XP] + (size_t)tok * DM : F.in[I_XS] + (size_t)(tok - NCTX) * DM; }

template <class RowMap>
__device__ __forceinline__ void p0_transpose_item(const float* W, int K, int N, bf16* WT, float* scr, int item, int lane, RowMap rowmap) {
    const int nblk = N / 32, kb = item / nblk, nb = item % nblk, k0 = 64 * kb, n0 = 32 * nb;
#pragma unroll 8
    for (int i = 0; i < 32; ++i) { const int kk = 2 * i + (lane >> 5); scr[kk * 33 + (lane & 31)] = W[(size_t)(k0 + kk) * N + n0 + (lane & 31)]; }
    __builtin_amdgcn_s_waitcnt(0xC07F); asm volatile("" ::: "memory");
    const int c = lane & 7;
#pragma unroll
    for (int j = 0; j < 4; ++j) { const int n = (lane >> 3) + 8 * j; const float* s = scr + (8 * c) * 33 + n;
        v4u o; o.x = pk2(s[0 * 33], s[1 * 33]); o.y = pk2(s[2 * 33], s[3 * 33]); o.z = pk2(s[4 * 33], s[5 * 33]); o.w = pk2(s[6 * 33], s[7 * 33]);
        *(v4u*)(WT + (size_t)rowmap(n0 + n) * K + k0 + 8 * c) = o; }
    __builtin_amdgcn_s_waitcnt(0xC07F); asm volatile("" ::: "memory");
}
struct MapId { __device__ __forceinline__ int operator()(int n) const { return n; } };
struct MapWin { __device__ __forceinline__ int operator()(int n) const { if (n >= 640) return n; const int hb = n & ~63, o = n & 63; return hb + ((o & 31) << 1) + (o >> 5); } };

__device__ __forceinline__ void p0_phase(Frame& F) {
    float* ldsf = (float*)F.lds;
    const int tid = F.tid, lane = F.lane, wave = F.wave, v = F.vcu;
    if (v < 192) {
        for (int i = tid; i < NMODV * DM; i += 512) { const int j = i >> 10, d = i & 1023; const float c = (j == 0) ? F.in[I_CCTX][d] : F.in[I_C][(j - 1) * DM + d]; ldsf[i] = c * sigmoidf_(c); }
        __syncthreads();
        const int e0 = 32 * v, c4 = tid & 7, kq = tid >> 3;
        float acc[NMODV][4];
#pragma unroll
        for (int j = 0; j < NMODV; ++j) { acc[j][0] = 0.f; acc[j][1] = 0.f; acc[j][2] = 0.f; acc[j][3] = 0.f; }
        const float* wm = F.in[I_WMOD] + e0 + 4 * c4;
#pragma unroll 4
        for (int kk = 0; kk < 16; ++kk) { const int k = kq * 16 + kk; const f32x4 w = *(const f32x4*)(wm + (size_t)k * MODW);
#pragma unroll
            for (int j = 0; j < NMODV; ++j) { const float s = ldsf[j * DM + k]; acc[j][0] += s * w[0]; acc[j][1] += s * w[1]; acc[j][2] += s * w[2]; acc[j][3] += s * w[3]; } }
#pragma unroll
        for (int j = 0; j < NMODV; ++j)
#pragma unroll
            for (int i = 0; i < 4; ++i) { float a = acc[j][i]; a += __shfl_xor(a, 8); a += __shfl_xor(a, 16); a += __shfl_xor(a, 32); acc[j][i] = a; }
        float* red = ldsf + NMODV * DM;
        if (lane < 8) {
#pragma unroll
            for (int j = 0; j < NMODV; ++j)
#pragma unroll
                for (int i = 0; i < 4; ++i) red[(wave * NMODV + j) * 32 + 4 * c4 + i] = acc[j][i];
        }
        __syncthreads();
        if (tid < NMODV * 32) { const int j = tid >> 5, col = tid & 31; float s = F.in[I_BMOD][e0 + col];
#pragma unroll
            for (int w = 0; w < 8; ++w) s += red[(w * NMODV + j) * 32 + col];
            ((float*)(F.ws + WS_MODS))[j * MODW + e0 + col] = s; }
        __syncthreads();
    }
    if (v < 256) {
        const int hh = v >> 4, dt = v & 15, d0 = 64 * dt;
        float* At = ldsf;
        float* Bkt = ldsf + 128 * 64;
        const float* wq = F.in[I_PWQ] + hh * 128;
        const float* sk = F.in[I_PSK] + (size_t)hh * 128 * 128;
#pragma unroll
        for (int i = 0; i < 4; ++i) { const int f = tid + 512 * i, d = f & 63, q4 = f >> 6; const f32x4 a = *(const f32x4*)(wq + (size_t)(d0 + d) * 2048 + 4 * q4);
            At[(4 * q4 + 0) * 64 + d] = a[0]; At[(4 * q4 + 1) * 64 + d] = a[1]; At[(4 * q4 + 2) * 64 + d] = a[2]; At[(4 * q4 + 3) * 64 + d] = a[3]; }
#pragma unroll
        for (int i = 0; i < 8; ++i) { const int f = tid + 512 * i, key = f & 127, q4 = f >> 7; const f32x4 b = *(const f32x4*)(sk + (size_t)key * 128 + 4 * q4);
            Bkt[(4 * q4 + 0) * 128 + key] = b[0]; Bkt[(4 * q4 + 1) * 128 + key] = b[1]; Bkt[(4 * q4 + 2) * 128 + key] = b[2]; Bkt[(4 * q4 + 3) * 128 + key] = b[3]; }
        __syncthreads();
        const int dg = tid & 15, kg = tid >> 4;
        float acc[4][4];
#pragma unroll
        for (int i = 0; i < 4; ++i)
#pragma unroll
            for (int j = 0; j < 4; ++j) acc[i][j] = 0.f;
#pragma unroll 4
        for (int q = 0; q < 128; ++q) { const f32x4 a = *(const f32x4*)(At + q * 64 + 4 * dg); const f32x4 b = *(const f32x4*)(Bkt + q * 128 + 4 * kg);
#pragma unroll
            for (int i = 0; i < 4; ++i)
#pragma unroll
                for (int j = 0; j < 4; ++j) acc[i][j] += a[i] * b[j]; }
        bf16* WcT = (bf16*)(F.ws + WS_WC);
#pragma unroll
        for (int j = 0; j < 4; ++j) { v2u o; o.x = pk2(acc[0][j], acc[1][j]); o.y = pk2(acc[2][j], acc[3][j]);
            *(v2u*)(WcT + (size_t)(hh * 128 + 4 * kg + j) * DM + d0 + 4 * dg) = o; }
        __syncthreads();
    }
    const int gw = v * NWAVES + wave, NGW = F.G * NWAVES;
    float* scr = ldsf + wave * 4096;
    {
        constexpr int I_IN = (DM / 64) * (D_IN / 32), I_OUT = (DM / 64) * (DM / 32), I_RG = 32 * 2;
        constexpr int NIT = I_IN + I_OUT + I_RG;
        for (int it = gw; it < NIT; it += NGW) {
            int r = it;
            if (r < I_IN) { p0_transpose_item(F.in[I_WIN], DM, D_IN, (bf16*)(F.ws + WS_WIN), scr, r, lane, MapWin()); continue; } r -= I_IN;
            if (r < I_OUT) { p0_transpose_item(F.in[I_WOUT], DM, DM, (bf16*)(F.ws + WS_WOUT), scr, r, lane, MapId()); continue; } r -= I_OUT;
            { const int mm = r >> 1, sub = r & 1, dir = mm >> 4, n = (mm >> 1) & 7, gate = mm & 1;
              const float* src = (gate ? F.in[I_RGWI] : F.in[I_RGWA]) + (size_t)(dir * 8 + n) * 4096;
              bf16* dst = (bf16*)(F.ws + WS_RGW) + (size_t)((dir * 8 + n) * 2 + gate) * 4096;
              p0_transpose_item(src, 64, 64, dst, scr, sub, lane, MapId()); }
        }
    }
    for (int it = gw; it < 2 * 16384; it += NGW) {
        const int tb = it >> 14, row = it & 16383;
        const float* src = (tb ? F.in[I_PV] : F.in[I_PU]) + (size_t)row * DM + 16 * lane;
        f32x4 a[4]; float am = 0.f;
#pragma unroll
        for (int j = 0; j < 4; ++j) { a[j] = *(const f32x4*)(src + 4 * j); am = fmaxf(am, fmaxf(fmaxf(fabsf(a[j][0]), fabsf(a[j][1])), fmaxf(fabsf(a[j][2]), fabsf(a[j][3])))); }
#pragma unroll
        for (int o = 1; o < 64; o <<= 1) am = fmaxf(am, __shfl_xor(am, o));
        const float inv = am > 0.f ? 127.f / am : 0.f;
        v4u o4;
#pragma unroll
        for (int j = 0; j < 4; ++j) { unsigned w = 0;
#pragma unroll
            for (int i = 0; i < 4; ++i) { int q = (int)rintf(a[j][i] * inv); q = q > 127 ? 127 : (q < -127 ? -127 : q); if (tb) q += 128; w |= ((unsigned)q & 0xffu) << (8 * i); }
            o4[j] = w; }
        *(v4u*)(F.ws + (tb ? WS_V : WS_U) + (size_t)row * DM + 16 * lane) = o4;
        if (lane == 0) ((float*)(F.ws + (tb ? WS_SV : WS_SU)))[row] = am * (1.f / 127.f);
    }
    const int gt = v * 512 + tid, NGT = F.G * 512;
    for (int e = gt; e < 8 * 256 * 128; e += NGT) {
        const int c = e & 127, bp = e >> 7, kvh = c >> 6, p = c & 63, old = (p & 1) ? 32 + (p >> 1) : (p >> 1);
        ((bf16*)(F.ws + WS_CK))[e] = (bf16)f2bf(F.in[I_CK][(size_t)bp * 128 + kvh * 64 + old]);
    }
    for (int e = gt; e < 8 * 256 * 128; e += NGT) {
        const int pos = e & 255, d = (e >> 8) & 63, kvh = (e >> 14) & 1, b = e >> 15;
        ((bf16*)(F.ws + WS_CVT))[e] = (bf16)f2bf(F.in[I_CV][(size_t)(b * 256 + pos) * 128 + kvh * 64 + d]);
    }
    for (int e = gt; e < 1024 * 32; e += NGT) {
        const int s = e >> 5, i = e & 31, row = s >> 6, col = s & 63;
        const float inv = powf(10000.0f, -(float)(i & 15) / 16.0f);
        const float ang = (i < 16 ? (float)row : (float)col) * inv;
        f32x2 cs; cs.x = cosf(ang); cs.y = sinf(ang);
        ((f32x2*)(F.ws + WS_ROPE))[e] = cs;
    }
}

__device__ __forceinline__ void norm_phase(Frame& F, int which) {
    const int gw = F.vcu * NWAVES + F.wave, NGW = F.G * NWAVES, lane = F.lane;
    const float* mods = (const float*)(F.ws + WS_MODS);
    const float* g = F.in[which ? I_GFFN : I_GMIX];
    bf16* H = (bf16*)(F.ws + WS_H);
    for (int tok = gw; tok < NTOK; tok += NGW) {
        const float* xr = which ? F.out + O_Y + (size_t)tok * DM : x_row(F, tok);
        const float* mv = mods + (size_t)mod_index(tok) * MODW + (which ? 3 * DM : 0);
        f32x4 v[4]; float ss = 0.f;
#pragma unroll
        for (int j = 0; j < 4; ++j) { v[j] = *(const f32x4*)(xr + 256 * j + 4 * lane); ss += (v[j][0] * v[j][0] + v[j][1] * v[j][1]) + (v[j][2] * v[j][2] + v[j][3] * v[j][3]); }
        const float rstd = 1.f / sqrtf(wave_sum(ss) * (1.f / DM) + EPS);
#pragma unroll
        for (int j = 0; j < 4; ++j) { const int e = 256 * j + 4 * lane;
            const f32x4 gg = *(const f32x4*)(g + e), sh = *(const f32x4*)(mv + e), sc = *(const f32x4*)(mv + DM + e);
            f32x4 o;
#pragma unroll
            for (int i = 0; i < 4; ++i) o[i] = v[j][i] * rstd * gg[i] * (1.f + sc[i]) + sh[i];
            v2u w; w.x = pk2(o[0], o[1]); w.y = pk2(o[2], o[3]); *(v2u*)(H + (size_t)tok * DM + e) = w; }
    }
}

struct EpiInProj {
    static constexpr bool PERM = false;
    bf16 *q, *k, *vT, *xr, *yg; float *newk, *newv; const f32x4* rope4;
    __device__ __forceinline__ void operator()(const f32x4 (&acc)[2][2][4][2], const pg8::Unit& u, int wr, int wc, int fr, int fq) const {
        const bool lat = u.pm >= 32;
        const int pn = u.pn;
#pragma unroll
        for (int ai = 0; ai < 2; ++ai)
#pragma unroll
            for (int m = 0; m < 4; ++m) {
                const int row = u.pm * 256 + ai * 128 + wr * 64 + m * 16 + fr;
                const int pos = lat ? ((row - NCTX) & 1023) : (row & 255);
#pragma unroll
                for (int bj = 0; bj < 2; ++bj)
#pragma unroll
                    for (int n = 0; n < 2; ++n) {
                        const int c = pn * 256 + bj * 128 + wc * 32 + n * 16 + 4 * fq;
                        f32x4 v = acc[ai][bj][m][n];
                        if (pn < 2 || (pn == 2 && bj == 0)) {
                            const int i = (c & 63) >> 1;
                            if (lat) { const f32x4 cs = rope4[(pos * 32 + i) >> 1];
                                const float a0 = v[0] * cs[0] - v[1] * cs[1], a1 = v[1] * cs[0] + v[0] * cs[1];
                                const float b0 = v[2] * cs[2] - v[3] * cs[3], b1 = v[3] * cs[2] + v[2] * cs[3];
                                v[0] = a0; v[1] = a1; v[2] = b0; v[3] = b1; }
                            if (pn < 2) { v2u w; w.x = pk2(v[0] * QSCALE, v[1] * QSCALE); w.y = pk2(v[2] * QSCALE, v[3] * QSCALE); *(v2u*)(q + (size_t)row * 512 + c) = w; }
                            else { const int kc = c - 512; v2u w; w.x = pk2(v[0], v[1]); w.y = pk2(v[2], v[3]); *(v2u*)(k + (size_t)row * 128 + kc) = w;
                                if (!lat) { float* nk = newk + (size_t)row * 128 + (kc & 64) + i; f32x2 lo; lo.x = v[0]; lo.y = v[2]; f32x2 hi; hi.x = v[1]; hi.y = v[3]; *(f32x2*)nk = lo; *(f32x2*)(nk + 32) = hi; } }
                        } else if (pn == 2) {
                            const int vc = c - 640, kvh = vc >> 6, d = vc & 63;
                            if (!lat) *(f32x4*)(newv + (size_t)row * 128 + vc) = v;
                            bf16* vp; int S;
                            if (!lat) { S = SEQ_C; vp = vT + ((size_t)((row >> 8) * 2 + kvh) * 64 + d) * SEQ_C + pos; }
                            else { S = SEQ_L; vp = vT + VT_LAT_OFF + ((size_t)(((row - NCTX) >> 10) * 2 + kvh) * 64 + d) * SEQ_L + pos; }
                            vp[0] = (bf16)f2bf(v[0]); vp[S] = (bf16)f2bf(v[1]); vp[2 * S] = (bf16)f2bf(v[2]); vp[3 * S] = (bf16)f2bf(v[3]);
                        } else if (pn < 5) {
                            v2u w; w.x = pk2(v[0], v[1]); w.y = pk2(v[2], v[3]); *(v2u*)(xr + (size_t)row * 512 + (c - 768)) = w;
                        } else {
                            v2u w; w.x = pk2(v[0], v[1]); w.y = pk2(v[2], v[3]); *(v2u*)(yg + (size_t)row * 512 + (c - 1280)) = w;
                        }
                    }
            }
    }
};
struct EpiOutProj {
    static constexpr bool PERM = false;
    const float *xp, *xs, *mods; float* x1;
    __device__ __forceinline__ void operator()(const f32x4 (&acc)[2][2][4][2], const pg8::Unit& u, int wr, int wc, int fr, int fq) const {
        const int mi = u.pm < 32 ? 0 : 1 + ((u.pm - 32) >> 2);
        const float* ga = mods + (size_t)mi * MODW + 2 * DM;
#pragma unroll
        for (int ai = 0; ai < 2; ++ai)
#pragma unroll
            for (int m = 0; m < 4; ++m) {
                const int row = u.pm * 256 + ai * 128 + wr * 64 + m * 16 + fr;
                const float* xrow = row < NCTX ? xp + (size_t)row * DM : xs + (size_t)(row - NCTX) * DM;
#pragma unroll
                for (int bj = 0; bj < 2; ++bj)
#pragma unroll
                    for (int n = 0; n < 2; ++n) {
                        const int c = u.pn * 256 + bj * 128 + wc * 32 + n * 16 + 4 * fq;
                        const f32x4 xv = *(const f32x4*)(xrow + c), gv = *(const f32x4*)(ga + c);
                        *(f32x4*)(x1 + (size_t)row * DM + c) = xv + gv * acc[ai][bj][m][n];
                    }
            }
    }
};
struct EpiScores {
    static constexpr bool PERM = true;
    bf16* sc;
    __device__ __forceinline__ void operator()(const f32x4 (&acc)[2][2][4][2], const pg8::Unit& u, int wr, int wc, int fr, int fq) const {
#pragma unroll
        for (int ai = 0; ai < 2; ++ai)
#pragma unroll
            for (int m = 0; m < 4; ++m) {
                const int row = u.pm * 256 + ai * 128 + wr * 64 + m * 16 + fr;
#pragma unroll
                for (int bj = 0; bj < 2; ++bj) {
                    const int c = u.pn * 256 + bj * 128 + wc * 32 + 8 * fq;
                    const f32x4 v0 = acc[ai][bj][m][0], v1 = acc[ai][bj][m][1];
                    v4u w; w.x = pk2(v0[0], v0[1]); w.y = pk2(v0[2], v0[3]); w.z = pk2(v1[0], v1[1]); w.w = pk2(v1[2], v1[3]);
                    *(v4u*)(sc + (size_t)row * 2048 + c) = w;
                }
            }
    }
};

__device__ __forceinline__ void attn_unit(Frame& F, bool lat, int seq, int kvh, int qt) {
    const int tid = F.tid, lane = F.lane, wave = F.wave, r32 = lane & 31, hi = lane >> 5;
    const int g = wave >> 1, qs = wave & 1, head = kvh * 4 + g;
    const int S = lat ? SEQ_L : SEQ_C, tokbase = lat ? NCTX + seq * SEQ_L : seq * SEQ_C;
    const int q0 = qt * 64, qpos = q0 + 32 * qs + r32;
    const bf16* Q = (const bf16*)(F.ws + WS_Q); const bf16* Kb = (const bf16*)(F.ws + WS_K); const bf16* VT = (const bf16*)(F.ws + WS_VT);
    const bf16* CK = (const bf16*)(F.ws + WS_CK); const bf16* CVT = (const bf16*)(F.ws + WS_CVT);
    unsigned char* ldsK = F.lds; unsigned char* ldsV = F.lds + 8192;
    bf16x8 qf[4];
    { const bf16* qp = Q + (size_t)(tokbase + qpos) * 512 + head * 64;
#pragma unroll
      for (int ks = 0; ks < 4; ++ks) qf[ks] = *(const bf16x8*)(qp + 16 * ks + 8 * hi); }
    const float sinkl = F.in[I_SINK][head] * LOG2E;
    float mrun = sinkl, lrun = (hi == 0) ? 1.f : 0.f;
    f32x16 o0, o1;
#pragma unroll
    for (int r = 0; r < 16; ++r) { o0[r] = 0.f; o1[r] = 0.f; }
    int tlo, thi;
    if (lat) { tlo = (q0 >= 128 ? q0 - 128 : 0) >> 6; thi = ((q0 + 192 < S ? q0 + 192 : S)) >> 6; } else { tlo = 0; thi = 4; }
    const int nband = thi - tlo, ntile = nband + (lat ? 4 : 0);
    const int key_t = tid >> 3, ch_t = tid & 7;
    for (int t = 0; t < ntile; ++t) {
        const bool band = t < nband;
        const bf16* kptr; const bf16* vptr; int vstride; int kbase = 0;
        if (band) { const int tile = tlo + t; kbase = tile * 64;
            kptr = Kb + (size_t)(tokbase + kbase) * 128 + kvh * 64;
            vptr = VT + (lat ? (size_t)VT_LAT_OFF + (size_t)((seq * 2 + kvh) * 64) * SEQ_L : (size_t)((seq * 2 + kvh) * 64) * SEQ_C) + kbase; vstride = S;
        } else { const int tc = t - nband;
            kptr = CK + (size_t)(seq * 256 + tc * 64) * 128 + kvh * 64;
            vptr = CVT + (size_t)((seq * 2 + kvh) * 64) * 256 + tc * 64; vstride = 256; }
        const v4u kv = *(const v4u*)(kptr + (size_t)key_t * 128 + ch_t * 8);
        const v4u vv = *(const v4u*)(vptr + (size_t)key_t * vstride + ch_t * 8);
        __syncthreads();
        *(v4u*)(ldsK + key_t * 128 + ((ch_t ^ (key_t & 7)) * 16)) = kv;
        *(v4u*)(ldsV + key_t * 128 + ((ch_t ^ (key_t & 7)) * 16)) = vv;
        __syncthreads();
        f32x16 p0, p1;
#pragma unroll
        for (int r = 0; r < 16; ++r) { p0[r] = 0.f; p1[r] = 0.f; }
#pragma unroll
        for (int ks = 0; ks < 4; ++ks) {
            const int sw = ((2 * ks + hi) ^ (r32 & 7)) * 16;
            const bf16x8 a0 = *(const bf16x8*)(ldsK + r32 * 128 + sw);
            const bf16x8 a1 = *(const bf16x8*)(ldsK + (32 + r32) * 128 + sw);
            p0 = __builtin_amdgcn_mfma_f32_32x32x16_bf16(a0, qf[ks], p0, 0, 0, 0);
            p1 = __builtin_amdgcn_mfma_f32_32x32x16_bf16(a1, qf[ks], p1, 0, 0, 0);
        }
        if (band && lat) {
#pragma unroll
            for (int r = 0; r < 16; ++r) { const int kp = kbase + crow(r, hi); int d0 = qpos - kp; d0 = d0 < 0 ? -d0 : d0; int d1 = qpos - kp - 32; d1 = d1 < 0 ? -d1 : d1;
                if (d0 > 128) p0[r] = -INFINITY; if (d1 > 128) p1[r] = -INFINITY; }
        }
        float tm = p0[0];
#pragma unroll
        for (int r = 1; r < 16; ++r) tm = fmaxf(tm, p0[r]);
#pragma unroll
        for (int r = 0; r < 16; ++r) tm = fmaxf(tm, p1[r]);
        tm = fmaxf(tm, __shfl_xor(tm, 32));
        const float mn = fmaxf(mrun, tm), alpha = exp2f(mrun - mn); mrun = mn;
        float ls = 0.f;
#pragma unroll
        for (int r = 0; r < 16; ++r) { p0[r] = exp2f(p0[r] - mn); p1[r] = exp2f(p1[r] - mn); ls += p0[r] + p1[r]; o0[r] *= alpha; o1[r] *= alpha; }
        lrun = lrun * alpha + ls;
        bf16x8 pf[4];
#pragma unroll
        for (int s = 0; s < 2; ++s) {
            v4u w0, w1;
            w0.x = pk2(p0[8 * s + 0], p0[8 * s + 1]); w0.y = pk2(p0[8 * s + 2], p0[8 * s + 3]); w0.z = pk2(p0[8 * s + 4], p0[8 * s + 5]); w0.w = pk2(p0[8 * s + 6], p0[8 * s + 7]);
            w1.x = pk2(p1[8 * s + 0], p1[8 * s + 1]); w1.y = pk2(p1[8 * s + 2], p1[8 * s + 3]); w1.z = pk2(p1[8 * s + 4], p1[8 * s + 5]); w1.w = pk2(p1[8 * s + 6], p1[8 * s + 7]);
            pf[s] = __builtin_bit_cast(bf16x8, w0); pf[2 + s] = __builtin_bit_cast(bf16x8, w1);
        }
#pragma unroll
        for (int s4 = 0; s4 < 4; ++s4) {
#pragma unroll
            for (int dt = 0; dt < 2; ++dt) {
                const int d = 32 * dt + r32;
                const v2u lo = *(const v2u*)(ldsV + d * 128 + (((2 * s4) ^ (d & 7)) * 16) + 8 * hi);
                const v2u hi2 = *(const v2u*)(ldsV + d * 128 + (((2 * s4 + 1) ^ (d & 7)) * 16) + 8 * hi);
                v4u vf4; vf4.x = lo.x; vf4.y = lo.y; vf4.z = hi2.x; vf4.w = hi2.y;
                const bf16x8 vf = __builtin_bit_cast(bf16x8, vf4);
                if (dt == 0) o0 = __builtin_amdgcn_mfma_f32_32x32x16_bf16(vf, pf[s4], o0, 0, 0, 0);
                else o1 = __builtin_amdgcn_mfma_f32_32x32x16_bf16(vf, pf[s4], o1, 0, 0, 0);
            }
        }
    }
    const float ltot = lrun + __shfl_xor(lrun, 32), inv = 1.f / ltot;
    bf16* mix = (bf16*)(F.ws + WS_MIX) + (size_t)(tokbase + qpos) * DM + head * 64;
#pragma unroll
    for (int g4 = 0; g4 < 4; ++g4) {
        v2u w; w.x = pk2(o0[4 * g4] * inv, o0[4 * g4 + 1] * inv); w.y = pk2(o0[4 * g4 + 2] * inv, o0[4 * g4 + 3] * inv);
        *(v2u*)(mix + 8 * g4 + 4 * hi) = w;
        v2u w2; w2.x = pk2(o1[4 * g4] * inv, o1[4 * g4 + 1] * inv); w2.y = pk2(o1[4 * g4 + 2] * inv, o1[4 * g4 + 3] * inv);
        *(v2u*)(mix + 32 + 8 * g4 + 4 * hi) = w2;
    }
    __syncthreads();
}

constexpr int RL_XC32 = 0, RL_XCB = 32768, RL_LA = 49152, RL_LB = 81920, RL_SEGA = 114688, RL_SEGB = 116736, RL_CARRY = 118784;
__device__ __forceinline__ void rnn_unit(Frame& F, bool lat, int seq, int n) {
    const int lane = F.lane, wave = F.wave, r32 = lane & 31, hi = lane >> 5;
    const int S = lat ? SEQ_L : SEQ_C, tokbase = lat ? NCTX + seq * SEQ_L : seq * SEQ_C, nchunk = S / 128;
    float* XC32 = (float*)(F.lds + RL_XC32); unsigned char* XCB = F.lds + RL_XCB; float* LA = (float*)(F.lds + RL_LA); float* LB = (float*)(F.lds + RL_LB);
    float* SEGA = (float*)(F.lds + RL_SEGA); float* SEGB = (float*)(F.lds + RL_SEGB); float* CARRY = (float*)(F.lds + RL_CARRY);
    const bf16* XR = (const bf16*)(F.ws + WS_XR) + (size_t)tokbase * 512 + n * 64 + lane;
    const bf16* YG = (const bf16*)(F.ws + WS_YG) + (size_t)tokbase * 512 + n * 64 + lane;
    float* HF = (float*)(F.ws + WS_HF) + (size_t)tokbase * 512 + n * 64 + lane;
    bf16* MIX = (bf16*)(F.ws + WS_MIX) + (size_t)tokbase * DM + 512 + n * 64 + lane;
    const int chc = n * 64 + lane;
    const float cw0 = F.in[I_CONVW][chc], cw1 = F.in[I_CONVW][512 + chc], cw2 = F.in[I_CONVW][1024 + chc], cw3 = F.in[I_CONVW][1536 + chc], cb = F.in[I_CONVB][chc];
    const int tt = wave >> 1, chh = wave & 1, che = chh * 32 + r32;
    const int seg = wave;
#pragma unroll 1
    for (int dir = 0; dir < 2; ++dir) {
        bf16x8 wf[2][4];
        { const bf16* wg = (const bf16*)(F.ws + WS_RGW) + (size_t)((dir * 8 + n) * 2) * 4096 + (size_t)che * 64 + 8 * hi;
#pragma unroll
          for (int gt = 0; gt < 2; ++gt)
#pragma unroll
            for (int ks = 0; ks < 4; ++ks) wf[gt][ks] = *(const bf16x8*)(wg + gt * 4096 + 16 * ks); }
        const int pe = dir * 512 + n * 64 + che;
        const float ba = F.in[I_RGBA][pe], bi = F.in[I_RGBI][pe];
        float sp8; { const float nl = -F.in[I_RGLAM][pe]; sp8 = 8.f * (nl > 20.f ? nl : log1pf(__expf(nl))); }
        __syncthreads();
        if (wave == 0) CARRY[lane] = lat ? F.in[I_SRNN][(size_t)(seq * 2 + dir) * 512 + chc] : 0.f;
#pragma unroll 1
        for (int ci = 0; ci < nchunk; ++ci) {
            const int c0 = (dir == 0 ? ci : nchunk - 1 - ci) * 128;
            __syncthreads();
            {
                float xv[19];
#pragma unroll
                for (int i = 0; i < 19; ++i) { const int pos = c0 + seg * 16 - 2 + i; xv[i] = (pos >= 0 && pos < S) ? bf2f(XR[(size_t)pos * 512]) : 0.f; }
#pragma unroll
                for (int i = 0; i < 16; ++i) { const float y = cb + cw0 * xv[i] + cw1 * xv[i + 1] + cw2 * xv[i + 2] + cw3 * xv[i + 3];
                    const int tk = seg * 16 + i; XC32[tk * 64 + lane] = y;
                    *(bf16*)(XCB + tk * 128 + (((lane >> 3) ^ (tk & 7)) * 16) + (lane & 7) * 2) = (bf16)f2bf(y); }
            }
            __syncthreads();
            {
                f32x16 ga, gi;
#pragma unroll
                for (int r = 0; r < 16; ++r) { ga[r] = 0.f; gi[r] = 0.f; }
                const int tk = tt * 32 + r32;
#pragma unroll
                for (int ks = 0; ks < 4; ++ks) {
                    const bf16x8 af = *(const bf16x8*)(XCB + tk * 128 + (((2 * ks + hi) ^ (tk & 7)) * 16));
                    ga = __builtin_amdgcn_mfma_f32_32x32x16_bf16(af, wf[0][ks], ga, 0, 0, 0);
                    gi = __builtin_amdgcn_mfma_f32_32x32x16_bf16(af, wf[1][ks], gi, 0, 0, 0);
                }
#pragma unroll
                for (int r = 0; r < 16; ++r) { const int tk2 = tt * 32 + crow(r, hi); const float x = XC32[tk2 * 64 + che];
                    const float rg = sigmoidf_(ga[r] + ba), ig = sigmoidf_(gi[r] + bi), la = -rg * sp8, a = __expf(la);
                    const float b = sqrtf(fmaxf(-expm1f(2.f * la), 0.f)) * ig * x;
                    LA[tk2 * 64 + che] = a; LB[tk2 * 64 + che] = b; }
            }
            __syncthreads();
            {
                float A = 1.f, B = 0.f;
#pragma unroll
                for (int i = 0; i < 16; ++i) { const int tk = seg * 16 + (dir == 0 ? i : 15 - i); const float a = LA[tk * 64 + lane], b = LB[tk * 64 + lane]; B = a * B + b; A = a * A; }
                SEGA[seg * 64 + lane] = A; SEGB[seg * 64 + lane] = B;
            }
            __syncthreads();
            {
                float h = CARRY[lane];
                if (dir == 0) { for (int s2 = 0; s2 < seg; ++s2) h = SEGA[s2 * 64 + lane] * h + SEGB[s2 * 64 + lane]; }
                else { for (int s2 = 7; s2 > seg; --s2) h = SEGA[s2 * 64 + lane] * h + SEGB[s2 * 64 + lane]; }
#pragma unroll
                for (int i = 0; i < 16; ++i) { const int tk = seg * 16 + (dir == 0 ? i : 15 - i); const float a = LA[tk * 64 + lane], b = LB[tk * 64 + lane]; h = a * h + b;
                    const int pos = c0 + tk;
                    if (dir == 0) { HF[(size_t)pos * 512] = h;
                        if (!lat && pos == S - 1) F.out[O_NEWRNN + (size_t)(seq * 2 + 0) * 512 + chc] = h; }
                    else { const float hf = HF[(size_t)pos * 512]; const float y = bf2f(YG[(size_t)pos * 512]);
                        MIX[(size_t)pos * DM] = (bf16)f2bf((hf + h) * gelu_tanh(y));
                        if (!lat && pos == 0) F.out[O_NEWRNN + (size_t)(seq * 2 + 1) * 512 + chc] = h; } }
                __syncthreads();
                if ((dir == 0 && seg == 7) || (dir == 1 && seg == 0)) CARRY[lane] = h;
            }
        }
    }
    __syncthreads();
}

__device__ __forceinline__ void p3_phase(Frame& F) {
    for (int it = F.vcu; it < 832; it += F.G) {
        bool lat; int a;
        if (it < 64 || (it >= 320 && it < 576)) { lat = it < 64; a = lat ? it : it - 320; rnn_unit(F, lat, a >> 3, a & 7); }
        else { lat = it < 320; a = lat ? it - 64 : it - 576;
            if (lat) attn_unit(F, true, a >> 5, (a >> 4) & 1, a & 15); else attn_unit(F, false, a >> 3, (a >> 2) & 1, a & 3); }
    }
}

__device__ __forceinline__ unsigned key16(unsigned b, unsigned idx) { const unsigned s = (b & 0x8000u) ? (~b & 0xffffu) : (b | 0x8000u); return (s << 16) | idx; }
__device__ __forceinline__ float keyval16(unsigned k) { const unsigned s = k >> 16; const unsigned b = (s & 0x8000u) ? (s & 0x7fffu) : (~s & 0xffffu); return bf2f(b); }
__device__ __forceinline__ unsigned sortable32(float f) { const unsigned u = __builtin_bit_cast(unsigned, f); return (u & 0x80000000u) ? ~u : (u | 0x80000000u); }
template <int CTRL> __device__ __forceinline__ unsigned dppu(unsigned v) { return (unsigned)__builtin_amdgcn_update_dpp(0, (int)v, CTRL, 0xf, 0xf, true); }
template <int CTRL> __device__ __forceinline__ float dppf(float v) { return __builtin_bit_cast(float, __builtin_amdgcn_update_dpp(0, __builtin_bit_cast(int, v), CTRL, 0xf, 0xf, true)); }
__device__ __forceinline__ unsigned umax_(unsigned a, unsigned b) { return a > b ? a : b; }
__device__ __forceinline__ unsigned umin_(unsigned a, unsigned b) { return a < b ? a : b; }
__device__ __forceinline__ unsigned rowmax16u(unsigned x) { x = umax_(x, dppu<0xB1>(x)); x = umax_(x, dppu<0x4E>(x)); x = umax_(x, dppu<0x141>(x)); x = umax_(x, dppu<0x140>(x)); return x; }
__device__ __forceinline__ float rowmax16f(float x) { x = fmaxf(x, dppf<0xB1>(x)); x = fmaxf(x, dppf<0x4E>(x)); x = fmaxf(x, dppf<0x141>(x)); x = fmaxf(x, dppf<0x140>(x)); return x; }
__device__ __forceinline__ float rowsum16f(float x) { x += dppf<0xB1>(x); x += dppf<0x4E>(x); x += dppf<0x141>(x); x += dppf<0x140>(x); return x; }
__device__ __forceinline__ int rowsum16i(int x) { x += (int)dppu<0xB1>((unsigned)x); x += (int)dppu<0x4E>((unsigned)x); x += (int)dppu<0x141>((unsigned)x); x += (int)dppu<0x140>((unsigned)x); return x; }
#define CEX(a, b) do { const unsigned _h = umax_(a, b), _l = umin_(a, b); a = _h; b = _l; } while (0)

constexpr int P7_WL = 16384;
constexpr int P7_TL = 0, P7_TE = 1024, P7_TG = 3072, P7_LE = 5120, P7_LG = 6336, P7_LSU = 8768, P7_LS = 11200, P7_H2Q = 11808, P7_HST = 15904;
static_assert(P7_LS + 608 <= P7_H2Q && (P7_H2Q % 16) == 0 && P7_HST + 16 <= P7_WL && P7_WL * 8 <= RING_BYTES, "P7 LDS map");

__device__ __forceinline__ void topk_token(const v4u (&rawv)[4], unsigned* TL, int lane, const int (&ctab)[4], int* oute, float* outg) {
    const int k = lane & 15, row = lane >> 4;
    v4u rq0 = rawv[0], rq1 = rawv[1], rq2 = rawv[2], rq3 = rawv[3];
#pragma unroll 1
    for (int pass = 0; pass < 4; ++pass) {
        const int gidx = pass * 4 + row;
        const v4u raw = rq0; rq0 = rq1; rq1 = rq2; rq2 = rq3;
        unsigned r0 = key16(raw.x & 0xffffu, k * 8 + 0), r1 = key16(raw.x >> 16, k * 8 + 1), r2 = key16(raw.y & 0xffffu, k * 8 + 2), r3 = key16(raw.y >> 16, k * 8 + 3);
        unsigned r4 = key16(raw.z & 0xffffu, k * 8 + 4), r5 = key16(raw.z >> 16, k * 8 + 5), r6 = key16(raw.w & 0xffffu, k * 8 + 6), r7 = key16(raw.w >> 16, k * 8 + 7);
        CEX(r0, r1); CEX(r2, r3); CEX(r4, r5); CEX(r6, r7);
        CEX(r0, r2); CEX(r1, r3); CEX(r4, r6); CEX(r5, r7);
        CEX(r1, r2); CEX(r5, r6);
        CEX(r0, r4); CEX(r1, r5); CEX(r2, r6); CEX(r3, r7);
        CEX(r2, r4); CEX(r3, r5);
        CEX(r1, r2); CEX(r3, r4); CEX(r5, r6);
        unsigned keep = 0;
#pragma unroll
        for (int it = 0; it < 16; ++it) {
            const unsigned m = rowmax16u(r0); const bool win = r0 == m;
            r0 = win ? r1 : r0; r1 = win ? r2 : r1; r2 = win ? r3 : r2; r3 = win ? r4 : r3; r4 = win ? r5 : r4; r5 = win ? r6 : r5; r6 = win ? r7 : r6; r7 = win ? 0u : r7;
            keep = (k == it) ? m : keep;
        }
        TL[gidx * 16 + k] = keep;
    }
#pragma unroll 1
    for (int q = 0; q < 2; ++q) {
        const int hh = 4 * q + row;
        const unsigned* LA = TL + (2 * hh) * 16; const unsigned* LB = TL + (2 * hh + 1) * 16;
        unsigned c[4];
#pragma unroll
        for (int s = 0; s < 4; ++s) { const int ij = ctab[s]; const bool valid = ij >= 0; const int i = (ij >> 4) & 15, j = ij & 15;
            const float sum = keyval16(LA[i]) + keyval16(LB[j]);
            c[s] = valid ? ((sortable32(sum) & 0xffffff00u) | (unsigned)(i * 16 + j)) : 0u; }
        CEX(c[0], c[1]); CEX(c[2], c[3]); CEX(c[0], c[2]); CEX(c[1], c[3]); CEX(c[1], c[2]);
        unsigned keep = 0;
#pragma unroll
        for (int it = 0; it < 16; ++it) {
            const unsigned m = rowmax16u(c[0]); const bool win = c[0] == m;
            c[0] = win ? c[1] : c[0]; c[1] = win ? c[2] : c[1]; c[2] = win ? c[3] : c[2]; c[3] = win ? 0u : c[3];
            keep = (k == it) ? m : keep;
        }
        const int i = (keep >> 4) & 15, j = keep & 15; const unsigned ka = LA[i], kb = LB[j];
        const float bv = keyval16(ka) + keyval16(kb);
        const float mx = rowmax16f(bv); const float ex = __expf(bv - mx); const float sm = rowsum16f(ex);
        oute[q * 64 + lane] = (int)((ka & 127u) * 128u + (kb & 127u)); outg[q * 64 + lane] = ex / sm;
    }
}

__device__ __forceinline__ int mbcnt64(unsigned long long m) { return (int)__builtin_amdgcn_mbcnt_hi((unsigned)(m >> 32), __builtin_amdgcn_mbcnt_lo((unsigned)m, 0u)); }
__device__ __forceinline__ int rfl(int v) { return __builtin_amdgcn_readfirstlane(v); }
__device__ __forceinline__ float rflf(float v) { return __builtin_bit_cast(float, __builtin_amdgcn_readfirstlane(__builtin_bit_cast(int, v))); }

__device__ __forceinline__ void p7_phase(Frame& F, bool dry) {
    const int lane0 = F.lane, wave = F.wave;
    unsigned char* wl = F.lds + wave * P7_WL;
    unsigned* TL = (unsigned*)(wl + P7_TL); int* TE = (int*)(wl + P7_TE); float* TG = (float*)(wl + P7_TG);
    unsigned short* LE = (unsigned short*)(wl + P7_LE); float* LG = (float*)(wl + P7_LG); float* LSU = (float*)(wl + P7_LSU); unsigned char* LS = wl + P7_LS; unsigned char* H2Q = wl + P7_H2Q; float* HST = (float*)(wl + P7_HST);
    const bf16* SC = (const bf16*)(F.ws + WS_SC); const bf16* H2 = (const bf16*)(F.ws + WS_H);
    const unsigned char* U8 = F.ws + WS_U; const unsigned char* V8 = F.ws + WS_V;
    const float* SU = (const float*)(F.ws + WS_SU); const float* SV = (const float*)(F.ws + WS_SV);
    const float* mods = (const float*)(F.ws + WS_MODS);
    int ctab[4];
#pragma unroll
    for (int s = 0; s < 4; ++s) { const int c = 16 * s + (lane0 & 15); int i, j;
        if (c < 16) { i = 0; j = c; } else if (c < 24) { i = 1; j = c - 16; } else if (c < 29) { i = 2; j = c - 24; } else if (c < 33) { i = 3; j = c - 29; } else if (c < 36) { i = 4; j = c - 33; }
        else if (c < 38) { i = 5; j = c - 36; } else if (c < 40) { i = 6; j = c - 38; } else if (c < 42) { i = 7; j = c - 40; } else if (c < 50) { i = c - 34; j = 0; } else { i = -1; j = 0; }
        ctab[s] = i < 0 ? -1 : i * 16 + j; }
    const int ntg = NTOK / (F.G * NWAVES * 4);
#pragma unroll 1
    for (int tg = 0; tg < ntg; ++tg) {
        const int tok0 = (F.vcu * ntg + tg) * (NWAVES * 4) + wave * 4;
        int lane = F.lane; asm volatile("" : "+v"(lane));
        {
            v4u craw[4], nraw[4]; v4u ch0, ch1, nh0, nh1;
#define P7_TLOAD(R, H0, H1, tk) do { const bf16* sp_ = SC + (size_t)(tk) * 2048 + (lane >> 4) * 128 + (lane & 15) * 8; \
                _Pragma("unroll") for (int ps = 0; ps < 4; ++ps) R[ps] = *(const v4u*)(sp_ + ps * 512); \
                H0 = *(const v4u*)(H2 + (size_t)(tk) * DM + 16 * lane); H1 = *(const v4u*)(H2 + (size_t)(tk) * DM + 16 * lane + 8); } while (0)
            P7_TLOAD(craw, ch0, ch1, tok0);
#pragma unroll 1
            for (int s = 0; s < 4; ++s) {
                if (s < 3) P7_TLOAD(nraw, nh0, nh1, tok0 + s + 1);
                topk_token(craw, TL, lane, ctab, TE + s * 128, TG + s * 128);
                const v4u a = ch0, b = ch1;
                float hv[16];
                hv[0] = bflo(a.x); hv[1] = bfhi(a.x); hv[2] = bflo(a.y); hv[3] = bfhi(a.y); hv[4] = bflo(a.z); hv[5] = bfhi(a.z); hv[6] = bflo(a.w); hv[7] = bfhi(a.w);
                hv[8] = bflo(b.x); hv[9] = bfhi(b.x); hv[10] = bflo(b.y); hv[11] = bfhi(b.y); hv[12] = bflo(b.z); hv[13] = bfhi(b.z); hv[14] = bflo(b.w); hv[15] = bfhi(b.w);
                float am = 0.f;
#pragma unroll
                for (int i = 0; i < 16; ++i) am = fmaxf(am, fabsf(hv[i]));
#pragma unroll
                for (int o = 1; o < 64; o <<= 1) am = fmaxf(am, __shfl_xor(am, o));
                const float inv = am > 0.f ? 127.f / am : 0.f;
                if (lane == 0) HST[s] = am * (1.f / 127.f);
                v4u qv;
#pragma unroll
                for (int j = 0; j < 4; ++j) { unsigned w = 0;
#pragma unroll
                    for (int i = 0; i < 4; ++i) { int q = (int)rintf(hv[4 * j + i] * inv); w |= ((unsigned)q & 0xffu) << (8 * i); }
                    qv[j] = w; }
                *(v4u*)(H2Q + s * 1024 + 16 * lane) = qv;
#pragma unroll
                for (int ps = 0; ps < 4; ++ps) craw[ps] = nraw[ps];
                ch0 = nh0; ch1 = nh1;
            }
#undef P7_TLOAD
        }
        int nb;
        {
            int tot[8];
#pragma unroll
            for (int c = 0; c < 8; ++c) tot[c] = 0;
#pragma unroll 1
            for (int s = 0; s < 4; ++s) { const int c0 = TE[s * 128 + lane] >> 11, c1 = TE[s * 128 + 64 + lane] >> 11;
#pragma unroll
                for (int c = 0; c < 8; ++c) { const int n = __popcll(__ballot(c0 == c)) + __popcll(__ballot(c1 == c)); tot[c] += (n + 3) & ~3; } }
            int off[8]; { int base = 0;
#pragma unroll
                for (int c = 0; c < 8; ++c) { off[c] = base; base += tot[c]; }
                { const int pe = (base + 15) & ~15; if (lane < pe - base) { const int p = base + lane; LE[p] = (unsigned short)0; LG[p] = 0.f; LSU[p] = 0.f; LS[p] = (unsigned char)0; } base = pe; }
            nb = base >> 2; }
#pragma unroll 1
            for (int s = 0; s < 4; ++s) { const int e0 = TE[s * 128 + lane], e1 = TE[s * 128 + 64 + lane]; const float g0 = TG[s * 128 + lane], g1 = TG[s * 128 + 64 + lane]; const int c0 = e0 >> 11, c1 = e1 >> 11;
                const float su0 = SU[e0], su1 = SU[e1], sv0 = SV[e0], sv1 = SV[e1];
#pragma unroll
                for (int c = 0; c < 8; ++c) {
                    const unsigned long long m0 = __ballot(c0 == c), m1 = __ballot(c1 == c);
                    const int n0 = __popcll(m0), n = n0 + __popcll(m1), np = (n + 3) & ~3, base = off[c];
                    if (c0 == c) { const int p = base + mbcnt64(m0); LE[p] = (unsigned short)e0; LG[p] = g0 * sv0; LSU[p] = su0; LS[p] = (unsigned char)s; }
                    if (c1 == c) { const int p = base + n0 + mbcnt64(m1); LE[p] = (unsigned short)e1; LG[p] = g1 * sv1; LSU[p] = su1; LS[p] = (unsigned char)s; }
                    if (lane < np - n) { const int p = base + n + lane; LE[p] = (unsigned short)(c * 2048); LG[p] = 0.f; LSU[p] = 0.f; LS[p] = (unsigned char)s; }
                    off[c] = base + np;
                } }
        }
#ifndef MK_DRY_SKIP
#define MK_DRY_SKIP 0
#endif
        if (!(dry && (MK_DRY_SKIP & 1))) {
            int lane_u = F.lane; asm volatile("" : "+v"(lane_u));
            const bool hi32 = lane_u >= 32, b16 = (lane_u & 16) != 0;
            const int xr = ((lane_u >> 5) & 1) | ((lane_u >> 3) & 2);
            v4u ra[4], rb[4], rc[4], rd[4];
#define P7_ULOAD(R, b) do { _Pragma("unroll") for (int x = 0; x < 4; ++x) { const int e = rfl((int)LE[4 * (b) + x]); R[x] = *(const v4u*)(U8 + (size_t)e * DM + 16 * lane_u); } } while (0)
#define P7_UCOMP(R, b) do { const int sl = rfl(LS[4 * (b)]); const v4u hq = *(const v4u*)(H2Q + sl * 1024 + 16 * lane_u); int p[4]; \
            _Pragma("unroll") for (int x = 0; x < 4; ++x) { int d = __builtin_amdgcn_sdot4((int)hq.x, (int)R[x].x, 0, false); d = __builtin_amdgcn_sdot4((int)hq.y, (int)R[x].y, d, false); \
                d = __builtin_amdgcn_sdot4((int)hq.z, (int)R[x].z, d, false); d = __builtin_amdgcn_sdot4((int)hq.w, (int)R[x].w, d, false); p[x] = d; } \
            const int t01 = (hi32 ? p[1] : p[0]) + __shfl_xor(hi32 ? p[0] : p[1], 32); const int t23 = (hi32 ? p[3] : p[2]) + __shfl_xor(hi32 ? p[2] : p[3], 32); \
            int t = (b16 ? t23 : t01) + __shfl_xor(b16 ? t01 : t23, 16); t = rowsum16i(t); \
            const int idx = 4 * (b) + xr; const float g = LG[idx]; \
            const float hs = HST[sl]; \
            const float dotf = (float)t * (hs * LSU[idx]); const float cf = g * gelu_tanh(dotf); \
            if ((lane_u & 15) == 0) LG[idx] = cf; } while (0)
            P7_ULOAD(ra, 0); P7_ULOAD(rb, 1); P7_ULOAD(rc, 2);
#pragma unroll 1
            for (int b = 0; b < nb; b += 4) {
                P7_ULOAD(rd, b + 3);
                P7_UCOMP(ra, b);
                P7_ULOAD(ra, (b + 4 < nb ? b + 4 : nb - 1));
                P7_UCOMP(rb, b + 1);
                P7_ULOAD(rb, (b + 5 < nb ? b + 5 : nb - 1));
                P7_UCOMP(rc, b + 2);
                P7_ULOAD(rc, (b + 6 < nb ? b + 6 : nb - 1));
                P7_UCOMP(rd, b + 3);
            }
#undef P7_ULOAD
#undef P7_UCOMP
        }
        float acc[4][16]; float sumc[4];
#pragma unroll
        for (int s = 0; s < 4; ++s) {
#pragma unroll
            for (int i = 0; i < 16; ++i) acc[s][i] = 0.f; }
        if (!(dry && (MK_DRY_SKIP & 2))) {
            int lane_v = F.lane; asm volatile("" : "+v"(lane_v));
            v4u ra[4], rb[4], rc[4], rd[4];
#define P7_VLOAD(R, b) do { _Pragma("unroll") for (int x = 0; x < 4; ++x) { const int e = rfl((int)LE[4 * (b) + x]); R[x] = *(const v4u*)(V8 + (size_t)e * DM + 16 * lane_v); } } while (0)
#define P7_VACC(S, R, b) do { _Pragma("unroll") for (int x = 0; x < 4; ++x) { const float cf = rflf(LG[4 * (b) + x]); \
                unsigned w0 = R[x][0], w1 = R[x][1], w2 = R[x][2], w3 = R[x][3]; asm volatile("" : "+v"(w0), "+v"(w1), "+v"(w2), "+v"(w3)); \
                acc[S][0] += cf * (float)(w0 & 0xffu); acc[S][1] += cf * (float)((w0 >> 8) & 0xffu); acc[S][2] += cf * (float)((w0 >> 16) & 0xffu); acc[S][3] += cf * (float)(w0 >> 24); \
                acc[S][4] += cf * (float)(w1 & 0xffu); acc[S][5] += cf * (float)((w1 >> 8) & 0xffu); acc[S][6] += cf * (float)((w1 >> 16) & 0xffu); acc[S][7] += cf * (float)(w1 >> 24); \
                acc[S][8] += cf * (float)(w2 & 0xffu); acc[S][9] += cf * (float)((w2 >> 8) & 0xffu); acc[S][10] += cf * (float)((w2 >> 16) & 0xffu); acc[S][11] += cf * (float)(w2 >> 24); \
                acc[S][12] += cf * (float)(w3 & 0xffu); acc[S][13] += cf * (float)((w3 >> 8) & 0xffu); acc[S][14] += cf * (float)((w3 >> 16) & 0xffu); acc[S][15] += cf * (float)(w3 >> 24); } } while (0)
#define P7_VCOMP(R, b) do { const int sl = rfl(LS[4 * (b)]); if (sl == 0) P7_VACC(0, R, b); else if (sl == 1) P7_VACC(1, R, b); else if (sl == 2) P7_VACC(2, R, b); else P7_VACC(3, R, b); } while (0)
            P7_VLOAD(ra, 0); P7_VLOAD(rb, 1); P7_VLOAD(rc, 2);
#pragma unroll 1
            for (int b = 0; b < nb; b += 4) {
                P7_VLOAD(rd, b + 3);
                P7_VCOMP(ra, b);
                P7_VLOAD(ra, (b + 4 < nb ? b + 4 : nb - 1));
                P7_VCOMP(rb, b + 1);
                P7_VLOAD(rb, (b + 5 < nb ? b + 5 : nb - 1));
                P7_VCOMP(rc, b + 2);
                P7_VLOAD(rc, (b + 6 < nb ? b + 6 : nb - 1));
                P7_VCOMP(rd, b + 3);
            }
#undef P7_VLOAD
#undef P7_VACC
#undef P7_VCOMP
        }
        { float s0 = 0.f, s1 = 0.f, s2 = 0.f, s3 = 0.f;
          for (int idx = lane; idx < 4 * nb; idx += 64) { const float c = LG[idx]; const int sl = LS[idx]; s0 += sl == 0 ? c : 0.f; s1 += sl == 1 ? c : 0.f; s2 += sl == 2 ? c : 0.f; s3 += sl == 3 ? c : 0.f; }
          sumc[0] = wave_sum(s0); sumc[1] = wave_sum(s1); sumc[2] = wave_sum(s2); sumc[3] = wave_sum(s3); }
#pragma unroll
        for (int s = 0; s < 4; ++s) {
            const int tok = tok0 + s;
            int lane_f = F.lane; asm volatile("" : "+v"(lane_f));
            float* xrow = F.out + O_Y + (size_t)tok * DM + 16 * lane_f;
            float* yrow = dry ? (float*)(F.ws + WS_MIX) + (size_t)(tok & 8191) * DM + 16 * lane_f : xrow;
            const float* ga2 = mods + (size_t)mod_index(tok) * MODW + 5 * DM + 16 * lane_f;
            const float* gf = F.in[I_GFINAL] + 16 * lane_f;
            float x2[16]; float ss = 0.f; const float off = 128.f * sumc[s];
#pragma unroll
            for (int j = 0; j < 4; ++j) { const f32x4 xv = *(const f32x4*)(xrow + 4 * j), gv = *(const f32x4*)(ga2 + 4 * j);
#pragma unroll
                for (int i = 0; i < 4; ++i) { const float t = xv[i] + gv[i] * (acc[s][4 * j + i] - off); x2[4 * j + i] = t; ss += t * t; } }
            const float rstd = 1.f / sqrtf(wave_sum(ss) * (1.f / DM) + EPS);
#pragma unroll
            for (int j = 0; j < 4; ++j) { const f32x4 gv = *(const f32x4*)(gf + 4 * j); f32x4 o;
#pragma unroll
                for (int i = 0; i < 4; ++i) o[i] = x2[4 * j + i] * rstd * gv[i];
                *(f32x4*)(yrow + 4 * j) = o; }
        }
    }
}

__global__ void __launch_bounds__(NWAVES * 64, 2) mk_fwd(Args args) {
    extern __shared__ __attribute__((aligned(16))) unsigned char lds[];
    Frame F;
    F.lds = lds;
    F.tid = threadIdx.x; F.lane = F.tid & 63; F.wave = __builtin_amdgcn_readfirstlane(F.tid >> 6);
    F.G = gridDim.x; { const int bx = blockIdx.x; F.vcu = (F.G % 8 == 0) ? (bx % 8) * (F.G / 8) + bx / 8 : bx; }
    F.in = args.in; F.out = args.out; F.ws = args.ws;
    LAS unsigned char* lds3 = (LAS unsigned char*)lds;
    volatile LAS unsigned* MISC = (volatile LAS unsigned*)(lds3 + MISC_OFF);
    for (int u = F.tid; u < (LDS_BYTES - LDSCTL_OFF) / 4; u += NWAVES * 64) ((LAS unsigned*)(lds3 + LDSCTL_OFF))[u] = 0u;
    __syncthreads();
    unsigned* ctl = (unsigned*)(args.ws + WS_CTL);
    XcdBarrier bar; bar.bar = ctl + CW_BAR; bar.x = 0; bar.st = nullptr;
    const bool one_launch = (args.ph_hi - args.ph_lo) > 1;
    if (one_launch) bar = xcd_barrier_post(ctl + CW_BAR, MISC + 8);
    const int lo = args.ph_lo, hi = args.ph_hi;
#ifndef MK_PHASE_MASK
#define MK_PHASE_MASK 0xff
#endif
#define IN(k) (((MK_PHASE_MASK >> (k)) & 1) && lo <= (k) && (k) < hi)
#define SEAM(k) do { if (IN(k) && IN((k) + 1)) xcd_barrier(bar); } while (0)

    if (IN(0)) { if (MK_DUP == 0) { p0_phase(F); xcd_barrier(bar); } p0_phase(F); SEAM(0); }
    if (IN(1)) { norm_phase(F, 0); SEAM(1); }
    if (IN(2)) {
        pg8::Gemm g{(const pg8::bf16_t*)(F.ws + WS_H), (const pg8::bf16_t*)(F.ws + WS_WIN), NTOK, D_IN, DM}; pg8::StaticOrder S; S.init(NTOK, D_IN, F.G, (int)blockIdx.x);
        EpiInProj E{(bf16*)(F.ws + WS_Q), (bf16*)(F.ws + WS_K), (bf16*)(F.ws + WS_VT), (bf16*)(F.ws + WS_XR), (bf16*)(F.ws + WS_YG), F.out + O_NEWK, F.out + O_NEWV, (const f32x4*)(F.ws + WS_ROPE)};
        pg8::gemm_phase<EpiInProj, pg8::StaticOrder, true, true>(lds3, g, S, E);
        SEAM(2);
    }
    if (IN(3)) { if (MK_DUP == 3) { p3_phase(F); xcd_barrier(bar); } p3_phase(F); SEAM(3); }
    if (IN(4)) {
        pg8::Gemm g{(const pg8::bf16_t*)(F.ws + WS_MIX), (const pg8::bf16_t*)(F.ws + WS_WOUT), NTOK, DM, DM}; pg8::StaticOrder S; S.init(NTOK, DM, F.G, (int)blockIdx.x);
        EpiOutProj E{F.in[I_XP], F.in[I_XS], (const float*)(F.ws + WS_MODS), F.out + O_Y};
        pg8::gemm_phase<EpiOutProj, pg8::StaticOrder, true, true>(lds3, g, S, E);
        SEAM(4);
    }
    if (IN(5)) { norm_phase(F, 1); SEAM(5); }
    if (IN(6)) {
        pg8::Gemm g{(const pg8::bf16_t*)(F.ws + WS_H), (const pg8::bf16_t*)(F.ws + WS_WC), NTOK, 2048, DM}; pg8::StaticOrder S; S.init(NTOK, 2048, F.G, (int)blockIdx.x);
        EpiScores E{(bf16*)(F.ws + WS_SC)};
        pg8::gemm_phase<EpiScores, pg8::StaticOrder, true, true>(lds3, g, S, E);
        SEAM(6);
    }
    if (IN(7)) { if (MK_DUP == 7) { p7_phase(F, true); xcd_barrier(bar); } p7_phase(F, false); }
#undef IN
#undef SEAM
}

extern "C" void kernel_launch(void* const* d_in, const int* in_sizes, int n_in, void* d_out, int out_size, void* d_ws, size_t ws_size, hipStream_t stream) {
    static int grid = 0;
    if (grid == 0) {
        if (n_in != 26 || ws_size < WS_END) { fprintf(stderr, "kernel_launch: unexpected n_in %d / ws %zu\n", n_in, ws_size); grid = -1; return; }
        int dev = 0, cus = 0, per_cu = 0;
        if (hipGetDevice(&dev) != hipSuccess || hipDeviceGetAttribute(&cus, hipDeviceAttributeMultiprocessorCount, dev) != hipSuccess) { grid = -1; return; }
        if (hipFuncSetAttribute((const void*)mk_fwd, hipFuncAttributeMaxDynamicSharedMemorySize, LDS_BYTES) != hipSuccess) { fprintf(stderr, "kernel_launch: hipFuncSetAttribute failed\n"); grid = -1; return; }
        if (hipOccupancyMaxActiveBlocksPerMultiprocessor(&per_cu, (const void*)mk_fwd, NWAVES * 64, LDS_BYTES) != hipSuccess || per_cu < 1)
            fprintf(stderr, "kernel_launch: occupancy query reports %d blocks per CU\n", per_cu);
        (void)hipGetLastError();
        grid = cus;
        if (grid != 256) fprintf(stderr, "kernel_launch: note: %d CUs\n", grid);
    }
    if (grid < 0) return;
    (void)hipMemsetAsync((char*)d_ws + WS_CTL, 0, CTL_ZERO_BYTES, stream);
    Args a{};
    for (int i = 0; i < 26; ++i) a.in[i] = (const float*)d_in[i];
    a.out = (float*)d_out; a.ws = (unsigned char*)d_ws;
    if (MK_N_LAUNCHES == 1) {
        a.ph_lo = 0; a.ph_hi = N_PHASES; a.li = 0;
        hipLaunchKernelGGL(mk_fwd, dim3(grid), dim3(NWAVES * 64), LDS_BYTES, stream, a);
    } else {
        for (int li = 0; li < N_PHASES; ++li) { a.ph_lo = li; a.ph_hi = li + 1; a.li = li;
            hipLaunchKernelGGL(mk_fwd, dim3(grid), dim3(NWAVES * 64), LDS_BYTES, stream, a); }
    }
}
```

```cpp
#include <hip/hip_runtime.h>
#include <cstdio>
#include <cstdint>

#ifndef MK_DUP
#define MK_DUP -1
#endif
#ifndef MK_N_LAUNCHES
#define MK_N_LAUNCHES 1
#endif

namespace pg8 {
#define PG8_LAS __attribute__((address_space(3)))
typedef unsigned short bf16_t;
typedef short bf16x8 __attribute__((ext_vector_type(8)));
typedef float f32x4 __attribute__((ext_vector_type(4)));
typedef unsigned u32x4 __attribute__((ext_vector_type(4)));
typedef unsigned u32x2 __attribute__((ext_vector_type(2)));
constexpr int BM = 256, BK = 64, HALF = 128, HTB = HALF * BK * 2, STAGE_BYTES = 8 * HTB, NXCD = 8, WGM = 8;

__host__ __device__ __forceinline__ int lds_byte(int r, int c) { const int st = (r >> 4) * 2 + (c >> 5), rr = r & 15, cc = c & 31, ob = rr * 64 + cc * 2; return st * 1024 + (ob ^ (((ob >> 9) & 1) << 5)); }
__host__ __device__ __forceinline__ void stage_rc(int b, int& R, int& C) { const int st = b / 1024, sb = b % 1024, swz = sb ^ (((sb >> 9) & 1) << 5); R = (st >> 1) * 16 + swz / 64; C = (st & 1) * 32 + (swz % 64) / 2; }
__host__ __device__ __forceinline__ int perm32(int rho) { const int n = rho >> 4, i = rho & 15; return 8 * (i >> 2) + 4 * n + (i & 3); }

struct Unit { int pm, pn; };
struct Gemm { const bf16_t* A; const bf16_t* Bt; int M, N, K; };

struct StaticOrder {
    int nM, nN, nwg, G, c;
    __host__ __device__ void init(int M, int N, int G_, int c_) { nM = M / BM; nN = N / BM; nwg = nM * nN; G = G_; c = c_; }
    __host__ __device__ bool next(int i, Unit& u) const {
        const long L = (long)i * G + c; if (L >= nwg) return false;
        int wgid = (int)L; { const int q = nwg / NXCD, r = nwg % NXCD, xcd = wgid % NXCD, off = wgid / NXCD; wgid = (xcd < r ? xcd * (q + 1) : r * (q + 1) + (xcd - r) * q) + off; }
        const int nig = WGM * nN, gid = wgid / nig, fm = gid * WGM, gsz = (nM - fm) < WGM ? (nM - fm) : WGM;
        u.pm = fm + ((wgid % nig) % gsz); u.pn = (wgid % nig) / gsz; return true;
    }
    __device__ __forceinline__ void a_ready(const Unit&) const {}
    __device__ __forceinline__ void done(const Unit&) const {}
};

__device__ __forceinline__ unsigned cvt_pk_bf16(float lo, float hi) { unsigned r; asm volatile("v_cvt_pk_bf16_f32 %0, %1, %2" : "=v"(r) : "v"(lo), "v"(hi)); return r; }

template <class Epi, class Sched, bool ALIGN_EPI = false, bool SP2 = false>
__device__ __forceinline__ void gemm_phase(PG8_LAS unsigned char* lds, const Gemm g, const Sched& S, const Epi& E) {
    const int tid = threadIdx.x, wid = __builtin_amdgcn_readfirstlane(tid >> 6), lane = tid & 63, wr = wid >> 2, wc = wid & 3, fr = lane & 15, fq = lane >> 4;
    const int K = g.K, nt = K / BK;
    unsigned voffA[2], voffB[2];
#pragma unroll
    for (int i = 0; i < 2; ++i) { int R, C; stage_rc(tid * 16 + i * 8192, R, C); const int Rb = Epi::PERM ? ((R & ~31) + perm32(R & 31)) : R;
        voffA[i] = (unsigned)(R * K + C) * 2u; voffB[i] = (unsigned)(Rb * K + C) * 2u; }
    const size_t kstep = (size_t)(BK * 2);
    const size_t hstep = (size_t)HALF * K * 2;
    const size_t tstep = 2 * hstep;
    const unsigned ldsw = (unsigned)wid * 1024u;
    const int aoff = lds_byte(wr * 64 + fr, fq * 8), boff = lds_byte(wc * 32 + fr, fq * 8);
#define PG8_SA(b, h) (((b) * 2 + (h)) * HTB)
#define PG8_SB(b, h) ((4 + (b) * 2 + (h)) * HTB)
#define PG8_STAGE(bufoff, gbase, voff) do { _Pragma("unroll") for (int _i = 0; _i < 2; ++_i) \
        __builtin_amdgcn_global_load_lds((const unsigned*)((const char*)(gbase) + (voff)[_i]), (PG8_LAS unsigned*)(lds + (bufoff) + ldsw + _i * 8192), 16, 0, 0); } while (0)
#define PG8_LDA(dst, b, h) do { _Pragma("unroll") for (int m = 0; m < 4; ++m) _Pragma("unroll") for (int k = 0; k < 2; ++k) dst[m][k] = *(const PG8_LAS bf16x8*)(lds + PG8_SA(b, h) + aoff + m * 2048 + k * 1024); } while (0)
#define PG8_LDB(dst, b, h) do { _Pragma("unroll") for (int n = 0; n < 2; ++n) _Pragma("unroll") for (int k = 0; k < 2; ++k) dst[n][k] = *(const PG8_LAS bf16x8*)(lds + PG8_SB(b, h) + boff + n * 2048 + k * 1024); } while (0)
#define PG8_MMA(ai, bj, At, Bt) do { __builtin_amdgcn_s_setprio(1); _Pragma("unroll") for (int m = 0; m < 4; ++m) _Pragma("unroll") for (int n = 0; n < 2; ++n) _Pragma("unroll") for (int k = 0; k < 2; ++k) \
        acc[ai][bj][m][n] = __builtin_amdgcn_mfma_f32_16x16x32_bf16(Bt[n][k], At[m][k], acc[ai][bj][m][n], 0, 0, 0); __builtin_amdgcn_s_setprio(0); } while (0)
#define PG8_WAIT_V(n) asm volatile("s_waitcnt vmcnt(" #n ")" ::: "memory")
#define PG8_WAIT_L(n) asm volatile("s_waitcnt lgkmcnt(" #n ")" ::: "memory")
#define PG8_BAR __builtin_amdgcn_s_barrier()
#define PG8_SCHED __builtin_amdgcn_sched_barrier(0)
    Unit cur, nxt; int ui = 0;
    if (!S.next(0, cur)) return;
    f32x4 acc[2][2][4][2];
#pragma unroll
    for (int a = 0; a < 2; ++a)
#pragma unroll
        for (int b = 0; b < 2; ++b)
#pragma unroll
            for (int m = 0; m < 4; ++m)
#pragma unroll
                for (int n = 0; n < 2; ++n) acc[a][b][m][n] = (f32x4){0.f, 0.f, 0.f, 0.f};
    bf16x8 At[4][2], B0[2][2], B1[2][2];
    const char* cA = (const char*)g.A + (size_t)cur.pm * tstep; const char* cB = (const char*)g.Bt + (size_t)cur.pn * tstep;
    S.a_ready(cur);
    if constexpr (SP2) {
        PG8_STAGE(PG8_SB(0, 0), cB, voffB); PG8_STAGE(PG8_SB(0, 1), cB + hstep, voffB); PG8_STAGE(PG8_SA(0, 0), cA, voffA); PG8_STAGE(PG8_SA(0, 1), cA + hstep, voffA);
        if (wr == 1) PG8_BAR;
        PG8_WAIT_V(2); PG8_BAR;
        PG8_STAGE(PG8_SB(1, 0), cB + kstep, voffB); PG8_STAGE(PG8_SA(1, 0), cA + kstep, voffA); PG8_STAGE(PG8_SB(1, 1), cB + hstep + kstep, voffB);
        PG8_WAIT_V(6); PG8_BAR;
    } else {
        PG8_STAGE(PG8_SB(0, 0), cB, voffB); PG8_STAGE(PG8_SA(0, 0), cA, voffA); PG8_STAGE(PG8_SB(0, 1), cB + hstep, voffB); PG8_STAGE(PG8_SA(0, 1), cA + hstep, voffA);
        if (wr == 1) PG8_BAR;
        PG8_WAIT_V(4); PG8_BAR;
        PG8_STAGE(PG8_SB(1, 0), cB + kstep, voffB); PG8_STAGE(PG8_SA(1, 0), cA + kstep, voffA); PG8_STAGE(PG8_SB(1, 1), cB + hstep + kstep, voffB);
        PG8_WAIT_V(6); PG8_BAR;
    }
    for (;;) {
        const bool has_next = S.next(ui + 1, nxt);
        const char* nA = has_next ? (const char*)g.A + (size_t)nxt.pm * tstep : cA; const char* nB = has_next ? (const char*)g.Bt + (size_t)nxt.pn * tstep : cB;
        for (int t = 0; t < nt; t += 2) {
            const bool last = (t == nt - 2);
            const char* a1 = cA + (size_t)(t + 1) * kstep;
            const char* a2 = last ? nA : cA + (size_t)(t + 2) * kstep; const char* b2 = last ? nB : cB + (size_t)(t + 2) * kstep;
            const char* a3 = a2 + kstep; const char* b3 = b2 + kstep;
            if (last && has_next) S.a_ready(nxt);
            if constexpr (SP2) {
            PG8_LDB(B0, 0, 0); PG8_LDB(B1, 0, 1); PG8_SCHED; PG8_LDA(At, 0, 0); PG8_STAGE(PG8_SA(1, 1), a1 + hstep, voffA);
            PG8_WAIT_V(8); PG8_WAIT_L(0); PG8_BAR; PG8_MMA(0, 0, At, B0); PG8_MMA(0, 1, At, B1); PG8_BAR; PG8_SCHED;
            PG8_LDA(At, 0, 1); PG8_STAGE(PG8_SB(0, 0), b2, voffB); PG8_STAGE(PG8_SB(0, 1), b2 + hstep, voffB); PG8_STAGE(PG8_SA(0, 0), a2, voffA);
            PG8_WAIT_V(8); PG8_WAIT_L(0); PG8_BAR; PG8_MMA(1, 0, At, B0); PG8_MMA(1, 1, At, B1); PG8_BAR; PG8_SCHED;
            PG8_LDB(B0, 1, 0); PG8_LDB(B1, 1, 1); PG8_SCHED; PG8_LDA(At, 1, 0); PG8_STAGE(PG8_SA(0, 1), a2 + hstep, voffA);
            PG8_WAIT_V(8); PG8_WAIT_L(0); PG8_BAR; PG8_MMA(0, 0, At, B0); PG8_MMA(0, 1, At, B1); PG8_BAR; PG8_SCHED;
            PG8_LDA(At, 1, 1); PG8_STAGE(PG8_SB(1, 0), b3, voffB); PG8_STAGE(PG8_SB(1, 1), b3 + hstep, voffB); PG8_STAGE(PG8_SA(1, 0), a3, voffA);
            PG8_WAIT_V(8); PG8_WAIT_L(0); PG8_BAR; PG8_MMA(1, 0, At, B0); PG8_MMA(1, 1, At, B1); PG8_BAR; PG8_SCHED;
            } else {
            PG8_LDB(B0, 0, 0); PG8_SCHED; PG8_LDA(At, 0, 0); PG8_STAGE(PG8_SA(1, 1), a1 + hstep, voffA);
            PG8_WAIT_L(8); PG8_BAR; PG8_WAIT_L(0); PG8_MMA(0, 0, At, B0); PG8_BAR; PG8_SCHED;
            PG8_LDB(B1, 0, 1); PG8_STAGE(PG8_SB(0, 0), b2, voffB);
            PG8_BAR; PG8_WAIT_L(0); PG8_MMA(0, 1, At, B1); PG8_BAR;
            PG8_LDA(At, 0, 1); PG8_STAGE(PG8_SA(0, 0), a2, voffA);
            PG8_BAR; PG8_WAIT_L(0); PG8_MMA(1, 0, At, B0); PG8_BAR; PG8_SCHED;
            PG8_STAGE(PG8_SB(0, 1), b2 + hstep, voffB);
            PG8_WAIT_V(6); PG8_BAR; PG8_MMA(1, 1, At, B1); PG8_BAR;
            PG8_LDB(B0, 1, 0); PG8_SCHED; PG8_LDA(At, 1, 0); PG8_STAGE(PG8_SA(0, 1), a2 + hstep, voffA);
            PG8_WAIT_L(8); PG8_BAR; PG8_WAIT_L(0); PG8_MMA(0, 0, At, B0); PG8_BAR; PG8_SCHED;
            PG8_LDB(B1, 1, 1); PG8_STAGE(PG8_SB(1, 0), b3, voffB);
            PG8_BAR; PG8_WAIT_L(0); PG8_MMA(0, 1, At, B1); PG8_BAR;
            PG8_LDA(At, 1, 1); PG8_STAGE(PG8_SA(1, 0), a3, voffA);
            PG8_BAR; PG8_WAIT_L(0); PG8_MMA(1, 0, At, B0); PG8_BAR; PG8_SCHED;
            PG8_STAGE(PG8_SB(1, 1), b3 + hstep, voffB);
            PG8_WAIT_V(6); PG8_BAR; PG8_MMA(1, 1, At, B1); PG8_BAR;
            }
        }
        if constexpr (ALIGN_EPI) { if (wr == 0) PG8_BAR; }
        E(acc, cur, wr, wc, fr, fq); S.done(cur);
        if (!has_next) break;
#pragma unroll
        for (int a = 0; a < 2; ++a)
#pragma unroll
            for (int b = 0; b < 2; ++b)
#pragma unroll
                for (int m = 0; m < 4; ++m)
#pragma unroll
                    for (int n = 0; n < 2; ++n) acc[a][b][m][n] = (f32x4){0.f, 0.f, 0.f, 0.f};
        cur = nxt; cA = nA; cB = nB; ++ui;
        if constexpr (ALIGN_EPI) { if (wr == 1) PG8_BAR; }
    }
    PG8_WAIT_V(0);
    if constexpr (!ALIGN_EPI) { if (wr == 0) PG8_BAR; }
    PG8_BAR;
#undef PG8_SA
#undef PG8_SB
#undef PG8_STAGE
#undef PG8_LDA
#undef PG8_LDB
#undef PG8_MMA
#undef PG8_WAIT_V
#undef PG8_WAIT_L
#undef PG8_BAR
#undef PG8_SCHED
}
}

constexpr int NWAVES = 8;
constexpr int DM = 1024, NTOK = 16384, NCTX = 8192, D_IN = 1792, NMODV = 9, MODW = 6144;
constexpr int SEQ_C = 256, SEQ_L = 1024, NSEQ_C = 32, NSEQ_L = 8;
constexpr int N_PHASES = 8;
constexpr float LOG2E = 1.4426950408889634f;
constexpr float QSCALE = 0.125f * LOG2E;
constexpr float EPS = 1e-6f;

constexpr size_t MiB = 1u << 20, KiB = 1u << 10;
constexpr size_t WS_CTL = 0, CTL_ZERO_BYTES = 64 * KiB;
constexpr size_t WS_MODS = 1 * MiB;
constexpr size_t WS_ROPE = 1 * MiB + 256 * KiB;
constexpr size_t WS_RGW  = 1 * MiB + 512 * KiB;
constexpr size_t WS_CK   = 1 * MiB + 768 * KiB;
constexpr size_t WS_CVT  = 2 * MiB + 256 * KiB;
constexpr size_t WS_WIN  = 3 * MiB;
constexpr size_t WS_WOUT = 7 * MiB;
constexpr size_t WS_WC   = 9 * MiB;
constexpr size_t WS_U    = 16 * MiB;
constexpr size_t WS_SU   = 13 * MiB;
constexpr size_t WS_SV   = 13 * MiB + 64 * KiB;
constexpr size_t WS_V    = 48 * MiB;
constexpr size_t WS_H    = 80 * MiB;
constexpr size_t WS_MIX  = 112 * MiB;
constexpr size_t WS_Q    = 144 * MiB;
constexpr size_t WS_K    = 160 * MiB;
constexpr size_t WS_VT   = 164 * MiB;
constexpr size_t WS_XR   = 168 * MiB;
constexpr size_t WS_YG   = 184 * MiB;
constexpr size_t WS_HF   = 200 * MiB;
constexpr size_t WS_SC   = 144 * MiB;
constexpr size_t WS_END  = 232 * MiB;
constexpr int VT_LAT_OFF = NSEQ_C * 2 * 64 * SEQ_C;

constexpr int CW_BAR = 4096;

constexpr int RING_BYTES = 131072;
constexpr int LDSCTL_OFF = 146944, MISC_OFF = LDSCTL_OFF + 320;
constexpr int LDS_BYTES = 147456;

#define GAS __attribute__((address_space(1)))
#define LAS __attribute__((address_space(3)))
typedef unsigned short bf16;
typedef unsigned v4u __attribute__((ext_vector_type(4)));
typedef unsigned v2u __attribute__((ext_vector_type(2)));
typedef float f32x4 __attribute__((ext_vector_type(4)));
typedef float f32x2 __attribute__((ext_vector_type(2)));
typedef float f32x16 __attribute__((ext_vector_type(16)));
typedef short bf16x8 __attribute__((ext_vector_type(8)));
typedef GAS unsigned gu32;
#define RLX_AGENT __ATOMIC_RELAXED, __HIP_MEMORY_SCOPE_AGENT

__device__ __forceinline__ unsigned f2bf(float f) { unsigned u = __builtin_bit_cast(unsigned, f); return (u + 0x7fffu + ((u >> 16) & 1u)) >> 16; }
__device__ __forceinline__ unsigned pk2(float lo, float hi) { return f2bf(lo) | (f2bf(hi) << 16); }
__device__ __forceinline__ float bf2f(unsigned b) { return __builtin_bit_cast(float, b << 16); }
__device__ __forceinline__ float bflo(unsigned w) { return __builtin_bit_cast(float, w << 16); }
__device__ __forceinline__ float bfhi(unsigned w) { return __builtin_bit_cast(float, w & 0xffff0000u); }
__device__ __forceinline__ float sigmoidf_(float x) { return 1.f / (1.f + __expf(-x)); }
__device__ __forceinline__ float gelu_tanh(float x) { const float y = 0.7978845608028654f * (x + 0.044715f * x * x * x); const float e = __expf(2.f * y); return 0.5f * x * (2.f - 2.f / (1.f + e)); }
__device__ __forceinline__ float wave_sum(float v) {
#pragma unroll
    for (int o = 1; o < 64; o <<= 1) v += __shfl_xor(v, o);
    return v;
}
__device__ __forceinline__ unsigned wave_max_u32(unsigned v) {
#pragma unroll
    for (int o = 1; o < 64; o <<= 1) { const unsigned t = (unsigned)__shfl_xor((int)v, o); v = t > v ? t : v; }
    return v;
}
__device__ __forceinline__ int crow(int r, int hi) { return (r & 3) + 8 * (r >> 2) + 4 * hi; }

#define XB_TMO      128
#define XB_XCNT(j)  (256  + 64 * (j))
#define XB_XSUB(j)  (1280 + 64 * (j))
#define XB_XGEN(j)  (2304 + 64 * (j))
#define XB_TOP      3328
#define XB_TOPGEN   3392
#define XCD_BAR_WORDS 3456
#define XB_SPIN_CAP (1u << 18)
__device__ __forceinline__ unsigned xb_ld(unsigned* p)              { return __hip_atomic_load(p, __ATOMIC_RELAXED, __HIP_MEMORY_SCOPE_AGENT); }
__device__ __forceinline__ unsigned xb_add(unsigned* p, unsigned v) { return __hip_atomic_fetch_add(p, v, __ATOMIC_RELAXED, __HIP_MEMORY_SCOPE_AGENT); }
__device__ __forceinline__ unsigned xb_xcc_id() { return (unsigned)__builtin_amdgcn_s_getreg((3 << 11) | 20) & 0xFu; }
#define XB_SPIN(cond, bar) do { unsigned _sp = 0; while (cond) { __builtin_amdgcn_s_sleep(1); \
    if ((++_sp & 255u) == 0u) { if (xb_ld(&(bar)[XB_TMO])) break; if (_sp > XB_SPIN_CAP) { atomicAdd(&(bar)[XB_TMO], 1u); break; } } } } while (0)
struct XcdBarrier { unsigned* bar; unsigned x; volatile LAS unsigned* st; };
__device__ __forceinline__ XcdBarrier xcd_barrier_post(unsigned* bar, volatile LAS unsigned* st) {
    XcdBarrier b; b.bar = bar; b.x = xb_xcc_id(); b.st = st;
    if (threadIdx.x == 0) (void)xb_add(&bar[XB_XCNT(b.x)], 1u);
    return b;
}
__device__ __forceinline__ void xcd_barrier_complete(unsigned* bar, unsigned x, unsigned& nloc, unsigned& nx) {
    const unsigned G = gridDim.x * gridDim.y * gridDim.z;
    unsigned sum, cnt, mine, sp = 0u;
    for (;;) {
        sum = 0u; cnt = 0u; mine = 0u;
#pragma unroll
        for (unsigned j = 0; j < 16; ++j) { const unsigned c = xb_ld(&bar[XB_XCNT(j)]); sum += c; cnt += (c > 0u) ? 1u : 0u; mine = (j == x) ? c : mine; }
        if (sum == G) break;
        __builtin_amdgcn_s_sleep(1);
        if ((++sp & 255u) == 0u) { if (xb_ld(&bar[XB_TMO])) break; if (sp > XB_SPIN_CAP) { atomicAdd(&bar[XB_TMO], 1u); break; } }
    }
    nloc = mine > 0u ? mine : 1u; nx = cnt > 0u ? cnt : 1u;
}
__device__ __forceinline__ void xcd_barrier(const XcdBarrier& b) {
    asm volatile("s_waitcnt vmcnt(0)" ::: "memory");
    __syncthreads();
    if (threadIdx.x == 0) {
        unsigned* bar = b.bar;
        __builtin_amdgcn_s_waitcnt(0);
        unsigned nloc = b.st[0], nx = b.st[1];
        if (nloc == 0u) { xcd_barrier_complete(bar, b.x, nloc, nx); b.st[0] = nloc; b.st[1] = nx; }
        const unsigned old = xb_add(&bar[XB_XSUB(b.x)], 1u);
        const unsigned gen = old / nloc;
        if (old + 1u == (gen + 1u) * nloc) {
            __builtin_amdgcn_fence(__ATOMIC_RELEASE, "agent");
            asm volatile("s_waitcnt vmcnt(0)" ::: "memory");
            const unsigned og = xb_add(&bar[XB_TOP], 1u);
            const unsigned tg = og / nx;
            if (og + 1u == (tg + 1u) * nx) xb_add(&bar[XB_TOPGEN], 1u);
            else XB_SPIN(xb_ld(&bar[XB_TOPGEN]) == tg, bar);
            __builtin_amdgcn_fence(__ATOMIC_ACQUIRE, "agent");
            xb_add(&bar[XB_XGEN(b.x)], 1u);
            asm volatile("s_waitcnt vmcnt(0)" ::: "memory");
        } else {
            XB_SPIN(xb_ld(&bar[XB_XGEN(b.x)]) == gen, bar);
            __builtin_amdgcn_fence(__ATOMIC_ACQUIRE, "agent");
            asm volatile("s_waitcnt vmcnt(0)" ::: "memory");
        }
    }
    __syncthreads();
}

struct Args { const float* in[26]; float* out; unsigned char* ws; int ph_lo, ph_hi, li, pad; };

struct Frame {
    unsigned char* lds;
    int tid, lane, wave, vcu, G;
    const float* const* in;
    float* out; unsigned char* ws;
};
enum { I_XP = 0, I_XS, I_CK, I_CV, I_SRNN, I_C, I_CCTX, I_WMOD, I_BMOD, I_GMIX, I_GFFN, I_WIN, I_CONVW, I_CONVB, I_RGWA, I_RGBA, I_RGWI, I_RGBI, I_RGLAM, I_SINK, I_WOUT, I_PWQ, I_PSK, I_PU, I_PV, I_GFINAL };
constexpr size_t O_Y = 0, O_NEWK = (size_t)NTOK * DM, O_NEWV = O_NEWK + (size_t)NCTX * 128, O_NEWRNN = O_NEWV + (size_t)NCTX * 128;

__device__ __forceinline__ int mod_index(int tok) { return tok < NCTX ? 0 : 1 + ((tok - NCTX) >> 10); }
__device__ __forceinline__ const float* x_row(const Frame& F, int tok) { return tok < NCTX ? F.in[I_XP] + (size_t)tok * DM : F.in[I_XS] + (size_t)(tok - NCTX) * DM; }

template <class RowMap>
__device__ __forceinline__ void p0_transpose_item(const float* W, int K, int N, bf16* WT, float* scr, int item, int lane, RowMap rowmap) {
    const int nblk = N / 32, kb = item / nblk, nb = item % nblk, k0 = 64 * kb, n0 = 32 * nb;
#pragma unroll 8
    for (int i = 0; i < 32; ++i) { const int kk = 2 * i + (lane >> 5); scr[kk * 33 + (lane & 31)] = W[(size_t)(k0 + kk) * N + n0 + (lane & 31)]; }
    __builtin_amdgcn_s_waitcnt(0xC07F); asm volatile("" ::: "memory");
    const int c = lane & 7;
#pragma unroll
    for (int j = 0; j < 4; ++j) { const int n = (lane >> 3) + 8 * j; const float* s = scr + (8 * c) * 33 + n;
        v4u o; o.x = pk2(s[0 * 33], s[1 * 33]); o.y = pk2(s[2 * 33], s[3 * 33]); o.z = pk2(s[4 * 33], s[5 * 33]); o.w = pk2(s[6 * 33], s[7 * 33]);
        *(v4u*)(WT + (size_t)rowmap(n0 + n) * K + k0 + 8 * c) = o; }
    __builtin_amdgcn_s_waitcnt(0xC07F); asm volatile("" ::: "memory");
}
struct MapId { __device__ __forceinline__ int operator()(int n) const { return n; } };
struct MapWin { __device__ __forceinline__ int operator()(int n) const { if (n >= 640) return n; const int hb = n & ~63, o = n & 63; return hb + ((o & 31) << 1) + (o >> 5); } };

__device__ __forceinline__ void p0_phase(Frame& F) {
    float* ldsf = (float*)F.lds;
    const int tid = F.tid, lane = F.lane, wave = F.wave, v = F.vcu;
    if (v < 192) {
        for (int i = tid; i < NMODV * DM; i += 512) { const int j = i >> 10, d = i & 1023; const float c = (j == 0) ? F.in[I_CCTX][d] : F.in[I_C][(j - 1) * DM + d]; ldsf[i] = c * sigmoidf_(c); }
        __syncthreads();
        const int e0 = 32 * v, c4 = tid & 7, kq = tid >> 3;
        float acc[NMODV][4];
#pragma unroll
        for (int j = 0; j < NMODV; ++j) { acc[j][0] = 0.f; acc[j][1] = 0.f; acc[j][2] = 0.f; acc[j][3] = 0.f; }
        const float* wm = F.in[I_WMOD] + e0 + 4 * c4;
#pragma unroll 4
        for (int kk = 0; kk < 16; ++kk) { const int k = kq * 16 + kk; const f32x4 w = *(const f32x4*)(wm + (size_t)k * MODW);
#pragma unroll
            for (int j = 0; j < NMODV; ++j) { const float s = ldsf[j * DM + k]; acc[j][0] += s * w[0]; acc[j][1] += s * w[1]; acc[j][2] += s * w[2]; acc[j][3] += s * w[3]; } }
#pragma unroll
        for (int j = 0; j < NMODV; ++j)
#pragma unroll
            for (int i = 0; i < 4; ++i) { float a = acc[j][i]; a += __shfl_xor(a, 8); a += __shfl_xor(a, 16); a += __shfl_xor(a, 32); acc[j][i] = a; }
        float* red = ldsf + NMODV * DM;
        if (lane < 8) {
#pragma unroll
            for (int j = 0; j < NMODV; ++j)
#pragma unroll
                for (int i = 0; i < 4; ++i) red[(wave * NMODV + j) * 32 + 4 * c4 + i] = acc[j][i];
        }
        __syncthreads();
        if (tid < NMODV * 32) { const int j = tid >> 5, col = tid & 31; float s = F.in[I_BMOD][e0 + col];
#pragma unroll
            for (int w = 0; w < 8; ++w) s += red[(w * NMODV + j) * 32 + col];
            ((float*)(F.ws + WS_MODS))[j * MODW + e0 + col] = s; }
        __syncthreads();
    }
    if (v < 256) {
        const int hh = v >> 4, dt = v & 15, d0 = 64 * dt;
        float* At = ldsf;
        float* Bkt = ldsf + 128 * 64;
        const float* wq = F.in[I_PWQ] + hh * 128;
        const float* sk = F.in[I_PSK] + (size_t)hh * 128 * 128;
#pragma unroll
        for (int i = 0; i < 4; ++i) { const int f = tid + 512 * i, d = f & 63, q4 = f >> 6; const f32x4 a = *(const f32x4*)(wq + (size_t)(d0 + d) * 2048 + 4 * q4);
            At[(4 * q4 + 0) * 64 + d] = a[0]; At[(4 * q4 + 1) * 64 + d] = a[1]; At[(4 * q4 + 2) * 64 + d] = a[2]; At[(4 * q4 + 3) * 64 + d] = a[3]; }
#pragma unroll
        for (int i = 0; i < 8; ++i) { const int f = tid + 512 * i, key = f & 127, q4 = f >> 7; const f32x4 b = *(const f32x4*)(sk + (size_t)key * 128 + 4 * q4);
            Bkt[(4 * q4 + 0) * 128 + key] = b[0]; Bkt[(4 * q4 + 1) * 128 + key] = b[1]; Bkt[(4 * q4 + 2) * 128 + key] = b[2]; Bkt[(4 * q4 + 3) * 128 + key] = b[3]; }
        __syncthreads();
        const int dg = tid & 15, kg = tid >> 4;
        float acc[4][4];
#pragma unroll
        for (int i = 0; i < 4; ++i)
#pragma unroll
            for (int j = 0; j < 4; ++j) acc[i][j] = 0.f;
#pragma unroll 4
        for (int q = 0; q < 128; ++q) { const f32x4 a = *(const f32x4*)(At + q * 64 + 4 * dg); const f32x4 b = *(const f32x4*)(Bkt + q * 128 + 4 * kg);
#pragma unroll
            for (int i = 0; i < 4; ++i)
#pragma unroll
                for (int j = 0; j < 4; ++j) acc[i][j] += a[i] * b[j]; }
        bf16* WcT = (bf16*)(F.ws + WS_WC);
#pragma unroll
        for (int j = 0; j < 4; ++j) { v2u o; o.x = pk2(acc[0][j], acc[1][j]); o.y = pk2(acc[2][j], acc[3][j]);
            *(v2u*)(WcT + (size_t)(hh * 128 + 4 * kg + j) * DM + d0 + 4 * dg) = o; }
        __syncthreads();
    }
    const int gw = v * NWAVES + wave, NGW = F.G * NWAVES;
    float* scr = ldsf + wave * 4096;
    {
        constexpr int I_IN = (DM / 64) * (D_IN / 32), I_OUT = (DM / 64) * (DM / 32), I_RG = 32 * 2;
        constexpr int NIT = I_IN + I_OUT + I_RG;
        for (int it = gw; it < NIT; it += NGW) {
            int r = it;
            if (r < I_IN) { p0_transpose_item(F.in[I_WIN], DM, D_IN, (bf16*)(F.ws + WS_WIN), scr, r, lane, MapWin()); continue; } r -= I_IN;
            if (r < I_OUT) { p0_transpose_item(F.in[I_WOUT], DM, DM, (bf16*)(F.ws + WS_WOUT), scr, r, lane, MapId()); continue; } r -= I_OUT;
            { const int mm = r >> 1, sub = r & 1, dir = mm >> 4, n = (mm >> 1) & 7, gate = mm & 1;
              const float* src = (gate ? F.in[I_RGWI] : F.in[I_RGWA]) + (size_t)(dir * 8 + n) * 4096;
              bf16* dst = (bf16*)(F.ws + WS_RGW) + (size_t)((dir * 8 + n) * 2 + gate) * 4096;
              p0_transpose_item(src, 64, 64, dst, scr, sub, lane, MapId()); }
        }
    }
    for (int it = gw; it < 2 * 16384; it += NGW) {
        const int tb = it >> 14, row = it & 16383;
        const float* src = (tb ? F.in[I_PV] : F.in[I_PU]) + (size_t)row * DM + 16 * lane;
        f32x4 a[4]; float am = 0.f;
#pragma unroll
        for (int j = 0; j < 4; ++j) { a[j] = *(const f32x4*)(src + 4 * j); am = fmaxf(am, fmaxf(fmaxf(fabsf(a[j][0]), fabsf(a[j][1])), fmaxf(fabsf(a[j][2]), fabsf(a[j][3])))); }
#pragma unroll
        for (int o = 1; o < 64; o <<= 1) am = fmaxf(am, __shfl_xor(am, o));
        const float inv = am > 0.f ? 127.f / am : 0.f;
        v4u o4;
#pragma unroll
        for (int j = 0; j < 4; ++j) { unsigned w = 0;
#pragma unroll
            for (int i = 0; i < 4; ++i) { int q = (int)rintf(a[j][i] * inv); q = q > 127 ? 127 : (q < -127 ? -127 : q); if (tb) q += 128; w |= ((unsigned)q & 0xffu) << (8 * i); }
            o4[j] = w; }
        *(v4u*)(F.ws + (tb ? WS_V : WS_U) + (size_t)row * DM + 16 * lane) = o4;
        if (lane == 0) ((float*)(F.ws + (tb ? WS_SV : WS_SU)))[row] = am * (1.f / 127.f);
    }
    const int gt = v * 512 + tid, NGT = F.G * 512;
    for (int e = gt; e < 8 * 256 * 128; e += NGT) {
        const int c = e & 127, bp = e >> 7, kvh = c >> 6, p = c & 63, old = (p & 1) ? 32 + (p >> 1) : (p >> 1);
        ((bf16*)(F.ws + WS_CK))[e] = (bf16)f2bf(F.in[I_CK][(size_t)bp * 128 + kvh * 64 + old]);
    }
    for (int e = gt; e < 8 * 256 * 128; e += NGT) {
        const int pos = e & 255, d = (e >> 8) & 63, kvh = (e >> 14) & 1, b = e >> 15;
        ((bf16*)(F.ws + WS_CVT))[e] = (bf16)f2bf(F.in[I_CV][(size_t)(b * 256 + pos) * 128 + kvh * 64 + d]);
    }
    for (int e = gt; e < 1024 * 32; e += NGT) {
        const int s = e >> 5, i = e & 31, row = s >> 6, col = s & 63;
        const float inv = powf(10000.0f, -(float)(i & 15) / 16.0f);
        const float ang = (i < 16 ? (float)row : (float)col) * inv;
        f32x2 cs; cs.x = cosf(ang); cs.y = sinf(ang);
        ((f32x2*)(F.ws + WS_ROPE))[e] = cs;
    }
}

__device__ __forceinline__ void norm_phase(Frame& F, int which) {
    const int gw = F.vcu * NWAVES + F.wave, NGW = F.G * NWAVES, lane = F.lane;
    const float* mods = (const float*)(F.ws + WS_MODS);
    const float* g = F.in[which ? I_GFFN : I_GMIX];
    bf16* H = (bf16*)(F.ws + WS_H);
    for (int tok = gw; tok < NTOK; tok += NGW) {
        const float* xr = which ? F.out + O_Y + (size_t)tok * DM : x_row(F, tok);
        const float* mv = mods + (size_t)mod_index(tok) * MODW + (which ? 3 * DM : 0);
        f32x4 v[4]; float ss = 0.f;
#pragma unroll
        for (int j = 0; j < 4; ++j) { v[j] = *(const f32x4*)(xr + 256 * j + 4 * lane); ss += (v[j][0] * v[j][0] + v[j][1] * v[j][1]) + (v[j][2] * v[j][2] + v[j][3] * v[j][3]); }
        const float rstd = 1.f / sqrtf(wave_sum(ss) * (1.f / DM) + EPS);
#pragma unroll
        for (int j = 0; j < 4; ++j) { const int e = 256 * j + 4 * lane;
            const f32x4 gg = *(const f32x4*)(g + e), sh = *(const f32x4*)(mv + e), sc = *(const f32x4*)(mv + DM + e);
            f32x4 o;
#pragma unroll
            for (int i = 0; i < 4; ++i) o[i] = v[j][i] * rstd * gg[i] * (1.f + sc[i]) + sh[i];
            v2u w; w.x = pk2(o[0], o[1]); w.y = pk2(o[2], o[3]); *(v2u*)(H + (size_t)tok * DM + e) = w; }
    }
}

struct EpiInProj {
    static constexpr bool PERM = false;
    bf16 *q, *k, *vT, *xr, *yg; float *newk, *newv; const f32x4* rope4;
    __device__ __forceinline__ void operator()(const f32x4 (&acc)[2][2][4][2], const pg8::Unit& u, int wr, int wc, int fr, int fq) const {
        const bool lat = u.pm >= 32;
        const int pn = u.pn;
#pragma unroll
        for (int ai = 0; ai < 2; ++ai)
#pragma unroll
            for (int m = 0; m < 4; ++m) {
                const int row = u.pm * 256 + ai * 128 + wr * 64 + m * 16 + fr;
                const int pos = lat ? ((row - NCTX) & 1023) : (row & 255);
#pragma unroll
                for (int bj = 0; bj < 2; ++bj)
#pragma unroll
                    for (int n = 0; n < 2; ++n) {
                        const int c = pn * 256 + bj * 128 + wc * 32 + n * 16 + 4 * fq;
                        f32x4 v = acc[ai][bj][m][n];
                        if (pn < 2 || (pn == 2 && bj == 0)) {
                            const int i = (c & 63) >> 1;
                            if (lat) { const f32x4 cs = rope4[(pos * 32 + i) >> 1];
                                const float a0 = v[0] * cs[0] - v[1] * cs[1], a1 = v[1] * cs[0] + v[0] * cs[1];
                                const float b0 = v[2] * cs[2] - v[3] * cs[3], b1 = v[3] * cs[2] + v[2] * cs[3];
                                v[0] = a0; v[1] = a1; v[2] = b0; v[3] = b1; }
                            if (pn < 2) { v2u w; w.x = pk2(v[0] * QSCALE, v[1] * QSCALE); w.y = pk2(v[2] * QSCALE, v[3] * QSCALE); *(v2u*)(q + (size_t)row * 512 + c) = w; }
                            else { const int kc = c - 512; v2u w; w.x = pk2(v[0], v[1]); w.y = pk2(v[2], v[3]); *(v2u*)(k + (size_t)row * 128 + kc) = w;
                                if (!lat) { float* nk = newk + (size_t)row * 128 + (kc & 64) + i; f32x2 lo; lo.x = v[0]; lo.y = v[2]; f32x2 hi; hi.x = v[1]; hi.y = v[3]; *(f32x2*)nk = lo; *(f32x2*)(nk + 32) = hi; } }
                        } else if (pn == 2) {
                            const int vc = c - 640, kvh = vc >> 6, d = vc & 63;
                            if (!lat) *(f32x4*)(newv + (size_t)row * 128 + vc) = v;
                            bf16* vp; int S;
                            if (!lat) { S = SEQ_C; vp = vT + ((size_t)((row >> 8) * 2 + kvh) * 64 + d) * SEQ_C + pos; }
                            else { S = SEQ_L; vp = vT + VT_LAT_OFF + ((size_t)(((row - NCTX) >> 10) * 2 + kvh) * 64 + d) * SEQ_L + pos; }
                            vp[0] = (bf16)f2bf(v[0]); vp[S] = (bf16)f2bf(v[1]); vp[2 * S] = (bf16)f2bf(v[2]); vp[3 * S] = (bf16)f2bf(v[3]);
                        } else if (pn < 5) {
                            v2u w; w.x = pk2(v[0], v[1]); w.y = pk2(v[2], v[3]); *(v2u*)(xr + (size_t)row * 512 + (c - 768)) = w;
                        } else {
                            v2u w; w.x = pk2(v[0], v[1]); w.y = pk2(v[2], v[3]); *(v2u*)(yg + (size_t)row * 512 + (c - 1280)) = w;
                        }
                    }
            }
    }
};
struct EpiOutProj {
    static constexpr bool PERM = false;
    const float *xp, *xs, *mods; float* x1;
    __device__ __forceinline__ void operator()(const f32x4 (&acc)[2][2][4][2], const pg8::Unit& u, int wr, int wc, int fr, int fq) const {
        const int mi = u.pm < 32 ? 0 : 1 + ((u.pm - 32) >> 2);
        const float* ga = mods + (size_t)mi * MODW + 2 * DM;
#pragma unroll
        for (int ai = 0; ai < 2; ++ai)
#pragma unroll
            for (int m = 0; m < 4; ++m) {
                const int row = u.pm * 256 + ai * 128 + wr * 64 + m * 16 + fr;
                const float* xrow = row < NCTX ? xp + (size_t)row * DM : xs + (size_t)(row - NCTX) * DM;
#pragma unroll
                for (int bj = 0; bj < 2; ++bj)
#pragma unroll
                    for (int n = 0; n < 2; ++n) {
                        const int c = u.pn * 256 + bj * 128 + wc * 32 + n * 16 + 4 * fq;
                        const f32x4 xv = *(const f32x4*)(xrow + c), gv = *(const f32x4*)(ga + c);
                        *(f32x4*)(x1 + (size_t)row * DM + c) = xv + gv * acc[ai][bj][m][n];
                    }
            }
    }
};
struct EpiScores {
    static constexpr bool PERM = true;
    bf16* sc;
    __device__ __forceinline__ void operator()(const f32x4 (&acc)[2][2][4][2], const pg8::Unit& u, int wr, int wc, int fr, int fq) const {
#pragma unroll
        for (int ai = 0; ai < 2; ++ai)
#pragma unroll
            for (int m = 0; m < 4; ++m) {
                const int row = u.pm * 256 + ai * 128 + wr * 64 + m * 16 + fr;
#pragma unroll
                for (int bj = 0; bj < 2; ++bj) {
                    const int c = u.pn * 256 + bj * 128 + wc * 32 + 8 * fq;
                    const f32x4 v0 = acc[ai][bj][m][0], v1 = acc[ai][bj][m][1];
                    v4u w; w.x = pk2(v0[0], v0[1]); w.y = pk2(v0[2], v0[3]); w.z = pk2(v1[0], v1[1]); w.w = pk2(v1[2], v1[3]);
                    *(v4u*)(sc + (size_t)row * 2048 + c) = w;
                }
            }
    }
};

__device__ __forceinline__ void attn_unit(Frame& F, bool lat, int seq, int kvh, int qt) {
    const int tid = F.tid, lane = F.lane, wave = F.wave, r32 = lane & 31, hi = lane >> 5;
    const int g = wave >> 1, qs = wave & 1, head = kvh * 4 + g;
    const int S = lat ? SEQ_L : SEQ_C, tokbase = lat ? NCTX + seq * SEQ_L : seq * SEQ_C;
    const int q0 = qt * 64, qpos = q0 + 32 * qs + r32;
    const bf16* Q = (const bf16*)(F.ws + WS_Q); const bf16* Kb = (const bf16*)(F.ws + WS_K); const bf16* VT = (const bf16*)(F.ws + WS_VT);
    const bf16* CK = (const bf16*)(F.ws + WS_CK); const bf16* CVT = (const bf16*)(F.ws + WS_CVT);
    unsigned char* ldsK = F.lds; unsigned char* ldsV = F.lds + 8192;
    bf16x8 qf[4];
    { const bf16* qp = Q + (size_t)(tokbase + qpos) * 512 + head * 64;
#pragma unroll
      for (int ks = 0; ks < 4; ++ks) qf[ks] = *(const bf16x8*)(qp + 16 * ks + 8 * hi); }
    const float sinkl = F.in[I_SINK][head] * LOG2E;
    float mrun = sinkl, lrun = (hi == 0) ? 1.f : 0.f;
    f32x16 o0, o1;
#pragma unroll
    for (int r = 0; r < 16; ++r) { o0[r] = 0.f; o1[r] = 0.f; }
    int tlo, thi;
    if (lat) { tlo = (q0 >= 128 ? q0 - 128 : 0) >> 6; thi = ((q0 + 192 < S ? q0 + 192 : S)) >> 6; } else { tlo = 0; thi = 4; }
    const int nband = thi - tlo, ntile = nband + (lat ? 4 : 0);
    const int key_t = tid >> 3, ch_t = tid & 7;
    for (int t = 0; t < ntile; ++t) {
        const bool band = t < nband;
        const bf16* kptr; const bf16* vptr; int vstride; int kbase = 0;
        if (band) { const int tile = tlo + t; kbase = tile * 64;
            kptr = Kb + (size_t)(tokbase + kbase) * 128 + kvh * 64;
            vptr = VT + (lat ? (size_t)VT_LAT_OFF + (size_t)((seq * 2 + kvh) * 64) * SEQ_L : (size_t)((seq * 2 + kvh) * 64) * SEQ_C) + kbase; vstride = S;
        } else { const int tc = t - nband;
            kptr = CK + (size_t)(seq * 256 + tc * 64) * 128 + kvh * 64;
            vptr = CVT + (size_t)((seq * 2 + kvh) * 64) * 256 + tc * 64; vstride = 256; }
        const v4u kv = *(const v4u*)(kptr + (size_t)key_t * 128 + ch_t * 8);
        const v4u vv = *(const v4u*)(vptr + (size_t)key_t * vstride + ch_t * 8);
        __syncthreads();
        *(v4u*)(ldsK + key_t * 128 + ((ch_t ^ (key_t & 7)) * 16)) = kv;
        *(v4u*)(ldsV + key_t * 128 + ((ch_t ^ (key_t & 7)) * 16)) = vv;
        __syncthreads();
        f32x16 p0, p1;
#pragma unroll
        for (int r = 0; r < 16; ++r) { p0[r] = 0.f; p1[r] = 0.f; }
#pragma unroll
        for (int ks = 0; ks < 4; ++ks) {
            const int sw = ((2 * ks + hi) ^ (r32 & 7)) * 16;
            const bf16x8 a0 = *(const bf16x8*)(ldsK + r32 * 128 + sw);
            const bf16x8 a1 = *(const bf16x8*)(ldsK + (32 + r32) * 128 + sw);
            p0 = __builtin_amdgcn_mfma_f32_32x32x16_bf16(a0, qf[ks], p0, 0, 0, 0);
            p1 = __builtin_amdgcn_mfma_f32_32x32x16_bf16(a1, qf[ks], p1, 0, 0, 0);
        }
        if (band && lat) {
#pragma unroll
            for (int r = 0; r < 16; ++r) { const int kp = kbase + crow(r, hi); int d0 = qpos - kp; d0 = d0 < 0 ? -d0 : d0; int d1 = qpos - kp - 32; d1 = d1 < 0 ? -d1 : d1;
                if (d0 > 128) p0[r] = -INFINITY; if (d1 > 128) p1[r] = -INFINITY; }
        }
        float tm = p0[0];
#pragma unroll
        for (int r = 1; r < 16; ++r) tm = fmaxf(tm, p0[r]);
#pragma unroll
        for (int r = 0; r < 16; ++r) tm = fmaxf(tm, p1[r]);
        tm = fmaxf(tm, __shfl_xor(tm, 32));
        const float mn = fmaxf(mrun, tm), alpha = exp2f(mrun - mn); mrun = mn;
        float ls = 0.f;
#pragma unroll
        for (int r = 0; r < 16; ++r) { p0[r] = exp2f(p0[r] - mn); p1[r] = exp2f(p1[r] - mn); ls += p0[r] + p1[r]; o0[r] *= alpha; o1[r] *= alpha; }
        lrun = lrun * alpha + ls;
        bf16x8 pf[4];
#pragma unroll
        for (int s = 0; s < 2; ++s) {
            v4u w0, w1;
            w0.x = pk2(p0[8 * s + 0], p0[8 * s + 1]); w0.y = pk2(p0[8 * s + 2], p0[8 * s + 3]); w0.z = pk2(p0[8 * s + 4], p0[8 * s + 5]); w0.w = pk2(p0[8 * s + 6], p0[8 * s + 7]);
            w1.x = pk2(p1[8 * s + 0], p1[8 * s + 1]); w1.y = pk2(p1[8 * s + 2], p1[8 * s + 3]); w1.z = pk2(p1[8 * s + 4], p1[8 * s + 5]); w1.w = pk2(p1[8 * s + 6], p1[8 * s + 7]);
            pf[s] = __builtin_bit_cast(bf16x8, w0); pf[2 + s] = __builtin_bit_cast(bf16x8, w1);
        }
#pragma unroll
        for (int s4 = 0; s4 < 4; ++s4) {
#pragma unroll
            for (int dt = 0; dt < 2; ++dt) {
                const int d = 32 * dt + r32;
                const v2u lo = *(const v2u*)(ldsV + d * 128 + (((2 * s4) ^ (d & 7)) * 16) + 8 * hi);
                const v2u hi2 = *(const v2u*)(ldsV + d * 128 + (((2 * s4 + 1) ^ (d & 7)) * 16) + 8 * hi);
                v4u vf4; vf4.x = lo.x; vf4.y = lo.y; vf4.z = hi2.x; vf4.w = hi2.y;
                const bf16x8 vf = __builtin_bit_cast(bf16x8, vf4);
                if (dt == 0) o0 = __builtin_amdgcn_mfma_f32_32x32x16_bf16(vf, pf[s4], o0, 0, 0, 0);
                else o1 = __builtin_amdgcn_mfma_f32_32x32x16_bf16(vf, pf[s4], o1, 0, 0, 0);
            }
        }
    }
    const float ltot = lrun + __shfl_xor(lrun, 32), inv = 1.f / ltot;
    bf16* mix = (bf16*)(F.ws + WS_MIX) + (size_t)(tokbase + qpos) * DM + head * 64;
#pragma unroll
    for (int g4 = 0; g4 < 4; ++g4) {
        v2u w; w.x = pk2(o0[4 * g4] * inv, o0[4 * g4 + 1] * inv); w.y = pk2(o0[4 * g4 + 2] * inv, o0[4 * g4 + 3] * inv);
        *(v2u*)(mix + 8 * g4 + 4 * hi) = w;
        v2u w2; w2.x = pk2(o1[4 * g4] * inv, o1[4 * g4 + 1] * inv); w2.y = pk2(o1[4 * g4 + 2] * inv, o1[4 * g4 + 3] * inv);
        *(v2u*)(mix + 32 + 8 * g4 + 4 * hi) = w2;
    }
    __syncthreads();
}

constexpr int RL_HALF = 49152;
constexpr int RL_XCB = 32768;
constexpr int RL_AGG = 98304;
constexpr int RL_CARRY = RL_AGG + 8192;
constexpr int RL_CW = RL_CARRY + 512;
constexpr int RL_WG = RL_CW + 1280;
static_assert(RL_WG + 32768 <= LDSCTL_OFF, "RNN LDS map");
__device__ __forceinline__ float fsigmoid(float x) { return __builtin_amdgcn_rcpf(1.f + __expf(-x)); }
__device__ __forceinline__ float gelu_fast(float x) { const float y = 0.7978845608028654f * (x + 0.044715f * x * x * x); const float e = __expf(2.f * y); return x - x * __builtin_amdgcn_rcpf(1.f + e); }

template <bool REV>
__device__ __forceinline__ void scan_prep(const float (&a)[16], const float (&b)[16], int h, float (&Apre)[4], float (&Bpre)[4], float& At, float& Bt) {
    float Ao[4], Bo[4], Ap[4], Bp[4];
#pragma unroll
    for (int g = 0; g < 4; ++g) { float A = 1.f, B = 0.f;
#pragma unroll
        for (int ii = 0; ii < 4; ++ii) { const int r = 4 * g + (REV ? 3 - ii : ii); B = a[r] * B + b[r]; A = a[r] * A; }
        Ao[g] = A; Bo[g] = B; }
#pragma unroll
    for (int g = 0; g < 4; ++g) { Ap[g] = __shfl_xor(Ao[g], 32); Bp[g] = __shfl_xor(Bo[g], 32); }
    const bool ownfirst = REV ? (h == 1) : (h == 0);
    float Ac = 1.f, Bc = 0.f;
#pragma unroll
    for (int gi = 0; gi < 4; ++gi) { const int g = REV ? 3 - gi : gi;
        const float A1 = ownfirst ? Ao[g] : Ap[g], B1 = ownfirst ? Bo[g] : Bp[g], A2 = ownfirst ? Ap[g] : Ao[g], B2 = ownfirst ? Bp[g] : Bo[g];
        const float Ac1 = A1 * Ac, Bc1 = A1 * Bc + B1;
        Apre[g] = ownfirst ? Ac : Ac1; Bpre[g] = ownfirst ? Bc : Bc1;
        Ac = A2 * Ac1; Bc = A2 * Bc1 + B2; }
    At = Ac; Bt = Bc;
}
template <bool REV>
__device__ __forceinline__ void scan_finish(const float (&a)[16], const float (&b)[16], const float (&Apre)[4], const float (&Bpre)[4], float hin, float* hp, int hi) {
#pragma unroll
    for (int g = 0; g < 4; ++g) { float hc = Apre[g] * hin + Bpre[g];
#pragma unroll
        for (int ii = 0; ii < 4; ++ii) { const int r = 4 * g + (REV ? 3 - ii : ii); hc = a[r] * hc + b[r]; hp[(size_t)crow(r, hi) * 512] = hc; } }
}

template <bool REV>
__device__ __forceinline__ void rnn_dir(Frame& F, bool lat, int seq, int n) {
    const int lane = F.lane, w4 = F.wave & 3, r32 = lane & 31, hi = lane >> 5, dirh = REV ? 1 : 0;
    const int S = lat ? SEQ_L : SEQ_C, tokbase = lat ? NCTX + seq * SEQ_L : seq * SEQ_C, nchunk = S / 128;
    unsigned char* hb = F.lds + dirh * RL_HALF;
    float* XC32 = (float*)hb; unsigned char* XCB = hb + RL_XCB;
    f32x2* AGG = (f32x2*)(F.lds + RL_AGG) + dirh * 256; float* CARRY = (float*)(F.lds + RL_CARRY) + dirh * 64; const float* CW = (const float*)(F.lds + RL_CW);
    const unsigned char* WG = F.lds + RL_WG + dirh * 16384;
    const bf16* XR = (const bf16*)(F.ws + WS_XR) + (size_t)tokbase * 512 + n * 64;
    float* HX = (float*)(F.ws + (REV ? WS_H : WS_HF)) + (size_t)tokbase * 512 + n * 64;
    const int t = F.tid & 255, c8 = t & 7, tg = t >> 3;
    float ba[2], bi[2], sp8[2];
#pragma unroll
    for (int chh = 0; chh < 2; ++chh) { const int pe = dirh * 512 + n * 64 + chh * 32 + r32; ba[chh] = F.in[I_RGBA][pe]; bi[chh] = F.in[I_RGBI][pe];
        const float nl = -F.in[I_RGLAM][pe]; sp8[chh] = 8.f * (nl > 20.f ? nl : log1pf(__expf(nl))); }
    v4u xin[7];
#define RL_XLOAD(c0_) do { _Pragma("unroll") for (int i = 0; i < 7; ++i) { const int pos = (c0_) + 4 * tg - 2 + i; \
        xin[i] = (pos >= 0 && pos < S) ? *(const v4u*)(XR + (size_t)pos * 512 + 8 * c8) : (v4u){0u, 0u, 0u, 0u}; } } while (0)
    RL_XLOAD((REV ? nchunk - 1 : 0) * 128);
    float newcarry[2] = {0.f, 0.f};
    const bool last_tile = REV ? (w4 == 0) : (w4 == 3);
#pragma unroll 1
    for (int k = 0; k < nchunk; ++k) {
        const int c0 = (REV ? nchunk - 1 - k : k) * 128;
        {
            const f32x4 b0 = *(const f32x4*)(CW + 256 + 8 * c8), b1 = *(const f32x4*)(CW + 256 + 8 * c8 + 4);
            f32x4 wt0[4], wt1[4];
#pragma unroll
            for (int tap = 0; tap < 4; ++tap) { wt0[tap] = *(const f32x4*)(CW + tap * 64 + 8 * c8); wt1[tap] = *(const f32x4*)(CW + tap * 64 + 8 * c8 + 4); }
#pragma unroll
            for (int i = 0; i < 4; ++i) {
                f32x4 y0 = b0, y1 = b1;
#pragma unroll
                for (int tap = 0; tap < 4; ++tap) { const v4u x = xin[i + tap];
                    y0[0] += wt0[tap][0] * bflo(x.x); y0[1] += wt0[tap][1] * bfhi(x.x); y0[2] += wt0[tap][2] * bflo(x.y); y0[3] += wt0[tap][3] * bfhi(x.y);
                    y1[0] += wt1[tap][0] * bflo(x.z); y1[1] += wt1[tap][1] * bfhi(x.z); y1[2] += wt1[tap][2] * bflo(x.w); y1[3] += wt1[tap][3] * bfhi(x.w); }
                const int tk = 4 * tg + i;
                *(f32x4*)(XC32 + tk * 64 + 8 * c8) = y0; *(f32x4*)(XC32 + tk * 64 + 8 * c8 + 4) = y1;
                v4u w; w.x = pk2(y0[0], y0[1]); w.y = pk2(y0[2], y0[3]); w.z = pk2(y1[0], y1[1]); w.w = pk2(y1[2], y1[3]);
                *(v4u*)(XCB + tk * 128 + ((c8 ^ (tk & 7)) * 16)) = w; }
        }
        if (k + 1 < nchunk) RL_XLOAD((REV ? nchunk - 2 - k : k + 1) * 128);
        __syncthreads();
        if (k > 0 && last_tile && hi == 0) { CARRY[r32] = newcarry[0]; CARRY[32 + r32] = newcarry[1]; }
        const int tkA = 32 * w4 + r32;
#pragma unroll
        for (int chh = 0; chh < 2; ++chh) {
            const int che = chh * 32 + r32;
            float av[16], bv[16], Apre[4], Bpre[4];
            {
                f32x16 ga, gi;
#pragma unroll
                for (int r = 0; r < 16; ++r) { ga[r] = 0.f; gi[r] = 0.f; }
#pragma unroll
                for (int ks = 0; ks < 4; ++ks) {
                    const bf16x8 af = *(const bf16x8*)(XCB + tkA * 128 + (((2 * ks + hi) ^ (tkA & 7)) * 16));
                    const bf16x8 wa = *(const bf16x8*)(WG + che * 128 + (((2 * ks + hi) ^ (che & 7)) * 16));
                    const bf16x8 wi = *(const bf16x8*)(WG + 8192 + che * 128 + (((2 * ks + hi) ^ (che & 7)) * 16));
                    ga = __builtin_amdgcn_mfma_f32_32x32x16_bf16(af, wa, ga, 0, 0, 0);
                    gi = __builtin_amdgcn_mfma_f32_32x32x16_bf16(af, wi, gi, 0, 0, 0);
                }
#pragma unroll
                for (int r = 0; r < 16; ++r) { const int tk2 = 32 * w4 + crow(r, hi); const float x = XC32[tk2 * 64 + che];
                    const float rg = fsigmoid(ga[r] + ba[chh]), ig = fsigmoid(gi[r] + bi[chh]), a = __expf(-rg * sp8[chh]);
                    av[r] = a; bv[r] = __builtin_amdgcn_sqrtf(fmaxf(1.f - a * a, 0.f)) * ig * x; }
                float At, Bt;
                scan_prep<REV>(av, bv, hi, Apre, Bpre, At, Bt);
                if (hi == 0) { f32x2 ab; ab.x = At; ab.y = Bt; AGG[chh * 512 + w4 * 64 + che] = ab; }
            }
            __syncthreads();
            {
                float hin = CARRY[che];
                if (!REV) { for (int t2 = 0; t2 < w4; ++t2) { const f32x2 ab = AGG[chh * 512 + t2 * 64 + che]; hin = ab.x * hin + ab.y; } }
                else { for (int t2 = 3; t2 > w4; --t2) { const f32x2 ab = AGG[chh * 512 + t2 * 64 + che]; hin = ab.x * hin + ab.y; } }
                scan_finish<REV>(av, bv, Apre, Bpre, hin, HX + (size_t)(c0 + 32 * w4) * 512 + che, hi);
                if (last_tile) { const f32x2 ab = AGG[chh * 512 + w4 * 64 + che]; newcarry[chh] = ab.x * hin + ab.y; }
            }
        }
    }
#undef RL_XLOAD
    if (!lat && last_tile && hi == 0) { float* o = F.out + O_NEWRNN + (size_t)(seq * 2 + dirh) * 512 + n * 64; o[r32] = newcarry[0]; o[32 + r32] = newcarry[1]; }
}

__device__ __forceinline__ void rnn_unit(Frame& F, bool lat, int seq, int n) {
    const int tid = F.tid;
    const int S = lat ? SEQ_L : SEQ_C, tokbase = lat ? NCTX + seq * SEQ_L : seq * SEQ_C;
    __syncthreads();
    { float* CW = (float*)(F.lds + RL_CW); float* CARRY = (float*)(F.lds + RL_CARRY);
      if (tid < 320) CW[tid] = tid < 256 ? F.in[I_CONVW][(tid >> 6) * 512 + n * 64 + (tid & 63)] : F.in[I_CONVB][n * 64 + (tid - 256)];
      if (tid < 128) CARRY[tid] = lat ? F.in[I_SRNN][(size_t)(seq * 2 + (tid >> 6)) * 512 + n * 64 + (tid & 63)] : 0.f;
      const bf16* rgw = (const bf16*)(F.ws + WS_RGW);
#pragma unroll
      for (int i = 0; i < 4; ++i) { const int q = tid + 512 * i, ch = q & 7, d = (q >> 3) & 63, gate = (q >> 9) & 1, dir = q >> 10;
          const v4u w = *(const v4u*)(rgw + (size_t)((dir * 8 + n) * 2 + gate) * 4096 + d * 64 + ch * 8);
          *(v4u*)(F.lds + RL_WG + dir * 16384 + gate * 8192 + d * 128 + ((ch ^ (d & 7)) * 16)) = w; } }
    __syncthreads();
    if (F.wave < 4) rnn_dir<false>(F, lat, seq, n); else rnn_dir<true>(F, lat, seq, n);
    __syncthreads();
    { const int c4 = tid & 15, tk = tid >> 4;
      const float* HF = (const float*)(F.ws + WS_HF) + (size_t)tokbase * 512 + n * 64 + 4 * c4;
      const float* HB = (const float*)(F.ws + WS_H) + (size_t)tokbase * 512 + n * 64 + 4 * c4;
      const bf16* YG = (const bf16*)(F.ws + WS_YG) + (size_t)tokbase * 512 + n * 64 + 4 * c4;
      bf16* MIX = (bf16*)(F.ws + WS_MIX) + (size_t)tokbase * DM + 512 + n * 64 + 4 * c4;
      for (int t0 = tk; t0 < S; t0 += 32) {
          const f32x4 a = *(const f32x4*)(HF + (size_t)t0 * 512), b = *(const f32x4*)(HB + (size_t)t0 * 512); const v2u y = *(const v2u*)(YG + (size_t)t0 * 512);
          v2u o; o.x = pk2((a[0] + b[0]) * gelu_fast(bflo(y.x)), (a[1] + b[1]) * gelu_fast(bfhi(y.x))); o.y = pk2((a[2] + b[2]) * gelu_fast(bflo(y.y)), (a[3] + b[3]) * gelu_fast(bfhi(y.y)));
          *(v2u*)(MIX + (size_t)t0 * DM) = o; } }
    __syncthreads();
}

__device__ __forceinline__ void p3_phase(Frame& F) {
    const int v = F.vcu;
#pragma unroll 1
    for (int i = 0; i < 832; ++i) {
        int type, idx;
        if (F.G == 256) {
            if (v < 64) { if (i > 0) break; type = 0; idx = v; }
            else { if (i >= 6) break; const int j = v - 64, sl = i >> 1, rep = i & 1; type = 1 + sl;
                const bool extra = sl == 0 ? (j < 64) : (sl == 1 ? (j >= 64 && j < 128) : (j >= 128));
                if (rep && !extra) continue; idx = rep ? 192 + (j - 64 * sl) : j; }
        } else { const int it = v + i * F.G; if (it >= 832) break;
            if (it < 64) { type = 0; idx = it; } else if (it < 320) { type = 1; idx = it - 64; } else if (it < 576) { type = 2; idx = it - 320; } else { type = 3; idx = it - 576; } }
        const bool lat = type < 2;
        Frame L = F; asm volatile("" : "+v"(L.tid)); L.lane = L.tid & 63;
        if ((type & 1) == 0) rnn_unit(L, lat, idx >> 3, idx & 7);
        else { if (lat) attn_unit(L, true, idx >> 5, (idx >> 4) & 1, idx & 15); else attn_unit(L, false, idx >> 3, (idx >> 2) & 1, idx & 3); }
    }
}

__device__ __forceinline__ unsigned key16(unsigned b, unsigned idx) { const unsigned s = (b & 0x8000u) ? (~b & 0xffffu) : (b | 0x8000u); return (s << 16) | idx; }
__device__ __forceinline__ float keyval16(unsigned k) { const unsigned s = k >> 16; const unsigned b = (s & 0x8000u) ? (s & 0x7fffu) : (~s & 0xffffu); return bf2f(b); }
__device__ __forceinline__ unsigned sortable32(float f) { const unsigned u = __builtin_bit_cast(unsigned, f); return (u & 0x80000000u) ? ~u : (u | 0x80000000u); }
template <int CTRL> __device__ __forceinline__ unsigned dppu(unsigned v) { return (unsigned)__builtin_amdgcn_update_dpp(0, (int)v, CTRL, 0xf, 0xf, true); }
template <int CTRL> __device__ __forceinline__ float dppf(float v) { return __builtin_bit_cast(float, __builtin_amdgcn_update_dpp(0, __builtin_bit_cast(int, v), CTRL, 0xf, 0xf, true)); }
__device__ __forceinline__ unsigned umax_(unsigned a, unsigned b) { return a > b ? a : b; }
__device__ __forceinline__ unsigned umin_(unsigned a, unsigned b) { return a < b ? a : b; }
__device__ __forceinline__ unsigned rowmax16u(unsigned x) { x = umax_(x, dppu<0xB1>(x)); x = umax_(x, dppu<0x4E>(x)); x = umax_(x, dppu<0x141>(x)); x = umax_(x, dppu<0x140>(x)); return x; }
__device__ __forceinline__ float rowmax16f(float x) { x = fmaxf(x, dppf<0xB1>(x)); x = fmaxf(x, dppf<0x4E>(x)); x = fmaxf(x, dppf<0x141>(x)); x = fmaxf(x, dppf<0x140>(x)); return x; }
__device__ __forceinline__ float rowsum16f(float x) { x += dppf<0xB1>(x); x += dppf<0x4E>(x); x += dppf<0x141>(x); x += dppf<0x140>(x); return x; }
__device__ __forceinline__ int rowsum16i(int x) { x += (int)dppu<0xB1>((unsigned)x); x += (int)dppu<0x4E>((unsigned)x); x += (int)dppu<0x141>((unsigned)x); x += (int)dppu<0x140>((unsigned)x); return x; }
#define CEX(a, b) do { const unsigned _h = umax_(a, b), _l = umin_(a, b); a = _h; b = _l; } while (0)

constexpr int P7_WL = 16384;
constexpr int P7_TL = 0, P7_TE = 1024, P7_TG = 3072, P7_LE = 5120, P7_LG = 6336, P7_LSU = 8768, P7_LS = 11200, P7_H2Q = 11808, P7_HST = 15904;
static_assert(P7_LS + 608 <= P7_H2Q && (P7_H2Q % 16) == 0 && P7_HST + 16 <= P7_WL && P7_WL * 8 <= RING_BYTES, "P7 LDS map");

__device__ __forceinline__ void topk_token(const v4u (&rawv)[4], unsigned* TL, int lane, const int (&ctab)[4], int* oute, float* outg) {
    const int k = lane & 15, row = lane >> 4;
    v4u rq0 = rawv[0], rq1 = rawv[1], rq2 = rawv[2], rq3 = rawv[3];
#pragma unroll 1
    for (int pass = 0; pass < 4; ++pass) {
        const int gidx = pass * 4 + row;
        const v4u raw = rq0; rq0 = rq1; rq1 = rq2; rq2 = rq3;
        unsigned r0 = key16(raw.x & 0xffffu, k * 8 + 0), r1 = key16(raw.x >> 16, k * 8 + 1), r2 = key16(raw.y & 0xffffu, k * 8 + 2), r3 = key16(raw.y >> 16, k * 8 + 3);
        unsigned r4 = key16(raw.z & 0xffffu, k * 8 + 4), r5 = key16(raw.z >> 16, k * 8 + 5), r6 = key16(raw.w & 0xffffu, k * 8 + 6), r7 = key16(raw.w >> 16, k * 8 + 7);
        CEX(r0, r1); CEX(r2, r3); CEX(r4, r5); CEX(r6, r7);
        CEX(r0, r2); CEX(r1, r3); CEX(r4, r6); CEX(r5, r7);
        CEX(r1, r2); CEX(r5, r6);
        CEX(r0, r4); CEX(r1, r5); CEX(r2, r6); CEX(r3, r7);
        CEX(r2, r4); CEX(r3, r5);
        CEX(r1, r2); CEX(r3, r4); CEX(r5, r6);
        unsigned keep = 0;
#pragma unroll
        for (int it = 0; it < 16; ++it) {
            const unsigned m = rowmax16u(r0); const bool win = r0 == m;
            r0 = win ? r1 : r0; r1 = win ? r2 : r1; r2 = win ? r3 : r2; r3 = win ? r4 : r3; r4 = win ? r5 : r4; r5 = win ? r6 : r5; r6 = win ? r7 : r6; r7 = win ? 0u : r7;
            keep = (k == it) ? m : keep;
        }
        TL[gidx * 16 + k] = keep;
    }
#pragma unroll 1
    for (int q = 0; q < 2; ++q) {
        const int hh = 4 * q + row;
        const unsigned* LA = TL + (2 * hh) * 16; const unsigned* LB = TL + (2 * hh + 1) * 16;
        unsigned c[4];
#pragma unroll
        for (int s = 0; s < 4; ++s) { const int ij = ctab[s]; const bool valid = ij >= 0; const int i = (ij >> 4) & 15, j = ij & 15;
            const float sum = keyval16(LA[i]) + keyval16(LB[j]);
            c[s] = valid ? ((sortable32(sum) & 0xffffff00u) | (unsigned)(i * 16 + j)) : 0u; }
        CEX(c[0], c[1]); CEX(c[2], c[3]); CEX(c[0], c[2]); CEX(c[1], c[3]); CEX(c[1], c[2]);
        unsigned keep = 0;
#pragma unroll
        for (int it = 0; it < 16; ++it) {
            const unsigned m = rowmax16u(c[0]); const bool win = c[0] == m;
            c[0] = win ? c[1] : c[0]; c[1] = win ? c[2] : c[1]; c[2] = win ? c[3] : c[2]; c[3] = win ? 0u : c[3];
            keep = (k == it) ? m : keep;
        }
        const int i = (keep >> 4) & 15, j = keep & 15; const unsigned ka = LA[i], kb = LB[j];
        const float bv = keyval16(ka) + keyval16(kb);
        const float mx = rowmax16f(bv); const float ex = __expf(bv - mx); const float sm = rowsum16f(ex);
        oute[q * 64 + lane] = (int)((ka & 127u) * 128u + (kb & 127u)); outg[q * 64 + lane] = ex / sm;
    }
}

__device__ __forceinline__ int mbcnt64(unsigned long long m) { return (int)__builtin_amdgcn_mbcnt_hi((unsigned)(m >> 32), __builtin_amdgcn_mbcnt_lo((unsigned)m, 0u)); }
__device__ __forceinline__ int rfl(int v) { return __builtin_amdgcn_readfirstlane(v); }
__device__ __forceinline__ float rflf(float v) { return __builtin_bit_cast(float, __builtin_amdgcn_readfirstlane(__builtin_bit_cast(int, v))); }

__device__ __forceinline__ void p7_phase(Frame& F, bool dry) {
    const int lane0 = F.lane, wave = F.wave;
    unsigned char* wl = F.lds + wave * P7_WL;
    unsigned* TL = (unsigned*)(wl + P7_TL); int* TE = (int*)(wl + P7_TE); float* TG = (float*)(wl + P7_TG);
    unsigned short* LE = (unsigned short*)(wl + P7_LE); float* LG = (float*)(wl + P7_LG); float* LSU = (float*)(wl + P7_LSU); unsigned char* LS = wl + P7_LS; unsigned char* H2Q = wl + P7_H2Q; float* HST = (float*)(wl + P7_HST);
    const bf16* SC = (const bf16*)(F.ws + WS_SC); const bf16* H2 = (const bf16*)(F.ws + WS_H);
    const unsigned char* U8 = F.ws + WS_U; const unsigned char* V8 = F.ws + WS_V;
    const float* SU = (const float*)(F.ws + WS_SU); const float* SV = (const float*)(F.ws + WS_SV);
    const float* mods = (const float*)(F.ws + WS_MODS);
    int ctab[4];
#pragma unroll
    for (int s = 0; s < 4; ++s) { const int c = 16 * s + (lane0 & 15); int i, j;
        if (c < 16) { i = 0; j = c; } else if (c < 24) { i = 1; j = c - 16; } else if (c < 29) { i = 2; j = c - 24; } else if (c < 33) { i = 3; j = c - 29; } else if (c < 36) { i = 4; j = c - 33; }
        else if (c < 38) { i = 5; j = c - 36; } else if (c < 40) { i = 6; j = c - 38; } else if (c < 42) { i = 7; j = c - 40; } else if (c < 50) { i = c - 34; j = 0; } else { i = -1; j = 0; }
        ctab[s] = i < 0 ? -1 : i * 16 + j; }
    const int ntg = NTOK / (F.G * NWAVES * 4);
#pragma unroll 1
    for (int tg = 0; tg < ntg; ++tg) {
        const int tok0 = (F.vcu * ntg + tg) * (NWAVES * 4) + wave * 4;
        int lane = F.lane; asm volatile("" : "+v"(lane));
        {
            v4u craw[4], nraw[4]; v4u ch0, ch1, nh0, nh1;
#define P7_TLOAD(R, H0, H1, tk) do { const bf16* sp_ = SC + (size_t)(tk) * 2048 + (lane >> 4) * 128 + (lane & 15) * 8; \
                _Pragma("unroll") for (int ps = 0; ps < 4; ++ps) R[ps] = *(const v4u*)(sp_ + ps * 512); \
                H0 = *(const v4u*)(H2 + (size_t)(tk) * DM + 16 * lane); H1 = *(const v4u*)(H2 + (size_t)(tk) * DM + 16 * lane + 8); } while (0)
            P7_TLOAD(craw, ch0, ch1, tok0);
#pragma unroll 1
            for (int s = 0; s < 4; ++s) {
                if (s < 3) P7_TLOAD(nraw, nh0, nh1, tok0 + s + 1);
                topk_token(craw, TL, lane, ctab, TE + s * 128, TG + s * 128);
                const v4u a = ch0, b = ch1;
                float hv[16];
                hv[0] = bflo(a.x); hv[1] = bfhi(a.x); hv[2] = bflo(a.y); hv[3] = bfhi(a.y); hv[4] = bflo(a.z); hv[5] = bfhi(a.z); hv[6] = bflo(a.w); hv[7] = bfhi(a.w);
                hv[8] = bflo(b.x); hv[9] = bfhi(b.x); hv[10] = bflo(b.y); hv[11] = bfhi(b.y); hv[12] = bflo(b.z); hv[13] = bfhi(b.z); hv[14] = bflo(b.w); hv[15] = bfhi(b.w);
                float am = 0.f;
#pragma unroll
                for (int i = 0; i < 16; ++i) am = fmaxf(am, fabsf(hv[i]));
#pragma unroll
                for (int o = 1; o < 64; o <<= 1) am = fmaxf(am, __shfl_xor(am, o));
                const float inv = am > 0.f ? 127.f / am : 0.f;
                if (lane == 0) HST[s] = am * (1.f / 127.f);
                v4u qv;
#pragma unroll
                for (int j = 0; j < 4; ++j) { unsigned w = 0;
#pragma unroll
                    for (int i = 0; i < 4; ++i) { int q = (int)rintf(hv[4 * j + i] * inv); w |= ((unsigned)q & 0xffu) << (8 * i); }
                    qv[j] = w; }
                *(v4u*)(H2Q + s * 1024 + 16 * lane) = qv;
#pragma unroll
                for (int ps = 0; ps < 4; ++ps) craw[ps] = nraw[ps];
                ch0 = nh0; ch1 = nh1;
            }
#undef P7_TLOAD
        }
        int nb;
        {
            int tot[8];
#pragma unroll
            for (int c = 0; c < 8; ++c) tot[c] = 0;
#pragma unroll 1
            for (int s = 0; s < 4; ++s) { const int c0 = TE[s * 128 + lane] >> 11, c1 = TE[s * 128 + 64 + lane] >> 11;
#pragma unroll
                for (int c = 0; c < 8; ++c) { const int n = __popcll(__ballot(c0 == c)) + __popcll(__ballot(c1 == c)); tot[c] += (n + 3) & ~3; } }
            int off[8]; { int base = 0;
#pragma unroll
                for (int c = 0; c < 8; ++c) { off[c] = base; base += tot[c]; }
                { const int pe = (base + 15) & ~15; if (lane < pe - base) { const int p = base + lane; LE[p] = (unsigned short)0; LG[p] = 0.f; LSU[p] = 0.f; LS[p] = (unsigned char)0; } base = pe; }
            nb = base >> 2; }
#pragma unroll 1
            for (int s = 0; s < 4; ++s) { const int e0 = TE[s * 128 + lane], e1 = TE[s * 128 + 64 + lane]; const float g0 = TG[s * 128 + lane], g1 = TG[s * 128 + 64 + lane]; const int c0 = e0 >> 11, c1 = e1 >> 11;
                const float su0 = SU[e0], su1 = SU[e1], sv0 = SV[e0], sv1 = SV[e1];
#pragma unroll
                for (int c = 0; c < 8; ++c) {
                    const unsigned long long m0 = __ballot(c0 == c), m1 = __ballot(c1 == c);
                    const int n0 = __popcll(m0), n = n0 + __popcll(m1), np = (n + 3) & ~3, base = off[c];
                    if (c0 == c) { const int p = base + mbcnt64(m0); LE[p] = (unsigned short)e0; LG[p] = g0 * sv0; LSU[p] = su0; LS[p] = (unsigned char)s; }
                    if (c1 == c) { const int p = base + n0 + mbcnt64(m1); LE[p] = (unsigned short)e1; LG[p] = g1 * sv1; LSU[p] = su1; LS[p] = (unsigned char)s; }
                    if (lane < np - n) { const int p = base + n + lane; LE[p] = (unsigned short)(c * 2048); LG[p] = 0.f; LSU[p] = 0.f; LS[p] = (unsigned char)s; }
                    off[c] = base + np;
                } }
        }
#ifndef MK_DRY_SKIP
#define MK_DRY_SKIP 0
#endif
        if (!(dry && (MK_DRY_SKIP & 1))) {
            int lane_u = F.lane; asm volatile("" : "+v"(lane_u));
            const bool hi32 = lane_u >= 32, b16 = (lane_u & 16) != 0;
            const int xr = ((lane_u >> 5) & 1) | ((lane_u >> 3) & 2);
            v4u ra[4], rb[4], rc[4], rd[4];
#define P7_ULOAD(R, b) do { _Pragma("unroll") for (int x = 0; x < 4; ++x) { const int e = rfl((int)LE[4 * (b) + x]); R[x] = *(const v4u*)(U8 + (size_t)e * DM + 16 * lane_u); } } while (0)
#define P7_UCOMP(R, b) do { const int sl = rfl(LS[4 * (b)]); const v4u hq = *(const v4u*)(H2Q + sl * 1024 + 16 * lane_u); int p[4]; \
            _Pragma("unroll") for (int x = 0; x < 4; ++x) { int d = __builtin_amdgcn_sdot4((int)hq.x, (int)R[x].x, 0, false); d = __builtin_amdgcn_sdot4((int)hq.y, (int)R[x].y, d, false); \
                d = __builtin_amdgcn_sdot4((int)hq.z, (int)R[x].z, d, false); d = __builtin_amdgcn_sdot4((int)hq.w, (int)R[x].w, d, false); p[x] = d; } \
            const int t01 = (hi32 ? p[1] : p[0]) + __shfl_xor(hi32 ? p[0] : p[1], 32); const int t23 = (hi32 ? p[3] : p[2]) + __shfl_xor(hi32 ? p[2] : p[3], 32); \
            int t = (b16 ? t23 : t01) + __shfl_xor(b16 ? t01 : t23, 16); t = rowsum16i(t); \
            const int idx = 4 * (b) + xr; const float g = LG[idx]; \
            const float hs = HST[sl]; \
            const float dotf = (float)t * (hs * LSU[idx]); const float cf = g * gelu_tanh(dotf); \
            if ((lane_u & 15) == 0) LG[idx] = cf; } while (0)
            P7_ULOAD(ra, 0); P7_ULOAD(rb, 1); P7_ULOAD(rc, 2);
#pragma unroll 1
            for (int b = 0; b < nb; b += 4) {
                P7_ULOAD(rd, b + 3);
                P7_UCOMP(ra, b);
                P7_ULOAD(ra, (b + 4 < nb ? b + 4 : nb - 1));
                P7_UCOMP(rb, b + 1);
                P7_ULOAD(rb, (b + 5 < nb ? b + 5 : nb - 1));
                P7_UCOMP(rc, b + 2);
                P7_ULOAD(rc, (b + 6 < nb ? b + 6 : nb - 1));
                P7_UCOMP(rd, b + 3);
            }
#undef P7_ULOAD
#undef P7_UCOMP
        }
        float acc[4][16]; float sumc[4];
#pragma unroll
        for (int s = 0; s < 4; ++s) {
#pragma unroll
            for (int i = 0; i < 16; ++i) acc[s][i] = 0.f; }
        if (!(dry && (MK_DRY_SKIP & 2))) {
            int lane_v = F.lane; asm volatile("" : "+v"(lane_v));
            v4u ra[4], rb[4], rc[4], rd[4];
#define P7_VLOAD(R, b) do { _Pragma("unroll") for (int x = 0; x < 4; ++x) { const int e = rfl((int)LE[4 * (b) + x]); R[x] = *(const v4u*)(V8 + (size_t)e * DM + 16 * lane_v); } } while (0)
#define P7_VACC(S, R, b) do { _Pragma("unroll") for (int x = 0; x < 4; ++x) { const float cf = rflf(LG[4 * (b) + x]); \
                unsigned w0 = R[x][0], w1 = R[x][1], w2 = R[x][2], w3 = R[x][3]; asm volatile("" : "+v"(w0), "+v"(w1), "+v"(w2), "+v"(w3)); \
                acc[S][0] += cf * (float)(w0 & 0xffu); acc[S][1] += cf * (float)((w0 >> 8) & 0xffu); acc[S][2] += cf * (float)((w0 >> 16) & 0xffu); acc[S][3] += cf * (float)(w0 >> 24); \
                acc[S][4] += cf * (float)(w1 & 0xffu); acc[S][5] += cf * (float)((w1 >> 8) & 0xffu); acc[S][6] += cf * (float)((w1 >> 16) & 0xffu); acc[S][7] += cf * (float)(w1 >> 24); \
                acc[S][8] += cf * (float)(w2 & 0xffu); acc[S][9] += cf * (float)((w2 >> 8) & 0xffu); acc[S][10] += cf * (float)((w2 >> 16) & 0xffu); acc[S][11] += cf * (float)(w2 >> 24); \
                acc[S][12] += cf * (float)(w3 & 0xffu); acc[S][13] += cf * (float)((w3 >> 8) & 0xffu); acc[S][14] += cf * (float)((w3 >> 16) & 0xffu); acc[S][15] += cf * (float)(w3 >> 24); } } while (0)
#define P7_VCOMP(R, b) do { const int sl = rfl(LS[4 * (b)]); if (sl == 0) P7_VACC(0, R, b); else if (sl == 1) P7_VACC(1, R, b); else if (sl == 2) P7_VACC(2, R, b); else P7_VACC(3, R, b); } while (0)
            P7_VLOAD(ra, 0); P7_VLOAD(rb, 1); P7_VLOAD(rc, 2);
#pragma unroll 1
            for (int b = 0; b < nb; b += 4) {
                P7_VLOAD(rd, b + 3);
                P7_VCOMP(ra, b);
                P7_VLOAD(ra, (b + 4 < nb ? b + 4 : nb - 1));
                P7_VCOMP(rb, b + 1);
                P7_VLOAD(rb, (b + 5 < nb ? b + 5 : nb - 1));
                P7_VCOMP(rc, b + 2);
                P7_VLOAD(rc, (b + 6 < nb ? b + 6 : nb - 1));
                P7_VCOMP(rd, b + 3);
            }
#undef P7_VLOAD
#undef P7_VACC
#undef P7_VCOMP
        }
        { float s0 = 0.f, s1 = 0.f, s2 = 0.f, s3 = 0.f;
          for (int idx = lane; idx < 4 * nb; idx += 64) { const float c = LG[idx]; const int sl = LS[idx]; s0 += sl == 0 ? c : 0.f; s1 += sl == 1 ? c : 0.f; s2 += sl == 2 ? c : 0.f; s3 += sl == 3 ? c : 0.f; }
          sumc[0] = wave_sum(s0); sumc[1] = wave_sum(s1); sumc[2] = wave_sum(s2); sumc[3] = wave_sum(s3); }
#pragma unroll
        for (int s = 0; s < 4; ++s) {
            const int tok = tok0 + s;
            int lane_f = F.lane; asm volatile("" : "+v"(lane_f));
            float* xrow = F.out + O_Y + (size_t)tok * DM + 16 * lane_f;
            float* yrow = dry ? (float*)(F.ws + WS_MIX) + (size_t)(tok & 8191) * DM + 16 * lane_f : xrow;
            const float* ga2 = mods + (size_t)mod_index(tok) * MODW + 5 * DM + 16 * lane_f;
            const float* gf = F.in[I_GFINAL] + 16 * lane_f;
            float x2[16]; float ss = 0.f; const float off = 128.f * sumc[s];
#pragma unroll
            for (int j = 0; j < 4; ++j) { const f32x4 xv = *(const f32x4*)(xrow + 4 * j), gv = *(const f32x4*)(ga2 + 4 * j);
#pragma unroll
                for (int i = 0; i < 4; ++i) { const float t = xv[i] + gv[i] * (acc[s][4 * j + i] - off); x2[4 * j + i] = t; ss += t * t; } }
            const float rstd = 1.f / sqrtf(wave_sum(ss) * (1.f / DM) + EPS);
#pragma unroll
            for (int j = 0; j < 4; ++j) { const f32x4 gv = *(const f32x4*)(gf + 4 * j); f32x4 o;
#pragma unroll
                for (int i = 0; i < 4; ++i) o[i] = x2[4 * j + i] * rstd * gv[i];
                *(f32x4*)(yrow + 4 * j) = o; }
        }
    }
}

__global__ void __launch_bounds__(NWAVES * 64, 2) mk_fwd(Args args) {
    extern __shared__ __attribute__((aligned(16))) unsigned char lds[];
    Frame F;
    F.lds = lds;
    F.tid = threadIdx.x; F.lane = F.tid & 63; F.wave = __builtin_amdgcn_readfirstlane(F.tid >> 6);
    F.G = gridDim.x; { const int bx = blockIdx.x; F.vcu = (F.G % 8 == 0) ? (bx % 8) * (F.G / 8) + bx / 8 : bx; }
    F.in = args.in; F.out = args.out; F.ws = args.ws;
    LAS unsigned char* lds3 = (LAS unsigned char*)lds;
    volatile LAS unsigned* MISC = (volatile LAS unsigned*)(lds3 + MISC_OFF);
    for (int u = F.tid; u < (LDS_BYTES - LDSCTL_OFF) / 4; u += NWAVES * 64) ((LAS unsigned*)(lds3 + LDSCTL_OFF))[u] = 0u;
    __syncthreads();
    unsigned* ctl = (unsigned*)(args.ws + WS_CTL);
    XcdBarrier bar; bar.bar = ctl + CW_BAR; bar.x = 0; bar.st = nullptr;
    const bool one_launch = (args.ph_hi - args.ph_lo) > 1;
    if (one_launch) bar = xcd_barrier_post(ctl + CW_BAR, MISC + 8);
    const int lo = args.ph_lo, hi = args.ph_hi;
#ifndef MK_PHASE_MASK
#define MK_PHASE_MASK 0xff
#endif
#define IN(k) (((MK_PHASE_MASK >> (k)) & 1) && lo <= (k) && (k) < hi)
#define SEAM(k) do { if (IN(k) && IN((k) + 1)) xcd_barrier(bar); } while (0)

    if (IN(0)) { if (MK_DUP == 0) { p0_phase(F); xcd_barrier(bar); } p0_phase(F); SEAM(0); }
    if (IN(1)) { norm_phase(F, 0); SEAM(1); }
    if (IN(2)) {
        pg8::Gemm g{(const pg8::bf16_t*)(F.ws + WS_H), (const pg8::bf16_t*)(F.ws + WS_WIN), NTOK, D_IN, DM}; pg8::StaticOrder S; S.init(NTOK, D_IN, F.G, (int)blockIdx.x);
        EpiInProj E{(bf16*)(F.ws + WS_Q), (bf16*)(F.ws + WS_K), (bf16*)(F.ws + WS_VT), (bf16*)(F.ws + WS_XR), (bf16*)(F.ws + WS_YG), F.out + O_NEWK, F.out + O_NEWV, (const f32x4*)(F.ws + WS_ROPE)};
        pg8::gemm_phase<EpiInProj, pg8::StaticOrder, true, true>(lds3, g, S, E);
        SEAM(2);
    }
    if (IN(3)) { if (MK_DUP == 3) { p3_phase(F); xcd_barrier(bar); } p3_phase(F); SEAM(3); }
    if (IN(4)) {
        pg8::Gemm g{(const pg8::bf16_t*)(F.ws + WS_MIX), (const pg8::bf16_t*)(F.ws + WS_WOUT), NTOK, DM, DM}; pg8::StaticOrder S; S.init(NTOK, DM, F.G, (int)blockIdx.x);
        EpiOutProj E{F.in[I_XP], F.in[I_XS], (const float*)(F.ws + WS_MODS), F.out + O_Y};
        pg8::gemm_phase<EpiOutProj, pg8::StaticOrder, true, true>(lds3, g, S, E);
        SEAM(4);
    }
    if (IN(5)) { norm_phase(F, 1); SEAM(5); }
    if (IN(6)) {
        pg8::Gemm g{(const pg8::bf16_t*)(F.ws + WS_H), (const pg8::bf16_t*)(F.ws + WS_WC), NTOK, 2048, DM}; pg8::StaticOrder S; S.init(NTOK, 2048, F.G, (int)blockIdx.x);
        EpiScores E{(bf16*)(F.ws + WS_SC)};
        pg8::gemm_phase<EpiScores, pg8::StaticOrder, true, true>(lds3, g, S, E);
        SEAM(6);
    }
    if (IN(7)) { if (MK_DUP == 7) { p7_phase(F, true); xcd_barrier(bar); } p7_phase(F, false); }
#undef IN
#undef SEAM
}

extern "C" void kernel_launch(void* const* d_in, const int* in_sizes, int n_in, void* d_out, int out_size, void* d_ws, size_t ws_size, hipStream_t stream) {
    static int grid = 0;
    if (grid == 0) {
        if (n_in != 26 || ws_size < WS_END) { fprintf(stderr, "kernel_launch: unexpected n_in %d / ws %zu\n", n_in, ws_size); grid = -1; return; }
        int dev = 0, cus = 0, per_cu = 0;
        if (hipGetDevice(&dev) != hipSuccess || hipDeviceGetAttribute(&cus, hipDeviceAttributeMultiprocessorCount, dev) != hipSuccess) { grid = -1; return; }
        if (hipFuncSetAttribute((const void*)mk_fwd, hipFuncAttributeMaxDynamicSharedMemorySize, LDS_BYTES) != hipSuccess) { fprintf(stderr, "kernel_launch: hipFuncSetAttribute failed\n"); grid = -1; return; }
        if (hipOccupancyMaxActiveBlocksPerMultiprocessor(&per_cu, (const void*)mk_fwd, NWAVES * 64, LDS_BYTES) != hipSuccess || per_cu < 1)
            fprintf(stderr, "kernel_launch: occupancy query reports %d blocks per CU\n", per_cu);
        (void)hipGetLastError();
        grid = cus;
        if (grid != 256) fprintf(stderr, "kernel_launch: note: %d CUs\n", grid);
    }
    if (grid < 0) return;
    (void)hipMemsetAsync((char*)d_ws + WS_CTL, 0, CTL_ZERO_BYTES, stream);
    Args a{};
    for (int i = 0; i < 26; ++i) a.in[i] = (const float*)d_in[i];
    a.out = (float*)d_out; a.ws = (unsigned char*)d_ws;
    if (MK_N_LAUNCHES == 1) {
        a.ph_lo = 0; a.ph_hi = N_PHASES; a.li = 0;
        hipLaunchKernelGGL(mk_fwd, dim3(grid), dim3(NWAVES * 64), LDS_BYTES, stream, a);
    } else {
        for (int li = 0; li < N_PHASES; ++li) { a.ph_lo = li; a.ph_hi = li + 1; a.li = li;
            hipLaunchKernelGGL(mk_fwd, dim3(grid), dim3(NWAVES * 64), LDS_BYTES, stream, a); }
    }
}
```

```cpp
#include <hip/hip_runtime.h>
#include <cstdio>
#include <cstdint>

#ifndef MK_DUP
#define MK_DUP -1
#endif
#ifndef MK_N_LAUNCHES
#define MK_N_LAUNCHES 1
#endif

namespace pg8 {
#define PG8_LAS __attribute__((address_space(3)))
typedef unsigned short bf16_t;
typedef short bf16x8 __attribute__((ext_vector_type(8)));
typedef float f32x4 __attribute__((ext_vector_type(4)));
typedef unsigned u32x4 __attribute__((ext_vector_type(4)));
typedef unsigned u32x2 __attribute__((ext_vector_type(2)));
constexpr int BM = 256, BK = 64, HALF = 128, HTB = HALF * BK * 2, STAGE_BYTES = 8 * HTB, NXCD = 8, WGM = 8;

__host__ __device__ __forceinline__ int lds_byte(int r, int c) { const int st = (r >> 4) * 2 + (c >> 5), rr = r & 15, cc = c & 31, ob = rr * 64 + cc * 2; return st * 1024 + (ob ^ (((ob >> 9) & 1) << 5)); }
__host__ __device__ __forceinline__ void stage_rc(int b, int& R, int& C) { const int st = b / 1024, sb = b % 1024, swz = sb ^ (((sb >> 9) & 1) << 5); R = (st >> 1) * 16 + swz / 64; C = (st & 1) * 32 + (swz % 64) / 2; }
__host__ __device__ __forceinline__ int perm32(int rho) { const int n = rho >> 4, i = rho & 15; return 8 * (i >> 2) + 4 * n + (i & 3); }

struct Unit { int pm, pn; };
struct Gemm { const bf16_t* A; const bf16_t* Bt; int M, N, K; };

struct StaticOrder {
    int nM, nN, nwg, G, c;
    __host__ __device__ void init(int M, int N, int G_, int c_) { nM = M / BM; nN = N / BM; nwg = nM * nN; G = G_; c = c_; }
    __host__ __device__ bool next(int i, Unit& u) const {
        const long L = (long)i * G + c; if (L >= nwg) return false;
        int wgid = (int)L; { const int q = nwg / NXCD, r = nwg % NXCD, xcd = wgid % NXCD, off = wgid / NXCD; wgid = (xcd < r ? xcd * (q + 1) : r * (q + 1) + (xcd - r) * q) + off; }
        const int nig = WGM * nN, gid = wgid / nig, fm = gid * WGM, gsz = (nM - fm) < WGM ? (nM - fm) : WGM;
        u.pm = fm + ((wgid % nig) % gsz); u.pn = (wgid % nig) / gsz; return true;
    }
    __device__ __forceinline__ void a_ready(const Unit&) const {}
    __device__ __forceinline__ void done(const Unit&) const {}
};

__device__ __forceinline__ unsigned cvt_pk_bf16(float lo, float hi) { unsigned r; asm volatile("v_cvt_pk_bf16_f32 %0, %1, %2" : "=v"(r) : "v"(lo), "v"(hi)); return r; }

template <class Epi, class Sched, bool ALIGN_EPI = false, bool SP2 = false>
__device__ __forceinline__ void gemm_phase(PG8_LAS unsigned char* lds, const Gemm g, const Sched& S, const Epi& E) {
    const int tid = threadIdx.x, wid = __builtin_amdgcn_readfirstlane(tid >> 6), lane = tid & 63, wr = wid >> 2, wc = wid & 3, fr = lane & 15, fq = lane >> 4;
    const int K = g.K, nt = K / BK;
    unsigned voffA[2], voffB[2];
#pragma unroll
    for (int i = 0; i < 2; ++i) { int R, C; stage_rc(tid * 16 + i * 8192, R, C); const int Rb = Epi::PERM ? ((R & ~31) + perm32(R & 31)) : R;
        voffA[i] = (unsigned)(R * K + C) * 2u; voffB[i] = (unsigned)(Rb * K + C) * 2u; }
    const size_t kstep = (size_t)(BK * 2);
    const size_t hstep = (size_t)HALF * K * 2;
    const size_t tstep = 2 * hstep;
    const unsigned ldsw = (unsigned)wid * 1024u;
    const int aoff = lds_byte(wr * 64 + fr, fq * 8), boff = lds_byte(wc * 32 + fr, fq * 8);
#define PG8_SA(b, h) (((b) * 2 + (h)) * HTB)
#define PG8_SB(b, h) ((4 + (b) * 2 + (h)) * HTB)
#define PG8_STAGE(bufoff, gbase, voff) do { _Pragma("unroll") for (int _i = 0; _i < 2; ++_i) \
        __builtin_amdgcn_global_load_lds((const unsigned*)((const char*)(gbase) + (voff)[_i]), (PG8_LAS unsigned*)(lds + (bufoff) + ldsw + _i * 8192), 16, 0, 0); } while (0)
#define PG8_LDA(dst, b, h) do { _Pragma("unroll") for (int m = 0; m < 4; ++m) _Pragma("unroll") for (int k = 0; k < 2; ++k) dst[m][k] = *(const PG8_LAS bf16x8*)(lds + PG8_SA(b, h) + aoff + m * 2048 + k * 1024); } while (0)
#define PG8_LDB(dst, b, h) do { _Pragma("unroll") for (int n = 0; n < 2; ++n) _Pragma("unroll") for (int k = 0; k < 2; ++k) dst[n][k] = *(const PG8_LAS bf16x8*)(lds + PG8_SB(b, h) + boff + n * 2048 + k * 1024); } while (0)
#define PG8_MMA(ai, bj, At, Bt) do { __builtin_amdgcn_s_setprio(1); _Pragma("unroll") for (int m = 0; m < 4; ++m) _Pragma("unroll") for (int n = 0; n < 2; ++n) _Pragma("unroll") for (int k = 0; k < 2; ++k) \
        acc[ai][bj][m][n] = __builtin_amdgcn_mfma_f32_16x16x32_bf16(Bt[n][k], At[m][k], acc[ai][bj][m][n], 0, 0, 0); __builtin_amdgcn_s_setprio(0); } while (0)
#define PG8_WAIT_V(n) asm volatile("s_waitcnt vmcnt(" #n ")" ::: "memory")
#define PG8_WAIT_L(n) asm volatile("s_waitcnt lgkmcnt(" #n ")" ::: "memory")
#define PG8_BAR __builtin_amdgcn_s_barrier()
#define PG8_SCHED __builtin_amdgcn_sched_barrier(0)
    Unit cur, nxt; int ui = 0;
    if (!S.next(0, cur)) return;
    f32x4 acc[2][2][4][2];
#pragma unroll
    for (int a = 0; a < 2; ++a)
#pragma unroll
        for (int b = 0; b < 2; ++b)
#pragma unroll
            for (int m = 0; m < 4; ++m)
#pragma unroll
                for (int n = 0; n < 2; ++n) acc[a][b][m][n] = (f32x4){0.f, 0.f, 0.f, 0.f};
    bf16x8 At[4][2], B0[2][2], B1[2][2];
    const char* cA = (const char*)g.A + (size_t)cur.pm * tstep; const char* cB = (const char*)g.Bt + (size_t)cur.pn * tstep;
    S.a_ready(cur);
    if constexpr (SP2) {
        PG8_STAGE(PG8_SB(0, 0), cB, voffB); PG8_STAGE(PG8_SB(0, 1), cB + hstep, voffB); PG8_STAGE(PG8_SA(0, 0), cA, voffA); PG8_STAGE(PG8_SA(0, 1), cA + hstep, voffA);
        if (wr == 1) PG8_BAR;
        PG8_WAIT_V(2); PG8_BAR;
        PG8_STAGE(PG8_SB(1, 0), cB + kstep, voffB); PG8_STAGE(PG8_SA(1, 0), cA + kstep, voffA); PG8_STAGE(PG8_SB(1, 1), cB + hstep + kstep, voffB);
        PG8_WAIT_V(6); PG8_BAR;
    } else {
        PG8_STAGE(PG8_SB(0, 0), cB, voffB); PG8_STAGE(PG8_SA(0, 0), cA, voffA); PG8_STAGE(PG8_SB(0, 1), cB + hstep, voffB); PG8_STAGE(PG8_SA(0, 1), cA + hstep, voffA);
        if (wr == 1) PG8_BAR;
        PG8_WAIT_V(4); PG8_BAR;
        PG8_STAGE(PG8_SB(1, 0), cB + kstep, voffB); PG8_STAGE(PG8_SA(1, 0), cA + kstep, voffA); PG8_STAGE(PG8_SB(1, 1), cB + hstep + kstep, voffB);
        PG8_WAIT_V(6); PG8_BAR;
    }
    for (;;) {
        const bool has_next = S.next(ui + 1, nxt);
        const char* nA = has_next ? (const char*)g.A + (size_t)nxt.pm * tstep : cA; const char* nB = has_next ? (const char*)g.Bt + (size_t)nxt.pn * tstep : cB;
        for (int t = 0; t < nt; t += 2) {
            const bool last = (t == nt - 2);
            const char* a1 = cA + (size_t)(t + 1) * kstep;
            const char* a2 = last ? nA : cA + (size_t)(t + 2) * kstep; const char* b2 = last ? nB : cB + (size_t)(t + 2) * kstep;
            const char* a3 = a2 + kstep; const char* b3 = b2 + kstep;
            if (last && has_next) S.a_ready(nxt);
            if constexpr (SP2) {
            PG8_LDB(B0, 0, 0); PG8_LDB(B1, 0, 1); PG8_SCHED; PG8_LDA(At, 0, 0); PG8_STAGE(PG8_SA(1, 1), a1 + hstep, voffA);
            PG8_WAIT_V(8); PG8_WAIT_L(0); PG8_BAR; PG8_MMA(0, 0, At, B0); PG8_MMA(0, 1, At, B1); PG8_BAR; PG8_SCHED;
            PG8_LDA(At, 0, 1); PG8_STAGE(PG8_SB(0, 0), b2, voffB); PG8_STAGE(PG8_SB(0, 1), b2 + hstep, voffB); PG8_STAGE(PG8_SA(0, 0), a2, voffA);
            PG8_WAIT_V(8); PG8_WAIT_L(0); PG8_BAR; PG8_MMA(1, 0, At, B0); PG8_MMA(1, 1, At, B1); PG8_BAR; PG8_SCHED;
            PG8_LDB(B0, 1, 0); PG8_LDB(B1, 1, 1); PG8_SCHED; PG8_LDA(At, 1, 0); PG8_STAGE(PG8_SA(0, 1), a2 + hstep, voffA);
            PG8_WAIT_V(8); PG8_WAIT_L(0); PG8_BAR; PG8_MMA(0, 0, At, B0); PG8_MMA(0, 1, At, B1); PG8_BAR; PG8_SCHED;
            PG8_LDA(At, 1, 1); PG8_STAGE(PG8_SB(1, 0), b3, voffB); PG8_STAGE(PG8_SB(1, 1), b3 + hstep, voffB); PG8_STAGE(PG8_SA(1, 0), a3, voffA);
            PG8_WAIT_V(8); PG8_WAIT_L(0); PG8_BAR; PG8_MMA(1, 0, At, B0); PG8_MMA(1, 1, At, B1); PG8_BAR; PG8_SCHED;
            } else {
            PG8_LDB(B0, 0, 0); PG8_SCHED; PG8_LDA(At, 0, 0); PG8_STAGE(PG8_SA(1, 1), a1 + hstep, voffA);
            PG8_WAIT_L(8); PG8_BAR; PG8_WAIT_L(0); PG8_MMA(0, 0, At, B0); PG8_BAR; PG8_SCHED;
            PG8_LDB(B1, 0, 1); PG8_STAGE(PG8_SB(0, 0), b2, voffB);
            PG8_BAR; PG8_WAIT_L(0); PG8_MMA(0, 1, At, B1); PG8_BAR;
            PG8_LDA(At, 0, 1); PG8_STAGE(PG8_SA(0, 0), a2, voffA);
            PG8_BAR; PG8_WAIT_L(0); PG8_MMA(1, 0, At, B0); PG8_BAR; PG8_SCHED;
            PG8_STAGE(PG8_SB(0, 1), b2 + hstep, voffB);
            PG8_WAIT_V(6); PG8_BAR; PG8_MMA(1, 1, At, B1); PG8_BAR;
            PG8_LDB(B0, 1, 0); PG8_SCHED; PG8_LDA(At, 1, 0); PG8_STAGE(PG8_SA(0, 1), a2 + hstep, voffA);
            PG8_WAIT_L(8); PG8_BAR; PG8_WAIT_L(0); PG8_MMA(0, 0, At, B0); PG8_BAR; PG8_SCHED;
            PG8_LDB(B1, 1, 1); PG8_STAGE(PG8_SB(1, 0), b3, voffB);
            PG8_BAR; PG8_WAIT_L(0); PG8_MMA(0, 1, At, B1); PG8_BAR;
            PG8_LDA(At, 1, 1); PG8_STAGE(PG8_SA(1, 0), a3, voffA);
            PG8_BAR; PG8_WAIT_L(0); PG8_MMA(1, 0, At, B0); PG8_BAR; PG8_SCHED;
            PG8_STAGE(PG8_SB(1, 1), b3 + hstep, voffB);
            PG8_WAIT_V(6); PG8_BAR; PG8_MMA(1, 1, At, B1); PG8_BAR;
            }
        }
        if constexpr (ALIGN_EPI) { if (wr == 0) PG8_BAR; }
        E(acc, cur, wr, wc, fr, fq); S.done(cur);
        if (!has_next) break;
#pragma unroll
        for (int a = 0; a < 2; ++a)
#pragma unroll
            for (int b = 0; b < 2; ++b)
#pragma unroll
                for (int m = 0; m < 4; ++m)
#pragma unroll
                    for (int n = 0; n < 2; ++n) acc[a][b][m][n] = (f32x4){0.f, 0.f, 0.f, 0.f};
        cur = nxt; cA = nA; cB = nB; ++ui;
        if constexpr (ALIGN_EPI) { if (wr == 1) PG8_BAR; }
    }
    PG8_WAIT_V(0);
    if constexpr (!ALIGN_EPI) { if (wr == 0) PG8_BAR; }
    PG8_BAR;
#undef PG8_SA
#undef PG8_SB
#undef PG8_STAGE
#undef PG8_LDA
#undef PG8_LDB
#undef PG8_MMA
#undef PG8_WAIT_V
#undef PG8_WAIT_L
#undef PG8_BAR
#undef PG8_SCHED
}
}

constexpr int NWAVES = 8;
constexpr int DM = 1024, NTOK = 16384, NCTX = 8192, D_IN = 1792, NMODV = 9, MODW = 6144;
constexpr int SEQ_C = 256, SEQ_L = 1024, NSEQ_C = 32, NSEQ_L = 8;
constexpr int N_PHASES = 8;
constexpr float LOG2E = 1.4426950408889634f;
constexpr float QSCALE = 0.125f * LOG2E;
constexpr float EPS = 1e-6f;

constexpr size_t MiB = 1u << 20, KiB = 1u << 10;
constexpr size_t WS_CTL = 0, CTL_ZERO_BYTES = 64 * KiB;
constexpr size_t WS_MODS = 1 * MiB;
constexpr size_t WS_ROPE = 1 * MiB + 256 * KiB;
constexpr size_t WS_RGW  = 1 * MiB + 512 * KiB;
constexpr size_t WS_CK   = 1 * MiB + 768 * KiB;
constexpr size_t WS_CVT  = 2 * MiB + 256 * KiB;
constexpr size_t WS_WIN  = 3 * MiB;
constexpr size_t WS_WOUT = 7 * MiB;
constexpr size_t WS_WC   = 9 * MiB;
constexpr size_t WS_U    = 16 * MiB;
constexpr size_t WS_SU   = 13 * MiB;
constexpr size_t WS_SV   = 13 * MiB + 64 * KiB;
constexpr size_t WS_V    = 48 * MiB;
constexpr size_t WS_H    = 80 * MiB;
constexpr size_t WS_MIX  = 112 * MiB;
constexpr size_t WS_Q    = 144 * MiB;
constexpr size_t WS_K    = 160 * MiB;
constexpr size_t WS_VT   = 164 * MiB;
constexpr size_t WS_XR   = 168 * MiB;
constexpr size_t WS_YG   = 184 * MiB;
constexpr size_t WS_HF   = 200 * MiB;
constexpr size_t WS_SC   = 144 * MiB;
constexpr size_t WS_END  = 232 * MiB;
constexpr int VT_LAT_OFF = NSEQ_C * 2 * 64 * SEQ_C;

constexpr int CW_BAR = 4096;

constexpr int RING_BYTES = 131072;
constexpr int LDSCTL_OFF = 146944, MISC_OFF = LDSCTL_OFF + 320;
constexpr int LDS_BYTES = 147456;

#define GAS __attribute__((address_space(1)))
#define LAS __attribute__((address_space(3)))
typedef unsigned short bf16;
typedef unsigned v4u __attribute__((ext_vector_type(4)));
typedef unsigned v2u __attribute__((ext_vector_type(2)));
typedef float f32x4 __attribute__((ext_vector_type(4)));
typedef float f32x2 __attribute__((ext_vector_type(2)));
typedef float f32x16 __attribute__((ext_vector_type(16)));
typedef short bf16x8 __attribute__((ext_vector_type(8)));
typedef GAS unsigned gu32;
#define RLX_AGENT __ATOMIC_RELAXED, __HIP_MEMORY_SCOPE_AGENT

__device__ __forceinline__ unsigned f2bf(float f) { unsigned u = __builtin_bit_cast(unsigned, f); return (u + 0x7fffu + ((u >> 16) & 1u)) >> 16; }
__device__ __forceinline__ unsigned pk2(float lo, float hi) { return f2bf(lo) | (f2bf(hi) << 16); }
__device__ __forceinline__ float bf2f(unsigned b) { return __builtin_bit_cast(float, b << 16); }
__device__ __forceinline__ float bflo(unsigned w) { return __builtin_bit_cast(float, w << 16); }
__device__ __forceinline__ float bfhi(unsigned w) { return __builtin_bit_cast(float, w & 0xffff0000u); }
__device__ __forceinline__ float sigmoidf_(float x) { return 1.f / (1.f + __expf(-x)); }
__device__ __forceinline__ float gelu_tanh(float x) { const float y = 0.7978845608028654f * (x + 0.044715f * x * x * x); const float e = __expf(2.f * y); return 0.5f * x * (2.f - 2.f / (1.f + e)); }
__device__ __forceinline__ float wave_sum(float v) {
#pragma unroll
    for (int o = 1; o < 64; o <<= 1) v += __shfl_xor(v, o);
    return v;
}
__device__ __forceinline__ unsigned wave_max_u32(unsigned v) {
#pragma unroll
    for (int o = 1; o < 64; o <<= 1) { const unsigned t = (unsigned)__shfl_xor((int)v, o); v = t > v ? t : v; }
    return v;
}
__device__ __forceinline__ int crow(int r, int hi) { return (r & 3) + 8 * (r >> 2) + 4 * hi; }

#define XB_TMO      128
#define XB_XCNT(j)  (256  + 64 * (j))
#define XB_XSUB(j)  (1280 + 64 * (j))
#define XB_XGEN(j)  (2304 + 64 * (j))
#define XB_TOP      3328
#define XB_TOPGEN   3392
#define XCD_BAR_WORDS 3456
#define XB_SPIN_CAP (1u << 18)
__device__ __forceinline__ unsigned xb_ld(unsigned* p)              { return __hip_atomic_load(p, __ATOMIC_RELAXED, __HIP_MEMORY_SCOPE_AGENT); }
__device__ __forceinline__ unsigned xb_add(unsigned* p, unsigned v) { return __hip_atomic_fetch_add(p, v, __ATOMIC_RELAXED, __HIP_MEMORY_SCOPE_AGENT); }
__device__ __forceinline__ unsigned xb_xcc_id() { return (unsigned)__builtin_amdgcn_s_getreg((3 << 11) | 20) & 0xFu; }
#define XB_SPIN(cond, bar) do { unsigned _sp = 0; while (cond) { __builtin_amdgcn_s_sleep(1); \
    if ((++_sp & 255u) == 0u) { if (xb_ld(&(bar)[XB_TMO])) break; if (_sp > XB_SPIN_CAP) { atomicAdd(&(bar)[XB_TMO], 1u); break; } } } } while (0)
struct XcdBarrier { unsigned* bar; unsigned x; volatile LAS unsigned* st; };
__device__ __forceinline__ XcdBarrier xcd_barrier_post(unsigned* bar, volatile LAS unsigned* st) {
    XcdBarrier b; b.bar = bar; b.x = xb_xcc_id(); b.st = st;
    if (threadIdx.x == 0) (void)xb_add(&bar[XB_XCNT(b.x)], 1u);
    return b;
}
__device__ __forceinline__ void xcd_barrier_complete(unsigned* bar, unsigned x, unsigned& nloc, unsigned& nx) {
    const unsigned G = gridDim.x * gridDim.y * gridDim.z;
    unsigned sum, cnt, mine, sp = 0u;
    for (;;) {
        sum = 0u; cnt = 0u; mine = 0u;
#pragma unroll
        for (unsigned j = 0; j < 16; ++j) { const unsigned c = xb_ld(&bar[XB_XCNT(j)]); sum += c; cnt += (c > 0u) ? 1u : 0u; mine = (j == x) ? c : mine; }
        if (sum == G) break;
        __builtin_amdgcn_s_sleep(1);
        if ((++sp & 255u) == 0u) { if (xb_ld(&bar[XB_TMO])) break; if (sp > XB_SPIN_CAP) { atomicAdd(&bar[XB_TMO], 1u); break; } }
    }
    nloc = mine > 0u ? mine : 1u; nx = cnt > 0u ? cnt : 1u;
}
__device__ __forceinline__ void xcd_barrier(const XcdBarrier& b) {
    asm volatile("s_waitcnt vmcnt(0)" ::: "memory");
    __syncthreads();
    if (threadIdx.x == 0) {
        unsigned* bar = b.bar;
        __builtin_amdgcn_s_waitcnt(0);
        unsigned nloc = b.st[0], nx = b.st[1];
        if (nloc == 0u) { xcd_barrier_complete(bar, b.x, nloc, nx); b.st[0] = nloc; b.st[1] = nx; }
        const unsigned old = xb_add(&bar[XB_XSUB(b.x)], 1u);
        const unsigned gen = old / nloc;
        if (old + 1u == (gen + 1u) * nloc) {
            __builtin_amdgcn_fence(__ATOMIC_RELEASE, "agent");
            asm volatile("s_waitcnt vmcnt(0)" ::: "memory");
            const unsigned og = xb_add(&bar[XB_TOP], 1u);
            const unsigned tg = og / nx;
            if (og + 1u == (tg + 1u) * nx) xb_add(&bar[XB_TOPGEN], 1u);
            else XB_SPIN(xb_ld(&bar[XB_TOPGEN]) == tg, bar);
            __builtin_amdgcn_fence(__ATOMIC_ACQUIRE, "agent");
            xb_add(&bar[XB_XGEN(b.x)], 1u);
            asm volatile("s_waitcnt vmcnt(0)" ::: "memory");
        } else {
            XB_SPIN(xb_ld(&bar[XB_XGEN(b.x)]) == gen, bar);
            __builtin_amdgcn_fence(__ATOMIC_ACQUIRE, "agent");
            asm volatile("s_waitcnt vmcnt(0)" ::: "memory");
        }
    }
    __syncthreads();
}

struct Args { const float* in[26]; float* out; unsigned char* ws; int ph_lo, ph_hi, li, pad; };

struct Frame {
    unsigned char* lds;
    int tid, lane, wave, vcu, G;
    const float* const* in;
    float* out; unsigned char* ws;
};
enum { I_XP = 0, I_XS, I_CK, I_CV, I_SRNN, I_C, I_CCTX, I_WMOD, I_BMOD, I_GMIX, I_GFFN, I_WIN, I_CONVW, I_CONVB, I_RGWA, I_RGBA, I_RGWI, I_RGBI, I_RGLAM, I_SINK, I_WOUT, I_PWQ, I_PSK, I_PU, I_PV, I_GFINAL };
constexpr size_t O_Y = 0, O_NEWK = (size_t)NTOK * DM, O_NEWV = O_NEWK + (size_t)NCTX * 128, O_NEWRNN = O_NEWV + (size_t)NCTX * 128;

__device__ __forceinline__ int mod_index(int tok) { return tok < NCTX ? 0 : 1 + ((tok - NCTX) >> 10); }
__device__ __forceinline__ const float* x_row(const Frame& F, int tok) { return tok < NCTX ? F.in[I_XP] + (size_t)tok * DM : F.in[I_XS] + (size_t)(tok - NCTX) * DM; }

template <class RowMap>
__device__ __forceinline__ void p0_transpose_item(const float* W, int K, int N, bf16* WT, float* scr, int item, int lane, RowMap rowmap) {
    const int nblk = N / 32, kb = item / nblk, nb = item % nblk, k0 = 64 * kb, n0 = 32 * nb;
#pragma unroll 8
    for (int i = 0; i < 32; ++i) { const int kk = 2 * i + (lane >> 5); scr[kk * 33 + (lane & 31)] = W[(size_t)(k0 + kk) * N + n0 + (lane & 31)]; }
    __builtin_amdgcn_s_waitcnt(0xC07F); asm volatile("" ::: "memory");
    const int c = lane & 7;
#pragma unroll
    for (int j = 0; j < 4; ++j) { const int n = (lane >> 3) + 8 * j; const float* s = scr + (8 * c) * 33 + n;
        v4u o; o.x = pk2(s[0 * 33], s[1 * 33]); o.y = pk2(s[2 * 33], s[3 * 33]); o.z = pk2(s[4 * 33], s[5 * 33]); o.w = pk2(s[6 * 33], s[7 * 33]);
        *(v4u*)(WT + (size_t)rowmap(n0 + n) * K + k0 + 8 * c) = o; }
    __builtin_amdgcn_s_waitcnt(0xC07F); asm volatile("" ::: "memory");
}
struct MapId { __device__ __forceinline__ int operator()(int n) const { return n; } };
struct MapWin { __device__ __forceinline__ int operator()(int n) const { if (n >= 640) return n; const int hb = n & ~63, o = n & 63; return hb + ((o & 31) << 1) + (o >> 5); } };

__device__ __forceinline__ void p0_phase(Frame& F) {
    float* ldsf = (float*)F.lds;
    const int tid = F.tid, lane = F.lane, wave = F.wave, v = F.vcu;
    if (v < 192) {
        for (int i = tid; i < NMODV * DM; i += 512) { const int j = i >> 10, d = i & 1023; const float c = (j == 0) ? F.in[I_CCTX][d] : F.in[I_C][(j - 1) * DM + d]; ldsf[i] = c * sigmoidf_(c); }
        __syncthreads();
        const int e0 = 32 * v, c4 = tid & 7, kq = tid >> 3;
        float acc[NMODV][4];
#pragma unroll
        for (int j = 0; j < NMODV; ++j) { acc[j][0] = 0.f; acc[j][1] = 0.f; acc[j][2] = 0.f; acc[j][3] = 0.f; }
        const float* wm = F.in[I_WMOD] + e0 + 4 * c4;
#pragma unroll 4
        for (int kk = 0; kk < 16; ++kk) { const int k = kq * 16 + kk; const f32x4 w = *(const f32x4*)(wm + (size_t)k * MODW);
#pragma unroll
            for (int j = 0; j < NMODV; ++j) { const float s = ldsf[j * DM + k]; acc[j][0] += s * w[0]; acc[j][1] += s * w[1]; acc[j][2] += s * w[2]; acc[j][3] += s * w[3]; } }
#pragma unroll
        for (int j = 0; j < NMODV; ++j)
#pragma unroll
            for (int i = 0; i < 4; ++i) { float a = acc[j][i]; a += __shfl_xor(a, 8); a += __shfl_xor(a, 16); a += __shfl_xor(a, 32); acc[j][i] = a; }
        float* red = ldsf + NMODV * DM;
        if (lane < 8) {
#pragma unroll
            for (int j = 0; j < NMODV; ++j)
#pragma unroll
                for (int i = 0; i < 4; ++i) red[(wave * NMODV + j) * 32 + 4 * c4 + i] = acc[j][i];
        }
        __syncthreads();
        if (tid < NMODV * 32) { const int j = tid >> 5, col = tid & 31; float s = F.in[I_BMOD][e0 + col];
#pragma unroll
            for (int w = 0; w < 8; ++w) s += red[(w * NMODV + j) * 32 + col];
            ((float*)(F.ws + WS_MODS))[j * MODW + e0 + col] = s; }
        __syncthreads();
    }
    if (v < 256) {
        const int hh = v >> 4, dt = v & 15, d0 = 64 * dt;
        float* At = ldsf;
        float* Bkt = ldsf + 128 * 64;
        const float* wq = F.in[I_PWQ] + hh * 128;
        const float* sk = F.in[I_PSK] + (size_t)hh * 128 * 128;
#pragma unroll
        for (int i = 0; i < 4; ++i) { const int f = tid + 512 * i, d = f & 63, q4 = f >> 6; const f32x4 a = *(const f32x4*)(wq + (size_t)(d0 + d) * 2048 + 4 * q4);
            At[(4 * q4 + 0) * 64 + d] = a[0]; At[(4 * q4 + 1) * 64 + d] = a[1]; At[(4 * q4 + 2) * 64 + d] = a[2]; At[(4 * q4 + 3) * 64 + d] = a[3]; }
#pragma unroll
        for (int i = 0; i < 8; ++i) { const int f = tid + 512 * i, key = f & 127, q4 = f >> 7; const f32x4 b = *(const f32x4*)(sk + (size_t)key * 128 + 4 * q4);
            Bkt[(4 * q4 + 0) * 128 + key] = b[0]; Bkt[(4 * q4 + 1) * 128 + key] = b[1]; Bkt[(4 * q4 + 2) * 128 + key] = b[2]; Bkt[(4 * q4 + 3) * 128 + key] = b[3]; }
        __syncthreads();
        const int dg = tid & 15, kg = tid >> 4;
        float acc[4][4];
#pragma unroll
        for (int i = 0; i < 4; ++i)
#pragma unroll
            for (int j = 0; j < 4; ++j) acc[i][j] = 0.f;
#pragma unroll 4
        for (int q = 0; q < 128; ++q) { const f32x4 a = *(const f32x4*)(At + q * 64 + 4 * dg); const f32x4 b = *(const f32x4*)(Bkt + q * 128 + 4 * kg);
#pragma unroll
            for (int i = 0; i < 4; ++i)
#pragma unroll
                for (int j = 0; j < 4; ++j) acc[i][j] += a[i] * b[j]; }
        bf16* WcT = (bf16*)(F.ws + WS_WC);
#pragma unroll
        for (int j = 0; j < 4; ++j) { v2u o; o.x = pk2(acc[0][j], acc[1][j]); o.y = pk2(acc[2][j], acc[3][j]);
            *(v2u*)(WcT + (size_t)(hh * 128 + 4 * kg + j) * DM + d0 + 4 * dg) = o; }
        __syncthreads();
    }
    const int gw = v * NWAVES + wave, NGW = F.G * NWAVES;
    float* scr = ldsf + wave * 4096;
    {
        constexpr int I_IN = (DM / 64) * (D_IN / 32), I_OUT = (DM / 64) * (DM / 32), I_RG = 32 * 2;
        constexpr int NIT = I_IN + I_OUT + I_RG;
        for (int it = gw; it < NIT; it += NGW) {
            int r = it;
            if (r < I_IN) { p0_transpose_item(F.in[I_WIN], DM, D_IN, (bf16*)(F.ws + WS_WIN), scr, r, lane, MapWin()); continue; } r -= I_IN;
            if (r < I_OUT) { p0_transpose_item(F.in[I_WOUT], DM, DM, (bf16*)(F.ws + WS_WOUT), scr, r, lane, MapId()); continue; } r -= I_OUT;
            { const int mm = r >> 1, sub = r & 1, dir = mm >> 4, n = (mm >> 1) & 7, gate = mm & 1;
              const float* src = (gate ? F.in[I_RGWI] : F.in[I_RGWA]) + (size_t)(dir * 8 + n) * 4096;
              bf16* dst = (bf16*)(F.ws + WS_RGW) + (size_t)((dir * 8 + n) * 2 + gate) * 4096;
              p0_transpose_item(src, 64, 64, dst, scr, sub, lane, MapId()); }
        }
    }
    for (int it = gw; it < 2 * 16384; it += NGW) {
        const int tb = it >> 14, row = it & 16383;
        const float* src = (tb ? F.in[I_PV] : F.in[I_PU]) + (size_t)row * DM + 16 * lane;
        f32x4 a[4]; float am = 0.f;
#pragma unroll
        for (int j = 0; j < 4; ++j) { a[j] = *(const f32x4*)(src + 4 * j); am = fmaxf(am, fmaxf(fmaxf(fabsf(a[j][0]), fabsf(a[j][1])), fmaxf(fabsf(a[j][2]), fabsf(a[j][3])))); }
#pragma unroll
        for (int o = 1; o < 64; o <<= 1) am = fmaxf(am, __shfl_xor(am, o));
        const float inv = am > 0.f ? 127.f / am : 0.f;
        v4u o4;
#pragma unroll
        for (int j = 0; j < 4; ++j) { unsigned w = 0;
#pragma unroll
            for (int i = 0; i < 4; ++i) { int q = (int)rintf(a[j][i] * inv); q = q > 127 ? 127 : (q < -127 ? -127 : q); w |= ((unsigned)q & 0xffu) << (8 * i); }
            o4[j] = w; }
        *(v4u*)(F.ws + (tb ? WS_V : WS_U) + (size_t)row * DM + 16 * lane) = o4;
        if (lane == 0) ((float*)(F.ws + (tb ? WS_SV : WS_SU)))[row] = am * (1.f / 127.f);
    }
    const int gt = v * 512 + tid, NGT = F.G * 512;
    for (int e = gt; e < 8 * 256 * 128; e += NGT) {
        const int c = e & 127, bp = e >> 7, kvh = c >> 6, p = c & 63, old = (p & 1) ? 32 + (p >> 1) : (p >> 1);
        ((bf16*)(F.ws + WS_CK))[e] = (bf16)f2bf(F.in[I_CK][(size_t)bp * 128 + kvh * 64 + old]);
    }
    for (int e = gt; e < 8 * 256 * 128; e += NGT) {
        const int pos = e & 255, d = (e >> 8) & 63, kvh = (e >> 14) & 1, b = e >> 15;
        ((bf16*)(F.ws + WS_CVT))[e] = (bf16)f2bf(F.in[I_CV][(size_t)(b * 256 + pos) * 128 + kvh * 64 + d]);
    }
    for (int e = gt; e < 1024 * 32; e += NGT) {
        const int s = e >> 5, i = e & 31, row = s >> 6, col = s & 63;
        const float inv = powf(10000.0f, -(float)(i & 15) / 16.0f);
        const float ang = (i < 16 ? (float)row : (float)col) * inv;
        f32x2 cs; cs.x = cosf(ang); cs.y = sinf(ang);
        ((f32x2*)(F.ws + WS_ROPE))[e] = cs;
    }
}

__device__ __forceinline__ void norm_phase(Frame& F, int which) {
    const int gw = F.vcu * NWAVES + F.wave, NGW = F.G * NWAVES, lane = F.lane;
    const float* mods = (const float*)(F.ws + WS_MODS);
    const float* g = F.in[which ? I_GFFN : I_GMIX];
    bf16* H = (bf16*)(F.ws + WS_H);
    for (int tok = gw; tok < NTOK; tok += NGW) {
        const float* xr = which ? F.out + O_Y + (size_t)tok * DM : x_row(F, tok);
        const float* mv = mods + (size_t)mod_index(tok) * MODW + (which ? 3 * DM : 0);
        f32x4 v[4]; float ss = 0.f;
#pragma unroll
        for (int j = 0; j < 4; ++j) { v[j] = *(const f32x4*)(xr + 256 * j + 4 * lane); ss += (v[j][0] * v[j][0] + v[j][1] * v[j][1]) + (v[j][2] * v[j][2] + v[j][3] * v[j][3]); }
        const float rstd = 1.f / sqrtf(wave_sum(ss) * (1.f / DM) + EPS);
#pragma unroll
        for (int j = 0; j < 4; ++j) { const int e = 256 * j + 4 * lane;
            const f32x4 gg = *(const f32x4*)(g + e), sh = *(const f32x4*)(mv + e), sc = *(const f32x4*)(mv + DM + e);
            f32x4 o;
#pragma unroll
            for (int i = 0; i < 4; ++i) o[i] = v[j][i] * rstd * gg[i] * (1.f + sc[i]) + sh[i];
            v2u w; w.x = pk2(o[0], o[1]); w.y = pk2(o[2], o[3]); *(v2u*)(H + (size_t)tok * DM + e) = w; }
    }
}

struct EpiInProj {
    static constexpr bool PERM = false;
    bf16 *q, *k, *vT, *xr, *yg; float *newk, *newv; const f32x4* rope4;
    __device__ __forceinline__ void operator()(const f32x4 (&acc)[2][2][4][2], const pg8::Unit& u, int wr, int wc, int fr, int fq) const {
        const bool lat = u.pm >= 32;
        const int pn = u.pn;
#pragma unroll
        for (int ai = 0; ai < 2; ++ai)
#pragma unroll
            for (int m = 0; m < 4; ++m) {
                const int row = u.pm * 256 + ai * 128 + wr * 64 + m * 16 + fr;
                const int pos = lat ? ((row - NCTX) & 1023) : (row & 255);
#pragma unroll
                for (int bj = 0; bj < 2; ++bj)
#pragma unroll
                    for (int n = 0; n < 2; ++n) {
                        const int c = pn * 256 + bj * 128 + wc * 32 + n * 16 + 4 * fq;
                        f32x4 v = acc[ai][bj][m][n];
                        if (pn < 2 || (pn == 2 && bj == 0)) {
                            const int i = (c & 63) >> 1;
                            if (lat) { const f32x4 cs = rope4[(pos * 32 + i) >> 1];
                                const float a0 = v[0] * cs[0] - v[1] * cs[1], a1 = v[1] * cs[0] + v[0] * cs[1];
                                const float b0 = v[2] * cs[2] - v[3] * cs[3], b1 = v[3] * cs[2] + v[2] * cs[3];
                                v[0] = a0; v[1] = a1; v[2] = b0; v[3] = b1; }
                            if (pn < 2) { v2u w; w.x = pk2(v[0] * QSCALE, v[1] * QSCALE); w.y = pk2(v[2] * QSCALE, v[3] * QSCALE); *(v2u*)(q + (size_t)row * 512 + c) = w; }
                            else { const int kc = c - 512; v2u w; w.x = pk2(v[0], v[1]); w.y = pk2(v[2], v[3]); *(v2u*)(k + (size_t)row * 128 + kc) = w;
                                if (!lat) { float* nk = newk + (size_t)row * 128 + (kc & 64) + i; f32x2 lo; lo.x = v[0]; lo.y = v[2]; f32x2 hi; hi.x = v[1]; hi.y = v[3]; *(f32x2*)nk = lo; *(f32x2*)(nk + 32) = hi; } }
                        } else if (pn == 2) {
                            const int vc = c - 640, kvh = vc >> 6, d = vc & 63;
                            if (!lat) *(f32x4*)(newv + (size_t)row * 128 + vc) = v;
                            bf16* vp; int S;
                            if (!lat) { S = SEQ_C; vp = vT + ((size_t)((row >> 8) * 2 + kvh) * 64 + d) * SEQ_C + pos; }
                            else { S = SEQ_L; vp = vT + VT_LAT_OFF + ((size_t)(((row - NCTX) >> 10) * 2 + kvh) * 64 + d) * SEQ_L + pos; }
                            vp[0] = (bf16)f2bf(v[0]); vp[S] = (bf16)f2bf(v[1]); vp[2 * S] = (bf16)f2bf(v[2]); vp[3 * S] = (bf16)f2bf(v[3]);
                        } else if (pn < 5) {
                            v2u w; w.x = pk2(v[0], v[1]); w.y = pk2(v[2], v[3]); *(v2u*)(xr + (size_t)row * 512 + (c - 768)) = w;
                        } else {
                            v2u w; w.x = pk2(v[0], v[1]); w.y = pk2(v[2], v[3]); *(v2u*)(yg + (size_t)row * 512 + (c - 1280)) = w;
                        }
                    }
            }
    }
};
struct EpiOutProj {
    static constexpr bool PERM = false;
    const float *xp, *xs, *mods; float* x1;
    __device__ __forceinline__ void operator()(const f32x4 (&acc)[2][2][4][2], const pg8::Unit& u, int wr, int wc, int fr, int fq) const {
        const int mi = u.pm < 32 ? 0 : 1 + ((u.pm - 32) >> 2);
        const float* ga = mods + (size_t)mi * MODW + 2 * DM;
#pragma unroll
        for (int ai = 0; ai < 2; ++ai)
#pragma unroll
            for (int m = 0; m < 4; ++m) {
                const int row = u.pm * 256 + ai * 128 + wr * 64 + m * 16 + fr;
                const float* xrow = row < NCTX ? xp + (size_t)row * DM : xs + (size_t)(row - NCTX) * DM;
#pragma unroll
                for (int bj = 0; bj < 2; ++bj)
#pragma unroll
                    for (int n = 0; n < 2; ++n) {
                        const int c = u.pn * 256 + bj * 128 + wc * 32 + n * 16 + 4 * fq;
                        const f32x4 xv = *(const f32x4*)(xrow + c), gv = *(const f32x4*)(ga + c);
                        *(f32x4*)(x1 + (size_t)row * DM + c) = xv + gv * acc[ai][bj][m][n];
                    }
            }
    }
};
struct EpiScores {
    static constexpr bool PERM = true;
    bf16* sc;
    __device__ __forceinline__ void operator()(const f32x4 (&acc)[2][2][4][2], const pg8::Unit& u, int wr, int wc, int fr, int fq) const {
#pragma unroll
        for (int ai = 0; ai < 2; ++ai)
#pragma unroll
            for (int m = 0; m < 4; ++m) {
                const int row = u.pm * 256 + ai * 128 + wr * 64 + m * 16 + fr;
#pragma unroll
                for (int bj = 0; bj < 2; ++bj) {
                    const int c = u.pn * 256 + bj * 128 + wc * 32 + 8 * fq;
                    const f32x4 v0 = acc[ai][bj][m][0], v1 = acc[ai][bj][m][1];
                    v4u w; w.x = pk2(v0[0], v0[1]); w.y = pk2(v0[2], v0[3]); w.z = pk2(v1[0], v1[1]); w.w = pk2(v1[2], v1[3]);
                    *(v4u*)(sc + (size_t)row * 2048 + c) = w;
                }
            }
    }
};

__device__ __forceinline__ void attn_unit(Frame& F, bool lat, int seq, int kvh, int qt) {
    const int tid = F.tid, lane = F.lane, wave = F.wave, r32 = lane & 31, hi = lane >> 5;
    const int g = wave >> 1, qs = wave & 1, head = kvh * 4 + g;
    const int S = lat ? SEQ_L : SEQ_C, tokbase = lat ? NCTX + seq * SEQ_L : seq * SEQ_C;
    const int q0 = qt * 64, qpos = q0 + 32 * qs + r32;
    const bf16* Q = (const bf16*)(F.ws + WS_Q); const bf16* Kb = (const bf16*)(F.ws + WS_K); const bf16* VT = (const bf16*)(F.ws + WS_VT);
    const bf16* CK = (const bf16*)(F.ws + WS_CK); const bf16* CVT = (const bf16*)(F.ws + WS_CVT);
    unsigned char* ldsK = F.lds; unsigned char* ldsV = F.lds + 8192;
    bf16x8 qf[4];
    { const bf16* qp = Q + (size_t)(tokbase + qpos) * 512 + head * 64;
#pragma unroll
      for (int ks = 0; ks < 4; ++ks) qf[ks] = *(const bf16x8*)(qp + 16 * ks + 8 * hi); }
    const float sinkl = F.in[I_SINK][head] * LOG2E;
    float mrun = sinkl, lrun = (hi == 0) ? 1.f : 0.f;
    f32x16 o0, o1;
#pragma unroll
    for (int r = 0; r < 16; ++r) { o0[r] = 0.f; o1[r] = 0.f; }
    int tlo, thi;
    if (lat) { tlo = (q0 >= 128 ? q0 - 128 : 0) >> 6; thi = ((q0 + 192 < S ? q0 + 192 : S)) >> 6; } else { tlo = 0; thi = 4; }
    const int nband = thi - tlo, ntile = nband + (lat ? 4 : 0);
    const int key_t = tid >> 3, ch_t = tid & 7;
    for (int t = 0; t < ntile; ++t) {
        const bool band = t < nband;
        const bf16* kptr; const bf16* vptr; int vstride; int kbase = 0;
        if (band) { const int tile = tlo + t; kbase = tile * 64;
            kptr = Kb + (size_t)(tokbase + kbase) * 128 + kvh * 64;
            vptr = VT + (lat ? (size_t)VT_LAT_OFF + (size_t)((seq * 2 + kvh) * 64) * SEQ_L : (size_t)((seq * 2 + kvh) * 64) * SEQ_C) + kbase; vstride = S;
        } else { const int tc = t - nband;
            kptr = CK + (size_t)(seq * 256 + tc * 64) * 128 + kvh * 64;
            vptr = CVT + (size_t)((seq * 2 + kvh) * 64) * 256 + tc * 64; vstride = 256; }
        const v4u kv = *(const v4u*)(kptr + (size_t)key_t * 128 + ch_t * 8);
        const v4u vv = *(const v4u*)(vptr + (size_t)key_t * vstride + ch_t * 8);
        __syncthreads();
        *(v4u*)(ldsK + key_t * 128 + ((ch_t ^ (key_t & 7)) * 16)) = kv;
        *(v4u*)(ldsV + key_t * 128 + ((ch_t ^ (key_t & 7)) * 16)) = vv;
        __syncthreads();
        f32x16 p0, p1;
#pragma unroll
        for (int r = 0; r < 16; ++r) { p0[r] = 0.f; p1[r] = 0.f; }
#pragma unroll
        for (int ks = 0; ks < 4; ++ks) {
            const int sw = ((2 * ks + hi) ^ (r32 & 7)) * 16;
            const bf16x8 a0 = *(const bf16x8*)(ldsK + r32 * 128 + sw);
            const bf16x8 a1 = *(const bf16x8*)(ldsK + (32 + r32) * 128 + sw);
            p0 = __builtin_amdgcn_mfma_f32_32x32x16_bf16(a0, qf[ks], p0, 0, 0, 0);
            p1 = __builtin_amdgcn_mfma_f32_32x32x16_bf16(a1, qf[ks], p1, 0, 0, 0);
        }
        if (band && lat) {
#pragma unroll
            for (int r = 0; r < 16; ++r) { const int kp = kbase + crow(r, hi); int d0 = qpos - kp; d0 = d0 < 0 ? -d0 : d0; int d1 = qpos - kp - 32; d1 = d1 < 0 ? -d1 : d1;
                if (d0 > 128) p0[r] = -INFINITY; if (d1 > 128) p1[r] = -INFINITY; }
        }
        float tm = p0[0];
#pragma unroll
        for (int r = 1; r < 16; ++r) tm = fmaxf(tm, p0[r]);
#pragma unroll
        for (int r = 0; r < 16; ++r) tm = fmaxf(tm, p1[r]);
        tm = fmaxf(tm, __shfl_xor(tm, 32));
        const float mn = fmaxf(mrun, tm), alpha = exp2f(mrun - mn); mrun = mn;
        float ls = 0.f;
#pragma unroll
        for (int r = 0; r < 16; ++r) { p0[r] = exp2f(p0[r] - mn); p1[r] = exp2f(p1[r] - mn); ls += p0[r] + p1[r]; o0[r] *= alpha; o1[r] *= alpha; }
        lrun = lrun * alpha + ls;
        bf16x8 pf[4];
#pragma unroll
        for (int s = 0; s < 2; ++s) {
            v4u w0, w1;
            w0.x = pk2(p0[8 * s + 0], p0[8 * s + 1]); w0.y = pk2(p0[8 * s + 2], p0[8 * s + 3]); w0.z = pk2(p0[8 * s + 4], p0[8 * s + 5]); w0.w = pk2(p0[8 * s + 6], p0[8 * s + 7]);
            w1.x = pk2(p1[8 * s + 0], p1[8 * s + 1]); w1.y = pk2(p1[8 * s + 2], p1[8 * s + 3]); w1.z = pk2(p1[8 * s + 4], p1[8 * s + 5]); w1.w = pk2(p1[8 * s + 6], p1[8 * s + 7]);
            pf[s] = __builtin_bit_cast(bf16x8, w0); pf[2 + s] = __builtin_bit_cast(bf16x8, w1);
        }
#pragma unroll
        for (int s4 = 0; s4 < 4; ++s4) {
#pragma unroll
            for (int dt = 0; dt < 2; ++dt) {
                const int d = 32 * dt + r32;
                const v2u lo = *(const v2u*)(ldsV + d * 128 + (((2 * s4) ^ (d & 7)) * 16) + 8 * hi);
                const v2u hi2 = *(const v2u*)(ldsV + d * 128 + (((2 * s4 + 1) ^ (d & 7)) * 16) + 8 * hi);
                v4u vf4; vf4.x = lo.x; vf4.y = lo.y; vf4.z = hi2.x; vf4.w = hi2.y;
                const bf16x8 vf = __builtin_bit_cast(bf16x8, vf4);
                if (dt == 0) o0 = __builtin_amdgcn_mfma_f32_32x32x16_bf16(vf, pf[s4], o0, 0, 0, 0);
                else o1 = __builtin_amdgcn_mfma_f32_32x32x16_bf16(vf, pf[s4], o1, 0, 0, 0);
            }
        }
    }
    const float ltot = lrun + __shfl_xor(lrun, 32), inv = 1.f / ltot;
    bf16* mix = (bf16*)(F.ws + WS_MIX) + (size_t)(tokbase + qpos) * DM + head * 64;
#pragma unroll
    for (int g4 = 0; g4 < 4; ++g4) {
        v2u w; w.x = pk2(o0[4 * g4] * inv, o0[4 * g4 + 1] * inv); w.y = pk2(o0[4 * g4 + 2] * inv, o0[4 * g4 + 3] * inv);
        *(v2u*)(mix + 8 * g4 + 4 * hi) = w;
        v2u w2; w2.x = pk2(o1[4 * g4] * inv, o1[4 * g4 + 1] * inv); w2.y = pk2(o1[4 * g4 + 2] * inv, o1[4 * g4 + 3] * inv);
        *(v2u*)(mix + 32 + 8 * g4 + 4 * hi) = w2;
    }
    __syncthreads();
}

constexpr int RL_HALF = 49152;
constexpr int RL_XCB = 32768;
constexpr int RL_AGG = 98304;
constexpr int RL_CARRY = RL_AGG + 8192;
constexpr int RL_CW = RL_CARRY + 512;
constexpr int RL_WG = RL_CW + 1280;
static_assert(RL_WG + 32768 <= LDSCTL_OFF, "RNN LDS map");
__device__ __forceinline__ float fsigmoid(float x) { return __builtin_amdgcn_rcpf(1.f + __expf(-x)); }
__device__ __forceinline__ float gelu_fast(float x) { const float y = 0.7978845608028654f * (x + 0.044715f * x * x * x); const float e = __expf(2.f * y); return x - x * __builtin_amdgcn_rcpf(1.f + e); }

template <bool REV>
__device__ __forceinline__ void scan_prep(const float (&a)[16], const float (&b)[16], int h, float (&Apre)[4], float (&Bpre)[4], float& At, float& Bt) {
    float Ao[4], Bo[4], Ap[4], Bp[4];
#pragma unroll
    for (int g = 0; g < 4; ++g) { float A = 1.f, B = 0.f;
#pragma unroll
        for (int ii = 0; ii < 4; ++ii) { const int r = 4 * g + (REV ? 3 - ii : ii); B = a[r] * B + b[r]; A = a[r] * A; }
        Ao[g] = A; Bo[g] = B; }
#pragma unroll
    for (int g = 0; g < 4; ++g) { Ap[g] = __shfl_xor(Ao[g], 32); Bp[g] = __shfl_xor(Bo[g], 32); }
    const bool ownfirst = REV ? (h == 1) : (h == 0);
    float Ac = 1.f, Bc = 0.f;
#pragma unroll
    for (int gi = 0; gi < 4; ++gi) { const int g = REV ? 3 - gi : gi;
        const float A1 = ownfirst ? Ao[g] : Ap[g], B1 = ownfirst ? Bo[g] : Bp[g], A2 = ownfirst ? Ap[g] : Ao[g], B2 = ownfirst ? Bp[g] : Bo[g];
        const float Ac1 = A1 * Ac, Bc1 = A1 * Bc + B1;
        Apre[g] = ownfirst ? Ac : Ac1; Bpre[g] = ownfirst ? Bc : Bc1;
        Ac = A2 * Ac1; Bc = A2 * Bc1 + B2; }
    At = Ac; Bt = Bc;
}
template <bool REV>
__device__ __forceinline__ void scan_finish(const float (&a)[16], const float (&b)[16], const float (&Apre)[4], const float (&Bpre)[4], float hin, float* hp, int hi) {
#pragma unroll
    for (int g = 0; g < 4; ++g) { float hc = Apre[g] * hin + Bpre[g];
#pragma unroll
        for (int ii = 0; ii < 4; ++ii) { const int r = 4 * g + (REV ? 3 - ii : ii); hc = a[r] * hc + b[r]; hp[(size_t)crow(r, hi) * 512] = hc; } }
}

template <bool REV>
__device__ __forceinline__ void rnn_dir(Frame& F, bool lat, int seq, int n) {
    const int lane = F.lane, w4 = F.wave & 3, r32 = lane & 31, hi = lane >> 5, dirh = REV ? 1 : 0;
    const int S = lat ? SEQ_L : SEQ_C, tokbase = lat ? NCTX + seq * SEQ_L : seq * SEQ_C, nchunk = S / 128;
    unsigned char* hb = F.lds + dirh * RL_HALF;
    float* XC32 = (float*)hb; unsigned char* XCB = hb + RL_XCB;
    f32x2* AGG = (f32x2*)(F.lds + RL_AGG) + dirh * 256; float* CARRY = (float*)(F.lds + RL_CARRY) + dirh * 64; const float* CW = (const float*)(F.lds + RL_CW);
    const unsigned char* WG = F.lds + RL_WG + dirh * 16384;
    const bf16* XR = (const bf16*)(F.ws + WS_XR) + (size_t)tokbase * 512 + n * 64;
    float* HX = (float*)(F.ws + (REV ? WS_H : WS_HF)) + (size_t)tokbase * 512 + n * 64;
    const int t = F.tid & 255, c8 = t & 7, tg = t >> 3;
    float ba[2], bi[2], sp8[2];
#pragma unroll
    for (int chh = 0; chh < 2; ++chh) { const int pe = dirh * 512 + n * 64 + chh * 32 + r32; ba[chh] = F.in[I_RGBA][pe]; bi[chh] = F.in[I_RGBI][pe];
        const float nl = -F.in[I_RGLAM][pe]; sp8[chh] = 8.f * (nl > 20.f ? nl : log1pf(__expf(nl))); }
    v4u xin[7];
#define RL_XLOAD(c0_) do { _Pragma("unroll") for (int i = 0; i < 7; ++i) { const int pos = (c0_) + 4 * tg - 2 + i; \
        xin[i] = (pos >= 0 && pos < S) ? *(const v4u*)(XR + (size_t)pos * 512 + 8 * c8) : (v4u){0u, 0u, 0u, 0u}; } } while (0)
    RL_XLOAD((REV ? nchunk - 1 : 0) * 128);
    float newcarry[2] = {0.f, 0.f};
    const bool last_tile = REV ? (w4 == 0) : (w4 == 3);
#pragma unroll 1
    for (int k = 0; k < nchunk; ++k) {
        const int c0 = (REV ? nchunk - 1 - k : k) * 128;
        {
            const f32x4 b0 = *(const f32x4*)(CW + 256 + 8 * c8), b1 = *(const f32x4*)(CW + 256 + 8 * c8 + 4);
            f32x4 wt0[4], wt1[4];
#pragma unroll
            for (int tap = 0; tap < 4; ++tap) { wt0[tap] = *(const f32x4*)(CW + tap * 64 + 8 * c8); wt1[tap] = *(const f32x4*)(CW + tap * 64 + 8 * c8 + 4); }
#pragma unroll
            for (int i = 0; i < 4; ++i) {
                f32x4 y0 = b0, y1 = b1;
#pragma unroll
                for (int tap = 0; tap < 4; ++tap) { const v4u x = xin[i + tap];
                    y0[0] += wt0[tap][0] * bflo(x.x); y0[1] += wt0[tap][1] * bfhi(x.x); y0[2] += wt0[tap][2] * bflo(x.y); y0[3] += wt0[tap][3] * bfhi(x.y);
                    y1[0] += wt1[tap][0] * bflo(x.z); y1[1] += wt1[tap][1] * bfhi(x.z); y1[2] += wt1[tap][2] * bflo(x.w); y1[3] += wt1[tap][3] * bfhi(x.w); }
                const int tk = 4 * tg + i;
                *(f32x4*)(XC32 + tk * 64 + 8 * c8) = y0; *(f32x4*)(XC32 + tk * 64 + 8 * c8 + 4) = y1;
                v4u w; w.x = pk2(y0[0], y0[1]); w.y = pk2(y0[2], y0[3]); w.z = pk2(y1[0], y1[1]); w.w = pk2(y1[2], y1[3]);
                *(v4u*)(XCB + tk * 128 + ((c8 ^ (tk & 7)) * 16)) = w; }
        }
        if (k + 1 < nchunk) RL_XLOAD((REV ? nchunk - 2 - k : k + 1) * 128);
        __syncthreads();
        if (k > 0 && last_tile && hi == 0) { CARRY[r32] = newcarry[0]; CARRY[32 + r32] = newcarry[1]; }
        const int tkA = 32 * w4 + r32;
#pragma unroll
        for (int chh = 0; chh < 2; ++chh) {
            const int che = chh * 32 + r32;
            float av[16], bv[16], Apre[4], Bpre[4];
            {
                f32x16 ga, gi;
#pragma unroll
                for (int r = 0; r < 16; ++r) { ga[r] = 0.f; gi[r] = 0.f; }
#pragma unroll
                for (int ks = 0; ks < 4; ++ks) {
                    const bf16x8 af = *(const bf16x8*)(XCB + tkA * 128 + (((2 * ks + hi) ^ (tkA & 7)) * 16));
                    const bf16x8 wa = *(const bf16x8*)(WG + che * 128 + (((2 * ks + hi) ^ (che & 7)) * 16));
                    const bf16x8 wi = *(const bf16x8*)(WG + 8192 + che * 128 + (((2 * ks + hi) ^ (che & 7)) * 16));
                    ga = __builtin_amdgcn_mfma_f32_32x32x16_bf16(af, wa, ga, 0, 0, 0);
                    gi = __builtin_amdgcn_mfma_f32_32x32x16_bf16(af, wi, gi, 0, 0, 0);
                }
#pragma unroll
                for (int r = 0; r < 16; ++r) { const int tk2 = 32 * w4 + crow(r, hi); const float x = XC32[tk2 * 64 + che];
                    const float rg = fsigmoid(ga[r] + ba[chh]), ig = fsigmoid(gi[r] + bi[chh]), a = __expf(-rg * sp8[chh]);
                    av[r] = a; bv[r] = __builtin_amdgcn_sqrtf(fmaxf(1.f - a * a, 0.f)) * ig * x; }
                float At, Bt;
                scan_prep<REV>(av, bv, hi, Apre, Bpre, At, Bt);
                if (hi == 0) { f32x2 ab; ab.x = At; ab.y = Bt; AGG[chh * 512 + w4 * 64 + che] = ab; }
            }
            __syncthreads();
            {
                float hin = CARRY[che];
                if (!REV) { for (int t2 = 0; t2 < w4; ++t2) { const f32x2 ab = AGG[chh * 512 + t2 * 64 + che]; hin = ab.x * hin + ab.y; } }
                else { for (int t2 = 3; t2 > w4; --t2) { const f32x2 ab = AGG[chh * 512 + t2 * 64 + che]; hin = ab.x * hin + ab.y; } }
                scan_finish<REV>(av, bv, Apre, Bpre, hin, HX + (size_t)(c0 + 32 * w4) * 512 + che, hi);
                if (last_tile) { const f32x2 ab = AGG[chh * 512 + w4 * 64 + che]; newcarry[chh] = ab.x * hin + ab.y; }
            }
        }
    }
#undef RL_XLOAD
    if (!lat && last_tile && hi == 0) { float* o = F.out + O_NEWRNN + (size_t)(seq * 2 + dirh) * 512 + n * 64; o[r32] = newcarry[0]; o[32 + r32] = newcarry[1]; }
}

__device__ __forceinline__ void rnn_unit(Frame& F, bool lat, int seq, int n) {
    const int tid = F.tid;
    const int S = lat ? SEQ_L : SEQ_C, tokbase = lat ? NCTX + seq * SEQ_L : seq * SEQ_C;
    __syncthreads();
    { float* CW = (float*)(F.lds + RL_CW); float* CARRY = (float*)(F.lds + RL_CARRY);
      if (tid < 320) CW[tid] = tid < 256 ? F.in[I_CONVW][(tid >> 6) * 512 + n * 64 + (tid & 63)] : F.in[I_CONVB][n * 64 + (tid - 256)];
      if (tid < 128) CARRY[tid] = lat ? F.in[I_SRNN][(size_t)(seq * 2 + (tid >> 6)) * 512 + n * 64 + (tid & 63)] : 0.f;
      const bf16* rgw = (const bf16*)(F.ws + WS_RGW);
#pragma unroll
      for (int i = 0; i < 4; ++i) { const int q = tid + 512 * i, ch = q & 7, d = (q >> 3) & 63, gate = (q >> 9) & 1, dir = q >> 10;
          const v4u w = *(const v4u*)(rgw + (size_t)((dir * 8 + n) * 2 + gate) * 4096 + d * 64 + ch * 8);
          *(v4u*)(F.lds + RL_WG + dir * 16384 + gate * 8192 + d * 128 + ((ch ^ (d & 7)) * 16)) = w; } }
    __syncthreads();
    if (F.wave < 4) rnn_dir<false>(F, lat, seq, n); else rnn_dir<true>(F, lat, seq, n);
    __syncthreads();
    { const int c4 = tid & 15, tk = tid >> 4;
      const float* HF = (const float*)(F.ws + WS_HF) + (size_t)tokbase * 512 + n * 64 + 4 * c4;
      const float* HB = (const float*)(F.ws + WS_H) + (size_t)tokbase * 512 + n * 64 + 4 * c4;
      const bf16* YG = (const bf16*)(F.ws + WS_YG) + (size_t)tokbase * 512 + n * 64 + 4 * c4;
      bf16* MIX = (bf16*)(F.ws + WS_MIX) + (size_t)tokbase * DM + 512 + n * 64 + 4 * c4;
      for (int t0 = tk; t0 < S; t0 += 32) {
          const f32x4 a = *(const f32x4*)(HF + (size_t)t0 * 512), b = *(const f32x4*)(HB + (size_t)t0 * 512); const v2u y = *(const v2u*)(YG + (size_t)t0 * 512);
          v2u o; o.x = pk2((a[0] + b[0]) * gelu_fast(bflo(y.x)), (a[1] + b[1]) * gelu_fast(bfhi(y.x))); o.y = pk2((a[2] + b[2]) * gelu_fast(bflo(y.y)), (a[3] + b[3]) * gelu_fast(bfhi(y.y)));
          *(v2u*)(MIX + (size_t)t0 * DM) = o; } }
    __syncthreads();
}

#ifndef MK_P3_TYPES
#define MK_P3_TYPES 15
#endif
__device__ __forceinline__ void p3_phase(Frame& F, int types = 15) {
    const int v = F.vcu;
#pragma unroll 1
    for (int i = 0; i < 832; ++i) {
        int type, idx;
        if (F.G == 256) {
            if (v < 64) { if (i > 0) break; type = 0; idx = v; }
            else { if (i >= 6) break; const int j = v - 64, sl = i >> 1, rep = i & 1; type = 1 + sl;
                const bool extra = sl == 0 ? (j < 64) : (sl == 1 ? (j >= 64 && j < 128) : (j >= 128));
                if (rep && !extra) continue; idx = rep ? 192 + (j - 64 * sl) : j; }
        } else { const int it = v + i * F.G; if (it >= 832) break;
            if (it < 64) { type = 0; idx = it; } else if (it < 320) { type = 1; idx = it - 64; } else if (it < 576) { type = 2; idx = it - 320; } else { type = 3; idx = it - 576; } }
        if (!((types >> type) & 1)) continue;
        const bool lat = type < 2;
        Frame L = F; asm volatile("" : "+v"(L.tid)); L.lane = L.tid & 63;
        if ((type & 1) == 0) rnn_unit(L, lat, idx >> 3, idx & 7);
        else { if (lat) attn_unit(L, true, idx >> 5, (idx >> 4) & 1, idx & 15); else attn_unit(L, false, idx >> 3, (idx >> 2) & 1, idx & 3); }
    }
}

__device__ __forceinline__ unsigned key16(unsigned b, unsigned idx) { const unsigned s = (b & 0x8000u) ? (~b & 0xffffu) : (b | 0x8000u); return (s << 16) | idx; }
__device__ __forceinline__ float keyval16(unsigned k) { const unsigned s = k >> 16; const unsigned b = (s & 0x8000u) ? (s & 0x7fffu) : (~s & 0xffffu); return bf2f(b); }
__device__ __forceinline__ unsigned sortable32(float f) { const unsigned u = __builtin_bit_cast(unsigned, f); return (u & 0x80000000u) ? ~u : (u | 0x80000000u); }
template <int CTRL> __device__ __forceinline__ unsigned dppu(unsigned v) { return (unsigned)__builtin_amdgcn_update_dpp(0, (int)v, CTRL, 0xf, 0xf, true); }
template <int CTRL> __device__ __forceinline__ float dppf(float v) { return __builtin_bit_cast(float, __builtin_amdgcn_update_dpp(0, __builtin_bit_cast(int, v), CTRL, 0xf, 0xf, true)); }
__device__ __forceinline__ unsigned umax_(unsigned a, unsigned b) { return a > b ? a : b; }
__device__ __forceinline__ unsigned umin_(unsigned a, unsigned b) { return a < b ? a : b; }
__device__ __forceinline__ unsigned rowmax16u(unsigned x) { x = umax_(x, dppu<0xB1>(x)); x = umax_(x, dppu<0x4E>(x)); x = umax_(x, dppu<0x141>(x)); x = umax_(x, dppu<0x140>(x)); return x; }
__device__ __forceinline__ float rowmax16f(float x) { x = fmaxf(x, dppf<0xB1>(x)); x = fmaxf(x, dppf<0x4E>(x)); x = fmaxf(x, dppf<0x141>(x)); x = fmaxf(x, dppf<0x140>(x)); return x; }
__device__ __forceinline__ float rowsum16f(float x) { x += dppf<0xB1>(x); x += dppf<0x4E>(x); x += dppf<0x141>(x); x += dppf<0x140>(x); return x; }
__device__ __forceinline__ int rowsum16i(int x) { x += (int)dppu<0xB1>((unsigned)x); x += (int)dppu<0x4E>((unsigned)x); x += (int)dppu<0x141>((unsigned)x); x += (int)dppu<0x140>((unsigned)x); return x; }
#define CEX(a, b) do { const unsigned _h = umax_(a, b), _l = umin_(a, b); a = _h; b = _l; } while (0)

constexpr int P7_WL = 16384;
constexpr int P7_TL = 0, P7_TE = 1024, P7_TG = 3072, P7_LE = 5120, P7_LG = 6400, P7_LSU = 8960, P7_LS = 11520, P7_H2Q = 12160, P7_HST = 16256;
static_assert(P7_LS + 640 <= P7_H2Q && (P7_H2Q % 16) == 0 && P7_HST + 16 <= P7_WL && P7_WL * 8 <= RING_BYTES, "P7 LDS map");

__device__ __forceinline__ void topk_token(const v4u (&rawv)[4], unsigned* TL, int lane, const int (&ctab)[4], int* oute, float* outg) {
    const int k = lane & 15, row = lane >> 4;
    v4u rq0 = rawv[0], rq1 = rawv[1], rq2 = rawv[2], rq3 = rawv[3];
#pragma unroll 1
    for (int pass = 0; pass < 4; ++pass) {
        const int gidx = pass * 4 + row;
        const v4u raw = rq0; rq0 = rq1; rq1 = rq2; rq2 = rq3;
        unsigned r0 = key16(raw.x & 0xffffu, k * 8 + 0), r1 = key16(raw.x >> 16, k * 8 + 1), r2 = key16(raw.y & 0xffffu, k * 8 + 2), r3 = key16(raw.y >> 16, k * 8 + 3);
        unsigned r4 = key16(raw.z & 0xffffu, k * 8 + 4), r5 = key16(raw.z >> 16, k * 8 + 5), r6 = key16(raw.w & 0xffffu, k * 8 + 6), r7 = key16(raw.w >> 16, k * 8 + 7);
        CEX(r0, r1); CEX(r2, r3); CEX(r4, r5); CEX(r6, r7);
        CEX(r0, r2); CEX(r1, r3); CEX(r4, r6); CEX(r5, r7);
        CEX(r1, r2); CEX(r5, r6);
        CEX(r0, r4); CEX(r1, r5); CEX(r2, r6); CEX(r3, r7);
        CEX(r2, r4); CEX(r3, r5);
        CEX(r1, r2); CEX(r3, r4); CEX(r5, r6);
        unsigned keep = 0;
#pragma unroll
        for (int it = 0; it < 16; ++it) {
            const unsigned m = rowmax16u(r0); const bool win = r0 == m;
            r0 = win ? r1 : r0; r1 = win ? r2 : r1; r2 = win ? r3 : r2; r3 = win ? r4 : r3; r4 = win ? r5 : r4; r5 = win ? r6 : r5; r6 = win ? r7 : r6; r7 = win ? 0u : r7;
            keep = (k == it) ? m : keep;
        }
        TL[gidx * 16 + k] = keep;
    }
#pragma unroll 1
    for (int q = 0; q < 2; ++q) {
        const int hh = 4 * q + row;
        const unsigned* LA = TL + (2 * hh) * 16; const unsigned* LB = TL + (2 * hh + 1) * 16;
        unsigned c[4];
#pragma unroll
        for (int s = 0; s < 4; ++s) { const int ij = ctab[s]; const bool valid = ij >= 0; const int i = (ij >> 4) & 15, j = ij & 15;
            const float sum = keyval16(LA[i]) + keyval16(LB[j]);
            c[s] = valid ? ((sortable32(sum) & 0xffffff00u) | (unsigned)(i * 16 + j)) : 0u; }
        CEX(c[0], c[1]); CEX(c[2], c[3]); CEX(c[0], c[2]); CEX(c[1], c[3]); CEX(c[1], c[2]);
        unsigned keep = 0;
#pragma unroll
        for (int it = 0; it < 16; ++it) {
            const unsigned m = rowmax16u(c[0]); const bool win = c[0] == m;
            c[0] = win ? c[1] : c[0]; c[1] = win ? c[2] : c[1]; c[2] = win ? c[3] : c[2]; c[3] = win ? 0u : c[3];
            keep = (k == it) ? m : keep;
        }
        const int i = (keep >> 4) & 15, j = keep & 15; const unsigned ka = LA[i], kb = LB[j];
        const float bv = keyval16(ka) + keyval16(kb);
        const float mx = rowmax16f(bv); const float ex = __expf(bv - mx); const float sm = rowsum16f(ex);
        oute[q * 64 + lane] = (int)((ka & 127u) * 128u + (kb & 127u)); outg[q * 64 + lane] = ex / sm;
    }
}

__device__ __forceinline__ void gl16(v4u& d, unsigned voff, const unsigned char* sbase) { asm volatile("global_load_dwordx4 %0, %1, %2" : "=v"(d) : "v"(voff), "s"(sbase) : "memory"); }
#define P7_VMWAIT(N, R) asm volatile("s_waitcnt vmcnt(" #N ")" : "+v"(R[0]), "+v"(R[1]), "+v"(R[2]), "+v"(R[3]) :: "memory")
__device__ __forceinline__ int mbcnt64(unsigned long long m) { return (int)__builtin_amdgcn_mbcnt_hi((unsigned)(m >> 32), __builtin_amdgcn_mbcnt_lo((unsigned)m, 0u)); }
__device__ __forceinline__ int rfl(int v) { return __builtin_amdgcn_readfirstlane(v); }
__device__ __forceinline__ float rflf(float v) { return __builtin_bit_cast(float, __builtin_amdgcn_readfirstlane(__builtin_bit_cast(int, v))); }

__device__ __forceinline__ void p7_phase(Frame& F, bool dry) {
    const int lane0 = F.lane, wave = F.wave;
    unsigned char* wl = F.lds + wave * P7_WL;
    unsigned* TL = (unsigned*)(wl + P7_TL); int* TE = (int*)(wl + P7_TE); float* TG = (float*)(wl + P7_TG);
    unsigned short* LE = (unsigned short*)(wl + P7_LE); float* LG = (float*)(wl + P7_LG); float* LSU = (float*)(wl + P7_LSU); unsigned char* LS = wl + P7_LS; unsigned char* H2Q = wl + P7_H2Q; float* HST = (float*)(wl + P7_HST);
    const bf16* SC = (const bf16*)(F.ws + WS_SC); const bf16* H2 = (const bf16*)(F.ws + WS_H);
    const unsigned char* U8 = F.ws + WS_U; const unsigned char* V8 = F.ws + WS_V;
    const float* SU = (const float*)(F.ws + WS_SU); const float* SV = (const float*)(F.ws + WS_SV);
    const float* mods = (const float*)(F.ws + WS_MODS);
    int ctab[4];
#pragma unroll
    for (int s = 0; s < 4; ++s) { const int c = 16 * s + (lane0 & 15); int i, j;
        if (c < 16) { i = 0; j = c; } else if (c < 24) { i = 1; j = c - 16; } else if (c < 29) { i = 2; j = c - 24; } else if (c < 33) { i = 3; j = c - 29; } else if (c < 36) { i = 4; j = c - 33; }
        else if (c < 38) { i = 5; j = c - 36; } else if (c < 40) { i = 6; j = c - 38; } else if (c < 42) { i = 7; j = c - 40; } else if (c < 50) { i = c - 34; j = 0; } else { i = -1; j = 0; }
        ctab[s] = i < 0 ? -1 : i * 16 + j; }
    const int ntg = NTOK / (F.G * NWAVES * 4);
#pragma unroll 1
    for (int tg = 0; tg < ntg; ++tg) {
        const int tok0 = (F.vcu * ntg + tg) * (NWAVES * 4) + wave * 4;
        int lane = F.lane; asm volatile("" : "+v"(lane));
        {
            v4u craw[4], nraw[4]; v4u ch0, ch1, nh0, nh1;
#define P7_TLOAD(R, H0, H1, tk) do { const bf16* sp_ = SC + (size_t)(tk) * 2048 + (lane >> 4) * 128 + (lane & 15) * 8; \
                _Pragma("unroll") for (int ps = 0; ps < 4; ++ps) R[ps] = *(const v4u*)(sp_ + ps * 512); \
                H0 = *(const v4u*)(H2 + (size_t)(tk) * DM + 16 * lane); H1 = *(const v4u*)(H2 + (size_t)(tk) * DM + 16 * lane + 8); } while (0)
            P7_TLOAD(craw, ch0, ch1, tok0);
#pragma unroll 1
            for (int s = 0; s < 4; ++s) {
                if (s < 3) P7_TLOAD(nraw, nh0, nh1, tok0 + s + 1);
                topk_token(craw, TL, lane, ctab, TE + s * 128, TG + s * 128);
                const v4u a = ch0, b = ch1;
                float hv[16];
                hv[0] = bflo(a.x); hv[1] = bfhi(a.x); hv[2] = bflo(a.y); hv[3] = bfhi(a.y); hv[4] = bflo(a.z); hv[5] = bfhi(a.z); hv[6] = bflo(a.w); hv[7] = bfhi(a.w);
                hv[8] = bflo(b.x); hv[9] = bfhi(b.x); hv[10] = bflo(b.y); hv[11] = bfhi(b.y); hv[12] = bflo(b.z); hv[13] = bfhi(b.z); hv[14] = bflo(b.w); hv[15] = bfhi(b.w);
                float am = 0.f;
#pragma unroll
                for (int i = 0; i < 16; ++i) am = fmaxf(am, fabsf(hv[i]));
#pragma unroll
                for (int o = 1; o < 64; o <<= 1) am = fmaxf(am, __shfl_xor(am, o));
                const float inv = am > 0.f ? 127.f / am : 0.f;
                if (lane == 0) HST[s] = am * (1.f / 127.f);
                v4u qv;
#pragma unroll
                for (int j = 0; j < 4; ++j) { unsigned w = 0;
#pragma unroll
                    for (int i = 0; i < 4; ++i) { int q = (int)rintf(hv[4 * j + i] * inv); w |= ((unsigned)q & 0xffu) << (8 * i); }
                    qv[j] = w; }
                *(v4u*)(H2Q + s * 1024 + 16 * lane) = qv;
#pragma unroll
                for (int ps = 0; ps < 4; ++ps) craw[ps] = nraw[ps];
                ch0 = nh0; ch1 = nh1;
            }
#undef P7_TLOAD
        }
        int nb;
        {
            int tot[8];
#pragma unroll
            for (int c = 0; c < 8; ++c) tot[c] = 0;
#pragma unroll 1
            for (int s = 0; s < 4; ++s) { const int c0 = TE[s * 128 + lane] >> 11, c1 = TE[s * 128 + 64 + lane] >> 11;
#pragma unroll
                for (int c = 0; c < 8; ++c) { const int n = __popcll(__ballot(c0 == c)) + __popcll(__ballot(c1 == c)); tot[c] += (n + 3) & ~3; } }
            int off[8]; { int base = 0;
#pragma unroll
                for (int c = 0; c < 8; ++c) { off[c] = base; base += tot[c]; }
                { const int pe = ((base + 47) / 48) * 48; if (lane < pe - base) { const int p = base + lane; LE[p] = (unsigned short)0; LG[p] = 0.f; LSU[p] = 0.f; LS[p] = (unsigned char)0; } base = pe; }
            nb = base >> 2; }
#pragma unroll 1
            for (int s = 0; s < 4; ++s) { const int e0 = TE[s * 128 + lane], e1 = TE[s * 128 + 64 + lane]; const float g0 = TG[s * 128 + lane], g1 = TG[s * 128 + 64 + lane]; const int c0 = e0 >> 11, c1 = e1 >> 11;
                const float su0 = SU[e0], su1 = SU[e1], sv0 = SV[e0], sv1 = SV[e1];
#pragma unroll
                for (int c = 0; c < 8; ++c) {
                    const unsigned long long m0 = __ballot(c0 == c), m1 = __ballot(c1 == c);
                    const int n0 = __popcll(m0), n = n0 + __popcll(m1), np = (n + 3) & ~3, base = off[c];
                    if (c0 == c) { const int p = base + mbcnt64(m0); LE[p] = (unsigned short)e0; LG[p] = g0 * sv0; LSU[p] = su0; LS[p] = (unsigned char)s; }
                    if (c1 == c) { const int p = base + n0 + mbcnt64(m1); LE[p] = (unsigned short)e1; LG[p] = g1 * sv1; LSU[p] = su1; LS[p] = (unsigned char)s; }
                    if (lane < np - n) { const int p = base + n + lane; LE[p] = (unsigned short)(c * 2048); LG[p] = 0.f; LSU[p] = 0.f; LS[p] = (unsigned char)s; }
                    off[c] = base + np;
                } }
        }
#ifndef MK_DRY_SKIP
#define MK_DRY_SKIP 0
#endif
        if (!(dry && (MK_DRY_SKIP & 1))) {
            int lane_u = F.lane; asm volatile("" : "+v"(lane_u));
            const bool hi32 = lane_u >= 32, b16 = (lane_u & 16) != 0;
            const int xr = ((lane_u >> 5) & 1) | ((lane_u >> 3) & 2);
            const unsigned voff_u = 16u * (unsigned)lane_u;
            v4u ra[4], rb[4], rc[4], rd[4], re[4], rf[4];
#define P7_ULOAD(R, b) do { _Pragma("unroll") for (int x = 0; x < 4; ++x) { const int e = rfl((int)LE[4 * (b) + x]); gl16(R[x], voff_u, U8 + (size_t)e * DM); } } while (0)
#define P7_UCOMP(R, b) do { const int sl = rfl(LS[4 * (b)]); const v4u hq = *(const v4u*)(H2Q + sl * 1024 + 16 * lane_u); int p[4]; \
            _Pragma("unroll") for (int x = 0; x < 4; ++x) { int d = __builtin_amdgcn_sdot4((int)hq.x, (int)R[x].x, 0, false); d = __builtin_amdgcn_sdot4((int)hq.y, (int)R[x].y, d, false); \
                d = __builtin_amdgcn_sdot4((int)hq.z, (int)R[x].z, d, false); d = __builtin_amdgcn_sdot4((int)hq.w, (int)R[x].w, d, false); p[x] = d; } \
            const int t01 = (hi32 ? p[1] : p[0]) + __shfl_xor(hi32 ? p[0] : p[1], 32); const int t23 = (hi32 ? p[3] : p[2]) + __shfl_xor(hi32 ? p[2] : p[3], 32); \
            int t = (b16 ? t23 : t01) + __shfl_xor(b16 ? t01 : t23, 16); t = rowsum16i(t); \
            const int idx = 4 * (b) + xr; const float g = LG[idx]; \
            const float hs = HST[sl]; \
            const float dotf = (float)t * (hs * LSU[idx]); const float cf = g * gelu_tanh(dotf); \
            LG[idx] = cf; } while (0)
            P7_ULOAD(ra, 0); P7_ULOAD(rb, 1); P7_ULOAD(rc, 2); P7_ULOAD(rd, 3); P7_ULOAD(re, 4);
#pragma unroll 1
            for (int b = 0; b < nb; b += 6) {
                P7_ULOAD(rf, b + 5);
                P7_VMWAIT(20, ra); P7_UCOMP(ra, b);
                P7_ULOAD(ra, (b + 6 < nb ? b + 6 : nb - 1));
                P7_VMWAIT(20, rb); P7_UCOMP(rb, b + 1);
                P7_ULOAD(rb, (b + 7 < nb ? b + 7 : nb - 1));
                P7_VMWAIT(20, rc); P7_UCOMP(rc, b + 2);
                P7_ULOAD(rc, (b + 8 < nb ? b + 8 : nb - 1));
                P7_VMWAIT(20, rd); P7_UCOMP(rd, b + 3);
                P7_ULOAD(rd, (b + 9 < nb ? b + 9 : nb - 1));
                P7_VMWAIT(20, re); P7_UCOMP(re, b + 4);
                P7_ULOAD(re, (b + 10 < nb ? b + 10 : nb - 1));
                P7_VMWAIT(20, rf); P7_UCOMP(rf, b + 5);
            }
            asm volatile("s_waitcnt vmcnt(0)" ::: "memory");
#undef P7_ULOAD
#undef P7_UCOMP
        }
        float cscale[4];
        {
            float m0 = 0.f, m1 = 0.f, m2 = 0.f, m3 = 0.f;
            for (int idx = lane; idx < 4 * nb; idx += 64) { const float c = fabsf(LG[idx]); const int sl = LS[idx]; m0 = fmaxf(m0, sl == 0 ? c : 0.f); m1 = fmaxf(m1, sl == 1 ? c : 0.f); m2 = fmaxf(m2, sl == 2 ? c : 0.f); m3 = fmaxf(m3, sl == 3 ? c : 0.f); }
#pragma unroll
            for (int o = 1; o < 64; o <<= 1) { m0 = fmaxf(m0, __shfl_xor(m0, o)); m1 = fmaxf(m1, __shfl_xor(m1, o)); m2 = fmaxf(m2, __shfl_xor(m2, o)); m3 = fmaxf(m3, __shfl_xor(m3, o)); }
            cscale[0] = m0 * (1.f / 127.f); cscale[1] = m1 * (1.f / 127.f); cscale[2] = m2 * (1.f / 127.f); cscale[3] = m3 * (1.f / 127.f);
            const float i0 = m0 > 0.f ? 127.f / m0 : 0.f, i1 = m1 > 0.f ? 127.f / m1 : 0.f, i2 = m2 > 0.f ? 127.f / m2 : 0.f, i3 = m3 > 0.f ? 127.f / m3 : 0.f;
            unsigned char* LQ = (unsigned char*)LSU;
            for (int idx = lane; idx < 4 * nb; idx += 64) { const int sl = LS[idx]; const float iv = sl == 0 ? i0 : (sl == 1 ? i1 : (sl == 2 ? i2 : i3)); LQ[idx] = (unsigned char)((int)rintf(LG[idx] * iv) & 0xff); }
        }
        int acc[4][16];
#pragma unroll
        for (int s = 0; s < 4; ++s) {
#pragma unroll
            for (int i = 0; i < 16; ++i) acc[s][i] = 0; }
        if (!(dry && (MK_DRY_SKIP & 2))) {
            int lane_v = F.lane; asm volatile("" : "+v"(lane_v));
            const int* LQ32 = (const int*)LSU;
            v4u ra[4], rb[4], rc[4], rd[4];
#define P7_VLOAD(R, b) do { _Pragma("unroll") for (int x = 0; x < 4; ++x) { const int e = rfl((int)LE[4 * (b) + x]); R[x] = *(const v4u*)(V8 + (size_t)e * DM + 16 * lane_v); } } while (0)
#define P7_VADD(S, T) do { _Pragma("unroll") for (int i_ = 0; i_ < 16; ++i_) acc[S][i_] += T[i_]; } while (0)
#define P7_VCOMP(R, b) do { const int sl = rfl(LS[4 * (b)]); const int cq = rfl(LQ32[(b)]); int t_[16]; \
                _Pragma("unroll") for (int d = 0; d < 4; ++d) { \
                    const unsigned x_ = __builtin_amdgcn_perm(R[1][d], R[0][d], 0x05010400u), y_ = __builtin_amdgcn_perm(R[1][d], R[0][d], 0x07030602u); \
                    const unsigned c_ = __builtin_amdgcn_perm(R[3][d], R[2][d], 0x05010400u), e_ = __builtin_amdgcn_perm(R[3][d], R[2][d], 0x07030602u); \
                    t_[4 * d + 0] = __builtin_amdgcn_sdot4((int)__builtin_amdgcn_perm(c_, x_, 0x05040100u), cq, 0, false); \
                    t_[4 * d + 1] = __builtin_amdgcn_sdot4((int)__builtin_amdgcn_perm(c_, x_, 0x07060302u), cq, 0, false); \
                    t_[4 * d + 2] = __builtin_amdgcn_sdot4((int)__builtin_amdgcn_perm(e_, y_, 0x05040100u), cq, 0, false); \
                    t_[4 * d + 3] = __builtin_amdgcn_sdot4((int)__builtin_amdgcn_perm(e_, y_, 0x07060302u), cq, 0, false); } \
                if (sl == 0) P7_VADD(0, t_); else if (sl == 1) P7_VADD(1, t_); else if (sl == 2) P7_VADD(2, t_); else P7_VADD(3, t_); } while (0)
            P7_VLOAD(ra, 0); P7_VLOAD(rb, 1); P7_VLOAD(rc, 2);
#pragma unroll 1
            for (int b = 0; b < nb; b += 4) {
                P7_VLOAD(rd, b + 3);
                P7_VCOMP(ra, b);
                P7_VLOAD(ra, (b + 4 < nb ? b + 4 : nb - 1));
                P7_VCOMP(rb, b + 1);
                P7_VLOAD(rb, (b + 5 < nb ? b + 5 : nb - 1));
                P7_VCOMP(rc, b + 2);
                P7_VLOAD(rc, (b + 6 < nb ? b + 6 : nb - 1));
                P7_VCOMP(rd, b + 3);
            }
#undef P7_VLOAD
#undef P7_VADD
#undef P7_VCOMP
        }
#pragma unroll
        for (int s = 0; s < 4; ++s) {
            const int tok = tok0 + s;
            int lane_f = F.lane; asm volatile("" : "+v"(lane_f));
            float* xrow = F.out + O_Y + (size_t)tok * DM + 16 * lane_f;
            float* yrow = dry ? (float*)(F.ws + WS_MIX) + (size_t)(tok & 8191) * DM + 16 * lane_f : xrow;
            const float* ga2 = mods + (size_t)mod_index(tok) * MODW + 5 * DM + 16 * lane_f;
            const float* gf = F.in[I_GFINAL] + 16 * lane_f;
            float x2[16]; float ss = 0.f; const float csc = cscale[s];
#pragma unroll
            for (int j = 0; j < 4; ++j) { const f32x4 xv = *(const f32x4*)(xrow + 4 * j), gv = *(const f32x4*)(ga2 + 4 * j);
#pragma unroll
                for (int i = 0; i < 4; ++i) { const float t = xv[i] + gv[i] * ((float)acc[s][4 * j + i] * csc); x2[4 * j + i] = t; ss += t * t; } }
            const float rstd = 1.f / sqrtf(wave_sum(ss) * (1.f / DM) + EPS);
#pragma unroll
            for (int j = 0; j < 4; ++j) { const f32x4 gv = *(const f32x4*)(gf + 4 * j); f32x4 o;
#pragma unroll
                for (int i = 0; i < 4; ++i) o[i] = x2[4 * j + i] * rstd * gv[i];
                *(f32x4*)(yrow + 4 * j) = o; }
        }
    }
}

__global__ void __launch_bounds__(NWAVES * 64, 2) mk_fwd(Args args) {
    extern __shared__ __attribute__((aligned(16))) unsigned char lds[];
    Frame F;
    F.lds = lds;
    F.tid = threadIdx.x; F.lane = F.tid & 63; F.wave = __builtin_amdgcn_readfirstlane(F.tid >> 6);
    F.G = gridDim.x; { const int bx = blockIdx.x; F.vcu = (F.G % 8 == 0) ? (bx % 8) * (F.G / 8) + bx / 8 : bx; }
    F.in = args.in; F.out = args.out; F.ws = args.ws;
    LAS unsigned char* lds3 = (LAS unsigned char*)lds;
    volatile LAS unsigned* MISC = (volatile LAS unsigned*)(lds3 + MISC_OFF);
    for (int u = F.tid; u < (LDS_BYTES - LDSCTL_OFF) / 4; u += NWAVES * 64) ((LAS unsigned*)(lds3 + LDSCTL_OFF))[u] = 0u;
    __syncthreads();
    unsigned* ctl = (unsigned*)(args.ws + WS_CTL);
    XcdBarrier bar; bar.bar = ctl + CW_BAR; bar.x = 0; bar.st = nullptr;
    const bool one_launch = (args.ph_hi - args.ph_lo) > 1;
    if (one_launch) bar = xcd_barrier_post(ctl + CW_BAR, MISC + 8);
    const int lo = args.ph_lo, hi = args.ph_hi;
#ifndef MK_PHASE_MASK
#define MK_PHASE_MASK 0xff
#endif
#define IN(k) (((MK_PHASE_MASK >> (k)) & 1) && lo <= (k) && (k) < hi)
#define SEAM(k) do { if (IN(k) && IN((k) + 1)) xcd_barrier(bar); } while (0)

#define DUPQ(k) (MK_DUP == (k))
    if (IN(0)) { if (DUPQ(0)) { p0_phase(F); xcd_barrier(bar); } p0_phase(F); SEAM(0); }
    if (IN(1)) { if (DUPQ(1)) { norm_phase(F, 0); xcd_barrier(bar); } norm_phase(F, 0); SEAM(1); }
    if (IN(2)) {
        pg8::Gemm g{(const pg8::bf16_t*)(F.ws + WS_H), (const pg8::bf16_t*)(F.ws + WS_WIN), NTOK, D_IN, DM}; pg8::StaticOrder S; S.init(NTOK, D_IN, F.G, (int)blockIdx.x);
        EpiInProj E{(bf16*)(F.ws + WS_Q), (bf16*)(F.ws + WS_K), (bf16*)(F.ws + WS_VT), (bf16*)(F.ws + WS_XR), (bf16*)(F.ws + WS_YG), F.out + O_NEWK, F.out + O_NEWV, (const f32x4*)(F.ws + WS_ROPE)};
        if (DUPQ(2)) { pg8::gemm_phase<EpiInProj, pg8::StaticOrder, true, true>(lds3, g, S, E); xcd_barrier(bar); }
        pg8::gemm_phase<EpiInProj, pg8::StaticOrder, true, true>(lds3, g, S, E);
        SEAM(2);
    }
    if (IN(3)) { if (DUPQ(3)) { p3_phase(F, MK_P3_TYPES); xcd_barrier(bar); } p3_phase(F); SEAM(3); }
    if (IN(4)) {
        pg8::Gemm g{(const pg8::bf16_t*)(F.ws + WS_MIX), (const pg8::bf16_t*)(F.ws + WS_WOUT), NTOK, DM, DM}; pg8::StaticOrder S; S.init(NTOK, DM, F.G, (int)blockIdx.x);
        EpiOutProj E{F.in[I_XP], F.in[I_XS], (const float*)(F.ws + WS_MODS), F.out + O_Y};
        if (DUPQ(4)) { pg8::gemm_phase<EpiOutProj, pg8::StaticOrder, true, true>(lds3, g, S, E); xcd_barrier(bar); }
        pg8::gemm_phase<EpiOutProj, pg8::StaticOrder, true, true>(lds3, g, S, E);
        SEAM(4);
    }
    if (IN(5)) { if (DUPQ(5)) { norm_phase(F, 1); xcd_barrier(bar); } norm_phase(F, 1); SEAM(5); }
    if (IN(6)) {
        pg8::Gemm g{(const pg8::bf16_t*)(F.ws + WS_H), (const pg8::bf16_t*)(F.ws + WS_WC), NTOK, 2048, DM}; pg8::StaticOrder S; S.init(NTOK, 2048, F.G, (int)blockIdx.x);
        EpiScores E{(bf16*)(F.ws + WS_SC)};
        if (DUPQ(6)) { pg8::gemm_phase<EpiScores, pg8::StaticOrder, true, true>(lds3, g, S, E); xcd_barrier(bar); }
        pg8::gemm_phase<EpiScores, pg8::StaticOrder, true, true>(lds3, g, S, E);
        SEAM(6);
    }
    if (IN(7)) { if (DUPQ(7)) { p7_phase(F, true); xcd_barrier(bar); } p7_phase(F, false); }
#undef IN
#undef SEAM
}

extern "C" void kernel_launch(void* const* d_in, const int* in_sizes, int n_in, void* d_out, int out_size, void* d_ws, size_t ws_size, hipStream_t stream) {
    static int grid = 0;
    if (grid == 0) {
        if (n_in != 26 || ws_size < WS_END) { fprintf(stderr, "kernel_launch: unexpected n_in %d / ws %zu\n", n_in, ws_size); grid = -1; return; }
        int dev = 0, cus = 0, per_cu = 0;
        if (hipGetDevice(&dev) != hipSuccess || hipDeviceGetAttribute(&cus, hipDeviceAttributeMultiprocessorCount, dev) != hipSuccess) { grid = -1; return; }
        if (hipFuncSetAttribute((const void*)mk_fwd, hipFuncAttributeMaxDynamicSharedMemorySize, LDS_BYTES) != hipSuccess) { fprintf(stderr, "kernel_launch: hipFuncSetAttribute failed\n"); grid = -1; return; }
        if (hipOccupancyMaxActiveBlocksPerMultiprocessor(&per_cu, (const void*)mk_fwd, NWAVES * 64, LDS_BYTES) != hipSuccess || per_cu < 1)
            fprintf(stderr, "kernel_launch: occupancy query reports %d blocks per CU\n", per_cu);
        (void)hipGetLastError();
        grid = cus;
        if (grid != 256) fprintf(stderr, "kernel_launch: note: %d CUs\n", grid);
    }
    if (grid < 0) return;
    (void)hipMemsetAsync((char*)d_ws + WS_CTL, 0, CTL_ZERO_BYTES, stream);
    Args a{};
    for (int i = 0; i < 26; ++i) a.in[i] = (const float*)d_in[i];
    a.out = (float*)d_out; a.ws = (unsigned char*)d_ws;
    if (MK_N_LAUNCHES == 1) {
        a.ph_lo = 0; a.ph_hi = N_PHASES; a.li = 0;
        hipLaunchKernelGGL(mk_fwd, dim3(grid), dim3(NWAVES * 64), LDS_BYTES, stream, a);
    } else {
        for (int li = 0; li < N_PHASES; ++li) { a.ph_lo = li; a.ph_hi = li + 1; a.li = li;
            hipLaunchKernelGGL(mk_fwd, dim3(grid), dim3(NWAVES * 64), LDS_BYTES, stream, a); }
    }
}
```

```cpp
#include <hip/hip_runtime.h>
#include <cstdio>
#include <cstdint>

#ifndef MK_DUP
#define MK_DUP -1
#endif
#ifndef MK_DRY_SKIP
#define MK_DRY_SKIP 0
#endif
#ifndef MK_N_LAUNCHES
#define MK_N_LAUNCHES 1
#endif

namespace pg8 {
#define PG8_LAS __attribute__((address_space(3)))
typedef unsigned short bf16_t;
typedef short bf16x8 __attribute__((ext_vector_type(8)));
typedef float f32x4 __attribute__((ext_vector_type(4)));
typedef unsigned u32x4 __attribute__((ext_vector_type(4)));
typedef unsigned u32x2 __attribute__((ext_vector_type(2)));
constexpr int BM = 256, BK = 64, HALF = 128, HTB = HALF * BK * 2, STAGE_BYTES = 8 * HTB, NXCD = 8, WGM = 8;

__host__ __device__ __forceinline__ int lds_byte(int r, int c) { const int st = (r >> 4) * 2 + (c >> 5), rr = r & 15, cc = c & 31, ob = rr * 64 + cc * 2; return st * 1024 + (ob ^ (((ob >> 9) & 1) << 5)); }
__host__ __device__ __forceinline__ void stage_rc(int b, int& R, int& C) { const int st = b / 1024, sb = b % 1024, swz = sb ^ (((sb >> 9) & 1) << 5); R = (st >> 1) * 16 + swz / 64; C = (st & 1) * 32 + (swz % 64) / 2; }
__host__ __device__ __forceinline__ int perm32(int rho) { const int n = rho >> 4, i = rho & 15; return 8 * (i >> 2) + 4 * n + (i & 3); }

struct Unit { int pm, pn; };
struct Gemm { const bf16_t* A; const bf16_t* Bt; int M, N, K; };

struct StaticOrder {
    int nM, nN, nwg, G, c;
    __host__ __device__ void init(int M, int N, int G_, int c_) { nM = M / BM; nN = N / BM; nwg = nM * nN; G = G_; c = c_; }
    __host__ __device__ bool next(int i, Unit& u) const {
        const long L = (long)i * G + c; if (L >= nwg) return false;
        int wgid = (int)L; { const int q = nwg / NXCD, r = nwg % NXCD, xcd = wgid % NXCD, off = wgid / NXCD; wgid = (xcd < r ? xcd * (q + 1) : r * (q + 1) + (xcd - r) * q) + off; }
        const int nig = WGM * nN, gid = wgid / nig, fm = gid * WGM, gsz = (nM - fm) < WGM ? (nM - fm) : WGM;
        u.pm = fm + ((wgid % nig) % gsz); u.pn = (wgid % nig) / gsz; return true;
    }
    __device__ __forceinline__ void a_ready(const Unit&) const {}
    __device__ __forceinline__ void done(const Unit&) const {}
};

__device__ __forceinline__ unsigned cvt_pk_bf16(float lo, float hi) { unsigned r; asm volatile("v_cvt_pk_bf16_f32 %0, %1, %2" : "=v"(r) : "v"(lo), "v"(hi)); return r; }

template <class Epi, class Sched, bool ALIGN_EPI = false, bool SP2 = false>
__device__ __forceinline__ void gemm_phase(PG8_LAS unsigned char* lds, const Gemm g, const Sched& S, const Epi& E) {
    const int tid = threadIdx.x, wid = __builtin_amdgcn_readfirstlane(tid >> 6), lane = tid & 63, wr = wid >> 2, wc = wid & 3, fr = lane & 15, fq = lane >> 4;
    const int K = g.K, nt = K / BK;
    unsigned voffA[2], voffB[2];
#pragma unroll
    for (int i = 0; i < 2; ++i) { int R, C; stage_rc(tid * 16 + i * 8192, R, C); const int Rb = Epi::PERM ? ((R & ~31) + perm32(R & 31)) : R;
        voffA[i] = (unsigned)(R * K + C) * 2u; voffB[i] = (unsigned)(Rb * K + C) * 2u; }
    const size_t kstep = (size_t)(BK * 2);
    const size_t hstep = (size_t)HALF * K * 2;
    const size_t tstep = 2 * hstep;
    const unsigned ldsw = (unsigned)wid * 1024u;
    const int aoff = lds_byte(wr * 64 + fr, fq * 8), boff = lds_byte(wc * 32 + fr, fq * 8);
#define PG8_SA(b, h) (((b) * 2 + (h)) * HTB)
#define PG8_SB(b, h) ((4 + (b) * 2 + (h)) * HTB)
#define PG8_STAGE(bufoff, gbase, voff) do { _Pragma("unroll") for (int _i = 0; _i < 2; ++_i) \
        __builtin_amdgcn_global_load_lds((const unsigned*)((const char*)(gbase) + (voff)[_i]), (PG8_LAS unsigned*)(lds + (bufoff) + ldsw + _i * 8192), 16, 0, 0); } while (0)
#define PG8_LDA(dst, b, h) do { _Pragma("unroll") for (int m = 0; m < 4; ++m) _Pragma("unroll") for (int k = 0; k < 2; ++k) dst[m][k] = *(const PG8_LAS bf16x8*)(lds + PG8_SA(b, h) + aoff + m * 2048 + k * 1024); } while (0)
#define PG8_LDB(dst, b, h) do { _Pragma("unroll") for (int n = 0; n < 2; ++n) _Pragma("unroll") for (int k = 0; k < 2; ++k) dst[n][k] = *(const PG8_LAS bf16x8*)(lds + PG8_SB(b, h) + boff + n * 2048 + k * 1024); } while (0)
#define PG8_MMA(ai, bj, At, Bt) do { __builtin_amdgcn_s_setprio(1); _Pragma("unroll") for (int m = 0; m < 4; ++m) _Pragma("unroll") for (int n = 0; n < 2; ++n) _Pragma("unroll") for (int k = 0; k < 2; ++k) \
        acc[ai][bj][m][n] = __builtin_amdgcn_mfma_f32_16x16x32_bf16(Bt[n][k], At[m][k], acc[ai][bj][m][n], 0, 0, 0); __builtin_amdgcn_s_setprio(0); } while (0)
#define PG8_WAIT_V(n) asm volatile("s_waitcnt vmcnt(" #n ")" ::: "memory")
#define PG8_WAIT_L(n) asm volatile("s_waitcnt lgkmcnt(" #n ")" ::: "memory")
#define PG8_BAR __builtin_amdgcn_s_barrier()
#define PG8_SCHED __builtin_amdgcn_sched_barrier(0)
    Unit cur, nxt; int ui = 0;
    if (!S.next(0, cur)) return;
    f32x4 acc[2][2][4][2];
#pragma unroll
    for (int a = 0; a < 2; ++a)
#pragma unroll
        for (int b = 0; b < 2; ++b)
#pragma unroll
            for (int m = 0; m < 4; ++m)
#pragma unroll
                for (int n = 0; n < 2; ++n) acc[a][b][m][n] = (f32x4){0.f, 0.f, 0.f, 0.f};
    bf16x8 At[4][2], B0[2][2], B1[2][2];
    const char* cA = (const char*)g.A + (size_t)cur.pm * tstep; const char* cB = (const char*)g.Bt + (size_t)cur.pn * tstep;
    S.a_ready(cur);
    if constexpr (SP2) {
        PG8_STAGE(PG8_SB(0, 0), cB, voffB); PG8_STAGE(PG8_SB(0, 1), cB + hstep, voffB); PG8_STAGE(PG8_SA(0, 0), cA, voffA); PG8_STAGE(PG8_SA(0, 1), cA + hstep, voffA);
        if (wr == 1) PG8_BAR;
        PG8_WAIT_V(2); PG8_BAR;
        PG8_STAGE(PG8_SB(1, 0), cB + kstep, voffB); PG8_STAGE(PG8_SA(1, 0), cA + kstep, voffA); PG8_STAGE(PG8_SB(1, 1), cB + hstep + kstep, voffB);
        PG8_WAIT_V(6); PG8_BAR;
    } else {
        PG8_STAGE(PG8_SB(0, 0), cB, voffB); PG8_STAGE(PG8_SA(0, 0), cA, voffA); PG8_STAGE(PG8_SB(0, 1), cB + hstep, voffB); PG8_STAGE(PG8_SA(0, 1), cA + hstep, voffA);
        if (wr == 1) PG8_BAR;
        PG8_WAIT_V(4); PG8_BAR;
        PG8_STAGE(PG8_SB(1, 0), cB + kstep, voffB); PG8_STAGE(PG8_SA(1, 0), cA + kstep, voffA); PG8_STAGE(PG8_SB(1, 1), cB + hstep + kstep, voffB);
        PG8_WAIT_V(6); PG8_BAR;
    }
    for (;;) {
        const bool has_next = S.next(ui + 1, nxt);
        const char* nA = has_next ? (const char*)g.A + (size_t)nxt.pm * tstep : cA; const char* nB = has_next ? (const char*)g.Bt + (size_t)nxt.pn * tstep : cB;
        for (int t = 0; t < nt; t += 2) {
            const bool last = (t == nt - 2);
            const char* a1 = cA + (size_t)(t + 1) * kstep;
            const char* a2 = last ? nA : cA + (size_t)(t + 2) * kstep; const char* b2 = last ? nB : cB + (size_t)(t + 2) * kstep;
            const char* a3 = a2 + kstep; const char* b3 = b2 + kstep;
            if (last && has_next) S.a_ready(nxt);
            if constexpr (SP2) {
            PG8_LDB(B0, 0, 0); PG8_LDB(B1, 0, 1); PG8_SCHED; PG8_LDA(At, 0, 0); PG8_STAGE(PG8_SA(1, 1), a1 + hstep, voffA);
            PG8_WAIT_V(8); PG8_WAIT_L(0); PG8_BAR; PG8_MMA(0, 0, At, B0); PG8_MMA(0, 1, At, B1); PG8_BAR; PG8_SCHED;
            PG8_LDA(At, 0, 1); PG8_STAGE(PG8_SB(0, 0), b2, voffB); PG8_STAGE(PG8_SB(0, 1), b2 + hstep, voffB); PG8_STAGE(PG8_SA(0, 0), a2, voffA);
            PG8_WAIT_V(8); PG8_WAIT_L(0); PG8_BAR; PG8_MMA(1, 0, At, B0); PG8_MMA(1, 1, At, B1); PG8_BAR; PG8_SCHED;
            PG8_LDB(B0, 1, 0); PG8_LDB(B1, 1, 1); PG8_SCHED; PG8_LDA(At, 1, 0); PG8_STAGE(PG8_SA(0, 1), a2 + hstep, voffA);
            PG8_WAIT_V(8); PG8_WAIT_L(0); PG8_BAR; PG8_MMA(0, 0, At, B0); PG8_MMA(0, 1, At, B1); PG8_BAR; PG8_SCHED;
            PG8_LDA(At, 1, 1); PG8_STAGE(PG8_SB(1, 0), b3, voffB); PG8_STAGE(PG8_SB(1, 1), b3 + hstep, voffB); PG8_STAGE(PG8_SA(1, 0), a3, voffA);
            PG8_WAIT_V(8); PG8_WAIT_L(0); PG8_BAR; PG8_MMA(1, 0, At, B0); PG8_MMA(1, 1, At, B1); PG8_BAR; PG8_SCHED;
            } else {
            PG8_LDB(B0, 0, 0); PG8_SCHED; PG8_LDA(At, 0, 0); PG8_STAGE(PG8_SA(1, 1), a1 + hstep, voffA);
            PG8_WAIT_L(8); PG8_BAR; PG8_WAIT_L(0); PG8_MMA(0, 0, At, B0); PG8_BAR; PG8_SCHED;
            PG8_LDB(B1, 0, 1); PG8_STAGE(PG8_SB(0, 0), b2, voffB);
            PG8_BAR; PG8_WAIT_L(0); PG8_MMA(0, 1, At, B1); PG8_BAR;
            PG8_LDA(At, 0, 1); PG8_STAGE(PG8_SA(0, 0), a2, voffA);
            PG8_BAR; PG8_WAIT_L(0); PG8_MMA(1, 0, At, B0); PG8_BAR; PG8_SCHED;
            PG8_STAGE(PG8_SB(0, 1), b2 + hstep, voffB);
            PG8_WAIT_V(6); PG8_BAR; PG8_MMA(1, 1, At, B1); PG8_BAR;
            PG8_LDB(B0, 1, 0); PG8_SCHED; PG8_LDA(At, 1, 0); PG8_STAGE(PG8_SA(0, 1), a2 + hstep, voffA);
            PG8_WAIT_L(8); PG8_BAR; PG8_WAIT_L(0); PG8_MMA(0, 0, At, B0); PG8_BAR; PG8_SCHED;
            PG8_LDB(B1, 1, 1); PG8_STAGE(PG8_SB(1, 0), b3, voffB);
            PG8_BAR; PG8_WAIT_L(0); PG8_MMA(0, 1, At, B1); PG8_BAR;
            PG8_LDA(At, 1, 1); PG8_STAGE(PG8_SA(1, 0), a3, voffA);
            PG8_BAR; PG8_WAIT_L(0); PG8_MMA(1, 0, At, B0); PG8_BAR; PG8_SCHED;
            PG8_STAGE(PG8_SB(1, 1), b3 + hstep, voffB);
            PG8_WAIT_V(6); PG8_BAR; PG8_MMA(1, 1, At, B1); PG8_BAR;
            }
        }
        if constexpr (ALIGN_EPI) { if (wr == 0) PG8_BAR; }
        E(acc, cur, wr, wc, fr, fq); S.done(cur);
        if (!has_next) break;
#pragma unroll
        for (int a = 0; a < 2; ++a)
#pragma unroll
            for (int b = 0; b < 2; ++b)
#pragma unroll
                for (int m = 0; m < 4; ++m)
#pragma unroll
                    for (int n = 0; n < 2; ++n) acc[a][b][m][n] = (f32x4){0.f, 0.f, 0.f, 0.f};
        cur = nxt; cA = nA; cB = nB; ++ui;
        if constexpr (ALIGN_EPI) { if (wr == 1) PG8_BAR; }
    }
    PG8_WAIT_V(0);
    if constexpr (!ALIGN_EPI) { if (wr == 0) PG8_BAR; }
    PG8_BAR;
#undef PG8_SA
#undef PG8_SB
#undef PG8_STAGE
#undef PG8_LDA
#undef PG8_LDB
#undef PG8_MMA
#undef PG8_WAIT_V
#undef PG8_WAIT_L
#undef PG8_BAR
#undef PG8_SCHED
}
}

constexpr int NWAVES = 8;
constexpr int DM = 1024, NTOK = 16384, NCTX = 8192, D_IN = 1792, NMODV = 9, MODW = 6144;
constexpr int SEQ_C = 256, SEQ_L = 1024, NSEQ_C = 32, NSEQ_L = 8;
constexpr int N_PHASES = 8;
constexpr float LOG2E = 1.4426950408889634f;
constexpr float QSCALE = 0.125f * LOG2E;
constexpr float EPS = 1e-6f;

constexpr size_t MiB = 1u << 20, KiB = 1u << 10;
constexpr size_t WS_CTL = 0, CTL_ZERO_BYTES = 64 * KiB;
constexpr size_t WS_MODS = 1 * MiB;
constexpr size_t WS_ROPE = 1 * MiB + 256 * KiB;
constexpr size_t WS_RGW  = 1 * MiB + 512 * KiB;
constexpr size_t WS_CK   = 1 * MiB + 768 * KiB;
constexpr size_t WS_CVT  = 2 * MiB + 256 * KiB;
constexpr size_t WS_WIN  = 3 * MiB;
constexpr size_t WS_WOUT = 7 * MiB;
constexpr size_t WS_WC   = 9 * MiB;
constexpr size_t WS_U    = 16 * MiB;
constexpr size_t WS_SSP  = 14 * MiB;
constexpr size_t WS_BIAS = 15 * MiB;
constexpr size_t WS_SU   = 13 * MiB;
constexpr size_t WS_SV   = 13 * MiB + 64 * KiB;
constexpr size_t WS_V    = 48 * MiB;
constexpr size_t WS_H    = 80 * MiB;
constexpr size_t WS_MIX  = 112 * MiB;
constexpr size_t WS_Q    = 144 * MiB;
constexpr size_t WS_K    = 160 * MiB;
constexpr size_t WS_VT   = 164 * MiB;
constexpr size_t WS_XR   = 168 * MiB;
constexpr size_t WS_YG   = 184 * MiB;
constexpr size_t WS_HF   = 200 * MiB;
constexpr size_t WS_SC   = 144 * MiB;
constexpr size_t WS_END  = 232 * MiB;
constexpr int VT_LAT_OFF = NSEQ_C * 2 * 64 * SEQ_C;

constexpr int CW_BAR = 4096;

constexpr int RING_BYTES = 131072;
constexpr int LDSCTL_OFF = 146944, MISC_OFF = LDSCTL_OFF + 320;
constexpr int LDS_BYTES = 147456;

#define GAS __attribute__((address_space(1)))
#define LAS __attribute__((address_space(3)))
typedef unsigned short bf16;
typedef unsigned v4u __attribute__((ext_vector_type(4)));
typedef unsigned v2u __attribute__((ext_vector_type(2)));
typedef float f32x4 __attribute__((ext_vector_type(4)));
typedef float f32x2 __attribute__((ext_vector_type(2)));
typedef float f32x16 __attribute__((ext_vector_type(16)));
typedef short bf16x8 __attribute__((ext_vector_type(8)));
typedef GAS unsigned gu32;
#define RLX_AGENT __ATOMIC_RELAXED, __HIP_MEMORY_SCOPE_AGENT

__device__ __forceinline__ unsigned f2bf(float f) { unsigned u = __builtin_bit_cast(unsigned, f); return (u + 0x7fffu + ((u >> 16) & 1u)) >> 16; }
__device__ __forceinline__ unsigned pk2(float lo, float hi) { return f2bf(lo) | (f2bf(hi) << 16); }
__device__ __forceinline__ float bf2f(unsigned b) { return __builtin_bit_cast(float, b << 16); }
__device__ __forceinline__ float bflo(unsigned w) { return __builtin_bit_cast(float, w << 16); }
__device__ __forceinline__ float bfhi(unsigned w) { return __builtin_bit_cast(float, w & 0xffff0000u); }
__device__ __forceinline__ float sigmoidf_(float x) { return 1.f / (1.f + __expf(-x)); }
__device__ __forceinline__ float gelu_tanh(float x) { const float y = 0.7978845608028654f * (x + 0.044715f * x * x * x); const float e = __expf(2.f * y); return 0.5f * x * (2.f - 2.f / (1.f + e)); }
__device__ __forceinline__ float wave_sum(float v) {
#pragma unroll
    for (int o = 1; o < 64; o <<= 1) v += __shfl_xor(v, o);
    return v;
}
__device__ __forceinline__ unsigned wave_max_u32(unsigned v) {
#pragma unroll
    for (int o = 1; o < 64; o <<= 1) { const unsigned t = (unsigned)__shfl_xor((int)v, o); v = t > v ? t : v; }
    return v;
}
__device__ __forceinline__ int crow(int r, int hi) { return (r & 3) + 8 * (r >> 2) + 4 * hi; }

#define XB_TMO      128
#define XB_XCNT(j)  (256  + 64 * (j))
#define XB_XSUB(j)  (1280 + 64 * (j))
#define XB_XGEN(j)  (2304 + 64 * (j))
#define XB_TOP      3328
#define XB_TOPGEN   3392
#define XCD_BAR_WORDS 3456
#define XB_SPIN_CAP (1u << 18)
__device__ __forceinline__ unsigned xb_ld(unsigned* p)              { return __hip_atomic_load(p, __ATOMIC_RELAXED, __HIP_MEMORY_SCOPE_AGENT); }
__device__ __forceinline__ unsigned xb_add(unsigned* p, unsigned v) { return __hip_atomic_fetch_add(p, v, __ATOMIC_RELAXED, __HIP_MEMORY_SCOPE_AGENT); }
__device__ __forceinline__ unsigned xb_xcc_id() { return (unsigned)__builtin_amdgcn_s_getreg((3 << 11) | 20) & 0xFu; }
#define XB_SPIN(cond, bar) do { unsigned _sp = 0; while (cond) { __builtin_amdgcn_s_sleep(1); \
    if ((++_sp & 255u) == 0u) { if (xb_ld(&(bar)[XB_TMO])) break; if (_sp > XB_SPIN_CAP) { atomicAdd(&(bar)[XB_TMO], 1u); break; } } } } while (0)
struct XcdBarrier { unsigned* bar; unsigned x; volatile LAS unsigned* st; };
__device__ __forceinline__ XcdBarrier xcd_barrier_post(unsigned* bar, volatile LAS unsigned* st) {
    XcdBarrier b; b.bar = bar; b.x = xb_xcc_id(); b.st = st;
    if (threadIdx.x == 0) (void)xb_add(&bar[XB_XCNT(b.x)], 1u);
    return b;
}
__device__ __forceinline__ void xcd_barrier_complete(unsigned* bar, unsigned x, unsigned& nloc, unsigned& nx) {
    const unsigned G = gridDim.x * gridDim.y * gridDim.z;
    unsigned sum, cnt, mine, sp = 0u;
    for (;;) {
        sum = 0u; cnt = 0u; mine = 0u;
#pragma unroll
        for (unsigned j = 0; j < 16; ++j) { const unsigned c = xb_ld(&bar[XB_XCNT(j)]); sum += c; cnt += (c > 0u) ? 1u : 0u; mine = (j == x) ? c : mine; }
        if (sum == G) break;
        __builtin_amdgcn_s_sleep(1);
        if ((++sp & 255u) == 0u) { if (xb_ld(&bar[XB_TMO])) break; if (sp > XB_SPIN_CAP) { atomicAdd(&bar[XB_TMO], 1u); break; } }
    }
    nloc = mine > 0u ? mine : 1u; nx = cnt > 0u ? cnt : 1u;
}
__device__ __forceinline__ void xcd_barrier(const XcdBarrier& b) {
    asm volatile("s_waitcnt vmcnt(0)" ::: "memory");
    __syncthreads();
    if (threadIdx.x == 0) {
        unsigned* bar = b.bar;
        __builtin_amdgcn_s_waitcnt(0);
        unsigned nloc = b.st[0], nx = b.st[1];
        if (nloc == 0u) { xcd_barrier_complete(bar, b.x, nloc, nx); b.st[0] = nloc; b.st[1] = nx; }
        const unsigned old = xb_add(&bar[XB_XSUB(b.x)], 1u);
        const unsigned gen = old / nloc;
        if (old + 1u == (gen + 1u) * nloc) {
            __builtin_amdgcn_fence(__ATOMIC_RELEASE, "agent");
            asm volatile("s_waitcnt vmcnt(0)" ::: "memory");
            const unsigned og = xb_add(&bar[XB_TOP], 1u);
            const unsigned tg = og / nx;
            if (og + 1u == (tg + 1u) * nx) xb_add(&bar[XB_TOPGEN], 1u);
            else XB_SPIN(xb_ld(&bar[XB_TOPGEN]) == tg, bar);
            __builtin_amdgcn_fence(__ATOMIC_ACQUIRE, "agent");
            xb_add(&bar[XB_XGEN(b.x)], 1u);
            asm volatile("s_waitcnt vmcnt(0)" ::: "memory");
        } else {
            XB_SPIN(xb_ld(&bar[XB_XGEN(b.x)]) == gen, bar);
            __builtin_amdgcn_fence(__ATOMIC_ACQUIRE, "agent");
            asm volatile("s_waitcnt vmcnt(0)" ::: "memory");
        }
    }
    __syncthreads();
}

struct Args { const float* in[26]; float* out; unsigned char* ws; int ph_lo, ph_hi, li, pad; };

struct Frame {
    unsigned char* lds;
    int tid, lane, wave, vcu, G;
    const float* const* in;
    float* out; unsigned char* ws;
};
enum { I_XP = 0, I_XS, I_CK, I_CV, I_SRNN, I_C, I_CCTX, I_WMOD, I_BMOD, I_GMIX, I_GFFN, I_WIN, I_CONVW, I_CONVB, I_RGWA, I_RGBA, I_RGWI, I_RGBI, I_RGLAM, I_SINK, I_WOUT, I_PWQ, I_PSK, I_PU, I_PV, I_GFINAL };
constexpr size_t O_Y = 0, O_NEWK = (size_t)NTOK * DM, O_NEWV = O_NEWK + (size_t)NCTX * 128, O_NEWRNN = O_NEWV + (size_t)NCTX * 128;

__device__ __forceinline__ int mod_index(int tok) { return tok < NCTX ? 0 : 1 + ((tok - NCTX) >> 10); }
__device__ __forceinline__ const float* x_row(const Frame& F, int tok) { return tok < NCTX ? F.in[I_XP] + (size_t)tok * DM : F.in[I_XS] + (size_t)(tok - NCTX) * DM; }

template <class RowMap>
__device__ __forceinline__ void p0_transpose_item(const float* W, int K, int N, bf16* WT, float* scr, int item, int lane, RowMap rowmap) {
    const int nblk = N / 32, kb = item / nblk, nb = item % nblk, k0 = 64 * kb, n0 = 32 * nb;
#pragma unroll 8
    for (int i = 0; i < 32; ++i) { const int kk = 2 * i + (lane >> 5); scr[kk * 33 + (lane & 31)] = W[(size_t)(k0 + kk) * N + n0 + (lane & 31)]; }
    __builtin_amdgcn_s_waitcnt(0xC07F); asm volatile("" ::: "memory");
    const int c = lane & 7;
#pragma unroll
    for (int j = 0; j < 4; ++j) { const int n = (lane >> 3) + 8 * j; const float* s = scr + (8 * c) * 33 + n;
        v4u o; o.x = pk2(s[0 * 33], s[1 * 33]); o.y = pk2(s[2 * 33], s[3 * 33]); o.z = pk2(s[4 * 33], s[5 * 33]); o.w = pk2(s[6 * 33], s[7 * 33]);
        *(v4u*)(WT + (size_t)rowmap(n0 + n) * K + k0 + 8 * c) = o; }
    __builtin_amdgcn_s_waitcnt(0xC07F); asm volatile("" ::: "memory");
}
struct MapId { __device__ __forceinline__ int operator()(int n) const { return n; } };
struct MapWin { __device__ __forceinline__ int operator()(int n) const { if (n >= 640) return n; const int hb = n & ~63, o = n & 63; return hb + ((o & 31) << 1) + (o >> 5); } };

__device__ __forceinline__ void p0_phase(Frame& F) {
    float* ldsf = (float*)F.lds;
    const int tid = F.tid, lane = F.lane, wave = F.wave, v = F.vcu;
    if (v < 192) {
        for (int i = tid; i < NMODV * DM; i += 512) { const int j = i >> 10, d = i & 1023; const float c = (j == 0) ? F.in[I_CCTX][d] : F.in[I_C][(j - 1) * DM + d]; ldsf[i] = c * sigmoidf_(c); }
        __syncthreads();
        const int e0 = 32 * v, c4 = tid & 7, kq = tid >> 3;
        float acc[NMODV][4];
#pragma unroll
        for (int j = 0; j < NMODV; ++j) { acc[j][0] = 0.f; acc[j][1] = 0.f; acc[j][2] = 0.f; acc[j][3] = 0.f; }
        const float* wm = F.in[I_WMOD] + e0 + 4 * c4;
#pragma unroll 4
        for (int kk = 0; kk < 16; ++kk) { const int k = kq * 16 + kk; const f32x4 w = *(const f32x4*)(wm + (size_t)k * MODW);
#pragma unroll
            for (int j = 0; j < NMODV; ++j) { const float s = ldsf[j * DM + k]; acc[j][0] += s * w[0]; acc[j][1] += s * w[1]; acc[j][2] += s * w[2]; acc[j][3] += s * w[3]; } }
#pragma unroll
        for (int j = 0; j < NMODV; ++j)
#pragma unroll
            for (int i = 0; i < 4; ++i) { float a = acc[j][i]; a += __shfl_xor(a, 8); a += __shfl_xor(a, 16); a += __shfl_xor(a, 32); acc[j][i] = a; }
        float* red = ldsf + NMODV * DM;
        if (lane < 8) {
#pragma unroll
            for (int j = 0; j < NMODV; ++j)
#pragma unroll
                for (int i = 0; i < 4; ++i) red[(wave * NMODV + j) * 32 + 4 * c4 + i] = acc[j][i];
        }
        __syncthreads();
        if (tid < NMODV * 32) { const int j = tid >> 5, col = tid & 31; float s = F.in[I_BMOD][e0 + col];
#pragma unroll
            for (int w = 0; w < 8; ++w) s += red[(w * NMODV + j) * 32 + col];
            ((float*)(F.ws + WS_MODS))[j * MODW + e0 + col] = s; }
        __syncthreads();
    }
    if (v < 256) {
        const int hh = v >> 4, dt = v & 15, d0 = 64 * dt;
        float* At = ldsf;
        float* Bkt = ldsf + 128 * 64;
        const float* wq = F.in[I_PWQ] + hh * 128;
        const float* sk = F.in[I_PSK] + (size_t)hh * 128 * 128;
#pragma unroll
        for (int i = 0; i < 4; ++i) { const int f = tid + 512 * i, d = f & 63, q4 = f >> 6; const f32x4 a = *(const f32x4*)(wq + (size_t)(d0 + d) * 2048 + 4 * q4);
            At[(4 * q4 + 0) * 64 + d] = a[0]; At[(4 * q4 + 1) * 64 + d] = a[1]; At[(4 * q4 + 2) * 64 + d] = a[2]; At[(4 * q4 + 3) * 64 + d] = a[3]; }
#pragma unroll
        for (int i = 0; i < 8; ++i) { const int f = tid + 512 * i, key = f & 127, q4 = f >> 7; const f32x4 b = *(const f32x4*)(sk + (size_t)key * 128 + 4 * q4);
            Bkt[(4 * q4 + 0) * 128 + key] = b[0]; Bkt[(4 * q4 + 1) * 128 + key] = b[1]; Bkt[(4 * q4 + 2) * 128 + key] = b[2]; Bkt[(4 * q4 + 3) * 128 + key] = b[3]; }
        __syncthreads();
        const int dg = tid & 15, kg = tid >> 4;
        float acc[4][4];
#pragma unroll
        for (int i = 0; i < 4; ++i)
#pragma unroll
            for (int j = 0; j < 4; ++j) acc[i][j] = 0.f;
#pragma unroll 4
        for (int q = 0; q < 128; ++q) { const f32x4 a = *(const f32x4*)(At + q * 64 + 4 * dg); const f32x4 b = *(const f32x4*)(Bkt + q * 128 + 4 * kg);
#pragma unroll
            for (int i = 0; i < 4; ++i)
#pragma unroll
                for (int j = 0; j < 4; ++j) acc[i][j] += a[i] * b[j]; }
        bf16* WcT = (bf16*)(F.ws + WS_WC);
#pragma unroll
        for (int j = 0; j < 4; ++j) { v2u o; o.x = pk2(acc[0][j], acc[1][j]); o.y = pk2(acc[2][j], acc[3][j]);
            *(v2u*)(WcT + (size_t)(hh * 128 + 4 * kg + j) * DM + d0 + 4 * dg) = o; }
        __syncthreads();
    }
    const int gw = v * NWAVES + wave, NGW = F.G * NWAVES;
    float* scr = ldsf + wave * 4096;
    {
        constexpr int I_IN = (DM / 64) * (D_IN / 32), I_OUT = (DM / 64) * (DM / 32), I_RG = 32 * 2;
        constexpr int NIT = I_IN + I_OUT + I_RG;
        for (int it = gw; it < NIT; it += NGW) {
            int r = it;
            if (r < I_IN) { p0_transpose_item(F.in[I_WIN], DM, D_IN, (bf16*)(F.ws + WS_WIN), scr, r, lane, MapWin()); continue; } r -= I_IN;
            if (r < I_OUT) { p0_transpose_item(F.in[I_WOUT], DM, DM, (bf16*)(F.ws + WS_WOUT), scr, r, lane, MapId()); continue; } r -= I_OUT;
            { const int mm = r >> 1, sub = r & 1, dir = mm >> 4, n = (mm >> 1) & 7, gate = mm & 1;
              const float* src = (gate ? F.in[I_RGWI] : F.in[I_RGWA]) + (size_t)(dir * 8 + n) * 4096;
              bf16* dst = (bf16*)(F.ws + WS_RGW) + (size_t)((dir * 8 + n) * 2 + gate) * 4096;
              p0_transpose_item(src, 64, 64, dst, scr, sub, lane, MapId()); }
        }
    }
    for (int it0 = 4 * gw; it0 < 2 * 16384; it0 += 4 * NGW) {
        f32x4 a[4][4];
#pragma unroll
        for (int r = 0; r < 4; ++r) { const int it = it0 + r, tb = it >> 14, row = it & 16383;
            const float* src = (tb ? F.in[I_PV] : F.in[I_PU]) + (size_t)row * DM + 16 * lane;
#pragma unroll
            for (int j = 0; j < 4; ++j) a[r][j] = *(const f32x4*)(src + 4 * j); }
        float am[4];
#pragma unroll
        for (int r = 0; r < 4; ++r) { float m = 0.f;
#pragma unroll
            for (int j = 0; j < 4; ++j) m = fmaxf(m, fmaxf(fmaxf(fabsf(a[r][j][0]), fabsf(a[r][j][1])), fmaxf(fabsf(a[r][j][2]), fabsf(a[r][j][3]))));
            am[r] = m; }
#pragma unroll
        for (int o = 1; o < 64; o <<= 1) {
#pragma unroll
            for (int r = 0; r < 4; ++r) am[r] = fmaxf(am[r], __shfl_xor(am[r], o)); }
#pragma unroll
        for (int r = 0; r < 4; ++r) { const int it = it0 + r, tb = it >> 14, row = it & 16383;
            const float inv = am[r] > 0.f ? 127.f / am[r] : 0.f;
            v4u o4;
#pragma unroll
            for (int j = 0; j < 4; ++j) { unsigned w = 0;
#pragma unroll
                for (int i = 0; i < 4; ++i) { int q = (int)rintf(a[r][j][i] * inv); q = q > 127 ? 127 : (q < -127 ? -127 : q); w |= ((unsigned)q & 0xffu) << (8 * i); }
                o4[j] = w; }
            *(v4u*)(F.ws + (tb ? WS_V : WS_U) + (size_t)row * DM + 16 * lane) = o4;
            if (lane == 0) ((float*)(F.ws + (tb ? WS_SV : WS_SU)))[row] = am[r] * (1.f / 127.f); }
    }
    const int gt = v * 512 + tid, NGT = F.G * 512;
    for (int e = gt; e < 8 * 256 * 128; e += NGT) {
        const int c = e & 127, bp = e >> 7, kvh = c >> 6, p = c & 63, old = (p & 1) ? 32 + (p >> 1) : (p >> 1);
        ((bf16*)(F.ws + WS_CK))[e] = (bf16)f2bf(F.in[I_CK][(size_t)bp * 128 + kvh * 64 + old]);
    }
    for (int e = gt; e < 8 * 256 * 128; e += NGT) {
        const int pos = e & 255, d = (e >> 8) & 63, kvh = (e >> 14) & 1, b = e >> 15;
        ((bf16*)(F.ws + WS_CVT))[e] = (bf16)f2bf(F.in[I_CV][(size_t)(b * 256 + pos) * 128 + kvh * 64 + d]);
    }
    for (int e = gt; e < 1024 * 32; e += NGT) {
        const int s = e >> 5, i = e & 31, row = s >> 6, col = s & 63;
        const float inv = powf(10000.0f, -(float)(i & 15) / 16.0f);
        const float ang = (i < 16 ? (float)row : (float)col) * inv;
        f32x2 cs; cs.x = cosf(ang); cs.y = sinf(ang);
        ((f32x2*)(F.ws + WS_ROPE))[e] = cs;
    }
}

__device__ __forceinline__ void bias_items(Frame& F) {
    const int gw = F.vcu * NWAVES + F.wave, NGW = F.G * NWAVES, lane = F.lane;
    const float* mods = (const float*)(F.ws + WS_MODS); const bf16* WcT = (const bf16*)(F.ws + WS_WC); float* BIAS = (float*)(F.ws + WS_BIAS);
    for (int n = gw; n < 2048; n += NGW) {
        const v4u a = *(const v4u*)(WcT + (size_t)n * DM + 16 * lane), b = *(const v4u*)(WcT + (size_t)n * DM + 16 * lane + 8);
        float w[16];
        w[0] = bflo(a.x); w[1] = bfhi(a.x); w[2] = bflo(a.y); w[3] = bfhi(a.y); w[4] = bflo(a.z); w[5] = bfhi(a.z); w[6] = bflo(a.w); w[7] = bfhi(a.w);
        w[8] = bflo(b.x); w[9] = bfhi(b.x); w[10] = bflo(b.y); w[11] = bfhi(b.y); w[12] = bflo(b.z); w[13] = bfhi(b.z); w[14] = bflo(b.w); w[15] = bfhi(b.w);
#pragma unroll 1
        for (int j = 0; j < NMODV; ++j) { const float* sh = mods + (size_t)j * MODW + 3 * DM + 16 * lane; float d = 0.f;
#pragma unroll
            for (int q = 0; q < 4; ++q) { const f32x4 v = *(const f32x4*)(sh + 4 * q); d += v[0] * w[4 * q] + v[1] * w[4 * q + 1] + v[2] * w[4 * q + 2] + v[3] * w[4 * q + 3]; }
            d = wave_sum(d); if (lane == 0) BIAS[j * 2048 + n] = d; }
    }
}
__device__ __forceinline__ void norm_phase(Frame& F, int which) {
    const int gw = F.vcu * NWAVES + F.wave, NGW = F.G * NWAVES, lane = F.lane;
    const float* mods = (const float*)(F.ws + WS_MODS);
    const float* g = F.in[which ? I_GFFN : I_GMIX];
    bf16* H = (bf16*)(F.ws + WS_H);
    for (int tok = gw; tok < NTOK; tok += NGW) {
        const float* xr = which ? F.out + O_Y + (size_t)tok * DM : x_row(F, tok);
        const float* mv = mods + (size_t)mod_index(tok) * MODW + (which ? 3 * DM : 0);
        f32x4 v[4]; float ss = 0.f;
#pragma unroll
        for (int j = 0; j < 4; ++j) { v[j] = *(const f32x4*)(xr + 256 * j + 4 * lane); ss += (v[j][0] * v[j][0] + v[j][1] * v[j][1]) + (v[j][2] * v[j][2] + v[j][3] * v[j][3]); }
        const float rstd = 1.f / sqrtf(wave_sum(ss) * (1.f / DM) + EPS);
#pragma unroll
        for (int j = 0; j < 4; ++j) { const int e = 256 * j + 4 * lane;
            const f32x4 gg = *(const f32x4*)(g + e), sh = *(const f32x4*)(mv + e), sc = *(const f32x4*)(mv + DM + e);
            f32x4 o;
#pragma unroll
            for (int i = 0; i < 4; ++i) o[i] = v[j][i] * rstd * gg[i] * (1.f + sc[i]) + sh[i];
            v2u w; w.x = pk2(o[0], o[1]); w.y = pk2(o[2], o[3]); *(v2u*)(H + (size_t)tok * DM + e) = w; }
    }
}

struct EpiInProj {
    static constexpr bool PERM = true;
    bf16 *q, *k, *vT, *xr, *yg; float *newk, *newv; const f32x4* rope4;
    __device__ __forceinline__ void operator()(const f32x4 (&acc)[2][2][4][2], const pg8::Unit& u, int wr, int wc, int fr, int fq) const {
        const bool lat = u.pm >= 32;
        const int pn = u.pn;
#pragma unroll
        for (int ai = 0; ai < 2; ++ai)
#pragma unroll
            for (int m = 0; m < 4; ++m) {
                const int row = u.pm * 256 + ai * 128 + wr * 64 + m * 16 + fr;
                const int pos = lat ? ((row - NCTX) & 1023) : (row & 255);
#pragma unroll
                for (int bj = 0; bj < 2; ++bj) {
                    const int c = pn * 256 + bj * 128 + wc * 32 + 8 * fq;
                    f32x4 v0 = acc[ai][bj][m][0], v1 = acc[ai][bj][m][1];
                    if (pn < 2 || (pn == 2 && bj == 0)) {
                        const int i = (c & 63) >> 1;
                        if (lat) { const f32x4 cs0 = rope4[(pos * 32 + i) >> 1], cs1 = rope4[((pos * 32 + i) >> 1) + 1];
                            const float a0 = v0[0] * cs0[0] - v0[1] * cs0[1], a1 = v0[1] * cs0[0] + v0[0] * cs0[1];
                            const float b0 = v0[2] * cs0[2] - v0[3] * cs0[3], b1 = v0[3] * cs0[2] + v0[2] * cs0[3];
                            const float c0 = v1[0] * cs1[0] - v1[1] * cs1[1], c1 = v1[1] * cs1[0] + v1[0] * cs1[1];
                            const float d0 = v1[2] * cs1[2] - v1[3] * cs1[3], d1 = v1[3] * cs1[2] + v1[2] * cs1[3];
                            v0[0] = a0; v0[1] = a1; v0[2] = b0; v0[3] = b1; v1[0] = c0; v1[1] = c1; v1[2] = d0; v1[3] = d1; }
                        if (pn < 2) { v4u w; w.x = pk2(v0[0] * QSCALE, v0[1] * QSCALE); w.y = pk2(v0[2] * QSCALE, v0[3] * QSCALE); w.z = pk2(v1[0] * QSCALE, v1[1] * QSCALE); w.w = pk2(v1[2] * QSCALE, v1[3] * QSCALE);
                            *(v4u*)(q + (size_t)row * 512 + c) = w; }
                        else { const int kc = c - 512; v4u w; w.x = pk2(v0[0], v0[1]); w.y = pk2(v0[2], v0[3]); w.z = pk2(v1[0], v1[1]); w.w = pk2(v1[2], v1[3]); *(v4u*)(k + (size_t)row * 128 + kc) = w;
                            if (!lat) { float* nk = newk + (size_t)row * 128 + (kc & 64) + i; f32x4 lo; lo[0] = v0[0]; lo[1] = v0[2]; lo[2] = v1[0]; lo[3] = v1[2]; f32x4 hi; hi[0] = v0[1]; hi[1] = v0[3]; hi[2] = v1[1]; hi[3] = v1[3];
                                *(f32x4*)nk = lo; *(f32x4*)(nk + 32) = hi; } }
                    } else if (pn == 2) {
                        const int vc = c - 640, kvh = vc >> 6, d = vc & 63;
                        if (!lat) { *(f32x4*)(newv + (size_t)row * 128 + vc) = v0; *(f32x4*)(newv + (size_t)row * 128 + vc + 4) = v1; }
                        bf16* vp; int S;
                        if (!lat) { S = SEQ_C; vp = vT + ((size_t)((row >> 8) * 2 + kvh) * 64 + d) * SEQ_C + pos; }
                        else { S = SEQ_L; vp = vT + VT_LAT_OFF + ((size_t)(((row - NCTX) >> 10) * 2 + kvh) * 64 + d) * SEQ_L + pos; }
                        vp[0] = (bf16)f2bf(v0[0]); vp[S] = (bf16)f2bf(v0[1]); vp[2 * S] = (bf16)f2bf(v0[2]); vp[3 * S] = (bf16)f2bf(v0[3]);
                        vp[4 * S] = (bf16)f2bf(v1[0]); vp[5 * S] = (bf16)f2bf(v1[1]); vp[6 * S] = (bf16)f2bf(v1[2]); vp[7 * S] = (bf16)f2bf(v1[3]);
                    } else {
                        v4u w; w.x = pk2(v0[0], v0[1]); w.y = pk2(v0[2], v0[3]); w.z = pk2(v1[0], v1[1]); w.w = pk2(v1[2], v1[3]);
                        if (pn < 5) *(v4u*)(xr + (size_t)row * 512 + (c - 768)) = w; else *(v4u*)(yg + (size_t)row * 512 + (c - 1280)) = w;
                    }
                }
            }
    }
};
struct EpiOutProj {
    static constexpr bool PERM = true;
    const float *xp, *xs, *mods, *gffn; float* x1; bf16* ap; float* ssp;
    __device__ __forceinline__ void operator()(const f32x4 (&acc)[2][2][4][2], const pg8::Unit& u, int wr, int wc, int fr, int fq) const {
        const int mi = u.pm < 32 ? 0 : 1 + ((u.pm - 32) >> 2);
        const float* mv = mods + (size_t)mi * MODW;
        const int row0 = u.pm * 256 + wr * 64 + fr;
        const float* xbase = (u.pm < 32 ? xp : xs - (size_t)NCTX * DM) + (size_t)row0 * DM;
        float ssq[2][4];
#pragma unroll
        for (int ai = 0; ai < 2; ++ai)
#pragma unroll
            for (int m = 0; m < 4; ++m) ssq[ai][m] = 0.f;
#pragma unroll
        for (int bj = 0; bj < 2; ++bj) {
            const int c = u.pn * 256 + bj * 128 + wc * 32 + 8 * fq;
            const f32x4 gv0 = *(const f32x4*)(mv + 2 * DM + c), gv1 = *(const f32x4*)(mv + 2 * DM + c + 4);
            const f32x4 g20 = *(const f32x4*)(gffn + c) * (1.f + *(const f32x4*)(mv + 4 * DM + c)), g21 = *(const f32x4*)(gffn + c + 4) * (1.f + *(const f32x4*)(mv + 4 * DM + c + 4));
#pragma unroll
            for (int h4 = 0; h4 < 4; ++h4) {
                const int ai = h4 >> 1;
                f32x4 xv[2][2];
#pragma unroll
                for (int mm = 0; mm < 2; ++mm) { const float* xr = xbase + (size_t)(ai * 128 + (2 * (h4 & 1) + mm) * 16) * DM + c; xv[mm][0] = *(const f32x4*)xr; xv[mm][1] = *(const f32x4*)(xr + 4); }
                asm volatile("" ::: "memory");
#pragma unroll
                for (int mm = 0; mm < 2; ++mm) {
                    const int m = 2 * (h4 & 1) + mm;
                    const size_t off = (size_t)(row0 + ai * 128 + m * 16) * DM + c;
                    const f32x4 o0 = xv[mm][0] + gv0 * acc[ai][bj][m][0], o1 = xv[mm][1] + gv1 * acc[ai][bj][m][1];
                    *(f32x4*)(x1 + off) = o0; *(f32x4*)(x1 + off + 4) = o1;
                    ssq[ai][m] += ((o0[0] * o0[0] + o0[1] * o0[1]) + (o0[2] * o0[2] + o0[3] * o0[3])) + ((o1[0] * o1[0] + o1[1] * o1[1]) + (o1[2] * o1[2] + o1[3] * o1[3]));
                    const f32x4 t0 = o0 * g20, t1 = o1 * g21; v4u w; w.x = pk2(t0[0], t0[1]); w.y = pk2(t0[2], t0[3]); w.z = pk2(t1[0], t1[1]); w.w = pk2(t1[2], t1[3]);
                    *(v4u*)(ap + off) = w;
                }
                asm volatile("" ::: "memory");
            }
        }
#pragma unroll
        for (int ai = 0; ai < 2; ++ai)
#pragma unroll
            for (int m = 0; m < 4; ++m) { float v = ssq[ai][m]; v += __shfl_xor(v, 16); v += __shfl_xor(v, 32);
                if (fq == 0) ssp[(size_t)(row0 + ai * 128 + m * 16) * 16 + u.pn * 4 + wc] = v; }
    }
};
struct EpiScores {
    static constexpr bool PERM = true;
    bf16* sc; const float* ssp; const float* bias;
    __device__ __forceinline__ void operator()(const f32x4 (&acc)[2][2][4][2], const pg8::Unit& u, int wr, int wc, int fr, int fq) const {
        const int mi = u.pm < 32 ? 0 : 1 + ((u.pm - 32) >> 2);
        const int row0 = u.pm * 256 + wr * 64 + fr;
        f32x4 b0[2], b1[2];
#pragma unroll
        for (int bj = 0; bj < 2; ++bj) { const int c = u.pn * 256 + bj * 128 + wc * 32 + 8 * fq; b0[bj] = *(const f32x4*)(bias + (size_t)mi * 2048 + c); b1[bj] = *(const f32x4*)(bias + (size_t)mi * 2048 + c + 4); }
#pragma unroll
        for (int h2 = 0; h2 < 4; ++h2) {
            const int ai = h2 >> 1;
            f32x4 sp[2][4];
#pragma unroll
            for (int mm = 0; mm < 2; ++mm)
#pragma unroll
                for (int q = 0; q < 4; ++q) sp[mm][q] = *((const f32x4*)(ssp + (size_t)(row0 + ai * 128 + (2 * (h2 & 1) + mm) * 16) * 16) + q);
            asm volatile("" ::: "memory");
#pragma unroll
            for (int mm = 0; mm < 2; ++mm) {
                const int m = 2 * (h2 & 1) + mm;
                const int row = row0 + ai * 128 + m * 16;
                const float ss = ((sp[mm][0][0] + sp[mm][0][1]) + (sp[mm][0][2] + sp[mm][0][3])) + ((sp[mm][1][0] + sp[mm][1][1]) + (sp[mm][1][2] + sp[mm][1][3]))
                               + ((sp[mm][2][0] + sp[mm][2][1]) + (sp[mm][2][2] + sp[mm][2][3])) + ((sp[mm][3][0] + sp[mm][3][1]) + (sp[mm][3][2] + sp[mm][3][3]));
                const float rstd = 1.f / sqrtf(ss * (1.f / DM) + EPS);
#pragma unroll
                for (int bj = 0; bj < 2; ++bj) {
                    const int c = u.pn * 256 + bj * 128 + wc * 32 + 8 * fq;
                    const f32x4 v0 = acc[ai][bj][m][0] * rstd + b0[bj], v1 = acc[ai][bj][m][1] * rstd + b1[bj];
                    v4u w; w.x = pk2(v0[0], v0[1]); w.y = pk2(v0[2], v0[3]); w.z = pk2(v1[0], v1[1]); w.w = pk2(v1[2], v1[3]);
                    *(v4u*)(sc + (size_t)row * 2048 + c) = w;
                }
            }
            asm volatile("" ::: "memory");
        }
    }
};

__device__ __forceinline__ void attn_unit(Frame& F, bool lat, int seq, int kvh, int qt) {
    const int tid = F.tid, lane = F.lane, wave = F.wave, r32 = lane & 31, hi = lane >> 5;
    const int g = wave >> 1, qs = wave & 1, head = kvh * 4 + g;
    const int S = lat ? SEQ_L : SEQ_C, tokbase = lat ? NCTX + seq * SEQ_L : seq * SEQ_C;
    const int q0 = qt * 64, qpos = q0 + 32 * qs + r32;
    const bf16* Q = (const bf16*)(F.ws + WS_Q); const bf16* Kb = (const bf16*)(F.ws + WS_K); const bf16* VT = (const bf16*)(F.ws + WS_VT);
    const bf16* CK = (const bf16*)(F.ws + WS_CK); const bf16* CVT = (const bf16*)(F.ws + WS_CVT);
    unsigned char* ldsK = F.lds; unsigned char* ldsV = F.lds + 8192;
    bf16x8 qf[4];
    { const bf16* qp = Q + (size_t)(tokbase + qpos) * 512 + head * 64;
#pragma unroll
      for (int ks = 0; ks < 4; ++ks) qf[ks] = *(const bf16x8*)(qp + 16 * ks + 8 * hi); }
    const float sinkl = F.in[I_SINK][head] * LOG2E;
    float mrun = sinkl, lrun = (hi == 0) ? 1.f : 0.f;
    f32x16 o0, o1;
#pragma unroll
    for (int r = 0; r < 16; ++r) { o0[r] = 0.f; o1[r] = 0.f; }
    int tlo, thi;
    if (lat) { tlo = (q0 >= 128 ? q0 - 128 : 0) >> 6; thi = ((q0 + 192 < S ? q0 + 192 : S)) >> 6; } else { tlo = 0; thi = 4; }
    const int nband = thi - tlo, ntile = nband + (lat ? 4 : 0);
    const int key_t = tid >> 3, ch_t = tid & 7;
    for (int t = 0; t < ntile; ++t) {
        const bool band = t < nband;
        const bf16* kptr; const bf16* vptr; int vstride; int kbase = 0;
        if (band) { const int tile = tlo + t; kbase = tile * 64;
            kptr = Kb + (size_t)(tokbase + kbase) * 128 + kvh * 64;
            vptr = VT + (lat ? (size_t)VT_LAT_OFF + (size_t)((seq * 2 + kvh) * 64) * SEQ_L : (size_t)((seq * 2 + kvh) * 64) * SEQ_C) + kbase; vstride = S;
        } else { const int tc = t - nband;
            kptr = CK + (size_t)(seq * 256 + tc * 64) * 128 + kvh * 64;
            vptr = CVT + (size_t)((seq * 2 + kvh) * 64) * 256 + tc * 64; vstride = 256; }
        const v4u kv = *(const v4u*)(kptr + (size_t)key_t * 128 + ch_t * 8);
        const v4u vv = *(const v4u*)(vptr + (size_t)key_t * vstride + ch_t * 8);
        __syncthreads();
        *(v4u*)(ldsK + key_t * 128 + ((ch_t ^ (key_t & 7)) * 16)) = kv;
        *(v4u*)(ldsV + key_t * 128 + ((ch_t ^ (key_t & 7)) * 16)) = vv;
        __syncthreads();
        f32x16 p0, p1;
#pragma unroll
        for (int r = 0; r < 16; ++r) { p0[r] = 0.f; p1[r] = 0.f; }
#pragma unroll
        for (int ks = 0; ks < 4; ++ks) {
            const int sw = ((2 * ks + hi) ^ (r32 & 7)) * 16;
            const bf16x8 a0 = *(const bf16x8*)(ldsK + r32 * 128 + sw);
            const bf16x8 a1 = *(const bf16x8*)(ldsK + (32 + r32) * 128 + sw);
            p0 = __builtin_amdgcn_mfma_f32_32x32x16_bf16(a0, qf[ks], p0, 0, 0, 0);
            p1 = __builtin_amdgcn_mfma_f32_32x32x16_bf16(a1, qf[ks], p1, 0, 0, 0);
        }
        if (band && lat) {
#pragma unroll
            for (int r = 0; r < 16; ++r) { const int kp = kbase + crow(r, hi); int d0 = qpos - kp; d0 = d0 < 0 ? -d0 : d0; int d1 = qpos - kp - 32; d1 = d1 < 0 ? -d1 : d1;
                if (d0 > 128) p0[r] = -INFINITY; if (d1 > 128) p1[r] = -INFINITY; }
        }
        float tm = p0[0];
#pragma unroll
        for (int r = 1; r < 16; ++r) tm = fmaxf(tm, p0[r]);
#pragma unroll
        for (int r = 0; r < 16; ++r) tm = fmaxf(tm, p1[r]);
        tm = fmaxf(tm, __shfl_xor(tm, 32));
        const float mn = fmaxf(mrun, tm), alpha = exp2f(mrun - mn); mrun = mn;
        float ls = 0.f;
#pragma unroll
        for (int r = 0; r < 16; ++r) { p0[r] = exp2f(p0[r] - mn); p1[r] = exp2f(p1[r] - mn); ls += p0[r] + p1[r]; o0[r] *= alpha; o1[r] *= alpha; }
        lrun = lrun * alpha + ls;
        bf16x8 pf[4];
#pragma unroll
        for (int s = 0; s < 2; ++s) {
            v4u w0, w1;
            w0.x = pk2(p0[8 * s + 0], p0[8 * s + 1]); w0.y = pk2(p0[8 * s + 2], p0[8 * s + 3]); w0.z = pk2(p0[8 * s + 4], p0[8 * s + 5]); w0.w = pk2(p0[8 * s + 6], p0[8 * s + 7]);
            w1.x = pk2(p1[8 * s + 0], p1[8 * s + 1]); w1.y = pk2(p1[8 * s + 2], p1[8 * s + 3]); w1.z = pk2(p1[8 * s + 4], p1[8 * s + 5]); w1.w = pk2(p1[8 * s + 6], p1[8 * s + 7]);
            pf[s] = __builtin_bit_cast(bf16x8, w0); pf[2 + s] = __builtin_bit_cast(bf16x8, w1);
        }
#pragma unroll
        for (int s4 = 0; s4 < 4; ++s4) {
#pragma unroll
            for (int dt = 0; dt < 2; ++dt) {
                const int d = 32 * dt + r32;
                const v2u lo = *(const v2u*)(ldsV + d * 128 + (((2 * s4) ^ (d & 7)) * 16) + 8 * hi);
                const v2u hi2 = *(const v2u*)(ldsV + d * 128 + (((2 * s4 + 1) ^ (d & 7)) * 16) + 8 * hi);
                v4u vf4; vf4.x = lo.x; vf4.y = lo.y; vf4.z = hi2.x; vf4.w = hi2.y;
                const bf16x8 vf = __builtin_bit_cast(bf16x8, vf4);
                if (dt == 0) o0 = __builtin_amdgcn_mfma_f32_32x32x16_bf16(vf, pf[s4], o0, 0, 0, 0);
                else o1 = __builtin_amdgcn_mfma_f32_32x32x16_bf16(vf, pf[s4], o1, 0, 0, 0);
            }
        }
    }
    const float ltot = lrun + __shfl_xor(lrun, 32), inv = 1.f / ltot;
    bf16* mix = (bf16*)(F.ws + WS_MIX) + (size_t)(tokbase + qpos) * DM + head * 64;
#pragma unroll
    for (int g4 = 0; g4 < 4; ++g4) {
        v2u w; w.x = pk2(o0[4 * g4] * inv, o0[4 * g4 + 1] * inv); w.y = pk2(o0[4 * g4 + 2] * inv, o0[4 * g4 + 3] * inv);
        *(v2u*)(mix + 8 * g4 + 4 * hi) = w;
        v2u w2; w2.x = pk2(o1[4 * g4] * inv, o1[4 * g4 + 1] * inv); w2.y = pk2(o1[4 * g4 + 2] * inv, o1[4 * g4 + 3] * inv);
        *(v2u*)(mix + 32 + 8 * g4 + 4 * hi) = w2;
    }
    __syncthreads();
}

constexpr int RL_HALF = 49152;
constexpr int RL_XCB = 32768;
constexpr int RL_AGG = 98304;
constexpr int RL_CARRY = RL_AGG + 8192;
constexpr int RL_CW = RL_CARRY + 512;
constexpr int RL_WG = RL_CW + 1280;
static_assert(RL_WG + 32768 <= LDSCTL_OFF, "RNN LDS map");
__device__ __forceinline__ float fsigmoid(float x) { return __builtin_amdgcn_rcpf(1.f + __expf(-x)); }
__device__ __forceinline__ float gelu_fast(float x) { const float y = 0.7978845608028654f * (x + 0.044715f * x * x * x); const float e = __expf(2.f * y); return x - x * __builtin_amdgcn_rcpf(1.f + e); }

template <bool REV>
__device__ __forceinline__ void scan_prep(const float (&a)[16], const float (&b)[16], int h, float (&Apre)[4], float (&Bpre)[4], float& At, float& Bt) {
    float Ao[4], Bo[4], Ap[4], Bp[4];
#pragma unroll
    for (int g = 0; g < 4; ++g) { float A = 1.f, B = 0.f;
#pragma unroll
        for (int ii = 0; ii < 4; ++ii) { const int r = 4 * g + (REV ? 3 - ii : ii); B = a[r] * B + b[r]; A = a[r] * A; }
        Ao[g] = A; Bo[g] = B; }
#pragma unroll
    for (int g = 0; g < 4; ++g) { Ap[g] = __shfl_xor(Ao[g], 32); Bp[g] = __shfl_xor(Bo[g], 32); }
    const bool ownfirst = REV ? (h == 1) : (h == 0);
    float Ac = 1.f, Bc = 0.f;
#pragma unroll
    for (int gi = 0; gi < 4; ++gi) { const int g = REV ? 3 - gi : gi;
        const float A1 = ownfirst ? Ao[g] : Ap[g], B1 = ownfirst ? Bo[g] : Bp[g], A2 = ownfirst ? Ap[g] : Ao[g], B2 = ownfirst ? Bp[g] : Bo[g];
        const float Ac1 = A1 * Ac, Bc1 = A1 * Bc + B1;
        Apre[g] = ownfirst ? Ac : Ac1; Bpre[g] = ownfirst ? Bc : Bc1;
        Ac = A2 * Ac1; Bc = A2 * Bc1 + B2; }
    At = Ac; Bt = Bc;
}
template <bool REV>
__device__ __forceinline__ void scan_finish(const float (&a)[16], const float (&b)[16], const float (&Apre)[4], const float (&Bpre)[4], float hin, float* hp, int hi) {
#pragma unroll
    for (int g = 0; g < 4; ++g) { float hc = Apre[g] * hin + Bpre[g];
#pragma unroll
        for (int ii = 0; ii < 4; ++ii) { const int r = 4 * g + (REV ? 3 - ii : ii); hc = a[r] * hc + b[r]; hp[(size_t)crow(r, hi) * 512] = hc; } }
}

template <bool REV>
__device__ __forceinline__ void rnn_dir(Frame& F, bool lat, int seq, int n) {
    const int lane = F.lane, w4 = F.wave & 3, r32 = lane & 31, hi = lane >> 5, dirh = REV ? 1 : 0;
    const int S = lat ? SEQ_L : SEQ_C, tokbase = lat ? NCTX + seq * SEQ_L : seq * SEQ_C, nchunk = S / 128;
    unsigned char* hb = F.lds + dirh * RL_HALF;
    float* XC32 = (float*)hb; unsigned char* XCB = hb + RL_XCB;
    f32x2* AGG = (f32x2*)(F.lds + RL_AGG) + dirh * 256; float* CARRY = (float*)(F.lds + RL_CARRY) + dirh * 64; const float* CW = (const float*)(F.lds + RL_CW);
    const unsigned char* WG = F.lds + RL_WG + dirh * 16384;
    const bf16* XR = (const bf16*)(F.ws + WS_XR) + (size_t)tokbase * 512 + n * 64;
    float* HX = (float*)(F.ws + (REV ? WS_H : WS_HF)) + (size_t)tokbase * 512 + n * 64;
    const int t = F.tid & 255, c8 = t & 7, tg = t >> 3;
    float ba[2], bi[2], sp8[2];
#pragma unroll
    for (int chh = 0; chh < 2; ++chh) { const int pe = dirh * 512 + n * 64 + chh * 32 + r32; ba[chh] = F.in[I_RGBA][pe]; bi[chh] = F.in[I_RGBI][pe];
        const float nl = -F.in[I_RGLAM][pe]; sp8[chh] = 8.f * (nl > 20.f ? nl : log1pf(__expf(nl))); }
    v4u xin[7];
#define RL_XLOAD(c0_) do { _Pragma("unroll") for (int i = 0; i < 7; ++i) { const int pos = (c0_) + 4 * tg - 2 + i; \
        xin[i] = (pos >= 0 && pos < S) ? *(const v4u*)(XR + (size_t)pos * 512 + 8 * c8) : (v4u){0u, 0u, 0u, 0u}; } } while (0)
    RL_XLOAD((REV ? nchunk - 1 : 0) * 128);
    float newcarry[2] = {0.f, 0.f};
    const bool last_tile = REV ? (w4 == 0) : (w4 == 3);
#pragma unroll 1
    for (int k = 0; k < nchunk; ++k) {
        const int c0 = (REV ? nchunk - 1 - k : k) * 128;
        {
            const f32x4 b0 = *(const f32x4*)(CW + 256 + 8 * c8), b1 = *(const f32x4*)(CW + 256 + 8 * c8 + 4);
            f32x4 wt0[4], wt1[4];
#pragma unroll
            for (int tap = 0; tap < 4; ++tap) { wt0[tap] = *(const f32x4*)(CW + tap * 64 + 8 * c8); wt1[tap] = *(const f32x4*)(CW + tap * 64 + 8 * c8 + 4); }
#pragma unroll
            for (int i = 0; i < 4; ++i) {
                f32x4 y0 = b0, y1 = b1;
#pragma unroll
                for (int tap = 0; tap < 4; ++tap) { const v4u x = xin[i + tap];
                    y0[0] += wt0[tap][0] * bflo(x.x); y0[1] += wt0[tap][1] * bfhi(x.x); y0[2] += wt0[tap][2] * bflo(x.y); y0[3] += wt0[tap][3] * bfhi(x.y);
                    y1[0] += wt1[tap][0] * bflo(x.z); y1[1] += wt1[tap][1] * bfhi(x.z); y1[2] += wt1[tap][2] * bflo(x.w); y1[3] += wt1[tap][3] * bfhi(x.w); }
                const int tk = 4 * tg + i;
                *(f32x4*)(XC32 + tk * 64 + 8 * c8) = y0; *(f32x4*)(XC32 + tk * 64 + 8 * c8 + 4) = y1;
                v4u w; w.x = pk2(y0[0], y0[1]); w.y = pk2(y0[2], y0[3]); w.z = pk2(y1[0], y1[1]); w.w = pk2(y1[2], y1[3]);
                *(v4u*)(XCB + tk * 128 + ((c8 ^ (tk & 7)) * 16)) = w; }
        }
        if (k + 1 < nchunk) RL_XLOAD((REV ? nchunk - 2 - k : k + 1) * 128);
        __syncthreads();
        if (k > 0 && last_tile && hi == 0) { CARRY[r32] = newcarry[0]; CARRY[32 + r32] = newcarry[1]; }
        const int tkA = 32 * w4 + r32;
#pragma unroll
        for (int chh = 0; chh < 2; ++chh) {
            const int che = chh * 32 + r32;
            float av[16], bv[16], Apre[4], Bpre[4];
            {
                f32x16 ga, gi;
#pragma unroll
                for (int r = 0; r < 16; ++r) { ga[r] = 0.f; gi[r] = 0.f; }
#pragma unroll
                for (int ks = 0; ks < 4; ++ks) {
                    const bf16x8 af = *(const bf16x8*)(XCB + tkA * 128 + (((2 * ks + hi) ^ (tkA & 7)) * 16));
                    const bf16x8 wa = *(const bf16x8*)(WG + che * 128 + (((2 * ks + hi) ^ (che & 7)) * 16));
                    const bf16x8 wi = *(const bf16x8*)(WG + 8192 + che * 128 + (((2 * ks + hi) ^ (che & 7)) * 16));
                    ga = __builtin_amdgcn_mfma_f32_32x32x16_bf16(af, wa, ga, 0, 0, 0);
                    gi = __builtin_amdgcn_mfma_f32_32x32x16_bf16(af, wi, gi, 0, 0, 0);
                }
#pragma unroll
                for (int r = 0; r < 16; ++r) { const int tk2 = 32 * w4 + crow(r, hi); const float x = XC32[tk2 * 64 + che];
                    const float rg = fsigmoid(ga[r] + ba[chh]), ig = fsigmoid(gi[r] + bi[chh]), a = __expf(-rg * sp8[chh]);
                    av[r] = a; bv[r] = __builtin_amdgcn_sqrtf(fmaxf(1.f - a * a, 0.f)) * ig * x; }
                float At, Bt;
                scan_prep<REV>(av, bv, hi, Apre, Bpre, At, Bt);
                if (hi == 0) { f32x2 ab; ab.x = At; ab.y = Bt; AGG[chh * 512 + w4 * 64 + che] = ab; }
            }
            __syncthreads();
            {
                float hin = CARRY[che];
                if (!REV) { for (int t2 = 0; t2 < w4; ++t2) { const f32x2 ab = AGG[chh * 512 + t2 * 64 + che]; hin = ab.x * hin + ab.y; } }
                else { for (int t2 = 3; t2 > w4; --t2) { const f32x2 ab = AGG[chh * 512 + t2 * 64 + che]; hin = ab.x * hin + ab.y; } }
                scan_finish<REV>(av, bv, Apre, Bpre, hin, HX + (size_t)(c0 + 32 * w4) * 512 + che, hi);
                if (last_tile) { const f32x2 ab = AGG[chh * 512 + w4 * 64 + che]; newcarry[chh] = ab.x * hin + ab.y; }
            }
        }
    }
#undef RL_XLOAD
    if (!lat && last_tile && hi == 0) { float* o = F.out + O_NEWRNN + (size_t)(seq * 2 + dirh) * 512 + n * 64; o[r32] = newcarry[0]; o[32 + r32] = newcarry[1]; }
}

__device__ __forceinline__ void rnn_unit(Frame& F, bool lat, int seq, int n) {
    const int tid = F.tid;
    const int S = lat ? SEQ_L : SEQ_C, tokbase = lat ? NCTX + seq * SEQ_L : seq * SEQ_C;
    __syncthreads();
    { float* CW = (float*)(F.lds + RL_CW); float* CARRY = (float*)(F.lds + RL_CARRY);
      if (tid < 320) CW[tid] = tid < 256 ? F.in[I_CONVW][(tid >> 6) * 512 + n * 64 + (tid & 63)] : F.in[I_CONVB][n * 64 + (tid - 256)];
      if (tid < 128) CARRY[tid] = lat ? F.in[I_SRNN][(size_t)(seq * 2 + (tid >> 6)) * 512 + n * 64 + (tid & 63)] : 0.f;
      const bf16* rgw = (const bf16*)(F.ws + WS_RGW);
#pragma unroll
      for (int i = 0; i < 4; ++i) { const int q = tid + 512 * i, ch = q & 7, d = (q >> 3) & 63, gate = (q >> 9) & 1, dir = q >> 10;
          const v4u w = *(const v4u*)(rgw + (size_t)((dir * 8 + n) * 2 + gate) * 4096 + d * 64 + ch * 8);
          *(v4u*)(F.lds + RL_WG + dir * 16384 + gate * 8192 + d * 128 + ((ch ^ (d & 7)) * 16)) = w; } }
    __syncthreads();
    if (F.wave < 4) rnn_dir<false>(F, lat, seq, n); else rnn_dir<true>(F, lat, seq, n);
    __syncthreads();
    { const int c4 = tid & 15, tk = tid >> 4;
      const float* HF = (const float*)(F.ws + WS_HF) + (size_t)tokbase * 512 + n * 64 + 4 * c4;
      const float* HB = (const float*)(F.ws + WS_H) + (size_t)tokbase * 512 + n * 64 + 4 * c4;
      const bf16* YG = (const bf16*)(F.ws + WS_YG) + (size_t)tokbase * 512 + n * 64 + 4 * c4;
      bf16* MIX = (bf16*)(F.ws + WS_MIX) + (size_t)tokbase * DM + 512 + n * 64 + 4 * c4;
      for (int t0 = tk; t0 < S; t0 += 32) {
          const f32x4 a = *(const f32x4*)(HF + (size_t)t0 * 512), b = *(const f32x4*)(HB + (size_t)t0 * 512); const v2u y = *(const v2u*)(YG + (size_t)t0 * 512);
          v2u o; o.x = pk2((a[0] + b[0]) * gelu_fast(bflo(y.x)), (a[1] + b[1]) * gelu_fast(bfhi(y.x))); o.y = pk2((a[2] + b[2]) * gelu_fast(bflo(y.y)), (a[3] + b[3]) * gelu_fast(bfhi(y.y)));
          *(v2u*)(MIX + (size_t)t0 * DM) = o; } }
    __syncthreads();
}

#ifndef MK_P3_TYPES
#define MK_P3_TYPES 15
#endif
__device__ __forceinline__ void p3_phase(Frame& F, int types = 15) {
    const int v = F.vcu;
#pragma unroll 1
    for (int i = 0; i < 832; ++i) {
        int type, idx;
        if (F.G == 256) {
            if (v < 64) { if (i > 0) break; type = 0; idx = v; }
            else { if (i >= 6) break; const int j = v - 64, sl = i >> 1, rep = i & 1; type = 1 + sl;
                const bool extra = sl == 0 ? (j < 64) : (sl == 1 ? (j >= 64 && j < 128) : (j >= 128));
                if (rep && !extra) continue; idx = rep ? 192 + (j - 64 * sl) : j; }
        } else { const int it = v + i * F.G; if (it >= 832) break;
            if (it < 64) { type = 0; idx = it; } else if (it < 320) { type = 1; idx = it - 64; } else if (it < 576) { type = 2; idx = it - 320; } else { type = 3; idx = it - 576; } }
        if (!((types >> type) & 1)) continue;
        const bool lat = type < 2;
        Frame L = F; asm volatile("" : "+v"(L.tid)); L.lane = L.tid & 63;
        if ((type & 1) == 0) rnn_unit(L, lat, idx >> 3, idx & 7);
        else { if (lat) attn_unit(L, true, idx >> 5, (idx >> 4) & 1, idx & 15); else attn_unit(L, false, idx >> 3, (idx >> 2) & 1, idx & 3); }
    }
}

__device__ __forceinline__ unsigned key16(unsigned b, unsigned idx) { const unsigned s = (b & 0x8000u) ? (~b & 0xffffu) : (b | 0x8000u); return (s << 16) | idx; }
__device__ __forceinline__ float keyval16(unsigned k) { const unsigned s = k >> 16; const unsigned b = (s & 0x8000u) ? (s & 0x7fffu) : (~s & 0xffffu); return bf2f(b); }
__device__ __forceinline__ unsigned sortable32(float f) { const unsigned u = __builtin_bit_cast(unsigned, f); return (u & 0x80000000u) ? ~u : (u | 0x80000000u); }
template <int CTRL> __device__ __forceinline__ unsigned dppu(unsigned v) { return (unsigned)__builtin_amdgcn_update_dpp(0, (int)v, CTRL, 0xf, 0xf, true); }
template <int CTRL> __device__ __forceinline__ float dppf(float v) { return __builtin_bit_cast(float, __builtin_amdgcn_update_dpp(0, __builtin_bit_cast(int, v), CTRL, 0xf, 0xf, true)); }
__device__ __forceinline__ unsigned umax_(unsigned a, unsigned b) { return a > b ? a : b; }
__device__ __forceinline__ unsigned umin_(unsigned a, unsigned b) { return a < b ? a : b; }
__device__ __forceinline__ unsigned rowmax16u(unsigned x) { x = umax_(x, dppu<0xB1>(x)); x = umax_(x, dppu<0x4E>(x)); x = umax_(x, dppu<0x141>(x)); x = umax_(x, dppu<0x140>(x)); return x; }
__device__ __forceinline__ float rowmax16f(float x) { x = fmaxf(x, dppf<0xB1>(x)); x = fmaxf(x, dppf<0x4E>(x)); x = fmaxf(x, dppf<0x141>(x)); x = fmaxf(x, dppf<0x140>(x)); return x; }
__device__ __forceinline__ float rowsum16f(float x) { x += dppf<0xB1>(x); x += dppf<0x4E>(x); x += dppf<0x141>(x); x += dppf<0x140>(x); return x; }
__device__ __forceinline__ int rowsum16i(int x) { x += (int)dppu<0xB1>((unsigned)x); x += (int)dppu<0x4E>((unsigned)x); x += (int)dppu<0x141>((unsigned)x); x += (int)dppu<0x140>((unsigned)x); return x; }
#define CEX(a, b) do { const unsigned _h = umax_(a, b), _l = umin_(a, b); a = _h; b = _l; } while (0)

constexpr int P7_WL = 16384;
constexpr int P7_TL = 0, P7_TE = 1024, P7_TG = 3072, P7_LE = 5120, P7_LG = 6400, P7_LSU = 8960, P7_LS = 11520, P7_H2Q = 12160, P7_HST = 16256;
static_assert(P7_LS + 640 <= P7_H2Q && (P7_H2Q % 16) == 0 && P7_HST + 16 <= P7_WL && P7_WL * 8 <= RING_BYTES, "P7 LDS map");

#define TK_KEYS(R, raw, kb) unsigned R##0 = key16(raw.x & 0xffffu, (kb) + 0), R##1 = key16(raw.x >> 16, (kb) + 1), R##2 = key16(raw.y & 0xffffu, (kb) + 2), R##3 = key16(raw.y >> 16, (kb) + 3), \
        R##4 = key16(raw.z & 0xffffu, (kb) + 4), R##5 = key16(raw.z >> 16, (kb) + 5), R##6 = key16(raw.w & 0xffffu, (kb) + 6), R##7 = key16(raw.w >> 16, (kb) + 7)
#define TK_SORT8(R) do { CEX(R##0, R##1); CEX(R##2, R##3); CEX(R##4, R##5); CEX(R##6, R##7); CEX(R##0, R##2); CEX(R##1, R##3); CEX(R##4, R##6); CEX(R##5, R##7); CEX(R##1, R##2); CEX(R##5, R##6); \
        CEX(R##0, R##4); CEX(R##1, R##5); CEX(R##2, R##6); CEX(R##3, R##7); CEX(R##2, R##4); CEX(R##3, R##5); CEX(R##1, R##2); CEX(R##3, R##4); CEX(R##5, R##6); } while (0)
#define TK_POP8(R, KEEP, it) do { const unsigned m_ = rowmax16u(R##0); const bool w_ = R##0 == m_; R##0 = w_ ? R##1 : R##0; R##1 = w_ ? R##2 : R##1; R##2 = w_ ? R##3 : R##2; R##3 = w_ ? R##4 : R##3; \
        R##4 = w_ ? R##5 : R##4; R##5 = w_ ? R##6 : R##5; R##6 = w_ ? R##7 : R##6; R##7 = w_ ? 0u : R##7; KEEP = (k == (it)) ? m_ : KEEP; } while (0)
#define TK_POP4(C, KEEP, it) do { const unsigned m_ = rowmax16u(C[0]); const bool w_ = C[0] == m_; C[0] = w_ ? C[1] : C[0]; C[1] = w_ ? C[2] : C[1]; C[2] = w_ ? C[3] : C[2]; C[3] = w_ ? 0u : C[3]; KEEP = (k == (it)) ? m_ : KEEP; } while (0)
__device__ __forceinline__ void topk_token(const v4u (&rawv)[4], unsigned* TL, int lane, const unsigned ctabp, int* oute, float* outg) {
    const int k = lane & 15, row = lane >> 4;
#pragma unroll
    for (int pp = 0; pp < 2; ++pp) {
        const v4u rawa = rawv[2 * pp], rawb = rawv[2 * pp + 1];
        TK_KEYS(a, rawa, k * 8); TK_KEYS(b, rawb, k * 8);
        TK_SORT8(a); TK_SORT8(b);
        unsigned keepa = 0, keepb = 0;
#pragma unroll
        for (int it = 0; it < 16; ++it) { TK_POP8(a, keepa, it); TK_POP8(b, keepb, it); }
        TL[((2 * pp) * 4 + row) * 16 + k] = keepa; TL[((2 * pp + 1) * 4 + row) * 16 + k] = keepb;
    }
    unsigned ca[4], cb[4];
    const unsigned* LAa = TL + (2 * row) * 16; const unsigned* LBa = TL + (2 * row + 1) * 16;
    const unsigned* LAb = TL + (2 * (4 + row)) * 16; const unsigned* LBb = TL + (2 * (4 + row) + 1) * 16;
#pragma unroll
    for (int s = 0; s < 4; ++s) { const int ij = (int)((ctabp >> (8 * s)) & 0xffu); const bool valid = ij != 255; const int i = (ij >> 4) & 15, j = ij & 15;
        const float sa = keyval16(LAa[i]) + keyval16(LBa[j]), sb = keyval16(LAb[i]) + keyval16(LBb[j]);
        ca[s] = valid ? ((sortable32(sa) & 0xffffff00u) | (unsigned)(i * 16 + j)) : 0u; cb[s] = valid ? ((sortable32(sb) & 0xffffff00u) | (unsigned)(i * 16 + j)) : 0u; }
    CEX(ca[0], ca[1]); CEX(ca[2], ca[3]); CEX(ca[0], ca[2]); CEX(ca[1], ca[3]); CEX(ca[1], ca[2]);
    CEX(cb[0], cb[1]); CEX(cb[2], cb[3]); CEX(cb[0], cb[2]); CEX(cb[1], cb[3]); CEX(cb[1], cb[2]);
    unsigned keepa = 0, keepb = 0;
#pragma unroll
    for (int it = 0; it < 16; ++it) { TK_POP4(ca, keepa, it); TK_POP4(cb, keepb, it); }
    {
        const unsigned kaa = LAa[(keepa >> 4) & 15], kba = LBa[keepa & 15], kab = LAb[(keepb >> 4) & 15], kbb = LBb[keepb & 15];
        const float bva = keyval16(kaa) + keyval16(kba), bvb = keyval16(kab) + keyval16(kbb);
        const float mxa = rowmax16f(bva), mxb = rowmax16f(bvb); const float exa = __expf(bva - mxa), exb = __expf(bvb - mxb); const float sma = rowsum16f(exa), smb = rowsum16f(exb);
        oute[lane] = (int)((kaa & 127u) * 128u + (kba & 127u)); outg[lane] = exa / sma;
        oute[64 + lane] = (int)((kab & 127u) * 128u + (kbb & 127u)); outg[64 + lane] = exb / smb;
    }
}
#undef TK_KEYS
#undef TK_SORT8
#undef TK_POP8
#undef TK_POP4

__device__ __forceinline__ void gl16(v4u& d, unsigned voff, const unsigned char* sbase) { asm volatile("global_load_dwordx4 %0, %1, %2" : "=v"(d) : "v"(voff), "s"(sbase) : "memory"); }
#define P7_VMWAIT(N, R) asm volatile("s_waitcnt vmcnt(" #N ")" : "+v"(R[0]), "+v"(R[1]), "+v"(R[2]), "+v"(R[3]) :: "memory")
__device__ __forceinline__ int mbcnt64(unsigned long long m) { return (int)__builtin_amdgcn_mbcnt_hi((unsigned)(m >> 32), __builtin_amdgcn_mbcnt_lo((unsigned)m, 0u)); }
__device__ __forceinline__ int rfl(int v) { return __builtin_amdgcn_readfirstlane(v); }
__device__ __forceinline__ float rflf(float v) { return __builtin_bit_cast(float, __builtin_amdgcn_readfirstlane(__builtin_bit_cast(int, v))); }

__device__ __forceinline__ void p7_phase(Frame& F, bool dry) {
    const int lane0 = F.lane, wave = F.wave;
    if (dry && (MK_DRY_SKIP & 16) && wave >= 4) return;
    unsigned char* wl = F.lds + wave * P7_WL;
    unsigned* TL = (unsigned*)(wl + P7_TL); int* TE = (int*)(wl + P7_TE); float* TG = (float*)(wl + P7_TG);
    unsigned short* LE = (unsigned short*)(wl + P7_LE); float* LG = (float*)(wl + P7_LG); float* LSU = (float*)(wl + P7_LSU); unsigned char* LS = wl + P7_LS; unsigned char* H2Q = wl + P7_H2Q; float* HST = (float*)(wl + P7_HST);
    const bf16* SC = (const bf16*)(F.ws + WS_SC); const bf16* H2 = (const bf16*)(F.ws + WS_H);
    const unsigned char* U8 = F.ws + WS_U; const unsigned char* V8 = F.ws + WS_V;
    const float* SU = (const float*)(F.ws + WS_SU); const float* SV = (const float*)(F.ws + WS_SV);
    const float* mods = (const float*)(F.ws + WS_MODS); const float* SSP = (const float*)(F.ws + WS_SSP);
    unsigned ctabp = 0;
#pragma unroll
    for (int s = 0; s < 4; ++s) { const int c = 16 * s + (lane0 & 15); int i, j;
        if (c < 16) { i = 0; j = c; } else if (c < 24) { i = 1; j = c - 16; } else if (c < 29) { i = 2; j = c - 24; } else if (c < 33) { i = 3; j = c - 29; } else if (c < 36) { i = 4; j = c - 33; }
        else if (c < 38) { i = 5; j = c - 36; } else if (c < 40) { i = 6; j = c - 38; } else if (c < 42) { i = 7; j = c - 40; } else if (c < 50) { i = c - 34; j = 0; } else { i = -1; j = 0; }
        ctabp |= (unsigned)(i < 0 ? 255 : i * 16 + j) << (8 * s); }
    const int ntg = NTOK / (F.G * NWAVES * 4);
#pragma unroll 1
    for (int tg = 0; tg < ntg; ++tg) {
        const int tok0 = (F.vcu * ntg + tg) * (NWAVES * 4) + wave * 4;
        int lane = F.lane; asm volatile("" : "+v"(lane));
        {
            v4u craw[4], nraw[4]; v4u ch0, ch1, nh0, nh1;
#define P7_TLOAD(R, H0, H1, tk) do { const bf16* sp_ = SC + (size_t)(tk) * 2048 + (lane >> 4) * 128 + (lane & 15) * 8; \
                _Pragma("unroll") for (int ps = 0; ps < 4; ++ps) R[ps] = *(const v4u*)(sp_ + ps * 512); \
                H0 = *(const v4u*)(H2 + (size_t)(tk) * DM + 16 * lane); H1 = *(const v4u*)(H2 + (size_t)(tk) * DM + 16 * lane + 8); } while (0)
            P7_TLOAD(craw, ch0, ch1, tok0);
#pragma unroll 1
            for (int s = 0; s < 4; ++s) {
                if (s < 3) P7_TLOAD(nraw, nh0, nh1, tok0 + s + 1);
                const int tokc = tok0 + s;
                const f32x4* spp = (const f32x4*)(SSP + (size_t)tokc * 16); const f32x4 q0 = spp[0], q1 = spp[1], q2 = spp[2], q3 = spp[3];
                const float* shp = mods + (size_t)mod_index(tokc) * MODW + 3 * DM + 16 * lane;
                const f32x4 sh0 = *(const f32x4*)(shp), sh1 = *(const f32x4*)(shp + 4), sh2v = *(const f32x4*)(shp + 8), sh3 = *(const f32x4*)(shp + 12);
                topk_token(craw, TL, lane, ctabp, TE + s * 128, TG + s * 128);
                const v4u a = ch0, b = ch1;
                const float ssr = ((q0[0] + q0[1]) + (q0[2] + q0[3])) + ((q1[0] + q1[1]) + (q1[2] + q1[3])) + ((q2[0] + q2[1]) + (q2[2] + q2[3])) + ((q3[0] + q3[1]) + (q3[2] + q3[3]));
                const float rstd = 1.f / sqrtf(ssr * (1.f / DM) + EPS);
                float hv[16];
                hv[0] = bflo(a.x); hv[1] = bfhi(a.x); hv[2] = bflo(a.y); hv[3] = bfhi(a.y); hv[4] = bflo(a.z); hv[5] = bfhi(a.z); hv[6] = bflo(a.w); hv[7] = bfhi(a.w);
                hv[8] = bflo(b.x); hv[9] = bfhi(b.x); hv[10] = bflo(b.y); hv[11] = bfhi(b.y); hv[12] = bflo(b.z); hv[13] = bfhi(b.z); hv[14] = bflo(b.w); hv[15] = bfhi(b.w);
#pragma unroll
                for (int i = 0; i < 4; ++i) { hv[i] = hv[i] * rstd + sh0[i]; hv[4 + i] = hv[4 + i] * rstd + sh1[i]; hv[8 + i] = hv[8 + i] * rstd + sh2v[i]; hv[12 + i] = hv[12 + i] * rstd + sh3[i]; }
                float am = 0.f;
#pragma unroll
                for (int i = 0; i < 16; ++i) am = fmaxf(am, fabsf(hv[i]));
#pragma unroll
                for (int o = 1; o < 64; o <<= 1) am = fmaxf(am, __shfl_xor(am, o));
                const float inv = am > 0.f ? 127.f / am : 0.f;
                if (lane == 0) HST[s] = am * (1.f / 127.f);
                v4u qv;
#pragma unroll
                for (int j = 0; j < 4; ++j) { unsigned w = 0;
#pragma unroll
                    for (int i = 0; i < 4; ++i) { int q = (int)rintf(hv[4 * j + i] * inv); w |= ((unsigned)q & 0xffu) << (8 * i); }
                    qv[j] = w; }
                *(v4u*)(H2Q + s * 1024 + 16 * lane) = qv;
#pragma unroll
                for (int ps = 0; ps < 4; ++ps) craw[ps] = nraw[ps];
                ch0 = nh0; ch1 = nh1;
            }
#undef P7_TLOAD
        }
        int nb;
        {
            int tot[8];
#pragma unroll
            for (int c = 0; c < 8; ++c) tot[c] = 0;
#pragma unroll 1
            for (int s = 0; s < 4; ++s) { const int c0 = TE[s * 128 + lane] >> 11, c1 = TE[s * 128 + 64 + lane] >> 11;
#pragma unroll
                for (int c = 0; c < 8; ++c) { const int n = __popcll(__ballot(c0 == c)) + __popcll(__ballot(c1 == c)); tot[c] += (n + 3) & ~3; } }
            int off[8]; { int base = 0;
#pragma unroll
                for (int c = 0; c < 8; ++c) { off[c] = base; base += tot[c]; }
                { const int pe = ((base + 47) / 48) * 48; if (lane < pe - base) { const int p = base + lane; LE[p] = (unsigned short)0; LG[p] = 0.f; LSU[p] = 0.f; LS[p] = (unsigned char)0; } base = pe; }
            nb = base >> 2; }
#pragma unroll 1
            for (int s = 0; s < 4; ++s) { const int e0 = TE[s * 128 + lane], e1 = TE[s * 128 + 64 + lane]; const float g0 = TG[s * 128 + lane], g1 = TG[s * 128 + 64 + lane]; const int c0 = e0 >> 11, c1 = e1 >> 11;
                const float su0 = SU[e0], su1 = SU[e1], sv0 = SV[e0], sv1 = SV[e1];
#pragma unroll
                for (int c = 0; c < 8; ++c) {
                    const unsigned long long m0 = __ballot(c0 == c), m1 = __ballot(c1 == c);
                    const int n0 = __popcll(m0), n = n0 + __popcll(m1), np = (n + 3) & ~3, base = off[c];
                    if (c0 == c) { const int p = base + mbcnt64(m0); LE[p] = (unsigned short)e0; LG[p] = g0 * sv0; LSU[p] = su0; LS[p] = (unsigned char)s; }
                    if (c1 == c) { const int p = base + n0 + mbcnt64(m1); LE[p] = (unsigned short)e1; LG[p] = g1 * sv1; LSU[p] = su1; LS[p] = (unsigned char)s; }
                    if (lane < np - n) { const int p = base + n + lane; LE[p] = (unsigned short)(c * 2048); LG[p] = 0.f; LSU[p] = 0.f; LS[p] = (unsigned char)s; }
                    off[c] = base + np;
                } }
        }
        if (!(dry && (MK_DRY_SKIP & 1))) {
            int lane_u = F.lane; asm volatile("" : "+v"(lane_u));
            const bool hi32 = lane_u >= 32, b16 = (lane_u & 16) != 0;
            const int xr = ((lane_u >> 5) & 1) | ((lane_u >> 3) & 2);
            const unsigned voff_u = 16u * (unsigned)lane_u;
            v4u ra[4], rb[4], rc[4], rd[4], re[4], rf[4];
#define P7_ULOAD(R, b) do { _Pragma("unroll") for (int x = 0; x < 4; ++x) { const int e = rfl((int)LE[4 * (b) + x]); gl16(R[x], voff_u, U8 + (size_t)e * DM); } } while (0)
#define P7_UCOMP(R, b) do { if (dry && (MK_DRY_SKIP & 8)) { if ((R[0].x ^ R[1].y ^ R[2].z ^ R[3].w) == 0x12345678u) LG[4 * (b)] = 0.f; break; } const int sl = rfl(LS[4 * (b)]); const v4u hq = *(const v4u*)(H2Q + sl * 1024 + 16 * lane_u); int p[4]; \
            _Pragma("unroll") for (int x = 0; x < 4; ++x) { int d = __builtin_amdgcn_sdot4((int)hq.x, (int)R[x].x, 0, false); d = __builtin_amdgcn_sdot4((int)hq.y, (int)R[x].y, d, false); \
                d = __builtin_amdgcn_sdot4((int)hq.z, (int)R[x].z, d, false); d = __builtin_amdgcn_sdot4((int)hq.w, (int)R[x].w, d, false); p[x] = d; } \
            const int t01 = (hi32 ? p[1] : p[0]) + __shfl_xor(hi32 ? p[0] : p[1], 32); const int t23 = (hi32 ? p[3] : p[2]) + __shfl_xor(hi32 ? p[2] : p[3], 32); \
            int t = (b16 ? t23 : t01) + __shfl_xor(b16 ? t01 : t23, 16); t = rowsum16i(t); \
            const int idx = 4 * (b) + xr; const float g = LG[idx]; \
            const float hs = HST[sl]; \
            const float dotf = (float)t * (hs * LSU[idx]); const float cf = g * gelu_tanh(dotf); \
            LG[idx] = cf; } while (0)
            P7_ULOAD(ra, 0); P7_ULOAD(rb, 1); P7_ULOAD(rc, 2); P7_ULOAD(rd, 3); P7_ULOAD(re, 4);
#pragma unroll 1
            for (int b = 0; b < nb; b += 6) {
                P7_ULOAD(rf, b + 5);
                P7_VMWAIT(20, ra); P7_UCOMP(ra, b);
                P7_ULOAD(ra, (b + 6 < nb ? b + 6 : nb - 1));
                P7_VMWAIT(20, rb); P7_UCOMP(rb, b + 1);
                P7_ULOAD(rb, (b + 7 < nb ? b + 7 : nb - 1));
                P7_VMWAIT(20, rc); P7_UCOMP(rc, b + 2);
                P7_ULOAD(rc, (b + 8 < nb ? b + 8 : nb - 1));
                P7_VMWAIT(20, rd); P7_UCOMP(rd, b + 3);
                P7_ULOAD(rd, (b + 9 < nb ? b + 9 : nb - 1));
                P7_VMWAIT(20, re); P7_UCOMP(re, b + 4);
                P7_ULOAD(re, (b + 10 < nb ? b + 10 : nb - 1));
                P7_VMWAIT(20, rf); P7_UCOMP(rf, b + 5);
            }
            asm volatile("s_waitcnt vmcnt(0)" ::: "memory");
#undef P7_ULOAD
#undef P7_UCOMP
        }
        float cscale[4];
        {
            float m0 = 0.f, m1 = 0.f, m2 = 0.f, m3 = 0.f;
            for (int idx = lane; idx < 4 * nb; idx += 64) { const float c = fabsf(LG[idx]); const int sl = LS[idx]; m0 = fmaxf(m0, sl == 0 ? c : 0.f); m1 = fmaxf(m1, sl == 1 ? c : 0.f); m2 = fmaxf(m2, sl == 2 ? c : 0.f); m3 = fmaxf(m3, sl == 3 ? c : 0.f); }
#pragma unroll
            for (int o = 1; o < 64; o <<= 1) { m0 = fmaxf(m0, __shfl_xor(m0, o)); m1 = fmaxf(m1, __shfl_xor(m1, o)); m2 = fmaxf(m2, __shfl_xor(m2, o)); m3 = fmaxf(m3, __shfl_xor(m3, o)); }
            cscale[0] = m0 * (1.f / 127.f); cscale[1] = m1 * (1.f / 127.f); cscale[2] = m2 * (1.f / 127.f); cscale[3] = m3 * (1.f / 127.f);
            const float i0 = m0 > 0.f ? 127.f / m0 : 0.f, i1 = m1 > 0.f ? 127.f / m1 : 0.f, i2 = m2 > 0.f ? 127.f / m2 : 0.f, i3 = m3 > 0.f ? 127.f / m3 : 0.f;
            unsigned char* LQ = (unsigned char*)LSU;
            for (int idx = lane; idx < 4 * nb; idx += 64) { const int sl = LS[idx]; const float iv = sl == 0 ? i0 : (sl == 1 ? i1 : (sl == 2 ? i2 : i3)); LQ[idx] = (unsigned char)((int)rintf(LG[idx] * iv) & 0xff); }
        }
        int acc[4][16];
#pragma unroll
        for (int s = 0; s < 4; ++s) {
#pragma unroll
            for (int i = 0; i < 16; ++i) acc[s][i] = 0; }
        if (!(dry && (MK_DRY_SKIP & 2))) {
            int lane_v = F.lane; asm volatile("" : "+v"(lane_v));
            const int* LQ32 = (const int*)LSU;
            v4u ra[4], rb[4], rc[4], rd[4];
#define P7_VLOAD(R, b) do { _Pragma("unroll") for (int x = 0; x < 4; ++x) { const int e = rfl((int)LE[4 * (b) + x]); R[x] = *(const v4u*)(V8 + (size_t)e * DM + 16 * lane_v); } } while (0)
#define P7_VADD(S, T) do { _Pragma("unroll") for (int i_ = 0; i_ < 16; ++i_) acc[S][i_] += T[i_]; } while (0)
#define P7_VCOMP(R, b) do { const int sl = rfl(LS[4 * (b)]); const int cq = rfl(LQ32[(b)]); int t_[16]; \
                _Pragma("unroll") for (int d = 0; d < 4; ++d) { \
                    const unsigned x_ = __builtin_amdgcn_perm(R[1][d], R[0][d], 0x05010400u), y_ = __builtin_amdgcn_perm(R[1][d], R[0][d], 0x07030602u); \
                    const unsigned c_ = __builtin_amdgcn_perm(R[3][d], R[2][d], 0x05010400u), e_ = __builtin_amdgcn_perm(R[3][d], R[2][d], 0x07030602u); \
                    t_[4 * d + 0] = __builtin_amdgcn_sdot4((int)__builtin_amdgcn_perm(c_, x_, 0x05040100u), cq, 0, false); \
                    t_[4 * d + 1] = __builtin_amdgcn_sdot4((int)__builtin_amdgcn_perm(c_, x_, 0x07060302u), cq, 0, false); \
                    t_[4 * d + 2] = __builtin_amdgcn_sdot4((int)__builtin_amdgcn_perm(e_, y_, 0x05040100u), cq, 0, false); \
                    t_[4 * d + 3] = __builtin_amdgcn_sdot4((int)__builtin_amdgcn_perm(e_, y_, 0x07060302u), cq, 0, false); } \
                if (sl == 0) P7_VADD(0, t_); else if (sl == 1) P7_VADD(1, t_); else if (sl == 2) P7_VADD(2, t_); else P7_VADD(3, t_); } while (0)
            P7_VLOAD(ra, 0); P7_VLOAD(rb, 1); P7_VLOAD(rc, 2);
#pragma unroll 1
            for (int b = 0; b < nb; b += 4) {
                P7_VLOAD(rd, b + 3);
                P7_VCOMP(ra, b);
                P7_VLOAD(ra, (b + 4 < nb ? b + 4 : nb - 1));
                P7_VCOMP(rb, b + 1);
                P7_VLOAD(rb, (b + 5 < nb ? b + 5 : nb - 1));
                P7_VCOMP(rc, b + 2);
                P7_VLOAD(rc, (b + 6 < nb ? b + 6 : nb - 1));
                P7_VCOMP(rd, b + 3);
            }
#undef P7_VLOAD
#undef P7_VADD
#undef P7_VCOMP
        }
#pragma unroll
        for (int s = 0; s < 4; ++s) {
            const int tok = tok0 + s;
            int lane_f = F.lane; asm volatile("" : "+v"(lane_f));
            float* xrow = F.out + O_Y + (size_t)tok * DM + 16 * lane_f;
            float* yrow = dry ? (float*)(F.ws + WS_MIX) + (size_t)(tok & 8191) * DM + 16 * lane_f : xrow;
            const float* ga2 = mods + (size_t)mod_index(tok) * MODW + 5 * DM + 16 * lane_f;
            const float* gf = F.in[I_GFINAL] + 16 * lane_f;
            float x2[16]; float ss = 0.f; const float csc = cscale[s];
#pragma unroll
            for (int j = 0; j < 4; ++j) { const f32x4 xv = *(const f32x4*)(xrow + 4 * j), gv = *(const f32x4*)(ga2 + 4 * j);
#pragma unroll
                for (int i = 0; i < 4; ++i) { const float t = xv[i] + gv[i] * ((float)acc[s][4 * j + i] * csc); x2[4 * j + i] = t; ss += t * t; } }
            const float rstd = 1.f / sqrtf(wave_sum(ss) * (1.f / DM) + EPS);
#pragma unroll
            for (int j = 0; j < 4; ++j) { const f32x4 gv = *(const f32x4*)(gf + 4 * j); f32x4 o;
#pragma unroll
                for (int i = 0; i < 4; ++i) o[i] = x2[4 * j + i] * rstd * gv[i];
                *(f32x4*)(yrow + 4 * j) = o; }
        }
    }
}

__global__ void __launch_bounds__(NWAVES * 64, 2) mk_fwd(Args args) {
    extern __shared__ __attribute__((aligned(16))) unsigned char lds[];
    Frame F;
    F.lds = lds;
    F.tid = threadIdx.x; F.lane = F.tid & 63; F.wave = __builtin_amdgcn_readfirstlane(F.tid >> 6);
    F.G = gridDim.x; { const int bx = blockIdx.x; F.vcu = (F.G % 8 == 0) ? (bx % 8) * (F.G / 8) + bx / 8 : bx; }
    F.in = args.in; F.out = args.out; F.ws = args.ws;
    LAS unsigned char* lds3 = (LAS unsigned char*)lds;
    volatile LAS unsigned* MISC = (volatile LAS unsigned*)(lds3 + MISC_OFF);
    for (int u = F.tid; u < (LDS_BYTES - LDSCTL_OFF) / 4; u += NWAVES * 64) ((LAS unsigned*)(lds3 + LDSCTL_OFF))[u] = 0u;
    __syncthreads();
    unsigned* ctl = (unsigned*)(args.ws + WS_CTL);
    XcdBarrier bar; bar.bar = ctl + CW_BAR; bar.x = 0; bar.st = nullptr;
    const bool one_launch = (args.ph_hi - args.ph_lo) > 1;
    if (one_launch) bar = xcd_barrier_post(ctl + CW_BAR, MISC + 8);
    const int lo = args.ph_lo, hi = args.ph_hi;
#ifndef MK_PHASE_MASK
#define MK_PHASE_MASK 0xff
#endif
#define IN(k) (((MK_PHASE_MASK >> (k)) & 1) && lo <= (k) && (k) < hi)
#define SEAM(k) do { if (IN(k) && IN((k) + 1)) xcd_barrier(bar); } while (0)

#define DUPQ(k) (MK_DUP == (k))
    if (IN(0)) { if (DUPQ(0)) { p0_phase(F); xcd_barrier(bar); } p0_phase(F); SEAM(0); }
    if (IN(1)) { if (DUPQ(1)) { norm_phase(F, 0); xcd_barrier(bar); } norm_phase(F, 0); bias_items(F); SEAM(1); }
    if (IN(2)) {
        pg8::Gemm g{(const pg8::bf16_t*)(F.ws + WS_H), (const pg8::bf16_t*)(F.ws + WS_WIN), NTOK, D_IN, DM}; pg8::StaticOrder S; S.init(NTOK, D_IN, F.G, (int)blockIdx.x);
        EpiInProj E{(bf16*)(F.ws + WS_Q), (bf16*)(F.ws + WS_K), (bf16*)(F.ws + WS_VT), (bf16*)(F.ws + WS_XR), (bf16*)(F.ws + WS_YG), F.out + O_NEWK, F.out + O_NEWV, (const f32x4*)(F.ws + WS_ROPE)};
        if (DUPQ(2)) { pg8::gemm_phase<EpiInProj, pg8::StaticOrder, true, true>(lds3, g, S, E); xcd_barrier(bar); }
        pg8::gemm_phase<EpiInProj, pg8::StaticOrder, true, true>(lds3, g, S, E);
        SEAM(2);
    }
    if (IN(3)) { if (DUPQ(3)) { p3_phase(F, MK_P3_TYPES); xcd_barrier(bar); } p3_phase(F); SEAM(3); }
    if (IN(4)) {
        pg8::Gemm g{(const pg8::bf16_t*)(F.ws + WS_MIX), (const pg8::bf16_t*)(F.ws + WS_WOUT), NTOK, DM, DM}; pg8::StaticOrder S; S.init(NTOK, DM, F.G, (int)blockIdx.x);
        EpiOutProj E{F.in[I_XP], F.in[I_XS], (const float*)(F.ws + WS_MODS), F.in[I_GFFN], F.out + O_Y, (bf16*)(F.ws + WS_H), (float*)(F.ws + WS_SSP)};
        if (DUPQ(4)) { pg8::gemm_phase<EpiOutProj, pg8::StaticOrder, true, true>(lds3, g, S, E); xcd_barrier(bar); }
        pg8::gemm_phase<EpiOutProj, pg8::StaticOrder, true, true>(lds3, g, S, E);
        SEAM(4);
    }
    if (IN(6)) {
        pg8::Gemm g{(const pg8::bf16_t*)(F.ws + WS_H), (const pg8::bf16_t*)(F.ws + WS_WC), NTOK, 2048, DM}; pg8::StaticOrder S; S.init(NTOK, 2048, F.G, (int)blockIdx.x);
        EpiScores E{(bf16*)(F.ws + WS_SC), (const float*)(F.ws + WS_SSP), (const float*)(F.ws + WS_BIAS)};
        if (DUPQ(6)) { pg8::gemm_phase<EpiScores, pg8::StaticOrder, true, true>(lds3, g, S, E); xcd_barrier(bar); }
        pg8::gemm_phase<EpiScores, pg8::StaticOrder, true, true>(lds3, g, S, E);
        SEAM(6);
    }
    if (IN(7)) { if (DUPQ(7)) { p7_phase(F, true); xcd_barrier(bar); } p7_phase(F, false); }
#undef IN
#undef SEAM
}

extern "C" void kernel_launch(void* const* d_in, const int* in_sizes, int n_in, void* d_out, int out_size, void* d_ws, size_t ws_size, hipStream_t stream) {
    static int grid = 0;
    if (grid == 0) {
        if (n_in != 26 || ws_size < WS_END) { fprintf(stderr, "kernel_launch: unexpected n_in %d / ws %zu\n", n_in, ws_size); grid = -1; return; }
        int dev = 0, cus = 0, per_cu = 0;
        if (hipGetDevice(&dev) != hipSuccess || hipDeviceGetAttribute(&cus, hipDeviceAttributeMultiprocessorCount, dev) != hipSuccess) { grid = -1; return; }
        if (hipFuncSetAttribute((const void*)mk_fwd, hipFuncAttributeMaxDynamicSharedMemorySize, LDS_BYTES) != hipSuccess) { fprintf(stderr, "kernel_launch: hipFuncSetAttribute failed\n"); grid = -1; return; }
        if (hipOccupancyMaxActiveBlocksPerMultiprocessor(&per_cu, (const void*)mk_fwd, NWAVES * 64, LDS_BYTES) != hipSuccess || per_cu < 1)
            fprintf(stderr, "kernel_launch: occupancy query reports %d blocks per CU\n", per_cu);
        (void)hipGetLastError();
        grid = cus;
        if (grid != 256) fprintf(stderr, "kernel_launch: note: %d CUs\n", grid);
    }
    if (grid < 0) return;
    (void)hipMemsetAsync((char*)d_ws + WS_CTL, 0, CTL_ZERO_BYTES, stream);
    Args a{};
    for (int i = 0; i < 26; ++i) a.in[i] = (const float*)d_in[i];
    a.out = (float*)d_out; a.ws = (unsigned char*)d_ws;
    if (MK_N_LAUNCHES == 1) {
        a.ph_lo = 0; a.ph_hi = N_PHASES; a.li = 0;
        hipLaunchKernelGGL(mk_fwd, dim3(grid), dim3(NWAVES * 64), LDS_BYTES, stream, a);
    } else {
        for (int li = 0; li < N_PHASES; ++li) { a.ph_lo = li; a.ph_hi = li + 1; a.li = li;
            hipLaunchKernelGGL(mk_fwd, dim3(grid), dim3(NWAVES * 64), LDS_BYTES, stream, a); }
    }
}
```

```cpp
#include <hip/hip_runtime.h>
#include <cstdio>
#include <cstdint>

#ifndef MK_DUP
#define MK_DUP -1
#endif
#ifndef MK_DRY_SKIP
#define MK_DRY_SKIP 0
#endif
#ifndef MK_N_LAUNCHES
#define MK_N_LAUNCHES 1
#endif

namespace pg8 {
#define PG8_LAS __attribute__((address_space(3)))
typedef unsigned short bf16_t;
typedef short bf16x8 __attribute__((ext_vector_type(8)));
typedef float f32x4 __attribute__((ext_vector_type(4)));
typedef unsigned u32x4 __attribute__((ext_vector_type(4)));
typedef unsigned u32x2 __attribute__((ext_vector_type(2)));
constexpr int BM = 256, BK = 64, HALF = 128, HTB = HALF * BK * 2, STAGE_BYTES = 8 * HTB, NXCD = 8, WGM = 8;

__host__ __device__ __forceinline__ int lds_byte(int r, int c) { const int st = (r >> 4) * 2 + (c >> 5), rr = r & 15, cc = c & 31, ob = rr * 64 + cc * 2; return st * 1024 + (ob ^ (((ob >> 9) & 1) << 5)); }
__host__ __device__ __forceinline__ void stage_rc(int b, int& R, int& C) { const int st = b / 1024, sb = b % 1024, swz = sb ^ (((sb >> 9) & 1) << 5); R = (st >> 1) * 16 + swz / 64; C = (st & 1) * 32 + (swz % 64) / 2; }
__host__ __device__ __forceinline__ int perm32(int rho) { const int n = rho >> 4, i = rho & 15; return 8 * (i >> 2) + 4 * n + (i & 3); }

struct Unit { int pm, pn; };
struct Gemm { const bf16_t* A; const bf16_t* Bt; int M, N, K; };

struct StaticOrder {
    int nM, nN, nwg, G, c;
    __host__ __device__ void init(int M, int N, int G_, int c_) { nM = M / BM; nN = N / BM; nwg = nM * nN; G = G_; c = c_; }
    __host__ __device__ bool next(int i, Unit& u) const {
        const long L = (long)i * G + c; if (L >= nwg) return false;
        int wgid = (int)L; { const int q = nwg / NXCD, r = nwg % NXCD, xcd = wgid % NXCD, off = wgid / NXCD; wgid = (xcd < r ? xcd * (q + 1) : r * (q + 1) + (xcd - r) * q) + off; }
        const int nig = WGM * nN, gid = wgid / nig, fm = gid * WGM, gsz = (nM - fm) < WGM ? (nM - fm) : WGM;
        u.pm = fm + ((wgid % nig) % gsz); u.pn = (wgid % nig) / gsz; return true;
    }
    __device__ __forceinline__ void a_ready(const Unit&) const {}
    __device__ __forceinline__ void done(const Unit&) const {}
};

__device__ __forceinline__ unsigned cvt_pk_bf16(float lo, float hi) { unsigned r; asm volatile("v_cvt_pk_bf16_f32 %0, %1, %2" : "=v"(r) : "v"(lo), "v"(hi)); return r; }

template <class Epi, class Sched, bool ALIGN_EPI = false, bool SP2 = false>
__device__ __forceinline__ void gemm_phase(PG8_LAS unsigned char* lds, const Gemm g, const Sched& S, const Epi& E) {
    const int tid = threadIdx.x, wid = __builtin_amdgcn_readfirstlane(tid >> 6), lane = tid & 63, wr = wid >> 2, wc = wid & 3, fr = lane & 15, fq = lane >> 4;
    const int K = g.K, nt = K / BK;
    unsigned voffA[2], voffB[2];
#pragma unroll
    for (int i = 0; i < 2; ++i) { int R, C; stage_rc(tid * 16 + i * 8192, R, C); const int Rb = Epi::PERM ? ((R & ~31) + perm32(R & 31)) : R;
        voffA[i] = (unsigned)(R * K + C) * 2u; voffB[i] = (unsigned)(Rb * K + C) * 2u; }
    const size_t kstep = (size_t)(BK * 2);
    const size_t hstep = (size_t)HALF * K * 2;
    const size_t tstep = 2 * hstep;
    const unsigned ldsw = (unsigned)wid * 1024u;
    const int aoff = lds_byte(wr * 64 + fr, fq * 8), boff = lds_byte(wc * 32 + fr, fq * 8);
#define PG8_SA(b, h) (((b) * 2 + (h)) * HTB)
#define PG8_SB(b, h) ((4 + (b) * 2 + (h)) * HTB)
#define PG8_STAGE(bufoff, gbase, voff) do { _Pragma("unroll") for (int _i = 0; _i < 2; ++_i) \
        __builtin_amdgcn_global_load_lds((const unsigned*)((const char*)(gbase) + (voff)[_i]), (PG8_LAS unsigned*)(lds + (bufoff) + ldsw + _i * 8192), 16, 0, 0); } while (0)
#define PG8_LDA(dst, b, h) do { _Pragma("unroll") for (int m = 0; m < 4; ++m) _Pragma("unroll") for (int k = 0; k < 2; ++k) dst[m][k] = *(const PG8_LAS bf16x8*)(lds + PG8_SA(b, h) + aoff + m * 2048 + k * 1024); } while (0)
#define PG8_LDB(dst, b, h) do { _Pragma("unroll") for (int n = 0; n < 2; ++n) _Pragma("unroll") for (int k = 0; k < 2; ++k) dst[n][k] = *(const PG8_LAS bf16x8*)(lds + PG8_SB(b, h) + boff + n * 2048 + k * 1024); } while (0)
#define PG8_MMA(ai, bj, At, Bt) do { __builtin_amdgcn_s_setprio(1); _Pragma("unroll") for (int m = 0; m < 4; ++m) _Pragma("unroll") for (int n = 0; n < 2; ++n) _Pragma("unroll") for (int k = 0; k < 2; ++k) \
        acc[ai][bj][m][n] = __builtin_amdgcn_mfma_f32_16x16x32_bf16(Bt[n][k], At[m][k], acc[ai][bj][m][n], 0, 0, 0); __builtin_amdgcn_s_setprio(0); } while (0)
#define PG8_WAIT_V(n) asm volatile("s_waitcnt vmcnt(" #n ")" ::: "memory")
#define PG8_WAIT_L(n) asm volatile("s_waitcnt lgkmcnt(" #n ")" ::: "memory")
#define PG8_BAR __builtin_amdgcn_s_barrier()
#define PG8_SCHED __builtin_amdgcn_sched_barrier(0)
    Unit cur, nxt; int ui = 0;
    if (!S.next(0, cur)) return;
    f32x4 acc[2][2][4][2];
#pragma unroll
    for (int a = 0; a < 2; ++a)
#pragma unroll
        for (int b = 0; b < 2; ++b)
#pragma unroll
            for (int m = 0; m < 4; ++m)
#pragma unroll
                for (int n = 0; n < 2; ++n) acc[a][b][m][n] = (f32x4){0.f, 0.f, 0.f, 0.f};
    bf16x8 At[4][2], B0[2][2], B1[2][2];
    const char* cA = (const char*)g.A + (size_t)cur.pm * tstep; const char* cB = (const char*)g.Bt + (size_t)cur.pn * tstep;
    S.a_ready(cur);
    if constexpr (SP2) {
        PG8_STAGE(PG8_SB(0, 0), cB, voffB); PG8_STAGE(PG8_SB(0, 1), cB + hstep, voffB); PG8_STAGE(PG8_SA(0, 0), cA, voffA); PG8_STAGE(PG8_SA(0, 1), cA + hstep, voffA);
        if (wr == 1) PG8_BAR;
        PG8_WAIT_V(2); PG8_BAR;
        PG8_STAGE(PG8_SB(1, 0), cB + kstep, voffB); PG8_STAGE(PG8_SA(1, 0), cA + kstep, voffA); PG8_STAGE(PG8_SB(1, 1), cB + hstep + kstep, voffB);
        PG8_WAIT_V(6); PG8_BAR;
    } else {
        PG8_STAGE(PG8_SB(0, 0), cB, voffB); PG8_STAGE(PG8_SA(0, 0), cA, voffA); PG8_STAGE(PG8_SB(0, 1), cB + hstep, voffB); PG8_STAGE(PG8_SA(0, 1), cA + hstep, voffA);
        if (wr == 1) PG8_BAR;
        PG8_WAIT_V(4); PG8_BAR;
        PG8_STAGE(PG8_SB(1, 0), cB + kstep, voffB); PG8_STAGE(PG8_SA(1, 0), cA + kstep, voffA); PG8_STAGE(PG8_SB(1, 1), cB + hstep + kstep, voffB);
        PG8_WAIT_V(6); PG8_BAR;
    }
    for (;;) {
        const bool has_next = S.next(ui + 1, nxt);
        const char* nA = has_next ? (const char*)g.A + (size_t)nxt.pm * tstep : cA; const char* nB = has_next ? (const char*)g.Bt + (size_t)nxt.pn * tstep : cB;
        for (int t = 0; t < nt; t += 2) {
            const bool last = (t == nt - 2);
            const char* a1 = cA + (size_t)(t + 1) * kstep;
            const char* a2 = last ? nA : cA + (size_t)(t + 2) * kstep; const char* b2 = last ? nB : cB + (size_t)(t + 2) * kstep;
            const char* a3 = a2 + kstep; const char* b3 = b2 + kstep;
            if (last && has_next) S.a_ready(nxt);
            if constexpr (SP2) {
            PG8_LDB(B0, 0, 0); PG8_LDB(B1, 0, 1); PG8_SCHED; PG8_LDA(At, 0, 0); PG8_STAGE(PG8_SA(1, 1), a1 + hstep, voffA);
            PG8_WAIT_V(8); PG8_WAIT_L(0); PG8_BAR; PG8_MMA(0, 0, At, B0); PG8_MMA(0, 1, At, B1); PG8_BAR; PG8_SCHED;
            PG8_LDA(At, 0, 1); PG8_STAGE(PG8_SB(0, 0), b2, voffB); PG8_STAGE(PG8_SB(0, 1), b2 + hstep, voffB); PG8_STAGE(PG8_SA(0, 0), a2, voffA);
            PG8_WAIT_V(8); PG8_WAIT_L(0); PG8_BAR; PG8_MMA(1, 0, At, B0); PG8_MMA(1, 1, At, B1); PG8_BAR; PG8_SCHED;
            PG8_LDB(B0, 1, 0); PG8_LDB(B1, 1, 1); PG8_SCHED; PG8_LDA(At, 1, 0); PG8_STAGE(PG8_SA(0, 1), a2 + hstep, voffA);
            PG8_WAIT_V(8); PG8_WAIT_L(0); PG8_BAR; PG8_MMA(0, 0, At, B0); PG8_MMA(0, 1, At, B1); PG8_BAR; PG8_SCHED;
            PG8_LDA(At, 1, 1); PG8_STAGE(PG8_SB(1, 0), b3, voffB); PG8_STAGE(PG8_SB(1, 1), b3 + hstep, voffB); PG8_STAGE(PG8_SA(1, 0), a3, voffA);
            PG8_WAIT_V(8); PG8_WAIT_L(0); PG8_BAR; PG8_MMA(1, 0, At, B0); PG8_MMA(1, 1, At, B1); PG8_BAR; PG8_SCHED;
            } else {
            PG8_LDB(B0, 0, 0); PG8_SCHED; PG8_LDA(At, 0, 0); PG8_STAGE(PG8_SA(1, 1), a1 + hstep, voffA);
            PG8_WAIT_L(8); PG8_BAR; PG8_WAIT_L(0); PG8_MMA(0, 0, At, B0); PG8_BAR; PG8_SCHED;
            PG8_LDB(B1, 0, 1); PG8_STAGE(PG8_SB(0, 0), b2, voffB);
            PG8_BAR; PG8_WAIT_L(0); PG8_MMA(0, 1, At, B1); PG8_BAR;
            PG8_LDA(At, 0, 1); PG8_STAGE(PG8_SA(0, 0), a2, voffA);
            PG8_BAR; PG8_WAIT_L(0); PG8_MMA(1, 0, At, B0); PG8_BAR; PG8_SCHED;
            PG8_STAGE(PG8_SB(0, 1), b2 + hstep, voffB);
            PG8_WAIT_V(6); PG8_BAR; PG8_MMA(1, 1, At, B1); PG8_BAR;
            PG8_LDB(B0, 1, 0); PG8_SCHED; PG8_LDA(At, 1, 0); PG8_STAGE(PG8_SA(0, 1), a2 + hstep, voffA);
            PG8_WAIT_L(8); PG8_BAR; PG8_WAIT_L(0); PG8_MMA(0, 0, At, B0); PG8_BAR; PG8_SCHED;
            PG8_LDB(B1, 1, 1); PG8_STAGE(PG8_SB(1, 0), b3, voffB);
            PG8_BAR; PG8_WAIT_L(0); PG8_MMA(0, 1, At, B1); PG8_BAR;
            PG8_LDA(At, 1, 1); PG8_STAGE(PG8_SA(1, 0), a3, voffA);
            PG8_BAR; PG8_WAIT_L(0); PG8_MMA(1, 0, At, B0); PG8_BAR; PG8_SCHED;
            PG8_STAGE(PG8_SB(1, 1), b3 + hstep, voffB);
            PG8_WAIT_V(6); PG8_BAR; PG8_MMA(1, 1, At, B1); PG8_BAR;
            }
        }
        if constexpr (ALIGN_EPI) { if (wr == 0) PG8_BAR; }
        E(acc, cur, wr, wc, fr, fq); S.done(cur);
        if (!has_next) break;
#pragma unroll
        for (int a = 0; a < 2; ++a)
#pragma unroll
            for (int b = 0; b < 2; ++b)
#pragma unroll
                for (int m = 0; m < 4; ++m)
#pragma unroll
                    for (int n = 0; n < 2; ++n) acc[a][b][m][n] = (f32x4){0.f, 0.f, 0.f, 0.f};
        cur = nxt; cA = nA; cB = nB; ++ui;
        if constexpr (ALIGN_EPI) { if (wr == 1) PG8_BAR; }
    }
    PG8_WAIT_V(0);
    if constexpr (!ALIGN_EPI) { if (wr == 0) PG8_BAR; }
    PG8_BAR;
#undef PG8_SA
#undef PG8_SB
#undef PG8_STAGE
#undef PG8_LDA
#undef PG8_LDB
#undef PG8_MMA
#undef PG8_WAIT_V
#undef PG8_WAIT_L
#undef PG8_BAR
#undef PG8_SCHED
}
}

constexpr int NWAVES = 8;
constexpr int DM = 1024, NTOK = 16384, NCTX = 8192, D_IN = 1792, NMODV = 9, MODW = 6144;
constexpr int SEQ_C = 256, SEQ_L = 1024, NSEQ_C = 32, NSEQ_L = 8;
constexpr int N_PHASES = 8;
constexpr float LOG2E = 1.4426950408889634f;
constexpr float QSCALE = 0.125f * LOG2E;
constexpr float EPS = 1e-6f;

constexpr size_t MiB = 1u << 20, KiB = 1u << 10;
constexpr size_t WS_CTL = 0, CTL_ZERO_BYTES = 64 * KiB;
constexpr size_t WS_MODS = 1 * MiB;
constexpr size_t WS_ROPE = 1 * MiB + 256 * KiB;
constexpr size_t WS_RGW  = 1 * MiB + 512 * KiB;
constexpr size_t WS_CK   = 1 * MiB + 768 * KiB;
constexpr size_t WS_CVT  = 2 * MiB + 256 * KiB;
constexpr size_t WS_WIN  = 3 * MiB;
constexpr size_t WS_WOUT = 7 * MiB;
constexpr size_t WS_WC   = 9 * MiB;
constexpr size_t WS_U    = 16 * MiB;
constexpr size_t WS_SSP  = 14 * MiB;
constexpr size_t WS_BIAS = 15 * MiB;
constexpr size_t WS_SU   = 13 * MiB;
constexpr size_t WS_SV   = 13 * MiB + 64 * KiB;
constexpr size_t WS_V    = 48 * MiB;
constexpr size_t WS_H    = 80 * MiB;
constexpr size_t WS_MIX  = 112 * MiB;
constexpr size_t WS_Q    = 144 * MiB;
constexpr size_t WS_K    = 160 * MiB;
constexpr size_t WS_VT   = 164 * MiB;
constexpr size_t WS_XR   = 168 * MiB;
constexpr size_t WS_YG   = 184 * MiB;
constexpr size_t WS_HF   = 200 * MiB;
constexpr size_t WS_SC   = 144 * MiB;
constexpr size_t WS_END  = 232 * MiB;
constexpr int VT_LAT_OFF = NSEQ_C * 2 * 64 * SEQ_C;

constexpr int CW_BAR = 4096;

constexpr int RING_BYTES = 131072;
constexpr int LDSCTL_OFF = 146944, MISC_OFF = LDSCTL_OFF + 320;
constexpr int LDS_BYTES = 147456;

#define GAS __attribute__((address_space(1)))
#define LAS __attribute__((address_space(3)))
typedef unsigned short bf16;
typedef unsigned v4u __attribute__((ext_vector_type(4)));
typedef unsigned v2u __attribute__((ext_vector_type(2)));
typedef float f32x4 __attribute__((ext_vector_type(4)));
typedef float f32x2 __attribute__((ext_vector_type(2)));
typedef float f32x16 __attribute__((ext_vector_type(16)));
typedef short bf16x8 __attribute__((ext_vector_type(8)));
typedef GAS unsigned gu32;
#define RLX_AGENT __ATOMIC_RELAXED, __HIP_MEMORY_SCOPE_AGENT

__device__ __forceinline__ unsigned f2bf(float f) { unsigned u = __builtin_bit_cast(unsigned, f); return (u + 0x7fffu + ((u >> 16) & 1u)) >> 16; }
typedef float f32x2_t_ __attribute__((ext_vector_type(2))); typedef __bf16 bf16x2_t_ __attribute__((ext_vector_type(2)));
__device__ __forceinline__ unsigned pk2(float lo, float hi) { f32x2_t_ v = {lo, hi}; bf16x2_t_ b = __builtin_convertvector(v, bf16x2_t_); return __builtin_bit_cast(unsigned, b); }
__device__ __forceinline__ float bf2f(unsigned b) { return __builtin_bit_cast(float, b << 16); }
__device__ __forceinline__ float bflo(unsigned w) { return __builtin_bit_cast(float, w << 16); }
__device__ __forceinline__ float bfhi(unsigned w) { return __builtin_bit_cast(float, w & 0xffff0000u); }
__device__ __forceinline__ float sigmoidf_(float x) { return 1.f / (1.f + __expf(-x)); }
__device__ __forceinline__ float gelu_tanh(float x) { const float y = 0.7978845608028654f * (x + 0.044715f * x * x * x); const float e = __expf(2.f * y); return 0.5f * x * (2.f - 2.f / (1.f + e)); }
template <int CTRL> __device__ __forceinline__ float dppf_(float v) { return __builtin_bit_cast(float, __builtin_amdgcn_update_dpp(0, __builtin_bit_cast(int, v), CTRL, 0xf, 0xf, true)); }
__device__ __forceinline__ float xrow16_(float v) {
    unsigned a = __builtin_bit_cast(unsigned, v), b = a; asm volatile("" : "+v"(b));
    const auto r = __builtin_amdgcn_permlane16_swap(a, b, false, false);
    const bool odd = (threadIdx.x & 16) != 0; return __builtin_bit_cast(float, odd ? r[0] : r[1]);
}
__device__ __forceinline__ float xhalf32_(float v) {
    unsigned a = __builtin_bit_cast(unsigned, v), b = a; asm volatile("" : "+v"(b));
    const auto r = __builtin_amdgcn_permlane32_swap(a, b, false, false);
    const bool hi = (threadIdx.x & 32) != 0; return __builtin_bit_cast(float, hi ? r[0] : r[1]);
}
__device__ __forceinline__ float wave_sum(float v) {
    v += dppf_<0xB1>(v); v += dppf_<0x4E>(v); v += dppf_<0x141>(v); v += dppf_<0x140>(v);
    v += xrow16_(v); v += xhalf32_(v); return v;
}
__device__ __forceinline__ float wave_max(float v) {
    v = fmaxf(v, dppf_<0xB1>(v)); v = fmaxf(v, dppf_<0x4E>(v)); v = fmaxf(v, dppf_<0x141>(v)); v = fmaxf(v, dppf_<0x140>(v));
    v = fmaxf(v, xrow16_(v)); v = fmaxf(v, xhalf32_(v)); return v;
}
__device__ __forceinline__ int crow(int r, int hi) { return (r & 3) + 8 * (r >> 2) + 4 * hi; }

#define XB_TMO      128
#define XB_XCNT(j)  (256  + 64 * (j))
#define XB_XSUB(j)  (1280 + 64 * (j))
#define XB_XGEN(j)  (2304 + 64 * (j))
#define XB_TOP      3328
#define XB_TOPGEN   3392
#define XCD_BAR_WORDS 3456
#define XB_SPIN_CAP (1u << 18)
__device__ __forceinline__ unsigned xb_ld(unsigned* p)              { return __hip_atomic_load(p, __ATOMIC_RELAXED, __HIP_MEMORY_SCOPE_AGENT); }
__device__ __forceinline__ unsigned xb_add(unsigned* p, unsigned v) { return __hip_atomic_fetch_add(p, v, __ATOMIC_RELAXED, __HIP_MEMORY_SCOPE_AGENT); }
__device__ __forceinline__ unsigned xb_xcc_id() { return (unsigned)__builtin_amdgcn_s_getreg((3 << 11) | 20) & 0xFu; }
#define XB_SPIN(cond, bar) do { unsigned _sp = 0; while (cond) { __builtin_amdgcn_s_sleep(1); \
    if ((++_sp & 255u) == 0u) { if (xb_ld(&(bar)[XB_TMO])) break; if (_sp > XB_SPIN_CAP) { atomicAdd(&(bar)[XB_TMO], 1u); break; } } } } while (0)
struct XcdBarrier { unsigned* bar; unsigned x; volatile LAS unsigned* st; };
__device__ __forceinline__ XcdBarrier xcd_barrier_post(unsigned* bar, volatile LAS unsigned* st) {
    XcdBarrier b; b.bar = bar; b.x = xb_xcc_id(); b.st = st;
    if (threadIdx.x == 0) (void)xb_add(&bar[XB_XCNT(b.x)], 1u);
    return b;
}
__device__ __forceinline__ void xcd_barrier_complete(unsigned* bar, unsigned x, unsigned& nloc, unsigned& nx) {
    const unsigned G = gridDim.x * gridDim.y * gridDim.z;
    unsigned sum, cnt, mine, sp = 0u;
    for (;;) {
        sum = 0u; cnt = 0u; mine = 0u;
#pragma unroll
        for (unsigned j = 0; j < 16; ++j) { const unsigned c = xb_ld(&bar[XB_XCNT(j)]); sum += c; cnt += (c > 0u) ? 1u : 0u; mine = (j == x) ? c : mine; }
        if (sum == G) break;
        __builtin_amdgcn_s_sleep(1);
        if ((++sp & 255u) == 0u) { if (xb_ld(&bar[XB_TMO])) break; if (sp > XB_SPIN_CAP) { atomicAdd(&bar[XB_TMO], 1u); break; } }
    }
    nloc = mine > 0u ? mine : 1u; nx = cnt > 0u ? cnt : 1u;
}
__device__ __forceinline__ void xcd_barrier(const XcdBarrier& b) {
    asm volatile("s_waitcnt vmcnt(0)" ::: "memory");
    __syncthreads();
    if (threadIdx.x == 0) {
        unsigned* bar = b.bar;
        __builtin_amdgcn_s_waitcnt(0);
        unsigned nloc = b.st[0], nx = b.st[1];
        if (nloc == 0u) { xcd_barrier_complete(bar, b.x, nloc, nx); b.st[0] = nloc; b.st[1] = nx; }
        const unsigned old = xb_add(&bar[XB_XSUB(b.x)], 1u);
        const unsigned gen = old / nloc;
        if (old + 1u == (gen + 1u) * nloc) {
            __builtin_amdgcn_fence(__ATOMIC_RELEASE, "agent");
            asm volatile("s_waitcnt vmcnt(0)" ::: "memory");
            const unsigned og = xb_add(&bar[XB_TOP], 1u);
            const unsigned tg = og / nx;
            if (og + 1u == (tg + 1u) * nx) xb_add(&bar[XB_TOPGEN], 1u);
            else XB_SPIN(xb_ld(&bar[XB_TOPGEN]) == tg, bar);
            __builtin_amdgcn_fence(__ATOMIC_ACQUIRE, "agent");
            xb_add(&bar[XB_XGEN(b.x)], 1u);
            asm volatile("s_waitcnt vmcnt(0)" ::: "memory");
        } else {
            XB_SPIN(xb_ld(&bar[XB_XGEN(b.x)]) == gen, bar);
            __builtin_amdgcn_fence(__ATOMIC_ACQUIRE, "agent");
            asm volatile("s_waitcnt vmcnt(0)" ::: "memory");
        }
    }
    __syncthreads();
}

struct Args { const float* in[26]; float* out; unsigned char* ws; int ph_lo, ph_hi, li, pad; };

struct Frame {
    unsigned char* lds;
    int tid, lane, wave, vcu, G;
    const float* const* in;
    float* out; unsigned char* ws;
};
enum { I_XP = 0, I_XS, I_CK, I_CV, I_SRNN, I_C, I_CCTX, I_WMOD, I_BMOD, I_GMIX, I_GFFN, I_WIN, I_CONVW, I_CONVB, I_RGWA, I_RGBA, I_RGWI, I_RGBI, I_RGLAM, I_SINK, I_WOUT, I_PWQ, I_PSK, I_PU, I_PV, I_GFINAL };
constexpr size_t O_Y = 0, O_NEWK = (size_t)NTOK * DM, O_NEWV = O_NEWK + (size_t)NCTX * 128, O_NEWRNN = O_NEWV + (size_t)NCTX * 128;

__device__ __forceinline__ int mod_index(int tok) { return tok < NCTX ? 0 : 1 + ((tok - NCTX) >> 10); }
__device__ __forceinline__ const float* x_row(const Frame& F, int tok) { return tok < NCTX ? F.in[I_XP] + (size_t)tok * DM : F.in[I_XS] + (size_t)(tok - NCTX) * DM; }

template <class RowMap>
__device__ __forceinline__ void p0_transpose_item(const float* W, int K, int N, bf16* WT, float* scr, int item, int lane, RowMap rowmap, float scale = 1.f) {
    const int nblk = N / 32, kb = item / nblk, nb = item % nblk, k0 = 64 * kb, n0 = 32 * nb;
#pragma unroll 8
    for (int i = 0; i < 32; ++i) { const int kk = 2 * i + (lane >> 5); scr[kk * 33 + (lane & 31)] = W[(size_t)(k0 + kk) * N + n0 + (lane & 31)]; }
    __builtin_amdgcn_s_waitcnt(0xC07F); asm volatile("" ::: "memory");
    const int c = lane & 7;
#pragma unroll
    for (int j = 0; j < 4; ++j) { const int n = (lane >> 3) + 8 * j; const float* s = scr + (8 * c) * 33 + n;
        v4u o; o.x = pk2(s[0 * 33] * scale, s[1 * 33] * scale); o.y = pk2(s[2 * 33] * scale, s[3 * 33] * scale); o.z = pk2(s[4 * 33] * scale, s[5 * 33] * scale); o.w = pk2(s[6 * 33] * scale, s[7 * 33] * scale);
        *(v4u*)(WT + (size_t)rowmap(n0 + n) * K + k0 + 8 * c) = o; }
    __builtin_amdgcn_s_waitcnt(0xC07F); asm volatile("" ::: "memory");
}
struct MapId { __device__ __forceinline__ int operator()(int n) const { return n; } };
struct MapWin { __device__ __forceinline__ int operator()(int n) const { if (n >= 640) return n; const int hb = n & ~63, o = n & 63; return hb + ((o & 31) << 1) + (o >> 5); } };

__device__ __forceinline__ void p0_phase(Frame& F) {
    float* ldsf = (float*)F.lds;
    const int tid = F.tid, lane = F.lane, wave = F.wave, v = F.vcu;
    if (v < 192) {
        for (int i = tid; i < NMODV * DM; i += 512) { const int j = i >> 10, d = i & 1023; const float c = (j == 0) ? F.in[I_CCTX][d] : F.in[I_C][(j - 1) * DM + d]; ldsf[i] = c * sigmoidf_(c); }
        __syncthreads();
        const int e0 = 32 * v, c4 = tid & 7, kq = tid >> 3;
        float acc[NMODV][4];
#pragma unroll
        for (int j = 0; j < NMODV; ++j) { acc[j][0] = 0.f; acc[j][1] = 0.f; acc[j][2] = 0.f; acc[j][3] = 0.f; }
        const float* wm = F.in[I_WMOD] + e0 + 4 * c4;
#pragma unroll 4
        for (int kk = 0; kk < 16; ++kk) { const int k = kq * 16 + kk; const f32x4 w = *(const f32x4*)(wm + (size_t)k * MODW);
#pragma unroll
            for (int j = 0; j < NMODV; ++j) { const float s = ldsf[j * DM + k]; acc[j][0] += s * w[0]; acc[j][1] += s * w[1]; acc[j][2] += s * w[2]; acc[j][3] += s * w[3]; } }
#pragma unroll
        for (int j = 0; j < NMODV; ++j)
#pragma unroll
            for (int i = 0; i < 4; ++i) { float a = acc[j][i]; a += __shfl_xor(a, 8); a += __shfl_xor(a, 16); a += __shfl_xor(a, 32); acc[j][i] = a; }
        float* red = ldsf + NMODV * DM;
        if (lane < 8) {
#pragma unroll
            for (int j = 0; j < NMODV; ++j)
#pragma unroll
                for (int i = 0; i < 4; ++i) red[(wave * NMODV + j) * 32 + 4 * c4 + i] = acc[j][i];
        }
        __syncthreads();
        if (tid < NMODV * 32) { const int j = tid >> 5, col = tid & 31; float s = F.in[I_BMOD][e0 + col];
#pragma unroll
            for (int w = 0; w < 8; ++w) s += red[(w * NMODV + j) * 32 + col];
            ((float*)(F.ws + WS_MODS))[j * MODW + e0 + col] = s; }
        __syncthreads();
    }
    if (v < 256) {
        const int hh = v >> 4, dt = v & 15, d0 = 64 * dt;
        float* At = ldsf;
        float* Bkt = ldsf + 128 * 64;
        const float* wq = F.in[I_PWQ] + hh * 128;
        const float* sk = F.in[I_PSK] + (size_t)hh * 128 * 128;
#pragma unroll
        for (int i = 0; i < 4; ++i) { const int f = tid + 512 * i, d = f & 63, q4 = f >> 6; const f32x4 a = *(const f32x4*)(wq + (size_t)(d0 + d) * 2048 + 4 * q4);
            At[(4 * q4 + 0) * 64 + d] = a[0]; At[(4 * q4 + 1) * 64 + d] = a[1]; At[(4 * q4 + 2) * 64 + d] = a[2]; At[(4 * q4 + 3) * 64 + d] = a[3]; }
#pragma unroll
        for (int i = 0; i < 8; ++i) { const int f = tid + 512 * i, key = f & 127, q4 = f >> 7; const f32x4 b = *(const f32x4*)(sk + (size_t)key * 128 + 4 * q4);
            Bkt[(4 * q4 + 0) * 128 + key] = b[0]; Bkt[(4 * q4 + 1) * 128 + key] = b[1]; Bkt[(4 * q4 + 2) * 128 + key] = b[2]; Bkt[(4 * q4 + 3) * 128 + key] = b[3]; }
        __syncthreads();
        const int dg = tid & 15, kg = tid >> 4;
        float acc[4][4];
#pragma unroll
        for (int i = 0; i < 4; ++i)
#pragma unroll
            for (int j = 0; j < 4; ++j) acc[i][j] = 0.f;
#pragma unroll 4
        for (int q = 0; q < 128; ++q) { const f32x4 a = *(const f32x4*)(At + q * 64 + 4 * dg); const f32x4 b = *(const f32x4*)(Bkt + q * 128 + 4 * kg);
#pragma unroll
            for (int i = 0; i < 4; ++i)
#pragma unroll
                for (int j = 0; j < 4; ++j) acc[i][j] += a[i] * b[j]; }
        bf16* WcT = (bf16*)(F.ws + WS_WC);
#pragma unroll
        for (int j = 0; j < 4; ++j) { v2u o; o.x = pk2(acc[0][j], acc[1][j]); o.y = pk2(acc[2][j], acc[3][j]);
            *(v2u*)(WcT + (size_t)(hh * 128 + 4 * kg + j) * DM + d0 + 4 * dg) = o; }
        __syncthreads();
    }
    const int gw = v * NWAVES + wave, NGW = F.G * NWAVES;
    float* scr = ldsf + wave * 4096;
    {
        constexpr int I_IN = (DM / 64) * (D_IN / 32), I_OUT = (DM / 64) * (DM / 32), I_RG = 32 * 2;
        constexpr int NIT = I_IN + I_OUT + I_RG;
        for (int it = gw; it < NIT; it += NGW) {
            int r = it;
            if (r < I_IN) { p0_transpose_item(F.in[I_WIN], DM, D_IN, (bf16*)(F.ws + WS_WIN), scr, r, lane, MapWin()); continue; } r -= I_IN;
            if (r < I_OUT) { p0_transpose_item(F.in[I_WOUT], DM, DM, (bf16*)(F.ws + WS_WOUT), scr, r, lane, MapId()); continue; } r -= I_OUT;
            { const int mm = r >> 1, sub = r & 1, dir = mm >> 4, n = (mm >> 1) & 7, gate = mm & 1;
              const float* src = (gate ? F.in[I_RGWI] : F.in[I_RGWA]) + (size_t)(dir * 8 + n) * 4096;
              bf16* dst = (bf16*)(F.ws + WS_RGW) + (size_t)((dir * 8 + n) * 2 + gate) * 4096;
              p0_transpose_item(src, 64, 64, dst, scr, sub, lane, MapId(), -LOG2E); }
        }
    }
    for (int it0 = 4 * gw; it0 < 2 * 16384; it0 += 4 * NGW) {
        f32x4 a[4][4];
#pragma unroll
        for (int r = 0; r < 4; ++r) { const int it = it0 + r, tb = it >> 14, row = it & 16383;
            const float* src = (tb ? F.in[I_PV] : F.in[I_PU]) + (size_t)row * DM + 16 * lane;
#pragma unroll
            for (int j = 0; j < 4; ++j) a[r][j] = *(const f32x4*)(src + 4 * j); }
        float am[4];
#pragma unroll
        for (int r = 0; r < 4; ++r) { float m = 0.f;
#pragma unroll
            for (int j = 0; j < 4; ++j) m = fmaxf(m, fmaxf(fmaxf(fabsf(a[r][j][0]), fabsf(a[r][j][1])), fmaxf(fabsf(a[r][j][2]), fabsf(a[r][j][3]))));
            am[r] = m; }
#pragma unroll
        for (int r = 0; r < 4; ++r) am[r] = wave_max(am[r]);
#pragma unroll
        for (int r = 0; r < 4; ++r) { const int it = it0 + r, tb = it >> 14, row = it & 16383;
            const float inv = am[r] > 0.f ? 127.f / am[r] : 0.f;
            v4u o4;
#pragma unroll
            for (int j = 0; j < 4; ++j) { unsigned w = 0;
#pragma unroll
                for (int i = 0; i < 4; ++i) { int q = (int)rintf(a[r][j][i] * inv); q = q > 127 ? 127 : (q < -127 ? -127 : q); w |= ((unsigned)q & 0xffu) << (8 * i); }
                o4[j] = w; }
            *(v4u*)(F.ws + (tb ? WS_V : WS_U) + (size_t)row * DM + 16 * lane) = o4;
            if (lane == 0) ((float*)(F.ws + (tb ? WS_SV : WS_SU)))[row] = am[r] * (1.f / 127.f); }
    }
    const int gt = v * 512 + tid, NGT = F.G * 512;
    for (int e = gt; e < 8 * 256 * 128; e += NGT) {
        const int c = e & 127, bp = e >> 7, kvh = c >> 6, p = c & 63, old = (p & 1) ? 32 + (p >> 1) : (p >> 1);
        ((bf16*)(F.ws + WS_CK))[e] = (bf16)f2bf(F.in[I_CK][(size_t)bp * 128 + kvh * 64 + old]);
    }
    for (int e = gt; e < 8 * 256 * 128; e += NGT) {
        const int pos = e & 255, d = (e >> 8) & 63, kvh = (e >> 14) & 1, b = e >> 15;
        ((bf16*)(F.ws + WS_CVT))[e] = (bf16)f2bf(F.in[I_CV][(size_t)(b * 256 + pos) * 128 + kvh * 64 + d]);
    }
    for (int e = gt; e < 1024 * 32; e += NGT) {
        const int s = e >> 5, i = e & 31, row = s >> 6, col = s & 63;
        const float inv = powf(10000.0f, -(float)(i & 15) / 16.0f);
        const float ang = (i < 16 ? (float)row : (float)col) * inv;
        f32x2 cs; cs.x = cosf(ang); cs.y = sinf(ang);
        ((f32x2*)(F.ws + WS_ROPE))[e] = cs;
    }
}

__device__ __forceinline__ void bias_items(Frame& F) {
    const int gw = F.vcu * NWAVES + F.wave, NGW = F.G * NWAVES, lane = F.lane;
    const float* mods = (const float*)(F.ws + WS_MODS); const bf16* WcT = (const bf16*)(F.ws + WS_WC); float* BIAS = (float*)(F.ws + WS_BIAS);
    for (int n = gw; n < 2048; n += NGW) {
        const v4u a = *(const v4u*)(WcT + (size_t)n * DM + 16 * lane), b = *(const v4u*)(WcT + (size_t)n * DM + 16 * lane + 8);
        float w[16];
        w[0] = bflo(a.x); w[1] = bfhi(a.x); w[2] = bflo(a.y); w[3] = bfhi(a.y); w[4] = bflo(a.z); w[5] = bfhi(a.z); w[6] = bflo(a.w); w[7] = bfhi(a.w);
        w[8] = bflo(b.x); w[9] = bfhi(b.x); w[10] = bflo(b.y); w[11] = bfhi(b.y); w[12] = bflo(b.z); w[13] = bfhi(b.z); w[14] = bflo(b.w); w[15] = bfhi(b.w);
#pragma unroll 1
        for (int j = 0; j < NMODV; ++j) { const float* sh = mods + (size_t)j * MODW + 3 * DM + 16 * lane; float d = 0.f;
#pragma unroll
            for (int q = 0; q < 4; ++q) { const f32x4 v = *(const f32x4*)(sh + 4 * q); d += v[0] * w[4 * q] + v[1] * w[4 * q + 1] + v[2] * w[4 * q + 2] + v[3] * w[4 * q + 3]; }
            d = wave_sum(d); if (lane == 0) BIAS[j * 2048 + n] = d; }
    }
}
__device__ __forceinline__ void norm_phase(Frame& F, int which) {
    const int gw = F.vcu * NWAVES + F.wave, NGW = F.G * NWAVES, lane = F.lane;
    const float* mods = (const float*)(F.ws + WS_MODS);
    const float* g = F.in[which ? I_GFFN : I_GMIX];
    bf16* H = (bf16*)(F.ws + WS_H);
    for (int tok = gw; tok < NTOK; tok += NGW) {
        const float* xr = which ? F.out + O_Y + (size_t)tok * DM : x_row(F, tok);
        const float* mv = mods + (size_t)mod_index(tok) * MODW + (which ? 3 * DM : 0);
        f32x4 v[4]; float ss = 0.f;
#pragma unroll
        for (int j = 0; j < 4; ++j) { v[j] = *(const f32x4*)(xr + 256 * j + 4 * lane); ss += (v[j][0] * v[j][0] + v[j][1] * v[j][1]) + (v[j][2] * v[j][2] + v[j][3] * v[j][3]); }
        const float rstd = 1.f / sqrtf(wave_sum(ss) * (1.f / DM) + EPS);
#pragma unroll
        for (int j = 0; j < 4; ++j) { const int e = 256 * j + 4 * lane;
            const f32x4 gg = *(const f32x4*)(g + e), sh = *(const f32x4*)(mv + e), sc = *(const f32x4*)(mv + DM + e);
            f32x4 o;
#pragma unroll
            for (int i = 0; i < 4; ++i) o[i] = v[j][i] * rstd * gg[i] * (1.f + sc[i]) + sh[i];
            v2u w; w.x = pk2(o[0], o[1]); w.y = pk2(o[2], o[3]); *(v2u*)(H + (size_t)tok * DM + e) = w; }
    }
}

struct EpiInProj {
    static constexpr bool PERM = true;
    bf16 *q, *k, *vT, *xr, *yg; float *newk, *newv; const f32x4* rope4;
    __device__ __forceinline__ void operator()(const f32x4 (&acc)[2][2][4][2], const pg8::Unit& u, int wr, int wc, int fr, int fq) const {
        const bool lat = u.pm >= 32;
        const int pn = u.pn;
#pragma unroll
        for (int ai = 0; ai < 2; ++ai)
#pragma unroll
            for (int m = 0; m < 4; ++m) {
                const int row = u.pm * 256 + ai * 128 + wr * 64 + m * 16 + fr;
                const int pos = lat ? ((row - NCTX) & 1023) : (row & 255);
#pragma unroll
                for (int bj = 0; bj < 2; ++bj) {
                    const int c = pn * 256 + bj * 128 + wc * 32 + 8 * fq;
                    f32x4 v0 = acc[ai][bj][m][0], v1 = acc[ai][bj][m][1];
                    if (pn < 2 || (pn == 2 && bj == 0)) {
                        const int i = (c & 63) >> 1;
                        if (lat) { const f32x4 cs0 = rope4[(pos * 32 + i) >> 1], cs1 = rope4[((pos * 32 + i) >> 1) + 1];
                            const float a0 = v0[0] * cs0[0] - v0[1] * cs0[1], a1 = v0[1] * cs0[0] + v0[0] * cs0[1];
                            const float b0 = v0[2] * cs0[2] - v0[3] * cs0[3], b1 = v0[3] * cs0[2] + v0[2] * cs0[3];
                            const float c0 = v1[0] * cs1[0] - v1[1] * cs1[1], c1 = v1[1] * cs1[0] + v1[0] * cs1[1];
                            const float d0 = v1[2] * cs1[2] - v1[3] * cs1[3], d1 = v1[3] * cs1[2] + v1[2] * cs1[3];
                            v0[0] = a0; v0[1] = a1; v0[2] = b0; v0[3] = b1; v1[0] = c0; v1[1] = c1; v1[2] = d0; v1[3] = d1; }
                        if (pn < 2) { v4u w; w.x = pk2(v0[0] * QSCALE, v0[1] * QSCALE); w.y = pk2(v0[2] * QSCALE, v0[3] * QSCALE); w.z = pk2(v1[0] * QSCALE, v1[1] * QSCALE); w.w = pk2(v1[2] * QSCALE, v1[3] * QSCALE);
                            *(v4u*)(q + (size_t)row * 512 + c) = w; }
                        else { const int kc = c - 512; v4u w; w.x = pk2(v0[0], v0[1]); w.y = pk2(v0[2], v0[3]); w.z = pk2(v1[0], v1[1]); w.w = pk2(v1[2], v1[3]); *(v4u*)(k + (size_t)row * 128 + kc) = w;
                            if (!lat) { float* nk = newk + (size_t)row * 128 + (kc & 64) + i; f32x4 lo; lo[0] = v0[0]; lo[1] = v0[2]; lo[2] = v1[0]; lo[3] = v1[2]; f32x4 hi; hi[0] = v0[1]; hi[1] = v0[3]; hi[2] = v1[1]; hi[3] = v1[3];
                                *(f32x4*)nk = lo; *(f32x4*)(nk + 32) = hi; } }
                    } else if (pn == 2) {
                        const int vc = c - 640, kvh = vc >> 6, d = vc & 63;
                        if (!lat) { *(f32x4*)(newv + (size_t)row * 128 + vc) = v0; *(f32x4*)(newv + (size_t)row * 128 + vc + 4) = v1; }
                        bf16* vp; int S;
                        if (!lat) { S = SEQ_C; vp = vT + ((size_t)((row >> 8) * 2 + kvh) * 64 + d) * SEQ_C + pos; }
                        else { S = SEQ_L; vp = vT + VT_LAT_OFF + ((size_t)(((row - NCTX) >> 10) * 2 + kvh) * 64 + d) * SEQ_L + pos; }
                        vp[0] = (bf16)f2bf(v0[0]); vp[S] = (bf16)f2bf(v0[1]); vp[2 * S] = (bf16)f2bf(v0[2]); vp[3 * S] = (bf16)f2bf(v0[3]);
                        vp[4 * S] = (bf16)f2bf(v1[0]); vp[5 * S] = (bf16)f2bf(v1[1]); vp[6 * S] = (bf16)f2bf(v1[2]); vp[7 * S] = (bf16)f2bf(v1[3]);
                    } else {
                        v4u w; w.x = pk2(v0[0], v0[1]); w.y = pk2(v0[2], v0[3]); w.z = pk2(v1[0], v1[1]); w.w = pk2(v1[2], v1[3]);
                        if (pn < 5) *(v4u*)(xr + (size_t)row * 512 + (c - 768)) = w; else *(v4u*)(yg + (size_t)row * 512 + (c - 1280)) = w;
                    }
                }
            }
    }
};
struct EpiOutProj {
    static constexpr bool PERM = true;
    const float *xp, *xs, *mods, *gffn; float* x1; bf16* ap; float* ssp;
    __device__ __forceinline__ void operator()(const f32x4 (&acc)[2][2][4][2], const pg8::Unit& u, int wr, int wc, int fr, int fq) const {
        const int mi = u.pm < 32 ? 0 : 1 + ((u.pm - 32) >> 2);
        const float* mv = mods + (size_t)mi * MODW;
        const int row0 = u.pm * 256 + wr * 64 + fr;
        const float* xbase = (u.pm < 32 ? xp : xs - (size_t)NCTX * DM) + (size_t)row0 * DM;
        float ssq[2][4];
#pragma unroll
        for (int ai = 0; ai < 2; ++ai)
#pragma unroll
            for (int m = 0; m < 4; ++m) ssq[ai][m] = 0.f;
#pragma unroll
        for (int bj = 0; bj < 2; ++bj) {
            const int c = u.pn * 256 + bj * 128 + wc * 32 + 8 * fq;
            const f32x4 gv0 = *(const f32x4*)(mv + 2 * DM + c), gv1 = *(const f32x4*)(mv + 2 * DM + c + 4);
            const f32x4 g20 = *(const f32x4*)(gffn + c) * (1.f + *(const f32x4*)(mv + 4 * DM + c)), g21 = *(const f32x4*)(gffn + c + 4) * (1.f + *(const f32x4*)(mv + 4 * DM + c + 4));
#pragma unroll
            for (int h4 = 0; h4 < 4; ++h4) {
                const int ai = h4 >> 1;
                f32x4 xv[2][2];
#pragma unroll
                for (int mm = 0; mm < 2; ++mm) { const float* xr = xbase + (size_t)(ai * 128 + (2 * (h4 & 1) + mm) * 16) * DM + c; xv[mm][0] = *(const f32x4*)xr; xv[mm][1] = *(const f32x4*)(xr + 4); }
                asm volatile("" ::: "memory");
#pragma unroll
                for (int mm = 0; mm < 2; ++mm) {
                    const int m = 2 * (h4 & 1) + mm;
                    const size_t off = (size_t)(row0 + ai * 128 + m * 16) * DM + c;
                    const f32x4 o0 = xv[mm][0] + gv0 * acc[ai][bj][m][0], o1 = xv[mm][1] + gv1 * acc[ai][bj][m][1];
                    *(f32x4*)(x1 + off) = o0; *(f32x4*)(x1 + off + 4) = o1;
                    ssq[ai][m] += ((o0[0] * o0[0] + o0[1] * o0[1]) + (o0[2] * o0[2] + o0[3] * o0[3])) + ((o1[0] * o1[0] + o1[1] * o1[1]) + (o1[2] * o1[2] + o1[3] * o1[3]));
                    const f32x4 t0 = o0 * g20, t1 = o1 * g21; v4u w; w.x = pk2(t0[0], t0[1]); w.y = pk2(t0[2], t0[3]); w.z = pk2(t1[0], t1[1]); w.w = pk2(t1[2], t1[3]);
                    *(v4u*)(ap + off) = w;
                }
                asm volatile("" ::: "memory");
            }
        }
#pragma unroll
        for (int ai = 0; ai < 2; ++ai)
#pragma unroll
            for (int m = 0; m < 4; ++m) { float v = ssq[ai][m]; v += __shfl_xor(v, 16); v += __shfl_xor(v, 32);
                if (fq == 0) ssp[(size_t)(row0 + ai * 128 + m * 16) * 16 + u.pn * 4 + wc] = v; }
    }
};
struct EpiScores {
    static constexpr bool PERM = true;
    bf16* sc; const float* ssp; const float* bias;
    __device__ __forceinline__ void operator()(const f32x4 (&acc)[2][2][4][2], const pg8::Unit& u, int wr, int wc, int fr, int fq) const {
        const int mi = u.pm < 32 ? 0 : 1 + ((u.pm - 32) >> 2);
        const int row0 = u.pm * 256 + wr * 64 + fr;
        f32x4 b0[2], b1[2];
#pragma unroll
        for (int bj = 0; bj < 2; ++bj) { const int c = u.pn * 256 + bj * 128 + wc * 32 + 8 * fq; b0[bj] = *(const f32x4*)(bias + (size_t)mi * 2048 + c); b1[bj] = *(const f32x4*)(bias + (size_t)mi * 2048 + c + 4); }
#pragma unroll
        for (int h2 = 0; h2 < 4; ++h2) {
            const int ai = h2 >> 1;
            f32x4 sp[2][4];
#pragma unroll
            for (int mm = 0; mm < 2; ++mm)
#pragma unroll
                for (int q = 0; q < 4; ++q) sp[mm][q] = *((const f32x4*)(ssp + (size_t)(row0 + ai * 128 + (2 * (h2 & 1) + mm) * 16) * 16) + q);
            asm volatile("" ::: "memory");
#pragma unroll
            for (int mm = 0; mm < 2; ++mm) {
                const int m = 2 * (h2 & 1) + mm;
                const int row = row0 + ai * 128 + m * 16;
                const float ss = ((sp[mm][0][0] + sp[mm][0][1]) + (sp[mm][0][2] + sp[mm][0][3])) + ((sp[mm][1][0] + sp[mm][1][1]) + (sp[mm][1][2] + sp[mm][1][3]))
                               + ((sp[mm][2][0] + sp[mm][2][1]) + (sp[mm][2][2] + sp[mm][2][3])) + ((sp[mm][3][0] + sp[mm][3][1]) + (sp[mm][3][2] + sp[mm][3][3]));
                const float rstd = 1.f / sqrtf(ss * (1.f / DM) + EPS);
#pragma unroll
                for (int bj = 0; bj < 2; ++bj) {
                    const int c = u.pn * 256 + bj * 128 + wc * 32 + 8 * fq;
                    const f32x4 v0 = acc[ai][bj][m][0] * rstd + b0[bj], v1 = acc[ai][bj][m][1] * rstd + b1[bj];
                    v4u w; w.x = pk2(v0[0], v0[1]); w.y = pk2(v0[2], v0[3]); w.z = pk2(v1[0], v1[1]); w.w = pk2(v1[2], v1[3]);
                    *(v4u*)(sc + (size_t)row * 2048 + c) = w;
                }
            }
            asm volatile("" ::: "memory");
        }
    }
};

__device__ __forceinline__ void attn_unit(Frame& F, bool lat, int seq, int kvh, int qt) {
    const int tid = F.tid, lane = F.lane, wave = F.wave, r32 = lane & 31, hi = lane >> 5;
    const int g = wave >> 1, qs = wave & 1, head = kvh * 4 + g;
    const int S = lat ? SEQ_L : SEQ_C, tokbase = lat ? NCTX + seq * SEQ_L : seq * SEQ_C;
    const int q0 = qt * 64, qpos = q0 + 32 * qs + r32;
    const bf16* Q = (const bf16*)(F.ws + WS_Q); const bf16* Kb = (const bf16*)(F.ws + WS_K); const bf16* VT = (const bf16*)(F.ws + WS_VT);
    const bf16* CK = (const bf16*)(F.ws + WS_CK); const bf16* CVT = (const bf16*)(F.ws + WS_CVT);
    unsigned char* ldsK = F.lds; unsigned char* ldsV = F.lds + 8192;
    bf16x8 qf[4];
    { const bf16* qp = Q + (size_t)(tokbase + qpos) * 512 + head * 64;
#pragma unroll
      for (int ks = 0; ks < 4; ++ks) qf[ks] = *(const bf16x8*)(qp + 16 * ks + 8 * hi); }
    const float sinkl = F.in[I_SINK][head] * LOG2E;
    float mrun = sinkl, lrun = (hi == 0) ? 1.f : 0.f;
    f32x16 o0, o1;
#pragma unroll
    for (int r = 0; r < 16; ++r) { o0[r] = 0.f; o1[r] = 0.f; }
    int tlo, thi;
    if (lat) { tlo = (q0 >= 128 ? q0 - 128 : 0) >> 6; thi = ((q0 + 192 < S ? q0 + 192 : S)) >> 6; } else { tlo = 0; thi = 4; }
    const int nband = thi - tlo, ntile = nband + (lat ? 4 : 0);
    const int key_t = tid >> 3, ch_t = tid & 7;
    v4u kv, vv;
#define AT_LOAD(t_) do { const int tt_ = (t_); const bf16* kptr; const bf16* vptr; int vstride; \
        if (tt_ < nband) { const int kb_ = (tlo + tt_) * 64; kptr = Kb + (size_t)(tokbase + kb_) * 128 + kvh * 64; \
            vptr = VT + (lat ? (size_t)VT_LAT_OFF + (size_t)((seq * 2 + kvh) * 64) * SEQ_L : (size_t)((seq * 2 + kvh) * 64) * SEQ_C) + kb_; vstride = S; } \
        else { const int tc = tt_ - nband; kptr = CK + (size_t)(seq * 256 + tc * 64) * 128 + kvh * 64; vptr = CVT + (size_t)((seq * 2 + kvh) * 64) * 256 + tc * 64; vstride = 256; } \
        kv = *(const v4u*)(kptr + (size_t)key_t * 128 + ch_t * 8); vv = *(const v4u*)(vptr + (size_t)key_t * vstride + ch_t * 8); } while (0)
    AT_LOAD(0);
    for (int t = 0; t < ntile; ++t) {
        const bool band = t < nband;
        const int kbase = band ? (tlo + t) * 64 : 0;
        __syncthreads();
        *(v4u*)(ldsK + key_t * 128 + ((ch_t ^ (key_t & 7)) * 16)) = kv;
        *(v4u*)(ldsV + key_t * 128 + ((ch_t ^ (key_t & 7)) * 16)) = vv;
        __syncthreads();
        f32x16 p0, p1;
#pragma unroll
        for (int r = 0; r < 16; ++r) { p0[r] = 0.f; p1[r] = 0.f; }
#pragma unroll
        for (int ks = 0; ks < 4; ++ks) {
            const int sw = ((2 * ks + hi) ^ (r32 & 7)) * 16;
            const bf16x8 a0 = *(const bf16x8*)(ldsK + r32 * 128 + sw);
            const bf16x8 a1 = *(const bf16x8*)(ldsK + (32 + r32) * 128 + sw);
            p0 = __builtin_amdgcn_mfma_f32_32x32x16_bf16(a0, qf[ks], p0, 0, 0, 0);
            p1 = __builtin_amdgcn_mfma_f32_32x32x16_bf16(a1, qf[ks], p1, 0, 0, 0);
        }
        if (t + 1 < ntile) AT_LOAD(t + 1);
        if (band && lat && (kbase < q0 + 63 - 128 || kbase + 63 > q0 + 128)) {
#pragma unroll
            for (int r = 0; r < 16; ++r) { const int kp = kbase + crow(r, hi); int d0 = qpos - kp; d0 = d0 < 0 ? -d0 : d0; int d1 = qpos - kp - 32; d1 = d1 < 0 ? -d1 : d1;
                if (d0 > 128) p0[r] = -INFINITY; if (d1 > 128) p1[r] = -INFINITY; }
        }
        float tm = p0[0];
#pragma unroll
        for (int r = 1; r < 16; ++r) tm = fmaxf(tm, p0[r]);
#pragma unroll
        for (int r = 0; r < 16; ++r) tm = fmaxf(tm, p1[r]);
        tm = fmaxf(tm, __shfl_xor(tm, 32));
        const float mn = fmaxf(mrun, tm), alpha = __builtin_amdgcn_exp2f(mrun - mn); mrun = mn;
        float ls = 0.f;
#pragma unroll
        for (int r = 0; r < 16; ++r) { p0[r] = __builtin_amdgcn_exp2f(p0[r] - mn); p1[r] = __builtin_amdgcn_exp2f(p1[r] - mn); ls += p0[r] + p1[r]; o0[r] *= alpha; o1[r] *= alpha; }
        lrun = lrun * alpha + ls;
        bf16x8 pf[4];
#pragma unroll
        for (int s = 0; s < 2; ++s) {
            v4u w0, w1;
            w0.x = pk2(p0[8 * s + 0], p0[8 * s + 1]); w0.y = pk2(p0[8 * s + 2], p0[8 * s + 3]); w0.z = pk2(p0[8 * s + 4], p0[8 * s + 5]); w0.w = pk2(p0[8 * s + 6], p0[8 * s + 7]);
            w1.x = pk2(p1[8 * s + 0], p1[8 * s + 1]); w1.y = pk2(p1[8 * s + 2], p1[8 * s + 3]); w1.z = pk2(p1[8 * s + 4], p1[8 * s + 5]); w1.w = pk2(p1[8 * s + 6], p1[8 * s + 7]);
            pf[s] = __builtin_bit_cast(bf16x8, w0); pf[2 + s] = __builtin_bit_cast(bf16x8, w1);
        }
#pragma unroll
        for (int s4 = 0; s4 < 4; ++s4) {
#pragma unroll
            for (int dt = 0; dt < 2; ++dt) {
                const int d = 32 * dt + r32;
                const v2u lo = *(const v2u*)(ldsV + d * 128 + (((2 * s4) ^ (d & 7)) * 16) + 8 * hi);
                const v2u hi2 = *(const v2u*)(ldsV + d * 128 + (((2 * s4 + 1) ^ (d & 7)) * 16) + 8 * hi);
                v4u vf4; vf4.x = lo.x; vf4.y = lo.y; vf4.z = hi2.x; vf4.w = hi2.y;
                const bf16x8 vf = __builtin_bit_cast(bf16x8, vf4);
                if (dt == 0) o0 = __builtin_amdgcn_mfma_f32_32x32x16_bf16(vf, pf[s4], o0, 0, 0, 0);
                else o1 = __builtin_amdgcn_mfma_f32_32x32x16_bf16(vf, pf[s4], o1, 0, 0, 0);
            }
        }
    }
    const float ltot = lrun + __shfl_xor(lrun, 32), inv = 1.f / ltot;
    bf16* mix = (bf16*)(F.ws + WS_MIX) + (size_t)(tokbase + qpos) * DM + head * 64;
#pragma unroll
    for (int g4 = 0; g4 < 4; ++g4) {
        v2u w; w.x = pk2(o0[4 * g4] * inv, o0[4 * g4 + 1] * inv); w.y = pk2(o0[4 * g4 + 2] * inv, o0[4 * g4 + 3] * inv);
        *(v2u*)(mix + 8 * g4 + 4 * hi) = w;
        v2u w2; w2.x = pk2(o1[4 * g4] * inv, o1[4 * g4 + 1] * inv); w2.y = pk2(o1[4 * g4 + 2] * inv, o1[4 * g4 + 3] * inv);
        *(v2u*)(mix + 32 + 8 * g4 + 4 * hi) = w2;
    }
    __syncthreads();
}

constexpr int RL_HALF = 49152;
constexpr int RL_XCB = 32768;
constexpr int RL_AGG = 98304;
constexpr int RL_CARRY = RL_AGG + 8192;
constexpr int RL_CW = RL_CARRY + 512;
constexpr int RL_WG = RL_CW + 1280;
static_assert(RL_WG + 32768 <= LDSCTL_OFF, "RNN LDS map");
__device__ __forceinline__ float fsigmoid(float x) { return __builtin_amdgcn_rcpf(1.f + __expf(-x)); }
__device__ __forceinline__ float gelu_fast(float x) { const float y = 0.7978845608028654f * (x + 0.044715f * x * x * x); const float e = __expf(2.f * y); return x - x * __builtin_amdgcn_rcpf(1.f + e); }

template <bool REV>
__device__ __forceinline__ void scan_prep(const float (&a)[16], const float (&b)[16], int h, float (&Apre)[4], float (&Bpre)[4], float& At, float& Bt) {
    float Ao[4], Bo[4], Ap[4], Bp[4];
#pragma unroll
    for (int g = 0; g < 4; ++g) { float A = 1.f, B = 0.f;
#pragma unroll
        for (int ii = 0; ii < 4; ++ii) { const int r = 4 * g + (REV ? 3 - ii : ii); B = a[r] * B + b[r]; A = a[r] * A; }
        Ao[g] = A; Bo[g] = B; }
#pragma unroll
    for (int g = 0; g < 4; ++g) { Ap[g] = __shfl_xor(Ao[g], 32); Bp[g] = __shfl_xor(Bo[g], 32); }
    const bool ownfirst = REV ? (h == 1) : (h == 0);
    float Ac = 1.f, Bc = 0.f;
#pragma unroll
    for (int gi = 0; gi < 4; ++gi) { const int g = REV ? 3 - gi : gi;
        const float A1 = ownfirst ? Ao[g] : Ap[g], B1 = ownfirst ? Bo[g] : Bp[g], A2 = ownfirst ? Ap[g] : Ao[g], B2 = ownfirst ? Bp[g] : Bo[g];
        const float Ac1 = A1 * Ac, Bc1 = A1 * Bc + B1;
        Apre[g] = ownfirst ? Ac : Ac1; Bpre[g] = ownfirst ? Bc : Bc1;
        Ac = A2 * Ac1; Bc = A2 * Bc1 + B2; }
    At = Ac; Bt = Bc;
}
template <bool REV>
__device__ __forceinline__ void scan_finish(const float (&a)[16], const float (&b)[16], const float (&Apre)[4], const float (&Bpre)[4], float hin, float* hp, int hi) {
#pragma unroll
    for (int g = 0; g < 4; ++g) { float hc = Apre[g] * hin + Bpre[g];
#pragma unroll
        for (int ii = 0; ii < 4; ++ii) { const int r = 4 * g + (REV ? 3 - ii : ii); hc = a[r] * hc + b[r]; hp[(size_t)crow(r, hi) * 512] = hc; } }
}

template <bool REV>
__device__ __forceinline__ void rnn_dir(Frame& F, bool lat, int seq, int n) {
    const int lane = F.lane, w4 = F.wave & 3, r32 = lane & 31, hi = lane >> 5, dirh = REV ? 1 : 0;
    const int S = lat ? SEQ_L : SEQ_C, tokbase = lat ? NCTX + seq * SEQ_L : seq * SEQ_C, nchunk = S / 128;
    unsigned char* hb = F.lds + dirh * RL_HALF;
    float* XC32 = (float*)hb; unsigned char* XCB = hb + RL_XCB;
    f32x2* AGG = (f32x2*)(F.lds + RL_AGG) + dirh * 256; float* CARRY = (float*)(F.lds + RL_CARRY) + dirh * 64; const float* CW = (const float*)(F.lds + RL_CW);
    const unsigned char* WG = F.lds + RL_WG + dirh * 16384;
    const bf16* XR = (const bf16*)(F.ws + WS_XR) + (size_t)tokbase * 512 + n * 64;
    float* HX = (float*)(F.ws + (REV ? WS_H : WS_HF)) + (size_t)tokbase * 512 + n * 64;
    const int t = F.tid & 255, c8 = t & 7, tg = t >> 3;
    float ba[2], bi[2], sp8[2];
#pragma unroll
    for (int chh = 0; chh < 2; ++chh) { const int pe = dirh * 512 + n * 64 + chh * 32 + r32; ba[chh] = -LOG2E * F.in[I_RGBA][pe]; bi[chh] = -LOG2E * F.in[I_RGBI][pe];
        const float nl = -F.in[I_RGLAM][pe]; sp8[chh] = -8.f * LOG2E * (nl > 20.f ? nl : log1pf(__expf(nl))); }
    v4u xin[7];
#define RL_XLOAD(c0_) do { _Pragma("unroll") for (int i = 0; i < 7; ++i) { const int pos = (c0_) + 4 * tg - 2 + i; \
        xin[i] = (pos >= 0 && pos < S) ? *(const v4u*)(XR + (size_t)pos * 512 + 8 * c8) : (v4u){0u, 0u, 0u, 0u}; } } while (0)
    RL_XLOAD((REV ? nchunk - 1 : 0) * 128);
    float newcarry[2] = {0.f, 0.f};
    const bool last_tile = REV ? (w4 == 0) : (w4 == 3);
#pragma unroll 1
    for (int k = 0; k < nchunk; ++k) {
        const int c0 = (REV ? nchunk - 1 - k : k) * 128;
        {
            const f32x4 b0 = *(const f32x4*)(CW + 256 + 8 * c8), b1 = *(const f32x4*)(CW + 256 + 8 * c8 + 4);
            f32x4 wt0[4], wt1[4];
#pragma unroll
            for (int tap = 0; tap < 4; ++tap) { wt0[tap] = *(const f32x4*)(CW + tap * 64 + 8 * c8); wt1[tap] = *(const f32x4*)(CW + tap * 64 + 8 * c8 + 4); }
#pragma unroll
            for (int i = 0; i < 4; ++i) {
                f32x4 y0 = b0, y1 = b1;
#pragma unroll
                for (int tap = 0; tap < 4; ++tap) { const v4u x = xin[i + tap];
                    y0[0] += wt0[tap][0] * bflo(x.x); y0[1] += wt0[tap][1] * bfhi(x.x); y0[2] += wt0[tap][2] * bflo(x.y); y0[3] += wt0[tap][3] * bfhi(x.y);
                    y1[0] += wt1[tap][0] * bflo(x.z); y1[1] += wt1[tap][1] * bfhi(x.z); y1[2] += wt1[tap][2] * bflo(x.w); y1[3] += wt1[tap][3] * bfhi(x.w); }
                const int tk = 4 * tg + i;
                *(f32x4*)(XC32 + tk * 64 + 8 * c8) = y0; *(f32x4*)(XC32 + tk * 64 + 8 * c8 + 4) = y1;
                v4u w; w.x = pk2(y0[0], y0[1]); w.y = pk2(y0[2], y0[3]); w.z = pk2(y1[0], y1[1]); w.w = pk2(y1[2], y1[3]);
                *(v4u*)(XCB + tk * 128 + ((c8 ^ (tk & 7)) * 16)) = w; }
        }
        if (k + 1 < nchunk) RL_XLOAD((REV ? nchunk - 2 - k : k + 1) * 128);
        __syncthreads();
        if (k > 0 && last_tile && hi == 0) { CARRY[r32] = newcarry[0]; CARRY[32 + r32] = newcarry[1]; }
        const int tkA = 32 * w4 + r32;
#pragma unroll
        for (int chh = 0; chh < 2; ++chh) {
            const int che = chh * 32 + r32;
            float av[16], bv[16], Apre[4], Bpre[4];
            {
                f32x16 ga, gi;
#pragma unroll
                for (int r = 0; r < 16; ++r) { ga[r] = 0.f; gi[r] = 0.f; }
#pragma unroll
                for (int ks = 0; ks < 4; ++ks) {
                    const bf16x8 af = *(const bf16x8*)(XCB + tkA * 128 + (((2 * ks + hi) ^ (tkA & 7)) * 16));
                    const bf16x8 wa = *(const bf16x8*)(WG + che * 128 + (((2 * ks + hi) ^ (che & 7)) * 16));
                    const bf16x8 wi = *(const bf16x8*)(WG + 8192 + che * 128 + (((2 * ks + hi) ^ (che & 7)) * 16));
                    ga = __builtin_amdgcn_mfma_f32_32x32x16_bf16(af, wa, ga, 0, 0, 0);
                    gi = __builtin_amdgcn_mfma_f32_32x32x16_bf16(af, wi, gi, 0, 0, 0);
                }
#pragma unroll
                for (int r = 0; r < 16; ++r) { const int tk2 = 32 * w4 + crow(r, hi); const float x = XC32[tk2 * 64 + che];
                    const float rg = __builtin_amdgcn_rcpf(1.f + __builtin_amdgcn_exp2f(ga[r] + ba[chh])), ig = __builtin_amdgcn_rcpf(1.f + __builtin_amdgcn_exp2f(gi[r] + bi[chh])), a = __builtin_amdgcn_exp2f(rg * sp8[chh]);
                    av[r] = a; bv[r] = __builtin_amdgcn_sqrtf(fmaxf(1.f - a * a, 0.f)) * ig * x;
                    if ((r & 3) == 3) __builtin_amdgcn_sched_barrier(0); }
                float At, Bt;
                scan_prep<REV>(av, bv, hi, Apre, Bpre, At, Bt);
                if (hi == 0) { f32x2 ab; ab.x = At; ab.y = Bt; AGG[chh * 512 + w4 * 64 + che] = ab; }
            }
            __syncthreads();
            {
                float hin = CARRY[che];
                if (!REV) { for (int t2 = 0; t2 < w4; ++t2) { const f32x2 ab = AGG[chh * 512 + t2 * 64 + che]; hin = ab.x * hin + ab.y; } }
                else { for (int t2 = 3; t2 > w4; --t2) { const f32x2 ab = AGG[chh * 512 + t2 * 64 + che]; hin = ab.x * hin + ab.y; } }
                scan_finish<REV>(av, bv, Apre, Bpre, hin, HX + (size_t)(c0 + 32 * w4) * 512 + che, hi);
                if (last_tile) { const f32x2 ab = AGG[chh * 512 + w4 * 64 + che]; newcarry[chh] = ab.x * hin + ab.y; }
            }
        }
    }
#undef RL_XLOAD
    if (!lat && last_tile && hi == 0) { float* o = F.out + O_NEWRNN + (size_t)(seq * 2 + dirh) * 512 + n * 64; o[r32] = newcarry[0]; o[32 + r32] = newcarry[1]; }
}

__device__ __forceinline__ void rnn_unit(Frame& F, bool lat, int seq, int n) {
    const int tid = F.tid;
    const int S = lat ? SEQ_L : SEQ_C, tokbase = lat ? NCTX + seq * SEQ_L : seq * SEQ_C;
    __syncthreads();
    { float* CW = (float*)(F.lds + RL_CW); float* CARRY = (float*)(F.lds + RL_CARRY);
      if (tid < 320) CW[tid] = tid < 256 ? F.in[I_CONVW][(tid >> 6) * 512 + n * 64 + (tid & 63)] : F.in[I_CONVB][n * 64 + (tid - 256)];
      if (tid < 128) CARRY[tid] = lat ? F.in[I_SRNN][(size_t)(seq * 2 + (tid >> 6)) * 512 + n * 64 + (tid & 63)] : 0.f;
      const bf16* rgw = (const bf16*)(F.ws + WS_RGW);
#pragma unroll
      for (int i = 0; i < 4; ++i) { const int q = tid + 512 * i, ch = q & 7, d = (q >> 3) & 63, gate = (q >> 9) & 1, dir = q >> 10;
          const v4u w = *(const v4u*)(rgw + (size_t)((dir * 8 + n) * 2 + gate) * 4096 + d * 64 + ch * 8);
          *(v4u*)(F.lds + RL_WG + dir * 16384 + gate * 8192 + d * 128 + ((ch ^ (d & 7)) * 16)) = w; } }
    __syncthreads();
    if (F.wave < 4) rnn_dir<false>(F, lat, seq, n); else rnn_dir<true>(F, lat, seq, n);
    __syncthreads();
    { const int c4 = tid & 15, tk = tid >> 4;
      const float* HF = (const float*)(F.ws + WS_HF) + (size_t)tokbase * 512 + n * 64 + 4 * c4;
      const float* HB = (const float*)(F.ws + WS_H) + (size_t)tokbase * 512 + n * 64 + 4 * c4;
      const bf16* YG = (const bf16*)(F.ws + WS_YG) + (size_t)tokbase * 512 + n * 64 + 4 * c4;
      bf16* MIX = (bf16*)(F.ws + WS_MIX) + (size_t)tokbase * DM + 512 + n * 64 + 4 * c4;
      for (int t0 = tk; t0 < S; t0 += 32) {
          const f32x4 a = *(const f32x4*)(HF + (size_t)t0 * 512), b = *(const f32x4*)(HB + (size_t)t0 * 512); const v2u y = *(const v2u*)(YG + (size_t)t0 * 512);
          v2u o; o.x = pk2((a[0] + b[0]) * gelu_fast(bflo(y.x)), (a[1] + b[1]) * gelu_fast(bfhi(y.x))); o.y = pk2((a[2] + b[2]) * gelu_fast(bflo(y.y)), (a[3] + b[3]) * gelu_fast(bfhi(y.y)));
          *(v2u*)(MIX + (size_t)t0 * DM) = o; } }
    __syncthreads();
}

#ifndef MK_P3_TYPES
#define MK_P3_TYPES 15
#endif
__device__ __forceinline__ void p3_phase(Frame& F, int types = 15) {
    const int v = F.vcu;
#pragma unroll 1
    for (int i = 0; i < 832; ++i) {
        int type, idx;
        if (F.G == 256) {
            if (v < 64) { if (i > 0) break; type = 0; idx = v; }
            else { if (i >= 6) break; const int j = v - 64, sl = i >> 1, rep = i & 1; type = 1 + sl;
                const bool extra = sl == 0 ? (j < 64) : (sl == 1 ? (j >= 64 && j < 128) : (j >= 128));
                if (rep && !extra) continue; idx = rep ? 192 + (j - 64 * sl) : j; }
        } else { const int it = v + i * F.G; if (it >= 832) break;
            if (it < 64) { type = 0; idx = it; } else if (it < 320) { type = 1; idx = it - 64; } else if (it < 576) { type = 2; idx = it - 320; } else { type = 3; idx = it - 576; } }
        if (!((types >> type) & 1)) continue;
        const bool lat = type < 2;
        Frame L = F; asm volatile("" : "+v"(L.tid)); L.lane = L.tid & 63;
        asm volatile("" : "+s"(L.ws), "+s"(L.out));
        if ((type & 1) == 0) rnn_unit(L, lat, idx >> 3, idx & 7);
        else { if (lat) attn_unit(L, true, idx >> 5, (idx >> 4) & 1, idx & 15); else attn_unit(L, false, idx >> 3, (idx >> 2) & 1, idx & 3); }
    }
}

__device__ __forceinline__ unsigned key16(unsigned b, unsigned idx) { const unsigned s = (b & 0x8000u) ? (~b & 0xffffu) : (b | 0x8000u); return (s << 16) | idx; }
__device__ __forceinline__ float keyval16(unsigned k) { const unsigned s = k >> 16; const unsigned b = (s & 0x8000u) ? (s & 0x7fffu) : (~s & 0xffffu); return bf2f(b); }
__device__ __forceinline__ unsigned sortable32(float f) { const unsigned u = __builtin_bit_cast(unsigned, f); return (u & 0x80000000u) ? ~u : (u | 0x80000000u); }
template <int CTRL> __device__ __forceinline__ unsigned dppu(unsigned v) { return (unsigned)__builtin_amdgcn_update_dpp(0, (int)v, CTRL, 0xf, 0xf, true); }
template <int CTRL> __device__ __forceinline__ float dppf(float v) { return __builtin_bit_cast(float, __builtin_amdgcn_update_dpp(0, __builtin_bit_cast(int, v), CTRL, 0xf, 0xf, true)); }
__device__ __forceinline__ unsigned umax_(unsigned a, unsigned b) { return a > b ? a : b; }
__device__ __forceinline__ unsigned umin_(unsigned a, unsigned b) { return a < b ? a : b; }
__device__ __forceinline__ unsigned rowmax16u(unsigned x) { x = umax_(x, dppu<0xB1>(x)); x = umax_(x, dppu<0x4E>(x)); x = umax_(x, dppu<0x141>(x)); x = umax_(x, dppu<0x140>(x)); return x; }
__device__ __forceinline__ float rowmax16f(float x) { x = fmaxf(x, dppf<0xB1>(x)); x = fmaxf(x, dppf<0x4E>(x)); x = fmaxf(x, dppf<0x141>(x)); x = fmaxf(x, dppf<0x140>(x)); return x; }
__device__ __forceinline__ float rowsum16f(float x) { x += dppf<0xB1>(x); x += dppf<0x4E>(x); x += dppf<0x141>(x); x += dppf<0x140>(x); return x; }
__device__ __forceinline__ int rowsum16i(int x) { x += (int)dppu<0xB1>((unsigned)x); x += (int)dppu<0x4E>((unsigned)x); x += (int)dppu<0x141>((unsigned)x); x += (int)dppu<0x140>((unsigned)x); return x; }
#define CEX(a, b) do { const unsigned _h = umax_(a, b), _l = umin_(a, b); a = _h; b = _l; } while (0)

constexpr int P7_WL = 16384;
constexpr int P7_TL = 0, P7_TE = 1024, P7_TG = 3072, P7_LE = 5120, P7_LG = 6400, P7_LSU = 8960, P7_LS = 11520, P7_H2Q = 12160, P7_HST = 16256;
static_assert(P7_LS + 640 <= P7_H2Q && (P7_H2Q % 16) == 0 && P7_HST + 16 <= P7_WL && P7_WL * 8 <= RING_BYTES, "P7 LDS map");

#define TK_KEYS(R, raw, kb) unsigned R##0 = key16(raw.x & 0xffffu, (kb) + 0), R##1 = key16(raw.x >> 16, (kb) + 1), R##2 = key16(raw.y & 0xffffu, (kb) + 2), R##3 = key16(raw.y >> 16, (kb) + 3), \
        R##4 = key16(raw.z & 0xffffu, (kb) + 4), R##5 = key16(raw.z >> 16, (kb) + 5), R##6 = key16(raw.w & 0xffffu, (kb) + 6), R##7 = key16(raw.w >> 16, (kb) + 7)
#define TK_SORT8(R) do { CEX(R##0, R##1); CEX(R##2, R##3); CEX(R##4, R##5); CEX(R##6, R##7); CEX(R##0, R##2); CEX(R##1, R##3); CEX(R##4, R##6); CEX(R##5, R##7); CEX(R##1, R##2); CEX(R##5, R##6); \
        CEX(R##0, R##4); CEX(R##1, R##5); CEX(R##2, R##6); CEX(R##3, R##7); CEX(R##2, R##4); CEX(R##3, R##5); CEX(R##1, R##2); CEX(R##3, R##4); CEX(R##5, R##6); } while (0)
#define TK_POP8(R, KEEP, it) do { const unsigned m_ = rowmax16u(R##0); const bool w_ = R##0 == m_; R##0 = w_ ? R##1 : R##0; R##1 = w_ ? R##2 : R##1; R##2 = w_ ? R##3 : R##2; R##3 = w_ ? R##4 : R##3; \
        R##4 = w_ ? R##5 : R##4; R##5 = w_ ? R##6 : R##5; R##6 = w_ ? R##7 : R##6; R##7 = w_ ? 0u : R##7; KEEP = (k == (it)) ? m_ : KEEP; } while (0)
#define TK_POP4(C, KEEP, it) do { const unsigned m_ = rowmax16u(C[0]); const bool w_ = C[0] == m_; C[0] = w_ ? C[1] : C[0]; C[1] = w_ ? C[2] : C[1]; C[2] = w_ ? C[3] : C[2]; C[3] = w_ ? 0u : C[3]; KEEP = (k == (it)) ? m_ : KEEP; } while (0)
__device__ __forceinline__ void topk_token(const v4u (&rawv)[4], unsigned* TL, int lane, const unsigned ctabp, int* oute, float* outg) {
    const int k = lane & 15, row = lane >> 4;
#pragma unroll
    for (int pp = 0; pp < 2; ++pp) {
        const v4u rawa = rawv[2 * pp], rawb = rawv[2 * pp + 1];
        TK_KEYS(a, rawa, k * 8); TK_KEYS(b, rawb, k * 8);
        TK_SORT8(a); TK_SORT8(b);
        unsigned keepa = 0, keepb = 0;
#pragma unroll
        for (int it = 0; it < 16; ++it) { TK_POP8(a, keepa, it); TK_POP8(b, keepb, it); }
        TL[((2 * pp) * 4 + row) * 16 + k] = keepa; TL[((2 * pp + 1) * 4 + row) * 16 + k] = keepb;
    }
    unsigned ca[4], cb[4];
    const unsigned* LAa = TL + (2 * row) * 16; const unsigned* LBa = TL + (2 * row + 1) * 16;
    const unsigned* LAb = TL + (2 * (4 + row)) * 16; const unsigned* LBb = TL + (2 * (4 + row) + 1) * 16;
#pragma unroll
    for (int s = 0; s < 4; ++s) { const int ij = (int)((ctabp >> (8 * s)) & 0xffu); const bool valid = ij != 255; const int i = (ij >> 4) & 15, j = ij & 15;
        const float sa = keyval16(LAa[i]) + keyval16(LBa[j]), sb = keyval16(LAb[i]) + keyval16(LBb[j]);
        ca[s] = valid ? ((sortable32(sa) & 0xffffff00u) | (unsigned)(i * 16 + j)) : 0u; cb[s] = valid ? ((sortable32(sb) & 0xffffff00u) | (unsigned)(i * 16 + j)) : 0u; }
    CEX(ca[0], ca[1]); CEX(ca[2], ca[3]); CEX(ca[0], ca[2]); CEX(ca[1], ca[3]); CEX(ca[1], ca[2]);
    CEX(cb[0], cb[1]); CEX(cb[2], cb[3]); CEX(cb[0], cb[2]); CEX(cb[1], cb[3]); CEX(cb[1], cb[2]);
    unsigned keepa = 0, keepb = 0;
#pragma unroll
    for (int it = 0; it < 16; ++it) { TK_POP4(ca, keepa, it); TK_POP4(cb, keepb, it); }
    {
        const unsigned kaa = LAa[(keepa >> 4) & 15], kba = LBa[keepa & 15], kab = LAb[(keepb >> 4) & 15], kbb = LBb[keepb & 15];
        const float bva = keyval16(kaa) + keyval16(kba), bvb = keyval16(kab) + keyval16(kbb);
        const float mxa = rowmax16f(bva), mxb = rowmax16f(bvb); const float exa = __expf(bva - mxa), exb = __expf(bvb - mxb); const float sma = rowsum16f(exa), smb = rowsum16f(exb);
        oute[lane] = (int)((kaa & 127u) * 128u + (kba & 127u)); outg[lane] = exa / sma;
        oute[64 + lane] = (int)((kab & 127u) * 128u + (kbb & 127u)); outg[64 + lane] = exb / smb;
    }
}
#undef TK_KEYS
#undef TK_SORT8
#undef TK_POP8
#undef TK_POP4

__device__ __forceinline__ void gl16x4(v4u (&r)[4], unsigned voff, const unsigned char* b0, const unsigned char* b1, const unsigned char* b2, const unsigned char* b3) {
    asm volatile("s_nop 4\n\tglobal_load_dwordx4 %0, %4, %5\n\tglobal_load_dwordx4 %1, %4, %6\n\tglobal_load_dwordx4 %2, %4, %7\n\tglobal_load_dwordx4 %3, %4, %8"
                 : "=&v"(r[0]), "=&v"(r[1]), "=&v"(r[2]), "=&v"(r[3]) : "v"(voff), "s"(b0), "s"(b1), "s"(b2), "s"(b3) : "memory");
}
#define P7_VMWAIT(N, R) asm volatile("s_waitcnt vmcnt(" #N ")" : "+v"(R[0]), "+v"(R[1]), "+v"(R[2]), "+v"(R[3]) :: "memory")
__device__ __forceinline__ int mbcnt64(unsigned long long m) { return (int)__builtin_amdgcn_mbcnt_hi((unsigned)(m >> 32), __builtin_amdgcn_mbcnt_lo((unsigned)m, 0u)); }
__device__ __forceinline__ int rfl(int v) { return __builtin_amdgcn_readfirstlane(v); }
__device__ __forceinline__ float rflf(float v) { return __builtin_bit_cast(float, __builtin_amdgcn_readfirstlane(__builtin_bit_cast(int, v))); }

__device__ __forceinline__ void p7_phase(Frame& F, bool dry) {
    const int lane0 = F.lane, wave = F.wave;
    if (dry && (MK_DRY_SKIP & 16) && wave >= 4) return;
    unsigned char* wl = F.lds + wave * P7_WL;
    unsigned* TL = (unsigned*)(wl + P7_TL); int* TE = (int*)(wl + P7_TE); float* TG = (float*)(wl + P7_TG);
    unsigned short* LE = (unsigned short*)(wl + P7_LE); float* LG = (float*)(wl + P7_LG); float* LSU = (float*)(wl + P7_LSU); unsigned char* LS = wl + P7_LS; unsigned char* H2Q = wl + P7_H2Q; float* HST = (float*)(wl + P7_HST);
    const bf16* SC = (const bf16*)(F.ws + WS_SC); const bf16* H2 = (const bf16*)(F.ws + WS_H);
    const unsigned char* U8 = F.ws + WS_U; const unsigned char* V8 = F.ws + WS_V;
    const float* SU = (const float*)(F.ws + WS_SU); const float* SV = (const float*)(F.ws + WS_SV);
    const float* mods = (const float*)(F.ws + WS_MODS); const float* SSP = (const float*)(F.ws + WS_SSP);
    unsigned ctabp = 0;
#pragma unroll
    for (int s = 0; s < 4; ++s) { const int c = 16 * s + (lane0 & 15); int i, j;
        if (c < 16) { i = 0; j = c; } else if (c < 24) { i = 1; j = c - 16; } else if (c < 29) { i = 2; j = c - 24; } else if (c < 33) { i = 3; j = c - 29; } else if (c < 36) { i = 4; j = c - 33; }
        else if (c < 38) { i = 5; j = c - 36; } else if (c < 40) { i = 6; j = c - 38; } else if (c < 42) { i = 7; j = c - 40; } else if (c < 50) { i = c - 34; j = 0; } else { i = -1; j = 0; }
        ctabp |= (unsigned)(i < 0 ? 255 : i * 16 + j) << (8 * s); }
    const int ntg = NTOK / (F.G * NWAVES * 4);
#pragma unroll 1
    for (int tg = 0; tg < ntg; ++tg) {
        const int tok0 = (F.vcu * ntg + tg) * (NWAVES * 4) + wave * 4;
        int lane = F.lane; asm volatile("" : "+v"(lane));
        {
            v4u craw[4], nraw[4]; v4u ch0, ch1, nh0, nh1;
#define P7_TLOAD(R, H0, H1, tk) do { const bf16* sp_ = SC + (size_t)(tk) * 2048 + (lane >> 4) * 128 + (lane & 15) * 8; \
                _Pragma("unroll") for (int ps = 0; ps < 4; ++ps) R[ps] = *(const v4u*)(sp_ + ps * 512); \
                H0 = *(const v4u*)(H2 + (size_t)(tk) * DM + 16 * lane); H1 = *(const v4u*)(H2 + (size_t)(tk) * DM + 16 * lane + 8); } while (0)
            P7_TLOAD(craw, ch0, ch1, tok0);
#pragma unroll 1
            for (int s = 0; s < 4; ++s) {
                if (s < 3) P7_TLOAD(nraw, nh0, nh1, tok0 + s + 1);
                const int tokc = tok0 + s;
                const f32x4* spp = (const f32x4*)(SSP + (size_t)tokc * 16); const f32x4 q0 = spp[0], q1 = spp[1], q2 = spp[2], q3 = spp[3];
                const float* shp = mods + (size_t)mod_index(tokc) * MODW + 3 * DM + 16 * lane;
                const f32x4 sh0 = *(const f32x4*)(shp), sh1 = *(const f32x4*)(shp + 4), sh2v = *(const f32x4*)(shp + 8), sh3 = *(const f32x4*)(shp + 12);
                topk_token(craw, TL, lane, ctabp, TE + s * 128, TG + s * 128);
                const v4u a = ch0, b = ch1;
                const float ssr = ((q0[0] + q0[1]) + (q0[2] + q0[3])) + ((q1[0] + q1[1]) + (q1[2] + q1[3])) + ((q2[0] + q2[1]) + (q2[2] + q2[3])) + ((q3[0] + q3[1]) + (q3[2] + q3[3]));
                const float rstd = 1.f / sqrtf(ssr * (1.f / DM) + EPS);
                float hv[16];
                hv[0] = bflo(a.x); hv[1] = bfhi(a.x); hv[2] = bflo(a.y); hv[3] = bfhi(a.y); hv[4] = bflo(a.z); hv[5] = bfhi(a.z); hv[6] = bflo(a.w); hv[7] = bfhi(a.w);
                hv[8] = bflo(b.x); hv[9] = bfhi(b.x); hv[10] = bflo(b.y); hv[11] = bfhi(b.y); hv[12] = bflo(b.z); hv[13] = bfhi(b.z); hv[14] = bflo(b.w); hv[15] = bfhi(b.w);
#pragma unroll
                for (int i = 0; i < 4; ++i) { hv[i] = hv[i] * rstd + sh0[i]; hv[4 + i] = hv[4 + i] * rstd + sh1[i]; hv[8 + i] = hv[8 + i] * rstd + sh2v[i]; hv[12 + i] = hv[12 + i] * rstd + sh3[i]; }
                float am = 0.f;
#pragma unroll
                for (int i = 0; i < 16; ++i) am = fmaxf(am, fabsf(hv[i]));
                am = wave_max(am);
                const float inv = am > 0.f ? 127.f / am : 0.f;
                if (lane == 0) HST[s] = am * (1.f / 127.f);
                v4u qv;
#pragma unroll
                for (int j = 0; j < 4; ++j) { unsigned w = 0;
#pragma unroll
                    for (int i = 0; i < 4; ++i) { int q = (int)rintf(hv[4 * j + i] * inv); w |= ((unsigned)q & 0xffu) << (8 * i); }
                    qv[j] = w; }
                *(v4u*)(H2Q + s * 1024 + 16 * lane) = qv;
#pragma unroll
                for (int ps = 0; ps < 4; ++ps) craw[ps] = nraw[ps];
                ch0 = nh0; ch1 = nh1;
            }
#undef P7_TLOAD
        }
        int nb;
        {
            int tot[8];
#pragma unroll
            for (int c = 0; c < 8; ++c) tot[c] = 0;
#pragma unroll 1
            for (int s = 0; s < 4; ++s) { const int c0 = TE[s * 128 + lane] >> 11, c1 = TE[s * 128 + 64 + lane] >> 11;
#pragma unroll
                for (int c = 0; c < 8; ++c) { const int n = __popcll(__ballot(c0 == c)) + __popcll(__ballot(c1 == c)); tot[c] += (n + 3) & ~3; } }
            int off[8]; { int base = 0;
#pragma unroll
                for (int c = 0; c < 8; ++c) { off[c] = base; base += tot[c]; }
                { const int pe = ((base + 47) / 48) * 48; if (lane < pe - base) { const int p = base + lane; LE[p] = (unsigned short)0; LG[p] = 0.f; LSU[p] = 0.f; LS[p] = (unsigned char)0; } base = pe; }
            nb = base >> 2; }
#pragma unroll 1
            for (int s = 0; s < 4; ++s) { const int e0 = TE[s * 128 + lane], e1 = TE[s * 128 + 64 + lane]; const float g0 = TG[s * 128 + lane], g1 = TG[s * 128 + 64 + lane]; const int c0 = e0 >> 11, c1 = e1 >> 11;
                const float su0 = SU[e0], su1 = SU[e1], sv0 = SV[e0], sv1 = SV[e1];
#pragma unroll
                for (int c = 0; c < 8; ++c) {
                    const unsigned long long m0 = __ballot(c0 == c), m1 = __ballot(c1 == c);
                    const int n0 = __popcll(m0), n = n0 + __popcll(m1), np = (n + 3) & ~3, base = off[c];
                    if (c0 == c) { const int p = base + mbcnt64(m0); LE[p] = (unsigned short)e0; LG[p] = g0 * sv0; LSU[p] = su0; LS[p] = (unsigned char)s; }
                    if (c1 == c) { const int p = base + n0 + mbcnt64(m1); LE[p] = (unsigned short)e1; LG[p] = g1 * sv1; LSU[p] = su1; LS[p] = (unsigned char)s; }
                    if (lane < np - n) { const int p = base + n + lane; LE[p] = (unsigned short)(c * 2048); LG[p] = 0.f; LSU[p] = 0.f; LS[p] = (unsigned char)s; }
                    off[c] = base + np;
                } }
        }
        if (!(dry && (MK_DRY_SKIP & 1))) {
            int lane_u = F.lane; asm volatile("" : "+v"(lane_u));
            const bool hi32 = lane_u >= 32, b16 = (lane_u & 16) != 0;
            const int xr = ((lane_u >> 5) & 1) | ((lane_u >> 3) & 2);
            const unsigned voff_u = 16u * (unsigned)lane_u;
            const v4u hq0 = *(const v4u*)(H2Q + 16 * lane_u), hq1 = *(const v4u*)(H2Q + 1024 + 16 * lane_u), hq2 = *(const v4u*)(H2Q + 2048 + 16 * lane_u), hq3 = *(const v4u*)(H2Q + 3072 + 16 * lane_u);
            const float hs0 = rflf(HST[0]), hs1 = rflf(HST[1]), hs2 = rflf(HST[2]), hs3 = rflf(HST[3]);
            v4u ra[4], rb[4], rc[4], rd[4], re[4], rf[4];
#define P7_ULOAD(R, b) do { const v2u le_ = *(const v2u*)(LE + 4 * (b)); const int e0 = rfl((int)(le_.x & 0xffffu)), e1 = rfl((int)(le_.x >> 16)), e2 = rfl((int)(le_.y & 0xffffu)), e3 = rfl((int)(le_.y >> 16)); \
            gl16x4(R, voff_u, U8 + (size_t)e0 * DM, U8 + (size_t)e1 * DM, U8 + (size_t)e2 * DM, U8 + (size_t)e3 * DM); } while (0)
#define P7_UMETA(b) const int msl_ = LS[4 * (b)]; const float mg_ = LG[4 * (b) + xr]; const float msu_ = LSU[4 * (b) + xr]
#define P7_UCOMP(R, b) do { const int sl = rfl(msl_); const v4u hq = sl == 0 ? hq0 : (sl == 1 ? hq1 : (sl == 2 ? hq2 : hq3)); const float hs = sl == 0 ? hs0 : (sl == 1 ? hs1 : (sl == 2 ? hs2 : hs3)); unsigned p[4]; \
            _Pragma("unroll") for (int x = 0; x < 4; ++x) { int d = __builtin_amdgcn_sdot4((int)hq.x, (int)R[x].x, 0, false); d = __builtin_amdgcn_sdot4((int)hq.y, (int)R[x].y, d, false); \
                d = __builtin_amdgcn_sdot4((int)hq.z, (int)R[x].z, d, false); d = __builtin_amdgcn_sdot4((int)hq.w, (int)R[x].w, d, false); p[x] = (unsigned)d; } \
            const auto s01 = __builtin_amdgcn_permlane32_swap(p[0], p[1], false, false); const auto s23 = __builtin_amdgcn_permlane32_swap(p[2], p[3], false, false); \
            const unsigned t01 = s01[0] + s01[1], t23 = s23[0] + s23[1];        \
            const auto s4 = __builtin_amdgcn_permlane16_swap(t01, t23, false, false); \
            const int t = rowsum16i((int)(s4[0] + s4[1]));                     \
            const float dotf = (float)t * (hs * msu_); const float cf = mg_ * gelu_fast(dotf); \
            LG[4 * (b) + xr] = cf; } while (0)
            P7_ULOAD(ra, 0); P7_ULOAD(rb, 1); P7_ULOAD(rc, 2); P7_ULOAD(rd, 3); P7_ULOAD(re, 4);
#pragma unroll 1
            for (int b = 0; b < nb; b += 6) {
                P7_ULOAD(rf, b + 5);
                { P7_UMETA(b);     P7_VMWAIT(20, ra); P7_UCOMP(ra, b); }
                P7_ULOAD(ra, (b + 6 < nb ? b + 6 : nb - 1));
                { P7_UMETA(b + 1); P7_VMWAIT(20, rb); P7_UCOMP(rb, b + 1); }
                P7_ULOAD(rb, (b + 7 < nb ? b + 7 : nb - 1));
                { P7_UMETA(b + 2); P7_VMWAIT(20, rc); P7_UCOMP(rc, b + 2); }
                P7_ULOAD(rc, (b + 8 < nb ? b + 8 : nb - 1));
                { P7_UMETA(b + 3); P7_VMWAIT(20, rd); P7_UCOMP(rd, b + 3); }
                P7_ULOAD(rd, (b + 9 < nb ? b + 9 : nb - 1));
                { P7_UMETA(b + 4); P7_VMWAIT(20, re); P7_UCOMP(re, b + 4); }
                P7_ULOAD(re, (b + 10 < nb ? b + 10 : nb - 1));
                { P7_UMETA(b + 5); P7_VMWAIT(20, rf); P7_UCOMP(rf, b + 5); }
            }
            asm volatile("s_waitcnt vmcnt(0)" ::: "memory");
#undef P7_ULOAD
#undef P7_UMETA
#undef P7_UCOMP
        }
        float cscale[4];
        {
            float m0 = 0.f, m1 = 0.f, m2 = 0.f, m3 = 0.f;
            for (int idx = lane; idx < 4 * nb; idx += 64) { const float c = fabsf(LG[idx]); const int sl = LS[idx]; m0 = fmaxf(m0, sl == 0 ? c : 0.f); m1 = fmaxf(m1, sl == 1 ? c : 0.f); m2 = fmaxf(m2, sl == 2 ? c : 0.f); m3 = fmaxf(m3, sl == 3 ? c : 0.f); }
            m0 = wave_max(m0); m1 = wave_max(m1); m2 = wave_max(m2); m3 = wave_max(m3);
            cscale[0] = m0 * (1.f / 127.f); cscale[1] = m1 * (1.f / 127.f); cscale[2] = m2 * (1.f / 127.f); cscale[3] = m3 * (1.f / 127.f);
            const float i0 = m0 > 0.f ? 127.f / m0 : 0.f, i1 = m1 > 0.f ? 127.f / m1 : 0.f, i2 = m2 > 0.f ? 127.f / m2 : 0.f, i3 = m3 > 0.f ? 127.f / m3 : 0.f;
            unsigned char* LQ = (unsigned char*)LSU;
            for (int idx = lane; idx < 4 * nb; idx += 64) { const int sl = LS[idx]; const float iv = sl == 0 ? i0 : (sl == 1 ? i1 : (sl == 2 ? i2 : i3)); LQ[idx] = (unsigned char)((int)rintf(LG[idx] * iv) & 0xff); }
        }
        int acc[4][16];
#pragma unroll
        for (int s = 0; s < 4; ++s) {
#pragma unroll
            for (int i = 0; i < 16; ++i) acc[s][i] = 0; }
        if (!(dry && (MK_DRY_SKIP & 2))) {
            int lane_v = F.lane; asm volatile("" : "+v"(lane_v));
            const int* LQ32 = (const int*)LSU;
            v4u ra[4], rb[4], rc[4], rd[4];
#define P7_VLOAD(R, b) do { const v2u le_ = *(const v2u*)(LE + 4 * (b)); const int e0 = rfl((int)(le_.x & 0xffffu)), e1 = rfl((int)(le_.x >> 16)), e2 = rfl((int)(le_.y & 0xffffu)), e3 = rfl((int)(le_.y >> 16)); \
            R[0] = *(const v4u*)(V8 + (size_t)e0 * DM + 16 * lane_v); R[1] = *(const v4u*)(V8 + (size_t)e1 * DM + 16 * lane_v); \
            R[2] = *(const v4u*)(V8 + (size_t)e2 * DM + 16 * lane_v); R[3] = *(const v4u*)(V8 + (size_t)e3 * DM + 16 * lane_v); } while (0)
#define P7_VCOMP(R, b) do { const int sl = rfl(LS[4 * (b)]); const int cq = rfl(LQ32[(b)]); \
                const int cq0 = sl == 0 ? cq : 0, cq1 = sl == 1 ? cq : 0, cq2 = sl == 2 ? cq : 0, cq3 = sl == 3 ? cq : 0; \
                _Pragma("unroll") for (int d = 0; d < 4; ++d) { \
                    const unsigned x_ = __builtin_amdgcn_perm(R[1][d], R[0][d], 0x05010400u), y_ = __builtin_amdgcn_perm(R[1][d], R[0][d], 0x07030602u); \
                    const unsigned c_ = __builtin_amdgcn_perm(R[3][d], R[2][d], 0x05010400u), e_ = __builtin_amdgcn_perm(R[3][d], R[2][d], 0x07030602u); \
                    const int k0 = (int)__builtin_amdgcn_perm(c_, x_, 0x05040100u), k1 = (int)__builtin_amdgcn_perm(c_, x_, 0x07060302u), k2 = (int)__builtin_amdgcn_perm(e_, y_, 0x05040100u), k3 = (int)__builtin_amdgcn_perm(e_, y_, 0x07060302u); \
                    acc[0][4 * d + 0] = __builtin_amdgcn_sdot4(k0, cq0, acc[0][4 * d + 0], false); acc[0][4 * d + 1] = __builtin_amdgcn_sdot4(k1, cq0, acc[0][4 * d + 1], false); \
                    acc[0][4 * d + 2] = __builtin_amdgcn_sdot4(k2, cq0, acc[0][4 * d + 2], false); acc[0][4 * d + 3] = __builtin_amdgcn_sdot4(k3, cq0, acc[0][4 * d + 3], false); \
                    acc[1][4 * d + 0] = __builtin_amdgcn_sdot4(k0, cq1, acc[1][4 * d + 0], false); acc[1][4 * d + 1] = __builtin_amdgcn_sdot4(k1, cq1, acc[1][4 * d + 1], false); \
                    acc[1][4 * d + 2] = __builtin_amdgcn_sdot4(k2, cq1, acc[1][4 * d + 2], false); acc[1][4 * d + 3] = __builtin_amdgcn_sdot4(k3, cq1, acc[1][4 * d + 3], false); \
                    acc[2][4 * d + 0] = __builtin_amdgcn_sdot4(k0, cq2, acc[2][4 * d + 0], false); acc[2][4 * d + 1] = __builtin_amdgcn_sdot4(k1, cq2, acc[2][4 * d + 1], false); \
                    acc[2][4 * d + 2] = __builtin_amdgcn_sdot4(k2, cq2, acc[2][4 * d + 2], false); acc[2][4 * d + 3] = __builtin_amdgcn_sdot4(k3, cq2, acc[2][4 * d + 3], false); \
                    acc[3][4 * d + 0] = __builtin_amdgcn_sdot4(k0, cq3, acc[3][4 * d + 0], false); acc[3][4 * d + 1] = __builtin_amdgcn_sdot4(k1, cq3, acc[3][4 * d + 1], false); \
                    acc[3][4 * d + 2] = __builtin_amdgcn_sdot4(k2, cq3, acc[3][4 * d + 2], false); acc[3][4 * d + 3] = __builtin_amdgcn_sdot4(k3, cq3, acc[3][4 * d + 3], false); } } while (0)
            P7_VLOAD(ra, 0); P7_VLOAD(rb, 1); P7_VLOAD(rc, 2);
#define P7_NX(k) ((k) < nb ? (k) : nb - 1)
#pragma unroll 1
            for (int b = 0; b < nb; b += 12) {
                P7_VLOAD(rd, b + 3);      P7_VCOMP(ra, b);      P7_VLOAD(ra, b + 4);      P7_VCOMP(rb, b + 1);
                P7_VLOAD(rb, b + 5);      P7_VCOMP(rc, b + 2);  P7_VLOAD(rc, b + 6);      P7_VCOMP(rd, b + 3);
                P7_VLOAD(rd, b + 7);      P7_VCOMP(ra, b + 4);  P7_VLOAD(ra, b + 8);      P7_VCOMP(rb, b + 5);
                P7_VLOAD(rb, b + 9);      P7_VCOMP(rc, b + 6);  P7_VLOAD(rc, b + 10);     P7_VCOMP(rd, b + 7);
                P7_VLOAD(rd, b + 11);     P7_VCOMP(ra, b + 8);  P7_VLOAD(ra, P7_NX(b + 12)); P7_VCOMP(rb, b + 9);
                P7_VLOAD(rb, P7_NX(b + 13)); P7_VCOMP(rc, b + 10); P7_VLOAD(rc, P7_NX(b + 14)); P7_VCOMP(rd, b + 11);
            }
#undef P7_NX
#undef P7_VLOAD
#undef P7_VCOMP
        }
#pragma unroll
        for (int s = 0; s < 4; ++s) {
            const int tok = tok0 + s;
            int lane_f = F.lane; asm volatile("" : "+v"(lane_f));
            float* xrow = F.out + O_Y + (size_t)tok * DM + 16 * lane_f;
            float* yrow = dry ? (float*)(F.ws + WS_MIX) + (size_t)(tok & 8191) * DM + 16 * lane_f : xrow;
            const float* ga2 = mods + (size_t)mod_index(tok) * MODW + 5 * DM + 16 * lane_f;
            const float* gf = F.in[I_GFINAL] + 16 * lane_f;
            float x2[16]; float ss = 0.f; const float csc = cscale[s];
#pragma unroll
            for (int j = 0; j < 4; ++j) { const f32x4 xv = *(const f32x4*)(xrow + 4 * j), gv = *(const f32x4*)(ga2 + 4 * j);
#pragma unroll
                for (int i = 0; i < 4; ++i) { const float t = xv[i] + gv[i] * ((float)acc[s][4 * j + i] * csc); x2[4 * j + i] = t; ss += t * t; } }
            const float rstd = 1.f / sqrtf(wave_sum(ss) * (1.f / DM) + EPS);
#pragma unroll
            for (int j = 0; j < 4; ++j) { const f32x4 gv = *(const f32x4*)(gf + 4 * j); f32x4 o;
#pragma unroll
                for (int i = 0; i < 4; ++i) o[i] = x2[4 * j + i] * rstd * gv[i];
                *(f32x4*)(yrow + 4 * j) = o; }
        }
    }
}

__global__ void __launch_bounds__(NWAVES * 64, 2) mk_fwd(Args args) {
    extern __shared__ __attribute__((aligned(16))) unsigned char lds[];
    Frame F;
    F.lds = lds;
    F.tid = threadIdx.x; F.lane = F.tid & 63; F.wave = __builtin_amdgcn_readfirstlane(F.tid >> 6);
    F.G = gridDim.x; { const int bx = blockIdx.x; F.vcu = (F.G % 8 == 0) ? (bx % 8) * (F.G / 8) + bx / 8 : bx; }
    F.in = args.in; F.out = args.out; F.ws = args.ws;
    LAS unsigned char* lds3 = (LAS unsigned char*)lds;
    volatile LAS unsigned* MISC = (volatile LAS unsigned*)(lds3 + MISC_OFF);
    for (int u = F.tid; u < (LDS_BYTES - LDSCTL_OFF) / 4; u += NWAVES * 64) ((LAS unsigned*)(lds3 + LDSCTL_OFF))[u] = 0u;
    __syncthreads();
    unsigned* ctl = (unsigned*)(args.ws + WS_CTL);
    XcdBarrier bar; bar.bar = ctl + CW_BAR; bar.x = 0; bar.st = nullptr;
    const bool one_launch = (args.ph_hi - args.ph_lo) > 1;
    if (one_launch) bar = xcd_barrier_post(ctl + CW_BAR, MISC + 8);
    const int lo = args.ph_lo, hi = args.ph_hi;
#ifndef MK_PHASE_MASK
#define MK_PHASE_MASK 0xff
#endif
#define IN(k) (((MK_PHASE_MASK >> (k)) & 1) && lo <= (k) && (k) < hi)
#define SEAM(k) do { if (IN(k) && IN((k) + 1)) xcd_barrier(bar); } while (0)

#define DUPQ(k) (MK_DUP == (k))
    if (IN(0)) { if (DUPQ(0)) { p0_phase(F); xcd_barrier(bar); } p0_phase(F); SEAM(0); }
    if (IN(1)) { if (DUPQ(1)) { norm_phase(F, 0); xcd_barrier(bar); } norm_phase(F, 0); bias_items(F); SEAM(1); }
    if (IN(2)) {
        pg8::Gemm g{(const pg8::bf16_t*)(F.ws + WS_H), (const pg8::bf16_t*)(F.ws + WS_WIN), NTOK, D_IN, DM}; pg8::StaticOrder S; S.init(NTOK, D_IN, F.G, (int)blockIdx.x);
        EpiInProj E{(bf16*)(F.ws + WS_Q), (bf16*)(F.ws + WS_K), (bf16*)(F.ws + WS_VT), (bf16*)(F.ws + WS_XR), (bf16*)(F.ws + WS_YG), F.out + O_NEWK, F.out + O_NEWV, (const f32x4*)(F.ws + WS_ROPE)};
        if (DUPQ(2)) { pg8::gemm_phase<EpiInProj, pg8::StaticOrder, true, true>(lds3, g, S, E); xcd_barrier(bar); }
        pg8::gemm_phase<EpiInProj, pg8::StaticOrder, true, true>(lds3, g, S, E);
        SEAM(2);
    }
    if (IN(3)) { if (DUPQ(3)) { p3_phase(F, MK_P3_TYPES); xcd_barrier(bar); } p3_phase(F); SEAM(3); }
    if (IN(4)) {
        pg8::Gemm g{(const pg8::bf16_t*)(F.ws + WS_MIX), (const pg8::bf16_t*)(F.ws + WS_WOUT), NTOK, DM, DM}; pg8::StaticOrder S; S.init(NTOK, DM, F.G, (int)blockIdx.x);
        EpiOutProj E{F.in[I_XP], F.in[I_XS], (const float*)(F.ws + WS_MODS), F.in[I_GFFN], F.out + O_Y, (bf16*)(F.ws + WS_H), (float*)(F.ws + WS_SSP)};
        if (DUPQ(4)) { pg8::gemm_phase<EpiOutProj, pg8::StaticOrder, true, true>(lds3, g, S, E); xcd_barrier(bar); }
        pg8::gemm_phase<EpiOutProj, pg8::StaticOrder, true, true>(lds3, g, S, E);
        SEAM(4);
    }
    if (IN(6)) {
        pg8::Gemm g{(const pg8::bf16_t*)(F.ws + WS_H), (const pg8::bf16_t*)(F.ws + WS_WC), NTOK, 2048, DM}; pg8::StaticOrder S; S.init(NTOK, 2048, F.G, (int)blockIdx.x);
        EpiScores E{(bf16*)(F.ws + WS_SC), (const float*)(F.ws + WS_SSP), (const float*)(F.ws + WS_BIAS)};
        if (DUPQ(6)) { pg8::gemm_phase<EpiScores, pg8::StaticOrder, true, true>(lds3, g, S, E); xcd_barrier(bar); }
        pg8::gemm_phase<EpiScores, pg8::StaticOrder, true, true>(lds3, g, S, E);
        SEAM(6);
    }
    if (IN(7)) { if (DUPQ(7)) { p7_phase(F, true); xcd_barrier(bar); } p7_phase(F, false); }
#undef IN
#undef SEAM
}

extern "C" void kernel_launch(void* const* d_in, const int* in_sizes, int n_in, void* d_out, int out_size, void* d_ws, size_t ws_size, hipStream_t stream) {
    static int grid = 0;
    if (grid == 0) {
        if (n_in != 26 || ws_size < WS_END) { fprintf(stderr, "kernel_launch: unexpected n_in %d / ws %zu\n", n_in, ws_size); grid = -1; return; }
        int dev = 0, cus = 0, per_cu = 0;
        if (hipGetDevice(&dev) != hipSuccess || hipDeviceGetAttribute(&cus, hipDeviceAttributeMultiprocessorCount, dev) != hipSuccess) { grid = -1; return; }
        if (hipFuncSetAttribute((const void*)mk_fwd, hipFuncAttributeMaxDynamicSharedMemorySize, LDS_BYTES) != hipSuccess) { fprintf(stderr, "kernel_launch: hipFuncSetAttribute failed\n"); grid = -1; return; }
        if (hipOccupancyMaxActiveBlocksPerMultiprocessor(&per_cu, (const void*)mk_fwd, NWAVES * 64, LDS_BYTES) != hipSuccess || per_cu < 1)
            fprintf(stderr, "kernel_launch: occupancy query reports %d blocks per CU\n", per_cu);
        (void)hipGetLastError();
        grid = cus;
        if (grid != 256) fprintf(stderr, "kernel_launch: note: %d CUs\n", grid);
    }
    if (grid < 0) return;
    (void)hipMemsetAsync((char*)d_ws + WS_CTL, 0, CTL_ZERO_BYTES, stream);
    Args a{};
    for (int i = 0; i < 26; ++i) a.in[i] = (const float*)d_in[i];
    a.out = (float*)d_out; a.ws = (unsigned char*)d_ws;
    if (MK_N_LAUNCHES == 1) {
        a.ph_lo = 0; a.ph_hi = N_PHASES; a.li = 0;
        hipLaunchKernelGGL(mk_fwd, dim3(grid), dim3(NWAVES * 64), LDS_BYTES, stream, a);
    } else {
        for (int li = 0; li < N_PHASES; ++li) { a.ph_lo = li; a.ph_hi = li + 1; a.li = li;
            hipLaunchKernelGGL(mk_fwd, dim3(grid), dim3(NWAVES * 64), LDS_BYTES, stream, a); }
    }
}
```

```cpp
#include <hip/hip_runtime.h>
#include <cstdio>
#include <cstdint>

#ifndef MK_DUP
#define MK_DUP -1
#endif
#ifndef MK_DRY_SKIP
#define MK_DRY_SKIP 0
#endif
#ifndef MK_N_LAUNCHES
#define MK_N_LAUNCHES 1
#endif

namespace pg8 {
#define PG8_LAS __attribute__((address_space(3)))
typedef unsigned short bf16_t;
typedef short bf16x8 __attribute__((ext_vector_type(8)));
typedef float f32x4 __attribute__((ext_vector_type(4)));
typedef unsigned u32x4 __attribute__((ext_vector_type(4)));
typedef unsigned u32x2 __attribute__((ext_vector_type(2)));
constexpr int BM = 256, BK = 64, HALF = 128, HTB = HALF * BK * 2, STAGE_BYTES = 8 * HTB, NXCD = 8, WGM = 8;

__host__ __device__ __forceinline__ int lds_byte(int r, int c) { const int st = (r >> 4) * 2 + (c >> 5), rr = r & 15, cc = c & 31, ob = rr * 64 + cc * 2; return st * 1024 + (ob ^ (((ob >> 9) & 1) << 5)); }
__host__ __device__ __forceinline__ void stage_rc(int b, int& R, int& C) { const int st = b / 1024, sb = b % 1024, swz = sb ^ (((sb >> 9) & 1) << 5); R = (st >> 1) * 16 + swz / 64; C = (st & 1) * 32 + (swz % 64) / 2; }
__host__ __device__ __forceinline__ int perm32(int rho) { const int n = rho >> 4, i = rho & 15; return 8 * (i >> 2) + 4 * n + (i & 3); }

struct Unit { int pm, pn; };
struct Gemm { const bf16_t* A; const bf16_t* Bt; int M, N, K; };

struct StaticOrder {
    int nM, nN, nwg, G, c;
    __host__ __device__ void init(int M, int N, int G_, int c_) { nM = M / BM; nN = N / BM; nwg = nM * nN; G = G_; c = c_; }
    __host__ __device__ bool next(int i, Unit& u) const {
        const long L = (long)i * G + c; if (L >= nwg) return false;
        int wgid = (int)L; { const int q = nwg / NXCD, r = nwg % NXCD, xcd = wgid % NXCD, off = wgid / NXCD; wgid = (xcd < r ? xcd * (q + 1) : r * (q + 1) + (xcd - r) * q) + off; }
        const int nig = WGM * nN, gid = wgid / nig, fm = gid * WGM, gsz = (nM - fm) < WGM ? (nM - fm) : WGM;
        u.pm = fm + ((wgid % nig) % gsz); u.pn = (wgid % nig) / gsz; return true;
    }
    __device__ __forceinline__ void a_ready(const Unit&) const {}
    __device__ __forceinline__ void done(const Unit&) const {}
};

__device__ __forceinline__ unsigned cvt_pk_bf16(float lo, float hi) { unsigned r; asm volatile("v_cvt_pk_bf16_f32 %0, %1, %2" : "=v"(r) : "v"(lo), "v"(hi)); return r; }

template <class Epi, class Sched, bool ALIGN_EPI = false, bool SP2 = false>
__device__ __forceinline__ void gemm_phase(PG8_LAS unsigned char* lds, const Gemm g, const Sched& S, const Epi& E) {
    const int tid = threadIdx.x, wid = __builtin_amdgcn_readfirstlane(tid >> 6), lane = tid & 63, wr = wid >> 2, wc = wid & 3, fr = lane & 15, fq = lane >> 4;
    const int K = g.K, nt = K / BK;
    unsigned voffA[2], voffB[2];
#pragma unroll
    for (int i = 0; i < 2; ++i) { int R, C; stage_rc(tid * 16 + i * 8192, R, C); const int Rb = Epi::PERM ? ((R & ~31) + perm32(R & 31)) : R;
        voffA[i] = (unsigned)(R * K + C) * 2u; voffB[i] = (unsigned)(Rb * K + C) * 2u; }
    const size_t kstep = (size_t)(BK * 2);
    const size_t hstep = (size_t)HALF * K * 2;
    const size_t tstep = 2 * hstep;
    const unsigned ldsw = (unsigned)wid * 1024u;
    const int aoff = lds_byte(wr * 64 + fr, fq * 8), boff = lds_byte(wc * 32 + fr, fq * 8);
#define PG8_SA(b, h) (((b) * 2 + (h)) * HTB)
#define PG8_SB(b, h) ((4 + (b) * 2 + (h)) * HTB)
#define PG8_STAGE(bufoff, gbase, voff) do { _Pragma("unroll") for (int _i = 0; _i < 2; ++_i) \
        __builtin_amdgcn_global_load_lds((const unsigned*)((const char*)(gbase) + (voff)[_i]), (PG8_LAS unsigned*)(lds + (bufoff) + ldsw + _i * 8192), 16, 0, 0); } while (0)
#define PG8_LDA(dst, b, h) do { _Pragma("unroll") for (int m = 0; m < 4; ++m) _Pragma("unroll") for (int k = 0; k < 2; ++k) dst[m][k] = *(const PG8_LAS bf16x8*)(lds + PG8_SA(b, h) + aoff + m * 2048 + k * 1024); } while (0)
#define PG8_LDB(dst, b, h) do { _Pragma("unroll") for (int n = 0; n < 2; ++n) _Pragma("unroll") for (int k = 0; k < 2; ++k) dst[n][k] = *(const PG8_LAS bf16x8*)(lds + PG8_SB(b, h) + boff + n * 2048 + k * 1024); } while (0)
#define PG8_MMA(ai, bj, At, Bt) do { __builtin_amdgcn_s_setprio(1); _Pragma("unroll") for (int m = 0; m < 4; ++m) _Pragma("unroll") for (int n = 0; n < 2; ++n) _Pragma("unroll") for (int k = 0; k < 2; ++k) \
        acc[ai][bj][m][n] = __builtin_amdgcn_mfma_f32_16x16x32_bf16(Bt[n][k], At[m][k], acc[ai][bj][m][n], 0, 0, 0); __builtin_amdgcn_s_setprio(0); } while (0)
#define PG8_WAIT_V(n) asm volatile("s_waitcnt vmcnt(" #n ")" ::: "memory")
#define PG8_WAIT_L(n) asm volatile("s_waitcnt lgkmcnt(" #n ")" ::: "memory")
#define PG8_BAR __builtin_amdgcn_s_barrier()
#define PG8_SCHED __builtin_amdgcn_sched_barrier(0)
    Unit cur, nxt; int ui = 0;
    if (!S.next(0, cur)) return;
    f32x4 acc[2][2][4][2];
#pragma unroll
    for (int a = 0; a < 2; ++a)
#pragma unroll
        for (int b = 0; b < 2; ++b)
#pragma unroll
            for (int m = 0; m < 4; ++m)
#pragma unroll
                for (int n = 0; n < 2; ++n) acc[a][b][m][n] = (f32x4){0.f, 0.f, 0.f, 0.f};
    bf16x8 At[4][2], B0[2][2], B1[2][2];
    const char* cA = (const char*)g.A + (size_t)cur.pm * tstep; const char* cB = (const char*)g.Bt + (size_t)cur.pn * tstep;
    S.a_ready(cur);
    if constexpr (SP2) {
        PG8_STAGE(PG8_SB(0, 0), cB, voffB); PG8_STAGE(PG8_SB(0, 1), cB + hstep, voffB); PG8_STAGE(PG8_SA(0, 0), cA, voffA); PG8_STAGE(PG8_SA(0, 1), cA + hstep, voffA);
        if (wr == 1) PG8_BAR;
        PG8_WAIT_V(2); PG8_BAR;
        PG8_STAGE(PG8_SB(1, 0), cB + kstep, voffB); PG8_STAGE(PG8_SA(1, 0), cA + kstep, voffA); PG8_STAGE(PG8_SB(1, 1), cB + hstep + kstep, voffB);
        PG8_WAIT_V(6); PG8_BAR;
    } else {
        PG8_STAGE(PG8_SB(0, 0), cB, voffB); PG8_STAGE(PG8_SA(0, 0), cA, voffA); PG8_STAGE(PG8_SB(0, 1), cB + hstep, voffB); PG8_STAGE(PG8_SA(0, 1), cA + hstep, voffA);
        if (wr == 1) PG8_BAR;
        PG8_WAIT_V(4); PG8_BAR;
        PG8_STAGE(PG8_SB(1, 0), cB + kstep, voffB); PG8_STAGE(PG8_SA(1, 0), cA + kstep, voffA); PG8_STAGE(PG8_SB(1, 1), cB + hstep + kstep, voffB);
        PG8_WAIT_V(6); PG8_BAR;
    }
    for (;;) {
        const bool has_next = S.next(ui + 1, nxt);
        const char* nA = has_next ? (const char*)g.A + (size_t)nxt.pm * tstep : cA; const char* nB = has_next ? (const char*)g.Bt + (size_t)nxt.pn * tstep : cB;
        for (int t = 0; t < nt; t += 2) {
            const bool last = (t == nt - 2);
            const char* a1 = cA + (size_t)(t + 1) * kstep;
            const char* a2 = last ? nA : cA + (size_t)(t + 2) * kstep; const char* b2 = last ? nB : cB + (size_t)(t + 2) * kstep;
            const char* a3 = a2 + kstep; const char* b3 = b2 + kstep;
            if (last && has_next) S.a_ready(nxt);
            if constexpr (SP2) {
            PG8_LDB(B0, 0, 0); PG8_LDB(B1, 0, 1); PG8_SCHED; PG8_LDA(At, 0, 0); PG8_STAGE(PG8_SA(1, 1), a1 + hstep, voffA);
            PG8_WAIT_V(8); PG8_WAIT_L(0); PG8_BAR; PG8_MMA(0, 0, At, B0); PG8_MMA(0, 1, At, B1); PG8_BAR; PG8_SCHED;
            PG8_LDA(At, 0, 1); PG8_STAGE(PG8_SB(0, 0), b2, voffB); PG8_STAGE(PG8_SB(0, 1), b2 + hstep, voffB); PG8_STAGE(PG8_SA(0, 0), a2, voffA);
            PG8_WAIT_V(8); PG8_WAIT_L(0); PG8_BAR; PG8_MMA(1, 0, At, B0); PG8_MMA(1, 1, At, B1); PG8_BAR; PG8_SCHED;
            PG8_LDB(B0, 1, 0); PG8_LDB(B1, 1, 1); PG8_SCHED; PG8_LDA(At, 1, 0); PG8_STAGE(PG8_SA(0, 1), a2 + hstep, voffA);
            PG8_WAIT_V(8); PG8_WAIT_L(0); PG8_BAR; PG8_MMA(0, 0, At, B0); PG8_MMA(0, 1, At, B1); PG8_BAR; PG8_SCHED;
            PG8_LDA(At, 1, 1); PG8_STAGE(PG8_SB(1, 0), b3, voffB); PG8_STAGE(PG8_SB(1, 1), b3 + hstep, voffB); PG8_STAGE(PG8_SA(1, 0), a3, voffA);
            PG8_WAIT_V(8); PG8_WAIT_L(0); PG8_BAR; PG8_MMA(1, 0, At, B0); PG8_MMA(1, 1, At, B1); PG8_BAR; PG8_SCHED;
            } else {
            PG8_LDB(B0, 0, 0); PG8_SCHED; PG8_LDA(At, 0, 0); PG8_STAGE(PG8_SA(1, 1), a1 + hstep, voffA);
            PG8_WAIT_L(8); PG8_BAR; PG8_WAIT_L(0); PG8_MMA(0, 0, At, B0); PG8_BAR; PG8_SCHED;
            PG8_LDB(B1, 0, 1); PG8_STAGE(PG8_SB(0, 0), b2, voffB);
            PG8_BAR; PG8_WAIT_L(0); PG8_MMA(0, 1, At, B1); PG8_BAR;
            PG8_LDA(At, 0, 1); PG8_STAGE(PG8_SA(0, 0), a2, voffA);
            PG8_BAR; PG8_WAIT_L(0); PG8_MMA(1, 0, At, B0); PG8_BAR; PG8_SCHED;
            PG8_STAGE(PG8_SB(0, 1), b2 + hstep, voffB);
            PG8_WAIT_V(6); PG8_BAR; PG8_MMA(1, 1, At, B1); PG8_BAR;
            PG8_LDB(B0, 1, 0); PG8_SCHED; PG8_LDA(At, 1, 0); PG8_STAGE(PG8_SA(0, 1), a2 + hstep, voffA);
            PG8_WAIT_L(8); PG8_BAR; PG8_WAIT_L(0); PG8_MMA(0, 0, At, B0); PG8_BAR; PG8_SCHED;
            PG8_LDB(B1, 1, 1); PG8_STAGE(PG8_SB(1, 0), b3, voffB);
            PG8_BAR; PG8_WAIT_L(0); PG8_MMA(0, 1, At, B1); PG8_BAR;
            PG8_LDA(At, 1, 1); PG8_STAGE(PG8_SA(1, 0), a3, voffA);
            PG8_BAR; PG8_WAIT_L(0); PG8_MMA(1, 0, At, B0); PG8_BAR; PG8_SCHED;
            PG8_STAGE(PG8_SB(1, 1), b3 + hstep, voffB);
            PG8_WAIT_V(6); PG8_BAR; PG8_MMA(1, 1, At, B1); PG8_BAR;
            }
        }
        if constexpr (ALIGN_EPI) { if (wr == 0) PG8_BAR; }
        E(acc, cur, wr, wc, fr, fq); S.done(cur);
        if (!has_next) break;
#pragma unroll
        for (int a = 0; a < 2; ++a)
#pragma unroll
            for (int b = 0; b < 2; ++b)
#pragma unroll
                for (int m = 0; m < 4; ++m)
#pragma unroll
                    for (int n = 0; n < 2; ++n) acc[a][b][m][n] = (f32x4){0.f, 0.f, 0.f, 0.f};
        cur = nxt; cA = nA; cB = nB; ++ui;
        if constexpr (ALIGN_EPI) { if (wr == 1) PG8_BAR; }
    }
    PG8_WAIT_V(0);
    if constexpr (!ALIGN_EPI) { if (wr == 0) PG8_BAR; }
    PG8_BAR;
#undef PG8_SA
#undef PG8_SB
#undef PG8_STAGE
#undef PG8_LDA
#undef PG8_LDB
#undef PG8_MMA
#undef PG8_WAIT_V
#undef PG8_WAIT_L
#undef PG8_BAR
#undef PG8_SCHED
}
}

constexpr int NWAVES = 8;
constexpr int DM = 1024, NTOK = 16384, NCTX = 8192, D_IN = 1792, NMODV = 9, MODW = 6144;
constexpr int SEQ_C = 256, SEQ_L = 1024, NSEQ_C = 32, NSEQ_L = 8;
constexpr int N_PHASES = 8;
constexpr float LOG2E = 1.4426950408889634f;
constexpr float QSCALE = 0.125f * LOG2E;
constexpr float EPS = 1e-6f;

constexpr size_t MiB = 1u << 20, KiB = 1u << 10;
constexpr size_t WS_CTL = 0, CTL_ZERO_BYTES = 64 * KiB;
constexpr size_t WS_MODS = 1 * MiB;
constexpr size_t WS_ROPE = 1 * MiB + 256 * KiB;
constexpr size_t WS_RGW  = 1 * MiB + 512 * KiB;
constexpr size_t WS_CK   = 1 * MiB + 768 * KiB;
constexpr size_t WS_CVT  = 2 * MiB + 256 * KiB;
constexpr size_t WS_WIN  = 3 * MiB;
constexpr size_t WS_WOUT = 7 * MiB;
constexpr size_t WS_WC   = 9 * MiB;
constexpr size_t WS_U    = 16 * MiB;
constexpr size_t WS_SSP  = 14 * MiB;
constexpr size_t WS_BIAS = 15 * MiB;
constexpr size_t WS_SU   = 13 * MiB;
constexpr size_t WS_SV   = 13 * MiB + 64 * KiB;
constexpr size_t WS_V    = 48 * MiB;
constexpr size_t WS_H    = 80 * MiB;
constexpr size_t WS_MIX  = 112 * MiB;
constexpr size_t WS_Q    = 144 * MiB;
constexpr size_t WS_K    = 160 * MiB;
constexpr size_t WS_VT   = 164 * MiB;
constexpr size_t WS_XR   = 168 * MiB;
constexpr size_t WS_YG   = 184 * MiB;
constexpr size_t WS_HF   = 200 * MiB;
constexpr size_t WS_SC   = 144 * MiB;
constexpr size_t WS_END  = 232 * MiB;
constexpr int VT_LAT_OFF = NSEQ_C * 2 * 64 * SEQ_C;

constexpr int CW_BAR = 4096;

constexpr int RING_BYTES = 131072;
constexpr int LDSCTL_OFF = 146944, MISC_OFF = LDSCTL_OFF + 320;
constexpr int LDS_BYTES = 147456;

#define GAS __attribute__((address_space(1)))
#define LAS __attribute__((address_space(3)))
typedef unsigned short bf16;
typedef unsigned v4u __attribute__((ext_vector_type(4)));
typedef unsigned v2u __attribute__((ext_vector_type(2)));
typedef float f32x4 __attribute__((ext_vector_type(4)));
typedef float f32x2 __attribute__((ext_vector_type(2)));
typedef float f32x16 __attribute__((ext_vector_type(16)));
typedef short bf16x8 __attribute__((ext_vector_type(8)));
typedef GAS unsigned gu32;
#define RLX_AGENT __ATOMIC_RELAXED, __HIP_MEMORY_SCOPE_AGENT

__device__ __forceinline__ unsigned f2bf(float f) { unsigned u = __builtin_bit_cast(unsigned, f); return (u + 0x7fffu + ((u >> 16) & 1u)) >> 16; }
typedef float f32x2_t_ __attribute__((ext_vector_type(2))); typedef __bf16 bf16x2_t_ __attribute__((ext_vector_type(2)));
__device__ __forceinline__ unsigned pk2(float lo, float hi) { f32x2_t_ v = {lo, hi}; bf16x2_t_ b = __builtin_convertvector(v, bf16x2_t_); return __builtin_bit_cast(unsigned, b); }
__device__ __forceinline__ float bf2f(unsigned b) { return __builtin_bit_cast(float, b << 16); }
__device__ __forceinline__ float bflo(unsigned w) { return __builtin_bit_cast(float, w << 16); }
__device__ __forceinline__ float bfhi(unsigned w) { return __builtin_bit_cast(float, w & 0xffff0000u); }
__device__ __forceinline__ float sigmoidf_(float x) { return 1.f / (1.f + __expf(-x)); }
__device__ __forceinline__ float gelu_tanh(float x) { const float y = 0.7978845608028654f * (x + 0.044715f * x * x * x); const float e = __expf(2.f * y); return 0.5f * x * (2.f - 2.f / (1.f + e)); }
template <int CTRL> __device__ __forceinline__ float dppf_(float v) { return __builtin_bit_cast(float, __builtin_amdgcn_update_dpp(0, __builtin_bit_cast(int, v), CTRL, 0xf, 0xf, true)); }
__device__ __forceinline__ float xrow16_(float v) {
    unsigned a = __builtin_bit_cast(unsigned, v), b = a; asm volatile("" : "+v"(b));
    const auto r = __builtin_amdgcn_permlane16_swap(a, b, false, false);
    const bool odd = (threadIdx.x & 16) != 0; return __builtin_bit_cast(float, odd ? r[0] : r[1]);
}
__device__ __forceinline__ float xhalf32_(float v) {
    unsigned a = __builtin_bit_cast(unsigned, v), b = a; asm volatile("" : "+v"(b));
    const auto r = __builtin_amdgcn_permlane32_swap(a, b, false, false);
    const bool hi = (threadIdx.x & 32) != 0; return __builtin_bit_cast(float, hi ? r[0] : r[1]);
}
__device__ __forceinline__ float wave_sum(float v) {
    v += dppf_<0xB1>(v); v += dppf_<0x4E>(v); v += dppf_<0x141>(v); v += dppf_<0x140>(v);
    v += xrow16_(v); v += xhalf32_(v); return v;
}
__device__ __forceinline__ float wave_max(float v) {
    v = fmaxf(v, dppf_<0xB1>(v)); v = fmaxf(v, dppf_<0x4E>(v)); v = fmaxf(v, dppf_<0x141>(v)); v = fmaxf(v, dppf_<0x140>(v));
    v = fmaxf(v, xrow16_(v)); v = fmaxf(v, xhalf32_(v)); return v;
}
__device__ __forceinline__ int crow(int r, int hi) { return (r & 3) + 8 * (r >> 2) + 4 * hi; }

#define XB_TMO      128
#define XB_XCNT(j)  (256  + 64 * (j))
#define XB_XSUB(j)  (1280 + 64 * (j))
#define XB_XGEN(j)  (2304 + 64 * (j))
#define XB_TOP      3328
#define XB_TOPGEN   3392
#define XCD_BAR_WORDS 3456
#define XB_SPIN_CAP (1u << 18)
__device__ __forceinline__ unsigned xb_ld(unsigned* p)              { return __hip_atomic_load(p, __ATOMIC_RELAXED, __HIP_MEMORY_SCOPE_AGENT); }
__device__ __forceinline__ unsigned xb_add(unsigned* p, unsigned v) { return __hip_atomic_fetch_add(p, v, __ATOMIC_RELAXED, __HIP_MEMORY_SCOPE_AGENT); }
__device__ __forceinline__ unsigned xb_xcc_id() { return (unsigned)__builtin_amdgcn_s_getreg((3 << 11) | 20) & 0xFu; }
#define XB_SPIN(cond, bar) do { unsigned _sp = 0; while (cond) { __builtin_amdgcn_s_sleep(1); \
    if ((++_sp & 255u) == 0u) { if (xb_ld(&(bar)[XB_TMO])) break; if (_sp > XB_SPIN_CAP) { atomicAdd(&(bar)[XB_TMO], 1u); break; } } } } while (0)
struct XcdBarrier { unsigned* bar; unsigned x; volatile LAS unsigned* st; };
__device__ __forceinline__ XcdBarrier xcd_barrier_post(unsigned* bar, volatile LAS unsigned* st) {
    XcdBarrier b; b.bar = bar; b.x = xb_xcc_id(); b.st = st;
    if (threadIdx.x == 0) (void)xb_add(&bar[XB_XCNT(b.x)], 1u);
    return b;
}
__device__ __forceinline__ void xcd_barrier_complete(unsigned* bar, unsigned x, unsigned& nloc, unsigned& nx) {
    const unsigned G = gridDim.x * gridDim.y * gridDim.z;
    unsigned sum, cnt, mine, sp = 0u;
    for (;;) {
        sum = 0u; cnt = 0u; mine = 0u;
#pragma unroll
        for (unsigned j = 0; j < 16; ++j) { const unsigned c = xb_ld(&bar[XB_XCNT(j)]); sum += c; cnt += (c > 0u) ? 1u : 0u; mine = (j == x) ? c : mine; }
        if (sum == G) break;
        __builtin_amdgcn_s_sleep(1);
        if ((++sp & 255u) == 0u) { if (xb_ld(&bar[XB_TMO])) break; if (sp > XB_SPIN_CAP) { atomicAdd(&bar[XB_TMO], 1u); break; } }
    }
    nloc = mine > 0u ? mine : 1u; nx = cnt > 0u ? cnt : 1u;
}
__device__ __forceinline__ void xcd_barrier(const XcdBarrier& b) {
    asm volatile("s_waitcnt vmcnt(0)" ::: "memory");
    __syncthreads();
    if (threadIdx.x == 0) {
        unsigned* bar = b.bar;
        __builtin_amdgcn_s_waitcnt(0);
        unsigned nloc = b.st[0], nx = b.st[1];
        if (nloc == 0u) { xcd_barrier_complete(bar, b.x, nloc, nx); b.st[0] = nloc; b.st[1] = nx; }
        const unsigned old = xb_add(&bar[XB_XSUB(b.x)], 1u);
        const unsigned gen = old / nloc;
        if (old + 1u == (gen + 1u) * nloc) {
            __builtin_amdgcn_fence(__ATOMIC_RELEASE, "agent");
            asm volatile("s_waitcnt vmcnt(0)" ::: "memory");
            const unsigned og = xb_add(&bar[XB_TOP], 1u);
            const unsigned tg = og / nx;
            if (og + 1u == (tg + 1u) * nx) xb_add(&bar[XB_TOPGEN], 1u);
            else XB_SPIN(xb_ld(&bar[XB_TOPGEN]) == tg, bar);
            __builtin_amdgcn_fence(__ATOMIC_ACQUIRE, "agent");
            xb_add(&bar[XB_XGEN(b.x)], 1u);
            asm volatile("s_waitcnt vmcnt(0)" ::: "memory");
        } else {
            XB_SPIN(xb_ld(&bar[XB_XGEN(b.x)]) == gen, bar);
            __builtin_amdgcn_fence(__ATOMIC_ACQUIRE, "agent");
            asm volatile("s_waitcnt vmcnt(0)" ::: "memory");
        }
    }
    __syncthreads();
}

struct Args { const float* in[26]; float* out; unsigned char* ws; int ph_lo, ph_hi, li, pad; };

struct Frame {
    unsigned char* lds;
    int tid, lane, wave, vcu, G;
    const float* const* in;
    float* out; unsigned char* ws;
};
enum { I_XP = 0, I_XS, I_CK, I_CV, I_SRNN, I_C, I_CCTX, I_WMOD, I_BMOD, I_GMIX, I_GFFN, I_WIN, I_CONVW, I_CONVB, I_RGWA, I_RGBA, I_RGWI, I_RGBI, I_RGLAM, I_SINK, I_WOUT, I_PWQ, I_PSK, I_PU, I_PV, I_GFINAL };
constexpr size_t O_Y = 0, O_NEWK = (size_t)NTOK * DM, O_NEWV = O_NEWK + (size_t)NCTX * 128, O_NEWRNN = O_NEWV + (size_t)NCTX * 128;

__device__ __forceinline__ int mod_index(int tok) { return tok < NCTX ? 0 : 1 + ((tok - NCTX) >> 10); }
__device__ __forceinline__ const float* x_row(const Frame& F, int tok) { return tok < NCTX ? F.in[I_XP] + (size_t)tok * DM : F.in[I_XS] + (size_t)(tok - NCTX) * DM; }

template <class RowMap>
__device__ __forceinline__ void p0_transpose_item(const float* W, int K, int N, bf16* WT, float* scr, int item, int lane, RowMap rowmap, float scale = 1.f) {
    const int nblk = N / 32, kb = item / nblk, nb = item % nblk, k0 = 64 * kb, n0 = 32 * nb;
#pragma unroll 8
    for (int i = 0; i < 32; ++i) { const int kk = 2 * i + (lane >> 5); scr[kk * 33 + (lane & 31)] = W[(size_t)(k0 + kk) * N + n0 + (lane & 31)]; }
    __builtin_amdgcn_s_waitcnt(0xC07F); asm volatile("" ::: "memory");
    const int c = lane & 7;
#pragma unroll
    for (int j = 0; j < 4; ++j) { const int n = (lane >> 3) + 8 * j; const float* s = scr + (8 * c) * 33 + n;
        v4u o; o.x = pk2(s[0 * 33] * scale, s[1 * 33] * scale); o.y = pk2(s[2 * 33] * scale, s[3 * 33] * scale); o.z = pk2(s[4 * 33] * scale, s[5 * 33] * scale); o.w = pk2(s[6 * 33] * scale, s[7 * 33] * scale);
        *(v4u*)(WT + (size_t)rowmap(n0 + n) * K + k0 + 8 * c) = o; }
    __builtin_amdgcn_s_waitcnt(0xC07F); asm volatile("" ::: "memory");
}
struct MapId { __device__ __forceinline__ int operator()(int n) const { return n; } };
struct MapWin { __device__ __forceinline__ int operator()(int n) const { if (n >= 640) return n; const int hb = n & ~63, o = n & 63; return hb + ((o & 31) << 1) + (o >> 5); } };

__device__ __forceinline__ void p0_phase(Frame& F) {
    float* ldsf = (float*)F.lds;
    const int tid = F.tid, lane = F.lane, wave = F.wave, v = F.vcu;
    if (v < 192) {
        for (int i = tid; i < NMODV * DM; i += 512) { const int j = i >> 10, d = i & 1023; const float c = (j == 0) ? F.in[I_CCTX][d] : F.in[I_C][(j - 1) * DM + d]; ldsf[i] = c * sigmoidf_(c); }
        __syncthreads();
        const int e0 = 32 * v, c4 = tid & 7, kq = tid >> 3;
        float acc[NMODV][4];
#pragma unroll
        for (int j = 0; j < NMODV; ++j) { acc[j][0] = 0.f; acc[j][1] = 0.f; acc[j][2] = 0.f; acc[j][3] = 0.f; }
        const float* wm = F.in[I_WMOD] + e0 + 4 * c4;
#pragma unroll 4
        for (int kk = 0; kk < 16; ++kk) { const int k = kq * 16 + kk; const f32x4 w = *(const f32x4*)(wm + (size_t)k * MODW);
#pragma unroll
            for (int j = 0; j < NMODV; ++j) { const float s = ldsf[j * DM + k]; acc[j][0] += s * w[0]; acc[j][1] += s * w[1]; acc[j][2] += s * w[2]; acc[j][3] += s * w[3]; } }
#pragma unroll
        for (int j = 0; j < NMODV; ++j)
#pragma unroll
            for (int i = 0; i < 4; ++i) { float a = acc[j][i]; a += __shfl_xor(a, 8); a += __shfl_xor(a, 16); a += __shfl_xor(a, 32); acc[j][i] = a; }
        float* red = ldsf + NMODV * DM;
        if (lane < 8) {
#pragma unroll
            for (int j = 0; j < NMODV; ++j)
#pragma unroll
                for (int i = 0; i < 4; ++i) red[(wave * NMODV + j) * 32 + 4 * c4 + i] = acc[j][i];
        }
        __syncthreads();
        if (tid < NMODV * 32) { const int j = tid >> 5, col = tid & 31; float s = F.in[I_BMOD][e0 + col];
#pragma unroll
            for (int w = 0; w < 8; ++w) s += red[(w * NMODV + j) * 32 + col];
            ((float*)(F.ws + WS_MODS))[j * MODW + e0 + col] = s; }
        __syncthreads();
    }
    if (v < 256) {
        const int hh = v >> 4, dt = v & 15, d0 = 64 * dt;
        float* At = ldsf;
        float* Bkt = ldsf + 128 * 64;
        const float* wq = F.in[I_PWQ] + hh * 128;
        const float* sk = F.in[I_PSK] + (size_t)hh * 128 * 128;
#pragma unroll
        for (int i = 0; i < 4; ++i) { const int f = tid + 512 * i, d = f & 63, q4 = f >> 6; const f32x4 a = *(const f32x4*)(wq + (size_t)(d0 + d) * 2048 + 4 * q4);
            At[(4 * q4 + 0) * 64 + d] = a[0]; At[(4 * q4 + 1) * 64 + d] = a[1]; At[(4 * q4 + 2) * 64 + d] = a[2]; At[(4 * q4 + 3) * 64 + d] = a[3]; }
#pragma unroll
        for (int i = 0; i < 8; ++i) { const int f = tid + 512 * i, key = f & 127, q4 = f >> 7; const f32x4 b = *(const f32x4*)(sk + (size_t)key * 128 + 4 * q4);
            Bkt[(4 * q4 + 0) * 128 + key] = b[0]; Bkt[(4 * q4 + 1) * 128 + key] = b[1]; Bkt[(4 * q4 + 2) * 128 + key] = b[2]; Bkt[(4 * q4 + 3) * 128 + key] = b[3]; }
        __syncthreads();
        const int dg = tid & 15, kg = tid >> 4;
        float acc[4][4];
#pragma unroll
        for (int i = 0; i < 4; ++i)
#pragma unroll
            for (int j = 0; j < 4; ++j) acc[i][j] = 0.f;
#pragma unroll 4
        for (int q = 0; q < 128; ++q) { const f32x4 a = *(const f32x4*)(At + q * 64 + 4 * dg); const f32x4 b = *(const f32x4*)(Bkt + q * 128 + 4 * kg);
#pragma unroll
            for (int i = 0; i < 4; ++i)
#pragma unroll
                for (int j = 0; j < 4; ++j) acc[i][j] += a[i] * b[j]; }
        bf16* WcT = (bf16*)(F.ws + WS_WC);
#pragma unroll
        for (int j = 0; j < 4; ++j) { v2u o; o.x = pk2(acc[0][j], acc[1][j]); o.y = pk2(acc[2][j], acc[3][j]);
            *(v2u*)(WcT + (size_t)(hh * 128 + 4 * kg + j) * DM + d0 + 4 * dg) = o; }
        __syncthreads();
    }
    const int gw = v * NWAVES + wave, NGW = F.G * NWAVES;
    float* scr = ldsf + wave * 4096;
    {
        constexpr int I_IN = (DM / 64) * (D_IN / 32), I_OUT = (DM / 64) * (DM / 32), I_RG = 32 * 2;
        constexpr int NIT = I_IN + I_OUT + I_RG;
        for (int it = gw; it < NIT; it += NGW) {
            int r = it;
            if (r < I_IN) { p0_transpose_item(F.in[I_WIN], DM, D_IN, (bf16*)(F.ws + WS_WIN), scr, r, lane, MapWin()); continue; } r -= I_IN;
            if (r < I_OUT) { p0_transpose_item(F.in[I_WOUT], DM, DM, (bf16*)(F.ws + WS_WOUT), scr, r, lane, MapId()); continue; } r -= I_OUT;
            { const int mm = r >> 1, sub = r & 1, dir = mm >> 4, n = (mm >> 1) & 7, gate = mm & 1;
              const float* src = (gate ? F.in[I_RGWI] : F.in[I_RGWA]) + (size_t)(dir * 8 + n) * 4096;
              bf16* dst = (bf16*)(F.ws + WS_RGW) + (size_t)((dir * 8 + n) * 2 + gate) * 4096;
              p0_transpose_item(src, 64, 64, dst, scr, sub, lane, MapId(), -LOG2E); }
        }
    }
    for (int it0 = 4 * gw; it0 < 2 * 16384; it0 += 4 * NGW) {
        f32x4 a[4][4];
#pragma unroll
        for (int r = 0; r < 4; ++r) { const int it = it0 + r, tb = it >> 14, row = it & 16383;
            const float* src = (tb ? F.in[I_PV] : F.in[I_PU]) + (size_t)row * DM + 16 * lane;
#pragma unroll
            for (int j = 0; j < 4; ++j) a[r][j] = *(const f32x4*)(src + 4 * j); }
        float am[4];
#pragma unroll
        for (int r = 0; r < 4; ++r) { float m = 0.f;
#pragma unroll
            for (int j = 0; j < 4; ++j) m = fmaxf(m, fmaxf(fmaxf(fabsf(a[r][j][0]), fabsf(a[r][j][1])), fmaxf(fabsf(a[r][j][2]), fabsf(a[r][j][3]))));
            am[r] = m; }
#pragma unroll
        for (int r = 0; r < 4; ++r) am[r] = wave_max(am[r]);
#pragma unroll
        for (int r = 0; r < 4; ++r) { const int it = it0 + r, tb = it >> 14, row = it & 16383;
            const float inv = am[r] > 0.f ? 127.f / am[r] : 0.f;
            v4u o4;
#pragma unroll
            for (int j = 0; j < 4; ++j) { unsigned w = 0;
#pragma unroll
                for (int i = 0; i < 4; ++i) { int q = (int)rintf(a[r][j][i] * inv); q = q > 127 ? 127 : (q < -127 ? -127 : q); w |= ((unsigned)q & 0xffu) << (8 * i); }
                o4[j] = w; }
            *(v4u*)(F.ws + (tb ? WS_V : WS_U) + (size_t)row * DM + 16 * lane) = o4;
            if (lane == 0) ((float*)(F.ws + (tb ? WS_SV : WS_SU)))[row] = am[r] * (1.f / 127.f); }
    }
    const int gt = v * 512 + tid, NGT = F.G * 512;
    for (int e = gt; e < 8 * 256 * 128; e += NGT) {
        const int c = e & 127, bp = e >> 7, kvh = c >> 6, p = c & 63, old = (p & 1) ? 32 + (p >> 1) : (p >> 1);
        ((bf16*)(F.ws + WS_CK))[e] = (bf16)f2bf(F.in[I_CK][(size_t)bp * 128 + kvh * 64 + old]);
    }
    for (int e = gt; e < 8 * 256 * 128; e += NGT) {
        const int pos = e & 255, d = (e >> 8) & 63, kvh = (e >> 14) & 1, b = e >> 15;
        ((bf16*)(F.ws + WS_CVT))[e] = (bf16)f2bf(F.in[I_CV][(size_t)(b * 256 + pos) * 128 + kvh * 64 + d]);
    }
    for (int e = gt; e < 1024 * 32; e += NGT) {
        const int s = e >> 5, i = e & 31, row = s >> 6, col = s & 63;
        const float inv = powf(10000.0f, -(float)(i & 15) / 16.0f);
        const float ang = (i < 16 ? (float)row : (float)col) * inv;
        f32x2 cs; cs.x = cosf(ang); cs.y = sinf(ang);
        ((f32x2*)(F.ws + WS_ROPE))[e] = cs;
    }
}

__device__ __forceinline__ void bias_items(Frame& F) {
    const int gw = F.vcu * NWAVES + F.wave, NGW = F.G * NWAVES, lane = F.lane;
    const float* mods = (const float*)(F.ws + WS_MODS); const bf16* WcT = (const bf16*)(F.ws + WS_WC); float* BIAS = (float*)(F.ws + WS_BIAS);
    for (int n = gw; n < 2048; n += NGW) {
        const v4u a = *(const v4u*)(WcT + (size_t)n * DM + 16 * lane), b = *(const v4u*)(WcT + (size_t)n * DM + 16 * lane + 8);
        float w[16];
        w[0] = bflo(a.x); w[1] = bfhi(a.x); w[2] = bflo(a.y); w[3] = bfhi(a.y); w[4] = bflo(a.z); w[5] = bfhi(a.z); w[6] = bflo(a.w); w[7] = bfhi(a.w);
        w[8] = bflo(b.x); w[9] = bfhi(b.x); w[10] = bflo(b.y); w[11] = bfhi(b.y); w[12] = bflo(b.z); w[13] = bfhi(b.z); w[14] = bflo(b.w); w[15] = bfhi(b.w);
#pragma unroll 1
        for (int j = 0; j < NMODV; ++j) { const float* sh = mods + (size_t)j * MODW + 3 * DM + 16 * lane; float d = 0.f;
#pragma unroll
            for (int q = 0; q < 4; ++q) { const f32x4 v = *(const f32x4*)(sh + 4 * q); d += v[0] * w[4 * q] + v[1] * w[4 * q + 1] + v[2] * w[4 * q + 2] + v[3] * w[4 * q + 3]; }
            d = wave_sum(d); if (lane == 0) BIAS[j * 2048 + n] = d; }
    }
}
__device__ __forceinline__ void norm_phase(Frame& F, int which) {
    const int gw = F.vcu * NWAVES + F.wave, NGW = F.G * NWAVES, lane = F.lane;
    const float* mods = (const float*)(F.ws + WS_MODS);
    const float* g = F.in[which ? I_GFFN : I_GMIX];
    bf16* H = (bf16*)(F.ws + WS_H);
    for (int tok = gw; tok < NTOK; tok += NGW) {
        const float* xr = which ? F.out + O_Y + (size_t)tok * DM : x_row(F, tok);
        const float* mv = mods + (size_t)mod_index(tok) * MODW + (which ? 3 * DM : 0);
        f32x4 v[4]; float ss = 0.f;
#pragma unroll
        for (int j = 0; j < 4; ++j) { v[j] = *(const f32x4*)(xr + 256 * j + 4 * lane); ss += (v[j][0] * v[j][0] + v[j][1] * v[j][1]) + (v[j][2] * v[j][2] + v[j][3] * v[j][3]); }
        const float rstd = 1.f / sqrtf(wave_sum(ss) * (1.f / DM) + EPS);
#pragma unroll
        for (int j = 0; j < 4; ++j) { const int e = 256 * j + 4 * lane;
            const f32x4 gg = *(const f32x4*)(g + e), sh = *(const f32x4*)(mv + e), sc = *(const f32x4*)(mv + DM + e);
            f32x4 o;
#pragma unroll
            for (int i = 0; i < 4; ++i) o[i] = v[j][i] * rstd * gg[i] * (1.f + sc[i]) + sh[i];
            v2u w; w.x = pk2(o[0], o[1]); w.y = pk2(o[2], o[3]); *(v2u*)(H + (size_t)tok * DM + e) = w; }
    }
}

struct EpiInProj {
    static constexpr bool PERM = true;
    bf16 *q, *k, *vT, *xr, *yg; float *newk, *newv; const f32x4* rope4;
    __device__ __forceinline__ void operator()(const f32x4 (&acc)[2][2][4][2], const pg8::Unit& u, int wr, int wc, int fr, int fq) const {
        const bool lat = u.pm >= 32;
        const int pn = u.pn;
#pragma unroll
        for (int ai = 0; ai < 2; ++ai)
#pragma unroll
            for (int m = 0; m < 4; ++m) {
                const int row = u.pm * 256 + ai * 128 + wr * 64 + m * 16 + fr;
                const int pos = lat ? ((row - NCTX) & 1023) : (row & 255);
#pragma unroll
                for (int bj = 0; bj < 2; ++bj) {
                    const int c = pn * 256 + bj * 128 + wc * 32 + 8 * fq;
                    f32x4 v0 = acc[ai][bj][m][0], v1 = acc[ai][bj][m][1];
                    if (pn < 2 || (pn == 2 && bj == 0)) {
                        const int i = (c & 63) >> 1;
                        if (lat) { const f32x4 cs0 = rope4[(pos * 32 + i) >> 1], cs1 = rope4[((pos * 32 + i) >> 1) + 1];
                            const float a0 = v0[0] * cs0[0] - v0[1] * cs0[1], a1 = v0[1] * cs0[0] + v0[0] * cs0[1];
                            const float b0 = v0[2] * cs0[2] - v0[3] * cs0[3], b1 = v0[3] * cs0[2] + v0[2] * cs0[3];
                            const float c0 = v1[0] * cs1[0] - v1[1] * cs1[1], c1 = v1[1] * cs1[0] + v1[0] * cs1[1];
                            const float d0 = v1[2] * cs1[2] - v1[3] * cs1[3], d1 = v1[3] * cs1[2] + v1[2] * cs1[3];
                            v0[0] = a0; v0[1] = a1; v0[2] = b0; v0[3] = b1; v1[0] = c0; v1[1] = c1; v1[2] = d0; v1[3] = d1; }
                        if (pn < 2) { v4u w; w.x = pk2(v0[0] * QSCALE, v0[1] * QSCALE); w.y = pk2(v0[2] * QSCALE, v0[3] * QSCALE); w.z = pk2(v1[0] * QSCALE, v1[1] * QSCALE); w.w = pk2(v1[2] * QSCALE, v1[3] * QSCALE);
                            *(v4u*)(q + (size_t)row * 512 + c) = w; }
                        else { const int kc = c - 512; v4u w; w.x = pk2(v0[0], v0[1]); w.y = pk2(v0[2], v0[3]); w.z = pk2(v1[0], v1[1]); w.w = pk2(v1[2], v1[3]); *(v4u*)(k + (size_t)row * 128 + kc) = w;
                            if (!lat) { float* nk = newk + (size_t)row * 128 + (kc & 64) + i; f32x4 lo; lo[0] = v0[0]; lo[1] = v0[2]; lo[2] = v1[0]; lo[3] = v1[2]; f32x4 hi; hi[0] = v0[1]; hi[1] = v0[3]; hi[2] = v1[1]; hi[3] = v1[3];
                                *(f32x4*)nk = lo; *(f32x4*)(nk + 32) = hi; } }
                    } else if (pn == 2) {
                        const int vc = c - 640, kvh = vc >> 6, d = vc & 63;
                        if (!lat) { *(f32x4*)(newv + (size_t)row * 128 + vc) = v0; *(f32x4*)(newv + (size_t)row * 128 + vc + 4) = v1; }
                        bf16* vp; int S;
                        if (!lat) { S = SEQ_C; vp = vT + ((size_t)((row >> 8) * 2 + kvh) * 64 + d) * SEQ_C + pos; }
                        else { S = SEQ_L; vp = vT + VT_LAT_OFF + ((size_t)(((row - NCTX) >> 10) * 2 + kvh) * 64 + d) * SEQ_L + pos; }
                        vp[0] = (bf16)f2bf(v0[0]); vp[S] = (bf16)f2bf(v0[1]); vp[2 * S] = (bf16)f2bf(v0[2]); vp[3 * S] = (bf16)f2bf(v0[3]);
                        vp[4 * S] = (bf16)f2bf(v1[0]); vp[5 * S] = (bf16)f2bf(v1[1]); vp[6 * S] = (bf16)f2bf(v1[2]); vp[7 * S] = (bf16)f2bf(v1[3]);
                    } else {
                        v4u w; w.x = pk2(v0[0], v0[1]); w.y = pk2(v0[2], v0[3]); w.z = pk2(v1[0], v1[1]); w.w = pk2(v1[2], v1[3]);
                        if (pn < 5) *(v4u*)(xr + (size_t)row * 512 + (c - 768)) = w; else *(v4u*)(yg + (size_t)row * 512 + (c - 1280)) = w;
                    }
                }
            }
    }
};
struct EpiOutProj {
    static constexpr bool PERM = true;
    const float *xp, *xs, *mods, *gffn; float* x1; bf16* ap; float* ssp;
    __device__ __forceinline__ void operator()(const f32x4 (&acc)[2][2][4][2], const pg8::Unit& u, int wr, int wc, int fr, int fq) const {
        const int mi = u.pm < 32 ? 0 : 1 + ((u.pm - 32) >> 2);
        const float* mv = mods + (size_t)mi * MODW;
        const int row0 = u.pm * 256 + wr * 64 + fr;
        const float* xbase = (u.pm < 32 ? xp : xs - (size_t)NCTX * DM) + (size_t)row0 * DM;
        float ssq[2][4];
#pragma unroll
        for (int ai = 0; ai < 2; ++ai)
#pragma unroll
            for (int m = 0; m < 4; ++m) ssq[ai][m] = 0.f;
#pragma unroll
        for (int bj = 0; bj < 2; ++bj) {
            const int c = u.pn * 256 + bj * 128 + wc * 32 + 8 * fq;
            const f32x4 gv0 = *(const f32x4*)(mv + 2 * DM + c), gv1 = *(const f32x4*)(mv + 2 * DM + c + 4);
            const f32x4 g20 = *(const f32x4*)(gffn + c) * (1.f + *(const f32x4*)(mv + 4 * DM + c)), g21 = *(const f32x4*)(gffn + c + 4) * (1.f + *(const f32x4*)(mv + 4 * DM + c + 4));
#pragma unroll
            for (int h4 = 0; h4 < 4; ++h4) {
                const int ai = h4 >> 1;
                f32x4 xv[2][2];
#pragma unroll
                for (int mm = 0; mm < 2; ++mm) { const float* xr = xbase + (size_t)(ai * 128 + (2 * (h4 & 1) + mm) * 16) * DM + c; xv[mm][0] = *(const f32x4*)xr; xv[mm][1] = *(const f32x4*)(xr + 4); }
                asm volatile("" ::: "memory");
#pragma unroll
                for (int mm = 0; mm < 2; ++mm) {
                    const int m = 2 * (h4 & 1) + mm;
                    const size_t off = (size_t)(row0 + ai * 128 + m * 16) * DM + c;
                    const f32x4 o0 = xv[mm][0] + gv0 * acc[ai][bj][m][0], o1 = xv[mm][1] + gv1 * acc[ai][bj][m][1];
                    *(f32x4*)(x1 + off) = o0; *(f32x4*)(x1 + off + 4) = o1;
                    ssq[ai][m] += ((o0[0] * o0[0] + o0[1] * o0[1]) + (o0[2] * o0[2] + o0[3] * o0[3])) + ((o1[0] * o1[0] + o1[1] * o1[1]) + (o1[2] * o1[2] + o1[3] * o1[3]));
                    const f32x4 t0 = o0 * g20, t1 = o1 * g21; v4u w; w.x = pk2(t0[0], t0[1]); w.y = pk2(t0[2], t0[3]); w.z = pk2(t1[0], t1[1]); w.w = pk2(t1[2], t1[3]);
                    *(v4u*)(ap + off) = w;
                }
                asm volatile("" ::: "memory");
            }
        }
#pragma unroll
        for (int ai = 0; ai < 2; ++ai)
#pragma unroll
            for (int m = 0; m < 4; ++m) { float v = ssq[ai][m]; v += __shfl_xor(v, 16); v += __shfl_xor(v, 32);
                if (fq == 0) ssp[(size_t)(row0 + ai * 128 + m * 16) * 16 + u.pn * 4 + wc] = v; }
    }
};
struct EpiScores {
    static constexpr bool PERM = true;
    bf16* sc; const float* ssp; const float* bias;
    __device__ __forceinline__ void operator()(const f32x4 (&acc)[2][2][4][2], const pg8::Unit& u, int wr, int wc, int fr, int fq) const {
        const int mi = u.pm < 32 ? 0 : 1 + ((u.pm - 32) >> 2);
        const int row0 = u.pm * 256 + wr * 64 + fr;
        f32x4 b0[2], b1[2];
#pragma unroll
        for (int bj = 0; bj < 2; ++bj) { const int c = u.pn * 256 + bj * 128 + wc * 32 + 8 * fq; b0[bj] = *(const f32x4*)(bias + (size_t)mi * 2048 + c); b1[bj] = *(const f32x4*)(bias + (size_t)mi * 2048 + c + 4); }
#pragma unroll
        for (int h2 = 0; h2 < 4; ++h2) {
            const int ai = h2 >> 1;
            f32x4 sp[2][4];
#pragma unroll
            for (int mm = 0; mm < 2; ++mm)
#pragma unroll
                for (int q = 0; q < 4; ++q) sp[mm][q] = *((const f32x4*)(ssp + (size_t)(row0 + ai * 128 + (2 * (h2 & 1) + mm) * 16) * 16) + q);
            asm volatile("" ::: "memory");
#pragma unroll
            for (int mm = 0; mm < 2; ++mm) {
                const int m = 2 * (h2 & 1) + mm;
                const int row = row0 + ai * 128 + m * 16;
                const float ss = ((sp[mm][0][0] + sp[mm][0][1]) + (sp[mm][0][2] + sp[mm][0][3])) + ((sp[mm][1][0] + sp[mm][1][1]) + (sp[mm][1][2] + sp[mm][1][3]))
                               + ((sp[mm][2][0] + sp[mm][2][1]) + (sp[mm][2][2] + sp[mm][2][3])) + ((sp[mm][3][0] + sp[mm][3][1]) + (sp[mm][3][2] + sp[mm][3][3]));
                const float rstd = 1.f / sqrtf(ss * (1.f / DM) + EPS);
#pragma unroll
                for (int bj = 0; bj < 2; ++bj) {
                    const int c = u.pn * 256 + bj * 128 + wc * 32 + 8 * fq;
                    const f32x4 v0 = acc[ai][bj][m][0] * rstd + b0[bj], v1 = acc[ai][bj][m][1] * rstd + b1[bj];
                    v4u w; w.x = pk2(v0[0], v0[1]); w.y = pk2(v0[2], v0[3]); w.z = pk2(v1[0], v1[1]); w.w = pk2(v1[2], v1[3]);
                    *(v4u*)(sc + (size_t)row * 2048 + c) = w;
                }
            }
            asm volatile("" ::: "memory");
        }
    }
};

__device__ __forceinline__ void attn_unit(Frame& F, bool lat, int seq, int kvh, int qt) {
    const int tid = F.tid, lane = F.lane, wave = F.wave, r32 = lane & 31, hi = lane >> 5;
    const int g = wave >> 1, qs = wave & 1, head = kvh * 4 + g;
    const int S = lat ? SEQ_L : SEQ_C, tokbase = lat ? NCTX + seq * SEQ_L : seq * SEQ_C;
    const int q0 = qt * 64, qpos = q0 + 32 * qs + r32;
    const bf16* Q = (const bf16*)(F.ws + WS_Q); const bf16* Kb = (const bf16*)(F.ws + WS_K); const bf16* VT = (const bf16*)(F.ws + WS_VT);
    const bf16* CK = (const bf16*)(F.ws + WS_CK); const bf16* CVT = (const bf16*)(F.ws + WS_CVT);
    unsigned char* ldsK = F.lds; unsigned char* ldsV = F.lds + 8192;
    bf16x8 qf[4];
    { const bf16* qp = Q + (size_t)(tokbase + qpos) * 512 + head * 64;
#pragma unroll
      for (int ks = 0; ks < 4; ++ks) qf[ks] = *(const bf16x8*)(qp + 16 * ks + 8 * hi); }
    const float sinkl = F.in[I_SINK][head] * LOG2E;
    float mrun = sinkl, lrun = (hi == 0) ? 1.f : 0.f;
    f32x16 o0, o1;
#pragma unroll
    for (int r = 0; r < 16; ++r) { o0[r] = 0.f; o1[r] = 0.f; }
    int tlo, thi;
    if (lat) { tlo = (q0 >= 128 ? q0 - 128 : 0) >> 6; thi = ((q0 + 192 < S ? q0 + 192 : S)) >> 6; } else { tlo = 0; thi = 4; }
    const int nband = thi - tlo, ntile = nband + (lat ? 4 : 0);
    const int key_t = tid >> 3, ch_t = tid & 7;
    v4u kv, vv;
#define AT_LOAD(t_) do { const int tt_ = (t_); const bf16* kptr; const bf16* vptr; int vstride; \
        if (tt_ < nband) { const int kb_ = (tlo + tt_) * 64; kptr = Kb + (size_t)(tokbase + kb_) * 128 + kvh * 64; \
            vptr = VT + (lat ? (size_t)VT_LAT_OFF + (size_t)((seq * 2 + kvh) * 64) * SEQ_L : (size_t)((seq * 2 + kvh) * 64) * SEQ_C) + kb_; vstride = S; } \
        else { const int tc = tt_ - nband; kptr = CK + (size_t)(seq * 256 + tc * 64) * 128 + kvh * 64; vptr = CVT + (size_t)((seq * 2 + kvh) * 64) * 256 + tc * 64; vstride = 256; } \
        kv = *(const v4u*)(kptr + (size_t)key_t * 128 + ch_t * 8); vv = *(const v4u*)(vptr + (size_t)key_t * vstride + ch_t * 8); } while (0)
    AT_LOAD(0);
    for (int t = 0; t < ntile; ++t) {
        const bool band = t < nband;
        const int kbase = band ? (tlo + t) * 64 : 0;
        __syncthreads();
        *(v4u*)(ldsK + key_t * 128 + ((ch_t ^ (key_t & 7)) * 16)) = kv;
        *(v4u*)(ldsV + key_t * 128 + ((ch_t ^ (key_t & 7)) * 16)) = vv;
        __syncthreads();
        f32x16 p0, p1;
#pragma unroll
        for (int r = 0; r < 16; ++r) { p0[r] = 0.f; p1[r] = 0.f; }
#pragma unroll
        for (int ks = 0; ks < 4; ++ks) {
            const int sw = ((2 * ks + hi) ^ (r32 & 7)) * 16;
            const bf16x8 a0 = *(const bf16x8*)(ldsK + r32 * 128 + sw);
            const bf16x8 a1 = *(const bf16x8*)(ldsK + (32 + r32) * 128 + sw);
            p0 = __builtin_amdgcn_mfma_f32_32x32x16_bf16(a0, qf[ks], p0, 0, 0, 0);
            p1 = __builtin_amdgcn_mfma_f32_32x32x16_bf16(a1, qf[ks], p1, 0, 0, 0);
        }
        if (t + 1 < ntile) AT_LOAD(t + 1);
        if (band && lat && (kbase < q0 + 63 - 128 || kbase + 63 > q0 + 128)) {
#pragma unroll
            for (int r = 0; r < 16; ++r) { const int kp = kbase + crow(r, hi); int d0 = qpos - kp; d0 = d0 < 0 ? -d0 : d0; int d1 = qpos - kp - 32; d1 = d1 < 0 ? -d1 : d1;
                if (d0 > 128) p0[r] = -INFINITY; if (d1 > 128) p1[r] = -INFINITY; }
        }
        float tm = p0[0];
#pragma unroll
        for (int r = 1; r < 16; ++r) tm = fmaxf(tm, p0[r]);
#pragma unroll
        for (int r = 0; r < 16; ++r) tm = fmaxf(tm, p1[r]);
        tm = fmaxf(tm, __shfl_xor(tm, 32));
        const float mn = fmaxf(mrun, tm), alpha = __builtin_amdgcn_exp2f(mrun - mn); mrun = mn;
        float ls = 0.f;
#pragma unroll
        for (int r = 0; r < 16; ++r) { p0[r] = __builtin_amdgcn_exp2f(p0[r] - mn); p1[r] = __builtin_amdgcn_exp2f(p1[r] - mn); ls += p0[r] + p1[r]; o0[r] *= alpha; o1[r] *= alpha; }
        lrun = lrun * alpha + ls;
        bf16x8 pf[4];
#pragma unroll
        for (int s = 0; s < 2; ++s) {
            v4u w0, w1;
            w0.x = pk2(p0[8 * s + 0], p0[8 * s + 1]); w0.y = pk2(p0[8 * s + 2], p0[8 * s + 3]); w0.z = pk2(p0[8 * s + 4], p0[8 * s + 5]); w0.w = pk2(p0[8 * s + 6], p0[8 * s + 7]);
            w1.x = pk2(p1[8 * s + 0], p1[8 * s + 1]); w1.y = pk2(p1[8 * s + 2], p1[8 * s + 3]); w1.z = pk2(p1[8 * s + 4], p1[8 * s + 5]); w1.w = pk2(p1[8 * s + 6], p1[8 * s + 7]);
            pf[s] = __builtin_bit_cast(bf16x8, w0); pf[2 + s] = __builtin_bit_cast(bf16x8, w1);
        }
#pragma unroll
        for (int s4 = 0; s4 < 4; ++s4) {
#pragma unroll
            for (int dt = 0; dt < 2; ++dt) {
                const int d = 32 * dt + r32;
                const v2u lo = *(const v2u*)(ldsV + d * 128 + (((2 * s4) ^ (d & 7)) * 16) + 8 * hi);
                const v2u hi2 = *(const v2u*)(ldsV + d * 128 + (((2 * s4 + 1) ^ (d & 7)) * 16) + 8 * hi);
                v4u vf4; vf4.x = lo.x; vf4.y = lo.y; vf4.z = hi2.x; vf4.w = hi2.y;
                const bf16x8 vf = __builtin_bit_cast(bf16x8, vf4);
                if (dt == 0) o0 = __builtin_amdgcn_mfma_f32_32x32x16_bf16(vf, pf[s4], o0, 0, 0, 0);
                else o1 = __builtin_amdgcn_mfma_f32_32x32x16_bf16(vf, pf[s4], o1, 0, 0, 0);
            }
        }
    }
    const float ltot = lrun + __shfl_xor(lrun, 32), inv = 1.f / ltot;
    bf16* mix = (bf16*)(F.ws + WS_MIX) + (size_t)(tokbase + qpos) * DM + head * 64;
#pragma unroll
    for (int g4 = 0; g4 < 4; ++g4) {
        v2u w; w.x = pk2(o0[4 * g4] * inv, o0[4 * g4 + 1] * inv); w.y = pk2(o0[4 * g4 + 2] * inv, o0[4 * g4 + 3] * inv);
        *(v2u*)(mix + 8 * g4 + 4 * hi) = w;
        v2u w2; w2.x = pk2(o1[4 * g4] * inv, o1[4 * g4 + 1] * inv); w2.y = pk2(o1[4 * g4 + 2] * inv, o1[4 * g4 + 3] * inv);
        *(v2u*)(mix + 32 + 8 * g4 + 4 * hi) = w2;
    }
    __syncthreads();
}

constexpr int RL_HALF = 49152;
constexpr int RL_XCB = 32768;
constexpr int RL_AGG = 98304;
constexpr int RL_CARRY = RL_AGG + 8192;
constexpr int RL_CW = RL_CARRY + 512;
constexpr int RL_WG = RL_CW + 1280;
static_assert(RL_WG + 32768 <= LDSCTL_OFF, "RNN LDS map");
__device__ __forceinline__ float fsigmoid(float x) { return __builtin_amdgcn_rcpf(1.f + __expf(-x)); }
__device__ __forceinline__ float gelu_fast(float x) { const float y = 0.7978845608028654f * (x + 0.044715f * x * x * x); const float e = __expf(2.f * y); return x - x * __builtin_amdgcn_rcpf(1.f + e); }

template <bool REV>
__device__ __forceinline__ void scan_prep(const float (&a)[16], const float (&b)[16], int h, float (&Apre)[4], float (&Bpre)[4], float& At, float& Bt) {
    float Ao[4], Bo[4], Ap[4], Bp[4];
#pragma unroll
    for (int g = 0; g < 4; ++g) { float A = 1.f, B = 0.f;
#pragma unroll
        for (int ii = 0; ii < 4; ++ii) { const int r = 4 * g + (REV ? 3 - ii : ii); B = a[r] * B + b[r]; A = a[r] * A; }
        Ao[g] = A; Bo[g] = B; }
#pragma unroll
    for (int g = 0; g < 4; ++g) { Ap[g] = __shfl_xor(Ao[g], 32); Bp[g] = __shfl_xor(Bo[g], 32); }
    const bool ownfirst = REV ? (h == 1) : (h == 0);
    float Ac = 1.f, Bc = 0.f;
#pragma unroll
    for (int gi = 0; gi < 4; ++gi) { const int g = REV ? 3 - gi : gi;
        const float A1 = ownfirst ? Ao[g] : Ap[g], B1 = ownfirst ? Bo[g] : Bp[g], A2 = ownfirst ? Ap[g] : Ao[g], B2 = ownfirst ? Bp[g] : Bo[g];
        const float Ac1 = A1 * Ac, Bc1 = A1 * Bc + B1;
        Apre[g] = ownfirst ? Ac : Ac1; Bpre[g] = ownfirst ? Bc : Bc1;
        Ac = A2 * Ac1; Bc = A2 * Bc1 + B2; }
    At = Ac; Bt = Bc;
}
template <bool REV>
__device__ __forceinline__ void scan_finish(const float (&a)[16], const float (&b)[16], const float (&Apre)[4], const float (&Bpre)[4], float hin, float* hp, int hi) {
#pragma unroll
    for (int g = 0; g < 4; ++g) { float hc = Apre[g] * hin + Bpre[g];
#pragma unroll
        for (int ii = 0; ii < 4; ++ii) { const int r = 4 * g + (REV ? 3 - ii : ii); hc = a[r] * hc + b[r]; hp[(size_t)crow(r, hi) * 512] = hc; } }
}

template <bool REV>
__device__ __forceinline__ void rnn_dir(Frame& F, bool lat, int seq, int n) {
    const int lane = F.lane, w4 = F.wave & 3, r32 = lane & 31, hi = lane >> 5, dirh = REV ? 1 : 0;
    const int S = lat ? SEQ_L : SEQ_C, tokbase = lat ? NCTX + seq * SEQ_L : seq * SEQ_C, nchunk = S / 128;
    unsigned char* hb = F.lds + dirh * RL_HALF;
    float* XC32 = (float*)hb; unsigned char* XCB = hb + RL_XCB;
    f32x2* AGG = (f32x2*)(F.lds + RL_AGG) + dirh * 256; float* CARRY = (float*)(F.lds + RL_CARRY) + dirh * 64; const float* CW = (const float*)(F.lds + RL_CW);
    const unsigned char* WG = F.lds + RL_WG + dirh * 16384;
    const bf16* XR = (const bf16*)(F.ws + WS_XR) + (size_t)tokbase * 512 + n * 64;
    float* HX = (float*)(F.ws + (REV ? WS_H : WS_HF)) + (size_t)tokbase * 512 + n * 64;
    const int t = F.tid & 255, c8 = t & 7, tg = t >> 3;
    float ba[2], bi[2], sp8[2];
#pragma unroll
    for (int chh = 0; chh < 2; ++chh) { const int pe = dirh * 512 + n * 64 + chh * 32 + r32; ba[chh] = -LOG2E * F.in[I_RGBA][pe]; bi[chh] = -LOG2E * F.in[I_RGBI][pe];
        const float nl = -F.in[I_RGLAM][pe]; sp8[chh] = -8.f * LOG2E * (nl > 20.f ? nl : log1pf(__expf(nl))); }
    v4u xin[7];
#define RL_XLOAD(c0_) do { _Pragma("unroll") for (int i = 0; i < 7; ++i) { const int pos = (c0_) + 4 * tg - 2 + i; \
        xin[i] = (pos >= 0 && pos < S) ? *(const v4u*)(XR + (size_t)pos * 512 + 8 * c8) : (v4u){0u, 0u, 0u, 0u}; } } while (0)
    RL_XLOAD((REV ? nchunk - 1 : 0) * 128);
    float newcarry[2] = {0.f, 0.f};
    const bool last_tile = REV ? (w4 == 0) : (w4 == 3);
#pragma unroll 1
    for (int k = 0; k < nchunk; ++k) {
        const int c0 = (REV ? nchunk - 1 - k : k) * 128;
        {
            const f32x4 b0 = *(const f32x4*)(CW + 256 + 8 * c8), b1 = *(const f32x4*)(CW + 256 + 8 * c8 + 4);
            f32x4 wt0[4], wt1[4];
#pragma unroll
            for (int tap = 0; tap < 4; ++tap) { wt0[tap] = *(const f32x4*)(CW + tap * 64 + 8 * c8); wt1[tap] = *(const f32x4*)(CW + tap * 64 + 8 * c8 + 4); }
#pragma unroll
            for (int i = 0; i < 4; ++i) {
                f32x4 y0 = b0, y1 = b1;
#pragma unroll
                for (int tap = 0; tap < 4; ++tap) { const v4u x = xin[i + tap];
                    y0[0] += wt0[tap][0] * bflo(x.x); y0[1] += wt0[tap][1] * bfhi(x.x); y0[2] += wt0[tap][2] * bflo(x.y); y0[3] += wt0[tap][3] * bfhi(x.y);
                    y1[0] += wt1[tap][0] * bflo(x.z); y1[1] += wt1[tap][1] * bfhi(x.z); y1[2] += wt1[tap][2] * bflo(x.w); y1[3] += wt1[tap][3] * bfhi(x.w); }
                const int tk = 4 * tg + i;
                *(f32x4*)(XC32 + tk * 64 + 8 * c8) = y0; *(f32x4*)(XC32 + tk * 64 + 8 * c8 + 4) = y1;
                v4u w; w.x = pk2(y0[0], y0[1]); w.y = pk2(y0[2], y0[3]); w.z = pk2(y1[0], y1[1]); w.w = pk2(y1[2], y1[3]);
                *(v4u*)(XCB + tk * 128 + ((c8 ^ (tk & 7)) * 16)) = w; }
        }
        if (k + 1 < nchunk) RL_XLOAD((REV ? nchunk - 2 - k : k + 1) * 128);
        __syncthreads();
        if (k > 0 && last_tile && hi == 0) { CARRY[r32] = newcarry[0]; CARRY[32 + r32] = newcarry[1]; }
        const int tkA = 32 * w4 + r32;
#pragma unroll
        for (int chh = 0; chh < 2; ++chh) {
            const int che = chh * 32 + r32;
            float av[16], bv[16], Apre[4], Bpre[4];
            {
                f32x16 ga, gi;
#pragma unroll
                for (int r = 0; r < 16; ++r) { ga[r] = 0.f; gi[r] = 0.f; }
#pragma unroll
                for (int ks = 0; ks < 4; ++ks) {
                    const bf16x8 af = *(const bf16x8*)(XCB + tkA * 128 + (((2 * ks + hi) ^ (tkA & 7)) * 16));
                    const bf16x8 wa = *(const bf16x8*)(WG + che * 128 + (((2 * ks + hi) ^ (che & 7)) * 16));
                    const bf16x8 wi = *(const bf16x8*)(WG + 8192 + che * 128 + (((2 * ks + hi) ^ (che & 7)) * 16));
                    ga = __builtin_amdgcn_mfma_f32_32x32x16_bf16(af, wa, ga, 0, 0, 0);
                    gi = __builtin_amdgcn_mfma_f32_32x32x16_bf16(af, wi, gi, 0, 0, 0);
                }
#pragma unroll
                for (int r = 0; r < 16; ++r) { const int tk2 = 32 * w4 + crow(r, hi); const float x = XC32[tk2 * 64 + che];
                    const float rg = __builtin_amdgcn_rcpf(1.f + __builtin_amdgcn_exp2f(ga[r] + ba[chh])), ig = __builtin_amdgcn_rcpf(1.f + __builtin_amdgcn_exp2f(gi[r] + bi[chh])), a = __builtin_amdgcn_exp2f(rg * sp8[chh]);
                    av[r] = a; bv[r] = __builtin_amdgcn_sqrtf(fmaxf(1.f - a * a, 0.f)) * ig * x;
                    if ((r & 3) == 3) __builtin_amdgcn_sched_barrier(0); }
                float At, Bt;
                scan_prep<REV>(av, bv, hi, Apre, Bpre, At, Bt);
                if (hi == 0) { f32x2 ab; ab.x = At; ab.y = Bt; AGG[chh * 512 + w4 * 64 + che] = ab; }
            }
            __syncthreads();
            {
                float hin = CARRY[che];
                if (!REV) { for (int t2 = 0; t2 < w4; ++t2) { const f32x2 ab = AGG[chh * 512 + t2 * 64 + che]; hin = ab.x * hin + ab.y; } }
                else { for (int t2 = 3; t2 > w4; --t2) { const f32x2 ab = AGG[chh * 512 + t2 * 64 + che]; hin = ab.x * hin + ab.y; } }
                scan_finish<REV>(av, bv, Apre, Bpre, hin, HX + (size_t)(c0 + 32 * w4) * 512 + che, hi);
                if (last_tile) { const f32x2 ab = AGG[chh * 512 + w4 * 64 + che]; newcarry[chh] = ab.x * hin + ab.y; }
            }
        }
    }
#undef RL_XLOAD
    if (!lat && last_tile && hi == 0) { float* o = F.out + O_NEWRNN + (size_t)(seq * 2 + dirh) * 512 + n * 64; o[r32] = newcarry[0]; o[32 + r32] = newcarry[1]; }
}

__device__ __forceinline__ void rnn_unit(Frame& F, bool lat, int seq, int n) {
    const int tid = F.tid;
    const int S = lat ? SEQ_L : SEQ_C, tokbase = lat ? NCTX + seq * SEQ_L : seq * SEQ_C;
    __syncthreads();
    { float* CW = (float*)(F.lds + RL_CW); float* CARRY = (float*)(F.lds + RL_CARRY);
      if (tid < 320) CW[tid] = tid < 256 ? F.in[I_CONVW][(tid >> 6) * 512 + n * 64 + (tid & 63)] : F.in[I_CONVB][n * 64 + (tid - 256)];
      if (tid < 128) CARRY[tid] = lat ? F.in[I_SRNN][(size_t)(seq * 2 + (tid >> 6)) * 512 + n * 64 + (tid & 63)] : 0.f;
      const bf16* rgw = (const bf16*)(F.ws + WS_RGW);
#pragma unroll
      for (int i = 0; i < 4; ++i) { const int q = tid + 512 * i, ch = q & 7, d = (q >> 3) & 63, gate = (q >> 9) & 1, dir = q >> 10;
          const v4u w = *(const v4u*)(rgw + (size_t)((dir * 8 + n) * 2 + gate) * 4096 + d * 64 + ch * 8);
          *(v4u*)(F.lds + RL_WG + dir * 16384 + gate * 8192 + d * 128 + ((ch ^ (d & 7)) * 16)) = w; } }
    __syncthreads();
    if (F.wave < 4) rnn_dir<false>(F, lat, seq, n); else rnn_dir<true>(F, lat, seq, n);
    __syncthreads();
    { const int c4 = tid & 15, tk = tid >> 4;
      const float* HF = (const float*)(F.ws + WS_HF) + (size_t)tokbase * 512 + n * 64 + 4 * c4;
      const float* HB = (const float*)(F.ws + WS_H) + (size_t)tokbase * 512 + n * 64 + 4 * c4;
      const bf16* YG = (const bf16*)(F.ws + WS_YG) + (size_t)tokbase * 512 + n * 64 + 4 * c4;
      bf16* MIX = (bf16*)(F.ws + WS_MIX) + (size_t)tokbase * DM + 512 + n * 64 + 4 * c4;
      for (int t0 = tk; t0 < S; t0 += 32) {
          const f32x4 a = *(const f32x4*)(HF + (size_t)t0 * 512), b = *(const f32x4*)(HB + (size_t)t0 * 512); const v2u y = *(const v2u*)(YG + (size_t)t0 * 512);
          v2u o; o.x = pk2((a[0] + b[0]) * gelu_fast(bflo(y.x)), (a[1] + b[1]) * gelu_fast(bfhi(y.x))); o.y = pk2((a[2] + b[2]) * gelu_fast(bflo(y.y)), (a[3] + b[3]) * gelu_fast(bfhi(y.y)));
          *(v2u*)(MIX + (size_t)t0 * DM) = o; } }
    __syncthreads();
}

#ifndef MK_P3_TYPES
#define MK_P3_TYPES 15
#endif
__device__ __forceinline__ void p3_phase(Frame& F, int types = 15) {
    const int v = F.vcu;
#pragma unroll 1
    for (int i = 0; i < 832; ++i) {
        int type, idx;
        if (F.G == 256) {
            if (v < 64) { if (i > 0) break; type = 0; idx = v; }
            else { if (i >= 6) break; const int j = v - 64, sl = i >> 1, rep = i & 1; type = 1 + sl;
                const bool extra = sl == 0 ? (j < 64) : (sl == 1 ? (j >= 64 && j < 128) : (j >= 128));
                if (rep && !extra) continue; idx = rep ? 192 + (j - 64 * sl) : j; }
        } else { const int it = v + i * F.G; if (it >= 832) break;
            if (it < 64) { type = 0; idx = it; } else if (it < 320) { type = 1; idx = it - 64; } else if (it < 576) { type = 2; idx = it - 320; } else { type = 3; idx = it - 576; } }
        if (!((types >> type) & 1)) continue;
        const bool lat = type < 2;
        Frame L = F; asm volatile("" : "+v"(L.tid)); L.lane = L.tid & 63;
        asm volatile("" : "+s"(L.ws), "+s"(L.out));
        if ((type & 1) == 0) rnn_unit(L, lat, idx >> 3, idx & 7);
        else { if (lat) attn_unit(L, true, idx >> 5, (idx >> 4) & 1, idx & 15); else attn_unit(L, false, idx >> 3, (idx >> 2) & 1, idx & 3); }
    }
}

__device__ __forceinline__ unsigned key16(unsigned b, unsigned idx) { const unsigned s = (b & 0x8000u) ? (~b & 0xffffu) : (b | 0x8000u); return (s << 16) | idx; }
__device__ __forceinline__ float keyval16(unsigned k) { const unsigned s = k >> 16; const unsigned b = (s & 0x8000u) ? (s & 0x7fffu) : (~s & 0xffffu); return bf2f(b); }
__device__ __forceinline__ unsigned sortable32(float f) { const unsigned u = __builtin_bit_cast(unsigned, f); return (u & 0x80000000u) ? ~u : (u | 0x80000000u); }
template <int CTRL> __device__ __forceinline__ unsigned dppu(unsigned v) { return (unsigned)__builtin_amdgcn_update_dpp(0, (int)v, CTRL, 0xf, 0xf, true); }
template <int CTRL> __device__ __forceinline__ float dppf(float v) { return __builtin_bit_cast(float, __builtin_amdgcn_update_dpp(0, __builtin_bit_cast(int, v), CTRL, 0xf, 0xf, true)); }
__device__ __forceinline__ unsigned umax_(unsigned a, unsigned b) { return a > b ? a : b; }
__device__ __forceinline__ unsigned umin_(unsigned a, unsigned b) { return a < b ? a : b; }
__device__ __forceinline__ unsigned rowmax16u(unsigned x) { x = umax_(x, dppu<0xB1>(x)); x = umax_(x, dppu<0x4E>(x)); x = umax_(x, dppu<0x141>(x)); x = umax_(x, dppu<0x140>(x)); return x; }
__device__ __forceinline__ float rowmax16f(float x) { x = fmaxf(x, dppf<0xB1>(x)); x = fmaxf(x, dppf<0x4E>(x)); x = fmaxf(x, dppf<0x141>(x)); x = fmaxf(x, dppf<0x140>(x)); return x; }
__device__ __forceinline__ float rowsum16f(float x) { x += dppf<0xB1>(x); x += dppf<0x4E>(x); x += dppf<0x141>(x); x += dppf<0x140>(x); return x; }
__device__ __forceinline__ int rowsum16i(int x) { x += (int)dppu<0xB1>((unsigned)x); x += (int)dppu<0x4E>((unsigned)x); x += (int)dppu<0x141>((unsigned)x); x += (int)dppu<0x140>((unsigned)x); return x; }
#define CEX(a, b) do { const unsigned _h = umax_(a, b), _l = umin_(a, b); a = _h; b = _l; } while (0)

#ifndef P7_NCH
#define P7_NCH 8
#endif
constexpr int P7_CSH = (P7_NCH == 4 ? 12 : (P7_NCH == 8 ? 11 : (P7_NCH == 16 ? 10 : 9)));
constexpr int P7_WL = 16384;
constexpr int P7_TL = 0, P7_TE = 1024, P7_TG = 3072, P7_LE = 5120, P7_LG = 6400, P7_LSU = 8960, P7_LS = 11520, P7_H2Q = 12160, P7_HST = 16256;
static_assert(P7_LS + 640 <= P7_H2Q && (P7_H2Q % 16) == 0 && P7_HST + 16 <= P7_WL && P7_WL * 8 <= RING_BYTES, "P7 LDS map");

#define TK_KEYS(R, raw, kb) unsigned R##0 = key16(raw.x & 0xffffu, (kb) + 0), R##1 = key16(raw.x >> 16, (kb) + 1), R##2 = key16(raw.y & 0xffffu, (kb) + 2), R##3 = key16(raw.y >> 16, (kb) + 3), \
        R##4 = key16(raw.z & 0xffffu, (kb) + 4), R##5 = key16(raw.z >> 16, (kb) + 5), R##6 = key16(raw.w & 0xffffu, (kb) + 6), R##7 = key16(raw.w >> 16, (kb) + 7)
#define TK_SORT8(R) do { CEX(R##0, R##1); CEX(R##2, R##3); CEX(R##4, R##5); CEX(R##6, R##7); CEX(R##0, R##2); CEX(R##1, R##3); CEX(R##4, R##6); CEX(R##5, R##7); CEX(R##1, R##2); CEX(R##5, R##6); \
        CEX(R##0, R##4); CEX(R##1, R##5); CEX(R##2, R##6); CEX(R##3, R##7); CEX(R##2, R##4); CEX(R##3, R##5); CEX(R##1, R##2); CEX(R##3, R##4); CEX(R##5, R##6); } while (0)
#define TK_POP8(R, KEEP, it) do { const unsigned m_ = rowmax16u(R##0); const bool w_ = R##0 == m_; R##0 = w_ ? R##1 : R##0; R##1 = w_ ? R##2 : R##1; R##2 = w_ ? R##3 : R##2; R##3 = w_ ? R##4 : R##3; \
        R##4 = w_ ? R##5 : R##4; R##5 = w_ ? R##6 : R##5; R##6 = w_ ? R##7 : R##6; R##7 = w_ ? 0u : R##7; KEEP = (k == (it)) ? m_ : KEEP; } while (0)
#define TK_POP4(C, KEEP, it) do { const unsigned m_ = rowmax16u(C[0]); const bool w_ = C[0] == m_; C[0] = w_ ? C[1] : C[0]; C[1] = w_ ? C[2] : C[1]; C[2] = w_ ? C[3] : C[2]; C[3] = w_ ? 0u : C[3]; KEEP = (k == (it)) ? m_ : KEEP; } while (0)
__device__ __forceinline__ void topk_token(const v4u (&rawv)[4], unsigned* TL, int lane, const unsigned ctabp, int* oute, float* outg) {
    const int k = lane & 15, row = lane >> 4;
#pragma unroll
    for (int pp = 0; pp < 2; ++pp) {
        const v4u rawa = rawv[2 * pp], rawb = rawv[2 * pp + 1];
        TK_KEYS(a, rawa, k * 8); TK_KEYS(b, rawb, k * 8);
        TK_SORT8(a); TK_SORT8(b);
        unsigned keepa = 0, keepb = 0;
#pragma unroll
        for (int it = 0; it < 16; ++it) { TK_POP8(a, keepa, it); TK_POP8(b, keepb, it); }
        TL[((2 * pp) * 4 + row) * 16 + k] = keepa; TL[((2 * pp + 1) * 4 + row) * 16 + k] = keepb;
    }
    unsigned ca[4], cb[4];
    const unsigned* LAa = TL + (2 * row) * 16; const unsigned* LBa = TL + (2 * row + 1) * 16;
    const unsigned* LAb = TL + (2 * (4 + row)) * 16; const unsigned* LBb = TL + (2 * (4 + row) + 1) * 16;
#pragma unroll
    for (int s = 0; s < 4; ++s) { const int ij = (int)((ctabp >> (8 * s)) & 0xffu); const bool valid = ij != 255; const int i = (ij >> 4) & 15, j = ij & 15;
        const float sa = keyval16(LAa[i]) + keyval16(LBa[j]), sb = keyval16(LAb[i]) + keyval16(LBb[j]);
        ca[s] = valid ? ((sortable32(sa) & 0xffffff00u) | (unsigned)(i * 16 + j)) : 0u; cb[s] = valid ? ((sortable32(sb) & 0xffffff00u) | (unsigned)(i * 16 + j)) : 0u; }
    CEX(ca[0], ca[1]); CEX(ca[2], ca[3]); CEX(ca[0], ca[2]); CEX(ca[1], ca[3]); CEX(ca[1], ca[2]);
    CEX(cb[0], cb[1]); CEX(cb[2], cb[3]); CEX(cb[0], cb[2]); CEX(cb[1], cb[3]); CEX(cb[1], cb[2]);
    unsigned keepa = 0, keepb = 0;
#pragma unroll
    for (int it = 0; it < 16; ++it) { TK_POP4(ca, keepa, it); TK_POP4(cb, keepb, it); }
    {
        const unsigned kaa = LAa[(keepa >> 4) & 15], kba = LBa[keepa & 15], kab = LAb[(keepb >> 4) & 15], kbb = LBb[keepb & 15];
        const float bva = keyval16(kaa) + keyval16(kba), bvb = keyval16(kab) + keyval16(kbb);
        const float mxa = rowmax16f(bva), mxb = rowmax16f(bvb); const float exa = __expf(bva - mxa), exb = __expf(bvb - mxb); const float sma = rowsum16f(exa), smb = rowsum16f(exb);
        oute[lane] = (int)((kaa & 127u) * 128u + (kba & 127u)); outg[lane] = exa / sma;
        oute[64 + lane] = (int)((kab & 127u) * 128u + (kbb & 127u)); outg[64 + lane] = exb / smb;
    }
}
#undef TK_KEYS
#undef TK_SORT8
#undef TK_POP8
#undef TK_POP4

__device__ __forceinline__ void gl16x4(v4u (&r)[4], unsigned voff, const unsigned char* b0, const unsigned char* b1, const unsigned char* b2, const unsigned char* b3) {
    asm volatile("s_nop 4\n\tglobal_load_dwordx4 %0, %4, %5\n\tglobal_load_dwordx4 %1, %4, %6\n\tglobal_load_dwordx4 %2, %4, %7\n\tglobal_load_dwordx4 %3, %4, %8"
                 : "=&v"(r[0]), "=&v"(r[1]), "=&v"(r[2]), "=&v"(r[3]) : "v"(voff), "s"(b0), "s"(b1), "s"(b2), "s"(b3) : "memory");
}
#define P7_VMWAIT(N, R) asm volatile("s_waitcnt vmcnt(" #N ")" : "+v"(R[0]), "+v"(R[1]), "+v"(R[2]), "+v"(R[3]) :: "memory")
__device__ __forceinline__ int mbcnt64(unsigned long long m) { return (int)__builtin_amdgcn_mbcnt_hi((unsigned)(m >> 32), __builtin_amdgcn_mbcnt_lo((unsigned)m, 0u)); }
__device__ __forceinline__ int rfl(int v) { return __builtin_amdgcn_readfirstlane(v); }
__device__ __forceinline__ float rflf(float v) { return __builtin_bit_cast(float, __builtin_amdgcn_readfirstlane(__builtin_bit_cast(int, v))); }

__device__ __forceinline__ void p7_phase(Frame& F, bool dry) {
    const int lane0 = F.lane, wave = F.wave;
    if (dry && (MK_DRY_SKIP & 16) && wave >= 4) return;
    unsigned char* wl = F.lds + wave * P7_WL;
    unsigned* TL = (unsigned*)(wl + P7_TL); int* TE = (int*)(wl + P7_TE); float* TG = (float*)(wl + P7_TG);
    unsigned short* LE = (unsigned short*)(wl + P7_LE); float* LG = (float*)(wl + P7_LG); float* LSU = (float*)(wl + P7_LSU); unsigned char* LS = wl + P7_LS; unsigned char* H2Q = wl + P7_H2Q; float* HST = (float*)(wl + P7_HST);
    const bf16* SC = (const bf16*)(F.ws + WS_SC); const bf16* H2 = (const bf16*)(F.ws + WS_H);
    const unsigned char* U8 = F.ws + WS_U; const unsigned char* V8 = F.ws + WS_V;
    const float* SU = (const float*)(F.ws + WS_SU); const float* SV = (const float*)(F.ws + WS_SV);
    const float* mods = (const float*)(F.ws + WS_MODS); const float* SSP = (const float*)(F.ws + WS_SSP);
    unsigned ctabp = 0;
#pragma unroll
    for (int s = 0; s < 4; ++s) { const int c = 16 * s + (lane0 & 15); int i, j;
        if (c < 16) { i = 0; j = c; } else if (c < 24) { i = 1; j = c - 16; } else if (c < 29) { i = 2; j = c - 24; } else if (c < 33) { i = 3; j = c - 29; } else if (c < 36) { i = 4; j = c - 33; }
        else if (c < 38) { i = 5; j = c - 36; } else if (c < 40) { i = 6; j = c - 38; } else if (c < 42) { i = 7; j = c - 40; } else if (c < 50) { i = c - 34; j = 0; } else { i = -1; j = 0; }
        ctabp |= (unsigned)(i < 0 ? 255 : i * 16 + j) << (8 * s); }
    const int ntg = NTOK / (F.G * NWAVES * 4);
#pragma unroll 1
    for (int tg = 0; tg < ntg; ++tg) {
        const int tok0 = (F.vcu * ntg + tg) * (NWAVES * 4) + wave * 4;
        int lane = F.lane; asm volatile("" : "+v"(lane));
        {
            v4u craw[4], nraw[4]; v4u ch0, ch1, nh0, nh1;
#define P7_TLOAD(R, H0, H1, tk) do { const bf16* sp_ = SC + (size_t)(tk) * 2048 + (lane >> 4) * 128 + (lane & 15) * 8; \
                _Pragma("unroll") for (int ps = 0; ps < 4; ++ps) R[ps] = *(const v4u*)(sp_ + ps * 512); \
                H0 = *(const v4u*)(H2 + (size_t)(tk) * DM + 16 * lane); H1 = *(const v4u*)(H2 + (size_t)(tk) * DM + 16 * lane + 8); } while (0)
            P7_TLOAD(craw, ch0, ch1, tok0);
#pragma unroll 1
            for (int s = 0; s < 4; ++s) {
                if (s < 3) P7_TLOAD(nraw, nh0, nh1, tok0 + s + 1);
                const int tokc = tok0 + s;
                const f32x4* spp = (const f32x4*)(SSP + (size_t)tokc * 16); const f32x4 q0 = spp[0], q1 = spp[1], q2 = spp[2], q3 = spp[3];
                const float* shp = mods + (size_t)mod_index(tokc) * MODW + 3 * DM + 16 * lane;
                const f32x4 sh0 = *(const f32x4*)(shp), sh1 = *(const f32x4*)(shp + 4), sh2v = *(const f32x4*)(shp + 8), sh3 = *(const f32x4*)(shp + 12);
                topk_token(craw, TL, lane, ctabp, TE + s * 128, TG + s * 128);
                const v4u a = ch0, b = ch1;
                const float ssr = ((q0[0] + q0[1]) + (q0[2] + q0[3])) + ((q1[0] + q1[1]) + (q1[2] + q1[3])) + ((q2[0] + q2[1]) + (q2[2] + q2[3])) + ((q3[0] + q3[1]) + (q3[2] + q3[3]));
                const float rstd = 1.f / sqrtf(ssr * (1.f / DM) + EPS);
                float hv[16];
                hv[0] = bflo(a.x); hv[1] = bfhi(a.x); hv[2] = bflo(a.y); hv[3] = bfhi(a.y); hv[4] = bflo(a.z); hv[5] = bfhi(a.z); hv[6] = bflo(a.w); hv[7] = bfhi(a.w);
                hv[8] = bflo(b.x); hv[9] = bfhi(b.x); hv[10] = bflo(b.y); hv[11] = bfhi(b.y); hv[12] = bflo(b.z); hv[13] = bfhi(b.z); hv[14] = bflo(b.w); hv[15] = bfhi(b.w);
#pragma unroll
                for (int i = 0; i < 4; ++i) { hv[i] = hv[i] * rstd + sh0[i]; hv[4 + i] = hv[4 + i] * rstd + sh1[i]; hv[8 + i] = hv[8 + i] * rstd + sh2v[i]; hv[12 + i] = hv[12 + i] * rstd + sh3[i]; }
                float am = 0.f;
#pragma unroll
                for (int i = 0; i < 16; ++i) am = fmaxf(am, fabsf(hv[i]));
                am = wave_max(am);
                const float inv = am > 0.f ? 127.f / am : 0.f;
                if (lane == 0) HST[s] = am * (1.f / 127.f);
                v4u qv;
#pragma unroll
                for (int j = 0; j < 4; ++j) { unsigned w = 0;
#pragma unroll
                    for (int i = 0; i < 4; ++i) { int q = (int)rintf(hv[4 * j + i] * inv); w |= ((unsigned)q & 0xffu) << (8 * i); }
                    qv[j] = w; }
                *(v4u*)(H2Q + s * 1024 + 16 * lane) = qv;
#pragma unroll
                for (int ps = 0; ps < 4; ++ps) craw[ps] = nraw[ps];
                ch0 = nh0; ch1 = nh1;
            }
#undef P7_TLOAD
        }
        int nb;
        {
            int tot[P7_NCH];
#pragma unroll
            for (int c = 0; c < P7_NCH; ++c) tot[c] = 0;
#pragma unroll 1
            for (int s = 0; s < 4; ++s) { const int c0 = TE[s * 128 + lane] >> P7_CSH, c1 = TE[s * 128 + 64 + lane] >> P7_CSH;
#pragma unroll
                for (int c = 0; c < P7_NCH; ++c) tot[c] += __popcll(__ballot(c0 == c)) + __popcll(__ballot(c1 == c)); }
            int off[P7_NCH]; { int base = 0;
#pragma unroll
                for (int c = 0; c < P7_NCH; ++c) { const int n = tot[c], np = (n + 3) & ~3; off[c] = base;
                    if (lane < np - n) { const int p = base + n + lane; LE[p] = (unsigned short)(c << P7_CSH); LG[p] = 0.f; LSU[p] = 0.f; LS[p] = (unsigned char)0; }
                    base += np; }
                { const int pe = ((base + 47) / 48) * 48; if (lane < pe - base) { const int p = base + lane; LE[p] = (unsigned short)0; LG[p] = 0.f; LSU[p] = 0.f; LS[p] = (unsigned char)0; } base = pe; }
            nb = base >> 2; }
            int ee0[4], ee1[4]; float gg0[4], gg1[4], us0[4], us1[4], vs0[4], vs1[4];
#pragma unroll
            for (int s = 0; s < 4; ++s) { ee0[s] = TE[s * 128 + lane]; ee1[s] = TE[s * 128 + 64 + lane]; gg0[s] = TG[s * 128 + lane]; gg1[s] = TG[s * 128 + 64 + lane]; }
#pragma unroll
            for (int s = 0; s < 4; ++s) { us0[s] = SU[ee0[s]]; us1[s] = SU[ee1[s]]; vs0[s] = SV[ee0[s]]; vs1[s] = SV[ee1[s]]; }
#pragma unroll
            for (int s = 0; s < 4; ++s) { const int e0 = ee0[s], e1 = ee1[s]; const int c0 = e0 >> P7_CSH, c1 = e1 >> P7_CSH;
#pragma unroll
                for (int c = 0; c < P7_NCH; ++c) {
                    const unsigned long long m0 = __ballot(c0 == c), m1 = __ballot(c1 == c);
                    const int n0 = __popcll(m0), n = n0 + __popcll(m1), base = off[c];
                    if (c0 == c) { const int p = base + mbcnt64(m0); LE[p] = (unsigned short)e0; LG[p] = gg0[s] * vs0[s]; LSU[p] = us0[s]; LS[p] = (unsigned char)s; }
                    if (c1 == c) { const int p = base + n0 + mbcnt64(m1); LE[p] = (unsigned short)e1; LG[p] = gg1[s] * vs1[s]; LSU[p] = us1[s]; LS[p] = (unsigned char)s; }
                    off[c] = base + n;
                } }
        }
        if (!(dry && (MK_DRY_SKIP & 1))) {
            int lane_u = F.lane; asm volatile("" : "+v"(lane_u));
            const bool hi32 = lane_u >= 32, b16 = (lane_u & 16) != 0;
            const int xr = ((lane_u >> 5) & 1) | ((lane_u >> 3) & 2);
            const unsigned voff_u = 16u * (unsigned)lane_u;
            v4u ra[4], rb[4], rc[4], rd[4], re[4], rf[4];
#define P7_ULOAD(R, b) do { const v2u le_ = *(const v2u*)(LE + 4 * (b)); const int e0 = rfl((int)(le_.x & 0xffffu)), e1 = rfl((int)(le_.x >> 16)), e2 = rfl((int)(le_.y & 0xffffu)), e3 = rfl((int)(le_.y >> 16)); \
            gl16x4(R, voff_u, U8 + (size_t)e0 * DM, U8 + (size_t)e1 * DM, U8 + (size_t)e2 * DM, U8 + (size_t)e3 * DM); } while (0)
#define P7_UMETA(b) const unsigned msl4_ = *(const unsigned*)(LS + 4 * (b)); const float mg_ = LG[4 * (b) + xr]; const float msu_ = LSU[4 * (b) + xr]; \
            const v4u mh0_ = *(const v4u*)(H2Q + (msl4_ & 0xffu) * 1024 + 16 * lane_u), mh1_ = *(const v4u*)(H2Q + ((msl4_ >> 8) & 0xffu) * 1024 + 16 * lane_u), \
                      mh2_ = *(const v4u*)(H2Q + ((msl4_ >> 16) & 0xffu) * 1024 + 16 * lane_u), mh3_ = *(const v4u*)(H2Q + (msl4_ >> 24) * 1024 + 16 * lane_u); \
            const float mhs_ = HST[(msl4_ >> (8 * xr)) & 0xffu]
#define P7_UDOT(H, X) __builtin_amdgcn_sdot4((int)H.w, (int)X.w, __builtin_amdgcn_sdot4((int)H.z, (int)X.z, __builtin_amdgcn_sdot4((int)H.y, (int)X.y, __builtin_amdgcn_sdot4((int)H.x, (int)X.x, 0, false), false), false), false)
#define P7_UCOMP(R, b) do { unsigned p[4]; p[0] = (unsigned)P7_UDOT(mh0_, R[0]); p[1] = (unsigned)P7_UDOT(mh1_, R[1]); p[2] = (unsigned)P7_UDOT(mh2_, R[2]); p[3] = (unsigned)P7_UDOT(mh3_, R[3]); \
            const auto s01 = __builtin_amdgcn_permlane32_swap(p[0], p[1], false, false); const auto s23 = __builtin_amdgcn_permlane32_swap(p[2], p[3], false, false); \
            const unsigned t01 = s01[0] + s01[1], t23 = s23[0] + s23[1];        \
            const auto s4 = __builtin_amdgcn_permlane16_swap(t01, t23, false, false); \
            const int t = rowsum16i((int)(s4[0] + s4[1]));                     \
            const float dotf = (float)t * (mhs_ * msu_); const float cf = mg_ * gelu_fast(dotf); \
            LG[4 * (b) + xr] = cf; } while (0)
            P7_ULOAD(ra, 0); P7_ULOAD(rb, 1); P7_ULOAD(rc, 2); P7_ULOAD(rd, 3); P7_ULOAD(re, 4);
#pragma unroll 1
            for (int b = 0; b < nb; b += 6) {
                P7_ULOAD(rf, b + 5);
                { P7_UMETA(b);     P7_VMWAIT(20, ra); P7_UCOMP(ra, b); }
                P7_ULOAD(ra, (b + 6 < nb ? b + 6 : nb - 1));
                { P7_UMETA(b + 1); P7_VMWAIT(20, rb); P7_UCOMP(rb, b + 1); }
                P7_ULOAD(rb, (b + 7 < nb ? b + 7 : nb - 1));
                { P7_UMETA(b + 2); P7_VMWAIT(20, rc); P7_UCOMP(rc, b + 2); }
                P7_ULOAD(rc, (b + 8 < nb ? b + 8 : nb - 1));
                { P7_UMETA(b + 3); P7_VMWAIT(20, rd); P7_UCOMP(rd, b + 3); }
                P7_ULOAD(rd, (b + 9 < nb ? b + 9 : nb - 1));
                { P7_UMETA(b + 4); P7_VMWAIT(20, re); P7_UCOMP(re, b + 4); }
                P7_ULOAD(re, (b + 10 < nb ? b + 10 : nb - 1));
                { P7_UMETA(b + 5); P7_VMWAIT(20, rf); P7_UCOMP(rf, b + 5); }
            }
            asm volatile("s_waitcnt vmcnt(0)" ::: "memory");
#undef P7_ULOAD
#undef P7_UMETA
#undef P7_UDOT
#undef P7_UCOMP
        }
        float cscale[4];
        {
            float m0 = 0.f, m1 = 0.f, m2 = 0.f, m3 = 0.f;
            for (int idx = lane; idx < 4 * nb; idx += 64) { const float c = fabsf(LG[idx]); const int sl = LS[idx]; m0 = fmaxf(m0, sl == 0 ? c : 0.f); m1 = fmaxf(m1, sl == 1 ? c : 0.f); m2 = fmaxf(m2, sl == 2 ? c : 0.f); m3 = fmaxf(m3, sl == 3 ? c : 0.f); }
            m0 = wave_max(m0); m1 = wave_max(m1); m2 = wave_max(m2); m3 = wave_max(m3);
            cscale[0] = m0 * (1.f / 127.f); cscale[1] = m1 * (1.f / 127.f); cscale[2] = m2 * (1.f / 127.f); cscale[3] = m3 * (1.f / 127.f);
            const float i0 = m0 > 0.f ? 127.f / m0 : 0.f, i1 = m1 > 0.f ? 127.f / m1 : 0.f, i2 = m2 > 0.f ? 127.f / m2 : 0.f, i3 = m3 > 0.f ? 127.f / m3 : 0.f;
            unsigned* LQ4 = (unsigned*)LSU;
            for (int i = lane; i < 4 * nb; i += 64) LQ4[i] = 0u;
            unsigned char* LQ = (unsigned char*)LSU;
            for (int idx = lane; idx < 4 * nb; idx += 64) { const int sl = LS[idx]; const float iv = sl == 0 ? i0 : (sl == 1 ? i1 : (sl == 2 ? i2 : i3));
                LQ[(idx >> 2) * 16 + sl * 4 + (idx & 3)] = (unsigned char)((int)rintf(LG[idx] * iv) & 0xff); }
        }
        int acc[4][16];
#pragma unroll
        for (int s = 0; s < 4; ++s) {
#pragma unroll
            for (int i = 0; i < 16; ++i) acc[s][i] = 0; }
        if (!(dry && (MK_DRY_SKIP & 2))) {
            int lane_v = F.lane; asm volatile("" : "+v"(lane_v));
            const int* LQ32 = (const int*)LSU;
            v4u ra[4], rb[4], rc[4], rd[4];
#define P7_VLOAD(R, b) do { const v2u le_ = *(const v2u*)(LE + 4 * (b)); const int e0 = rfl((int)(le_.x & 0xffffu)), e1 = rfl((int)(le_.x >> 16)), e2 = rfl((int)(le_.y & 0xffffu)), e3 = rfl((int)(le_.y >> 16)); \
            R[0] = *(const v4u*)(V8 + (size_t)e0 * DM + 16 * lane_v); R[1] = *(const v4u*)(V8 + (size_t)e1 * DM + 16 * lane_v); \
            R[2] = *(const v4u*)(V8 + (size_t)e2 * DM + 16 * lane_v); R[3] = *(const v4u*)(V8 + (size_t)e3 * DM + 16 * lane_v); } while (0)
#define P7_VCOMP(R, b) do { const v4u cq4_ = *(const v4u*)(LQ32 + 4 * (b)); const int cq0 = rfl((int)cq4_.x), cq1 = rfl((int)cq4_.y), cq2 = rfl((int)cq4_.z), cq3 = rfl((int)cq4_.w); \
                _Pragma("unroll") for (int d = 0; d < 4; ++d) { \
                    const unsigned x_ = __builtin_amdgcn_perm(R[1][d], R[0][d], 0x05010400u), y_ = __builtin_amdgcn_perm(R[1][d], R[0][d], 0x07030602u); \
                    const unsigned c_ = __builtin_amdgcn_perm(R[3][d], R[2][d], 0x05010400u), e_ = __builtin_amdgcn_perm(R[3][d], R[2][d], 0x07030602u); \
                    const int k0 = (int)__builtin_amdgcn_perm(c_, x_, 0x05040100u), k1 = (int)__builtin_amdgcn_perm(c_, x_, 0x07060302u), k2 = (int)__builtin_amdgcn_perm(e_, y_, 0x05040100u), k3 = (int)__builtin_amdgcn_perm(e_, y_, 0x07060302u); \
                    acc[0][4 * d + 0] = __builtin_amdgcn_sdot4(k0, cq0, acc[0][4 * d + 0], false); acc[0][4 * d + 1] = __builtin_amdgcn_sdot4(k1, cq0, acc[0][4 * d + 1], false); \
                    acc[0][4 * d + 2] = __builtin_amdgcn_sdot4(k2, cq0, acc[0][4 * d + 2], false); acc[0][4 * d + 3] = __builtin_amdgcn_sdot4(k3, cq0, acc[0][4 * d + 3], false); \
                    acc[1][4 * d + 0] = __builtin_amdgcn_sdot4(k0, cq1, acc[1][4 * d + 0], false); acc[1][4 * d + 1] = __builtin_amdgcn_sdot4(k1, cq1, acc[1][4 * d + 1], false); \
                    acc[1][4 * d + 2] = __builtin_amdgcn_sdot4(k2, cq1, acc[1][4 * d + 2], false); acc[1][4 * d + 3] = __builtin_amdgcn_sdot4(k3, cq1, acc[1][4 * d + 3], false); \
                    acc[2][4 * d + 0] = __builtin_amdgcn_sdot4(k0, cq2, acc[2][4 * d + 0], false); acc[2][4 * d + 1] = __builtin_amdgcn_sdot4(k1, cq2, acc[2][4 * d + 1], false); \
                    acc[2][4 * d + 2] = __builtin_amdgcn_sdot4(k2, cq2, acc[2][4 * d + 2], false); acc[2][4 * d + 3] = __builtin_amdgcn_sdot4(k3, cq2, acc[2][4 * d + 3], false); \
                    acc[3][4 * d + 0] = __builtin_amdgcn_sdot4(k0, cq3, acc[3][4 * d + 0], false); acc[3][4 * d + 1] = __builtin_amdgcn_sdot4(k1, cq3, acc[3][4 * d + 1], false); \
                    acc[3][4 * d + 2] = __builtin_amdgcn_sdot4(k2, cq3, acc[3][4 * d + 2], false); acc[3][4 * d + 3] = __builtin_amdgcn_sdot4(k3, cq3, acc[3][4 * d + 3], false); } } while (0)
            P7_VLOAD(ra, 0); P7_VLOAD(rb, 1); P7_VLOAD(rc, 2);
#define P7_NX(k) ((k) < nb ? (k) : nb - 1)
#pragma unroll 1
            for (int b = 0; b < nb; b += 12) {
                P7_VLOAD(rd, b + 3);      P7_VCOMP(ra, b);      P7_VLOAD(ra, b + 4);      P7_VCOMP(rb, b + 1);
                P7_VLOAD(rb, b + 5);      P7_VCOMP(rc, b + 2);  P7_VLOAD(rc, b + 6);      P7_VCOMP(rd, b + 3);
                P7_VLOAD(rd, b + 7);      P7_VCOMP(ra, b + 4);  P7_VLOAD(ra, b + 8);      P7_VCOMP(rb, b + 5);
                P7_VLOAD(rb, b + 9);      P7_VCOMP(rc, b + 6);  P7_VLOAD(rc, b + 10);     P7_VCOMP(rd, b + 7);
                P7_VLOAD(rd, b + 11);     P7_VCOMP(ra, b + 8);  P7_VLOAD(ra, P7_NX(b + 12)); P7_VCOMP(rb, b + 9);
                P7_VLOAD(rb, P7_NX(b + 13)); P7_VCOMP(rc, b + 10); P7_VLOAD(rc, P7_NX(b + 14)); P7_VCOMP(rd, b + 11);
            }
#undef P7_NX
#undef P7_VLOAD
#undef P7_VCOMP
        }
        {
            int lane_f = F.lane; asm volatile("" : "+v"(lane_f));
            const float* ga2 = mods + (size_t)mod_index(tok0) * MODW + 5 * DM + 16 * lane_f;
            const float* gf = F.in[I_GFINAL] + 16 * lane_f;
            f32x4 xv[4][4], gav[4], gfv[4];
#pragma unroll
            for (int s = 0; s < 4; ++s)
#pragma unroll
                for (int j = 0; j < 4; ++j) xv[s][j] = *(const f32x4*)(F.out + O_Y + (size_t)(tok0 + s) * DM + 16 * lane_f + 4 * j);
#pragma unroll
            for (int j = 0; j < 4; ++j) { gav[j] = *(const f32x4*)(ga2 + 4 * j); gfv[j] = *(const f32x4*)(gf + 4 * j); }
#pragma unroll
            for (int s = 0; s < 4; ++s) {
                const int tok = tok0 + s;
                float* yrow = dry ? (float*)(F.ws + WS_MIX) + (size_t)(tok & 8191) * DM + 16 * lane_f : F.out + O_Y + (size_t)tok * DM + 16 * lane_f;
                float ss = 0.f; const float csc = cscale[s];
#pragma unroll
                for (int j = 0; j < 4; ++j)
#pragma unroll
                    for (int i = 0; i < 4; ++i) { const float t = xv[s][j][i] + gav[j][i] * ((float)acc[s][4 * j + i] * csc); xv[s][j][i] = t; ss += t * t; }
                const float rstd = 1.f / sqrtf(wave_sum(ss) * (1.f / DM) + EPS);
#pragma unroll
                for (int j = 0; j < 4; ++j) { f32x4 o;
#pragma unroll
                    for (int i = 0; i < 4; ++i) o[i] = xv[s][j][i] * rstd * gfv[j][i];
                    *(f32x4*)(yrow + 4 * j) = o; }
            }
        }
    }
}

__global__ void __launch_bounds__(NWAVES * 64, 2) mk_fwd(Args args) {
    extern __shared__ __attribute__((aligned(16))) unsigned char lds[];
    Frame F;
    F.lds = lds;
    F.tid = threadIdx.x; F.lane = F.tid & 63; F.wave = __builtin_amdgcn_readfirstlane(F.tid >> 6);
    F.G = gridDim.x; { const int bx = blockIdx.x; F.vcu = (F.G % 8 == 0) ? (bx % 8) * (F.G / 8) + bx / 8 : bx; }
    F.in = args.in; F.out = args.out; F.ws = args.ws;
    LAS unsigned char* lds3 = (LAS unsigned char*)lds;
    volatile LAS unsigned* MISC = (volatile LAS unsigned*)(lds3 + MISC_OFF);
    for (int u = F.tid; u < (LDS_BYTES - LDSCTL_OFF) / 4; u += NWAVES * 64) ((LAS unsigned*)(lds3 + LDSCTL_OFF))[u] = 0u;
    __syncthreads();
    unsigned* ctl = (unsigned*)(args.ws + WS_CTL);
    XcdBarrier bar; bar.bar = ctl + CW_BAR; bar.x = 0; bar.st = nullptr;
    const bool one_launch = (args.ph_hi - args.ph_lo) > 1;
    if (one_launch) bar = xcd_barrier_post(ctl + CW_BAR, MISC + 8);
    const int lo = args.ph_lo, hi = args.ph_hi;
#ifndef MK_PHASE_MASK
#define MK_PHASE_MASK 0xff
#endif
#define IN(k) (((MK_PHASE_MASK >> (k)) & 1) && lo <= (k) && (k) < hi)
#define SEAM(k) do { if (IN(k) && IN((k) + 1)) xcd_barrier(bar); } while (0)

#define DUPQ(k) (MK_DUP == (k))
    if (IN(0)) { if (DUPQ(0)) { p0_phase(F); xcd_barrier(bar); } p0_phase(F); SEAM(0); }
    if (IN(1)) { if (DUPQ(1)) { norm_phase(F, 0); xcd_barrier(bar); } norm_phase(F, 0); bias_items(F); SEAM(1); }
    if (IN(2)) {
        pg8::Gemm g{(const pg8::bf16_t*)(F.ws + WS_H), (const pg8::bf16_t*)(F.ws + WS_WIN), NTOK, D_IN, DM}; pg8::StaticOrder S; S.init(NTOK, D_IN, F.G, (int)blockIdx.x);
        EpiInProj E{(bf16*)(F.ws + WS_Q), (bf16*)(F.ws + WS_K), (bf16*)(F.ws + WS_VT), (bf16*)(F.ws + WS_XR), (bf16*)(F.ws + WS_YG), F.out + O_NEWK, F.out + O_NEWV, (const f32x4*)(F.ws + WS_ROPE)};
        if (DUPQ(2)) { pg8::gemm_phase<EpiInProj, pg8::StaticOrder, true, true>(lds3, g, S, E); xcd_barrier(bar); }
        pg8::gemm_phase<EpiInProj, pg8::StaticOrder, true, true>(lds3, g, S, E);
        SEAM(2);
    }
    if (IN(3)) { if (DUPQ(3)) { p3_phase(F, MK_P3_TYPES); xcd_barrier(bar); } p3_phase(F); SEAM(3); }
    if (IN(4)) {
        pg8::Gemm g{(const pg8::bf16_t*)(F.ws + WS_MIX), (const pg8::bf16_t*)(F.ws + WS_WOUT), NTOK, DM, DM}; pg8::StaticOrder S; S.init(NTOK, DM, F.G, (int)blockIdx.x);
        EpiOutProj E{F.in[I_XP], F.in[I_XS], (const float*)(F.ws + WS_MODS), F.in[I_GFFN], F.out + O_Y, (bf16*)(F.ws + WS_H), (float*)(F.ws + WS_SSP)};
        if (DUPQ(4)) { pg8::gemm_phase<EpiOutProj, pg8::StaticOrder, true, true>(lds3, g, S, E); xcd_barrier(bar); }
        pg8::gemm_phase<EpiOutProj, pg8::StaticOrder, true, true>(lds3, g, S, E);
        SEAM(4);
    }
    if (IN(6)) {
        pg8::Gemm g{(const pg8::bf16_t*)(F.ws + WS_H), (const pg8::bf16_t*)(F.ws + WS_WC), NTOK, 2048, DM}; pg8::StaticOrder S; S.init(NTOK, 2048, F.G, (int)blockIdx.x);
        EpiScores E{(bf16*)(F.ws + WS_SC), (const float*)(F.ws + WS_SSP), (const float*)(F.ws + WS_BIAS)};
        if (DUPQ(6)) { pg8::gemm_phase<EpiScores, pg8::StaticOrder, true, true>(lds3, g, S, E); xcd_barrier(bar); }
        pg8::gemm_phase<EpiScores, pg8::StaticOrder, true, true>(lds3, g, S, E);
        SEAM(6);
    }
    if (IN(7)) { if (DUPQ(7)) { p7_phase(F, true); xcd_barrier(bar); } p7_phase(F, false); }
#undef IN
#undef SEAM
}

extern "C" void kernel_launch(void* const* d_in, const int* in_sizes, int n_in, void* d_out, int out_size, void* d_ws, size_t ws_size, hipStream_t stream) {
    static int grid = 0;
    if (grid == 0) {
        if (n_in != 26 || ws_size < WS_END) { fprintf(stderr, "kernel_launch: unexpected n_in %d / ws %zu\n", n_in, ws_size); grid = -1; return; }
        int dev = 0, cus = 0, per_cu = 0;
        if (hipGetDevice(&dev) != hipSuccess || hipDeviceGetAttribute(&cus, hipDeviceAttributeMultiprocessorCount, dev) != hipSuccess) { grid = -1; return; }
        if (hipFuncSetAttribute((const void*)mk_fwd, hipFuncAttributeMaxDynamicSharedMemorySize, LDS_BYTES) != hipSuccess) { fprintf(stderr, "kernel_launch: hipFuncSetAttribute failed\n"); grid = -1; return; }
        if (hipOccupancyMaxActiveBlocksPerMultiprocessor(&per_cu, (const void*)mk_fwd, NWAVES * 64, LDS_BYTES) != hipSuccess || per_cu < 1)
            fprintf(stderr, "kernel_launch: occupancy query reports %d blocks per CU\n", per_cu);
        (void)hipGetLastError();
        grid = cus;
        if (grid != 256) fprintf(stderr, "kernel_launch: note: %d CUs\n", grid);
    }
    if (grid < 0) return;
    (void)hipMemsetAsync((char*)d_ws + WS_CTL, 0, CTL_ZERO_BYTES, stream);
    Args a{};
    for (int i = 0; i < 26; ++i) a.in[i] = (const float*)d_in[i];
    a.out = (float*)d_out; a.ws = (unsigned char*)d_ws;
    if (MK_N_LAUNCHES == 1) {
        a.ph_lo = 0; a.ph_hi = N_PHASES; a.li = 0;
        hipLaunchKernelGGL(mk_fwd, dim3(grid), dim3(NWAVES * 64), LDS_BYTES, stream, a);
    } else {
        for (int li = 0; li < N_PHASES; ++li) { a.ph_lo = li; a.ph_hi = li + 1; a.li = li;
            hipLaunchKernelGGL(mk_fwd, dim3(grid), dim3(NWAVES * 64), LDS_BYTES, stream, a); }
    }
}
```

```cpp
#include <hip/hip_runtime.h>
#include <cstdio>
#include <cstdint>

#ifndef MK_DUP
#define MK_DUP -1
#endif
#ifndef MK_DRY_SKIP
#define MK_DRY_SKIP 0
#endif
#ifndef MK_N_LAUNCHES
#define MK_N_LAUNCHES 1
#endif

namespace pg8 {
#define PG8_LAS __attribute__((address_space(3)))
typedef unsigned short bf16_t;
typedef short bf16x8 __attribute__((ext_vector_type(8)));
typedef float f32x4 __attribute__((ext_vector_type(4)));
typedef unsigned u32x4 __attribute__((ext_vector_type(4)));
typedef unsigned u32x2 __attribute__((ext_vector_type(2)));
constexpr int BM = 256, BK = 64, HALF = 128, HTB = HALF * BK * 2, STAGE_BYTES = 8 * HTB, NXCD = 8, WGM = 8;

__host__ __device__ __forceinline__ int lds_byte(int r, int c) { const int st = (r >> 4) * 2 + (c >> 5), rr = r & 15, cc = c & 31, ob = rr * 64 + cc * 2; return st * 1024 + (ob ^ (((ob >> 9) & 1) << 5)); }
__host__ __device__ __forceinline__ void stage_rc(int b, int& R, int& C) { const int st = b / 1024, sb = b % 1024, swz = sb ^ (((sb >> 9) & 1) << 5); R = (st >> 1) * 16 + swz / 64; C = (st & 1) * 32 + (swz % 64) / 2; }
__host__ __device__ __forceinline__ int perm32(int rho) { const int n = rho >> 4, i = rho & 15; return 8 * (i >> 2) + 4 * n + (i & 3); }

struct Unit { int pm, pn; };
struct Gemm { const bf16_t* A; const bf16_t* Bt; int M, N, K; };

struct StaticOrder {
    int nM, nN, nwg, G, c;
    __host__ __device__ void init(int M, int N, int G_, int c_) { nM = M / BM; nN = N / BM; nwg = nM * nN; G = G_; c = c_; }
    __host__ __device__ bool next(int i, Unit& u) const {
        const long L = (long)i * G + c; if (L >= nwg) return false;
        int wgid = (int)L; { const int q = nwg / NXCD, r = nwg % NXCD, xcd = wgid % NXCD, off = wgid / NXCD; wgid = (xcd < r ? xcd * (q + 1) : r * (q + 1) + (xcd - r) * q) + off; }
        const int nig = WGM * nN, gid = wgid / nig, fm = gid * WGM, gsz = (nM - fm) < WGM ? (nM - fm) : WGM;
        u.pm = fm + ((wgid % nig) % gsz); u.pn = (wgid % nig) / gsz; return true;
    }
    __device__ __forceinline__ void a_ready(const Unit&) const {}
    __device__ __forceinline__ void done(const Unit&) const {}
};

__device__ __forceinline__ unsigned cvt_pk_bf16(float lo, float hi) { unsigned r; asm volatile("v_cvt_pk_bf16_f32 %0, %1, %2" : "=v"(r) : "v"(lo), "v"(hi)); return r; }

template <class Epi, class Sched, bool ALIGN_EPI = false, bool SP2 = false>
__device__ __forceinline__ void gemm_phase(PG8_LAS unsigned char* lds, const Gemm g, const Sched& S, const Epi& E) {
    const int tid = threadIdx.x, wid = __builtin_amdgcn_readfirstlane(tid >> 6), lane = tid & 63, wr = wid >> 2, wc = wid & 3, fr = lane & 15, fq = lane >> 4;
    const int K = g.K, nt = K / BK;
    unsigned voffA[2], voffB[2];
#pragma unroll
    for (int i = 0; i < 2; ++i) { int R, C; stage_rc(tid * 16 + i * 8192, R, C); const int Rb = Epi::PERM ? ((R & ~31) + perm32(R & 31)) : R;
        voffA[i] = (unsigned)(R * K + C) * 2u; voffB[i] = (unsigned)(Rb * K + C) * 2u; }
    const size_t kstep = (size_t)(BK * 2);
    const size_t hstep = (size_t)HALF * K * 2;
    const size_t tstep = 2 * hstep;
    const unsigned ldsw = (unsigned)wid * 1024u;
    const int aoff = lds_byte(wr * 64 + fr, fq * 8), boff = lds_byte(wc * 32 + fr, fq * 8);
#define PG8_SA(b, h) (((b) * 2 + (h)) * HTB)
#define PG8_SB(b, h) ((4 + (b) * 2 + (h)) * HTB)
#define PG8_STAGE(bufoff, gbase, voff) do { _Pragma("unroll") for (int _i = 0; _i < 2; ++_i) \
        __builtin_amdgcn_global_load_lds((const unsigned*)((const char*)(gbase) + (voff)[_i]), (PG8_LAS unsigned*)(lds + (bufoff) + ldsw + _i * 8192), 16, 0, 0); } while (0)
#define PG8_LDA(dst, b, h) do { _Pragma("unroll") for (int m = 0; m < 4; ++m) _Pragma("unroll") for (int k = 0; k < 2; ++k) dst[m][k] = *(const PG8_LAS bf16x8*)(lds + PG8_SA(b, h) + aoff + m * 2048 + k * 1024); } while (0)
#define PG8_LDB(dst, b, h) do { _Pragma("unroll") for (int n = 0; n < 2; ++n) _Pragma("unroll") for (int k = 0; k < 2; ++k) dst[n][k] = *(const PG8_LAS bf16x8*)(lds + PG8_SB(b, h) + boff + n * 2048 + k * 1024); } while (0)
#define PG8_MMA(ai, bj, At, Bt) do { __builtin_amdgcn_s_setprio(1); _Pragma("unroll") for (int m = 0; m < 4; ++m) _Pragma("unroll") for (int n = 0; n < 2; ++n) _Pragma("unroll") for (int k = 0; k < 2; ++k) \
        acc[ai][bj][m][n] = __builtin_amdgcn_mfma_f32_16x16x32_bf16(Bt[n][k], At[m][k], acc[ai][bj][m][n], 0, 0, 0); __builtin_amdgcn_s_setprio(0); } while (0)
#define PG8_WAIT_V(n) asm volatile("s_waitcnt vmcnt(" #n ")" ::: "memory")
#define PG8_WAIT_L(n) asm volatile("s_waitcnt lgkmcnt(" #n ")" ::: "memory")
#define PG8_BAR __builtin_amdgcn_s_barrier()
#define PG8_SCHED __builtin_amdgcn_sched_barrier(0)
    Unit cur, nxt; int ui = 0;
    if (!S.next(0, cur)) return;
    f32x4 acc[2][2][4][2];
#pragma unroll
    for (int a = 0; a < 2; ++a)
#pragma unroll
        for (int b = 0; b < 2; ++b)
#pragma unroll
            for (int m = 0; m < 4; ++m)
#pragma unroll
                for (int n = 0; n < 2; ++n) acc[a][b][m][n] = (f32x4){0.f, 0.f, 0.f, 0.f};
    bf16x8 At[4][2], B0[2][2], B1[2][2];
    const char* cA = (const char*)g.A + (size_t)cur.pm * tstep; const char* cB = (const char*)g.Bt + (size_t)cur.pn * tstep;
    S.a_ready(cur);
    if constexpr (SP2) {
        PG8_STAGE(PG8_SB(0, 0), cB, voffB); PG8_STAGE(PG8_SB(0, 1), cB + hstep, voffB); PG8_STAGE(PG8_SA(0, 0), cA, voffA); PG8_STAGE(PG8_SA(0, 1), cA + hstep, voffA);
        if (wr == 1) PG8_BAR;
        PG8_WAIT_V(2); PG8_BAR;
        PG8_STAGE(PG8_SB(1, 0), cB + kstep, voffB); PG8_STAGE(PG8_SA(1, 0), cA + kstep, voffA); PG8_STAGE(PG8_SB(1, 1), cB + hstep + kstep, voffB);
        PG8_WAIT_V(6); PG8_BAR;
    } else {
        PG8_STAGE(PG8_SB(0, 0), cB, voffB); PG8_STAGE(PG8_SA(0, 0), cA, voffA); PG8_STAGE(PG8_SB(0, 1), cB + hstep, voffB); PG8_STAGE(PG8_SA(0, 1), cA + hstep, voffA);
        if (wr == 1) PG8_BAR;
        PG8_WAIT_V(4); PG8_BAR;
        PG8_STAGE(PG8_SB(1, 0), cB + kstep, voffB); PG8_STAGE(PG8_SA(1, 0), cA + kstep, voffA); PG8_STAGE(PG8_SB(1, 1), cB + hstep + kstep, voffB);
        PG8_WAIT_V(6); PG8_BAR;
    }
    for (;;) {
        const bool has_next = S.next(ui + 1, nxt);
        const char* nA = has_next ? (const char*)g.A + (size_t)nxt.pm * tstep : cA; const char* nB = has_next ? (const char*)g.Bt + (size_t)nxt.pn * tstep : cB;
        for (int t = 0; t < nt; t += 2) {
            const bool last = (t == nt - 2);
            const char* a1 = cA + (size_t)(t + 1) * kstep;
            const char* a2 = last ? nA : cA + (size_t)(t + 2) * kstep; const char* b2 = last ? nB : cB + (size_t)(t + 2) * kstep;
            const char* a3 = a2 + kstep; const char* b3 = b2 + kstep;
            if (last && has_next) S.a_ready(nxt);
            if constexpr (SP2) {
            PG8_LDB(B0, 0, 0); PG8_LDB(B1, 0, 1); PG8_SCHED; PG8_LDA(At, 0, 0); PG8_STAGE(PG8_SA(1, 1), a1 + hstep, voffA);
            PG8_WAIT_V(8); PG8_WAIT_L(0); PG8_BAR; PG8_MMA(0, 0, At, B0); PG8_MMA(0, 1, At, B1); PG8_BAR; PG8_SCHED;
            PG8_LDA(At, 0, 1); PG8_STAGE(PG8_SB(0, 0), b2, voffB); PG8_STAGE(PG8_SB(0, 1), b2 + hstep, voffB); PG8_STAGE(PG8_SA(0, 0), a2, voffA);
            PG8_WAIT_V(8); PG8_WAIT_L(0); PG8_BAR; PG8_MMA(1, 0, At, B0); PG8_MMA(1, 1, At, B1); PG8_BAR; PG8_SCHED;
            PG8_LDB(B0, 1, 0); PG8_LDB(B1, 1, 1); PG8_SCHED; PG8_LDA(At, 1, 0); PG8_STAGE(PG8_SA(0, 1), a2 + hstep, voffA);
            PG8_WAIT_V(8); PG8_WAIT_L(0); PG8_BAR; PG8_MMA(0, 0, At, B0); PG8_MMA(0, 1, At, B1); PG8_BAR; PG8_SCHED;
            PG8_LDA(At, 1, 1); PG8_STAGE(PG8_SB(1, 0), b3, voffB); PG8_STAGE(PG8_SB(1, 1), b3 + hstep, voffB); PG8_STAGE(PG8_SA(1, 0), a3, voffA);
            PG8_WAIT_V(8); PG8_WAIT_L(0); PG8_BAR; PG8_MMA(1, 0, At, B0); PG8_MMA(1, 1, At, B1); PG8_BAR; PG8_SCHED;
            } else {
            PG8_LDB(B0, 0, 0); PG8_SCHED; PG8_LDA(At, 0, 0); PG8_STAGE(PG8_SA(1, 1), a1 + hstep, voffA);
            PG8_WAIT_L(8); PG8_BAR; PG8_WAIT_L(0); PG8_MMA(0, 0, At, B0); PG8_BAR; PG8_SCHED;
            PG8_LDB(B1, 0, 1); PG8_STAGE(PG8_SB(0, 0), b2, voffB);
            PG8_BAR; PG8_WAIT_L(0); PG8_MMA(0, 1, At, B1); PG8_BAR;
            PG8_LDA(At, 0, 1); PG8_STAGE(PG8_SA(0, 0), a2, voffA);
            PG8_BAR; PG8_WAIT_L(0); PG8_MMA(1, 0, At, B0); PG8_BAR; PG8_SCHED;
            PG8_STAGE(PG8_SB(0, 1), b2 + hstep, voffB);
            PG8_WAIT_V(6); PG8_BAR; PG8_MMA(1, 1, At, B1); PG8_BAR;
            PG8_LDB(B0, 1, 0); PG8_SCHED; PG8_LDA(At, 1, 0); PG8_STAGE(PG8_SA(0, 1), a2 + hstep, voffA);
            PG8_WAIT_L(8); PG8_BAR; PG8_WAIT_L(0); PG8_MMA(0, 0, At, B0); PG8_BAR; PG8_SCHED;
            PG8_LDB(B1, 1, 1); PG8_STAGE(PG8_SB(1, 0), b3, voffB);
            PG8_BAR; PG8_WAIT_L(0); PG8_MMA(0, 1, At, B1); PG8_BAR;
            PG8_LDA(At, 1, 1); PG8_STAGE(PG8_SA(1, 0), a3, voffA);
            PG8_BAR; PG8_WAIT_L(0); PG8_MMA(1, 0, At, B0); PG8_BAR; PG8_SCHED;
            PG8_STAGE(PG8_SB(1, 1), b3 + hstep, voffB);
            PG8_WAIT_V(6); PG8_BAR; PG8_MMA(1, 1, At, B1); PG8_BAR;
            }
        }
        if constexpr (ALIGN_EPI) { if (wr == 0) PG8_BAR; }
        E(acc, cur, wr, wc, fr, fq); S.done(cur);
        if (!has_next) break;
#pragma unroll
        for (int a = 0; a < 2; ++a)
#pragma unroll
            for (int b = 0; b < 2; ++b)
#pragma unroll
                for (int m = 0; m < 4; ++m)
#pragma unroll
                    for (int n = 0; n < 2; ++n) acc[a][b][m][n] = (f32x4){0.f, 0.f, 0.f, 0.f};
        cur = nxt; cA = nA; cB = nB; ++ui;
        if constexpr (ALIGN_EPI) { if (wr == 1) PG8_BAR; }
    }
    PG8_WAIT_V(0);
    if constexpr (!ALIGN_EPI) { if (wr == 0) PG8_BAR; }
    PG8_BAR;
#undef PG8_SA
#undef PG8_SB
#undef PG8_STAGE
#undef PG8_LDA
#undef PG8_LDB
#undef PG8_MMA
#undef PG8_WAIT_V
#undef PG8_WAIT_L
#undef PG8_BAR
#undef PG8_SCHED
}
}

constexpr int NWAVES = 8;
constexpr int DM = 1024, NTOK = 16384, NCTX = 8192, D_IN = 1792, NMODV = 9, MODW = 6144;
constexpr int SEQ_C = 256, SEQ_L = 1024, NSEQ_C = 32, NSEQ_L = 8;
constexpr int N_PHASES = 8;
constexpr float LOG2E = 1.4426950408889634f;
constexpr float QSCALE = 0.125f * LOG2E;
constexpr float EPS = 1e-6f;

constexpr size_t MiB = 1u << 20, KiB = 1u << 10;
constexpr size_t WS_CTL = 0, CTL_ZERO_BYTES = 64 * KiB;
constexpr size_t WS_MODS = 1 * MiB;
constexpr size_t WS_ROPE = 1 * MiB + 256 * KiB;
constexpr size_t WS_RGW  = 1 * MiB + 512 * KiB;
constexpr size_t WS_CK   = 1 * MiB + 768 * KiB;
constexpr size_t WS_CVT  = 2 * MiB + 256 * KiB;
constexpr size_t WS_WIN  = 3 * MiB;
constexpr size_t WS_WOUT = 7 * MiB;
constexpr size_t WS_WC   = 9 * MiB;
constexpr size_t WS_U    = 16 * MiB;
constexpr size_t WS_SSP  = 14 * MiB;
constexpr size_t WS_BIAS = 15 * MiB;
constexpr size_t WS_SU   = 13 * MiB;
constexpr size_t WS_SV   = 13 * MiB + 64 * KiB;
constexpr size_t WS_V    = 48 * MiB;
constexpr size_t WS_H    = 80 * MiB;
constexpr size_t WS_MIX  = 112 * MiB;
constexpr size_t WS_Q    = 144 * MiB;
constexpr size_t WS_K    = 160 * MiB;
constexpr size_t WS_VT   = 164 * MiB;
constexpr size_t WS_XR   = 168 * MiB;
constexpr size_t WS_YG   = 184 * MiB;
constexpr size_t WS_HF   = 200 * MiB;
constexpr size_t WS_SC   = 144 * MiB;
constexpr size_t WS_END  = 232 * MiB;
constexpr int VT_LAT_OFF = NSEQ_C * 2 * 64 * SEQ_C;

constexpr int CW_BAR = 4096;

constexpr int RING_BYTES = 131072;
constexpr int LDSCTL_OFF = 146944, MISC_OFF = LDSCTL_OFF + 320;
constexpr int LDS_BYTES = 147456;

#define GAS __attribute__((address_space(1)))
#define LAS __attribute__((address_space(3)))
typedef unsigned short bf16;
typedef unsigned v4u __attribute__((ext_vector_type(4)));
typedef unsigned v2u __attribute__((ext_vector_type(2)));
typedef float f32x4 __attribute__((ext_vector_type(4)));
typedef float f32x2 __attribute__((ext_vector_type(2)));
typedef float f32x16 __attribute__((ext_vector_type(16)));
typedef short bf16x8 __attribute__((ext_vector_type(8)));
typedef GAS unsigned gu32;
#define RLX_AGENT __ATOMIC_RELAXED, __HIP_MEMORY_SCOPE_AGENT

__device__ __forceinline__ unsigned f2bf(float f) { unsigned u = __builtin_bit_cast(unsigned, f); return (u + 0x7fffu + ((u >> 16) & 1u)) >> 16; }
typedef float f32x2_t_ __attribute__((ext_vector_type(2))); typedef __bf16 bf16x2_t_ __attribute__((ext_vector_type(2)));
__device__ __forceinline__ unsigned pk2(float lo, float hi) { f32x2_t_ v = {lo, hi}; bf16x2_t_ b = __builtin_convertvector(v, bf16x2_t_); return __builtin_bit_cast(unsigned, b); }
__device__ __forceinline__ float bf2f(unsigned b) { return __builtin_bit_cast(float, b << 16); }
__device__ __forceinline__ float bflo(unsigned w) { return __builtin_bit_cast(float, w << 16); }
__device__ __forceinline__ float bfhi(unsigned w) { return __builtin_bit_cast(float, w & 0xffff0000u); }
__device__ __forceinline__ float sigmoidf_(float x) { return 1.f / (1.f + __expf(-x)); }
__device__ __forceinline__ float gelu_tanh(float x) { const float y = 0.7978845608028654f * (x + 0.044715f * x * x * x); const float e = __expf(2.f * y); return 0.5f * x * (2.f - 2.f / (1.f + e)); }
template <int CTRL> __device__ __forceinline__ float dppf_(float v) { return __builtin_bit_cast(float, __builtin_amdgcn_update_dpp(0, __builtin_bit_cast(int, v), CTRL, 0xf, 0xf, true)); }
__device__ __forceinline__ float xrow16_(float v) {
    unsigned a = __builtin_bit_cast(unsigned, v), b = a; asm volatile("" : "+v"(b));
    const auto r = __builtin_amdgcn_permlane16_swap(a, b, false, false);
    const bool odd = (threadIdx.x & 16) != 0; return __builtin_bit_cast(float, odd ? r[0] : r[1]);
}
__device__ __forceinline__ float xhalf32_(float v) {
    unsigned a = __builtin_bit_cast(unsigned, v), b = a; asm volatile("" : "+v"(b));
    const auto r = __builtin_amdgcn_permlane32_swap(a, b, false, false);
    const bool hi = (threadIdx.x & 32) != 0; return __builtin_bit_cast(float, hi ? r[0] : r[1]);
}
__device__ __forceinline__ float wave_sum(float v) {
    v += dppf_<0xB1>(v); v += dppf_<0x4E>(v); v += dppf_<0x141>(v); v += dppf_<0x140>(v);
    v += xrow16_(v); v += xhalf32_(v); return v;
}
__device__ __forceinline__ float wave_max(float v) {
    v = fmaxf(v, dppf_<0xB1>(v)); v = fmaxf(v, dppf_<0x4E>(v)); v = fmaxf(v, dppf_<0x141>(v)); v = fmaxf(v, dppf_<0x140>(v));
    v = fmaxf(v, xrow16_(v)); v = fmaxf(v, xhalf32_(v)); return v;
}
__device__ __forceinline__ int crow(int r, int hi) { return (r & 3) + 8 * (r >> 2) + 4 * hi; }

#define XB_TMO      128
#define XB_XCNT(j)  (256  + 64 * (j))
#define XB_XSUB(j)  (1280 + 64 * (j))
#define XB_XGEN(j)  (2304 + 64 * (j))
#define XB_TOP      3328
#define XB_TOPGEN   3392
#define XCD_BAR_WORDS 3456
#define XB_SPIN_CAP (1u << 18)
__device__ __forceinline__ unsigned xb_ld(unsigned* p)              { return __hip_atomic_load(p, __ATOMIC_RELAXED, __HIP_MEMORY_SCOPE_AGENT); }
__device__ __forceinline__ unsigned xb_add(unsigned* p, unsigned v) { return __hip_atomic_fetch_add(p, v, __ATOMIC_RELAXED, __HIP_MEMORY_SCOPE_AGENT); }
__device__ __forceinline__ unsigned xb_xcc_id() { return (unsigned)__builtin_amdgcn_s_getreg((3 << 11) | 20) & 0xFu; }
#define XB_SPIN(cond, bar) do { unsigned _sp = 0; while (cond) { __builtin_amdgcn_s_sleep(1); \
    if ((++_sp & 255u) == 0u) { if (xb_ld(&(bar)[XB_TMO])) break; if (_sp > XB_SPIN_CAP) { atomicAdd(&(bar)[XB_TMO], 1u); break; } } } } while (0)
struct XcdBarrier { unsigned* bar; unsigned x; volatile LAS unsigned* st; };
__device__ __forceinline__ XcdBarrier xcd_barrier_post(unsigned* bar, volatile LAS unsigned* st) {
    XcdBarrier b; b.bar = bar; b.x = xb_xcc_id(); b.st = st;
    if (threadIdx.x == 0) (void)xb_add(&bar[XB_XCNT(b.x)], 1u);
    return b;
}
__device__ __forceinline__ void xcd_barrier_complete(unsigned* bar, unsigned x, unsigned& nloc, unsigned& nx) {
    const unsigned G = gridDim.x * gridDim.y * gridDim.z;
    unsigned sum, cnt, mine, sp = 0u;
    for (;;) {
        sum = 0u; cnt = 0u; mine = 0u;
#pragma unroll
        for (unsigned j = 0; j < 16; ++j) { const unsigned c = xb_ld(&bar[XB_XCNT(j)]); sum += c; cnt += (c > 0u) ? 1u : 0u; mine = (j == x) ? c : mine; }
        if (sum == G) break;
        __builtin_amdgcn_s_sleep(1);
        if ((++sp & 255u) == 0u) { if (xb_ld(&bar[XB_TMO])) break; if (sp > XB_SPIN_CAP) { atomicAdd(&bar[XB_TMO], 1u); break; } }
    }
    nloc = mine > 0u ? mine : 1u; nx = cnt > 0u ? cnt : 1u;
}
__device__ __forceinline__ void xcd_barrier(const XcdBarrier& b) {
    asm volatile("s_waitcnt vmcnt(0)" ::: "memory");
    __syncthreads();
    if (threadIdx.x == 0) {
        unsigned* bar = b.bar;
        __builtin_amdgcn_s_waitcnt(0);
        unsigned nloc = b.st[0], nx = b.st[1];
        if (nloc == 0u) { xcd_barrier_complete(bar, b.x, nloc, nx); b.st[0] = nloc; b.st[1] = nx; }
        const unsigned old = xb_add(&bar[XB_XSUB(b.x)], 1u);
        const unsigned gen = old / nloc;
        if (old + 1u == (gen + 1u) * nloc) {
            __builtin_amdgcn_fence(__ATOMIC_RELEASE, "agent");
            asm volatile("s_waitcnt vmcnt(0)" ::: "memory");
            const unsigned og = xb_add(&bar[XB_TOP], 1u);
            const unsigned tg = og / nx;
            if (og + 1u == (tg + 1u) * nx) xb_add(&bar[XB_TOPGEN], 1u);
            else XB_SPIN(xb_ld(&bar[XB_TOPGEN]) == tg, bar);
            __builtin_amdgcn_fence(__ATOMIC_ACQUIRE, "agent");
            xb_add(&bar[XB_XGEN(b.x)], 1u);
            asm volatile("s_waitcnt vmcnt(0)" ::: "memory");
        } else {
            XB_SPIN(xb_ld(&bar[XB_XGEN(b.x)]) == gen, bar);
            __builtin_amdgcn_fence(__ATOMIC_ACQUIRE, "agent");
            asm volatile("s_waitcnt vmcnt(0)" ::: "memory");
        }
    }
    __syncthreads();
}

struct Args { const float* in[26]; float* out; unsigned char* ws; int ph_lo, ph_hi, li, pad; };

struct Frame {
    unsigned char* lds;
    int tid, lane, wave, vcu, G;
    const float* const* in;
    float* out; unsigned char* ws;
};
enum { I_XP = 0, I_XS, I_CK, I_CV, I_SRNN, I_C, I_CCTX, I_WMOD, I_BMOD, I_GMIX, I_GFFN, I_WIN, I_CONVW, I_CONVB, I_RGWA, I_RGBA, I_RGWI, I_RGBI, I_RGLAM, I_SINK, I_WOUT, I_PWQ, I_PSK, I_PU, I_PV, I_GFINAL };
constexpr size_t O_Y = 0, O_NEWK = (size_t)NTOK * DM, O_NEWV = O_NEWK + (size_t)NCTX * 128, O_NEWRNN = O_NEWV + (size_t)NCTX * 128;

__device__ __forceinline__ int mod_index(int tok) { return tok < NCTX ? 0 : 1 + ((tok - NCTX) >> 10); }
__device__ __forceinline__ const float* x_row(const Frame& F, int tok) { return tok < NCTX ? F.in[I_XP] + (size_t)tok * DM : F.in[I_XS] + (size_t)(tok - NCTX) * DM; }

template <class RowMap>
__device__ __forceinline__ void p0_transpose_item(const float* W, int K, int N, bf16* WT, float* scr, int item, int lane, RowMap rowmap, float scale = 1.f) {
    const int nblk = N / 32, kb = item / nblk, nb = item % nblk, k0 = 64 * kb, n0 = 32 * nb;
#pragma unroll 8
    for (int i = 0; i < 32; ++i) { const int kk = 2 * i + (lane >> 5); scr[kk * 33 + (lane & 31)] = W[(size_t)(k0 + kk) * N + n0 + (lane & 31)]; }
    __builtin_amdgcn_s_waitcnt(0xC07F); asm volatile("" ::: "memory");
    const int c = lane & 7;
#pragma unroll
    for (int j = 0; j < 4; ++j) { const int n = (lane >> 3) + 8 * j; const float* s = scr + (8 * c) * 33 + n;
        v4u o; o.x = pk2(s[0 * 33] * scale, s[1 * 33] * scale); o.y = pk2(s[2 * 33] * scale, s[3 * 33] * scale); o.z = pk2(s[4 * 33] * scale, s[5 * 33] * scale); o.w = pk2(s[6 * 33] * scale, s[7 * 33] * scale);
        *(v4u*)(WT + (size_t)rowmap(n0 + n) * K + k0 + 8 * c) = o; }
    __builtin_amdgcn_s_waitcnt(0xC07F); asm volatile("" ::: "memory");
}
struct MapId { __device__ __forceinline__ int operator()(int n) const { return n; } };
struct MapWin { __device__ __forceinline__ int operator()(int n) const { if (n >= 640) return n; const int hb = n & ~63, o = n & 63; return hb + ((o & 31) << 1) + (o >> 5); } };

__device__ __forceinline__ void p0_phase(Frame& F) {
    float* ldsf = (float*)F.lds;
    const int tid = F.tid, lane = F.lane, wave = F.wave, v = F.vcu;
    if (v < 192) {
        for (int i = tid; i < NMODV * DM; i += 512) { const int j = i >> 10, d = i & 1023; const float c = (j == 0) ? F.in[I_CCTX][d] : F.in[I_C][(j - 1) * DM + d]; ldsf[i] = c * sigmoidf_(c); }
        __syncthreads();
        const int e0 = 32 * v, c4 = tid & 7, kq = tid >> 3;
        float acc[NMODV][4];
#pragma unroll
        for (int j = 0; j < NMODV; ++j) { acc[j][0] = 0.f; acc[j][1] = 0.f; acc[j][2] = 0.f; acc[j][3] = 0.f; }
        const float* wm = F.in[I_WMOD] + e0 + 4 * c4;
#pragma unroll 4
        for (int kk = 0; kk < 16; ++kk) { const int k = kq * 16 + kk; const f32x4 w = *(const f32x4*)(wm + (size_t)k * MODW);
#pragma unroll
            for (int j = 0; j < NMODV; ++j) { const float s = ldsf[j * DM + k]; acc[j][0] += s * w[0]; acc[j][1] += s * w[1]; acc[j][2] += s * w[2]; acc[j][3] += s * w[3]; } }
#pragma unroll
        for (int j = 0; j < NMODV; ++j)
#pragma unroll
            for (int i = 0; i < 4; ++i) { float a = acc[j][i]; a += __shfl_xor(a, 8); a += __shfl_xor(a, 16); a += __shfl_xor(a, 32); acc[j][i] = a; }
        float* red = ldsf + NMODV * DM;
        if (lane < 8) {
#pragma unroll
            for (int j = 0; j < NMODV; ++j)
#pragma unroll
                for (int i = 0; i < 4; ++i) red[(wave * NMODV + j) * 32 + 4 * c4 + i] = acc[j][i];
        }
        __syncthreads();
        if (tid < NMODV * 32) { const int j = tid >> 5, col = tid & 31; float s = F.in[I_BMOD][e0 + col];
#pragma unroll
            for (int w = 0; w < 8; ++w) s += red[(w * NMODV + j) * 32 + col];
            ((float*)(F.ws + WS_MODS))[j * MODW + e0 + col] = s; }
        __syncthreads();
    }
    if (v < 256) {
        const int hh = v >> 4, dt = v & 15, d0 = 64 * dt;
        float* At = ldsf;
        float* Bkt = ldsf + 128 * 64;
        const float* wq = F.in[I_PWQ] + hh * 128;
        const float* sk = F.in[I_PSK] + (size_t)hh * 128 * 128;
#pragma unroll
        for (int i = 0; i < 4; ++i) { const int f = tid + 512 * i, d = f & 63, q4 = f >> 6; const f32x4 a = *(const f32x4*)(wq + (size_t)(d0 + d) * 2048 + 4 * q4);
            At[(4 * q4 + 0) * 64 + d] = a[0]; At[(4 * q4 + 1) * 64 + d] = a[1]; At[(4 * q4 + 2) * 64 + d] = a[2]; At[(4 * q4 + 3) * 64 + d] = a[3]; }
#pragma unroll
        for (int i = 0; i < 8; ++i) { const int f = tid + 512 * i, key = f & 127, q4 = f >> 7; const f32x4 b = *(const f32x4*)(sk + (size_t)key * 128 + 4 * q4);
            Bkt[(4 * q4 + 0) * 128 + key] = b[0]; Bkt[(4 * q4 + 1) * 128 + key] = b[1]; Bkt[(4 * q4 + 2) * 128 + key] = b[2]; Bkt[(4 * q4 + 3) * 128 + key] = b[3]; }
        __syncthreads();
        const int dg = tid & 15, kg = tid >> 4;
        float acc[4][4];
#pragma unroll
        for (int i = 0; i < 4; ++i)
#pragma unroll
            for (int j = 0; j < 4; ++j) acc[i][j] = 0.f;
#pragma unroll 4
        for (int q = 0; q < 128; ++q) { const f32x4 a = *(const f32x4*)(At + q * 64 + 4 * dg); const f32x4 b = *(const f32x4*)(Bkt + q * 128 + 4 * kg);
#pragma unroll
            for (int i = 0; i < 4; ++i)
#pragma unroll
                for (int j = 0; j < 4; ++j) acc[i][j] += a[i] * b[j]; }
        bf16* WcT = (bf16*)(F.ws + WS_WC);
#pragma unroll
        for (int j = 0; j < 4; ++j) { v2u o; o.x = pk2(acc[0][j], acc[1][j]); o.y = pk2(acc[2][j], acc[3][j]);
            *(v2u*)(WcT + (size_t)(hh * 128 + 4 * kg + j) * DM + d0 + 4 * dg) = o; }
        __syncthreads();
    }
    const int gw = v * NWAVES + wave, NGW = F.G * NWAVES;
    float* scr = ldsf + wave * 4096;
    {
        constexpr int I_IN = (DM / 64) * (D_IN / 32), I_OUT = (DM / 64) * (DM / 32), I_RG = 32 * 2;
        constexpr int NIT = I_IN + I_OUT + I_RG;
        for (int it = gw; it < NIT; it += NGW) {
            int r = it;
            if (r < I_IN) { p0_transpose_item(F.in[I_WIN], DM, D_IN, (bf16*)(F.ws + WS_WIN), scr, r, lane, MapWin()); continue; } r -= I_IN;
            if (r < I_OUT) { p0_transpose_item(F.in[I_WOUT], DM, DM, (bf16*)(F.ws + WS_WOUT), scr, r, lane, MapId()); continue; } r -= I_OUT;
            { const int mm = r >> 1, sub = r & 1, dir = mm >> 4, n = (mm >> 1) & 7, gate = mm & 1;
              const float* src = (gate ? F.in[I_RGWI] : F.in[I_RGWA]) + (size_t)(dir * 8 + n) * 4096;
              bf16* dst = (bf16*)(F.ws + WS_RGW) + (size_t)((dir * 8 + n) * 2 + gate) * 4096;
              p0_transpose_item(src, 64, 64, dst, scr, sub, lane, MapId(), -LOG2E); }
        }
    }
    for (int it0 = 4 * gw; it0 < 2 * 16384; it0 += 4 * NGW) {
        f32x4 a[4][4];
#pragma unroll
        for (int r = 0; r < 4; ++r) { const int it = it0 + r, tb = it >> 14, row = it & 16383;
            const float* src = (tb ? F.in[I_PV] : F.in[I_PU]) + (size_t)row * DM + 16 * lane;
#pragma unroll
            for (int j = 0; j < 4; ++j) a[r][j] = *(const f32x4*)(src + 4 * j); }
        float am[4];
#pragma unroll
        for (int r = 0; r < 4; ++r) { float m = 0.f;
#pragma unroll
            for (int j = 0; j < 4; ++j) m = fmaxf(m, fmaxf(fmaxf(fabsf(a[r][j][0]), fabsf(a[r][j][1])), fmaxf(fabsf(a[r][j][2]), fabsf(a[r][j][3]))));
            am[r] = m; }
#pragma unroll
        for (int r = 0; r < 4; ++r) am[r] = wave_max(am[r]);
#pragma unroll
        for (int r = 0; r < 4; ++r) { const int it = it0 + r, tb = it >> 14, row = it & 16383;
            const float inv = am[r] > 0.f ? 127.f / am[r] : 0.f;
            v4u o4;
#pragma unroll
            for (int j = 0; j < 4; ++j) { unsigned w = 0;
#pragma unroll
                for (int i = 0; i < 4; ++i) { int q = (int)rintf(a[r][j][i] * inv); q = q > 127 ? 127 : (q < -127 ? -127 : q); w |= ((unsigned)q & 0xffu) << (8 * i); }
                o4[j] = w; }
            *(v4u*)(F.ws + (tb ? WS_V : WS_U) + (size_t)row * DM + 16 * lane) = o4;
            if (lane == 0) ((float*)(F.ws + (tb ? WS_SV : WS_SU)))[row] = am[r] * (1.f / 127.f); }
    }
    const int gt = v * 512 + tid, NGT = F.G * 512;
    for (int e = gt; e < 8 * 256 * 128; e += NGT) {
        const int c = e & 127, bp = e >> 7, kvh = c >> 6, p = c & 63, old = (p & 1) ? 32 + (p >> 1) : (p >> 1);
        ((bf16*)(F.ws + WS_CK))[e] = (bf16)f2bf(F.in[I_CK][(size_t)bp * 128 + kvh * 64 + old]);
    }
    for (int e = gt; e < 8 * 256 * 128; e += NGT) {
        const int pos = e & 255, d = (e >> 8) & 63, kvh = (e >> 14) & 1, b = e >> 15;
        ((bf16*)(F.ws + WS_CVT))[e] = (bf16)f2bf(F.in[I_CV][(size_t)(b * 256 + pos) * 128 + kvh * 64 + d]);
    }
    for (int e = gt; e < 1024 * 32; e += NGT) {
        const int s = e >> 5, i = e & 31, row = s >> 6, col = s & 63;
        const float inv = powf(10000.0f, -(float)(i & 15) / 16.0f);
        const float ang = (i < 16 ? (float)row : (float)col) * inv;
        f32x2 cs; cs.x = cosf(ang); cs.y = sinf(ang);
        ((f32x2*)(F.ws + WS_ROPE))[e] = cs;
    }
}

__device__ __forceinline__ void bias_items(Frame& F) {
    const int gw = F.vcu * NWAVES + F.wave, NGW = F.G * NWAVES, lane = F.lane;
    const float* mods = (const float*)(F.ws + WS_MODS); const bf16* WcT = (const bf16*)(F.ws + WS_WC); float* BIAS = (float*)(F.ws + WS_BIAS);
    for (int n = gw; n < 2048; n += NGW) {
        const v4u a = *(const v4u*)(WcT + (size_t)n * DM + 16 * lane), b = *(const v4u*)(WcT + (size_t)n * DM + 16 * lane + 8);
        float w[16];
        w[0] = bflo(a.x); w[1] = bfhi(a.x); w[2] = bflo(a.y); w[3] = bfhi(a.y); w[4] = bflo(a.z); w[5] = bfhi(a.z); w[6] = bflo(a.w); w[7] = bfhi(a.w);
        w[8] = bflo(b.x); w[9] = bfhi(b.x); w[10] = bflo(b.y); w[11] = bfhi(b.y); w[12] = bflo(b.z); w[13] = bfhi(b.z); w[14] = bflo(b.w); w[15] = bfhi(b.w);
#pragma unroll 1
        for (int j = 0; j < NMODV; ++j) { const float* sh = mods + (size_t)j * MODW + 3 * DM + 16 * lane; float d = 0.f;
#pragma unroll
            for (int q = 0; q < 4; ++q) { const f32x4 v = *(const f32x4*)(sh + 4 * q); d += v[0] * w[4 * q] + v[1] * w[4 * q + 1] + v[2] * w[4 * q + 2] + v[3] * w[4 * q + 3]; }
            d = wave_sum(d); if (lane == 0) BIAS[j * 2048 + n] = d; }
    }
}
__device__ __forceinline__ void norm_phase(Frame& F, int which) {
    const int gw = F.vcu * NWAVES + F.wave, NGW = F.G * NWAVES, lane = F.lane;
    const float* mods = (const float*)(F.ws + WS_MODS);
    const float* g = F.in[which ? I_GFFN : I_GMIX];
    bf16* H = (bf16*)(F.ws + WS_H);
    for (int tok = gw; tok < NTOK; tok += NGW) {
        const float* xr = which ? F.out + O_Y + (size_t)tok * DM : x_row(F, tok);
        const float* mv = mods + (size_t)mod_index(tok) * MODW + (which ? 3 * DM : 0);
        f32x4 v[4]; float ss = 0.f;
#pragma unroll
        for (int j = 0; j < 4; ++j) { v[j] = *(const f32x4*)(xr + 256 * j + 4 * lane); ss += (v[j][0] * v[j][0] + v[j][1] * v[j][1]) + (v[j][2] * v[j][2] + v[j][3] * v[j][3]); }
        const float rstd = 1.f / sqrtf(wave_sum(ss) * (1.f / DM) + EPS);
#pragma unroll
        for (int j = 0; j < 4; ++j) { const int e = 256 * j + 4 * lane;
            const f32x4 gg = *(const f32x4*)(g + e), sh = *(const f32x4*)(mv + e), sc = *(const f32x4*)(mv + DM + e);
            f32x4 o;
#pragma unroll
            for (int i = 0; i < 4; ++i) o[i] = v[j][i] * rstd * gg[i] * (1.f + sc[i]) + sh[i];
            v2u w; w.x = pk2(o[0], o[1]); w.y = pk2(o[2], o[3]); *(v2u*)(H + (size_t)tok * DM + e) = w; }
    }
}

struct EpiInProj {
    static constexpr bool PERM = true;
    bf16 *q, *k, *vT, *xr, *yg; float *newk, *newv; const f32x4* rope4;
    __device__ __forceinline__ void operator()(const f32x4 (&acc)[2][2][4][2], const pg8::Unit& u, int wr, int wc, int fr, int fq) const {
        const bool lat = u.pm >= 32;
        const int pn = u.pn;
#pragma unroll
        for (int ai = 0; ai < 2; ++ai)
#pragma unroll
            for (int m = 0; m < 4; ++m) {
                const int row = u.pm * 256 + ai * 128 + wr * 64 + m * 16 + fr;
                const int pos = lat ? ((row - NCTX) & 1023) : (row & 255);
#pragma unroll
                for (int bj = 0; bj < 2; ++bj) {
                    const int c = pn * 256 + bj * 128 + wc * 32 + 8 * fq;
                    f32x4 v0 = acc[ai][bj][m][0], v1 = acc[ai][bj][m][1];
                    if (pn < 2 || (pn == 2 && bj == 0)) {
                        const int i = (c & 63) >> 1;
                        if (lat) { const f32x4 cs0 = rope4[(pos * 32 + i) >> 1], cs1 = rope4[((pos * 32 + i) >> 1) + 1];
                            const float a0 = v0[0] * cs0[0] - v0[1] * cs0[1], a1 = v0[1] * cs0[0] + v0[0] * cs0[1];
                            const float b0 = v0[2] * cs0[2] - v0[3] * cs0[3], b1 = v0[3] * cs0[2] + v0[2] * cs0[3];
                            const float c0 = v1[0] * cs1[0] - v1[1] * cs1[1], c1 = v1[1] * cs1[0] + v1[0] * cs1[1];
                            const float d0 = v1[2] * cs1[2] - v1[3] * cs1[3], d1 = v1[3] * cs1[2] + v1[2] * cs1[3];
                            v0[0] = a0; v0[1] = a1; v0[2] = b0; v0[3] = b1; v1[0] = c0; v1[1] = c1; v1[2] = d0; v1[3] = d1; }
                        if (pn < 2) { v4u w; w.x = pk2(v0[0] * QSCALE, v0[1] * QSCALE); w.y = pk2(v0[2] * QSCALE, v0[3] * QSCALE); w.z = pk2(v1[0] * QSCALE, v1[1] * QSCALE); w.w = pk2(v1[2] * QSCALE, v1[3] * QSCALE);
                            *(v4u*)(q + (size_t)row * 512 + c) = w; }
                        else { const int kc = c - 512; v4u w; w.x = pk2(v0[0], v0[1]); w.y = pk2(v0[2], v0[3]); w.z = pk2(v1[0], v1[1]); w.w = pk2(v1[2], v1[3]); *(v4u*)(k + (size_t)row * 128 + kc) = w;
                            if (!lat) { float* nk = newk + (size_t)row * 128 + (kc & 64) + i; f32x4 lo; lo[0] = v0[0]; lo[1] = v0[2]; lo[2] = v1[0]; lo[3] = v1[2]; f32x4 hi; hi[0] = v0[1]; hi[1] = v0[3]; hi[2] = v1[1]; hi[3] = v1[3];
                                *(f32x4*)nk = lo; *(f32x4*)(nk + 32) = hi; } }
                    } else if (pn == 2) {
                        const int vc = c - 640, kvh = vc >> 6, d = vc & 63;
                        if (!lat) { *(f32x4*)(newv + (size_t)row * 128 + vc) = v0; *(f32x4*)(newv + (size_t)row * 128 + vc + 4) = v1; }
                        bf16* vp; int S;
                        if (!lat) { S = SEQ_C; vp = vT + ((size_t)((row >> 8) * 2 + kvh) * 64 + d) * SEQ_C + pos; }
                        else { S = SEQ_L; vp = vT + VT_LAT_OFF + ((size_t)(((row - NCTX) >> 10) * 2 + kvh) * 64 + d) * SEQ_L + pos; }
                        vp[0] = (bf16)f2bf(v0[0]); vp[S] = (bf16)f2bf(v0[1]); vp[2 * S] = (bf16)f2bf(v0[2]); vp[3 * S] = (bf16)f2bf(v0[3]);
                        vp[4 * S] = (bf16)f2bf(v1[0]); vp[5 * S] = (bf16)f2bf(v1[1]); vp[6 * S] = (bf16)f2bf(v1[2]); vp[7 * S] = (bf16)f2bf(v1[3]);
                    } else {
                        v4u w; w.x = pk2(v0[0], v0[1]); w.y = pk2(v0[2], v0[3]); w.z = pk2(v1[0], v1[1]); w.w = pk2(v1[2], v1[3]);
                        if (pn < 5) *(v4u*)(xr + (size_t)row * 512 + (c - 768)) = w; else *(v4u*)(yg + (size_t)row * 512 + (c - 1280)) = w;
                    }
                }
            }
    }
};
struct EpiOutProj {
    static constexpr bool PERM = true;
    const float *xp, *xs, *mods, *gffn; float* x1; bf16* ap; float* ssp;
    __device__ __forceinline__ void operator()(const f32x4 (&acc)[2][2][4][2], const pg8::Unit& u, int wr, int wc, int fr, int fq) const {
        const int mi = u.pm < 32 ? 0 : 1 + ((u.pm - 32) >> 2);
        const float* mv = mods + (size_t)mi * MODW;
        const int row0 = u.pm * 256 + wr * 64 + fr;
        const float* xbase = (u.pm < 32 ? xp : xs - (size_t)NCTX * DM) + (size_t)row0 * DM;
        float ssq[2][4];
#pragma unroll
        for (int ai = 0; ai < 2; ++ai)
#pragma unroll
            for (int m = 0; m < 4; ++m) ssq[ai][m] = 0.f;
#pragma unroll
        for (int bj = 0; bj < 2; ++bj) {
            const int c = u.pn * 256 + bj * 128 + wc * 32 + 8 * fq;
            const f32x4 gv0 = *(const f32x4*)(mv + 2 * DM + c), gv1 = *(const f32x4*)(mv + 2 * DM + c + 4);
            const f32x4 g20 = *(const f32x4*)(gffn + c) * (1.f + *(const f32x4*)(mv + 4 * DM + c)), g21 = *(const f32x4*)(gffn + c + 4) * (1.f + *(const f32x4*)(mv + 4 * DM + c + 4));
#pragma unroll
            for (int h4 = 0; h4 < 4; ++h4) {
                const int ai = h4 >> 1;
                f32x4 xv[2][2];
#pragma unroll
                for (int mm = 0; mm < 2; ++mm) { const float* xr = xbase + (size_t)(ai * 128 + (2 * (h4 & 1) + mm) * 16) * DM + c; xv[mm][0] = *(const f32x4*)xr; xv[mm][1] = *(const f32x4*)(xr + 4); }
                asm volatile("" ::: "memory");
#pragma unroll
                for (int mm = 0; mm < 2; ++mm) {
                    const int m = 2 * (h4 & 1) + mm;
                    const size_t off = (size_t)(row0 + ai * 128 + m * 16) * DM + c;
                    const f32x4 o0 = xv[mm][0] + gv0 * acc[ai][bj][m][0], o1 = xv[mm][1] + gv1 * acc[ai][bj][m][1];
                    *(f32x4*)(x1 + off) = o0; *(f32x4*)(x1 + off + 4) = o1;
                    ssq[ai][m] += ((o0[0] * o0[0] + o0[1] * o0[1]) + (o0[2] * o0[2] + o0[3] * o0[3])) + ((o1[0] * o1[0] + o1[1] * o1[1]) + (o1[2] * o1[2] + o1[3] * o1[3]));
                    const f32x4 t0 = o0 * g20, t1 = o1 * g21; v4u w; w.x = pk2(t0[0], t0[1]); w.y = pk2(t0[2], t0[3]); w.z = pk2(t1[0], t1[1]); w.w = pk2(t1[2], t1[3]);
                    *(v4u*)(ap + off) = w;
                }
                asm volatile("" ::: "memory");
            }
        }
#pragma unroll
        for (int ai = 0; ai < 2; ++ai)
#pragma unroll
            for (int m = 0; m < 4; ++m) { float v = ssq[ai][m]; v += __shfl_xor(v, 16); v += __shfl_xor(v, 32);
                if (fq == 0) ssp[(size_t)(row0 + ai * 128 + m * 16) * 16 + u.pn * 4 + wc] = v; }
    }
};
struct EpiScores {
    static constexpr bool PERM = true;
    bf16* sc; const float* ssp; const float* bias;
    __device__ __forceinline__ void operator()(const f32x4 (&acc)[2][2][4][2], const pg8::Unit& u, int wr, int wc, int fr, int fq) const {
        const int mi = u.pm < 32 ? 0 : 1 + ((u.pm - 32) >> 2);
        const int row0 = u.pm * 256 + wr * 64 + fr;
        f32x4 b0[2], b1[2];
#pragma unroll
        for (int bj = 0; bj < 2; ++bj) { const int c = u.pn * 256 + bj * 128 + wc * 32 + 8 * fq; b0[bj] = *(const f32x4*)(bias + (size_t)mi * 2048 + c); b1[bj] = *(const f32x4*)(bias + (size_t)mi * 2048 + c + 4); }
#pragma unroll
        for (int h2 = 0; h2 < 4; ++h2) {
            const int ai = h2 >> 1;
            f32x4 sp[2][4];
#pragma unroll
            for (int mm = 0; mm < 2; ++mm)
#pragma unroll
                for (int q = 0; q < 4; ++q) sp[mm][q] = *((const f32x4*)(ssp + (size_t)(row0 + ai * 128 + (2 * (h2 & 1) + mm) * 16) * 16) + q);
            asm volatile("" ::: "memory");
#pragma unroll
            for (int mm = 0; mm < 2; ++mm) {
                const int m = 2 * (h2 & 1) + mm;
                const int row = row0 + ai * 128 + m * 16;
                const float ss = ((sp[mm][0][0] + sp[mm][0][1]) + (sp[mm][0][2] + sp[mm][0][3])) + ((sp[mm][1][0] + sp[mm][1][1]) + (sp[mm][1][2] + sp[mm][1][3]))
                               + ((sp[mm][2][0] + sp[mm][2][1]) + (sp[mm][2][2] + sp[mm][2][3])) + ((sp[mm][3][0] + sp[mm][3][1]) + (sp[mm][3][2] + sp[mm][3][3]));
                const float rstd = 1.f / sqrtf(ss * (1.f / DM) + EPS);
#pragma unroll
                for (int bj = 0; bj < 2; ++bj) {
                    const int c = u.pn * 256 + bj * 128 + wc * 32 + 8 * fq;
                    const f32x4 v0 = acc[ai][bj][m][0] * rstd + b0[bj], v1 = acc[ai][bj][m][1] * rstd + b1[bj];
                    v4u w; w.x = pk2(v0[0], v0[1]); w.y = pk2(v0[2], v0[3]); w.z = pk2(v1[0], v1[1]); w.w = pk2(v1[2], v1[3]);
                    *(v4u*)(sc + (size_t)row * 2048 + c) = w;
                }
            }
            asm volatile("" ::: "memory");
        }
    }
};

__device__ __forceinline__ void attn_unit(Frame& F, bool lat, int seq, int kvh, int qt) {
    const int tid = F.tid, lane = F.lane, wave = F.wave, r32 = lane & 31, hi = lane >> 5;
    const int g = wave >> 1, qs = wave & 1, head = kvh * 4 + g;
    const int S = lat ? SEQ_L : SEQ_C, tokbase = lat ? NCTX + seq * SEQ_L : seq * SEQ_C;
    const int q0 = qt * 64, qpos = q0 + 32 * qs + r32;
    const bf16* Q = (const bf16*)(F.ws + WS_Q); const bf16* Kb = (const bf16*)(F.ws + WS_K); const bf16* VT = (const bf16*)(F.ws + WS_VT);
    const bf16* CK = (const bf16*)(F.ws + WS_CK); const bf16* CVT = (const bf16*)(F.ws + WS_CVT);
    unsigned char* ldsK = F.lds; unsigned char* ldsV = F.lds + 8192;
    bf16x8 qf[4];
    { const bf16* qp = Q + (size_t)(tokbase + qpos) * 512 + head * 64;
#pragma unroll
      for (int ks = 0; ks < 4; ++ks) qf[ks] = *(const bf16x8*)(qp + 16 * ks + 8 * hi); }
    const float sinkl = F.in[I_SINK][head] * LOG2E;
    float mrun = sinkl, lrun = (hi == 0) ? 1.f : 0.f;
    f32x16 o0, o1;
#pragma unroll
    for (int r = 0; r < 16; ++r) { o0[r] = 0.f; o1[r] = 0.f; }
    int tlo, thi;
    if (lat) { tlo = (q0 >= 128 ? q0 - 128 : 0) >> 6; thi = ((q0 + 192 < S ? q0 + 192 : S)) >> 6; } else { tlo = 0; thi = 4; }
    const int nband = thi - tlo, ntile = nband + (lat ? 4 : 0);
    const int key_t = tid >> 3, ch_t = tid & 7;
    v4u kv, vv;
#define AT_LOAD(t_) do { const int tt_ = (t_); const bf16* kptr; const bf16* vptr; int vstride; \
        if (tt_ < nband) { const int kb_ = (tlo + tt_) * 64; kptr = Kb + (size_t)(tokbase + kb_) * 128 + kvh * 64; \
            vptr = VT + (lat ? (size_t)VT_LAT_OFF + (size_t)((seq * 2 + kvh) * 64) * SEQ_L : (size_t)((seq * 2 + kvh) * 64) * SEQ_C) + kb_; vstride = S; } \
        else { const int tc = tt_ - nband; kptr = CK + (size_t)(seq * 256 + tc * 64) * 128 + kvh * 64; vptr = CVT + (size_t)((seq * 2 + kvh) * 64) * 256 + tc * 64; vstride = 256; } \
        kv = *(const v4u*)(kptr + (size_t)key_t * 128 + ch_t * 8); vv = *(const v4u*)(vptr + (size_t)key_t * vstride + ch_t * 8); } while (0)
    AT_LOAD(0);
    for (int t = 0; t < ntile; ++t) {
        const bool band = t < nband;
        const int kbase = band ? (tlo + t) * 64 : 0;
        __syncthreads();
        *(v4u*)(ldsK + key_t * 128 + ((ch_t ^ (key_t & 7)) * 16)) = kv;
        *(v4u*)(ldsV + key_t * 128 + ((ch_t ^ (key_t & 7)) * 16)) = vv;
        __syncthreads();
        f32x16 p0, p1;
#pragma unroll
        for (int r = 0; r < 16; ++r) { p0[r] = 0.f; p1[r] = 0.f; }
#pragma unroll
        for (int ks = 0; ks < 4; ++ks) {
            const int sw = ((2 * ks + hi) ^ (r32 & 7)) * 16;
            const bf16x8 a0 = *(const bf16x8*)(ldsK + r32 * 128 + sw);
            const bf16x8 a1 = *(const bf16x8*)(ldsK + (32 + r32) * 128 + sw);
            p0 = __builtin_amdgcn_mfma_f32_32x32x16_bf16(a0, qf[ks], p0, 0, 0, 0);
            p1 = __builtin_amdgcn_mfma_f32_32x32x16_bf16(a1, qf[ks], p1, 0, 0, 0);
        }
        if (t + 1 < ntile) AT_LOAD(t + 1);
        if (band && lat && (kbase < q0 + 63 - 128 || kbase + 63 > q0 + 128)) {
#pragma unroll
            for (int r = 0; r < 16; ++r) { const int kp = kbase + crow(r, hi); int d0 = qpos - kp; d0 = d0 < 0 ? -d0 : d0; int d1 = qpos - kp - 32; d1 = d1 < 0 ? -d1 : d1;
                if (d0 > 128) p0[r] = -INFINITY; if (d1 > 128) p1[r] = -INFINITY; }
        }
        float tm = p0[0];
#pragma unroll
        for (int r = 1; r < 16; ++r) tm = fmaxf(tm, p0[r]);
#pragma unroll
        for (int r = 0; r < 16; ++r) tm = fmaxf(tm, p1[r]);
        tm = fmaxf(tm, __shfl_xor(tm, 32));
        const float mn = fmaxf(mrun, tm), alpha = __builtin_amdgcn_exp2f(mrun - mn); mrun = mn;
        float ls = 0.f;
#pragma unroll
        for (int r = 0; r < 16; ++r) { p0[r] = __builtin_amdgcn_exp2f(p0[r] - mn); p1[r] = __builtin_amdgcn_exp2f(p1[r] - mn); ls += p0[r] + p1[r]; o0[r] *= alpha; o1[r] *= alpha; }
        lrun = lrun * alpha + ls;
        bf16x8 pf[4];
#pragma unroll
        for (int s = 0; s < 2; ++s) {
            v4u w0, w1;
            w0.x = pk2(p0[8 * s + 0], p0[8 * s + 1]); w0.y = pk2(p0[8 * s + 2], p0[8 * s + 3]); w0.z = pk2(p0[8 * s + 4], p0[8 * s + 5]); w0.w = pk2(p0[8 * s + 6], p0[8 * s + 7]);
            w1.x = pk2(p1[8 * s + 0], p1[8 * s + 1]); w1.y = pk2(p1[8 * s + 2], p1[8 * s + 3]); w1.z = pk2(p1[8 * s + 4], p1[8 * s + 5]); w1.w = pk2(p1[8 * s + 6], p1[8 * s + 7]);
            pf[s] = __builtin_bit_cast(bf16x8, w0); pf[2 + s] = __builtin_bit_cast(bf16x8, w1);
        }
#pragma unroll
        for (int s4 = 0; s4 < 4; ++s4) {
#pragma unroll
            for (int dt = 0; dt < 2; ++dt) {
                const int d = 32 * dt + r32;
                const v2u lo = *(const v2u*)(ldsV + d * 128 + (((2 * s4) ^ (d & 7)) * 16) + 8 * hi);
                const v2u hi2 = *(const v2u*)(ldsV + d * 128 + (((2 * s4 + 1) ^ (d & 7)) * 16) + 8 * hi);
                v4u vf4; vf4.x = lo.x; vf4.y = lo.y; vf4.z = hi2.x; vf4.w = hi2.y;
                const bf16x8 vf = __builtin_bit_cast(bf16x8, vf4);
                if (dt == 0) o0 = __builtin_amdgcn_mfma_f32_32x32x16_bf16(vf, pf[s4], o0, 0, 0, 0);
                else o1 = __builtin_amdgcn_mfma_f32_32x32x16_bf16(vf, pf[s4], o1, 0, 0, 0);
            }
        }
    }
    const float ltot = lrun + __shfl_xor(lrun, 32), inv = 1.f / ltot;
    bf16* mix = (bf16*)(F.ws + WS_MIX) + (size_t)(tokbase + qpos) * DM + head * 64;
#pragma unroll
    for (int g4 = 0; g4 < 4; ++g4) {
        v2u w; w.x = pk2(o0[4 * g4] * inv, o0[4 * g4 + 1] * inv); w.y = pk2(o0[4 * g4 + 2] * inv, o0[4 * g4 + 3] * inv);
        *(v2u*)(mix + 8 * g4 + 4 * hi) = w;
        v2u w2; w2.x = pk2(o1[4 * g4] * inv, o1[4 * g4 + 1] * inv); w2.y = pk2(o1[4 * g4 + 2] * inv, o1[4 * g4 + 3] * inv);
        *(v2u*)(mix + 32 + 8 * g4 + 4 * hi) = w2;
    }
    __syncthreads();
}

constexpr int RL_HALF = 49152;
constexpr int RL_XCB = 32768;
constexpr int RL_AGG = 98304;
constexpr int RL_CARRY = RL_AGG + 8192;
constexpr int RL_CW = RL_CARRY + 512;
constexpr int RL_WG = RL_CW + 1280;
static_assert(RL_WG + 32768 <= LDSCTL_OFF, "RNN LDS map");
__device__ __forceinline__ float fsigmoid(float x) { return __builtin_amdgcn_rcpf(1.f + __expf(-x)); }
__device__ __forceinline__ float gelu_fast(float x) { const float y = 0.7978845608028654f * (x + 0.044715f * x * x * x); const float e = __expf(2.f * y); return x - x * __builtin_amdgcn_rcpf(1.f + e); }

template <bool REV>
__device__ __forceinline__ void scan_prep(const float (&a)[16], const float (&b)[16], int h, float (&Apre)[4], float (&Bpre)[4], float& At, float& Bt) {
    float Ao[4], Bo[4], Ap[4], Bp[4];
#pragma unroll
    for (int g = 0; g < 4; ++g) { float A = 1.f, B = 0.f;
#pragma unroll
        for (int ii = 0; ii < 4; ++ii) { const int r = 4 * g + (REV ? 3 - ii : ii); B = a[r] * B + b[r]; A = a[r] * A; }
        Ao[g] = A; Bo[g] = B; }
#pragma unroll
    for (int g = 0; g < 4; ++g) { Ap[g] = __shfl_xor(Ao[g], 32); Bp[g] = __shfl_xor(Bo[g], 32); }
    const bool ownfirst = REV ? (h == 1) : (h == 0);
    float Ac = 1.f, Bc = 0.f;
#pragma unroll
    for (int gi = 0; gi < 4; ++gi) { const int g = REV ? 3 - gi : gi;
        const float A1 = ownfirst ? Ao[g] : Ap[g], B1 = ownfirst ? Bo[g] : Bp[g], A2 = ownfirst ? Ap[g] : Ao[g], B2 = ownfirst ? Bp[g] : Bo[g];
        const float Ac1 = A1 * Ac, Bc1 = A1 * Bc + B1;
        Apre[g] = ownfirst ? Ac : Ac1; Bpre[g] = ownfirst ? Bc : Bc1;
        Ac = A2 * Ac1; Bc = A2 * Bc1 + B2; }
    At = Ac; Bt = Bc;
}
template <bool REV>
__device__ __forceinline__ void scan_finish(const float (&a)[16], const float (&b)[16], const float (&Apre)[4], const float (&Bpre)[4], float hin, float* hp, int hi) {
#pragma unroll
    for (int g = 0; g < 4; ++g) { float hc = Apre[g] * hin + Bpre[g];
#pragma unroll
        for (int ii = 0; ii < 4; ++ii) { const int r = 4 * g + (REV ? 3 - ii : ii); hc = a[r] * hc + b[r]; hp[(size_t)crow(r, hi) * 512] = hc; } }
}

template <bool REV>
__device__ __forceinline__ void rnn_dir(Frame& F, bool lat, int seq, int n) {
    const int lane = F.lane, w4 = F.wave & 3, r32 = lane & 31, hi = lane >> 5, dirh = REV ? 1 : 0;
    const int S = lat ? SEQ_L : SEQ_C, tokbase = lat ? NCTX + seq * SEQ_L : seq * SEQ_C, nchunk = S / 128;
    unsigned char* hb = F.lds + dirh * RL_HALF;
    float* XC32 = (float*)hb; unsigned char* XCB = hb + RL_XCB;
    f32x2* AGG = (f32x2*)(F.lds + RL_AGG) + dirh * 256; float* CARRY = (float*)(F.lds + RL_CARRY) + dirh * 64; const float* CW = (const float*)(F.lds + RL_CW);
    const unsigned char* WG = F.lds + RL_WG + dirh * 16384;
    const bf16* XR = (const bf16*)(F.ws + WS_XR) + (size_t)tokbase * 512 + n * 64;
    float* HX = (float*)(F.ws + (REV ? WS_H : WS_HF)) + (size_t)tokbase * 512 + n * 64;
    const int t = F.tid & 255, c8 = t & 7, tg = t >> 3;
    float ba[2], bi[2], sp8[2];
#pragma unroll
    for (int chh = 0; chh < 2; ++chh) { const int pe = dirh * 512 + n * 64 + chh * 32 + r32; ba[chh] = -LOG2E * F.in[I_RGBA][pe]; bi[chh] = -LOG2E * F.in[I_RGBI][pe];
        const float nl = -F.in[I_RGLAM][pe]; sp8[chh] = -8.f * LOG2E * (nl > 20.f ? nl : log1pf(__expf(nl))); }
    v4u xin[7];
#define RL_XLOAD(c0_) do { _Pragma("unroll") for (int i = 0; i < 7; ++i) { const int pos = (c0_) + 4 * tg - 2 + i; \
        xin[i] = (pos >= 0 && pos < S) ? *(const v4u*)(XR + (size_t)pos * 512 + 8 * c8) : (v4u){0u, 0u, 0u, 0u}; } } while (0)
    RL_XLOAD((REV ? nchunk - 1 : 0) * 128);
    float newcarry[2] = {0.f, 0.f};
    const bool last_tile = REV ? (w4 == 0) : (w4 == 3);
#pragma unroll 1
    for (int k = 0; k < nchunk; ++k) {
        const int c0 = (REV ? nchunk - 1 - k : k) * 128;
        {
            const f32x4 b0 = *(const f32x4*)(CW + 256 + 8 * c8), b1 = *(const f32x4*)(CW + 256 + 8 * c8 + 4);
            f32x4 wt0[4], wt1[4];
#pragma unroll
            for (int tap = 0; tap < 4; ++tap) { wt0[tap] = *(const f32x4*)(CW + tap * 64 + 8 * c8); wt1[tap] = *(const f32x4*)(CW + tap * 64 + 8 * c8 + 4); }
#pragma unroll
            for (int i = 0; i < 4; ++i) {
                f32x4 y0 = b0, y1 = b1;
#pragma unroll
                for (int tap = 0; tap < 4; ++tap) { const v4u x = xin[i + tap];
                    y0[0] += wt0[tap][0] * bflo(x.x); y0[1] += wt0[tap][1] * bfhi(x.x); y0[2] += wt0[tap][2] * bflo(x.y); y0[3] += wt0[tap][3] * bfhi(x.y);
                    y1[0] += wt1[tap][0] * bflo(x.z); y1[1] += wt1[tap][1] * bfhi(x.z); y1[2] += wt1[tap][2] * bflo(x.w); y1[3] += wt1[tap][3] * bfhi(x.w); }
                const int tk = 4 * tg + i;
                *(f32x4*)(XC32 + tk * 64 + 8 * c8) = y0; *(f32x4*)(XC32 + tk * 64 + 8 * c8 + 4) = y1;
                v4u w; w.x = pk2(y0[0], y0[1]); w.y = pk2(y0[2], y0[3]); w.z = pk2(y1[0], y1[1]); w.w = pk2(y1[2], y1[3]);
                *(v4u*)(XCB + tk * 128 + ((c8 ^ (tk & 7)) * 16)) = w; }
        }
        if (k + 1 < nchunk) RL_XLOAD((REV ? nchunk - 2 - k : k + 1) * 128);
        __syncthreads();
        if (k > 0 && last_tile && hi == 0) { CARRY[r32] = newcarry[0]; CARRY[32 + r32] = newcarry[1]; }
        const int tkA = 32 * w4 + r32;
#pragma unroll
        for (int chh = 0; chh < 2; ++chh) {
            const int che = chh * 32 + r32;
            float av[16], bv[16], Apre[4], Bpre[4];
            {
                f32x16 ga, gi;
#pragma unroll
                for (int r = 0; r < 16; ++r) { ga[r] = 0.f; gi[r] = 0.f; }
#pragma unroll
                for (int ks = 0; ks < 4; ++ks) {
                    const bf16x8 af = *(const bf16x8*)(XCB + tkA * 128 + (((2 * ks + hi) ^ (tkA & 7)) * 16));
                    const bf16x8 wa = *(const bf16x8*)(WG + che * 128 + (((2 * ks + hi) ^ (che & 7)) * 16));
                    const bf16x8 wi = *(const bf16x8*)(WG + 8192 + che * 128 + (((2 * ks + hi) ^ (che & 7)) * 16));
                    ga = __builtin_amdgcn_mfma_f32_32x32x16_bf16(af, wa, ga, 0, 0, 0);
                    gi = __builtin_amdgcn_mfma_f32_32x32x16_bf16(af, wi, gi, 0, 0, 0);
                }
#pragma unroll
                for (int r = 0; r < 16; ++r) { const int tk2 = 32 * w4 + crow(r, hi); const float x = XC32[tk2 * 64 + che];
                    const float rg = __builtin_amdgcn_rcpf(1.f + __builtin_amdgcn_exp2f(ga[r] + ba[chh])), ig = __builtin_amdgcn_rcpf(1.f + __builtin_amdgcn_exp2f(gi[r] + bi[chh])), a = __builtin_amdgcn_exp2f(rg * sp8[chh]);
                    av[r] = a; bv[r] = __builtin_amdgcn_sqrtf(fmaxf(1.f - a * a, 0.f)) * ig * x;
                    if ((r & 3) == 3) __builtin_amdgcn_sched_barrier(0); }
                float At, Bt;
                scan_prep<REV>(av, bv, hi, Apre, Bpre, At, Bt);
                if (hi == 0) { f32x2 ab; ab.x = At; ab.y = Bt; AGG[chh * 512 + w4 * 64 + che] = ab; }
            }
            __syncthreads();
            {
                float hin = CARRY[che];
                if (!REV) { for (int t2 = 0; t2 < w4; ++t2) { const f32x2 ab = AGG[chh * 512 + t2 * 64 + che]; hin = ab.x * hin + ab.y; } }
                else { for (int t2 = 3; t2 > w4; --t2) { const f32x2 ab = AGG[chh * 512 + t2 * 64 + che]; hin = ab.x * hin + ab.y; } }
                scan_finish<REV>(av, bv, Apre, Bpre, hin, HX + (size_t)(c0 + 32 * w4) * 512 + che, hi);
                if (last_tile) { const f32x2 ab = AGG[chh * 512 + w4 * 64 + che]; newcarry[chh] = ab.x * hin + ab.y; }
            }
        }
    }
#undef RL_XLOAD
    if (!lat && last_tile && hi == 0) { float* o = F.out + O_NEWRNN + (size_t)(seq * 2 + dirh) * 512 + n * 64; o[r32] = newcarry[0]; o[32 + r32] = newcarry[1]; }
}

__device__ __forceinline__ void rnn_unit(Frame& F, bool lat, int seq, int n) {
    const int tid = F.tid;
    const int S = lat ? SEQ_L : SEQ_C, tokbase = lat ? NCTX + seq * SEQ_L : seq * SEQ_C;
    __syncthreads();
    { float* CW = (float*)(F.lds + RL_CW); float* CARRY = (float*)(F.lds + RL_CARRY);
      if (tid < 320) CW[tid] = tid < 256 ? F.in[I_CONVW][(tid >> 6) * 512 + n * 64 + (tid & 63)] : F.in[I_CONVB][n * 64 + (tid - 256)];
      if (tid < 128) CARRY[tid] = lat ? F.in[I_SRNN][(size_t)(seq * 2 + (tid >> 6)) * 512 + n * 64 + (tid & 63)] : 0.f;
      const bf16* rgw = (const bf16*)(F.ws + WS_RGW);
#pragma unroll
      for (int i = 0; i < 4; ++i) { const int q = tid + 512 * i, ch = q & 7, d = (q >> 3) & 63, gate = (q >> 9) & 1, dir = q >> 10;
          const v4u w = *(const v4u*)(rgw + (size_t)((dir * 8 + n) * 2 + gate) * 4096 + d * 64 + ch * 8);
          *(v4u*)(F.lds + RL_WG + dir * 16384 + gate * 8192 + d * 128 + ((ch ^ (d & 7)) * 16)) = w; } }
    __syncthreads();
    if (F.wave < 4) rnn_dir<false>(F, lat, seq, n); else rnn_dir<true>(F, lat, seq, n);
    __syncthreads();
    { const int c4 = tid & 15, tk = tid >> 4;
      const float* HF = (const float*)(F.ws + WS_HF) + (size_t)tokbase * 512 + n * 64 + 4 * c4;
      const float* HB = (const float*)(F.ws + WS_H) + (size_t)tokbase * 512 + n * 64 + 4 * c4;
      const bf16* YG = (const bf16*)(F.ws + WS_YG) + (size_t)tokbase * 512 + n * 64 + 4 * c4;
      bf16* MIX = (bf16*)(F.ws + WS_MIX) + (size_t)tokbase * DM + 512 + n * 64 + 4 * c4;
      for (int t0 = tk; t0 < S; t0 += 32) {
          const f32x4 a = *(const f32x4*)(HF + (size_t)t0 * 512), b = *(const f32x4*)(HB + (size_t)t0 * 512); const v2u y = *(const v2u*)(YG + (size_t)t0 * 512);
          v2u o; o.x = pk2((a[0] + b[0]) * gelu_fast(bflo(y.x)), (a[1] + b[1]) * gelu_fast(bfhi(y.x))); o.y = pk2((a[2] + b[2]) * gelu_fast(bflo(y.y)), (a[3] + b[3]) * gelu_fast(bfhi(y.y)));
          *(v2u*)(MIX + (size_t)t0 * DM) = o; } }
    __syncthreads();
}

#ifndef MK_P3_TYPES
#define MK_P3_TYPES 15
#endif
__device__ __forceinline__ void p3_phase(Frame& F, int types = 15) {
    const int v = F.vcu;
#pragma unroll 1
    for (int i = 0; i < 832; ++i) {
        int type, idx;
        if (F.G == 256) {
            if (v < 64) { if (i > 0) break; type = 0; idx = v; }
            else { if (i >= 6) break; const int j = v - 64, sl = i >> 1, rep = i & 1; type = 1 + sl;
                const bool extra = sl == 0 ? (j < 64) : (sl == 1 ? (j >= 64 && j < 128) : (j >= 128));
                if (rep && !extra) continue; idx = rep ? 192 + (j - 64 * sl) : j; }
        } else { const int it = v + i * F.G; if (it >= 832) break;
            if (it < 64) { type = 0; idx = it; } else if (it < 320) { type = 1; idx = it - 64; } else if (it < 576) { type = 2; idx = it - 320; } else { type = 3; idx = it - 576; } }
        if (!((types >> type) & 1)) continue;
        const bool lat = type < 2;
        Frame L = F; asm volatile("" : "+v"(L.tid)); L.lane = L.tid & 63;
        asm volatile("" : "+s"(L.ws), "+s"(L.out));
        if ((type & 1) == 0) rnn_unit(L, lat, idx >> 3, idx & 7);
        else { if (lat) attn_unit(L, true, idx >> 5, (idx >> 4) & 1, idx & 15); else attn_unit(L, false, idx >> 3, (idx >> 2) & 1, idx & 3); }
    }
}

__device__ __forceinline__ unsigned key16(unsigned b, unsigned idx) { const unsigned s = (b & 0x8000u) ? (~b & 0xffffu) : (b | 0x8000u); return (s << 16) | idx; }
__device__ __forceinline__ float keyval16(unsigned k) { const unsigned s = k >> 16; const unsigned b = (s & 0x8000u) ? (s & 0x7fffu) : (~s & 0xffffu); return bf2f(b); }
__device__ __forceinline__ unsigned sortable32(float f) { const unsigned u = __builtin_bit_cast(unsigned, f); return (u & 0x80000000u) ? ~u : (u | 0x80000000u); }
template <int CTRL> __device__ __forceinline__ unsigned dppu(unsigned v) { return (unsigned)__builtin_amdgcn_update_dpp(0, (int)v, CTRL, 0xf, 0xf, true); }
template <int CTRL> __device__ __forceinline__ float dppf(float v) { return __builtin_bit_cast(float, __builtin_amdgcn_update_dpp(0, __builtin_bit_cast(int, v), CTRL, 0xf, 0xf, true)); }
__device__ __forceinline__ unsigned umax_(unsigned a, unsigned b) { return a > b ? a : b; }
__device__ __forceinline__ unsigned umin_(unsigned a, unsigned b) { return a < b ? a : b; }
__device__ __forceinline__ unsigned rowmax16u(unsigned x) { x = umax_(x, dppu<0xB1>(x)); x = umax_(x, dppu<0x4E>(x)); x = umax_(x, dppu<0x141>(x)); x = umax_(x, dppu<0x140>(x)); return x; }
__device__ __forceinline__ float rowmax16f(float x) { x = fmaxf(x, dppf<0xB1>(x)); x = fmaxf(x, dppf<0x4E>(x)); x = fmaxf(x, dppf<0x141>(x)); x = fmaxf(x, dppf<0x140>(x)); return x; }
__device__ __forceinline__ float rowsum16f(float x) { x += dppf<0xB1>(x); x += dppf<0x4E>(x); x += dppf<0x141>(x); x += dppf<0x140>(x); return x; }
__device__ __forceinline__ int rowsum16i(int x) { x += (int)dppu<0xB1>((unsigned)x); x += (int)dppu<0x4E>((unsigned)x); x += (int)dppu<0x141>((unsigned)x); x += (int)dppu<0x140>((unsigned)x); return x; }
#define CEX(a, b) do { const unsigned _h = umax_(a, b), _l = umin_(a, b); a = _h; b = _l; } while (0)

#ifndef P7_NCH
#define P7_NCH 8
#endif
constexpr int P7_CSH = (P7_NCH == 4 ? 12 : (P7_NCH == 8 ? 11 : (P7_NCH == 16 ? 10 : 9)));
constexpr int P7_WL = 16384;
constexpr int P7_TL = 0, P7_TE = 1024, P7_TG = 3072, P7_LE = 5120, P7_LG = 7168, P7_LSU = 9216, P7_LQ = 11264, P7_H2Q = 12160, P7_HST = 16256;
static_assert(P7_LQ + 512 <= P7_H2Q && (P7_H2Q % 16) == 0 && P7_HST + 16 <= P7_WL && P7_WL * 8 <= RING_BYTES, "P7 LDS map");

#define TK_KEYS(R, raw, kb) unsigned R##0 = key16(raw.x & 0xffffu, (kb) + 0), R##1 = key16(raw.x >> 16, (kb) + 1), R##2 = key16(raw.y & 0xffffu, (kb) + 2), R##3 = key16(raw.y >> 16, (kb) + 3), \
        R##4 = key16(raw.z & 0xffffu, (kb) + 4), R##5 = key16(raw.z >> 16, (kb) + 5), R##6 = key16(raw.w & 0xffffu, (kb) + 6), R##7 = key16(raw.w >> 16, (kb) + 7)
#define TK_SORT8(R) do { CEX(R##0, R##1); CEX(R##2, R##3); CEX(R##4, R##5); CEX(R##6, R##7); CEX(R##0, R##2); CEX(R##1, R##3); CEX(R##4, R##6); CEX(R##5, R##7); CEX(R##1, R##2); CEX(R##5, R##6); \
        CEX(R##0, R##4); CEX(R##1, R##5); CEX(R##2, R##6); CEX(R##3, R##7); CEX(R##2, R##4); CEX(R##3, R##5); CEX(R##1, R##2); CEX(R##3, R##4); CEX(R##5, R##6); } while (0)
#define TK_POP8(R, KEEP, it) do { const unsigned m_ = rowmax16u(R##0); const bool w_ = R##0 == m_; R##0 = w_ ? R##1 : R##0; R##1 = w_ ? R##2 : R##1; R##2 = w_ ? R##3 : R##2; R##3 = w_ ? R##4 : R##3; \
        R##4 = w_ ? R##5 : R##4; R##5 = w_ ? R##6 : R##5; R##6 = w_ ? R##7 : R##6; R##7 = w_ ? 0u : R##7; KEEP = (k == (it)) ? m_ : KEEP; } while (0)
#define TK_POP4(C, KEEP, it) do { const unsigned m_ = rowmax16u(C[0]); const bool w_ = C[0] == m_; C[0] = w_ ? C[1] : C[0]; C[1] = w_ ? C[2] : C[1]; C[2] = w_ ? C[3] : C[2]; C[3] = w_ ? 0u : C[3]; KEEP = (k == (it)) ? m_ : KEEP; } while (0)
__device__ __forceinline__ void topk_token(const v4u (&rawv)[4], unsigned* TL, int lane, const unsigned ctabp, int* oute, float* outg) {
    const int k = lane & 15, row = lane >> 4;
#pragma unroll
    for (int pp = 0; pp < 2; ++pp) {
        const v4u rawa = rawv[2 * pp], rawb = rawv[2 * pp + 1];
        TK_KEYS(a, rawa, k * 8); TK_KEYS(b, rawb, k * 8);
        TK_SORT8(a); TK_SORT8(b);
        unsigned keepa = 0, keepb = 0;
#pragma unroll
        for (int it = 0; it < 16; ++it) { TK_POP8(a, keepa, it); TK_POP8(b, keepb, it); }
        TL[((2 * pp) * 4 + row) * 16 + k] = keepa; TL[((2 * pp + 1) * 4 + row) * 16 + k] = keepb;
    }
    unsigned ca[4], cb[4];
    const unsigned* LAa = TL + (2 * row) * 16; const unsigned* LBa = TL + (2 * row + 1) * 16;
    const unsigned* LAb = TL + (2 * (4 + row)) * 16; const unsigned* LBb = TL + (2 * (4 + row) + 1) * 16;
#pragma unroll
    for (int s = 0; s < 4; ++s) { const int ij = (int)((ctabp >> (8 * s)) & 0xffu); const bool valid = ij != 255; const int i = (ij >> 4) & 15, j = ij & 15;
        const float sa = keyval16(LAa[i]) + keyval16(LBa[j]), sb = keyval16(LAb[i]) + keyval16(LBb[j]);
        ca[s] = valid ? ((sortable32(sa) & 0xffffff00u) | (unsigned)(i * 16 + j)) : 0u; cb[s] = valid ? ((sortable32(sb) & 0xffffff00u) | (unsigned)(i * 16 + j)) : 0u; }
    CEX(ca[0], ca[1]); CEX(ca[2], ca[3]); CEX(ca[0], ca[2]); CEX(ca[1], ca[3]); CEX(ca[1], ca[2]);
    CEX(cb[0], cb[1]); CEX(cb[2], cb[3]); CEX(cb[0], cb[2]); CEX(cb[1], cb[3]); CEX(cb[1], cb[2]);
    unsigned keepa = 0, keepb = 0;
#pragma unroll
    for (int it = 0; it < 16; ++it) { TK_POP4(ca, keepa, it); TK_POP4(cb, keepb, it); }
    {
        const unsigned kaa = LAa[(keepa >> 4) & 15], kba = LBa[keepa & 15], kab = LAb[(keepb >> 4) & 15], kbb = LBb[keepb & 15];
        const float bva = keyval16(kaa) + keyval16(kba), bvb = keyval16(kab) + keyval16(kbb);
        const float mxa = rowmax16f(bva), mxb = rowmax16f(bvb); const float exa = __expf(bva - mxa), exb = __expf(bvb - mxb); const float sma = rowsum16f(exa), smb = rowsum16f(exb);
        oute[lane] = (int)((kaa & 127u) * 128u + (kba & 127u)); outg[lane] = exa / sma;
        oute[64 + lane] = (int)((kab & 127u) * 128u + (kbb & 127u)); outg[64 + lane] = exb / smb;
    }
}
#undef TK_KEYS
#undef TK_SORT8
#undef TK_POP8
#undef TK_POP4

__device__ __forceinline__ void gl16x4(v4u (&r)[4], unsigned voff, const unsigned char* b0, const unsigned char* b1, const unsigned char* b2, const unsigned char* b3) {
    asm volatile("s_nop 4\n\tglobal_load_dwordx4 %0, %4, %5\n\tglobal_load_dwordx4 %1, %4, %6\n\tglobal_load_dwordx4 %2, %4, %7\n\tglobal_load_dwordx4 %3, %4, %8"
                 : "=&v"(r[0]), "=&v"(r[1]), "=&v"(r[2]), "=&v"(r[3]) : "v"(voff), "s"(b0), "s"(b1), "s"(b2), "s"(b3) : "memory");
}
#define P7_VMWAIT(N, R) asm volatile("s_waitcnt vmcnt(" #N ")" : "+v"(R[0]), "+v"(R[1]), "+v"(R[2]), "+v"(R[3]) :: "memory")
__device__ __forceinline__ int mbcnt64(unsigned long long m) { return (int)__builtin_amdgcn_mbcnt_hi((unsigned)(m >> 32), __builtin_amdgcn_mbcnt_lo((unsigned)m, 0u)); }
__device__ __forceinline__ int rfl(int v) { return __builtin_amdgcn_readfirstlane(v); }
__device__ __forceinline__ float rflf(float v) { return __builtin_bit_cast(float, __builtin_amdgcn_readfirstlane(__builtin_bit_cast(int, v))); }

__device__ __forceinline__ void p7_phase(Frame& F, bool dry) {
    const int lane0 = F.lane, wave = F.wave;
    if (dry && (MK_DRY_SKIP & 16) && wave >= 4) return;
    unsigned char* wl = F.lds + wave * P7_WL;
    unsigned* TL = (unsigned*)(wl + P7_TL); int* TE = (int*)(wl + P7_TE); float* TG = (float*)(wl + P7_TG);
    float* LG = (float*)(wl + P7_LG); float* LSU = (float*)(wl + P7_LSU); unsigned char* H2Q = wl + P7_H2Q; float* HST = (float*)(wl + P7_HST);
    const bf16* SC = (const bf16*)(F.ws + WS_SC); const bf16* H2 = (const bf16*)(F.ws + WS_H);
    const unsigned char* U8 = F.ws + WS_U; const unsigned char* V8 = F.ws + WS_V;
    const float* SU = (const float*)(F.ws + WS_SU); const float* SV = (const float*)(F.ws + WS_SV);
    const float* mods = (const float*)(F.ws + WS_MODS); const float* SSP = (const float*)(F.ws + WS_SSP);
    unsigned ctabp = 0;
#pragma unroll
    for (int s = 0; s < 4; ++s) { const int c = 16 * s + (lane0 & 15); int i, j;
        if (c < 16) { i = 0; j = c; } else if (c < 24) { i = 1; j = c - 16; } else if (c < 29) { i = 2; j = c - 24; } else if (c < 33) { i = 3; j = c - 29; } else if (c < 36) { i = 4; j = c - 33; }
        else if (c < 38) { i = 5; j = c - 36; } else if (c < 40) { i = 6; j = c - 38; } else if (c < 42) { i = 7; j = c - 40; } else if (c < 50) { i = c - 34; j = 0; } else { i = -1; j = 0; }
        ctabp |= (unsigned)(i < 0 ? 255 : i * 16 + j) << (8 * s); }
    const int ntg = NTOK / (F.G * NWAVES * 4);
#pragma unroll 1
    for (int tg = 0; tg < ntg; ++tg) {
        const int tok0 = (F.vcu * ntg + tg) * (NWAVES * 4) + wave * 4;
        int lane = F.lane; asm volatile("" : "+v"(lane));
        {
            v4u craw[4], nraw[4]; v4u ch0, ch1, nh0, nh1;
#define P7_TLOAD(R, H0, H1, tk) do { const bf16* sp_ = SC + (size_t)(tk) * 2048 + (lane >> 4) * 128 + (lane & 15) * 8; \
                _Pragma("unroll") for (int ps = 0; ps < 4; ++ps) R[ps] = *(const v4u*)(sp_ + ps * 512); \
                H0 = *(const v4u*)(H2 + (size_t)(tk) * DM + 16 * lane); H1 = *(const v4u*)(H2 + (size_t)(tk) * DM + 16 * lane + 8); } while (0)
            P7_TLOAD(craw, ch0, ch1, tok0);
#pragma unroll 1
            for (int s = 0; s < 4; ++s) {
                if (s < 3) P7_TLOAD(nraw, nh0, nh1, tok0 + s + 1);
                const int tokc = tok0 + s;
                const f32x4* spp = (const f32x4*)(SSP + (size_t)tokc * 16); const f32x4 q0 = spp[0], q1 = spp[1], q2 = spp[2], q3 = spp[3];
                const float* shp = mods + (size_t)mod_index(tokc) * MODW + 3 * DM + 16 * lane;
                const f32x4 sh0 = *(const f32x4*)(shp), sh1 = *(const f32x4*)(shp + 4), sh2v = *(const f32x4*)(shp + 8), sh3 = *(const f32x4*)(shp + 12);
                unsigned ctab_ = ctabp; asm volatile("" : "+v"(ctab_));
                topk_token(craw, TL, lane, ctab_, TE + s * 128, TG + s * 128);
                const v4u a = ch0, b = ch1;
                const float ssr = ((q0[0] + q0[1]) + (q0[2] + q0[3])) + ((q1[0] + q1[1]) + (q1[2] + q1[3])) + ((q2[0] + q2[1]) + (q2[2] + q2[3])) + ((q3[0] + q3[1]) + (q3[2] + q3[3]));
                const float rstd = 1.f / sqrtf(ssr * (1.f / DM) + EPS);
                float hv[16];
                hv[0] = bflo(a.x); hv[1] = bfhi(a.x); hv[2] = bflo(a.y); hv[3] = bfhi(a.y); hv[4] = bflo(a.z); hv[5] = bfhi(a.z); hv[6] = bflo(a.w); hv[7] = bfhi(a.w);
                hv[8] = bflo(b.x); hv[9] = bfhi(b.x); hv[10] = bflo(b.y); hv[11] = bfhi(b.y); hv[12] = bflo(b.z); hv[13] = bfhi(b.z); hv[14] = bflo(b.w); hv[15] = bfhi(b.w);
#pragma unroll
                for (int i = 0; i < 4; ++i) { hv[i] = hv[i] * rstd + sh0[i]; hv[4 + i] = hv[4 + i] * rstd + sh1[i]; hv[8 + i] = hv[8 + i] * rstd + sh2v[i]; hv[12 + i] = hv[12 + i] * rstd + sh3[i]; }
                float am = 0.f;
#pragma unroll
                for (int i = 0; i < 16; ++i) am = fmaxf(am, fabsf(hv[i]));
                am = wave_max(am);
                const float inv = am > 0.f ? 127.f / am : 0.f;
                if (lane == 0) HST[s] = am * (1.f / 127.f);
                v4u qv;
#pragma unroll
                for (int j = 0; j < 4; ++j) { unsigned w = 0;
#pragma unroll
                    for (int i = 0; i < 4; ++i) { int q = (int)rintf(hv[4 * j + i] * inv); w |= ((unsigned)q & 0xffu) << (8 * i); }
                    qv[j] = w; }
                *(v4u*)(H2Q + s * 1024 + 16 * lane) = qv;
#pragma unroll
                for (int ps = 0; ps < 4; ++ps) craw[ps] = nraw[ps];
                ch0 = nh0; ch1 = nh1;
            }
#undef P7_TLOAD
        }
        {
            unsigned* LEO = (unsigned*)(wl + P7_LE);
            int ee0[4], ee1[4]; float gg0[4], gg1[4], us0[4], us1[4], vs0[4], vs1[4];
#pragma unroll
            for (int s = 0; s < 4; ++s) { ee0[s] = TE[s * 128 + lane]; ee1[s] = TE[s * 128 + 64 + lane]; gg0[s] = TG[s * 128 + lane]; gg1[s] = TG[s * 128 + 64 + lane]; }
#pragma unroll
            for (int s = 0; s < 4; ++s) { us0[s] = SU[ee0[s]]; us1[s] = SU[ee1[s]]; vs0[s] = SV[ee0[s]]; vs1[s] = SV[ee1[s]]; }
#pragma unroll
            for (int s = 0; s < 4; ++s) { const int e0 = ee0[s], e1 = ee1[s]; const int c0 = e0 >> P7_CSH, c1 = e1 >> P7_CSH; int base = s * 128;
#pragma unroll
                for (int c = 0; c < P7_NCH; ++c) {
                    const unsigned long long m0 = __ballot(c0 == c), m1 = __ballot(c1 == c);
                    const int n0 = __popcll(m0), n = n0 + __popcll(m1);
                    if (c0 == c) { const int p = base + mbcnt64(m0); LEO[p] = (unsigned)e0 << 10; LG[p] = gg0[s] * vs0[s]; LSU[p] = us0[s]; }
                    if (c1 == c) { const int p = base + n0 + mbcnt64(m1); LEO[p] = (unsigned)e1 << 10; LG[p] = gg1[s] * vs1[s]; LSU[p] = us1[s]; }
                    base += n;
                } }
        }
        typedef __attribute__((address_space(1))) v4u GV4;
#define P7_SLOAD(R, t, BASE) do { const v4u eo_ = *(const v4u*)(LEOs + 4 * (t)); \
            _Pragma("unroll") for (int r = 0; r < 4; ++r) { unsigned o_ = eo_[r] + j16; asm volatile("" : "+v"(o_)); \
                _Pragma("unroll") for (int i = 0; i < 4; ++i) R[r][i] = *(const GV4*)(BASE + o_ + 256 * i); } \
            __builtin_amdgcn_sched_barrier(0); } while (0)
        if (!(dry && (MK_DRY_SKIP & 1))) {
            int lane_u = F.lane; asm volatile("" : "+v"(lane_u));
            const int su = lane_u >> 4, ju = lane_u & 15; const unsigned j16 = 16u * (unsigned)ju;
            const unsigned* LEOs = (const unsigned*)(wl + P7_LE) + su * 128; float* LGs = LG + su * 128; const float* LSUs = LSU + su * 128;
            const unsigned long long u8i = (unsigned long long)U8;
            v4u hq[4];
#pragma unroll
            for (int i = 0; i < 4; ++i) hq[i] = *(const v4u*)(H2Q + su * 1024 + 256 * i + 16 * ju);
            const float hs = HST[su];
            const bool b0 = (ju & 1) != 0, b1 = (ju & 2) != 0; const int rr = ju & 3;
            v4u A[4][4], B[4][4];
#define P7_SCOMP_U(R, t) do { const float su_ = LSUs[4 * (t) + rr], g_ = LGs[4 * (t) + rr]; int p_[4]; \
                _Pragma("unroll") for (int r = 0; r < 4; ++r) { int a0 = 0, a1 = 0; \
                    _Pragma("unroll") for (int i = 0; i < 4; ++i) { a0 = __builtin_amdgcn_sdot4((int)hq[i].x, (int)R[r][i].x, a0, false); a1 = __builtin_amdgcn_sdot4((int)hq[i].y, (int)R[r][i].y, a1, false); \
                                                                   a0 = __builtin_amdgcn_sdot4((int)hq[i].z, (int)R[r][i].z, a0, false); a1 = __builtin_amdgcn_sdot4((int)hq[i].w, (int)R[r][i].w, a1, false); } \
                    p_[r] = a0 + a1; } \
                const int q01 = (b0 ? p_[1] : p_[0]) + (int)dppu<0xB1>((unsigned)(b0 ? p_[0] : p_[1])); const int q23 = (b0 ? p_[3] : p_[2]) + (int)dppu<0xB1>((unsigned)(b0 ? p_[2] : p_[3])); \
                int q_ = (b1 ? q23 : q01) + (int)dppu<0x4E>((unsigned)(b1 ? q01 : q23)); q_ += (int)dppu<0x128>((unsigned)q_); q_ += (int)dppu<0x124>((unsigned)q_); \
                const float dotf = (float)q_ * (hs * su_); LGs[4 * (t) + rr] = g_ * gelu_fast(dotf); } while (0)
            P7_SLOAD(A, 0, u8i);
#pragma unroll 1
            for (int t = 0; t < 32; t += 2) {
                P7_SLOAD(B, t + 1, u8i);
                P7_SCOMP_U(A, t);
                P7_SLOAD(A, (t + 2) & 31, u8i);
                P7_SCOMP_U(B, t + 1);
                asm volatile("" ::: "memory");
            }
#undef P7_SCOMP_U
        }
        float cscale;
        {
            int lane_q = F.lane; asm volatile("" : "+v"(lane_q));
            const int sq = lane_q >> 4, jq = lane_q & 15;
            const float* lg = LG + sq * 128 + 8 * jq; const f32x4 c0 = *(const f32x4*)lg, c1 = *(const f32x4*)(lg + 4);
            float m = fmaxf(fmaxf(fmaxf(fabsf(c0[0]), fabsf(c0[1])), fmaxf(fabsf(c0[2]), fabsf(c0[3]))), fmaxf(fmaxf(fabsf(c1[0]), fabsf(c1[1])), fmaxf(fabsf(c1[2]), fabsf(c1[3]))));
            m = rowmax16f(m);
            cscale = m * (1.f / 127.f); const float iv = m > 0.f ? 127.f / m : 0.f;
            v2u w; w.x = 0u; w.y = 0u;
#pragma unroll
            for (int k = 0; k < 4; ++k) { w.x |= ((unsigned)(int)rintf(c0[k] * iv) & 0xffu) << (8 * k); w.y |= ((unsigned)(int)rintf(c1[k] * iv) & 0xffu) << (8 * k); }
            *(v2u*)(wl + P7_LQ + (sq * 32 + 2 * jq) * 4) = w;
        }
        int acc[64];
#pragma unroll
        for (int i = 0; i < 64; ++i) acc[i] = 0;
        if (!(dry && (MK_DRY_SKIP & 2))) {
            int lane_v = F.lane; asm volatile("" : "+v"(lane_v));
            const int sv_ = lane_v >> 4, jv = lane_v & 15; const unsigned j16 = 16u * (unsigned)jv;
            const unsigned* LEOs = (const unsigned*)(wl + P7_LE) + sv_ * 128; const int* LQs = (const int*)(wl + P7_LQ) + sv_ * 32;
            const unsigned long long v8i = (unsigned long long)V8;
            v4u A[4][4], B[4][4];
#define P7_SCOMP_V(R, t) do { const int cq_ = LQs[(t)]; \
                _Pragma("unroll") for (int i = 0; i < 4; ++i) { _Pragma("unroll") for (int w = 0; w < 4; ++w) { \
                    const unsigned x_ = __builtin_amdgcn_perm(R[1][i][w], R[0][i][w], 0x05010400u), y_ = __builtin_amdgcn_perm(R[1][i][w], R[0][i][w], 0x07030602u); \
                    const unsigned c_ = __builtin_amdgcn_perm(R[3][i][w], R[2][i][w], 0x05010400u), e_ = __builtin_amdgcn_perm(R[3][i][w], R[2][i][w], 0x07030602u); \
                    const int k0 = (int)__builtin_amdgcn_perm(c_, x_, 0x05040100u), k1 = (int)__builtin_amdgcn_perm(c_, x_, 0x07060302u), k2 = (int)__builtin_amdgcn_perm(e_, y_, 0x05040100u), k3 = (int)__builtin_amdgcn_perm(e_, y_, 0x07060302u); \
                    acc[16 * i + 4 * w + 0] = __builtin_amdgcn_sdot4(k0, cq_, acc[16 * i + 4 * w + 0], false); acc[16 * i + 4 * w + 1] = __builtin_amdgcn_sdot4(k1, cq_, acc[16 * i + 4 * w + 1], false); \
                    acc[16 * i + 4 * w + 2] = __builtin_amdgcn_sdot4(k2, cq_, acc[16 * i + 4 * w + 2], false); acc[16 * i + 4 * w + 3] = __builtin_amdgcn_sdot4(k3, cq_, acc[16 * i + 4 * w + 3], false); } } } while (0)
            P7_SLOAD(A, 0, v8i);
#pragma unroll 1
            for (int t = 0; t < 32; t += 2) {
                P7_SLOAD(B, t + 1, v8i);
                P7_SCOMP_V(A, t);
                P7_SLOAD(A, (t + 2) & 31, v8i);
                P7_SCOMP_V(B, t + 1);
                asm volatile("" ::: "memory");
            }
#undef P7_SCOMP_V
        }
#undef P7_SLOAD
        {
            int lane_f = F.lane; asm volatile("" : "+v"(lane_f));
            const int sf = lane_f >> 4, jf = lane_f & 15; const int tok = tok0 + sf;
            const float* xrow = F.out + O_Y + (size_t)tok * DM + 16 * jf;
            const float* ga2 = mods + (size_t)mod_index(tok0) * MODW + 5 * DM + 16 * jf;
            const float* gf = F.in[I_GFINAL] + 16 * jf;
            float* yrow = dry ? (float*)(F.ws + WS_MIX) + (size_t)(tok & 8191) * DM + 16 * jf : F.out + O_Y + (size_t)tok * DM + 16 * jf;
            float xs[64]; float ss = 0.f;
#pragma unroll
            for (int i = 0; i < 4; ++i) { f32x4 xv[4], gv[4];
#pragma unroll
                for (int w = 0; w < 4; ++w) { xv[w] = *(const f32x4*)(xrow + 256 * i + 4 * w); gv[w] = *(const f32x4*)(ga2 + 256 * i + 4 * w); }
#pragma unroll
                for (int w = 0; w < 4; ++w)
#pragma unroll
                    for (int k = 0; k < 4; ++k) { const float t = xv[w][k] + gv[w][k] * ((float)acc[16 * i + 4 * w + k] * cscale); xs[16 * i + 4 * w + k] = t; ss += t * t; } }
            const float rstd = 1.f / sqrtf(rowsum16f(ss) * (1.f / DM) + EPS);
#pragma unroll
            for (int i = 0; i < 4; ++i) { f32x4 gfv[4];
#pragma unroll
                for (int w = 0; w < 4; ++w) gfv[w] = *(const f32x4*)(gf + 256 * i + 4 * w);
#pragma unroll
                for (int w = 0; w < 4; ++w) { f32x4 o;
#pragma unroll
                    for (int k = 0; k < 4; ++k) o[k] = xs[16 * i + 4 * w + k] * rstd * gfv[w][k];
                    *(f32x4*)(yrow + 256 * i + 4 * w) = o; } }
        }
    }
}

__global__ void __launch_bounds__(NWAVES * 64, 2) mk_fwd(Args args) {
    extern __shared__ __attribute__((aligned(16))) unsigned char lds[];
    Frame F;
    F.lds = lds;
    F.tid = threadIdx.x; F.lane = F.tid & 63; F.wave = __builtin_amdgcn_readfirstlane(F.tid >> 6);
    F.G = gridDim.x; { const int bx = blockIdx.x; F.vcu = (F.G % 8 == 0) ? (bx % 8) * (F.G / 8) + bx / 8 : bx; }
    F.in = args.in; F.out = args.out; F.ws = args.ws;
    LAS unsigned char* lds3 = (LAS unsigned char*)lds;
    volatile LAS unsigned* MISC = (volatile LAS unsigned*)(lds3 + MISC_OFF);
    for (int u = F.tid; u < (LDS_BYTES - LDSCTL_OFF) / 4; u += NWAVES * 64) ((LAS unsigned*)(lds3 + LDSCTL_OFF))[u] = 0u;
    __syncthreads();
    unsigned* ctl = (unsigned*)(args.ws + WS_CTL);
    XcdBarrier bar; bar.bar = ctl + CW_BAR; bar.x = 0; bar.st = nullptr;
    const bool one_launch = (args.ph_hi - args.ph_lo) > 1;
    if (one_launch) bar = xcd_barrier_post(ctl + CW_BAR, MISC + 8);
    const int lo = args.ph_lo, hi = args.ph_hi;
#ifndef MK_PHASE_MASK
#define MK_PHASE_MASK 0xff
#endif
#define IN(k) (((MK_PHASE_MASK >> (k)) & 1) && lo <= (k) && (k) < hi)
#define SEAM(k) do { if (IN(k) && IN((k) + 1)) xcd_barrier(bar); } while (0)

#define DUPQ(k) (MK_DUP == (k))
    if (IN(0)) { if (DUPQ(0)) { p0_phase(F); xcd_barrier(bar); } p0_phase(F); SEAM(0); }
    if (IN(1)) { if (DUPQ(1)) { norm_phase(F, 0); xcd_barrier(bar); } norm_phase(F, 0); bias_items(F); SEAM(1); }
    if (IN(2)) {
        pg8::Gemm g{(const pg8::bf16_t*)(F.ws + WS_H), (const pg8::bf16_t*)(F.ws + WS_WIN), NTOK, D_IN, DM}; pg8::StaticOrder S; S.init(NTOK, D_IN, F.G, (int)blockIdx.x);
        EpiInProj E{(bf16*)(F.ws + WS_Q), (bf16*)(F.ws + WS_K), (bf16*)(F.ws + WS_VT), (bf16*)(F.ws + WS_XR), (bf16*)(F.ws + WS_YG), F.out + O_NEWK, F.out + O_NEWV, (const f32x4*)(F.ws + WS_ROPE)};
        if (DUPQ(2)) { pg8::gemm_phase<EpiInProj, pg8::StaticOrder, true, true>(lds3, g, S, E); xcd_barrier(bar); }
        pg8::gemm_phase<EpiInProj, pg8::StaticOrder, true, true>(lds3, g, S, E);
        SEAM(2);
    }
    if (IN(3)) { if (DUPQ(3)) { p3_phase(F, MK_P3_TYPES); xcd_barrier(bar); } p3_phase(F); SEAM(3); }
    if (IN(4)) {
        pg8::Gemm g{(const pg8::bf16_t*)(F.ws + WS_MIX), (const pg8::bf16_t*)(F.ws + WS_WOUT), NTOK, DM, DM}; pg8::StaticOrder S; S.init(NTOK, DM, F.G, (int)blockIdx.x);
        EpiOutProj E{F.in[I_XP], F.in[I_XS], (const float*)(F.ws + WS_MODS), F.in[I_GFFN], F.out + O_Y, (bf16*)(F.ws + WS_H), (float*)(F.ws + WS_SSP)};
        if (DUPQ(4)) { pg8::gemm_phase<EpiOutProj, pg8::StaticOrder, true, true>(lds3, g, S, E); xcd_barrier(bar); }
        pg8::gemm_phase<EpiOutProj, pg8::StaticOrder, true, true>(lds3, g, S, E);
        SEAM(4);
    }
    if (IN(6)) {
        pg8::Gemm g{(const pg8::bf16_t*)(F.ws + WS_H), (const pg8::bf16_t*)(F.ws + WS_WC), NTOK, 2048, DM}; pg8::StaticOrder S; S.init(NTOK, 2048, F.G, (int)blockIdx.x);
        EpiScores E{(bf16*)(F.ws + WS_SC), (const float*)(F.ws + WS_SSP), (const float*)(F.ws + WS_BIAS)};
        if (DUPQ(6)) { pg8::gemm_phase<EpiScores, pg8::StaticOrder, true, true>(lds3, g, S, E); xcd_barrier(bar); }
        pg8::gemm_phase<EpiScores, pg8::StaticOrder, true, true>(lds3, g, S, E);
        SEAM(6);
    }
    if (IN(7)) { if (DUPQ(7)) { p7_phase(F, true); xcd_barrier(bar); } p7_phase(F, false); }
#undef IN
#undef SEAM
}

extern "C" void kernel_launch(void* const* d_in, const int* in_sizes, int n_in, void* d_out, int out_size, void* d_ws, size_t ws_size, hipStream_t stream) {
    static int grid = 0;
    if (grid == 0) {
        if (n_in != 26 || ws_size < WS_END) { fprintf(stderr, "kernel_launch: unexpected n_in %d / ws %zu\n", n_in, ws_size); grid = -1; return; }
        int dev = 0, cus = 0, per_cu = 0;
        if (hipGetDevice(&dev) != hipSuccess || hipDeviceGetAttribute(&cus, hipDeviceAttributeMultiprocessorCount, dev) != hipSuccess) { grid = -1; return; }
        if (hipFuncSetAttribute((const void*)mk_fwd, hipFuncAttributeMaxDynamicSharedMemorySize, LDS_BYTES) != hipSuccess) { fprintf(stderr, "kernel_launch: hipFuncSetAttribute failed\n"); grid = -1; return; }
        if (hipOccupancyMaxActiveBlocksPerMultiprocessor(&per_cu, (const void*)mk_fwd, NWAVES * 64, LDS_BYTES) != hipSuccess || per_cu < 1)
            fprintf(stderr, "kernel_launch: occupancy query reports %d blocks per CU\n", per_cu);
        (void)hipGetLastError();
        grid = cus;
        if (grid != 256) fprintf(stderr, "kernel_launch: note: %d CUs\n", grid);
    }
    if (grid < 0) return;
    (void)hipMemsetAsync((char*)d_ws + WS_CTL, 0, CTL_ZERO_BYTES, stream);
    Args a{};
    for (int i = 0; i < 26; ++i) a.in[i] = (const float*)d_in[i];
    a.out = (float*)d_out; a.ws = (unsigned char*)d_ws;
    if (MK_N_LAUNCHES == 1) {
        a.ph_lo = 0; a.ph_hi = N_PHASES; a.li = 0;
        hipLaunchKernelGGL(mk_fwd, dim3(grid), dim3(NWAVES * 64), LDS_BYTES, stream, a);
    } else {
        for (int li = 0; li < N_PHASES; ++li) { a.ph_lo = li; a.ph_hi = li + 1; a.li = li;
            hipLaunchKernelGGL(mk_fwd, dim3(grid), dim3(NWAVES * 64), LDS_BYTES, stream, a); }
    }
}
```

```cpp
#include <hip/hip_runtime.h>
#include <cstdio>
#include <cstdint>

#ifndef MK_DUP
#define MK_DUP -1
#endif
#ifndef MK_DRY_SKIP
#define MK_DRY_SKIP 0
#endif
#ifndef MK_N_LAUNCHES
#define MK_N_LAUNCHES 1
#endif

namespace pg8 {
#define PG8_LAS __attribute__((address_space(3)))
typedef unsigned short bf16_t;
typedef short bf16x8 __attribute__((ext_vector_type(8)));
typedef float f32x4 __attribute__((ext_vector_type(4)));
typedef unsigned u32x4 __attribute__((ext_vector_type(4)));
typedef unsigned u32x2 __attribute__((ext_vector_type(2)));
constexpr int BM = 256, BK = 64, HALF = 128, HTB = HALF * BK * 2, STAGE_BYTES = 8 * HTB, NXCD = 8, WGM = 8;

__host__ __device__ __forceinline__ int lds_byte(int r, int c) { const int st = (r >> 4) * 2 + (c >> 5), rr = r & 15, cc = c & 31, ob = rr * 64 + cc * 2; return st * 1024 + (ob ^ (((ob >> 9) & 1) << 5)); }
__host__ __device__ __forceinline__ void stage_rc(int b, int& R, int& C) { const int st = b / 1024, sb = b % 1024, swz = sb ^ (((sb >> 9) & 1) << 5); R = (st >> 1) * 16 + swz / 64; C = (st & 1) * 32 + (swz % 64) / 2; }
__host__ __device__ __forceinline__ int perm32(int rho) { const int n = rho >> 4, i = rho & 15; return 8 * (i >> 2) + 4 * n + (i & 3); }

struct Unit { int pm, pn; };
struct Gemm { const bf16_t* A; const bf16_t* Bt; int M, N, K; };

struct StaticOrder {
    int nM, nN, nwg, G, c;
    __host__ __device__ void init(int M, int N, int G_, int c_) { nM = M / BM; nN = N / BM; nwg = nM * nN; G = G_; c = c_; }
    __host__ __device__ bool next(int i, Unit& u) const {
        const long L = (long)i * G + c; if (L >= nwg) return false;
        int wgid = (int)L; { const int q = nwg / NXCD, r = nwg % NXCD, xcd = wgid % NXCD, off = wgid / NXCD; wgid = (xcd < r ? xcd * (q + 1) : r * (q + 1) + (xcd - r) * q) + off; }
        const int nig = WGM * nN, gid = wgid / nig, fm = gid * WGM, gsz = (nM - fm) < WGM ? (nM - fm) : WGM;
        u.pm = fm + ((wgid % nig) % gsz); u.pn = (wgid % nig) / gsz; return true;
    }
    __device__ __forceinline__ void a_ready(const Unit&) const {}
    __device__ __forceinline__ void done(const Unit&) const {}
};

__device__ __forceinline__ unsigned cvt_pk_bf16(float lo, float hi) { unsigned r; asm volatile("v_cvt_pk_bf16_f32 %0, %1, %2" : "=v"(r) : "v"(lo), "v"(hi)); return r; }

template <class Epi, class Sched, bool ALIGN_EPI = false, bool SP2 = false>
__device__ __forceinline__ void gemm_phase(PG8_LAS unsigned char* lds, const Gemm g, const Sched& S, const Epi& E) {
    const int tid = threadIdx.x, wid = __builtin_amdgcn_readfirstlane(tid >> 6), lane = tid & 63, wr = wid >> 2, wc = wid & 3, fr = lane & 15, fq = lane >> 4;
    const int K = g.K, nt = K / BK;
    unsigned voffA[2], voffB[2];
#pragma unroll
    for (int i = 0; i < 2; ++i) { int R, C; stage_rc(tid * 16 + i * 8192, R, C); const int Rb = Epi::PERM ? ((R & ~31) + perm32(R & 31)) : R;
        voffA[i] = (unsigned)(R * K + C) * 2u; voffB[i] = (unsigned)(Rb * K + C) * 2u; }
    const size_t kstep = (size_t)(BK * 2);
    const size_t hstep = (size_t)HALF * K * 2;
    const size_t tstep = 2 * hstep;
    const unsigned ldsw = (unsigned)wid * 1024u;
    const int aoff = lds_byte(wr * 64 + fr, fq * 8), boff = lds_byte(wc * 32 + fr, fq * 8);
#define PG8_SA(b, h) (((b) * 2 + (h)) * HTB)
#define PG8_SB(b, h) ((4 + (b) * 2 + (h)) * HTB)
#define PG8_STAGE(bufoff, gbase, voff) do { _Pragma("unroll") for (int _i = 0; _i < 2; ++_i) \
        __builtin_amdgcn_global_load_lds((const unsigned*)((const char*)(gbase) + (voff)[_i]), (PG8_LAS unsigned*)(lds + (bufoff) + ldsw + _i * 8192), 16, 0, 0); } while (0)
#define PG8_LDA(dst, b, h) do { _Pragma("unroll") for (int m = 0; m < 4; ++m) _Pragma("unroll") for (int k = 0; k < 2; ++k) dst[m][k] = *(const PG8_LAS bf16x8*)(lds + PG8_SA(b, h) + aoff + m * 2048 + k * 1024); } while (0)
#define PG8_LDB(dst, b, h) do { _Pragma("unroll") for (int n = 0; n < 2; ++n) _Pragma("unroll") for (int k = 0; k < 2; ++k) dst[n][k] = *(const PG8_LAS bf16x8*)(lds + PG8_SB(b, h) + boff + n * 2048 + k * 1024); } while (0)
#define PG8_MMA(ai, bj, At, Bt) do { __builtin_amdgcn_s_setprio(1); _Pragma("unroll") for (int m = 0; m < 4; ++m) _Pragma("unroll") for (int n = 0; n < 2; ++n) _Pragma("unroll") for (int k = 0; k < 2; ++k) \
        acc[ai][bj][m][n] = __builtin_amdgcn_mfma_f32_16x16x32_bf16(Bt[n][k], At[m][k], acc[ai][bj][m][n], 0, 0, 0); __builtin_amdgcn_s_setprio(0); } while (0)
#define PG8_WAIT_V(n) asm volatile("s_waitcnt vmcnt(" #n ")" ::: "memory")
#define PG8_WAIT_L(n) asm volatile("s_waitcnt lgkmcnt(" #n ")" ::: "memory")
#define PG8_BAR __builtin_amdgcn_s_barrier()
#define PG8_SCHED __builtin_amdgcn_sched_barrier(0)
    Unit cur, nxt; int ui = 0;
    if (!S.next(0, cur)) return;
    f32x4 acc[2][2][4][2];
#pragma unroll
    for (int a = 0; a < 2; ++a)
#pragma unroll
        for (int b = 0; b < 2; ++b)
#pragma unroll
            for (int m = 0; m < 4; ++m)
#pragma unroll
                for (int n = 0; n < 2; ++n) acc[a][b][m][n] = (f32x4){0.f, 0.f, 0.f, 0.f};
    bf16x8 At[4][2], B0[2][2], B1[2][2];
    const char* cA = (const char*)g.A + (size_t)cur.pm * tstep; const char* cB = (const char*)g.Bt + (size_t)cur.pn * tstep;
    S.a_ready(cur);
    if constexpr (SP2) {
        PG8_STAGE(PG8_SB(0, 0), cB, voffB); PG8_STAGE(PG8_SB(0, 1), cB + hstep, voffB); PG8_STAGE(PG8_SA(0, 0), cA, voffA); PG8_STAGE(PG8_SA(0, 1), cA + hstep, voffA);
        if (wr == 1) PG8_BAR;
        PG8_WAIT_V(2); PG8_BAR;
        PG8_STAGE(PG8_SB(1, 0), cB + kstep, voffB); PG8_STAGE(PG8_SA(1, 0), cA + kstep, voffA); PG8_STAGE(PG8_SB(1, 1), cB + hstep + kstep, voffB);
        PG8_WAIT_V(6); PG8_BAR;
    } else {
        PG8_STAGE(PG8_SB(0, 0), cB, voffB); PG8_STAGE(PG8_SA(0, 0), cA, voffA); PG8_STAGE(PG8_SB(0, 1), cB + hstep, voffB); PG8_STAGE(PG8_SA(0, 1), cA + hstep, voffA);
        if (wr == 1) PG8_BAR;
        PG8_WAIT_V(4); PG8_BAR;
        PG8_STAGE(PG8_SB(1, 0), cB + kstep, voffB); PG8_STAGE(PG8_SA(1, 0), cA + kstep, voffA); PG8_STAGE(PG8_SB(1, 1), cB + hstep + kstep, voffB);
        PG8_WAIT_V(6); PG8_BAR;
    }
    for (;;) {
        const bool has_next = S.next(ui + 1, nxt);
        const char* nA = has_next ? (const char*)g.A + (size_t)nxt.pm * tstep : cA; const char* nB = has_next ? (const char*)g.Bt + (size_t)nxt.pn * tstep : cB;
        for (int t = 0; t < nt; t += 2) {
            const bool last = (t == nt - 2);
            const char* a1 = cA + (size_t)(t + 1) * kstep;
            const char* a2 = last ? nA : cA + (size_t)(t + 2) * kstep; const char* b2 = last ? nB : cB + (size_t)(t + 2) * kstep;
            const char* a3 = a2 + kstep; const char* b3 = b2 + kstep;
            if (last && has_next) S.a_ready(nxt);
            if constexpr (SP2) {
            PG8_LDB(B0, 0, 0); PG8_LDB(B1, 0, 1); PG8_SCHED; PG8_LDA(At, 0, 0); PG8_STAGE(PG8_SA(1, 1), a1 + hstep, voffA);
            PG8_WAIT_V(8); PG8_WAIT_L(0); PG8_BAR; PG8_MMA(0, 0, At, B0); PG8_MMA(0, 1, At, B1); PG8_BAR; PG8_SCHED;
            PG8_LDA(At, 0, 1); PG8_STAGE(PG8_SB(0, 0), b2, voffB); PG8_STAGE(PG8_SB(0, 1), b2 + hstep, voffB); PG8_STAGE(PG8_SA(0, 0), a2, voffA);
            PG8_WAIT_V(8); PG8_WAIT_L(0); PG8_BAR; PG8_MMA(1, 0, At, B0); PG8_MMA(1, 1, At, B1); PG8_BAR; PG8_SCHED;
            PG8_LDB(B0, 1, 0); PG8_LDB(B1, 1, 1); PG8_SCHED; PG8_LDA(At, 1, 0); PG8_STAGE(PG8_SA(0, 1), a2 + hstep, voffA);
            PG8_WAIT_V(8); PG8_WAIT_L(0); PG8_BAR; PG8_MMA(0, 0, At, B0); PG8_MMA(0, 1, At, B1); PG8_BAR; PG8_SCHED;
            PG8_LDA(At, 1, 1); PG8_STAGE(PG8_SB(1, 0), b3, voffB); PG8_STAGE(PG8_SB(1, 1), b3 + hstep, voffB); PG8_STAGE(PG8_SA(1, 0), a3, voffA);
            PG8_WAIT_V(8); PG8_WAIT_L(0); PG8_BAR; PG8_MMA(1, 0, At, B0); PG8_MMA(1, 1, At, B1); PG8_BAR; PG8_SCHED;
            } else {
            PG8_LDB(B0, 0, 0); PG8_SCHED; PG8_LDA(At, 0, 0); PG8_STAGE(PG8_SA(1, 1), a1 + hstep, voffA);
            PG8_WAIT_L(8); PG8_BAR; PG8_WAIT_L(0); PG8_MMA(0, 0, At, B0); PG8_BAR; PG8_SCHED;
            PG8_LDB(B1, 0, 1); PG8_STAGE(PG8_SB(0, 0), b2, voffB);
            PG8_BAR; PG8_WAIT_L(0); PG8_MMA(0, 1, At, B1); PG8_BAR;
            PG8_LDA(At, 0, 1); PG8_STAGE(PG8_SA(0, 0), a2, voffA);
            PG8_BAR; PG8_WAIT_L(0); PG8_MMA(1, 0, At, B0); PG8_BAR; PG8_SCHED;
            PG8_STAGE(PG8_SB(0, 1), b2 + hstep, voffB);
            PG8_WAIT_V(6); PG8_BAR; PG8_MMA(1, 1, At, B1); PG8_BAR;
            PG8_LDB(B0, 1, 0); PG8_SCHED; PG8_LDA(At, 1, 0); PG8_STAGE(PG8_SA(0, 1), a2 + hstep, voffA);
            PG8_WAIT_L(8); PG8_BAR; PG8_WAIT_L(0); PG8_MMA(0, 0, At, B0); PG8_BAR; PG8_SCHED;
            PG8_LDB(B1, 1, 1); PG8_STAGE(PG8_SB(1, 0), b3, voffB);
            PG8_BAR; PG8_WAIT_L(0); PG8_MMA(0, 1, At, B1); PG8_BAR;
            PG8_LDA(At, 1, 1); PG8_STAGE(PG8_SA(1, 0), a3, voffA);
            PG8_BAR; PG8_WAIT_L(0); PG8_MMA(1, 0, At, B0); PG8_BAR; PG8_SCHED;
            PG8_STAGE(PG8_SB(1, 1), b3 + hstep, voffB);
            PG8_WAIT_V(6); PG8_BAR; PG8_MMA(1, 1, At, B1); PG8_BAR;
            }
        }
        if constexpr (ALIGN_EPI) { if (wr == 0) PG8_BAR; }
        E(acc, cur, wr, wc, fr, fq); S.done(cur);
        if (!has_next) break;
#pragma unroll
        for (int a = 0; a < 2; ++a)
#pragma unroll
            for (int b = 0; b < 2; ++b)
#pragma unroll
                for (int m = 0; m < 4; ++m)
#pragma unroll
                    for (int n = 0; n < 2; ++n) acc[a][b][m][n] = (f32x4){0.f, 0.f, 0.f, 0.f};
        cur = nxt; cA = nA; cB = nB; ++ui;
        if constexpr (ALIGN_EPI) { if (wr == 1) PG8_BAR; }
    }
    PG8_WAIT_V(0);
    if constexpr (!ALIGN_EPI) { if (wr == 0) PG8_BAR; }
    PG8_BAR;
#undef PG8_SA
#undef PG8_SB
#undef PG8_STAGE
#undef PG8_LDA
#undef PG8_LDB
#undef PG8_MMA
#undef PG8_WAIT_V
#undef PG8_WAIT_L
#undef PG8_BAR
#undef PG8_SCHED
}
}

constexpr int NWAVES = 8;
constexpr int DM = 1024, NTOK = 16384, NCTX = 8192, D_IN = 1792, NMODV = 9, MODW = 6144;
constexpr int SEQ_C = 256, SEQ_L = 1024, NSEQ_C = 32, NSEQ_L = 8;
constexpr int N_PHASES = 8;
constexpr float LOG2E = 1.4426950408889634f;
constexpr float QSCALE = 0.125f * LOG2E;
constexpr float EPS = 1e-6f;

constexpr size_t MiB = 1u << 20, KiB = 1u << 10;
constexpr size_t WS_CTL = 0, CTL_ZERO_BYTES = 64 * KiB;
constexpr size_t WS_MODS = 1 * MiB;
constexpr size_t WS_ROPE = 1 * MiB + 256 * KiB;
constexpr size_t WS_RGW  = 1 * MiB + 512 * KiB;
constexpr size_t WS_CK   = 1 * MiB + 768 * KiB;
constexpr size_t WS_CVT  = 2 * MiB + 256 * KiB;
constexpr size_t WS_WIN  = 3 * MiB;
constexpr size_t WS_WOUT = 7 * MiB;
constexpr size_t WS_WC   = 9 * MiB;
constexpr size_t WS_U    = 16 * MiB;
constexpr size_t WS_SSP  = 14 * MiB;
constexpr size_t WS_BIAS = 15 * MiB;
constexpr size_t WS_SU   = 13 * MiB;
constexpr size_t WS_SV   = 13 * MiB + 64 * KiB;
constexpr size_t WS_V    = 48 * MiB;
constexpr size_t WS_H    = 80 * MiB;
constexpr size_t WS_MIX  = 112 * MiB;
constexpr size_t WS_Q    = 144 * MiB;
constexpr size_t WS_K    = 160 * MiB;
constexpr size_t WS_VT   = 164 * MiB;
constexpr size_t WS_XR   = 168 * MiB;
constexpr size_t WS_YG   = 184 * MiB;
constexpr size_t WS_HF   = 200 * MiB;
constexpr size_t WS_SC   = 144 * MiB;
constexpr size_t WS_END  = 232 * MiB;
constexpr int VT_LAT_OFF = NSEQ_C * 2 * 64 * SEQ_C;

constexpr int CW_BAR = 4096;

constexpr int RING_BYTES = 131072;
constexpr int LDSCTL_OFF = 146944, MISC_OFF = LDSCTL_OFF + 320;
constexpr int LDS_BYTES = 147456;

#define GAS __attribute__((address_space(1)))
#define LAS __attribute__((address_space(3)))
typedef unsigned short bf16;
typedef unsigned v4u __attribute__((ext_vector_type(4)));
typedef unsigned v2u __attribute__((ext_vector_type(2)));
typedef float f32x4 __attribute__((ext_vector_type(4)));
typedef float f32x2 __attribute__((ext_vector_type(2)));
typedef float f32x16 __attribute__((ext_vector_type(16)));
typedef short bf16x8 __attribute__((ext_vector_type(8)));
typedef GAS unsigned gu32;
#define RLX_AGENT __ATOMIC_RELAXED, __HIP_MEMORY_SCOPE_AGENT

__device__ __forceinline__ unsigned f2bf(float f) { unsigned u = __builtin_bit_cast(unsigned, f); return (u + 0x7fffu + ((u >> 16) & 1u)) >> 16; }
typedef float f32x2_t_ __attribute__((ext_vector_type(2))); typedef __bf16 bf16x2_t_ __attribute__((ext_vector_type(2)));
__device__ __forceinline__ unsigned pk2(float lo, float hi) { f32x2_t_ v = {lo, hi}; bf16x2_t_ b = __builtin_convertvector(v, bf16x2_t_); return __builtin_bit_cast(unsigned, b); }
__device__ __forceinline__ float bf2f(unsigned b) { return __builtin_bit_cast(float, b << 16); }
__device__ __forceinline__ float bflo(unsigned w) { return __builtin_bit_cast(float, w << 16); }
__device__ __forceinline__ float bfhi(unsigned w) { return __builtin_bit_cast(float, w & 0xffff0000u); }
__device__ __forceinline__ float sigmoidf_(float x) { return 1.f / (1.f + __expf(-x)); }
__device__ __forceinline__ float gelu_tanh(float x) { const float y = 0.7978845608028654f * (x + 0.044715f * x * x * x); const float e = __expf(2.f * y); return 0.5f * x * (2.f - 2.f / (1.f + e)); }
template <int CTRL> __device__ __forceinline__ float dppf_(float v) { return __builtin_bit_cast(float, __builtin_amdgcn_update_dpp(0, __builtin_bit_cast(int, v), CTRL, 0xf, 0xf, true)); }
__device__ __forceinline__ float xrow16_(float v) {
    unsigned a = __builtin_bit_cast(unsigned, v), b = a; asm volatile("" : "+v"(b));
    const auto r = __builtin_amdgcn_permlane16_swap(a, b, false, false);
    const bool odd = (threadIdx.x & 16) != 0; return __builtin_bit_cast(float, odd ? r[0] : r[1]);
}
__device__ __forceinline__ float xhalf32_(float v) {
    unsigned a = __builtin_bit_cast(unsigned, v), b = a; asm volatile("" : "+v"(b));
    const auto r = __builtin_amdgcn_permlane32_swap(a, b, false, false);
    const bool hi = (threadIdx.x & 32) != 0; return __builtin_bit_cast(float, hi ? r[0] : r[1]);
}
__device__ __forceinline__ float wave_sum(float v) {
    v += dppf_<0xB1>(v); v += dppf_<0x4E>(v); v += dppf_<0x141>(v); v += dppf_<0x140>(v);
    v += xrow16_(v); v += xhalf32_(v); return v;
}
__device__ __forceinline__ float wave_max(float v) {
    v = fmaxf(v, dppf_<0xB1>(v)); v = fmaxf(v, dppf_<0x4E>(v)); v = fmaxf(v, dppf_<0x141>(v)); v = fmaxf(v, dppf_<0x140>(v));
    v = fmaxf(v, xrow16_(v)); v = fmaxf(v, xhalf32_(v)); return v;
}
__device__ __forceinline__ int crow(int r, int hi) { return (r & 3) + 8 * (r >> 2) + 4 * hi; }

#define XB_TMO      128
#define XB_XCNT(j)  (256  + 64 * (j))
#define XB_XSUB(j)  (1280 + 64 * (j))
#define XB_XGEN(j)  (2304 + 64 * (j))
#define XB_TOP      3328
#define XB_TOPGEN   3392
#define XCD_BAR_WORDS 3456
#define XB_SPIN_CAP (1u << 18)
__device__ __forceinline__ unsigned xb_ld(unsigned* p)              { return __hip_atomic_load(p, __ATOMIC_RELAXED, __HIP_MEMORY_SCOPE_AGENT); }
__device__ __forceinline__ unsigned xb_add(unsigned* p, unsigned v) { return __hip_atomic_fetch_add(p, v, __ATOMIC_RELAXED, __HIP_MEMORY_SCOPE_AGENT); }
__device__ __forceinline__ unsigned xb_xcc_id() { return (unsigned)__builtin_amdgcn_s_getreg((3 << 11) | 20) & 0xFu; }
#define XB_SPIN(cond, bar) do { unsigned _sp = 0; while (cond) { __builtin_amdgcn_s_sleep(1); \
    if ((++_sp & 255u) == 0u) { if (xb_ld(&(bar)[XB_TMO])) break; if (_sp > XB_SPIN_CAP) { atomicAdd(&(bar)[XB_TMO], 1u); break; } } } } while (0)
struct XcdBarrier { unsigned* bar; unsigned x; volatile LAS unsigned* st; };
__device__ __forceinline__ XcdBarrier xcd_barrier_post(unsigned* bar, volatile LAS unsigned* st) {
    XcdBarrier b; b.bar = bar; b.x = xb_xcc_id(); b.st = st;
    if (threadIdx.x == 0) (void)xb_add(&bar[XB_XCNT(b.x)], 1u);
    return b;
}
__device__ __forceinline__ void xcd_barrier_complete(unsigned* bar, unsigned x, unsigned& nloc, unsigned& nx) {
    const unsigned G = gridDim.x * gridDim.y * gridDim.z;
    unsigned sum, cnt, mine, sp = 0u;
    for (;;) {
        sum = 0u; cnt = 0u; mine = 0u;
#pragma unroll
        for (unsigned j = 0; j < 16; ++j) { const unsigned c = xb_ld(&bar[XB_XCNT(j)]); sum += c; cnt += (c > 0u) ? 1u : 0u; mine = (j == x) ? c : mine; }
        if (sum == G) break;
        __builtin_amdgcn_s_sleep(1);
        if ((++sp & 255u) == 0u) { if (xb_ld(&bar[XB_TMO])) break; if (sp > XB_SPIN_CAP) { atomicAdd(&bar[XB_TMO], 1u); break; } }
    }
    nloc = mine > 0u ? mine : 1u; nx = cnt > 0u ? cnt : 1u;
}
__device__ __forceinline__ void xcd_barrier(const XcdBarrier& b) {
    asm volatile("s_waitcnt vmcnt(0)" ::: "memory");
    __syncthreads();
    if (threadIdx.x == 0) {
        unsigned* bar = b.bar;
        __builtin_amdgcn_s_waitcnt(0);
        unsigned nloc = b.st[0], nx = b.st[1];
        if (nloc == 0u) { xcd_barrier_complete(bar, b.x, nloc, nx); b.st[0] = nloc; b.st[1] = nx; }
        const unsigned old = xb_add(&bar[XB_XSUB(b.x)], 1u);
        const unsigned gen = old / nloc;
        if (old + 1u == (gen + 1u) * nloc) {
            __builtin_amdgcn_fence(__ATOMIC_RELEASE, "agent");
            asm volatile("s_waitcnt vmcnt(0)" ::: "memory");
            const unsigned og = xb_add(&bar[XB_TOP], 1u);
            const unsigned tg = og / nx;
            if (og + 1u == (tg + 1u) * nx) xb_add(&bar[XB_TOPGEN], 1u);
            else XB_SPIN(xb_ld(&bar[XB_TOPGEN]) == tg, bar);
            __builtin_amdgcn_fence(__ATOMIC_ACQUIRE, "agent");
            xb_add(&bar[XB_XGEN(b.x)], 1u);
            asm volatile("s_waitcnt vmcnt(0)" ::: "memory");
        } else {
            XB_SPIN(xb_ld(&bar[XB_XGEN(b.x)]) == gen, bar);
            __builtin_amdgcn_fence(__ATOMIC_ACQUIRE, "agent");
            asm volatile("s_waitcnt vmcnt(0)" ::: "memory");
        }
    }
    __syncthreads();
}

struct Args { const float* in[26]; float* out; unsigned char* ws; int ph_lo, ph_hi, li, pad; };

struct Frame {
    unsigned char* lds;
    int tid, lane, wave, vcu, G;
    const float* const* in;
    float* out; unsigned char* ws;
};
enum { I_XP = 0, I_XS, I_CK, I_CV, I_SRNN, I_C, I_CCTX, I_WMOD, I_BMOD, I_GMIX, I_GFFN, I_WIN, I_CONVW, I_CONVB, I_RGWA, I_RGBA, I_RGWI, I_RGBI, I_RGLAM, I_SINK, I_WOUT, I_PWQ, I_PSK, I_PU, I_PV, I_GFINAL };
constexpr size_t O_Y = 0, O_NEWK = (size_t)NTOK * DM, O_NEWV = O_NEWK + (size_t)NCTX * 128, O_NEWRNN = O_NEWV + (size_t)NCTX * 128;

__device__ __forceinline__ int mod_index(int tok) { return tok < NCTX ? 0 : 1 + ((tok - NCTX) >> 10); }
__device__ __forceinline__ const float* x_row(const Frame& F, int tok) { return tok < NCTX ? F.in[I_XP] + (size_t)tok * DM : F.in[I_XS] + (size_t)(tok - NCTX) * DM; }

template <class RowMap>
__device__ __forceinline__ void p0_transpose_item(const float* W, int K, int N, bf16* WT, float* scr, int item, int lane, RowMap rowmap, float scale = 1.f) {
    const int nblk = N / 32, kb = item / nblk, nb = item % nblk, k0 = 64 * kb, n0 = 32 * nb;
#pragma unroll 8
    for (int i = 0; i < 32; ++i) { const int kk = 2 * i + (lane >> 5); scr[kk * 33 + (lane & 31)] = W[(size_t)(k0 + kk) * N + n0 + (lane & 31)]; }
    __builtin_amdgcn_s_waitcnt(0xC07F); asm volatile("" ::: "memory");
    const int c = lane & 7;
#pragma unroll
    for (int j = 0; j < 4; ++j) { const int n = (lane >> 3) + 8 * j; const float* s = scr + (8 * c) * 33 + n;
        v4u o; o.x = pk2(s[0 * 33] * scale, s[1 * 33] * scale); o.y = pk2(s[2 * 33] * scale, s[3 * 33] * scale); o.z = pk2(s[4 * 33] * scale, s[5 * 33] * scale); o.w = pk2(s[6 * 33] * scale, s[7 * 33] * scale);
        *(v4u*)(WT + (size_t)rowmap(n0 + n) * K + k0 + 8 * c) = o; }
    __builtin_amdgcn_s_waitcnt(0xC07F); asm volatile("" ::: "memory");
}
struct MapId { __device__ __forceinline__ int operator()(int n) const { return n; } };
struct MapWin { __device__ __forceinline__ int operator()(int n) const { if (n >= 640) return n; const int hb = n & ~63, o = n & 63; return hb + ((o & 31) << 1) + (o >> 5); } };

__device__ __forceinline__ void p0_phase(Frame& F) {
    float* ldsf = (float*)F.lds;
    const int tid = F.tid, lane = F.lane, wave = F.wave, v = F.vcu;
    if (v < 192) {
        for (int i = tid; i < NMODV * DM; i += 512) { const int j = i >> 10, d = i & 1023; const float c = (j == 0) ? F.in[I_CCTX][d] : F.in[I_C][(j - 1) * DM + d]; ldsf[i] = c * sigmoidf_(c); }
        __syncthreads();
        const int e0 = 32 * v, c4 = tid & 7, kq = tid >> 3;
        float acc[NMODV][4];
#pragma unroll
        for (int j = 0; j < NMODV; ++j) { acc[j][0] = 0.f; acc[j][1] = 0.f; acc[j][2] = 0.f; acc[j][3] = 0.f; }
        const float* wm = F.in[I_WMOD] + e0 + 4 * c4;
#pragma unroll 4
        for (int kk = 0; kk < 16; ++kk) { const int k = kq * 16 + kk; const f32x4 w = *(const f32x4*)(wm + (size_t)k * MODW);
#pragma unroll
            for (int j = 0; j < NMODV; ++j) { const float s = ldsf[j * DM + k]; acc[j][0] += s * w[0]; acc[j][1] += s * w[1]; acc[j][2] += s * w[2]; acc[j][3] += s * w[3]; } }
#pragma unroll
        for (int j = 0; j < NMODV; ++j)
#pragma unroll
            for (int i = 0; i < 4; ++i) { float a = acc[j][i]; a += __shfl_xor(a, 8); a += __shfl_xor(a, 16); a += __shfl_xor(a, 32); acc[j][i] = a; }
        float* red = ldsf + NMODV * DM;
        if (lane < 8) {
#pragma unroll
            for (int j = 0; j < NMODV; ++j)
#pragma unroll
                for (int i = 0; i < 4; ++i) red[(wave * NMODV + j) * 32 + 4 * c4 + i] = acc[j][i];
        }
        __syncthreads();
        if (tid < NMODV * 32) { const int j = tid >> 5, col = tid & 31; float s = F.in[I_BMOD][e0 + col];
#pragma unroll
            for (int w = 0; w < 8; ++w) s += red[(w * NMODV + j) * 32 + col];
            ((float*)(F.ws + WS_MODS))[j * MODW + e0 + col] = s; }
        __syncthreads();
    }
    if (v < 256) {
        const int hh = v >> 4, dt = v & 15, d0 = 64 * dt;
        float* At = ldsf;
        float* Bkt = ldsf + 128 * 64;
        const float* wq = F.in[I_PWQ] + hh * 128;
        const float* sk = F.in[I_PSK] + (size_t)hh * 128 * 128;
#pragma unroll
        for (int i = 0; i < 4; ++i) { const int f = tid + 512 * i, d = f & 63, q4 = f >> 6; const f32x4 a = *(const f32x4*)(wq + (size_t)(d0 + d) * 2048 + 4 * q4);
            At[(4 * q4 + 0) * 64 + d] = a[0]; At[(4 * q4 + 1) * 64 + d] = a[1]; At[(4 * q4 + 2) * 64 + d] = a[2]; At[(4 * q4 + 3) * 64 + d] = a[3]; }
#pragma unroll
        for (int i = 0; i < 8; ++i) { const int f = tid + 512 * i, key = f & 127, q4 = f >> 7; const f32x4 b = *(const f32x4*)(sk + (size_t)key * 128 + 4 * q4);
            Bkt[(4 * q4 + 0) * 128 + key] = b[0]; Bkt[(4 * q4 + 1) * 128 + key] = b[1]; Bkt[(4 * q4 + 2) * 128 + key] = b[2]; Bkt[(4 * q4 + 3) * 128 + key] = b[3]; }
        __syncthreads();
        const int dg = tid & 15, kg = tid >> 4;
        float acc[4][4];
#pragma unroll
        for (int i = 0; i < 4; ++i)
#pragma unroll
            for (int j = 0; j < 4; ++j) acc[i][j] = 0.f;
#pragma unroll 4
        for (int q = 0; q < 128; ++q) { const f32x4 a = *(const f32x4*)(At + q * 64 + 4 * dg); const f32x4 b = *(const f32x4*)(Bkt + q * 128 + 4 * kg);
#pragma unroll
            for (int i = 0; i < 4; ++i)
#pragma unroll
                for (int j = 0; j < 4; ++j) acc[i][j] += a[i] * b[j]; }
        bf16* WcT = (bf16*)(F.ws + WS_WC);
#pragma unroll
        for (int j = 0; j < 4; ++j) { v2u o; o.x = pk2(acc[0][j], acc[1][j]); o.y = pk2(acc[2][j], acc[3][j]);
            *(v2u*)(WcT + (size_t)(hh * 128 + 4 * kg + j) * DM + d0 + 4 * dg) = o; }
        __syncthreads();
    }
    const int gw = v * NWAVES + wave, NGW = F.G * NWAVES;
    float* scr = ldsf + wave * 4096;
    {
        constexpr int I_IN = (DM / 64) * (D_IN / 32), I_OUT = (DM / 64) * (DM / 32), I_RG = 32 * 2;
        constexpr int NIT = I_IN + I_OUT + I_RG;
        for (int it = gw; it < NIT; it += NGW) {
            int r = it;
            if (r < I_IN) { p0_transpose_item(F.in[I_WIN], DM, D_IN, (bf16*)(F.ws + WS_WIN), scr, r, lane, MapWin()); continue; } r -= I_IN;
            if (r < I_OUT) { p0_transpose_item(F.in[I_WOUT], DM, DM, (bf16*)(F.ws + WS_WOUT), scr, r, lane, MapId()); continue; } r -= I_OUT;
            { const int mm = r >> 1, sub = r & 1, dir = mm >> 4, n = (mm >> 1) & 7, gate = mm & 1;
              const float* src = (gate ? F.in[I_RGWI] : F.in[I_RGWA]) + (size_t)(dir * 8 + n) * 4096;
              bf16* dst = (bf16*)(F.ws + WS_RGW) + (size_t)((dir * 8 + n) * 2 + gate) * 4096;
              p0_transpose_item(src, 64, 64, dst, scr, sub, lane, MapId(), -LOG2E); }
        }
    }
    for (int it0 = 4 * gw; it0 < 2 * 16384; it0 += 4 * NGW) {
        f32x4 a[4][4];
#pragma unroll
        for (int r = 0; r < 4; ++r) { const int it = it0 + r, tb = it >> 14, row = it & 16383;
            const float* src = (tb ? F.in[I_PV] : F.in[I_PU]) + (size_t)row * DM + 16 * lane;
#pragma unroll
            for (int j = 0; j < 4; ++j) a[r][j] = *(const f32x4*)(src + 4 * j); }
        float am[4];
#pragma unroll
        for (int r = 0; r < 4; ++r) { float m = 0.f;
#pragma unroll
            for (int j = 0; j < 4; ++j) m = fmaxf(m, fmaxf(fmaxf(fabsf(a[r][j][0]), fabsf(a[r][j][1])), fmaxf(fabsf(a[r][j][2]), fabsf(a[r][j][3]))));
            am[r] = m; }
#pragma unroll
        for (int r = 0; r < 4; ++r) am[r] = wave_max(am[r]);
#pragma unroll
        for (int r = 0; r < 4; ++r) { const int it = it0 + r, tb = it >> 14, row = it & 16383;
            if (tb) {
                const float inv = am[r] > 0.f ? 127.f / am[r] : 0.f;
                v4u o4;
#pragma unroll
                for (int j = 0; j < 4; ++j) { unsigned w = 0;
#pragma unroll
                    for (int i = 0; i < 4; ++i) { int q = (int)rintf(a[r][j][i] * inv); q = q > 127 ? 127 : (q < -127 ? -127 : q); w |= ((unsigned)q & 0xffu) << (8 * i); }
                    o4[j] = w; }
                *(v4u*)(F.ws + WS_V + (size_t)row * DM + 16 * lane) = o4;
                if (lane == 0) ((float*)(F.ws + WS_SV))[row] = am[r] * (1.f / 127.f);
            } else {
                const float inv = am[r] > 0.f ? 7.f / am[r] : 0.f;
                v2u o2;
#pragma unroll
                for (int h = 0; h < 2; ++h) { unsigned w = 0;
#pragma unroll
                    for (int c = 0; c < 8; ++c) { int q = (int)rintf(a[r][2 * h + (c >> 2)][c & 3] * inv); q = q > 7 ? 7 : (q < -7 ? -7 : q); w |= ((unsigned)q & 0xfu) << (4 * c); }
                    o2[h] = w; }
                *(v2u*)(F.ws + WS_U + (size_t)row * (DM / 2) + 8 * lane) = o2;
                if (lane == 0) ((float*)(F.ws + WS_SU))[row] = am[r] * (1.f / 7.f);
            } }
    }
    const int gt = v * 512 + tid, NGT = F.G * 512;
    for (int e = gt; e < 8 * 256 * 128; e += NGT) {
        const int c = e & 127, bp = e >> 7, kvh = c >> 6, p = c & 63, old = (p & 1) ? 32 + (p >> 1) : (p >> 1);
        ((bf16*)(F.ws + WS_CK))[e] = (bf16)f2bf(F.in[I_CK][(size_t)bp * 128 + kvh * 64 + old]);
    }
    for (int e = gt; e < 8 * 256 * 128; e += NGT) {
        const int pos = e & 255, d = (e >> 8) & 63, kvh = (e >> 14) & 1, b = e >> 15;
        ((bf16*)(F.ws + WS_CVT))[e] = (bf16)f2bf(F.in[I_CV][(size_t)(b * 256 + pos) * 128 + kvh * 64 + d]);
    }
    for (int e = gt; e < 1024 * 32; e += NGT) {
        const int s = e >> 5, i = e & 31, row = s >> 6, col = s & 63;
        const float inv = powf(10000.0f, -(float)(i & 15) / 16.0f);
        const float ang = (i < 16 ? (float)row : (float)col) * inv;
        f32x2 cs; cs.x = cosf(ang); cs.y = sinf(ang);
        ((f32x2*)(F.ws + WS_ROPE))[e] = cs;
    }
}

__device__ __forceinline__ void bias_items(Frame& F) {
    const int gw = F.vcu * NWAVES + F.wave, NGW = F.G * NWAVES, lane = F.lane;
    const float* mods = (const float*)(F.ws + WS_MODS); const bf16* WcT = (const bf16*)(F.ws + WS_WC); float* BIAS = (float*)(F.ws + WS_BIAS);
    for (int n = gw; n < 2048; n += NGW) {
        const v4u a = *(const v4u*)(WcT + (size_t)n * DM + 16 * lane), b = *(const v4u*)(WcT + (size_t)n * DM + 16 * lane + 8);
        float w[16];
        w[0] = bflo(a.x); w[1] = bfhi(a.x); w[2] = bflo(a.y); w[3] = bfhi(a.y); w[4] = bflo(a.z); w[5] = bfhi(a.z); w[6] = bflo(a.w); w[7] = bfhi(a.w);
        w[8] = bflo(b.x); w[9] = bfhi(b.x); w[10] = bflo(b.y); w[11] = bfhi(b.y); w[12] = bflo(b.z); w[13] = bfhi(b.z); w[14] = bflo(b.w); w[15] = bfhi(b.w);
#pragma unroll 1
        for (int j = 0; j < NMODV; ++j) { const float* sh = mods + (size_t)j * MODW + 3 * DM + 16 * lane; float d = 0.f;
#pragma unroll
            for (int q = 0; q < 4; ++q) { const f32x4 v = *(const f32x4*)(sh + 4 * q); d += v[0] * w[4 * q] + v[1] * w[4 * q + 1] + v[2] * w[4 * q + 2] + v[3] * w[4 * q + 3]; }
            d = wave_sum(d); if (lane == 0) BIAS[j * 2048 + n] = d; }
    }
}
__device__ __forceinline__ void norm_phase(Frame& F, int which) {
    const int gw = F.vcu * NWAVES + F.wave, NGW = F.G * NWAVES, lane = F.lane;
    const float* mods = (const float*)(F.ws + WS_MODS);
    const float* g = F.in[which ? I_GFFN : I_GMIX];
    bf16* H = (bf16*)(F.ws + WS_H);
    for (int tok = gw; tok < NTOK; tok += NGW) {
        const float* xr = which ? F.out + O_Y + (size_t)tok * DM : x_row(F, tok);
        const float* mv = mods + (size_t)mod_index(tok) * MODW + (which ? 3 * DM : 0);
        f32x4 v[4]; float ss = 0.f;
#pragma unroll
        for (int j = 0; j < 4; ++j) { v[j] = *(const f32x4*)(xr + 256 * j + 4 * lane); ss += (v[j][0] * v[j][0] + v[j][1] * v[j][1]) + (v[j][2] * v[j][2] + v[j][3] * v[j][3]); }
        const float rstd = 1.f / sqrtf(wave_sum(ss) * (1.f / DM) + EPS);
#pragma unroll
        for (int j = 0; j < 4; ++j) { const int e = 256 * j + 4 * lane;
            const f32x4 gg = *(const f32x4*)(g + e), sh = *(const f32x4*)(mv + e), sc = *(const f32x4*)(mv + DM + e);
            f32x4 o;
#pragma unroll
            for (int i = 0; i < 4; ++i) o[i] = v[j][i] * rstd * gg[i] * (1.f + sc[i]) + sh[i];
            v2u w; w.x = pk2(o[0], o[1]); w.y = pk2(o[2], o[3]); *(v2u*)(H + (size_t)tok * DM + e) = w; }
    }
}

struct EpiInProj {
    static constexpr bool PERM = true;
    bf16 *q, *k, *vT, *xr, *yg; float *newk, *newv; const f32x4* rope4;
    __device__ __forceinline__ void operator()(const f32x4 (&acc)[2][2][4][2], const pg8::Unit& u, int wr, int wc, int fr, int fq) const {
        const bool lat = u.pm >= 32;
        const int pn = u.pn;
#pragma unroll
        for (int ai = 0; ai < 2; ++ai)
#pragma unroll
            for (int m = 0; m < 4; ++m) {
                const int row = u.pm * 256 + ai * 128 + wr * 64 + m * 16 + fr;
                const int pos = lat ? ((row - NCTX) & 1023) : (row & 255);
#pragma unroll
                for (int bj = 0; bj < 2; ++bj) {
                    const int c = pn * 256 + bj * 128 + wc * 32 + 8 * fq;
                    f32x4 v0 = acc[ai][bj][m][0], v1 = acc[ai][bj][m][1];
                    if (pn < 2 || (pn == 2 && bj == 0)) {
                        const int i = (c & 63) >> 1;
                        if (lat) { const f32x4 cs0 = rope4[(pos * 32 + i) >> 1], cs1 = rope4[((pos * 32 + i) >> 1) + 1];
                            const float a0 = v0[0] * cs0[0] - v0[1] * cs0[1], a1 = v0[1] * cs0[0] + v0[0] * cs0[1];
                            const float b0 = v0[2] * cs0[2] - v0[3] * cs0[3], b1 = v0[3] * cs0[2] + v0[2] * cs0[3];
                            const float c0 = v1[0] * cs1[0] - v1[1] * cs1[1], c1 = v1[1] * cs1[0] + v1[0] * cs1[1];
                            const float d0 = v1[2] * cs1[2] - v1[3] * cs1[3], d1 = v1[3] * cs1[2] + v1[2] * cs1[3];
                            v0[0] = a0; v0[1] = a1; v0[2] = b0; v0[3] = b1; v1[0] = c0; v1[1] = c1; v1[2] = d0; v1[3] = d1; }
                        if (pn < 2) { v4u w; w.x = pk2(v0[0] * QSCALE, v0[1] * QSCALE); w.y = pk2(v0[2] * QSCALE, v0[3] * QSCALE); w.z = pk2(v1[0] * QSCALE, v1[1] * QSCALE); w.w = pk2(v1[2] * QSCALE, v1[3] * QSCALE);
                            *(v4u*)(q + (size_t)row * 512 + c) = w; }
                        else { const int kc = c - 512; v4u w; w.x = pk2(v0[0], v0[1]); w.y = pk2(v0[2], v0[3]); w.z = pk2(v1[0], v1[1]); w.w = pk2(v1[2], v1[3]); *(v4u*)(k + (size_t)row * 128 + kc) = w;
                            if (!lat) { float* nk = newk + (size_t)row * 128 + (kc & 64) + i; f32x4 lo; lo[0] = v0[0]; lo[1] = v0[2]; lo[2] = v1[0]; lo[3] = v1[2]; f32x4 hi; hi[0] = v0[1]; hi[1] = v0[3]; hi[2] = v1[1]; hi[3] = v1[3];
                                *(f32x4*)nk = lo; *(f32x4*)(nk + 32) = hi; } }
                    } else if (pn == 2) {
                        const int vc = c - 640, kvh = vc >> 6, d = vc & 63;
                        if (!lat) { *(f32x4*)(newv + (size_t)row * 128 + vc) = v0; *(f32x4*)(newv + (size_t)row * 128 + vc + 4) = v1; }
                        bf16* vp; int S;
                        if (!lat) { S = SEQ_C; vp = vT + ((size_t)((row >> 8) * 2 + kvh) * 64 + d) * SEQ_C + pos; }
                        else { S = SEQ_L; vp = vT + VT_LAT_OFF + ((size_t)(((row - NCTX) >> 10) * 2 + kvh) * 64 + d) * SEQ_L + pos; }
                        vp[0] = (bf16)f2bf(v0[0]); vp[S] = (bf16)f2bf(v0[1]); vp[2 * S] = (bf16)f2bf(v0[2]); vp[3 * S] = (bf16)f2bf(v0[3]);
                        vp[4 * S] = (bf16)f2bf(v1[0]); vp[5 * S] = (bf16)f2bf(v1[1]); vp[6 * S] = (bf16)f2bf(v1[2]); vp[7 * S] = (bf16)f2bf(v1[3]);
                    } else {
                        v4u w; w.x = pk2(v0[0], v0[1]); w.y = pk2(v0[2], v0[3]); w.z = pk2(v1[0], v1[1]); w.w = pk2(v1[2], v1[3]);
                        if (pn < 5) *(v4u*)(xr + (size_t)row * 512 + (c - 768)) = w; else *(v4u*)(yg + (size_t)row * 512 + (c - 1280)) = w;
                    }
                }
            }
    }
};
struct EpiOutProj {
    static constexpr bool PERM = true;
    const float *xp, *xs, *mods, *gffn; float* x1; bf16* ap; float* ssp;
    __device__ __forceinline__ void operator()(const f32x4 (&acc)[2][2][4][2], const pg8::Unit& u, int wr, int wc, int fr, int fq) const {
        const int mi = u.pm < 32 ? 0 : 1 + ((u.pm - 32) >> 2);
        const float* mv = mods + (size_t)mi * MODW;
        const int row0 = u.pm * 256 + wr * 64 + fr;
        const float* xbase = (u.pm < 32 ? xp : xs - (size_t)NCTX * DM) + (size_t)row0 * DM;
        float ssq[2][4];
#pragma unroll
        for (int ai = 0; ai < 2; ++ai)
#pragma unroll
            for (int m = 0; m < 4; ++m) ssq[ai][m] = 0.f;
#pragma unroll
        for (int bj = 0; bj < 2; ++bj) {
            const int c = u.pn * 256 + bj * 128 + wc * 32 + 8 * fq;
            const f32x4 gv0 = *(const f32x4*)(mv + 2 * DM + c), gv1 = *(const f32x4*)(mv + 2 * DM + c + 4);
            const f32x4 g20 = *(const f32x4*)(gffn + c) * (1.f + *(const f32x4*)(mv + 4 * DM + c)), g21 = *(const f32x4*)(gffn + c + 4) * (1.f + *(const f32x4*)(mv + 4 * DM + c + 4));
#pragma unroll
            for (int h4 = 0; h4 < 4; ++h4) {
                const int ai = h4 >> 1;
                f32x4 xv[2][2];
#pragma unroll
                for (int mm = 0; mm < 2; ++mm) { const float* xr = xbase + (size_t)(ai * 128 + (2 * (h4 & 1) + mm) * 16) * DM + c; xv[mm][0] = *(const f32x4*)xr; xv[mm][1] = *(const f32x4*)(xr + 4); }
                asm volatile("" ::: "memory");
#pragma unroll
                for (int mm = 0; mm < 2; ++mm) {
                    const int m = 2 * (h4 & 1) + mm;
                    const size_t off = (size_t)(row0 + ai * 128 + m * 16) * DM + c;
                    const f32x4 o0 = xv[mm][0] + gv0 * acc[ai][bj][m][0], o1 = xv[mm][1] + gv1 * acc[ai][bj][m][1];
                    *(f32x4*)(x1 + off) = o0; *(f32x4*)(x1 + off + 4) = o1;
                    ssq[ai][m] += ((o0[0] * o0[0] + o0[1] * o0[1]) + (o0[2] * o0[2] + o0[3] * o0[3])) + ((o1[0] * o1[0] + o1[1] * o1[1]) + (o1[2] * o1[2] + o1[3] * o1[3]));
                    const f32x4 t0 = o0 * g20, t1 = o1 * g21; v4u w; w.x = pk2(t0[0], t0[1]); w.y = pk2(t0[2], t0[3]); w.z = pk2(t1[0], t1[1]); w.w = pk2(t1[2], t1[3]);
                    *(v4u*)(ap + off) = w;
                }
                asm volatile("" ::: "memory");
            }
        }
#pragma unroll
        for (int ai = 0; ai < 2; ++ai)
#pragma unroll
            for (int m = 0; m < 4; ++m) { float v = ssq[ai][m]; v += __shfl_xor(v, 16); v += __shfl_xor(v, 32);
                if (fq == 0) ssp[(size_t)(row0 + ai * 128 + m * 16) * 16 + u.pn * 4 + wc] = v; }
    }
};
struct EpiScores {
    static constexpr bool PERM = true;
    bf16* sc; const float* ssp; const float* bias;
    __device__ __forceinline__ void operator()(const f32x4 (&acc)[2][2][4][2], const pg8::Unit& u, int wr, int wc, int fr, int fq) const {
        const int mi = u.pm < 32 ? 0 : 1 + ((u.pm - 32) >> 2);
        const int row0 = u.pm * 256 + wr * 64 + fr;
        f32x4 b0[2], b1[2];
#pragma unroll
        for (int bj = 0; bj < 2; ++bj) { const int c = u.pn * 256 + bj * 128 + wc * 32 + 8 * fq; b0[bj] = *(const f32x4*)(bias + (size_t)mi * 2048 + c); b1[bj] = *(const f32x4*)(bias + (size_t)mi * 2048 + c + 4); }
#pragma unroll
        for (int h2 = 0; h2 < 4; ++h2) {
            const int ai = h2 >> 1;
            f32x4 sp[2][4];
#pragma unroll
            for (int mm = 0; mm < 2; ++mm)
#pragma unroll
                for (int q = 0; q < 4; ++q) sp[mm][q] = *((const f32x4*)(ssp + (size_t)(row0 + ai * 128 + (2 * (h2 & 1) + mm) * 16) * 16) + q);
            asm volatile("" ::: "memory");
#pragma unroll
            for (int mm = 0; mm < 2; ++mm) {
                const int m = 2 * (h2 & 1) + mm;
                const int row = row0 + ai * 128 + m * 16;
                const float ss = ((sp[mm][0][0] + sp[mm][0][1]) + (sp[mm][0][2] + sp[mm][0][3])) + ((sp[mm][1][0] + sp[mm][1][1]) + (sp[mm][1][2] + sp[mm][1][3]))
                               + ((sp[mm][2][0] + sp[mm][2][1]) + (sp[mm][2][2] + sp[mm][2][3])) + ((sp[mm][3][0] + sp[mm][3][1]) + (sp[mm][3][2] + sp[mm][3][3]));
                const float rstd = 1.f / sqrtf(ss * (1.f / DM) + EPS);
#pragma unroll
                for (int bj = 0; bj < 2; ++bj) {
                    const int c = u.pn * 256 + bj * 128 + wc * 32 + 8 * fq;
                    const f32x4 v0 = acc[ai][bj][m][0] * rstd + b0[bj], v1 = acc[ai][bj][m][1] * rstd + b1[bj];
                    v4u w; w.x = pk2(v0[0], v0[1]); w.y = pk2(v0[2], v0[3]); w.z = pk2(v1[0], v1[1]); w.w = pk2(v1[2], v1[3]);
                    *(v4u*)(sc + (size_t)row * 2048 + c) = w;
                }
            }
            asm volatile("" ::: "memory");
        }
    }
};

__device__ __forceinline__ void attn_unit(Frame& F, bool lat, int seq, int kvh, int qt) {
    const int tid = F.tid, lane = F.lane, wave = F.wave, r32 = lane & 31, hi = lane >> 5;
    const int g = wave >> 1, qs = wave & 1, head = kvh * 4 + g;
    const int S = lat ? SEQ_L : SEQ_C, tokbase = lat ? NCTX + seq * SEQ_L : seq * SEQ_C;
    const int q0 = qt * 64, qpos = q0 + 32 * qs + r32;
    const bf16* Q = (const bf16*)(F.ws + WS_Q); const bf16* Kb = (const bf16*)(F.ws + WS_K); const bf16* VT = (const bf16*)(F.ws + WS_VT);
    const bf16* CK = (const bf16*)(F.ws + WS_CK); const bf16* CVT = (const bf16*)(F.ws + WS_CVT);
    unsigned char* ldsK = F.lds; unsigned char* ldsV = F.lds + 8192;
    bf16x8 qf[4];
    { const bf16* qp = Q + (size_t)(tokbase + qpos) * 512 + head * 64;
#pragma unroll
      for (int ks = 0; ks < 4; ++ks) qf[ks] = *(const bf16x8*)(qp + 16 * ks + 8 * hi); }
    const float sinkl = F.in[I_SINK][head] * LOG2E;
    float mrun = sinkl, lrun = (hi == 0) ? 1.f : 0.f;
    f32x16 o0, o1;
#pragma unroll
    for (int r = 0; r < 16; ++r) { o0[r] = 0.f; o1[r] = 0.f; }
    int tlo, thi;
    if (lat) { tlo = (q0 >= 128 ? q0 - 128 : 0) >> 6; thi = ((q0 + 192 < S ? q0 + 192 : S)) >> 6; } else { tlo = 0; thi = 4; }
    const int nband = thi - tlo, ntile = nband + (lat ? 4 : 0);
    const int key_t = tid >> 3, ch_t = tid & 7;
    v4u kv, vv;
#define AT_LOAD(t_) do { const int tt_ = (t_); const bf16* kptr; const bf16* vptr; int vstride; \
        if (tt_ < nband) { const int kb_ = (tlo + tt_) * 64; kptr = Kb + (size_t)(tokbase + kb_) * 128 + kvh * 64; \
            vptr = VT + (lat ? (size_t)VT_LAT_OFF + (size_t)((seq * 2 + kvh) * 64) * SEQ_L : (size_t)((seq * 2 + kvh) * 64) * SEQ_C) + kb_; vstride = S; } \
        else { const int tc = tt_ - nband; kptr = CK + (size_t)(seq * 256 + tc * 64) * 128 + kvh * 64; vptr = CVT + (size_t)((seq * 2 + kvh) * 64) * 256 + tc * 64; vstride = 256; } \
        kv = *(const v4u*)(kptr + (size_t)key_t * 128 + ch_t * 8); vv = *(const v4u*)(vptr + (size_t)key_t * vstride + ch_t * 8); } while (0)
    AT_LOAD(0);
    for (int t = 0; t < ntile; ++t) {
        const bool band = t < nband;
        const int kbase = band ? (tlo + t) * 64 : 0;
        __syncthreads();
        *(v4u*)(ldsK + key_t * 128 + ((ch_t ^ (key_t & 7)) * 16)) = kv;
        *(v4u*)(ldsV + key_t * 128 + ((ch_t ^ (key_t & 7)) * 16)) = vv;
        __syncthreads();
        f32x16 p0, p1;
#pragma unroll
        for (int r = 0; r < 16; ++r) { p0[r] = 0.f; p1[r] = 0.f; }
#pragma unroll
        for (int ks = 0; ks < 4; ++ks) {
            const int sw = ((2 * ks + hi) ^ (r32 & 7)) * 16;
            const bf16x8 a0 = *(const bf16x8*)(ldsK + r32 * 128 + sw);
            const bf16x8 a1 = *(const bf16x8*)(ldsK + (32 + r32) * 128 + sw);
            p0 = __builtin_amdgcn_mfma_f32_32x32x16_bf16(a0, qf[ks], p0, 0, 0, 0);
            p1 = __builtin_amdgcn_mfma_f32_32x32x16_bf16(a1, qf[ks], p1, 0, 0, 0);
        }
        if (t + 1 < ntile) AT_LOAD(t + 1);
        if (band && lat && (kbase < q0 + 63 - 128 || kbase + 63 > q0 + 128)) {
#pragma unroll
            for (int r = 0; r < 16; ++r) { const int kp = kbase + crow(r, hi); int d0 = qpos - kp; d0 = d0 < 0 ? -d0 : d0; int d1 = qpos - kp - 32; d1 = d1 < 0 ? -d1 : d1;
                if (d0 > 128) p0[r] = -INFINITY; if (d1 > 128) p1[r] = -INFINITY; }
        }
        float tm = p0[0];
#pragma unroll
        for (int r = 1; r < 16; ++r) tm = fmaxf(tm, p0[r]);
#pragma unroll
        for (int r = 0; r < 16; ++r) tm = fmaxf(tm, p1[r]);
        tm = fmaxf(tm, __shfl_xor(tm, 32));
        const float mn = fmaxf(mrun, tm), alpha = __builtin_amdgcn_exp2f(mrun - mn); mrun = mn;
        float ls = 0.f;
#pragma unroll
        for (int r = 0; r < 16; ++r) { p0[r] = __builtin_amdgcn_exp2f(p0[r] - mn); p1[r] = __builtin_amdgcn_exp2f(p1[r] - mn); ls += p0[r] + p1[r]; o0[r] *= alpha; o1[r] *= alpha; }
        lrun = lrun * alpha + ls;
        bf16x8 pf[4];
#pragma unroll
        for (int s = 0; s < 2; ++s) {
            v4u w0, w1;
            w0.x = pk2(p0[8 * s + 0], p0[8 * s + 1]); w0.y = pk2(p0[8 * s + 2], p0[8 * s + 3]); w0.z = pk2(p0[8 * s + 4], p0[8 * s + 5]); w0.w = pk2(p0[8 * s + 6], p0[8 * s + 7]);
            w1.x = pk2(p1[8 * s + 0], p1[8 * s + 1]); w1.y = pk2(p1[8 * s + 2], p1[8 * s + 3]); w1.z = pk2(p1[8 * s + 4], p1[8 * s + 5]); w1.w = pk2(p1[8 * s + 6], p1[8 * s + 7]);
            pf[s] = __builtin_bit_cast(bf16x8, w0); pf[2 + s] = __builtin_bit_cast(bf16x8, w1);
        }
#pragma unroll
        for (int s4 = 0; s4 < 4; ++s4) {
#pragma unroll
            for (int dt = 0; dt < 2; ++dt) {
                const int d = 32 * dt + r32;
                const v2u lo = *(const v2u*)(ldsV + d * 128 + (((2 * s4) ^ (d & 7)) * 16) + 8 * hi);
                const v2u hi2 = *(const v2u*)(ldsV + d * 128 + (((2 * s4 + 1) ^ (d & 7)) * 16) + 8 * hi);
                v4u vf4; vf4.x = lo.x; vf4.y = lo.y; vf4.z = hi2.x; vf4.w = hi2.y;
                const bf16x8 vf = __builtin_bit_cast(bf16x8, vf4);
                if (dt == 0) o0 = __builtin_amdgcn_mfma_f32_32x32x16_bf16(vf, pf[s4], o0, 0, 0, 0);
                else o1 = __builtin_amdgcn_mfma_f32_32x32x16_bf16(vf, pf[s4], o1, 0, 0, 0);
            }
        }
    }
    const float ltot = lrun + __shfl_xor(lrun, 32), inv = 1.f / ltot;
    bf16* mix = (bf16*)(F.ws + WS_MIX) + (size_t)(tokbase + qpos) * DM + head * 64;
#pragma unroll
    for (int g4 = 0; g4 < 4; ++g4) {
        v2u w; w.x = pk2(o0[4 * g4] * inv, o0[4 * g4 + 1] * inv); w.y = pk2(o0[4 * g4 + 2] * inv, o0[4 * g4 + 3] * inv);
        *(v2u*)(mix + 8 * g4 + 4 * hi) = w;
        v2u w2; w2.x = pk2(o1[4 * g4] * inv, o1[4 * g4 + 1] * inv); w2.y = pk2(o1[4 * g4 + 2] * inv, o1[4 * g4 + 3] * inv);
        *(v2u*)(mix + 32 + 8 * g4 + 4 * hi) = w2;
    }
    __syncthreads();
}

constexpr int RL_HALF = 49152;
constexpr int RL_XCB = 32768;
constexpr int RL_AGG = 98304;
constexpr int RL_CARRY = RL_AGG + 8192;
constexpr int RL_CW = RL_CARRY + 512;
constexpr int RL_WG = RL_CW + 1280;
static_assert(RL_WG + 32768 <= LDSCTL_OFF, "RNN LDS map");
__device__ __forceinline__ float fsigmoid(float x) { return __builtin_amdgcn_rcpf(1.f + __expf(-x)); }
__device__ __forceinline__ float gelu_fast(float x) { const float y = 0.7978845608028654f * (x + 0.044715f * x * x * x); const float e = __expf(2.f * y); return x - x * __builtin_amdgcn_rcpf(1.f + e); }

template <bool REV>
__device__ __forceinline__ void scan_prep(const float (&a)[16], const float (&b)[16], int h, float (&Apre)[4], float (&Bpre)[4], float& At, float& Bt) {
    float Ao[4], Bo[4], Ap[4], Bp[4];
#pragma unroll
    for (int g = 0; g < 4; ++g) { float A = 1.f, B = 0.f;
#pragma unroll
        for (int ii = 0; ii < 4; ++ii) { const int r = 4 * g + (REV ? 3 - ii : ii); B = a[r] * B + b[r]; A = a[r] * A; }
        Ao[g] = A; Bo[g] = B; }
#pragma unroll
    for (int g = 0; g < 4; ++g) { Ap[g] = __shfl_xor(Ao[g], 32); Bp[g] = __shfl_xor(Bo[g], 32); }
    const bool ownfirst = REV ? (h == 1) : (h == 0);
    float Ac = 1.f, Bc = 0.f;
#pragma unroll
    for (int gi = 0; gi < 4; ++gi) { const int g = REV ? 3 - gi : gi;
        const float A1 = ownfirst ? Ao[g] : Ap[g], B1 = ownfirst ? Bo[g] : Bp[g], A2 = ownfirst ? Ap[g] : Ao[g], B2 = ownfirst ? Bp[g] : Bo[g];
        const float Ac1 = A1 * Ac, Bc1 = A1 * Bc + B1;
        Apre[g] = ownfirst ? Ac : Ac1; Bpre[g] = ownfirst ? Bc : Bc1;
        Ac = A2 * Ac1; Bc = A2 * Bc1 + B2; }
    At = Ac; Bt = Bc;
}
template <bool REV>
__device__ __forceinline__ void scan_finish(const float (&a)[16], const float (&b)[16], const float (&Apre)[4], const float (&Bpre)[4], float hin, float* hp, int hi) {
#pragma unroll
    for (int g = 0; g < 4; ++g) { float hc = Apre[g] * hin + Bpre[g];
#pragma unroll
        for (int ii = 0; ii < 4; ++ii) { const int r = 4 * g + (REV ? 3 - ii : ii); hc = a[r] * hc + b[r]; hp[(size_t)crow(r, hi) * 512] = hc; } }
}

template <bool REV>
__device__ __forceinline__ void rnn_dir(Frame& F, bool lat, int seq, int n) {
    const int lane = F.lane, w4 = F.wave & 3, r32 = lane & 31, hi = lane >> 5, dirh = REV ? 1 : 0;
    const int S = lat ? SEQ_L : SEQ_C, tokbase = lat ? NCTX + seq * SEQ_L : seq * SEQ_C, nchunk = S / 128;
    unsigned char* hb = F.lds + dirh * RL_HALF;
    float* XC32 = (float*)hb; unsigned char* XCB = hb + RL_XCB;
    f32x2* AGG = (f32x2*)(F.lds + RL_AGG) + dirh * 256; float* CARRY = (float*)(F.lds + RL_CARRY) + dirh * 64; const float* CW = (const float*)(F.lds + RL_CW);
    const unsigned char* WG = F.lds + RL_WG + dirh * 16384;
    const bf16* XR = (const bf16*)(F.ws + WS_XR) + (size_t)tokbase * 512 + n * 64;
    float* HX = (float*)(F.ws + (REV ? WS_H : WS_HF)) + (size_t)tokbase * 512 + n * 64;
    const int t = F.tid & 255, c8 = t & 7, tg = t >> 3;
    float ba[2], bi[2], sp8[2];
#pragma unroll
    for (int chh = 0; chh < 2; ++chh) { const int pe = dirh * 512 + n * 64 + chh * 32 + r32; ba[chh] = -LOG2E * F.in[I_RGBA][pe]; bi[chh] = -LOG2E * F.in[I_RGBI][pe];
        const float nl = -F.in[I_RGLAM][pe]; sp8[chh] = -8.f * LOG2E * (nl > 20.f ? nl : log1pf(__expf(nl))); }
    v4u xin[7];
#define RL_XLOAD(c0_) do { _Pragma("unroll") for (int i = 0; i < 7; ++i) { const int pos = (c0_) + 4 * tg - 2 + i; \
        xin[i] = (pos >= 0 && pos < S) ? *(const v4u*)(XR + (size_t)pos * 512 + 8 * c8) : (v4u){0u, 0u, 0u, 0u}; } } while (0)
    RL_XLOAD((REV ? nchunk - 1 : 0) * 128);
    float newcarry[2] = {0.f, 0.f};
    const bool last_tile = REV ? (w4 == 0) : (w4 == 3);
#pragma unroll 1
    for (int k = 0; k < nchunk; ++k) {
        const int c0 = (REV ? nchunk - 1 - k : k) * 128;
        {
            const f32x4 b0 = *(const f32x4*)(CW + 256 + 8 * c8), b1 = *(const f32x4*)(CW + 256 + 8 * c8 + 4);
            f32x4 wt0[4], wt1[4];
#pragma unroll
            for (int tap = 0; tap < 4; ++tap) { wt0[tap] = *(const f32x4*)(CW + tap * 64 + 8 * c8); wt1[tap] = *(const f32x4*)(CW + tap * 64 + 8 * c8 + 4); }
#pragma unroll
            for (int i = 0; i < 4; ++i) {
                f32x4 y0 = b0, y1 = b1;
#pragma unroll
                for (int tap = 0; tap < 4; ++tap) { const v4u x = xin[i + tap];
                    y0[0] += wt0[tap][0] * bflo(x.x); y0[1] += wt0[tap][1] * bfhi(x.x); y0[2] += wt0[tap][2] * bflo(x.y); y0[3] += wt0[tap][3] * bfhi(x.y);
                    y1[0] += wt1[tap][0] * bflo(x.z); y1[1] += wt1[tap][1] * bfhi(x.z); y1[2] += wt1[tap][2] * bflo(x.w); y1[3] += wt1[tap][3] * bfhi(x.w); }
                const int tk = 4 * tg + i;
                *(f32x4*)(XC32 + tk * 64 + 8 * c8) = y0; *(f32x4*)(XC32 + tk * 64 + 8 * c8 + 4) = y1;
                v4u w; w.x = pk2(y0[0], y0[1]); w.y = pk2(y0[2], y0[3]); w.z = pk2(y1[0], y1[1]); w.w = pk2(y1[2], y1[3]);
                *(v4u*)(XCB + tk * 128 + ((c8 ^ (tk & 7)) * 16)) = w; }
        }
        if (k + 1 < nchunk) RL_XLOAD((REV ? nchunk - 2 - k : k + 1) * 128);
        __syncthreads();
        if (k > 0 && last_tile && hi == 0) { CARRY[r32] = newcarry[0]; CARRY[32 + r32] = newcarry[1]; }
        const int tkA = 32 * w4 + r32;
#pragma unroll
        for (int chh = 0; chh < 2; ++chh) {
            const int che = chh * 32 + r32;
            float av[16], bv[16], Apre[4], Bpre[4];
            {
                f32x16 ga, gi;
#pragma unroll
                for (int r = 0; r < 16; ++r) { ga[r] = 0.f; gi[r] = 0.f; }
#pragma unroll
                for (int ks = 0; ks < 4; ++ks) {
                    const bf16x8 af = *(const bf16x8*)(XCB + tkA * 128 + (((2 * ks + hi) ^ (tkA & 7)) * 16));
                    const bf16x8 wa = *(const bf16x8*)(WG + che * 128 + (((2 * ks + hi) ^ (che & 7)) * 16));
                    const bf16x8 wi = *(const bf16x8*)(WG + 8192 + che * 128 + (((2 * ks + hi) ^ (che & 7)) * 16));
                    ga = __builtin_amdgcn_mfma_f32_32x32x16_bf16(af, wa, ga, 0, 0, 0);
                    gi = __builtin_amdgcn_mfma_f32_32x32x16_bf16(af, wi, gi, 0, 0, 0);
                }
#pragma unroll
                for (int r = 0; r < 16; ++r) { const int tk2 = 32 * w4 + crow(r, hi); const float x = XC32[tk2 * 64 + che];
                    const float rg = __builtin_amdgcn_rcpf(1.f + __builtin_amdgcn_exp2f(ga[r] + ba[chh])), ig = __builtin_amdgcn_rcpf(1.f + __builtin_amdgcn_exp2f(gi[r] + bi[chh])), a = __builtin_amdgcn_exp2f(rg * sp8[chh]);
                    av[r] = a; bv[r] = __builtin_amdgcn_sqrtf(fmaxf(1.f - a * a, 0.f)) * ig * x;
                    if ((r & 3) == 3) __builtin_amdgcn_sched_barrier(0); }
                float At, Bt;
                scan_prep<REV>(av, bv, hi, Apre, Bpre, At, Bt);
                if (hi == 0) { f32x2 ab; ab.x = At; ab.y = Bt; AGG[chh * 512 + w4 * 64 + che] = ab; }
            }
            __syncthreads();
            {
                float hin = CARRY[che];
                if (!REV) { for (int t2 = 0; t2 < w4; ++t2) { const f32x2 ab = AGG[chh * 512 + t2 * 64 + che]; hin = ab.x * hin + ab.y; } }
                else { for (int t2 = 3; t2 > w4; --t2) { const f32x2 ab = AGG[chh * 512 + t2 * 64 + che]; hin = ab.x * hin + ab.y; } }
                scan_finish<REV>(av, bv, Apre, Bpre, hin, HX + (size_t)(c0 + 32 * w4) * 512 + che, hi);
                if (last_tile) { const f32x2 ab = AGG[chh * 512 + w4 * 64 + che]; newcarry[chh] = ab.x * hin + ab.y; }
            }
        }
    }
#undef RL_XLOAD
    if (!lat && last_tile && hi == 0) { float* o = F.out + O_NEWRNN + (size_t)(seq * 2 + dirh) * 512 + n * 64; o[r32] = newcarry[0]; o[32 + r32] = newcarry[1]; }
}

__device__ __forceinline__ void rnn_unit(Frame& F, bool lat, int seq, int n) {
    const int tid = F.tid;
    const int S = lat ? SEQ_L : SEQ_C, tokbase = lat ? NCTX + seq * SEQ_L : seq * SEQ_C;
    __syncthreads();
    { float* CW = (float*)(F.lds + RL_CW); float* CARRY = (float*)(F.lds + RL_CARRY);
      if (tid < 320) CW[tid] = tid < 256 ? F.in[I_CONVW][(tid >> 6) * 512 + n * 64 + (tid & 63)] : F.in[I_CONVB][n * 64 + (tid - 256)];
      if (tid < 128) CARRY[tid] = lat ? F.in[I_SRNN][(size_t)(seq * 2 + (tid >> 6)) * 512 + n * 64 + (tid & 63)] : 0.f;
      const bf16* rgw = (const bf16*)(F.ws + WS_RGW);
#pragma unroll
      for (int i = 0; i < 4; ++i) { const int q = tid + 512 * i, ch = q & 7, d = (q >> 3) & 63, gate = (q >> 9) & 1, dir = q >> 10;
          const v4u w = *(const v4u*)(rgw + (size_t)((dir * 8 + n) * 2 + gate) * 4096 + d * 64 + ch * 8);
          *(v4u*)(F.lds + RL_WG + dir * 16384 + gate * 8192 + d * 128 + ((ch ^ (d & 7)) * 16)) = w; } }
    __syncthreads();
    if (F.wave < 4) rnn_dir<false>(F, lat, seq, n); else rnn_dir<true>(F, lat, seq, n);
    __syncthreads();
    { const int c4 = tid & 15, tk = tid >> 4;
      const float* HF = (const float*)(F.ws + WS_HF) + (size_t)tokbase * 512 + n * 64 + 4 * c4;
      const float* HB = (const float*)(F.ws + WS_H) + (size_t)tokbase * 512 + n * 64 + 4 * c4;
      const bf16* YG = (const bf16*)(F.ws + WS_YG) + (size_t)tokbase * 512 + n * 64 + 4 * c4;
      bf16* MIX = (bf16*)(F.ws + WS_MIX) + (size_t)tokbase * DM + 512 + n * 64 + 4 * c4;
      for (int t0 = tk; t0 < S; t0 += 32) {
          const f32x4 a = *(const f32x4*)(HF + (size_t)t0 * 512), b = *(const f32x4*)(HB + (size_t)t0 * 512); const v2u y = *(const v2u*)(YG + (size_t)t0 * 512);
          v2u o; o.x = pk2((a[0] + b[0]) * gelu_fast(bflo(y.x)), (a[1] + b[1]) * gelu_fast(bfhi(y.x))); o.y = pk2((a[2] + b[2]) * gelu_fast(bflo(y.y)), (a[3] + b[3]) * gelu_fast(bfhi(y.y)));
          *(v2u*)(MIX + (size_t)t0 * DM) = o; } }
    __syncthreads();
}

#ifndef MK_P3_TYPES
#define MK_P3_TYPES 15
#endif
__device__ __forceinline__ void p3_phase(Frame& F, int types = 15) {
    const int v = F.vcu;
#pragma unroll 1
    for (int i = 0; i < 832; ++i) {
        int type, idx;
        if (F.G == 256) {
            if (v < 64) { if (i > 0) break; type = 0; idx = v; }
            else { if (i >= 6) break; const int j = v - 64, sl = i >> 1, rep = i & 1; type = 1 + sl;
                const bool extra = sl == 0 ? (j < 64) : (sl == 1 ? (j >= 64 && j < 128) : (j >= 128));
                if (rep && !extra) continue; idx = rep ? 192 + (j - 64 * sl) : j; }
        } else { const int it = v + i * F.G; if (it >= 832) break;
            if (it < 64) { type = 0; idx = it; } else if (it < 320) { type = 1; idx = it - 64; } else if (it < 576) { type = 2; idx = it - 320; } else { type = 3; idx = it - 576; } }
        if (!((types >> type) & 1)) continue;
        const bool lat = type < 2;
        Frame L = F; asm volatile("" : "+v"(L.tid)); L.lane = L.tid & 63;
        asm volatile("" : "+s"(L.ws), "+s"(L.out));
        if ((type & 1) == 0) rnn_unit(L, lat, idx >> 3, idx & 7);
        else { if (lat) attn_unit(L, true, idx >> 5, (idx >> 4) & 1, idx & 15); else attn_unit(L, false, idx >> 3, (idx >> 2) & 1, idx & 3); }
    }
}

__device__ __forceinline__ unsigned key16(unsigned b, unsigned idx) { const unsigned s = (b & 0x8000u) ? (~b & 0xffffu) : (b | 0x8000u); return (s << 16) | idx; }
__device__ __forceinline__ float keyval16(unsigned k) { const unsigned s = k >> 16; const unsigned b = (s & 0x8000u) ? (s & 0x7fffu) : (~s & 0xffffu); return bf2f(b); }
__device__ __forceinline__ unsigned sortable32(float f) { const unsigned u = __builtin_bit_cast(unsigned, f); return (u & 0x80000000u) ? ~u : (u | 0x80000000u); }
template <int CTRL> __device__ __forceinline__ unsigned dppu(unsigned v) { return (unsigned)__builtin_amdgcn_update_dpp(0, (int)v, CTRL, 0xf, 0xf, true); }
template <int CTRL> __device__ __forceinline__ float dppf(float v) { return __builtin_bit_cast(float, __builtin_amdgcn_update_dpp(0, __builtin_bit_cast(int, v), CTRL, 0xf, 0xf, true)); }
__device__ __forceinline__ unsigned umax_(unsigned a, unsigned b) { return a > b ? a : b; }
__device__ __forceinline__ unsigned umin_(unsigned a, unsigned b) { return a < b ? a : b; }
__device__ __forceinline__ unsigned rowmax16u(unsigned x) { x = umax_(x, dppu<0xB1>(x)); x = umax_(x, dppu<0x4E>(x)); x = umax_(x, dppu<0x141>(x)); x = umax_(x, dppu<0x140>(x)); return x; }
__device__ __forceinline__ float rowmax16f(float x) { x = fmaxf(x, dppf<0xB1>(x)); x = fmaxf(x, dppf<0x4E>(x)); x = fmaxf(x, dppf<0x141>(x)); x = fmaxf(x, dppf<0x140>(x)); return x; }
__device__ __forceinline__ float rowsum16f(float x) { x += dppf<0xB1>(x); x += dppf<0x4E>(x); x += dppf<0x141>(x); x += dppf<0x140>(x); return x; }
__device__ __forceinline__ int rowsum16i(int x) { x += (int)dppu<0xB1>((unsigned)x); x += (int)dppu<0x4E>((unsigned)x); x += (int)dppu<0x141>((unsigned)x); x += (int)dppu<0x140>((unsigned)x); return x; }
#define CEX(a, b) do { const unsigned _h = umax_(a, b), _l = umin_(a, b); a = _h; b = _l; } while (0)

#ifndef P7_NCH
#define P7_NCH 8
#endif
constexpr int P7_CSH = (P7_NCH == 4 ? 12 : (P7_NCH == 8 ? 11 : (P7_NCH == 16 ? 10 : 9)));
constexpr int P7_WL = 16384;
constexpr int P7_TL = 0, P7_TE = 1024, P7_TG = 3072, P7_LE = 5120, P7_LG = 7168, P7_LSU = 9216, P7_LQ = 11264, P7_H2Q = 12160, P7_HST = 16256;
static_assert(P7_LQ + 512 <= P7_H2Q && (P7_H2Q % 16) == 0 && P7_HST + 16 <= P7_WL && P7_WL * 8 <= RING_BYTES, "P7 LDS map");

#define TK_KEYS(R, raw, kb) unsigned R##0 = key16(raw.x & 0xffffu, (kb) + 0), R##1 = key16(raw.x >> 16, (kb) + 1), R##2 = key16(raw.y & 0xffffu, (kb) + 2), R##3 = key16(raw.y >> 16, (kb) + 3), \
        R##4 = key16(raw.z & 0xffffu, (kb) + 4), R##5 = key16(raw.z >> 16, (kb) + 5), R##6 = key16(raw.w & 0xffffu, (kb) + 6), R##7 = key16(raw.w >> 16, (kb) + 7)
#define TK_SORT8(R) do { CEX(R##0, R##1); CEX(R##2, R##3); CEX(R##4, R##5); CEX(R##6, R##7); CEX(R##0, R##2); CEX(R##1, R##3); CEX(R##4, R##6); CEX(R##5, R##7); CEX(R##1, R##2); CEX(R##5, R##6); \
        CEX(R##0, R##4); CEX(R##1, R##5); CEX(R##2, R##6); CEX(R##3, R##7); CEX(R##2, R##4); CEX(R##3, R##5); CEX(R##1, R##2); CEX(R##3, R##4); CEX(R##5, R##6); } while (0)
#define TK_POP8(R, KEEP, it) do { const unsigned m_ = rowmax16u(R##0); const bool w_ = R##0 == m_; R##0 = w_ ? R##1 : R##0; R##1 = w_ ? R##2 : R##1; R##2 = w_ ? R##3 : R##2; R##3 = w_ ? R##4 : R##3; \
        R##4 = w_ ? R##5 : R##4; R##5 = w_ ? R##6 : R##5; R##6 = w_ ? R##7 : R##6; R##7 = w_ ? 0u : R##7; KEEP = (k == (it)) ? m_ : KEEP; } while (0)
#define TK_POP4(C, KEEP, it) do { const unsigned m_ = rowmax16u(C[0]); const bool w_ = C[0] == m_; C[0] = w_ ? C[1] : C[0]; C[1] = w_ ? C[2] : C[1]; C[2] = w_ ? C[3] : C[2]; C[3] = w_ ? 0u : C[3]; KEEP = (k == (it)) ? m_ : KEEP; } while (0)
__device__ __forceinline__ void topk_token(const v4u (&rawv)[4], unsigned* TL, int lane, const unsigned ctabp, int* oute, float* outg) {
    const int k = lane & 15, row = lane >> 4;
#pragma unroll
    for (int pp = 0; pp < 2; ++pp) {
        const v4u rawa = rawv[2 * pp], rawb = rawv[2 * pp + 1];
        TK_KEYS(a, rawa, k * 8); TK_KEYS(b, rawb, k * 8);
        TK_SORT8(a); TK_SORT8(b);
        unsigned keepa = 0, keepb = 0;
#pragma unroll
        for (int it = 0; it < 16; ++it) { TK_POP8(a, keepa, it); TK_POP8(b, keepb, it); }
        TL[((2 * pp) * 4 + row) * 16 + k] = keepa; TL[((2 * pp + 1) * 4 + row) * 16 + k] = keepb;
    }
    unsigned ca[4], cb[4];
    const unsigned* LAa = TL + (2 * row) * 16; const unsigned* LBa = TL + (2 * row + 1) * 16;
    const unsigned* LAb = TL + (2 * (4 + row)) * 16; const unsigned* LBb = TL + (2 * (4 + row) + 1) * 16;
#pragma unroll
    for (int s = 0; s < 4; ++s) { const int ij = (int)((ctabp >> (8 * s)) & 0xffu); const bool valid = ij != 255; const int i = (ij >> 4) & 15, j = ij & 15;
        const float sa = keyval16(LAa[i]) + keyval16(LBa[j]), sb = keyval16(LAb[i]) + keyval16(LBb[j]);
        ca[s] = valid ? ((sortable32(sa) & 0xffffff00u) | (unsigned)(i * 16 + j)) : 0u; cb[s] = valid ? ((sortable32(sb) & 0xffffff00u) | (unsigned)(i * 16 + j)) : 0u; }
    CEX(ca[0], ca[1]); CEX(ca[2], ca[3]); CEX(ca[0], ca[2]); CEX(ca[1], ca[3]); CEX(ca[1], ca[2]);
    CEX(cb[0], cb[1]); CEX(cb[2], cb[3]); CEX(cb[0], cb[2]); CEX(cb[1], cb[3]); CEX(cb[1], cb[2]);
    unsigned keepa = 0, keepb = 0;
#pragma unroll
    for (int it = 0; it < 16; ++it) { TK_POP4(ca, keepa, it); TK_POP4(cb, keepb, it); }
    {
        const unsigned kaa = LAa[(keepa >> 4) & 15], kba = LBa[keepa & 15], kab = LAb[(keepb >> 4) & 15], kbb = LBb[keepb & 15];
        const float bva = keyval16(kaa) + keyval16(kba), bvb = keyval16(kab) + keyval16(kbb);
        const float mxa = rowmax16f(bva), mxb = rowmax16f(bvb); const float exa = __expf(bva - mxa), exb = __expf(bvb - mxb); const float sma = rowsum16f(exa), smb = rowsum16f(exb);
        oute[lane] = (int)((kaa & 127u) * 128u + (kba & 127u)); outg[lane] = exa / sma;
        oute[64 + lane] = (int)((kab & 127u) * 128u + (kbb & 127u)); outg[64 + lane] = exb / smb;
    }
}
#undef TK_KEYS
#undef TK_SORT8
#undef TK_POP8
#undef TK_POP4

__device__ __forceinline__ void gl16x4(v4u (&r)[4], unsigned voff, const unsigned char* b0, const unsigned char* b1, const unsigned char* b2, const unsigned char* b3) {
    asm volatile("s_nop 4\n\tglobal_load_dwordx4 %0, %4, %5\n\tglobal_load_dwordx4 %1, %4, %6\n\tglobal_load_dwordx4 %2, %4, %7\n\tglobal_load_dwordx4 %3, %4, %8"
                 : "=&v"(r[0]), "=&v"(r[1]), "=&v"(r[2]), "=&v"(r[3]) : "v"(voff), "s"(b0), "s"(b1), "s"(b2), "s"(b3) : "memory");
}
#define P7_VMWAIT(N, R) asm volatile("s_waitcnt vmcnt(" #N ")" : "+v"(R[0]), "+v"(R[1]), "+v"(R[2]), "+v"(R[3]) :: "memory")
__device__ __forceinline__ int mbcnt64(unsigned long long m) { return (int)__builtin_amdgcn_mbcnt_hi((unsigned)(m >> 32), __builtin_amdgcn_mbcnt_lo((unsigned)m, 0u)); }
__device__ __forceinline__ int rfl(int v) { return __builtin_amdgcn_readfirstlane(v); }
__device__ __forceinline__ float rflf(float v) { return __builtin_bit_cast(float, __builtin_amdgcn_readfirstlane(__builtin_bit_cast(int, v))); }

__device__ __forceinline__ void p7_phase(Frame& F, bool dry) {
    const int lane0 = F.lane, wave = F.wave;
    if (dry && (MK_DRY_SKIP & 16) && wave >= 4) return;
    unsigned char* wl = F.lds + wave * P7_WL;
    unsigned* TL = (unsigned*)(wl + P7_TL); int* TE = (int*)(wl + P7_TE); float* TG = (float*)(wl + P7_TG);
    float* LG = (float*)(wl + P7_LG); float* LSU = (float*)(wl + P7_LSU); unsigned char* H2Q = wl + P7_H2Q; float* HST = (float*)(wl + P7_HST);
    const bf16* SC = (const bf16*)(F.ws + WS_SC); const bf16* H2 = (const bf16*)(F.ws + WS_H);
    const unsigned char* U8 = F.ws + WS_U; const unsigned char* V8 = F.ws + WS_V;
    const float* SU = (const float*)(F.ws + WS_SU); const float* SV = (const float*)(F.ws + WS_SV);
    const float* mods = (const float*)(F.ws + WS_MODS); const float* SSP = (const float*)(F.ws + WS_SSP);
    unsigned ctabp = 0;
#pragma unroll
    for (int s = 0; s < 4; ++s) { const int c = 16 * s + (lane0 & 15); int i, j;
        if (c < 16) { i = 0; j = c; } else if (c < 24) { i = 1; j = c - 16; } else if (c < 29) { i = 2; j = c - 24; } else if (c < 33) { i = 3; j = c - 29; } else if (c < 36) { i = 4; j = c - 33; }
        else if (c < 38) { i = 5; j = c - 36; } else if (c < 40) { i = 6; j = c - 38; } else if (c < 42) { i = 7; j = c - 40; } else if (c < 50) { i = c - 34; j = 0; } else { i = -1; j = 0; }
        ctabp |= (unsigned)(i < 0 ? 255 : i * 16 + j) << (8 * s); }
    const int ntg = NTOK / (F.G * NWAVES * 4);
#pragma unroll 1
    for (int tg = 0; tg < ntg; ++tg) {
        const int tok0 = (F.vcu * ntg + tg) * (NWAVES * 4) + wave * 4;
        int lane = F.lane; asm volatile("" : "+v"(lane));
        {
            v4u craw[4], nraw[4]; v4u ch0, ch1, nh0, nh1;
#define P7_TLOAD(R, H0, H1, tk) do { const bf16* sp_ = SC + (size_t)(tk) * 2048 + (lane >> 4) * 128 + (lane & 15) * 8; \
                _Pragma("unroll") for (int ps = 0; ps < 4; ++ps) R[ps] = *(const v4u*)(sp_ + ps * 512); \
                H0 = *(const v4u*)(H2 + (size_t)(tk) * DM + 16 * lane); H1 = *(const v4u*)(H2 + (size_t)(tk) * DM + 16 * lane + 8); } while (0)
            P7_TLOAD(craw, ch0, ch1, tok0);
#pragma unroll 1
            for (int s = 0; s < 4; ++s) {
                if (s < 3) P7_TLOAD(nraw, nh0, nh1, tok0 + s + 1);
                const int tokc = tok0 + s;
                const f32x4* spp = (const f32x4*)(SSP + (size_t)tokc * 16); const f32x4 q0 = spp[0], q1 = spp[1], q2 = spp[2], q3 = spp[3];
                const float* shp = mods + (size_t)mod_index(tokc) * MODW + 3 * DM + 16 * lane;
                const f32x4 sh0 = *(const f32x4*)(shp), sh1 = *(const f32x4*)(shp + 4), sh2v = *(const f32x4*)(shp + 8), sh3 = *(const f32x4*)(shp + 12);
                unsigned ctab_ = ctabp; asm volatile("" : "+v"(ctab_));
                topk_token(craw, TL, lane, ctab_, TE + s * 128, TG + s * 128);
                const v4u a = ch0, b = ch1;
                const float ssr = ((q0[0] + q0[1]) + (q0[2] + q0[3])) + ((q1[0] + q1[1]) + (q1[2] + q1[3])) + ((q2[0] + q2[1]) + (q2[2] + q2[3])) + ((q3[0] + q3[1]) + (q3[2] + q3[3]));
                const float rstd = 1.f / sqrtf(ssr * (1.f / DM) + EPS);
                float hv[16];
                hv[0] = bflo(a.x); hv[1] = bfhi(a.x); hv[2] = bflo(a.y); hv[3] = bfhi(a.y); hv[4] = bflo(a.z); hv[5] = bfhi(a.z); hv[6] = bflo(a.w); hv[7] = bfhi(a.w);
                hv[8] = bflo(b.x); hv[9] = bfhi(b.x); hv[10] = bflo(b.y); hv[11] = bfhi(b.y); hv[12] = bflo(b.z); hv[13] = bfhi(b.z); hv[14] = bflo(b.w); hv[15] = bfhi(b.w);
#pragma unroll
                for (int i = 0; i < 4; ++i) { hv[i] = hv[i] * rstd + sh0[i]; hv[4 + i] = hv[4 + i] * rstd + sh1[i]; hv[8 + i] = hv[8 + i] * rstd + sh2v[i]; hv[12 + i] = hv[12 + i] * rstd + sh3[i]; }
                float am = 0.f;
#pragma unroll
                for (int i = 0; i < 16; ++i) am = fmaxf(am, fabsf(hv[i]));
                am = wave_max(am);
                const float inv = am > 0.f ? 119.f / am : 0.f;
                if (lane == 0) HST[s] = am * (1.f / 119.f);
                v4u qv;
#pragma unroll
                for (int j = 0; j < 4; ++j) { unsigned w = 0;
#pragma unroll
                    for (int i = 0; i < 4; ++i) { int q = (int)rintf(hv[4 * j + i] * inv); w |= ((unsigned)q & 0xffu) << (8 * i); }
                    qv[j] = w; }
                *(v4u*)(H2Q + s * 1024 + 16 * lane) = qv;
#pragma unroll
                for (int ps = 0; ps < 4; ++ps) craw[ps] = nraw[ps];
                ch0 = nh0; ch1 = nh1;
            }
#undef P7_TLOAD
        }
        {
            unsigned* LEO = (unsigned*)(wl + P7_LE);
            int ee0[4], ee1[4]; float gg0[4], gg1[4], us0[4], us1[4], vs0[4], vs1[4];
#pragma unroll
            for (int s = 0; s < 4; ++s) { ee0[s] = TE[s * 128 + lane]; ee1[s] = TE[s * 128 + 64 + lane]; gg0[s] = TG[s * 128 + lane]; gg1[s] = TG[s * 128 + 64 + lane]; }
#pragma unroll
            for (int s = 0; s < 4; ++s) { us0[s] = SU[ee0[s]]; us1[s] = SU[ee1[s]]; vs0[s] = SV[ee0[s]]; vs1[s] = SV[ee1[s]]; }
#pragma unroll
            for (int s = 0; s < 4; ++s) { const int e0 = ee0[s], e1 = ee1[s]; const int c0 = e0 >> P7_CSH, c1 = e1 >> P7_CSH; int base = s * 128;
#pragma unroll
                for (int c = 0; c < P7_NCH; ++c) {
                    const unsigned long long m0 = __ballot(c0 == c), m1 = __ballot(c1 == c);
                    const int n0 = __popcll(m0), n = n0 + __popcll(m1);
                    if (c0 == c) { const int p = base + mbcnt64(m0); LEO[p] = (unsigned)e0 << 10; LG[p] = gg0[s] * vs0[s]; LSU[p] = us0[s]; }
                    if (c1 == c) { const int p = base + n0 + mbcnt64(m1); LEO[p] = (unsigned)e1 << 10; LG[p] = gg1[s] * vs1[s]; LSU[p] = us1[s]; }
                    base += n;
                } }
        }
        typedef __attribute__((address_space(1))) v4u GV4;
#define P7_SLOAD(R, t, BASE) do { const v4u eo_ = *(const v4u*)(LEOs + 4 * (t)); \
            _Pragma("unroll") for (int r = 0; r < 4; ++r) { unsigned o_ = eo_[r] + j16; asm volatile("" : "+v"(o_)); \
                _Pragma("unroll") for (int i = 0; i < 4; ++i) R[r][i] = *(const GV4*)(BASE + o_ + 256 * i); } \
            __builtin_amdgcn_sched_barrier(0); } while (0)
        if (!(dry && (MK_DRY_SKIP & 1))) {
            int lane_u = F.lane; asm volatile("" : "+v"(lane_u));
            const int su = lane_u >> 4, ju = lane_u & 15; const unsigned j16 = 16u * (unsigned)ju;
            const unsigned* LEOs = (const unsigned*)(wl + P7_LE) + su * 128; float* LGs = LG + su * 128; const float* LSUs = LSU + su * 128;
            const unsigned long long u8i = (unsigned long long)U8;
            unsigned hh[2][4], hl[2][4];
#pragma unroll
            for (int i = 0; i < 2; ++i) { const v4u ha = *(const v4u*)(H2Q + su * 1024 + 512 * i + 32 * ju), hb = *(const v4u*)(H2Q + su * 1024 + 512 * i + 32 * ju + 16);
#pragma unroll
                for (int w = 0; w < 4; ++w) { unsigned lo16[2], hi16[2];
#pragma unroll
                    for (int h = 0; h < 2; ++h) { const unsigned d = (w < 2 ? ha : hb)[2 * (w & 1) + h];
                        const unsigned t = ((d & 0x7f7f7f7fu) + 0x08080808u) ^ (d & 0x80808080u);
                        unsigned l = (t & 0x0f0f0f0fu) ^ 0x08080808u, g = (t >> 4) & 0x0f0f0f0fu;
                        l = (l | (l >> 4)) & 0x00ff00ffu; l = (l | (l >> 8)) & 0xffffu; g = (g | (g >> 4)) & 0x00ff00ffu; g = (g | (g >> 8)) & 0xffffu;
                        lo16[h] = l; hi16[h] = g; }
                    hl[i][w] = lo16[0] | (lo16[1] << 16); hh[i][w] = hi16[0] | (hi16[1] << 16); } }
            const float hs = HST[su];
            const bool b0 = (ju & 1) != 0, b1 = (ju & 2) != 0; const int rr = ju & 3;
            v4u A[4][2], B[4][2], C[4][2], D[4][2];
#define P7_ULOAD(R, t) do { const v4u eo_ = *(const v4u*)(LEOs + 4 * (t)); \
            _Pragma("unroll") for (int r = 0; r < 4; ++r) { unsigned o_ = (eo_[r] >> 1) + j16; asm volatile("" : "+v"(o_)); \
                R[r][0] = *(const GV4*)(u8i + o_); R[r][1] = *(const GV4*)(u8i + o_ + 256); } \
            __builtin_amdgcn_sched_barrier(0); } while (0)
#define P7_SCOMP_U(R, t) do { const float su_ = LSUs[4 * (t) + rr], g_ = LGs[4 * (t) + rr]; int p_[4]; \
                _Pragma("unroll") for (int r = 0; r < 4; ++r) { int ah = 0, al = 0; \
                    _Pragma("unroll") for (int i = 0; i < 2; ++i) { _Pragma("unroll") for (int w = 0; w < 4; ++w) { \
                        ah = __builtin_amdgcn_sdot8((int)hh[i][w], (int)R[r][i][w], ah, false); al = __builtin_amdgcn_sdot8((int)hl[i][w], (int)R[r][i][w], al, false); } } \
                    p_[r] = 16 * ah + al; } \
                const int q01 = (b0 ? p_[1] : p_[0]) + (int)dppu<0xB1>((unsigned)(b0 ? p_[0] : p_[1])); const int q23 = (b0 ? p_[3] : p_[2]) + (int)dppu<0xB1>((unsigned)(b0 ? p_[2] : p_[3])); \
                int q_ = (b1 ? q23 : q01) + (int)dppu<0x4E>((unsigned)(b1 ? q01 : q23)); q_ += (int)dppu<0x128>((unsigned)q_); q_ += (int)dppu<0x124>((unsigned)q_); \
                const float dotf = (float)q_ * (hs * su_); LGs[4 * (t) + rr] = g_ * gelu_fast(dotf); } while (0)
            P7_ULOAD(A, 0); P7_ULOAD(B, 1); P7_ULOAD(C, 2);
#pragma unroll 1
            for (int t = 0; t < 28; t += 4) {
                P7_ULOAD(D, t + 3); P7_SCOMP_U(A, t);
                P7_ULOAD(A, t + 4); P7_SCOMP_U(B, t + 1);
                P7_ULOAD(B, t + 5); P7_SCOMP_U(C, t + 2);
                P7_ULOAD(C, t + 6); P7_SCOMP_U(D, t + 3);
                asm volatile("" ::: "memory");
            }
            P7_ULOAD(D, 31); P7_SCOMP_U(A, 28); P7_SCOMP_U(B, 29); P7_SCOMP_U(C, 30); P7_SCOMP_U(D, 31);
#undef P7_SCOMP_U
#undef P7_ULOAD
        }
        float cscale;
        {
            int lane_q = F.lane; asm volatile("" : "+v"(lane_q));
            const int sq = lane_q >> 4, jq = lane_q & 15;
            const float* lg = LG + sq * 128 + 8 * jq; const f32x4 c0 = *(const f32x4*)lg, c1 = *(const f32x4*)(lg + 4);
            float m = fmaxf(fmaxf(fmaxf(fabsf(c0[0]), fabsf(c0[1])), fmaxf(fabsf(c0[2]), fabsf(c0[3]))), fmaxf(fmaxf(fabsf(c1[0]), fabsf(c1[1])), fmaxf(fabsf(c1[2]), fabsf(c1[3]))));
            m = rowmax16f(m);
            cscale = m * (1.f / 127.f); const float iv = m > 0.f ? 127.f / m : 0.f;
            v2u w; w.x = 0u; w.y = 0u;
#pragma unroll
            for (int k = 0; k < 4; ++k) { w.x |= ((unsigned)(int)rintf(c0[k] * iv) & 0xffu) << (8 * k); w.y |= ((unsigned)(int)rintf(c1[k] * iv) & 0xffu) << (8 * k); }
            *(v2u*)(wl + P7_LQ + (sq * 32 + 2 * jq) * 4) = w;
        }
        int acc[64];
#pragma unroll
        for (int i = 0; i < 64; ++i) acc[i] = 0;
        if (!(dry && (MK_DRY_SKIP & 2))) {
            int lane_v = F.lane; asm volatile("" : "+v"(lane_v));
            const int sv_ = lane_v >> 4, jv = lane_v & 15; const unsigned j16 = 16u * (unsigned)jv;
            const unsigned* LEOs = (const unsigned*)(wl + P7_LE) + sv_ * 128; const int* LQs = (const int*)(wl + P7_LQ) + sv_ * 32;
            const unsigned long long v8i = (unsigned long long)V8;
            v4u A[4][4], B[4][4];
#define P7_SCOMP_V(R, t) do { const int cq_ = LQs[(t)]; \
                _Pragma("unroll") for (int i = 0; i < 4; ++i) { _Pragma("unroll") for (int w = 0; w < 4; ++w) { \
                    const unsigned x_ = __builtin_amdgcn_perm(R[1][i][w], R[0][i][w], 0x05010400u), y_ = __builtin_amdgcn_perm(R[1][i][w], R[0][i][w], 0x07030602u); \
                    const unsigned c_ = __builtin_amdgcn_perm(R[3][i][w], R[2][i][w], 0x05010400u), e_ = __builtin_amdgcn_perm(R[3][i][w], R[2][i][w], 0x07030602u); \
                    const int k0 = (int)__builtin_amdgcn_perm(c_, x_, 0x05040100u), k1 = (int)__builtin_amdgcn_perm(c_, x_, 0x07060302u), k2 = (int)__builtin_amdgcn_perm(e_, y_, 0x05040100u), k3 = (int)__builtin_amdgcn_perm(e_, y_, 0x07060302u); \
                    acc[16 * i + 4 * w + 0] = __builtin_amdgcn_sdot4(k0, cq_, acc[16 * i + 4 * w + 0], false); acc[16 * i + 4 * w + 1] = __builtin_amdgcn_sdot4(k1, cq_, acc[16 * i + 4 * w + 1], false); \
                    acc[16 * i + 4 * w + 2] = __builtin_amdgcn_sdot4(k2, cq_, acc[16 * i + 4 * w + 2], false); acc[16 * i + 4 * w + 3] = __builtin_amdgcn_sdot4(k3, cq_, acc[16 * i + 4 * w + 3], false); } } } while (0)
            P7_SLOAD(A, 0, v8i);
#pragma unroll 1
            for (int t = 0; t < 32; t += 2) {
                P7_SLOAD(B, t + 1, v8i);
                P7_SCOMP_V(A, t);
                P7_SLOAD(A, (t + 2) & 31, v8i);
                P7_SCOMP_V(B, t + 1);
                asm volatile("" ::: "memory");
            }
#undef P7_SCOMP_V
        }
#undef P7_SLOAD
        {
            int lane_f = F.lane; asm volatile("" : "+v"(lane_f));
            const int sf = lane_f >> 4, jf = lane_f & 15; const int tok = tok0 + sf;
            const float* xrow = F.out + O_Y + (size_t)tok * DM + 16 * jf;
            const float* ga2 = mods + (size_t)mod_index(tok0) * MODW + 5 * DM + 16 * jf;
            const float* gf = F.in[I_GFINAL] + 16 * jf;
            float* yrow = dry ? (float*)(F.ws + WS_MIX) + (size_t)(tok & 8191) * DM + 16 * jf : F.out + O_Y + (size_t)tok * DM + 16 * jf;
            float xs[64]; float ss = 0.f;
#pragma unroll
            for (int i = 0; i < 4; ++i) { f32x4 xv[4], gv[4];
#pragma unroll
                for (int w = 0; w < 4; ++w) { xv[w] = *(const f32x4*)(xrow + 256 * i + 4 * w); gv[w] = *(const f32x4*)(ga2 + 256 * i + 4 * w); }
#pragma unroll
                for (int w = 0; w < 4; ++w)
#pragma unroll
                    for (int k = 0; k < 4; ++k) { const float t = xv[w][k] + gv[w][k] * ((float)acc[16 * i + 4 * w + k] * cscale); xs[16 * i + 4 * w + k] = t; ss += t * t; } }
            const float rstd = 1.f / sqrtf(rowsum16f(ss) * (1.f / DM) + EPS);
#pragma unroll
            for (int i = 0; i < 4; ++i) { f32x4 gfv[4];
#pragma unroll
                for (int w = 0; w < 4; ++w) gfv[w] = *(const f32x4*)(gf + 256 * i + 4 * w);
#pragma unroll
                for (int w = 0; w < 4; ++w) { f32x4 o;
#pragma unroll
                    for (int k = 0; k < 4; ++k) o[k] = xs[16 * i + 4 * w + k] * rstd * gfv[w][k];
                    *(f32x4*)(yrow + 256 * i + 4 * w) = o; } }
        }
    }
}

__global__ void __launch_bounds__(NWAVES * 64, 2) mk_fwd(Args args) {
    extern __shared__ __attribute__((aligned(16))) unsigned char lds[];
    Frame F;
    F.lds = lds;
    F.tid = threadIdx.x; F.lane = F.tid & 63; F.wave = __builtin_amdgcn_readfirstlane(F.tid >> 6);
    F.G = gridDim.x; { const int bx = blockIdx.x; F.vcu = (F.G % 8 == 0) ? (bx % 8) * (F.G / 8) + bx / 8 : bx; }
    F.in = args.in; F.out = args.out; F.ws = args.ws;
    LAS unsigned char* lds3 = (LAS unsigned char*)lds;
    volatile LAS unsigned* MISC = (volatile LAS unsigned*)(lds3 + MISC_OFF);
    for (int u = F.tid; u < (LDS_BYTES - LDSCTL_OFF) / 4; u += NWAVES * 64) ((LAS unsigned*)(lds3 + LDSCTL_OFF))[u] = 0u;
    __syncthreads();
    unsigned* ctl = (unsigned*)(args.ws + WS_CTL);
    XcdBarrier bar; bar.bar = ctl + CW_BAR; bar.x = 0; bar.st = nullptr;
    const bool one_launch = (args.ph_hi - args.ph_lo) > 1;
    if (one_launch) bar = xcd_barrier_post(ctl + CW_BAR, MISC + 8);
    const int lo = args.ph_lo, hi = args.ph_hi;
#ifndef MK_PHASE_MASK
#define MK_PHASE_MASK 0xff
#endif
#define IN(k) (((MK_PHASE_MASK >> (k)) & 1) && lo <= (k) && (k) < hi)
#define SEAM(k) do { if (IN(k) && IN((k) + 1)) xcd_barrier(bar); } while (0)

#define DUPQ(k) (MK_DUP == (k))
    if (IN(0)) { if (DUPQ(0)) { p0_phase(F); xcd_barrier(bar); } p0_phase(F); SEAM(0); }
    if (IN(1)) { if (DUPQ(1)) { norm_phase(F, 0); xcd_barrier(bar); } norm_phase(F, 0); bias_items(F); SEAM(1); }
    if (IN(2)) {
        pg8::Gemm g{(const pg8::bf16_t*)(F.ws + WS_H), (const pg8::bf16_t*)(F.ws + WS_WIN), NTOK, D_IN, DM}; pg8::StaticOrder S; S.init(NTOK, D_IN, F.G, (int)blockIdx.x);
        EpiInProj E{(bf16*)(F.ws + WS_Q), (bf16*)(F.ws + WS_K), (bf16*)(F.ws + WS_VT), (bf16*)(F.ws + WS_XR), (bf16*)(F.ws + WS_YG), F.out + O_NEWK, F.out + O_NEWV, (const f32x4*)(F.ws + WS_ROPE)};
        if (DUPQ(2)) { pg8::gemm_phase<EpiInProj, pg8::StaticOrder, true, true>(lds3, g, S, E); xcd_barrier(bar); }
        pg8::gemm_phase<EpiInProj, pg8::StaticOrder, true, true>(lds3, g, S, E);
        SEAM(2);
    }
    if (IN(3)) { if (DUPQ(3)) { p3_phase(F, MK_P3_TYPES); xcd_barrier(bar); } p3_phase(F); SEAM(3); }
    if (IN(4)) {
        pg8::Gemm g{(const pg8::bf16_t*)(F.ws + WS_MIX), (const pg8::bf16_t*)(F.ws + WS_WOUT), NTOK, DM, DM}; pg8::StaticOrder S; S.init(NTOK, DM, F.G, (int)blockIdx.x);
        EpiOutProj E{F.in[I_XP], F.in[I_XS], (const float*)(F.ws + WS_MODS), F.in[I_GFFN], F.out + O_Y, (bf16*)(F.ws + WS_H), (float*)(F.ws + WS_SSP)};
        if (DUPQ(4)) { pg8::gemm_phase<EpiOutProj, pg8::StaticOrder, true, true>(lds3, g, S, E); xcd_barrier(bar); }
        pg8::gemm_phase<EpiOutProj, pg8::StaticOrder, true, true>(lds3, g, S, E);
        SEAM(4);
    }
    if (IN(6)) {
        pg8::Gemm g{(const pg8::bf16_t*)(F.ws + WS_H), (const pg8::bf16_t*)(F.ws + WS_WC), NTOK, 2048, DM}; pg8::StaticOrder S; S.init(NTOK, 2048, F.G, (int)blockIdx.x);
        EpiScores E{(bf16*)(F.ws + WS_SC), (const float*)(F.ws + WS_SSP), (const float*)(F.ws + WS_BIAS)};
        if (DUPQ(6)) { pg8::gemm_phase<EpiScores, pg8::StaticOrder, true, true>(lds3, g, S, E); xcd_barrier(bar); }
        pg8::gemm_phase<EpiScores, pg8::StaticOrder, true, true>(lds3, g, S, E);
        SEAM(6);
    }
    if (IN(7)) { if (DUPQ(7)) { p7_phase(F, true); xcd_barrier(bar); } p7_phase(F, false); }
#undef IN
#undef SEAM
}

extern "C" void kernel_launch(void* const* d_in, const int* in_sizes, int n_in, void* d_out, int out_size, void* d_ws, size_t ws_size, hipStream_t stream) {
    static int grid = 0;
    if (grid == 0) {
        if (n_in != 26 || ws_size < WS_END) { fprintf(stderr, "kernel_launch: unexpected n_in %d / ws %zu\n", n_in, ws_size); grid = -1; return; }
        int dev = 0, cus = 0, per_cu = 0;
        if (hipGetDevice(&dev) != hipSuccess || hipDeviceGetAttribute(&cus, hipDeviceAttributeMultiprocessorCount, dev) != hipSuccess) { grid = -1; return; }
        if (hipFuncSetAttribute((const void*)mk_fwd, hipFuncAttributeMaxDynamicSharedMemorySize, LDS_BYTES) != hipSuccess) { fprintf(stderr, "kernel_launch: hipFuncSetAttribute failed\n"); grid = -1; return; }
        if (hipOccupancyMaxActiveBlocksPerMultiprocessor(&per_cu, (const void*)mk_fwd, NWAVES * 64, LDS_BYTES) != hipSuccess || per_cu < 1)
            fprintf(stderr, "kernel_launch: occupancy query reports %d blocks per CU\n", per_cu);
        (void)hipGetLastError();
        grid = cus;
        if (grid != 256) fprintf(stderr, "kernel_launch: note: %d CUs\n", grid);
    }
    if (grid < 0) return;
    (void)hipMemsetAsync((char*)d_ws + WS_CTL, 0, CTL_ZERO_BYTES, stream);
    Args a{};
    for (int i = 0; i < 26; ++i) a.in[i] = (const float*)d_in[i];
    a.out = (float*)d_out; a.ws = (unsigned char*)d_ws;
    if (MK_N_LAUNCHES == 1) {
        a.ph_lo = 0; a.ph_hi = N_PHASES; a.li = 0;
        hipLaunchKernelGGL(mk_fwd, dim3(grid), dim3(NWAVES * 64), LDS_BYTES, stream, a);
    } else {
        for (int li = 0; li < N_PHASES; ++li) { a.ph_lo = li; a.ph_hi = li + 1; a.li = li;
            hipLaunchKernelGGL(mk_fwd, dim3(grid), dim3(NWAVES * 64), LDS_BYTES, stream, a); }
    }
}
```

```cpp
#include <hip/hip_runtime.h>
#include <cstdio>
#include <cstdint>

#ifndef MK_DUP
#define MK_DUP -1
#endif
#ifndef MK_DRY_SKIP
#define MK_DRY_SKIP 0
#endif
#ifndef MK_N_LAUNCHES
#define MK_N_LAUNCHES 1
#endif

namespace pg8 {
#define PG8_LAS __attribute__((address_space(3)))
typedef unsigned short bf16_t;
typedef short bf16x8 __attribute__((ext_vector_type(8)));
typedef float f32x4 __attribute__((ext_vector_type(4)));
typedef unsigned u32x4 __attribute__((ext_vector_type(4)));
typedef unsigned u32x2 __attribute__((ext_vector_type(2)));
constexpr int BM = 256, BK = 64, HALF = 128, HTB = HALF * BK * 2, STAGE_BYTES = 8 * HTB, NXCD = 8, WGM = 8;

__host__ __device__ __forceinline__ int lds_byte(int r, int c) { const int st = (r >> 4) * 2 + (c >> 5), rr = r & 15, cc = c & 31, ob = rr * 64 + cc * 2; return st * 1024 + (ob ^ (((ob >> 9) & 1) << 5)); }
__host__ __device__ __forceinline__ void stage_rc(int b, int& R, int& C) { const int st = b / 1024, sb = b % 1024, swz = sb ^ (((sb >> 9) & 1) << 5); R = (st >> 1) * 16 + swz / 64; C = (st & 1) * 32 + (swz % 64) / 2; }
__host__ __device__ __forceinline__ int perm32(int rho) { const int n = rho >> 4, i = rho & 15; return 8 * (i >> 2) + 4 * n + (i & 3); }

struct Unit { int pm, pn; };
struct Gemm { const bf16_t* A; const bf16_t* Bt; int M, N, K; };

struct StaticOrder {
    int nM, nN, nwg, G, c;
    __host__ __device__ void init(int M, int N, int G_, int c_) { nM = M / BM; nN = N / BM; nwg = nM * nN; G = G_; c = c_; }
    __host__ __device__ bool next(int i, Unit& u) const {
        const long L = (long)i * G + c; if (L >= nwg) return false;
        int wgid = (int)L; { const int q = nwg / NXCD, r = nwg % NXCD, xcd = wgid % NXCD, off = wgid / NXCD; wgid = (xcd < r ? xcd * (q + 1) : r * (q + 1) + (xcd - r) * q) + off; }
        const int nig = WGM * nN, gid = wgid / nig, fm = gid * WGM, gsz = (nM - fm) < WGM ? (nM - fm) : WGM;
        u.pm = fm + ((wgid % nig) % gsz); u.pn = (wgid % nig) / gsz; return true;
    }
    __device__ __forceinline__ void a_ready(const Unit&) const {}
    __device__ __forceinline__ void done(const Unit&) const {}
};

__device__ __forceinline__ unsigned cvt_pk_bf16(float lo, float hi) { unsigned r; asm volatile("v_cvt_pk_bf16_f32 %0, %1, %2" : "=v"(r) : "v"(lo), "v"(hi)); return r; }

template <class Epi, class Sched, bool ALIGN_EPI = false, bool SP2 = false>
__device__ __forceinline__ void gemm_phase(PG8_LAS unsigned char* lds, const Gemm g, const Sched& S, const Epi& E) {
    const int tid = threadIdx.x, wid = __builtin_amdgcn_readfirstlane(tid >> 6), lane = tid & 63, wr = wid >> 2, wc = wid & 3, fr = lane & 15, fq = lane >> 4;
    const int K = g.K, nt = K / BK;
    unsigned voffA[2], voffB[2];
#pragma unroll
    for (int i = 0; i < 2; ++i) { int R, C; stage_rc(tid * 16 + i * 8192, R, C); const int Rb = Epi::PERM ? ((R & ~31) + perm32(R & 31)) : R;
        voffA[i] = (unsigned)(R * K + C) * 2u; voffB[i] = (unsigned)(Rb * K + C) * 2u; }
    const size_t kstep = (size_t)(BK * 2);
    const size_t hstep = (size_t)HALF * K * 2;
    const size_t tstep = 2 * hstep;
    const unsigned ldsw = (unsigned)wid * 1024u;
    const int aoff = lds_byte(wr * 64 + fr, fq * 8), boff = lds_byte(wc * 32 + fr, fq * 8);
#define PG8_SA(b, h) (((b) * 2 + (h)) * HTB)
#define PG8_SB(b, h) ((4 + (b) * 2 + (h)) * HTB)
#define PG8_STAGE(bufoff, gbase, voff) do { _Pragma("unroll") for (int _i = 0; _i < 2; ++_i) \
        __builtin_amdgcn_global_load_lds((const unsigned*)((const char*)(gbase) + (voff)[_i]), (PG8_LAS unsigned*)(lds + (bufoff) + ldsw + _i * 8192), 16, 0, 0); } while (0)
#define PG8_LDA(dst, b, h) do { _Pragma("unroll") for (int m = 0; m < 4; ++m) _Pragma("unroll") for (int k = 0; k < 2; ++k) dst[m][k] = *(const PG8_LAS bf16x8*)(lds + PG8_SA(b, h) + aoff + m * 2048 + k * 1024); } while (0)
#define PG8_LDB(dst, b, h) do { _Pragma("unroll") for (int n = 0; n < 2; ++n) _Pragma("unroll") for (int k = 0; k < 2; ++k) dst[n][k] = *(const PG8_LAS bf16x8*)(lds + PG8_SB(b, h) + boff + n * 2048 + k * 1024); } while (0)
#define PG8_MMA(ai, bj, At, Bt) do { __builtin_amdgcn_s_setprio(1); _Pragma("unroll") for (int m = 0; m < 4; ++m) _Pragma("unroll") for (int n = 0; n < 2; ++n) _Pragma("unroll") for (int k = 0; k < 2; ++k) \
        acc[ai][bj][m][n] = __builtin_amdgcn_mfma_f32_16x16x32_bf16(Bt[n][k], At[m][k], acc[ai][bj][m][n], 0, 0, 0); __builtin_amdgcn_s_setprio(0); } while (0)
#define PG8_WAIT_V(n) asm volatile("s_waitcnt vmcnt(" #n ")" ::: "memory")
#define PG8_WAIT_L(n) asm volatile("s_waitcnt lgkmcnt(" #n ")" ::: "memory")
#define PG8_BAR __builtin_amdgcn_s_barrier()
#define PG8_SCHED __builtin_amdgcn_sched_barrier(0)
    Unit cur, nxt; int ui = 0;
    if (!S.next(0, cur)) return;
    f32x4 acc[2][2][4][2];
#pragma unroll
    for (int a = 0; a < 2; ++a)
#pragma unroll
        for (int b = 0; b < 2; ++b)
#pragma unroll
            for (int m = 0; m < 4; ++m)
#pragma unroll
                for (int n = 0; n < 2; ++n) acc[a][b][m][n] = (f32x4){0.f, 0.f, 0.f, 0.f};
    bf16x8 At[4][2], B0[2][2], B1[2][2];
    const char* cA = (const char*)g.A + (size_t)cur.pm * tstep; const char* cB = (const char*)g.Bt + (size_t)cur.pn * tstep;
    S.a_ready(cur);
    if constexpr (SP2) {
        PG8_STAGE(PG8_SB(0, 0), cB, voffB); PG8_STAGE(PG8_SB(0, 1), cB + hstep, voffB); PG8_STAGE(PG8_SA(0, 0), cA, voffA); PG8_STAGE(PG8_SA(0, 1), cA + hstep, voffA);
        if (wr == 1) PG8_BAR;
        PG8_WAIT_V(2); PG8_BAR;
        PG8_STAGE(PG8_SB(1, 0), cB + kstep, voffB); PG8_STAGE(PG8_SA(1, 0), cA + kstep, voffA); PG8_STAGE(PG8_SB(1, 1), cB + hstep + kstep, voffB);
        PG8_WAIT_V(6); PG8_BAR;
    } else {
        PG8_STAGE(PG8_SB(0, 0), cB, voffB); PG8_STAGE(PG8_SA(0, 0), cA, voffA); PG8_STAGE(PG8_SB(0, 1), cB + hstep, voffB); PG8_STAGE(PG8_SA(0, 1), cA + hstep, voffA);
        if (wr == 1) PG8_BAR;
        PG8_WAIT_V(4); PG8_BAR;
        PG8_STAGE(PG8_SB(1, 0), cB + kstep, voffB); PG8_STAGE(PG8_SA(1, 0), cA + kstep, voffA); PG8_STAGE(PG8_SB(1, 1), cB + hstep + kstep, voffB);
        PG8_WAIT_V(6); PG8_BAR;
    }
    for (;;) {
        const bool has_next = S.next(ui + 1, nxt);
        const char* nA = has_next ? (const char*)g.A + (size_t)nxt.pm * tstep : cA; const char* nB = has_next ? (const char*)g.Bt + (size_t)nxt.pn * tstep : cB;
        for (int t = 0; t < nt; t += 2) {
            const bool last = (t == nt - 2);
            const char* a1 = cA + (size_t)(t + 1) * kstep;
            const char* a2 = last ? nA : cA + (size_t)(t + 2) * kstep; const char* b2 = last ? nB : cB + (size_t)(t + 2) * kstep;
            const char* a3 = a2 + kstep; const char* b3 = b2 + kstep;
            if (last && has_next) S.a_ready(nxt);
            if constexpr (SP2) {
            PG8_LDB(B0, 0, 0); PG8_LDB(B1, 0, 1); PG8_SCHED; PG8_LDA(At, 0, 0); PG8_STAGE(PG8_SA(1, 1), a1 + hstep, voffA);
            PG8_WAIT_V(8); PG8_WAIT_L(0); PG8_BAR; PG8_MMA(0, 0, At, B0); PG8_MMA(0, 1, At, B1); PG8_BAR; PG8_SCHED;
            PG8_LDA(At, 0, 1); PG8_STAGE(PG8_SB(0, 0), b2, voffB); PG8_STAGE(PG8_SB(0, 1), b2 + hstep, voffB); PG8_STAGE(PG8_SA(0, 0), a2, voffA);
            PG8_WAIT_V(8); PG8_WAIT_L(0); PG8_BAR; PG8_MMA(1, 0, At, B0); PG8_MMA(1, 1, At, B1); PG8_BAR; PG8_SCHED;
            PG8_LDB(B0, 1, 0); PG8_LDB(B1, 1, 1); PG8_SCHED; PG8_LDA(At, 1, 0); PG8_STAGE(PG8_SA(0, 1), a2 + hstep, voffA);
            PG8_WAIT_V(8); PG8_WAIT_L(0); PG8_BAR; PG8_MMA(0, 0, At, B0); PG8_MMA(0, 1, At, B1); PG8_BAR; PG8_SCHED;
            PG8_LDA(At, 1, 1); PG8_STAGE(PG8_SB(1, 0), b3, voffB); PG8_STAGE(PG8_SB(1, 1), b3 + hstep, voffB); PG8_STAGE(PG8_SA(1, 0), a3, voffA);
            PG8_WAIT_V(8); PG8_WAIT_L(0); PG8_BAR; PG8_MMA(1, 0, At, B0); PG8_MMA(1, 1, At, B1); PG8_BAR; PG8_SCHED;
            } else {
            PG8_LDB(B0, 0, 0); PG8_SCHED; PG8_LDA(At, 0, 0); PG8_STAGE(PG8_SA(1, 1), a1 + hstep, voffA);
            PG8_WAIT_L(8); PG8_BAR; PG8_WAIT_L(0); PG8_MMA(0, 0, At, B0); PG8_BAR; PG8_SCHED;
            PG8_LDB(B1, 0, 1); PG8_STAGE(PG8_SB(0, 0), b2, voffB);
            PG8_BAR; PG8_WAIT_L(0); PG8_MMA(0, 1, At, B1); PG8_BAR;
            PG8_LDA(At, 0, 1); PG8_STAGE(PG8_SA(0, 0), a2, voffA);
            PG8_BAR; PG8_WAIT_L(0); PG8_MMA(1, 0, At, B0); PG8_BAR; PG8_SCHED;
            PG8_STAGE(PG8_SB(0, 1), b2 + hstep, voffB);
            PG8_WAIT_V(6); PG8_BAR; PG8_MMA(1, 1, At, B1); PG8_BAR;
            PG8_LDB(B0, 1, 0); PG8_SCHED; PG8_LDA(At, 1, 0); PG8_STAGE(PG8_SA(0, 1), a2 + hstep, voffA);
            PG8_WAIT_L(8); PG8_BAR; PG8_WAIT_L(0); PG8_MMA(0, 0, At, B0); PG8_BAR; PG8_SCHED;
            PG8_LDB(B1, 1, 1); PG8_STAGE(PG8_SB(1, 0), b3, voffB);
            PG8_BAR; PG8_WAIT_L(0); PG8_MMA(0, 1, At, B1); PG8_BAR;
            PG8_LDA(At, 1, 1); PG8_STAGE(PG8_SA(1, 0), a3, voffA);
            PG8_BAR; PG8_WAIT_L(0); PG8_MMA(1, 0, At, B0); PG8_BAR; PG8_SCHED;
            PG8_STAGE(PG8_SB(1, 1), b3 + hstep, voffB);
            PG8_WAIT_V(6); PG8_BAR; PG8_MMA(1, 1, At, B1); PG8_BAR;
            }
        }
        if constexpr (ALIGN_EPI) { if (wr == 0) PG8_BAR; }
        E(acc, cur, wr, wc, fr, fq); S.done(cur);
        if (!has_next) break;
#pragma unroll
        for (int a = 0; a < 2; ++a)
#pragma unroll
            for (int b = 0; b < 2; ++b)
#pragma unroll
                for (int m = 0; m < 4; ++m)
#pragma unroll
                    for (int n = 0; n < 2; ++n) acc[a][b][m][n] = (f32x4){0.f, 0.f, 0.f, 0.f};
        cur = nxt; cA = nA; cB = nB; ++ui;
        if constexpr (ALIGN_EPI) { if (wr == 1) PG8_BAR; }
    }
    PG8_WAIT_V(0);
    if constexpr (!ALIGN_EPI) { if (wr == 0) PG8_BAR; }
    PG8_BAR;
#undef PG8_SA
#undef PG8_SB
#undef PG8_STAGE
#undef PG8_LDA
#undef PG8_LDB
#undef PG8_MMA
#undef PG8_WAIT_V
#undef PG8_WAIT_L
#undef PG8_BAR
#undef PG8_SCHED
}
}

constexpr int NWAVES = 8;
constexpr int DM = 1024, NTOK = 16384, NCTX = 8192, D_IN = 1792, NMODV = 9, MODW = 6144;
constexpr int SEQ_C = 256, SEQ_L = 1024, NSEQ_C = 32, NSEQ_L = 8;
constexpr int N_PHASES = 8;
constexpr float LOG2E = 1.4426950408889634f;
constexpr float QSCALE = 0.125f * LOG2E;
constexpr float EPS = 1e-6f;

constexpr size_t MiB = 1u << 20, KiB = 1u << 10;
constexpr size_t WS_CTL = 0, CTL_ZERO_BYTES = 64 * KiB;
constexpr size_t WS_MODS = 1 * MiB;
constexpr size_t WS_ROPE = 1 * MiB + 256 * KiB;
constexpr size_t WS_RGW  = 1 * MiB + 512 * KiB;
constexpr size_t WS_CK   = 1 * MiB + 768 * KiB;
constexpr size_t WS_CVT  = 2 * MiB + 256 * KiB;
constexpr size_t WS_WIN  = 3 * MiB;
constexpr size_t WS_WOUT = 7 * MiB;
constexpr size_t WS_WC   = 9 * MiB;
constexpr size_t WS_U    = 16 * MiB;
constexpr size_t WS_SSP  = 14 * MiB;
constexpr size_t WS_BIAS = 15 * MiB;
constexpr size_t WS_SU   = 13 * MiB;
constexpr size_t WS_SV   = 13 * MiB + 64 * KiB;
constexpr size_t WS_V    = 48 * MiB;
constexpr size_t WS_H    = 80 * MiB;
constexpr size_t WS_MIX  = 112 * MiB;
constexpr size_t WS_Q    = 144 * MiB;
constexpr size_t WS_K    = 160 * MiB;
constexpr size_t WS_VT   = 164 * MiB;
constexpr size_t WS_XR   = 168 * MiB;
constexpr size_t WS_YG   = 184 * MiB;
constexpr size_t WS_HF   = 200 * MiB;
constexpr size_t WS_SC   = 144 * MiB;
constexpr size_t WS_END  = 232 * MiB;
constexpr int VT_LAT_OFF = NSEQ_C * 2 * 64 * SEQ_C;

constexpr int CW_BAR = 4096;

constexpr int RING_BYTES = 131072;
constexpr int LDSCTL_OFF = 146944, MISC_OFF = LDSCTL_OFF + 320;
constexpr int LDS_BYTES = 147456;

#define GAS __attribute__((address_space(1)))
#define LAS __attribute__((address_space(3)))
typedef unsigned short bf16;
typedef unsigned v4u __attribute__((ext_vector_type(4)));
typedef unsigned v2u __attribute__((ext_vector_type(2)));
typedef float f32x4 __attribute__((ext_vector_type(4)));
typedef float f32x2 __attribute__((ext_vector_type(2)));
typedef float f32x16 __attribute__((ext_vector_type(16)));
typedef short bf16x8 __attribute__((ext_vector_type(8)));
typedef GAS unsigned gu32;
#define RLX_AGENT __ATOMIC_RELAXED, __HIP_MEMORY_SCOPE_AGENT

__device__ __forceinline__ unsigned f2bf(float f) { unsigned u = __builtin_bit_cast(unsigned, f); return (u + 0x7fffu + ((u >> 16) & 1u)) >> 16; }
typedef float f32x2_t_ __attribute__((ext_vector_type(2))); typedef __bf16 bf16x2_t_ __attribute__((ext_vector_type(2)));
__device__ __forceinline__ unsigned pk2(float lo, float hi) { f32x2_t_ v = {lo, hi}; bf16x2_t_ b = __builtin_convertvector(v, bf16x2_t_); return __builtin_bit_cast(unsigned, b); }
__device__ __forceinline__ float bf2f(unsigned b) { return __builtin_bit_cast(float, b << 16); }
__device__ __forceinline__ float bflo(unsigned w) { return __builtin_bit_cast(float, w << 16); }
__device__ __forceinline__ float bfhi(unsigned w) { return __builtin_bit_cast(float, w & 0xffff0000u); }
__device__ __forceinline__ float sigmoidf_(float x) { return 1.f / (1.f + __expf(-x)); }
__device__ __forceinline__ float gelu_tanh(float x) { const float y = 0.7978845608028654f * (x + 0.044715f * x * x * x); const float e = __expf(2.f * y); return 0.5f * x * (2.f - 2.f / (1.f + e)); }
template <int CTRL> __device__ __forceinline__ float dppf_(float v) { return __builtin_bit_cast(float, __builtin_amdgcn_update_dpp(0, __builtin_bit_cast(int, v), CTRL, 0xf, 0xf, true)); }
__device__ __forceinline__ float xrow16_(float v) {
    unsigned a = __builtin_bit_cast(unsigned, v), b = a; asm volatile("" : "+v"(b));
    const auto r = __builtin_amdgcn_permlane16_swap(a, b, false, false);
    const bool odd = (threadIdx.x & 16) != 0; return __builtin_bit_cast(float, odd ? r[0] : r[1]);
}
__device__ __forceinline__ float xhalf32_(float v) {
    unsigned a = __builtin_bit_cast(unsigned, v), b = a; asm volatile("" : "+v"(b));
    const auto r = __builtin_amdgcn_permlane32_swap(a, b, false, false);
    const bool hi = (threadIdx.x & 32) != 0; return __builtin_bit_cast(float, hi ? r[0] : r[1]);
}
__device__ __forceinline__ float wave_sum(float v) {
    v += dppf_<0xB1>(v); v += dppf_<0x4E>(v); v += dppf_<0x141>(v); v += dppf_<0x140>(v);
    v += xrow16_(v); v += xhalf32_(v); return v;
}
__device__ __forceinline__ float wave_max(float v) {
    v = fmaxf(v, dppf_<0xB1>(v)); v = fmaxf(v, dppf_<0x4E>(v)); v = fmaxf(v, dppf_<0x141>(v)); v = fmaxf(v, dppf_<0x140>(v));
    v = fmaxf(v, xrow16_(v)); v = fmaxf(v, xhalf32_(v)); return v;
}
__device__ __forceinline__ int crow(int r, int hi) { return (r & 3) + 8 * (r >> 2) + 4 * hi; }

#define XB_TMO      128
#define XB_XCNT(j)  (256  + 64 * (j))
#define XB_XSUB(j)  (1280 + 64 * (j))
#define XB_XGEN(j)  (2304 + 64 * (j))
#define XB_TOP      3328
#define XB_TOPGEN   3392
#define XCD_BAR_WORDS 3456
#define XB_SPIN_CAP (1u << 18)
__device__ __forceinline__ unsigned xb_ld(unsigned* p)              { return __hip_atomic_load(p, __ATOMIC_RELAXED, __HIP_MEMORY_SCOPE_AGENT); }
__device__ __forceinline__ unsigned xb_add(unsigned* p, unsigned v) { return __hip_atomic_fetch_add(p, v, __ATOMIC_RELAXED, __HIP_MEMORY_SCOPE_AGENT); }
__device__ __forceinline__ unsigned xb_xcc_id() { return (unsigned)__builtin_amdgcn_s_getreg((3 << 11) | 20) & 0xFu; }
#define XB_SPIN(cond, bar) do { unsigned _sp = 0; while (cond) { __builtin_amdgcn_s_sleep(1); \
    if ((++_sp & 255u) == 0u) { if (xb_ld(&(bar)[XB_TMO])) break; if (_sp > XB_SPIN_CAP) { atomicAdd(&(bar)[XB_TMO], 1u); break; } } } } while (0)
struct XcdBarrier { unsigned* bar; unsigned x; volatile LAS unsigned* st; };
__device__ __forceinline__ XcdBarrier xcd_barrier_post(unsigned* bar, volatile LAS unsigned* st) {
    XcdBarrier b; b.bar = bar; b.x = xb_xcc_id(); b.st = st;
    if (threadIdx.x == 0) (void)xb_add(&bar[XB_XCNT(b.x)], 1u);
    return b;
}
__device__ __forceinline__ void xcd_barrier_complete(unsigned* bar, unsigned x, unsigned& nloc, unsigned& nx) {
    const unsigned G = gridDim.x * gridDim.y * gridDim.z;
    unsigned sum, cnt, mine, sp = 0u;
    for (;;) {
        sum = 0u; cnt = 0u; mine = 0u;
#pragma unroll
        for (unsigned j = 0; j < 16; ++j) { const unsigned c = xb_ld(&bar[XB_XCNT(j)]); sum += c; cnt += (c > 0u) ? 1u : 0u; mine = (j == x) ? c : mine; }
        if (sum == G) break;
        __builtin_amdgcn_s_sleep(1);
        if ((++sp & 255u) == 0u) { if (xb_ld(&bar[XB_TMO])) break; if (sp > XB_SPIN_CAP) { atomicAdd(&bar[XB_TMO], 1u); break; } }
    }
    nloc = mine > 0u ? mine : 1u; nx = cnt > 0u ? cnt : 1u;
}
__device__ __forceinline__ void xcd_barrier(const XcdBarrier& b) {
    asm volatile("s_waitcnt vmcnt(0)" ::: "memory");
    __syncthreads();
    if (threadIdx.x == 0) {
        unsigned* bar = b.bar;
        __builtin_amdgcn_s_waitcnt(0);
        unsigned nloc = b.st[0], nx = b.st[1];
        if (nloc == 0u) { xcd_barrier_complete(bar, b.x, nloc, nx); b.st[0] = nloc; b.st[1] = nx; }
        const unsigned old = xb_add(&bar[XB_XSUB(b.x)], 1u);
        const unsigned gen = old / nloc;
        if (old + 1u == (gen + 1u) * nloc) {
            __builtin_amdgcn_fence(__ATOMIC_RELEASE, "agent");
            asm volatile("s_waitcnt vmcnt(0)" ::: "memory");
            const unsigned og = xb_add(&bar[XB_TOP], 1u);
            const unsigned tg = og / nx;
            if (og + 1u == (tg + 1u) * nx) xb_add(&bar[XB_TOPGEN], 1u);
            else XB_SPIN(xb_ld(&bar[XB_TOPGEN]) == tg, bar);
            __builtin_amdgcn_fence(__ATOMIC_ACQUIRE, "agent");
            xb_add(&bar[XB_XGEN(b.x)], 1u);
            asm volatile("s_waitcnt vmcnt(0)" ::: "memory");
        } else {
            XB_SPIN(xb_ld(&bar[XB_XGEN(b.x)]) == gen, bar);
            __builtin_amdgcn_fence(__ATOMIC_ACQUIRE, "agent");
            asm volatile("s_waitcnt vmcnt(0)" ::: "memory");
        }
    }
    __syncthreads();
}

struct Args { const float* in[26]; float* out; unsigned char* ws; int ph_lo, ph_hi, li, pad; };

struct Frame {
    unsigned char* lds;
    int tid, lane, wave, vcu, G;
    const float* const* in;
    float* out; unsigned char* ws;
};
enum { I_XP = 0, I_XS, I_CK, I_CV, I_SRNN, I_C, I_CCTX, I_WMOD, I_BMOD, I_GMIX, I_GFFN, I_WIN, I_CONVW, I_CONVB, I_RGWA, I_RGBA, I_RGWI, I_RGBI, I_RGLAM, I_SINK, I_WOUT, I_PWQ, I_PSK, I_PU, I_PV, I_GFINAL };
constexpr size_t O_Y = 0, O_NEWK = (size_t)NTOK * DM, O_NEWV = O_NEWK + (size_t)NCTX * 128, O_NEWRNN = O_NEWV + (size_t)NCTX * 128;

__device__ __forceinline__ int mod_index(int tok) { return tok < NCTX ? 0 : 1 + ((tok - NCTX) >> 10); }
__device__ __forceinline__ const float* x_row(const Frame& F, int tok) { return tok < NCTX ? F.in[I_XP] + (size_t)tok * DM : F.in[I_XS] + (size_t)(tok - NCTX) * DM; }

template <class RowMap>
__device__ __forceinline__ void p0_transpose_item(const float* W, int K, int N, bf16* WT, float* scr, int item, int lane, RowMap rowmap, float scale = 1.f) {
    const int nblk = N / 32, kb = item / nblk, nb = item % nblk, k0 = 64 * kb, n0 = 32 * nb;
#pragma unroll 8
    for (int i = 0; i < 32; ++i) { const int kk = 2 * i + (lane >> 5); scr[kk * 33 + (lane & 31)] = W[(size_t)(k0 + kk) * N + n0 + (lane & 31)]; }
    __builtin_amdgcn_s_waitcnt(0xC07F); asm volatile("" ::: "memory");
    const int c = lane & 7;
#pragma unroll
    for (int j = 0; j < 4; ++j) { const int n = (lane >> 3) + 8 * j; const float* s = scr + (8 * c) * 33 + n;
        v4u o; o.x = pk2(s[0 * 33] * scale, s[1 * 33] * scale); o.y = pk2(s[2 * 33] * scale, s[3 * 33] * scale); o.z = pk2(s[4 * 33] * scale, s[5 * 33] * scale); o.w = pk2(s[6 * 33] * scale, s[7 * 33] * scale);
        *(v4u*)(WT + (size_t)rowmap(n0 + n) * K + k0 + 8 * c) = o; }
    __builtin_amdgcn_s_waitcnt(0xC07F); asm volatile("" ::: "memory");
}
struct MapId { __device__ __forceinline__ int operator()(int n) const { return n; } };
struct MapWin { __device__ __forceinline__ int operator()(int n) const { if (n >= 640) return n; const int hb = n & ~63, o = n & 63; return hb + ((o & 31) << 1) + (o >> 5); } };

__device__ __forceinline__ void p0_phase(Frame& F) {
    float* ldsf = (float*)F.lds;
    const int tid = F.tid, lane = F.lane, wave = F.wave, v = F.vcu;
    if (v < 192) {
        for (int i = tid; i < NMODV * DM; i += 512) { const int j = i >> 10, d = i & 1023; const float c = (j == 0) ? F.in[I_CCTX][d] : F.in[I_C][(j - 1) * DM + d]; ldsf[i] = c * sigmoidf_(c); }
        __syncthreads();
        const int e0 = 32 * v, c4 = tid & 7, kq = tid >> 3;
        float acc[NMODV][4];
#pragma unroll
        for (int j = 0; j < NMODV; ++j) { acc[j][0] = 0.f; acc[j][1] = 0.f; acc[j][2] = 0.f; acc[j][3] = 0.f; }
        const float* wm = F.in[I_WMOD] + e0 + 4 * c4;
#pragma unroll 4
        for (int kk = 0; kk < 16; ++kk) { const int k = kq * 16 + kk; const f32x4 w = *(const f32x4*)(wm + (size_t)k * MODW);
#pragma unroll
            for (int j = 0; j < NMODV; ++j) { const float s = ldsf[j * DM + k]; acc[j][0] += s * w[0]; acc[j][1] += s * w[1]; acc[j][2] += s * w[2]; acc[j][3] += s * w[3]; } }
#pragma unroll
        for (int j = 0; j < NMODV; ++j)
#pragma unroll
            for (int i = 0; i < 4; ++i) { float a = acc[j][i]; a += __shfl_xor(a, 8); a += __shfl_xor(a, 16); a += __shfl_xor(a, 32); acc[j][i] = a; }
        float* red = ldsf + NMODV * DM;
        if (lane < 8) {
#pragma unroll
            for (int j = 0; j < NMODV; ++j)
#pragma unroll
                for (int i = 0; i < 4; ++i) red[(wave * NMODV + j) * 32 + 4 * c4 + i] = acc[j][i];
        }
        __syncthreads();
        if (tid < NMODV * 32) { const int j = tid >> 5, col = tid & 31; float s = F.in[I_BMOD][e0 + col];
#pragma unroll
            for (int w = 0; w < 8; ++w) s += red[(w * NMODV + j) * 32 + col];
            ((float*)(F.ws + WS_MODS))[j * MODW + e0 + col] = s; }
        __syncthreads();
    }
    if (v < 256) {
        const int hh = v >> 4, dt = v & 15, d0 = 64 * dt;
        float* At = ldsf;
        float* Bkt = ldsf + 128 * 64;
        const float* wq = F.in[I_PWQ] + hh * 128;
        const float* sk = F.in[I_PSK] + (size_t)hh * 128 * 128;
#pragma unroll
        for (int i = 0; i < 4; ++i) { const int f = tid + 512 * i, d = f & 63, q4 = f >> 6; const f32x4 a = *(const f32x4*)(wq + (size_t)(d0 + d) * 2048 + 4 * q4);
            At[(4 * q4 + 0) * 64 + d] = a[0]; At[(4 * q4 + 1) * 64 + d] = a[1]; At[(4 * q4 + 2) * 64 + d] = a[2]; At[(4 * q4 + 3) * 64 + d] = a[3]; }
#pragma unroll
        for (int i = 0; i < 8; ++i) { const int f = tid + 512 * i, key = f & 127, q4 = f >> 7; const f32x4 b = *(const f32x4*)(sk + (size_t)key * 128 + 4 * q4);
            Bkt[(4 * q4 + 0) * 128 + key] = b[0]; Bkt[(4 * q4 + 1) * 128 + key] = b[1]; Bkt[(4 * q4 + 2) * 128 + key] = b[2]; Bkt[(4 * q4 + 3) * 128 + key] = b[3]; }
        __syncthreads();
        const int dg = tid & 15, kg = tid >> 4;
        float acc[4][4];
#pragma unroll
        for (int i = 0; i < 4; ++i)
#pragma unroll
            for (int j = 0; j < 4; ++j) acc[i][j] = 0.f;
#pragma unroll 4
        for (int q = 0; q < 128; ++q) { const f32x4 a = *(const f32x4*)(At + q * 64 + 4 * dg); const f32x4 b = *(const f32x4*)(Bkt + q * 128 + 4 * kg);
#pragma unroll
            for (int i = 0; i < 4; ++i)
#pragma unroll
                for (int j = 0; j < 4; ++j) acc[i][j] += a[i] * b[j]; }
        bf16* WcT = (bf16*)(F.ws + WS_WC);
#pragma unroll
        for (int j = 0; j < 4; ++j) { v2u o; o.x = pk2(acc[0][j], acc[1][j]); o.y = pk2(acc[2][j], acc[3][j]);
            *(v2u*)(WcT + (size_t)(hh * 128 + 4 * kg + j) * DM + d0 + 4 * dg) = o; }
        __syncthreads();
    }
    const int gw = v * NWAVES + wave, NGW = F.G * NWAVES;
    float* scr = ldsf + wave * 4096;
    {
        constexpr int I_IN = (DM / 64) * (D_IN / 32), I_OUT = (DM / 64) * (DM / 32), I_RG = 32 * 2;
        constexpr int NIT = I_IN + I_OUT + I_RG;
        for (int it = gw; it < NIT; it += NGW) {
            int r = it;
            if (r < I_IN) { p0_transpose_item(F.in[I_WIN], DM, D_IN, (bf16*)(F.ws + WS_WIN), scr, r, lane, MapWin()); continue; } r -= I_IN;
            if (r < I_OUT) { p0_transpose_item(F.in[I_WOUT], DM, DM, (bf16*)(F.ws + WS_WOUT), scr, r, lane, MapId()); continue; } r -= I_OUT;
            { const int mm = r >> 1, sub = r & 1, dir = mm >> 4, n = (mm >> 1) & 7, gate = mm & 1;
              const float* src = (gate ? F.in[I_RGWI] : F.in[I_RGWA]) + (size_t)(dir * 8 + n) * 4096;
              bf16* dst = (bf16*)(F.ws + WS_RGW) + (size_t)((dir * 8 + n) * 2 + gate) * 4096;
              p0_transpose_item(src, 64, 64, dst, scr, sub, lane, MapId(), -LOG2E); }
        }
    }
    for (int it0 = 4 * gw; it0 < 2 * 16384; it0 += 4 * NGW) {
        f32x4 a[4][4];
#pragma unroll
        for (int r = 0; r < 4; ++r) { const int it = it0 + r, tb = it >> 14, row = it & 16383;
            const float* src = (tb ? F.in[I_PV] : F.in[I_PU]) + (size_t)row * DM + 16 * lane;
#pragma unroll
            for (int j = 0; j < 4; ++j) a[r][j] = *(const f32x4*)(src + 4 * j); }
        float am[4];
#pragma unroll
        for (int r = 0; r < 4; ++r) { float m = 0.f;
#pragma unroll
            for (int j = 0; j < 4; ++j) m = fmaxf(m, fmaxf(fmaxf(fabsf(a[r][j][0]), fabsf(a[r][j][1])), fmaxf(fabsf(a[r][j][2]), fabsf(a[r][j][3]))));
            am[r] = m; }
#pragma unroll
        for (int r = 0; r < 4; ++r) am[r] = wave_max(am[r]);
#pragma unroll
        for (int r = 0; r < 4; ++r) { const int it = it0 + r, tb = it >> 14, row = it & 16383;
            if (tb) {
                const float inv = am[r] > 0.f ? 7.f / am[r] : 0.f;
                v2u o2;
#pragma unroll
                for (int h = 0; h < 2; ++h) { unsigned w = 0;
#pragma unroll
                    for (int c = 0; c < 8; ++c) { int q = (int)rintf(a[r][2 * h + (c >> 2)][c & 3] * inv); q = q > 7 ? 7 : (q < -7 ? -7 : q); w |= ((unsigned)(q + 8) & 0xfu) << (4 * c); }
                    o2[h] = w; }
                *(v2u*)(F.ws + WS_V + (size_t)row * (DM / 2) + 8 * lane) = o2;
                if (lane == 0) ((float*)(F.ws + WS_SV))[row] = am[r] * (1.f / 7.f);
            } else {
                const float inv = am[r] > 0.f ? 7.f / am[r] : 0.f;
                v2u o2;
#pragma unroll
                for (int h = 0; h < 2; ++h) { unsigned w = 0;
#pragma unroll
                    for (int c = 0; c < 8; ++c) { int q = (int)rintf(a[r][2 * h + (c >> 2)][c & 3] * inv); q = q > 7 ? 7 : (q < -7 ? -7 : q); w |= ((unsigned)q & 0xfu) << (4 * c); }
                    o2[h] = w; }
                *(v2u*)(F.ws + WS_U + (size_t)row * (DM / 2) + 8 * lane) = o2;
                if (lane == 0) ((float*)(F.ws + WS_SU))[row] = am[r] * (1.f / 7.f);
            } }
    }
    const int gt = v * 512 + tid, NGT = F.G * 512;
    for (int e = gt; e < 8 * 256 * 128; e += NGT) {
        const int c = e & 127, bp = e >> 7, kvh = c >> 6, p = c & 63, old = (p & 1) ? 32 + (p >> 1) : (p >> 1);
        ((bf16*)(F.ws + WS_CK))[e] = (bf16)f2bf(F.in[I_CK][(size_t)bp * 128 + kvh * 64 + old]);
    }
    for (int e = gt; e < 8 * 256 * 128; e += NGT) {
        const int pos = e & 255, d = (e >> 8) & 63, kvh = (e >> 14) & 1, b = e >> 15;
        ((bf16*)(F.ws + WS_CVT))[e] = (bf16)f2bf(F.in[I_CV][(size_t)(b * 256 + pos) * 128 + kvh * 64 + d]);
    }
    for (int e = gt; e < 1024 * 32; e += NGT) {
        const int s = e >> 5, i = e & 31, row = s >> 6, col = s & 63;
        const float inv = powf(10000.0f, -(float)(i & 15) / 16.0f);
        const float ang = (i < 16 ? (float)row : (float)col) * inv;
        f32x2 cs; cs.x = cosf(ang); cs.y = sinf(ang);
        ((f32x2*)(F.ws + WS_ROPE))[e] = cs;
    }
}

__device__ __forceinline__ void bias_items(Frame& F) {
    const int gw = F.vcu * NWAVES + F.wave, NGW = F.G * NWAVES, lane = F.lane;
    const float* mods = (const float*)(F.ws + WS_MODS); const bf16* WcT = (const bf16*)(F.ws + WS_WC); float* BIAS = (float*)(F.ws + WS_BIAS);
    for (int n = gw; n < 2048; n += NGW) {
        const v4u a = *(const v4u*)(WcT + (size_t)n * DM + 16 * lane), b = *(const v4u*)(WcT + (size_t)n * DM + 16 * lane + 8);
        float w[16];
        w[0] = bflo(a.x); w[1] = bfhi(a.x); w[2] = bflo(a.y); w[3] = bfhi(a.y); w[4] = bflo(a.z); w[5] = bfhi(a.z); w[6] = bflo(a.w); w[7] = bfhi(a.w);
        w[8] = bflo(b.x); w[9] = bfhi(b.x); w[10] = bflo(b.y); w[11] = bfhi(b.y); w[12] = bflo(b.z); w[13] = bfhi(b.z); w[14] = bflo(b.w); w[15] = bfhi(b.w);
#pragma unroll 1
        for (int j = 0; j < NMODV; ++j) { const float* sh = mods + (size_t)j * MODW + 3 * DM + 16 * lane; float d = 0.f;
#pragma unroll
            for (int q = 0; q < 4; ++q) { const f32x4 v = *(const f32x4*)(sh + 4 * q); d += v[0] * w[4 * q] + v[1] * w[4 * q + 1] + v[2] * w[4 * q + 2] + v[3] * w[4 * q + 3]; }
            d = wave_sum(d); if (lane == 0) BIAS[j * 2048 + n] = d; }
    }
}
__device__ __forceinline__ void norm_phase(Frame& F, int which) {
    const int gw = F.vcu * NWAVES + F.wave, NGW = F.G * NWAVES, lane = F.lane;
    const float* mods = (const float*)(F.ws + WS_MODS);
    const float* g = F.in[which ? I_GFFN : I_GMIX];
    bf16* H = (bf16*)(F.ws + WS_H);
    for (int tok = gw; tok < NTOK; tok += NGW) {
        const float* xr = which ? F.out + O_Y + (size_t)tok * DM : x_row(F, tok);
        const float* mv = mods + (size_t)mod_index(tok) * MODW + (which ? 3 * DM : 0);
        f32x4 v[4]; float ss = 0.f;
#pragma unroll
        for (int j = 0; j < 4; ++j) { v[j] = *(const f32x4*)(xr + 256 * j + 4 * lane); ss += (v[j][0] * v[j][0] + v[j][1] * v[j][1]) + (v[j][2] * v[j][2] + v[j][3] * v[j][3]); }
        const float rstd = 1.f / sqrtf(wave_sum(ss) * (1.f / DM) + EPS);
#pragma unroll
        for (int j = 0; j < 4; ++j) { const int e = 256 * j + 4 * lane;
            const f32x4 gg = *(const f32x4*)(g + e), sh = *(const f32x4*)(mv + e), sc = *(const f32x4*)(mv + DM + e);
            f32x4 o;
#pragma unroll
            for (int i = 0; i < 4; ++i) o[i] = v[j][i] * rstd * gg[i] * (1.f + sc[i]) + sh[i];
            v2u w; w.x = pk2(o[0], o[1]); w.y = pk2(o[2], o[3]); *(v2u*)(H + (size_t)tok * DM + e) = w; }
    }
}

struct EpiInProj {
    static constexpr bool PERM = true;
    bf16 *q, *k, *vT, *xr, *yg; float *newk, *newv; const f32x4* rope4;
    __device__ __forceinline__ void operator()(const f32x4 (&acc)[2][2][4][2], const pg8::Unit& u, int wr, int wc, int fr, int fq) const {
        const bool lat = u.pm >= 32;
        const int pn = u.pn;
#pragma unroll
        for (int ai = 0; ai < 2; ++ai)
#pragma unroll
            for (int m = 0; m < 4; ++m) {
                const int row = u.pm * 256 + ai * 128 + wr * 64 + m * 16 + fr;
                const int pos = lat ? ((row - NCTX) & 1023) : (row & 255);
#pragma unroll
                for (int bj = 0; bj < 2; ++bj) {
                    const int c = pn * 256 + bj * 128 + wc * 32 + 8 * fq;
                    f32x4 v0 = acc[ai][bj][m][0], v1 = acc[ai][bj][m][1];
                    if (pn < 2 || (pn == 2 && bj == 0)) {
                        const int i = (c & 63) >> 1;
                        if (lat) { const f32x4 cs0 = rope4[(pos * 32 + i) >> 1], cs1 = rope4[((pos * 32 + i) >> 1) + 1];
                            const float a0 = v0[0] * cs0[0] - v0[1] * cs0[1], a1 = v0[1] * cs0[0] + v0[0] * cs0[1];
                            const float b0 = v0[2] * cs0[2] - v0[3] * cs0[3], b1 = v0[3] * cs0[2] + v0[2] * cs0[3];
                            const float c0 = v1[0] * cs1[0] - v1[1] * cs1[1], c1 = v1[1] * cs1[0] + v1[0] * cs1[1];
                            const float d0 = v1[2] * cs1[2] - v1[3] * cs1[3], d1 = v1[3] * cs1[2] + v1[2] * cs1[3];
                            v0[0] = a0; v0[1] = a1; v0[2] = b0; v0[3] = b1; v1[0] = c0; v1[1] = c1; v1[2] = d0; v1[3] = d1; }
                        if (pn < 2) { v4u w; w.x = pk2(v0[0] * QSCALE, v0[1] * QSCALE); w.y = pk2(v0[2] * QSCALE, v0[3] * QSCALE); w.z = pk2(v1[0] * QSCALE, v1[1] * QSCALE); w.w = pk2(v1[2] * QSCALE, v1[3] * QSCALE);
                            *(v4u*)(q + (size_t)row * 512 + c) = w; }
                        else { const int kc = c - 512; v4u w; w.x = pk2(v0[0], v0[1]); w.y = pk2(v0[2], v0[3]); w.z = pk2(v1[0], v1[1]); w.w = pk2(v1[2], v1[3]); *(v4u*)(k + (size_t)row * 128 + kc) = w;
                            if (!lat) { float* nk = newk + (size_t)row * 128 + (kc & 64) + i; f32x4 lo; lo[0] = v0[0]; lo[1] = v0[2]; lo[2] = v1[0]; lo[3] = v1[2]; f32x4 hi; hi[0] = v0[1]; hi[1] = v0[3]; hi[2] = v1[1]; hi[3] = v1[3];
                                *(f32x4*)nk = lo; *(f32x4*)(nk + 32) = hi; } }
                    } else if (pn == 2) {
                        const int vc = c - 640, kvh = vc >> 6, d = vc & 63;
                        if (!lat) { *(f32x4*)(newv + (size_t)row * 128 + vc) = v0; *(f32x4*)(newv + (size_t)row * 128 + vc + 4) = v1; }
                        bf16* vp; int S;
                        if (!lat) { S = SEQ_C; vp = vT + ((size_t)((row >> 8) * 2 + kvh) * 64 + d) * SEQ_C + pos; }
                        else { S = SEQ_L; vp = vT + VT_LAT_OFF + ((size_t)(((row - NCTX) >> 10) * 2 + kvh) * 64 + d) * SEQ_L + pos; }
                        vp[0] = (bf16)f2bf(v0[0]); vp[S] = (bf16)f2bf(v0[1]); vp[2 * S] = (bf16)f2bf(v0[2]); vp[3 * S] = (bf16)f2bf(v0[3]);
                        vp[4 * S] = (bf16)f2bf(v1[0]); vp[5 * S] = (bf16)f2bf(v1[1]); vp[6 * S] = (bf16)f2bf(v1[2]); vp[7 * S] = (bf16)f2bf(v1[3]);
                    } else {
                        v4u w; w.x = pk2(v0[0], v0[1]); w.y = pk2(v0[2], v0[3]); w.z = pk2(v1[0], v1[1]); w.w = pk2(v1[2], v1[3]);
                        if (pn < 5) *(v4u*)(xr + (size_t)row * 512 + (c - 768)) = w; else *(v4u*)(yg + (size_t)row * 512 + (c - 1280)) = w;
                    }
                }
            }
    }
};
struct EpiOutProj {
    static constexpr bool PERM = true;
    const float *xp, *xs, *mods, *gffn; float* x1; bf16* ap; float* ssp;
    __device__ __forceinline__ void operator()(const f32x4 (&acc)[2][2][4][2], const pg8::Unit& u, int wr, int wc, int fr, int fq) const {
        const int mi = u.pm < 32 ? 0 : 1 + ((u.pm - 32) >> 2);
        const float* mv = mods + (size_t)mi * MODW;
        const int row0 = u.pm * 256 + wr * 64 + fr;
        const float* xbase = (u.pm < 32 ? xp : xs - (size_t)NCTX * DM) + (size_t)row0 * DM;
        float ssq[2][4];
#pragma unroll
        for (int ai = 0; ai < 2; ++ai)
#pragma unroll
            for (int m = 0; m < 4; ++m) ssq[ai][m] = 0.f;
#pragma unroll
        for (int bj = 0; bj < 2; ++bj) {
            const int c = u.pn * 256 + bj * 128 + wc * 32 + 8 * fq;
            const f32x4 gv0 = *(const f32x4*)(mv + 2 * DM + c), gv1 = *(const f32x4*)(mv + 2 * DM + c + 4);
            const f32x4 g20 = *(const f32x4*)(gffn + c) * (1.f + *(const f32x4*)(mv + 4 * DM + c)), g21 = *(const f32x4*)(gffn + c + 4) * (1.f + *(const f32x4*)(mv + 4 * DM + c + 4));
#pragma unroll
            for (int h4 = 0; h4 < 4; ++h4) {
                const int ai = h4 >> 1;
                f32x4 xv[2][2];
#pragma unroll
                for (int mm = 0; mm < 2; ++mm) { const float* xr = xbase + (size_t)(ai * 128 + (2 * (h4 & 1) + mm) * 16) * DM + c; xv[mm][0] = *(const f32x4*)xr; xv[mm][1] = *(const f32x4*)(xr + 4); }
                asm volatile("" ::: "memory");
#pragma unroll
                for (int mm = 0; mm < 2; ++mm) {
                    const int m = 2 * (h4 & 1) + mm;
                    const size_t off = (size_t)(row0 + ai * 128 + m * 16) * DM + c;
                    const f32x4 o0 = xv[mm][0] + gv0 * acc[ai][bj][m][0], o1 = xv[mm][1] + gv1 * acc[ai][bj][m][1];
                    *(f32x4*)(x1 + off) = o0; *(f32x4*)(x1 + off + 4) = o1;
                    ssq[ai][m] += ((o0[0] * o0[0] + o0[1] * o0[1]) + (o0[2] * o0[2] + o0[3] * o0[3])) + ((o1[0] * o1[0] + o1[1] * o1[1]) + (o1[2] * o1[2] + o1[3] * o1[3]));
                    const f32x4 t0 = o0 * g20, t1 = o1 * g21; v4u w; w.x = pk2(t0[0], t0[1]); w.y = pk2(t0[2], t0[3]); w.z = pk2(t1[0], t1[1]); w.w = pk2(t1[2], t1[3]);
                    *(v4u*)(ap + off) = w;
                }
                asm volatile("" ::: "memory");
            }
        }
#pragma unroll
        for (int ai = 0; ai < 2; ++ai)
#pragma unroll
            for (int m = 0; m < 4; ++m) { float v = ssq[ai][m]; v += __shfl_xor(v, 16); v += __shfl_xor(v, 32);
                if (fq == 0) ssp[(size_t)(row0 + ai * 128 + m * 16) * 16 + u.pn * 4 + wc] = v; }
    }
};
struct EpiScores {
    static constexpr bool PERM = true;
    bf16* sc; const float* ssp; const float* bias;
    __device__ __forceinline__ void operator()(const f32x4 (&acc)[2][2][4][2], const pg8::Unit& u, int wr, int wc, int fr, int fq) const {
        const int mi = u.pm < 32 ? 0 : 1 + ((u.pm - 32) >> 2);
        const int row0 = u.pm * 256 + wr * 64 + fr;
        f32x4 b0[2], b1[2];
#pragma unroll
        for (int bj = 0; bj < 2; ++bj) { const int c = u.pn * 256 + bj * 128 + wc * 32 + 8 * fq; b0[bj] = *(const f32x4*)(bias + (size_t)mi * 2048 + c); b1[bj] = *(const f32x4*)(bias + (size_t)mi * 2048 + c + 4); }
#pragma unroll
        for (int h2 = 0; h2 < 4; ++h2) {
            const int ai = h2 >> 1;
            f32x4 sp[2][4];
#pragma unroll
            for (int mm = 0; mm < 2; ++mm)
#pragma unroll
                for (int q = 0; q < 4; ++q) sp[mm][q] = *((const f32x4*)(ssp + (size_t)(row0 + ai * 128 + (2 * (h2 & 1) + mm) * 16) * 16) + q);
            asm volatile("" ::: "memory");
#pragma unroll
            for (int mm = 0; mm < 2; ++mm) {
                const int m = 2 * (h2 & 1) + mm;
                const int row = row0 + ai * 128 + m * 16;
                const float ss = ((sp[mm][0][0] + sp[mm][0][1]) + (sp[mm][0][2] + sp[mm][0][3])) + ((sp[mm][1][0] + sp[mm][1][1]) + (sp[mm][1][2] + sp[mm][1][3]))
                               + ((sp[mm][2][0] + sp[mm][2][1]) + (sp[mm][2][2] + sp[mm][2][3])) + ((sp[mm][3][0] + sp[mm][3][1]) + (sp[mm][3][2] + sp[mm][3][3]));
                const float rstd = 1.f / sqrtf(ss * (1.f / DM) + EPS);
#pragma unroll
                for (int bj = 0; bj < 2; ++bj) {
                    const int c = u.pn * 256 + bj * 128 + wc * 32 + 8 * fq;
                    const f32x4 v0 = acc[ai][bj][m][0] * rstd + b0[bj], v1 = acc[ai][bj][m][1] * rstd + b1[bj];
                    v4u w; w.x = pk2(v0[0], v0[1]); w.y = pk2(v0[2], v0[3]); w.z = pk2(v1[0], v1[1]); w.w = pk2(v1[2], v1[3]);
                    *(v4u*)(sc + (size_t)row * 2048 + c) = w;
                }
            }
            asm volatile("" ::: "memory");
        }
    }
};

__device__ __forceinline__ void attn_unit(Frame& F, bool lat, int seq, int kvh, int qt) {
    const int tid = F.tid, lane = F.lane, wave = F.wave, r32 = lane & 31, hi = lane >> 5;
    const int g = wave >> 1, qs = wave & 1, head = kvh * 4 + g;
    const int S = lat ? SEQ_L : SEQ_C, tokbase = lat ? NCTX + seq * SEQ_L : seq * SEQ_C;
    const int q0 = qt * 64, qpos = q0 + 32 * qs + r32;
    const bf16* Q = (const bf16*)(F.ws + WS_Q); const bf16* Kb = (const bf16*)(F.ws + WS_K); const bf16* VT = (const bf16*)(F.ws + WS_VT);
    const bf16* CK = (const bf16*)(F.ws + WS_CK); const bf16* CVT = (const bf16*)(F.ws + WS_CVT);
    unsigned char* ldsK = F.lds; unsigned char* ldsV = F.lds + 8192;
    bf16x8 qf[4];
    { const bf16* qp = Q + (size_t)(tokbase + qpos) * 512 + head * 64;
#pragma unroll
      for (int ks = 0; ks < 4; ++ks) qf[ks] = *(const bf16x8*)(qp + 16 * ks + 8 * hi); }
    const float sinkl = F.in[I_SINK][head] * LOG2E;
    float mrun = sinkl, lrun = (hi == 0) ? 1.f : 0.f;
    f32x16 o0, o1;
#pragma unroll
    for (int r = 0; r < 16; ++r) { o0[r] = 0.f; o1[r] = 0.f; }
    int tlo, thi;
    if (lat) { tlo = (q0 >= 128 ? q0 - 128 : 0) >> 6; thi = ((q0 + 192 < S ? q0 + 192 : S)) >> 6; } else { tlo = 0; thi = 4; }
    const int nband = thi - tlo, ntile = nband + (lat ? 4 : 0);
    const int key_t = tid >> 3, ch_t = tid & 7;
    v4u kv, vv;
#define AT_LOAD(t_) do { const int tt_ = (t_); const bf16* kptr; const bf16* vptr; int vstride; \
        if (tt_ < nband) { const int kb_ = (tlo + tt_) * 64; kptr = Kb + (size_t)(tokbase + kb_) * 128 + kvh * 64; \
            vptr = VT + (lat ? (size_t)VT_LAT_OFF + (size_t)((seq * 2 + kvh) * 64) * SEQ_L : (size_t)((seq * 2 + kvh) * 64) * SEQ_C) + kb_; vstride = S; } \
        else { const int tc = tt_ - nband; kptr = CK + (size_t)(seq * 256 + tc * 64) * 128 + kvh * 64; vptr = CVT + (size_t)((seq * 2 + kvh) * 64) * 256 + tc * 64; vstride = 256; } \
        kv = *(const v4u*)(kptr + (size_t)key_t * 128 + ch_t * 8); vv = *(const v4u*)(vptr + (size_t)key_t * vstride + ch_t * 8); } while (0)
    AT_LOAD(0);
    for (int t = 0; t < ntile; ++t) {
        const bool band = t < nband;
        const int kbase = band ? (tlo + t) * 64 : 0;
        __syncthreads();
        *(v4u*)(ldsK + key_t * 128 + ((ch_t ^ (key_t & 7)) * 16)) = kv;
        *(v4u*)(ldsV + key_t * 128 + ((ch_t ^ (key_t & 7)) * 16)) = vv;
        __syncthreads();
        f32x16 p0, p1;
#pragma unroll
        for (int r = 0; r < 16; ++r) { p0[r] = 0.f; p1[r] = 0.f; }
#pragma unroll
        for (int ks = 0; ks < 4; ++ks) {
            const int sw = ((2 * ks + hi) ^ (r32 & 7)) * 16;
            const bf16x8 a0 = *(const bf16x8*)(ldsK + r32 * 128 + sw);
            const bf16x8 a1 = *(const bf16x8*)(ldsK + (32 + r32) * 128 + sw);
            p0 = __builtin_amdgcn_mfma_f32_32x32x16_bf16(a0, qf[ks], p0, 0, 0, 0);
            p1 = __builtin_amdgcn_mfma_f32_32x32x16_bf16(a1, qf[ks], p1, 0, 0, 0);
        }
        if (t + 1 < ntile) AT_LOAD(t + 1);
        if (band && lat && (kbase < q0 + 63 - 128 || kbase + 63 > q0 + 128)) {
#pragma unroll
            for (int r = 0; r < 16; ++r) { const int kp = kbase + crow(r, hi); int d0 = qpos - kp; d0 = d0 < 0 ? -d0 : d0; int d1 = qpos - kp - 32; d1 = d1 < 0 ? -d1 : d1;
                if (d0 > 128) p0[r] = -INFINITY; if (d1 > 128) p1[r] = -INFINITY; }
        }
        float tm = p0[0];
#pragma unroll
        for (int r = 1; r < 16; ++r) tm = fmaxf(tm, p0[r]);
#pragma unroll
        for (int r = 0; r < 16; ++r) tm = fmaxf(tm, p1[r]);
        tm = fmaxf(tm, __shfl_xor(tm, 32));
        const float mn = fmaxf(mrun, tm), alpha = __builtin_amdgcn_exp2f(mrun - mn); mrun = mn;
        float ls = 0.f;
#pragma unroll
        for (int r = 0; r < 16; ++r) { p0[r] = __builtin_amdgcn_exp2f(p0[r] - mn); p1[r] = __builtin_amdgcn_exp2f(p1[r] - mn); ls += p0[r] + p1[r]; o0[r] *= alpha; o1[r] *= alpha; }
        lrun = lrun * alpha + ls;
        bf16x8 pf[4];
#pragma unroll
        for (int s = 0; s < 2; ++s) {
            v4u w0, w1;
            w0.x = pk2(p0[8 * s + 0], p0[8 * s + 1]); w0.y = pk2(p0[8 * s + 2], p0[8 * s + 3]); w0.z = pk2(p0[8 * s + 4], p0[8 * s + 5]); w0.w = pk2(p0[8 * s + 6], p0[8 * s + 7]);
            w1.x = pk2(p1[8 * s + 0], p1[8 * s + 1]); w1.y = pk2(p1[8 * s + 2], p1[8 * s + 3]); w1.z = pk2(p1[8 * s + 4], p1[8 * s + 5]); w1.w = pk2(p1[8 * s + 6], p1[8 * s + 7]);
            pf[s] = __builtin_bit_cast(bf16x8, w0); pf[2 + s] = __builtin_bit_cast(bf16x8, w1);
        }
#pragma unroll
        for (int s4 = 0; s4 < 4; ++s4) {
#pragma unroll
            for (int dt = 0; dt < 2; ++dt) {
                const int d = 32 * dt + r32;
                const v2u lo = *(const v2u*)(ldsV + d * 128 + (((2 * s4) ^ (d & 7)) * 16) + 8 * hi);
                const v2u hi2 = *(const v2u*)(ldsV + d * 128 + (((2 * s4 + 1) ^ (d & 7)) * 16) + 8 * hi);
                v4u vf4; vf4.x = lo.x; vf4.y = lo.y; vf4.z = hi2.x; vf4.w = hi2.y;
                const bf16x8 vf = __builtin_bit_cast(bf16x8, vf4);
                if (dt == 0) o0 = __builtin_amdgcn_mfma_f32_32x32x16_bf16(vf, pf[s4], o0, 0, 0, 0);
                else o1 = __builtin_amdgcn_mfma_f32_32x32x16_bf16(vf, pf[s4], o1, 0, 0, 0);
            }
        }
    }
    const float ltot = lrun + __shfl_xor(lrun, 32), inv = 1.f / ltot;
    bf16* mix = (bf16*)(F.ws + WS_MIX) + (size_t)(tokbase + qpos) * DM + head * 64;
#pragma unroll
    for (int g4 = 0; g4 < 4; ++g4) {
        v2u w; w.x = pk2(o0[4 * g4] * inv, o0[4 * g4 + 1] * inv); w.y = pk2(o0[4 * g4 + 2] * inv, o0[4 * g4 + 3] * inv);
        *(v2u*)(mix + 8 * g4 + 4 * hi) = w;
        v2u w2; w2.x = pk2(o1[4 * g4] * inv, o1[4 * g4 + 1] * inv); w2.y = pk2(o1[4 * g4 + 2] * inv, o1[4 * g4 + 3] * inv);
        *(v2u*)(mix + 32 + 8 * g4 + 4 * hi) = w2;
    }
    __syncthreads();
}

constexpr int RL_HALF = 49152;
constexpr int RL_XCB = 32768;
constexpr int RL_AGG = 98304;
constexpr int RL_CARRY = RL_AGG + 8192;
constexpr int RL_CW = RL_CARRY + 512;
constexpr int RL_WG = RL_CW + 1280;
static_assert(RL_WG + 32768 <= LDSCTL_OFF, "RNN LDS map");
__device__ __forceinline__ float fsigmoid(float x) { return __builtin_amdgcn_rcpf(1.f + __expf(-x)); }
__device__ __forceinline__ float gelu_fast(float x) { const float y = 0.7978845608028654f * (x + 0.044715f * x * x * x); const float e = __expf(2.f * y); return x - x * __builtin_amdgcn_rcpf(1.f + e); }

template <bool REV>
__device__ __forceinline__ void scan_prep(const float (&a)[16], const float (&b)[16], int h, float (&Apre)[4], float (&Bpre)[4], float& At, float& Bt) {
    float Ao[4], Bo[4], Ap[4], Bp[4];
#pragma unroll
    for (int g = 0; g < 4; ++g) { float A = 1.f, B = 0.f;
#pragma unroll
        for (int ii = 0; ii < 4; ++ii) { const int r = 4 * g + (REV ? 3 - ii : ii); B = a[r] * B + b[r]; A = a[r] * A; }
        Ao[g] = A; Bo[g] = B; }
#pragma unroll
    for (int g = 0; g < 4; ++g) { Ap[g] = __shfl_xor(Ao[g], 32); Bp[g] = __shfl_xor(Bo[g], 32); }
    const bool ownfirst = REV ? (h == 1) : (h == 0);
    float Ac = 1.f, Bc = 0.f;
#pragma unroll
    for (int gi = 0; gi < 4; ++gi) { const int g = REV ? 3 - gi : gi;
        const float A1 = ownfirst ? Ao[g] : Ap[g], B1 = ownfirst ? Bo[g] : Bp[g], A2 = ownfirst ? Ap[g] : Ao[g], B2 = ownfirst ? Bp[g] : Bo[g];
        const float Ac1 = A1 * Ac, Bc1 = A1 * Bc + B1;
        Apre[g] = ownfirst ? Ac : Ac1; Bpre[g] = ownfirst ? Bc : Bc1;
        Ac = A2 * Ac1; Bc = A2 * Bc1 + B2; }
    At = Ac; Bt = Bc;
}
template <bool REV>
__device__ __forceinline__ void scan_finish(const float (&a)[16], const float (&b)[16], const float (&Apre)[4], const float (&Bpre)[4], float hin, float* hp, int hi) {
#pragma unroll
    for (int g = 0; g < 4; ++g) { float hc = Apre[g] * hin + Bpre[g];
#pragma unroll
        for (int ii = 0; ii < 4; ++ii) { const int r = 4 * g + (REV ? 3 - ii : ii); hc = a[r] * hc + b[r]; hp[(size_t)crow(r, hi) * 512] = hc; } }
}

template <bool REV>
__device__ __forceinline__ void rnn_dir(Frame& F, bool lat, int seq, int n) {
    const int lane = F.lane, w4 = F.wave & 3, r32 = lane & 31, hi = lane >> 5, dirh = REV ? 1 : 0;
    const int S = lat ? SEQ_L : SEQ_C, tokbase = lat ? NCTX + seq * SEQ_L : seq * SEQ_C, nchunk = S / 128;
    unsigned char* hb = F.lds + dirh * RL_HALF;
    float* XC32 = (float*)hb; unsigned char* XCB = hb + RL_XCB;
    f32x2* AGG = (f32x2*)(F.lds + RL_AGG) + dirh * 256; float* CARRY = (float*)(F.lds + RL_CARRY) + dirh * 64; const float* CW = (const float*)(F.lds + RL_CW);
    const unsigned char* WG = F.lds + RL_WG + dirh * 16384;
    const bf16* XR = (const bf16*)(F.ws + WS_XR) + (size_t)tokbase * 512 + n * 64;
    float* HX = (float*)(F.ws + (REV ? WS_H : WS_HF)) + (size_t)tokbase * 512 + n * 64;
    const int t = F.tid & 255, c8 = t & 7, tg = t >> 3;
    float ba[2], bi[2], sp8[2];
#pragma unroll
    for (int chh = 0; chh < 2; ++chh) { const int pe = dirh * 512 + n * 64 + chh * 32 + r32; ba[chh] = -LOG2E * F.in[I_RGBA][pe]; bi[chh] = -LOG2E * F.in[I_RGBI][pe];
        const float nl = -F.in[I_RGLAM][pe]; sp8[chh] = -8.f * LOG2E * (nl > 20.f ? nl : log1pf(__expf(nl))); }
    v4u xin[7];
#define RL_XLOAD(c0_) do { _Pragma("unroll") for (int i = 0; i < 7; ++i) { const int pos = (c0_) + 4 * tg - 2 + i; \
        xin[i] = (pos >= 0 && pos < S) ? *(const v4u*)(XR + (size_t)pos * 512 + 8 * c8) : (v4u){0u, 0u, 0u, 0u}; } } while (0)
    RL_XLOAD((REV ? nchunk - 1 : 0) * 128);
    float newcarry[2] = {0.f, 0.f};
    const bool last_tile = REV ? (w4 == 0) : (w4 == 3);
#pragma unroll 1
    for (int k = 0; k < nchunk; ++k) {
        const int c0 = (REV ? nchunk - 1 - k : k) * 128;
        {
            const f32x4 b0 = *(const f32x4*)(CW + 256 + 8 * c8), b1 = *(const f32x4*)(CW + 256 + 8 * c8 + 4);
            f32x4 wt0[4], wt1[4];
#pragma unroll
            for (int tap = 0; tap < 4; ++tap) { wt0[tap] = *(const f32x4*)(CW + tap * 64 + 8 * c8); wt1[tap] = *(const f32x4*)(CW + tap * 64 + 8 * c8 + 4); }
#pragma unroll
            for (int i = 0; i < 4; ++i) {
                f32x4 y0 = b0, y1 = b1;
#pragma unroll
                for (int tap = 0; tap < 4; ++tap) { const v4u x = xin[i + tap];
                    y0[0] += wt0[tap][0] * bflo(x.x); y0[1] += wt0[tap][1] * bfhi(x.x); y0[2] += wt0[tap][2] * bflo(x.y); y0[3] += wt0[tap][3] * bfhi(x.y);
                    y1[0] += wt1[tap][0] * bflo(x.z); y1[1] += wt1[tap][1] * bfhi(x.z); y1[2] += wt1[tap][2] * bflo(x.w); y1[3] += wt1[tap][3] * bfhi(x.w); }
                const int tk = 4 * tg + i;
                *(f32x4*)(XC32 + tk * 64 + 8 * c8) = y0; *(f32x4*)(XC32 + tk * 64 + 8 * c8 + 4) = y1;
                v4u w; w.x = pk2(y0[0], y0[1]); w.y = pk2(y0[2], y0[3]); w.z = pk2(y1[0], y1[1]); w.w = pk2(y1[2], y1[3]);
                *(v4u*)(XCB + tk * 128 + ((c8 ^ (tk & 7)) * 16)) = w; }
        }
        if (k + 1 < nchunk) RL_XLOAD((REV ? nchunk - 2 - k : k + 1) * 128);
        __syncthreads();
        if (k > 0 && last_tile && hi == 0) { CARRY[r32] = newcarry[0]; CARRY[32 + r32] = newcarry[1]; }
        const int tkA = 32 * w4 + r32;
#pragma unroll
        for (int chh = 0; chh < 2; ++chh) {
            const int che = chh * 32 + r32;
            float av[16], bv[16], Apre[4], Bpre[4];
            {
                f32x16 ga, gi;
#pragma unroll
                for (int r = 0; r < 16; ++r) { ga[r] = 0.f; gi[r] = 0.f; }
#pragma unroll
                for (int ks = 0; ks < 4; ++ks) {
                    const bf16x8 af = *(const bf16x8*)(XCB + tkA * 128 + (((2 * ks + hi) ^ (tkA & 7)) * 16));
                    const bf16x8 wa = *(const bf16x8*)(WG + che * 128 + (((2 * ks + hi) ^ (che & 7)) * 16));
                    const bf16x8 wi = *(const bf16x8*)(WG + 8192 + che * 128 + (((2 * ks + hi) ^ (che & 7)) * 16));
                    ga = __builtin_amdgcn_mfma_f32_32x32x16_bf16(af, wa, ga, 0, 0, 0);
                    gi = __builtin_amdgcn_mfma_f32_32x32x16_bf16(af, wi, gi, 0, 0, 0);
                }
#pragma unroll
                for (int r = 0; r < 16; ++r) { const int tk2 = 32 * w4 + crow(r, hi); const float x = XC32[tk2 * 64 + che];
                    const float rg = __builtin_amdgcn_rcpf(1.f + __builtin_amdgcn_exp2f(ga[r] + ba[chh])), ig = __builtin_amdgcn_rcpf(1.f + __builtin_amdgcn_exp2f(gi[r] + bi[chh])), a = __builtin_amdgcn_exp2f(rg * sp8[chh]);
                    av[r] = a; bv[r] = __builtin_amdgcn_sqrtf(fmaxf(1.f - a * a, 0.f)) * ig * x;
                    if ((r & 3) == 3) __builtin_amdgcn_sched_barrier(0); }
                float At, Bt;
                scan_prep<REV>(av, bv, hi, Apre, Bpre, At, Bt);
                if (hi == 0) { f32x2 ab; ab.x = At; ab.y = Bt; AGG[chh * 512 + w4 * 64 + che] = ab; }
            }
            __syncthreads();
            {
                float hin = CARRY[che];
                if (!REV) { for (int t2 = 0; t2 < w4; ++t2) { const f32x2 ab = AGG[chh * 512 + t2 * 64 + che]; hin = ab.x * hin + ab.y; } }
                else { for (int t2 = 3; t2 > w4; --t2) { const f32x2 ab = AGG[chh * 512 + t2 * 64 + che]; hin = ab.x * hin + ab.y; } }
                scan_finish<REV>(av, bv, Apre, Bpre, hin, HX + (size_t)(c0 + 32 * w4) * 512 + che, hi);
                if (last_tile) { const f32x2 ab = AGG[chh * 512 + w4 * 64 + che]; newcarry[chh] = ab.x * hin + ab.y; }
            }
        }
    }
#undef RL_XLOAD
    if (!lat && last_tile && hi == 0) { float* o = F.out + O_NEWRNN + (size_t)(seq * 2 + dirh) * 512 + n * 64; o[r32] = newcarry[0]; o[32 + r32] = newcarry[1]; }
}

__device__ __forceinline__ void rnn_unit(Frame& F, bool lat, int seq, int n) {
    const int tid = F.tid;
    const int S = lat ? SEQ_L : SEQ_C, tokbase = lat ? NCTX + seq * SEQ_L : seq * SEQ_C;
    __syncthreads();
    { float* CW = (float*)(F.lds + RL_CW); float* CARRY = (float*)(F.lds + RL_CARRY);
      if (tid < 320) CW[tid] = tid < 256 ? F.in[I_CONVW][(tid >> 6) * 512 + n * 64 + (tid & 63)] : F.in[I_CONVB][n * 64 + (tid - 256)];
      if (tid < 128) CARRY[tid] = lat ? F.in[I_SRNN][(size_t)(seq * 2 + (tid >> 6)) * 512 + n * 64 + (tid & 63)] : 0.f;
      const bf16* rgw = (const bf16*)(F.ws + WS_RGW);
#pragma unroll
      for (int i = 0; i < 4; ++i) { const int q = tid + 512 * i, ch = q & 7, d = (q >> 3) & 63, gate = (q >> 9) & 1, dir = q >> 10;
          const v4u w = *(const v4u*)(rgw + (size_t)((dir * 8 + n) * 2 + gate) * 4096 + d * 64 + ch * 8);
          *(v4u*)(F.lds + RL_WG + dir * 16384 + gate * 8192 + d * 128 + ((ch ^ (d & 7)) * 16)) = w; } }
    __syncthreads();
    if (F.wave < 4) rnn_dir<false>(F, lat, seq, n); else rnn_dir<true>(F, lat, seq, n);
    __syncthreads();
    { const int c4 = tid & 15, tk = tid >> 4;
      const float* HF = (const float*)(F.ws + WS_HF) + (size_t)tokbase * 512 + n * 64 + 4 * c4;
      const float* HB = (const float*)(F.ws + WS_H) + (size_t)tokbase * 512 + n * 64 + 4 * c4;
      const bf16* YG = (const bf16*)(F.ws + WS_YG) + (size_t)tokbase * 512 + n * 64 + 4 * c4;
      bf16* MIX = (bf16*)(F.ws + WS_MIX) + (size_t)tokbase * DM + 512 + n * 64 + 4 * c4;
      for (int t0 = tk; t0 < S; t0 += 32) {
          const f32x4 a = *(const f32x4*)(HF + (size_t)t0 * 512), b = *(const f32x4*)(HB + (size_t)t0 * 512); const v2u y = *(const v2u*)(YG + (size_t)t0 * 512);
          v2u o; o.x = pk2((a[0] + b[0]) * gelu_fast(bflo(y.x)), (a[1] + b[1]) * gelu_fast(bfhi(y.x))); o.y = pk2((a[2] + b[2]) * gelu_fast(bflo(y.y)), (a[3] + b[3]) * gelu_fast(bfhi(y.y)));
          *(v2u*)(MIX + (size_t)t0 * DM) = o; } }
    __syncthreads();
}

#ifndef MK_P3_TYPES
#define MK_P3_TYPES 15
#endif
__device__ __forceinline__ void p3_phase(Frame& F, int types = 15) {
    const int v = F.vcu;
#pragma unroll 1
    for (int i = 0; i < 832; ++i) {
        int type, idx;
        if (F.G == 256) {
            if (v < 64) { if (i > 0) break; type = 0; idx = v; }
            else { if (i >= 6) break; const int j = v - 64, sl = i >> 1, rep = i & 1; type = 1 + sl;
                const bool extra = sl == 0 ? (j < 64) : (sl == 1 ? (j >= 64 && j < 128) : (j >= 128));
                if (rep && !extra) continue; idx = rep ? 192 + (j - 64 * sl) : j; }
        } else { const int it = v + i * F.G; if (it >= 832) break;
            if (it < 64) { type = 0; idx = it; } else if (it < 320) { type = 1; idx = it - 64; } else if (it < 576) { type = 2; idx = it - 320; } else { type = 3; idx = it - 576; } }
        if (!((types >> type) & 1)) continue;
        const bool lat = type < 2;
        Frame L = F; asm volatile("" : "+v"(L.tid)); L.lane = L.tid & 63;
        asm volatile("" : "+s"(L.ws), "+s"(L.out));
        if ((type & 1) == 0) rnn_unit(L, lat, idx >> 3, idx & 7);
        else { if (lat) attn_unit(L, true, idx >> 5, (idx >> 4) & 1, idx & 15); else attn_unit(L, false, idx >> 3, (idx >> 2) & 1, idx & 3); }
    }
}

__device__ __forceinline__ unsigned key16(unsigned b, unsigned idx) { const unsigned s = (b & 0x8000u) ? (~b & 0xffffu) : (b | 0x8000u); return (s << 16) | idx; }
__device__ __forceinline__ float keyval16(unsigned k) { const unsigned s = k >> 16; const unsigned b = (s & 0x8000u) ? (s & 0x7fffu) : (~s & 0xffffu); return bf2f(b); }
__device__ __forceinline__ unsigned sortable32(float f) { const unsigned u = __builtin_bit_cast(unsigned, f); return (u & 0x80000000u) ? ~u : (u | 0x80000000u); }
template <int CTRL> __device__ __forceinline__ unsigned dppu(unsigned v) { return (unsigned)__builtin_amdgcn_update_dpp(0, (int)v, CTRL, 0xf, 0xf, true); }
template <int CTRL> __device__ __forceinline__ float dppf(float v) { return __builtin_bit_cast(float, __builtin_amdgcn_update_dpp(0, __builtin_bit_cast(int, v), CTRL, 0xf, 0xf, true)); }
__device__ __forceinline__ unsigned umax_(unsigned a, unsigned b) { return a > b ? a : b; }
__device__ __forceinline__ unsigned umin_(unsigned a, unsigned b) { return a < b ? a : b; }
__device__ __forceinline__ unsigned rowmax16u(unsigned x) { x = umax_(x, dppu<0xB1>(x)); x = umax_(x, dppu<0x4E>(x)); x = umax_(x, dppu<0x141>(x)); x = umax_(x, dppu<0x140>(x)); return x; }
__device__ __forceinline__ float rowmax16f(float x) { x = fmaxf(x, dppf<0xB1>(x)); x = fmaxf(x, dppf<0x4E>(x)); x = fmaxf(x, dppf<0x141>(x)); x = fmaxf(x, dppf<0x140>(x)); return x; }
__device__ __forceinline__ float rowsum16f(float x) { x += dppf<0xB1>(x); x += dppf<0x4E>(x); x += dppf<0x141>(x); x += dppf<0x140>(x); return x; }
__device__ __forceinline__ int rowsum16i(int x) { x += (int)dppu<0xB1>((unsigned)x); x += (int)dppu<0x4E>((unsigned)x); x += (int)dppu<0x141>((unsigned)x); x += (int)dppu<0x140>((unsigned)x); return x; }
#define CEX(a, b) do { const unsigned _h = umax_(a, b), _l = umin_(a, b); a = _h; b = _l; } while (0)

#ifndef P7_NCH
#define P7_NCH 8
#endif
constexpr int P7_CSH = (P7_NCH == 4 ? 12 : (P7_NCH == 8 ? 11 : (P7_NCH == 16 ? 10 : 9)));
constexpr int P7_WL = 16384;
constexpr int P7_TL = 0, P7_TE = 1024, P7_TG = 3072, P7_LE = 5120, P7_LG = 7168, P7_LSU = 9216, P7_LQ = 11264, P7_H2Q = 12160, P7_HST = 16256;
static_assert(P7_LQ + 512 <= P7_H2Q && (P7_H2Q % 16) == 0 && P7_HST + 16 <= P7_WL && P7_WL * 8 <= RING_BYTES, "P7 LDS map");

#define TK_KEYS(R, raw, kb) unsigned R##0 = key16(raw.x & 0xffffu, (kb) + 0), R##1 = key16(raw.x >> 16, (kb) + 1), R##2 = key16(raw.y & 0xffffu, (kb) + 2), R##3 = key16(raw.y >> 16, (kb) + 3), \
        R##4 = key16(raw.z & 0xffffu, (kb) + 4), R##5 = key16(raw.z >> 16, (kb) + 5), R##6 = key16(raw.w & 0xffffu, (kb) + 6), R##7 = key16(raw.w >> 16, (kb) + 7)
#define TK_SORT8(R) do { CEX(R##0, R##1); CEX(R##2, R##3); CEX(R##4, R##5); CEX(R##6, R##7); CEX(R##0, R##2); CEX(R##1, R##3); CEX(R##4, R##6); CEX(R##5, R##7); CEX(R##1, R##2); CEX(R##5, R##6); \
        CEX(R##0, R##4); CEX(R##1, R##5); CEX(R##2, R##6); CEX(R##3, R##7); CEX(R##2, R##4); CEX(R##3, R##5); CEX(R##1, R##2); CEX(R##3, R##4); CEX(R##5, R##6); } while (0)
#define TK_POP8(R, KEEP, it) do { const unsigned m_ = rowmax16u(R##0); const bool w_ = R##0 == m_; R##0 = w_ ? R##1 : R##0; R##1 = w_ ? R##2 : R##1; R##2 = w_ ? R##3 : R##2; R##3 = w_ ? R##4 : R##3; \
        R##4 = w_ ? R##5 : R##4; R##5 = w_ ? R##6 : R##5; R##6 = w_ ? R##7 : R##6; R##7 = w_ ? 0u : R##7; KEEP = (k == (it)) ? m_ : KEEP; } while (0)
#define TK_POP4(C, KEEP, it) do { const unsigned m_ = rowmax16u(C[0]); const bool w_ = C[0] == m_; C[0] = w_ ? C[1] : C[0]; C[1] = w_ ? C[2] : C[1]; C[2] = w_ ? C[3] : C[2]; C[3] = w_ ? 0u : C[3]; KEEP = (k == (it)) ? m_ : KEEP; } while (0)
__device__ __forceinline__ void topk_token(const v4u (&rawv)[4], unsigned* TL, int lane, const unsigned ctabp, int* oute, float* outg) {
    const int k = lane & 15, row = lane >> 4;
#pragma unroll
    for (int pp = 0; pp < 2; ++pp) {
        const v4u rawa = rawv[2 * pp], rawb = rawv[2 * pp + 1];
        TK_KEYS(a, rawa, k * 8); TK_KEYS(b, rawb, k * 8);
        TK_SORT8(a); TK_SORT8(b);
        unsigned keepa = 0, keepb = 0;
#pragma unroll
        for (int it = 0; it < 16; ++it) { TK_POP8(a, keepa, it); TK_POP8(b, keepb, it); }
        TL[((2 * pp) * 4 + row) * 16 + k] = keepa; TL[((2 * pp + 1) * 4 + row) * 16 + k] = keepb;
    }
    unsigned ca[4], cb[4];
    const unsigned* LAa = TL + (2 * row) * 16; const unsigned* LBa = TL + (2 * row + 1) * 16;
    const unsigned* LAb = TL + (2 * (4 + row)) * 16; const unsigned* LBb = TL + (2 * (4 + row) + 1) * 16;
#pragma unroll
    for (int s = 0; s < 4; ++s) { const int ij = (int)((ctabp >> (8 * s)) & 0xffu); const bool valid = ij != 255; const int i = (ij >> 4) & 15, j = ij & 15;
        const float sa = keyval16(LAa[i]) + keyval16(LBa[j]), sb = keyval16(LAb[i]) + keyval16(LBb[j]);
        ca[s] = valid ? ((sortable32(sa) & 0xffffff00u) | (unsigned)(i * 16 + j)) : 0u; cb[s] = valid ? ((sortable32(sb) & 0xffffff00u) | (unsigned)(i * 16 + j)) : 0u; }
    CEX(ca[0], ca[1]); CEX(ca[2], ca[3]); CEX(ca[0], ca[2]); CEX(ca[1], ca[3]); CEX(ca[1], ca[2]);
    CEX(cb[0], cb[1]); CEX(cb[2], cb[3]); CEX(cb[0], cb[2]); CEX(cb[1], cb[3]); CEX(cb[1], cb[2]);
    unsigned keepa = 0, keepb = 0;
#pragma unroll
    for (int it = 0; it < 16; ++it) { TK_POP4(ca, keepa, it); TK_POP4(cb, keepb, it); }
    {
        const unsigned kaa = LAa[(keepa >> 4) & 15], kba = LBa[keepa & 15], kab = LAb[(keepb >> 4) & 15], kbb = LBb[keepb & 15];
        const float bva = keyval16(kaa) + keyval16(kba), bvb = keyval16(kab) + keyval16(kbb);
        const float mxa = rowmax16f(bva), mxb = rowmax16f(bvb); const float exa = __expf(bva - mxa), exb = __expf(bvb - mxb); const float sma = rowsum16f(exa), smb = rowsum16f(exb);
        oute[lane] = (int)((kaa & 127u) * 128u + (kba & 127u)); outg[lane] = exa / sma;
        oute[64 + lane] = (int)((kab & 127u) * 128u + (kbb & 127u)); outg[64 + lane] = exb / smb;
    }
}
#undef TK_KEYS
#undef TK_SORT8
#undef TK_POP8
#undef TK_POP4

__device__ __forceinline__ void gl16x4(v4u (&r)[4], unsigned voff, const unsigned char* b0, const unsigned char* b1, const unsigned char* b2, const unsigned char* b3) {
    asm volatile("s_nop 4\n\tglobal_load_dwordx4 %0, %4, %5\n\tglobal_load_dwordx4 %1, %4, %6\n\tglobal_load_dwordx4 %2, %4, %7\n\tglobal_load_dwordx4 %3, %4, %8"
                 : "=&v"(r[0]), "=&v"(r[1]), "=&v"(r[2]), "=&v"(r[3]) : "v"(voff), "s"(b0), "s"(b1), "s"(b2), "s"(b3) : "memory");
}
#define P7_VMWAIT(N, R) asm volatile("s_waitcnt vmcnt(" #N ")" : "+v"(R[0]), "+v"(R[1]), "+v"(R[2]), "+v"(R[3]) :: "memory")
__device__ __forceinline__ int mbcnt64(unsigned long long m) { return (int)__builtin_amdgcn_mbcnt_hi((unsigned)(m >> 32), __builtin_amdgcn_mbcnt_lo((unsigned)m, 0u)); }
__device__ __forceinline__ int rfl(int v) { return __builtin_amdgcn_readfirstlane(v); }
__device__ __forceinline__ float rflf(float v) { return __builtin_bit_cast(float, __builtin_amdgcn_readfirstlane(__builtin_bit_cast(int, v))); }

__device__ __forceinline__ void p7_phase(Frame& F, bool dry) {
    const int lane0 = F.lane, wave = F.wave;
    if (dry && (MK_DRY_SKIP & 16) && wave >= 4) return;
    unsigned char* wl = F.lds + wave * P7_WL;
    unsigned* TL = (unsigned*)(wl + P7_TL); int* TE = (int*)(wl + P7_TE); float* TG = (float*)(wl + P7_TG);
    float* LG = (float*)(wl + P7_LG); float* LSU = (float*)(wl + P7_LSU); unsigned char* H2Q = wl + P7_H2Q; float* HST = (float*)(wl + P7_HST);
    const bf16* SC = (const bf16*)(F.ws + WS_SC); const bf16* H2 = (const bf16*)(F.ws + WS_H);
    const unsigned char* U8 = F.ws + WS_U; const unsigned char* V8 = F.ws + WS_V;
    const float* SU = (const float*)(F.ws + WS_SU); const float* SV = (const float*)(F.ws + WS_SV);
    const float* mods = (const float*)(F.ws + WS_MODS); const float* SSP = (const float*)(F.ws + WS_SSP);
    unsigned ctabp = 0;
#pragma unroll
    for (int s = 0; s < 4; ++s) { const int c = 16 * s + (lane0 & 15); int i, j;
        if (c < 16) { i = 0; j = c; } else if (c < 24) { i = 1; j = c - 16; } else if (c < 29) { i = 2; j = c - 24; } else if (c < 33) { i = 3; j = c - 29; } else if (c < 36) { i = 4; j = c - 33; }
        else if (c < 38) { i = 5; j = c - 36; } else if (c < 40) { i = 6; j = c - 38; } else if (c < 42) { i = 7; j = c - 40; } else if (c < 50) { i = c - 34; j = 0; } else { i = -1; j = 0; }
        ctabp |= (unsigned)(i < 0 ? 255 : i * 16 + j) << (8 * s); }
    const int ntg = NTOK / (F.G * NWAVES * 4);
#pragma unroll 1
    for (int tg = 0; tg < ntg; ++tg) {
        const int tok0 = (F.vcu * ntg + tg) * (NWAVES * 4) + wave * 4;
        int lane = F.lane; asm volatile("" : "+v"(lane));
        {
            v4u craw[4], nraw[4]; v4u ch0, ch1, nh0, nh1;
#define P7_TLOAD(R, H0, H1, tk) do { const bf16* sp_ = SC + (size_t)(tk) * 2048 + (lane >> 4) * 128 + (lane & 15) * 8; \
                _Pragma("unroll") for (int ps = 0; ps < 4; ++ps) R[ps] = *(const v4u*)(sp_ + ps * 512); \
                H0 = *(const v4u*)(H2 + (size_t)(tk) * DM + 16 * lane); H1 = *(const v4u*)(H2 + (size_t)(tk) * DM + 16 * lane + 8); } while (0)
            P7_TLOAD(craw, ch0, ch1, tok0);
#pragma unroll 1
            for (int s = 0; s < 4; ++s) {
                if (s < 3) P7_TLOAD(nraw, nh0, nh1, tok0 + s + 1);
                const int tokc = tok0 + s;
                const f32x4* spp = (const f32x4*)(SSP + (size_t)tokc * 16); const f32x4 q0 = spp[0], q1 = spp[1], q2 = spp[2], q3 = spp[3];
                const float* shp = mods + (size_t)mod_index(tokc) * MODW + 3 * DM + 16 * lane;
                const f32x4 sh0 = *(const f32x4*)(shp), sh1 = *(const f32x4*)(shp + 4), sh2v = *(const f32x4*)(shp + 8), sh3 = *(const f32x4*)(shp + 12);
                unsigned ctab_ = ctabp; asm volatile("" : "+v"(ctab_));
                topk_token(craw, TL, lane, ctab_, TE + s * 128, TG + s * 128);
                const v4u a = ch0, b = ch1;
                const float ssr = ((q0[0] + q0[1]) + (q0[2] + q0[3])) + ((q1[0] + q1[1]) + (q1[2] + q1[3])) + ((q2[0] + q2[1]) + (q2[2] + q2[3])) + ((q3[0] + q3[1]) + (q3[2] + q3[3]));
                const float rstd = 1.f / sqrtf(ssr * (1.f / DM) + EPS);
                float hv[16];
                hv[0] = bflo(a.x); hv[1] = bfhi(a.x); hv[2] = bflo(a.y); hv[3] = bfhi(a.y); hv[4] = bflo(a.z); hv[5] = bfhi(a.z); hv[6] = bflo(a.w); hv[7] = bfhi(a.w);
                hv[8] = bflo(b.x); hv[9] = bfhi(b.x); hv[10] = bflo(b.y); hv[11] = bfhi(b.y); hv[12] = bflo(b.z); hv[13] = bfhi(b.z); hv[14] = bflo(b.w); hv[15] = bfhi(b.w);
#pragma unroll
                for (int i = 0; i < 4; ++i) { hv[i] = hv[i] * rstd + sh0[i]; hv[4 + i] = hv[4 + i] * rstd + sh1[i]; hv[8 + i] = hv[8 + i] * rstd + sh2v[i]; hv[12 + i] = hv[12 + i] * rstd + sh3[i]; }
                float am = 0.f;
#pragma unroll
                for (int i = 0; i < 16; ++i) am = fmaxf(am, fabsf(hv[i]));
                am = wave_max(am);
                const float inv = am > 0.f ? 119.f / am : 0.f;
                if (lane == 0) HST[s] = am * (1.f / 119.f);
                v4u qv;
#pragma unroll
                for (int j = 0; j < 4; ++j) { unsigned w = 0;
#pragma unroll
                    for (int i = 0; i < 4; ++i) { int q = (int)rintf(hv[4 * j + i] * inv); w |= ((unsigned)q & 0xffu) << (8 * i); }
                    qv[j] = w; }
                *(v4u*)(H2Q + s * 1024 + 16 * lane) = qv;
#pragma unroll
                for (int ps = 0; ps < 4; ++ps) craw[ps] = nraw[ps];
                ch0 = nh0; ch1 = nh1;
            }
#undef P7_TLOAD
        }
        {
            unsigned* LEO = (unsigned*)(wl + P7_LE);
            int ee0[4], ee1[4]; float gg0[4], gg1[4], us0[4], us1[4], vs0[4], vs1[4];
#pragma unroll
            for (int s = 0; s < 4; ++s) { ee0[s] = TE[s * 128 + lane]; ee1[s] = TE[s * 128 + 64 + lane]; gg0[s] = TG[s * 128 + lane]; gg1[s] = TG[s * 128 + 64 + lane]; }
#pragma unroll
            for (int s = 0; s < 4; ++s) { us0[s] = SU[ee0[s]]; us1[s] = SU[ee1[s]]; vs0[s] = SV[ee0[s]]; vs1[s] = SV[ee1[s]]; }
#pragma unroll
            for (int s = 0; s < 4; ++s) { const int e0 = ee0[s], e1 = ee1[s]; const int c0 = e0 >> P7_CSH, c1 = e1 >> P7_CSH; int base = s * 128;
#pragma unroll
                for (int c = 0; c < P7_NCH; ++c) {
                    const unsigned long long m0 = __ballot(c0 == c), m1 = __ballot(c1 == c);
                    const int n0 = __popcll(m0), n = n0 + __popcll(m1);
                    if (c0 == c) { const int p = base + mbcnt64(m0); LEO[p] = (unsigned)e0 << 9; LG[p] = gg0[s] * vs0[s]; LSU[p] = us0[s]; }
                    if (c1 == c) { const int p = base + n0 + mbcnt64(m1); LEO[p] = (unsigned)e1 << 9; LG[p] = gg1[s] * vs1[s]; LSU[p] = us1[s]; }
                    base += n;
                } }
        }
        typedef __attribute__((address_space(1))) v4u GV4;
        if (!(dry && (MK_DRY_SKIP & 1))) {
            int lane_u = F.lane; asm volatile("" : "+v"(lane_u));
            const int su = lane_u >> 4, ju = lane_u & 15; const unsigned j16 = 16u * (unsigned)ju;
            const unsigned* LEOs = (const unsigned*)(wl + P7_LE) + su * 128; float* LGs = LG + su * 128; const float* LSUs = LSU + su * 128;
            const unsigned long long u8i = (unsigned long long)U8;
            unsigned hh[2][4], hl[2][4];
#pragma unroll
            for (int i = 0; i < 2; ++i) { const v4u ha = *(const v4u*)(H2Q + su * 1024 + 512 * i + 32 * ju), hb = *(const v4u*)(H2Q + su * 1024 + 512 * i + 32 * ju + 16);
#pragma unroll
                for (int w = 0; w < 4; ++w) { unsigned lo16[2], hi16[2];
#pragma unroll
                    for (int h = 0; h < 2; ++h) { const unsigned d = (w < 2 ? ha : hb)[2 * (w & 1) + h];
                        const unsigned t = ((d & 0x7f7f7f7fu) + 0x08080808u) ^ (d & 0x80808080u);
                        unsigned l = (t & 0x0f0f0f0fu) ^ 0x08080808u, g = (t >> 4) & 0x0f0f0f0fu;
                        l = (l | (l >> 4)) & 0x00ff00ffu; l = (l | (l >> 8)) & 0xffffu; g = (g | (g >> 4)) & 0x00ff00ffu; g = (g | (g >> 8)) & 0xffffu;
                        lo16[h] = l; hi16[h] = g; }
                    hl[i][w] = lo16[0] | (lo16[1] << 16); hh[i][w] = hi16[0] | (hi16[1] << 16); } }
            const float hs = HST[su];
            const bool b0 = (ju & 1) != 0, b1 = (ju & 2) != 0; const int rr = ju & 3;
            v4u A[4][2], B[4][2], C[4][2], D[4][2];
#define P7_ULOAD(R, t) do { const v4u eo_ = *(const v4u*)(LEOs + 4 * (t)); \
            _Pragma("unroll") for (int r = 0; r < 4; ++r) { unsigned o_ = eo_[r] + j16; asm volatile("" : "+v"(o_)); \
                R[r][0] = *(const GV4*)(u8i + o_); R[r][1] = *(const GV4*)(u8i + o_ + 256); } \
            __builtin_amdgcn_sched_barrier(0); } while (0)
#define P7_SCOMP_U(R, t) do { const float su_ = LSUs[4 * (t) + rr], g_ = LGs[4 * (t) + rr]; int p_[4]; \
                _Pragma("unroll") for (int r = 0; r < 4; ++r) { int ah = 0, al = 0; \
                    _Pragma("unroll") for (int i = 0; i < 2; ++i) { _Pragma("unroll") for (int w = 0; w < 4; ++w) { \
                        ah = __builtin_amdgcn_sdot8((int)hh[i][w], (int)R[r][i][w], ah, false); al = __builtin_amdgcn_sdot8((int)hl[i][w], (int)R[r][i][w], al, false); } } \
                    p_[r] = 16 * ah + al; } \
                const int q01 = (b0 ? p_[1] : p_[0]) + (int)dppu<0xB1>((unsigned)(b0 ? p_[0] : p_[1])); const int q23 = (b0 ? p_[3] : p_[2]) + (int)dppu<0xB1>((unsigned)(b0 ? p_[2] : p_[3])); \
                int q_ = (b1 ? q23 : q01) + (int)dppu<0x4E>((unsigned)(b1 ? q01 : q23)); q_ += (int)dppu<0x128>((unsigned)q_); q_ += (int)dppu<0x124>((unsigned)q_); \
                const float dotf = (float)q_ * (hs * su_); LGs[4 * (t) + rr] = g_ * gelu_fast(dotf); } while (0)
            P7_ULOAD(A, 0); P7_ULOAD(B, 1); P7_ULOAD(C, 2);
#pragma unroll 1
            for (int t = 0; t < 28; t += 4) {
                P7_ULOAD(D, t + 3); P7_SCOMP_U(A, t);
                P7_ULOAD(A, t + 4); P7_SCOMP_U(B, t + 1);
                P7_ULOAD(B, t + 5); P7_SCOMP_U(C, t + 2);
                P7_ULOAD(C, t + 6); P7_SCOMP_U(D, t + 3);
                asm volatile("" ::: "memory");
            }
            P7_ULOAD(D, 31); P7_SCOMP_U(A, 28); P7_SCOMP_U(B, 29); P7_SCOMP_U(C, 30); P7_SCOMP_U(D, 31);
#undef P7_SCOMP_U
#undef P7_ULOAD
        }
        float cscale; int sumq8;
        {
            int lane_q = F.lane; asm volatile("" : "+v"(lane_q));
            const int sq = lane_q >> 4, jq = lane_q & 15;
            const float* lg = LG + sq * 128 + 8 * jq; const f32x4 c0 = *(const f32x4*)lg, c1 = *(const f32x4*)(lg + 4);
            float m = fmaxf(fmaxf(fmaxf(fabsf(c0[0]), fabsf(c0[1])), fmaxf(fabsf(c0[2]), fabsf(c0[3]))), fmaxf(fmaxf(fabsf(c1[0]), fabsf(c1[1])), fmaxf(fabsf(c1[2]), fabsf(c1[3]))));
            m = rowmax16f(m);
            cscale = m * (1.f / 127.f); const float iv = m > 0.f ? 127.f / m : 0.f;
            v2u w; w.x = 0u; w.y = 0u;
#pragma unroll
            for (int k = 0; k < 4; ++k) { w.x |= ((unsigned)(int)rintf(c0[k] * iv) & 0xffu) << (8 * k); w.y |= ((unsigned)(int)rintf(c1[k] * iv) & 0xffu) << (8 * k); }
            *(v2u*)(wl + P7_LQ + (sq * 32 + 2 * jq) * 4) = w;
            int sq8 = 0;
#pragma unroll
            for (int k = 0; k < 4; ++k) sq8 += (int)rintf(c0[k] * iv) + (int)rintf(c1[k] * iv);
            sumq8 = 8 * rowsum16i(sq8);
        }
        int acc[64];
#pragma unroll
        for (int i = 0; i < 64; ++i) acc[i] = 0;
        if (!(dry && (MK_DRY_SKIP & 2))) {
            int lane_v = F.lane; asm volatile("" : "+v"(lane_v));
            const int sv_ = lane_v >> 4, jv = lane_v & 15; const unsigned j16 = 16u * (unsigned)jv;
            const unsigned* LEOs = (const unsigned*)(wl + P7_LE) + sv_ * 128; const int* LQs = (const int*)(wl + P7_LQ) + sv_ * 32;
            const unsigned long long v8i = (unsigned long long)V8;
            v4u A[4][2], B[4][2], C[4][2];
#define P7_VLOAD(R, t) do { const v4u eo_ = *(const v4u*)(LEOs + 4 * (t)); \
            _Pragma("unroll") for (int r = 0; r < 4; ++r) { unsigned o_ = eo_[r] + j16; asm volatile("" : "+v"(o_)); \
                R[r][0] = *(const GV4*)(v8i + o_); R[r][1] = *(const GV4*)(v8i + o_ + 256); } \
            __builtin_amdgcn_sched_barrier(0); } while (0)
#define P7_SCOMP_V(R, t) do { const int cq_ = LQs[(t)]; \
                _Pragma("unroll") for (int i = 0; i < 2; ++i) { _Pragma("unroll") for (int w = 0; w < 4; ++w) { \
                    const unsigned x_ = __builtin_amdgcn_perm(R[1][i][w], R[0][i][w], 0x05010400u), y_ = __builtin_amdgcn_perm(R[1][i][w], R[0][i][w], 0x07030602u); \
                    const unsigned c_ = __builtin_amdgcn_perm(R[3][i][w], R[2][i][w], 0x05010400u), e_ = __builtin_amdgcn_perm(R[3][i][w], R[2][i][w], 0x07030602u); \
                    unsigned tb_[4]; tb_[0] = __builtin_amdgcn_perm(c_, x_, 0x05040100u); tb_[1] = __builtin_amdgcn_perm(c_, x_, 0x07060302u); tb_[2] = __builtin_amdgcn_perm(e_, y_, 0x05040100u); tb_[3] = __builtin_amdgcn_perm(e_, y_, 0x07060302u); \
                    _Pragma("unroll") for (int b = 0; b < 4; ++b) { \
                        acc[32 * i + 8 * w + 2 * b]     = __builtin_amdgcn_sdot4((int)(tb_[b] & 0x0f0f0f0fu), cq_, acc[32 * i + 8 * w + 2 * b], false); \
                        acc[32 * i + 8 * w + 2 * b + 1] = __builtin_amdgcn_sdot4((int)((tb_[b] >> 4) & 0x0f0f0f0fu), cq_, acc[32 * i + 8 * w + 2 * b + 1], false); } } } } while (0)
            P7_VLOAD(A, 0); P7_VLOAD(B, 1);
#pragma unroll 1
            for (int t = 0; t < 30; t += 3) {
                P7_VLOAD(C, t + 2); P7_SCOMP_V(A, t);
                P7_VLOAD(A, t + 3); P7_SCOMP_V(B, t + 1);
                P7_VLOAD(B, t + 4); P7_SCOMP_V(C, t + 2);
                asm volatile("" ::: "memory");
            }
            P7_SCOMP_V(A, 30); P7_SCOMP_V(B, 31);
#undef P7_SCOMP_V
#undef P7_VLOAD
        }
        {
            int lane_f = F.lane; asm volatile("" : "+v"(lane_f));
            const int sf = lane_f >> 4, jf = lane_f & 15; const int tok = tok0 + sf;
            const float* xrow = F.out + O_Y + (size_t)tok * DM + 32 * jf;
            const float* ga2 = mods + (size_t)mod_index(tok0) * MODW + 5 * DM + 32 * jf;
            const float* gf = F.in[I_GFINAL] + 32 * jf;
            float* yrow = dry ? (float*)(F.ws + WS_MIX) + (size_t)(tok & 8191) * DM + 32 * jf : F.out + O_Y + (size_t)tok * DM + 32 * jf;
            float xs[64]; float ss = 0.f;
#pragma unroll
            for (int i = 0; i < 2; ++i) {
#pragma unroll
                for (int hh_ = 0; hh_ < 2; ++hh_) { f32x4 xv[4], gv[4];
#pragma unroll
                    for (int q = 0; q < 4; ++q) { xv[q] = *(const f32x4*)(xrow + 512 * i + 16 * hh_ + 4 * q); gv[q] = *(const f32x4*)(ga2 + 512 * i + 16 * hh_ + 4 * q); }
#pragma unroll
                    for (int q = 0; q < 4; ++q)
#pragma unroll
                        for (int k = 0; k < 4; ++k) { const int ci = 32 * i + 16 * hh_ + 4 * q + k; const float t = xv[q][k] + gv[q][k] * ((float)(acc[ci] - sumq8) * cscale); xs[ci] = t; ss += t * t; }
                    asm volatile("" ::: "memory"); } }
            const float rstd = 1.f / sqrtf(rowsum16f(ss) * (1.f / DM) + EPS);
#pragma unroll
            for (int i = 0; i < 2; ++i) {
#pragma unroll
                for (int hh_ = 0; hh_ < 2; ++hh_) { f32x4 gfv[4];
#pragma unroll
                    for (int q = 0; q < 4; ++q) gfv[q] = *(const f32x4*)(gf + 512 * i + 16 * hh_ + 4 * q);
#pragma unroll
                    for (int q = 0; q < 4; ++q) { f32x4 o;
#pragma unroll
                        for (int k = 0; k < 4; ++k) o[k] = xs[32 * i + 16 * hh_ + 4 * q + k] * rstd * gfv[q][k];
                        *(f32x4*)(yrow + 512 * i + 16 * hh_ + 4 * q) = o; }
                    asm volatile("" ::: "memory"); } }
        }
    }
}

__global__ void __launch_bounds__(NWAVES * 64, 2) mk_fwd(Args args) {
    extern __shared__ __attribute__((aligned(16))) unsigned char lds[];
    Frame F;
    F.lds = lds;
    F.tid = threadIdx.x; F.lane = F.tid & 63; F.wave = __builtin_amdgcn_readfirstlane(F.tid >> 6);
    F.G = gridDim.x; { const int bx = blockIdx.x; F.vcu = (F.G % 8 == 0) ? (bx % 8) * (F.G / 8) + bx / 8 : bx; }
    F.in = args.in; F.out = args.out; F.ws = args.ws;
    LAS unsigned char* lds3 = (LAS unsigned char*)lds;
    volatile LAS unsigned* MISC = (volatile LAS unsigned*)(lds3 + MISC_OFF);
    for (int u = F.tid; u < (LDS_BYTES - LDSCTL_OFF) / 4; u += NWAVES * 64) ((LAS unsigned*)(lds3 + LDSCTL_OFF))[u] = 0u;
    __syncthreads();
    unsigned* ctl = (unsigned*)(args.ws + WS_CTL);
    XcdBarrier bar; bar.bar = ctl + CW_BAR; bar.x = 0; bar.st = nullptr;
    const bool one_launch = (args.ph_hi - args.ph_lo) > 1;
    if (one_launch) bar = xcd_barrier_post(ctl + CW_BAR, MISC + 8);
    const int lo = args.ph_lo, hi = args.ph_hi;
#ifndef MK_PHASE_MASK
#define MK_PHASE_MASK 0xff
#endif
#define IN(k) (((MK_PHASE_MASK >> (k)) & 1) && lo <= (k) && (k) < hi)
#define SEAM(k) do { if (IN(k) && IN((k) + 1)) xcd_barrier(bar); } while (0)

#define DUPQ(k) (MK_DUP == (k))
    if (IN(0)) { if (DUPQ(0)) { p0_phase(F); xcd_barrier(bar); } p0_phase(F); SEAM(0); }
    if (IN(1)) { if (DUPQ(1)) { norm_phase(F, 0); xcd_barrier(bar); } norm_phase(F, 0); bias_items(F); SEAM(1); }
    if (IN(2)) {
        pg8::Gemm g{(const pg8::bf16_t*)(F.ws + WS_H), (const pg8::bf16_t*)(F.ws + WS_WIN), NTOK, D_IN, DM}; pg8::StaticOrder S; S.init(NTOK, D_IN, F.G, (int)blockIdx.x);
        EpiInProj E{(bf16*)(F.ws + WS_Q), (bf16*)(F.ws + WS_K), (bf16*)(F.ws + WS_VT), (bf16*)(F.ws + WS_XR), (bf16*)(F.ws + WS_YG), F.out + O_NEWK, F.out + O_NEWV, (const f32x4*)(F.ws + WS_ROPE)};
        if (DUPQ(2)) { pg8::gemm_phase<EpiInProj, pg8::StaticOrder, true, true>(lds3, g, S, E); xcd_barrier(bar); }
        pg8::gemm_phase<EpiInProj, pg8::StaticOrder, true, true>(lds3, g, S, E);
        SEAM(2);
    }
    if (IN(3)) { if (DUPQ(3)) { p3_phase(F, MK_P3_TYPES); xcd_barrier(bar); } p3_phase(F); SEAM(3); }
    if (IN(4)) {
        pg8::Gemm g{(const pg8::bf16_t*)(F.ws + WS_MIX), (const pg8::bf16_t*)(F.ws + WS_WOUT), NTOK, DM, DM}; pg8::StaticOrder S; S.init(NTOK, DM, F.G, (int)blockIdx.x);
        EpiOutProj E{F.in[I_XP], F.in[I_XS], (const float*)(F.ws + WS_MODS), F.in[I_GFFN], F.out + O_Y, (bf16*)(F.ws + WS_H), (float*)(F.ws + WS_SSP)};
        if (DUPQ(4)) { pg8::gemm_phase<EpiOutProj, pg8::StaticOrder, true, true>(lds3, g, S, E); xcd_barrier(bar); }
        pg8::gemm_phase<EpiOutProj, pg8::StaticOrder, true, true>(lds3, g, S, E);
        SEAM(4);
    }
    if (IN(6)) {
        pg8::Gemm g{(const pg8::bf16_t*)(F.ws + WS_H), (const pg8::bf16_t*)(F.ws + WS_WC), NTOK, 2048, DM}; pg8::StaticOrder S; S.init(NTOK, 2048, F.G, (int)blockIdx.x);
        EpiScores E{(bf16*)(F.ws + WS_SC), (const float*)(F.ws + WS_SSP), (const float*)(F.ws + WS_BIAS)};
        if (DUPQ(6)) { pg8::gemm_phase<EpiScores, pg8::StaticOrder, true, true>(lds3, g, S, E); xcd_barrier(bar); }
        pg8::gemm_phase<EpiScores, pg8::StaticOrder, true, true>(lds3, g, S, E);
        SEAM(6);
    }
    if (IN(7)) { if (DUPQ(7)) { p7_phase(F, true); xcd_barrier(bar); } p7_phase(F, false); }
#undef IN
#undef SEAM
}

extern "C" void kernel_launch(void* const* d_in, const int* in_sizes, int n_in, void* d_out, int out_size, void* d_ws, size_t ws_size, hipStream_t stream) {
    static int grid = 0;
    if (grid == 0) {
        if (n_in != 26 || ws_size < WS_END) { fprintf(stderr, "kernel_launch: unexpected n_in %d / ws %zu\n", n_in, ws_size); grid = -1; return; }
        int dev = 0, cus = 0, per_cu = 0;
        if (hipGetDevice(&dev) != hipSuccess || hipDeviceGetAttribute(&cus, hipDeviceAttributeMultiprocessorCount, dev) != hipSuccess) { grid = -1; return; }
        if (hipFuncSetAttribute((const void*)mk_fwd, hipFuncAttributeMaxDynamicSharedMemorySize, LDS_BYTES) != hipSuccess) { fprintf(stderr, "kernel_launch: hipFuncSetAttribute failed\n"); grid = -1; return; }
        if (hipOccupancyMaxActiveBlocksPerMultiprocessor(&per_cu, (const void*)mk_fwd, NWAVES * 64, LDS_BYTES) != hipSuccess || per_cu < 1)
            fprintf(stderr, "kernel_launch: occupancy query reports %d blocks per CU\n", per_cu);
        (void)hipGetLastError();
        grid = cus;
        if (grid != 256) fprintf(stderr, "kernel_launch: note: %d CUs\n", grid);
    }
    if (grid < 0) return;
    (void)hipMemsetAsync((char*)d_ws + WS_CTL, 0, CTL_ZERO_BYTES, stream);
    Args a{};
    for (int i = 0; i < 26; ++i) a.in[i] = (const float*)d_in[i];
    a.out = (float*)d_out; a.ws = (unsigned char*)d_ws;
    if (MK_N_LAUNCHES == 1) {
        a.ph_lo = 0; a.ph_hi = N_PHASES; a.li = 0;
        hipLaunchKernelGGL(mk_fwd, dim3(grid), dim3(NWAVES * 64), LDS_BYTES, stream, a);
    } else {
        for (int li = 0; li < N_PHASES; ++li) { a.ph_lo = li; a.ph_hi = li + 1; a.li = li;
            hipLaunchKernelGGL(mk_fwd, dim3(grid), dim3(NWAVES * 64), LDS_BYTES, stream, a); }
    }
}
```

```cpp
#include <hip/hip_runtime.h>
#include <cstdio>
#include <cstdint>

#ifndef MK_DUP
#define MK_DUP -1
#endif
#ifndef MK_DRY_SKIP
#define MK_DRY_SKIP 0
#endif
#ifndef MK_N_LAUNCHES
#define MK_N_LAUNCHES 1
#endif

namespace pg8 {
#define PG8_LAS __attribute__((address_space(3)))
typedef unsigned short bf16_t;
typedef short bf16x8 __attribute__((ext_vector_type(8)));
typedef float f32x4 __attribute__((ext_vector_type(4)));
typedef unsigned u32x4 __attribute__((ext_vector_type(4)));
typedef unsigned u32x2 __attribute__((ext_vector_type(2)));
constexpr int BM = 256, BK = 64, HALF = 128, HTB = HALF * BK * 2, STAGE_BYTES = 8 * HTB, NXCD = 8, WGM = 8;

__host__ __device__ __forceinline__ int lds_byte(int r, int c) { const int st = (r >> 4) * 2 + (c >> 5), rr = r & 15, cc = c & 31, ob = rr * 64 + cc * 2; return st * 1024 + (ob ^ (((ob >> 9) & 1) << 5)); }
__host__ __device__ __forceinline__ void stage_rc(int b, int& R, int& C) { const int st = b / 1024, sb = b % 1024, swz = sb ^ (((sb >> 9) & 1) << 5); R = (st >> 1) * 16 + swz / 64; C = (st & 1) * 32 + (swz % 64) / 2; }
__host__ __device__ __forceinline__ int perm32(int rho) { const int n = rho >> 4, i = rho & 15; return 8 * (i >> 2) + 4 * n + (i & 3); }

struct Unit { int pm, pn; };
struct Gemm { const bf16_t* A; const bf16_t* Bt; int M, N, K; };

struct StaticOrder {
    int nM, nN, nwg, G, c;
    __host__ __device__ void init(int M, int N, int G_, int c_) { nM = M / BM; nN = N / BM; nwg = nM * nN; G = G_; c = c_; }
    __host__ __device__ bool next(int i, Unit& u) const {
        const long L = (long)i * G + c; if (L >= nwg) return false;
        int wgid = (int)L; { const int q = nwg / NXCD, r = nwg % NXCD, xcd = wgid % NXCD, off = wgid / NXCD; wgid = (xcd < r ? xcd * (q + 1) : r * (q + 1) + (xcd - r) * q) + off; }
        const int nig = WGM * nN, gid = wgid / nig, fm = gid * WGM, gsz = (nM - fm) < WGM ? (nM - fm) : WGM;
        u.pm = fm + ((wgid % nig) % gsz); u.pn = (wgid % nig) / gsz; return true;
    }
    __device__ __forceinline__ void a_ready(const Unit&) const {}
    __device__ __forceinline__ void done(const Unit&) const {}
};

__device__ __forceinline__ unsigned cvt_pk_bf16(float lo, float hi) { unsigned r; asm volatile("v_cvt_pk_bf16_f32 %0, %1, %2" : "=v"(r) : "v"(lo), "v"(hi)); return r; }

template <class Epi, class Sched, bool ALIGN_EPI = false, bool SP2 = false>
__device__ __forceinline__ void gemm_phase(PG8_LAS unsigned char* lds, const Gemm g, const Sched& S, const Epi& E) {
    const int tid = threadIdx.x, wid = __builtin_amdgcn_readfirstlane(tid >> 6), lane = tid & 63, wr = wid >> 2, wc = wid & 3, fr = lane & 15, fq = lane >> 4;
    const int K = g.K, nt = K / BK;
    unsigned voffA[2], voffB[2];
#pragma unroll
    for (int i = 0; i < 2; ++i) { int R, C; stage_rc(tid * 16 + i * 8192, R, C); const int Rb = Epi::PERM ? ((R & ~31) + perm32(R & 31)) : R;
        voffA[i] = (unsigned)(R * K + C) * 2u; voffB[i] = (unsigned)(Rb * K + C) * 2u; }
    const size_t kstep = (size_t)(BK * 2);
    const size_t hstep = (size_t)HALF * K * 2;
    const size_t tstep = 2 * hstep;
    const unsigned ldsw = (unsigned)wid * 1024u;
    const int aoff = lds_byte(wr * 64 + fr, fq * 8), boff = lds_byte(wc * 32 + fr, fq * 8);
#define PG8_SA(b, h) (((b) * 2 + (h)) * HTB)
#define PG8_SB(b, h) ((4 + (b) * 2 + (h)) * HTB)
#define PG8_STAGE(bufoff, gbase, voff) do { _Pragma("unroll") for (int _i = 0; _i < 2; ++_i) \
        __builtin_amdgcn_global_load_lds((const unsigned*)((const char*)(gbase) + (voff)[_i]), (PG8_LAS unsigned*)(lds + (bufoff) + ldsw + _i * 8192), 16, 0, 0); } while (0)
#define PG8_LDA(dst, b, h) do { _Pragma("unroll") for (int m = 0; m < 4; ++m) _Pragma("unroll") for (int k = 0; k < 2; ++k) dst[m][k] = *(const PG8_LAS bf16x8*)(lds + PG8_SA(b, h) + aoff + m * 2048 + k * 1024); } while (0)
#define PG8_LDB(dst, b, h) do { _Pragma("unroll") for (int n = 0; n < 2; ++n) _Pragma("unroll") for (int k = 0; k < 2; ++k) dst[n][k] = *(const PG8_LAS bf16x8*)(lds + PG8_SB(b, h) + boff + n * 2048 + k * 1024); } while (0)
#define PG8_MMA(ai, bj, At, Bt) do { __builtin_amdgcn_s_setprio(1); _Pragma("unroll") for (int m = 0; m < 4; ++m) _Pragma("unroll") for (int n = 0; n < 2; ++n) _Pragma("unroll") for (int k = 0; k < 2; ++k) \
        acc[ai][bj][m][n] = __builtin_amdgcn_mfma_f32_16x16x32_bf16(Bt[n][k], At[m][k], acc[ai][bj][m][n], 0, 0, 0); __builtin_amdgcn_s_setprio(0); } while (0)
#define PG8_WAIT_V(n) asm volatile("s_waitcnt vmcnt(" #n ")" ::: "memory")
#define PG8_WAIT_L(n) asm volatile("s_waitcnt lgkmcnt(" #n ")" ::: "memory")
#define PG8_BAR __builtin_amdgcn_s_barrier()
#define PG8_SCHED __builtin_amdgcn_sched_barrier(0)
    Unit cur, nxt; int ui = 0;
    if (!S.next(0, cur)) return;
    f32x4 acc[2][2][4][2];
#pragma unroll
    for (int a = 0; a < 2; ++a)
#pragma unroll
        for (int b = 0; b < 2; ++b)
#pragma unroll
            for (int m = 0; m < 4; ++m)
#pragma unroll
                for (int n = 0; n < 2; ++n) acc[a][b][m][n] = (f32x4){0.f, 0.f, 0.f, 0.f};
    bf16x8 At[4][2], B0[2][2], B1[2][2];
    const char* cA = (const char*)g.A + (size_t)cur.pm * tstep; const char* cB = (const char*)g.Bt + (size_t)cur.pn * tstep;
    S.a_ready(cur);
    if constexpr (SP2) {
        PG8_STAGE(PG8_SB(0, 0), cB, voffB); PG8_STAGE(PG8_SB(0, 1), cB + hstep, voffB); PG8_STAGE(PG8_SA(0, 0), cA, voffA); PG8_STAGE(PG8_SA(0, 1), cA + hstep, voffA);
        if (wr == 1) PG8_BAR;
        PG8_WAIT_V(2); PG8_BAR;
        PG8_STAGE(PG8_SB(1, 0), cB + kstep, voffB); PG8_STAGE(PG8_SA(1, 0), cA + kstep, voffA); PG8_STAGE(PG8_SB(1, 1), cB + hstep + kstep, voffB);
        PG8_WAIT_V(6); PG8_BAR;
    } else {
        PG8_STAGE(PG8_SB(0, 0), cB, voffB); PG8_STAGE(PG8_SA(0, 0), cA, voffA); PG8_STAGE(PG8_SB(0, 1), cB + hstep, voffB); PG8_STAGE(PG8_SA(0, 1), cA + hstep, voffA);
        if (wr == 1) PG8_BAR;
        PG8_WAIT_V(4); PG8_BAR;
        PG8_STAGE(PG8_SB(1, 0), cB + kstep, voffB); PG8_STAGE(PG8_SA(1, 0), cA + kstep, voffA); PG8_STAGE(PG8_SB(1, 1), cB + hstep + kstep, voffB);
        PG8_WAIT_V(6); PG8_BAR;
    }
    for (;;) {
        const bool has_next = S.next(ui + 1, nxt);
        const char* nA = has_next ? (const char*)g.A + (size_t)nxt.pm * tstep : cA; const char* nB = has_next ? (const char*)g.Bt + (size_t)nxt.pn * tstep : cB;
        for (int t = 0; t < nt; t += 2) {
            const bool last = (t == nt - 2);
            const char* a1 = cA + (size_t)(t + 1) * kstep;
            const char* a2 = last ? nA : cA + (size_t)(t + 2) * kstep; const char* b2 = last ? nB : cB + (size_t)(t + 2) * kstep;
            const char* a3 = a2 + kstep; const char* b3 = b2 + kstep;
            if (last && has_next) S.a_ready(nxt);
            if constexpr (SP2) {
            PG8_LDB(B0, 0, 0); PG8_LDB(B1, 0, 1); PG8_SCHED; PG8_LDA(At, 0, 0); PG8_STAGE(PG8_SA(1, 1), a1 + hstep, voffA);
            PG8_WAIT_V(8); PG8_WAIT_L(0); PG8_BAR; PG8_MMA(0, 0, At, B0); PG8_MMA(0, 1, At, B1); PG8_BAR; PG8_SCHED;
            PG8_LDA(At, 0, 1); PG8_STAGE(PG8_SB(0, 0), b2, voffB); PG8_STAGE(PG8_SB(0, 1), b2 + hstep, voffB); PG8_STAGE(PG8_SA(0, 0), a2, voffA);
            PG8_WAIT_V(8); PG8_WAIT_L(0); PG8_BAR; PG8_MMA(1, 0, At, B0); PG8_MMA(1, 1, At, B1); PG8_BAR; PG8_SCHED;
            PG8_LDB(B0, 1, 0); PG8_LDB(B1, 1, 1); PG8_SCHED; PG8_LDA(At, 1, 0); PG8_STAGE(PG8_SA(0, 1), a2 + hstep, voffA);
            PG8_WAIT_V(8); PG8_WAIT_L(0); PG8_BAR; PG8_MMA(0, 0, At, B0); PG8_MMA(0, 1, At, B1); PG8_BAR; PG8_SCHED;
            PG8_LDA(At, 1, 1); PG8_STAGE(PG8_SB(1, 0), b3, voffB); PG8_STAGE(PG8_SB(1, 1), b3 + hstep, voffB); PG8_STAGE(PG8_SA(1, 0), a3, voffA);
            PG8_WAIT_V(8); PG8_WAIT_L(0); PG8_BAR; PG8_MMA(1, 0, At, B0); PG8_MMA(1, 1, At, B1); PG8_BAR; PG8_SCHED;
            } else {
            PG8_LDB(B0, 0, 0); PG8_SCHED; PG8_LDA(At, 0, 0); PG8_STAGE(PG8_SA(1, 1), a1 + hstep, voffA);
            PG8_WAIT_L(8); PG8_BAR; PG8_WAIT_L(0); PG8_MMA(0, 0, At, B0); PG8_BAR; PG8_SCHED;
            PG8_LDB(B1, 0, 1); PG8_STAGE(PG8_SB(0, 0), b2, voffB);
            PG8_BAR; PG8_WAIT_L(0); PG8_MMA(0, 1, At, B1); PG8_BAR;
            PG8_LDA(At, 0, 1); PG8_STAGE(PG8_SA(0, 0), a2, voffA);
            PG8_BAR; PG8_WAIT_L(0); PG8_MMA(1, 0, At, B0); PG8_BAR; PG8_SCHED;
            PG8_STAGE(PG8_SB(0, 1), b2 + hstep, voffB);
            PG8_WAIT_V(6); PG8_BAR; PG8_MMA(1, 1, At, B1); PG8_BAR;
            PG8_LDB(B0, 1, 0); PG8_SCHED; PG8_LDA(At, 1, 0); PG8_STAGE(PG8_SA(0, 1), a2 + hstep, voffA);
            PG8_WAIT_L(8); PG8_BAR; PG8_WAIT_L(0); PG8_MMA(0, 0, At, B0); PG8_BAR; PG8_SCHED;
            PG8_LDB(B1, 1, 1); PG8_STAGE(PG8_SB(1, 0), b3, voffB);
            PG8_BAR; PG8_WAIT_L(0); PG8_MMA(0, 1, At, B1); PG8_BAR;
            PG8_LDA(At, 1, 1); PG8_STAGE(PG8_SA(1, 0), a3, voffA);
            PG8_BAR; PG8_WAIT_L(0); PG8_MMA(1, 0, At, B0); PG8_BAR; PG8_SCHED;
            PG8_STAGE(PG8_SB(1, 1), b3 + hstep, voffB);
            PG8_WAIT_V(6); PG8_BAR; PG8_MMA(1, 1, At, B1); PG8_BAR;
            }
        }
        if constexpr (ALIGN_EPI) { if (wr == 0) PG8_BAR; }
        E(acc, cur, wr, wc, fr, fq); S.done(cur);
        if (!has_next) break;
#pragma unroll
        for (int a = 0; a < 2; ++a)
#pragma unroll
            for (int b = 0; b < 2; ++b)
#pragma unroll
                for (int m = 0; m < 4; ++m)
#pragma unroll
                    for (int n = 0; n < 2; ++n) acc[a][b][m][n] = (f32x4){0.f, 0.f, 0.f, 0.f};
        cur = nxt; cA = nA; cB = nB; ++ui;
        if constexpr (ALIGN_EPI) { if (wr == 1) PG8_BAR; }
    }
    PG8_WAIT_V(0);
    if constexpr (!ALIGN_EPI) { if (wr == 0) PG8_BAR; }
    PG8_BAR;
#undef PG8_SA
#undef PG8_SB
#undef PG8_STAGE
#undef PG8_LDA
#undef PG8_LDB
#undef PG8_MMA
#undef PG8_WAIT_V
#undef PG8_WAIT_L
#undef PG8_BAR
#undef PG8_SCHED
}
}

constexpr int NWAVES = 8;
constexpr int DM = 1024, NTOK = 16384, NCTX = 8192, D_IN = 1792, NMODV = 9, MODW = 6144;
constexpr int SEQ_C = 256, SEQ_L = 1024, NSEQ_C = 32, NSEQ_L = 8;
constexpr int N_PHASES = 8;
constexpr float LOG2E = 1.4426950408889634f;
constexpr float QSCALE = 0.125f * LOG2E;
constexpr float EPS = 1e-6f;

constexpr size_t MiB = 1u << 20, KiB = 1u << 10;
constexpr size_t WS_CTL = 0, CTL_ZERO_BYTES = 64 * KiB;
constexpr size_t WS_MODS = 1 * MiB;
constexpr size_t WS_ROPE = 1 * MiB + 256 * KiB;
constexpr size_t WS_RGW  = 1 * MiB + 512 * KiB;
constexpr size_t WS_CK   = 1 * MiB + 768 * KiB;
constexpr size_t WS_CVT  = 2 * MiB + 256 * KiB;
constexpr size_t WS_WIN  = 3 * MiB;
constexpr size_t WS_WOUT = 7 * MiB;
constexpr size_t WS_WC   = 9 * MiB;
constexpr size_t WS_U    = 16 * MiB;
constexpr size_t WS_SSP  = 14 * MiB;
constexpr size_t WS_BIAS = 15 * MiB;
constexpr size_t WS_SU   = 13 * MiB;
constexpr size_t WS_SV   = 13 * MiB + 64 * KiB;
constexpr size_t WS_V    = 48 * MiB;
constexpr size_t WS_H    = 80 * MiB;
constexpr size_t WS_MIX  = 112 * MiB;
constexpr size_t WS_Q    = 144 * MiB;
constexpr size_t WS_K    = 160 * MiB;
constexpr size_t WS_VT   = 164 * MiB;
constexpr size_t WS_XR   = 168 * MiB;
constexpr size_t WS_YG   = 184 * MiB;
constexpr size_t WS_HF   = 200 * MiB;
constexpr size_t WS_SC   = 144 * MiB;
constexpr size_t WS_END  = 232 * MiB;
constexpr int VT_LAT_OFF = NSEQ_C * 2 * 64 * SEQ_C;

constexpr int CW_BAR = 4096;

constexpr int RING_BYTES = 131072;
constexpr int LDSCTL_OFF = 146944, MISC_OFF = LDSCTL_OFF + 320;
constexpr int LDS_BYTES = 147456;

#define GAS __attribute__((address_space(1)))
#define LAS __attribute__((address_space(3)))
typedef unsigned short bf16;
typedef unsigned v4u __attribute__((ext_vector_type(4)));
typedef unsigned v2u __attribute__((ext_vector_type(2)));
typedef float f32x4 __attribute__((ext_vector_type(4)));
typedef float f32x2 __attribute__((ext_vector_type(2)));
typedef float f32x16 __attribute__((ext_vector_type(16)));
typedef short bf16x8 __attribute__((ext_vector_type(8)));
typedef GAS unsigned gu32;
#define RLX_AGENT __ATOMIC_RELAXED, __HIP_MEMORY_SCOPE_AGENT

__device__ __forceinline__ unsigned f2bf(float f) { unsigned u = __builtin_bit_cast(unsigned, f); return (u + 0x7fffu + ((u >> 16) & 1u)) >> 16; }
typedef float f32x2_t_ __attribute__((ext_vector_type(2))); typedef __bf16 bf16x2_t_ __attribute__((ext_vector_type(2)));
__device__ __forceinline__ unsigned pk2(float lo, float hi) { f32x2_t_ v = {lo, hi}; bf16x2_t_ b = __builtin_convertvector(v, bf16x2_t_); return __builtin_bit_cast(unsigned, b); }
__device__ __forceinline__ float bf2f(unsigned b) { return __builtin_bit_cast(float, b << 16); }
__device__ __forceinline__ float bflo(unsigned w) { return __builtin_bit_cast(float, w << 16); }
__device__ __forceinline__ float bfhi(unsigned w) { return __builtin_bit_cast(float, w & 0xffff0000u); }
__device__ __forceinline__ float sigmoidf_(float x) { return 1.f / (1.f + __expf(-x)); }
__device__ __forceinline__ float gelu_tanh(float x) { const float y = 0.7978845608028654f * (x + 0.044715f * x * x * x); const float e = __expf(2.f * y); return 0.5f * x * (2.f - 2.f / (1.f + e)); }
template <int CTRL> __device__ __forceinline__ float dppf_(float v) { return __builtin_bit_cast(float, __builtin_amdgcn_update_dpp(0, __builtin_bit_cast(int, v), CTRL, 0xf, 0xf, true)); }
__device__ __forceinline__ float xrow16_(float v) {
    unsigned a = __builtin_bit_cast(unsigned, v), b = a; asm volatile("" : "+v"(b));
    const auto r = __builtin_amdgcn_permlane16_swap(a, b, false, false);
    const bool odd = (threadIdx.x & 16) != 0; return __builtin_bit_cast(float, odd ? r[0] : r[1]);
}
__device__ __forceinline__ float xhalf32_(float v) {
    unsigned a = __builtin_bit_cast(unsigned, v), b = a; asm volatile("" : "+v"(b));
    const auto r = __builtin_amdgcn_permlane32_swap(a, b, false, false);
    const bool hi = (threadIdx.x & 32) != 0; return __builtin_bit_cast(float, hi ? r[0] : r[1]);
}
__device__ __forceinline__ float wave_sum(float v) {
    v += dppf_<0xB1>(v); v += dppf_<0x4E>(v); v += dppf_<0x141>(v); v += dppf_<0x140>(v);
    v += xrow16_(v); v += xhalf32_(v); return v;
}
__device__ __forceinline__ float wave_max(float v) {
    v = fmaxf(v, dppf_<0xB1>(v)); v = fmaxf(v, dppf_<0x4E>(v)); v = fmaxf(v, dppf_<0x141>(v)); v = fmaxf(v, dppf_<0x140>(v));
    v = fmaxf(v, xrow16_(v)); v = fmaxf(v, xhalf32_(v)); return v;
}
__device__ __forceinline__ int crow(int r, int hi) { return (r & 3) + 8 * (r >> 2) + 4 * hi; }

#define XB_TMO      128
#define XB_XCNT(j)  (256  + 64 * (j))
#define XB_XSUB(j)  (1280 + 64 * (j))
#define XB_XGEN(j)  (2304 + 64 * (j))
#define XB_TOP      3328
#define XB_TOPGEN   3392
#define XCD_BAR_WORDS 3456
#define XB_SPIN_CAP (1u << 18)
__device__ __forceinline__ unsigned xb_ld(unsigned* p)              { return __hip_atomic_load(p, __ATOMIC_RELAXED, __HIP_MEMORY_SCOPE_AGENT); }
__device__ __forceinline__ unsigned xb_add(unsigned* p, unsigned v) { return __hip_atomic_fetch_add(p, v, __ATOMIC_RELAXED, __HIP_MEMORY_SCOPE_AGENT); }
__device__ __forceinline__ unsigned xb_xcc_id() { return (unsigned)__builtin_amdgcn_s_getreg((3 << 11) | 20) & 0xFu; }
#define XB_SPIN(cond, bar) do { unsigned _sp = 0; while (cond) { __builtin_amdgcn_s_sleep(1); \
    if ((++_sp & 255u) == 0u) { if (xb_ld(&(bar)[XB_TMO])) break; if (_sp > XB_SPIN_CAP) { atomicAdd(&(bar)[XB_TMO], 1u); break; } } } } while (0)
struct XcdBarrier { unsigned* bar; unsigned x; volatile LAS unsigned* st; };
__device__ __forceinline__ XcdBarrier xcd_barrier_post(unsigned* bar, volatile LAS unsigned* st) {
    XcdBarrier b; b.bar = bar; b.x = xb_xcc_id(); b.st = st;
    if (threadIdx.x == 0) (void)xb_add(&bar[XB_XCNT(b.x)], 1u);
    return b;
}
__device__ __forceinline__ void xcd_barrier_complete(unsigned* bar, unsigned x, unsigned& nloc, unsigned& nx) {
    const unsigned G = gridDim.x * gridDim.y * gridDim.z;
    unsigned sum, cnt, mine, sp = 0u;
    for (;;) {
        sum = 0u; cnt = 0u; mine = 0u;
#pragma unroll
        for (unsigned j = 0; j < 16; ++j) { const unsigned c = xb_ld(&bar[XB_XCNT(j)]); sum += c; cnt += (c > 0u) ? 1u : 0u; mine = (j == x) ? c : mine; }
        if (sum == G) break;
        __builtin_amdgcn_s_sleep(1);
        if ((++sp & 255u) == 0u) { if (xb_ld(&bar[XB_TMO])) break; if (sp > XB_SPIN_CAP) { atomicAdd(&bar[XB_TMO], 1u); break; } }
    }
    nloc = mine > 0u ? mine : 1u; nx = cnt > 0u ? cnt : 1u;
}
__device__ __forceinline__ void xcd_barrier(const XcdBarrier& b) {
    asm volatile("s_waitcnt vmcnt(0)" ::: "memory");
    __syncthreads();
    if (threadIdx.x == 0) {
        unsigned* bar = b.bar;
        __builtin_amdgcn_s_waitcnt(0);
        unsigned nloc = b.st[0], nx = b.st[1];
        if (nloc == 0u) { xcd_barrier_complete(bar, b.x, nloc, nx); b.st[0] = nloc; b.st[1] = nx; }
        const unsigned old = xb_add(&bar[XB_XSUB(b.x)], 1u);
        const unsigned gen = old / nloc;
        if (old + 1u == (gen + 1u) * nloc) {
            __builtin_amdgcn_fence(__ATOMIC_RELEASE, "agent");
            asm volatile("s_waitcnt vmcnt(0)" ::: "memory");
            const unsigned og = xb_add(&bar[XB_TOP], 1u);
            const unsigned tg = og / nx;
            if (og + 1u == (tg + 1u) * nx) xb_add(&bar[XB_TOPGEN], 1u);
            else XB_SPIN(xb_ld(&bar[XB_TOPGEN]) == tg, bar);
            __builtin_amdgcn_fence(__ATOMIC_ACQUIRE, "agent");
            xb_add(&bar[XB_XGEN(b.x)], 1u);
            asm volatile("s_waitcnt vmcnt(0)" ::: "memory");
        } else {
            XB_SPIN(xb_ld(&bar[XB_XGEN(b.x)]) == gen, bar);
            __builtin_amdgcn_fence(__ATOMIC_ACQUIRE, "agent");
            asm volatile("s_waitcnt vmcnt(0)" ::: "memory");
        }
    }
    __syncthreads();
}

struct Args { const float* in[26]; float* out; unsigned char* ws; int ph_lo, ph_hi, li, pad; };

struct Frame {
    unsigned char* lds;
    int tid, lane, wave, vcu, G;
    const float* const* in;
    float* out; unsigned char* ws;
};
enum { I_XP = 0, I_XS, I_CK, I_CV, I_SRNN, I_C, I_CCTX, I_WMOD, I_BMOD, I_GMIX, I_GFFN, I_WIN, I_CONVW, I_CONVB, I_RGWA, I_RGBA, I_RGWI, I_RGBI, I_RGLAM, I_SINK, I_WOUT, I_PWQ, I_PSK, I_PU, I_PV, I_GFINAL };
constexpr size_t O_Y = 0, O_NEWK = (size_t)NTOK * DM, O_NEWV = O_NEWK + (size_t)NCTX * 128, O_NEWRNN = O_NEWV + (size_t)NCTX * 128;

__device__ __forceinline__ int mod_index(int tok) { return tok < NCTX ? 0 : 1 + ((tok - NCTX) >> 10); }
__device__ __forceinline__ const float* x_row(const Frame& F, int tok) { return tok < NCTX ? F.in[I_XP] + (size_t)tok * DM : F.in[I_XS] + (size_t)(tok - NCTX) * DM; }

template <class RowMap>
__device__ __forceinline__ void p0_transpose_item(const float* W, int K, int N, bf16* WT, float* scr, int item, int lane, RowMap rowmap, float scale = 1.f) {
    const int nblk = N / 32, kb = item / nblk, nb = item % nblk, k0 = 64 * kb, n0 = 32 * nb;
#pragma unroll 8
    for (int i = 0; i < 32; ++i) { const int kk = 2 * i + (lane >> 5); scr[kk * 33 + (lane & 31)] = W[(size_t)(k0 + kk) * N + n0 + (lane & 31)]; }
    __builtin_amdgcn_s_waitcnt(0xC07F); asm volatile("" ::: "memory");
    const int c = lane & 7;
#pragma unroll
    for (int j = 0; j < 4; ++j) { const int n = (lane >> 3) + 8 * j; const float* s = scr + (8 * c) * 33 + n;
        v4u o; o.x = pk2(s[0 * 33] * scale, s[1 * 33] * scale); o.y = pk2(s[2 * 33] * scale, s[3 * 33] * scale); o.z = pk2(s[4 * 33] * scale, s[5 * 33] * scale); o.w = pk2(s[6 * 33] * scale, s[7 * 33] * scale);
        *(v4u*)(WT + (size_t)rowmap(n0 + n) * K + k0 + 8 * c) = o; }
    __builtin_amdgcn_s_waitcnt(0xC07F); asm volatile("" ::: "memory");
}
struct MapId { __device__ __forceinline__ int operator()(int n) const { return n; } };
struct MapWin { __device__ __forceinline__ int operator()(int n) const { if (n >= 640) return n; const int hb = n & ~63, o = n & 63; return hb + ((o & 31) << 1) + (o >> 5); } };

__device__ __forceinline__ void p0_phase(Frame& F) {
    float* ldsf = (float*)F.lds;
    const int tid = F.tid, lane = F.lane, wave = F.wave, v = F.vcu;
    if (v < 192) {
        for (int i = tid; i < NMODV * DM; i += 512) { const int j = i >> 10, d = i & 1023; const float c = (j == 0) ? F.in[I_CCTX][d] : F.in[I_C][(j - 1) * DM + d]; ldsf[i] = c * sigmoidf_(c); }
        __syncthreads();
        const int e0 = 32 * v, c4 = tid & 7, kq = tid >> 3;
        float acc[NMODV][4];
#pragma unroll
        for (int j = 0; j < NMODV; ++j) { acc[j][0] = 0.f; acc[j][1] = 0.f; acc[j][2] = 0.f; acc[j][3] = 0.f; }
        const float* wm = F.in[I_WMOD] + e0 + 4 * c4;
#pragma unroll 4
        for (int kk = 0; kk < 16; ++kk) { const int k = kq * 16 + kk; const f32x4 w = *(const f32x4*)(wm + (size_t)k * MODW);
#pragma unroll
            for (int j = 0; j < NMODV; ++j) { const float s = ldsf[j * DM + k]; acc[j][0] += s * w[0]; acc[j][1] += s * w[1]; acc[j][2] += s * w[2]; acc[j][3] += s * w[3]; } }
#pragma unroll
        for (int j = 0; j < NMODV; ++j)
#pragma unroll
            for (int i = 0; i < 4; ++i) { float a = acc[j][i]; a += __shfl_xor(a, 8); a += __shfl_xor(a, 16); a += __shfl_xor(a, 32); acc[j][i] = a; }
        float* red = ldsf + NMODV * DM;
        if (lane < 8) {
#pragma unroll
            for (int j = 0; j < NMODV; ++j)
#pragma unroll
                for (int i = 0; i < 4; ++i) red[(wave * NMODV + j) * 32 + 4 * c4 + i] = acc[j][i];
        }
        __syncthreads();
        if (tid < NMODV * 32) { const int j = tid >> 5, col = tid & 31; float s = F.in[I_BMOD][e0 + col];
#pragma unroll
            for (int w = 0; w < 8; ++w) s += red[(w * NMODV + j) * 32 + col];
            ((float*)(F.ws + WS_MODS))[j * MODW + e0 + col] = s; }
        __syncthreads();
    }
    if (v < 256) {
        const int hh = v >> 4, dt = v & 15, d0 = 64 * dt;
        float* At = ldsf;
        float* Bkt = ldsf + 128 * 64;
        const float* wq = F.in[I_PWQ] + hh * 128;
        const float* sk = F.in[I_PSK] + (size_t)hh * 128 * 128;
#pragma unroll
        for (int i = 0; i < 4; ++i) { const int f = tid + 512 * i, d = f & 63, q4 = f >> 6; const f32x4 a = *(const f32x4*)(wq + (size_t)(d0 + d) * 2048 + 4 * q4);
            At[(4 * q4 + 0) * 64 + d] = a[0]; At[(4 * q4 + 1) * 64 + d] = a[1]; At[(4 * q4 + 2) * 64 + d] = a[2]; At[(4 * q4 + 3) * 64 + d] = a[3]; }
#pragma unroll
        for (int i = 0; i < 8; ++i) { const int f = tid + 512 * i, key = f & 127, q4 = f >> 7; const f32x4 b = *(const f32x4*)(sk + (size_t)key * 128 + 4 * q4);
            Bkt[(4 * q4 + 0) * 128 + key] = b[0]; Bkt[(4 * q4 + 1) * 128 + key] = b[1]; Bkt[(4 * q4 + 2) * 128 + key] = b[2]; Bkt[(4 * q4 + 3) * 128 + key] = b[3]; }
        __syncthreads();
        const int dg = tid & 15, kg = tid >> 4;
        float acc[4][4];
#pragma unroll
        for (int i = 0; i < 4; ++i)
#pragma unroll
            for (int j = 0; j < 4; ++j) acc[i][j] = 0.f;
#pragma unroll 4
        for (int q = 0; q < 128; ++q) { const f32x4 a = *(const f32x4*)(At + q * 64 + 4 * dg); const f32x4 b = *(const f32x4*)(Bkt + q * 128 + 4 * kg);
#pragma unroll
            for (int i = 0; i < 4; ++i)
#pragma unroll
                for (int j = 0; j < 4; ++j) acc[i][j] += a[i] * b[j]; }
        bf16* WcT = (bf16*)(F.ws + WS_WC);
#pragma unroll
        for (int j = 0; j < 4; ++j) { v2u o; o.x = pk2(acc[0][j], acc[1][j]); o.y = pk2(acc[2][j], acc[3][j]);
            *(v2u*)(WcT + (size_t)(hh * 128 + 4 * kg + j) * DM + d0 + 4 * dg) = o; }
        __syncthreads();
    }
    const int gw = v * NWAVES + wave, NGW = F.G * NWAVES;
    float* scr = ldsf + wave * 4096;
    {
        constexpr int I_IN = (DM / 64) * (D_IN / 32), I_OUT = (DM / 64) * (DM / 32), I_RG = 32 * 2;
        constexpr int NIT = I_IN + I_OUT + I_RG;
        for (int it = gw; it < NIT; it += NGW) {
            int r = it;
            if (r < I_IN) { p0_transpose_item(F.in[I_WIN], DM, D_IN, (bf16*)(F.ws + WS_WIN), scr, r, lane, MapWin()); continue; } r -= I_IN;
            if (r < I_OUT) { p0_transpose_item(F.in[I_WOUT], DM, DM, (bf16*)(F.ws + WS_WOUT), scr, r, lane, MapId()); continue; } r -= I_OUT;
            { const int mm = r >> 1, sub = r & 1, dir = mm >> 4, n = (mm >> 1) & 7, gate = mm & 1;
              const float* src = (gate ? F.in[I_RGWI] : F.in[I_RGWA]) + (size_t)(dir * 8 + n) * 4096;
              bf16* dst = (bf16*)(F.ws + WS_RGW) + (size_t)((dir * 8 + n) * 2 + gate) * 4096;
              p0_transpose_item(src, 64, 64, dst, scr, sub, lane, MapId(), -LOG2E); }
        }
    }
    for (int it0 = 4 * gw; it0 < 2 * 16384; it0 += 4 * NGW) {
        f32x4 a[4][4];
#pragma unroll
        for (int r = 0; r < 4; ++r) { const int it = it0 + r, tb = it >> 14, row = it & 16383;
            const float* src = (tb ? F.in[I_PV] : F.in[I_PU]) + (size_t)row * DM + 16 * lane;
#pragma unroll
            for (int j = 0; j < 4; ++j) a[r][j] = *(const f32x4*)(src + 4 * j); }
        float am[4];
#pragma unroll
        for (int r = 0; r < 4; ++r) { float m = 0.f;
#pragma unroll
            for (int j = 0; j < 4; ++j) m = fmaxf(m, fmaxf(fmaxf(fabsf(a[r][j][0]), fabsf(a[r][j][1])), fmaxf(fabsf(a[r][j][2]), fabsf(a[r][j][3]))));
            am[r] = m; }
#pragma unroll
        for (int r = 0; r < 4; ++r) am[r] = wave_max(am[r]);
#pragma unroll
        for (int r = 0; r < 4; ++r) { const int it = it0 + r, tb = it >> 14, row = it & 16383;
            if (tb) {
                const float inv = am[r] > 0.f ? 7.f / am[r] : 0.f;
                v2u o2;
#pragma unroll
                for (int h = 0; h < 2; ++h) { unsigned w = 0;
#pragma unroll
                    for (int c = 0; c < 8; ++c) { int q = (int)rintf(a[r][2 * h + (c >> 2)][c & 3] * inv); q = q > 7 ? 7 : (q < -7 ? -7 : q); w |= ((unsigned)(q + 8) & 0xfu) << (4 * c); }
                    o2[h] = w; }
                *(v2u*)(F.ws + WS_V + (size_t)row * (DM / 2) + 8 * lane) = o2;
                if (lane == 0) ((float*)(F.ws + WS_SV))[row] = am[r] * (1.f / 7.f);
            } else {
                const float inv = am[r] > 0.f ? 7.f / am[r] : 0.f;
                v2u o2;
#pragma unroll
                for (int h = 0; h < 2; ++h) { unsigned w = 0;
#pragma unroll
                    for (int c = 0; c < 8; ++c) { int q = (int)rintf(a[r][2 * h + (c >> 2)][c & 3] * inv); q = q > 7 ? 7 : (q < -7 ? -7 : q); w |= ((unsigned)q & 0xfu) << (4 * c); }
                    o2[h] = w; }
                *(v2u*)(F.ws + WS_U + (size_t)row * (DM / 2) + 8 * lane) = o2;
                if (lane == 0) ((float*)(F.ws + WS_SU))[row] = am[r] * (1.f / 7.f);
            } }
    }
    const int gt = v * 512 + tid, NGT = F.G * 512;
    for (int e = gt; e < 8 * 256 * 128; e += NGT) {
        const int c = e & 127, bp = e >> 7, kvh = c >> 6, p = c & 63, old = (p & 1) ? 32 + (p >> 1) : (p >> 1);
        ((bf16*)(F.ws + WS_CK))[e] = (bf16)f2bf(F.in[I_CK][(size_t)bp * 128 + kvh * 64 + old]);
    }
    for (int e = gt; e < 8 * 256 * 128; e += NGT) {
        const int pos = e & 255, d = (e >> 8) & 63, kvh = (e >> 14) & 1, b = e >> 15;
        ((bf16*)(F.ws + WS_CVT))[e] = (bf16)f2bf(F.in[I_CV][(size_t)(b * 256 + pos) * 128 + kvh * 64 + d]);
    }
    for (int e = gt; e < 1024 * 32; e += NGT) {
        const int s = e >> 5, i = e & 31, row = s >> 6, col = s & 63;
        const float inv = powf(10000.0f, -(float)(i & 15) / 16.0f);
        const float ang = (i < 16 ? (float)row : (float)col) * inv;
        f32x2 cs; cs.x = cosf(ang); cs.y = sinf(ang);
        ((f32x2*)(F.ws + WS_ROPE))[e] = cs;
    }
}

__device__ __forceinline__ void bias_items(Frame& F) {
    const int gw = F.vcu * NWAVES + F.wave, NGW = F.G * NWAVES, lane = F.lane;
    const float* mods = (const float*)(F.ws + WS_MODS); const bf16* WcT = (const bf16*)(F.ws + WS_WC); float* BIAS = (float*)(F.ws + WS_BIAS);
    for (int n = gw; n < 2048; n += NGW) {
        const v4u a = *(const v4u*)(WcT + (size_t)n * DM + 16 * lane), b = *(const v4u*)(WcT + (size_t)n * DM + 16 * lane + 8);
        float w[16];
        w[0] = bflo(a.x); w[1] = bfhi(a.x); w[2] = bflo(a.y); w[3] = bfhi(a.y); w[4] = bflo(a.z); w[5] = bfhi(a.z); w[6] = bflo(a.w); w[7] = bfhi(a.w);
        w[8] = bflo(b.x); w[9] = bfhi(b.x); w[10] = bflo(b.y); w[11] = bfhi(b.y); w[12] = bflo(b.z); w[13] = bfhi(b.z); w[14] = bflo(b.w); w[15] = bfhi(b.w);
#pragma unroll 1
        for (int j = 0; j < NMODV; ++j) { const float* sh = mods + (size_t)j * MODW + 3 * DM + 16 * lane; float d = 0.f;
#pragma unroll
            for (int q = 0; q < 4; ++q) { const f32x4 v = *(const f32x4*)(sh + 4 * q); d += v[0] * w[4 * q] + v[1] * w[4 * q + 1] + v[2] * w[4 * q + 2] + v[3] * w[4 * q + 3]; }
            d = wave_sum(d); if (lane == 0) BIAS[j * 2048 + n] = d; }
    }
}
__device__ __forceinline__ void norm_phase(Frame& F, int which) {
    const int gw = F.vcu * NWAVES + F.wave, NGW = F.G * NWAVES, lane = F.lane;
    const float* mods = (const float*)(F.ws + WS_MODS);
    const float* g = F.in[which ? I_GFFN : I_GMIX];
    bf16* H = (bf16*)(F.ws + WS_H);
    for (int tok = gw; tok < NTOK; tok += NGW) {
        const float* xr = which ? F.out + O_Y + (size_t)tok * DM : x_row(F, tok);
        const float* mv = mods + (size_t)mod_index(tok) * MODW + (which ? 3 * DM : 0);
        f32x4 v[4]; float ss = 0.f;
#pragma unroll
        for (int j = 0; j < 4; ++j) { v[j] = *(const f32x4*)(xr + 256 * j + 4 * lane); ss += (v[j][0] * v[j][0] + v[j][1] * v[j][1]) + (v[j][2] * v[j][2] + v[j][3] * v[j][3]); }
        const float rstd = 1.f / sqrtf(wave_sum(ss) * (1.f / DM) + EPS);
#pragma unroll
        for (int j = 0; j < 4; ++j) { const int e = 256 * j + 4 * lane;
            const f32x4 gg = *(const f32x4*)(g + e), sh = *(const f32x4*)(mv + e), sc = *(const f32x4*)(mv + DM + e);
            f32x4 o;
#pragma unroll
            for (int i = 0; i < 4; ++i) o[i] = v[j][i] * rstd * gg[i] * (1.f + sc[i]) + sh[i];
            v2u w; w.x = pk2(o[0], o[1]); w.y = pk2(o[2], o[3]); *(v2u*)(H + (size_t)tok * DM + e) = w; }
    }
}

struct EpiInProj {
    static constexpr bool PERM = true;
    bf16 *q, *k, *vT, *xr, *yg; float *newk, *newv; const f32x4* rope4;
    __device__ __forceinline__ void operator()(const f32x4 (&acc)[2][2][4][2], const pg8::Unit& u, int wr, int wc, int fr, int fq) const {
        const bool lat = u.pm >= 32;
        const int pn = u.pn;
#pragma unroll
        for (int ai = 0; ai < 2; ++ai)
#pragma unroll
            for (int m = 0; m < 4; ++m) {
                const int row = u.pm * 256 + ai * 128 + wr * 64 + m * 16 + fr;
                const int pos = lat ? ((row - NCTX) & 1023) : (row & 255);
#pragma unroll
                for (int bj = 0; bj < 2; ++bj) {
                    const int c = pn * 256 + bj * 128 + wc * 32 + 8 * fq;
                    f32x4 v0 = acc[ai][bj][m][0], v1 = acc[ai][bj][m][1];
                    if (pn < 2 || (pn == 2 && bj == 0)) {
                        const int i = (c & 63) >> 1;
                        if (lat) { const f32x4 cs0 = rope4[(pos * 32 + i) >> 1], cs1 = rope4[((pos * 32 + i) >> 1) + 1];
                            const float a0 = v0[0] * cs0[0] - v0[1] * cs0[1], a1 = v0[1] * cs0[0] + v0[0] * cs0[1];
                            const float b0 = v0[2] * cs0[2] - v0[3] * cs0[3], b1 = v0[3] * cs0[2] + v0[2] * cs0[3];
                            const float c0 = v1[0] * cs1[0] - v1[1] * cs1[1], c1 = v1[1] * cs1[0] + v1[0] * cs1[1];
                            const float d0 = v1[2] * cs1[2] - v1[3] * cs1[3], d1 = v1[3] * cs1[2] + v1[2] * cs1[3];
                            v0[0] = a0; v0[1] = a1; v0[2] = b0; v0[3] = b1; v1[0] = c0; v1[1] = c1; v1[2] = d0; v1[3] = d1; }
                        if (pn < 2) { v4u w; w.x = pk2(v0[0] * QSCALE, v0[1] * QSCALE); w.y = pk2(v0[2] * QSCALE, v0[3] * QSCALE); w.z = pk2(v1[0] * QSCALE, v1[1] * QSCALE); w.w = pk2(v1[2] * QSCALE, v1[3] * QSCALE);
                            *(v4u*)(q + (size_t)row * 512 + c) = w; }
                        else { const int kc = c - 512; v4u w; w.x = pk2(v0[0], v0[1]); w.y = pk2(v0[2], v0[3]); w.z = pk2(v1[0], v1[1]); w.w = pk2(v1[2], v1[3]); *(v4u*)(k + (size_t)row * 128 + kc) = w;
                            if (!lat) { float* nk = newk + (size_t)row * 128 + (kc & 64) + i; f32x4 lo; lo[0] = v0[0]; lo[1] = v0[2]; lo[2] = v1[0]; lo[3] = v1[2]; f32x4 hi; hi[0] = v0[1]; hi[1] = v0[3]; hi[2] = v1[1]; hi[3] = v1[3];
                                *(f32x4*)nk = lo; *(f32x4*)(nk + 32) = hi; } }
                    } else if (pn == 2) {
                        const int vc = c - 640, kvh = vc >> 6, d = vc & 63;
                        if (!lat) { *(f32x4*)(newv + (size_t)row * 128 + vc) = v0; *(f32x4*)(newv + (size_t)row * 128 + vc + 4) = v1; }
                        bf16* vp; int S;
                        if (!lat) { S = SEQ_C; vp = vT + ((size_t)((row >> 8) * 2 + kvh) * 64 + d) * SEQ_C + pos; }
                        else { S = SEQ_L; vp = vT + VT_LAT_OFF + ((size_t)(((row - NCTX) >> 10) * 2 + kvh) * 64 + d) * SEQ_L + pos; }
                        vp[0] = (bf16)f2bf(v0[0]); vp[S] = (bf16)f2bf(v0[1]); vp[2 * S] = (bf16)f2bf(v0[2]); vp[3 * S] = (bf16)f2bf(v0[3]);
                        vp[4 * S] = (bf16)f2bf(v1[0]); vp[5 * S] = (bf16)f2bf(v1[1]); vp[6 * S] = (bf16)f2bf(v1[2]); vp[7 * S] = (bf16)f2bf(v1[3]);
                    } else {
                        v4u w; w.x = pk2(v0[0], v0[1]); w.y = pk2(v0[2], v0[3]); w.z = pk2(v1[0], v1[1]); w.w = pk2(v1[2], v1[3]);
                        if (pn < 5) *(v4u*)(xr + (size_t)row * 512 + (c - 768)) = w; else *(v4u*)(yg + (size_t)row * 512 + (c - 1280)) = w;
                    }
                }
            }
    }
};
struct EpiOutProj {
    static constexpr bool PERM = true;
    const float *xp, *xs, *mods, *gffn; float* x1; bf16* ap; float* ssp;
    __device__ __forceinline__ void operator()(const f32x4 (&acc)[2][2][4][2], const pg8::Unit& u, int wr, int wc, int fr, int fq) const {
        const int mi = u.pm < 32 ? 0 : 1 + ((u.pm - 32) >> 2);
        const float* mv = mods + (size_t)mi * MODW;
        const int row0 = u.pm * 256 + wr * 64 + fr;
        const float* xbase = (u.pm < 32 ? xp : xs - (size_t)NCTX * DM) + (size_t)row0 * DM;
        float ssq[2][4];
#pragma unroll
        for (int ai = 0; ai < 2; ++ai)
#pragma unroll
            for (int m = 0; m < 4; ++m) ssq[ai][m] = 0.f;
#pragma unroll
        for (int bj = 0; bj < 2; ++bj) {
            const int c = u.pn * 256 + bj * 128 + wc * 32 + 8 * fq;
            const f32x4 gv0 = *(const f32x4*)(mv + 2 * DM + c), gv1 = *(const f32x4*)(mv + 2 * DM + c + 4);
            const f32x4 g20 = *(const f32x4*)(gffn + c) * (1.f + *(const f32x4*)(mv + 4 * DM + c)), g21 = *(const f32x4*)(gffn + c + 4) * (1.f + *(const f32x4*)(mv + 4 * DM + c + 4));
#pragma unroll
            for (int h4 = 0; h4 < 4; ++h4) {
                const int ai = h4 >> 1;
                f32x4 xv[2][2];
#pragma unroll
                for (int mm = 0; mm < 2; ++mm) { const float* xr = xbase + (size_t)(ai * 128 + (2 * (h4 & 1) + mm) * 16) * DM + c; xv[mm][0] = *(const f32x4*)xr; xv[mm][1] = *(const f32x4*)(xr + 4); }
                asm volatile("" ::: "memory");
#pragma unroll
                for (int mm = 0; mm < 2; ++mm) {
                    const int m = 2 * (h4 & 1) + mm;
                    const size_t off = (size_t)(row0 + ai * 128 + m * 16) * DM + c;
                    const f32x4 o0 = xv[mm][0] + gv0 * acc[ai][bj][m][0], o1 = xv[mm][1] + gv1 * acc[ai][bj][m][1];
                    *(f32x4*)(x1 + off) = o0; *(f32x4*)(x1 + off + 4) = o1;
                    ssq[ai][m] += ((o0[0] * o0[0] + o0[1] * o0[1]) + (o0[2] * o0[2] + o0[3] * o0[3])) + ((o1[0] * o1[0] + o1[1] * o1[1]) + (o1[2] * o1[2] + o1[3] * o1[3]));
                    const f32x4 t0 = o0 * g20, t1 = o1 * g21; v4u w; w.x = pk2(t0[0], t0[1]); w.y = pk2(t0[2], t0[3]); w.z = pk2(t1[0], t1[1]); w.w = pk2(t1[2], t1[3]);
                    *(v4u*)(ap + off) = w;
                }
                asm volatile("" ::: "memory");
            }
        }
#pragma unroll
        for (int ai = 0; ai < 2; ++ai)
#pragma unroll
            for (int m = 0; m < 4; ++m) { float v = ssq[ai][m]; v += __shfl_xor(v, 16); v += __shfl_xor(v, 32);
                if (fq == 0) ssp[(size_t)(row0 + ai * 128 + m * 16) * 16 + u.pn * 4 + wc] = v; }
    }
};
struct EpiScores {
    static constexpr bool PERM = true;
    bf16* sc; const float* ssp; const float* bias;
    __device__ __forceinline__ void operator()(const f32x4 (&acc)[2][2][4][2], const pg8::Unit& u, int wr, int wc, int fr, int fq) const {
        const int mi = u.pm < 32 ? 0 : 1 + ((u.pm - 32) >> 2);
        const int row0 = u.pm * 256 + wr * 64 + fr;
        f32x4 b0[2], b1[2];
#pragma unroll
        for (int bj = 0; bj < 2; ++bj) { const int c = u.pn * 256 + bj * 128 + wc * 32 + 8 * fq; b0[bj] = *(const f32x4*)(bias + (size_t)mi * 2048 + c); b1[bj] = *(const f32x4*)(bias + (size_t)mi * 2048 + c + 4); }
#pragma unroll
        for (int h2 = 0; h2 < 4; ++h2) {
            const int ai = h2 >> 1;
            f32x4 sp[2][4];
#pragma unroll
            for (int mm = 0; mm < 2; ++mm)
#pragma unroll
                for (int q = 0; q < 4; ++q) sp[mm][q] = *((const f32x4*)(ssp + (size_t)(row0 + ai * 128 + (2 * (h2 & 1) + mm) * 16) * 16) + q);
            asm volatile("" ::: "memory");
#pragma unroll
            for (int mm = 0; mm < 2; ++mm) {
                const int m = 2 * (h2 & 1) + mm;
                const int row = row0 + ai * 128 + m * 16;
                const float ss = ((sp[mm][0][0] + sp[mm][0][1]) + (sp[mm][0][2] + sp[mm][0][3])) + ((sp[mm][1][0] + sp[mm][1][1]) + (sp[mm][1][2] + sp[mm][1][3]))
                               + ((sp[mm][2][0] + sp[mm][2][1]) + (sp[mm][2][2] + sp[mm][2][3])) + ((sp[mm][3][0] + sp[mm][3][1]) + (sp[mm][3][2] + sp[mm][3][3]));
                const float rstd = 1.f / sqrtf(ss * (1.f / DM) + EPS);
#pragma unroll
                for (int bj = 0; bj < 2; ++bj) {
                    const int c = u.pn * 256 + bj * 128 + wc * 32 + 8 * fq;
                    const f32x4 v0 = acc[ai][bj][m][0] * rstd + b0[bj], v1 = acc[ai][bj][m][1] * rstd + b1[bj];
                    v4u w; w.x = pk2(v0[0], v0[1]); w.y = pk2(v0[2], v0[3]); w.z = pk2(v1[0], v1[1]); w.w = pk2(v1[2], v1[3]);
                    *(v4u*)(sc + (size_t)row * 2048 + c) = w;
                }
            }
            asm volatile("" ::: "memory");
        }
    }
};

__device__ __forceinline__ void attn_unit(Frame& F, bool lat, int seq, int kvh, int qt) {
    const int tid = F.tid, lane = F.lane, wave = F.wave, r32 = lane & 31, hi = lane >> 5;
    const int g = wave >> 1, qs = wave & 1, head = kvh * 4 + g;
    const int S = lat ? SEQ_L : SEQ_C, tokbase = lat ? NCTX + seq * SEQ_L : seq * SEQ_C;
    const int q0 = qt * 64, qpos = q0 + 32 * qs + r32;
    const bf16* Q = (const bf16*)(F.ws + WS_Q); const bf16* Kb = (const bf16*)(F.ws + WS_K); const bf16* VT = (const bf16*)(F.ws + WS_VT);
    const bf16* CK = (const bf16*)(F.ws + WS_CK); const bf16* CVT = (const bf16*)(F.ws + WS_CVT);
    unsigned char* ldsK = F.lds; unsigned char* ldsV = F.lds + 8192;
    bf16x8 qf[4];
    { const bf16* qp = Q + (size_t)(tokbase + qpos) * 512 + head * 64;
#pragma unroll
      for (int ks = 0; ks < 4; ++ks) qf[ks] = *(const bf16x8*)(qp + 16 * ks + 8 * hi); }
    const float sinkl = F.in[I_SINK][head] * LOG2E;
    float mrun = sinkl, lrun = (hi == 0) ? 1.f : 0.f;
    f32x16 o0, o1;
#pragma unroll
    for (int r = 0; r < 16; ++r) { o0[r] = 0.f; o1[r] = 0.f; }
    int tlo, thi;
    if (lat) { tlo = (q0 >= 128 ? q0 - 128 : 0) >> 6; thi = ((q0 + 192 < S ? q0 + 192 : S)) >> 6; } else { tlo = 0; thi = 4; }
    const int nband = thi - tlo, ntile = nband + (lat ? 4 : 0);
    const int key_t = tid >> 3, ch_t = tid & 7;
    v4u kv, vv;
#define AT_LOAD(t_) do { const int tt_ = (t_); const bf16* kptr; const bf16* vptr; int vstride; \
        if (tt_ < nband) { const int kb_ = (tlo + tt_) * 64; kptr = Kb + (size_t)(tokbase + kb_) * 128 + kvh * 64; \
            vptr = VT + (lat ? (size_t)VT_LAT_OFF + (size_t)((seq * 2 + kvh) * 64) * SEQ_L : (size_t)((seq * 2 + kvh) * 64) * SEQ_C) + kb_; vstride = S; } \
        else { const int tc = tt_ - nband; kptr = CK + (size_t)(seq * 256 + tc * 64) * 128 + kvh * 64; vptr = CVT + (size_t)((seq * 2 + kvh) * 64) * 256 + tc * 64; vstride = 256; } \
        kv = *(const v4u*)(kptr + (size_t)key_t * 128 + ch_t * 8); vv = *(const v4u*)(vptr + (size_t)key_t * vstride + ch_t * 8); } while (0)
    AT_LOAD(0);
    for (int t = 0; t < ntile; ++t) {
        const bool band = t < nband;
        const int kbase = band ? (tlo + t) * 64 : 0;
        __syncthreads();
        *(v4u*)(ldsK + key_t * 128 + ((ch_t ^ (key_t & 7)) * 16)) = kv;
        *(v4u*)(ldsV + key_t * 128 + ((ch_t ^ (key_t & 7)) * 16)) = vv;
        __syncthreads();
        f32x16 p0, p1;
#pragma unroll
        for (int r = 0; r < 16; ++r) { p0[r] = 0.f; p1[r] = 0.f; }
#pragma unroll
        for (int ks = 0; ks < 4; ++ks) {
            const int sw = ((2 * ks + hi) ^ (r32 & 7)) * 16;
            const bf16x8 a0 = *(const bf16x8*)(ldsK + r32 * 128 + sw);
            const bf16x8 a1 = *(const bf16x8*)(ldsK + (32 + r32) * 128 + sw);
            p0 = __builtin_amdgcn_mfma_f32_32x32x16_bf16(a0, qf[ks], p0, 0, 0, 0);
            p1 = __builtin_amdgcn_mfma_f32_32x32x16_bf16(a1, qf[ks], p1, 0, 0, 0);
        }
        if (t + 1 < ntile) AT_LOAD(t + 1);
        if (band && lat && (kbase < q0 + 63 - 128 || kbase + 63 > q0 + 128)) {
#pragma unroll
            for (int r = 0; r < 16; ++r) { const int kp = kbase + crow(r, hi); int d0 = qpos - kp; d0 = d0 < 0 ? -d0 : d0; int d1 = qpos - kp - 32; d1 = d1 < 0 ? -d1 : d1;
                if (d0 > 128) p0[r] = -INFINITY; if (d1 > 128) p1[r] = -INFINITY; }
        }
        float tm = p0[0];
#pragma unroll
        for (int r = 1; r < 16; ++r) tm = fmaxf(tm, p0[r]);
#pragma unroll
        for (int r = 0; r < 16; ++r) tm = fmaxf(tm, p1[r]);
        tm = fmaxf(tm, __shfl_xor(tm, 32));
        const float mn = fmaxf(mrun, tm), alpha = __builtin_amdgcn_exp2f(mrun - mn); mrun = mn;
        float ls = 0.f;
#pragma unroll
        for (int r = 0; r < 16; ++r) { p0[r] = __builtin_amdgcn_exp2f(p0[r] - mn); p1[r] = __builtin_amdgcn_exp2f(p1[r] - mn); ls += p0[r] + p1[r]; o0[r] *= alpha; o1[r] *= alpha; }
        lrun = lrun * alpha + ls;
        bf16x8 pf[4];
#pragma unroll
        for (int s = 0; s < 2; ++s) {
            v4u w0, w1;
            w0.x = pk2(p0[8 * s + 0], p0[8 * s + 1]); w0.y = pk2(p0[8 * s + 2], p0[8 * s + 3]); w0.z = pk2(p0[8 * s + 4], p0[8 * s + 5]); w0.w = pk2(p0[8 * s + 6], p0[8 * s + 7]);
            w1.x = pk2(p1[8 * s + 0], p1[8 * s + 1]); w1.y = pk2(p1[8 * s + 2], p1[8 * s + 3]); w1.z = pk2(p1[8 * s + 4], p1[8 * s + 5]); w1.w = pk2(p1[8 * s + 6], p1[8 * s + 7]);
            pf[s] = __builtin_bit_cast(bf16x8, w0); pf[2 + s] = __builtin_bit_cast(bf16x8, w1);
        }
#pragma unroll
        for (int s4 = 0; s4 < 4; ++s4) {
#pragma unroll
            for (int dt = 0; dt < 2; ++dt) {
                const int d = 32 * dt + r32;
                const v2u lo = *(const v2u*)(ldsV + d * 128 + (((2 * s4) ^ (d & 7)) * 16) + 8 * hi);
                const v2u hi2 = *(const v2u*)(ldsV + d * 128 + (((2 * s4 + 1) ^ (d & 7)) * 16) + 8 * hi);
                v4u vf4; vf4.x = lo.x; vf4.y = lo.y; vf4.z = hi2.x; vf4.w = hi2.y;
                const bf16x8 vf = __builtin_bit_cast(bf16x8, vf4);
                if (dt == 0) o0 = __builtin_amdgcn_mfma_f32_32x32x16_bf16(vf, pf[s4], o0, 0, 0, 0);
                else o1 = __builtin_amdgcn_mfma_f32_32x32x16_bf16(vf, pf[s4], o1, 0, 0, 0);
            }
        }
    }
    const float ltot = lrun + __shfl_xor(lrun, 32), inv = 1.f / ltot;
    bf16* mix = (bf16*)(F.ws + WS_MIX) + (size_t)(tokbase + qpos) * DM + head * 64;
#pragma unroll
    for (int g4 = 0; g4 < 4; ++g4) {
        v2u w; w.x = pk2(o0[4 * g4] * inv, o0[4 * g4 + 1] * inv); w.y = pk2(o0[4 * g4 + 2] * inv, o0[4 * g4 + 3] * inv);
        *(v2u*)(mix + 8 * g4 + 4 * hi) = w;
        v2u w2; w2.x = pk2(o1[4 * g4] * inv, o1[4 * g4 + 1] * inv); w2.y = pk2(o1[4 * g4 + 2] * inv, o1[4 * g4 + 3] * inv);
        *(v2u*)(mix + 32 + 8 * g4 + 4 * hi) = w2;
    }
    __syncthreads();
}

constexpr int RL_HALF = 49152;
constexpr int RL_XCB = 32768;
constexpr int RL_AGG = 98304;
constexpr int RL_CARRY = RL_AGG + 8192;
constexpr int RL_CW = RL_CARRY + 512;
constexpr int RL_WG = RL_CW + 1280;
static_assert(RL_WG + 32768 <= LDSCTL_OFF, "RNN LDS map");
__device__ __forceinline__ float fsigmoid(float x) { return __builtin_amdgcn_rcpf(1.f + __expf(-x)); }
__device__ __forceinline__ float gelu_fast(float x) { const float y = 0.7978845608028654f * (x + 0.044715f * x * x * x); const float e = __expf(2.f * y); return x - x * __builtin_amdgcn_rcpf(1.f + e); }

template <bool REV>
__device__ __forceinline__ void scan_prep(const float (&a)[16], const float (&b)[16], int h, float (&Apre)[4], float (&Bpre)[4], float& At, float& Bt) {
    float Ao[4], Bo[4], Ap[4], Bp[4];
#pragma unroll
    for (int g = 0; g < 4; ++g) { float A = 1.f, B = 0.f;
#pragma unroll
        for (int ii = 0; ii < 4; ++ii) { const int r = 4 * g + (REV ? 3 - ii : ii); B = a[r] * B + b[r]; A = a[r] * A; }
        Ao[g] = A; Bo[g] = B; }
#pragma unroll
    for (int g = 0; g < 4; ++g) { Ap[g] = __shfl_xor(Ao[g], 32); Bp[g] = __shfl_xor(Bo[g], 32); }
    const bool ownfirst = REV ? (h == 1) : (h == 0);
    float Ac = 1.f, Bc = 0.f;
#pragma unroll
    for (int gi = 0; gi < 4; ++gi) { const int g = REV ? 3 - gi : gi;
        const float A1 = ownfirst ? Ao[g] : Ap[g], B1 = ownfirst ? Bo[g] : Bp[g], A2 = ownfirst ? Ap[g] : Ao[g], B2 = ownfirst ? Bp[g] : Bo[g];
        const float Ac1 = A1 * Ac, Bc1 = A1 * Bc + B1;
        Apre[g] = ownfirst ? Ac : Ac1; Bpre[g] = ownfirst ? Bc : Bc1;
        Ac = A2 * Ac1; Bc = A2 * Bc1 + B2; }
    At = Ac; Bt = Bc;
}
template <bool REV>
__device__ __forceinline__ void scan_finish(const float (&a)[16], const float (&b)[16], const float (&Apre)[4], const float (&Bpre)[4], float hin, float* hp, int hi) {
#pragma unroll
    for (int g = 0; g < 4; ++g) { float hc = Apre[g] * hin + Bpre[g];
#pragma unroll
        for (int ii = 0; ii < 4; ++ii) { const int r = 4 * g + (REV ? 3 - ii : ii); hc = a[r] * hc + b[r]; hp[(size_t)crow(r, hi) * 512] = hc; } }
}

template <bool REV>
__device__ __forceinline__ void rnn_dir(Frame& F, bool lat, int seq, int n) {
    const int lane = F.lane, w4 = F.wave & 3, r32 = lane & 31, hi = lane >> 5, dirh = REV ? 1 : 0;
    const int S = lat ? SEQ_L : SEQ_C, tokbase = lat ? NCTX + seq * SEQ_L : seq * SEQ_C, nchunk = S / 128;
    unsigned char* hb = F.lds + dirh * RL_HALF;
    float* XC32 = (float*)hb; unsigned char* XCB = hb + RL_XCB;
    f32x2* AGG = (f32x2*)(F.lds + RL_AGG) + dirh * 256; float* CARRY = (float*)(F.lds + RL_CARRY) + dirh * 64; const float* CW = (const float*)(F.lds + RL_CW);
    const unsigned char* WG = F.lds + RL_WG + dirh * 16384;
    const bf16* XR = (const bf16*)(F.ws + WS_XR) + (size_t)tokbase * 512 + n * 64;
    float* HX = (float*)(F.ws + (REV ? WS_H : WS_HF)) + (size_t)tokbase * 512 + n * 64;
    const int t = F.tid & 255, c8 = t & 7, tg = t >> 3;
    float ba[2], bi[2], sp8[2];
#pragma unroll
    for (int chh = 0; chh < 2; ++chh) { const int pe = dirh * 512 + n * 64 + chh * 32 + r32; ba[chh] = -LOG2E * F.in[I_RGBA][pe]; bi[chh] = -LOG2E * F.in[I_RGBI][pe];
        const float nl = -F.in[I_RGLAM][pe]; sp8[chh] = -8.f * LOG2E * (nl > 20.f ? nl : log1pf(__expf(nl))); }
    v4u xin[7];
#define RL_XLOAD(c0_) do { _Pragma("unroll") for (int i = 0; i < 7; ++i) { const int pos = (c0_) + 4 * tg - 2 + i; \
        xin[i] = (pos >= 0 && pos < S) ? *(const v4u*)(XR + (size_t)pos * 512 + 8 * c8) : (v4u){0u, 0u, 0u, 0u}; } } while (0)
    RL_XLOAD((REV ? nchunk - 1 : 0) * 128);
    float newcarry[2] = {0.f, 0.f};
    const bool last_tile = REV ? (w4 == 0) : (w4 == 3);
#pragma unroll 1
    for (int k = 0; k < nchunk; ++k) {
        const int c0 = (REV ? nchunk - 1 - k : k) * 128;
        {
            const f32x4 b0 = *(const f32x4*)(CW + 256 + 8 * c8), b1 = *(const f32x4*)(CW + 256 + 8 * c8 + 4);
            f32x4 wt0[4], wt1[4];
#pragma unroll
            for (int tap = 0; tap < 4; ++tap) { wt0[tap] = *(const f32x4*)(CW + tap * 64 + 8 * c8); wt1[tap] = *(const f32x4*)(CW + tap * 64 + 8 * c8 + 4); }
#pragma unroll
            for (int i = 0; i < 4; ++i) {
                f32x4 y0 = b0, y1 = b1;
#pragma unroll
                for (int tap = 0; tap < 4; ++tap) { const v4u x = xin[i + tap];
                    y0[0] += wt0[tap][0] * bflo(x.x); y0[1] += wt0[tap][1] * bfhi(x.x); y0[2] += wt0[tap][2] * bflo(x.y); y0[3] += wt0[tap][3] * bfhi(x.y);
                    y1[0] += wt1[tap][0] * bflo(x.z); y1[1] += wt1[tap][1] * bfhi(x.z); y1[2] += wt1[tap][2] * bflo(x.w); y1[3] += wt1[tap][3] * bfhi(x.w); }
                const int tk = 4 * tg + i;
                *(f32x4*)(XC32 + tk * 64 + 8 * c8) = y0; *(f32x4*)(XC32 + tk * 64 + 8 * c8 + 4) = y1;
                v4u w; w.x = pk2(y0[0], y0[1]); w.y = pk2(y0[2], y0[3]); w.z = pk2(y1[0], y1[1]); w.w = pk2(y1[2], y1[3]);
                *(v4u*)(XCB + tk * 128 + ((c8 ^ (tk & 7)) * 16)) = w; }
        }
        if (k + 1 < nchunk) RL_XLOAD((REV ? nchunk - 2 - k : k + 1) * 128);
        __syncthreads();
        if (k > 0 && last_tile && hi == 0) { CARRY[r32] = newcarry[0]; CARRY[32 + r32] = newcarry[1]; }
        const int tkA = 32 * w4 + r32;
#pragma unroll
        for (int chh = 0; chh < 2; ++chh) {
            const int che = chh * 32 + r32;
            float av[16], bv[16], Apre[4], Bpre[4];
            {
                f32x16 ga, gi;
#pragma unroll
                for (int r = 0; r < 16; ++r) { ga[r] = 0.f; gi[r] = 0.f; }
#pragma unroll
                for (int ks = 0; ks < 4; ++ks) {
                    const bf16x8 af = *(const bf16x8*)(XCB + tkA * 128 + (((2 * ks + hi) ^ (tkA & 7)) * 16));
                    const bf16x8 wa = *(const bf16x8*)(WG + che * 128 + (((2 * ks + hi) ^ (che & 7)) * 16));
                    const bf16x8 wi = *(const bf16x8*)(WG + 8192 + che * 128 + (((2 * ks + hi) ^ (che & 7)) * 16));
                    ga = __builtin_amdgcn_mfma_f32_32x32x16_bf16(af, wa, ga, 0, 0, 0);
                    gi = __builtin_amdgcn_mfma_f32_32x32x16_bf16(af, wi, gi, 0, 0, 0);
                }
#pragma unroll
                for (int r = 0; r < 16; ++r) { const int tk2 = 32 * w4 + crow(r, hi); const float x = XC32[tk2 * 64 + che];
                    const float rg = __builtin_amdgcn_rcpf(1.f + __builtin_amdgcn_exp2f(ga[r] + ba[chh])), ig = __builtin_amdgcn_rcpf(1.f + __builtin_amdgcn_exp2f(gi[r] + bi[chh])), a = __builtin_amdgcn_exp2f(rg * sp8[chh]);
                    av[r] = a; bv[r] = __builtin_amdgcn_sqrtf(fmaxf(1.f - a * a, 0.f)) * ig * x;
                    if ((r & 3) == 3) __builtin_amdgcn_sched_barrier(0); }
                float At, Bt;
                scan_prep<REV>(av, bv, hi, Apre, Bpre, At, Bt);
                if (hi == 0) { f32x2 ab; ab.x = At; ab.y = Bt; AGG[chh * 512 + w4 * 64 + che] = ab; }
            }
            __syncthreads();
            {
                float hin = CARRY[che];
                if (!REV) { for (int t2 = 0; t2 < w4; ++t2) { const f32x2 ab = AGG[chh * 512 + t2 * 64 + che]; hin = ab.x * hin + ab.y; } }
                else { for (int t2 = 3; t2 > w4; --t2) { const f32x2 ab = AGG[chh * 512 + t2 * 64 + che]; hin = ab.x * hin + ab.y; } }
                scan_finish<REV>(av, bv, Apre, Bpre, hin, HX + (size_t)(c0 + 32 * w4) * 512 + che, hi);
                if (last_tile) { const f32x2 ab = AGG[chh * 512 + w4 * 64 + che]; newcarry[chh] = ab.x * hin + ab.y; }
            }
        }
    }
#undef RL_XLOAD
    if (!lat && last_tile && hi == 0) { float* o = F.out + O_NEWRNN + (size_t)(seq * 2 + dirh) * 512 + n * 64; o[r32] = newcarry[0]; o[32 + r32] = newcarry[1]; }
}

__device__ __forceinline__ void rnn_unit(Frame& F, bool lat, int seq, int n) {
    const int tid = F.tid;
    const int S = lat ? SEQ_L : SEQ_C, tokbase = lat ? NCTX + seq * SEQ_L : seq * SEQ_C;
    __syncthreads();
    { float* CW = (float*)(F.lds + RL_CW); float* CARRY = (float*)(F.lds + RL_CARRY);
      if (tid < 320) CW[tid] = tid < 256 ? F.in[I_CONVW][(tid >> 6) * 512 + n * 64 + (tid & 63)] : F.in[I_CONVB][n * 64 + (tid - 256)];
      if (tid < 128) CARRY[tid] = lat ? F.in[I_SRNN][(size_t)(seq * 2 + (tid >> 6)) * 512 + n * 64 + (tid & 63)] : 0.f;
      const bf16* rgw = (const bf16*)(F.ws + WS_RGW);
#pragma unroll
      for (int i = 0; i < 4; ++i) { const int q = tid + 512 * i, ch = q & 7, d = (q >> 3) & 63, gate = (q >> 9) & 1, dir = q >> 10;
          const v4u w = *(const v4u*)(rgw + (size_t)((dir * 8 + n) * 2 + gate) * 4096 + d * 64 + ch * 8);
          *(v4u*)(F.lds + RL_WG + dir * 16384 + gate * 8192 + d * 128 + ((ch ^ (d & 7)) * 16)) = w; } }
    __syncthreads();
    if (F.wave < 4) rnn_dir<false>(F, lat, seq, n); else rnn_dir<true>(F, lat, seq, n);
    __syncthreads();
    { const int c4 = tid & 15, tk = tid >> 4;
      const float* HF = (const float*)(F.ws + WS_HF) + (size_t)tokbase * 512 + n * 64 + 4 * c4;
      const float* HB = (const float*)(F.ws + WS_H) + (size_t)tokbase * 512 + n * 64 + 4 * c4;
      const bf16* YG = (const bf16*)(F.ws + WS_YG) + (size_t)tokbase * 512 + n * 64 + 4 * c4;
      bf16* MIX = (bf16*)(F.ws + WS_MIX) + (size_t)tokbase * DM + 512 + n * 64 + 4 * c4;
      for (int t0 = tk; t0 < S; t0 += 32) {
          const f32x4 a = *(const f32x4*)(HF + (size_t)t0 * 512), b = *(const f32x4*)(HB + (size_t)t0 * 512); const v2u y = *(const v2u*)(YG + (size_t)t0 * 512);
          v2u o; o.x = pk2((a[0] + b[0]) * gelu_fast(bflo(y.x)), (a[1] + b[1]) * gelu_fast(bfhi(y.x))); o.y = pk2((a[2] + b[2]) * gelu_fast(bflo(y.y)), (a[3] + b[3]) * gelu_fast(bfhi(y.y)));
          *(v2u*)(MIX + (size_t)t0 * DM) = o; } }
    __syncthreads();
}

#ifndef MK_P3_TYPES
#define MK_P3_TYPES 15
#endif
__device__ __forceinline__ void p3_phase(Frame& F, int types = 15) {
    const int v = F.vcu;
#pragma unroll 1
    for (int i = 0; i < 832; ++i) {
        int type, idx;
        if (F.G == 256) {
            if (v < 64) { if (i > 0) break; type = 0; idx = v; }
            else { if (i >= 6) break; const int j = v - 64, sl = i >> 1, rep = i & 1; type = 1 + sl;
                const bool extra = sl == 0 ? (j < 64) : (sl == 1 ? (j >= 64 && j < 128) : (j >= 128));
                if (rep && !extra) continue; idx = rep ? 192 + (j - 64 * sl) : j; }
        } else { const int it = v + i * F.G; if (it >= 832) break;
            if (it < 64) { type = 0; idx = it; } else if (it < 320) { type = 1; idx = it - 64; } else if (it < 576) { type = 2; idx = it - 320; } else { type = 3; idx = it - 576; } }
        if (!((types >> type) & 1)) continue;
        const bool lat = type < 2;
        Frame L = F; asm volatile("" : "+v"(L.tid)); L.lane = L.tid & 63;
        asm volatile("" : "+s"(L.ws), "+s"(L.out));
        if ((type & 1) == 0) rnn_unit(L, lat, idx >> 3, idx & 7);
        else { if (lat) attn_unit(L, true, idx >> 5, (idx >> 4) & 1, idx & 15); else attn_unit(L, false, idx >> 3, (idx >> 2) & 1, idx & 3); }
    }
}

__device__ __forceinline__ unsigned key16(unsigned b, unsigned idx) { const unsigned s = (b & 0x8000u) ? (~b & 0xffffu) : (b | 0x8000u); return (s << 16) | idx; }
__device__ __forceinline__ float keyval16(unsigned k) { const unsigned s = k >> 16; const unsigned b = (s & 0x8000u) ? (s & 0x7fffu) : (~s & 0xffffu); return bf2f(b); }
__device__ __forceinline__ unsigned sortable32(float f) { const unsigned u = __builtin_bit_cast(unsigned, f); return (u & 0x80000000u) ? ~u : (u | 0x80000000u); }
template <int CTRL> __device__ __forceinline__ unsigned dppu(unsigned v) { return (unsigned)__builtin_amdgcn_update_dpp(0, (int)v, CTRL, 0xf, 0xf, true); }
template <int CTRL> __device__ __forceinline__ float dppf(float v) { return __builtin_bit_cast(float, __builtin_amdgcn_update_dpp(0, __builtin_bit_cast(int, v), CTRL, 0xf, 0xf, true)); }
__device__ __forceinline__ unsigned umax_(unsigned a, unsigned b) { return a > b ? a : b; }
__device__ __forceinline__ unsigned umin_(unsigned a, unsigned b) { return a < b ? a : b; }
__device__ __forceinline__ unsigned rowmax16u(unsigned x) { x = umax_(x, dppu<0xB1>(x)); x = umax_(x, dppu<0x4E>(x)); x = umax_(x, dppu<0x141>(x)); x = umax_(x, dppu<0x140>(x)); return x; }
__device__ __forceinline__ float rowmax16f(float x) { x = fmaxf(x, dppf<0xB1>(x)); x = fmaxf(x, dppf<0x4E>(x)); x = fmaxf(x, dppf<0x141>(x)); x = fmaxf(x, dppf<0x140>(x)); return x; }
__device__ __forceinline__ float rowsum16f(float x) { x += dppf<0xB1>(x); x += dppf<0x4E>(x); x += dppf<0x141>(x); x += dppf<0x140>(x); return x; }
__device__ __forceinline__ int rowsum16i(int x) { x += (int)dppu<0xB1>((unsigned)x); x += (int)dppu<0x4E>((unsigned)x); x += (int)dppu<0x141>((unsigned)x); x += (int)dppu<0x140>((unsigned)x); return x; }
#define CEX(a, b) do { const unsigned _h = umax_(a, b), _l = umin_(a, b); a = _h; b = _l; } while (0)

#ifndef P7_NCH
#define P7_NCH 8
#endif
constexpr int P7_CSH = (P7_NCH == 4 ? 12 : (P7_NCH == 8 ? 11 : (P7_NCH == 16 ? 10 : 9)));
constexpr int P7_WL = 16384;
constexpr int P7_TL = 0, P7_TE = 1024, P7_TG = 3072, P7_LE = 5120, P7_LG = 7168, P7_LSU = 9216, P7_LQ = 11264, P7_H2Q = 12160, P7_HST = 16256;
static_assert(P7_LQ + 512 <= P7_H2Q && (P7_H2Q % 16) == 0 && P7_HST + 16 <= P7_WL && P7_WL * 8 <= RING_BYTES, "P7 LDS map");

__device__ __forceinline__ float tkval(unsigned k) { return __builtin_bit_cast(float, k & 0xffff0000u); }
#define TKX(a, b) do { unsigned hi_, lo_; asm("v_max_f32 %0, %1, %2" : "=v"(hi_) : "v"(a), "v"(b)); asm("v_min_f32 %0, %1, %2" : "=v"(lo_) : "v"(a), "v"(b)); a = hi_; b = lo_; } while (0)
#define TK_SORT16(c) do { TKX(c[0], c[1]); TKX(c[2], c[3]); TKX(c[0], c[2]); TKX(c[1], c[3]); TKX(c[1], c[2]); TKX(c[4], c[5]); TKX(c[6], c[7]); TKX(c[4], c[6]); TKX(c[5], c[7]); TKX(c[5], c[6]); TKX(c[0], c[4]); TKX(c[2], c[6]); TKX(c[2], c[4]); TKX(c[1], c[5]); TKX(c[3], c[7]); TKX(c[3], c[5]); TKX(c[1], c[2]); TKX(c[3], c[4]); TKX(c[5], c[6]); TKX(c[8], c[9]); TKX(c[10], c[11]); TKX(c[8], c[10]); TKX(c[9], c[11]); TKX(c[9], c[10]); TKX(c[12], c[13]); TKX(c[14], c[15]); TKX(c[12], c[14]); TKX(c[13], c[15]); TKX(c[13], c[14]); TKX(c[8], c[12]); TKX(c[10], c[14]); TKX(c[10], c[12]); TKX(c[9], c[13]); TKX(c[11], c[15]); TKX(c[11], c[13]); TKX(c[9], c[10]); TKX(c[11], c[12]); TKX(c[13], c[14]); TKX(c[0], c[8]); TKX(c[4], c[12]); TKX(c[4], c[8]); TKX(c[2], c[10]); TKX(c[6], c[14]); TKX(c[6], c[10]); TKX(c[2], c[4]); TKX(c[6], c[8]); TKX(c[10], c[12]); TKX(c[1], c[9]); TKX(c[5], c[13]); TKX(c[5], c[9]); TKX(c[3], c[11]); TKX(c[7], c[15]); TKX(c[7], c[11]); TKX(c[3], c[5]); TKX(c[7], c[9]); TKX(c[11], c[13]); TKX(c[1], c[2]); TKX(c[3], c[4]); TKX(c[5], c[6]); TKX(c[7], c[8]); TKX(c[9], c[10]); TKX(c[11], c[12]); TKX(c[13], c[14]); } while (0)
#define TK_BITONIC16(c) do { TKX(c[0], c[8]); TKX(c[1], c[9]); TKX(c[2], c[10]); TKX(c[3], c[11]); TKX(c[4], c[12]); TKX(c[5], c[13]); TKX(c[6], c[14]); TKX(c[7], c[15]); TKX(c[0], c[4]); TKX(c[1], c[5]); TKX(c[2], c[6]); TKX(c[3], c[7]); TKX(c[8], c[12]); TKX(c[9], c[13]); TKX(c[10], c[14]); TKX(c[11], c[15]); TKX(c[0], c[2]); TKX(c[1], c[3]); TKX(c[4], c[6]); TKX(c[5], c[7]); TKX(c[8], c[10]); TKX(c[9], c[11]); TKX(c[12], c[14]); TKX(c[13], c[15]); TKX(c[0], c[1]); TKX(c[2], c[3]); TKX(c[4], c[5]); TKX(c[6], c[7]); TKX(c[8], c[9]); TKX(c[10], c[11]); TKX(c[12], c[13]); TKX(c[14], c[15]); } while (0)
__device__ __forceinline__ void topk_stage1(const bf16* SC, int tok0, int lane, unsigned* TL4) {
    const v4u* src = (const v4u*)(SC + (size_t)(tok0 + (lane >> 4)) * 2048 + (lane & 15) * 128);
    unsigned T[16];
#pragma unroll
    for (int ch = 0; ch < 8; ++ch) {
        const v4u r0 = src[2 * ch], r1 = src[2 * ch + 1];
        unsigned c[16];
#pragma unroll
        for (int m = 0; m < 4; ++m) { c[2 * m] = (r0[m] << 16) | (unsigned)(16 * ch + 2 * m); c[2 * m + 1] = (r0[m] & 0xffff0000u) | (unsigned)(16 * ch + 2 * m + 1);
                                      c[8 + 2 * m] = (r1[m] << 16) | (unsigned)(16 * ch + 8 + 2 * m); c[8 + 2 * m + 1] = (r1[m] & 0xffff0000u) | (unsigned)(16 * ch + 8 + 2 * m + 1); }
        TK_SORT16(c);
        if (ch == 0) {
#pragma unroll
            for (int i = 0; i < 16; ++i) T[i] = c[i];
        } else {
#pragma unroll
            for (int i = 0; i < 16; ++i) { unsigned m_; asm("v_max_f32 %0, %1, %2" : "=v"(m_) : "v"(T[i]), "v"(c[15 - i])); T[i] = m_; }
            TK_BITONIC16(T);
        }
    }
    v4u* dst = (v4u*)(TL4 + lane * 16);
#pragma unroll
    for (int q = 0; q < 4; ++q) { v4u o; o.x = T[4 * q]; o.y = T[4 * q + 1]; o.z = T[4 * q + 2]; o.w = T[4 * q + 3]; dst[q] = o; }
}
#define TK_POP4(C, KEEP, it) do { const unsigned m_ = rowmax16u(C[0]); const bool w_ = C[0] == m_; C[0] = w_ ? C[1] : C[0]; C[1] = w_ ? C[2] : C[1]; C[2] = w_ ? C[3] : C[2]; C[3] = w_ ? 0u : C[3]; KEEP = (k == (it)) ? m_ : KEEP; } while (0)
__device__ __forceinline__ void topk_stage2(const unsigned* TL, int lane, const unsigned ctabp, int* oute, float* outg) {
    const int k = lane & 15, row = lane >> 4;
    unsigned ca[4], cb[4];
    const unsigned* LAa = TL + (2 * row) * 16; const unsigned* LBa = TL + (2 * row + 1) * 16;
    const unsigned* LAb = TL + (2 * (4 + row)) * 16; const unsigned* LBb = TL + (2 * (4 + row) + 1) * 16;
#pragma unroll
    for (int s = 0; s < 4; ++s) { const int ij = (int)((ctabp >> (8 * s)) & 0xffu); const bool valid = ij != 255; const int i = (ij >> 4) & 15, j = ij & 15;
        const float sa = tkval(LAa[i]) + tkval(LBa[j]), sb = tkval(LAb[i]) + tkval(LBb[j]);
        ca[s] = valid ? ((sortable32(sa) & 0xffffff00u) | (unsigned)(i * 16 + j)) : 0u; cb[s] = valid ? ((sortable32(sb) & 0xffffff00u) | (unsigned)(i * 16 + j)) : 0u; }
    CEX(ca[0], ca[1]); CEX(ca[2], ca[3]); CEX(ca[0], ca[2]); CEX(ca[1], ca[3]); CEX(ca[1], ca[2]);
    CEX(cb[0], cb[1]); CEX(cb[2], cb[3]); CEX(cb[0], cb[2]); CEX(cb[1], cb[3]); CEX(cb[1], cb[2]);
    unsigned keepa = 0, keepb = 0;
#pragma unroll
    for (int it = 0; it < 16; ++it) { TK_POP4(ca, keepa, it); TK_POP4(cb, keepb, it); }
    {
        const unsigned kaa = LAa[(keepa >> 4) & 15], kba = LBa[keepa & 15], kab = LAb[(keepb >> 4) & 15], kbb = LBb[keepb & 15];
        const float bva = tkval(kaa) + tkval(kba), bvb = tkval(kab) + tkval(kbb);
        const float mxa = rowmax16f(bva), mxb = rowmax16f(bvb); const float exa = __expf(bva - mxa), exb = __expf(bvb - mxb); const float sma = rowsum16f(exa), smb = rowsum16f(exb);
        oute[lane] = (int)((kaa & 127u) * 128u + (kba & 127u)); outg[lane] = exa / sma;
        oute[64 + lane] = (int)((kab & 127u) * 128u + (kbb & 127u)); outg[64 + lane] = exb / smb;
    }
}
#undef TK_POP4

__device__ __forceinline__ void gl16x4(v4u (&r)[4], unsigned voff, const unsigned char* b0, const unsigned char* b1, const unsigned char* b2, const unsigned char* b3) {
    asm volatile("s_nop 4\n\tglobal_load_dwordx4 %0, %4, %5\n\tglobal_load_dwordx4 %1, %4, %6\n\tglobal_load_dwordx4 %2, %4, %7\n\tglobal_load_dwordx4 %3, %4, %8"
                 : "=&v"(r[0]), "=&v"(r[1]), "=&v"(r[2]), "=&v"(r[3]) : "v"(voff), "s"(b0), "s"(b1), "s"(b2), "s"(b3) : "memory");
}
#define P7_VMWAIT(N, R) asm volatile("s_waitcnt vmcnt(" #N ")" : "+v"(R[0]), "+v"(R[1]), "+v"(R[2]), "+v"(R[3]) :: "memory")
__device__ __forceinline__ int mbcnt64(unsigned long long m) { return (int)__builtin_amdgcn_mbcnt_hi((unsigned)(m >> 32), __builtin_amdgcn_mbcnt_lo((unsigned)m, 0u)); }
__device__ __forceinline__ int rfl(int v) { return __builtin_amdgcn_readfirstlane(v); }
__device__ __forceinline__ float rflf(float v) { return __builtin_bit_cast(float, __builtin_amdgcn_readfirstlane(__builtin_bit_cast(int, v))); }

__device__ __forceinline__ void p7_phase(Frame& F, bool dry) {
    const int lane0 = F.lane, wave = F.wave;
    if (dry && (MK_DRY_SKIP & 16) && wave >= 4) return;
    unsigned char* wl = F.lds + wave * P7_WL;
    int* TE = (int*)(wl + P7_TE); float* TG = (float*)(wl + P7_TG);
    float* LG = (float*)(wl + P7_LG); float* LSU = (float*)(wl + P7_LSU); unsigned char* H2Q = wl + P7_H2Q; float* HST = (float*)(wl + P7_HST);
    const bf16* SC = (const bf16*)(F.ws + WS_SC); const bf16* H2 = (const bf16*)(F.ws + WS_H);
    const unsigned char* U8 = F.ws + WS_U; const unsigned char* V8 = F.ws + WS_V;
    const float* SU = (const float*)(F.ws + WS_SU); const float* SV = (const float*)(F.ws + WS_SV);
    const float* mods = (const float*)(F.ws + WS_MODS); const float* SSP = (const float*)(F.ws + WS_SSP);
    unsigned ctabp = 0;
#pragma unroll
    for (int s = 0; s < 4; ++s) { const int c = 16 * s + (lane0 & 15); int i, j;
        if (c < 16) { i = 0; j = c; } else if (c < 24) { i = 1; j = c - 16; } else if (c < 29) { i = 2; j = c - 24; } else if (c < 33) { i = 3; j = c - 29; } else if (c < 36) { i = 4; j = c - 33; }
        else if (c < 38) { i = 5; j = c - 36; } else if (c < 40) { i = 6; j = c - 38; } else if (c < 42) { i = 7; j = c - 40; } else if (c < 50) { i = c - 34; j = 0; } else { i = -1; j = 0; }
        ctabp |= (unsigned)(i < 0 ? 255 : i * 16 + j) << (8 * s); }
    const int ntg = NTOK / (F.G * NWAVES * 4);
#pragma unroll 1
    for (int tg = 0; tg < ntg; ++tg) {
        const int tok0 = (F.vcu * ntg + tg) * (NWAVES * 4) + wave * 4;
        int lane = F.lane; asm volatile("" : "+v"(lane));
        {
            unsigned* TL4 = (unsigned*)(wl + P7_LE);
            topk_stage1(SC, tok0, lane, TL4);
            v4u ch0, ch1, nh0, nh1;
#define P7_TLOAD(H0, H1, tk) do { H0 = *(const v4u*)(H2 + (size_t)(tk) * DM + 16 * lane); H1 = *(const v4u*)(H2 + (size_t)(tk) * DM + 16 * lane + 8); } while (0)
            P7_TLOAD(ch0, ch1, tok0);
#pragma unroll 1
            for (int s = 0; s < 4; ++s) {
                if (s < 3) P7_TLOAD(nh0, nh1, tok0 + s + 1);
                const int tokc = tok0 + s;
                const f32x4* spp = (const f32x4*)(SSP + (size_t)tokc * 16); const f32x4 q0 = spp[0], q1 = spp[1], q2 = spp[2], q3 = spp[3];
                const float* shp = mods + (size_t)mod_index(tokc) * MODW + 3 * DM + 16 * lane;
                const f32x4 sh0 = *(const f32x4*)(shp), sh1 = *(const f32x4*)(shp + 4), sh2v = *(const f32x4*)(shp + 8), sh3 = *(const f32x4*)(shp + 12);
                unsigned ctab_ = ctabp; asm volatile("" : "+v"(ctab_));
                topk_stage2(TL4 + s * 256, lane, ctab_, TE + s * 128, TG + s * 128);
                const v4u a = ch0, b = ch1;
                const float ssr = ((q0[0] + q0[1]) + (q0[2] + q0[3])) + ((q1[0] + q1[1]) + (q1[2] + q1[3])) + ((q2[0] + q2[1]) + (q2[2] + q2[3])) + ((q3[0] + q3[1]) + (q3[2] + q3[3]));
                const float rstd = 1.f / sqrtf(ssr * (1.f / DM) + EPS);
                float hv[16];
                hv[0] = bflo(a.x); hv[1] = bfhi(a.x); hv[2] = bflo(a.y); hv[3] = bfhi(a.y); hv[4] = bflo(a.z); hv[5] = bfhi(a.z); hv[6] = bflo(a.w); hv[7] = bfhi(a.w);
                hv[8] = bflo(b.x); hv[9] = bfhi(b.x); hv[10] = bflo(b.y); hv[11] = bfhi(b.y); hv[12] = bflo(b.z); hv[13] = bfhi(b.z); hv[14] = bflo(b.w); hv[15] = bfhi(b.w);
#pragma unroll
                for (int i = 0; i < 4; ++i) { hv[i] = hv[i] * rstd + sh0[i]; hv[4 + i] = hv[4 + i] * rstd + sh1[i]; hv[8 + i] = hv[8 + i] * rstd + sh2v[i]; hv[12 + i] = hv[12 + i] * rstd + sh3[i]; }
                float am = 0.f;
#pragma unroll
                for (int i = 0; i < 16; ++i) am = fmaxf(am, fabsf(hv[i]));
                am = wave_max(am);
                const float inv = am > 0.f ? 119.f / am : 0.f;
                if (lane == 0) HST[s] = am * (1.f / 119.f);
                v4u qv;
#pragma unroll
                for (int j = 0; j < 4; ++j) { unsigned w = 0;
#pragma unroll
                    for (int i = 0; i < 4; ++i) { int q = (int)rintf(hv[4 * j + i] * inv); w |= ((unsigned)q & 0xffu) << (8 * i); }
                    qv[j] = w; }
                *(v4u*)(H2Q + s * 1024 + 16 * lane) = qv;
                ch0 = nh0; ch1 = nh1;
            }
#undef P7_TLOAD
        }
        {
            unsigned* LEO = (unsigned*)(wl + P7_LE);
            int ee0[4], ee1[4]; float gg0[4], gg1[4], us0[4], us1[4], vs0[4], vs1[4];
#pragma unroll
            for (int s = 0; s < 4; ++s) { ee0[s] = TE[s * 128 + lane]; ee1[s] = TE[s * 128 + 64 + lane]; gg0[s] = TG[s * 128 + lane]; gg1[s] = TG[s * 128 + 64 + lane]; }
#pragma unroll
            for (int s = 0; s < 4; ++s) { us0[s] = SU[ee0[s]]; us1[s] = SU[ee1[s]]; vs0[s] = SV[ee0[s]]; vs1[s] = SV[ee1[s]]; }
#pragma unroll
            for (int s = 0; s < 4; ++s) { const int e0 = ee0[s], e1 = ee1[s]; const int c0 = e0 >> P7_CSH, c1 = e1 >> P7_CSH; int base = s * 128;
#pragma unroll
                for (int c = 0; c < P7_NCH; ++c) {
                    const unsigned long long m0 = __ballot(c0 == c), m1 = __ballot(c1 == c);
                    const int n0 = __popcll(m0), n = n0 + __popcll(m1);
                    if (c0 == c) { const int p = base + mbcnt64(m0); LEO[p] = (unsigned)e0 << 9; LG[p] = gg0[s] * vs0[s]; LSU[p] = us0[s]; }
                    if (c1 == c) { const int p = base + n0 + mbcnt64(m1); LEO[p] = (unsigned)e1 << 9; LG[p] = gg1[s] * vs1[s]; LSU[p] = us1[s]; }
                    base += n;
                } }
        }
        typedef __attribute__((address_space(1))) v4u GV4;
        if (!(dry && (MK_DRY_SKIP & 1))) {
            int lane_u = F.lane; asm volatile("" : "+v"(lane_u));
            const int su = lane_u >> 4, ju = lane_u & 15; const unsigned j16 = 16u * (unsigned)ju;
            const unsigned* LEOs = (const unsigned*)(wl + P7_LE) + su * 128; float* LGs = LG + su * 128; const float* LSUs = LSU + su * 128;
            const unsigned long long u8i = (unsigned long long)U8;
            unsigned hh[2][4], hl[2][4];
#pragma unroll
            for (int i = 0; i < 2; ++i) { const v4u ha = *(const v4u*)(H2Q + su * 1024 + 512 * i + 32 * ju), hb = *(const v4u*)(H2Q + su * 1024 + 512 * i + 32 * ju + 16);
#pragma unroll
                for (int w = 0; w < 4; ++w) { unsigned lo16[2], hi16[2];
#pragma unroll
                    for (int h = 0; h < 2; ++h) { const unsigned d = (w < 2 ? ha : hb)[2 * (w & 1) + h];
                        const unsigned t = ((d & 0x7f7f7f7fu) + 0x08080808u) ^ (d & 0x80808080u);
                        unsigned l = (t & 0x0f0f0f0fu) ^ 0x08080808u, g = (t >> 4) & 0x0f0f0f0fu;
                        l = (l | (l >> 4)) & 0x00ff00ffu; l = (l | (l >> 8)) & 0xffffu; g = (g | (g >> 4)) & 0x00ff00ffu; g = (g | (g >> 8)) & 0xffffu;
                        lo16[h] = l; hi16[h] = g; }
                    hl[i][w] = lo16[0] | (lo16[1] << 16); hh[i][w] = hi16[0] | (hi16[1] << 16); } }
            const float hs = HST[su];
            const bool b0 = (ju & 1) != 0, b1 = (ju & 2) != 0; const int rr = ju & 3;
            v4u A[4][2], B[4][2], C[4][2], D[4][2];
#define P7_ULOAD(R, t) do { const v4u eo_ = *(const v4u*)(LEOs + 4 * (t)); \
            _Pragma("unroll") for (int r = 0; r < 4; ++r) { unsigned o_ = eo_[r] + j16; asm volatile("" : "+v"(o_)); \
                R[r][0] = *(const GV4*)(u8i + o_); R[r][1] = *(const GV4*)(u8i + o_ + 256); } \
            __builtin_amdgcn_sched_barrier(0); } while (0)
#define P7_SCOMP_U(R, t) do { const float su_ = LSUs[4 * (t) + rr], g_ = LGs[4 * (t) + rr]; int p_[4]; \
                _Pragma("unroll") for (int r = 0; r < 4; ++r) { int ah = 0, al = 0; \
                    _Pragma("unroll") for (int i = 0; i < 2; ++i) { _Pragma("unroll") for (int w = 0; w < 4; ++w) { \
                        ah = __builtin_amdgcn_sdot8((int)hh[i][w], (int)R[r][i][w], ah, false); al = __builtin_amdgcn_sdot8((int)hl[i][w], (int)R[r][i][w], al, false); } } \
                    p_[r] = 16 * ah + al; } \
                const int q01 = (b0 ? p_[1] : p_[0]) + (int)dppu<0xB1>((unsigned)(b0 ? p_[0] : p_[1])); const int q23 = (b0 ? p_[3] : p_[2]) + (int)dppu<0xB1>((unsigned)(b0 ? p_[2] : p_[3])); \
                int q_ = (b1 ? q23 : q01) + (int)dppu<0x4E>((unsigned)(b1 ? q01 : q23)); q_ += (int)dppu<0x128>((unsigned)q_); q_ += (int)dppu<0x124>((unsigned)q_); \
                const float dotf = (float)q_ * (hs * su_); LGs[4 * (t) + rr] = g_ * gelu_fast(dotf); } while (0)
            P7_ULOAD(A, 0); P7_ULOAD(B, 1); P7_ULOAD(C, 2);
#pragma unroll 1
            for (int t = 0; t < 28; t += 4) {
                P7_ULOAD(D, t + 3); P7_SCOMP_U(A, t);
                P7_ULOAD(A, t + 4); P7_SCOMP_U(B, t + 1);
                P7_ULOAD(B, t + 5); P7_SCOMP_U(C, t + 2);
                P7_ULOAD(C, t + 6); P7_SCOMP_U(D, t + 3);
                asm volatile("" ::: "memory");
            }
            P7_ULOAD(D, 31); P7_SCOMP_U(A, 28); P7_SCOMP_U(B, 29); P7_SCOMP_U(C, 30); P7_SCOMP_U(D, 31);
#undef P7_SCOMP_U
#undef P7_ULOAD
        }
        float cscale; int sumq8;
        {
            int lane_q = F.lane; asm volatile("" : "+v"(lane_q));
            const int sq = lane_q >> 4, jq = lane_q & 15;
            const float* lg = LG + sq * 128 + 8 * jq; const f32x4 c0 = *(const f32x4*)lg, c1 = *(const f32x4*)(lg + 4);
            float m = fmaxf(fmaxf(fmaxf(fabsf(c0[0]), fabsf(c0[1])), fmaxf(fabsf(c0[2]), fabsf(c0[3]))), fmaxf(fmaxf(fabsf(c1[0]), fabsf(c1[1])), fmaxf(fabsf(c1[2]), fabsf(c1[3]))));
            m = rowmax16f(m);
            cscale = m * (1.f / 127.f); const float iv = m > 0.f ? 127.f / m : 0.f;
            v2u w; w.x = 0u; w.y = 0u;
#pragma unroll
            for (int k = 0; k < 4; ++k) { w.x |= ((unsigned)(int)rintf(c0[k] * iv) & 0xffu) << (8 * k); w.y |= ((unsigned)(int)rintf(c1[k] * iv) & 0xffu) << (8 * k); }
            *(v2u*)(wl + P7_LQ + (sq * 32 + 2 * jq) * 4) = w;
            int sq8 = 0;
#pragma unroll
            for (int k = 0; k < 4; ++k) sq8 += (int)rintf(c0[k] * iv) + (int)rintf(c1[k] * iv);
            sumq8 = 8 * rowsum16i(sq8);
        }
        int acc[64];
#pragma unroll
        for (int i = 0; i < 64; ++i) acc[i] = 0;
        if (!(dry && (MK_DRY_SKIP & 2))) {
            int lane_v = F.lane; asm volatile("" : "+v"(lane_v));
            const int sv_ = lane_v >> 4, jv = lane_v & 15; const unsigned j16 = 16u * (unsigned)jv;
            const unsigned* LEOs = (const unsigned*)(wl + P7_LE) + sv_ * 128; const int* LQs = (const int*)(wl + P7_LQ) + sv_ * 32;
            const unsigned long long v8i = (unsigned long long)V8;
            v4u A[4][2], B[4][2], C[4][2];
#define P7_VLOAD(R, t) do { const v4u eo_ = *(const v4u*)(LEOs + 4 * (t)); \
            _Pragma("unroll") for (int r = 0; r < 4; ++r) { unsigned o_ = eo_[r] + j16; asm volatile("" : "+v"(o_)); \
                R[r][0] = *(const GV4*)(v8i + o_); R[r][1] = *(const GV4*)(v8i + o_ + 256); } \
            __builtin_amdgcn_sched_barrier(0); } while (0)
#define P7_SCOMP_V(R, t) do { const int cq_ = LQs[(t)]; \
                _Pragma("unroll") for (int i = 0; i < 2; ++i) { _Pragma("unroll") for (int w = 0; w < 4; ++w) { \
                    const unsigned x_ = __builtin_amdgcn_perm(R[1][i][w], R[0][i][w], 0x05010400u), y_ = __builtin_amdgcn_perm(R[1][i][w], R[0][i][w], 0x07030602u); \
                    const unsigned c_ = __builtin_amdgcn_perm(R[3][i][w], R[2][i][w], 0x05010400u), e_ = __builtin_amdgcn_perm(R[3][i][w], R[2][i][w], 0x07030602u); \
                    unsigned tb_[4]; tb_[0] = __builtin_amdgcn_perm(c_, x_, 0x05040100u); tb_[1] = __builtin_amdgcn_perm(c_, x_, 0x07060302u); tb_[2] = __builtin_amdgcn_perm(e_, y_, 0x05040100u); tb_[3] = __builtin_amdgcn_perm(e_, y_, 0x07060302u); \
                    _Pragma("unroll") for (int b = 0; b < 4; ++b) { \
                        acc[32 * i + 8 * w + 2 * b]     = __builtin_amdgcn_sdot4((int)(tb_[b] & 0x0f0f0f0fu), cq_, acc[32 * i + 8 * w + 2 * b], false); \
                        acc[32 * i + 8 * w + 2 * b + 1] = __builtin_amdgcn_sdot4((int)((tb_[b] >> 4) & 0x0f0f0f0fu), cq_, acc[32 * i + 8 * w + 2 * b + 1], false); } } } } while (0)
            P7_VLOAD(A, 0); P7_VLOAD(B, 1);
#pragma unroll 1
            for (int t = 0; t < 30; t += 3) {
                P7_VLOAD(C, t + 2); P7_SCOMP_V(A, t);
                P7_VLOAD(A, t + 3); P7_SCOMP_V(B, t + 1);
                P7_VLOAD(B, t + 4); P7_SCOMP_V(C, t + 2);
                asm volatile("" ::: "memory");
            }
            P7_SCOMP_V(A, 30); P7_SCOMP_V(B, 31);
#undef P7_SCOMP_V
#undef P7_VLOAD
        }
        {
            int lane_f = F.lane; asm volatile("" : "+v"(lane_f));
            const int sf = lane_f >> 4, jf = lane_f & 15; const int tok = tok0 + sf;
            const float* xrow = F.out + O_Y + (size_t)tok * DM + 32 * jf;
            const float* ga2 = mods + (size_t)mod_index(tok0) * MODW + 5 * DM + 32 * jf;
            const float* gf = F.in[I_GFINAL] + 32 * jf;
            float* yrow = dry ? (float*)(F.ws + WS_MIX) + (size_t)(tok & 8191) * DM + 32 * jf : F.out + O_Y + (size_t)tok * DM + 32 * jf;
            float xs[64]; float ss = 0.f;
#pragma unroll
            for (int i = 0; i < 2; ++i) {
#pragma unroll
                for (int hh_ = 0; hh_ < 2; ++hh_) { f32x4 xv[4], gv[4];
#pragma unroll
                    for (int q = 0; q < 4; ++q) { xv[q] = *(const f32x4*)(xrow + 512 * i + 16 * hh_ + 4 * q); gv[q] = *(const f32x4*)(ga2 + 512 * i + 16 * hh_ + 4 * q); }
#pragma unroll
                    for (int q = 0; q < 4; ++q)
#pragma unroll
                        for (int k = 0; k < 4; ++k) { const int ci = 32 * i + 16 * hh_ + 4 * q + k; const float t = xv[q][k] + gv[q][k] * ((float)(acc[ci] - sumq8) * cscale); xs[ci] = t; ss += t * t; }
                    asm volatile("" ::: "memory"); } }
            const float rstd = 1.f / sqrtf(rowsum16f(ss) * (1.f / DM) + EPS);
#pragma unroll
            for (int i = 0; i < 2; ++i) {
#pragma unroll
                for (int hh_ = 0; hh_ < 2; ++hh_) { f32x4 gfv[4];
#pragma unroll
                    for (int q = 0; q < 4; ++q) gfv[q] = *(const f32x4*)(gf + 512 * i + 16 * hh_ + 4 * q);
#pragma unroll
                    for (int q = 0; q < 4; ++q) { f32x4 o;
#pragma unroll
                        for (int k = 0; k < 4; ++k) o[k] = xs[32 * i + 16 * hh_ + 4 * q + k] * rstd * gfv[q][k];
                        *(f32x4*)(yrow + 512 * i + 16 * hh_ + 4 * q) = o; }
                    asm volatile("" ::: "memory"); } }
        }
    }
}

__global__ void __launch_bounds__(NWAVES * 64, 2) mk_fwd(Args args) {
    extern __shared__ __attribute__((aligned(16))) unsigned char lds[];
    Frame F;
    F.lds = lds;
    F.tid = threadIdx.x; F.lane = F.tid & 63; F.wave = __builtin_amdgcn_readfirstlane(F.tid >> 6);
    F.G = gridDim.x; { const int bx = blockIdx.x; F.vcu = (F.G % 8 == 0) ? (bx % 8) * (F.G / 8) + bx / 8 : bx; }
    F.in = args.in; F.out = args.out; F.ws = args.ws;
    LAS unsigned char* lds3 = (LAS unsigned char*)lds;
    volatile LAS unsigned* MISC = (volatile LAS unsigned*)(lds3 + MISC_OFF);
    for (int u = F.tid; u < (LDS_BYTES - LDSCTL_OFF) / 4; u += NWAVES * 64) ((LAS unsigned*)(lds3 + LDSCTL_OFF))[u] = 0u;
    __syncthreads();
    unsigned* ctl = (unsigned*)(args.ws + WS_CTL);
    XcdBarrier bar; bar.bar = ctl + CW_BAR; bar.x = 0; bar.st = nullptr;
    const bool one_launch = (args.ph_hi - args.ph_lo) > 1;
    if (one_launch) bar = xcd_barrier_post(ctl + CW_BAR, MISC + 8);
    const int lo = args.ph_lo, hi = args.ph_hi;
#ifndef MK_PHASE_MASK
#define MK_PHASE_MASK 0xff
#endif
#define IN(k) (((MK_PHASE_MASK >> (k)) & 1) && lo <= (k) && (k) < hi)
#define SEAM(k) do { if (IN(k) && IN((k) + 1)) xcd_barrier(bar); } while (0)

#define DUPQ(k) (MK_DUP == (k))
    if (IN(0)) { if (DUPQ(0)) { p0_phase(F); xcd_barrier(bar); } p0_phase(F); SEAM(0); }
    if (IN(1)) { if (DUPQ(1)) { norm_phase(F, 0); xcd_barrier(bar); } norm_phase(F, 0); bias_items(F); SEAM(1); }
    if (IN(2)) {
        pg8::Gemm g{(const pg8::bf16_t*)(F.ws + WS_H), (const pg8::bf16_t*)(F.ws + WS_WIN), NTOK, D_IN, DM}; pg8::StaticOrder S; S.init(NTOK, D_IN, F.G, (int)blockIdx.x);
        EpiInProj E{(bf16*)(F.ws + WS_Q), (bf16*)(F.ws + WS_K), (bf16*)(F.ws + WS_VT), (bf16*)(F.ws + WS_XR), (bf16*)(F.ws + WS_YG), F.out + O_NEWK, F.out + O_NEWV, (const f32x4*)(F.ws + WS_ROPE)};
        if (DUPQ(2)) { pg8::gemm_phase<EpiInProj, pg8::StaticOrder, true, true>(lds3, g, S, E); xcd_barrier(bar); }
        pg8::gemm_phase<EpiInProj, pg8::StaticOrder, true, true>(lds3, g, S, E);
        SEAM(2);
    }
    if (IN(3)) { if (DUPQ(3)) { p3_phase(F, MK_P3_TYPES); xcd_barrier(bar); } p3_phase(F); SEAM(3); }
    if (IN(4)) {
        pg8::Gemm g{(const pg8::bf16_t*)(F.ws + WS_MIX), (const pg8::bf16_t*)(F.ws + WS_WOUT), NTOK, DM, DM}; pg8::StaticOrder S; S.init(NTOK, DM, F.G, (int)blockIdx.x);
        EpiOutProj E{F.in[I_XP], F.in[I_XS], (const float*)(F.ws + WS_MODS), F.in[I_GFFN], F.out + O_Y, (bf16*)(F.ws + WS_H), (float*)(F.ws + WS_SSP)};
        if (DUPQ(4)) { pg8::gemm_phase<EpiOutProj, pg8::StaticOrder, true, true>(lds3, g, S, E); xcd_barrier(bar); }
        pg8::gemm_phase<EpiOutProj, pg8::StaticOrder, true, true>(lds3, g, S, E);
        SEAM(4);
    }
    if (IN(6)) {
        pg8::Gemm g{(const pg8::bf16_t*)(F.ws + WS_H), (const pg8::bf16_t*)(F.ws + WS_WC), NTOK, 2048, DM}; pg8::StaticOrder S; S.init(NTOK, 2048, F.G, (int)blockIdx.x);
        EpiScores E{(bf16*)(F.ws + WS_SC), (const float*)(F.ws + WS_SSP), (const float*)(F.ws + WS_BIAS)};
        if (DUPQ(6)) { pg8::gemm_phase<EpiScores, pg8::StaticOrder, true, true>(lds3, g, S, E); xcd_barrier(bar); }
        pg8::gemm_phase<EpiScores, pg8::StaticOrder, true, true>(lds3, g, S, E);
        SEAM(6);
    }
    if (IN(7)) { if (DUPQ(7)) { p7_phase(F, true); xcd_barrier(bar); } p7_phase(F, false); }
#undef IN
#undef SEAM
}

extern "C" void kernel_launch(void* const* d_in, const int* in_sizes, int n_in, void* d_out, int out_size, void* d_ws, size_t ws_size, hipStream_t stream) {
    static int grid = 0;
    if (grid == 0) {
        if (n_in != 26 || ws_size < WS_END) { fprintf(stderr, "kernel_launch: unexpected n_in %d / ws %zu\n", n_in, ws_size); grid = -1; return; }
        int dev = 0, cus = 0, per_cu = 0;
        if (hipGetDevice(&dev) != hipSuccess || hipDeviceGetAttribute(&cus, hipDeviceAttributeMultiprocessorCount, dev) != hipSuccess) { grid = -1; return; }
        if (hipFuncSetAttribute((const void*)mk_fwd, hipFuncAttributeMaxDynamicSharedMemorySize, LDS_BYTES) != hipSuccess) { fprintf(stderr, "kernel_launch: hipFuncSetAttribute failed\n"); grid = -1; return; }
        if (hipOccupancyMaxActiveBlocksPerMultiprocessor(&per_cu, (const void*)mk_fwd, NWAVES * 64, LDS_BYTES) != hipSuccess || per_cu < 1)
            fprintf(stderr, "kernel_launch: occupancy query reports %d blocks per CU\n", per_cu);
        (void)hipGetLastError();
        grid = cus;
        if (grid != 256) fprintf(stderr, "kernel_launch: note: %d CUs\n", grid);
    }
    if (grid < 0) return;
    (void)hipMemsetAsync((char*)d_ws + WS_CTL, 0, CTL_ZERO_BYTES, stream);
    Args a{};
    for (int i = 0; i < 26; ++i) a.in[i] = (const float*)d_in[i];
    a.out = (float*)d_out; a.ws = (unsigned char*)d_ws;
    if (MK_N_LAUNCHES == 1) {
        a.ph_lo = 0; a.ph_hi = N_PHASES; a.li = 0;
        hipLaunchKernelGGL(mk_fwd, dim3(grid), dim3(NWAVES * 64), LDS_BYTES, stream, a);
    } else {
        for (int li = 0; li < N_PHASES; ++li) { a.ph_lo = li; a.ph_hi = li + 1; a.li = li;
            hipLaunchKernelGGL(mk_fwd, dim3(grid), dim3(NWAVES * 64), LDS_BYTES, stream, a); }
    }
}
```

```cpp
#include <hip/hip_runtime.h>
#include <cstdio>
#include <cstdint>

#ifndef MK_DUP
#define MK_DUP -1
#endif
#ifndef MK_DRY_SKIP
#define MK_DRY_SKIP 0
#endif
#ifndef MK_N_LAUNCHES
#define MK_N_LAUNCHES 1
#endif

namespace pg8 {
#define PG8_LAS __attribute__((address_space(3)))
typedef unsigned short bf16_t;
typedef short bf16x8 __attribute__((ext_vector_type(8)));
typedef float f32x4 __attribute__((ext_vector_type(4)));
typedef unsigned u32x4 __attribute__((ext_vector_type(4)));
typedef unsigned u32x2 __attribute__((ext_vector_type(2)));
constexpr int BM = 256, BK = 64, HALF = 128, HTB = HALF * BK * 2, STAGE_BYTES = 8 * HTB, NXCD = 8, WGM = 8;

__host__ __device__ __forceinline__ int lds_byte(int r, int c) { const int st = (r >> 4) * 2 + (c >> 5), rr = r & 15, cc = c & 31, ob = rr * 64 + cc * 2; return st * 1024 + (ob ^ (((ob >> 9) & 1) << 5)); }
__host__ __device__ __forceinline__ void stage_rc(int b, int& R, int& C) { const int st = b / 1024, sb = b % 1024, swz = sb ^ (((sb >> 9) & 1) << 5); R = (st >> 1) * 16 + swz / 64; C = (st & 1) * 32 + (swz % 64) / 2; }
__host__ __device__ __forceinline__ int perm32(int rho) { const int n = rho >> 4, i = rho & 15; return 8 * (i >> 2) + 4 * n + (i & 3); }

struct Unit { int pm, pn; };
struct Gemm { const bf16_t* A; const bf16_t* Bt; int M, N, K; };

struct StaticOrder {
    int nM, nN, nwg, G, c;
    __host__ __device__ void init(int M, int N, int G_, int c_) { nM = M / BM; nN = N / BM; nwg = nM * nN; G = G_; c = c_; }
    __host__ __device__ bool next(int i, Unit& u) const {
        const long L = (long)i * G + c; if (L >= nwg) return false;
        int wgid = (int)L; { const int q = nwg / NXCD, r = nwg % NXCD, xcd = wgid % NXCD, off = wgid / NXCD; wgid = (xcd < r ? xcd * (q + 1) : r * (q + 1) + (xcd - r) * q) + off; }
        const int nig = WGM * nN, gid = wgid / nig, fm = gid * WGM, gsz = (nM - fm) < WGM ? (nM - fm) : WGM;
        u.pm = fm + ((wgid % nig) % gsz); u.pn = (wgid % nig) / gsz; return true;
    }
    __device__ __forceinline__ void a_ready(const Unit&) const {}
    __device__ __forceinline__ void done(const Unit&) const {}
};

__device__ __forceinline__ unsigned cvt_pk_bf16(float lo, float hi) { unsigned r; asm volatile("v_cvt_pk_bf16_f32 %0, %1, %2" : "=v"(r) : "v"(lo), "v"(hi)); return r; }

template <class Epi, class Sched, bool ALIGN_EPI = false, bool SP2 = false>
__device__ __forceinline__ void gemm_phase(PG8_LAS unsigned char* lds, const Gemm g, const Sched& S, const Epi& E) {
    const int tid = threadIdx.x, wid = __builtin_amdgcn_readfirstlane(tid >> 6), lane = tid & 63, wr = wid >> 2, wc = wid & 3, fr = lane & 15, fq = lane >> 4;
    const int K = g.K, nt = K / BK;
    unsigned voffA[2], voffB[2];
#pragma unroll
    for (int i = 0; i < 2; ++i) { int R, C; stage_rc(tid * 16 + i * 8192, R, C); const int Rb = Epi::PERM ? ((R & ~31) + perm32(R & 31)) : R;
        voffA[i] = (unsigned)(R * K + C) * 2u; voffB[i] = (unsigned)(Rb * K + C) * 2u; }
    const size_t kstep = (size_t)(BK * 2);
    const size_t hstep = (size_t)HALF * K * 2;
    const size_t tstep = 2 * hstep;
    const unsigned ldsw = (unsigned)wid * 1024u;
    const int aoff = lds_byte(wr * 64 + fr, fq * 8), boff = lds_byte(wc * 32 + fr, fq * 8);
#define PG8_SA(b, h) (((b) * 2 + (h)) * HTB)
#define PG8_SB(b, h) ((4 + (b) * 2 + (h)) * HTB)
#define PG8_STAGE(bufoff, gbase, voff) do { _Pragma("unroll") for (int _i = 0; _i < 2; ++_i) \
        __builtin_amdgcn_global_load_lds((const unsigned*)((const char*)(gbase) + (voff)[_i]), (PG8_LAS unsigned*)(lds + (bufoff) + ldsw + _i * 8192), 16, 0, 0); } while (0)
#define PG8_LDA(dst, b, h) do { _Pragma("unroll") for (int m = 0; m < 4; ++m) _Pragma("unroll") for (int k = 0; k < 2; ++k) dst[m][k] = *(const PG8_LAS bf16x8*)(lds + PG8_SA(b, h) + aoff + m * 2048 + k * 1024); } while (0)
#define PG8_LDB(dst, b, h) do { _Pragma("unroll") for (int n = 0; n < 2; ++n) _Pragma("unroll") for (int k = 0; k < 2; ++k) dst[n][k] = *(const PG8_LAS bf16x8*)(lds + PG8_SB(b, h) + boff + n * 2048 + k * 1024); } while (0)
#define PG8_MMA(ai, bj, At, Bt) do { __builtin_amdgcn_s_setprio(1); _Pragma("unroll") for (int m = 0; m < 4; ++m) _Pragma("unroll") for (int n = 0; n < 2; ++n) _Pragma("unroll") for (int k = 0; k < 2; ++k) \
        acc[ai][bj][m][n] = __builtin_amdgcn_mfma_f32_16x16x32_bf16(Bt[n][k], At[m][k], acc[ai][bj][m][n], 0, 0, 0); __builtin_amdgcn_s_setprio(0); } while (0)
#define PG8_WAIT_V(n) asm volatile("s_waitcnt vmcnt(" #n ")" ::: "memory")
#define PG8_WAIT_L(n) asm volatile("s_waitcnt lgkmcnt(" #n ")" ::: "memory")
#define PG8_BAR __builtin_amdgcn_s_barrier()
#define PG8_SCHED __builtin_amdgcn_sched_barrier(0)
    Unit cur, nxt; int ui = 0;
    if (!S.next(0, cur)) return;
    f32x4 acc[2][2][4][2];
#pragma unroll
    for (int a = 0; a < 2; ++a)
#pragma unroll
        for (int b = 0; b < 2; ++b)
#pragma unroll
            for (int m = 0; m < 4; ++m)
#pragma unroll
                for (int n = 0; n < 2; ++n) acc[a][b][m][n] = (f32x4){0.f, 0.f, 0.f, 0.f};
    bf16x8 At[4][2], B0[2][2], B1[2][2];
    const char* cA = (const char*)g.A + (size_t)cur.pm * tstep; const char* cB = (const char*)g.Bt + (size_t)cur.pn * tstep;
    S.a_ready(cur);
    if constexpr (SP2) {
        PG8_STAGE(PG8_SB(0, 0), cB, voffB); PG8_STAGE(PG8_SB(0, 1), cB + hstep, voffB); PG8_STAGE(PG8_SA(0, 0), cA, voffA); PG8_STAGE(PG8_SA(0, 1), cA + hstep, voffA);
        if (wr == 1) PG8_BAR;
        PG8_WAIT_V(2); PG8_BAR;
        PG8_STAGE(PG8_SB(1, 0), cB + kstep, voffB); PG8_STAGE(PG8_SA(1, 0), cA + kstep, voffA); PG8_STAGE(PG8_SB(1, 1), cB + hstep + kstep, voffB);
        PG8_WAIT_V(6); PG8_BAR;
    } else {
        PG8_STAGE(PG8_SB(0, 0), cB, voffB); PG8_STAGE(PG8_SA(0, 0), cA, voffA); PG8_STAGE(PG8_SB(0, 1), cB + hstep, voffB); PG8_STAGE(PG8_SA(0, 1), cA + hstep, voffA);
        if (wr == 1) PG8_BAR;
        PG8_WAIT_V(4); PG8_BAR;
        PG8_STAGE(PG8_SB(1, 0), cB + kstep, voffB); PG8_STAGE(PG8_SA(1, 0), cA + kstep, voffA); PG8_STAGE(PG8_SB(1, 1), cB + hstep + kstep, voffB);
        PG8_WAIT_V(6); PG8_BAR;
    }
    for (;;) {
        const bool has_next = S.next(ui + 1, nxt);
        const char* nA = has_next ? (const char*)g.A + (size_t)nxt.pm * tstep : cA; const char* nB = has_next ? (const char*)g.Bt + (size_t)nxt.pn * tstep : cB;
        for (int t = 0; t < nt; t += 2) {
            const bool last = (t == nt - 2);
            const char* a1 = cA + (size_t)(t + 1) * kstep;
            const char* a2 = last ? nA : cA + (size_t)(t + 2) * kstep; const char* b2 = last ? nB : cB + (size_t)(t + 2) * kstep;
            const char* a3 = a2 + kstep; const char* b3 = b2 + kstep;
            if (last && has_next) S.a_ready(nxt);
            if constexpr (SP2) {
            PG8_LDB(B0, 0, 0); PG8_LDB(B1, 0, 1); PG8_SCHED; PG8_LDA(At, 0, 0); PG8_STAGE(PG8_SA(1, 1), a1 + hstep, voffA);
            PG8_WAIT_V(8); PG8_WAIT_L(0); PG8_BAR; PG8_MMA(0, 0, At, B0); PG8_MMA(0, 1, At, B1); PG8_BAR; PG8_SCHED;
            PG8_LDA(At, 0, 1); PG8_STAGE(PG8_SB(0, 0), b2, voffB); PG8_STAGE(PG8_SB(0, 1), b2 + hstep, voffB); PG8_STAGE(PG8_SA(0, 0), a2, voffA);
            PG8_WAIT_V(8); PG8_WAIT_L(0); PG8_BAR; PG8_MMA(1, 0, At, B0); PG8_MMA(1, 1, At, B1); PG8_BAR; PG8_SCHED;
            PG8_LDB(B0, 1, 0); PG8_LDB(B1, 1, 1); PG8_SCHED; PG8_LDA(At, 1, 0); PG8_STAGE(PG8_SA(0, 1), a2 + hstep, voffA);
            PG8_WAIT_V(8); PG8_WAIT_L(0); PG8_BAR; PG8_MMA(0, 0, At, B0); PG8_MMA(0, 1, At, B1); PG8_BAR; PG8_SCHED;
            PG8_LDA(At, 1, 1); PG8_STAGE(PG8_SB(1, 0), b3, voffB); PG8_STAGE(PG8_SB(1, 1), b3 + hstep, voffB); PG8_STAGE(PG8_SA(1, 0), a3, voffA);
            PG8_WAIT_V(8); PG8_WAIT_L(0); PG8_BAR; PG8_MMA(1, 0, At, B0); PG8_MMA(1, 1, At, B1); PG8_BAR; PG8_SCHED;
            } else {
            PG8_LDB(B0, 0, 0); PG8_SCHED; PG8_LDA(At, 0, 0); PG8_STAGE(PG8_SA(1, 1), a1 + hstep, voffA);
            PG8_WAIT_L(8); PG8_BAR; PG8_WAIT_L(0); PG8_MMA(0, 0, At, B0); PG8_BAR; PG8_SCHED;
            PG8_LDB(B1, 0, 1); PG8_STAGE(PG8_SB(0, 0), b2, voffB);
            PG8_BAR; PG8_WAIT_L(0); PG8_MMA(0, 1, At, B1); PG8_BAR;
            PG8_LDA(At, 0, 1); PG8_STAGE(PG8_SA(0, 0), a2, voffA);
            PG8_BAR; PG8_WAIT_L(0); PG8_MMA(1, 0, At, B0); PG8_BAR; PG8_SCHED;
            PG8_STAGE(PG8_SB(0, 1), b2 + hstep, voffB);
            PG8_WAIT_V(6); PG8_BAR; PG8_MMA(1, 1, At, B1); PG8_BAR;
            PG8_LDB(B0, 1, 0); PG8_SCHED; PG8_LDA(At, 1, 0); PG8_STAGE(PG8_SA(0, 1), a2 + hstep, voffA);
            PG8_WAIT_L(8); PG8_BAR; PG8_WAIT_L(0); PG8_MMA(0, 0, At, B0); PG8_BAR; PG8_SCHED;
            PG8_LDB(B1, 1, 1); PG8_STAGE(PG8_SB(1, 0), b3, voffB);
            PG8_BAR; PG8_WAIT_L(0); PG8_MMA(0, 1, At, B1); PG8_BAR;
            PG8_LDA(At, 1, 1); PG8_STAGE(PG8_SA(1, 0), a3, voffA);
            PG8_BAR; PG8_WAIT_L(0); PG8_MMA(1, 0, At, B0); PG8_BAR; PG8_SCHED;
            PG8_STAGE(PG8_SB(1, 1), b3 + hstep, voffB);
            PG8_WAIT_V(6); PG8_BAR; PG8_MMA(1, 1, At, B1); PG8_BAR;
            }
        }
        if constexpr (ALIGN_EPI) { if (wr == 0) PG8_BAR; }
        E(acc, cur, wr, wc, fr, fq); S.done(cur);
        if (!has_next) break;
#pragma unroll
        for (int a = 0; a < 2; ++a)
#pragma unroll
            for (int b = 0; b < 2; ++b)
#pragma unroll
                for (int m = 0; m < 4; ++m)
#pragma unroll
                    for (int n = 0; n < 2; ++n) acc[a][b][m][n] = (f32x4){0.f, 0.f, 0.f, 0.f};
        cur = nxt; cA = nA; cB = nB; ++ui;
        if constexpr (ALIGN_EPI) { if (wr == 1) PG8_BAR; }
    }
    PG8_WAIT_V(0);
    if constexpr (!ALIGN_EPI) { if (wr == 0) PG8_BAR; }
    PG8_BAR;
#undef PG8_SA
#undef PG8_SB
#undef PG8_STAGE
#undef PG8_LDA
#undef PG8_LDB
#undef PG8_MMA
#undef PG8_WAIT_V
#undef PG8_WAIT_L
#undef PG8_BAR
#undef PG8_SCHED
}
}

constexpr int NWAVES = 8;
constexpr int DM = 1024, NTOK = 16384, NCTX = 8192, D_IN = 1792, NMODV = 9, MODW = 6144;
constexpr int SEQ_C = 256, SEQ_L = 1024, NSEQ_C = 32, NSEQ_L = 8;
constexpr int N_PHASES = 8;
constexpr float LOG2E = 1.4426950408889634f;
constexpr float QSCALE = 0.125f * LOG2E;
constexpr float EPS = 1e-6f;

constexpr size_t MiB = 1u << 20, KiB = 1u << 10;
constexpr size_t WS_CTL = 0, CTL_ZERO_BYTES = 64 * KiB;
constexpr size_t WS_MODS = 1 * MiB;
constexpr size_t WS_ROPE = 1 * MiB + 256 * KiB;
constexpr size_t WS_RGW  = 1 * MiB + 512 * KiB;
constexpr size_t WS_CK   = 1 * MiB + 768 * KiB;
constexpr size_t WS_CVT  = 2 * MiB + 256 * KiB;
constexpr size_t WS_WIN  = 3 * MiB;
constexpr size_t WS_WOUT = 7 * MiB;
constexpr size_t WS_WC   = 9 * MiB;
constexpr size_t WS_U    = 16 * MiB;
constexpr size_t WS_SSP  = 14 * MiB;
constexpr size_t WS_BIAS = 15 * MiB;
constexpr size_t WS_SU   = 13 * MiB;
constexpr size_t WS_SV   = 13 * MiB + 64 * KiB;
constexpr size_t WS_V    = 48 * MiB;
constexpr size_t WS_H    = 80 * MiB;
constexpr size_t WS_MIX  = 112 * MiB;
constexpr size_t WS_Q    = 144 * MiB;
constexpr size_t WS_K    = 160 * MiB;
constexpr size_t WS_VT   = 164 * MiB;
constexpr size_t WS_XR   = 168 * MiB;
constexpr size_t WS_YG   = 184 * MiB;
constexpr size_t WS_HF   = 200 * MiB;
constexpr size_t WS_SC   = 144 * MiB;
constexpr size_t WS_END  = 232 * MiB;
constexpr int VT_LAT_OFF = NSEQ_C * 2 * 64 * SEQ_C;

constexpr int CW_BAR = 4096;

constexpr int RING_BYTES = 131072;
constexpr int LDSCTL_OFF = 146944, MISC_OFF = LDSCTL_OFF + 320;
constexpr int LDS_BYTES = 147456;

#define GAS __attribute__((address_space(1)))
#define LAS __attribute__((address_space(3)))
typedef unsigned short bf16;
typedef unsigned v4u __attribute__((ext_vector_type(4)));
typedef unsigned v2u __attribute__((ext_vector_type(2)));
typedef float f32x4 __attribute__((ext_vector_type(4)));
typedef float f32x2 __attribute__((ext_vector_type(2)));
typedef float f32x16 __attribute__((ext_vector_type(16)));
typedef short bf16x8 __attribute__((ext_vector_type(8)));
typedef GAS unsigned gu32;
#define RLX_AGENT __ATOMIC_RELAXED, __HIP_MEMORY_SCOPE_AGENT

__device__ __forceinline__ unsigned f2bf(float f) { unsigned u = __builtin_bit_cast(unsigned, f); return (u + 0x7fffu + ((u >> 16) & 1u)) >> 16; }
typedef float f32x2_t_ __attribute__((ext_vector_type(2))); typedef __bf16 bf16x2_t_ __attribute__((ext_vector_type(2)));
__device__ __forceinline__ unsigned pk2(float lo, float hi) { f32x2_t_ v = {lo, hi}; bf16x2_t_ b = __builtin_convertvector(v, bf16x2_t_); return __builtin_bit_cast(unsigned, b); }
__device__ __forceinline__ float bf2f(unsigned b) { return __builtin_bit_cast(float, b << 16); }
__device__ __forceinline__ float bflo(unsigned w) { return __builtin_bit_cast(float, w << 16); }
__device__ __forceinline__ float bfhi(unsigned w) { return __builtin_bit_cast(float, w & 0xffff0000u); }
__device__ __forceinline__ float sigmoidf_(float x) { return 1.f / (1.f + __expf(-x)); }
__device__ __forceinline__ float gelu_tanh(float x) { const float y = 0.7978845608028654f * (x + 0.044715f * x * x * x); const float e = __expf(2.f * y); return 0.5f * x * (2.f - 2.f / (1.f + e)); }
template <int CTRL> __device__ __forceinline__ float dppf_(float v) { return __builtin_bit_cast(float, __builtin_amdgcn_update_dpp(0, __builtin_bit_cast(int, v), CTRL, 0xf, 0xf, true)); }
__device__ __forceinline__ float xrow16_(float v) {
    unsigned a = __builtin_bit_cast(unsigned, v), b = a; asm volatile("" : "+v"(b));
    const auto r = __builtin_amdgcn_permlane16_swap(a, b, false, false);
    const bool odd = (threadIdx.x & 16) != 0; return __builtin_bit_cast(float, odd ? r[0] : r[1]);
}
__device__ __forceinline__ float xhalf32_(float v) {
    unsigned a = __builtin_bit_cast(unsigned, v), b = a; asm volatile("" : "+v"(b));
    const auto r = __builtin_amdgcn_permlane32_swap(a, b, false, false);
    const bool hi = (threadIdx.x & 32) != 0; return __builtin_bit_cast(float, hi ? r[0] : r[1]);
}
__device__ __forceinline__ float wave_sum(float v) {
    v += dppf_<0xB1>(v); v += dppf_<0x4E>(v); v += dppf_<0x141>(v); v += dppf_<0x140>(v);
    v += xrow16_(v); v += xhalf32_(v); return v;
}
__device__ __forceinline__ float wave_max(float v) {
    v = fmaxf(v, dppf_<0xB1>(v)); v = fmaxf(v, dppf_<0x4E>(v)); v = fmaxf(v, dppf_<0x141>(v)); v = fmaxf(v, dppf_<0x140>(v));
    v = fmaxf(v, xrow16_(v)); v = fmaxf(v, xhalf32_(v)); return v;
}
__device__ __forceinline__ int crow(int r, int hi) { return (r & 3) + 8 * (r >> 2) + 4 * hi; }

#define XB_TMO      128
#define XB_XCNT(j)  (256  + 64 * (j))
#define XB_XSUB(j)  (1280 + 64 * (j))
#define XB_XGEN(j)  (2304 + 64 * (j))
#define XB_TOP      3328
#define XB_TOPGEN   3392
#define XCD_BAR_WORDS 3456
#define XB_SPIN_CAP (1u << 18)
__device__ __forceinline__ unsigned xb_ld(unsigned* p)              { return __hip_atomic_load(p, __ATOMIC_RELAXED, __HIP_MEMORY_SCOPE_AGENT); }
__device__ __forceinline__ unsigned xb_add(unsigned* p, unsigned v) { return __hip_atomic_fetch_add(p, v, __ATOMIC_RELAXED, __HIP_MEMORY_SCOPE_AGENT); }
__device__ __forceinline__ unsigned xb_xcc_id() { return (unsigned)__builtin_amdgcn_s_getreg((3 << 11) | 20) & 0xFu; }
#define XB_SPIN(cond, bar) do { unsigned _sp = 0; while (cond) { __builtin_amdgcn_s_sleep(1); \
    if ((++_sp & 255u) == 0u) { if (xb_ld(&(bar)[XB_TMO])) break; if (_sp > XB_SPIN_CAP) { atomicAdd(&(bar)[XB_TMO], 1u); break; } } } } while (0)
struct XcdBarrier { unsigned* bar; unsigned x; volatile LAS unsigned* st; };
__device__ __forceinline__ XcdBarrier xcd_barrier_post(unsigned* bar, volatile LAS unsigned* st) {
    XcdBarrier b; b.bar = bar; b.x = xb_xcc_id(); b.st = st;
    if (threadIdx.x == 0) (void)xb_add(&bar[XB_XCNT(b.x)], 1u);
    return b;
}
__device__ __forceinline__ void xcd_barrier_complete(unsigned* bar, unsigned x, unsigned& nloc, unsigned& nx) {
    const unsigned G = gridDim.x * gridDim.y * gridDim.z;
    unsigned sum, cnt, mine, sp = 0u;
    for (;;) {
        sum = 0u; cnt = 0u; mine = 0u;
#pragma unroll
        for (unsigned j = 0; j < 16; ++j) { const unsigned c = xb_ld(&bar[XB_XCNT(j)]); sum += c; cnt += (c > 0u) ? 1u : 0u; mine = (j == x) ? c : mine; }
        if (sum == G) break;
        __builtin_amdgcn_s_sleep(1);
        if ((++sp & 255u) == 0u) { if (xb_ld(&bar[XB_TMO])) break; if (sp > XB_SPIN_CAP) { atomicAdd(&bar[XB_TMO], 1u); break; } }
    }
    nloc = mine > 0u ? mine : 1u; nx = cnt > 0u ? cnt : 1u;
}
__device__ __forceinline__ void xcd_barrier(const XcdBarrier& b) {
    asm volatile("s_waitcnt vmcnt(0)" ::: "memory");
    __syncthreads();
    if (threadIdx.x == 0) {
        unsigned* bar = b.bar;
        __builtin_amdgcn_s_waitcnt(0);
        unsigned nloc = b.st[0], nx = b.st[1];
        if (nloc == 0u) { xcd_barrier_complete(bar, b.x, nloc, nx); b.st[0] = nloc; b.st[1] = nx; }
        const unsigned old = xb_add(&bar[XB_XSUB(b.x)], 1u);
        const unsigned gen = old / nloc;
        if (old + 1u == (gen + 1u) * nloc) {
            __builtin_amdgcn_fence(__ATOMIC_RELEASE, "agent");
            asm volatile("s_waitcnt vmcnt(0)" ::: "memory");
            const unsigned og = xb_add(&bar[XB_TOP], 1u);
            const unsigned tg = og / nx;
            if (og + 1u == (tg + 1u) * nx) xb_add(&bar[XB_TOPGEN], 1u);
            else XB_SPIN(xb_ld(&bar[XB_TOPGEN]) == tg, bar);
            __builtin_amdgcn_fence(__ATOMIC_ACQUIRE, "agent");
            xb_add(&bar[XB_XGEN(b.x)], 1u);
            asm volatile("s_waitcnt vmcnt(0)" ::: "memory");
        } else {
            XB_SPIN(xb_ld(&bar[XB_XGEN(b.x)]) == gen, bar);
            __builtin_amdgcn_fence(__ATOMIC_ACQUIRE, "agent");
            asm volatile("s_waitcnt vmcnt(0)" ::: "memory");
        }
    }
    __syncthreads();
}

struct Args { const float* in[26]; float* out; unsigned char* ws; int ph_lo, ph_hi, li, pad; };

struct Frame {
    unsigned char* lds;
    int tid, lane, wave, vcu, G;
    const float* const* in;
    float* out; unsigned char* ws;
};
enum { I_XP = 0, I_XS, I_CK, I_CV, I_SRNN, I_C, I_CCTX, I_WMOD, I_BMOD, I_GMIX, I_GFFN, I_WIN, I_CONVW, I_CONVB, I_RGWA, I_RGBA, I_RGWI, I_RGBI, I_RGLAM, I_SINK, I_WOUT, I_PWQ, I_PSK, I_PU, I_PV, I_GFINAL };
constexpr size_t O_Y = 0, O_NEWK = (size_t)NTOK * DM, O_NEWV = O_NEWK + (size_t)NCTX * 128, O_NEWRNN = O_NEWV + (size_t)NCTX * 128;

__device__ __forceinline__ int mod_index(int tok) { return tok < NCTX ? 0 : 1 + ((tok - NCTX) >> 10); }
__device__ __forceinline__ const float* x_row(const Frame& F, int tok) { return tok < NCTX ? F.in[I_XP] + (size_t)tok * DM : F.in[I_XS] + (size_t)(tok - NCTX) * DM; }

template <class RowMap>
__device__ __forceinline__ void p0_transpose_item(const float* W, int K, int N, bf16* WT, float* scr, int item, int lane, RowMap rowmap, float scale = 1.f) {
    const int nblk = N / 32, kb = item / nblk, nb = item % nblk, k0 = 64 * kb, n0 = 32 * nb;
#pragma unroll 8
    for (int i = 0; i < 32; ++i) { const int kk = 2 * i + (lane >> 5); scr[kk * 33 + (lane & 31)] = W[(size_t)(k0 + kk) * N + n0 + (lane & 31)]; }
    __builtin_amdgcn_s_waitcnt(0xC07F); asm volatile("" ::: "memory");
    const int c = lane & 7;
#pragma unroll
    for (int j = 0; j < 4; ++j) { const int n = (lane >> 3) + 8 * j; const float* s = scr + (8 * c) * 33 + n;
        v4u o; o.x = pk2(s[0 * 33] * scale, s[1 * 33] * scale); o.y = pk2(s[2 * 33] * scale, s[3 * 33] * scale); o.z = pk2(s[4 * 33] * scale, s[5 * 33] * scale); o.w = pk2(s[6 * 33] * scale, s[7 * 33] * scale);
        *(v4u*)(WT + (size_t)rowmap(n0 + n) * K + k0 + 8 * c) = o; }
    __builtin_amdgcn_s_waitcnt(0xC07F); asm volatile("" ::: "memory");
}
struct MapId { __device__ __forceinline__ int operator()(int n) const { return n; } };
struct MapWin { __device__ __forceinline__ int operator()(int n) const { if (n >= 640) return n; const int hb = n & ~63, o = n & 63; return hb + ((o & 31) << 1) + (o >> 5); } };

__device__ __forceinline__ void p0_phase(Frame& F) {
    float* ldsf = (float*)F.lds;
    const int tid = F.tid, lane = F.lane, wave = F.wave, v = F.vcu;
    if (v < 192) {
        for (int i = tid; i < NMODV * DM; i += 512) { const int j = i >> 10, d = i & 1023; const float c = (j == 0) ? F.in[I_CCTX][d] : F.in[I_C][(j - 1) * DM + d]; ldsf[i] = c * sigmoidf_(c); }
        __syncthreads();
        const int e0 = 32 * v, c4 = tid & 7, kq = tid >> 3;
        float acc[NMODV][4];
#pragma unroll
        for (int j = 0; j < NMODV; ++j) { acc[j][0] = 0.f; acc[j][1] = 0.f; acc[j][2] = 0.f; acc[j][3] = 0.f; }
        const float* wm = F.in[I_WMOD] + e0 + 4 * c4;
#pragma unroll 4
        for (int kk = 0; kk < 16; ++kk) { const int k = kq * 16 + kk; const f32x4 w = *(const f32x4*)(wm + (size_t)k * MODW);
#pragma unroll
            for (int j = 0; j < NMODV; ++j) { const float s = ldsf[j * DM + k]; acc[j][0] += s * w[0]; acc[j][1] += s * w[1]; acc[j][2] += s * w[2]; acc[j][3] += s * w[3]; } }
#pragma unroll
        for (int j = 0; j < NMODV; ++j)
#pragma unroll
            for (int i = 0; i < 4; ++i) { float a = acc[j][i]; a += __shfl_xor(a, 8); a += __shfl_xor(a, 16); a += __shfl_xor(a, 32); acc[j][i] = a; }
        float* red = ldsf + NMODV * DM;
        if (lane < 8) {
#pragma unroll
            for (int j = 0; j < NMODV; ++j)
#pragma unroll
                for (int i = 0; i < 4; ++i) red[(wave * NMODV + j) * 32 + 4 * c4 + i] = acc[j][i];
        }
        __syncthreads();
        if (tid < NMODV * 32) { const int j = tid >> 5, col = tid & 31; float s = F.in[I_BMOD][e0 + col];
#pragma unroll
            for (int w = 0; w < 8; ++w) s += red[(w * NMODV + j) * 32 + col];
            ((float*)(F.ws + WS_MODS))[j * MODW + e0 + col] = s; }
        __syncthreads();
    }
    if (v < 256) {
        const int hh = v >> 4, dt = v & 15, d0 = 64 * dt;
        float* At = ldsf;
        float* Bkt = ldsf + 128 * 64;
        const float* wq = F.in[I_PWQ] + hh * 128;
        const float* sk = F.in[I_PSK] + (size_t)hh * 128 * 128;
#pragma unroll
        for (int i = 0; i < 4; ++i) { const int f = tid + 512 * i, d = f & 63, q4 = f >> 6; const f32x4 a = *(const f32x4*)(wq + (size_t)(d0 + d) * 2048 + 4 * q4);
            At[(4 * q4 + 0) * 64 + d] = a[0]; At[(4 * q4 + 1) * 64 + d] = a[1]; At[(4 * q4 + 2) * 64 + d] = a[2]; At[(4 * q4 + 3) * 64 + d] = a[3]; }
#pragma unroll
        for (int i = 0; i < 8; ++i) { const int f = tid + 512 * i, key = f & 127, q4 = f >> 7; const f32x4 b = *(const f32x4*)(sk + (size_t)key * 128 + 4 * q4);
            Bkt[(4 * q4 + 0) * 128 + key] = b[0]; Bkt[(4 * q4 + 1) * 128 + key] = b[1]; Bkt[(4 * q4 + 2) * 128 + key] = b[2]; Bkt[(4 * q4 + 3) * 128 + key] = b[3]; }
        __syncthreads();
        const int dg = tid & 15, kg = tid >> 4;
        float acc[4][4];
#pragma unroll
        for (int i = 0; i < 4; ++i)
#pragma unroll
            for (int j = 0; j < 4; ++j) acc[i][j] = 0.f;
#pragma unroll 4
        for (int q = 0; q < 128; ++q) { const f32x4 a = *(const f32x4*)(At + q * 64 + 4 * dg); const f32x4 b = *(const f32x4*)(Bkt + q * 128 + 4 * kg);
#pragma unroll
            for (int i = 0; i < 4; ++i)
#pragma unroll
                for (int j = 0; j < 4; ++j) acc[i][j] += a[i] * b[j]; }
        bf16* WcT = (bf16*)(F.ws + WS_WC);
#pragma unroll
        for (int j = 0; j < 4; ++j) { v2u o; o.x = pk2(acc[0][j], acc[1][j]); o.y = pk2(acc[2][j], acc[3][j]);
            *(v2u*)(WcT + (size_t)(hh * 128 + 4 * kg + j) * DM + d0 + 4 * dg) = o; }
        __syncthreads();
    }
    const int gw = v * NWAVES + wave, NGW = F.G * NWAVES;
    float* scr = ldsf + wave * 4096;
    {
        constexpr int I_IN = (DM / 64) * (D_IN / 32), I_OUT = (DM / 64) * (DM / 32), I_RG = 32 * 2;
        constexpr int NIT = I_IN + I_OUT + I_RG;
        for (int it = gw; it < NIT; it += NGW) {
            int r = it;
            if (r < I_IN) { p0_transpose_item(F.in[I_WIN], DM, D_IN, (bf16*)(F.ws + WS_WIN), scr, r, lane, MapWin()); continue; } r -= I_IN;
            if (r < I_OUT) { p0_transpose_item(F.in[I_WOUT], DM, DM, (bf16*)(F.ws + WS_WOUT), scr, r, lane, MapId()); continue; } r -= I_OUT;
            { const int mm = r >> 1, sub = r & 1, dir = mm >> 4, n = (mm >> 1) & 7, gate = mm & 1;
              const float* src = (gate ? F.in[I_RGWI] : F.in[I_RGWA]) + (size_t)(dir * 8 + n) * 4096;
              bf16* dst = (bf16*)(F.ws + WS_RGW) + (size_t)((dir * 8 + n) * 2 + gate) * 4096;
              p0_transpose_item(src, 64, 64, dst, scr, sub, lane, MapId(), -LOG2E); }
        }
    }
    for (int it0 = 4 * gw; it0 < 2 * 16384; it0 += 4 * NGW) {
        f32x4 a[4][4];
#pragma unroll
        for (int r = 0; r < 4; ++r) { const int it = it0 + r, tb = it >> 14, row = it & 16383;
            const float* src = (tb ? F.in[I_PV] : F.in[I_PU]) + (size_t)row * DM + 16 * lane;
#pragma unroll
            for (int j = 0; j < 4; ++j) a[r][j] = *(const f32x4*)(src + 4 * j); }
        float am[4];
#pragma unroll
        for (int r = 0; r < 4; ++r) { float m = 0.f;
#pragma unroll
            for (int j = 0; j < 4; ++j) m = fmaxf(m, fmaxf(fmaxf(fabsf(a[r][j][0]), fabsf(a[r][j][1])), fmaxf(fabsf(a[r][j][2]), fabsf(a[r][j][3]))));
            am[r] = m; }
#pragma unroll
        for (int r = 0; r < 4; ++r) am[r] = wave_max(am[r]);
#pragma unroll
        for (int r = 0; r < 4; ++r) { const int it = it0 + r, tb = it >> 14, row = it & 16383;
            if (tb) {
                const float inv = am[r] > 0.f ? 7.f / am[r] : 0.f;
                v2u o2;
#pragma unroll
                for (int h = 0; h < 2; ++h) { unsigned w = 0;
#pragma unroll
                    for (int c = 0; c < 8; ++c) { int q = (int)rintf(a[r][2 * h + (c >> 2)][c & 3] * inv); q = q > 7 ? 7 : (q < -7 ? -7 : q); w |= ((unsigned)((c & 1) ? q : q + 8) & 0xfu) << (4 * c); }
                    o2[h] = w; }
                *(v2u*)(F.ws + WS_V + (size_t)row * (DM / 2) + 8 * lane) = o2;
                if (lane == 0) ((float*)(F.ws + WS_SV))[row] = am[r] * (1.f / 7.f);
            } else {
                const float inv = am[r] > 0.f ? 7.f / am[r] : 0.f;
                v2u o2;
#pragma unroll
                for (int h = 0; h < 2; ++h) { unsigned w = 0;
#pragma unroll
                    for (int c = 0; c < 8; ++c) { int q = (int)rintf(a[r][2 * h + (c >> 2)][c & 3] * inv); q = q > 7 ? 7 : (q < -7 ? -7 : q); w |= ((unsigned)q & 0xfu) << (4 * c); }
                    o2[h] = w; }
                *(v2u*)(F.ws + WS_U + (size_t)row * (DM / 2) + 8 * lane) = o2;
                if (lane == 0) ((float*)(F.ws + WS_SU))[row] = am[r] * (1.f / 7.f);
            } }
    }
    const int gt = v * 512 + tid, NGT = F.G * 512;
    for (int e = gt; e < 8 * 256 * 128; e += NGT) {
        const int c = e & 127, bp = e >> 7, kvh = c >> 6, p = c & 63, old = (p & 1) ? 32 + (p >> 1) : (p >> 1);
        ((bf16*)(F.ws + WS_CK))[e] = (bf16)f2bf(F.in[I_CK][(size_t)bp * 128 + kvh * 64 + old]);
    }
    for (int e = gt; e < 8 * 256 * 128; e += NGT) {
        const int pos = e & 255, d = (e >> 8) & 63, kvh = (e >> 14) & 1, b = e >> 15;
        ((bf16*)(F.ws + WS_CVT))[e] = (bf16)f2bf(F.in[I_CV][(size_t)(b * 256 + pos) * 128 + kvh * 64 + d]);
    }
    for (int e = gt; e < 1024 * 32; e += NGT) {
        const int s = e >> 5, i = e & 31, row = s >> 6, col = s & 63;
        const float inv = powf(10000.0f, -(float)(i & 15) / 16.0f);
        const float ang = (i < 16 ? (float)row : (float)col) * inv;
        f32x2 cs; cs.x = cosf(ang); cs.y = sinf(ang);
        ((f32x2*)(F.ws + WS_ROPE))[e] = cs;
    }
}

__device__ __forceinline__ void bias_items(Frame& F) {
    const int gw = F.vcu * NWAVES + F.wave, NGW = F.G * NWAVES, lane = F.lane;
    const float* mods = (const float*)(F.ws + WS_MODS); const bf16* WcT = (const bf16*)(F.ws + WS_WC); float* BIAS = (float*)(F.ws + WS_BIAS);
    for (int n = gw; n < 2048; n += NGW) {
        const v4u a = *(const v4u*)(WcT + (size_t)n * DM + 16 * lane), b = *(const v4u*)(WcT + (size_t)n * DM + 16 * lane + 8);
        float w[16];
        w[0] = bflo(a.x); w[1] = bfhi(a.x); w[2] = bflo(a.y); w[3] = bfhi(a.y); w[4] = bflo(a.z); w[5] = bfhi(a.z); w[6] = bflo(a.w); w[7] = bfhi(a.w);
        w[8] = bflo(b.x); w[9] = bfhi(b.x); w[10] = bflo(b.y); w[11] = bfhi(b.y); w[12] = bflo(b.z); w[13] = bfhi(b.z); w[14] = bflo(b.w); w[15] = bfhi(b.w);
#pragma unroll 1
        for (int j = 0; j < NMODV; ++j) { const float* sh = mods + (size_t)j * MODW + 3 * DM + 16 * lane; float d = 0.f;
#pragma unroll
            for (int q = 0; q < 4; ++q) { const f32x4 v = *(const f32x4*)(sh + 4 * q); d += v[0] * w[4 * q] + v[1] * w[4 * q + 1] + v[2] * w[4 * q + 2] + v[3] * w[4 * q + 3]; }
            d = wave_sum(d); if (lane == 0) BIAS[j * 2048 + n] = d; }
    }
}
__device__ __forceinline__ void norm_phase(Frame& F, int which) {
    const int gw = F.vcu * NWAVES + F.wave, NGW = F.G * NWAVES, lane = F.lane;
    const float* mods = (const float*)(F.ws + WS_MODS);
    const float* g = F.in[which ? I_GFFN : I_GMIX];
    bf16* H = (bf16*)(F.ws + WS_H);
    for (int tok = gw; tok < NTOK; tok += NGW) {
        const float* xr = which ? F.out + O_Y + (size_t)tok * DM : x_row(F, tok);
        const float* mv = mods + (size_t)mod_index(tok) * MODW + (which ? 3 * DM : 0);
        f32x4 v[4]; float ss = 0.f;
#pragma unroll
        for (int j = 0; j < 4; ++j) { v[j] = *(const f32x4*)(xr + 256 * j + 4 * lane); ss += (v[j][0] * v[j][0] + v[j][1] * v[j][1]) + (v[j][2] * v[j][2] + v[j][3] * v[j][3]); }
        const float rstd = 1.f / sqrtf(wave_sum(ss) * (1.f / DM) + EPS);
#pragma unroll
        for (int j = 0; j < 4; ++j) { const int e = 256 * j + 4 * lane;
            const f32x4 gg = *(const f32x4*)(g + e), sh = *(const f32x4*)(mv + e), sc = *(const f32x4*)(mv + DM + e);
            f32x4 o;
#pragma unroll
            for (int i = 0; i < 4; ++i) o[i] = v[j][i] * rstd * gg[i] * (1.f + sc[i]) + sh[i];
            v2u w; w.x = pk2(o[0], o[1]); w.y = pk2(o[2], o[3]); *(v2u*)(H + (size_t)tok * DM + e) = w; }
    }
}

struct EpiInProj {
    static constexpr bool PERM = true;
    bf16 *q, *k, *vT, *xr, *yg; float *newk, *newv; const f32x4* rope4;
    __device__ __forceinline__ void operator()(const f32x4 (&acc)[2][2][4][2], const pg8::Unit& u, int wr, int wc, int fr, int fq) const {
        const bool lat = u.pm >= 32;
        const int pn = u.pn;
#pragma unroll
        for (int ai = 0; ai < 2; ++ai)
#pragma unroll
            for (int m = 0; m < 4; ++m) {
                const int row = u.pm * 256 + ai * 128 + wr * 64 + m * 16 + fr;
                const int pos = lat ? ((row - NCTX) & 1023) : (row & 255);
#pragma unroll
                for (int bj = 0; bj < 2; ++bj) {
                    const int c = pn * 256 + bj * 128 + wc * 32 + 8 * fq;
                    f32x4 v0 = acc[ai][bj][m][0], v1 = acc[ai][bj][m][1];
                    if (pn < 2 || (pn == 2 && bj == 0)) {
                        const int i = (c & 63) >> 1;
                        if (lat) { const f32x4 cs0 = rope4[(pos * 32 + i) >> 1], cs1 = rope4[((pos * 32 + i) >> 1) + 1];
                            const float a0 = v0[0] * cs0[0] - v0[1] * cs0[1], a1 = v0[1] * cs0[0] + v0[0] * cs0[1];
                            const float b0 = v0[2] * cs0[2] - v0[3] * cs0[3], b1 = v0[3] * cs0[2] + v0[2] * cs0[3];
                            const float c0 = v1[0] * cs1[0] - v1[1] * cs1[1], c1 = v1[1] * cs1[0] + v1[0] * cs1[1];
                            const float d0 = v1[2] * cs1[2] - v1[3] * cs1[3], d1 = v1[3] * cs1[2] + v1[2] * cs1[3];
                            v0[0] = a0; v0[1] = a1; v0[2] = b0; v0[3] = b1; v1[0] = c0; v1[1] = c1; v1[2] = d0; v1[3] = d1; }
                        if (pn < 2) { v4u w; w.x = pk2(v0[0] * QSCALE, v0[1] * QSCALE); w.y = pk2(v0[2] * QSCALE, v0[3] * QSCALE); w.z = pk2(v1[0] * QSCALE, v1[1] * QSCALE); w.w = pk2(v1[2] * QSCALE, v1[3] * QSCALE);
                            *(v4u*)(q + (size_t)row * 512 + c) = w; }
                        else { const int kc = c - 512; v4u w; w.x = pk2(v0[0], v0[1]); w.y = pk2(v0[2], v0[3]); w.z = pk2(v1[0], v1[1]); w.w = pk2(v1[2], v1[3]); *(v4u*)(k + (size_t)row * 128 + kc) = w;
                            if (!lat) { float* nk = newk + (size_t)row * 128 + (kc & 64) + i; f32x4 lo; lo[0] = v0[0]; lo[1] = v0[2]; lo[2] = v1[0]; lo[3] = v1[2]; f32x4 hi; hi[0] = v0[1]; hi[1] = v0[3]; hi[2] = v1[1]; hi[3] = v1[3];
                                *(f32x4*)nk = lo; *(f32x4*)(nk + 32) = hi; } }
                    } else if (pn == 2) {
                        const int vc = c - 640, kvh = vc >> 6, d = vc & 63;
                        if (!lat) { *(f32x4*)(newv + (size_t)row * 128 + vc) = v0; *(f32x4*)(newv + (size_t)row * 128 + vc + 4) = v1; }
                        bf16* vp; int S;
                        if (!lat) { S = SEQ_C; vp = vT + ((size_t)((row >> 8) * 2 + kvh) * 64 + d) * SEQ_C + pos; }
                        else { S = SEQ_L; vp = vT + VT_LAT_OFF + ((size_t)(((row - NCTX) >> 10) * 2 + kvh) * 64 + d) * SEQ_L + pos; }
                        vp[0] = (bf16)f2bf(v0[0]); vp[S] = (bf16)f2bf(v0[1]); vp[2 * S] = (bf16)f2bf(v0[2]); vp[3 * S] = (bf16)f2bf(v0[3]);
                        vp[4 * S] = (bf16)f2bf(v1[0]); vp[5 * S] = (bf16)f2bf(v1[1]); vp[6 * S] = (bf16)f2bf(v1[2]); vp[7 * S] = (bf16)f2bf(v1[3]);
                    } else {
                        v4u w; w.x = pk2(v0[0], v0[1]); w.y = pk2(v0[2], v0[3]); w.z = pk2(v1[0], v1[1]); w.w = pk2(v1[2], v1[3]);
                        if (pn < 5) *(v4u*)(xr + (size_t)row * 512 + (c - 768)) = w; else *(v4u*)(yg + (size_t)row * 512 + (c - 1280)) = w;
                    }
                }
            }
    }
};
struct EpiOutProj {
    static constexpr bool PERM = true;
    const float *xp, *xs, *mods, *gffn; float* x1; bf16* ap; float* ssp;
    __device__ __forceinline__ void operator()(const f32x4 (&acc)[2][2][4][2], const pg8::Unit& u, int wr, int wc, int fr, int fq) const {
        const int mi = u.pm < 32 ? 0 : 1 + ((u.pm - 32) >> 2);
        const float* mv = mods + (size_t)mi * MODW;
        const int row0 = u.pm * 256 + wr * 64 + fr;
        const float* xbase = (u.pm < 32 ? xp : xs - (size_t)NCTX * DM) + (size_t)row0 * DM;
        float ssq[2][4];
#pragma unroll
        for (int ai = 0; ai < 2; ++ai)
#pragma unroll
            for (int m = 0; m < 4; ++m) ssq[ai][m] = 0.f;
#pragma unroll
        for (int bj = 0; bj < 2; ++bj) {
            const int c = u.pn * 256 + bj * 128 + wc * 32 + 8 * fq;
            const f32x4 gv0 = *(const f32x4*)(mv + 2 * DM + c), gv1 = *(const f32x4*)(mv + 2 * DM + c + 4);
            const f32x4 g20 = *(const f32x4*)(gffn + c) * (1.f + *(const f32x4*)(mv + 4 * DM + c)), g21 = *(const f32x4*)(gffn + c + 4) * (1.f + *(const f32x4*)(mv + 4 * DM + c + 4));
#pragma unroll
            for (int h4 = 0; h4 < 4; ++h4) {
                const int ai = h4 >> 1;
                f32x4 xv[2][2];
#pragma unroll
                for (int mm = 0; mm < 2; ++mm) { const float* xr = xbase + (size_t)(ai * 128 + (2 * (h4 & 1) + mm) * 16) * DM + c; xv[mm][0] = *(const f32x4*)xr; xv[mm][1] = *(const f32x4*)(xr + 4); }
                asm volatile("" ::: "memory");
#pragma unroll
                for (int mm = 0; mm < 2; ++mm) {
                    const int m = 2 * (h4 & 1) + mm;
                    const size_t off = (size_t)(row0 + ai * 128 + m * 16) * DM + c;
                    const f32x4 o0 = xv[mm][0] + gv0 * acc[ai][bj][m][0], o1 = xv[mm][1] + gv1 * acc[ai][bj][m][1];
                    *(f32x4*)(x1 + off) = o0; *(f32x4*)(x1 + off + 4) = o1;
                    ssq[ai][m] += ((o0[0] * o0[0] + o0[1] * o0[1]) + (o0[2] * o0[2] + o0[3] * o0[3])) + ((o1[0] * o1[0] + o1[1] * o1[1]) + (o1[2] * o1[2] + o1[3] * o1[3]));
                    const f32x4 t0 = o0 * g20, t1 = o1 * g21; v4u w; w.x = pk2(t0[0], t0[1]); w.y = pk2(t0[2], t0[3]); w.z = pk2(t1[0], t1[1]); w.w = pk2(t1[2], t1[3]);
                    *(v4u*)(ap + off) = w;
                }
                asm volatile("" ::: "memory");
            }
        }
#pragma unroll
        for (int ai = 0; ai < 2; ++ai)
#pragma unroll
            for (int m = 0; m < 4; ++m) { float v = ssq[ai][m]; v += __shfl_xor(v, 16); v += __shfl_xor(v, 32);
                if (fq == 0) ssp[(size_t)(row0 + ai * 128 + m * 16) * 16 + u.pn * 4 + wc] = v; }
    }
};
struct EpiScores {
    static constexpr bool PERM = true;
    bf16* sc; const float* ssp; const float* bias;
    __device__ __forceinline__ void operator()(const f32x4 (&acc)[2][2][4][2], const pg8::Unit& u, int wr, int wc, int fr, int fq) const {
        const int mi = u.pm < 32 ? 0 : 1 + ((u.pm - 32) >> 2);
        const int row0 = u.pm * 256 + wr * 64 + fr;
        f32x4 b0[2], b1[2];
#pragma unroll
        for (int bj = 0; bj < 2; ++bj) { const int c = u.pn * 256 + bj * 128 + wc * 32 + 8 * fq; b0[bj] = *(const f32x4*)(bias + (size_t)mi * 2048 + c); b1[bj] = *(const f32x4*)(bias + (size_t)mi * 2048 + c + 4); }
#pragma unroll
        for (int h2 = 0; h2 < 4; ++h2) {
            const int ai = h2 >> 1;
            f32x4 sp[2][4];
#pragma unroll
            for (int mm = 0; mm < 2; ++mm)
#pragma unroll
                for (int q = 0; q < 4; ++q) sp[mm][q] = *((const f32x4*)(ssp + (size_t)(row0 + ai * 128 + (2 * (h2 & 1) + mm) * 16) * 16) + q);
            asm volatile("" ::: "memory");
#pragma unroll
            for (int mm = 0; mm < 2; ++mm) {
                const int m = 2 * (h2 & 1) + mm;
                const int row = row0 + ai * 128 + m * 16;
                const float ss = ((sp[mm][0][0] + sp[mm][0][1]) + (sp[mm][0][2] + sp[mm][0][3])) + ((sp[mm][1][0] + sp[mm][1][1]) + (sp[mm][1][2] + sp[mm][1][3]))
                               + ((sp[mm][2][0] + sp[mm][2][1]) + (sp[mm][2][2] + sp[mm][2][3])) + ((sp[mm][3][0] + sp[mm][3][1]) + (sp[mm][3][2] + sp[mm][3][3]));
                const float rstd = 1.f / sqrtf(ss * (1.f / DM) + EPS);
#pragma unroll
                for (int bj = 0; bj < 2; ++bj) {
                    const int c = u.pn * 256 + bj * 128 + wc * 32 + 8 * fq;
                    const f32x4 v0 = acc[ai][bj][m][0] * rstd + b0[bj], v1 = acc[ai][bj][m][1] * rstd + b1[bj];
                    v4u w; w.x = pk2(v0[0], v0[1]); w.y = pk2(v0[2], v0[3]); w.z = pk2(v1[0], v1[1]); w.w = pk2(v1[2], v1[3]);
                    *(v4u*)(sc + (size_t)row * 2048 + c) = w;
                }
            }
            asm volatile("" ::: "memory");
        }
    }
};

__device__ __forceinline__ void attn_unit(Frame& F, bool lat, int seq, int kvh, int qt) {
    const int tid = F.tid, lane = F.lane, wave = F.wave, r32 = lane & 31, hi = lane >> 5;
    const int g = wave >> 1, qs = wave & 1, head = kvh * 4 + g;
    const int S = lat ? SEQ_L : SEQ_C, tokbase = lat ? NCTX + seq * SEQ_L : seq * SEQ_C;
    const int q0 = qt * 64, qpos = q0 + 32 * qs + r32;
    const bf16* Q = (const bf16*)(F.ws + WS_Q); const bf16* Kb = (const bf16*)(F.ws + WS_K); const bf16* VT = (const bf16*)(F.ws + WS_VT);
    const bf16* CK = (const bf16*)(F.ws + WS_CK); const bf16* CVT = (const bf16*)(F.ws + WS_CVT);
    unsigned char* ldsK = F.lds; unsigned char* ldsV = F.lds + 8192;
    bf16x8 qf[4];
    { const bf16* qp = Q + (size_t)(tokbase + qpos) * 512 + head * 64;
#pragma unroll
      for (int ks = 0; ks < 4; ++ks) qf[ks] = *(const bf16x8*)(qp + 16 * ks + 8 * hi); }
    const float sinkl = F.in[I_SINK][head] * LOG2E;
    float mrun = sinkl, lrun = (hi == 0) ? 1.f : 0.f;
    f32x16 o0, o1;
#pragma unroll
    for (int r = 0; r < 16; ++r) { o0[r] = 0.f; o1[r] = 0.f; }
    int tlo, thi;
    if (lat) { tlo = (q0 >= 128 ? q0 - 128 : 0) >> 6; thi = ((q0 + 192 < S ? q0 + 192 : S)) >> 6; } else { tlo = 0; thi = 4; }
    const int nband = thi - tlo, ntile = nband + (lat ? 4 : 0);
    const int key_t = tid >> 3, ch_t = tid & 7;
    v4u kv, vv;
#define AT_LOAD(t_) do { const int tt_ = (t_); const bf16* kptr; const bf16* vptr; int vstride; \
        if (tt_ < nband) { const int kb_ = (tlo + tt_) * 64; kptr = Kb + (size_t)(tokbase + kb_) * 128 + kvh * 64; \
            vptr = VT + (lat ? (size_t)VT_LAT_OFF + (size_t)((seq * 2 + kvh) * 64) * SEQ_L : (size_t)((seq * 2 + kvh) * 64) * SEQ_C) + kb_; vstride = S; } \
        else { const int tc = tt_ - nband; kptr = CK + (size_t)(seq * 256 + tc * 64) * 128 + kvh * 64; vptr = CVT + (size_t)((seq * 2 + kvh) * 64) * 256 + tc * 64; vstride = 256; } \
        kv = *(const v4u*)(kptr + (size_t)key_t * 128 + ch_t * 8); vv = *(const v4u*)(vptr + (size_t)key_t * vstride + ch_t * 8); } while (0)
    AT_LOAD(0);
    for (int t = 0; t < ntile; ++t) {
        const bool band = t < nband;
        const int kbase = band ? (tlo + t) * 64 : 0;
        __syncthreads();
        *(v4u*)(ldsK + key_t * 128 + ((ch_t ^ (key_t & 7)) * 16)) = kv;
        *(v4u*)(ldsV + key_t * 128 + ((ch_t ^ (key_t & 7)) * 16)) = vv;
        __syncthreads();
        f32x16 p0, p1;
#pragma unroll
        for (int r = 0; r < 16; ++r) { p0[r] = 0.f; p1[r] = 0.f; }
#pragma unroll
        for (int ks = 0; ks < 4; ++ks) {
            const int sw = ((2 * ks + hi) ^ (r32 & 7)) * 16;
            const bf16x8 a0 = *(const bf16x8*)(ldsK + r32 * 128 + sw);
            const bf16x8 a1 = *(const bf16x8*)(ldsK + (32 + r32) * 128 + sw);
            p0 = __builtin_amdgcn_mfma_f32_32x32x16_bf16(a0, qf[ks], p0, 0, 0, 0);
            p1 = __builtin_amdgcn_mfma_f32_32x32x16_bf16(a1, qf[ks], p1, 0, 0, 0);
        }
        if (t + 1 < ntile) AT_LOAD(t + 1);
        if (band && lat && (kbase < q0 + 63 - 128 || kbase + 63 > q0 + 128)) {
#pragma unroll
            for (int r = 0; r < 16; ++r) { const int kp = kbase + crow(r, hi); int d0 = qpos - kp; d0 = d0 < 0 ? -d0 : d0; int d1 = qpos - kp - 32; d1 = d1 < 0 ? -d1 : d1;
                if (d0 > 128) p0[r] = -INFINITY; if (d1 > 128) p1[r] = -INFINITY; }
        }
        float tm = p0[0];
#pragma unroll
        for (int r = 1; r < 16; ++r) tm = fmaxf(tm, p0[r]);
#pragma unroll
        for (int r = 0; r < 16; ++r) tm = fmaxf(tm, p1[r]);
        tm = fmaxf(tm, __shfl_xor(tm, 32));
        const float mn = fmaxf(mrun, tm), alpha = __builtin_amdgcn_exp2f(mrun - mn); mrun = mn;
        float ls = 0.f;
#pragma unroll
        for (int r = 0; r < 16; ++r) { p0[r] = __builtin_amdgcn_exp2f(p0[r] - mn); p1[r] = __builtin_amdgcn_exp2f(p1[r] - mn); ls += p0[r] + p1[r]; o0[r] *= alpha; o1[r] *= alpha; }
        lrun = lrun * alpha + ls;
        bf16x8 pf[4];
#pragma unroll
        for (int s = 0; s < 2; ++s) {
            v4u w0, w1;
            w0.x = pk2(p0[8 * s + 0], p0[8 * s + 1]); w0.y = pk2(p0[8 * s + 2], p0[8 * s + 3]); w0.z = pk2(p0[8 * s + 4], p0[8 * s + 5]); w0.w = pk2(p0[8 * s + 6], p0[8 * s + 7]);
            w1.x = pk2(p1[8 * s + 0], p1[8 * s + 1]); w1.y = pk2(p1[8 * s + 2], p1[8 * s + 3]); w1.z = pk2(p1[8 * s + 4], p1[8 * s + 5]); w1.w = pk2(p1[8 * s + 6], p1[8 * s + 7]);
            pf[s] = __builtin_bit_cast(bf16x8, w0); pf[2 + s] = __builtin_bit_cast(bf16x8, w1);
        }
#pragma unroll
        for (int s4 = 0; s4 < 4; ++s4) {
#pragma unroll
            for (int dt = 0; dt < 2; ++dt) {
                const int d = 32 * dt + r32;
                const v2u lo = *(const v2u*)(ldsV + d * 128 + (((2 * s4) ^ (d & 7)) * 16) + 8 * hi);
                const v2u hi2 = *(const v2u*)(ldsV + d * 128 + (((2 * s4 + 1) ^ (d & 7)) * 16) + 8 * hi);
                v4u vf4; vf4.x = lo.x; vf4.y = lo.y; vf4.z = hi2.x; vf4.w = hi2.y;
                const bf16x8 vf = __builtin_bit_cast(bf16x8, vf4);
                if (dt == 0) o0 = __builtin_amdgcn_mfma_f32_32x32x16_bf16(vf, pf[s4], o0, 0, 0, 0);
                else o1 = __builtin_amdgcn_mfma_f32_32x32x16_bf16(vf, pf[s4], o1, 0, 0, 0);
            }
        }
    }
    const float ltot = lrun + __shfl_xor(lrun, 32), inv = 1.f / ltot;
    bf16* mix = (bf16*)(F.ws + WS_MIX) + (size_t)(tokbase + qpos) * DM + head * 64;
#pragma unroll
    for (int g4 = 0; g4 < 4; ++g4) {
        v2u w; w.x = pk2(o0[4 * g4] * inv, o0[4 * g4 + 1] * inv); w.y = pk2(o0[4 * g4 + 2] * inv, o0[4 * g4 + 3] * inv);
        *(v2u*)(mix + 8 * g4 + 4 * hi) = w;
        v2u w2; w2.x = pk2(o1[4 * g4] * inv, o1[4 * g4 + 1] * inv); w2.y = pk2(o1[4 * g4 + 2] * inv, o1[4 * g4 + 3] * inv);
        *(v2u*)(mix + 32 + 8 * g4 + 4 * hi) = w2;
    }
    __syncthreads();
}

constexpr int RL_HALF = 49152;
constexpr int RL_XCB = 32768;
constexpr int RL_AGG = 98304;
constexpr int RL_CARRY = RL_AGG + 8192;
constexpr int RL_CW = RL_CARRY + 512;
constexpr int RL_WG = RL_CW + 1280;
static_assert(RL_WG + 32768 <= LDSCTL_OFF, "RNN LDS map");
__device__ __forceinline__ float fsigmoid(float x) { return __builtin_amdgcn_rcpf(1.f + __expf(-x)); }
__device__ __forceinline__ float gelu_fast(float x) { const float y = 0.7978845608028654f * (x + 0.044715f * x * x * x); const float e = __expf(2.f * y); return x - x * __builtin_amdgcn_rcpf(1.f + e); }

template <bool REV>
__device__ __forceinline__ void scan_prep(const float (&a)[16], const float (&b)[16], int h, float (&Apre)[4], float (&Bpre)[4], float& At, float& Bt) {
    float Ao[4], Bo[4], Ap[4], Bp[4];
#pragma unroll
    for (int g = 0; g < 4; ++g) { float A = 1.f, B = 0.f;
#pragma unroll
        for (int ii = 0; ii < 4; ++ii) { const int r = 4 * g + (REV ? 3 - ii : ii); B = a[r] * B + b[r]; A = a[r] * A; }
        Ao[g] = A; Bo[g] = B; }
#pragma unroll
    for (int g = 0; g < 4; ++g) { Ap[g] = __shfl_xor(Ao[g], 32); Bp[g] = __shfl_xor(Bo[g], 32); }
    const bool ownfirst = REV ? (h == 1) : (h == 0);
    float Ac = 1.f, Bc = 0.f;
#pragma unroll
    for (int gi = 0; gi < 4; ++gi) { const int g = REV ? 3 - gi : gi;
        const float A1 = ownfirst ? Ao[g] : Ap[g], B1 = ownfirst ? Bo[g] : Bp[g], A2 = ownfirst ? Ap[g] : Ao[g], B2 = ownfirst ? Bp[g] : Bo[g];
        const float Ac1 = A1 * Ac, Bc1 = A1 * Bc + B1;
        Apre[g] = ownfirst ? Ac : Ac1; Bpre[g] = ownfirst ? Bc : Bc1;
        Ac = A2 * Ac1; Bc = A2 * Bc1 + B2; }
    At = Ac; Bt = Bc;
}
template <bool REV>
__device__ __forceinline__ void scan_finish(const float (&a)[16], const float (&b)[16], const float (&Apre)[4], const float (&Bpre)[4], float hin, float* hp, int hi) {
#pragma unroll
    for (int g = 0; g < 4; ++g) { float hc = Apre[g] * hin + Bpre[g];
#pragma unroll
        for (int ii = 0; ii < 4; ++ii) { const int r = 4 * g + (REV ? 3 - ii : ii); hc = a[r] * hc + b[r]; hp[(size_t)crow(r, hi) * 512] = hc; } }
}

template <bool REV>
__device__ __forceinline__ void rnn_dir(Frame& F, bool lat, int seq, int n) {
    const int lane = F.lane, w4 = F.wave & 3, r32 = lane & 31, hi = lane >> 5, dirh = REV ? 1 : 0;
    const int S = lat ? SEQ_L : SEQ_C, tokbase = lat ? NCTX + seq * SEQ_L : seq * SEQ_C, nchunk = S / 128;
    unsigned char* hb = F.lds + dirh * RL_HALF;
    float* XC32 = (float*)hb; unsigned char* XCB = hb + RL_XCB;
    f32x2* AGG = (f32x2*)(F.lds + RL_AGG) + dirh * 256; float* CARRY = (float*)(F.lds + RL_CARRY) + dirh * 64; const float* CW = (const float*)(F.lds + RL_CW);
    const unsigned char* WG = F.lds + RL_WG + dirh * 16384;
    const bf16* XR = (const bf16*)(F.ws + WS_XR) + (size_t)tokbase * 512 + n * 64;
    float* HX = (float*)(F.ws + (REV ? WS_H : WS_HF)) + (size_t)tokbase * 512 + n * 64;
    const int t = F.tid & 255, c8 = t & 7, tg = t >> 3;
    float ba[2], bi[2], sp8[2];
#pragma unroll
    for (int chh = 0; chh < 2; ++chh) { const int pe = dirh * 512 + n * 64 + chh * 32 + r32; ba[chh] = -LOG2E * F.in[I_RGBA][pe]; bi[chh] = -LOG2E * F.in[I_RGBI][pe];
        const float nl = -F.in[I_RGLAM][pe]; sp8[chh] = -8.f * LOG2E * (nl > 20.f ? nl : log1pf(__expf(nl))); }
    v4u xin[7];
#define RL_XLOAD(c0_) do { _Pragma("unroll") for (int i = 0; i < 7; ++i) { const int pos = (c0_) + 4 * tg - 2 + i; \
        xin[i] = (pos >= 0 && pos < S) ? *(const v4u*)(XR + (size_t)pos * 512 + 8 * c8) : (v4u){0u, 0u, 0u, 0u}; } } while (0)
    RL_XLOAD((REV ? nchunk - 1 : 0) * 128);
    float newcarry[2] = {0.f, 0.f};
    const bool last_tile = REV ? (w4 == 0) : (w4 == 3);
#pragma unroll 1
    for (int k = 0; k < nchunk; ++k) {
        const int c0 = (REV ? nchunk - 1 - k : k) * 128;
        {
            const f32x4 b0 = *(const f32x4*)(CW + 256 + 8 * c8), b1 = *(const f32x4*)(CW + 256 + 8 * c8 + 4);
            f32x4 wt0[4], wt1[4];
#pragma unroll
            for (int tap = 0; tap < 4; ++tap) { wt0[tap] = *(const f32x4*)(CW + tap * 64 + 8 * c8); wt1[tap] = *(const f32x4*)(CW + tap * 64 + 8 * c8 + 4); }
#pragma unroll
            for (int i = 0; i < 4; ++i) {
                f32x4 y0 = b0, y1 = b1;
#pragma unroll
                for (int tap = 0; tap < 4; ++tap) { const v4u x = xin[i + tap];
                    y0[0] += wt0[tap][0] * bflo(x.x); y0[1] += wt0[tap][1] * bfhi(x.x); y0[2] += wt0[tap][2] * bflo(x.y); y0[3] += wt0[tap][3] * bfhi(x.y);
                    y1[0] += wt1[tap][0] * bflo(x.z); y1[1] += wt1[tap][1] * bfhi(x.z); y1[2] += wt1[tap][2] * bflo(x.w); y1[3] += wt1[tap][3] * bfhi(x.w); }
                const int tk = 4 * tg + i;
                *(f32x4*)(XC32 + tk * 64 + 8 * c8) = y0; *(f32x4*)(XC32 + tk * 64 + 8 * c8 + 4) = y1;
                v4u w; w.x = pk2(y0[0], y0[1]); w.y = pk2(y0[2], y0[3]); w.z = pk2(y1[0], y1[1]); w.w = pk2(y1[2], y1[3]);
                *(v4u*)(XCB + tk * 128 + ((c8 ^ (tk & 7)) * 16)) = w; }
        }
        if (k + 1 < nchunk) RL_XLOAD((REV ? nchunk - 2 - k : k + 1) * 128);
        __syncthreads();
        if (k > 0 && last_tile && hi == 0) { CARRY[r32] = newcarry[0]; CARRY[32 + r32] = newcarry[1]; }
        const int tkA = 32 * w4 + r32;
#pragma unroll
        for (int chh = 0; chh < 2; ++chh) {
            const int che = chh * 32 + r32;
            float av[16], bv[16], Apre[4], Bpre[4];
            {
                f32x16 ga, gi;
#pragma unroll
                for (int r = 0; r < 16; ++r) { ga[r] = 0.f; gi[r] = 0.f; }
#pragma unroll
                for (int ks = 0; ks < 4; ++ks) {
                    const bf16x8 af = *(const bf16x8*)(XCB + tkA * 128 + (((2 * ks + hi) ^ (tkA & 7)) * 16));
                    const bf16x8 wa = *(const bf16x8*)(WG + che * 128 + (((2 * ks + hi) ^ (che & 7)) * 16));
                    const bf16x8 wi = *(const bf16x8*)(WG + 8192 + che * 128 + (((2 * ks + hi) ^ (che & 7)) * 16));
                    ga = __builtin_amdgcn_mfma_f32_32x32x16_bf16(af, wa, ga, 0, 0, 0);
                    gi = __builtin_amdgcn_mfma_f32_32x32x16_bf16(af, wi, gi, 0, 0, 0);
                }
#pragma unroll
                for (int r = 0; r < 16; ++r) { const int tk2 = 32 * w4 + crow(r, hi); const float x = XC32[tk2 * 64 + che];
                    const float rg = __builtin_amdgcn_rcpf(1.f + __builtin_amdgcn_exp2f(ga[r] + ba[chh])), ig = __builtin_amdgcn_rcpf(1.f + __builtin_amdgcn_exp2f(gi[r] + bi[chh])), a = __builtin_amdgcn_exp2f(rg * sp8[chh]);
                    av[r] = a; bv[r] = __builtin_amdgcn_sqrtf(fmaxf(1.f - a * a, 0.f)) * ig * x;
                    if ((r & 3) == 3) __builtin_amdgcn_sched_barrier(0); }
                float At, Bt;
                scan_prep<REV>(av, bv, hi, Apre, Bpre, At, Bt);
                if (hi == 0) { f32x2 ab; ab.x = At; ab.y = Bt; AGG[chh * 512 + w4 * 64 + che] = ab; }
            }
            __syncthreads();
            {
                float hin = CARRY[che];
                if (!REV) { for (int t2 = 0; t2 < w4; ++t2) { const f32x2 ab = AGG[chh * 512 + t2 * 64 + che]; hin = ab.x * hin + ab.y; } }
                else { for (int t2 = 3; t2 > w4; --t2) { const f32x2 ab = AGG[chh * 512 + t2 * 64 + che]; hin = ab.x * hin + ab.y; } }
                scan_finish<REV>(av, bv, Apre, Bpre, hin, HX + (size_t)(c0 + 32 * w4) * 512 + che, hi);
                if (last_tile) { const f32x2 ab = AGG[chh * 512 + w4 * 64 + che]; newcarry[chh] = ab.x * hin + ab.y; }
            }
        }
    }
#undef RL_XLOAD
    if (!lat && last_tile && hi == 0) { float* o = F.out + O_NEWRNN + (size_t)(seq * 2 + dirh) * 512 + n * 64; o[r32] = newcarry[0]; o[32 + r32] = newcarry[1]; }
}

__device__ __forceinline__ void rnn_unit(Frame& F, bool lat, int seq, int n) {
    const int tid = F.tid;
    const int S = lat ? SEQ_L : SEQ_C, tokbase = lat ? NCTX + seq * SEQ_L : seq * SEQ_C;
    __syncthreads();
    { float* CW = (float*)(F.lds + RL_CW); float* CARRY = (float*)(F.lds + RL_CARRY);
      if (tid < 320) CW[tid] = tid < 256 ? F.in[I_CONVW][(tid >> 6) * 512 + n * 64 + (tid & 63)] : F.in[I_CONVB][n * 64 + (tid - 256)];
      if (tid < 128) CARRY[tid] = lat ? F.in[I_SRNN][(size_t)(seq * 2 + (tid >> 6)) * 512 + n * 64 + (tid & 63)] : 0.f;
      const bf16* rgw = (const bf16*)(F.ws + WS_RGW);
#pragma unroll
      for (int i = 0; i < 4; ++i) { const int q = tid + 512 * i, ch = q & 7, d = (q >> 3) & 63, gate = (q >> 9) & 1, dir = q >> 10;
          const v4u w = *(const v4u*)(rgw + (size_t)((dir * 8 + n) * 2 + gate) * 4096 + d * 64 + ch * 8);
          *(v4u*)(F.lds + RL_WG + dir * 16384 + gate * 8192 + d * 128 + ((ch ^ (d & 7)) * 16)) = w; } }
    __syncthreads();
    if (F.wave < 4) rnn_dir<false>(F, lat, seq, n); else rnn_dir<true>(F, lat, seq, n);
    __syncthreads();
    { const int c4 = tid & 15, tk = tid >> 4;
      const float* HF = (const float*)(F.ws + WS_HF) + (size_t)tokbase * 512 + n * 64 + 4 * c4;
      const float* HB = (const float*)(F.ws + WS_H) + (size_t)tokbase * 512 + n * 64 + 4 * c4;
      const bf16* YG = (const bf16*)(F.ws + WS_YG) + (size_t)tokbase * 512 + n * 64 + 4 * c4;
      bf16* MIX = (bf16*)(F.ws + WS_MIX) + (size_t)tokbase * DM + 512 + n * 64 + 4 * c4;
      for (int t0 = tk; t0 < S; t0 += 32) {
          const f32x4 a = *(const f32x4*)(HF + (size_t)t0 * 512), b = *(const f32x4*)(HB + (size_t)t0 * 512); const v2u y = *(const v2u*)(YG + (size_t)t0 * 512);
          v2u o; o.x = pk2((a[0] + b[0]) * gelu_fast(bflo(y.x)), (a[1] + b[1]) * gelu_fast(bfhi(y.x))); o.y = pk2((a[2] + b[2]) * gelu_fast(bflo(y.y)), (a[3] + b[3]) * gelu_fast(bfhi(y.y)));
          *(v2u*)(MIX + (size_t)t0 * DM) = o; } }
    __syncthreads();
}

#ifndef MK_P3_TYPES
#define MK_P3_TYPES 15
#endif
__device__ __forceinline__ void p3_phase(Frame& F, int types = 15) {
    const int v = F.vcu;
#pragma unroll 1
    for (int i = 0; i < 832; ++i) {
        int type, idx;
        if (F.G == 256) {
            if (v < 64) { if (i > 0) break; type = 0; idx = v; }
            else { if (i >= 6) break; const int j = v - 64, sl = i >> 1, rep = i & 1; type = 1 + sl;
                const bool extra = sl == 0 ? (j < 64) : (sl == 1 ? (j >= 64 && j < 128) : (j >= 128));
                if (rep && !extra) continue; idx = rep ? 192 + (j - 64 * sl) : j; }
        } else { const int it = v + i * F.G; if (it >= 832) break;
            if (it < 64) { type = 0; idx = it; } else if (it < 320) { type = 1; idx = it - 64; } else if (it < 576) { type = 2; idx = it - 320; } else { type = 3; idx = it - 576; } }
        if (!((types >> type) & 1)) continue;
        const bool lat = type < 2;
        Frame L = F; asm volatile("" : "+v"(L.tid)); L.lane = L.tid & 63;
        asm volatile("" : "+s"(L.ws), "+s"(L.out));
        if ((type & 1) == 0) rnn_unit(L, lat, idx >> 3, idx & 7);
        else { if (lat) attn_unit(L, true, idx >> 5, (idx >> 4) & 1, idx & 15); else attn_unit(L, false, idx >> 3, (idx >> 2) & 1, idx & 3); }
    }
}

__device__ __forceinline__ unsigned key16(unsigned b, unsigned idx) { const unsigned s = (b & 0x8000u) ? (~b & 0xffffu) : (b | 0x8000u); return (s << 16) | idx; }
__device__ __forceinline__ float keyval16(unsigned k) { const unsigned s = k >> 16; const unsigned b = (s & 0x8000u) ? (s & 0x7fffu) : (~s & 0xffffu); return bf2f(b); }
__device__ __forceinline__ unsigned sortable32(float f) { const unsigned u = __builtin_bit_cast(unsigned, f); return (u & 0x80000000u) ? ~u : (u | 0x80000000u); }
template <int CTRL> __device__ __forceinline__ unsigned dppu(unsigned v) { return (unsigned)__builtin_amdgcn_update_dpp(0, (int)v, CTRL, 0xf, 0xf, true); }
template <int CTRL> __device__ __forceinline__ float dppf(float v) { return __builtin_bit_cast(float, __builtin_amdgcn_update_dpp(0, __builtin_bit_cast(int, v), CTRL, 0xf, 0xf, true)); }
__device__ __forceinline__ unsigned umax_(unsigned a, unsigned b) { return a > b ? a : b; }
__device__ __forceinline__ unsigned umin_(unsigned a, unsigned b) { return a < b ? a : b; }
__device__ __forceinline__ unsigned rowmax16u(unsigned x) { x = umax_(x, dppu<0xB1>(x)); x = umax_(x, dppu<0x4E>(x)); x = umax_(x, dppu<0x141>(x)); x = umax_(x, dppu<0x140>(x)); return x; }
__device__ __forceinline__ float rowmax16f(float x) { x = fmaxf(x, dppf<0xB1>(x)); x = fmaxf(x, dppf<0x4E>(x)); x = fmaxf(x, dppf<0x141>(x)); x = fmaxf(x, dppf<0x140>(x)); return x; }
__device__ __forceinline__ float rowsum16f(float x) { x += dppf<0xB1>(x); x += dppf<0x4E>(x); x += dppf<0x141>(x); x += dppf<0x140>(x); return x; }
__device__ __forceinline__ int rowsum16i(int x) { x += (int)dppu<0xB1>((unsigned)x); x += (int)dppu<0x4E>((unsigned)x); x += (int)dppu<0x141>((unsigned)x); x += (int)dppu<0x140>((unsigned)x); return x; }
#define CEX(a, b) do { const unsigned _h = umax_(a, b), _l = umin_(a, b); a = _h; b = _l; } while (0)

#ifndef P7_NCH
#define P7_NCH 8
#endif
constexpr int P7_CSH = (P7_NCH == 4 ? 12 : (P7_NCH == 8 ? 11 : (P7_NCH == 16 ? 10 : 9)));
constexpr int P7_WL = 16384;
constexpr int P7_TL = 0, P7_TE = 1024, P7_TG = 3072, P7_LE = 5120, P7_LG = 7168, P7_LSU = 9216, P7_LQ = 11264, P7_H2Q = 12160, P7_HST = 16256;
static_assert(P7_LQ + 512 <= P7_H2Q && (P7_H2Q % 16) == 0 && P7_HST + 16 <= P7_WL && P7_WL * 8 <= RING_BYTES, "P7 LDS map");

__device__ __forceinline__ float tkval(unsigned k) { return __builtin_bit_cast(float, k & 0xffff0000u); }
#define TKX(a, b) do { unsigned hi_, lo_; asm("v_max_f32 %0, %1, %2" : "=v"(hi_) : "v"(a), "v"(b)); asm("v_min_f32 %0, %1, %2" : "=v"(lo_) : "v"(a), "v"(b)); a = hi_; b = lo_; } while (0)
#define TK_SORT16(c) do { TKX(c[0], c[1]); TKX(c[2], c[3]); TKX(c[0], c[2]); TKX(c[1], c[3]); TKX(c[1], c[2]); TKX(c[4], c[5]); TKX(c[6], c[7]); TKX(c[4], c[6]); TKX(c[5], c[7]); TKX(c[5], c[6]); TKX(c[0], c[4]); TKX(c[2], c[6]); TKX(c[2], c[4]); TKX(c[1], c[5]); TKX(c[3], c[7]); TKX(c[3], c[5]); TKX(c[1], c[2]); TKX(c[3], c[4]); TKX(c[5], c[6]); TKX(c[8], c[9]); TKX(c[10], c[11]); TKX(c[8], c[10]); TKX(c[9], c[11]); TKX(c[9], c[10]); TKX(c[12], c[13]); TKX(c[14], c[15]); TKX(c[12], c[14]); TKX(c[13], c[15]); TKX(c[13], c[14]); TKX(c[8], c[12]); TKX(c[10], c[14]); TKX(c[10], c[12]); TKX(c[9], c[13]); TKX(c[11], c[15]); TKX(c[11], c[13]); TKX(c[9], c[10]); TKX(c[11], c[12]); TKX(c[13], c[14]); TKX(c[0], c[8]); TKX(c[4], c[12]); TKX(c[4], c[8]); TKX(c[2], c[10]); TKX(c[6], c[14]); TKX(c[6], c[10]); TKX(c[2], c[4]); TKX(c[6], c[8]); TKX(c[10], c[12]); TKX(c[1], c[9]); TKX(c[5], c[13]); TKX(c[5], c[9]); TKX(c[3], c[11]); TKX(c[7], c[15]); TKX(c[7], c[11]); TKX(c[3], c[5]); TKX(c[7], c[9]); TKX(c[11], c[13]); TKX(c[1], c[2]); TKX(c[3], c[4]); TKX(c[5], c[6]); TKX(c[7], c[8]); TKX(c[9], c[10]); TKX(c[11], c[12]); TKX(c[13], c[14]); } while (0)
#define TK_BITONIC16(c) do { TKX(c[0], c[8]); TKX(c[1], c[9]); TKX(c[2], c[10]); TKX(c[3], c[11]); TKX(c[4], c[12]); TKX(c[5], c[13]); TKX(c[6], c[14]); TKX(c[7], c[15]); TKX(c[0], c[4]); TKX(c[1], c[5]); TKX(c[2], c[6]); TKX(c[3], c[7]); TKX(c[8], c[12]); TKX(c[9], c[13]); TKX(c[10], c[14]); TKX(c[11], c[15]); TKX(c[0], c[2]); TKX(c[1], c[3]); TKX(c[4], c[6]); TKX(c[5], c[7]); TKX(c[8], c[10]); TKX(c[9], c[11]); TKX(c[12], c[14]); TKX(c[13], c[15]); TKX(c[0], c[1]); TKX(c[2], c[3]); TKX(c[4], c[5]); TKX(c[6], c[7]); TKX(c[8], c[9]); TKX(c[10], c[11]); TKX(c[12], c[13]); TKX(c[14], c[15]); } while (0)
__device__ __forceinline__ void topk_stage1(const bf16* SC, int tok0, int lane, unsigned* TL4) {
    const v4u* src = (const v4u*)(SC + (size_t)(tok0 + (lane >> 4)) * 2048 + (lane & 15) * 128);
    unsigned T[16];
#pragma unroll
    for (int ch = 0; ch < 8; ++ch) {
        const v4u r0 = src[2 * ch], r1 = src[2 * ch + 1];
        unsigned c[16];
#pragma unroll
        for (int m = 0; m < 4; ++m) { c[2 * m] = (r0[m] << 16) | (unsigned)(16 * ch + 2 * m); c[2 * m + 1] = (r0[m] & 0xffff0000u) | (unsigned)(16 * ch + 2 * m + 1);
                                      c[8 + 2 * m] = (r1[m] << 16) | (unsigned)(16 * ch + 8 + 2 * m); c[8 + 2 * m + 1] = (r1[m] & 0xffff0000u) | (unsigned)(16 * ch + 8 + 2 * m + 1); }
        TK_SORT16(c);
        if (ch == 0) {
#pragma unroll
            for (int i = 0; i < 16; ++i) T[i] = c[i];
        } else {
#pragma unroll
            for (int i = 0; i < 16; ++i) { unsigned m_; asm("v_max_f32 %0, %1, %2" : "=v"(m_) : "v"(T[i]), "v"(c[15 - i])); T[i] = m_; }
            TK_BITONIC16(T);
        }
    }
    v4u* dst = (v4u*)(TL4 + lane * 16);
#pragma unroll
    for (int q = 0; q < 4; ++q) { v4u o; o.x = T[4 * q]; o.y = T[4 * q + 1]; o.z = T[4 * q + 2]; o.w = T[4 * q + 3]; dst[q] = o; }
}
#define TK_POP4(C, KEEP, it) do { const unsigned m_ = rowmax16u(C[0]); const bool w_ = C[0] == m_; C[0] = w_ ? C[1] : C[0]; C[1] = w_ ? C[2] : C[1]; C[2] = w_ ? C[3] : C[2]; C[3] = w_ ? 0u : C[3]; KEEP = (k == (it)) ? m_ : KEEP; } while (0)
__device__ __forceinline__ void topk_stage2(const unsigned* TL, int lane, const unsigned ctabp, int* oute, float* outg) {
    const int k = lane & 15, row = lane >> 4;
    unsigned ca[4], cb[4];
    const unsigned* LAa = TL + (2 * row) * 16; const unsigned* LBa = TL + (2 * row + 1) * 16;
    const unsigned* LAb = TL + (2 * (4 + row)) * 16; const unsigned* LBb = TL + (2 * (4 + row) + 1) * 16;
#pragma unroll
    for (int s = 0; s < 4; ++s) { const int ij = (int)((ctabp >> (8 * s)) & 0xffu); const bool valid = ij != 255; const int i = (ij >> 4) & 15, j = ij & 15;
        const float sa = tkval(LAa[i]) + tkval(LBa[j]), sb = tkval(LAb[i]) + tkval(LBb[j]);
        ca[s] = valid ? ((sortable32(sa) & 0xffffff00u) | (unsigned)(i * 16 + j)) : 0u; cb[s] = valid ? ((sortable32(sb) & 0xffffff00u) | (unsigned)(i * 16 + j)) : 0u; }
    CEX(ca[0], ca[1]); CEX(ca[2], ca[3]); CEX(ca[0], ca[2]); CEX(ca[1], ca[3]); CEX(ca[1], ca[2]);
    CEX(cb[0], cb[1]); CEX(cb[2], cb[3]); CEX(cb[0], cb[2]); CEX(cb[1], cb[3]); CEX(cb[1], cb[2]);
    unsigned keepa = 0, keepb = 0;
#pragma unroll
    for (int it = 0; it < 16; ++it) { TK_POP4(ca, keepa, it); TK_POP4(cb, keepb, it); }
    {
        const unsigned kaa = LAa[(keepa >> 4) & 15], kba = LBa[keepa & 15], kab = LAb[(keepb >> 4) & 15], kbb = LBb[keepb & 15];
        const float bva = tkval(kaa) + tkval(kba), bvb = tkval(kab) + tkval(kbb);
        const float mxa = rowmax16f(bva), mxb = rowmax16f(bvb); const float exa = __expf(bva - mxa), exb = __expf(bvb - mxb); const float sma = rowsum16f(exa), smb = rowsum16f(exb);
        oute[lane] = (int)((kaa & 127u) * 128u + (kba & 127u)); outg[lane] = exa / sma;
        oute[64 + lane] = (int)((kab & 127u) * 128u + (kbb & 127u)); outg[64 + lane] = exb / smb;
    }
}
#undef TK_POP4

__device__ __forceinline__ void gl16x4(v4u (&r)[4], unsigned voff, const unsigned char* b0, const unsigned char* b1, const unsigned char* b2, const unsigned char* b3) {
    asm volatile("s_nop 4\n\tglobal_load_dwordx4 %0, %4, %5\n\tglobal_load_dwordx4 %1, %4, %6\n\tglobal_load_dwordx4 %2, %4, %7\n\tglobal_load_dwordx4 %3, %4, %8"
                 : "=&v"(r[0]), "=&v"(r[1]), "=&v"(r[2]), "=&v"(r[3]) : "v"(voff), "s"(b0), "s"(b1), "s"(b2), "s"(b3) : "memory");
}
#define P7_VMWAIT(N, R) asm volatile("s_waitcnt vmcnt(" #N ")" : "+v"(R[0]), "+v"(R[1]), "+v"(R[2]), "+v"(R[3]) :: "memory")
__device__ __forceinline__ int mbcnt64(unsigned long long m) { return (int)__builtin_amdgcn_mbcnt_hi((unsigned)(m >> 32), __builtin_amdgcn_mbcnt_lo((unsigned)m, 0u)); }
__device__ __forceinline__ int rfl(int v) { return __builtin_amdgcn_readfirstlane(v); }
__device__ __forceinline__ float rflf(float v) { return __builtin_bit_cast(float, __builtin_amdgcn_readfirstlane(__builtin_bit_cast(int, v))); }

__device__ __forceinline__ void p7_phase(Frame& F, bool dry) {
    const int lane0 = F.lane, wave = F.wave;
    if (dry && (MK_DRY_SKIP & 16) && wave >= 4) return;
    unsigned char* wl = F.lds + wave * P7_WL;
    int* TE = (int*)(wl + P7_TE); float* TG = (float*)(wl + P7_TG);
    float* LG = (float*)(wl + P7_LG); float* LSU = (float*)(wl + P7_LSU); unsigned char* H2Q = wl + P7_H2Q; float* HST = (float*)(wl + P7_HST);
    const bf16* SC = (const bf16*)(F.ws + WS_SC); const bf16* H2 = (const bf16*)(F.ws + WS_H);
    const unsigned char* U8 = F.ws + WS_U; const unsigned char* V8 = F.ws + WS_V;
    const float* SU = (const float*)(F.ws + WS_SU); const float* SV = (const float*)(F.ws + WS_SV);
    const float* mods = (const float*)(F.ws + WS_MODS); const float* SSP = (const float*)(F.ws + WS_SSP);
    unsigned ctabp = 0;
#pragma unroll
    for (int s = 0; s < 4; ++s) { const int c = 16 * s + (lane0 & 15); int i, j;
        if (c < 16) { i = 0; j = c; } else if (c < 24) { i = 1; j = c - 16; } else if (c < 29) { i = 2; j = c - 24; } else if (c < 33) { i = 3; j = c - 29; } else if (c < 36) { i = 4; j = c - 33; }
        else if (c < 38) { i = 5; j = c - 36; } else if (c < 40) { i = 6; j = c - 38; } else if (c < 42) { i = 7; j = c - 40; } else if (c < 50) { i = c - 34; j = 0; } else { i = -1; j = 0; }
        ctabp |= (unsigned)(i < 0 ? 255 : i * 16 + j) << (8 * s); }
    const int ntg = NTOK / (F.G * NWAVES * 4);
#pragma unroll 1
    for (int tg = 0; tg < ntg; ++tg) {
        const int tok0 = (F.vcu * ntg + tg) * (NWAVES * 4) + wave * 4;
        int lane = F.lane; asm volatile("" : "+v"(lane));
        {
            unsigned* TL4 = (unsigned*)(wl + P7_LE);
            topk_stage1(SC, tok0, lane, TL4);
            v4u ch0, ch1, nh0, nh1;
#define P7_TLOAD(H0, H1, tk) do { H0 = *(const v4u*)(H2 + (size_t)(tk) * DM + 16 * lane); H1 = *(const v4u*)(H2 + (size_t)(tk) * DM + 16 * lane + 8); } while (0)
            P7_TLOAD(ch0, ch1, tok0);
#pragma unroll 1
            for (int s = 0; s < 4; ++s) {
                if (s < 3) P7_TLOAD(nh0, nh1, tok0 + s + 1);
                const int tokc = tok0 + s;
                const f32x4* spp = (const f32x4*)(SSP + (size_t)tokc * 16); const f32x4 q0 = spp[0], q1 = spp[1], q2 = spp[2], q3 = spp[3];
                const float* shp = mods + (size_t)mod_index(tokc) * MODW + 3 * DM + 16 * lane;
                const f32x4 sh0 = *(const f32x4*)(shp), sh1 = *(const f32x4*)(shp + 4), sh2v = *(const f32x4*)(shp + 8), sh3 = *(const f32x4*)(shp + 12);
                unsigned ctab_ = ctabp; asm volatile("" : "+v"(ctab_));
                topk_stage2(TL4 + s * 256, lane, ctab_, TE + s * 128, TG + s * 128);
                const v4u a = ch0, b = ch1;
                const float ssr = ((q0[0] + q0[1]) + (q0[2] + q0[3])) + ((q1[0] + q1[1]) + (q1[2] + q1[3])) + ((q2[0] + q2[1]) + (q2[2] + q2[3])) + ((q3[0] + q3[1]) + (q3[2] + q3[3]));
                const float rstd = 1.f / sqrtf(ssr * (1.f / DM) + EPS);
                float hv[16];
                hv[0] = bflo(a.x); hv[1] = bfhi(a.x); hv[2] = bflo(a.y); hv[3] = bfhi(a.y); hv[4] = bflo(a.z); hv[5] = bfhi(a.z); hv[6] = bflo(a.w); hv[7] = bfhi(a.w);
                hv[8] = bflo(b.x); hv[9] = bfhi(b.x); hv[10] = bflo(b.y); hv[11] = bfhi(b.y); hv[12] = bflo(b.z); hv[13] = bfhi(b.z); hv[14] = bflo(b.w); hv[15] = bfhi(b.w);
#pragma unroll
                for (int i = 0; i < 4; ++i) { hv[i] = hv[i] * rstd + sh0[i]; hv[4 + i] = hv[4 + i] * rstd + sh1[i]; hv[8 + i] = hv[8 + i] * rstd + sh2v[i]; hv[12 + i] = hv[12 + i] * rstd + sh3[i]; }
                float am = 0.f;
#pragma unroll
                for (int i = 0; i < 16; ++i) am = fmaxf(am, fabsf(hv[i]));
                am = wave_max(am);
                const float inv = am > 0.f ? 119.f / am : 0.f;
                if (lane == 0) HST[s] = am * (1.f / 119.f);
                v4u qv;
#pragma unroll
                for (int j = 0; j < 4; ++j) { unsigned w = 0;
#pragma unroll
                    for (int i = 0; i < 4; ++i) { int q = (int)rintf(hv[4 * j + i] * inv); w |= ((unsigned)q & 0xffu) << (8 * i); }
                    qv[j] = w; }
                *(v4u*)(H2Q + s * 1024 + 16 * lane) = qv;
                ch0 = nh0; ch1 = nh1;
            }
#undef P7_TLOAD
        }
        {
            unsigned* LEO = (unsigned*)(wl + P7_LE);
            int ee0[4], ee1[4]; float gg0[4], gg1[4], us0[4], us1[4], vs0[4], vs1[4];
#pragma unroll
            for (int s = 0; s < 4; ++s) { ee0[s] = TE[s * 128 + lane]; ee1[s] = TE[s * 128 + 64 + lane]; gg0[s] = TG[s * 128 + lane]; gg1[s] = TG[s * 128 + 64 + lane]; }
#pragma unroll
            for (int s = 0; s < 4; ++s) { us0[s] = SU[ee0[s]]; us1[s] = SU[ee1[s]]; vs0[s] = SV[ee0[s]]; vs1[s] = SV[ee1[s]]; }
#pragma unroll
            for (int s = 0; s < 4; ++s) { const int e0 = ee0[s], e1 = ee1[s]; const int c0 = e0 >> P7_CSH, c1 = e1 >> P7_CSH; int base = s * 128;
#pragma unroll
                for (int c = 0; c < P7_NCH; ++c) {
                    const unsigned long long m0 = __ballot(c0 == c), m1 = __ballot(c1 == c);
                    const int n0 = __popcll(m0), n = n0 + __popcll(m1);
                    if (c0 == c) { const int p = base + mbcnt64(m0); LEO[p] = (unsigned)e0 << 9; LG[p] = gg0[s] * vs0[s]; LSU[p] = us0[s]; }
                    if (c1 == c) { const int p = base + n0 + mbcnt64(m1); LEO[p] = (unsigned)e1 << 9; LG[p] = gg1[s] * vs1[s]; LSU[p] = us1[s]; }
                    base += n;
                } }
        }
        typedef __attribute__((address_space(1))) v4u GV4;
        if (!(dry && (MK_DRY_SKIP & 1))) {
            int lane_u = F.lane; asm volatile("" : "+v"(lane_u));
            const int su = lane_u >> 4, ju = lane_u & 15; const unsigned j16 = 16u * (unsigned)ju;
            const unsigned* LEOs = (const unsigned*)(wl + P7_LE) + su * 128; float* LGs = LG + su * 128; const float* LSUs = LSU + su * 128;
            const unsigned long long u8i = (unsigned long long)U8;
            unsigned hh[2][4], hl[2][4];
#pragma unroll
            for (int i = 0; i < 2; ++i) { const v4u ha = *(const v4u*)(H2Q + su * 1024 + 512 * i + 32 * ju), hb = *(const v4u*)(H2Q + su * 1024 + 512 * i + 32 * ju + 16);
#pragma unroll
                for (int w = 0; w < 4; ++w) { unsigned lo16[2], hi16[2];
#pragma unroll
                    for (int h = 0; h < 2; ++h) { const unsigned d = (w < 2 ? ha : hb)[2 * (w & 1) + h];
                        const unsigned t = ((d & 0x7f7f7f7fu) + 0x08080808u) ^ (d & 0x80808080u);
                        unsigned l = (t & 0x0f0f0f0fu) ^ 0x08080808u, g = (t >> 4) & 0x0f0f0f0fu;
                        l = (l | (l >> 4)) & 0x00ff00ffu; l = (l | (l >> 8)) & 0xffffu; g = (g | (g >> 4)) & 0x00ff00ffu; g = (g | (g >> 8)) & 0xffffu;
                        lo16[h] = l; hi16[h] = g; }
                    hl[i][w] = lo16[0] | (lo16[1] << 16); hh[i][w] = hi16[0] | (hi16[1] << 16); } }
            const float hs = HST[su];
            const bool b0 = (ju & 1) != 0, b1 = (ju & 2) != 0; const int rr = ju & 3;
            v4u A[4][2], B[4][2], C[4][2], D[4][2];
#define P7_ULOAD(R, t) do { const v4u eo_ = *(const v4u*)(LEOs + 4 * (t)); \
            _Pragma("unroll") for (int r = 0; r < 4; ++r) { unsigned o_ = eo_[r] + j16; asm volatile("" : "+v"(o_)); \
                R[r][0] = *(const GV4*)(u8i + o_); R[r][1] = *(const GV4*)(u8i + o_ + 256); } \
            __builtin_amdgcn_sched_barrier(0); } while (0)
#define P7_SCOMP_U(R, t) do { const float su_ = LSUs[4 * (t) + rr], g_ = LGs[4 * (t) + rr]; int p_[4]; \
                _Pragma("unroll") for (int r = 0; r < 4; ++r) { int ah = 0, al = 0; \
                    _Pragma("unroll") for (int i = 0; i < 2; ++i) { _Pragma("unroll") for (int w = 0; w < 4; ++w) { \
                        ah = __builtin_amdgcn_sdot8((int)hh[i][w], (int)R[r][i][w], ah, false); al = __builtin_amdgcn_sdot8((int)hl[i][w], (int)R[r][i][w], al, false); } } \
                    p_[r] = 16 * ah + al; } \
                const int q01 = (b0 ? p_[1] : p_[0]) + (int)dppu<0xB1>((unsigned)(b0 ? p_[0] : p_[1])); const int q23 = (b0 ? p_[3] : p_[2]) + (int)dppu<0xB1>((unsigned)(b0 ? p_[2] : p_[3])); \
                int q_ = (b1 ? q23 : q01) + (int)dppu<0x4E>((unsigned)(b1 ? q01 : q23)); q_ += (int)dppu<0x128>((unsigned)q_); q_ += (int)dppu<0x124>((unsigned)q_); \
                const float dotf = (float)q_ * (hs * su_); LGs[4 * (t) + rr] = g_ * gelu_fast(dotf); } while (0)
            P7_ULOAD(A, 0); P7_ULOAD(B, 1); P7_ULOAD(C, 2);
#pragma unroll 1
            for (int t = 0; t < 28; t += 4) {
                P7_ULOAD(D, t + 3); P7_SCOMP_U(A, t);
                P7_ULOAD(A, t + 4); P7_SCOMP_U(B, t + 1);
                P7_ULOAD(B, t + 5); P7_SCOMP_U(C, t + 2);
                P7_ULOAD(C, t + 6); P7_SCOMP_U(D, t + 3);
                asm volatile("" ::: "memory");
            }
            P7_ULOAD(D, 31); P7_SCOMP_U(A, 28); P7_SCOMP_U(B, 29); P7_SCOMP_U(C, 30); P7_SCOMP_U(D, 31);
#undef P7_SCOMP_U
#undef P7_ULOAD
        }
        float cscale; int sumq8;
        {
            int lane_q = F.lane; asm volatile("" : "+v"(lane_q));
            const int sq = lane_q >> 4, jq = lane_q & 15;
            const float* lg = LG + sq * 128 + 8 * jq; const f32x4 c0 = *(const f32x4*)lg, c1 = *(const f32x4*)(lg + 4);
            float m = fmaxf(fmaxf(fmaxf(fabsf(c0[0]), fabsf(c0[1])), fmaxf(fabsf(c0[2]), fabsf(c0[3]))), fmaxf(fmaxf(fabsf(c1[0]), fabsf(c1[1])), fmaxf(fabsf(c1[2]), fabsf(c1[3]))));
            m = rowmax16f(m);
            cscale = m * (1.f / 127.f); const float iv = m > 0.f ? 127.f / m : 0.f;
            v2u w; w.x = 0u; w.y = 0u;
#pragma unroll
            for (int k = 0; k < 4; ++k) { w.x |= ((unsigned)(int)rintf(c0[k] * iv) & 0xffu) << (8 * k); w.y |= ((unsigned)(int)rintf(c1[k] * iv) & 0xffu) << (8 * k); }
            *(v2u*)(wl + P7_LQ + (sq * 32 + 2 * jq) * 4) = w;
            int sq8 = 0;
#pragma unroll
            for (int k = 0; k < 4; ++k) sq8 += (int)rintf(c0[k] * iv) + (int)rintf(c1[k] * iv);
            sumq8 = 8 * rowsum16i(sq8);
        }
        int acc[64];
#pragma unroll
        for (int i = 0; i < 64; ++i) acc[i] = 0;
        if (!(dry && (MK_DRY_SKIP & 2))) {
            int lane_v = F.lane; asm volatile("" : "+v"(lane_v));
            const int sv_ = lane_v >> 4, jv = lane_v & 15; const unsigned j16 = 16u * (unsigned)jv;
            const unsigned* LEOs = (const unsigned*)(wl + P7_LE) + sv_ * 128; const int* LQs = (const int*)(wl + P7_LQ) + sv_ * 32;
            const unsigned long long v8i = (unsigned long long)V8;
            v4u A[4][2], B[4][2], C[4][2];
#define P7_VLOAD(R, t) do { const v4u eo_ = *(const v4u*)(LEOs + 4 * (t)); \
            _Pragma("unroll") for (int r = 0; r < 4; ++r) { unsigned o_ = eo_[r] + j16; asm volatile("" : "+v"(o_)); \
                R[r][0] = *(const GV4*)(v8i + o_); R[r][1] = *(const GV4*)(v8i + o_ + 256); } \
            __builtin_amdgcn_sched_barrier(0); } while (0)
#define P7_SCOMP_V(R, t) do { const int cq_ = LQs[(t)]; \
                _Pragma("unroll") for (int i = 0; i < 2; ++i) { _Pragma("unroll") for (int w = 0; w < 4; ++w) { \
                    const unsigned x_ = __builtin_amdgcn_perm(R[1][i][w], R[0][i][w], 0x05010400u), y_ = __builtin_amdgcn_perm(R[1][i][w], R[0][i][w], 0x07030602u); \
                    const unsigned c_ = __builtin_amdgcn_perm(R[3][i][w], R[2][i][w], 0x05010400u), e_ = __builtin_amdgcn_perm(R[3][i][w], R[2][i][w], 0x07030602u); \
                    unsigned tb_[4]; tb_[0] = __builtin_amdgcn_perm(c_, x_, 0x05040100u); tb_[1] = __builtin_amdgcn_perm(c_, x_, 0x07060302u); tb_[2] = __builtin_amdgcn_perm(e_, y_, 0x05040100u); tb_[3] = __builtin_amdgcn_perm(e_, y_, 0x07060302u); \
                    _Pragma("unroll") for (int b = 0; b < 4; ++b) {     \
                        acc[32 * i + 8 * w + 2 * b]     = __builtin_amdgcn_sdot4((int)(tb_[b] & 0x0f0f0f0fu), cq_, acc[32 * i + 8 * w + 2 * b], false); \
                        acc[32 * i + 8 * w + 2 * b + 1] = __builtin_amdgcn_sdot4((int)tb_[b], cq_, acc[32 * i + 8 * w + 2 * b + 1], false); } } } } while (0)
            P7_VLOAD(A, 0); P7_VLOAD(B, 1);
#pragma unroll 1
            for (int t = 0; t < 30; t += 3) {
                P7_VLOAD(C, t + 2); P7_SCOMP_V(A, t);
                P7_VLOAD(A, t + 3); P7_SCOMP_V(B, t + 1);
                P7_VLOAD(B, t + 4); P7_SCOMP_V(C, t + 2);
                asm volatile("" ::: "memory");
            }
            P7_SCOMP_V(A, 30); P7_SCOMP_V(B, 31);
#undef P7_SCOMP_V
#undef P7_VLOAD
        }
        {
            int lane_f = F.lane; asm volatile("" : "+v"(lane_f));
            const int sf = lane_f >> 4, jf = lane_f & 15; const int tok = tok0 + sf;
            const float* xrow = F.out + O_Y + (size_t)tok * DM + 32 * jf;
            const float* ga2 = mods + (size_t)mod_index(tok0) * MODW + 5 * DM + 32 * jf;
            const float* gf = F.in[I_GFINAL] + 32 * jf;
            float* yrow = dry ? (float*)(F.ws + WS_MIX) + (size_t)(tok & 8191) * DM + 32 * jf : F.out + O_Y + (size_t)tok * DM + 32 * jf;
            float xs[64]; float ss = 0.f;
#pragma unroll
            for (int i = 0; i < 2; ++i) {
#pragma unroll
                for (int hh_ = 0; hh_ < 2; ++hh_) { f32x4 xv[4], gv[4];
#pragma unroll
                    for (int q = 0; q < 4; ++q) { xv[q] = *(const f32x4*)(xrow + 512 * i + 16 * hh_ + 4 * q); gv[q] = *(const f32x4*)(ga2 + 512 * i + 16 * hh_ + 4 * q); }
#pragma unroll
                    for (int q = 0; q < 4; ++q)
#pragma unroll
                        for (int k = 0; k < 4; ++k) { const int ci = 32 * i + 16 * hh_ + 4 * q + k;
                            const float pv = (k & 1) ? (float)(acc[ci] - acc[ci - 1]) * (cscale * (1.f / 16.f)) : (float)(acc[ci] - sumq8) * cscale;
                            const float t = xv[q][k] + gv[q][k] * pv; xs[ci] = t; ss += t * t; }
                    asm volatile("" ::: "memory"); } }
            const float rstd = 1.f / sqrtf(rowsum16f(ss) * (1.f / DM) + EPS);
#pragma unroll
            for (int i = 0; i < 2; ++i) {
#pragma unroll
                for (int hh_ = 0; hh_ < 2; ++hh_) { f32x4 gfv[4];
#pragma unroll
                    for (int q = 0; q < 4; ++q) gfv[q] = *(const f32x4*)(gf + 512 * i + 16 * hh_ + 4 * q);
#pragma unroll
                    for (int q = 0; q < 4; ++q) { f32x4 o;
#pragma unroll
                        for (int k = 0; k < 4; ++k) o[k] = xs[32 * i + 16 * hh_ + 4 * q + k] * rstd * gfv[q][k];
                        *(f32x4*)(yrow + 512 * i + 16 * hh_ + 4 * q) = o; }
                    asm volatile("" ::: "memory"); } }
        }
    }
}

__global__ void __launch_bounds__(NWAVES * 64, 2) mk_fwd(Args args) {
    extern __shared__ __attribute__((aligned(16))) unsigned char lds[];
    Frame F;
    F.lds = lds;
    F.tid = threadIdx.x; F.lane = F.tid & 63; F.wave = __builtin_amdgcn_readfirstlane(F.tid >> 6);
    F.G = gridDim.x; { const int bx = blockIdx.x; F.vcu = (F.G % 8 == 0) ? (bx % 8) * (F.G / 8) + bx / 8 : bx; }
    F.in = args.in; F.out = args.out; F.ws = args.ws;
    LAS unsigned char* lds3 = (LAS unsigned char*)lds;
    volatile LAS unsigned* MISC = (volatile LAS unsigned*)(lds3 + MISC_OFF);
    for (int u = F.tid; u < (LDS_BYTES - LDSCTL_OFF) / 4; u += NWAVES * 64) ((LAS unsigned*)(lds3 + LDSCTL_OFF))[u] = 0u;
    __syncthreads();
    unsigned* ctl = (unsigned*)(args.ws + WS_CTL);
    XcdBarrier bar; bar.bar = ctl + CW_BAR; bar.x = 0; bar.st = nullptr;
    const bool one_launch = (args.ph_hi - args.ph_lo) > 1;
    if (one_launch) bar = xcd_barrier_post(ctl + CW_BAR, MISC + 8);
    const int lo = args.ph_lo, hi = args.ph_hi;
#ifndef MK_PHASE_MASK
#define MK_PHASE_MASK 0xff
#endif
#define IN(k) (((MK_PHASE_MASK >> (k)) & 1) && lo <= (k) && (k) < hi)
#define SEAM(k) do { if (IN(k) && IN((k) + 1)) xcd_barrier(bar); } while (0)

#define DUPQ(k) (MK_DUP == (k))
    if (IN(0)) { if (DUPQ(0)) { p0_phase(F); xcd_barrier(bar); } p0_phase(F); SEAM(0); }
    if (IN(1)) { if (DUPQ(1)) { norm_phase(F, 0); xcd_barrier(bar); } norm_phase(F, 0); bias_items(F); SEAM(1); }
    if (IN(2)) {
        pg8::Gemm g{(const pg8::bf16_t*)(F.ws + WS_H), (const pg8::bf16_t*)(F.ws + WS_WIN), NTOK, D_IN, DM}; pg8::StaticOrder S; S.init(NTOK, D_IN, F.G, (int)blockIdx.x);
        EpiInProj E{(bf16*)(F.ws + WS_Q), (bf16*)(F.ws + WS_K), (bf16*)(F.ws + WS_VT), (bf16*)(F.ws + WS_XR), (bf16*)(F.ws + WS_YG), F.out + O_NEWK, F.out + O_NEWV, (const f32x4*)(F.ws + WS_ROPE)};
        if (DUPQ(2)) { pg8::gemm_phase<EpiInProj, pg8::StaticOrder, true, true>(lds3, g, S, E); xcd_barrier(bar); }
        pg8::gemm_phase<EpiInProj, pg8::StaticOrder, true, true>(lds3, g, S, E);
        SEAM(2);
    }
    if (IN(3)) { if (DUPQ(3)) { p3_phase(F, MK_P3_TYPES); xcd_barrier(bar); } p3_phase(F); SEAM(3); }
    if (IN(4)) {
        pg8::Gemm g{(const pg8::bf16_t*)(F.ws + WS_MIX), (const pg8::bf16_t*)(F.ws + WS_WOUT), NTOK, DM, DM}; pg8::StaticOrder S; S.init(NTOK, DM, F.G, (int)blockIdx.x);
        EpiOutProj E{F.in[I_XP], F.in[I_XS], (const float*)(F.ws + WS_MODS), F.in[I_GFFN], F.out + O_Y, (bf16*)(F.ws + WS_H), (float*)(F.ws + WS_SSP)};
        if (DUPQ(4)) { pg8::gemm_phase<EpiOutProj, pg8::StaticOrder, true, true>(lds3, g, S, E); xcd_barrier(bar); }
        pg8::gemm_phase<EpiOutProj, pg8::StaticOrder, true, true>(lds3, g, S, E);
        SEAM(4);
    }
    if (IN(6)) {
        pg8::Gemm g{(const pg8::bf16_t*)(F.ws + WS_H), (const pg8::bf16_t*)(F.ws + WS_WC), NTOK, 2048, DM}; pg8::StaticOrder S; S.init(NTOK, 2048, F.G, (int)blockIdx.x);
        EpiScores E{(bf16*)(F.ws + WS_SC), (const float*)(F.ws + WS_SSP), (const float*)(F.ws + WS_BIAS)};
        if (DUPQ(6)) { pg8::gemm_phase<EpiScores, pg8::StaticOrder, true, true>(lds3, g, S, E); xcd_barrier(bar); }
        pg8::gemm_phase<EpiScores, pg8::StaticOrder, true, true>(lds3, g, S, E);
        SEAM(6);
    }
    if (IN(7)) { if (DUPQ(7)) { p7_phase(F, true); xcd_barrier(bar); } p7_phase(F, false); }
#undef IN
#undef SEAM
}

extern "C" void kernel_launch(void* const* d_in, const int* in_sizes, int n_in, void* d_out, int out_size, void* d_ws, size_t ws_size, hipStream_t stream) {
    static int grid = 0;
    if (grid == 0) {
        if (n_in != 26 || ws_size < WS_END) { fprintf(stderr, "kernel_launch: unexpected n_in %d / ws %zu\n", n_in, ws_size); grid = -1; return; }
        int dev = 0, cus = 0, per_cu = 0;
        if (hipGetDevice(&dev) != hipSuccess || hipDeviceGetAttribute(&cus, hipDeviceAttributeMultiprocessorCount, dev) != hipSuccess) { grid = -1; return; }
        if (hipFuncSetAttribute((const void*)mk_fwd, hipFuncAttributeMaxDynamicSharedMemorySize, LDS_BYTES) != hipSuccess) { fprintf(stderr, "kernel_launch: hipFuncSetAttribute failed\n"); grid = -1; return; }
        if (hipOccupancyMaxActiveBlocksPerMultiprocessor(&per_cu, (const void*)mk_fwd, NWAVES * 64, LDS_BYTES) != hipSuccess || per_cu < 1)
            fprintf(stderr, "kernel_launch: occupancy query reports %d blocks per CU\n", per_cu);
        (void)hipGetLastError();
        grid = cus;
        if (grid != 256) fprintf(stderr, "kernel_launch: note: %d CUs\n", grid);
    }
    if (grid < 0) return;
    (void)hipMemsetAsync((char*)d_ws + WS_CTL, 0, CTL_ZERO_BYTES, stream);
    Args a{};
    for (int i = 0; i < 26; ++i) a.in[i] = (const float*)d_in[i];
    a.out = (float*)d_out; a.ws = (unsigned char*)d_ws;
    if (MK_N_LAUNCHES == 1) {
        a.ph_lo = 0; a.ph_hi = N_PHASES; a.li = 0;
        hipLaunchKernelGGL(mk_fwd, dim3(grid), dim3(NWAVES * 64), LDS_BYTES, stream, a);
    } else {
        for (int li = 0; li < N_PHASES; ++li) { a.ph_lo = li; a.ph_hi = li + 1; a.li = li;
            hipLaunchKernelGGL(mk_fwd, dim3(grid), dim3(NWAVES * 64), LDS_BYTES, stream, a); }
    }
}
```

```cpp
#include <hip/hip_runtime.h>
#include <cstdio>
#include <cstdint>

#ifndef MK_DUP
#define MK_DUP -1
#endif
#ifndef MK_DRY_SKIP
#define MK_DRY_SKIP 0
#endif
#ifndef MK_N_LAUNCHES
#define MK_N_LAUNCHES 1
#endif

namespace pg8 {
#define PG8_LAS __attribute__((address_space(3)))
typedef unsigned short bf16_t;
typedef short bf16x8 __attribute__((ext_vector_type(8)));
typedef float f32x4 __attribute__((ext_vector_type(4)));
typedef unsigned u32x4 __attribute__((ext_vector_type(4)));
typedef unsigned u32x2 __attribute__((ext_vector_type(2)));
constexpr int BM = 256, BK = 64, HALF = 128, HTB = HALF * BK * 2, STAGE_BYTES = 8 * HTB, NXCD = 8, WGM = 8;

__host__ __device__ __forceinline__ int lds_byte(int r, int c) { const int st = (r >> 4) * 2 + (c >> 5), rr = r & 15, cc = c & 31, ob = rr * 64 + cc * 2; return st * 1024 + (ob ^ (((ob >> 9) & 1) << 5)); }
__host__ __device__ __forceinline__ void stage_rc(int b, int& R, int& C) { const int st = b / 1024, sb = b % 1024, swz = sb ^ (((sb >> 9) & 1) << 5); R = (st >> 1) * 16 + swz / 64; C = (st & 1) * 32 + (swz % 64) / 2; }
__host__ __device__ __forceinline__ int perm32(int rho) { const int n = rho >> 4, i = rho & 15; return 8 * (i >> 2) + 4 * n + (i & 3); }

struct Unit { int pm, pn; };
struct Gemm { const bf16_t* A; const bf16_t* Bt; int M, N, K; };

struct StaticOrder {
    int nM, nN, nwg, G, c;
    __host__ __device__ void init(int M, int N, int G_, int c_) { nM = M / BM; nN = N / BM; nwg = nM * nN; G = G_; c = c_; }
    __host__ __device__ bool next(int i, Unit& u) const {
        const long L = (long)i * G + c; if (L >= nwg) return false;
        int wgid = (int)L; { const int q = nwg / NXCD, r = nwg % NXCD, xcd = wgid % NXCD, off = wgid / NXCD; wgid = (xcd < r ? xcd * (q + 1) : r * (q + 1) + (xcd - r) * q) + off; }
        const int nig = WGM * nN, gid = wgid / nig, fm = gid * WGM, gsz = (nM - fm) < WGM ? (nM - fm) : WGM;
        u.pm = fm + ((wgid % nig) % gsz); u.pn = (wgid % nig) / gsz; return true;
    }
    __device__ __forceinline__ void a_ready(const Unit&) const {}
    __device__ __forceinline__ void done(const Unit&) const {}
};

__device__ __forceinline__ unsigned cvt_pk_bf16(float lo, float hi) { unsigned r; asm volatile("v_cvt_pk_bf16_f32 %0, %1, %2" : "=v"(r) : "v"(lo), "v"(hi)); return r; }

template <class Epi, class Sched, bool ALIGN_EPI = false, bool SP2 = false>
__device__ __forceinline__ void gemm_phase(PG8_LAS unsigned char* lds, const Gemm g, const Sched& S, const Epi& E) {
    int tid_ = threadIdx.x; asm volatile("" : "+v"(tid_));
    const int tid = tid_, wid = __builtin_amdgcn_readfirstlane(tid >> 6), lane = tid & 63, wr = wid >> 2, wc = wid & 3, fr = lane & 15, fq = lane >> 4;
    const int K = g.K, nt = K / BK;
    unsigned voffA[2], voffB[2];
#pragma unroll
    for (int i = 0; i < 2; ++i) { int R, C; stage_rc(tid * 16 + i * 8192, R, C); const int Rb = Epi::PERM ? ((R & ~31) + perm32(R & 31)) : R;
        voffA[i] = (unsigned)(R * K + C) * 2u; voffB[i] = (unsigned)(Rb * K + C) * 2u; }
    const size_t kstep = (size_t)(BK * 2);
    const size_t hstep = (size_t)HALF * K * 2;
    const size_t tstep = 2 * hstep;
    const unsigned ldsw = (unsigned)wid * 1024u;
    const int aoff = lds_byte(wr * 64 + fr, fq * 8), boff = lds_byte(wc * 32 + fr, fq * 8);
#define PG8_SA(b, h) (((b) * 2 + (h)) * HTB)
#define PG8_SB(b, h) ((4 + (b) * 2 + (h)) * HTB)
#define PG8_STAGE(bufoff, gbase, voff) do { _Pragma("unroll") for (int _i = 0; _i < 2; ++_i) \
        __builtin_amdgcn_global_load_lds((const unsigned*)((const char*)(gbase) + (voff)[_i]), (PG8_LAS unsigned*)(lds + (bufoff) + ldsw + _i * 8192), 16, 0, 0); } while (0)
#define PG8_LDA(dst, b, h) do { _Pragma("unroll") for (int m = 0; m < 4; ++m) _Pragma("unroll") for (int k = 0; k < 2; ++k) dst[m][k] = *(const PG8_LAS bf16x8*)(lds + PG8_SA(b, h) + aoff + m * 2048 + k * 1024); } while (0)
#define PG8_LDB(dst, b, h) do { _Pragma("unroll") for (int n = 0; n < 2; ++n) _Pragma("unroll") for (int k = 0; k < 2; ++k) dst[n][k] = *(const PG8_LAS bf16x8*)(lds + PG8_SB(b, h) + boff + n * 2048 + k * 1024); } while (0)
#define PG8_MMA(ai, bj, At, Bt) do { __builtin_amdgcn_s_setprio(1); _Pragma("unroll") for (int m = 0; m < 4; ++m) _Pragma("unroll") for (int n = 0; n < 2; ++n) _Pragma("unroll") for (int k = 0; k < 2; ++k) \
        acc[ai][bj][m][n] = __builtin_amdgcn_mfma_f32_16x16x32_bf16(Bt[n][k], At[m][k], acc[ai][bj][m][n], 0, 0, 0); __builtin_amdgcn_s_setprio(0); } while (0)
#define PG8_WAIT_V(n) asm volatile("s_waitcnt vmcnt(" #n ")" ::: "memory")
#define PG8_WAIT_L(n) asm volatile("s_waitcnt lgkmcnt(" #n ")" ::: "memory")
#define PG8_BAR __builtin_amdgcn_s_barrier()
#define PG8_SCHED __builtin_amdgcn_sched_barrier(0)
    Unit cur, nxt; int ui = 0;
    if (!S.next(0, cur)) return;
    f32x4 acc[2][2][4][2];
#pragma unroll
    for (int a = 0; a < 2; ++a)
#pragma unroll
        for (int b = 0; b < 2; ++b)
#pragma unroll
            for (int m = 0; m < 4; ++m)
#pragma unroll
                for (int n = 0; n < 2; ++n) acc[a][b][m][n] = (f32x4){0.f, 0.f, 0.f, 0.f};
    bf16x8 At[4][2], B0[2][2], B1[2][2];
    const char* cA = (const char*)g.A + (size_t)cur.pm * tstep; const char* cB = (const char*)g.Bt + (size_t)cur.pn * tstep;
    S.a_ready(cur);
    if constexpr (SP2) {
        PG8_STAGE(PG8_SB(0, 0), cB, voffB); PG8_STAGE(PG8_SB(0, 1), cB + hstep, voffB); PG8_STAGE(PG8_SA(0, 0), cA, voffA); PG8_STAGE(PG8_SA(0, 1), cA + hstep, voffA);
        if (wr == 1) PG8_BAR;
        PG8_WAIT_V(2); PG8_BAR;
        PG8_STAGE(PG8_SB(1, 0), cB + kstep, voffB); PG8_STAGE(PG8_SA(1, 0), cA + kstep, voffA); PG8_STAGE(PG8_SB(1, 1), cB + hstep + kstep, voffB);
        PG8_WAIT_V(6); PG8_BAR;
    } else {
        PG8_STAGE(PG8_SB(0, 0), cB, voffB); PG8_STAGE(PG8_SA(0, 0), cA, voffA); PG8_STAGE(PG8_SB(0, 1), cB + hstep, voffB); PG8_STAGE(PG8_SA(0, 1), cA + hstep, voffA);
        if (wr == 1) PG8_BAR;
        PG8_WAIT_V(4); PG8_BAR;
        PG8_STAGE(PG8_SB(1, 0), cB + kstep, voffB); PG8_STAGE(PG8_SA(1, 0), cA + kstep, voffA); PG8_STAGE(PG8_SB(1, 1), cB + hstep + kstep, voffB);
        PG8_WAIT_V(6); PG8_BAR;
    }
    for (;;) {
        const bool has_next = S.next(ui + 1, nxt);
        const char* nA = has_next ? (const char*)g.A + (size_t)nxt.pm * tstep : cA; const char* nB = has_next ? (const char*)g.Bt + (size_t)nxt.pn * tstep : cB;
        for (int t = 0; t < nt; t += 2) {
            const bool last = (t == nt - 2);
            const char* a1 = cA + (size_t)(t + 1) * kstep;
            const char* a2 = last ? nA : cA + (size_t)(t + 2) * kstep; const char* b2 = last ? nB : cB + (size_t)(t + 2) * kstep;
            const char* a3 = a2 + kstep; const char* b3 = b2 + kstep;
            if (last && has_next) S.a_ready(nxt);
            if constexpr (SP2) {
            PG8_LDB(B0, 0, 0); PG8_LDB(B1, 0, 1); PG8_SCHED; PG8_LDA(At, 0, 0); PG8_STAGE(PG8_SA(1, 1), a1 + hstep, voffA);
            PG8_WAIT_V(8); PG8_WAIT_L(0); PG8_BAR; PG8_MMA(0, 0, At, B0); PG8_MMA(0, 1, At, B1); PG8_BAR; PG8_SCHED;
            PG8_LDA(At, 0, 1); PG8_STAGE(PG8_SB(0, 0), b2, voffB); PG8_STAGE(PG8_SB(0, 1), b2 + hstep, voffB); PG8_STAGE(PG8_SA(0, 0), a2, voffA);
            PG8_WAIT_V(8); PG8_WAIT_L(0); PG8_BAR; PG8_MMA(1, 0, At, B0); PG8_MMA(1, 1, At, B1); PG8_BAR; PG8_SCHED;
            PG8_LDB(B0, 1, 0); PG8_LDB(B1, 1, 1); PG8_SCHED; PG8_LDA(At, 1, 0); PG8_STAGE(PG8_SA(0, 1), a2 + hstep, voffA);
            PG8_WAIT_V(8); PG8_WAIT_L(0); PG8_BAR; PG8_MMA(0, 0, At, B0); PG8_MMA(0, 1, At, B1); PG8_BAR; PG8_SCHED;
            PG8_LDA(At, 1, 1); PG8_STAGE(PG8_SB(1, 0), b3, voffB); PG8_STAGE(PG8_SB(1, 1), b3 + hstep, voffB); PG8_STAGE(PG8_SA(1, 0), a3, voffA);
            PG8_WAIT_V(8); PG8_WAIT_L(0); PG8_BAR; PG8_MMA(1, 0, At, B0); PG8_MMA(1, 1, At, B1); PG8_BAR; PG8_SCHED;
            } else {
            PG8_LDB(B0, 0, 0); PG8_SCHED; PG8_LDA(At, 0, 0); PG8_STAGE(PG8_SA(1, 1), a1 + hstep, voffA);
            PG8_WAIT_L(8); PG8_BAR; PG8_WAIT_L(0); PG8_MMA(0, 0, At, B0); PG8_BAR; PG8_SCHED;
            PG8_LDB(B1, 0, 1); PG8_STAGE(PG8_SB(0, 0), b2, voffB);
            PG8_BAR; PG8_WAIT_L(0); PG8_MMA(0, 1, At, B1); PG8_BAR;
            PG8_LDA(At, 0, 1); PG8_STAGE(PG8_SA(0, 0), a2, voffA);
            PG8_BAR; PG8_WAIT_L(0); PG8_MMA(1, 0, At, B0); PG8_BAR; PG8_SCHED;
            PG8_STAGE(PG8_SB(0, 1), b2 + hstep, voffB);
            PG8_WAIT_V(6); PG8_BAR; PG8_MMA(1, 1, At, B1); PG8_BAR;
            PG8_LDB(B0, 1, 0); PG8_SCHED; PG8_LDA(At, 1, 0); PG8_STAGE(PG8_SA(0, 1), a2 + hstep, voffA);
            PG8_WAIT_L(8); PG8_BAR; PG8_WAIT_L(0); PG8_MMA(0, 0, At, B0); PG8_BAR; PG8_SCHED;
            PG8_LDB(B1, 1, 1); PG8_STAGE(PG8_SB(1, 0), b3, voffB);
            PG8_BAR; PG8_WAIT_L(0); PG8_MMA(0, 1, At, B1); PG8_BAR;
            PG8_LDA(At, 1, 1); PG8_STAGE(PG8_SA(1, 0), a3, voffA);
            PG8_BAR; PG8_WAIT_L(0); PG8_MMA(1, 0, At, B0); PG8_BAR; PG8_SCHED;
            PG8_STAGE(PG8_SB(1, 1), b3 + hstep, voffB);
            PG8_WAIT_V(6); PG8_BAR; PG8_MMA(1, 1, At, B1); PG8_BAR;
            }
        }
        if constexpr (ALIGN_EPI) { if (wr == 0) PG8_BAR; }
        { int te_ = threadIdx.x; asm volatile("" : "+v"(te_));
          const int we_ = __builtin_amdgcn_readfirstlane(te_ >> 6), le_ = te_ & 63;
          E(acc, cur, we_ >> 2, we_ & 3, le_ & 15, le_ >> 4); }
        S.done(cur);
        if (!has_next) break;
#pragma unroll
        for (int a = 0; a < 2; ++a)
#pragma unroll
            for (int b = 0; b < 2; ++b)
#pragma unroll
                for (int m = 0; m < 4; ++m)
#pragma unroll
                    for (int n = 0; n < 2; ++n) acc[a][b][m][n] = (f32x4){0.f, 0.f, 0.f, 0.f};
        cur = nxt; cA = nA; cB = nB; ++ui;
        if constexpr (ALIGN_EPI) { if (wr == 1) PG8_BAR; }
    }
    PG8_WAIT_V(0);
    if constexpr (!ALIGN_EPI) { if (wr == 0) PG8_BAR; }
    PG8_BAR;
#undef PG8_SA
#undef PG8_SB
#undef PG8_STAGE
#undef PG8_LDA
#undef PG8_LDB
#undef PG8_MMA
#undef PG8_WAIT_V
#undef PG8_WAIT_L
#undef PG8_BAR
#undef PG8_SCHED
}
}

constexpr int NWAVES = 8;
constexpr int DM = 1024, NTOK = 16384, NCTX = 8192, D_IN = 1792, NMODV = 9, MODW = 6144;
constexpr int SEQ_C = 256, SEQ_L = 1024, NSEQ_C = 32, NSEQ_L = 8;
constexpr int N_PHASES = 8;
constexpr float LOG2E = 1.4426950408889634f;
constexpr float QSCALE = 0.125f * LOG2E;
constexpr float EPS = 1e-6f;

constexpr size_t MiB = 1u << 20, KiB = 1u << 10;
constexpr size_t WS_CTL = 0, CTL_ZERO_BYTES = 64 * KiB;
constexpr size_t WS_MODS = 1 * MiB;
constexpr size_t WS_ROPE = 1 * MiB + 256 * KiB;
constexpr size_t WS_RGW  = 1 * MiB + 512 * KiB;
constexpr size_t WS_CK   = 1 * MiB + 768 * KiB;
constexpr size_t WS_CVT  = 2 * MiB + 256 * KiB;
constexpr size_t WS_WIN  = 3 * MiB;
constexpr size_t WS_WOUT = 7 * MiB;
constexpr size_t WS_WC   = 9 * MiB;
constexpr size_t WS_U    = 16 * MiB;
constexpr size_t WS_SSP  = 14 * MiB;
constexpr size_t WS_BIAS = 15 * MiB;
constexpr size_t WS_SU   = 13 * MiB;
constexpr size_t WS_SV   = 13 * MiB + 64 * KiB;
constexpr size_t WS_V    = 48 * MiB;
constexpr size_t WS_H    = 80 * MiB;
constexpr size_t WS_MIX  = 112 * MiB;
constexpr size_t WS_Q    = 144 * MiB;
constexpr size_t WS_K    = 160 * MiB;
constexpr size_t WS_VT   = 164 * MiB;
constexpr size_t WS_XR   = 168 * MiB;
constexpr size_t WS_YG   = 184 * MiB;
constexpr size_t WS_HF   = 200 * MiB;
constexpr size_t WS_X1   = 208 * MiB;
constexpr size_t WS_SC   = 144 * MiB;
constexpr size_t WS_END  = 232 * MiB;
constexpr int VT_LAT_OFF = NSEQ_C * 2 * 64 * SEQ_C;

constexpr int CW_BAR = 4096;

constexpr int RING_BYTES = 131072;
constexpr int LDSCTL_OFF = 146944, MISC_OFF = LDSCTL_OFF + 320;
constexpr int LDS_BYTES = 147456;

#define GAS __attribute__((address_space(1)))
#define LAS __attribute__((address_space(3)))
typedef unsigned short bf16;
typedef unsigned v4u __attribute__((ext_vector_type(4)));
typedef unsigned v2u __attribute__((ext_vector_type(2)));
typedef float f32x4 __attribute__((ext_vector_type(4)));
typedef float f32x2 __attribute__((ext_vector_type(2)));
typedef float f32x16 __attribute__((ext_vector_type(16)));
typedef short bf16x8 __attribute__((ext_vector_type(8)));
typedef GAS unsigned gu32;
#define RLX_AGENT __ATOMIC_RELAXED, __HIP_MEMORY_SCOPE_AGENT

__device__ __forceinline__ unsigned f2bf(float f) { unsigned u = __builtin_bit_cast(unsigned, f); return (u + 0x7fffu + ((u >> 16) & 1u)) >> 16; }
typedef float f32x2_t_ __attribute__((ext_vector_type(2))); typedef __bf16 bf16x2_t_ __attribute__((ext_vector_type(2)));
__device__ __forceinline__ unsigned pk2(float lo, float hi) { f32x2_t_ v = {lo, hi}; bf16x2_t_ b = __builtin_convertvector(v, bf16x2_t_); return __builtin_bit_cast(unsigned, b); }
__device__ __forceinline__ float bf2f(unsigned b) { return __builtin_bit_cast(float, b << 16); }
__device__ __forceinline__ float bflo(unsigned w) { return __builtin_bit_cast(float, w << 16); }
__device__ __forceinline__ float bfhi(unsigned w) { return __builtin_bit_cast(float, w & 0xffff0000u); }
__device__ __forceinline__ float sigmoidf_(float x) { return 1.f / (1.f + __expf(-x)); }
__device__ __forceinline__ float gelu_tanh(float x) { const float y = 0.7978845608028654f * (x + 0.044715f * x * x * x); const float e = __expf(2.f * y); return 0.5f * x * (2.f - 2.f / (1.f + e)); }
template <int CTRL> __device__ __forceinline__ float dppf_(float v) { return __builtin_bit_cast(float, __builtin_amdgcn_update_dpp(0, __builtin_bit_cast(int, v), CTRL, 0xf, 0xf, true)); }
__device__ __forceinline__ float xrow16_(float v) {
    unsigned a = __builtin_bit_cast(unsigned, v), b = a; asm volatile("" : "+v"(b));
    const auto r = __builtin_amdgcn_permlane16_swap(a, b, false, false);
    const bool odd = (threadIdx.x & 16) != 0; return __builtin_bit_cast(float, odd ? r[0] : r[1]);
}
__device__ __forceinline__ float xhalf32_(float v) {
    unsigned a = __builtin_bit_cast(unsigned, v), b = a; asm volatile("" : "+v"(b));
    const auto r = __builtin_amdgcn_permlane32_swap(a, b, false, false);
    const bool hi = (threadIdx.x & 32) != 0; return __builtin_bit_cast(float, hi ? r[0] : r[1]);
}
__device__ __forceinline__ float wave_sum(float v) {
    v += dppf_<0xB1>(v); v += dppf_<0x4E>(v); v += dppf_<0x141>(v); v += dppf_<0x140>(v);
    v += xrow16_(v); v += xhalf32_(v); return v;
}
__device__ __forceinline__ float wave_max(float v) {
    v = fmaxf(v, dppf_<0xB1>(v)); v = fmaxf(v, dppf_<0x4E>(v)); v = fmaxf(v, dppf_<0x141>(v)); v = fmaxf(v, dppf_<0x140>(v));
    v = fmaxf(v, xrow16_(v)); v = fmaxf(v, xhalf32_(v)); return v;
}
__device__ __forceinline__ int crow(int r, int hi) { return (r & 3) + 8 * (r >> 2) + 4 * hi; }

#define XB_TMO      128
#define XB_XCNT(j)  (256  + 64 * (j))
#define XB_XSUB(j)  (1280 + 64 * (j))
#define XB_XGEN(j)  (2304 + 64 * (j))
#define XB_TOP      3328
#define XB_TOPGEN   3392
#define XCD_BAR_WORDS 3456
#define XB_SPIN_CAP (1u << 18)
__device__ __forceinline__ unsigned xb_ld(unsigned* p)              { return __hip_atomic_load(p, __ATOMIC_RELAXED, __HIP_MEMORY_SCOPE_AGENT); }
__device__ __forceinline__ unsigned xb_add(unsigned* p, unsigned v) { return __hip_atomic_fetch_add(p, v, __ATOMIC_RELAXED, __HIP_MEMORY_SCOPE_AGENT); }
__device__ __forceinline__ unsigned xb_xcc_id() { return (unsigned)__builtin_amdgcn_s_getreg((3 << 11) | 20) & 0xFu; }
#define XB_SPIN(cond, bar) do { unsigned _sp = 0; while (cond) { __builtin_amdgcn_s_sleep(1); \
    if ((++_sp & 255u) == 0u) { if (xb_ld(&(bar)[XB_TMO])) break; if (_sp > XB_SPIN_CAP) { atomicAdd(&(bar)[XB_TMO], 1u); break; } } } } while (0)
struct XcdBarrier { unsigned* bar; unsigned x; volatile LAS unsigned* st; };
__device__ __forceinline__ XcdBarrier xcd_barrier_post(unsigned* bar, volatile LAS unsigned* st) {
    XcdBarrier b; b.bar = bar; b.x = xb_xcc_id(); b.st = st;
    if (threadIdx.x == 0) (void)xb_add(&bar[XB_XCNT(b.x)], 1u);
    return b;
}
__device__ __forceinline__ void xcd_barrier_complete(unsigned* bar, unsigned x, unsigned& nloc, unsigned& nx) {
    const unsigned G = gridDim.x * gridDim.y * gridDim.z;
    unsigned sum, cnt, mine, sp = 0u;
    for (;;) {
        sum = 0u; cnt = 0u; mine = 0u;
#pragma unroll
        for (unsigned j = 0; j < 16; ++j) { const unsigned c = xb_ld(&bar[XB_XCNT(j)]); sum += c; cnt += (c > 0u) ? 1u : 0u; mine = (j == x) ? c : mine; }
        if (sum == G) break;
        __builtin_amdgcn_s_sleep(1);
        if ((++sp & 255u) == 0u) { if (xb_ld(&bar[XB_TMO])) break; if (sp > XB_SPIN_CAP) { atomicAdd(&bar[XB_TMO], 1u); break; } }
    }
    nloc = mine > 0u ? mine : 1u; nx = cnt > 0u ? cnt : 1u;
}
__device__ __forceinline__ void xcd_barrier(const XcdBarrier& b) {
    asm volatile("s_waitcnt vmcnt(0)" ::: "memory");
    __syncthreads();
    if (threadIdx.x == 0) {
        unsigned* bar = b.bar;
        __builtin_amdgcn_s_waitcnt(0);
        unsigned nloc = b.st[0], nx = b.st[1];
        if (nloc == 0u) { xcd_barrier_complete(bar, b.x, nloc, nx); b.st[0] = nloc; b.st[1] = nx; }
        const unsigned old = xb_add(&bar[XB_XSUB(b.x)], 1u);
        const unsigned gen = old / nloc;
        if (old + 1u == (gen + 1u) * nloc) {
            __builtin_amdgcn_fence(__ATOMIC_RELEASE, "agent");
            asm volatile("s_waitcnt vmcnt(0)" ::: "memory");
            const unsigned og = xb_add(&bar[XB_TOP], 1u);
            const unsigned tg = og / nx;
            if (og + 1u == (tg + 1u) * nx) xb_add(&bar[XB_TOPGEN], 1u);
            else XB_SPIN(xb_ld(&bar[XB_TOPGEN]) == tg, bar);
            __builtin_amdgcn_fence(__ATOMIC_ACQUIRE, "agent");
            xb_add(&bar[XB_XGEN(b.x)], 1u);
            asm volatile("s_waitcnt vmcnt(0)" ::: "memory");
        } else {
            XB_SPIN(xb_ld(&bar[XB_XGEN(b.x)]) == gen, bar);
            __builtin_amdgcn_fence(__ATOMIC_ACQUIRE, "agent");
            asm volatile("s_waitcnt vmcnt(0)" ::: "memory");
        }
    }
    __syncthreads();
}

struct Args { const float* in[26]; float* out; unsigned char* ws; int ph_lo, ph_hi, li, pad; };

struct Frame {
    unsigned char* lds;
    int tid, lane, wave, vcu, G;
    const float* const* in;
    float* out; unsigned char* ws;
};
enum { I_XP = 0, I_XS, I_CK, I_CV, I_SRNN, I_C, I_CCTX, I_WMOD, I_BMOD, I_GMIX, I_GFFN, I_WIN, I_CONVW, I_CONVB, I_RGWA, I_RGBA, I_RGWI, I_RGBI, I_RGLAM, I_SINK, I_WOUT, I_PWQ, I_PSK, I_PU, I_PV, I_GFINAL };
constexpr size_t O_Y = 0, O_NEWK = (size_t)NTOK * DM, O_NEWV = O_NEWK + (size_t)NCTX * 128, O_NEWRNN = O_NEWV + (size_t)NCTX * 128;

__device__ __forceinline__ int mod_index(int tok) { return tok < NCTX ? 0 : 1 + ((tok - NCTX) >> 10); }
__device__ __forceinline__ const float* x_row(const Frame& F, int tok) { return tok < NCTX ? F.in[I_XP] + (size_t)tok * DM : F.in[I_XS] + (size_t)(tok - NCTX) * DM; }

__device__ __forceinline__ int hw_lane() { int l; asm volatile("v_mbcnt_lo_u32_b32 %0, -1, 0\n\tv_mbcnt_hi_u32_b32 %0, -1, %0" : "=v"(l)); return l; }
#define REFRESH_IDS(F) do { F.lane = hw_lane(); F.tid = F.wave * 64 + F.lane; } while (0)
template <class RowMap>
__device__ __forceinline__ void p0_transpose_item(const float* W, int K, int N, bf16* WT, float* scr, int item, int lane, RowMap rowmap, float scale = 1.f) {
    const int nblk = N / 32, kb = item / nblk, nb = item % nblk, k0 = 64 * kb, n0 = 32 * nb;
#pragma unroll 8
    for (int i = 0; i < 32; ++i) { const int kk = 2 * i + (lane >> 5); scr[kk * 33 + (lane & 31)] = W[(size_t)(k0 + kk) * N + n0 + (lane & 31)]; }
    __builtin_amdgcn_s_waitcnt(0xC07F); asm volatile("" ::: "memory");
    const int c = lane & 7;
#pragma unroll
    for (int j = 0; j < 4; ++j) { const int n = (lane >> 3) + 8 * j; const float* s = scr + (8 * c) * 33 + n;
        v4u o; o.x = pk2(s[0 * 33] * scale, s[1 * 33] * scale); o.y = pk2(s[2 * 33] * scale, s[3 * 33] * scale); o.z = pk2(s[4 * 33] * scale, s[5 * 33] * scale); o.w = pk2(s[6 * 33] * scale, s[7 * 33] * scale);
        *(v4u*)(WT + (size_t)rowmap(n0 + n) * K + k0 + 8 * c) = o; }
    __builtin_amdgcn_s_waitcnt(0xC07F); asm volatile("" ::: "memory");
}
struct MapId { __device__ __forceinline__ int operator()(int n) const { return n; } };
struct MapWin { __device__ __forceinline__ int operator()(int n) const { if (n >= 640) return n; const int hb = n & ~63, o = n & 63; return hb + ((o & 31) << 1) + (o >> 5); } };

__device__ __forceinline__ bool u_in_p2(int G) { return 2 * G - (NTOK / 256) * (D_IN / 256) == 64 && G == 256; }
__device__ __forceinline__ void quant_rows(Frame& F, int it_lo, int it_hi, int w, int nw) {
    const int lane = F.lane;
    for (int it0 = it_lo + 4 * w; it0 < it_hi; it0 += 4 * nw) {
        f32x4 a[4][4];
#pragma unroll
        for (int r = 0; r < 4; ++r) { const int it = it0 + r, tb = it >> 14, row = it & 16383;
            const float* src = (tb ? F.in[I_PV] : F.in[I_PU]) + (size_t)row * DM + 16 * lane;
#pragma unroll
            for (int j = 0; j < 4; ++j) a[r][j] = *(const f32x4*)(src + 4 * j); }
        float am[4];
#pragma unroll
        for (int r = 0; r < 4; ++r) { float m = 0.f;
#pragma unroll
            for (int j = 0; j < 4; ++j) m = fmaxf(m, fmaxf(fmaxf(fabsf(a[r][j][0]), fabsf(a[r][j][1])), fmaxf(fabsf(a[r][j][2]), fabsf(a[r][j][3]))));
            am[r] = m; }
#pragma unroll
        for (int r = 0; r < 4; ++r) am[r] = wave_max(am[r]);
#pragma unroll
        for (int r = 0; r < 4; ++r) { const int it = it0 + r, tb = it >> 14, row = it & 16383;
            if (tb) {
                const float inv = am[r] > 0.f ? 7.f / am[r] : 0.f;
                v2u o2;
#pragma unroll
                for (int h = 0; h < 2; ++h) { unsigned w = 0;
#pragma unroll
                    for (int c = 0; c < 8; ++c) { int q = (int)rintf(a[r][2 * h + (c >> 2)][c & 3] * inv); q = q > 7 ? 7 : (q < -7 ? -7 : q); w |= ((unsigned)((c & 1) ? q : q + 8) & 0xfu) << (4 * c); }
                    o2[h] = w; }
                *(v2u*)(F.ws + WS_V + (size_t)row * (DM / 2) + 8 * lane) = o2;
                if (lane == 0) ((float*)(F.ws + WS_SV))[row] = am[r] * (1.f / 7.f);
            } else {
                const float inv = am[r] > 0.f ? 7.f / am[r] : 0.f;
                v2u o2;
#pragma unroll
                for (int h = 0; h < 2; ++h) { unsigned w = 0;
#pragma unroll
                    for (int c = 0; c < 8; ++c) { int q = (int)rintf(a[r][2 * h + (c >> 2)][c & 3] * inv); q = q > 7 ? 7 : (q < -7 ? -7 : q); w |= ((unsigned)q & 0xfu) << (4 * c); }
                    o2[h] = w; }
                *(v2u*)(F.ws + WS_U + (size_t)row * (DM / 2) + 8 * lane) = o2;
                if (lane == 0) ((float*)(F.ws + WS_SU))[row] = am[r] * (1.f / 7.f);
            } }
    }
}

__device__ __forceinline__ void p0_phase(Frame& F) {
    float* ldsf = (float*)F.lds;
    const int tid = F.tid, lane = F.lane, wave = F.wave, v = F.vcu;
    if (v < 192) {
        for (int i = tid; i < NMODV * DM; i += 512) { const int j = i >> 10, d = i & 1023; const float c = (j == 0) ? F.in[I_CCTX][d] : F.in[I_C][(j - 1) * DM + d]; ldsf[i] = c * sigmoidf_(c); }
        __syncthreads();
        const int e0 = 32 * v, c4 = tid & 7, kq = tid >> 3;
        float acc[NMODV][4];
#pragma unroll
        for (int j = 0; j < NMODV; ++j) { acc[j][0] = 0.f; acc[j][1] = 0.f; acc[j][2] = 0.f; acc[j][3] = 0.f; }
        const float* wm = F.in[I_WMOD] + e0 + 4 * c4;
#pragma unroll 4
        for (int kk = 0; kk < 16; ++kk) { const int k = kq * 16 + kk; const f32x4 w = *(const f32x4*)(wm + (size_t)k * MODW);
#pragma unroll
            for (int j = 0; j < NMODV; ++j) { const float s = ldsf[j * DM + k]; acc[j][0] += s * w[0]; acc[j][1] += s * w[1]; acc[j][2] += s * w[2]; acc[j][3] += s * w[3]; } }
#pragma unroll
        for (int j = 0; j < NMODV; ++j)
#pragma unroll
            for (int i = 0; i < 4; ++i) { float a = acc[j][i]; a += __shfl_xor(a, 8); a += __shfl_xor(a, 16); a += __shfl_xor(a, 32); acc[j][i] = a; }
        float* red = ldsf + NMODV * DM;
        if (lane < 8) {
#pragma unroll
            for (int j = 0; j < NMODV; ++j)
#pragma unroll
                for (int i = 0; i < 4; ++i) red[(wave * NMODV + j) * 32 + 4 * c4 + i] = acc[j][i];
        }
        __syncthreads();
        if (tid < NMODV * 32) { const int j = tid >> 5, col = tid & 31; float s = F.in[I_BMOD][e0 + col];
#pragma unroll
            for (int w = 0; w < 8; ++w) s += red[(w * NMODV + j) * 32 + col];
            ((float*)(F.ws + WS_MODS))[j * MODW + e0 + col] = s; }
        __syncthreads();
    }
    if (v < 256) {
        const int hh = v >> 4, dt = v & 15, d0 = 64 * dt;
        float* At = ldsf;
        float* Bkt = ldsf + 128 * 64;
        const float* wq = F.in[I_PWQ] + hh * 128;
        const float* sk = F.in[I_PSK] + (size_t)hh * 128 * 128;
#pragma unroll
        for (int i = 0; i < 4; ++i) { const int f = tid + 512 * i, d = f & 63, q4 = f >> 6; const f32x4 a = *(const f32x4*)(wq + (size_t)(d0 + d) * 2048 + 4 * q4);
            At[(4 * q4 + 0) * 64 + d] = a[0]; At[(4 * q4 + 1) * 64 + d] = a[1]; At[(4 * q4 + 2) * 64 + d] = a[2]; At[(4 * q4 + 3) * 64 + d] = a[3]; }
#pragma unroll
        for (int i = 0; i < 8; ++i) { const int f = tid + 512 * i, key = f & 127, q4 = f >> 7; const f32x4 b = *(const f32x4*)(sk + (size_t)key * 128 + 4 * q4);
            Bkt[(4 * q4 + 0) * 128 + key] = b[0]; Bkt[(4 * q4 + 1) * 128 + key] = b[1]; Bkt[(4 * q4 + 2) * 128 + key] = b[2]; Bkt[(4 * q4 + 3) * 128 + key] = b[3]; }
        __syncthreads();
        const int dg = tid & 15, kg = tid >> 4;
        float acc[4][4];
#pragma unroll
        for (int i = 0; i < 4; ++i)
#pragma unroll
            for (int j = 0; j < 4; ++j) acc[i][j] = 0.f;
#pragma unroll 4
        for (int q = 0; q < 128; ++q) { const f32x4 a = *(const f32x4*)(At + q * 64 + 4 * dg); const f32x4 b = *(const f32x4*)(Bkt + q * 128 + 4 * kg);
#pragma unroll
            for (int i = 0; i < 4; ++i)
#pragma unroll
                for (int j = 0; j < 4; ++j) acc[i][j] += a[i] * b[j]; }
        bf16* WcT = (bf16*)(F.ws + WS_WC);
#pragma unroll
        for (int j = 0; j < 4; ++j) { v2u o; o.x = pk2(acc[0][j], acc[1][j]); o.y = pk2(acc[2][j], acc[3][j]);
            *(v2u*)(WcT + (size_t)(hh * 128 + 4 * kg + j) * DM + d0 + 4 * dg) = o; }
        __syncthreads();
    }
    const int gw = v * NWAVES + wave, NGW = F.G * NWAVES;
    float* scr = ldsf + wave * 4096;
    {
        constexpr int I_IN = (DM / 64) * (D_IN / 32), I_OUT = (DM / 64) * (DM / 32), I_RG = 32 * 2;
        constexpr int NIT = I_IN + I_OUT + I_RG;
        for (int it = gw; it < NIT; it += NGW) {
            int r = it;
            if (r < I_IN) { p0_transpose_item(F.in[I_WIN], DM, D_IN, (bf16*)(F.ws + WS_WIN), scr, r, lane, MapWin()); continue; } r -= I_IN;
            if (r < I_OUT) { p0_transpose_item(F.in[I_WOUT], DM, DM, (bf16*)(F.ws + WS_WOUT), scr, r, lane, MapId()); continue; } r -= I_OUT;
            { const int mm = r >> 1, sub = r & 1, dir = mm >> 4, n = (mm >> 1) & 7, gate = mm & 1;
              const float* src = (gate ? F.in[I_RGWI] : F.in[I_RGWA]) + (size_t)(dir * 8 + n) * 4096;
              bf16* dst = (bf16*)(F.ws + WS_RGW) + (size_t)((dir * 8 + n) * 2 + gate) * 4096;
              p0_transpose_item(src, 64, 64, dst, scr, sub, lane, MapId(), -LOG2E); }
        }
    }
    quant_rows(F, u_in_p2(F.G) ? 16384 : 0, 2 * 16384, gw, NGW);
    const int gt = v * 512 + tid, NGT = F.G * 512;
    for (int e = gt; e < 8 * 256 * 128; e += NGT) {
        const int c = e & 127, bp = e >> 7, kvh = c >> 6, p = c & 63, old = (p & 1) ? 32 + (p >> 1) : (p >> 1);
        ((bf16*)(F.ws + WS_CK))[e] = (bf16)f2bf(F.in[I_CK][(size_t)bp * 128 + kvh * 64 + old]);
    }
    for (int e = gt; e < 8 * 256 * 128; e += NGT) {
        const int pos = e & 255, d = (e >> 8) & 63, kvh = (e >> 14) & 1, b = e >> 15;
        ((bf16*)(F.ws + WS_CVT))[e] = (bf16)f2bf(F.in[I_CV][(size_t)(b * 256 + pos) * 128 + kvh * 64 + d]);
    }
    for (int e = gt; e < 1024 * 32; e += NGT) {
        const int s = e >> 5, i = e & 31, row = s >> 6, col = s & 63;
        const float inv = powf(10000.0f, -(float)(i & 15) / 16.0f);
        const float ang = (i < 16 ? (float)row : (float)col) * inv;
        f32x2 cs; cs.x = cosf(ang); cs.y = sinf(ang);
        ((f32x2*)(F.ws + WS_ROPE))[e] = cs;
    }
}

__device__ __forceinline__ void bias_items(Frame& F) {
    const int gw = F.vcu * NWAVES + F.wave, NGW = F.G * NWAVES, lane = F.lane;
    const float* mods = (const float*)(F.ws + WS_MODS); const bf16* WcT = (const bf16*)(F.ws + WS_WC); float* BIAS = (float*)(F.ws + WS_BIAS);
    for (int n = gw; n < 2048; n += NGW) {
        const v4u a = *(const v4u*)(WcT + (size_t)n * DM + 16 * lane), b = *(const v4u*)(WcT + (size_t)n * DM + 16 * lane + 8);
        float w[16];
        w[0] = bflo(a.x); w[1] = bfhi(a.x); w[2] = bflo(a.y); w[3] = bfhi(a.y); w[4] = bflo(a.z); w[5] = bfhi(a.z); w[6] = bflo(a.w); w[7] = bfhi(a.w);
        w[8] = bflo(b.x); w[9] = bfhi(b.x); w[10] = bflo(b.y); w[11] = bfhi(b.y); w[12] = bflo(b.z); w[13] = bfhi(b.z); w[14] = bflo(b.w); w[15] = bfhi(b.w);
#pragma unroll 1
        for (int j = 0; j < NMODV; ++j) { const float* sh = mods + (size_t)j * MODW + 3 * DM + 16 * lane; float d = 0.f;
#pragma unroll
            for (int q = 0; q < 4; ++q) { const f32x4 v = *(const f32x4*)(sh + 4 * q); d += v[0] * w[4 * q] + v[1] * w[4 * q + 1] + v[2] * w[4 * q + 2] + v[3] * w[4 * q + 3]; }
            d = wave_sum(d); if (lane == 0) BIAS[j * 2048 + n] = d; }
    }
}
__device__ __forceinline__ void norm_phase(Frame& F, int which) {
    const int gw = F.vcu * NWAVES + F.wave, NGW = F.G * NWAVES, lane = F.lane;
    const float* mods = (const float*)(F.ws + WS_MODS);
    const float* g = F.in[which ? I_GFFN : I_GMIX];
    bf16* H = (bf16*)(F.ws + WS_H);
    for (int tok = gw; tok < NTOK; tok += NGW) {
        const float* xr = which ? F.out + O_Y + (size_t)tok * DM : x_row(F, tok);
        const float* mv = mods + (size_t)mod_index(tok) * MODW + (which ? 3 * DM : 0);
        f32x4 v[4]; float ss = 0.f;
#pragma unroll
        for (int j = 0; j < 4; ++j) { v[j] = *(const f32x4*)(xr + 256 * j + 4 * lane); ss += (v[j][0] * v[j][0] + v[j][1] * v[j][1]) + (v[j][2] * v[j][2] + v[j][3] * v[j][3]); }
        const float rstd = 1.f / sqrtf(wave_sum(ss) * (1.f / DM) + EPS);
#pragma unroll
        for (int j = 0; j < 4; ++j) { const int e = 256 * j + 4 * lane;
            const f32x4 gg = *(const f32x4*)(g + e), sh = *(const f32x4*)(mv + e), sc = *(const f32x4*)(mv + DM + e);
            f32x4 o;
#pragma unroll
            for (int i = 0; i < 4; ++i) o[i] = v[j][i] * rstd * gg[i] * (1.f + sc[i]) + sh[i];
            v2u w; w.x = pk2(o[0], o[1]); w.y = pk2(o[2], o[3]); *(v2u*)(H + (size_t)tok * DM + e) = w; }
    }
}

struct EpiInProj {
    static constexpr bool PERM = true;
    bf16 *q, *k, *vT, *xr, *yg; float *newk, *newv; const f32x4* rope4;
    __device__ __forceinline__ void operator()(const f32x4 (&acc)[2][2][4][2], const pg8::Unit& u, int wr, int wc, int fr, int fq) const {
        const bool lat = u.pm >= 32;
        const int pn = u.pn;
#pragma unroll
        for (int ai = 0; ai < 2; ++ai)
#pragma unroll
            for (int m = 0; m < 4; ++m) {
                const int row = u.pm * 256 + ai * 128 + wr * 64 + m * 16 + fr;
                const int pos = lat ? ((row - NCTX) & 1023) : (row & 255);
#pragma unroll
                for (int bj = 0; bj < 2; ++bj) {
                    const int c = pn * 256 + bj * 128 + wc * 32 + 8 * fq;
                    f32x4 v0 = acc[ai][bj][m][0], v1 = acc[ai][bj][m][1];
                    if (pn < 2 || (pn == 2 && bj == 0)) {
                        const int i = (c & 63) >> 1;
                        if (lat) { const f32x4 cs0 = rope4[(pos * 32 + i) >> 1], cs1 = rope4[((pos * 32 + i) >> 1) + 1];
                            const float a0 = v0[0] * cs0[0] - v0[1] * cs0[1], a1 = v0[1] * cs0[0] + v0[0] * cs0[1];
                            const float b0 = v0[2] * cs0[2] - v0[3] * cs0[3], b1 = v0[3] * cs0[2] + v0[2] * cs0[3];
                            const float c0 = v1[0] * cs1[0] - v1[1] * cs1[1], c1 = v1[1] * cs1[0] + v1[0] * cs1[1];
                            const float d0 = v1[2] * cs1[2] - v1[3] * cs1[3], d1 = v1[3] * cs1[2] + v1[2] * cs1[3];
                            v0[0] = a0; v0[1] = a1; v0[2] = b0; v0[3] = b1; v1[0] = c0; v1[1] = c1; v1[2] = d0; v1[3] = d1; }
                        if (pn < 2) { v4u w; w.x = pk2(v0[0] * QSCALE, v0[1] * QSCALE); w.y = pk2(v0[2] * QSCALE, v0[3] * QSCALE); w.z = pk2(v1[0] * QSCALE, v1[1] * QSCALE); w.w = pk2(v1[2] * QSCALE, v1[3] * QSCALE);
                            *(v4u*)(q + (size_t)row * 512 + c) = w; }
                        else { const int kc = c - 512; v4u w; w.x = pk2(v0[0], v0[1]); w.y = pk2(v0[2], v0[3]); w.z = pk2(v1[0], v1[1]); w.w = pk2(v1[2], v1[3]); *(v4u*)(k + (size_t)row * 128 + kc) = w;
                            if (!lat) { float* nk = newk + (size_t)row * 128 + (kc & 64) + i; f32x4 lo; lo[0] = v0[0]; lo[1] = v0[2]; lo[2] = v1[0]; lo[3] = v1[2]; f32x4 hi; hi[0] = v0[1]; hi[1] = v0[3]; hi[2] = v1[1]; hi[3] = v1[3];
                                *(f32x4*)nk = lo; *(f32x4*)(nk + 32) = hi; } }
                    } else if (pn == 2) {
                        const int vc = c - 640, kvh = vc >> 6, d = vc & 63;
                        if (!lat) { *(f32x4*)(newv + (size_t)row * 128 + vc) = v0; *(f32x4*)(newv + (size_t)row * 128 + vc + 4) = v1; }
                        bf16* vp; int S;
                        if (!lat) { S = SEQ_C; vp = vT + ((size_t)((row >> 8) * 2 + kvh) * 64 + d) * SEQ_C + pos; }
                        else { S = SEQ_L; vp = vT + VT_LAT_OFF + ((size_t)(((row - NCTX) >> 10) * 2 + kvh) * 64 + d) * SEQ_L + pos; }
                        vp[0] = (bf16)f2bf(v0[0]); vp[S] = (bf16)f2bf(v0[1]); vp[2 * S] = (bf16)f2bf(v0[2]); vp[3 * S] = (bf16)f2bf(v0[3]);
                        vp[4 * S] = (bf16)f2bf(v1[0]); vp[5 * S] = (bf16)f2bf(v1[1]); vp[6 * S] = (bf16)f2bf(v1[2]); vp[7 * S] = (bf16)f2bf(v1[3]);
                    } else {
                        v4u w; w.x = pk2(v0[0], v0[1]); w.y = pk2(v0[2], v0[3]); w.z = pk2(v1[0], v1[1]); w.w = pk2(v1[2], v1[3]);
                        if (pn < 5) *(v4u*)(xr + (size_t)row * 512 + (c - 768)) = w; else *(v4u*)(yg + (size_t)row * 512 + (c - 1280)) = w;
                    }
                }
            }
    }
};
struct EpiOutProj {
    static constexpr bool PERM = true;
    const float *xp, *xs, *mods, *gffn; bf16* x1; bf16* ap; float* ssp;
    __device__ __forceinline__ void operator()(const f32x4 (&acc)[2][2][4][2], const pg8::Unit& u, int wr, int wc, int fr, int fq) const {
        const int mi = u.pm < 32 ? 0 : 1 + ((u.pm - 32) >> 2);
        const float* mv = mods + (size_t)mi * MODW;
        const int row0 = u.pm * 256 + wr * 64 + fr;
        const float* xbase = (u.pm < 32 ? xp : xs - (size_t)NCTX * DM) + (size_t)row0 * DM;
        float ssq[2][4];
#pragma unroll
        for (int ai = 0; ai < 2; ++ai)
#pragma unroll
            for (int m = 0; m < 4; ++m) ssq[ai][m] = 0.f;
#pragma unroll
        for (int bj = 0; bj < 2; ++bj) {
            const int c = u.pn * 256 + bj * 128 + wc * 32 + 8 * fq;
            const f32x4 gv0 = *(const f32x4*)(mv + 2 * DM + c), gv1 = *(const f32x4*)(mv + 2 * DM + c + 4);
            const f32x4 g20 = *(const f32x4*)(gffn + c) * (1.f + *(const f32x4*)(mv + 4 * DM + c)), g21 = *(const f32x4*)(gffn + c + 4) * (1.f + *(const f32x4*)(mv + 4 * DM + c + 4));
#pragma unroll
            for (int h4 = 0; h4 < 4; ++h4) {
                const int ai = h4 >> 1;
                f32x4 xv[2][2];
#pragma unroll
                for (int mm = 0; mm < 2; ++mm) { const float* xr = xbase + (size_t)(ai * 128 + (2 * (h4 & 1) + mm) * 16) * DM + c; xv[mm][0] = *(const f32x4*)xr; xv[mm][1] = *(const f32x4*)(xr + 4); }
                asm volatile("" ::: "memory");
#pragma unroll
                for (int mm = 0; mm < 2; ++mm) {
                    const int m = 2 * (h4 & 1) + mm;
                    const size_t off = (size_t)(row0 + ai * 128 + m * 16) * DM + c;
                    const f32x4 o0 = xv[mm][0] + gv0 * acc[ai][bj][m][0], o1 = xv[mm][1] + gv1 * acc[ai][bj][m][1];
                    { v4u xw; xw.x = pk2(o0[0], o0[1]); xw.y = pk2(o0[2], o0[3]); xw.z = pk2(o1[0], o1[1]); xw.w = pk2(o1[2], o1[3]); *(v4u*)(x1 + off) = xw; }
                    ssq[ai][m] += ((o0[0] * o0[0] + o0[1] * o0[1]) + (o0[2] * o0[2] + o0[3] * o0[3])) + ((o1[0] * o1[0] + o1[1] * o1[1]) + (o1[2] * o1[2] + o1[3] * o1[3]));
                    const f32x4 t0 = o0 * g20, t1 = o1 * g21; v4u w; w.x = pk2(t0[0], t0[1]); w.y = pk2(t0[2], t0[3]); w.z = pk2(t1[0], t1[1]); w.w = pk2(t1[2], t1[3]);
                    *(v4u*)(ap + off) = w;
                }
                asm volatile("" ::: "memory");
            }
        }
#pragma unroll
        for (int ai = 0; ai < 2; ++ai)
#pragma unroll
            for (int m = 0; m < 4; ++m) { float v = ssq[ai][m]; v += __shfl_xor(v, 16); v += __shfl_xor(v, 32);
                if (fq == 0) ssp[(size_t)(row0 + ai * 128 + m * 16) * 16 + u.pn * 4 + wc] = v; }
    }
};
struct EpiScores {
    static constexpr bool PERM = true;
    bf16* sc; const float* ssp; const float* bias;
    __device__ __forceinline__ void operator()(const f32x4 (&acc)[2][2][4][2], const pg8::Unit& u, int wr, int wc, int fr, int fq) const {
        const int mi = u.pm < 32 ? 0 : 1 + ((u.pm - 32) >> 2);
        const int row0 = u.pm * 256 + wr * 64 + fr;
        f32x4 b0[2], b1[2];
#pragma unroll
        for (int bj = 0; bj < 2; ++bj) { const int c = u.pn * 256 + bj * 128 + wc * 32 + 8 * fq; b0[bj] = *(const f32x4*)(bias + (size_t)mi * 2048 + c); b1[bj] = *(const f32x4*)(bias + (size_t)mi * 2048 + c + 4); }
#pragma unroll
        for (int h2 = 0; h2 < 4; ++h2) {
            const int ai = h2 >> 1;
            f32x4 sp[2][4];
#pragma unroll
            for (int mm = 0; mm < 2; ++mm)
#pragma unroll
                for (int q = 0; q < 4; ++q) sp[mm][q] = *((const f32x4*)(ssp + (size_t)(row0 + ai * 128 + (2 * (h2 & 1) + mm) * 16) * 16) + q);
            asm volatile("" ::: "memory");
#pragma unroll
            for (int mm = 0; mm < 2; ++mm) {
                const int m = 2 * (h2 & 1) + mm;
                const int row = row0 + ai * 128 + m * 16;
                const float ss = ((sp[mm][0][0] + sp[mm][0][1]) + (sp[mm][0][2] + sp[mm][0][3])) + ((sp[mm][1][0] + sp[mm][1][1]) + (sp[mm][1][2] + sp[mm][1][3]))
                               + ((sp[mm][2][0] + sp[mm][2][1]) + (sp[mm][2][2] + sp[mm][2][3])) + ((sp[mm][3][0] + sp[mm][3][1]) + (sp[mm][3][2] + sp[mm][3][3]));
                const float rstd = 1.f / sqrtf(ss * (1.f / DM) + EPS);
#pragma unroll
                for (int bj = 0; bj < 2; ++bj) {
                    const int c = u.pn * 256 + bj * 128 + wc * 32 + 8 * fq;
                    const f32x4 v0 = acc[ai][bj][m][0] * rstd + b0[bj], v1 = acc[ai][bj][m][1] * rstd + b1[bj];
                    v4u w; w.x = pk2(v0[0], v0[1]); w.y = pk2(v0[2], v0[3]); w.z = pk2(v1[0], v1[1]); w.w = pk2(v1[2], v1[3]);
                    *(v4u*)(sc + (size_t)row * 2048 + c) = w;
                }
            }
            asm volatile("" ::: "memory");
        }
    }
};

__device__ __forceinline__ void attn_unit(Frame& F, bool lat, int seq, int kvh, int qt) {
    const int tid = F.tid, lane = F.lane, wave = F.wave, r32 = lane & 31, hi = lane >> 5;
    const int g = wave >> 1, qs = wave & 1, head = kvh * 4 + g;
    const int S = lat ? SEQ_L : SEQ_C, tokbase = lat ? NCTX + seq * SEQ_L : seq * SEQ_C;
    const int q0 = qt * 64, qpos = q0 + 32 * qs + r32;
    const bf16* Q = (const bf16*)(F.ws + WS_Q); const bf16* Kb = (const bf16*)(F.ws + WS_K); const bf16* VT = (const bf16*)(F.ws + WS_VT);
    const bf16* CK = (const bf16*)(F.ws + WS_CK); const bf16* CVT = (const bf16*)(F.ws + WS_CVT);
    unsigned char* ldsK = F.lds; unsigned char* ldsV = F.lds + 8192;
    bf16x8 qf[4];
    { const bf16* qp = Q + (size_t)(tokbase + qpos) * 512 + head * 64;
#pragma unroll
      for (int ks = 0; ks < 4; ++ks) qf[ks] = *(const bf16x8*)(qp + 16 * ks + 8 * hi); }
    const float sinkl = F.in[I_SINK][head] * LOG2E;
    float mrun = sinkl, lrun = (hi == 0) ? 1.f : 0.f;
    f32x16 o0, o1;
#pragma unroll
    for (int r = 0; r < 16; ++r) { o0[r] = 0.f; o1[r] = 0.f; }
    int tlo, thi;
    if (lat) { tlo = (q0 >= 128 ? q0 - 128 : 0) >> 6; thi = ((q0 + 192 < S ? q0 + 192 : S)) >> 6; } else { tlo = 0; thi = 4; }
    const int nband = thi - tlo, ntile = nband + (lat ? 4 : 0);
    const int key_t = tid >> 3, ch_t = tid & 7;
    v4u kv, vv;
#define AT_LOAD(t_) do { const int tt_ = (t_); const bf16* kptr; const bf16* vptr; int vstride; \
        if (tt_ < nband) { const int kb_ = (tlo + tt_) * 64; kptr = Kb + (size_t)(tokbase + kb_) * 128 + kvh * 64; \
            vptr = VT + (lat ? (size_t)VT_LAT_OFF + (size_t)((seq * 2 + kvh) * 64) * SEQ_L : (size_t)((seq * 2 + kvh) * 64) * SEQ_C) + kb_; vstride = S; } \
        else { const int tc = tt_ - nband; kptr = CK + (size_t)(seq * 256 + tc * 64) * 128 + kvh * 64; vptr = CVT + (size_t)((seq * 2 + kvh) * 64) * 256 + tc * 64; vstride = 256; } \
        kv = *(const v4u*)(kptr + (size_t)key_t * 128 + ch_t * 8); vv = *(const v4u*)(vptr + (size_t)key_t * vstride + ch_t * 8); } while (0)
    AT_LOAD(0);
    for (int t = 0; t < ntile; ++t) {
        const bool band = t < nband;
        const int kbase = band ? (tlo + t) * 64 : 0;
        __syncthreads();
        *(v4u*)(ldsK + key_t * 128 + ((ch_t ^ (key_t & 7)) * 16)) = kv;
        *(v4u*)(ldsV + key_t * 128 + ((ch_t ^ (key_t & 7)) * 16)) = vv;
        __syncthreads();
        f32x16 p0, p1;
#pragma unroll
        for (int r = 0; r < 16; ++r) { p0[r] = 0.f; p1[r] = 0.f; }
#pragma unroll
        for (int ks = 0; ks < 4; ++ks) {
            const int sw = ((2 * ks + hi) ^ (r32 & 7)) * 16;
            const bf16x8 a0 = *(const bf16x8*)(ldsK + r32 * 128 + sw);
            const bf16x8 a1 = *(const bf16x8*)(ldsK + (32 + r32) * 128 + sw);
            p0 = __builtin_amdgcn_mfma_f32_32x32x16_bf16(a0, qf[ks], p0, 0, 0, 0);
            p1 = __builtin_amdgcn_mfma_f32_32x32x16_bf16(a1, qf[ks], p1, 0, 0, 0);
        }
        if (t + 1 < ntile) AT_LOAD(t + 1);
        if (band && lat && (kbase < q0 + 63 - 128 || kbase + 63 > q0 + 128)) {
#pragma unroll
            for (int r = 0; r < 16; ++r) { const int kp = kbase + crow(r, hi); int d0 = qpos - kp; d0 = d0 < 0 ? -d0 : d0; int d1 = qpos - kp - 32; d1 = d1 < 0 ? -d1 : d1;
                if (d0 > 128) p0[r] = -INFINITY; if (d1 > 128) p1[r] = -INFINITY; }
        }
        float tm = p0[0];
#pragma unroll
        for (int r = 1; r < 16; ++r) tm = fmaxf(tm, p0[r]);
#pragma unroll
        for (int r = 0; r < 16; ++r) tm = fmaxf(tm, p1[r]);
        tm = fmaxf(tm, __shfl_xor(tm, 32));
        const float mn = fmaxf(mrun, tm), alpha = __builtin_amdgcn_exp2f(mrun - mn); mrun = mn;
        float ls = 0.f;
#pragma unroll
        for (int r = 0; r < 16; ++r) { p0[r] = __builtin_amdgcn_exp2f(p0[r] - mn); p1[r] = __builtin_amdgcn_exp2f(p1[r] - mn); ls += p0[r] + p1[r]; o0[r] *= alpha; o1[r] *= alpha; }
        lrun = lrun * alpha + ls;
        bf16x8 pf[4];
#pragma unroll
        for (int s = 0; s < 2; ++s) {
            v4u w0, w1;
            w0.x = pk2(p0[8 * s + 0], p0[8 * s + 1]); w0.y = pk2(p0[8 * s + 2], p0[8 * s + 3]); w0.z = pk2(p0[8 * s + 4], p0[8 * s + 5]); w0.w = pk2(p0[8 * s + 6], p0[8 * s + 7]);
            w1.x = pk2(p1[8 * s + 0], p1[8 * s + 1]); w1.y = pk2(p1[8 * s + 2], p1[8 * s + 3]); w1.z = pk2(p1[8 * s + 4], p1[8 * s + 5]); w1.w = pk2(p1[8 * s + 6], p1[8 * s + 7]);
            pf[s] = __builtin_bit_cast(bf16x8, w0); pf[2 + s] = __builtin_bit_cast(bf16x8, w1);
        }
#pragma unroll
        for (int s4 = 0; s4 < 4; ++s4) {
#pragma unroll
            for (int dt = 0; dt < 2; ++dt) {
                const int d = 32 * dt + r32;
                const v2u lo = *(const v2u*)(ldsV + d * 128 + (((2 * s4) ^ (d & 7)) * 16) + 8 * hi);
                const v2u hi2 = *(const v2u*)(ldsV + d * 128 + (((2 * s4 + 1) ^ (d & 7)) * 16) + 8 * hi);
                v4u vf4; vf4.x = lo.x; vf4.y = lo.y; vf4.z = hi2.x; vf4.w = hi2.y;
                const bf16x8 vf = __builtin_bit_cast(bf16x8, vf4);
                if (dt == 0) o0 = __builtin_amdgcn_mfma_f32_32x32x16_bf16(vf, pf[s4], o0, 0, 0, 0);
                else o1 = __builtin_amdgcn_mfma_f32_32x32x16_bf16(vf, pf[s4], o1, 0, 0, 0);
            }
        }
    }
    const float ltot = lrun + __shfl_xor(lrun, 32), inv = 1.f / ltot;
    bf16* mix = (bf16*)(F.ws + WS_MIX) + (size_t)(tokbase + qpos) * DM + head * 64;
#pragma unroll
    for (int g4 = 0; g4 < 4; ++g4) {
        v2u w; w.x = pk2(o0[4 * g4] * inv, o0[4 * g4 + 1] * inv); w.y = pk2(o0[4 * g4 + 2] * inv, o0[4 * g4 + 3] * inv);
        *(v2u*)(mix + 8 * g4 + 4 * hi) = w;
        v2u w2; w2.x = pk2(o1[4 * g4] * inv, o1[4 * g4 + 1] * inv); w2.y = pk2(o1[4 * g4 + 2] * inv, o1[4 * g4 + 3] * inv);
        *(v2u*)(mix + 32 + 8 * g4 + 4 * hi) = w2;
    }
    __syncthreads();
}

constexpr int RL_HALF = 49152;
constexpr int RL_XCB = 32768;
constexpr int RL_AGG = 98304;
constexpr int RL_CARRY = RL_AGG + 8192;
constexpr int RL_CW = RL_CARRY + 512;
constexpr int RL_WG = RL_CW + 1280;
static_assert(RL_WG + 32768 <= LDSCTL_OFF, "RNN LDS map");
__device__ __forceinline__ float fsigmoid(float x) { return __builtin_amdgcn_rcpf(1.f + __expf(-x)); }
__device__ __forceinline__ float gelu_fast(float x) { const float y = 0.7978845608028654f * (x + 0.044715f * x * x * x); const float e = __expf(2.f * y); return x - x * __builtin_amdgcn_rcpf(1.f + e); }

template <bool REV>
__device__ __forceinline__ void scan_prep(const float (&a)[16], const float (&b)[16], int h, float (&Apre)[4], float (&Bpre)[4], float& At, float& Bt) {
    float Ao[4], Bo[4], Ap[4], Bp[4];
#pragma unroll
    for (int g = 0; g < 4; ++g) { float A = 1.f, B = 0.f;
#pragma unroll
        for (int ii = 0; ii < 4; ++ii) { const int r = 4 * g + (REV ? 3 - ii : ii); B = a[r] * B + b[r]; A = a[r] * A; }
        Ao[g] = A; Bo[g] = B; }
#pragma unroll
    for (int g = 0; g < 4; ++g) { Ap[g] = __shfl_xor(Ao[g], 32); Bp[g] = __shfl_xor(Bo[g], 32); }
    const bool ownfirst = REV ? (h == 1) : (h == 0);
    float Ac = 1.f, Bc = 0.f;
#pragma unroll
    for (int gi = 0; gi < 4; ++gi) { const int g = REV ? 3 - gi : gi;
        const float A1 = ownfirst ? Ao[g] : Ap[g], B1 = ownfirst ? Bo[g] : Bp[g], A2 = ownfirst ? Ap[g] : Ao[g], B2 = ownfirst ? Bp[g] : Bo[g];
        const float Ac1 = A1 * Ac, Bc1 = A1 * Bc + B1;
        Apre[g] = ownfirst ? Ac : Ac1; Bpre[g] = ownfirst ? Bc : Bc1;
        Ac = A2 * Ac1; Bc = A2 * Bc1 + B2; }
    At = Ac; Bt = Bc;
}
template <bool REV>
__device__ __forceinline__ void scan_finish(const float (&a)[16], const float (&b)[16], const float (&Apre)[4], const float (&Bpre)[4], float hin, float* hp, int hi) {
#pragma unroll
    for (int g = 0; g < 4; ++g) { float hc = Apre[g] * hin + Bpre[g];
#pragma unroll
        for (int ii = 0; ii < 4; ++ii) { const int r = 4 * g + (REV ? 3 - ii : ii); hc = a[r] * hc + b[r]; hp[(size_t)crow(r, hi) * 512] = hc; } }
}

template <bool REV>
__device__ __forceinline__ void rnn_dir(Frame& F, bool lat, int seq, int n) {
    const int lane = F.lane, w4 = F.wave & 3, r32 = lane & 31, hi = lane >> 5, dirh = REV ? 1 : 0;
    const int S = lat ? SEQ_L : SEQ_C, tokbase = lat ? NCTX + seq * SEQ_L : seq * SEQ_C, nchunk = S / 128;
    unsigned char* hb = F.lds + dirh * RL_HALF;
    float* XC32 = (float*)hb; unsigned char* XCB = hb + RL_XCB;
    f32x2* AGG = (f32x2*)(F.lds + RL_AGG) + dirh * 256; float* CARRY = (float*)(F.lds + RL_CARRY) + dirh * 64; const float* CW = (const float*)(F.lds + RL_CW);
    const unsigned char* WG = F.lds + RL_WG + dirh * 16384;
    const bf16* XR = (const bf16*)(F.ws + WS_XR) + (size_t)tokbase * 512 + n * 64;
    float* HX = (float*)(F.ws + (REV ? WS_H : WS_HF)) + (size_t)tokbase * 512 + n * 64;
    const int t = F.tid & 255, c8 = t & 7, tg = t >> 3;
    float ba[2], bi[2], sp8[2];
#pragma unroll
    for (int chh = 0; chh < 2; ++chh) { const int pe = dirh * 512 + n * 64 + chh * 32 + r32; ba[chh] = -LOG2E * F.in[I_RGBA][pe]; bi[chh] = -LOG2E * F.in[I_RGBI][pe];
        const float nl = -F.in[I_RGLAM][pe]; sp8[chh] = -8.f * LOG2E * (nl > 20.f ? nl : log1pf(__expf(nl))); }
    v4u xin[7];
#define RL_XLOAD(c0_) do { _Pragma("unroll") for (int i = 0; i < 7; ++i) { const int pos = (c0_) + 4 * tg - 2 + i; \
        xin[i] = (pos >= 0 && pos < S) ? *(const v4u*)(XR + (size_t)pos * 512 + 8 * c8) : (v4u){0u, 0u, 0u, 0u}; } } while (0)
    RL_XLOAD((REV ? nchunk - 1 : 0) * 128);
    float newcarry[2] = {0.f, 0.f};
    const bool last_tile = REV ? (w4 == 0) : (w4 == 3);
#pragma unroll 1
    for (int k = 0; k < nchunk; ++k) {
        const int c0 = (REV ? nchunk - 1 - k : k) * 128;
        {
            const f32x4 b0 = *(const f32x4*)(CW + 256 + 8 * c8), b1 = *(const f32x4*)(CW + 256 + 8 * c8 + 4);
            f32x4 wt0[4], wt1[4];
#pragma unroll
            for (int tap = 0; tap < 4; ++tap) { wt0[tap] = *(const f32x4*)(CW + tap * 64 + 8 * c8); wt1[tap] = *(const f32x4*)(CW + tap * 64 + 8 * c8 + 4); }
#pragma unroll
            for (int i = 0; i < 4; ++i) {
                f32x4 y0 = b0, y1 = b1;
#pragma unroll
                for (int tap = 0; tap < 4; ++tap) { const v4u x = xin[i + tap];
                    y0[0] += wt0[tap][0] * bflo(x.x); y0[1] += wt0[tap][1] * bfhi(x.x); y0[2] += wt0[tap][2] * bflo(x.y); y0[3] += wt0[tap][3] * bfhi(x.y);
                    y1[0] += wt1[tap][0] * bflo(x.z); y1[1] += wt1[tap][1] * bfhi(x.z); y1[2] += wt1[tap][2] * bflo(x.w); y1[3] += wt1[tap][3] * bfhi(x.w); }
                const int tk = 4 * tg + i;
                *(f32x4*)(XC32 + tk * 64 + 8 * c8) = y0; *(f32x4*)(XC32 + tk * 64 + 8 * c8 + 4) = y1;
                v4u w; w.x = pk2(y0[0], y0[1]); w.y = pk2(y0[2], y0[3]); w.z = pk2(y1[0], y1[1]); w.w = pk2(y1[2], y1[3]);
                *(v4u*)(XCB + tk * 128 + ((c8 ^ (tk & 7)) * 16)) = w; }
        }
        if (k + 1 < nchunk) RL_XLOAD((REV ? nchunk - 2 - k : k + 1) * 128);
        __syncthreads();
        if (k > 0 && last_tile && hi == 0) { CARRY[r32] = newcarry[0]; CARRY[32 + r32] = newcarry[1]; }
        const int tkA = 32 * w4 + r32;
#pragma unroll
        for (int chh = 0; chh < 2; ++chh) {
            const int che = chh * 32 + r32;
            float av[16], bv[16], Apre[4], Bpre[4];
            {
                f32x16 ga, gi;
#pragma unroll
                for (int r = 0; r < 16; ++r) { ga[r] = 0.f; gi[r] = 0.f; }
#pragma unroll
                for (int ks = 0; ks < 4; ++ks) {
                    const bf16x8 af = *(const bf16x8*)(XCB + tkA * 128 + (((2 * ks + hi) ^ (tkA & 7)) * 16));
                    const bf16x8 wa = *(const bf16x8*)(WG + che * 128 + (((2 * ks + hi) ^ (che & 7)) * 16));
                    const bf16x8 wi = *(const bf16x8*)(WG + 8192 + che * 128 + (((2 * ks + hi) ^ (che & 7)) * 16));
                    ga = __builtin_amdgcn_mfma_f32_32x32x16_bf16(af, wa, ga, 0, 0, 0);
                    gi = __builtin_amdgcn_mfma_f32_32x32x16_bf16(af, wi, gi, 0, 0, 0);
                }
#pragma unroll
                for (int r = 0; r < 16; ++r) { const int tk2 = 32 * w4 + crow(r, hi); const float x = XC32[tk2 * 64 + che];
                    const float rg = __builtin_amdgcn_rcpf(1.f + __builtin_amdgcn_exp2f(ga[r] + ba[chh])), ig = __builtin_amdgcn_rcpf(1.f + __builtin_amdgcn_exp2f(gi[r] + bi[chh])), a = __builtin_amdgcn_exp2f(rg * sp8[chh]);
                    av[r] = a; bv[r] = __builtin_amdgcn_sqrtf(fmaxf(1.f - a * a, 0.f)) * ig * x;
                    if ((r & 3) == 3) __builtin_amdgcn_sched_barrier(0); }
                float At, Bt;
                scan_prep<REV>(av, bv, hi, Apre, Bpre, At, Bt);
                if (hi == 0) { f32x2 ab; ab.x = At; ab.y = Bt; AGG[chh * 512 + w4 * 64 + che] = ab; }
            }
            __syncthreads();
            {
                float hin = CARRY[che];
                if (!REV) { for (int t2 = 0; t2 < w4; ++t2) { const f32x2 ab = AGG[chh * 512 + t2 * 64 + che]; hin = ab.x * hin + ab.y; } }
                else { for (int t2 = 3; t2 > w4; --t2) { const f32x2 ab = AGG[chh * 512 + t2 * 64 + che]; hin = ab.x * hin + ab.y; } }
                scan_finish<REV>(av, bv, Apre, Bpre, hin, HX + (size_t)(c0 + 32 * w4) * 512 + che, hi);
                if (last_tile) { const f32x2 ab = AGG[chh * 512 + w4 * 64 + che]; newcarry[chh] = ab.x * hin + ab.y; }
            }
        }
    }
#undef RL_XLOAD
    if (!lat && last_tile && hi == 0) { float* o = F.out + O_NEWRNN + (size_t)(seq * 2 + dirh) * 512 + n * 64; o[r32] = newcarry[0]; o[32 + r32] = newcarry[1]; }
}

__device__ __forceinline__ void rnn_unit(Frame& F, bool lat, int seq, int n) {
    const int tid = F.tid;
    const int S = lat ? SEQ_L : SEQ_C, tokbase = lat ? NCTX + seq * SEQ_L : seq * SEQ_C;
    __syncthreads();
    { float* CW = (float*)(F.lds + RL_CW); float* CARRY = (float*)(F.lds + RL_CARRY);
      if (tid < 320) CW[tid] = tid < 256 ? F.in[I_CONVW][(tid >> 6) * 512 + n * 64 + (tid & 63)] : F.in[I_CONVB][n * 64 + (tid - 256)];
      if (tid < 128) CARRY[tid] = lat ? F.in[I_SRNN][(size_t)(seq * 2 + (tid >> 6)) * 512 + n * 64 + (tid & 63)] : 0.f;
      const bf16* rgw = (const bf16*)(F.ws + WS_RGW);
#pragma unroll
      for (int i = 0; i < 4; ++i) { const int q = tid + 512 * i, ch = q & 7, d = (q >> 3) & 63, gate = (q >> 9) & 1, dir = q >> 10;
          const v4u w = *(const v4u*)(rgw + (size_t)((dir * 8 + n) * 2 + gate) * 4096 + d * 64 + ch * 8);
          *(v4u*)(F.lds + RL_WG + dir * 16384 + gate * 8192 + d * 128 + ((ch ^ (d & 7)) * 16)) = w; } }
    __syncthreads();
    if (F.wave < 4) rnn_dir<false>(F, lat, seq, n); else rnn_dir<true>(F, lat, seq, n);
    __syncthreads();
    { const int c4 = tid & 15, tk = tid >> 4;
      const float* HF = (const float*)(F.ws + WS_HF) + (size_t)tokbase * 512 + n * 64 + 4 * c4;
      const float* HB = (const float*)(F.ws + WS_H) + (size_t)tokbase * 512 + n * 64 + 4 * c4;
      const bf16* YG = (const bf16*)(F.ws + WS_YG) + (size_t)tokbase * 512 + n * 64 + 4 * c4;
      bf16* MIX = (bf16*)(F.ws + WS_MIX) + (size_t)tokbase * DM + 512 + n * 64 + 4 * c4;
      for (int t0 = tk; t0 < S; t0 += 32) {
          const f32x4 a = *(const f32x4*)(HF + (size_t)t0 * 512), b = *(const f32x4*)(HB + (size_t)t0 * 512); const v2u y = *(const v2u*)(YG + (size_t)t0 * 512);
          v2u o; o.x = pk2((a[0] + b[0]) * gelu_fast(bflo(y.x)), (a[1] + b[1]) * gelu_fast(bfhi(y.x))); o.y = pk2((a[2] + b[2]) * gelu_fast(bflo(y.y)), (a[3] + b[3]) * gelu_fast(bfhi(y.y)));
          *(v2u*)(MIX + (size_t)t0 * DM) = o; } }
    __syncthreads();
}

#ifndef MK_P3_TYPES
#define MK_P3_TYPES 15
#endif
__device__ __forceinline__ void p3_phase(Frame& F, int types = 15) {
    const int v = F.vcu;
#pragma unroll 1
    for (int i = 0; i < 832; ++i) {
        int type, idx;
        if (F.G == 256) {
            if (v < 64) { if (i > 0) break; type = 0; idx = v; }
            else { if (i >= 6) break; const int j = v - 64, sl = i >> 1, rep = i & 1; type = 1 + sl;
                const bool extra = sl == 0 ? (j < 64) : (sl == 1 ? (j >= 64 && j < 128) : (j >= 128));
                if (rep && !extra) continue; idx = rep ? 192 + (j - 64 * sl) : j; }
        } else { const int it = v + i * F.G; if (it >= 832) break;
            if (it < 64) { type = 0; idx = it; } else if (it < 320) { type = 1; idx = it - 64; } else if (it < 576) { type = 2; idx = it - 320; } else { type = 3; idx = it - 576; } }
        if (!((types >> type) & 1)) continue;
        const bool lat = type < 2;
        Frame L = F; asm volatile("" : "+v"(L.tid)); L.lane = L.tid & 63;
        asm volatile("" : "+s"(L.ws), "+s"(L.out));
        if ((type & 1) == 0) rnn_unit(L, lat, idx >> 3, idx & 7);
        else { if (lat) attn_unit(L, true, idx >> 5, (idx >> 4) & 1, idx & 15); else attn_unit(L, false, idx >> 3, (idx >> 2) & 1, idx & 3); }
    }
}

__device__ __forceinline__ unsigned key16(unsigned b, unsigned idx) { const unsigned s = (b & 0x8000u) ? (~b & 0xffffu) : (b | 0x8000u); return (s << 16) | idx; }
__device__ __forceinline__ float keyval16(unsigned k) { const unsigned s = k >> 16; const unsigned b = (s & 0x8000u) ? (s & 0x7fffu) : (~s & 0xffffu); return bf2f(b); }
__device__ __forceinline__ unsigned sortable32(float f) { const unsigned u = __builtin_bit_cast(unsigned, f); return (u & 0x80000000u) ? ~u : (u | 0x80000000u); }
template <int CTRL> __device__ __forceinline__ unsigned dppu(unsigned v) { return (unsigned)__builtin_amdgcn_update_dpp(0, (int)v, CTRL, 0xf, 0xf, true); }
template <int CTRL> __device__ __forceinline__ float dppf(float v) { return __builtin_bit_cast(float, __builtin_amdgcn_update_dpp(0, __builtin_bit_cast(int, v), CTRL, 0xf, 0xf, true)); }
__device__ __forceinline__ unsigned umax_(unsigned a, unsigned b) { return a > b ? a : b; }
__device__ __forceinline__ unsigned umin_(unsigned a, unsigned b) { return a < b ? a : b; }
__device__ __forceinline__ unsigned rowmax16u(unsigned x) { x = umax_(x, dppu<0xB1>(x)); x = umax_(x, dppu<0x4E>(x)); x = umax_(x, dppu<0x141>(x)); x = umax_(x, dppu<0x140>(x)); return x; }
__device__ __forceinline__ float rowmax16f(float x) { x = fmaxf(x, dppf<0xB1>(x)); x = fmaxf(x, dppf<0x4E>(x)); x = fmaxf(x, dppf<0x141>(x)); x = fmaxf(x, dppf<0x140>(x)); return x; }
__device__ __forceinline__ float rowsum16f(float x) { x += dppf<0xB1>(x); x += dppf<0x4E>(x); x += dppf<0x141>(x); x += dppf<0x140>(x); return x; }
__device__ __forceinline__ int rowsum16i(int x) { x += (int)dppu<0xB1>((unsigned)x); x += (int)dppu<0x4E>((unsigned)x); x += (int)dppu<0x141>((unsigned)x); x += (int)dppu<0x140>((unsigned)x); return x; }
#define CEX(a, b) do { const unsigned _h = umax_(a, b), _l = umin_(a, b); a = _h; b = _l; } while (0)

#ifndef P7_NCH
#define P7_NCH 8
#endif
constexpr int P7_CSH = (P7_NCH == 4 ? 12 : (P7_NCH == 8 ? 11 : (P7_NCH == 16 ? 10 : 9)));
constexpr int P7_WL = 16384;
constexpr int P7_TL = 0, P7_TE = 1024, P7_TG = 3072, P7_LE = 5120, P7_LG = 7168, P7_LSU = 9216, P7_LQ = 11264, P7_H2Q = 12160, P7_HST = 16256;
static_assert(P7_LQ + 512 <= P7_H2Q && (P7_H2Q % 16) == 0 && P7_HST + 16 <= P7_WL && P7_WL * 8 <= RING_BYTES, "P7 LDS map");

__device__ __forceinline__ float tkval(unsigned k) { return __builtin_bit_cast(float, k & 0xffff0000u); }
#define TKX(a, b) do { unsigned hi_, lo_; asm("v_max_f32 %0, %1, %2" : "=v"(hi_) : "v"(a), "v"(b)); asm("v_min_f32 %0, %1, %2" : "=v"(lo_) : "v"(a), "v"(b)); a = hi_; b = lo_; } while (0)
#define TK_SORT16(c) do { TKX(c[0], c[1]); TKX(c[2], c[3]); TKX(c[0], c[2]); TKX(c[1], c[3]); TKX(c[1], c[2]); TKX(c[4], c[5]); TKX(c[6], c[7]); TKX(c[4], c[6]); TKX(c[5], c[7]); TKX(c[5], c[6]); TKX(c[0], c[4]); TKX(c[2], c[6]); TKX(c[2], c[4]); TKX(c[1], c[5]); TKX(c[3], c[7]); TKX(c[3], c[5]); TKX(c[1], c[2]); TKX(c[3], c[4]); TKX(c[5], c[6]); TKX(c[8], c[9]); TKX(c[10], c[11]); TKX(c[8], c[10]); TKX(c[9], c[11]); TKX(c[9], c[10]); TKX(c[12], c[13]); TKX(c[14], c[15]); TKX(c[12], c[14]); TKX(c[13], c[15]); TKX(c[13], c[14]); TKX(c[8], c[12]); TKX(c[10], c[14]); TKX(c[10], c[12]); TKX(c[9], c[13]); TKX(c[11], c[15]); TKX(c[11], c[13]); TKX(c[9], c[10]); TKX(c[11], c[12]); TKX(c[13], c[14]); TKX(c[0], c[8]); TKX(c[4], c[12]); TKX(c[4], c[8]); TKX(c[2], c[10]); TKX(c[6], c[14]); TKX(c[6], c[10]); TKX(c[2], c[4]); TKX(c[6], c[8]); TKX(c[10], c[12]); TKX(c[1], c[9]); TKX(c[5], c[13]); TKX(c[5], c[9]); TKX(c[3], c[11]); TKX(c[7], c[15]); TKX(c[7], c[11]); TKX(c[3], c[5]); TKX(c[7], c[9]); TKX(c[11], c[13]); TKX(c[1], c[2]); TKX(c[3], c[4]); TKX(c[5], c[6]); TKX(c[7], c[8]); TKX(c[9], c[10]); TKX(c[11], c[12]); TKX(c[13], c[14]); } while (0)
#define TK_BITONIC16(c) do { TKX(c[0], c[8]); TKX(c[1], c[9]); TKX(c[2], c[10]); TKX(c[3], c[11]); TKX(c[4], c[12]); TKX(c[5], c[13]); TKX(c[6], c[14]); TKX(c[7], c[15]); TKX(c[0], c[4]); TKX(c[1], c[5]); TKX(c[2], c[6]); TKX(c[3], c[7]); TKX(c[8], c[12]); TKX(c[9], c[13]); TKX(c[10], c[14]); TKX(c[11], c[15]); TKX(c[0], c[2]); TKX(c[1], c[3]); TKX(c[4], c[6]); TKX(c[5], c[7]); TKX(c[8], c[10]); TKX(c[9], c[11]); TKX(c[12], c[14]); TKX(c[13], c[15]); TKX(c[0], c[1]); TKX(c[2], c[3]); TKX(c[4], c[5]); TKX(c[6], c[7]); TKX(c[8], c[9]); TKX(c[10], c[11]); TKX(c[12], c[13]); TKX(c[14], c[15]); } while (0)
__device__ __forceinline__ void topk_stage1(const bf16* SC, int tok0, int lane, unsigned* TL4) {
    const v4u* src = (const v4u*)(SC + (size_t)(tok0 + (lane >> 4)) * 2048 + (lane & 15) * 128);
    unsigned T[16];
#pragma unroll
    for (int ch = 0; ch < 8; ++ch) {
        const v4u r0 = src[2 * ch], r1 = src[2 * ch + 1];
        unsigned c[16];
#pragma unroll
        for (int m = 0; m < 4; ++m) { c[2 * m] = (r0[m] << 16) | (unsigned)(16 * ch + 2 * m); c[2 * m + 1] = (r0[m] & 0xffff0000u) | (unsigned)(16 * ch + 2 * m + 1);
                                      c[8 + 2 * m] = (r1[m] << 16) | (unsigned)(16 * ch + 8 + 2 * m); c[8 + 2 * m + 1] = (r1[m] & 0xffff0000u) | (unsigned)(16 * ch + 8 + 2 * m + 1); }
        TK_SORT16(c);
        if (ch == 0) {
#pragma unroll
            for (int i = 0; i < 16; ++i) T[i] = c[i];
        } else {
#pragma unroll
            for (int i = 0; i < 16; ++i) { unsigned m_; asm("v_max_f32 %0, %1, %2" : "=v"(m_) : "v"(T[i]), "v"(c[15 - i])); T[i] = m_; }
            TK_BITONIC16(T);
        }
    }
    v4u* dst = (v4u*)(TL4 + lane * 16);
#pragma unroll
    for (int q = 0; q < 4; ++q) { v4u o; o.x = T[4 * q]; o.y = T[4 * q + 1]; o.z = T[4 * q + 2]; o.w = T[4 * q + 3]; dst[q] = o; }
}
#define TK_POP4(C, KEEP, it) do { const unsigned m_ = rowmax16u(C[0]); const bool w_ = C[0] == m_; C[0] = w_ ? C[1] : C[0]; C[1] = w_ ? C[2] : C[1]; C[2] = w_ ? C[3] : C[2]; C[3] = w_ ? 0u : C[3]; KEEP = (k == (it)) ? m_ : KEEP; } while (0)
__device__ __forceinline__ void topk_stage2(const unsigned* TL, int lane, const unsigned ctabp, int* oute, float* outg) {
    const int k = lane & 15, row = lane >> 4;
    unsigned ca[4], cb[4];
    const unsigned* LAa = TL + (2 * row) * 16; const unsigned* LBa = TL + (2 * row + 1) * 16;
    const unsigned* LAb = TL + (2 * (4 + row)) * 16; const unsigned* LBb = TL + (2 * (4 + row) + 1) * 16;
#pragma unroll
    for (int s = 0; s < 4; ++s) { const int ij = (int)((ctabp >> (8 * s)) & 0xffu); const bool valid = ij != 255; const int i = (ij >> 4) & 15, j = ij & 15;
        const float sa = tkval(LAa[i]) + tkval(LBa[j]), sb = tkval(LAb[i]) + tkval(LBb[j]);
        ca[s] = valid ? ((sortable32(sa) & 0xffffff00u) | (unsigned)(i * 16 + j)) : 0u; cb[s] = valid ? ((sortable32(sb) & 0xffffff00u) | (unsigned)(i * 16 + j)) : 0u; }
    CEX(ca[0], ca[1]); CEX(ca[2], ca[3]); CEX(ca[0], ca[2]); CEX(ca[1], ca[3]); CEX(ca[1], ca[2]);
    CEX(cb[0], cb[1]); CEX(cb[2], cb[3]); CEX(cb[0], cb[2]); CEX(cb[1], cb[3]); CEX(cb[1], cb[2]);
    unsigned keepa = 0, keepb = 0;
#pragma unroll
    for (int it = 0; it < 16; ++it) { TK_POP4(ca, keepa, it); TK_POP4(cb, keepb, it); }
    {
        const unsigned kaa = LAa[(keepa >> 4) & 15], kba = LBa[keepa & 15], kab = LAb[(keepb >> 4) & 15], kbb = LBb[keepb & 15];
        const float bva = tkval(kaa) + tkval(kba), bvb = tkval(kab) + tkval(kbb);
        const float mxa = rowmax16f(bva), mxb = rowmax16f(bvb); const float exa = __expf(bva - mxa), exb = __expf(bvb - mxb); const float sma = rowsum16f(exa), smb = rowsum16f(exb);
        oute[lane] = (int)((kaa & 127u) * 128u + (kba & 127u)); outg[lane] = exa / sma;
        oute[64 + lane] = (int)((kab & 127u) * 128u + (kbb & 127u)); outg[64 + lane] = exb / smb;
    }
}
#undef TK_POP4

__device__ __forceinline__ void gl16x4(v4u (&r)[4], unsigned voff, const unsigned char* b0, const unsigned char* b1, const unsigned char* b2, const unsigned char* b3) {
    asm volatile("s_nop 4\n\tglobal_load_dwordx4 %0, %4, %5\n\tglobal_load_dwordx4 %1, %4, %6\n\tglobal_load_dwordx4 %2, %4, %7\n\tglobal_load_dwordx4 %3, %4, %8"
                 : "=&v"(r[0]), "=&v"(r[1]), "=&v"(r[2]), "=&v"(r[3]) : "v"(voff), "s"(b0), "s"(b1), "s"(b2), "s"(b3) : "memory");
}
#define P7_VMWAIT(N, R) asm volatile("s_waitcnt vmcnt(" #N ")" : "+v"(R[0]), "+v"(R[1]), "+v"(R[2]), "+v"(R[3]) :: "memory")
__device__ __forceinline__ int mbcnt64(unsigned long long m) { return (int)__builtin_amdgcn_mbcnt_hi((unsigned)(m >> 32), __builtin_amdgcn_mbcnt_lo((unsigned)m, 0u)); }
__device__ __forceinline__ int rfl(int v) { return __builtin_amdgcn_readfirstlane(v); }
__device__ __forceinline__ float rflf(float v) { return __builtin_bit_cast(float, __builtin_amdgcn_readfirstlane(__builtin_bit_cast(int, v))); }

__device__ __forceinline__ void p7_phase(Frame& F, bool dry) {
    const int lane0 = hw_lane(), wave = F.wave;
    if (dry && (MK_DRY_SKIP & 16) && wave >= 4) return;
    unsigned char* wl = F.lds + wave * P7_WL;
    int* TE = (int*)(wl + P7_TE); float* TG = (float*)(wl + P7_TG);
    float* LG = (float*)(wl + P7_LG); float* LSU = (float*)(wl + P7_LSU); unsigned char* H2Q = wl + P7_H2Q; float* HST = (float*)(wl + P7_HST);
    const bf16* SC = (const bf16*)(F.ws + WS_SC); const bf16* H2 = (const bf16*)(F.ws + WS_H);
    const unsigned char* U8 = F.ws + WS_U; const unsigned char* V8 = F.ws + WS_V;
    const float* SU = (const float*)(F.ws + WS_SU); const float* SV = (const float*)(F.ws + WS_SV);
    const float* mods = (const float*)(F.ws + WS_MODS); const float* SSP = (const float*)(F.ws + WS_SSP);
    unsigned ctabp = 0;
#pragma unroll
    for (int s = 0; s < 4; ++s) { const int c = 16 * s + (lane0 & 15); int i, j;
        if (c < 16) { i = 0; j = c; } else if (c < 24) { i = 1; j = c - 16; } else if (c < 29) { i = 2; j = c - 24; } else if (c < 33) { i = 3; j = c - 29; } else if (c < 36) { i = 4; j = c - 33; }
        else if (c < 38) { i = 5; j = c - 36; } else if (c < 40) { i = 6; j = c - 38; } else if (c < 42) { i = 7; j = c - 40; } else if (c < 50) { i = c - 34; j = 0; } else { i = -1; j = 0; }
        ctabp |= (unsigned)(i < 0 ? 255 : i * 16 + j) << (8 * s); }
    const int ntg = NTOK / (F.G * NWAVES * 4);
#pragma unroll 1
    for (int tg = 0; tg < ntg; ++tg) {
        const int tok0 = (F.vcu * ntg + tg) * (NWAVES * 4) + wave * 4;
        int lane = hw_lane(); asm volatile("" : "+v"(lane));
        {
            unsigned* TL4 = (unsigned*)(wl + P7_LE);
            topk_stage1(SC, tok0, lane, TL4);
            v4u ch0, ch1, nh0, nh1;
#define P7_TLOAD(H0, H1, tk) do { H0 = *(const v4u*)(H2 + (size_t)(tk) * DM + 16 * lane); H1 = *(const v4u*)(H2 + (size_t)(tk) * DM + 16 * lane + 8); } while (0)
            P7_TLOAD(ch0, ch1, tok0);
#pragma unroll 1
            for (int s = 0; s < 4; ++s) {
                if (s < 3) P7_TLOAD(nh0, nh1, tok0 + s + 1);
                const int tokc = tok0 + s;
                const f32x4* spp = (const f32x4*)(SSP + (size_t)tokc * 16); const f32x4 q0 = spp[0], q1 = spp[1], q2 = spp[2], q3 = spp[3];
                const float* shp = mods + (size_t)mod_index(tokc) * MODW + 3 * DM + 16 * lane;
                const f32x4 sh0 = *(const f32x4*)(shp), sh1 = *(const f32x4*)(shp + 4), sh2v = *(const f32x4*)(shp + 8), sh3 = *(const f32x4*)(shp + 12);
                unsigned ctab_ = ctabp; asm volatile("" : "+v"(ctab_));
                topk_stage2(TL4 + s * 256, lane, ctab_, TE + s * 128, TG + s * 128);
                const v4u a = ch0, b = ch1;
                const float ssr = ((q0[0] + q0[1]) + (q0[2] + q0[3])) + ((q1[0] + q1[1]) + (q1[2] + q1[3])) + ((q2[0] + q2[1]) + (q2[2] + q2[3])) + ((q3[0] + q3[1]) + (q3[2] + q3[3]));
                const float rstd = 1.f / sqrtf(ssr * (1.f / DM) + EPS);
                float hv[16];
                hv[0] = bflo(a.x); hv[1] = bfhi(a.x); hv[2] = bflo(a.y); hv[3] = bfhi(a.y); hv[4] = bflo(a.z); hv[5] = bfhi(a.z); hv[6] = bflo(a.w); hv[7] = bfhi(a.w);
                hv[8] = bflo(b.x); hv[9] = bfhi(b.x); hv[10] = bflo(b.y); hv[11] = bfhi(b.y); hv[12] = bflo(b.z); hv[13] = bfhi(b.z); hv[14] = bflo(b.w); hv[15] = bfhi(b.w);
#pragma unroll
                for (int i = 0; i < 4; ++i) { hv[i] = hv[i] * rstd + sh0[i]; hv[4 + i] = hv[4 + i] * rstd + sh1[i]; hv[8 + i] = hv[8 + i] * rstd + sh2v[i]; hv[12 + i] = hv[12 + i] * rstd + sh3[i]; }
                float am = 0.f;
#pragma unroll
                for (int i = 0; i < 16; ++i) am = fmaxf(am, fabsf(hv[i]));
                am = wave_max(am);
                const float inv = am > 0.f ? 119.f / am : 0.f;
                if (lane == 0) HST[s] = am * (1.f / 119.f);
                v4u qv;
#pragma unroll
                for (int j = 0; j < 4; ++j) { unsigned w = 0;
#pragma unroll
                    for (int i = 0; i < 4; ++i) { int q = (int)rintf(hv[4 * j + i] * inv); w |= ((unsigned)q & 0xffu) << (8 * i); }
                    qv[j] = w; }
                *(v4u*)(H2Q + s * 1024 + 16 * lane) = qv;
                ch0 = nh0; ch1 = nh1;
            }
#undef P7_TLOAD
        }
        {
            unsigned* LEO = (unsigned*)(wl + P7_LE);
            int ee0[4], ee1[4]; float gg0[4], gg1[4], us0[4], us1[4], vs0[4], vs1[4];
#pragma unroll
            for (int s = 0; s < 4; ++s) { ee0[s] = TE[s * 128 + lane]; ee1[s] = TE[s * 128 + 64 + lane]; gg0[s] = TG[s * 128 + lane]; gg1[s] = TG[s * 128 + 64 + lane]; }
#pragma unroll
            for (int s = 0; s < 4; ++s) { us0[s] = SU[ee0[s]]; us1[s] = SU[ee1[s]]; vs0[s] = SV[ee0[s]]; vs1[s] = SV[ee1[s]]; }
#pragma unroll
            for (int s = 0; s < 4; ++s) { const int e0 = ee0[s], e1 = ee1[s]; const int c0 = e0 >> P7_CSH, c1 = e1 >> P7_CSH; int base = s * 128;
#pragma unroll
                for (int c = 0; c < P7_NCH; ++c) {
                    const unsigned long long m0 = __ballot(c0 == c), m1 = __ballot(c1 == c);
                    const int n0 = __popcll(m0), n = n0 + __popcll(m1);
                    if (c0 == c) { const int p = base + mbcnt64(m0); LEO[p] = (unsigned)e0 << 9; LG[p] = gg0[s] * vs0[s]; LSU[p] = us0[s]; }
                    if (c1 == c) { const int p = base + n0 + mbcnt64(m1); LEO[p] = (unsigned)e1 << 9; LG[p] = gg1[s] * vs1[s]; LSU[p] = us1[s]; }
                    base += n;
                } }
        }
        typedef __attribute__((address_space(1))) v4u GV4;
        if (!(dry && (MK_DRY_SKIP & 1))) {
            int lane_u = hw_lane(); asm volatile("" : "+v"(lane_u));
            const int su = lane_u >> 4, ju = lane_u & 15; const unsigned j16 = 16u * (unsigned)ju;
            const unsigned* LEOs = (const unsigned*)(wl + P7_LE) + su * 128; float* LGs = LG + su * 128; const float* LSUs = LSU + su * 128;
            const unsigned long long u8i = (unsigned long long)U8;
            unsigned hh[2][4], hl[2][4];
#pragma unroll
            for (int i = 0; i < 2; ++i) { const v4u ha = *(const v4u*)(H2Q + su * 1024 + 512 * i + 32 * ju), hb = *(const v4u*)(H2Q + su * 1024 + 512 * i + 32 * ju + 16);
#pragma unroll
                for (int w = 0; w < 4; ++w) { unsigned lo16[2], hi16[2];
#pragma unroll
                    for (int h = 0; h < 2; ++h) { const unsigned d = (w < 2 ? ha : hb)[2 * (w & 1) + h];
                        const unsigned t = ((d & 0x7f7f7f7fu) + 0x08080808u) ^ (d & 0x80808080u);
                        unsigned l = (t & 0x0f0f0f0fu) ^ 0x08080808u, g = (t >> 4) & 0x0f0f0f0fu;
                        l = (l | (l >> 4)) & 0x00ff00ffu; l = (l | (l >> 8)) & 0xffffu; g = (g | (g >> 4)) & 0x00ff00ffu; g = (g | (g >> 8)) & 0xffffu;
                        lo16[h] = l; hi16[h] = g; }
                    hl[i][w] = lo16[0] | (lo16[1] << 16); hh[i][w] = hi16[0] | (hi16[1] << 16); } }
            const float hs = HST[su];
            const bool b0 = (ju & 1) != 0, b1 = (ju & 2) != 0; const int rr = ju & 3;
            v4u A[4][2], B[4][2], C[4][2], D[4][2];
#define P7_ULOAD(R, t) do { const v4u eo_ = *(const v4u*)(LEOs + 4 * (t)); \
            _Pragma("unroll") for (int r = 0; r < 4; ++r) { unsigned o_ = eo_[r] + j16; asm volatile("" : "+v"(o_)); \
                R[r][0] = *(const GV4*)(u8i + o_); R[r][1] = *(const GV4*)(u8i + o_ + 256); } \
            __builtin_amdgcn_sched_barrier(0); } while (0)
#define P7_SCOMP_U(R, t) do { const float su_ = LSUs[4 * (t) + rr], g_ = LGs[4 * (t) + rr]; int p_[4]; \
                _Pragma("unroll") for (int r = 0; r < 4; ++r) { int ah = 0, al = 0; \
                    _Pragma("unroll") for (int i = 0; i < 2; ++i) { _Pragma("unroll") for (int w = 0; w < 4; ++w) { \
                        ah = __builtin_amdgcn_sdot8((int)hh[i][w], (int)R[r][i][w], ah, false); al = __builtin_amdgcn_sdot8((int)hl[i][w], (int)R[r][i][w], al, false); } } \
                    p_[r] = 16 * ah + al; } \
                const int q01 = (b0 ? p_[1] : p_[0]) + (int)dppu<0xB1>((unsigned)(b0 ? p_[0] : p_[1])); const int q23 = (b0 ? p_[3] : p_[2]) + (int)dppu<0xB1>((unsigned)(b0 ? p_[2] : p_[3])); \
                int q_ = (b1 ? q23 : q01) + (int)dppu<0x4E>((unsigned)(b1 ? q01 : q23)); q_ += (int)dppu<0x128>((unsigned)q_); q_ += (int)dppu<0x124>((unsigned)q_); \
                const float dotf = (float)q_ * (hs * su_); LGs[4 * (t) + rr] = g_ * gelu_fast(dotf); } while (0)
            P7_ULOAD(A, 0); P7_ULOAD(B, 1); P7_ULOAD(C, 2);
#pragma unroll 1
            for (int t = 0; t < 28; t += 4) {
                P7_ULOAD(D, t + 3); P7_SCOMP_U(A, t);
                P7_ULOAD(A, t + 4); P7_SCOMP_U(B, t + 1);
                P7_ULOAD(B, t + 5); P7_SCOMP_U(C, t + 2);
                P7_ULOAD(C, t + 6); P7_SCOMP_U(D, t + 3);
                asm volatile("" ::: "memory");
            }
            P7_ULOAD(D, 31); P7_SCOMP_U(A, 28); P7_SCOMP_U(B, 29); P7_SCOMP_U(C, 30); P7_SCOMP_U(D, 31);
#undef P7_SCOMP_U
#undef P7_ULOAD
        }
        float cscale; int sumq8;
        {
            int lane_q = hw_lane(); asm volatile("" : "+v"(lane_q));
            const int sq = lane_q >> 4, jq = lane_q & 15;
            const float* lg = LG + sq * 128 + 8 * jq; const f32x4 c0 = *(const f32x4*)lg, c1 = *(const f32x4*)(lg + 4);
            float m = fmaxf(fmaxf(fmaxf(fabsf(c0[0]), fabsf(c0[1])), fmaxf(fabsf(c0[2]), fabsf(c0[3]))), fmaxf(fmaxf(fabsf(c1[0]), fabsf(c1[1])), fmaxf(fabsf(c1[2]), fabsf(c1[3]))));
            m = rowmax16f(m);
            cscale = m * (1.f / 127.f); const float iv = m > 0.f ? 127.f / m : 0.f;
            v2u w; w.x = 0u; w.y = 0u;
#pragma unroll
            for (int k = 0; k < 4; ++k) { w.x |= ((unsigned)(int)rintf(c0[k] * iv) & 0xffu) << (8 * k); w.y |= ((unsigned)(int)rintf(c1[k] * iv) & 0xffu) << (8 * k); }
            *(v2u*)(wl + P7_LQ + (sq * 32 + 2 * jq) * 4) = w;
            int sq8 = 0;
#pragma unroll
            for (int k = 0; k < 4; ++k) sq8 += (int)rintf(c0[k] * iv) + (int)rintf(c1[k] * iv);
            sumq8 = 8 * rowsum16i(sq8);
        }
        int acc[64];
#pragma unroll
        for (int i = 0; i < 64; ++i) acc[i] = 0;
        if (!(dry && (MK_DRY_SKIP & 2))) {
            int lane_v = hw_lane(); asm volatile("" : "+v"(lane_v));
            const int sv_ = lane_v >> 4, jv = lane_v & 15; const unsigned j16 = 16u * (unsigned)jv;
            const unsigned* LEOs = (const unsigned*)(wl + P7_LE) + sv_ * 128; const int* LQs = (const int*)(wl + P7_LQ) + sv_ * 32;
            const unsigned long long v8i = (unsigned long long)V8;
            v4u A[4][2], B[4][2], C[4][2];
#define P7_VLOAD(R, t) do { const v4u eo_ = *(const v4u*)(LEOs + 4 * (t)); \
            _Pragma("unroll") for (int r = 0; r < 4; ++r) { unsigned o_ = eo_[r] + j16; asm volatile("" : "+v"(o_)); \
                R[r][0] = *(const GV4*)(v8i + o_); R[r][1] = *(const GV4*)(v8i + o_ + 256); } \
            __builtin_amdgcn_sched_barrier(0); } while (0)
#define P7_SCOMP_V(R, t) do { const int cq_ = LQs[(t)]; \
                _Pragma("unroll") for (int i = 0; i < 2; ++i) { _Pragma("unroll") for (int w = 0; w < 4; ++w) { \
                    const unsigned x_ = __builtin_amdgcn_perm(R[1][i][w], R[0][i][w], 0x05010400u), y_ = __builtin_amdgcn_perm(R[1][i][w], R[0][i][w], 0x07030602u); \
                    const unsigned c_ = __builtin_amdgcn_perm(R[3][i][w], R[2][i][w], 0x05010400u), e_ = __builtin_amdgcn_perm(R[3][i][w], R[2][i][w], 0x07030602u); \
                    unsigned tb_[4]; tb_[0] = __builtin_amdgcn_perm(c_, x_, 0x05040100u); tb_[1] = __builtin_amdgcn_perm(c_, x_, 0x07060302u); tb_[2] = __builtin_amdgcn_perm(e_, y_, 0x05040100u); tb_[3] = __builtin_amdgcn_perm(e_, y_, 0x07060302u); \
                    _Pragma("unroll") for (int b = 0; b < 4; ++b) {     \
                        acc[32 * i + 8 * w + 2 * b]     = __builtin_amdgcn_sdot4((int)(tb_[b] & 0x0f0f0f0fu), cq_, acc[32 * i + 8 * w + 2 * b], false); \
                        acc[32 * i + 8 * w + 2 * b + 1] = __builtin_amdgcn_sdot4((int)tb_[b], cq_, acc[32 * i + 8 * w + 2 * b + 1], false); } } } } while (0)
            P7_VLOAD(A, 0); P7_VLOAD(B, 1);
#pragma unroll 1
            for (int t = 0; t < 30; t += 3) {
                P7_VLOAD(C, t + 2); P7_SCOMP_V(A, t);
                P7_VLOAD(A, t + 3); P7_SCOMP_V(B, t + 1);
                P7_VLOAD(B, t + 4); P7_SCOMP_V(C, t + 2);
                asm volatile("" ::: "memory");
            }
            P7_SCOMP_V(A, 30); P7_SCOMP_V(B, 31);
#undef P7_SCOMP_V
#undef P7_VLOAD
        }
        {
            int lane_f = hw_lane(); asm volatile("" : "+v"(lane_f));
            const int sf = lane_f >> 4, jf = lane_f & 15; const int tok = tok0 + sf;
            const bf16* xrow = (const bf16*)(F.ws + WS_X1) + (size_t)tok * DM + 32 * jf;
            const float* ga2 = mods + (size_t)mod_index(tok0) * MODW + 5 * DM + 32 * jf;
            const float* gf = F.in[I_GFINAL] + 32 * jf;
            float* yrow = dry ? (float*)(F.ws + WS_MIX) + (size_t)(tok & 8191) * DM + 32 * jf : F.out + O_Y + (size_t)tok * DM + 32 * jf;
            float xs[64]; float ss = 0.f;
#pragma unroll
            for (int i = 0; i < 2; ++i) {
#pragma unroll
                for (int hh_ = 0; hh_ < 2; ++hh_) { f32x4 gv[4];
                    const v4u xa = *(const v4u*)(xrow + 512 * i + 16 * hh_), xb = *(const v4u*)(xrow + 512 * i + 16 * hh_ + 8);
#pragma unroll
                    for (int q = 0; q < 4; ++q) gv[q] = *(const f32x4*)(ga2 + 512 * i + 16 * hh_ + 4 * q);
                    float xv[16];
                    xv[0] = bflo(xa.x); xv[1] = bfhi(xa.x); xv[2] = bflo(xa.y); xv[3] = bfhi(xa.y); xv[4] = bflo(xa.z); xv[5] = bfhi(xa.z); xv[6] = bflo(xa.w); xv[7] = bfhi(xa.w);
                    xv[8] = bflo(xb.x); xv[9] = bfhi(xb.x); xv[10] = bflo(xb.y); xv[11] = bfhi(xb.y); xv[12] = bflo(xb.z); xv[13] = bfhi(xb.z); xv[14] = bflo(xb.w); xv[15] = bfhi(xb.w);
#pragma unroll
                    for (int q = 0; q < 4; ++q)
#pragma unroll
                        for (int k = 0; k < 4; ++k) { const int ci = 32 * i + 16 * hh_ + 4 * q + k;
                            const float pv = (k & 1) ? (float)(acc[ci] - acc[ci - 1]) * (cscale * (1.f / 16.f)) : (float)(acc[ci] - sumq8) * cscale;
                            const float t = xv[4 * q + k] + gv[q][k] * pv; xs[ci] = t; ss += t * t; }
                    asm volatile("" ::: "memory"); } }
            const float rstd = 1.f / sqrtf(rowsum16f(ss) * (1.f / DM) + EPS);
#pragma unroll
            for (int i = 0; i < 2; ++i) {
#pragma unroll
                for (int hh_ = 0; hh_ < 2; ++hh_) { f32x4 gfv[4];
#pragma unroll
                    for (int q = 0; q < 4; ++q) gfv[q] = *(const f32x4*)(gf + 512 * i + 16 * hh_ + 4 * q);
#pragma unroll
                    for (int q = 0; q < 4; ++q) { f32x4 o;
#pragma unroll
                        for (int k = 0; k < 4; ++k) o[k] = xs[32 * i + 16 * hh_ + 4 * q + k] * rstd * gfv[q][k];
                        *(f32x4*)(yrow + 512 * i + 16 * hh_ + 4 * q) = o; }
                    asm volatile("" ::: "memory"); } }
        }
    }
}

__global__ void __launch_bounds__(NWAVES * 64, 2) mk_fwd(Args args) {
    extern __shared__ __attribute__((aligned(16))) unsigned char lds[];
    Frame F;
    F.lds = lds;
    F.tid = threadIdx.x; F.lane = F.tid & 63; F.wave = __builtin_amdgcn_readfirstlane(F.tid >> 6);
    F.G = gridDim.x; { const int bx = blockIdx.x; F.vcu = (F.G % 8 == 0) ? (bx % 8) * (F.G / 8) + bx / 8 : bx; }
    F.in = args.in; F.out = args.out; F.ws = args.ws;
    LAS unsigned char* lds3 = (LAS unsigned char*)lds;
    volatile LAS unsigned* MISC = (volatile LAS unsigned*)(lds3 + MISC_OFF);
    for (int u = F.tid; u < (LDS_BYTES - LDSCTL_OFF) / 4; u += NWAVES * 64) ((LAS unsigned*)(lds3 + LDSCTL_OFF))[u] = 0u;
    __syncthreads();
    unsigned* ctl = (unsigned*)(args.ws + WS_CTL);
    XcdBarrier bar; bar.bar = ctl + CW_BAR; bar.x = 0; bar.st = nullptr;
    const bool one_launch = (args.ph_hi - args.ph_lo) > 1;
    if (one_launch) bar = xcd_barrier_post(ctl + CW_BAR, MISC + 8);
    const int lo = args.ph_lo, hi = args.ph_hi;
#ifndef MK_PHASE_MASK
#define MK_PHASE_MASK 0xff
#endif
#define IN(k) (((MK_PHASE_MASK >> (k)) & 1) && lo <= (k) && (k) < hi)
#define SEAM(k) do { if (IN(k) && IN((k) + 1)) xcd_barrier(bar); } while (0)

#define DUPQ(k) (MK_DUP == (k))
    if (IN(0)) { if (DUPQ(0)) { p0_phase(F); xcd_barrier(bar); } p0_phase(F); SEAM(0); }
    if (IN(1)) { REFRESH_IDS(F); if (DUPQ(1)) { norm_phase(F, 0); xcd_barrier(bar); } norm_phase(F, 0); bias_items(F); SEAM(1); }
    if (IN(2)) { REFRESH_IDS(F);
        pg8::Gemm g{(const pg8::bf16_t*)(F.ws + WS_H), (const pg8::bf16_t*)(F.ws + WS_WIN), NTOK, D_IN, DM}; pg8::StaticOrder S; S.init(NTOK, D_IN, F.G, (int)blockIdx.x);
        EpiInProj E{(bf16*)(F.ws + WS_Q), (bf16*)(F.ws + WS_K), (bf16*)(F.ws + WS_VT), (bf16*)(F.ws + WS_XR), (bf16*)(F.ws + WS_YG), F.out + O_NEWK, F.out + O_NEWV, (const f32x4*)(F.ws + WS_ROPE)};
        if (DUPQ(2)) { pg8::gemm_phase<EpiInProj, pg8::StaticOrder, true, true>(lds3, g, S, E); xcd_barrier(bar); }
        pg8::gemm_phase<EpiInProj, pg8::StaticOrder, true, true>(lds3, g, S, E);
        if (u_in_p2(F.G) && (int)blockIdx.x >= 192) quant_rows(F, 0, 16384, ((int)blockIdx.x - 192) * NWAVES + F.wave, 64 * NWAVES);
        SEAM(2);
    }
    if (IN(3)) { REFRESH_IDS(F); if (DUPQ(3)) { p3_phase(F, MK_P3_TYPES); xcd_barrier(bar); } p3_phase(F); SEAM(3); }
    if (IN(4)) { REFRESH_IDS(F);
        pg8::Gemm g{(const pg8::bf16_t*)(F.ws + WS_MIX), (const pg8::bf16_t*)(F.ws + WS_WOUT), NTOK, DM, DM}; pg8::StaticOrder S; S.init(NTOK, DM, F.G, (int)blockIdx.x);
        EpiOutProj E{F.in[I_XP], F.in[I_XS], (const float*)(F.ws + WS_MODS), F.in[I_GFFN], (bf16*)(F.ws + WS_X1), (bf16*)(F.ws + WS_H), (float*)(F.ws + WS_SSP)};
        if (DUPQ(4)) { pg8::gemm_phase<EpiOutProj, pg8::StaticOrder, true, true>(lds3, g, S, E); xcd_barrier(bar); }
        pg8::gemm_phase<EpiOutProj, pg8::StaticOrder, true, true>(lds3, g, S, E);
        SEAM(4);
    }
    if (IN(6)) { REFRESH_IDS(F);
        pg8::Gemm g{(const pg8::bf16_t*)(F.ws + WS_H), (const pg8::bf16_t*)(F.ws + WS_WC), NTOK, 2048, DM}; pg8::StaticOrder S; S.init(NTOK, 2048, F.G, (int)blockIdx.x);
        EpiScores E{(bf16*)(F.ws + WS_SC), (const float*)(F.ws + WS_SSP), (const float*)(F.ws + WS_BIAS)};
        if (DUPQ(6)) { pg8::gemm_phase<EpiScores, pg8::StaticOrder, true, true>(lds3, g, S, E); xcd_barrier(bar); }
        pg8::gemm_phase<EpiScores, pg8::StaticOrder, true, true>(lds3, g, S, E);
        SEAM(6);
    }
    if (IN(7)) { REFRESH_IDS(F); if (DUPQ(7)) { p7_phase(F, true); xcd_barrier(bar); } p7_phase(F, false); }
#undef IN
#undef SEAM
}

extern "C" void kernel_launch(void* const* d_in, const int* in_sizes, int n_in, void* d_out, int out_size, void* d_ws, size_t ws_size, hipStream_t stream) {
    static int grid = 0;
    if (grid == 0) {
        if (n_in != 26 || ws_size < WS_END) { fprintf(stderr, "kernel_launch: unexpected n_in %d / ws %zu\n", n_in, ws_size); grid = -1; return; }
        int dev = 0, cus = 0, per_cu = 0;
        if (hipGetDevice(&dev) != hipSuccess || hipDeviceGetAttribute(&cus, hipDeviceAttributeMultiprocessorCount, dev) != hipSuccess) { grid = -1; return; }
        if (hipFuncSetAttribute((const void*)mk_fwd, hipFuncAttributeMaxDynamicSharedMemorySize, LDS_BYTES) != hipSuccess) { fprintf(stderr, "kernel_launch: hipFuncSetAttribute failed\n"); grid = -1; return; }
        if (hipOccupancyMaxActiveBlocksPerMultiprocessor(&per_cu, (const void*)mk_fwd, NWAVES * 64, LDS_BYTES) != hipSuccess || per_cu < 1)
            fprintf(stderr, "kernel_launch: occupancy query reports %d blocks per CU\n", per_cu);
        (void)hipGetLastError();
        grid = cus;
        if (grid != 256) fprintf(stderr, "kernel_launch: note: %d CUs\n", grid);
    }
    if (grid < 0) return;
    (void)hipMemsetAsync((char*)d_ws + WS_CTL, 0, CTL_ZERO_BYTES, stream);
    Args a{};
    for (int i = 0; i < 26; ++i) a.in[i] = (const float*)d_in[i];
    a.out = (float*)d_out; a.ws = (unsigned char*)d_ws;
    if (MK_N_LAUNCHES == 1) {
        a.ph_lo = 0; a.ph_hi = N_PHASES; a.li = 0;
        hipLaunchKernelGGL(mk_fwd, dim3(grid), dim3(NWAVES * 64), LDS_BYTES, stream, a);
    } else {
        for (int li = 0; li < N_PHASES; ++li) { a.ph_lo = li; a.ph_hi = li + 1; a.li = li;
            hipLaunchKernelGGL(mk_fwd, dim3(grid), dim3(NWAVES * 64), LDS_BYTES, stream, a); }
    }
}
```

```cpp
#include <hip/hip_runtime.h>
#include <cstdio>
#include <cstdint>

#ifndef MK_DUP
#define MK_DUP -1
#endif
#ifndef MK_DRY_SKIP
#define MK_DRY_SKIP 0
#endif
#ifndef MK_N_LAUNCHES
#define MK_N_LAUNCHES 1
#endif

namespace pg8 {
#define PG8_LAS __attribute__((address_space(3)))
typedef unsigned short bf16_t;
typedef short bf16x8 __attribute__((ext_vector_type(8)));
typedef float f32x4 __attribute__((ext_vector_type(4)));
typedef unsigned u32x4 __attribute__((ext_vector_type(4)));
typedef unsigned u32x2 __attribute__((ext_vector_type(2)));
constexpr int BM = 256, BK = 64, HALF = 128, HTB = HALF * BK * 2, STAGE_BYTES = 8 * HTB, NXCD = 8, WGM = 8;

__host__ __device__ __forceinline__ int lds_byte(int r, int c) { const int st = (r >> 4) * 2 + (c >> 5), rr = r & 15, cc = c & 31, ob = rr * 64 + cc * 2; return st * 1024 + (ob ^ (((ob >> 9) & 1) << 5)); }
__host__ __device__ __forceinline__ void stage_rc(int b, int& R, int& C) { const int st = b / 1024, sb = b % 1024, swz = sb ^ (((sb >> 9) & 1) << 5); R = (st >> 1) * 16 + swz / 64; C = (st & 1) * 32 + (swz % 64) / 2; }
__host__ __device__ __forceinline__ int perm32(int rho) { const int n = rho >> 4, i = rho & 15; return 8 * (i >> 2) + 4 * n + (i & 3); }

struct Unit { int pm, pn; };
struct Gemm { const bf16_t* A; const bf16_t* Bt; int M, N, K; };

struct StaticOrder {
    int nM, nN, nwg, G, c;
    __host__ __device__ void init(int M, int N, int G_, int c_) { nM = M / BM; nN = N / BM; nwg = nM * nN; G = G_; c = c_; }
    __host__ __device__ bool next(int i, Unit& u) const {
        const long L = (long)i * G + c; if (L >= nwg) return false;
        int wgid = (int)L; { const int q = nwg / NXCD, r = nwg % NXCD, xcd = wgid % NXCD, off = wgid / NXCD; wgid = (xcd < r ? xcd * (q + 1) : r * (q + 1) + (xcd - r) * q) + off; }
        const int nig = WGM * nN, gid = wgid / nig, fm = gid * WGM, gsz = (nM - fm) < WGM ? (nM - fm) : WGM;
        u.pm = fm + ((wgid % nig) % gsz); u.pn = (wgid % nig) / gsz; return true;
    }
    __device__ __forceinline__ void a_ready(const Unit&) const {}
    __device__ __forceinline__ void done(const Unit&) const {}
};

__device__ __forceinline__ unsigned cvt_pk_bf16(float lo, float hi) { unsigned r; asm volatile("v_cvt_pk_bf16_f32 %0, %1, %2" : "=v"(r) : "v"(lo), "v"(hi)); return r; }

template <class Epi, class Sched, bool ALIGN_EPI = false, bool SP2 = false>
__device__ __forceinline__ void gemm_phase(PG8_LAS unsigned char* lds, const Gemm g, const Sched& S, const Epi& E) {
    int tid_ = threadIdx.x; asm volatile("" : "+v"(tid_));
    const int tid = tid_, wid = __builtin_amdgcn_readfirstlane(tid >> 6), lane = tid & 63, wr = wid >> 2, wc = wid & 3, fr = lane & 15, fq = lane >> 4;
    const int K = g.K, nt = K / BK;
    unsigned voffA[2], voffB[2];
#pragma unroll
    for (int i = 0; i < 2; ++i) { int R, C; stage_rc(tid * 16 + i * 8192, R, C); const int Rb = Epi::PERM ? ((R & ~31) + perm32(R & 31)) : R;
        voffA[i] = (unsigned)(R * K + C) * 2u; voffB[i] = (unsigned)(Rb * K + C) * 2u; }
    const size_t kstep = (size_t)(BK * 2);
    const size_t hstep = (size_t)HALF * K * 2;
    const size_t tstep = 2 * hstep;
    const unsigned ldsw = (unsigned)wid * 1024u;
    const int aoff = lds_byte(wr * 64 + fr, fq * 8), boff = lds_byte(wc * 32 + fr, fq * 8);
#define PG8_SA(b, h) (((b) * 2 + (h)) * HTB)
#define PG8_SB(b, h) ((4 + (b) * 2 + (h)) * HTB)
#define PG8_STAGE(bufoff, gbase, voff) do { _Pragma("unroll") for (int _i = 0; _i < 2; ++_i) \
        __builtin_amdgcn_global_load_lds((const unsigned*)((const char*)(gbase) + (voff)[_i]), (PG8_LAS unsigned*)(lds + (bufoff) + ldsw + _i * 8192), 16, 0, 0); } while (0)
#define PG8_LDA(dst, b, h) do { _Pragma("unroll") for (int m = 0; m < 4; ++m) _Pragma("unroll") for (int k = 0; k < 2; ++k) dst[m][k] = *(const PG8_LAS bf16x8*)(lds + PG8_SA(b, h) + aoff + m * 2048 + k * 1024); } while (0)
#define PG8_LDB(dst, b, h) do { _Pragma("unroll") for (int n = 0; n < 2; ++n) _Pragma("unroll") for (int k = 0; k < 2; ++k) dst[n][k] = *(const PG8_LAS bf16x8*)(lds + PG8_SB(b, h) + boff + n * 2048 + k * 1024); } while (0)
#define PG8_MMA(ai, bj, At, Bt) do { __builtin_amdgcn_s_setprio(1); _Pragma("unroll") for (int m = 0; m < 4; ++m) _Pragma("unroll") for (int n = 0; n < 2; ++n) _Pragma("unroll") for (int k = 0; k < 2; ++k) \
        acc[ai][bj][m][n] = __builtin_amdgcn_mfma_f32_16x16x32_bf16(Bt[n][k], At[m][k], acc[ai][bj][m][n], 0, 0, 0); __builtin_amdgcn_s_setprio(0); } while (0)
#define PG8_WAIT_V(n) asm volatile("s_waitcnt vmcnt(" #n ")" ::: "memory")
#define PG8_WAIT_L(n) asm volatile("s_waitcnt lgkmcnt(" #n ")" ::: "memory")
#define PG8_BAR __builtin_amdgcn_s_barrier()
#define PG8_SCHED __builtin_amdgcn_sched_barrier(0)
    Unit cur, nxt; int ui = 0;
    if (!S.next(0, cur)) return;
    f32x4 acc[2][2][4][2];
#pragma unroll
    for (int a = 0; a < 2; ++a)
#pragma unroll
        for (int b = 0; b < 2; ++b)
#pragma unroll
            for (int m = 0; m < 4; ++m)
#pragma unroll
                for (int n = 0; n < 2; ++n) acc[a][b][m][n] = (f32x4){0.f, 0.f, 0.f, 0.f};
    bf16x8 At[4][2], B0[2][2], B1[2][2];
    const char* cA = (const char*)g.A + (size_t)cur.pm * tstep; const char* cB = (const char*)g.Bt + (size_t)cur.pn * tstep;
    S.a_ready(cur);
    if constexpr (SP2) {
        PG8_STAGE(PG8_SB(0, 0), cB, voffB); PG8_STAGE(PG8_SB(0, 1), cB + hstep, voffB); PG8_STAGE(PG8_SA(0, 0), cA, voffA); PG8_STAGE(PG8_SA(0, 1), cA + hstep, voffA);
        if (wr == 1) PG8_BAR;
        PG8_WAIT_V(2); PG8_BAR;
        PG8_STAGE(PG8_SB(1, 0), cB + kstep, voffB); PG8_STAGE(PG8_SA(1, 0), cA + kstep, voffA); PG8_STAGE(PG8_SB(1, 1), cB + hstep + kstep, voffB);
        PG8_WAIT_V(6); PG8_BAR;
    } else {
        PG8_STAGE(PG8_SB(0, 0), cB, voffB); PG8_STAGE(PG8_SA(0, 0), cA, voffA); PG8_STAGE(PG8_SB(0, 1), cB + hstep, voffB); PG8_STAGE(PG8_SA(0, 1), cA + hstep, voffA);
        if (wr == 1) PG8_BAR;
        PG8_WAIT_V(4); PG8_BAR;
        PG8_STAGE(PG8_SB(1, 0), cB + kstep, voffB); PG8_STAGE(PG8_SA(1, 0), cA + kstep, voffA); PG8_STAGE(PG8_SB(1, 1), cB + hstep + kstep, voffB);
        PG8_WAIT_V(6); PG8_BAR;
    }
    for (;;) {
        const bool has_next = S.next(ui + 1, nxt);
        const char* nA = has_next ? (const char*)g.A + (size_t)nxt.pm * tstep : cA; const char* nB = has_next ? (const char*)g.Bt + (size_t)nxt.pn * tstep : cB;
        for (int t = 0; t < nt; t += 2) {
            const bool last = (t == nt - 2);
            const char* a1 = cA + (size_t)(t + 1) * kstep;
            const char* a2 = last ? nA : cA + (size_t)(t + 2) * kstep; const char* b2 = last ? nB : cB + (size_t)(t + 2) * kstep;
            const char* a3 = a2 + kstep; const char* b3 = b2 + kstep;
            if (last && has_next) S.a_ready(nxt);
            if constexpr (SP2) {
            PG8_LDB(B0, 0, 0); PG8_LDB(B1, 0, 1); PG8_SCHED; PG8_LDA(At, 0, 0); PG8_STAGE(PG8_SA(1, 1), a1 + hstep, voffA);
            PG8_WAIT_V(8); PG8_WAIT_L(0); PG8_BAR; PG8_MMA(0, 0, At, B0); PG8_MMA(0, 1, At, B1); PG8_BAR; PG8_SCHED;
            PG8_LDA(At, 0, 1); PG8_STAGE(PG8_SB(0, 0), b2, voffB); PG8_STAGE(PG8_SB(0, 1), b2 + hstep, voffB); PG8_STAGE(PG8_SA(0, 0), a2, voffA);
            PG8_WAIT_V(8); PG8_WAIT_L(0); PG8_BAR; PG8_MMA(1, 0, At, B0); PG8_MMA(1, 1, At, B1); PG8_BAR; PG8_SCHED;
            PG8_LDB(B0, 1, 0); PG8_LDB(B1, 1, 1); PG8_SCHED; PG8_LDA(At, 1, 0); PG8_STAGE(PG8_SA(0, 1), a2 + hstep, voffA);
            PG8_WAIT_V(8); PG8_WAIT_L(0); PG8_BAR; PG8_MMA(0, 0, At, B0); PG8_MMA(0, 1, At, B1); PG8_BAR; PG8_SCHED;
            PG8_LDA(At, 1, 1); PG8_STAGE(PG8_SB(1, 0), b3, voffB); PG8_STAGE(PG8_SB(1, 1), b3 + hstep, voffB); PG8_STAGE(PG8_SA(1, 0), a3, voffA);
            PG8_WAIT_V(8); PG8_WAIT_L(0); PG8_BAR; PG8_MMA(1, 0, At, B0); PG8_MMA(1, 1, At, B1); PG8_BAR; PG8_SCHED;
            } else {
            PG8_LDB(B0, 0, 0); PG8_SCHED; PG8_LDA(At, 0, 0); PG8_STAGE(PG8_SA(1, 1), a1 + hstep, voffA);
            PG8_WAIT_L(8); PG8_BAR; PG8_WAIT_L(0); PG8_MMA(0, 0, At, B0); PG8_BAR; PG8_SCHED;
            PG8_LDB(B1, 0, 1); PG8_STAGE(PG8_SB(0, 0), b2, voffB);
            PG8_BAR; PG8_WAIT_L(0); PG8_MMA(0, 1, At, B1); PG8_BAR;
            PG8_LDA(At, 0, 1); PG8_STAGE(PG8_SA(0, 0), a2, voffA);
            PG8_BAR; PG8_WAIT_L(0); PG8_MMA(1, 0, At, B0); PG8_BAR; PG8_SCHED;
            PG8_STAGE(PG8_SB(0, 1), b2 + hstep, voffB);
            PG8_WAIT_V(6); PG8_BAR; PG8_MMA(1, 1, At, B1); PG8_BAR;
            PG8_LDB(B0, 1, 0); PG8_SCHED; PG8_LDA(At, 1, 0); PG8_STAGE(PG8_SA(0, 1), a2 + hstep, voffA);
            PG8_WAIT_L(8); PG8_BAR; PG8_WAIT_L(0); PG8_MMA(0, 0, At, B0); PG8_BAR; PG8_SCHED;
            PG8_LDB(B1, 1, 1); PG8_STAGE(PG8_SB(1, 0), b3, voffB);
            PG8_BAR; PG8_WAIT_L(0); PG8_MMA(0, 1, At, B1); PG8_BAR;
            PG8_LDA(At, 1, 1); PG8_STAGE(PG8_SA(1, 0), a3, voffA);
            PG8_BAR; PG8_WAIT_L(0); PG8_MMA(1, 0, At, B0); PG8_BAR; PG8_SCHED;
            PG8_STAGE(PG8_SB(1, 1), b3 + hstep, voffB);
            PG8_WAIT_V(6); PG8_BAR; PG8_MMA(1, 1, At, B1); PG8_BAR;
            }
        }
        if constexpr (ALIGN_EPI) { if (wr == 0) PG8_BAR; }
        { int te_ = threadIdx.x; asm volatile("" : "+v"(te_));
          const int we_ = __builtin_amdgcn_readfirstlane(te_ >> 6), le_ = te_ & 63;
          E(acc, cur, we_ >> 2, we_ & 3, le_ & 15, le_ >> 4); }
        S.done(cur);
        if (!has_next) break;
#pragma unroll
        for (int a = 0; a < 2; ++a)
#pragma unroll
            for (int b = 0; b < 2; ++b)
#pragma unroll
                for (int m = 0; m < 4; ++m)
#pragma unroll
                    for (int n = 0; n < 2; ++n) acc[a][b][m][n] = (f32x4){0.f, 0.f, 0.f, 0.f};
        cur = nxt; cA = nA; cB = nB; ++ui;
        if constexpr (ALIGN_EPI) { if (wr == 1) PG8_BAR; }
    }
    PG8_WAIT_V(0);
    if constexpr (!ALIGN_EPI) { if (wr == 0) PG8_BAR; }
    PG8_BAR;
#undef PG8_SA
#undef PG8_SB
#undef PG8_STAGE
#undef PG8_LDA
#undef PG8_LDB
#undef PG8_MMA
#undef PG8_WAIT_V
#undef PG8_WAIT_L
#undef PG8_BAR
#undef PG8_SCHED
}
}

constexpr int NWAVES = 8;
constexpr int DM = 1024, NTOK = 16384, NCTX = 8192, D_IN = 1792, NMODV = 9, MODW = 6144;
constexpr int SEQ_C = 256, SEQ_L = 1024, NSEQ_C = 32, NSEQ_L = 8;
constexpr int N_PHASES = 8;
constexpr float LOG2E = 1.4426950408889634f;
constexpr float QSCALE = 0.125f * LOG2E;
constexpr float EPS = 1e-6f;

constexpr size_t MiB = 1u << 20, KiB = 1u << 10;
constexpr size_t WS_CTL = 0, CTL_ZERO_BYTES = 64 * KiB;
constexpr size_t WS_MODS = 1 * MiB;
constexpr size_t WS_ROPE = 1 * MiB + 256 * KiB;
constexpr size_t WS_RGW  = 1 * MiB + 512 * KiB;
constexpr size_t WS_CK   = 1 * MiB + 768 * KiB;
constexpr size_t WS_CVT  = 2 * MiB + 256 * KiB;
constexpr size_t WS_WIN  = 3 * MiB;
constexpr size_t WS_WOUT = 7 * MiB;
constexpr size_t WS_WC   = 9 * MiB;
constexpr size_t WS_U    = 16 * MiB;
constexpr size_t WS_SSP  = 14 * MiB;
constexpr size_t WS_BIAS = 15 * MiB;
constexpr size_t WS_SU   = 13 * MiB;
constexpr size_t WS_SV   = 13 * MiB + 64 * KiB;
constexpr size_t WS_V    = 48 * MiB;
constexpr size_t WS_H    = 80 * MiB;
constexpr size_t WS_MIX  = 112 * MiB;
constexpr size_t WS_Q    = 144 * MiB;
constexpr size_t WS_K    = 160 * MiB;
constexpr size_t WS_VT   = 164 * MiB;
constexpr size_t WS_XR   = 168 * MiB;
constexpr size_t WS_YG   = 184 * MiB;
constexpr size_t WS_HF   = 200 * MiB;
constexpr size_t WS_X1   = 208 * MiB;
constexpr size_t WS_SC   = 144 * MiB;
constexpr size_t WS_END  = 232 * MiB;
constexpr int VT_LAT_OFF = NSEQ_C * 2 * 64 * SEQ_C;

constexpr int CW_BAR = 4096;

constexpr int RING_BYTES = 131072;
constexpr int LDSCTL_OFF = 146944, MISC_OFF = LDSCTL_OFF + 320;
constexpr int LDS_BYTES = 147456;

#define GAS __attribute__((address_space(1)))
#define LAS __attribute__((address_space(3)))
typedef unsigned short bf16;
typedef unsigned v4u __attribute__((ext_vector_type(4)));
typedef unsigned v2u __attribute__((ext_vector_type(2)));
typedef float f32x4 __attribute__((ext_vector_type(4)));
typedef float f32x2 __attribute__((ext_vector_type(2)));
typedef float f32x16 __attribute__((ext_vector_type(16)));
typedef short bf16x8 __attribute__((ext_vector_type(8)));
typedef GAS unsigned gu32;
#define RLX_AGENT __ATOMIC_RELAXED, __HIP_MEMORY_SCOPE_AGENT

__device__ __forceinline__ unsigned f2bf(float f) { unsigned u = __builtin_bit_cast(unsigned, f); return (u + 0x7fffu + ((u >> 16) & 1u)) >> 16; }
typedef float f32x2_t_ __attribute__((ext_vector_type(2))); typedef __bf16 bf16x2_t_ __attribute__((ext_vector_type(2)));
__device__ __forceinline__ unsigned pk2(float lo, float hi) { f32x2_t_ v = {lo, hi}; bf16x2_t_ b = __builtin_convertvector(v, bf16x2_t_); return __builtin_bit_cast(unsigned, b); }
__device__ __forceinline__ float bf2f(unsigned b) { return __builtin_bit_cast(float, b << 16); }
__device__ __forceinline__ float bflo(unsigned w) { return __builtin_bit_cast(float, w << 16); }
__device__ __forceinline__ float bfhi(unsigned w) { return __builtin_bit_cast(float, w & 0xffff0000u); }
__device__ __forceinline__ float sigmoidf_(float x) { return 1.f / (1.f + __expf(-x)); }
__device__ __forceinline__ float gelu_tanh(float x) { const float y = 0.7978845608028654f * (x + 0.044715f * x * x * x); const float e = __expf(2.f * y); return 0.5f * x * (2.f - 2.f / (1.f + e)); }
template <int CTRL> __device__ __forceinline__ float dppf_(float v) { return __builtin_bit_cast(float, __builtin_amdgcn_update_dpp(0, __builtin_bit_cast(int, v), CTRL, 0xf, 0xf, true)); }
__device__ __forceinline__ float xrow16_(float v) {
    unsigned a = __builtin_bit_cast(unsigned, v), b = a; asm volatile("" : "+v"(b));
    const auto r = __builtin_amdgcn_permlane16_swap(a, b, false, false);
    const bool odd = (threadIdx.x & 16) != 0; return __builtin_bit_cast(float, odd ? r[0] : r[1]);
}
__device__ __forceinline__ float xhalf32_(float v) {
    unsigned a = __builtin_bit_cast(unsigned, v), b = a; asm volatile("" : "+v"(b));
    const auto r = __builtin_amdgcn_permlane32_swap(a, b, false, false);
    const bool hi = (threadIdx.x & 32) != 0; return __builtin_bit_cast(float, hi ? r[0] : r[1]);
}
__device__ __forceinline__ float wave_sum(float v) {
    v += dppf_<0xB1>(v); v += dppf_<0x4E>(v); v += dppf_<0x141>(v); v += dppf_<0x140>(v);
    v += xrow16_(v); v += xhalf32_(v); return v;
}
__device__ __forceinline__ float wave_max(float v) {
    v = fmaxf(v, dppf_<0xB1>(v)); v = fmaxf(v, dppf_<0x4E>(v)); v = fmaxf(v, dppf_<0x141>(v)); v = fmaxf(v, dppf_<0x140>(v));
    v = fmaxf(v, xrow16_(v)); v = fmaxf(v, xhalf32_(v)); return v;
}
__device__ __forceinline__ int crow(int r, int hi) { return (r & 3) + 8 * (r >> 2) + 4 * hi; }

#define XB_TMO      128
#define XB_XCNT(j)  (256  + 64 * (j))
#define XB_XSUB(j)  (1280 + 64 * (j))
#define XB_XGEN(j)  (2304 + 64 * (j))
#define XB_TOP      3328
#define XB_TOPGEN   3392
#define XCD_BAR_WORDS 3456
#define XB_SPIN_CAP (1u << 18)
__device__ __forceinline__ unsigned xb_ld(unsigned* p)              { return __hip_atomic_load(p, __ATOMIC_RELAXED, __HIP_MEMORY_SCOPE_AGENT); }
__device__ __forceinline__ unsigned xb_add(unsigned* p, unsigned v) { return __hip_atomic_fetch_add(p, v, __ATOMIC_RELAXED, __HIP_MEMORY_SCOPE_AGENT); }
__device__ __forceinline__ unsigned xb_xcc_id() { return (unsigned)__builtin_amdgcn_s_getreg((3 << 11) | 20) & 0xFu; }
#define XB_SPIN(cond, bar) do { unsigned _sp = 0; while (cond) { __builtin_amdgcn_s_sleep(1); \
    if ((++_sp & 255u) == 0u) { if (xb_ld(&(bar)[XB_TMO])) break; if (_sp > XB_SPIN_CAP) { atomicAdd(&(bar)[XB_TMO], 1u); break; } } } } while (0)
struct XcdBarrier { unsigned* bar; unsigned x; volatile LAS unsigned* st; };
__device__ __forceinline__ XcdBarrier xcd_barrier_post(unsigned* bar, volatile LAS unsigned* st) {
    XcdBarrier b; b.bar = bar; b.x = xb_xcc_id(); b.st = st;
    if (threadIdx.x == 0) (void)xb_add(&bar[XB_XCNT(b.x)], 1u);
    return b;
}
__device__ __forceinline__ void xcd_barrier_complete(unsigned* bar, unsigned x, unsigned& nloc, unsigned& nx) {
    const unsigned G = gridDim.x * gridDim.y * gridDim.z;
    unsigned sum, cnt, mine, sp = 0u;
    for (;;) {
        sum = 0u; cnt = 0u; mine = 0u;
#pragma unroll
        for (unsigned j = 0; j < 16; ++j) { const unsigned c = xb_ld(&bar[XB_XCNT(j)]); sum += c; cnt += (c > 0u) ? 1u : 0u; mine = (j == x) ? c : mine; }
        if (sum == G) break;
        __builtin_amdgcn_s_sleep(1);
        if ((++sp & 255u) == 0u) { if (xb_ld(&bar[XB_TMO])) break; if (sp > XB_SPIN_CAP) { atomicAdd(&bar[XB_TMO], 1u); break; } }
    }
    nloc = mine > 0u ? mine : 1u; nx = cnt > 0u ? cnt : 1u;
}
__device__ __forceinline__ void xcd_barrier(const XcdBarrier& b) {
    asm volatile("s_waitcnt vmcnt(0)" ::: "memory");
    __syncthreads();
    if (threadIdx.x == 0) {
        unsigned* bar = b.bar;
        __builtin_amdgcn_s_waitcnt(0);
        unsigned nloc = b.st[0], nx = b.st[1];
        if (nloc == 0u) { xcd_barrier_complete(bar, b.x, nloc, nx); b.st[0] = nloc; b.st[1] = nx; }
        const unsigned old = xb_add(&bar[XB_XSUB(b.x)], 1u);
        const unsigned gen = old / nloc;
        if (old + 1u == (gen + 1u) * nloc) {
            __builtin_amdgcn_fence(__ATOMIC_RELEASE, "agent");
            asm volatile("s_waitcnt vmcnt(0)" ::: "memory");
            const unsigned og = xb_add(&bar[XB_TOP], 1u);
            const unsigned tg = og / nx;
            if (og + 1u == (tg + 1u) * nx) xb_add(&bar[XB_TOPGEN], 1u);
            else XB_SPIN(xb_ld(&bar[XB_TOPGEN]) == tg, bar);
            __builtin_amdgcn_fence(__ATOMIC_ACQUIRE, "agent");
            xb_add(&bar[XB_XGEN(b.x)], 1u);
            asm volatile("s_waitcnt vmcnt(0)" ::: "memory");
        } else {
            XB_SPIN(xb_ld(&bar[XB_XGEN(b.x)]) == gen, bar);
            __builtin_amdgcn_fence(__ATOMIC_ACQUIRE, "agent");
            asm volatile("s_waitcnt vmcnt(0)" ::: "memory");
        }
    }
    __syncthreads();
}

struct Args { const float* in[26]; float* out; unsigned char* ws; int ph_lo, ph_hi, li, pad; };

struct Frame {
    unsigned char* lds;
    int tid, lane, wave, vcu, G;
    const float* const* in;
    float* out; unsigned char* ws;
};
enum { I_XP = 0, I_XS, I_CK, I_CV, I_SRNN, I_C, I_CCTX, I_WMOD, I_BMOD, I_GMIX, I_GFFN, I_WIN, I_CONVW, I_CONVB, I_RGWA, I_RGBA, I_RGWI, I_RGBI, I_RGLAM, I_SINK, I_WOUT, I_PWQ, I_PSK, I_PU, I_PV, I_GFINAL };
constexpr size_t O_Y = 0, O_NEWK = (size_t)NTOK * DM, O_NEWV = O_NEWK + (size_t)NCTX * 128, O_NEWRNN = O_NEWV + (size_t)NCTX * 128;

__device__ __forceinline__ int mod_index(int tok) { return tok < NCTX ? 0 : 1 + ((tok - NCTX) >> 10); }
__device__ __forceinline__ const float* x_row(const Frame& F, int tok) { return tok < NCTX ? F.in[I_XP] + (size_t)tok * DM : F.in[I_XS] + (size_t)(tok - NCTX) * DM; }

__device__ __forceinline__ int hw_lane() { int l; asm volatile("v_mbcnt_lo_u32_b32 %0, -1, 0\n\tv_mbcnt_hi_u32_b32 %0, -1, %0" : "=v"(l)); return l; }
#define REFRESH_IDS(F) do { F.lane = hw_lane(); F.tid = F.wave * 64 + F.lane; } while (0)
template <class RowMap>
__device__ __forceinline__ void p0_transpose_item(const float* W, int K, int N, bf16* WT, float* scr, int item, int lane, RowMap rowmap, float scale = 1.f) {
    const int nblk = N / 32, kb = item / nblk, nb = item % nblk, k0 = 64 * kb, n0 = 32 * nb;
#pragma unroll 8
    for (int i = 0; i < 32; ++i) { const int kk = 2 * i + (lane >> 5); scr[kk * 33 + (lane & 31)] = W[(size_t)(k0 + kk) * N + n0 + (lane & 31)]; }
    __builtin_amdgcn_s_waitcnt(0xC07F); asm volatile("" ::: "memory");
    const int c = lane & 7;
#pragma unroll
    for (int j = 0; j < 4; ++j) { const int n = (lane >> 3) + 8 * j; const float* s = scr + (8 * c) * 33 + n;
        v4u o; o.x = pk2(s[0 * 33] * scale, s[1 * 33] * scale); o.y = pk2(s[2 * 33] * scale, s[3 * 33] * scale); o.z = pk2(s[4 * 33] * scale, s[5 * 33] * scale); o.w = pk2(s[6 * 33] * scale, s[7 * 33] * scale);
        *(v4u*)(WT + (size_t)rowmap(n0 + n) * K + k0 + 8 * c) = o; }
    __builtin_amdgcn_s_waitcnt(0xC07F); asm volatile("" ::: "memory");
}
struct MapId { __device__ __forceinline__ int operator()(int n) const { return n; } };
struct MapWin { __device__ __forceinline__ int operator()(int n) const { if (n >= 640) return n; const int hb = n & ~63, o = n & 63; return hb + ((o & 31) << 1) + (o >> 5); } };

__device__ __forceinline__ bool u_in_p2(int G) { return 2 * G - (NTOK / 256) * (D_IN / 256) == 64 && G == 256; }
__device__ __forceinline__ void quant_rows(Frame& F, int it_lo, int it_hi, int w, int nw) {
    const int lane = F.lane;
    for (int it0 = it_lo + 4 * w; it0 < it_hi; it0 += 4 * nw) {
        f32x4 a[4][4];
#pragma unroll
        for (int r = 0; r < 4; ++r) { const int it = it0 + r, tb = it >> 14, row = it & 16383;
            const float* src = (tb ? F.in[I_PV] : F.in[I_PU]) + (size_t)row * DM + 16 * lane;
#pragma unroll
            for (int j = 0; j < 4; ++j) a[r][j] = *(const f32x4*)(src + 4 * j); }
        float am[4];
#pragma unroll
        for (int r = 0; r < 4; ++r) { float m = 0.f;
#pragma unroll
            for (int j = 0; j < 4; ++j) m = fmaxf(m, fmaxf(fmaxf(fabsf(a[r][j][0]), fabsf(a[r][j][1])), fmaxf(fabsf(a[r][j][2]), fabsf(a[r][j][3]))));
            am[r] = m; }
#pragma unroll
        for (int r = 0; r < 4; ++r) am[r] = wave_max(am[r]);
#pragma unroll
        for (int r = 0; r < 4; ++r) { const int it = it0 + r, tb = it >> 14, row = it & 16383;
            if (tb) {
                const float inv = am[r] > 0.f ? 7.f / am[r] : 0.f;
                v2u o2;
#pragma unroll
                for (int h = 0; h < 2; ++h) { unsigned w = 0;
#pragma unroll
                    for (int c = 0; c < 8; ++c) { int q = (int)rintf(a[r][2 * h + (c >> 2)][c & 3] * inv); q = q > 7 ? 7 : (q < -7 ? -7 : q); w |= ((unsigned)((c & 1) ? q : q + 8) & 0xfu) << (4 * c); }
                    o2[h] = w; }
                *(v2u*)(F.ws + WS_V + (size_t)row * (DM / 2) + 8 * lane) = o2;
                if (lane == 0) ((float*)(F.ws + WS_SV))[row] = am[r] * (1.f / 7.f);
            } else {
                const float inv = am[r] > 0.f ? 7.f / am[r] : 0.f;
                v2u o2;
#pragma unroll
                for (int h = 0; h < 2; ++h) { unsigned w = 0;
#pragma unroll
                    for (int c = 0; c < 8; ++c) { int q = (int)rintf(a[r][2 * h + (c >> 2)][c & 3] * inv); q = q > 7 ? 7 : (q < -7 ? -7 : q); w |= ((unsigned)q & 0xfu) << (4 * c); }
                    o2[h] = w; }
                *(v2u*)(F.ws + WS_U + (size_t)row * (DM / 2) + 8 * lane) = o2;
                if (lane == 0) ((float*)(F.ws + WS_SU))[row] = am[r] * (1.f / 7.f);
            } }
    }
}

__device__ __forceinline__ void p0_phase(Frame& F) {
    float* ldsf = (float*)F.lds;
    const int tid = F.tid, lane = F.lane, wave = F.wave, v = F.vcu;
    if (v < 192) {
        for (int i = tid; i < NMODV * DM; i += 512) { const int j = i >> 10, d = i & 1023; const float c = (j == 0) ? F.in[I_CCTX][d] : F.in[I_C][(j - 1) * DM + d]; ldsf[i] = c * sigmoidf_(c); }
        __syncthreads();
        const int e0 = 32 * v, c4 = tid & 7, kq = tid >> 3;
        float acc[NMODV][4];
#pragma unroll
        for (int j = 0; j < NMODV; ++j) { acc[j][0] = 0.f; acc[j][1] = 0.f; acc[j][2] = 0.f; acc[j][3] = 0.f; }
        const float* wm = F.in[I_WMOD] + e0 + 4 * c4;
#pragma unroll 4
        for (int kk = 0; kk < 16; ++kk) { const int k = kq * 16 + kk; const f32x4 w = *(const f32x4*)(wm + (size_t)k * MODW);
#pragma unroll
            for (int j = 0; j < NMODV; ++j) { const float s = ldsf[j * DM + k]; acc[j][0] += s * w[0]; acc[j][1] += s * w[1]; acc[j][2] += s * w[2]; acc[j][3] += s * w[3]; } }
#pragma unroll
        for (int j = 0; j < NMODV; ++j)
#pragma unroll
            for (int i = 0; i < 4; ++i) { float a = acc[j][i]; a += __shfl_xor(a, 8); a += __shfl_xor(a, 16); a += __shfl_xor(a, 32); acc[j][i] = a; }
        float* red = ldsf + NMODV * DM;
        if (lane < 8) {
#pragma unroll
            for (int j = 0; j < NMODV; ++j)
#pragma unroll
                for (int i = 0; i < 4; ++i) red[(wave * NMODV + j) * 32 + 4 * c4 + i] = acc[j][i];
        }
        __syncthreads();
        if (tid < NMODV * 32) { const int j = tid >> 5, col = tid & 31; float s = F.in[I_BMOD][e0 + col];
#pragma unroll
            for (int w = 0; w < 8; ++w) s += red[(w * NMODV + j) * 32 + col];
            ((float*)(F.ws + WS_MODS))[j * MODW + e0 + col] = s; }
        __syncthreads();
    }
    if (v < 256) {
        const int hh = v >> 4, dt = v & 15, d0 = 64 * dt;
        float* At = ldsf;
        float* Bkt = ldsf + 128 * 64;
        const float* wq = F.in[I_PWQ] + hh * 128;
        const float* sk = F.in[I_PSK] + (size_t)hh * 128 * 128;
#pragma unroll
        for (int i = 0; i < 4; ++i) { const int f = tid + 512 * i, d = f & 63, q4 = f >> 6; const f32x4 a = *(const f32x4*)(wq + (size_t)(d0 + d) * 2048 + 4 * q4);
            At[(4 * q4 + 0) * 64 + d] = a[0]; At[(4 * q4 + 1) * 64 + d] = a[1]; At[(4 * q4 + 2) * 64 + d] = a[2]; At[(4 * q4 + 3) * 64 + d] = a[3]; }
#pragma unroll
        for (int i = 0; i < 8; ++i) { const int f = tid + 512 * i, key = f & 127, q4 = f >> 7; const f32x4 b = *(const f32x4*)(sk + (size_t)key * 128 + 4 * q4);
            Bkt[(4 * q4 + 0) * 128 + key] = b[0]; Bkt[(4 * q4 + 1) * 128 + key] = b[1]; Bkt[(4 * q4 + 2) * 128 + key] = b[2]; Bkt[(4 * q4 + 3) * 128 + key] = b[3]; }
        __syncthreads();
        const int dg = tid & 15, kg = tid >> 4;
        float acc[4][4];
#pragma unroll
        for (int i = 0; i < 4; ++i)
#pragma unroll
            for (int j = 0; j < 4; ++j) acc[i][j] = 0.f;
#pragma unroll 4
        for (int q = 0; q < 128; ++q) { const f32x4 a = *(const f32x4*)(At + q * 64 + 4 * dg); const f32x4 b = *(const f32x4*)(Bkt + q * 128 + 4 * kg);
#pragma unroll
            for (int i = 0; i < 4; ++i)
#pragma unroll
                for (int j = 0; j < 4; ++j) acc[i][j] += a[i] * b[j]; }
        bf16* WcT = (bf16*)(F.ws + WS_WC);
#pragma unroll
        for (int j = 0; j < 4; ++j) { v2u o; o.x = pk2(acc[0][j], acc[1][j]); o.y = pk2(acc[2][j], acc[3][j]);
            *(v2u*)(WcT + (size_t)(hh * 128 + 4 * kg + j) * DM + d0 + 4 * dg) = o; }
        __syncthreads();
    }
    const int gw = v * NWAVES + wave, NGW = F.G * NWAVES;
    float* scr = ldsf + wave * 4096;
    {
        constexpr int I_IN = (DM / 64) * (D_IN / 32), I_OUT = (DM / 64) * (DM / 32), I_RG = 32 * 2;
        constexpr int NIT = I_IN + I_OUT + I_RG;
        for (int it = gw; it < NIT; it += NGW) {
            int r = it;
            if (r < I_IN) { p0_transpose_item(F.in[I_WIN], DM, D_IN, (bf16*)(F.ws + WS_WIN), scr, r, lane, MapWin()); continue; } r -= I_IN;
            if (r < I_OUT) { p0_transpose_item(F.in[I_WOUT], DM, DM, (bf16*)(F.ws + WS_WOUT), scr, r, lane, MapId()); continue; } r -= I_OUT;
            { const int mm = r >> 1, sub = r & 1, dir = mm >> 4, n = (mm >> 1) & 7, gate = mm & 1;
              const float* src = (gate ? F.in[I_RGWI] : F.in[I_RGWA]) + (size_t)(dir * 8 + n) * 4096;
              bf16* dst = (bf16*)(F.ws + WS_RGW) + (size_t)((dir * 8 + n) * 2 + gate) * 4096;
              p0_transpose_item(src, 64, 64, dst, scr, sub, lane, MapId(), -LOG2E); }
        }
    }
    quant_rows(F, u_in_p2(F.G) ? 16384 : 0, 2 * 16384, gw, NGW);
    const int gt = v * 512 + tid, NGT = F.G * 512;
    for (int e = gt; e < 8 * 256 * 128; e += NGT) {
        const int c = e & 127, bp = e >> 7, kvh = c >> 6, p = c & 63, old = (p & 1) ? 32 + (p >> 1) : (p >> 1);
        ((bf16*)(F.ws + WS_CK))[e] = (bf16)f2bf(F.in[I_CK][(size_t)bp * 128 + kvh * 64 + old]);
    }
    for (int e = gt; e < 8 * 256 * 128; e += NGT) {
        const int pos = e & 255, d = (e >> 8) & 63, kvh = (e >> 14) & 1, b = e >> 15;
        ((bf16*)(F.ws + WS_CVT))[e] = (bf16)f2bf(F.in[I_CV][(size_t)(b * 256 + pos) * 128 + kvh * 64 + d]);
    }
    for (int e = gt; e < 1024 * 32; e += NGT) {
        const int s = e >> 5, i = e & 31, row = s >> 6, col = s & 63;
        const float inv = powf(10000.0f, -(float)(i & 15) / 16.0f);
        const float ang = (i < 16 ? (float)row : (float)col) * inv;
        f32x2 cs; cs.x = cosf(ang); cs.y = sinf(ang);
        ((f32x2*)(F.ws + WS_ROPE))[e] = cs;
    }
}

__device__ __forceinline__ void bias_items(Frame& F) {
    const int gw = F.vcu * NWAVES + F.wave, NGW = F.G * NWAVES, lane = F.lane;
    const float* mods = (const float*)(F.ws + WS_MODS); const bf16* WcT = (const bf16*)(F.ws + WS_WC); float* BIAS = (float*)(F.ws + WS_BIAS);
    for (int n = gw; n < 2048; n += NGW) {
        const v4u a = *(const v4u*)(WcT + (size_t)n * DM + 16 * lane), b = *(const v4u*)(WcT + (size_t)n * DM + 16 * lane + 8);
        float w[16];
        w[0] = bflo(a.x); w[1] = bfhi(a.x); w[2] = bflo(a.y); w[3] = bfhi(a.y); w[4] = bflo(a.z); w[5] = bfhi(a.z); w[6] = bflo(a.w); w[7] = bfhi(a.w);
        w[8] = bflo(b.x); w[9] = bfhi(b.x); w[10] = bflo(b.y); w[11] = bfhi(b.y); w[12] = bflo(b.z); w[13] = bfhi(b.z); w[14] = bflo(b.w); w[15] = bfhi(b.w);
#pragma unroll 1
        for (int j = 0; j < NMODV; ++j) { const float* sh = mods + (size_t)j * MODW + 3 * DM + 16 * lane; float d = 0.f;
#pragma unroll
            for (int q = 0; q < 4; ++q) { const f32x4 v = *(const f32x4*)(sh + 4 * q); d += v[0] * w[4 * q] + v[1] * w[4 * q + 1] + v[2] * w[4 * q + 2] + v[3] * w[4 * q + 3]; }
            d = wave_sum(d); if (lane == 0) BIAS[j * 2048 + n] = d; }
    }
}
__device__ __forceinline__ void norm_phase(Frame& F, int which) {
    const int gw = F.vcu * NWAVES + F.wave, NGW = F.G * NWAVES, lane = F.lane;
    const float* mods = (const float*)(F.ws + WS_MODS);
    const float* g = F.in[which ? I_GFFN : I_GMIX];
    bf16* H = (bf16*)(F.ws + WS_H);
    for (int tok = gw; tok < NTOK; tok += NGW) {
        const float* xr = which ? F.out + O_Y + (size_t)tok * DM : x_row(F, tok);
        const float* mv = mods + (size_t)mod_index(tok) * MODW + (which ? 3 * DM : 0);
        f32x4 v[4]; float ss = 0.f;
#pragma unroll
        for (int j = 0; j < 4; ++j) { v[j] = *(const f32x4*)(xr + 256 * j + 4 * lane); ss += (v[j][0] * v[j][0] + v[j][1] * v[j][1]) + (v[j][2] * v[j][2] + v[j][3] * v[j][3]); }
        const float rstd = 1.f / sqrtf(wave_sum(ss) * (1.f / DM) + EPS);
#pragma unroll
        for (int j = 0; j < 4; ++j) { const int e = 256 * j + 4 * lane;
            const f32x4 gg = *(const f32x4*)(g + e), sh = *(const f32x4*)(mv + e), sc = *(const f32x4*)(mv + DM + e);
            f32x4 o;
#pragma unroll
            for (int i = 0; i < 4; ++i) o[i] = v[j][i] * rstd * gg[i] * (1.f + sc[i]) + sh[i];
            v2u w; w.x = pk2(o[0], o[1]); w.y = pk2(o[2], o[3]); *(v2u*)(H + (size_t)tok * DM + e) = w; }
    }
}

struct EpiInProj {
    static constexpr bool PERM = true;
    bf16 *q, *k, *vT, *xr, *yg; float *newk, *newv; const f32x4* rope4;
    __device__ __forceinline__ void operator()(const f32x4 (&acc)[2][2][4][2], const pg8::Unit& u, int wr, int wc, int fr, int fq) const {
        const bool lat = u.pm >= 32;
        const int pn = u.pn;
#pragma unroll
        for (int ai = 0; ai < 2; ++ai)
#pragma unroll
            for (int m = 0; m < 4; ++m) {
                const int row = u.pm * 256 + ai * 128 + wr * 64 + m * 16 + fr;
                const int pos = lat ? ((row - NCTX) & 1023) : (row & 255);
#pragma unroll
                for (int bj = 0; bj < 2; ++bj) {
                    const int c = pn * 256 + bj * 128 + wc * 32 + 8 * fq;
                    f32x4 v0 = acc[ai][bj][m][0], v1 = acc[ai][bj][m][1];
                    if (pn < 2 || (pn == 2 && bj == 0)) {
                        const int i = (c & 63) >> 1;
                        if (lat) { const f32x4 cs0 = rope4[(pos * 32 + i) >> 1], cs1 = rope4[((pos * 32 + i) >> 1) + 1];
                            const float a0 = v0[0] * cs0[0] - v0[1] * cs0[1], a1 = v0[1] * cs0[0] + v0[0] * cs0[1];
                            const float b0 = v0[2] * cs0[2] - v0[3] * cs0[3], b1 = v0[3] * cs0[2] + v0[2] * cs0[3];
                            const float c0 = v1[0] * cs1[0] - v1[1] * cs1[1], c1 = v1[1] * cs1[0] + v1[0] * cs1[1];
                            const float d0 = v1[2] * cs1[2] - v1[3] * cs1[3], d1 = v1[3] * cs1[2] + v1[2] * cs1[3];
                            v0[0] = a0; v0[1] = a1; v0[2] = b0; v0[3] = b1; v1[0] = c0; v1[1] = c1; v1[2] = d0; v1[3] = d1; }
                        if (pn < 2) { v4u w; w.x = pk2(v0[0] * QSCALE, v0[1] * QSCALE); w.y = pk2(v0[2] * QSCALE, v0[3] * QSCALE); w.z = pk2(v1[0] * QSCALE, v1[1] * QSCALE); w.w = pk2(v1[2] * QSCALE, v1[3] * QSCALE);
                            *(v4u*)(q + (size_t)row * 512 + c) = w; }
                        else { const int kc = c - 512; v4u w; w.x = pk2(v0[0], v0[1]); w.y = pk2(v0[2], v0[3]); w.z = pk2(v1[0], v1[1]); w.w = pk2(v1[2], v1[3]); *(v4u*)(k + (size_t)row * 128 + kc) = w;
                            if (!lat) { float* nk = newk + (size_t)row * 128 + (kc & 64) + i; f32x4 lo; lo[0] = v0[0]; lo[1] = v0[2]; lo[2] = v1[0]; lo[3] = v1[2]; f32x4 hi; hi[0] = v0[1]; hi[1] = v0[3]; hi[2] = v1[1]; hi[3] = v1[3];
                                *(f32x4*)nk = lo; *(f32x4*)(nk + 32) = hi; } }
                    } else if (pn == 2) {
                        const int vc = c - 640, kvh = vc >> 6, d = vc & 63;
                        if (!lat) { *(f32x4*)(newv + (size_t)row * 128 + vc) = v0; *(f32x4*)(newv + (size_t)row * 128 + vc + 4) = v1; }
                        bf16* vp; int S;
                        if (!lat) { S = SEQ_C; vp = vT + ((size_t)((row >> 8) * 2 + kvh) * 64 + d) * SEQ_C + pos; }
                        else { S = SEQ_L; vp = vT + VT_LAT_OFF + ((size_t)(((row - NCTX) >> 10) * 2 + kvh) * 64 + d) * SEQ_L + pos; }
                        vp[0] = (bf16)f2bf(v0[0]); vp[S] = (bf16)f2bf(v0[1]); vp[2 * S] = (bf16)f2bf(v0[2]); vp[3 * S] = (bf16)f2bf(v0[3]);
                        vp[4 * S] = (bf16)f2bf(v1[0]); vp[5 * S] = (bf16)f2bf(v1[1]); vp[6 * S] = (bf16)f2bf(v1[2]); vp[7 * S] = (bf16)f2bf(v1[3]);
                    } else {
                        v4u w; w.x = pk2(v0[0], v0[1]); w.y = pk2(v0[2], v0[3]); w.z = pk2(v1[0], v1[1]); w.w = pk2(v1[2], v1[3]);
                        if (pn < 5) *(v4u*)(xr + (size_t)row * 512 + (c - 768)) = w; else *(v4u*)(yg + (size_t)row * 512 + (c - 1280)) = w;
                    }
                }
            }
    }
};
struct EpiOutProj {
    static constexpr bool PERM = true;
    const float *xp, *xs, *mods, *gffn; bf16* x1; bf16* ap; float* ssp;
    __device__ __forceinline__ void operator()(const f32x4 (&acc)[2][2][4][2], const pg8::Unit& u, int wr, int wc, int fr, int fq) const {
        const int mi = u.pm < 32 ? 0 : 1 + ((u.pm - 32) >> 2);
        const float* mv = mods + (size_t)mi * MODW;
        const int row0 = u.pm * 256 + wr * 64 + fr;
        const float* xbase = (u.pm < 32 ? xp : xs - (size_t)NCTX * DM) + (size_t)row0 * DM;
        float ssq[2][4];
#pragma unroll
        for (int ai = 0; ai < 2; ++ai)
#pragma unroll
            for (int m = 0; m < 4; ++m) ssq[ai][m] = 0.f;
#pragma unroll
        for (int bj = 0; bj < 2; ++bj) {
            const int c = u.pn * 256 + bj * 128 + wc * 32 + 8 * fq;
            const f32x4 gv0 = *(const f32x4*)(mv + 2 * DM + c), gv1 = *(const f32x4*)(mv + 2 * DM + c + 4);
            const f32x4 g20 = *(const f32x4*)(gffn + c) * (1.f + *(const f32x4*)(mv + 4 * DM + c)), g21 = *(const f32x4*)(gffn + c + 4) * (1.f + *(const f32x4*)(mv + 4 * DM + c + 4));
#pragma unroll
            for (int h4 = 0; h4 < 4; ++h4) {
                const int ai = h4 >> 1;
                f32x4 xv[2][2];
#pragma unroll
                for (int mm = 0; mm < 2; ++mm) { const float* xr = xbase + (size_t)(ai * 128 + (2 * (h4 & 1) + mm) * 16) * DM + c; xv[mm][0] = *(const f32x4*)xr; xv[mm][1] = *(const f32x4*)(xr + 4); }
                asm volatile("" ::: "memory");
#pragma unroll
                for (int mm = 0; mm < 2; ++mm) {
                    const int m = 2 * (h4 & 1) + mm;
                    const size_t off = (size_t)(row0 + ai * 128 + m * 16) * DM + c;
                    const f32x4 o0 = xv[mm][0] + gv0 * acc[ai][bj][m][0], o1 = xv[mm][1] + gv1 * acc[ai][bj][m][1];
                    { v4u xw; xw.x = pk2(o0[0], o0[1]); xw.y = pk2(o0[2], o0[3]); xw.z = pk2(o1[0], o1[1]); xw.w = pk2(o1[2], o1[3]); *(v4u*)(x1 + off) = xw; }
                    ssq[ai][m] += ((o0[0] * o0[0] + o0[1] * o0[1]) + (o0[2] * o0[2] + o0[3] * o0[3])) + ((o1[0] * o1[0] + o1[1] * o1[1]) + (o1[2] * o1[2] + o1[3] * o1[3]));
                    const f32x4 t0 = o0 * g20, t1 = o1 * g21; v4u w; w.x = pk2(t0[0], t0[1]); w.y = pk2(t0[2], t0[3]); w.z = pk2(t1[0], t1[1]); w.w = pk2(t1[2], t1[3]);
                    *(v4u*)(ap + off) = w;
                }
                asm volatile("" ::: "memory");
            }
        }
#pragma unroll
        for (int ai = 0; ai < 2; ++ai)
#pragma unroll
            for (int m = 0; m < 4; ++m) { float v = ssq[ai][m]; v += __shfl_xor(v, 16); v += __shfl_xor(v, 32);
                if (fq == 0) ssp[(size_t)(row0 + ai * 128 + m * 16) * 16 + u.pn * 4 + wc] = v; }
    }
};
struct EpiScores {
    static constexpr bool PERM = true;
    bf16* sc; const float* ssp; const float* bias;
    __device__ __forceinline__ void operator()(const f32x4 (&acc)[2][2][4][2], const pg8::Unit& u, int wr, int wc, int fr, int fq) const {
        const int mi = u.pm < 32 ? 0 : 1 + ((u.pm - 32) >> 2);
        const int row0 = u.pm * 256 + wr * 64 + fr;
        f32x4 b0[2], b1[2];
#pragma unroll
        for (int bj = 0; bj < 2; ++bj) { const int c = u.pn * 256 + bj * 128 + wc * 32 + 8 * fq; b0[bj] = *(const f32x4*)(bias + (size_t)mi * 2048 + c); b1[bj] = *(const f32x4*)(bias + (size_t)mi * 2048 + c + 4); }
#pragma unroll
        for (int h2 = 0; h2 < 4; ++h2) {
            const int ai = h2 >> 1;
            f32x4 sp[2][4];
#pragma unroll
            for (int mm = 0; mm < 2; ++mm)
#pragma unroll
                for (int q = 0; q < 4; ++q) sp[mm][q] = *((const f32x4*)(ssp + (size_t)(row0 + ai * 128 + (2 * (h2 & 1) + mm) * 16) * 16) + q);
            asm volatile("" ::: "memory");
#pragma unroll
            for (int mm = 0; mm < 2; ++mm) {
                const int m = 2 * (h2 & 1) + mm;
                const int row = row0 + ai * 128 + m * 16;
                const float ss = ((sp[mm][0][0] + sp[mm][0][1]) + (sp[mm][0][2] + sp[mm][0][3])) + ((sp[mm][1][0] + sp[mm][1][1]) + (sp[mm][1][2] + sp[mm][1][3]))
                               + ((sp[mm][2][0] + sp[mm][2][1]) + (sp[mm][2][2] + sp[mm][2][3])) + ((sp[mm][3][0] + sp[mm][3][1]) + (sp[mm][3][2] + sp[mm][3][3]));
                const float rstd = 1.f / sqrtf(ss * (1.f / DM) + EPS);
#pragma unroll
                for (int bj = 0; bj < 2; ++bj) {
                    const int c = u.pn * 256 + bj * 128 + wc * 32 + 8 * fq;
                    const f32x4 v0 = acc[ai][bj][m][0] * rstd + b0[bj], v1 = acc[ai][bj][m][1] * rstd + b1[bj];
                    v4u w; w.x = pk2(v0[0], v0[1]); w.y = pk2(v0[2], v0[3]); w.z = pk2(v1[0], v1[1]); w.w = pk2(v1[2], v1[3]);
                    *(v4u*)(sc + (size_t)row * 2048 + c) = w;
                }
            }
            asm volatile("" ::: "memory");
        }
    }
};

__device__ __forceinline__ void attn_unit(Frame& F, bool lat, int seq, int kvh, int qt) {
    const int tid = F.tid, lane = F.lane, wave = F.wave, r32 = lane & 31, hi = lane >> 5;
    const int g = wave >> 1, qs = wave & 1, head = kvh * 4 + g;
    const int S = lat ? SEQ_L : SEQ_C, tokbase = lat ? NCTX + seq * SEQ_L : seq * SEQ_C;
    const int q0 = qt * 64, qpos = q0 + 32 * qs + r32;
    const bf16* Q = (const bf16*)(F.ws + WS_Q); const bf16* Kb = (const bf16*)(F.ws + WS_K); const bf16* VT = (const bf16*)(F.ws + WS_VT);
    const bf16* CK = (const bf16*)(F.ws + WS_CK); const bf16* CVT = (const bf16*)(F.ws + WS_CVT);
    unsigned char* ldsK = F.lds; unsigned char* ldsV = F.lds + 8192;
    bf16x8 qf[4];
    { const bf16* qp = Q + (size_t)(tokbase + qpos) * 512 + head * 64;
#pragma unroll
      for (int ks = 0; ks < 4; ++ks) qf[ks] = *(const bf16x8*)(qp + 16 * ks + 8 * hi); }
    const float sinkl = F.in[I_SINK][head] * LOG2E;
    float mrun = sinkl, lrun = (hi == 0) ? 1.f : 0.f;
    f32x16 o0, o1;
#pragma unroll
    for (int r = 0; r < 16; ++r) { o0[r] = 0.f; o1[r] = 0.f; }
    int tlo, thi;
    if (lat) { tlo = (q0 >= 128 ? q0 - 128 : 0) >> 6; thi = ((q0 + 192 < S ? q0 + 192 : S)) >> 6; } else { tlo = 0; thi = 4; }
    const int nband = thi - tlo, ntile = nband + (lat ? 4 : 0);
    const int key_t = tid >> 3, ch_t = tid & 7;
    v4u kv, vv;
#define AT_LOAD(t_) do { const int tt_ = (t_); const bf16* kptr; const bf16* vptr; int vstride; \
        if (tt_ < nband) { const int kb_ = (tlo + tt_) * 64; kptr = Kb + (size_t)(tokbase + kb_) * 128 + kvh * 64; \
            vptr = VT + (lat ? (size_t)VT_LAT_OFF + (size_t)((seq * 2 + kvh) * 64) * SEQ_L : (size_t)((seq * 2 + kvh) * 64) * SEQ_C) + kb_; vstride = S; } \
        else { const int tc = tt_ - nband; kptr = CK + (size_t)(seq * 256 + tc * 64) * 128 + kvh * 64; vptr = CVT + (size_t)((seq * 2 + kvh) * 64) * 256 + tc * 64; vstride = 256; } \
        kv = *(const v4u*)(kptr + (size_t)key_t * 128 + ch_t * 8); vv = *(const v4u*)(vptr + (size_t)key_t * vstride + ch_t * 8); } while (0)
    AT_LOAD(0);
    for (int t = 0; t < ntile; ++t) {
        const bool band = t < nband;
        const int kbase = band ? (tlo + t) * 64 : 0;
        __syncthreads();
        *(v4u*)(ldsK + key_t * 128 + ((ch_t ^ (key_t & 7)) * 16)) = kv;
        *(v4u*)(ldsV + key_t * 128 + ((ch_t ^ (key_t & 7)) * 16)) = vv;
        __syncthreads();
        f32x16 p0, p1;
#pragma unroll
        for (int r = 0; r < 16; ++r) { p0[r] = 0.f; p1[r] = 0.f; }
#pragma unroll
        for (int ks = 0; ks < 4; ++ks) {
            const int sw = ((2 * ks + hi) ^ (r32 & 7)) * 16;
            const bf16x8 a0 = *(const bf16x8*)(ldsK + r32 * 128 + sw);
            const bf16x8 a1 = *(const bf16x8*)(ldsK + (32 + r32) * 128 + sw);
            p0 = __builtin_amdgcn_mfma_f32_32x32x16_bf16(a0, qf[ks], p0, 0, 0, 0);
            p1 = __builtin_amdgcn_mfma_f32_32x32x16_bf16(a1, qf[ks], p1, 0, 0, 0);
        }
        if (t + 1 < ntile) AT_LOAD(t + 1);
        if (band && lat && (kbase < q0 + 63 - 128 || kbase + 63 > q0 + 128)) {
#pragma unroll
            for (int r = 0; r < 16; ++r) { const int kp = kbase + crow(r, hi); int d0 = qpos - kp; d0 = d0 < 0 ? -d0 : d0; int d1 = qpos - kp - 32; d1 = d1 < 0 ? -d1 : d1;
                if (d0 > 128) p0[r] = -INFINITY; if (d1 > 128) p1[r] = -INFINITY; }
        }
        float tm = p0[0];
#pragma unroll
        for (int r = 1; r < 16; ++r) tm = fmaxf(tm, p0[r]);
#pragma unroll
        for (int r = 0; r < 16; ++r) tm = fmaxf(tm, p1[r]);
        tm = fmaxf(tm, __shfl_xor(tm, 32));
        const float mn = fmaxf(mrun, tm), alpha = __builtin_amdgcn_exp2f(mrun - mn); mrun = mn;
        float ls = 0.f;
#pragma unroll
        for (int r = 0; r < 16; ++r) { p0[r] = __builtin_amdgcn_exp2f(p0[r] - mn); p1[r] = __builtin_amdgcn_exp2f(p1[r] - mn); ls += p0[r] + p1[r]; o0[r] *= alpha; o1[r] *= alpha; }
        lrun = lrun * alpha + ls;
        bf16x8 pf[4];
#pragma unroll
        for (int s = 0; s < 2; ++s) {
            v4u w0, w1;
            w0.x = pk2(p0[8 * s + 0], p0[8 * s + 1]); w0.y = pk2(p0[8 * s + 2], p0[8 * s + 3]); w0.z = pk2(p0[8 * s + 4], p0[8 * s + 5]); w0.w = pk2(p0[8 * s + 6], p0[8 * s + 7]);
            w1.x = pk2(p1[8 * s + 0], p1[8 * s + 1]); w1.y = pk2(p1[8 * s + 2], p1[8 * s + 3]); w1.z = pk2(p1[8 * s + 4], p1[8 * s + 5]); w1.w = pk2(p1[8 * s + 6], p1[8 * s + 7]);
            pf[s] = __builtin_bit_cast(bf16x8, w0); pf[2 + s] = __builtin_bit_cast(bf16x8, w1);
        }
#pragma unroll
        for (int s4 = 0; s4 < 4; ++s4) {
#pragma unroll
            for (int dt = 0; dt < 2; ++dt) {
                const int d = 32 * dt + r32;
                const v2u lo = *(const v2u*)(ldsV + d * 128 + (((2 * s4) ^ (d & 7)) * 16) + 8 * hi);
                const v2u hi2 = *(const v2u*)(ldsV + d * 128 + (((2 * s4 + 1) ^ (d & 7)) * 16) + 8 * hi);
                v4u vf4; vf4.x = lo.x; vf4.y = lo.y; vf4.z = hi2.x; vf4.w = hi2.y;
                const bf16x8 vf = __builtin_bit_cast(bf16x8, vf4);
                if (dt == 0) o0 = __builtin_amdgcn_mfma_f32_32x32x16_bf16(vf, pf[s4], o0, 0, 0, 0);
                else o1 = __builtin_amdgcn_mfma_f32_32x32x16_bf16(vf, pf[s4], o1, 0, 0, 0);
            }
        }
    }
    const float ltot = lrun + __shfl_xor(lrun, 32), inv = 1.f / ltot;
    bf16* mix = (bf16*)(F.ws + WS_MIX) + (size_t)(tokbase + qpos) * DM + head * 64;
#pragma unroll
    for (int g4 = 0; g4 < 4; ++g4) {
        v2u w; w.x = pk2(o0[4 * g4] * inv, o0[4 * g4 + 1] * inv); w.y = pk2(o0[4 * g4 + 2] * inv, o0[4 * g4 + 3] * inv);
        *(v2u*)(mix + 8 * g4 + 4 * hi) = w;
        v2u w2; w2.x = pk2(o1[4 * g4] * inv, o1[4 * g4 + 1] * inv); w2.y = pk2(o1[4 * g4 + 2] * inv, o1[4 * g4 + 3] * inv);
        *(v2u*)(mix + 32 + 8 * g4 + 4 * hi) = w2;
    }
    __syncthreads();
}

constexpr int RL_HALF = 49152;
constexpr int RL_XCB = 32768;
constexpr int RL_AGG = 98304;
constexpr int RL_CARRY = RL_AGG + 8192;
constexpr int RL_CW = RL_CARRY + 512;
constexpr int RL_WG = RL_CW + 1280;
static_assert(RL_WG + 32768 <= LDSCTL_OFF, "RNN LDS map");
__device__ __forceinline__ float fsigmoid(float x) { return __builtin_amdgcn_rcpf(1.f + __expf(-x)); }
__device__ __forceinline__ float gelu_fast(float x) { const float y = 0.7978845608028654f * (x + 0.044715f * x * x * x); const float e = __expf(2.f * y); return x - x * __builtin_amdgcn_rcpf(1.f + e); }

template <bool REV>
__device__ __forceinline__ void scan_prep(const float (&a)[16], const float (&b)[16], int h, float (&Apre)[4], float (&Bpre)[4], float& At, float& Bt) {
    float Ao[4], Bo[4], Ap[4], Bp[4];
#pragma unroll
    for (int g = 0; g < 4; ++g) { float A = 1.f, B = 0.f;
#pragma unroll
        for (int ii = 0; ii < 4; ++ii) { const int r = 4 * g + (REV ? 3 - ii : ii); B = a[r] * B + b[r]; A = a[r] * A; }
        Ao[g] = A; Bo[g] = B; }
#pragma unroll
    for (int g = 0; g < 4; ++g) { Ap[g] = __shfl_xor(Ao[g], 32); Bp[g] = __shfl_xor(Bo[g], 32); }
    const bool ownfirst = REV ? (h == 1) : (h == 0);
    float Ac = 1.f, Bc = 0.f;
#pragma unroll
    for (int gi = 0; gi < 4; ++gi) { const int g = REV ? 3 - gi : gi;
        const float A1 = ownfirst ? Ao[g] : Ap[g], B1 = ownfirst ? Bo[g] : Bp[g], A2 = ownfirst ? Ap[g] : Ao[g], B2 = ownfirst ? Bp[g] : Bo[g];
        const float Ac1 = A1 * Ac, Bc1 = A1 * Bc + B1;
        Apre[g] = ownfirst ? Ac : Ac1; Bpre[g] = ownfirst ? Bc : Bc1;
        Ac = A2 * Ac1; Bc = A2 * Bc1 + B2; }
    At = Ac; Bt = Bc;
}
template <bool REV>
__device__ __forceinline__ void scan_finish(const float (&a)[16], const float (&b)[16], const float (&Apre)[4], const float (&Bpre)[4], float hin, float* hp, int hi) {
#pragma unroll
    for (int g = 0; g < 4; ++g) { float hc = Apre[g] * hin + Bpre[g];
#pragma unroll
        for (int ii = 0; ii < 4; ++ii) { const int r = 4 * g + (REV ? 3 - ii : ii); hc = a[r] * hc + b[r]; hp[(size_t)crow(r, hi) * 512] = hc; } }
}

template <bool REV>
__device__ __forceinline__ void rnn_dir(Frame& F, bool lat, int seq, int n) {
    const int lane = F.lane, w4 = F.wave & 3, r32 = lane & 31, hi = lane >> 5, dirh = REV ? 1 : 0;
    const int S = lat ? SEQ_L : SEQ_C, tokbase = lat ? NCTX + seq * SEQ_L : seq * SEQ_C, nchunk = S / 128;
    unsigned char* hb = F.lds + dirh * RL_HALF;
    float* XC32 = (float*)hb; unsigned char* XCB = hb + RL_XCB;
    f32x2* AGG = (f32x2*)(F.lds + RL_AGG) + dirh * 256; float* CARRY = (float*)(F.lds + RL_CARRY) + dirh * 64; const float* CW = (const float*)(F.lds + RL_CW);
    const unsigned char* WG = F.lds + RL_WG + dirh * 16384;
    const bf16* XR = (const bf16*)(F.ws + WS_XR) + (size_t)tokbase * 512 + n * 64;
    float* HX = (float*)(F.ws + (REV ? WS_H : WS_HF)) + (size_t)tokbase * 512 + n * 64;
    const int t = F.tid & 255, c8 = t & 7, tg = t >> 3;
    float ba[2], bi[2], sp8[2];
#pragma unroll
    for (int chh = 0; chh < 2; ++chh) { const int pe = dirh * 512 + n * 64 + chh * 32 + r32; ba[chh] = -LOG2E * F.in[I_RGBA][pe]; bi[chh] = -LOG2E * F.in[I_RGBI][pe];
        const float nl = -F.in[I_RGLAM][pe]; sp8[chh] = -8.f * LOG2E * (nl > 20.f ? nl : log1pf(__expf(nl))); }
    v4u xin[7];
#define RL_XLOAD(c0_) do { _Pragma("unroll") for (int i = 0; i < 7; ++i) { const int pos = (c0_) + 4 * tg - 2 + i; \
        xin[i] = (pos >= 0 && pos < S) ? *(const v4u*)(XR + (size_t)pos * 512 + 8 * c8) : (v4u){0u, 0u, 0u, 0u}; } } while (0)
    RL_XLOAD((REV ? nchunk - 1 : 0) * 128);
    float newcarry[2] = {0.f, 0.f};
    const bool last_tile = REV ? (w4 == 0) : (w4 == 3);
#pragma unroll 1
    for (int k = 0; k < nchunk; ++k) {
        const int c0 = (REV ? nchunk - 1 - k : k) * 128;
        {
            const f32x4 b0 = *(const f32x4*)(CW + 256 + 8 * c8), b1 = *(const f32x4*)(CW + 256 + 8 * c8 + 4);
            f32x4 wt0[4], wt1[4];
#pragma unroll
            for (int tap = 0; tap < 4; ++tap) { wt0[tap] = *(const f32x4*)(CW + tap * 64 + 8 * c8); wt1[tap] = *(const f32x4*)(CW + tap * 64 + 8 * c8 + 4); }
#pragma unroll
            for (int i = 0; i < 4; ++i) {
                f32x4 y0 = b0, y1 = b1;
#pragma unroll
                for (int tap = 0; tap < 4; ++tap) { const v4u x = xin[i + tap];
                    y0[0] += wt0[tap][0] * bflo(x.x); y0[1] += wt0[tap][1] * bfhi(x.x); y0[2] += wt0[tap][2] * bflo(x.y); y0[3] += wt0[tap][3] * bfhi(x.y);
                    y1[0] += wt1[tap][0] * bflo(x.z); y1[1] += wt1[tap][1] * bfhi(x.z); y1[2] += wt1[tap][2] * bflo(x.w); y1[3] += wt1[tap][3] * bfhi(x.w); }
                const int tk = 4 * tg + i;
                *(f32x4*)(XC32 + tk * 64 + 8 * c8) = y0; *(f32x4*)(XC32 + tk * 64 + 8 * c8 + 4) = y1;
                v4u w; w.x = pk2(y0[0], y0[1]); w.y = pk2(y0[2], y0[3]); w.z = pk2(y1[0], y1[1]); w.w = pk2(y1[2], y1[3]);
                *(v4u*)(XCB + tk * 128 + ((c8 ^ (tk & 7)) * 16)) = w; }
        }
        if (k + 1 < nchunk) RL_XLOAD((REV ? nchunk - 2 - k : k + 1) * 128);
        __syncthreads();
        if (k > 0 && last_tile && hi == 0) { CARRY[r32] = newcarry[0]; CARRY[32 + r32] = newcarry[1]; }
        const int tkA = 32 * w4 + r32;
#pragma unroll
        for (int chh = 0; chh < 2; ++chh) {
            const int che = chh * 32 + r32;
            float av[16], bv[16], Apre[4], Bpre[4];
            {
                f32x16 ga, gi;
#pragma unroll
                for (int r = 0; r < 16; ++r) { ga[r] = 0.f; gi[r] = 0.f; }
#pragma unroll
                for (int ks = 0; ks < 4; ++ks) {
                    const bf16x8 af = *(const bf16x8*)(XCB + tkA * 128 + (((2 * ks + hi) ^ (tkA & 7)) * 16));
                    const bf16x8 wa = *(const bf16x8*)(WG + che * 128 + (((2 * ks + hi) ^ (che & 7)) * 16));
                    const bf16x8 wi = *(const bf16x8*)(WG + 8192 + che * 128 + (((2 * ks + hi) ^ (che & 7)) * 16));
                    ga = __builtin_amdgcn_mfma_f32_32x32x16_bf16(af, wa, ga, 0, 0, 0);
                    gi = __builtin_amdgcn_mfma_f32_32x32x16_bf16(af, wi, gi, 0, 0, 0);
                }
#pragma unroll
                for (int r = 0; r < 16; ++r) { const int tk2 = 32 * w4 + crow(r, hi); const float x = XC32[tk2 * 64 + che];
                    const float rg = __builtin_amdgcn_rcpf(1.f + __builtin_amdgcn_exp2f(ga[r] + ba[chh])), ig = __builtin_amdgcn_rcpf(1.f + __builtin_amdgcn_exp2f(gi[r] + bi[chh])), a = __builtin_amdgcn_exp2f(rg * sp8[chh]);
                    av[r] = a; bv[r] = __builtin_amdgcn_sqrtf(fmaxf(1.f - a * a, 0.f)) * ig * x;
                    if ((r & 3) == 3) __builtin_amdgcn_sched_barrier(0); }
                float At, Bt;
                scan_prep<REV>(av, bv, hi, Apre, Bpre, At, Bt);
                if (hi == 0) { f32x2 ab; ab.x = At; ab.y = Bt; AGG[chh * 512 + w4 * 64 + che] = ab; }
            }
            __syncthreads();
            {
                float hin = CARRY[che];
                if (!REV) { for (int t2 = 0; t2 < w4; ++t2) { const f32x2 ab = AGG[chh * 512 + t2 * 64 + che]; hin = ab.x * hin + ab.y; } }
                else { for (int t2 = 3; t2 > w4; --t2) { const f32x2 ab = AGG[chh * 512 + t2 * 64 + che]; hin = ab.x * hin + ab.y; } }
                scan_finish<REV>(av, bv, Apre, Bpre, hin, HX + (size_t)(c0 + 32 * w4) * 512 + che, hi);
                if (last_tile) { const f32x2 ab = AGG[chh * 512 + w4 * 64 + che]; newcarry[chh] = ab.x * hin + ab.y; }
            }
        }
    }
#undef RL_XLOAD
    if (!lat && last_tile && hi == 0) { float* o = F.out + O_NEWRNN + (size_t)(seq * 2 + dirh) * 512 + n * 64; o[r32] = newcarry[0]; o[32 + r32] = newcarry[1]; }
}

__device__ __forceinline__ void rnn_unit(Frame& F, bool lat, int seq, int n) {
    const int tid = F.tid;
    const int S = lat ? SEQ_L : SEQ_C, tokbase = lat ? NCTX + seq * SEQ_L : seq * SEQ_C;
    __syncthreads();
    { float* CW = (float*)(F.lds + RL_CW); float* CARRY = (float*)(F.lds + RL_CARRY);
      if (tid < 320) CW[tid] = tid < 256 ? F.in[I_CONVW][(tid >> 6) * 512 + n * 64 + (tid & 63)] : F.in[I_CONVB][n * 64 + (tid - 256)];
      if (tid < 128) CARRY[tid] = lat ? F.in[I_SRNN][(size_t)(seq * 2 + (tid >> 6)) * 512 + n * 64 + (tid & 63)] : 0.f;
      const bf16* rgw = (const bf16*)(F.ws + WS_RGW);
#pragma unroll
      for (int i = 0; i < 4; ++i) { const int q = tid + 512 * i, ch = q & 7, d = (q >> 3) & 63, gate = (q >> 9) & 1, dir = q >> 10;
          const v4u w = *(const v4u*)(rgw + (size_t)((dir * 8 + n) * 2 + gate) * 4096 + d * 64 + ch * 8);
          *(v4u*)(F.lds + RL_WG + dir * 16384 + gate * 8192 + d * 128 + ((ch ^ (d & 7)) * 16)) = w; } }
    __syncthreads();
    if (F.wave < 4) rnn_dir<false>(F, lat, seq, n); else rnn_dir<true>(F, lat, seq, n);
    __syncthreads();
    { const int c4 = tid & 15, tk = tid >> 4;
      const float* HF = (const float*)(F.ws + WS_HF) + (size_t)tokbase * 512 + n * 64 + 4 * c4;
      const float* HB = (const float*)(F.ws + WS_H) + (size_t)tokbase * 512 + n * 64 + 4 * c4;
      const bf16* YG = (const bf16*)(F.ws + WS_YG) + (size_t)tokbase * 512 + n * 64 + 4 * c4;
      bf16* MIX = (bf16*)(F.ws + WS_MIX) + (size_t)tokbase * DM + 512 + n * 64 + 4 * c4;
      for (int t0 = tk; t0 < S; t0 += 32) {
          const f32x4 a = *(const f32x4*)(HF + (size_t)t0 * 512), b = *(const f32x4*)(HB + (size_t)t0 * 512); const v2u y = *(const v2u*)(YG + (size_t)t0 * 512);
          v2u o; o.x = pk2((a[0] + b[0]) * gelu_fast(bflo(y.x)), (a[1] + b[1]) * gelu_fast(bfhi(y.x))); o.y = pk2((a[2] + b[2]) * gelu_fast(bflo(y.y)), (a[3] + b[3]) * gelu_fast(bfhi(y.y)));
          *(v2u*)(MIX + (size_t)t0 * DM) = o; } }
    __syncthreads();
}

#ifndef MK_P3_TYPES
#define MK_P3_TYPES 15
#endif
__device__ __forceinline__ void p3_phase(Frame& F, int types = 15) {
    const int v = F.vcu;
#pragma unroll 1
    for (int i = 0; i < 832; ++i) {
        int type, idx;
        if (F.G == 256) {
            if (v < 64) { if (i > 0) break; type = 0; idx = v; }
            else { if (i >= 6) break; const int j = v - 64, sl = i >> 1, rep = i & 1; type = 1 + sl;
                const bool extra = sl == 0 ? (j < 64) : (sl == 1 ? (j >= 64 && j < 128) : (j >= 128));
                if (rep && !extra) continue; idx = rep ? 192 + (j - 64 * sl) : j; }
        } else { const int it = v + i * F.G; if (it >= 832) break;
            if (it < 64) { type = 0; idx = it; } else if (it < 320) { type = 1; idx = it - 64; } else if (it < 576) { type = 2; idx = it - 320; } else { type = 3; idx = it - 576; } }
        if (!((types >> type) & 1)) continue;
        const bool lat = type < 2;
        Frame L = F; asm volatile("" : "+v"(L.tid)); L.lane = L.tid & 63;
        asm volatile("" : "+s"(L.ws), "+s"(L.out));
        if ((type & 1) == 0) rnn_unit(L, lat, idx >> 3, idx & 7);
        else { if (lat) attn_unit(L, true, idx >> 5, (idx >> 4) & 1, idx & 15); else attn_unit(L, false, idx >> 3, (idx >> 2) & 1, idx & 3); }
    }
}

__device__ __forceinline__ unsigned key16(unsigned b, unsigned idx) { const unsigned s = (b & 0x8000u) ? (~b & 0xffffu) : (b | 0x8000u); return (s << 16) | idx; }
__device__ __forceinline__ float keyval16(unsigned k) { const unsigned s = k >> 16; const unsigned b = (s & 0x8000u) ? (s & 0x7fffu) : (~s & 0xffffu); return bf2f(b); }
__device__ __forceinline__ unsigned sortable32(float f) { const unsigned u = __builtin_bit_cast(unsigned, f); return (u & 0x80000000u) ? ~u : (u | 0x80000000u); }
template <int CTRL> __device__ __forceinline__ unsigned dppu(unsigned v) { return (unsigned)__builtin_amdgcn_update_dpp(0, (int)v, CTRL, 0xf, 0xf, true); }
template <int CTRL> __device__ __forceinline__ float dppf(float v) { return __builtin_bit_cast(float, __builtin_amdgcn_update_dpp(0, __builtin_bit_cast(int, v), CTRL, 0xf, 0xf, true)); }
__device__ __forceinline__ unsigned umax_(unsigned a, unsigned b) { return a > b ? a : b; }
__device__ __forceinline__ unsigned umin_(unsigned a, unsigned b) { return a < b ? a : b; }
__device__ __forceinline__ unsigned rowmax16u(unsigned x) { x = umax_(x, dppu<0xB1>(x)); x = umax_(x, dppu<0x4E>(x)); x = umax_(x, dppu<0x141>(x)); x = umax_(x, dppu<0x140>(x)); return x; }
__device__ __forceinline__ float rowmax16f(float x) { x = fmaxf(x, dppf<0xB1>(x)); x = fmaxf(x, dppf<0x4E>(x)); x = fmaxf(x, dppf<0x141>(x)); x = fmaxf(x, dppf<0x140>(x)); return x; }
__device__ __forceinline__ float rowsum16f(float x) { x += dppf<0xB1>(x); x += dppf<0x4E>(x); x += dppf<0x141>(x); x += dppf<0x140>(x); return x; }
__device__ __forceinline__ int rowsum16i(int x) { x += (int)dppu<0xB1>((unsigned)x); x += (int)dppu<0x4E>((unsigned)x); x += (int)dppu<0x141>((unsigned)x); x += (int)dppu<0x140>((unsigned)x); return x; }
#define CEX(a, b) do { const unsigned _h = umax_(a, b), _l = umin_(a, b); a = _h; b = _l; } while (0)

#ifndef P7_NCH
#define P7_NCH 8
#endif
constexpr int P7_CSH = (P7_NCH == 4 ? 12 : (P7_NCH == 8 ? 11 : (P7_NCH == 16 ? 10 : 9)));
constexpr int P7_WL = 16384;
constexpr int P7_TL = 0, P7_TE = 1024, P7_TG = 3072, P7_LE = 5120, P7_LG = 7168, P7_LSU = 9216, P7_LQ = 11264, P7_H2Q = 12160, P7_HST = 16256;
static_assert(P7_LQ + 512 <= P7_H2Q && (P7_H2Q % 16) == 0 && P7_HST + 16 <= P7_WL && P7_WL * 8 <= RING_BYTES, "P7 LDS map");

__device__ __forceinline__ float tkval(unsigned k) { return __builtin_bit_cast(float, k & 0xffff0000u); }
#define TKX(a, b) do { unsigned hi_, lo_; asm("v_max_f32 %0, %1, %2" : "=v"(hi_) : "v"(a), "v"(b)); asm("v_min_f32 %0, %1, %2" : "=v"(lo_) : "v"(a), "v"(b)); a = hi_; b = lo_; } while (0)
#define TK_SORT16(c) do { TKX(c[0], c[1]); TKX(c[2], c[3]); TKX(c[0], c[2]); TKX(c[1], c[3]); TKX(c[1], c[2]); TKX(c[4], c[5]); TKX(c[6], c[7]); TKX(c[4], c[6]); TKX(c[5], c[7]); TKX(c[5], c[6]); TKX(c[0], c[4]); TKX(c[2], c[6]); TKX(c[2], c[4]); TKX(c[1], c[5]); TKX(c[3], c[7]); TKX(c[3], c[5]); TKX(c[1], c[2]); TKX(c[3], c[4]); TKX(c[5], c[6]); TKX(c[8], c[9]); TKX(c[10], c[11]); TKX(c[8], c[10]); TKX(c[9], c[11]); TKX(c[9], c[10]); TKX(c[12], c[13]); TKX(c[14], c[15]); TKX(c[12], c[14]); TKX(c[13], c[15]); TKX(c[13], c[14]); TKX(c[8], c[12]); TKX(c[10], c[14]); TKX(c[10], c[12]); TKX(c[9], c[13]); TKX(c[11], c[15]); TKX(c[11], c[13]); TKX(c[9], c[10]); TKX(c[11], c[12]); TKX(c[13], c[14]); TKX(c[0], c[8]); TKX(c[4], c[12]); TKX(c[4], c[8]); TKX(c[2], c[10]); TKX(c[6], c[14]); TKX(c[6], c[10]); TKX(c[2], c[4]); TKX(c[6], c[8]); TKX(c[10], c[12]); TKX(c[1], c[9]); TKX(c[5], c[13]); TKX(c[5], c[9]); TKX(c[3], c[11]); TKX(c[7], c[15]); TKX(c[7], c[11]); TKX(c[3], c[5]); TKX(c[7], c[9]); TKX(c[11], c[13]); TKX(c[1], c[2]); TKX(c[3], c[4]); TKX(c[5], c[6]); TKX(c[7], c[8]); TKX(c[9], c[10]); TKX(c[11], c[12]); TKX(c[13], c[14]); } while (0)
#define TK_BITONIC16(c) do { TKX(c[0], c[8]); TKX(c[1], c[9]); TKX(c[2], c[10]); TKX(c[3], c[11]); TKX(c[4], c[12]); TKX(c[5], c[13]); TKX(c[6], c[14]); TKX(c[7], c[15]); TKX(c[0], c[4]); TKX(c[1], c[5]); TKX(c[2], c[6]); TKX(c[3], c[7]); TKX(c[8], c[12]); TKX(c[9], c[13]); TKX(c[10], c[14]); TKX(c[11], c[15]); TKX(c[0], c[2]); TKX(c[1], c[3]); TKX(c[4], c[6]); TKX(c[5], c[7]); TKX(c[8], c[10]); TKX(c[9], c[11]); TKX(c[12], c[14]); TKX(c[13], c[15]); TKX(c[0], c[1]); TKX(c[2], c[3]); TKX(c[4], c[5]); TKX(c[6], c[7]); TKX(c[8], c[9]); TKX(c[10], c[11]); TKX(c[12], c[13]); TKX(c[14], c[15]); } while (0)
__device__ __forceinline__ void topk_stage1(const bf16* SC, int tok0, int lane, unsigned* TL4) {
    const v4u* src = (const v4u*)(SC + (size_t)(tok0 + (lane >> 4)) * 2048 + (lane & 15) * 128);
    unsigned T[16];
#pragma unroll
    for (int ch = 0; ch < 8; ++ch) {
        const v4u r0 = src[2 * ch], r1 = src[2 * ch + 1];
        unsigned c[16];
#pragma unroll
        for (int m = 0; m < 4; ++m) { c[2 * m] = (r0[m] << 16) | (unsigned)(16 * ch + 2 * m); c[2 * m + 1] = (r0[m] & 0xffff0000u) | (unsigned)(16 * ch + 2 * m + 1);
                                      c[8 + 2 * m] = (r1[m] << 16) | (unsigned)(16 * ch + 8 + 2 * m); c[8 + 2 * m + 1] = (r1[m] & 0xffff0000u) | (unsigned)(16 * ch + 8 + 2 * m + 1); }
        TK_SORT16(c);
        if (ch == 0) {
#pragma unroll
            for (int i = 0; i < 16; ++i) T[i] = c[i];
        } else {
#pragma unroll
            for (int i = 0; i < 16; ++i) { unsigned m_; asm("v_max_f32 %0, %1, %2" : "=v"(m_) : "v"(T[i]), "v"(c[15 - i])); T[i] = m_; }
            TK_BITONIC16(T);
        }
    }
    v4u* dst = (v4u*)(TL4 + lane * 16);
#pragma unroll
    for (int q = 0; q < 4; ++q) { v4u o; o.x = T[4 * q]; o.y = T[4 * q + 1]; o.z = T[4 * q + 2]; o.w = T[4 * q + 3]; dst[q] = o; }
}
#define TK_POP4(C, KEEP, it) do { const unsigned m_ = rowmax16u(C[0]); const bool w_ = C[0] == m_; C[0] = w_ ? C[1] : C[0]; C[1] = w_ ? C[2] : C[1]; C[2] = w_ ? C[3] : C[2]; C[3] = w_ ? 0u : C[3]; KEEP = (k == (it)) ? m_ : KEEP; } while (0)
__device__ __forceinline__ void topk_stage2(const unsigned* TL, int lane, const unsigned ctabp, int* oute, float* outg) {
    const int k = lane & 15, row = lane >> 4;
    unsigned ca[4], cb[4];
    const unsigned* LAa = TL + (2 * row) * 16; const unsigned* LBa = TL + (2 * row + 1) * 16;
    const unsigned* LAb = TL + (2 * (4 + row)) * 16; const unsigned* LBb = TL + (2 * (4 + row) + 1) * 16;
#pragma unroll
    for (int s = 0; s < 4; ++s) { const int ij = (int)((ctabp >> (8 * s)) & 0xffu); const bool valid = ij != 255; const int i = (ij >> 4) & 15, j = ij & 15;
        const float sa = tkval(LAa[i]) + tkval(LBa[j]), sb = tkval(LAb[i]) + tkval(LBb[j]);
        ca[s] = valid ? ((sortable32(sa) & 0xffffff00u) | (unsigned)(i * 16 + j)) : 0u; cb[s] = valid ? ((sortable32(sb) & 0xffffff00u) | (unsigned)(i * 16 + j)) : 0u; }
    CEX(ca[0], ca[1]); CEX(ca[2], ca[3]); CEX(ca[0], ca[2]); CEX(ca[1], ca[3]); CEX(ca[1], ca[2]);
    CEX(cb[0], cb[1]); CEX(cb[2], cb[3]); CEX(cb[0], cb[2]); CEX(cb[1], cb[3]); CEX(cb[1], cb[2]);
    unsigned keepa = 0, keepb = 0;
#pragma unroll
    for (int it = 0; it < 16; ++it) { TK_POP4(ca, keepa, it); TK_POP4(cb, keepb, it); }
    {
        const unsigned kaa = LAa[(keepa >> 4) & 15], kba = LBa[keepa & 15], kab = LAb[(keepb >> 4) & 15], kbb = LBb[keepb & 15];
        const float bva = tkval(kaa) + tkval(kba), bvb = tkval(kab) + tkval(kbb);
        const float mxa = rowmax16f(bva), mxb = rowmax16f(bvb); const float exa = __expf(bva - mxa), exb = __expf(bvb - mxb); const float sma = rowsum16f(exa), smb = rowsum16f(exb);
        oute[lane] = (int)((kaa & 127u) * 128u + (kba & 127u)); outg[lane] = exa / sma;
        oute[64 + lane] = (int)((kab & 127u) * 128u + (kbb & 127u)); outg[64 + lane] = exb / smb;
    }
}
#undef TK_POP4

__device__ __forceinline__ void gl16x4(v4u (&r)[4], unsigned voff, const unsigned char* b0, const unsigned char* b1, const unsigned char* b2, const unsigned char* b3) {
    asm volatile("s_nop 4\n\tglobal_load_dwordx4 %0, %4, %5\n\tglobal_load_dwordx4 %1, %4, %6\n\tglobal_load_dwordx4 %2, %4, %7\n\tglobal_load_dwordx4 %3, %4, %8"
                 : "=&v"(r[0]), "=&v"(r[1]), "=&v"(r[2]), "=&v"(r[3]) : "v"(voff), "s"(b0), "s"(b1), "s"(b2), "s"(b3) : "memory");
}
#define P7_VMWAIT(N, R) asm volatile("s_waitcnt vmcnt(" #N ")" : "+v"(R[0]), "+v"(R[1]), "+v"(R[2]), "+v"(R[3]) :: "memory")
__device__ __forceinline__ int mbcnt64(unsigned long long m) { return (int)__builtin_amdgcn_mbcnt_hi((unsigned)(m >> 32), __builtin_amdgcn_mbcnt_lo((unsigned)m, 0u)); }
__device__ __forceinline__ int rfl(int v) { return __builtin_amdgcn_readfirstlane(v); }
__device__ __forceinline__ float rflf(float v) { return __builtin_bit_cast(float, __builtin_amdgcn_readfirstlane(__builtin_bit_cast(int, v))); }

__device__ __forceinline__ void p7_phase(Frame& F, bool dry) {
    const int lane0 = hw_lane(), wave = F.wave;
    if (dry && (MK_DRY_SKIP & 16) && wave >= 4) return;
    unsigned char* wl = F.lds + wave * P7_WL;
    int* TE = (int*)(wl + P7_TE); float* TG = (float*)(wl + P7_TG);
    float* LG = (float*)(wl + P7_LG); float* LSU = (float*)(wl + P7_LSU); unsigned char* H2Q = wl + P7_H2Q; float* HST = (float*)(wl + P7_HST);
    const bf16* SC = (const bf16*)(F.ws + WS_SC); const bf16* H2 = (const bf16*)(F.ws + WS_H);
    const unsigned char* U8 = F.ws + WS_U; const unsigned char* V8 = F.ws + WS_V;
    const float* SU = (const float*)(F.ws + WS_SU); const float* SV = (const float*)(F.ws + WS_SV);
    const float* mods = (const float*)(F.ws + WS_MODS); const float* SSP = (const float*)(F.ws + WS_SSP);
    unsigned ctabp = 0;
#pragma unroll
    for (int s = 0; s < 4; ++s) { const int c = 16 * s + (lane0 & 15); int i, j;
        if (c < 16) { i = 0; j = c; } else if (c < 24) { i = 1; j = c - 16; } else if (c < 29) { i = 2; j = c - 24; } else if (c < 33) { i = 3; j = c - 29; } else if (c < 36) { i = 4; j = c - 33; }
        else if (c < 38) { i = 5; j = c - 36; } else if (c < 40) { i = 6; j = c - 38; } else if (c < 42) { i = 7; j = c - 40; } else if (c < 50) { i = c - 34; j = 0; } else { i = -1; j = 0; }
        ctabp |= (unsigned)(i < 0 ? 255 : i * 16 + j) << (8 * s); }
    const int ntg = NTOK / (F.G * NWAVES * 4);
#pragma unroll 1
    for (int tg = 0; tg < ntg; ++tg) {
        const int tok0 = (F.vcu * ntg + tg) * (NWAVES * 4) + wave * 4;
        int lane = hw_lane(); asm volatile("" : "+v"(lane));
        {
            unsigned* TL4 = (unsigned*)(wl + P7_LE);
            topk_stage1(SC, tok0, lane, TL4);
            v4u ch0, ch1, nh0, nh1;
#define P7_TLOAD(H0, H1, tk) do { H0 = *(const v4u*)(H2 + (size_t)(tk) * DM + 16 * lane); H1 = *(const v4u*)(H2 + (size_t)(tk) * DM + 16 * lane + 8); } while (0)
            P7_TLOAD(ch0, ch1, tok0);
#pragma unroll 1
            for (int s = 0; s < 4; ++s) {
                if (s < 3) P7_TLOAD(nh0, nh1, tok0 + s + 1);
                const int tokc = tok0 + s;
                const f32x4* spp = (const f32x4*)(SSP + (size_t)tokc * 16); const f32x4 q0 = spp[0], q1 = spp[1], q2 = spp[2], q3 = spp[3];
                const float* shp = mods + (size_t)mod_index(tokc) * MODW + 3 * DM + 16 * lane;
                const f32x4 sh0 = *(const f32x4*)(shp), sh1 = *(const f32x4*)(shp + 4), sh2v = *(const f32x4*)(shp + 8), sh3 = *(const f32x4*)(shp + 12);
                unsigned ctab_ = ctabp; asm volatile("" : "+v"(ctab_));
                topk_stage2(TL4 + s * 256, lane, ctab_, TE + s * 128, TG + s * 128);
                const v4u a = ch0, b = ch1;
                const float ssr = ((q0[0] + q0[1]) + (q0[2] + q0[3])) + ((q1[0] + q1[1]) + (q1[2] + q1[3])) + ((q2[0] + q2[1]) + (q2[2] + q2[3])) + ((q3[0] + q3[1]) + (q3[2] + q3[3]));
                const float rstd = 1.f / sqrtf(ssr * (1.f / DM) + EPS);
                float hv[16];
                hv[0] = bflo(a.x); hv[1] = bfhi(a.x); hv[2] = bflo(a.y); hv[3] = bfhi(a.y); hv[4] = bflo(a.z); hv[5] = bfhi(a.z); hv[6] = bflo(a.w); hv[7] = bfhi(a.w);
                hv[8] = bflo(b.x); hv[9] = bfhi(b.x); hv[10] = bflo(b.y); hv[11] = bfhi(b.y); hv[12] = bflo(b.z); hv[13] = bfhi(b.z); hv[14] = bflo(b.w); hv[15] = bfhi(b.w);
#pragma unroll
                for (int i = 0; i < 4; ++i) { hv[i] = hv[i] * rstd + sh0[i]; hv[4 + i] = hv[4 + i] * rstd + sh1[i]; hv[8 + i] = hv[8 + i] * rstd + sh2v[i]; hv[12 + i] = hv[12 + i] * rstd + sh3[i]; }
                float am = 0.f;
#pragma unroll
                for (int i = 0; i < 16; ++i) am = fmaxf(am, fabsf(hv[i]));
                am = wave_max(am);
                const float inv = am > 0.f ? 119.f / am : 0.f;
                if (lane == 0) HST[s] = am * (1.f / 119.f);
                v4u qv;
#pragma unroll
                for (int j = 0; j < 4; ++j) { unsigned w = 0;
#pragma unroll
                    for (int i = 0; i < 4; ++i) { int q = (int)rintf(hv[4 * j + i] * inv); w |= ((unsigned)q & 0xffu) << (8 * i); }
                    qv[j] = w; }
                *(v4u*)(H2Q + s * 1024 + 16 * lane) = qv;
                ch0 = nh0; ch1 = nh1;
            }
#undef P7_TLOAD
        }
        {
            unsigned* LEO = (unsigned*)(wl + P7_LE);
            int ee0[4], ee1[4]; float gg0[4], gg1[4], us0[4], us1[4], vs0[4], vs1[4];
#pragma unroll
            for (int s = 0; s < 4; ++s) { ee0[s] = TE[s * 128 + lane]; ee1[s] = TE[s * 128 + 64 + lane]; gg0[s] = TG[s * 128 + lane]; gg1[s] = TG[s * 128 + 64 + lane]; }
#pragma unroll
            for (int s = 0; s < 4; ++s) { us0[s] = SU[ee0[s]]; us1[s] = SU[ee1[s]]; vs0[s] = SV[ee0[s]]; vs1[s] = SV[ee1[s]]; }
#pragma unroll
            for (int s = 0; s < 4; ++s) { const int e0 = ee0[s], e1 = ee1[s]; const int c0 = e0 >> P7_CSH, c1 = e1 >> P7_CSH; int base = s * 128;
#pragma unroll
                for (int c = 0; c < P7_NCH; ++c) {
                    const unsigned long long m0 = __ballot(c0 == c), m1 = __ballot(c1 == c);
                    const int n0 = __popcll(m0), n = n0 + __popcll(m1);
                    if (c0 == c) { const int p = base + mbcnt64(m0); LEO[p] = (unsigned)e0 << 9; LG[p] = gg0[s] * vs0[s]; LSU[p] = us0[s]; }
                    if (c1 == c) { const int p = base + n0 + mbcnt64(m1); LEO[p] = (unsigned)e1 << 9; LG[p] = gg1[s] * vs1[s]; LSU[p] = us1[s]; }
                    base += n;
                } }
        }
        typedef __attribute__((address_space(1))) v4u GV4;
        if (!(dry && (MK_DRY_SKIP & 1))) {
            int lane_u = hw_lane(); asm volatile("" : "+v"(lane_u));
            const int su = lane_u >> 4, ju = lane_u & 15; const unsigned j16 = 16u * (unsigned)ju;
            const unsigned* LEOs = (const unsigned*)(wl + P7_LE) + su * 128; float* LGs = LG + su * 128; const float* LSUs = LSU + su * 128;
            const unsigned long long u8i = (unsigned long long)U8;
            unsigned hh[2][4], hl[2][4];
#pragma unroll
            for (int i = 0; i < 2; ++i) { const v4u ha = *(const v4u*)(H2Q + su * 1024 + 512 * i + 32 * ju), hb = *(const v4u*)(H2Q + su * 1024 + 512 * i + 32 * ju + 16);
#pragma unroll
                for (int w = 0; w < 4; ++w) { unsigned lo16[2], hi16[2];
#pragma unroll
                    for (int h = 0; h < 2; ++h) { const unsigned d = (w < 2 ? ha : hb)[2 * (w & 1) + h];
                        const unsigned t = ((d & 0x7f7f7f7fu) + 0x08080808u) ^ (d & 0x80808080u);
                        unsigned l = (t & 0x0f0f0f0fu) ^ 0x08080808u, g = (t >> 4) & 0x0f0f0f0fu;
                        l = (l | (l >> 4)) & 0x00ff00ffu; l = (l | (l >> 8)) & 0xffffu; g = (g | (g >> 4)) & 0x00ff00ffu; g = (g | (g >> 8)) & 0xffffu;
                        lo16[h] = l; hi16[h] = g; }
                    hl[i][w] = lo16[0] | (lo16[1] << 16); hh[i][w] = hi16[0] | (hi16[1] << 16); } }
            const float hs = HST[su];
            const bool b0 = (ju & 1) != 0, b1 = (ju & 2) != 0; const int rr = ju & 3;
            v4u A[4][2], B[4][2], C[4][2], D[4][2];
#define P7_ULOAD(R, t) do { const v4u eo_ = *(const v4u*)(LEOs + 4 * (t)); \
            _Pragma("unroll") for (int r = 0; r < 4; ++r) { unsigned o_ = eo_[r] + j16; asm volatile("" : "+v"(o_)); \
                R[r][0] = *(const GV4*)(u8i + o_); R[r][1] = *(const GV4*)(u8i + o_ + 256); } \
            __builtin_amdgcn_sched_barrier(0); } while (0)
#define P7_SCOMP_U(R, t) do { const float su_ = LSUs[4 * (t) + rr], g_ = LGs[4 * (t) + rr]; int p_[4]; \
                _Pragma("unroll") for (int r = 0; r < 4; ++r) { int ah = 0, al = 0; \
                    _Pragma("unroll") for (int i = 0; i < 2; ++i) { _Pragma("unroll") for (int w = 0; w < 4; ++w) { \
                        ah = __builtin_amdgcn_sdot8((int)hh[i][w], (int)R[r][i][w], ah, false); al = __builtin_amdgcn_sdot8((int)hl[i][w], (int)R[r][i][w], al, false); } } \
                    p_[r] = 16 * ah + al; } \
                const int q01 = (b0 ? p_[1] : p_[0]) + (int)dppu<0xB1>((unsigned)(b0 ? p_[0] : p_[1])); const int q23 = (b0 ? p_[3] : p_[2]) + (int)dppu<0xB1>((unsigned)(b0 ? p_[2] : p_[3])); \
                int q_ = (b1 ? q23 : q01) + (int)dppu<0x4E>((unsigned)(b1 ? q01 : q23)); q_ += (int)dppu<0x128>((unsigned)q_); q_ += (int)dppu<0x124>((unsigned)q_); \
                const float dotf = (float)q_ * (hs * su_); LGs[4 * (t) + rr] = g_ * gelu_fast(dotf); } while (0)
            P7_ULOAD(A, 0); P7_ULOAD(B, 1); P7_ULOAD(C, 2);
#pragma unroll 1
            for (int t = 0; t < 28; t += 4) {
                P7_ULOAD(D, t + 3); P7_SCOMP_U(A, t);
                P7_ULOAD(A, t + 4); P7_SCOMP_U(B, t + 1);
                P7_ULOAD(B, t + 5); P7_SCOMP_U(C, t + 2);
                P7_ULOAD(C, t + 6); P7_SCOMP_U(D, t + 3);
                asm volatile("" ::: "memory");
            }
            P7_ULOAD(D, 31); P7_SCOMP_U(A, 28); P7_SCOMP_U(B, 29); P7_SCOMP_U(C, 30); P7_SCOMP_U(D, 31);
#undef P7_SCOMP_U
#undef P7_ULOAD
        }
        float cscale; int sumq8;
        {
            int lane_q = hw_lane(); asm volatile("" : "+v"(lane_q));
            const int sq = lane_q >> 4, jq = lane_q & 15;
            const float* lg = LG + sq * 128 + 8 * jq; const f32x4 c0 = *(const f32x4*)lg, c1 = *(const f32x4*)(lg + 4);
            float m = fmaxf(fmaxf(fmaxf(fabsf(c0[0]), fabsf(c0[1])), fmaxf(fabsf(c0[2]), fabsf(c0[3]))), fmaxf(fmaxf(fabsf(c1[0]), fabsf(c1[1])), fmaxf(fabsf(c1[2]), fabsf(c1[3]))));
            m = rowmax16f(m);
            cscale = m * (1.f / 127.f); const float iv = m > 0.f ? 127.f / m : 0.f;
            v2u w; w.x = 0u; w.y = 0u;
#pragma unroll
            for (int k = 0; k < 4; ++k) { w.x |= ((unsigned)(int)rintf(c0[k] * iv) & 0xffu) << (8 * k); w.y |= ((unsigned)(int)rintf(c1[k] * iv) & 0xffu) << (8 * k); }
            *(v2u*)(wl + P7_LQ + (sq * 32 + 2 * jq) * 4) = w;
            int sq8 = 0;
#pragma unroll
            for (int k = 0; k < 4; ++k) sq8 += (int)rintf(c0[k] * iv) + (int)rintf(c1[k] * iv);
            sumq8 = 8 * rowsum16i(sq8);
        }
        int acc[64];
#pragma unroll
        for (int i = 0; i < 64; ++i) acc[i] = 0;
        if (!(dry && (MK_DRY_SKIP & 2))) {
            int lane_v = hw_lane(); asm volatile("" : "+v"(lane_v));
            const int sv_ = lane_v >> 4, jv = lane_v & 15; const unsigned j16 = 16u * (unsigned)jv;
            const unsigned* LEOs = (const unsigned*)(wl + P7_LE) + sv_ * 128; const int* LQs = (const int*)(wl + P7_LQ) + sv_ * 32;
            const unsigned long long v8i = (unsigned long long)V8;
            v4u A[4][2], B[4][2], C[4][2];
#define P7_VLOAD(R, t) do { const v4u eo_ = *(const v4u*)(LEOs + 4 * (t)); \
            _Pragma("unroll") for (int r = 0; r < 4; ++r) { unsigned o_ = eo_[r] + j16; asm volatile("" : "+v"(o_)); \
                R[r][0] = *(const GV4*)(v8i + o_); R[r][1] = *(const GV4*)(v8i + o_ + 256); } \
            __builtin_amdgcn_sched_barrier(0); } while (0)
#define P7_SCOMP_V(R, t) do { const int cq_ = LQs[(t)]; \
                _Pragma("unroll") for (int i = 0; i < 2; ++i) { _Pragma("unroll") for (int w = 0; w < 4; ++w) { \
                    const unsigned x_ = __builtin_amdgcn_perm(R[1][i][w], R[0][i][w], 0x05010400u), y_ = __builtin_amdgcn_perm(R[1][i][w], R[0][i][w], 0x07030602u); \
                    const unsigned c_ = __builtin_amdgcn_perm(R[3][i][w], R[2][i][w], 0x05010400u), e_ = __builtin_amdgcn_perm(R[3][i][w], R[2][i][w], 0x07030602u); \
                    unsigned tb_[4]; tb_[0] = __builtin_amdgcn_perm(c_, x_, 0x05040100u); tb_[1] = __builtin_amdgcn_perm(c_, x_, 0x07060302u); tb_[2] = __builtin_amdgcn_perm(e_, y_, 0x05040100u); tb_[3] = __builtin_amdgcn_perm(e_, y_, 0x07060302u); \
                    _Pragma("unroll") for (int b = 0; b < 4; ++b) {     \
                        acc[32 * i + 8 * w + 2 * b]     = __builtin_amdgcn_sdot4((int)(tb_[b] & 0x0f0f0f0fu), cq_, acc[32 * i + 8 * w + 2 * b], false); \
                        acc[32 * i + 8 * w + 2 * b + 1] = __builtin_amdgcn_sdot4((int)tb_[b], cq_, acc[32 * i + 8 * w + 2 * b + 1], false); } } } } while (0)
            P7_VLOAD(A, 0); P7_VLOAD(B, 1);
#pragma unroll 1
            for (int t = 0; t < 30; t += 3) {
                P7_VLOAD(C, t + 2); P7_SCOMP_V(A, t);
                P7_VLOAD(A, t + 3); P7_SCOMP_V(B, t + 1);
                P7_VLOAD(B, t + 4); P7_SCOMP_V(C, t + 2);
                asm volatile("" ::: "memory");
            }
            P7_SCOMP_V(A, 30); P7_SCOMP_V(B, 31);
#undef P7_SCOMP_V
#undef P7_VLOAD
        }
        {
            int lane_f = hw_lane(); asm volatile("" : "+v"(lane_f));
            const int sf = lane_f >> 4, jf = lane_f & 15; const int tok = tok0 + sf;
            const bf16* xrow = (const bf16*)(F.ws + WS_X1) + (size_t)tok * DM + 32 * jf;
            const float* ga2 = mods + (size_t)mod_index(tok0) * MODW + 5 * DM + 32 * jf;
            const float* gf = F.in[I_GFINAL] + 32 * jf;
            float xs[64]; float ss = 0.f;
#pragma unroll
            for (int i = 0; i < 2; ++i) {
#pragma unroll
                for (int hh_ = 0; hh_ < 2; ++hh_) { f32x4 gv[4];
                    const v4u xa = *(const v4u*)(xrow + 512 * i + 16 * hh_), xb = *(const v4u*)(xrow + 512 * i + 16 * hh_ + 8);
#pragma unroll
                    for (int q = 0; q < 4; ++q) gv[q] = *(const f32x4*)(ga2 + 512 * i + 16 * hh_ + 4 * q);
                    float xv[16];
                    xv[0] = bflo(xa.x); xv[1] = bfhi(xa.x); xv[2] = bflo(xa.y); xv[3] = bfhi(xa.y); xv[4] = bflo(xa.z); xv[5] = bfhi(xa.z); xv[6] = bflo(xa.w); xv[7] = bfhi(xa.w);
                    xv[8] = bflo(xb.x); xv[9] = bfhi(xb.x); xv[10] = bflo(xb.y); xv[11] = bfhi(xb.y); xv[12] = bflo(xb.z); xv[13] = bfhi(xb.z); xv[14] = bflo(xb.w); xv[15] = bfhi(xb.w);
#pragma unroll
                    for (int q = 0; q < 4; ++q)
#pragma unroll
                        for (int k = 0; k < 4; ++k) { const int ci = 32 * i + 16 * hh_ + 4 * q + k;
                            const float pv = (k & 1) ? (float)(acc[ci] - acc[ci - 1]) * (cscale * (1.f / 16.f)) : (float)(acc[ci] - sumq8) * cscale;
                            const float t = xv[4 * q + k] + gv[q][k] * pv; xs[ci] = t; ss += t * t; }
                    asm volatile("" ::: "memory"); } }
            const float rstd = 1.f / sqrtf(rowsum16f(ss) * (1.f / DM) + EPS);
#pragma unroll
            for (int i = 0; i < 2; ++i) {
#pragma unroll
                for (int hh_ = 0; hh_ < 2; ++hh_) { f32x4 gfv[4];
#pragma unroll
                    for (int q = 0; q < 4; ++q) gfv[q] = *(const f32x4*)(gf + 512 * i + 16 * hh_ + 4 * q);
#pragma unroll
                    for (int q = 0; q < 4; ++q) { f32x4 o;
#pragma unroll
                        for (int k = 0; k < 4; ++k) o[k] = xs[32 * i + 16 * hh_ + 4 * q + k] * rstd * gfv[q][k];
                        *(f32x4*)(wl + sf * 4096 + 2048 * i + 128 * jf + 16 * ((4 * hh_ + q) ^ (jf & 7))) = o; }
                    asm volatile("" ::: "memory"); } }
            float* ybase = dry ? (float*)(F.ws + WS_MIX) : F.out + O_Y;
#pragma unroll
            for (int m = 0; m < 16; ++m) { const int sr = m >> 2, f = (m & 3) * 64 + lane_f, jr = (f >> 3) & 15;
                const f32x4 o = *(const f32x4*)(wl + sr * 4096 + 2048 * (f >> 7) + 128 * jr + 16 * ((f & 7) ^ (jr & 7)));
                const int tr = tok0 + sr; *(f32x4*)(ybase + (size_t)(dry ? (tr & 8191) : tr) * DM + 4 * f) = o; }
        }
    }
}

__global__ void __launch_bounds__(NWAVES * 64, 2) mk_fwd(Args args) {
    extern __shared__ __attribute__((aligned(16))) unsigned char lds[];
    Frame F;
    F.lds = lds;
    F.tid = threadIdx.x; F.lane = F.tid & 63; F.wave = __builtin_amdgcn_readfirstlane(F.tid >> 6);
    F.G = gridDim.x; { const int bx = blockIdx.x; F.vcu = (F.G % 8 == 0) ? (bx % 8) * (F.G / 8) + bx / 8 : bx; }
    F.in = args.in; F.out = args.out; F.ws = args.ws;
    LAS unsigned char* lds3 = (LAS unsigned char*)lds;
    volatile LAS unsigned* MISC = (volatile LAS unsigned*)(lds3 + MISC_OFF);
    for (int u = F.tid; u < (LDS_BYTES - LDSCTL_OFF) / 4; u += NWAVES * 64) ((LAS unsigned*)(lds3 + LDSCTL_OFF))[u] = 0u;
    __syncthreads();
    unsigned* ctl = (unsigned*)(args.ws + WS_CTL);
    XcdBarrier bar; bar.bar = ctl + CW_BAR; bar.x = 0; bar.st = nullptr;
    const bool one_launch = (args.ph_hi - args.ph_lo) > 1;
    if (one_launch) bar = xcd_barrier_post(ctl + CW_BAR, MISC + 8);
    const int lo = args.ph_lo, hi = args.ph_hi;
#ifndef MK_PHASE_MASK
#define MK_PHASE_MASK 0xff
#endif
#define IN(k) (((MK_PHASE_MASK >> (k)) & 1) && lo <= (k) && (k) < hi)
#define SEAM(k) do { if (IN(k) && IN((k) + 1)) xcd_barrier(bar); } while (0)

#define DUPQ(k) (MK_DUP == (k))
    if (IN(0)) { if (DUPQ(0)) { p0_phase(F); xcd_barrier(bar); } p0_phase(F); SEAM(0); }
    if (IN(1)) { REFRESH_IDS(F); if (DUPQ(1)) { norm_phase(F, 0); xcd_barrier(bar); } norm_phase(F, 0); bias_items(F); SEAM(1); }
    if (IN(2)) { REFRESH_IDS(F);
        pg8::Gemm g{(const pg8::bf16_t*)(F.ws + WS_H), (const pg8::bf16_t*)(F.ws + WS_WIN), NTOK, D_IN, DM}; pg8::StaticOrder S; S.init(NTOK, D_IN, F.G, (int)blockIdx.x);
        EpiInProj E{(bf16*)(F.ws + WS_Q), (bf16*)(F.ws + WS_K), (bf16*)(F.ws + WS_VT), (bf16*)(F.ws + WS_XR), (bf16*)(F.ws + WS_YG), F.out + O_NEWK, F.out + O_NEWV, (const f32x4*)(F.ws + WS_ROPE)};
        if (DUPQ(2)) { pg8::gemm_phase<EpiInProj, pg8::StaticOrder, true, true>(lds3, g, S, E); xcd_barrier(bar); }
        pg8::gemm_phase<EpiInProj, pg8::StaticOrder, true, true>(lds3, g, S, E);
        if (u_in_p2(F.G) && (int)blockIdx.x >= 192) quant_rows(F, 0, 16384, ((int)blockIdx.x - 192) * NWAVES + F.wave, 64 * NWAVES);
        SEAM(2);
    }
    if (IN(3)) { REFRESH_IDS(F); if (DUPQ(3)) { p3_phase(F, MK_P3_TYPES); xcd_barrier(bar); } p3_phase(F); SEAM(3); }
    if (IN(4)) { REFRESH_IDS(F);
        pg8::Gemm g{(const pg8::bf16_t*)(F.ws + WS_MIX), (const pg8::bf16_t*)(F.ws + WS_WOUT), NTOK, DM, DM}; pg8::StaticOrder S; S.init(NTOK, DM, F.G, (int)blockIdx.x);
        EpiOutProj E{F.in[I_XP], F.in[I_XS], (const float*)(F.ws + WS_MODS), F.in[I_GFFN], (bf16*)(F.ws + WS_X1), (bf16*)(F.ws + WS_H), (float*)(F.ws + WS_SSP)};
        if (DUPQ(4)) { pg8::gemm_phase<EpiOutProj, pg8::StaticOrder, true, true>(lds3, g, S, E); xcd_barrier(bar); }
        pg8::gemm_phase<EpiOutProj, pg8::StaticOrder, true, true>(lds3, g, S, E);
        SEAM(4);
    }
    if (IN(6)) { REFRESH_IDS(F);
        pg8::Gemm g{(const pg8::bf16_t*)(F.ws + WS_H), (const pg8::bf16_t*)(F.ws + WS_WC), NTOK, 2048, DM}; pg8::StaticOrder S; S.init(NTOK, 2048, F.G, (int)blockIdx.x);
        EpiScores E{(bf16*)(F.ws + WS_SC), (const float*)(F.ws + WS_SSP), (const float*)(F.ws + WS_BIAS)};
        if (DUPQ(6)) { pg8::gemm_phase<EpiScores, pg8::StaticOrder, true, true>(lds3, g, S, E); xcd_barrier(bar); }
        pg8::gemm_phase<EpiScores, pg8::StaticOrder, true, true>(lds3, g, S, E);
        SEAM(6);
    }
    if (IN(7)) { REFRESH_IDS(F); if (DUPQ(7)) { p7_phase(F, true); xcd_barrier(bar); } p7_phase(F, false); }
#undef IN
#undef SEAM
}

extern "C" void kernel_launch(void* const* d_in, const int* in_sizes, int n_in, void* d_out, int out_size, void* d_ws, size_t ws_size, hipStream_t stream) {
    static int grid = 0;
    if (grid == 0) {
        if (n_in != 26 || ws_size < WS_END) { fprintf(stderr, "kernel_launch: unexpected n_in %d / ws %zu\n", n_in, ws_size); grid = -1; return; }
        int dev = 0, cus = 0, per_cu = 0;
        if (hipGetDevice(&dev) != hipSuccess || hipDeviceGetAttribute(&cus, hipDeviceAttributeMultiprocessorCount, dev) != hipSuccess) { grid = -1; return; }
        if (hipFuncSetAttribute((const void*)mk_fwd, hipFuncAttributeMaxDynamicSharedMemorySize, LDS_BYTES) != hipSuccess) { fprintf(stderr, "kernel_launch: hipFuncSetAttribute failed\n"); grid = -1; return; }
        if (hipOccupancyMaxActiveBlocksPerMultiprocessor(&per_cu, (const void*)mk_fwd, NWAVES * 64, LDS_BYTES) != hipSuccess || per_cu < 1)
            fprintf(stderr, "kernel_launch: occupancy query reports %d blocks per CU\n", per_cu);
        (void)hipGetLastError();
        grid = cus;
        if (grid != 256) fprintf(stderr, "kernel_launch: note: %d CUs\n", grid);
    }
    if (grid < 0) return;
    (void)hipMemsetAsync((char*)d_ws + WS_CTL, 0, CTL_ZERO_BYTES, stream);
    Args a{};
    for (int i = 0; i < 26; ++i) a.in[i] = (const float*)d_in[i];
    a.out = (float*)d_out; a.ws = (unsigned char*)d_ws;
    if (MK_N_LAUNCHES == 1) {
        a.ph_lo = 0; a.ph_hi = N_PHASES; a.li = 0;
        hipLaunchKernelGGL(mk_fwd, dim3(grid), dim3(NWAVES * 64), LDS_BYTES, stream, a);
    } else {
        for (int li = 0; li < N_PHASES; ++li) { a.ph_lo = li; a.ph_hi = li + 1; a.li = li;
            hipLaunchKernelGGL(mk_fwd, dim3(grid), dim3(NWAVES * 64), LDS_BYTES, stream, a); }
    }
}
```

```cpp
#include <hip/hip_runtime.h>
#include <cstdio>
#include <cstdint>

#ifndef MK_DUP
#define MK_DUP -1
#endif
#ifndef MK_DRY_SKIP
#define MK_DRY_SKIP 0
#endif
#ifndef MK_N_LAUNCHES
#define MK_N_LAUNCHES 1
#endif

namespace pg8 {
#define PG8_LAS __attribute__((address_space(3)))
typedef unsigned short bf16_t;
typedef short bf16x8 __attribute__((ext_vector_type(8)));
typedef float f32x4 __attribute__((ext_vector_type(4)));
typedef unsigned u32x4 __attribute__((ext_vector_type(4)));
typedef unsigned u32x2 __attribute__((ext_vector_type(2)));
constexpr int BM = 256, BK = 64, HALF = 128, HTB = HALF * BK * 2, STAGE_BYTES = 8 * HTB, NXCD = 8, WGM = 8;

__host__ __device__ __forceinline__ int lds_byte(int r, int c) { const int st = (r >> 4) * 2 + (c >> 5), rr = r & 15, cc = c & 31, ob = rr * 64 + cc * 2; return st * 1024 + (ob ^ (((ob >> 9) & 1) << 5)); }
__host__ __device__ __forceinline__ void stage_rc(int b, int& R, int& C) { const int st = b / 1024, sb = b % 1024, swz = sb ^ (((sb >> 9) & 1) << 5); R = (st >> 1) * 16 + swz / 64; C = (st & 1) * 32 + (swz % 64) / 2; }
__host__ __device__ __forceinline__ int perm32(int rho) { const int n = rho >> 4, i = rho & 15; return 8 * (i >> 2) + 4 * n + (i & 3); }

struct Unit { int pm, pn; };
struct Gemm { const bf16_t* A; const bf16_t* Bt; int M, N, K; };

struct StaticOrder {
    int nM, nN, nwg, G, c;
    __host__ __device__ void init(int M, int N, int G_, int c_) { nM = M / BM; nN = N / BM; nwg = nM * nN; G = G_; c = c_; }
    __host__ __device__ bool next(int i, Unit& u) const {
        const long L = (long)i * G + c; if (L >= nwg) return false;
        int wgid = (int)L; { const int q = nwg / NXCD, r = nwg % NXCD, xcd = wgid % NXCD, off = wgid / NXCD; wgid = (xcd < r ? xcd * (q + 1) : r * (q + 1) + (xcd - r) * q) + off; }
        const int nig = WGM * nN, gid = wgid / nig, fm = gid * WGM, gsz = (nM - fm) < WGM ? (nM - fm) : WGM;
        u.pm = fm + ((wgid % nig) % gsz); u.pn = (wgid % nig) / gsz; return true;
    }
    __device__ __forceinline__ void a_ready(const Unit&) const {}
    __device__ __forceinline__ void done(const Unit&) const {}
};

__device__ __forceinline__ unsigned cvt_pk_bf16(float lo, float hi) { unsigned r; asm volatile("v_cvt_pk_bf16_f32 %0, %1, %2" : "=v"(r) : "v"(lo), "v"(hi)); return r; }

template <class Epi, class Sched, bool ALIGN_EPI = false, bool SP2 = false>
__device__ __forceinline__ void gemm_phase(PG8_LAS unsigned char* lds, const Gemm g, const Sched& S, const Epi& E) {
    int tid_ = threadIdx.x; asm volatile("" : "+v"(tid_));
    const int tid = tid_, wid = __builtin_amdgcn_readfirstlane(tid >> 6), lane = tid & 63, wr = wid >> 2, wc = wid & 3, fr = lane & 15, fq = lane >> 4;
    const int K = g.K, nt = K / BK;
    unsigned voffA[2], voffB[2];
#pragma unroll
    for (int i = 0; i < 2; ++i) { int R, C; stage_rc(tid * 16 + i * 8192, R, C); const int Rb = Epi::PERM ? ((R & ~31) + perm32(R & 31)) : R;
        voffA[i] = (unsigned)(R * K + C) * 2u; voffB[i] = (unsigned)(Rb * K + C) * 2u; }
    const size_t kstep = (size_t)(BK * 2);
    const size_t hstep = (size_t)HALF * K * 2;
    const size_t tstep = 2 * hstep;
    const unsigned ldsw = (unsigned)wid * 1024u;
    const int aoff = lds_byte(wr * 64 + fr, fq * 8), boff = lds_byte(wc * 32 + fr, fq * 8);
#define PG8_SA(b, h) (((b) * 2 + (h)) * HTB)
#define PG8_SB(b, h) ((4 + (b) * 2 + (h)) * HTB)
#define PG8_STAGE(bufoff, gbase, voff) do { _Pragma("unroll") for (int _i = 0; _i < 2; ++_i) \
        __builtin_amdgcn_global_load_lds((const unsigned*)((const char*)(gbase) + (voff)[_i]), (PG8_LAS unsigned*)(lds + (bufoff) + ldsw + _i * 8192), 16, 0, 0); } while (0)
#define PG8_LDA(dst, b, h) do { _Pragma("unroll") for (int m = 0; m < 4; ++m) _Pragma("unroll") for (int k = 0; k < 2; ++k) dst[m][k] = *(const PG8_LAS bf16x8*)(lds + PG8_SA(b, h) + aoff + m * 2048 + k * 1024); } while (0)
#define PG8_LDB(dst, b, h) do { _Pragma("unroll") for (int n = 0; n < 2; ++n) _Pragma("unroll") for (int k = 0; k < 2; ++k) dst[n][k] = *(const PG8_LAS bf16x8*)(lds + PG8_SB(b, h) + boff + n * 2048 + k * 1024); } while (0)
#define PG8_MMA(ai, bj, At, Bt) do { __builtin_amdgcn_s_setprio(1); _Pragma("unroll") for (int m = 0; m < 4; ++m) _Pragma("unroll") for (int n = 0; n < 2; ++n) _Pragma("unroll") for (int k = 0; k < 2; ++k) \
        acc[ai][bj][m][n] = __builtin_amdgcn_mfma_f32_16x16x32_bf16(Bt[n][k], At[m][k], acc[ai][bj][m][n], 0, 0, 0); __builtin_amdgcn_s_setprio(0); } while (0)
#define PG8_WAIT_V(n) asm volatile("s_waitcnt vmcnt(" #n ")" ::: "memory")
#define PG8_WAIT_L(n) asm volatile("s_waitcnt lgkmcnt(" #n ")" ::: "memory")
#define PG8_BAR __builtin_amdgcn_s_barrier()
#define PG8_SCHED __builtin_amdgcn_sched_barrier(0)
    Unit cur, nxt; int ui = 0;
    if (!S.next(0, cur)) return;
    f32x4 acc[2][2][4][2];
#pragma unroll
    for (int a = 0; a < 2; ++a)
#pragma unroll
        for (int b = 0; b < 2; ++b)
#pragma unroll
            for (int m = 0; m < 4; ++m)
#pragma unroll
                for (int n = 0; n < 2; ++n) acc[a][b][m][n] = (f32x4){0.f, 0.f, 0.f, 0.f};
    bf16x8 At[4][2], B0[2][2], B1[2][2];
    const char* cA = (const char*)g.A + (size_t)cur.pm * tstep; const char* cB = (const char*)g.Bt + (size_t)cur.pn * tstep;
    S.a_ready(cur);
    if constexpr (SP2) {
        PG8_STAGE(PG8_SB(0, 0), cB, voffB); PG8_STAGE(PG8_SB(0, 1), cB + hstep, voffB); PG8_STAGE(PG8_SA(0, 0), cA, voffA); PG8_STAGE(PG8_SA(0, 1), cA + hstep, voffA);
        if (wr == 1) PG8_BAR;
        PG8_WAIT_V(2); PG8_BAR;
        PG8_STAGE(PG8_SB(1, 0), cB + kstep, voffB); PG8_STAGE(PG8_SA(1, 0), cA + kstep, voffA); PG8_STAGE(PG8_SB(1, 1), cB + hstep + kstep, voffB);
        PG8_WAIT_V(6); PG8_BAR;
    } else {
        PG8_STAGE(PG8_SB(0, 0), cB, voffB); PG8_STAGE(PG8_SA(0, 0), cA, voffA); PG8_STAGE(PG8_SB(0, 1), cB + hstep, voffB); PG8_STAGE(PG8_SA(0, 1), cA + hstep, voffA);
        if (wr == 1) PG8_BAR;
        PG8_WAIT_V(4); PG8_BAR;
        PG8_STAGE(PG8_SB(1, 0), cB + kstep, voffB); PG8_STAGE(PG8_SA(1, 0), cA + kstep, voffA); PG8_STAGE(PG8_SB(1, 1), cB + hstep + kstep, voffB);
        PG8_WAIT_V(6); PG8_BAR;
    }
    for (;;) {
        const bool has_next = S.next(ui + 1, nxt);
        const char* nA = has_next ? (const char*)g.A + (size_t)nxt.pm * tstep : cA; const char* nB = has_next ? (const char*)g.Bt + (size_t)nxt.pn * tstep : cB;
        for (int t = 0; t < nt; t += 2) {
            const bool last = (t == nt - 2);
            const char* a1 = cA + (size_t)(t + 1) * kstep;
            const char* a2 = last ? nA : cA + (size_t)(t + 2) * kstep; const char* b2 = last ? nB : cB + (size_t)(t + 2) * kstep;
            const char* a3 = a2 + kstep; const char* b3 = b2 + kstep;
            if (last && has_next) S.a_ready(nxt);
            if constexpr (SP2) {
            PG8_LDB(B0, 0, 0); PG8_LDB(B1, 0, 1); PG8_SCHED; PG8_LDA(At, 0, 0); PG8_STAGE(PG8_SA(1, 1), a1 + hstep, voffA);
            PG8_WAIT_V(8); PG8_WAIT_L(0); PG8_BAR; PG8_MMA(0, 0, At, B0); PG8_MMA(0, 1, At, B1); PG8_BAR; PG8_SCHED;
            PG8_LDA(At, 0, 1); PG8_STAGE(PG8_SB(0, 0), b2, voffB); PG8_STAGE(PG8_SB(0, 1), b2 + hstep, voffB); PG8_STAGE(PG8_SA(0, 0), a2, voffA);
            PG8_WAIT_V(8); PG8_WAIT_L(0); PG8_BAR; PG8_MMA(1, 0, At, B0); PG8_MMA(1, 1, At, B1); PG8_BAR; PG8_SCHED;
            PG8_LDB(B0, 1, 0); PG8_LDB(B1, 1, 1); PG8_SCHED; PG8_LDA(At, 1, 0); PG8_STAGE(PG8_SA(0, 1), a2 + hstep, voffA);
            PG8_WAIT_V(8); PG8_WAIT_L(0); PG8_BAR; PG8_MMA(0, 0, At, B0); PG8_MMA(0, 1, At, B1); PG8_BAR; PG8_SCHED;
            PG8_LDA(At, 1, 1); PG8_STAGE(PG8_SB(1, 0), b3, voffB); PG8_STAGE(PG8_SB(1, 1), b3 + hstep, voffB); PG8_STAGE(PG8_SA(1, 0), a3, voffA);
            PG8_WAIT_V(8); PG8_WAIT_L(0); PG8_BAR; PG8_MMA(1, 0, At, B0); PG8_MMA(1, 1, At, B1); PG8_BAR; PG8_SCHED;
            } else {
            PG8_LDB(B0, 0, 0); PG8_SCHED; PG8_LDA(At, 0, 0); PG8_STAGE(PG8_SA(1, 1), a1 + hstep, voffA);
            PG8_WAIT_L(8); PG8_BAR; PG8_WAIT_L(0); PG8_MMA(0, 0, At, B0); PG8_BAR; PG8_SCHED;
            PG8_LDB(B1, 0, 1); PG8_STAGE(PG8_SB(0, 0), b2, voffB);
            PG8_BAR; PG8_WAIT_L(0); PG8_MMA(0, 1, At, B1); PG8_BAR;
            PG8_LDA(At, 0, 1); PG8_STAGE(PG8_SA(0, 0), a2, voffA);
            PG8_BAR; PG8_WAIT_L(0); PG8_MMA(1, 0, At, B0); PG8_BAR; PG8_SCHED;
            PG8_STAGE(PG8_SB(0, 1), b2 + hstep, voffB);
            PG8_WAIT_V(6); PG8_BAR; PG8_MMA(1, 1, At, B1); PG8_BAR;
            PG8_LDB(B0, 1, 0); PG8_SCHED; PG8_LDA(At, 1, 0); PG8_STAGE(PG8_SA(0, 1), a2 + hstep, voffA);
            PG8_WAIT_L(8); PG8_BAR; PG8_WAIT_L(0); PG8_MMA(0, 0, At, B0); PG8_BAR; PG8_SCHED;
            PG8_LDB(B1, 1, 1); PG8_STAGE(PG8_SB(1, 0), b3, voffB);
            PG8_BAR; PG8_WAIT_L(0); PG8_MMA(0, 1, At, B1); PG8_BAR;
            PG8_LDA(At, 1, 1); PG8_STAGE(PG8_SA(1, 0), a3, voffA);
            PG8_BAR; PG8_WAIT_L(0); PG8_MMA(1, 0, At, B0); PG8_BAR; PG8_SCHED;
            PG8_STAGE(PG8_SB(1, 1), b3 + hstep, voffB);
            PG8_WAIT_V(6); PG8_BAR; PG8_MMA(1, 1, At, B1); PG8_BAR;
            }
        }
        if constexpr (ALIGN_EPI) { if (wr == 0) PG8_BAR; }
        { int te_ = threadIdx.x; asm volatile("" : "+v"(te_));
          const int we_ = __builtin_amdgcn_readfirstlane(te_ >> 6), le_ = te_ & 63;
          E(acc, cur, we_ >> 2, we_ & 3, le_ & 15, le_ >> 4); }
        S.done(cur);
        if (!has_next) break;
#pragma unroll
        for (int a = 0; a < 2; ++a)
#pragma unroll
            for (int b = 0; b < 2; ++b)
#pragma unroll
                for (int m = 0; m < 4; ++m)
#pragma unroll
                    for (int n = 0; n < 2; ++n) acc[a][b][m][n] = (f32x4){0.f, 0.f, 0.f, 0.f};
        cur = nxt; cA = nA; cB = nB; ++ui;
        if constexpr (ALIGN_EPI) { if (wr == 1) PG8_BAR; }
    }
    PG8_WAIT_V(0);
    if constexpr (!ALIGN_EPI) { if (wr == 0) PG8_BAR; }
    PG8_BAR;
#undef PG8_SA
#undef PG8_SB
#undef PG8_STAGE
#undef PG8_LDA
#undef PG8_LDB
#undef PG8_MMA
#undef PG8_WAIT_V
#undef PG8_WAIT_L
#undef PG8_BAR
#undef PG8_SCHED
}
}

constexpr int NWAVES = 8;
constexpr int DM = 1024, NTOK = 16384, NCTX = 8192, D_IN = 1792, NMODV = 9, MODW = 6144;
constexpr int SEQ_C = 256, SEQ_L = 1024, NSEQ_C = 32, NSEQ_L = 8;
constexpr int N_PHASES = 8;
constexpr float LOG2E = 1.4426950408889634f;
constexpr float QSCALE = 0.125f * LOG2E;
constexpr float EPS = 1e-6f;

constexpr size_t MiB = 1u << 20, KiB = 1u << 10;
constexpr size_t WS_CTL = 0, CTL_ZERO_BYTES = 64 * KiB;
constexpr size_t WS_MODS = 1 * MiB;
constexpr size_t WS_ROPE = 1 * MiB + 256 * KiB;
constexpr size_t WS_RGW  = 1 * MiB + 512 * KiB;
constexpr size_t WS_CK   = 1 * MiB + 768 * KiB;
constexpr size_t WS_CVT  = 2 * MiB + 256 * KiB;
constexpr size_t WS_WIN  = 3 * MiB;
constexpr size_t WS_WOUT = 7 * MiB;
constexpr size_t WS_WC   = 9 * MiB;
constexpr size_t WS_U    = 16 * MiB;
constexpr size_t WS_SSP  = 14 * MiB;
constexpr size_t WS_BIAS = 15 * MiB;
constexpr size_t WS_SU   = 13 * MiB;
constexpr size_t WS_SV   = 13 * MiB + 64 * KiB;
constexpr size_t WS_V    = 48 * MiB;
constexpr size_t WS_H    = 80 * MiB;
constexpr size_t WS_MIX  = 112 * MiB;
constexpr size_t WS_Q    = 144 * MiB;
constexpr size_t WS_K    = 160 * MiB;
constexpr size_t WS_VT   = 164 * MiB;
constexpr size_t WS_XR   = 168 * MiB;
constexpr size_t WS_YG   = 184 * MiB;
constexpr size_t WS_HF   = 200 * MiB;
constexpr size_t WS_X1   = 208 * MiB;
constexpr size_t WS_SC   = 144 * MiB;
constexpr size_t WS_END  = 232 * MiB;
constexpr int VT_LAT_OFF = NSEQ_C * 2 * 64 * SEQ_C;

constexpr int CW_BAR = 4096;

constexpr int RING_BYTES = 131072;
constexpr int LDSCTL_OFF = 146944, MISC_OFF = LDSCTL_OFF + 320;
constexpr int LDS_BYTES = 147456;

#define GAS __attribute__((address_space(1)))
#define LAS __attribute__((address_space(3)))
typedef unsigned short bf16;
typedef unsigned v4u __attribute__((ext_vector_type(4)));
typedef unsigned v2u __attribute__((ext_vector_type(2)));
typedef float f32x4 __attribute__((ext_vector_type(4)));
typedef float f32x2 __attribute__((ext_vector_type(2)));
typedef float f32x16 __attribute__((ext_vector_type(16)));
typedef short bf16x8 __attribute__((ext_vector_type(8)));
typedef GAS unsigned gu32;
#define RLX_AGENT __ATOMIC_RELAXED, __HIP_MEMORY_SCOPE_AGENT

__device__ __forceinline__ unsigned f2bf(float f) { unsigned u = __builtin_bit_cast(unsigned, f); return (u + 0x7fffu + ((u >> 16) & 1u)) >> 16; }
typedef float f32x2_t_ __attribute__((ext_vector_type(2))); typedef __bf16 bf16x2_t_ __attribute__((ext_vector_type(2)));
__device__ __forceinline__ unsigned pk2(float lo, float hi) { f32x2_t_ v = {lo, hi}; bf16x2_t_ b = __builtin_convertvector(v, bf16x2_t_); return __builtin_bit_cast(unsigned, b); }
__device__ __forceinline__ float bf2f(unsigned b) { return __builtin_bit_cast(float, b << 16); }
__device__ __forceinline__ float bflo(unsigned w) { return __builtin_bit_cast(float, w << 16); }
__device__ __forceinline__ float bfhi(unsigned w) { return __builtin_bit_cast(float, w & 0xffff0000u); }
__device__ __forceinline__ float sigmoidf_(float x) { return 1.f / (1.f + __expf(-x)); }
__device__ __forceinline__ float gelu_tanh(float x) { const float y = 0.7978845608028654f * (x + 0.044715f * x * x * x); const float e = __expf(2.f * y); return 0.5f * x * (2.f - 2.f / (1.f + e)); }
template <int CTRL> __device__ __forceinline__ float dppf_(float v) { return __builtin_bit_cast(float, __builtin_amdgcn_update_dpp(0, __builtin_bit_cast(int, v), CTRL, 0xf, 0xf, true)); }
__device__ __forceinline__ float xrow16_(float v) {
    unsigned a = __builtin_bit_cast(unsigned, v), b = a; asm volatile("" : "+v"(b));
    const auto r = __builtin_amdgcn_permlane16_swap(a, b, false, false);
    const bool odd = (threadIdx.x & 16) != 0; return __builtin_bit_cast(float, odd ? r[0] : r[1]);
}
__device__ __forceinline__ float xhalf32_(float v) {
    unsigned a = __builtin_bit_cast(unsigned, v), b = a; asm volatile("" : "+v"(b));
    const auto r = __builtin_amdgcn_permlane32_swap(a, b, false, false);
    const bool hi = (threadIdx.x & 32) != 0; return __builtin_bit_cast(float, hi ? r[0] : r[1]);
}
__device__ __forceinline__ float wave_sum(float v) {
    v += dppf_<0xB1>(v); v += dppf_<0x4E>(v); v += dppf_<0x141>(v); v += dppf_<0x140>(v);
    v += xrow16_(v); v += xhalf32_(v); return v;
}
__device__ __forceinline__ float wave_max(float v) {
    v = fmaxf(v, dppf_<0xB1>(v)); v = fmaxf(v, dppf_<0x4E>(v)); v = fmaxf(v, dppf_<0x141>(v)); v = fmaxf(v, dppf_<0x140>(v));
    v = fmaxf(v, xrow16_(v)); v = fmaxf(v, xhalf32_(v)); return v;
}
__device__ __forceinline__ int crow(int r, int hi) { return (r & 3) + 8 * (r >> 2) + 4 * hi; }

#define XB_TMO      128
#define XB_XCNT(j)  (256  + 64 * (j))
#define XB_XSUB(j)  (1280 + 64 * (j))
#define XB_XGEN(j)  (2304 + 64 * (j))
#define XB_TOP      3328
#define XB_TOPGEN   3392
#define XCD_BAR_WORDS 3456
#define XB_SPIN_CAP (1u << 18)
__device__ __forceinline__ unsigned xb_ld(unsigned* p)              { return __hip_atomic_load(p, __ATOMIC_RELAXED, __HIP_MEMORY_SCOPE_AGENT); }
__device__ __forceinline__ unsigned xb_add(unsigned* p, unsigned v) { return __hip_atomic_fetch_add(p, v, __ATOMIC_RELAXED, __HIP_MEMORY_SCOPE_AGENT); }
__device__ __forceinline__ unsigned xb_xcc_id() { return (unsigned)__builtin_amdgcn_s_getreg((3 << 11) | 20) & 0xFu; }
#define XB_SPIN(cond, bar) do { unsigned _sp = 0; while (cond) { __builtin_amdgcn_s_sleep(1); \
    if ((++_sp & 255u) == 0u) { if (xb_ld(&(bar)[XB_TMO])) break; if (_sp > XB_SPIN_CAP) { atomicAdd(&(bar)[XB_TMO], 1u); break; } } } } while (0)
struct XcdBarrier { unsigned* bar; unsigned x; volatile LAS unsigned* st; };
__device__ __forceinline__ XcdBarrier xcd_barrier_post(unsigned* bar, volatile LAS unsigned* st) {
    XcdBarrier b; b.bar = bar; b.x = xb_xcc_id(); b.st = st;
    if (threadIdx.x == 0) (void)xb_add(&bar[XB_XCNT(b.x)], 1u);
    return b;
}
__device__ __forceinline__ void xcd_barrier_complete(unsigned* bar, unsigned x, unsigned& nloc, unsigned& nx) {
    const unsigned G = gridDim.x * gridDim.y * gridDim.z;
    unsigned sum, cnt, mine, sp = 0u;
    for (;;) {
        sum = 0u; cnt = 0u; mine = 0u;
#pragma unroll
        for (unsigned j = 0; j < 16; ++j) { const unsigned c = xb_ld(&bar[XB_XCNT(j)]); sum += c; cnt += (c > 0u) ? 1u : 0u; mine = (j == x) ? c : mine; }
        if (sum == G) break;
        __builtin_amdgcn_s_sleep(1);
        if ((++sp & 255u) == 0u) { if (xb_ld(&bar[XB_TMO])) break; if (sp > XB_SPIN_CAP) { atomicAdd(&bar[XB_TMO], 1u); break; } }
    }
    nloc = mine > 0u ? mine : 1u; nx = cnt > 0u ? cnt : 1u;
}
__device__ __forceinline__ void xcd_barrier(const XcdBarrier& b) {
    asm volatile("s_waitcnt vmcnt(0)" ::: "memory");
    __syncthreads();
    if (threadIdx.x == 0) {
        unsigned* bar = b.bar;
        __builtin_amdgcn_s_waitcnt(0);
        unsigned nloc = b.st[0], nx = b.st[1];
        if (nloc == 0u) { xcd_barrier_complete(bar, b.x, nloc, nx); b.st[0] = nloc; b.st[1] = nx; }
        const unsigned old = xb_add(&bar[XB_XSUB(b.x)], 1u);
        const unsigned gen = old / nloc;
        if (old + 1u == (gen + 1u) * nloc) {
            __builtin_amdgcn_fence(__ATOMIC_RELEASE, "agent");
            asm volatile("s_waitcnt vmcnt(0)" ::: "memory");
            const unsigned og = xb_add(&bar[XB_TOP], 1u);
            const unsigned tg = og / nx;
            if (og + 1u == (tg + 1u) * nx) xb_add(&bar[XB_TOPGEN], 1u);
            else XB_SPIN(xb_ld(&bar[XB_TOPGEN]) == tg, bar);
            __builtin_amdgcn_fence(__ATOMIC_ACQUIRE, "agent");
            xb_add(&bar[XB_XGEN(b.x)], 1u);
            asm volatile("s_waitcnt vmcnt(0)" ::: "memory");
        } else {
            XB_SPIN(xb_ld(&bar[XB_XGEN(b.x)]) == gen, bar);
            __builtin_amdgcn_fence(__ATOMIC_ACQUIRE, "agent");
            asm volatile("s_waitcnt vmcnt(0)" ::: "memory");
        }
    }
    __syncthreads();
}

struct Args { const float* in[26]; float* out; unsigned char* ws; int ph_lo, ph_hi, li, pad; };

struct Frame {
    unsigned char* lds;
    int tid, lane, wave, vcu, G;
    const float* const* in;
    float* out; unsigned char* ws;
};
enum { I_XP = 0, I_XS, I_CK, I_CV, I_SRNN, I_C, I_CCTX, I_WMOD, I_BMOD, I_GMIX, I_GFFN, I_WIN, I_CONVW, I_CONVB, I_RGWA, I_RGBA, I_RGWI, I_RGBI, I_RGLAM, I_SINK, I_WOUT, I_PWQ, I_PSK, I_PU, I_PV, I_GFINAL };
constexpr size_t O_Y = 0, O_NEWK = (size_t)NTOK * DM, O_NEWV = O_NEWK + (size_t)NCTX * 128, O_NEWRNN = O_NEWV + (size_t)NCTX * 128;

__device__ __forceinline__ int mod_index(int tok) { return tok < NCTX ? 0 : 1 + ((tok - NCTX) >> 10); }
__device__ __forceinline__ const float* x_row(const Frame& F, int tok) { return tok < NCTX ? F.in[I_XP] + (size_t)tok * DM : F.in[I_XS] + (size_t)(tok - NCTX) * DM; }

__device__ __forceinline__ int hw_lane() { int l; asm volatile("v_mbcnt_lo_u32_b32 %0, -1, 0\n\tv_mbcnt_hi_u32_b32 %0, -1, %0" : "=v"(l)); return l; }
#define REFRESH_IDS(F) do { F.lane = hw_lane(); F.tid = F.wave * 64 + F.lane; } while (0)
template <class RowMap>
__device__ __forceinline__ void p0_transpose_item(const float* W, int K, int N, bf16* WT, float* scr, int item, int lane, RowMap rowmap, float scale = 1.f) {
    const int nblk = N / 32, kb = item / nblk, nb = item % nblk, k0 = 64 * kb, n0 = 32 * nb;
#pragma unroll 8
    for (int i = 0; i < 32; ++i) { const int kk = 2 * i + (lane >> 5); scr[kk * 33 + (lane & 31)] = W[(size_t)(k0 + kk) * N + n0 + (lane & 31)]; }
    __builtin_amdgcn_s_waitcnt(0xC07F); asm volatile("" ::: "memory");
    const int c = lane & 7;
#pragma unroll
    for (int j = 0; j < 4; ++j) { const int n = (lane >> 3) + 8 * j; const float* s = scr + (8 * c) * 33 + n;
        v4u o; o.x = pk2(s[0 * 33] * scale, s[1 * 33] * scale); o.y = pk2(s[2 * 33] * scale, s[3 * 33] * scale); o.z = pk2(s[4 * 33] * scale, s[5 * 33] * scale); o.w = pk2(s[6 * 33] * scale, s[7 * 33] * scale);
        *(v4u*)(WT + (size_t)rowmap(n0 + n) * K + k0 + 8 * c) = o; }
    __builtin_amdgcn_s_waitcnt(0xC07F); asm volatile("" ::: "memory");
}
struct MapId { __device__ __forceinline__ int operator()(int n) const { return n; } };
struct MapWin { __device__ __forceinline__ int operator()(int n) const { if (n >= 640) return n; const int hb = n & ~63, o = n & 63; return hb + ((o & 31) << 1) + (o >> 5); } };

__device__ __forceinline__ bool u_in_p2(int G) { return 2 * G - (NTOK / 256) * (D_IN / 256) == 64 && G == 256; }
__device__ __forceinline__ void quant_rows(Frame& F, int it_lo, int it_hi, int w, int nw) {
    const int lane = F.lane;
    for (int it0 = it_lo + 4 * w; it0 < it_hi; it0 += 4 * nw) {
        f32x4 a[4][4];
#pragma unroll
        for (int r = 0; r < 4; ++r) { const int it = it0 + r, tb = it >> 14, row = it & 16383;
            const float* src = (tb ? F.in[I_PV] : F.in[I_PU]) + (size_t)row * DM + 16 * lane;
#pragma unroll
            for (int j = 0; j < 4; ++j) a[r][j] = *(const f32x4*)(src + 4 * j); }
        float am[4];
#pragma unroll
        for (int r = 0; r < 4; ++r) { float m = 0.f;
#pragma unroll
            for (int j = 0; j < 4; ++j) m = fmaxf(m, fmaxf(fmaxf(fabsf(a[r][j][0]), fabsf(a[r][j][1])), fmaxf(fabsf(a[r][j][2]), fabsf(a[r][j][3]))));
            am[r] = m; }
#pragma unroll
        for (int r = 0; r < 4; ++r) am[r] = wave_max(am[r]);
#pragma unroll
        for (int r = 0; r < 4; ++r) { const int it = it0 + r, tb = it >> 14, row = it & 16383;
            if (tb) {
                const float inv = am[r] > 0.f ? 7.f / am[r] : 0.f;
                v2u o2;
#pragma unroll
                for (int h = 0; h < 2; ++h) { unsigned w = 0;
#pragma unroll
                    for (int c = 0; c < 8; ++c) { int q = (int)rintf(a[r][2 * h + (c >> 2)][c & 3] * inv); q = q > 7 ? 7 : (q < -7 ? -7 : q); w |= ((unsigned)((c & 1) ? q : q + 8) & 0xfu) << (4 * c); }
                    o2[h] = w; }
                *(v2u*)(F.ws + WS_V + (size_t)row * (DM / 2) + 8 * lane) = o2;
                if (lane == 0) ((float*)(F.ws + WS_SV))[row] = am[r] * (1.f / 7.f);
            } else {
                const float inv = am[r] > 0.f ? 7.f / am[r] : 0.f;
                v2u o2;
#pragma unroll
                for (int h = 0; h < 2; ++h) { unsigned w = 0;
#pragma unroll
                    for (int c = 0; c < 8; ++c) { int q = (int)rintf(a[r][2 * h + (c >> 2)][c & 3] * inv); q = q > 7 ? 7 : (q < -7 ? -7 : q); w |= ((unsigned)q & 0xfu) << (4 * c); }
                    o2[h] = w; }
                *(v2u*)(F.ws + WS_U + (size_t)row * (DM / 2) + 8 * lane) = o2;
                if (lane == 0) ((float*)(F.ws + WS_SU))[row] = am[r] * (1.f / 7.f);
            } }
    }
}

__device__ __forceinline__ void p0_phase(Frame& F) {
    float* ldsf = (float*)F.lds;
    const int tid = F.tid, lane = F.lane, wave = F.wave, v = F.vcu;
    if (v < 192) {
        for (int i = tid; i < NMODV * DM; i += 512) { const int j = i >> 10, d = i & 1023; const float c = (j == 0) ? F.in[I_CCTX][d] : F.in[I_C][(j - 1) * DM + d]; ldsf[i] = c * sigmoidf_(c); }
        __syncthreads();
        const int e0 = 32 * v, c4 = tid & 7, kq = tid >> 3;
        float acc[NMODV][4];
#pragma unroll
        for (int j = 0; j < NMODV; ++j) { acc[j][0] = 0.f; acc[j][1] = 0.f; acc[j][2] = 0.f; acc[j][3] = 0.f; }
        const float* wm = F.in[I_WMOD] + e0 + 4 * c4;
#pragma unroll 4
        for (int kk = 0; kk < 16; ++kk) { const int k = kq * 16 + kk; const f32x4 w = *(const f32x4*)(wm + (size_t)k * MODW);
#pragma unroll
            for (int j = 0; j < NMODV; ++j) { const float s = ldsf[j * DM + k]; acc[j][0] += s * w[0]; acc[j][1] += s * w[1]; acc[j][2] += s * w[2]; acc[j][3] += s * w[3]; } }
#pragma unroll
        for (int j = 0; j < NMODV; ++j)
#pragma unroll
            for (int i = 0; i < 4; ++i) { float a = acc[j][i]; a += __shfl_xor(a, 8); a += __shfl_xor(a, 16); a += __shfl_xor(a, 32); acc[j][i] = a; }
        float* red = ldsf + NMODV * DM;
        if (lane < 8) {
#pragma unroll
            for (int j = 0; j < NMODV; ++j)
#pragma unroll
                for (int i = 0; i < 4; ++i) red[(wave * NMODV + j) * 32 + 4 * c4 + i] = acc[j][i];
        }
        __syncthreads();
        if (tid < NMODV * 32) { const int j = tid >> 5, col = tid & 31; float s = F.in[I_BMOD][e0 + col];
#pragma unroll
            for (int w = 0; w < 8; ++w) s += red[(w * NMODV + j) * 32 + col];
            ((float*)(F.ws + WS_MODS))[j * MODW + e0 + col] = s; }
        __syncthreads();
    }
    if (v < 256) {
        const int hh = v >> 4, dt = v & 15, d0 = 64 * dt;
        float* At = ldsf;
        float* Bkt = ldsf + 128 * 64;
        const float* wq = F.in[I_PWQ] + hh * 128;
        const float* sk = F.in[I_PSK] + (size_t)hh * 128 * 128;
#pragma unroll
        for (int i = 0; i < 4; ++i) { const int f = tid + 512 * i, d = f & 63, q4 = f >> 6; const f32x4 a = *(const f32x4*)(wq + (size_t)(d0 + d) * 2048 + 4 * q4);
            At[(4 * q4 + 0) * 64 + d] = a[0]; At[(4 * q4 + 1) * 64 + d] = a[1]; At[(4 * q4 + 2) * 64 + d] = a[2]; At[(4 * q4 + 3) * 64 + d] = a[3]; }
#pragma unroll
        for (int i = 0; i < 8; ++i) { const int f = tid + 512 * i, key = f & 127, q4 = f >> 7; const f32x4 b = *(const f32x4*)(sk + (size_t)key * 128 + 4 * q4);
            Bkt[(4 * q4 + 0) * 128 + key] = b[0]; Bkt[(4 * q4 + 1) * 128 + key] = b[1]; Bkt[(4 * q4 + 2) * 128 + key] = b[2]; Bkt[(4 * q4 + 3) * 128 + key] = b[3]; }
        __syncthreads();
        const int dg = tid & 15, kg = tid >> 4;
        float acc[4][4];
#pragma unroll
        for (int i = 0; i < 4; ++i)
#pragma unroll
            for (int j = 0; j < 4; ++j) acc[i][j] = 0.f;
#pragma unroll 4
        for (int q = 0; q < 128; ++q) { const f32x4 a = *(const f32x4*)(At + q * 64 + 4 * dg); const f32x4 b = *(const f32x4*)(Bkt + q * 128 + 4 * kg);
#pragma unroll
            for (int i = 0; i < 4; ++i)
#pragma unroll
                for (int j = 0; j < 4; ++j) acc[i][j] += a[i] * b[j]; }
        bf16* WcT = (bf16*)(F.ws + WS_WC);
#pragma unroll
        for (int j = 0; j < 4; ++j) { v2u o; o.x = pk2(acc[0][j], acc[1][j]); o.y = pk2(acc[2][j], acc[3][j]);
            *(v2u*)(WcT + (size_t)(hh * 128 + 4 * kg + j) * DM + d0 + 4 * dg) = o; }
        __syncthreads();
    }
    const int gw = v * NWAVES + wave, NGW = F.G * NWAVES;
    float* scr = ldsf + wave * 4096;
    {
        constexpr int I_IN = (DM / 64) * (D_IN / 32), I_OUT = (DM / 64) * (DM / 32), I_RG = 32 * 2;
        constexpr int NIT = I_IN + I_OUT + I_RG;
        for (int it = gw; it < NIT; it += NGW) {
            int r = it;
            if (r < I_IN) { p0_transpose_item(F.in[I_WIN], DM, D_IN, (bf16*)(F.ws + WS_WIN), scr, r, lane, MapWin()); continue; } r -= I_IN;
            if (r < I_OUT) { p0_transpose_item(F.in[I_WOUT], DM, DM, (bf16*)(F.ws + WS_WOUT), scr, r, lane, MapId()); continue; } r -= I_OUT;
            { const int mm = r >> 1, sub = r & 1, dir = mm >> 4, n = (mm >> 1) & 7, gate = mm & 1;
              const float* src = (gate ? F.in[I_RGWI] : F.in[I_RGWA]) + (size_t)(dir * 8 + n) * 4096;
              bf16* dst = (bf16*)(F.ws + WS_RGW) + (size_t)((dir * 8 + n) * 2 + gate) * 4096;
              p0_transpose_item(src, 64, 64, dst, scr, sub, lane, MapId(), -LOG2E); }
        }
    }
    quant_rows(F, u_in_p2(F.G) ? 16384 : 0, 2 * 16384, gw, NGW);
    const int gt = v * 512 + tid, NGT = F.G * 512;
    for (int e = gt; e < 8 * 256 * 128; e += NGT) {
        const int c = e & 127, bp = e >> 7, kvh = c >> 6, p = c & 63, old = (p & 1) ? 32 + (p >> 1) : (p >> 1);
        ((bf16*)(F.ws + WS_CK))[e] = (bf16)f2bf(F.in[I_CK][(size_t)bp * 128 + kvh * 64 + old]);
    }
    for (int e = gt; e < 8 * 256 * 128; e += NGT) {
        const int pos = e & 255, d = (e >> 8) & 63, kvh = (e >> 14) & 1, b = e >> 15;
        ((bf16*)(F.ws + WS_CVT))[e] = (bf16)f2bf(F.in[I_CV][(size_t)(b * 256 + pos) * 128 + kvh * 64 + d]);
    }
    for (int e = gt; e < 1024 * 32; e += NGT) {
        const int s = e >> 5, i = e & 31, row = s >> 6, col = s & 63;
        const float inv = powf(10000.0f, -(float)(i & 15) / 16.0f);
        const float ang = (i < 16 ? (float)row : (float)col) * inv;
        f32x2 cs; cs.x = cosf(ang); cs.y = sinf(ang);
        ((f32x2*)(F.ws + WS_ROPE))[e] = cs;
    }
}

__device__ __forceinline__ void bias_items(Frame& F) {
    const int gw = F.vcu * NWAVES + F.wave, NGW = F.G * NWAVES, lane = F.lane;
    const float* mods = (const float*)(F.ws + WS_MODS); const bf16* WcT = (const bf16*)(F.ws + WS_WC); float* BIAS = (float*)(F.ws + WS_BIAS);
    for (int n = gw; n < 2048; n += NGW) {
        const v4u a = *(const v4u*)(WcT + (size_t)n * DM + 16 * lane), b = *(const v4u*)(WcT + (size_t)n * DM + 16 * lane + 8);
        float w[16];
        w[0] = bflo(a.x); w[1] = bfhi(a.x); w[2] = bflo(a.y); w[3] = bfhi(a.y); w[4] = bflo(a.z); w[5] = bfhi(a.z); w[6] = bflo(a.w); w[7] = bfhi(a.w);
        w[8] = bflo(b.x); w[9] = bfhi(b.x); w[10] = bflo(b.y); w[11] = bfhi(b.y); w[12] = bflo(b.z); w[13] = bfhi(b.z); w[14] = bflo(b.w); w[15] = bfhi(b.w);
#pragma unroll 1
        for (int j = 0; j < NMODV; ++j) { const float* sh = mods + (size_t)j * MODW + 3 * DM + 16 * lane; float d = 0.f;
#pragma unroll
            for (int q = 0; q < 4; ++q) { const f32x4 v = *(const f32x4*)(sh + 4 * q); d += v[0] * w[4 * q] + v[1] * w[4 * q + 1] + v[2] * w[4 * q + 2] + v[3] * w[4 * q + 3]; }
            d = wave_sum(d); if (lane == 0) BIAS[j * 2048 + n] = d; }
    }
}
__device__ __forceinline__ void norm_phase(Frame& F, int which) {
    const int gw = F.vcu * NWAVES + F.wave, NGW = F.G * NWAVES, lane = F.lane;
    const float* mods = (const float*)(F.ws + WS_MODS);
    const float* g = F.in[which ? I_GFFN : I_GMIX];
    bf16* H = (bf16*)(F.ws + WS_H);
    for (int tok = gw; tok < NTOK; tok += NGW) {
        const float* xr = which ? F.out + O_Y + (size_t)tok * DM : x_row(F, tok);
        const float* mv = mods + (size_t)mod_index(tok) * MODW + (which ? 3 * DM : 0);
        f32x4 v[4]; float ss = 0.f;
#pragma unroll
        for (int j = 0; j < 4; ++j) { v[j] = *(const f32x4*)(xr + 256 * j + 4 * lane); ss += (v[j][0] * v[j][0] + v[j][1] * v[j][1]) + (v[j][2] * v[j][2] + v[j][3] * v[j][3]); }
        const float rstd = 1.f / sqrtf(wave_sum(ss) * (1.f / DM) + EPS);
#pragma unroll
        for (int j = 0; j < 4; ++j) { const int e = 256 * j + 4 * lane;
            const f32x4 gg = *(const f32x4*)(g + e), sh = *(const f32x4*)(mv + e), sc = *(const f32x4*)(mv + DM + e);
            f32x4 o;
#pragma unroll
            for (int i = 0; i < 4; ++i) o[i] = v[j][i] * rstd * gg[i] * (1.f + sc[i]) + sh[i];
            v2u w; w.x = pk2(o[0], o[1]); w.y = pk2(o[2], o[3]); *(v2u*)(H + (size_t)tok * DM + e) = w; }
    }
}

struct EpiInProj {
    static constexpr bool PERM = true;
    bf16 *q, *k, *vT, *xr, *yg; float *newk, *newv; const f32x4* rope4;
    __device__ __forceinline__ void operator()(const f32x4 (&acc)[2][2][4][2], const pg8::Unit& u, int wr, int wc, int fr, int fq) const {
        const bool lat = u.pm >= 32;
        const int pn = u.pn;
#pragma unroll
        for (int ai = 0; ai < 2; ++ai)
#pragma unroll
            for (int m = 0; m < 4; ++m) {
                const int row = u.pm * 256 + ai * 128 + wr * 64 + m * 16 + fr;
                const int pos = lat ? ((row - NCTX) & 1023) : (row & 255);
#pragma unroll
                for (int bj = 0; bj < 2; ++bj) {
                    const int c = pn * 256 + bj * 128 + wc * 32 + 8 * fq;
                    f32x4 v0 = acc[ai][bj][m][0], v1 = acc[ai][bj][m][1];
                    if (pn < 2 || (pn == 2 && bj == 0)) {
                        const int i = (c & 63) >> 1;
                        if (lat) { const f32x4 cs0 = rope4[(pos * 32 + i) >> 1], cs1 = rope4[((pos * 32 + i) >> 1) + 1];
                            const float a0 = v0[0] * cs0[0] - v0[1] * cs0[1], a1 = v0[1] * cs0[0] + v0[0] * cs0[1];
                            const float b0 = v0[2] * cs0[2] - v0[3] * cs0[3], b1 = v0[3] * cs0[2] + v0[2] * cs0[3];
                            const float c0 = v1[0] * cs1[0] - v1[1] * cs1[1], c1 = v1[1] * cs1[0] + v1[0] * cs1[1];
                            const float d0 = v1[2] * cs1[2] - v1[3] * cs1[3], d1 = v1[3] * cs1[2] + v1[2] * cs1[3];
                            v0[0] = a0; v0[1] = a1; v0[2] = b0; v0[3] = b1; v1[0] = c0; v1[1] = c1; v1[2] = d0; v1[3] = d1; }
                        if (pn < 2) { v4u w; w.x = pk2(v0[0] * QSCALE, v0[1] * QSCALE); w.y = pk2(v0[2] * QSCALE, v0[3] * QSCALE); w.z = pk2(v1[0] * QSCALE, v1[1] * QSCALE); w.w = pk2(v1[2] * QSCALE, v1[3] * QSCALE);
                            *(v4u*)(q + (size_t)row * 512 + c) = w; }
                        else { const int kc = c - 512; v4u w; w.x = pk2(v0[0], v0[1]); w.y = pk2(v0[2], v0[3]); w.z = pk2(v1[0], v1[1]); w.w = pk2(v1[2], v1[3]); *(v4u*)(k + (size_t)row * 128 + kc) = w;
                            if (!lat) { float* nk = newk + (size_t)row * 128 + (kc & 64) + i; f32x4 lo; lo[0] = v0[0]; lo[1] = v0[2]; lo[2] = v1[0]; lo[3] = v1[2]; f32x4 hi; hi[0] = v0[1]; hi[1] = v0[3]; hi[2] = v1[1]; hi[3] = v1[3];
                                *(f32x4*)nk = lo; *(f32x4*)(nk + 32) = hi; } }
                    } else if (pn == 2) {
                        const int vc = c - 640, kvh = vc >> 6, d = vc & 63;
                        if (!lat) { *(f32x4*)(newv + (size_t)row * 128 + vc) = v0; *(f32x4*)(newv + (size_t)row * 128 + vc + 4) = v1; }
                        bf16* vp; int S;
                        if (!lat) { S = SEQ_C; vp = vT + ((size_t)((row >> 8) * 2 + kvh) * 64 + d) * SEQ_C + pos; }
                        else { S = SEQ_L; vp = vT + VT_LAT_OFF + ((size_t)(((row - NCTX) >> 10) * 2 + kvh) * 64 + d) * SEQ_L + pos; }
                        vp[0] = (bf16)f2bf(v0[0]); vp[S] = (bf16)f2bf(v0[1]); vp[2 * S] = (bf16)f2bf(v0[2]); vp[3 * S] = (bf16)f2bf(v0[3]);
                        vp[4 * S] = (bf16)f2bf(v1[0]); vp[5 * S] = (bf16)f2bf(v1[1]); vp[6 * S] = (bf16)f2bf(v1[2]); vp[7 * S] = (bf16)f2bf(v1[3]);
                    } else {
                        v4u w; w.x = pk2(v0[0], v0[1]); w.y = pk2(v0[2], v0[3]); w.z = pk2(v1[0], v1[1]); w.w = pk2(v1[2], v1[3]);
                        if (pn < 5) *(v4u*)(xr + (size_t)row * 512 + (c - 768)) = w; else *(v4u*)(yg + (size_t)row * 512 + (c - 1280)) = w;
                    }
                }
            }
    }
};
struct EpiOutProj {
    static constexpr bool PERM = true;
    const float *xp, *xs, *mods, *gffn; bf16* x1; bf16* ap; float* ssp;
    __device__ __forceinline__ void operator()(const f32x4 (&acc)[2][2][4][2], const pg8::Unit& u, int wr, int wc, int fr, int fq) const {
        const int mi = u.pm < 32 ? 0 : 1 + ((u.pm - 32) >> 2);
        const float* mv = mods + (size_t)mi * MODW;
        const int row0 = u.pm * 256 + wr * 64 + fr;
        const float* xbase = (u.pm < 32 ? xp : xs - (size_t)NCTX * DM) + (size_t)row0 * DM;
        float ssq[2][4];
#pragma unroll
        for (int ai = 0; ai < 2; ++ai)
#pragma unroll
            for (int m = 0; m < 4; ++m) ssq[ai][m] = 0.f;
#pragma unroll
        for (int bj = 0; bj < 2; ++bj) {
            const int c = u.pn * 256 + bj * 128 + wc * 32 + 8 * fq;
            const f32x4 gv0 = *(const f32x4*)(mv + 2 * DM + c), gv1 = *(const f32x4*)(mv + 2 * DM + c + 4);
            const f32x4 g20 = *(const f32x4*)(gffn + c) * (1.f + *(const f32x4*)(mv + 4 * DM + c)), g21 = *(const f32x4*)(gffn + c + 4) * (1.f + *(const f32x4*)(mv + 4 * DM + c + 4));
#pragma unroll
            for (int h4 = 0; h4 < 4; ++h4) {
                const int ai = h4 >> 1;
                f32x4 xv[2][2];
#pragma unroll
                for (int mm = 0; mm < 2; ++mm) { const float* xr = xbase + (size_t)(ai * 128 + (2 * (h4 & 1) + mm) * 16) * DM + c; xv[mm][0] = *(const f32x4*)xr; xv[mm][1] = *(const f32x4*)(xr + 4); }
                asm volatile("" ::: "memory");
#pragma unroll
                for (int mm = 0; mm < 2; ++mm) {
                    const int m = 2 * (h4 & 1) + mm;
                    const size_t off = (size_t)(row0 + ai * 128 + m * 16) * DM + c;
                    const f32x4 o0 = xv[mm][0] + gv0 * acc[ai][bj][m][0], o1 = xv[mm][1] + gv1 * acc[ai][bj][m][1];
                    { v4u xw; xw.x = pk2(o0[0], o0[1]); xw.y = pk2(o0[2], o0[3]); xw.z = pk2(o1[0], o1[1]); xw.w = pk2(o1[2], o1[3]); *(v4u*)(x1 + off) = xw; }
                    ssq[ai][m] += ((o0[0] * o0[0] + o0[1] * o0[1]) + (o0[2] * o0[2] + o0[3] * o0[3])) + ((o1[0] * o1[0] + o1[1] * o1[1]) + (o1[2] * o1[2] + o1[3] * o1[3]));
                    const f32x4 t0 = o0 * g20, t1 = o1 * g21; v4u w; w.x = pk2(t0[0], t0[1]); w.y = pk2(t0[2], t0[3]); w.z = pk2(t1[0], t1[1]); w.w = pk2(t1[2], t1[3]);
                    *(v4u*)(ap + off) = w;
                }
                asm volatile("" ::: "memory");
            }
        }
#pragma unroll
        for (int ai = 0; ai < 2; ++ai)
#pragma unroll
            for (int m = 0; m < 4; ++m) { float v = ssq[ai][m]; v += __shfl_xor(v, 16); v += __shfl_xor(v, 32);
                if (fq == 0) ssp[(size_t)(row0 + ai * 128 + m * 16) * 16 + u.pn * 4 + wc] = v; }
    }
};
struct EpiScores {
    static constexpr bool PERM = true;
    bf16* sc; const float* ssp; const float* bias;
    __device__ __forceinline__ void operator()(const f32x4 (&acc)[2][2][4][2], const pg8::Unit& u, int wr, int wc, int fr, int fq) const {
        const int mi = u.pm < 32 ? 0 : 1 + ((u.pm - 32) >> 2);
        const int row0 = u.pm * 256 + wr * 64 + fr;
        f32x4 b0[2], b1[2];
#pragma unroll
        for (int bj = 0; bj < 2; ++bj) { const int c = u.pn * 256 + bj * 128 + wc * 32 + 8 * fq; b0[bj] = *(const f32x4*)(bias + (size_t)mi * 2048 + c); b1[bj] = *(const f32x4*)(bias + (size_t)mi * 2048 + c + 4); }
#pragma unroll
        for (int h2 = 0; h2 < 4; ++h2) {
            const int ai = h2 >> 1;
            f32x4 sp[2][4];
#pragma unroll
            for (int mm = 0; mm < 2; ++mm)
#pragma unroll
                for (int q = 0; q < 4; ++q) sp[mm][q] = *((const f32x4*)(ssp + (size_t)(row0 + ai * 128 + (2 * (h2 & 1) + mm) * 16) * 16) + q);
            asm volatile("" ::: "memory");
#pragma unroll
            for (int mm = 0; mm < 2; ++mm) {
                const int m = 2 * (h2 & 1) + mm;
                const int row = row0 + ai * 128 + m * 16;
                const float ss = ((sp[mm][0][0] + sp[mm][0][1]) + (sp[mm][0][2] + sp[mm][0][3])) + ((sp[mm][1][0] + sp[mm][1][1]) + (sp[mm][1][2] + sp[mm][1][3]))
                               + ((sp[mm][2][0] + sp[mm][2][1]) + (sp[mm][2][2] + sp[mm][2][3])) + ((sp[mm][3][0] + sp[mm][3][1]) + (sp[mm][3][2] + sp[mm][3][3]));
                const float rstd = 1.f / sqrtf(ss * (1.f / DM) + EPS);
#pragma unroll
                for (int bj = 0; bj < 2; ++bj) {
                    const int c = u.pn * 256 + bj * 128 + wc * 32 + 8 * fq;
                    const f32x4 v0 = acc[ai][bj][m][0] * rstd + b0[bj], v1 = acc[ai][bj][m][1] * rstd + b1[bj];
                    v4u w; w.x = pk2(v0[0], v0[1]); w.y = pk2(v0[2], v0[3]); w.z = pk2(v1[0], v1[1]); w.w = pk2(v1[2], v1[3]);
                    *(v4u*)(sc + (size_t)row * 2048 + c) = w;
                }
            }
            asm volatile("" ::: "memory");
        }
    }
};

__device__ __forceinline__ void attn_unit(Frame& F, bool lat, int seq, int kvh, int qt) {
    const int tid = F.tid, lane = F.lane, wave = F.wave, r32 = lane & 31, hi = lane >> 5;
    const int g = wave >> 1, qs = wave & 1, head = kvh * 4 + g;
    const int S = lat ? SEQ_L : SEQ_C, tokbase = lat ? NCTX + seq * SEQ_L : seq * SEQ_C;
    const int q0 = qt * 64, qpos = q0 + 32 * qs + r32;
    const bf16* Q = (const bf16*)(F.ws + WS_Q); const bf16* Kb = (const bf16*)(F.ws + WS_K); const bf16* VT = (const bf16*)(F.ws + WS_VT);
    const bf16* CK = (const bf16*)(F.ws + WS_CK); const bf16* CVT = (const bf16*)(F.ws + WS_CVT);
    unsigned char* ldsK = F.lds; unsigned char* ldsV = F.lds + 8192;
    bf16x8 qf[4];
    { const bf16* qp = Q + (size_t)(tokbase + qpos) * 512 + head * 64;
#pragma unroll
      for (int ks = 0; ks < 4; ++ks) qf[ks] = *(const bf16x8*)(qp + 16 * ks + 8 * hi); }
    const float sinkl = F.in[I_SINK][head] * LOG2E;
    float mrun = sinkl, lrun = (hi == 0) ? 1.f : 0.f;
    f32x16 o0, o1;
#pragma unroll
    for (int r = 0; r < 16; ++r) { o0[r] = 0.f; o1[r] = 0.f; }
    int tlo, thi;
    if (lat) { tlo = (q0 >= 128 ? q0 - 128 : 0) >> 6; thi = ((q0 + 192 < S ? q0 + 192 : S)) >> 6; } else { tlo = 0; thi = 4; }
    const int nband = thi - tlo, ntile = nband + (lat ? 4 : 0);
    const int key_t = tid >> 3, ch_t = tid & 7;
    v4u kv, vv;
#define AT_LOAD(t_) do { const int tt_ = (t_); const bf16* kptr; const bf16* vptr; int vstride; \
        if (tt_ < nband) { const int kb_ = (tlo + tt_) * 64; kptr = Kb + (size_t)(tokbase + kb_) * 128 + kvh * 64; \
            vptr = VT + (lat ? (size_t)VT_LAT_OFF + (size_t)((seq * 2 + kvh) * 64) * SEQ_L : (size_t)((seq * 2 + kvh) * 64) * SEQ_C) + kb_; vstride = S; } \
        else { const int tc = tt_ - nband; kptr = CK + (size_t)(seq * 256 + tc * 64) * 128 + kvh * 64; vptr = CVT + (size_t)((seq * 2 + kvh) * 64) * 256 + tc * 64; vstride = 256; } \
        kv = *(const v4u*)(kptr + (size_t)key_t * 128 + ch_t * 8); vv = *(const v4u*)(vptr + (size_t)key_t * vstride + ch_t * 8); } while (0)
    AT_LOAD(0);
    for (int t = 0; t < ntile; ++t) {
        const bool band = t < nband;
        const int kbase = band ? (tlo + t) * 64 : 0;
        __syncthreads();
        *(v4u*)(ldsK + key_t * 128 + ((ch_t ^ (key_t & 7)) * 16)) = kv;
        *(v4u*)(ldsV + key_t * 128 + ((ch_t ^ (key_t & 7)) * 16)) = vv;
        __syncthreads();
        f32x16 p0, p1;
#pragma unroll
        for (int r = 0; r < 16; ++r) { p0[r] = 0.f; p1[r] = 0.f; }
#pragma unroll
        for (int ks = 0; ks < 4; ++ks) {
            const int sw = ((2 * ks + hi) ^ (r32 & 7)) * 16;
            const bf16x8 a0 = *(const bf16x8*)(ldsK + r32 * 128 + sw);
            const bf16x8 a1 = *(const bf16x8*)(ldsK + (32 + r32) * 128 + sw);
            p0 = __builtin_amdgcn_mfma_f32_32x32x16_bf16(a0, qf[ks], p0, 0, 0, 0);
            p1 = __builtin_amdgcn_mfma_f32_32x32x16_bf16(a1, qf[ks], p1, 0, 0, 0);
        }
        if (t + 1 < ntile) AT_LOAD(t + 1);
        if (band && lat && (kbase < q0 + 63 - 128 || kbase + 63 > q0 + 128)) {
#pragma unroll
            for (int r = 0; r < 16; ++r) { const int kp = kbase + crow(r, hi); int d0 = qpos - kp; d0 = d0 < 0 ? -d0 : d0; int d1 = qpos - kp - 32; d1 = d1 < 0 ? -d1 : d1;
                if (d0 > 128) p0[r] = -INFINITY; if (d1 > 128) p1[r] = -INFINITY; }
        }
        float tm = p0[0];
#pragma unroll
        for (int r = 1; r < 16; ++r) tm = fmaxf(tm, p0[r]);
#pragma unroll
        for (int r = 0; r < 16; ++r) tm = fmaxf(tm, p1[r]);
        tm = fmaxf(tm, __shfl_xor(tm, 32));
        const float mn = fmaxf(mrun, tm), alpha = __builtin_amdgcn_exp2f(mrun - mn); mrun = mn;
        float ls = 0.f;
#pragma unroll
        for (int r = 0; r < 16; ++r) { p0[r] = __builtin_amdgcn_exp2f(p0[r] - mn); p1[r] = __builtin_amdgcn_exp2f(p1[r] - mn); ls += p0[r] + p1[r]; o0[r] *= alpha; o1[r] *= alpha; }
        lrun = lrun * alpha + ls;
        bf16x8 pf[4];
#pragma unroll
        for (int s = 0; s < 2; ++s) {
            v4u w0, w1;
            w0.x = pk2(p0[8 * s + 0], p0[8 * s + 1]); w0.y = pk2(p0[8 * s + 2], p0[8 * s + 3]); w0.z = pk2(p0[8 * s + 4], p0[8 * s + 5]); w0.w = pk2(p0[8 * s + 6], p0[8 * s + 7]);
            w1.x = pk2(p1[8 * s + 0], p1[8 * s + 1]); w1.y = pk2(p1[8 * s + 2], p1[8 * s + 3]); w1.z = pk2(p1[8 * s + 4], p1[8 * s + 5]); w1.w = pk2(p1[8 * s + 6], p1[8 * s + 7]);
            pf[s] = __builtin_bit_cast(bf16x8, w0); pf[2 + s] = __builtin_bit_cast(bf16x8, w1);
        }
#pragma unroll
        for (int s4 = 0; s4 < 4; ++s4) {
#pragma unroll
            for (int dt = 0; dt < 2; ++dt) {
                const int d = 32 * dt + r32;
                const v2u lo = *(const v2u*)(ldsV + d * 128 + (((2 * s4) ^ (d & 7)) * 16) + 8 * hi);
                const v2u hi2 = *(const v2u*)(ldsV + d * 128 + (((2 * s4 + 1) ^ (d & 7)) * 16) + 8 * hi);
                v4u vf4; vf4.x = lo.x; vf4.y = lo.y; vf4.z = hi2.x; vf4.w = hi2.y;
                const bf16x8 vf = __builtin_bit_cast(bf16x8, vf4);
                if (dt == 0) o0 = __builtin_amdgcn_mfma_f32_32x32x16_bf16(vf, pf[s4], o0, 0, 0, 0);
                else o1 = __builtin_amdgcn_mfma_f32_32x32x16_bf16(vf, pf[s4], o1, 0, 0, 0);
            }
        }
    }
    const float ltot = lrun + __shfl_xor(lrun, 32), inv = 1.f / ltot;
    bf16* mix = (bf16*)(F.ws + WS_MIX) + (size_t)(tokbase + qpos) * DM + head * 64;
#pragma unroll
    for (int g4 = 0; g4 < 4; ++g4) {
        v2u w; w.x = pk2(o0[4 * g4] * inv, o0[4 * g4 + 1] * inv); w.y = pk2(o0[4 * g4 + 2] * inv, o0[4 * g4 + 3] * inv);
        *(v2u*)(mix + 8 * g4 + 4 * hi) = w;
        v2u w2; w2.x = pk2(o1[4 * g4] * inv, o1[4 * g4 + 1] * inv); w2.y = pk2(o1[4 * g4 + 2] * inv, o1[4 * g4 + 3] * inv);
        *(v2u*)(mix + 32 + 8 * g4 + 4 * hi) = w2;
    }
    __syncthreads();
}

constexpr int RL_HALF = 49152;
constexpr int RL_XCB = 32768;
constexpr int RL_AGG = 98304;
constexpr int RL_CARRY = RL_AGG + 8192;
constexpr int RL_CW = RL_CARRY + 512;
constexpr int RL_WG = RL_CW + 1280;
static_assert(RL_WG + 32768 <= LDSCTL_OFF, "RNN LDS map");
__device__ __forceinline__ float fsigmoid(float x) { return __builtin_amdgcn_rcpf(1.f + __expf(-x)); }
__device__ __forceinline__ float gelu_fast(float x) { const float y = 0.7978845608028654f * (x + 0.044715f * x * x * x); const float e = __expf(2.f * y); return x - x * __builtin_amdgcn_rcpf(1.f + e); }

template <bool REV>
__device__ __forceinline__ void scan_prep(const float (&a)[16], const float (&b)[16], int h, float (&Apre)[4], float (&Bpre)[4], float& At, float& Bt) {
    float Ao[4], Bo[4], Ap[4], Bp[4];
#pragma unroll
    for (int g = 0; g < 4; ++g) { float A = 1.f, B = 0.f;
#pragma unroll
        for (int ii = 0; ii < 4; ++ii) { const int r = 4 * g + (REV ? 3 - ii : ii); B = a[r] * B + b[r]; A = a[r] * A; }
        Ao[g] = A; Bo[g] = B; }
#pragma unroll
    for (int g = 0; g < 4; ++g) { Ap[g] = __shfl_xor(Ao[g], 32); Bp[g] = __shfl_xor(Bo[g], 32); }
    const bool ownfirst = REV ? (h == 1) : (h == 0);
    float Ac = 1.f, Bc = 0.f;
#pragma unroll
    for (int gi = 0; gi < 4; ++gi) { const int g = REV ? 3 - gi : gi;
        const float A1 = ownfirst ? Ao[g] : Ap[g], B1 = ownfirst ? Bo[g] : Bp[g], A2 = ownfirst ? Ap[g] : Ao[g], B2 = ownfirst ? Bp[g] : Bo[g];
        const float Ac1 = A1 * Ac, Bc1 = A1 * Bc + B1;
        Apre[g] = ownfirst ? Ac : Ac1; Bpre[g] = ownfirst ? Bc : Bc1;
        Ac = A2 * Ac1; Bc = A2 * Bc1 + B2; }
    At = Ac; Bt = Bc;
}
template <bool REV>
__device__ __forceinline__ void scan_finish(const float (&a)[16], const float (&b)[16], const float (&Apre)[4], const float (&Bpre)[4], float hin, float* hp, int hi) {
#pragma unroll
    for (int g = 0; g < 4; ++g) { float hc = Apre[g] * hin + Bpre[g];
#pragma unroll
        for (int ii = 0; ii < 4; ++ii) { const int r = 4 * g + (REV ? 3 - ii : ii); hc = a[r] * hc + b[r]; hp[(size_t)crow(r, hi) * 512] = hc; } }
}

template <bool REV>
__device__ __forceinline__ void rnn_dir(Frame& F, bool lat, int seq, int n) {
    const int lane = F.lane, w4 = F.wave & 3, r32 = lane & 31, hi = lane >> 5, dirh = REV ? 1 : 0;
    const int S = lat ? SEQ_L : SEQ_C, tokbase = lat ? NCTX + seq * SEQ_L : seq * SEQ_C, nchunk = S / 128;
    unsigned char* hb = F.lds + dirh * RL_HALF;
    float* XC32 = (float*)hb; unsigned char* XCB = hb + RL_XCB;
    f32x2* AGG = (f32x2*)(F.lds + RL_AGG) + dirh * 256; float* CARRY = (float*)(F.lds + RL_CARRY) + dirh * 64; const float* CW = (const float*)(F.lds + RL_CW);
    const unsigned char* WG = F.lds + RL_WG + dirh * 16384;
    const bf16* XR = (const bf16*)(F.ws + WS_XR) + (size_t)tokbase * 512 + n * 64;
    float* HX = (float*)(F.ws + (REV ? WS_H : WS_HF)) + (size_t)tokbase * 512 + n * 64;
    const int t = F.tid & 255, c8 = t & 7, tg = t >> 3;
    float ba[2], bi[2], sp8[2];
#pragma unroll
    for (int chh = 0; chh < 2; ++chh) { const int pe = dirh * 512 + n * 64 + chh * 32 + r32; ba[chh] = -LOG2E * F.in[I_RGBA][pe]; bi[chh] = -LOG2E * F.in[I_RGBI][pe];
        const float nl = -F.in[I_RGLAM][pe]; sp8[chh] = -8.f * LOG2E * (nl > 20.f ? nl : log1pf(__expf(nl))); }
    v4u xin[7];
#define RL_XLOAD(c0_) do { _Pragma("unroll") for (int i = 0; i < 7; ++i) { const int pos = (c0_) + 4 * tg - 2 + i; \
        xin[i] = (pos >= 0 && pos < S) ? *(const v4u*)(XR + (size_t)pos * 512 + 8 * c8) : (v4u){0u, 0u, 0u, 0u}; } } while (0)
    RL_XLOAD((REV ? nchunk - 1 : 0) * 128);
    float newcarry[2] = {0.f, 0.f};
    const bool last_tile = REV ? (w4 == 0) : (w4 == 3);
#pragma unroll 1
    for (int k = 0; k < nchunk; ++k) {
        const int c0 = (REV ? nchunk - 1 - k : k) * 128;
        {
            const f32x4 b0 = *(const f32x4*)(CW + 256 + 8 * c8), b1 = *(const f32x4*)(CW + 256 + 8 * c8 + 4);
            f32x4 wt0[4], wt1[4];
#pragma unroll
            for (int tap = 0; tap < 4; ++tap) { wt0[tap] = *(const f32x4*)(CW + tap * 64 + 8 * c8); wt1[tap] = *(const f32x4*)(CW + tap * 64 + 8 * c8 + 4); }
#pragma unroll
            for (int i = 0; i < 4; ++i) {
                f32x4 y0 = b0, y1 = b1;
#pragma unroll
                for (int tap = 0; tap < 4; ++tap) { const v4u x = xin[i + tap];
                    y0[0] += wt0[tap][0] * bflo(x.x); y0[1] += wt0[tap][1] * bfhi(x.x); y0[2] += wt0[tap][2] * bflo(x.y); y0[3] += wt0[tap][3] * bfhi(x.y);
                    y1[0] += wt1[tap][0] * bflo(x.z); y1[1] += wt1[tap][1] * bfhi(x.z); y1[2] += wt1[tap][2] * bflo(x.w); y1[3] += wt1[tap][3] * bfhi(x.w); }
                const int tk = 4 * tg + i;
                *(f32x4*)(XC32 + tk * 64 + 8 * c8) = y0; *(f32x4*)(XC32 + tk * 64 + 8 * c8 + 4) = y1;
                v4u w; w.x = pk2(y0[0], y0[1]); w.y = pk2(y0[2], y0[3]); w.z = pk2(y1[0], y1[1]); w.w = pk2(y1[2], y1[3]);
                *(v4u*)(XCB + tk * 128 + ((c8 ^ (tk & 7)) * 16)) = w; }
        }
        if (k + 1 < nchunk) RL_XLOAD((REV ? nchunk - 2 - k : k + 1) * 128);
        __syncthreads();
        if (k > 0 && last_tile && hi == 0) { CARRY[r32] = newcarry[0]; CARRY[32 + r32] = newcarry[1]; }
        const int tkA = 32 * w4 + r32;
#pragma unroll
        for (int chh = 0; chh < 2; ++chh) {
            const int che = chh * 32 + r32;
            float av[16], bv[16], Apre[4], Bpre[4];
            {
                f32x16 ga, gi;
#pragma unroll
                for (int r = 0; r < 16; ++r) { ga[r] = 0.f; gi[r] = 0.f; }
#pragma unroll
                for (int ks = 0; ks < 4; ++ks) {
                    const bf16x8 af = *(const bf16x8*)(XCB + tkA * 128 + (((2 * ks + hi) ^ (tkA & 7)) * 16));
                    const bf16x8 wa = *(const bf16x8*)(WG + che * 128 + (((2 * ks + hi) ^ (che & 7)) * 16));
                    const bf16x8 wi = *(const bf16x8*)(WG + 8192 + che * 128 + (((2 * ks + hi) ^ (che & 7)) * 16));
                    ga = __builtin_amdgcn_mfma_f32_32x32x16_bf16(af, wa, ga, 0, 0, 0);
                    gi = __builtin_amdgcn_mfma_f32_32x32x16_bf16(af, wi, gi, 0, 0, 0);
                }
#pragma unroll
                for (int r = 0; r < 16; ++r) { const int tk2 = 32 * w4 + crow(r, hi); const float x = XC32[tk2 * 64 + che];
                    const float rg = __builtin_amdgcn_rcpf(1.f + __builtin_amdgcn_exp2f(ga[r] + ba[chh])), ig = __builtin_amdgcn_rcpf(1.f + __builtin_amdgcn_exp2f(gi[r] + bi[chh])), a = __builtin_amdgcn_exp2f(rg * sp8[chh]);
                    av[r] = a; bv[r] = __builtin_amdgcn_sqrtf(fmaxf(1.f - a * a, 0.f)) * ig * x;
                    if ((r & 3) == 3) __builtin_amdgcn_sched_barrier(0); }
                float At, Bt;
                scan_prep<REV>(av, bv, hi, Apre, Bpre, At, Bt);
                if (hi == 0) { f32x2 ab; ab.x = At; ab.y = Bt; AGG[chh * 512 + w4 * 64 + che] = ab; }
            }
            __syncthreads();
            {
                float hin = CARRY[che];
                if (!REV) { for (int t2 = 0; t2 < w4; ++t2) { const f32x2 ab = AGG[chh * 512 + t2 * 64 + che]; hin = ab.x * hin + ab.y; } }
                else { for (int t2 = 3; t2 > w4; --t2) { const f32x2 ab = AGG[chh * 512 + t2 * 64 + che]; hin = ab.x * hin + ab.y; } }
                scan_finish<REV>(av, bv, Apre, Bpre, hin, HX + (size_t)(c0 + 32 * w4) * 512 + che, hi);
                if (last_tile) { const f32x2 ab = AGG[chh * 512 + w4 * 64 + che]; newcarry[chh] = ab.x * hin + ab.y; }
            }
        }
    }
#undef RL_XLOAD
    if (!lat && last_tile && hi == 0) { float* o = F.out + O_NEWRNN + (size_t)(seq * 2 + dirh) * 512 + n * 64; o[r32] = newcarry[0]; o[32 + r32] = newcarry[1]; }
}

__device__ __forceinline__ void rnn_unit(Frame& F, bool lat, int seq, int n) {
    const int tid = F.tid;
    const int S = lat ? SEQ_L : SEQ_C, tokbase = lat ? NCTX + seq * SEQ_L : seq * SEQ_C;
    __syncthreads();
    { float* CW = (float*)(F.lds + RL_CW); float* CARRY = (float*)(F.lds + RL_CARRY);
      if (tid < 320) CW[tid] = tid < 256 ? F.in[I_CONVW][(tid >> 6) * 512 + n * 64 + (tid & 63)] : F.in[I_CONVB][n * 64 + (tid - 256)];
      if (tid < 128) CARRY[tid] = lat ? F.in[I_SRNN][(size_t)(seq * 2 + (tid >> 6)) * 512 + n * 64 + (tid & 63)] : 0.f;
      const bf16* rgw = (const bf16*)(F.ws + WS_RGW);
#pragma unroll
      for (int i = 0; i < 4; ++i) { const int q = tid + 512 * i, ch = q & 7, d = (q >> 3) & 63, gate = (q >> 9) & 1, dir = q >> 10;
          const v4u w = *(const v4u*)(rgw + (size_t)((dir * 8 + n) * 2 + gate) * 4096 + d * 64 + ch * 8);
          *(v4u*)(F.lds + RL_WG + dir * 16384 + gate * 8192 + d * 128 + ((ch ^ (d & 7)) * 16)) = w; } }
    __syncthreads();
    if (F.wave < 4) rnn_dir<false>(F, lat, seq, n); else rnn_dir<true>(F, lat, seq, n);
    __syncthreads();
    { const int c4 = tid & 15, tk = tid >> 4;
      const float* HF = (const float*)(F.ws + WS_HF) + (size_t)tokbase * 512 + n * 64 + 4 * c4;
      const float* HB = (const float*)(F.ws + WS_H) + (size_t)tokbase * 512 + n * 64 + 4 * c4;
      const bf16* YG = (const bf16*)(F.ws + WS_YG) + (size_t)tokbase * 512 + n * 64 + 4 * c4;
      bf16* MIX = (bf16*)(F.ws + WS_MIX) + (size_t)tokbase * DM + 512 + n * 64 + 4 * c4;
      for (int t0 = tk; t0 < S; t0 += 32) {
          const f32x4 a = *(const f32x4*)(HF + (size_t)t0 * 512), b = *(const f32x4*)(HB + (size_t)t0 * 512); const v2u y = *(const v2u*)(YG + (size_t)t0 * 512);
          v2u o; o.x = pk2((a[0] + b[0]) * gelu_fast(bflo(y.x)), (a[1] + b[1]) * gelu_fast(bfhi(y.x))); o.y = pk2((a[2] + b[2]) * gelu_fast(bflo(y.y)), (a[3] + b[3]) * gelu_fast(bfhi(y.y)));
          *(v2u*)(MIX + (size_t)t0 * DM) = o; } }
    __syncthreads();
}

#ifndef MK_P3_TYPES
#define MK_P3_TYPES 15
#endif
__device__ __forceinline__ void p3_phase(Frame& F, int types = 15) {
    const int v = F.vcu;
#pragma unroll 1
    for (int i = 0; i < 832; ++i) {
        int type, idx;
        if (F.G == 256) {
            if (v < 64) { if (i > 0) break; type = 0; idx = v; }
            else { if (i >= 6) break; const int j = v - 64, sl = i >> 1, rep = i & 1; type = 1 + sl;
                const bool extra = sl == 0 ? (j < 64) : (sl == 1 ? (j >= 64 && j < 128) : (j >= 128));
                if (rep && !extra) continue; idx = rep ? 192 + (j - 64 * sl) : j; }
        } else { const int it = v + i * F.G; if (it >= 832) break;
            if (it < 64) { type = 0; idx = it; } else if (it < 320) { type = 1; idx = it - 64; } else if (it < 576) { type = 2; idx = it - 320; } else { type = 3; idx = it - 576; } }
        if (!((types >> type) & 1)) continue;
        const bool lat = type < 2;
        Frame L = F; asm volatile("" : "+v"(L.tid)); L.lane = L.tid & 63;
        asm volatile("" : "+s"(L.ws), "+s"(L.out));
        if ((type & 1) == 0) rnn_unit(L, lat, idx >> 3, idx & 7);
        else { if (lat) attn_unit(L, true, idx >> 5, (idx >> 4) & 1, idx & 15); else attn_unit(L, false, idx >> 3, (idx >> 2) & 1, idx & 3); }
    }
}

__device__ __forceinline__ unsigned key16(unsigned b, unsigned idx) { const unsigned s = (b & 0x8000u) ? (~b & 0xffffu) : (b | 0x8000u); return (s << 16) | idx; }
__device__ __forceinline__ float keyval16(unsigned k) { const unsigned s = k >> 16; const unsigned b = (s & 0x8000u) ? (s & 0x7fffu) : (~s & 0xffffu); return bf2f(b); }
__device__ __forceinline__ unsigned sortable32(float f) { const unsigned u = __builtin_bit_cast(unsigned, f); return (u & 0x80000000u) ? ~u : (u | 0x80000000u); }
template <int CTRL> __device__ __forceinline__ unsigned dppu(unsigned v) { return (unsigned)__builtin_amdgcn_update_dpp(0, (int)v, CTRL, 0xf, 0xf, true); }
template <int CTRL> __device__ __forceinline__ float dppf(float v) { return __builtin_bit_cast(float, __builtin_amdgcn_update_dpp(0, __builtin_bit_cast(int, v), CTRL, 0xf, 0xf, true)); }
__device__ __forceinline__ unsigned umax_(unsigned a, unsigned b) { return a > b ? a : b; }
__device__ __forceinline__ unsigned umin_(unsigned a, unsigned b) { return a < b ? a : b; }
__device__ __forceinline__ unsigned rowmax16u(unsigned x) { x = umax_(x, dppu<0xB1>(x)); x = umax_(x, dppu<0x4E>(x)); x = umax_(x, dppu<0x141>(x)); x = umax_(x, dppu<0x140>(x)); return x; }
__device__ __forceinline__ float rowmax16f(float x) { x = fmaxf(x, dppf<0xB1>(x)); x = fmaxf(x, dppf<0x4E>(x)); x = fmaxf(x, dppf<0x141>(x)); x = fmaxf(x, dppf<0x140>(x)); return x; }
__device__ __forceinline__ float rowsum16f(float x) { x += dppf<0xB1>(x); x += dppf<0x4E>(x); x += dppf<0x141>(x); x += dppf<0x140>(x); return x; }
__device__ __forceinline__ int rowsum16i(int x) { x += (int)dppu<0xB1>((unsigned)x); x += (int)dppu<0x4E>((unsigned)x); x += (int)dppu<0x141>((unsigned)x); x += (int)dppu<0x140>((unsigned)x); return x; }
#define CEX(a, b) do { const unsigned _h = umax_(a, b), _l = umin_(a, b); a = _h; b = _l; } while (0)

#ifndef P7_NCH
#define P7_NCH 8
#endif
constexpr int P7_CSH = (P7_NCH == 4 ? 12 : (P7_NCH == 8 ? 11 : (P7_NCH == 16 ? 10 : 9)));
constexpr int P7_WL = 16384;
constexpr int P7_TL = 0, P7_TE = 1024, P7_TG = 3072, P7_LE = 5120, P7_LG = 7168, P7_LSU = 9216, P7_LQ = 11264, P7_H2Q = 12160, P7_HST = 16256;
static_assert(P7_LQ + 512 <= P7_H2Q && (P7_H2Q % 16) == 0 && P7_HST + 16 <= P7_WL && P7_WL * 8 <= RING_BYTES, "P7 LDS map");

__device__ __forceinline__ float tkval(unsigned k) { return __builtin_bit_cast(float, k & 0xffff0000u); }
#define TKX(a, b) do { unsigned hi_, lo_; asm("v_max_f32 %0, %1, %2" : "=v"(hi_) : "v"(a), "v"(b)); asm("v_min_f32 %0, %1, %2" : "=v"(lo_) : "v"(a), "v"(b)); a = hi_; b = lo_; } while (0)
#define TK_SORT16(c) do { TKX(c[0], c[1]); TKX(c[2], c[3]); TKX(c[0], c[2]); TKX(c[1], c[3]); TKX(c[1], c[2]); TKX(c[4], c[5]); TKX(c[6], c[7]); TKX(c[4], c[6]); TKX(c[5], c[7]); TKX(c[5], c[6]); TKX(c[0], c[4]); TKX(c[2], c[6]); TKX(c[2], c[4]); TKX(c[1], c[5]); TKX(c[3], c[7]); TKX(c[3], c[5]); TKX(c[1], c[2]); TKX(c[3], c[4]); TKX(c[5], c[6]); TKX(c[8], c[9]); TKX(c[10], c[11]); TKX(c[8], c[10]); TKX(c[9], c[11]); TKX(c[9], c[10]); TKX(c[12], c[13]); TKX(c[14], c[15]); TKX(c[12], c[14]); TKX(c[13], c[15]); TKX(c[13], c[14]); TKX(c[8], c[12]); TKX(c[10], c[14]); TKX(c[10], c[12]); TKX(c[9], c[13]); TKX(c[11], c[15]); TKX(c[11], c[13]); TKX(c[9], c[10]); TKX(c[11], c[12]); TKX(c[13], c[14]); TKX(c[0], c[8]); TKX(c[4], c[12]); TKX(c[4], c[8]); TKX(c[2], c[10]); TKX(c[6], c[14]); TKX(c[6], c[10]); TKX(c[2], c[4]); TKX(c[6], c[8]); TKX(c[10], c[12]); TKX(c[1], c[9]); TKX(c[5], c[13]); TKX(c[5], c[9]); TKX(c[3], c[11]); TKX(c[7], c[15]); TKX(c[7], c[11]); TKX(c[3], c[5]); TKX(c[7], c[9]); TKX(c[11], c[13]); TKX(c[1], c[2]); TKX(c[3], c[4]); TKX(c[5], c[6]); TKX(c[7], c[8]); TKX(c[9], c[10]); TKX(c[11], c[12]); TKX(c[13], c[14]); } while (0)
#define TK_BITONIC16(c) do { TKX(c[0], c[8]); TKX(c[1], c[9]); TKX(c[2], c[10]); TKX(c[3], c[11]); TKX(c[4], c[12]); TKX(c[5], c[13]); TKX(c[6], c[14]); TKX(c[7], c[15]); TKX(c[0], c[4]); TKX(c[1], c[5]); TKX(c[2], c[6]); TKX(c[3], c[7]); TKX(c[8], c[12]); TKX(c[9], c[13]); TKX(c[10], c[14]); TKX(c[11], c[15]); TKX(c[0], c[2]); TKX(c[1], c[3]); TKX(c[4], c[6]); TKX(c[5], c[7]); TKX(c[8], c[10]); TKX(c[9], c[11]); TKX(c[12], c[14]); TKX(c[13], c[15]); TKX(c[0], c[1]); TKX(c[2], c[3]); TKX(c[4], c[5]); TKX(c[6], c[7]); TKX(c[8], c[9]); TKX(c[10], c[11]); TKX(c[12], c[13]); TKX(c[14], c[15]); } while (0)
__device__ __forceinline__ void topk_stage1(const bf16* SC, int tok0, int lane, unsigned* TL4) {
    const v4u* src = (const v4u*)(SC + (size_t)(tok0 + (lane >> 4)) * 2048 + (lane & 15) * 128);
    unsigned T[16];
#pragma unroll
    for (int ch = 0; ch < 8; ++ch) {
        const v4u r0 = src[2 * ch], r1 = src[2 * ch + 1];
        unsigned c[16];
#pragma unroll
        for (int m = 0; m < 4; ++m) { c[2 * m] = (r0[m] << 16) | (unsigned)(16 * ch + 2 * m); c[2 * m + 1] = (r0[m] & 0xffff0000u) | (unsigned)(16 * ch + 2 * m + 1);
                                      c[8 + 2 * m] = (r1[m] << 16) | (unsigned)(16 * ch + 8 + 2 * m); c[8 + 2 * m + 1] = (r1[m] & 0xffff0000u) | (unsigned)(16 * ch + 8 + 2 * m + 1); }
        TK_SORT16(c);
        if (ch == 0) {
#pragma unroll
            for (int i = 0; i < 16; ++i) T[i] = c[i];
        } else {
#pragma unroll
            for (int i = 0; i < 16; ++i) { unsigned m_; asm("v_max_f32 %0, %1, %2" : "=v"(m_) : "v"(T[i]), "v"(c[15 - i])); T[i] = m_; }
            TK_BITONIC16(T);
        }
    }
    v4u* dst = (v4u*)(TL4 + lane * 16);
#pragma unroll
    for (int q = 0; q < 4; ++q) { v4u o; o.x = T[4 * q]; o.y = T[4 * q + 1]; o.z = T[4 * q + 2]; o.w = T[4 * q + 3]; dst[q] = o; }
}
__device__ __forceinline__ void topk_stage2x4(const unsigned* TL4, int lane, int* TE, float* TG) {
    const int x = lane & 1, lh = lane >> 1;
    const unsigned long long xm = __ballot(x != 0);
#define TKSEL(a1, a0) ({ unsigned r_; asm("v_cndmask_b32_e64 %0, %1, %2, %3" : "=v"(r_) : "v"(a0), "v"(a1), "s"(xm)); r_; })
    const unsigned* LA = TL4 + (2 * lh) * 16; const unsigned* LB = LA + 16;
    float av[16], bs[8];
    {
        unsigned ka[16], kb[16];
#pragma unroll
        for (int q = 0; q < 4; ++q) { const v4u a = *(const v4u*)(LA + 4 * q), b = *(const v4u*)(LB + 4 * q);
            ka[4 * q] = a.x; ka[4 * q + 1] = a.y; ka[4 * q + 2] = a.z; ka[4 * q + 3] = a.w; kb[4 * q] = b.x; kb[4 * q + 1] = b.y; kb[4 * q + 2] = b.z; kb[4 * q + 3] = b.w; }
#pragma unroll
        for (int i = 0; i < 16; ++i) av[i] = tkval(ka[i]);
#pragma unroll
        for (int m = 0; m < 8; ++m) bs[m] = tkval(TKSEL(kb[2 * m + 1], kb[2 * m]));
    }
    const unsigned NEGK = 0xff7fff00u;
#define TKC(i, m) ((__builtin_bit_cast(unsigned, av[i] + bs[m]) & 0xffffff00u) | (unsigned)(16 * (i) + 2 * (m)) | (unsigned)x)
    unsigned c[16], d[16];
    c[0] = TKC(0, 0);
    c[1] = TKC(0, 1);
    c[2] = TKC(0, 2);
    c[3] = TKC(0, 3);
    c[4] = TKC(0, 4);
    c[5] = TKC(0, 5);
    c[6] = TKC(0, 6);
    c[7] = TKC(0, 7);
    c[8] = TKC(1, 0);
    c[9] = TKC(1, 1);
    c[10] = TKC(1, 2);
    c[11] = TKC(1, 3);
    c[12] = TKC(2, 0);
    c[13] = TKC(2, 1);
    c[14] = TKSEL(NEGK, TKC(2, 2));
    c[15] = TKC(3, 0);
    d[0] = TKC(3, 1);
    d[1] = TKC(4, 0);
    d[2] = TKSEL(NEGK, TKC(4, 1));
    d[3] = TKC(5, 0);
    d[4] = TKC(6, 0);
    d[5] = TKC(7, 0);
    d[6] = TKSEL(NEGK, TKC(8, 0));
    d[7] = TKSEL(NEGK, TKC(9, 0));
    d[8] = TKSEL(NEGK, TKC(10, 0));
    d[9] = TKSEL(NEGK, TKC(11, 0));
    d[10] = TKSEL(NEGK, TKC(12, 0));
    d[11] = TKSEL(NEGK, TKC(13, 0));
    d[12] = TKSEL(NEGK, TKC(14, 0));
    d[13] = TKSEL(NEGK, TKC(15, 0));
    d[14] = NEGK; d[15] = NEGK;
#undef TKC
    TK_SORT16(c); TK_SORT16(d);
    unsigned T[16], U[16];
#pragma unroll
    for (int i = 0; i < 16; ++i) { unsigned m_; asm("v_max_f32 %0, %1, %2" : "=v"(m_) : "v"(c[i]), "v"(d[15 - i])); T[i] = m_; }
    TK_BITONIC16(T);
#pragma unroll
    for (int i = 0; i < 16; ++i) { const unsigned p_ = dppu<0xB1>(T[15 - i]); unsigned m_; asm("v_max_f32 %0, %1, %2" : "=v"(m_) : "v"(T[i]), "v"(p_)); U[i] = m_; }
    TK_BITONIC16(U);
    const float vmax = __builtin_bit_cast(float, U[0] & 0xffffff00u);
    float ex[8]; unsigned code[8]; float sum = 0.f;
#pragma unroll
    for (int m = 0; m < 8; ++m) { const unsigned k_ = TKSEL(U[8 + m], U[m]); code[m] = k_ & 0xffu; ex[m] = __expf(__builtin_bit_cast(float, k_ & 0xffffff00u) - vmax); sum += ex[m]; }
    sum += dppf<0xB1>(sum);
    const float inv = 1.f / sum;
    int eo[8]; float go[8];
#pragma unroll
    for (int m = 0; m < 8; ++m) { const unsigned ka_ = LA[code[m] >> 4], kb_ = LB[code[m] & 15u]; eo[m] = (int)((ka_ & 127u) * 128u + (kb_ & 127u)); go[m] = ex[m] * inv; }
    int* te = TE + 8 * lane; float* tg = TG + 8 * lane;
    *(v4u*)te = (v4u){(unsigned)eo[0], (unsigned)eo[1], (unsigned)eo[2], (unsigned)eo[3]}; *(v4u*)(te + 4) = (v4u){(unsigned)eo[4], (unsigned)eo[5], (unsigned)eo[6], (unsigned)eo[7]};
    *(f32x4*)tg = (f32x4){go[0], go[1], go[2], go[3]}; *(f32x4*)(tg + 4) = (f32x4){go[4], go[5], go[6], go[7]};
#undef TKSEL
}

__device__ __forceinline__ void gl16x4(v4u (&r)[4], unsigned voff, const unsigned char* b0, const unsigned char* b1, const unsigned char* b2, const unsigned char* b3) {
    asm volatile("s_nop 4\n\tglobal_load_dwordx4 %0, %4, %5\n\tglobal_load_dwordx4 %1, %4, %6\n\tglobal_load_dwordx4 %2, %4, %7\n\tglobal_load_dwordx4 %3, %4, %8"
                 : "=&v"(r[0]), "=&v"(r[1]), "=&v"(r[2]), "=&v"(r[3]) : "v"(voff), "s"(b0), "s"(b1), "s"(b2), "s"(b3) : "memory");
}
#define P7_VMWAIT(N, R) asm volatile("s_waitcnt vmcnt(" #N ")" : "+v"(R[0]), "+v"(R[1]), "+v"(R[2]), "+v"(R[3]) :: "memory")
__device__ __forceinline__ int mbcnt64(unsigned long long m) { return (int)__builtin_amdgcn_mbcnt_hi((unsigned)(m >> 32), __builtin_amdgcn_mbcnt_lo((unsigned)m, 0u)); }
__device__ __forceinline__ int rfl(int v) { return __builtin_amdgcn_readfirstlane(v); }
__device__ __forceinline__ float rflf(float v) { return __builtin_bit_cast(float, __builtin_amdgcn_readfirstlane(__builtin_bit_cast(int, v))); }

__device__ __forceinline__ void p7_phase(Frame& F, bool dry) {
    const int lane0 = hw_lane(), wave = F.wave;
    if (dry && (MK_DRY_SKIP & 16) && wave >= 4) return;
    unsigned char* wl = F.lds + wave * P7_WL;
    int* TE = (int*)(wl + P7_TE); float* TG = (float*)(wl + P7_TG);
    float* LG = (float*)(wl + P7_LG); float* LSU = (float*)(wl + P7_LSU); unsigned char* H2Q = wl + P7_H2Q; float* HST = (float*)(wl + P7_HST);
    const bf16* SC = (const bf16*)(F.ws + WS_SC); const bf16* H2 = (const bf16*)(F.ws + WS_H);
    const unsigned char* U8 = F.ws + WS_U; const unsigned char* V8 = F.ws + WS_V;
    const float* SU = (const float*)(F.ws + WS_SU); const float* SV = (const float*)(F.ws + WS_SV);
    const float* mods = (const float*)(F.ws + WS_MODS); const float* SSP = (const float*)(F.ws + WS_SSP);
    const int ntg = NTOK / (F.G * NWAVES * 4);
#pragma unroll 1
    for (int tg = 0; tg < ntg; ++tg) {
        const int tok0 = (F.vcu * ntg + tg) * (NWAVES * 4) + wave * 4;
        int lane = hw_lane(); asm volatile("" : "+v"(lane));
        {
            unsigned* TL4 = (unsigned*)(wl + P7_LE);
            topk_stage1(SC, tok0, lane, TL4);
            topk_stage2x4(TL4, lane, TE, TG);
            v4u ch0, ch1, nh0, nh1;
#define P7_TLOAD(H0, H1, tk) do { H0 = *(const v4u*)(H2 + (size_t)(tk) * DM + 16 * lane); H1 = *(const v4u*)(H2 + (size_t)(tk) * DM + 16 * lane + 8); } while (0)
            P7_TLOAD(ch0, ch1, tok0);
#pragma unroll 1
            for (int s = 0; s < 4; ++s) {
                if (s < 3) P7_TLOAD(nh0, nh1, tok0 + s + 1);
                const int tokc = tok0 + s;
                const f32x4* spp = (const f32x4*)(SSP + (size_t)tokc * 16); const f32x4 q0 = spp[0], q1 = spp[1], q2 = spp[2], q3 = spp[3];
                const float* shp = mods + (size_t)mod_index(tokc) * MODW + 3 * DM + 16 * lane;
                const f32x4 sh0 = *(const f32x4*)(shp), sh1 = *(const f32x4*)(shp + 4), sh2v = *(const f32x4*)(shp + 8), sh3 = *(const f32x4*)(shp + 12);
                const v4u a = ch0, b = ch1;
                const float ssr = ((q0[0] + q0[1]) + (q0[2] + q0[3])) + ((q1[0] + q1[1]) + (q1[2] + q1[3])) + ((q2[0] + q2[1]) + (q2[2] + q2[3])) + ((q3[0] + q3[1]) + (q3[2] + q3[3]));
                const float rstd = 1.f / sqrtf(ssr * (1.f / DM) + EPS);
                float hv[16];
                hv[0] = bflo(a.x); hv[1] = bfhi(a.x); hv[2] = bflo(a.y); hv[3] = bfhi(a.y); hv[4] = bflo(a.z); hv[5] = bfhi(a.z); hv[6] = bflo(a.w); hv[7] = bfhi(a.w);
                hv[8] = bflo(b.x); hv[9] = bfhi(b.x); hv[10] = bflo(b.y); hv[11] = bfhi(b.y); hv[12] = bflo(b.z); hv[13] = bfhi(b.z); hv[14] = bflo(b.w); hv[15] = bfhi(b.w);
#pragma unroll
                for (int i = 0; i < 4; ++i) { hv[i] = hv[i] * rstd + sh0[i]; hv[4 + i] = hv[4 + i] * rstd + sh1[i]; hv[8 + i] = hv[8 + i] * rstd + sh2v[i]; hv[12 + i] = hv[12 + i] * rstd + sh3[i]; }
                float am = 0.f;
#pragma unroll
                for (int i = 0; i < 16; ++i) am = fmaxf(am, fabsf(hv[i]));
                am = wave_max(am);
                const float inv = am > 0.f ? 119.f / am : 0.f;
                if (lane == 0) HST[s] = am * (1.f / 119.f);
                v4u qv;
#pragma unroll
                for (int j = 0; j < 4; ++j) { unsigned w = 0;
#pragma unroll
                    for (int i = 0; i < 4; ++i) { int q = (int)rintf(hv[4 * j + i] * inv); w |= ((unsigned)q & 0xffu) << (8 * i); }
                    qv[j] = w; }
                *(v4u*)(H2Q + s * 1024 + 16 * lane) = qv;
                ch0 = nh0; ch1 = nh1;
            }
#undef P7_TLOAD
        }
        {
            unsigned* LEO = (unsigned*)(wl + P7_LE);
            int ee0[4], ee1[4]; float gg0[4], gg1[4], us0[4], us1[4], vs0[4], vs1[4];
#pragma unroll
            for (int s = 0; s < 4; ++s) { ee0[s] = TE[s * 128 + lane]; ee1[s] = TE[s * 128 + 64 + lane]; gg0[s] = TG[s * 128 + lane]; gg1[s] = TG[s * 128 + 64 + lane]; }
#pragma unroll
            for (int s = 0; s < 4; ++s) { us0[s] = SU[ee0[s]]; us1[s] = SU[ee1[s]]; vs0[s] = SV[ee0[s]]; vs1[s] = SV[ee1[s]]; }
#pragma unroll
            for (int s = 0; s < 4; ++s) { const int e0 = ee0[s], e1 = ee1[s]; const int c0 = e0 >> P7_CSH, c1 = e1 >> P7_CSH; int base = s * 128;
#pragma unroll
                for (int c = 0; c < P7_NCH; ++c) {
                    const unsigned long long m0 = __ballot(c0 == c), m1 = __ballot(c1 == c);
                    const int n0 = __popcll(m0), n = n0 + __popcll(m1);
                    if (c0 == c) { const int p = base + mbcnt64(m0); LEO[p] = (unsigned)e0 << 9; LG[p] = gg0[s] * vs0[s]; LSU[p] = us0[s]; }
                    if (c1 == c) { const int p = base + n0 + mbcnt64(m1); LEO[p] = (unsigned)e1 << 9; LG[p] = gg1[s] * vs1[s]; LSU[p] = us1[s]; }
                    base += n;
                } }
        }
        typedef __attribute__((address_space(1))) v4u GV4;
        if (!(dry && (MK_DRY_SKIP & 1))) {
            int lane_u = hw_lane(); asm volatile("" : "+v"(lane_u));
            const int su = lane_u >> 4, ju = lane_u & 15; const unsigned j16 = 16u * (unsigned)ju;
            const unsigned* LEOs = (const unsigned*)(wl + P7_LE) + su * 128; float* LGs = LG + su * 128; const float* LSUs = LSU + su * 128;
            const unsigned long long u8i = (unsigned long long)U8;
            unsigned hh[2][4], hl[2][4];
#pragma unroll
            for (int i = 0; i < 2; ++i) { const v4u ha = *(const v4u*)(H2Q + su * 1024 + 512 * i + 32 * ju), hb = *(const v4u*)(H2Q + su * 1024 + 512 * i + 32 * ju + 16);
#pragma unroll
                for (int w = 0; w < 4; ++w) { unsigned lo16[2], hi16[2];
#pragma unroll
                    for (int h = 0; h < 2; ++h) { const unsigned d = (w < 2 ? ha : hb)[2 * (w & 1) + h];
                        const unsigned t = ((d & 0x7f7f7f7fu) + 0x08080808u) ^ (d & 0x80808080u);
                        unsigned l = (t & 0x0f0f0f0fu) ^ 0x08080808u, g = (t >> 4) & 0x0f0f0f0fu;
                        l = (l | (l >> 4)) & 0x00ff00ffu; l = (l | (l >> 8)) & 0xffffu; g = (g | (g >> 4)) & 0x00ff00ffu; g = (g | (g >> 8)) & 0xffffu;
                        lo16[h] = l; hi16[h] = g; }
                    hl[i][w] = lo16[0] | (lo16[1] << 16); hh[i][w] = hi16[0] | (hi16[1] << 16); } }
            const float hs = HST[su];
            const bool b0 = (ju & 1) != 0, b1 = (ju & 2) != 0; const int rr = ju & 3;
            v4u A[4][2], B[4][2], C[4][2], D[4][2];
#define P7_ULOAD(R, t) do { const v4u eo_ = *(const v4u*)(LEOs + 4 * (t)); \
            _Pragma("unroll") for (int r = 0; r < 4; ++r) { unsigned o_ = eo_[r] + j16; asm volatile("" : "+v"(o_)); \
                R[r][0] = *(const GV4*)(u8i + o_); R[r][1] = *(const GV4*)(u8i + o_ + 256); } \
            __builtin_amdgcn_sched_barrier(0); } while (0)
#define P7_SCOMP_U(R, t) do { const float su_ = LSUs[4 * (t) + rr], g_ = LGs[4 * (t) + rr]; int p_[4]; \
                _Pragma("unroll") for (int r = 0; r < 4; ++r) { int ah = 0, al = 0; \
                    _Pragma("unroll") for (int i = 0; i < 2; ++i) { _Pragma("unroll") for (int w = 0; w < 4; ++w) { \
                        ah = __builtin_amdgcn_sdot8((int)hh[i][w], (int)R[r][i][w], ah, false); al = __builtin_amdgcn_sdot8((int)hl[i][w], (int)R[r][i][w], al, false); } } \
                    p_[r] = 16 * ah + al; } \
                const int q01 = (b0 ? p_[1] : p_[0]) + (int)dppu<0xB1>((unsigned)(b0 ? p_[0] : p_[1])); const int q23 = (b0 ? p_[3] : p_[2]) + (int)dppu<0xB1>((unsigned)(b0 ? p_[2] : p_[3])); \
                int q_ = (b1 ? q23 : q01) + (int)dppu<0x4E>((unsigned)(b1 ? q01 : q23)); q_ += (int)dppu<0x128>((unsigned)q_); q_ += (int)dppu<0x124>((unsigned)q_); \
                const float dotf = (float)q_ * (hs * su_); LGs[4 * (t) + rr] = g_ * gelu_fast(dotf); } while (0)
            P7_ULOAD(A, 0); P7_ULOAD(B, 1); P7_ULOAD(C, 2);
#pragma unroll 1
            for (int t = 0; t < 28; t += 4) {
                P7_ULOAD(D, t + 3); P7_SCOMP_U(A, t);
                P7_ULOAD(A, t + 4); P7_SCOMP_U(B, t + 1);
                P7_ULOAD(B, t + 5); P7_SCOMP_U(C, t + 2);
                P7_ULOAD(C, t + 6); P7_SCOMP_U(D, t + 3);
                asm volatile("" ::: "memory");
            }
            P7_ULOAD(D, 31); P7_SCOMP_U(A, 28); P7_SCOMP_U(B, 29); P7_SCOMP_U(C, 30); P7_SCOMP_U(D, 31);
#undef P7_SCOMP_U
#undef P7_ULOAD
        }
        float cscale; int sumq8;
        {
            int lane_q = hw_lane(); asm volatile("" : "+v"(lane_q));
            const int sq = lane_q >> 4, jq = lane_q & 15;
            const float* lg = LG + sq * 128 + 8 * jq; const f32x4 c0 = *(const f32x4*)lg, c1 = *(const f32x4*)(lg + 4);
            float m = fmaxf(fmaxf(fmaxf(fabsf(c0[0]), fabsf(c0[1])), fmaxf(fabsf(c0[2]), fabsf(c0[3]))), fmaxf(fmaxf(fabsf(c1[0]), fabsf(c1[1])), fmaxf(fabsf(c1[2]), fabsf(c1[3]))));
            m = rowmax16f(m);
            cscale = m * (1.f / 127.f); const float iv = m > 0.f ? 127.f / m : 0.f;
            v2u w; w.x = 0u; w.y = 0u;
#pragma unroll
            for (int k = 0; k < 4; ++k) { w.x |= ((unsigned)(int)rintf(c0[k] * iv) & 0xffu) << (8 * k); w.y |= ((unsigned)(int)rintf(c1[k] * iv) & 0xffu) << (8 * k); }
            *(v2u*)(wl + P7_LQ + (sq * 32 + 2 * jq) * 4) = w;
            int sq8 = 0;
#pragma unroll
            for (int k = 0; k < 4; ++k) sq8 += (int)rintf(c0[k] * iv) + (int)rintf(c1[k] * iv);
            sumq8 = 8 * rowsum16i(sq8);
        }
        int acc[64];
#pragma unroll
        for (int i = 0; i < 64; ++i) acc[i] = 0;
        if (!(dry && (MK_DRY_SKIP & 2))) {
            int lane_v = hw_lane(); asm volatile("" : "+v"(lane_v));
            const int sv_ = lane_v >> 4, jv = lane_v & 15; const unsigned j16 = 16u * (unsigned)jv;
            const unsigned* LEOs = (const unsigned*)(wl + P7_LE) + sv_ * 128; const int* LQs = (const int*)(wl + P7_LQ) + sv_ * 32;
            const unsigned long long v8i = (unsigned long long)V8;
            v4u A[4][2], B[4][2], C[4][2];
#define P7_VLOAD(R, t) do { const v4u eo_ = *(const v4u*)(LEOs + 4 * (t)); \
            _Pragma("unroll") for (int r = 0; r < 4; ++r) { unsigned o_ = eo_[r] + j16; asm volatile("" : "+v"(o_)); \
                R[r][0] = *(const GV4*)(v8i + o_); R[r][1] = *(const GV4*)(v8i + o_ + 256); } \
            __builtin_amdgcn_sched_barrier(0); } while (0)
#define P7_SCOMP_V(R, t) do { const int cq_ = LQs[(t)]; \
                _Pragma("unroll") for (int i = 0; i < 2; ++i) { _Pragma("unroll") for (int w = 0; w < 4; ++w) { \
                    const unsigned x_ = __builtin_amdgcn_perm(R[1][i][w], R[0][i][w], 0x05010400u), y_ = __builtin_amdgcn_perm(R[1][i][w], R[0][i][w], 0x07030602u); \
                    const unsigned c_ = __builtin_amdgcn_perm(R[3][i][w], R[2][i][w], 0x05010400u), e_ = __builtin_amdgcn_perm(R[3][i][w], R[2][i][w], 0x07030602u); \
                    unsigned tb_[4]; tb_[0] = __builtin_amdgcn_perm(c_, x_, 0x05040100u); tb_[1] = __builtin_amdgcn_perm(c_, x_, 0x07060302u); tb_[2] = __builtin_amdgcn_perm(e_, y_, 0x05040100u); tb_[3] = __builtin_amdgcn_perm(e_, y_, 0x07060302u); \
                    _Pragma("unroll") for (int b = 0; b < 4; ++b) {     \
                        acc[32 * i + 8 * w + 2 * b]     = __builtin_amdgcn_sdot4((int)(tb_[b] & 0x0f0f0f0fu), cq_, acc[32 * i + 8 * w + 2 * b], false); \
                        acc[32 * i + 8 * w + 2 * b + 1] = __builtin_amdgcn_sdot4((int)tb_[b], cq_, acc[32 * i + 8 * w + 2 * b + 1], false); } } } } while (0)
            P7_VLOAD(A, 0); P7_VLOAD(B, 1);
#pragma unroll 1
            for (int t = 0; t < 30; t += 3) {
                P7_VLOAD(C, t + 2); P7_SCOMP_V(A, t);
                P7_VLOAD(A, t + 3); P7_SCOMP_V(B, t + 1);
                P7_VLOAD(B, t + 4); P7_SCOMP_V(C, t + 2);
                asm volatile("" ::: "memory");
            }
            P7_SCOMP_V(A, 30); P7_SCOMP_V(B, 31);
#undef P7_SCOMP_V
#undef P7_VLOAD
        }
        {
            int lane_f = hw_lane(); asm volatile("" : "+v"(lane_f));
            const int sf = lane_f >> 4, jf = lane_f & 15; const int tok = tok0 + sf;
            const bf16* xrow = (const bf16*)(F.ws + WS_X1) + (size_t)tok * DM + 32 * jf;
            const float* ga2 = mods + (size_t)mod_index(tok0) * MODW + 5 * DM + 32 * jf;
            const float* gf = F.in[I_GFINAL] + 32 * jf;
            float xs[64]; float ss = 0.f;
#pragma unroll
            for (int i = 0; i < 2; ++i) {
#pragma unroll
                for (int hh_ = 0; hh_ < 2; ++hh_) { f32x4 gv[4];
                    const v4u xa = *(const v4u*)(xrow + 512 * i + 16 * hh_), xb = *(const v4u*)(xrow + 512 * i + 16 * hh_ + 8);
#pragma unroll
                    for (int q = 0; q < 4; ++q) gv[q] = *(const f32x4*)(ga2 + 512 * i + 16 * hh_ + 4 * q);
                    float xv[16];
                    xv[0] = bflo(xa.x); xv[1] = bfhi(xa.x); xv[2] = bflo(xa.y); xv[3] = bfhi(xa.y); xv[4] = bflo(xa.z); xv[5] = bfhi(xa.z); xv[6] = bflo(xa.w); xv[7] = bfhi(xa.w);
                    xv[8] = bflo(xb.x); xv[9] = bfhi(xb.x); xv[10] = bflo(xb.y); xv[11] = bfhi(xb.y); xv[12] = bflo(xb.z); xv[13] = bfhi(xb.z); xv[14] = bflo(xb.w); xv[15] = bfhi(xb.w);
#pragma unroll
                    for (int q = 0; q < 4; ++q)
#pragma unroll
                        for (int k = 0; k < 4; ++k) { const int ci = 32 * i + 16 * hh_ + 4 * q + k;
                            const float pv = (k & 1) ? (float)(acc[ci] - acc[ci - 1]) * (cscale * (1.f / 16.f)) : (float)(acc[ci] - sumq8) * cscale;
                            const float t = xv[4 * q + k] + gv[q][k] * pv; xs[ci] = t; ss += t * t; }
                    asm volatile("" ::: "memory"); } }
            const float rstd = 1.f / sqrtf(rowsum16f(ss) * (1.f / DM) + EPS);
#pragma unroll
            for (int i = 0; i < 2; ++i) {
#pragma unroll
                for (int hh_ = 0; hh_ < 2; ++hh_) { f32x4 gfv[4];
#pragma unroll
                    for (int q = 0; q < 4; ++q) gfv[q] = *(const f32x4*)(gf + 512 * i + 16 * hh_ + 4 * q);
#pragma unroll
                    for (int q = 0; q < 4; ++q) { f32x4 o;
#pragma unroll
                        for (int k = 0; k < 4; ++k) o[k] = xs[32 * i + 16 * hh_ + 4 * q + k] * rstd * gfv[q][k];
                        *(f32x4*)(wl + sf * 4096 + 2048 * i + 128 * jf + 16 * ((4 * hh_ + q) ^ (jf & 7))) = o; }
                    asm volatile("" ::: "memory"); } }
            float* ybase = dry ? (float*)(F.ws + WS_MIX) : F.out + O_Y;
#pragma unroll
            for (int m = 0; m < 16; ++m) { const int sr = m >> 2, f = (m & 3) * 64 + lane_f, jr = (f >> 3) & 15;
                const f32x4 o = *(const f32x4*)(wl + sr * 4096 + 2048 * (f >> 7) + 128 * jr + 16 * ((f & 7) ^ (jr & 7)));
                const int tr = tok0 + sr; *(f32x4*)(ybase + (size_t)(dry ? (tr & 8191) : tr) * DM + 4 * f) = o; }
        }
    }
}

__global__ void __launch_bounds__(NWAVES * 64, 2) mk_fwd(Args args) {
    extern __shared__ __attribute__((aligned(16))) unsigned char lds[];
    Frame F;
    F.lds = lds;
    F.tid = threadIdx.x; F.lane = F.tid & 63; F.wave = __builtin_amdgcn_readfirstlane(F.tid >> 6);
    F.G = gridDim.x; { const int bx = blockIdx.x; F.vcu = (F.G % 8 == 0) ? (bx % 8) * (F.G / 8) + bx / 8 : bx; }
    F.in = args.in; F.out = args.out; F.ws = args.ws;
    LAS unsigned char* lds3 = (LAS unsigned char*)lds;
    volatile LAS unsigned* MISC = (volatile LAS unsigned*)(lds3 + MISC_OFF);
    for (int u = F.tid; u < (LDS_BYTES - LDSCTL_OFF) / 4; u += NWAVES * 64) ((LAS unsigned*)(lds3 + LDSCTL_OFF))[u] = 0u;
    __syncthreads();
    unsigned* ctl = (unsigned*)(args.ws + WS_CTL);
    XcdBarrier bar; bar.bar = ctl + CW_BAR; bar.x = 0; bar.st = nullptr;
    const bool one_launch = (args.ph_hi - args.ph_lo) > 1;
    if (one_launch) bar = xcd_barrier_post(ctl + CW_BAR, MISC + 8);
    const int lo = args.ph_lo, hi = args.ph_hi;
#ifndef MK_PHASE_MASK
#define MK_PHASE_MASK 0xff
#endif
#define IN(k) (((MK_PHASE_MASK >> (k)) & 1) && lo <= (k) && (k) < hi)
#define SEAM(k) do { if (IN(k) && IN((k) + 1)) xcd_barrier(bar); } while (0)

#define DUPQ(k) (MK_DUP == (k))
    if (IN(0)) { if (DUPQ(0)) { p0_phase(F); xcd_barrier(bar); } p0_phase(F); SEAM(0); }
    if (IN(1)) { REFRESH_IDS(F); if (DUPQ(1)) { norm_phase(F, 0); xcd_barrier(bar); } norm_phase(F, 0); bias_items(F); SEAM(1); }
    if (IN(2)) { REFRESH_IDS(F);
        pg8::Gemm g{(const pg8::bf16_t*)(F.ws + WS_H), (const pg8::bf16_t*)(F.ws + WS_WIN), NTOK, D_IN, DM}; pg8::StaticOrder S; S.init(NTOK, D_IN, F.G, (int)blockIdx.x);
        EpiInProj E{(bf16*)(F.ws + WS_Q), (bf16*)(F.ws + WS_K), (bf16*)(F.ws + WS_VT), (bf16*)(F.ws + WS_XR), (bf16*)(F.ws + WS_YG), F.out + O_NEWK, F.out + O_NEWV, (const f32x4*)(F.ws + WS_ROPE)};
        if (DUPQ(2)) { pg8::gemm_phase<EpiInProj, pg8::StaticOrder, true, true>(lds3, g, S, E); xcd_barrier(bar); }
        pg8::gemm_phase<EpiInProj, pg8::StaticOrder, true, true>(lds3, g, S, E);
        if (u_in_p2(F.G) && (int)blockIdx.x >= 192) quant_rows(F, 0, 16384, ((int)blockIdx.x - 192) * NWAVES + F.wave, 64 * NWAVES);
        SEAM(2);
    }
    if (IN(3)) { REFRESH_IDS(F); if (DUPQ(3)) { p3_phase(F, MK_P3_TYPES); xcd_barrier(bar); } p3_phase(F); SEAM(3); }
    if (IN(4)) { REFRESH_IDS(F);
        pg8::Gemm g{(const pg8::bf16_t*)(F.ws + WS_MIX), (const pg8::bf16_t*)(F.ws + WS_WOUT), NTOK, DM, DM}; pg8::StaticOrder S; S.init(NTOK, DM, F.G, (int)blockIdx.x);
        EpiOutProj E{F.in[I_XP], F.in[I_XS], (const float*)(F.ws + WS_MODS), F.in[I_GFFN], (bf16*)(F.ws + WS_X1), (bf16*)(F.ws + WS_H), (float*)(F.ws + WS_SSP)};
        if (DUPQ(4)) { pg8::gemm_phase<EpiOutProj, pg8::StaticOrder, true, true>(lds3, g, S, E); xcd_barrier(bar); }
        pg8::gemm_phase<EpiOutProj, pg8::StaticOrder, true, true>(lds3, g, S, E);
        SEAM(4);
    }
    if (IN(6)) { REFRESH_IDS(F);
        pg8::Gemm g{(const pg8::bf16_t*)(F.ws + WS_H), (const pg8::bf16_t*)(F.ws + WS_WC), NTOK, 2048, DM}; pg8::StaticOrder S; S.init(NTOK, 2048, F.G, (int)blockIdx.x);
        EpiScores E{(bf16*)(F.ws + WS_SC), (const float*)(F.ws + WS_SSP), (const float*)(F.ws + WS_BIAS)};
        if (DUPQ(6)) { pg8::gemm_phase<EpiScores, pg8::StaticOrder, true, true>(lds3, g, S, E); xcd_barrier(bar); }
        pg8::gemm_phase<EpiScores, pg8::StaticOrder, true, true>(lds3, g, S, E);
        SEAM(6);
    }
    if (IN(7)) { REFRESH_IDS(F); if (DUPQ(7)) { p7_phase(F, true); xcd_barrier(bar); } p7_phase(F, false); }
#undef IN
#undef SEAM
}

extern "C" void kernel_launch(void* const* d_in, const int* in_sizes, int n_in, void* d_out, int out_size, void* d_ws, size_t ws_size, hipStream_t stream) {
    static int grid = 0;
    if (grid == 0) {
        if (n_in != 26 || ws_size < WS_END) { fprintf(stderr, "kernel_launch: unexpected n_in %d / ws %zu\n", n_in, ws_size); grid = -1; return; }
        int dev = 0, cus = 0, per_cu = 0;
        if (hipGetDevice(&dev) != hipSuccess || hipDeviceGetAttribute(&cus, hipDeviceAttributeMultiprocessorCount, dev) != hipSuccess) { grid = -1; return; }
        if (hipFuncSetAttribute((const void*)mk_fwd, hipFuncAttributeMaxDynamicSharedMemorySize, LDS_BYTES) != hipSuccess) { fprintf(stderr, "kernel_launch: hipFuncSetAttribute failed\n"); grid = -1; return; }
        if (hipOccupancyMaxActiveBlocksPerMultiprocessor(&per_cu, (const void*)mk_fwd, NWAVES * 64, LDS_BYTES) != hipSuccess || per_cu < 1)
            fprintf(stderr, "kernel_launch: occupancy query reports %d blocks per CU\n", per_cu);
        (void)hipGetLastError();
        grid = cus;
        if (grid != 256) fprintf(stderr, "kernel_launch: note: %d CUs\n", grid);
    }
    if (grid < 0) return;
    (void)hipMemsetAsync((char*)d_ws + WS_CTL, 0, CTL_ZERO_BYTES, stream);
    Args a{};
    for (int i = 0; i < 26; ++i) a.in[i] = (const float*)d_in[i];
    a.out = (float*)d_out; a.ws = (unsigned char*)d_ws;
    if (MK_N_LAUNCHES == 1) {
        a.ph_lo = 0; a.ph_hi = N_PHASES; a.li = 0;
        hipLaunchKernelGGL(mk_fwd, dim3(grid), dim3(NWAVES * 64), LDS_BYTES, stream, a);
    } else {
        for (int li = 0; li < N_PHASES; ++li) { a.ph_lo = li; a.ph_hi = li + 1; a.li = li;
            hipLaunchKernelGGL(mk_fwd, dim3(grid), dim3(NWAVES * 64), LDS_BYTES, stream, a); }
    }
}
```

```cpp
#include <hip/hip_runtime.h>
#include <cstdio>
#include <cstdint>

#ifndef MK_DUP
#define MK_DUP -1
#endif
#ifndef MK_DRY_SKIP
#define MK_DRY_SKIP 0
#endif
#ifndef MK_N_LAUNCHES
#define MK_N_LAUNCHES 1
#endif

namespace pg8 {
#define PG8_LAS __attribute__((address_space(3)))
typedef unsigned short bf16_t;
typedef short bf16x8 __attribute__((ext_vector_type(8)));
typedef float f32x4 __attribute__((ext_vector_type(4)));
typedef unsigned u32x4 __attribute__((ext_vector_type(4)));
typedef unsigned u32x2 __attribute__((ext_vector_type(2)));
constexpr int BM = 256, BK = 64, HALF = 128, HTB = HALF * BK * 2, STAGE_BYTES = 8 * HTB, NXCD = 8, WGM = 8;

__host__ __device__ __forceinline__ int lds_byte(int r, int c) { const int st = (r >> 4) * 2 + (c >> 5), rr = r & 15, cc = c & 31, ob = rr * 64 + cc * 2; return st * 1024 + (ob ^ (((ob >> 9) & 1) << 5)); }
__host__ __device__ __forceinline__ void stage_rc(int b, int& R, int& C) { const int st = b / 1024, sb = b % 1024, swz = sb ^ (((sb >> 9) & 1) << 5); R = (st >> 1) * 16 + swz / 64; C = (st & 1) * 32 + (swz % 64) / 2; }
__host__ __device__ __forceinline__ int perm32(int rho) { const int n = rho >> 4, i = rho & 15; return 8 * (i >> 2) + 4 * n + (i & 3); }

struct Unit { int pm, pn; };
struct Gemm { const bf16_t* A; const bf16_t* Bt; int M, N, K; };

struct StaticOrder {
    int nM, nN, nwg, G, c;
    __host__ __device__ void init(int M, int N, int G_, int c_) { nM = M / BM; nN = N / BM; nwg = nM * nN; G = G_; c = c_; }
    __host__ __device__ bool next(int i, Unit& u) const {
        const long L = (long)i * G + c; if (L >= nwg) return false;
        int wgid = (int)L; { const int q = nwg / NXCD, r = nwg % NXCD, xcd = wgid % NXCD, off = wgid / NXCD; wgid = (xcd < r ? xcd * (q + 1) : r * (q + 1) + (xcd - r) * q) + off; }
        const int nig = WGM * nN, gid = wgid / nig, fm = gid * WGM, gsz = (nM - fm) < WGM ? (nM - fm) : WGM;
        u.pm = fm + ((wgid % nig) % gsz); u.pn = (wgid % nig) / gsz; return true;
    }
    __device__ __forceinline__ void a_ready(const Unit&) const {}
    __device__ __forceinline__ void done(const Unit&) const {}
};

__device__ __forceinline__ unsigned cvt_pk_bf16(float lo, float hi) { unsigned r; asm volatile("v_cvt_pk_bf16_f32 %0, %1, %2" : "=v"(r) : "v"(lo), "v"(hi)); return r; }

template <class Epi, class Sched, bool ALIGN_EPI = false, bool SP2 = false>
__device__ __forceinline__ void gemm_phase(PG8_LAS unsigned char* lds, const Gemm g, const Sched& S, const Epi& E) {
    int tid_ = threadIdx.x; asm volatile("" : "+v"(tid_));
    const int tid = tid_, wid = __builtin_amdgcn_readfirstlane(tid >> 6), lane = tid & 63, wr = wid >> 2, wc = wid & 3, fr = lane & 15, fq = lane >> 4;
    const int K = g.K, nt = K / BK;
    unsigned voffA[2], voffB[2];
#pragma unroll
    for (int i = 0; i < 2; ++i) { int R, C; stage_rc(tid * 16 + i * 8192, R, C); const int Rb = Epi::PERM ? ((R & ~31) + perm32(R & 31)) : R;
        voffA[i] = (unsigned)(R * K + C) * 2u; voffB[i] = (unsigned)(Rb * K + C) * 2u; }
    const size_t kstep = (size_t)(BK * 2);
    const size_t hstep = (size_t)HALF * K * 2;
    const size_t tstep = 2 * hstep;
    const unsigned ldsw = (unsigned)wid * 1024u;
    const int aoff = lds_byte(wr * 64 + fr, fq * 8), boff = lds_byte(wc * 32 + fr, fq * 8);
#define PG8_SA(b, h) (((b) * 2 + (h)) * HTB)
#define PG8_SB(b, h) ((4 + (b) * 2 + (h)) * HTB)
#define PG8_STAGE(bufoff, gbase, voff) do { _Pragma("unroll") for (int _i = 0; _i < 2; ++_i) \
        __builtin_amdgcn_global_load_lds((const unsigned*)((const char*)(gbase) + (voff)[_i]), (PG8_LAS unsigned*)(lds + (bufoff) + ldsw + _i * 8192), 16, 0, 0); } while (0)
#define PG8_LDA(dst, b, h) do { _Pragma("unroll") for (int m = 0; m < 4; ++m) _Pragma("unroll") for (int k = 0; k < 2; ++k) dst[m][k] = *(const PG8_LAS bf16x8*)(lds + PG8_SA(b, h) + aoff + m * 2048 + k * 1024); } while (0)
#define PG8_LDB(dst, b, h) do { _Pragma("unroll") for (int n = 0; n < 2; ++n) _Pragma("unroll") for (int k = 0; k < 2; ++k) dst[n][k] = *(const PG8_LAS bf16x8*)(lds + PG8_SB(b, h) + boff + n * 2048 + k * 1024); } while (0)
#define PG8_MMA(ai, bj, At, Bt) do { __builtin_amdgcn_s_setprio(1); _Pragma("unroll") for (int m = 0; m < 4; ++m) _Pragma("unroll") for (int n = 0; n < 2; ++n) _Pragma("unroll") for (int k = 0; k < 2; ++k) \
        acc[ai][bj][m][n] = __builtin_amdgcn_mfma_f32_16x16x32_bf16(Bt[n][k], At[m][k], acc[ai][bj][m][n], 0, 0, 0); __builtin_amdgcn_s_setprio(0); } while (0)
#define PG8_WAIT_V(n) asm volatile("s_waitcnt vmcnt(" #n ")" ::: "memory")
#define PG8_WAIT_L(n) asm volatile("s_waitcnt lgkmcnt(" #n ")" ::: "memory")
#define PG8_BAR __builtin_amdgcn_s_barrier()
#define PG8_SCHED __builtin_amdgcn_sched_barrier(0)
    Unit cur, nxt; int ui = 0;
    if (!S.next(0, cur)) return;
    f32x4 acc[2][2][4][2];
#pragma unroll
    for (int a = 0; a < 2; ++a)
#pragma unroll
        for (int b = 0; b < 2; ++b)
#pragma unroll
            for (int m = 0; m < 4; ++m)
#pragma unroll
                for (int n = 0; n < 2; ++n) acc[a][b][m][n] = (f32x4){0.f, 0.f, 0.f, 0.f};
    bf16x8 At[4][2], B0[2][2], B1[2][2];
    const char* cA = (const char*)g.A + (size_t)cur.pm * tstep; const char* cB = (const char*)g.Bt + (size_t)cur.pn * tstep;
    S.a_ready(cur);
    if constexpr (SP2) {
        PG8_STAGE(PG8_SB(0, 0), cB, voffB); PG8_STAGE(PG8_SB(0, 1), cB + hstep, voffB); PG8_STAGE(PG8_SA(0, 0), cA, voffA); PG8_STAGE(PG8_SA(0, 1), cA + hstep, voffA);
        if (wr == 1) PG8_BAR;
        PG8_WAIT_V(2); PG8_BAR;
        PG8_STAGE(PG8_SB(1, 0), cB + kstep, voffB); PG8_STAGE(PG8_SA(1, 0), cA + kstep, voffA); PG8_STAGE(PG8_SB(1, 1), cB + hstep + kstep, voffB);
        PG8_WAIT_V(6); PG8_BAR;
    } else {
        PG8_STAGE(PG8_SB(0, 0), cB, voffB); PG8_STAGE(PG8_SA(0, 0), cA, voffA); PG8_STAGE(PG8_SB(0, 1), cB + hstep, voffB); PG8_STAGE(PG8_SA(0, 1), cA + hstep, voffA);
        if (wr == 1) PG8_BAR;
        PG8_WAIT_V(4); PG8_BAR;
        PG8_STAGE(PG8_SB(1, 0), cB + kstep, voffB); PG8_STAGE(PG8_SA(1, 0), cA + kstep, voffA); PG8_STAGE(PG8_SB(1, 1), cB + hstep + kstep, voffB);
        PG8_WAIT_V(6); PG8_BAR;
    }
    for (;;) {
        const bool has_next = S.next(ui + 1, nxt);
        const char* nA = has_next ? (const char*)g.A + (size_t)nxt.pm * tstep : cA; const char* nB = has_next ? (const char*)g.Bt + (size_t)nxt.pn * tstep : cB;
        for (int t = 0; t < nt; t += 2) {
            const bool last = (t == nt - 2);
            const char* a1 = cA + (size_t)(t + 1) * kstep;
            const char* a2 = last ? nA : cA + (size_t)(t + 2) * kstep; const char* b2 = last ? nB : cB + (size_t)(t + 2) * kstep;
            const char* a3 = a2 + kstep; const char* b3 = b2 + kstep;
            if (last && has_next) S.a_ready(nxt);
            if constexpr (SP2) {
            PG8_LDB(B0, 0, 0); PG8_LDB(B1, 0, 1); PG8_SCHED; PG8_LDA(At, 0, 0); PG8_STAGE(PG8_SA(1, 1), a1 + hstep, voffA);
            PG8_WAIT_V(8); PG8_WAIT_L(0); PG8_BAR; PG8_MMA(0, 0, At, B0); PG8_MMA(0, 1, At, B1); PG8_BAR; PG8_SCHED;
            PG8_LDA(At, 0, 1); PG8_STAGE(PG8_SB(0, 0), b2, voffB); PG8_STAGE(PG8_SB(0, 1), b2 + hstep, voffB); PG8_STAGE(PG8_SA(0, 0), a2, voffA);
            PG8_WAIT_V(8); PG8_WAIT_L(0); PG8_BAR; PG8_MMA(1, 0, At, B0); PG8_MMA(1, 1, At, B1); PG8_BAR; PG8_SCHED;
            PG8_LDB(B0, 1, 0); PG8_LDB(B1, 1, 1); PG8_SCHED; PG8_LDA(At, 1, 0); PG8_STAGE(PG8_SA(0, 1), a2 + hstep, voffA);
            PG8_WAIT_V(8); PG8_WAIT_L(0); PG8_BAR; PG8_MMA(0, 0, At, B0); PG8_MMA(0, 1, At, B1); PG8_BAR; PG8_SCHED;
            PG8_LDA(At, 1, 1); PG8_STAGE(PG8_SB(1, 0), b3, voffB); PG8_STAGE(PG8_SB(1, 1), b3 + hstep, voffB); PG8_STAGE(PG8_SA(1, 0), a3, voffA);
            PG8_WAIT_V(8); PG8_WAIT_L(0); PG8_BAR; PG8_MMA(1, 0, At, B0); PG8_MMA(1, 1, At, B1); PG8_BAR; PG8_SCHED;
            } else {
            PG8_LDB(B0, 0, 0); PG8_SCHED; PG8_LDA(At, 0, 0); PG8_STAGE(PG8_SA(1, 1), a1 + hstep, voffA);
            PG8_WAIT_L(8); PG8_BAR; PG8_WAIT_L(0); PG8_MMA(0, 0, At, B0); PG8_BAR; PG8_SCHED;
            PG8_LDB(B1, 0, 1); PG8_STAGE(PG8_SB(0, 0), b2, voffB);
            PG8_BAR; PG8_WAIT_L(0); PG8_MMA(0, 1, At, B1); PG8_BAR;
            PG8_LDA(At, 0, 1); PG8_STAGE(PG8_SA(0, 0), a2, voffA);
            PG8_BAR; PG8_WAIT_L(0); PG8_MMA(1, 0, At, B0); PG8_BAR; PG8_SCHED;
            PG8_STAGE(PG8_SB(0, 1), b2 + hstep, voffB);
            PG8_WAIT_V(6); PG8_BAR; PG8_MMA(1, 1, At, B1); PG8_BAR;
            PG8_LDB(B0, 1, 0); PG8_SCHED; PG8_LDA(At, 1, 0); PG8_STAGE(PG8_SA(0, 1), a2 + hstep, voffA);
            PG8_WAIT_L(8); PG8_BAR; PG8_WAIT_L(0); PG8_MMA(0, 0, At, B0); PG8_BAR; PG8_SCHED;
            PG8_LDB(B1, 1, 1); PG8_STAGE(PG8_SB(1, 0), b3, voffB);
            PG8_BAR; PG8_WAIT_L(0); PG8_MMA(0, 1, At, B1); PG8_BAR;
            PG8_LDA(At, 1, 1); PG8_STAGE(PG8_SA(1, 0), a3, voffA);
            PG8_BAR; PG8_WAIT_L(0); PG8_MMA(1, 0, At, B0); PG8_BAR; PG8_SCHED;
            PG8_STAGE(PG8_SB(1, 1), b3 + hstep, voffB);
            PG8_WAIT_V(6); PG8_BAR; PG8_MMA(1, 1, At, B1); PG8_BAR;
            }
        }
        if constexpr (ALIGN_EPI) { if (wr == 0) PG8_BAR; }
        { int te_ = threadIdx.x; asm volatile("" : "+v"(te_));
          const int we_ = __builtin_amdgcn_readfirstlane(te_ >> 6), le_ = te_ & 63;
          E(acc, cur, we_ >> 2, we_ & 3, le_ & 15, le_ >> 4); }
        S.done(cur);
        if (!has_next) break;
#pragma unroll
        for (int a = 0; a < 2; ++a)
#pragma unroll
            for (int b = 0; b < 2; ++b)
#pragma unroll
                for (int m = 0; m < 4; ++m)
#pragma unroll
                    for (int n = 0; n < 2; ++n) acc[a][b][m][n] = (f32x4){0.f, 0.f, 0.f, 0.f};
        cur = nxt; cA = nA; cB = nB; ++ui;
        if constexpr (ALIGN_EPI) { if (wr == 1) PG8_BAR; }
    }
    PG8_WAIT_V(0);
    if constexpr (!ALIGN_EPI) { if (wr == 0) PG8_BAR; }
    PG8_BAR;
#undef PG8_SA
#undef PG8_SB
#undef PG8_STAGE
#undef PG8_LDA
#undef PG8_LDB
#undef PG8_MMA
#undef PG8_WAIT_V
#undef PG8_WAIT_L
#undef PG8_BAR
#undef PG8_SCHED
}
}

constexpr int NWAVES = 8;
constexpr int DM = 1024, NTOK = 16384, NCTX = 8192, D_IN = 1792, NMODV = 9, MODW = 6144;
constexpr int SEQ_C = 256, SEQ_L = 1024, NSEQ_C = 32, NSEQ_L = 8;
constexpr int N_PHASES = 8;
constexpr float LOG2E = 1.4426950408889634f;
constexpr float QSCALE = 0.125f * LOG2E;
constexpr float EPS = 1e-6f;

constexpr size_t MiB = 1u << 20, KiB = 1u << 10;
constexpr size_t WS_CTL = 0, CTL_ZERO_BYTES = 64 * KiB;
constexpr size_t WS_MODS = 1 * MiB;
constexpr size_t WS_ROPE = 1 * MiB + 256 * KiB;
constexpr size_t WS_RGW  = 1 * MiB + 512 * KiB;
constexpr size_t WS_CK   = 1 * MiB + 768 * KiB;
constexpr size_t WS_CVT  = 2 * MiB + 256 * KiB;
constexpr size_t WS_WIN  = 3 * MiB;
constexpr size_t WS_WOUT = 7 * MiB;
constexpr size_t WS_WC   = 9 * MiB;
constexpr size_t WS_U    = 16 * MiB;
constexpr size_t WS_SSP  = 14 * MiB;
constexpr size_t WS_BIAS = 15 * MiB;
constexpr size_t WS_SU   = 13 * MiB;
constexpr size_t WS_SV   = 13 * MiB + 64 * KiB;
constexpr size_t WS_V    = 48 * MiB;
constexpr size_t WS_H    = 80 * MiB;
constexpr size_t WS_MIX  = 112 * MiB;
constexpr size_t WS_Q    = 144 * MiB;
constexpr size_t WS_K    = 160 * MiB;
constexpr size_t WS_VT   = 164 * MiB;
constexpr size_t WS_XR   = 168 * MiB;
constexpr size_t WS_YG   = 184 * MiB;
constexpr size_t WS_HF   = 200 * MiB;
constexpr size_t WS_X1   = 208 * MiB;
constexpr size_t WS_SC   = 144 * MiB;
constexpr size_t WS_END  = 232 * MiB;
constexpr int VT_LAT_OFF = NSEQ_C * 2 * 64 * SEQ_C;

constexpr int CW_BAR = 4096;

constexpr int RING_BYTES = 131072;
constexpr int LDSCTL_OFF = 146944, MISC_OFF = LDSCTL_OFF + 320;
constexpr int LDS_BYTES = 147456;

#define GAS __attribute__((address_space(1)))
#define LAS __attribute__((address_space(3)))
typedef unsigned short bf16;
typedef unsigned v4u __attribute__((ext_vector_type(4)));
typedef unsigned v2u __attribute__((ext_vector_type(2)));
typedef float f32x4 __attribute__((ext_vector_type(4)));
typedef float f32x2 __attribute__((ext_vector_type(2)));
typedef float f32x16 __attribute__((ext_vector_type(16)));
typedef short bf16x8 __attribute__((ext_vector_type(8)));
typedef GAS unsigned gu32;
#define RLX_AGENT __ATOMIC_RELAXED, __HIP_MEMORY_SCOPE_AGENT

__device__ __forceinline__ unsigned f2bf(float f) { unsigned u = __builtin_bit_cast(unsigned, f); return (u + 0x7fffu + ((u >> 16) & 1u)) >> 16; }
typedef float f32x2_t_ __attribute__((ext_vector_type(2))); typedef __bf16 bf16x2_t_ __attribute__((ext_vector_type(2)));
__device__ __forceinline__ unsigned pk2(float lo, float hi) { f32x2_t_ v = {lo, hi}; bf16x2_t_ b = __builtin_convertvector(v, bf16x2_t_); return __builtin_bit_cast(unsigned, b); }
__device__ __forceinline__ float bf2f(unsigned b) { return __builtin_bit_cast(float, b << 16); }
__device__ __forceinline__ float bflo(unsigned w) { return __builtin_bit_cast(float, w << 16); }
__device__ __forceinline__ float bfhi(unsigned w) { return __builtin_bit_cast(float, w & 0xffff0000u); }
__device__ __forceinline__ float sigmoidf_(float x) { return 1.f / (1.f + __expf(-x)); }
__device__ __forceinline__ float gelu_tanh(float x) { const float y = 0.7978845608028654f * (x + 0.044715f * x * x * x); const float e = __expf(2.f * y); return 0.5f * x * (2.f - 2.f / (1.f + e)); }
template <int CTRL> __device__ __forceinline__ float dppf_(float v) { return __builtin_bit_cast(float, __builtin_amdgcn_update_dpp(0, __builtin_bit_cast(int, v), CTRL, 0xf, 0xf, true)); }
__device__ __forceinline__ float xrow16_(float v) {
    unsigned a = __builtin_bit_cast(unsigned, v), b = a; asm volatile("" : "+v"(b));
    const auto r = __builtin_amdgcn_permlane16_swap(a, b, false, false);
    const bool odd = (threadIdx.x & 16) != 0; return __builtin_bit_cast(float, odd ? r[0] : r[1]);
}
__device__ __forceinline__ float xhalf32_(float v) {
    unsigned a = __builtin_bit_cast(unsigned, v), b = a; asm volatile("" : "+v"(b));
    const auto r = __builtin_amdgcn_permlane32_swap(a, b, false, false);
    const bool hi = (threadIdx.x & 32) != 0; return __builtin_bit_cast(float, hi ? r[0] : r[1]);
}
__device__ __forceinline__ float wave_sum(float v) {
    v += dppf_<0xB1>(v); v += dppf_<0x4E>(v); v += dppf_<0x141>(v); v += dppf_<0x140>(v);
    v += xrow16_(v); v += xhalf32_(v); return v;
}
__device__ __forceinline__ float wave_max(float v) {
    v = fmaxf(v, dppf_<0xB1>(v)); v = fmaxf(v, dppf_<0x4E>(v)); v = fmaxf(v, dppf_<0x141>(v)); v = fmaxf(v, dppf_<0x140>(v));
    v = fmaxf(v, xrow16_(v)); v = fmaxf(v, xhalf32_(v)); return v;
}
__device__ __forceinline__ int crow(int r, int hi) { return (r & 3) + 8 * (r >> 2) + 4 * hi; }

#define XB_TMO      128
#define XB_XCNT(j)  (256  + 64 * (j))
#define XB_XSUB(j)  (1280 + 64 * (j))
#define XB_XGEN(j)  (2304 + 64 * (j))
#define XB_TOP      3328
#define XB_TOPGEN   3392
#define XCD_BAR_WORDS 3456
#define XB_SPIN_CAP (1u << 18)
__device__ __forceinline__ unsigned xb_ld(unsigned* p)              { return __hip_atomic_load(p, __ATOMIC_RELAXED, __HIP_MEMORY_SCOPE_AGENT); }
__device__ __forceinline__ unsigned xb_add(unsigned* p, unsigned v) { return __hip_atomic_fetch_add(p, v, __ATOMIC_RELAXED, __HIP_MEMORY_SCOPE_AGENT); }
__device__ __forceinline__ unsigned xb_xcc_id() { return (unsigned)__builtin_amdgcn_s_getreg((3 << 11) | 20) & 0xFu; }
#define XB_SPIN(cond, bar) do { unsigned _sp = 0; while (cond) { __builtin_amdgcn_s_sleep(1); \
    if ((++_sp & 255u) == 0u) { if (xb_ld(&(bar)[XB_TMO])) break; if (_sp > XB_SPIN_CAP) { atomicAdd(&(bar)[XB_TMO], 1u); break; } } } } while (0)
struct XcdBarrier { unsigned* bar; unsigned x; volatile LAS unsigned* st; };
__device__ __forceinline__ XcdBarrier xcd_barrier_post(unsigned* bar, volatile LAS unsigned* st) {
    XcdBarrier b; b.bar = bar; b.x = xb_xcc_id(); b.st = st;
    if (threadIdx.x == 0) (void)xb_add(&bar[XB_XCNT(b.x)], 1u);
    return b;
}
__device__ __forceinline__ void xcd_barrier_complete(unsigned* bar, unsigned x, unsigned& nloc, unsigned& nx) {
    const unsigned G = gridDim.x * gridDim.y * gridDim.z;
    unsigned sum, cnt, mine, sp = 0u;
    for (;;) {
        sum = 0u; cnt = 0u; mine = 0u;
#pragma unroll
        for (unsigned j = 0; j < 16; ++j) { const unsigned c = xb_ld(&bar[XB_XCNT(j)]); sum += c; cnt += (c > 0u) ? 1u : 0u; mine = (j == x) ? c : mine; }
        if (sum == G) break;
        __builtin_amdgcn_s_sleep(1);
        if ((++sp & 255u) == 0u) { if (xb_ld(&bar[XB_TMO])) break; if (sp > XB_SPIN_CAP) { atomicAdd(&bar[XB_TMO], 1u); break; } }
    }
    nloc = mine > 0u ? mine : 1u; nx = cnt > 0u ? cnt : 1u;
}
__device__ __forceinline__ void xcd_barrier(const XcdBarrier& b) {
    asm volatile("s_waitcnt vmcnt(0)" ::: "memory");
    __syncthreads();
    if (threadIdx.x == 0) {
        unsigned* bar = b.bar;
        __builtin_amdgcn_s_waitcnt(0);
        unsigned nloc = b.st[0], nx = b.st[1];
        if (nloc == 0u) { xcd_barrier_complete(bar, b.x, nloc, nx); b.st[0] = nloc; b.st[1] = nx; }
        const unsigned old = xb_add(&bar[XB_XSUB(b.x)], 1u);
        const unsigned gen = old / nloc;
        if (old + 1u == (gen + 1u) * nloc) {
            __builtin_amdgcn_fence(__ATOMIC_RELEASE, "agent");
            asm volatile("s_waitcnt vmcnt(0)" ::: "memory");
            const unsigned og = xb_add(&bar[XB_TOP], 1u);
            const unsigned tg = og / nx;
            if (og + 1u == (tg + 1u) * nx) xb_add(&bar[XB_TOPGEN], 1u);
            else XB_SPIN(xb_ld(&bar[XB_TOPGEN]) == tg, bar);
            __builtin_amdgcn_fence(__ATOMIC_ACQUIRE, "agent");
            xb_add(&bar[XB_XGEN(b.x)], 1u);
            asm volatile("s_waitcnt vmcnt(0)" ::: "memory");
        } else {
            XB_SPIN(xb_ld(&bar[XB_XGEN(b.x)]) == gen, bar);
            __builtin_amdgcn_fence(__ATOMIC_ACQUIRE, "agent");
            asm volatile("s_waitcnt vmcnt(0)" ::: "memory");
        }
    }
    __syncthreads();
}

struct Args { const float* in[26]; float* out; unsigned char* ws; int ph_lo, ph_hi, li, pad; };

struct Frame {
    unsigned char* lds;
    int tid, lane, wave, vcu, G;
    const float* const* in;
    float* out; unsigned char* ws;
};
enum { I_XP = 0, I_XS, I_CK, I_CV, I_SRNN, I_C, I_CCTX, I_WMOD, I_BMOD, I_GMIX, I_GFFN, I_WIN, I_CONVW, I_CONVB, I_RGWA, I_RGBA, I_RGWI, I_RGBI, I_RGLAM, I_SINK, I_WOUT, I_PWQ, I_PSK, I_PU, I_PV, I_GFINAL };
constexpr size_t O_Y = 0, O_NEWK = (size_t)NTOK * DM, O_NEWV = O_NEWK + (size_t)NCTX * 128, O_NEWRNN = O_NEWV + (size_t)NCTX * 128;

__device__ __forceinline__ int mod_index(int tok) { return tok < NCTX ? 0 : 1 + ((tok - NCTX) >> 10); }
__device__ __forceinline__ const float* x_row(const Frame& F, int tok) { return tok < NCTX ? F.in[I_XP] + (size_t)tok * DM : F.in[I_XS] + (size_t)(tok - NCTX) * DM; }

__device__ __forceinline__ int hw_lane() { int l; asm volatile("v_mbcnt_lo_u32_b32 %0, -1, 0\n\tv_mbcnt_hi_u32_b32 %0, -1, %0" : "=v"(l)); return l; }
#define REFRESH_IDS(F) do { F.lane = hw_lane(); F.tid = F.wave * 64 + F.lane; } while (0)
template <class RowMap>
__device__ __forceinline__ void p0_transpose_item(const float* W, int K, int N, bf16* WT, float* scr, int item, int lane, RowMap rowmap, float scale = 1.f) {
    const int nblk = N / 32, kb = item / nblk, nb = item % nblk, k0 = 64 * kb, n0 = 32 * nb;
    { float tv[32];
#pragma unroll
      for (int i = 0; i < 32; ++i) tv[i] = W[(size_t)(k0 + 2 * i + (lane >> 5)) * N + n0 + (lane & 31)];
#pragma unroll
      for (int i = 0; i < 32; ++i) scr[(2 * i + (lane >> 5)) * 33 + (lane & 31)] = tv[i]; }
    __builtin_amdgcn_s_waitcnt(0xC07F); asm volatile("" ::: "memory");
    const int c = lane & 7;
#pragma unroll
    for (int j = 0; j < 4; ++j) { const int n = (lane >> 3) + 8 * j; const float* s = scr + (8 * c) * 33 + n;
        v4u o; o.x = pk2(s[0 * 33] * scale, s[1 * 33] * scale); o.y = pk2(s[2 * 33] * scale, s[3 * 33] * scale); o.z = pk2(s[4 * 33] * scale, s[5 * 33] * scale); o.w = pk2(s[6 * 33] * scale, s[7 * 33] * scale);
        *(v4u*)(WT + (size_t)rowmap(n0 + n) * K + k0 + 8 * c) = o; }
    __builtin_amdgcn_s_waitcnt(0xC07F); asm volatile("" ::: "memory");
}
struct MapId { __device__ __forceinline__ int operator()(int n) const { return n; } };
struct MapWin { __device__ __forceinline__ int operator()(int n) const { if (n >= 640) return n; const int hb = n & ~63, o = n & 63; return hb + ((o & 31) << 1) + (o >> 5); } };

__device__ __forceinline__ bool u_in_p2(int G) { return 2 * G - (NTOK / 256) * (D_IN / 256) == 64 && G == 256; }
__device__ __forceinline__ void quant_rows(Frame& F, int it_lo, int it_hi, int w, int nw) {
    const int lane = F.lane;
    for (int it0 = it_lo + 4 * w; it0 < it_hi; it0 += 4 * nw) {
        f32x4 a[4][4];
#pragma unroll
        for (int r = 0; r < 4; ++r) { const int it = it0 + r, tb = it >> 14, row = it & 16383;
            const float* src = (tb ? F.in[I_PV] : F.in[I_PU]) + (size_t)row * DM + 16 * lane;
#pragma unroll
            for (int j = 0; j < 4; ++j) a[r][j] = *(const f32x4*)(src + 4 * j); }
        float am[4];
#pragma unroll
        for (int r = 0; r < 4; ++r) { float m = 0.f;
#pragma unroll
            for (int j = 0; j < 4; ++j) m = fmaxf(m, fmaxf(fmaxf(fabsf(a[r][j][0]), fabsf(a[r][j][1])), fmaxf(fabsf(a[r][j][2]), fabsf(a[r][j][3]))));
            am[r] = m; }
#pragma unroll
        for (int r = 0; r < 4; ++r) am[r] = wave_max(am[r]);
#pragma unroll
        for (int r = 0; r < 4; ++r) { const int it = it0 + r, tb = it >> 14, row = it & 16383;
            if (tb) {
                const float inv = am[r] > 0.f ? 7.f / am[r] : 0.f;
                v2u o2;
#pragma unroll
                for (int h = 0; h < 2; ++h) { unsigned w = 0;
#pragma unroll
                    for (int c = 0; c < 8; ++c) { int q = (int)rintf(a[r][2 * h + (c >> 2)][c & 3] * inv); q = q > 7 ? 7 : (q < -7 ? -7 : q); w |= ((unsigned)((c & 1) ? q : q + 8) & 0xfu) << (4 * c); }
                    o2[h] = w; }
                *(v2u*)(F.ws + WS_V + (size_t)row * (DM / 2) + 8 * lane) = o2;
                if (lane == 0) ((float*)(F.ws + WS_SV))[row] = am[r] * (1.f / 7.f);
            } else {
                const float inv = am[r] > 0.f ? 7.f / am[r] : 0.f;
                v2u o2;
#pragma unroll
                for (int h = 0; h < 2; ++h) { unsigned w = 0;
#pragma unroll
                    for (int c = 0; c < 8; ++c) { int q = (int)rintf(a[r][2 * h + (c >> 2)][c & 3] * inv); q = q > 7 ? 7 : (q < -7 ? -7 : q); w |= ((unsigned)q & 0xfu) << (4 * c); }
                    o2[h] = w; }
                *(v2u*)(F.ws + WS_U + (size_t)row * (DM / 2) + 8 * lane) = o2;
                if (lane == 0) ((float*)(F.ws + WS_SU))[row] = am[r] * (1.f / 7.f);
            } }
    }
}

__device__ __forceinline__ void p0_phase(Frame& F) {
    float* ldsf = (float*)F.lds;
    const int tid = F.tid, lane = F.lane, wave = F.wave, v = F.vcu;
    if (v < 192) {
        { float cv[NMODV * DM / 512];
#pragma unroll
          for (int t = 0; t < NMODV * DM / 512; ++t) { const int i = tid + 512 * t, j = i >> 10, d = i & 1023; cv[t] = (j == 0) ? F.in[I_CCTX][d] : F.in[I_C][(j - 1) * DM + d]; }
#pragma unroll
          for (int t = 0; t < NMODV * DM / 512; ++t) ldsf[tid + 512 * t] = cv[t] * sigmoidf_(cv[t]); }
        __syncthreads();
        const int e0 = 32 * v, c4 = tid & 7, kq = tid >> 3;
        float acc[NMODV][4];
#pragma unroll
        for (int j = 0; j < NMODV; ++j) { acc[j][0] = 0.f; acc[j][1] = 0.f; acc[j][2] = 0.f; acc[j][3] = 0.f; }
        const float* wm = F.in[I_WMOD] + e0 + 4 * c4;
        f32x4 wv[16];
#pragma unroll
        for (int kk = 0; kk < 16; ++kk) wv[kk] = *(const f32x4*)(wm + (size_t)(kq * 16 + kk) * MODW);
#pragma unroll
        for (int kk = 0; kk < 16; ++kk) { const int k = kq * 16 + kk; const f32x4 w = wv[kk];
#pragma unroll
            for (int j = 0; j < NMODV; ++j) { const float s = ldsf[j * DM + k]; acc[j][0] += s * w[0]; acc[j][1] += s * w[1]; acc[j][2] += s * w[2]; acc[j][3] += s * w[3]; } }
#pragma unroll
        for (int j = 0; j < NMODV; ++j)
#pragma unroll
            for (int i = 0; i < 4; ++i) { float a = acc[j][i]; a += dppf_<0x128>(a); a += xrow16_(a); a += xhalf32_(a); acc[j][i] = a; }
        float* red = ldsf + NMODV * DM;
        if (lane < 8) {
#pragma unroll
            for (int j = 0; j < NMODV; ++j)
#pragma unroll
                for (int i = 0; i < 4; ++i) red[(wave * NMODV + j) * 32 + 4 * c4 + i] = acc[j][i];
        }
        __syncthreads();
        if (tid < NMODV * 32) { const int j = tid >> 5, col = tid & 31; float s = F.in[I_BMOD][e0 + col];
#pragma unroll
            for (int w = 0; w < 8; ++w) s += red[(w * NMODV + j) * 32 + col];
            ((float*)(F.ws + WS_MODS))[j * MODW + e0 + col] = s; }
        __syncthreads();
    }
    if (v < 256) {
        const int hh = v >> 4, dt = v & 15, dm = wave & 1, kn = wave >> 1, r32 = lane & 31, hi = lane >> 5;
        const float* ap = F.in[I_PWQ] + (size_t)(64 * dt + 32 * dm + r32) * 2048 + hh * 128 + 8 * hi;
        const float* bp = F.in[I_PSK] + (size_t)hh * 128 * 128 + (size_t)(32 * kn + r32) * 128 + 8 * hi;
        f32x4 ar[8][2], br[8][2];
#pragma unroll
        for (int ks = 0; ks < 8; ++ks) { ar[ks][0] = *(const f32x4*)(ap + 16 * ks); ar[ks][1] = *(const f32x4*)(ap + 16 * ks + 4); br[ks][0] = *(const f32x4*)(bp + 16 * ks); br[ks][1] = *(const f32x4*)(bp + 16 * ks + 4); }
        f32x16 acc;
#pragma unroll
        for (int r = 0; r < 16; ++r) acc[r] = 0.f;
#pragma unroll
        for (int ks = 0; ks < 8; ++ks) {
            v4u ah, al, bh, bl;
#pragma unroll
            for (int p2 = 0; p2 < 4; ++p2) { const float a0 = ar[ks][p2 >> 1][2 * (p2 & 1)], a1 = ar[ks][p2 >> 1][2 * (p2 & 1) + 1], b0 = br[ks][p2 >> 1][2 * (p2 & 1)], b1 = br[ks][p2 >> 1][2 * (p2 & 1) + 1];
                const unsigned pah = pk2(a0, a1), pbh = pk2(b0, b1);
                ah[p2] = pah; al[p2] = pk2(a0 - bflo(pah), a1 - bfhi(pah)); bh[p2] = pbh; bl[p2] = pk2(b0 - bflo(pbh), b1 - bfhi(pbh)); }
            const bf16x8 fah = __builtin_bit_cast(bf16x8, ah), fal = __builtin_bit_cast(bf16x8, al), fbh = __builtin_bit_cast(bf16x8, bh), fbl = __builtin_bit_cast(bf16x8, bl);
            acc = __builtin_amdgcn_mfma_f32_32x32x16_bf16(fal, fbh, acc, 0, 0, 0);
            acc = __builtin_amdgcn_mfma_f32_32x32x16_bf16(fah, fbl, acc, 0, 0, 0);
            acc = __builtin_amdgcn_mfma_f32_32x32x16_bf16(fah, fbh, acc, 0, 0, 0);
        }
        bf16* WcT = (bf16*)(F.ws + WS_WC) + (size_t)(hh * 128 + 32 * kn + r32) * DM + 64 * dt + 32 * dm + 4 * hi;
#pragma unroll
        for (int g = 0; g < 4; ++g) { v2u o; o.x = pk2(acc[4 * g], acc[4 * g + 1]); o.y = pk2(acc[4 * g + 2], acc[4 * g + 3]); *(v2u*)(WcT + 8 * g) = o; }
    }
    const int gw = v * NWAVES + wave, NGW = F.G * NWAVES;
    float* scr = ldsf + wave * 4096;
    {
        constexpr int I_IN = (DM / 64) * (D_IN / 32), I_OUT = (DM / 64) * (DM / 32), I_RG = 32 * 2;
        constexpr int NIT = I_IN + I_OUT + I_RG;
        for (int it = gw; it < NIT; it += NGW) {
            int r = it;
            if (r < I_IN) { p0_transpose_item(F.in[I_WIN], DM, D_IN, (bf16*)(F.ws + WS_WIN), scr, r, lane, MapWin()); continue; } r -= I_IN;
            if (r < I_OUT) { p0_transpose_item(F.in[I_WOUT], DM, DM, (bf16*)(F.ws + WS_WOUT), scr, r, lane, MapId()); continue; } r -= I_OUT;
            { const int mm = r >> 1, sub = r & 1, dir = mm >> 4, n = (mm >> 1) & 7, gate = mm & 1;
              const float* src = (gate ? F.in[I_RGWI] : F.in[I_RGWA]) + (size_t)(dir * 8 + n) * 4096;
              bf16* dst = (bf16*)(F.ws + WS_RGW) + (size_t)((dir * 8 + n) * 2 + gate) * 4096;
              p0_transpose_item(src, 64, 64, dst, scr, sub, lane, MapId(), -LOG2E); }
        }
    }
    quant_rows(F, u_in_p2(F.G) ? 16384 : 0, 2 * 16384, gw, NGW);
    const int gt = v * 512 + tid, NGT = F.G * 512;
    for (int e = gt; e < 8 * 256 * 128; e += NGT) {
        const int c = e & 127, bp = e >> 7, kvh = c >> 6, p = c & 63, old = (p & 1) ? 32 + (p >> 1) : (p >> 1);
        ((bf16*)(F.ws + WS_CK))[e] = (bf16)f2bf(F.in[I_CK][(size_t)bp * 128 + kvh * 64 + old]);
    }
    for (int e = gt; e < 8 * 256 * 128; e += NGT) {
        const int pos = e & 255, d = (e >> 8) & 63, kvh = (e >> 14) & 1, b = e >> 15;
        ((bf16*)(F.ws + WS_CVT))[e] = (bf16)f2bf(F.in[I_CV][(size_t)(b * 256 + pos) * 128 + kvh * 64 + d]);
    }
    for (int e = gt; e < 1024 * 32; e += NGT) {
        const int s = e >> 5, i = e & 31, row = s >> 6, col = s & 63;
        const float inv = powf(10000.0f, -(float)(i & 15) / 16.0f);
        const float ang = (i < 16 ? (float)row : (float)col) * inv;
        f32x2 cs; cs.x = cosf(ang); cs.y = sinf(ang);
        ((f32x2*)(F.ws + WS_ROPE))[e] = cs;
    }
}

__device__ __forceinline__ void bias_items(Frame& F) {
    const int gw = F.vcu * NWAVES + F.wave, NGW = F.G * NWAVES, lane = F.lane;
    const float* mods = (const float*)(F.ws + WS_MODS); const bf16* WcT = (const bf16*)(F.ws + WS_WC); float* BIAS = (float*)(F.ws + WS_BIAS);
    for (int n = gw; n < 2048; n += NGW) {
        const v4u a = *(const v4u*)(WcT + (size_t)n * DM + 16 * lane), b = *(const v4u*)(WcT + (size_t)n * DM + 16 * lane + 8);
        float w[16];
        w[0] = bflo(a.x); w[1] = bfhi(a.x); w[2] = bflo(a.y); w[3] = bfhi(a.y); w[4] = bflo(a.z); w[5] = bfhi(a.z); w[6] = bflo(a.w); w[7] = bfhi(a.w);
        w[8] = bflo(b.x); w[9] = bfhi(b.x); w[10] = bflo(b.y); w[11] = bfhi(b.y); w[12] = bflo(b.z); w[13] = bfhi(b.z); w[14] = bflo(b.w); w[15] = bfhi(b.w);
        f32x4 sv[NMODV][4];
#pragma unroll
        for (int j = 0; j < NMODV; ++j) { const float* sh = mods + (size_t)j * MODW + 3 * DM + 16 * lane;
#pragma unroll
            for (int q = 0; q < 4; ++q) sv[j][q] = *(const f32x4*)(sh + 4 * q); }
        float dd[NMODV];
#pragma unroll
        for (int j = 0; j < NMODV; ++j) { float d = 0.f;
#pragma unroll
            for (int q = 0; q < 4; ++q) d += sv[j][q][0] * w[4 * q] + sv[j][q][1] * w[4 * q + 1] + sv[j][q][2] * w[4 * q + 2] + sv[j][q][3] * w[4 * q + 3];
            dd[j] = d; }
#pragma unroll
        for (int j = 0; j < NMODV; ++j) dd[j] = wave_sum(dd[j]);
        if (lane == 0) {
#pragma unroll
            for (int j = 0; j < NMODV; ++j) BIAS[j * 2048 + n] = dd[j]; }
    }
}
__device__ __forceinline__ void norm_phase(Frame& F, int which) {
    const int gw = F.vcu * NWAVES + F.wave, NGW = F.G * NWAVES, lane = F.lane;
    const float* mods = (const float*)(F.ws + WS_MODS);
    const float* g = F.in[which ? I_GFFN : I_GMIX];
    bf16* H = (bf16*)(F.ws + WS_H);
    if (NTOK % (NGW * 4) == 0) {
        const int tpw = NTOK / NGW, t0 = gw * tpw;
        const float* mv = mods + (size_t)mod_index(t0) * MODW + (which ? 3 * DM : 0);
        f32x4 gs[4], sh[4];
#pragma unroll
        for (int j = 0; j < 4; ++j) { const int e = 256 * j + 4 * lane; const f32x4 gg = *(const f32x4*)(g + e), sc = *(const f32x4*)(mv + DM + e); sh[j] = *(const f32x4*)(mv + e);
#pragma unroll
            for (int i = 0; i < 4; ++i) gs[j][i] = gg[i] * (1.f + sc[i]); }
#pragma unroll 1
        for (int tb = t0; tb < t0 + tpw; tb += 4) {
            f32x4 v[4][4]; float ss[4];
#pragma unroll
            for (int r = 0; r < 4; ++r) { const float* xr = which ? F.out + O_Y + (size_t)(tb + r) * DM : x_row(F, tb + r);
#pragma unroll
                for (int j = 0; j < 4; ++j) v[r][j] = *(const f32x4*)(xr + 256 * j + 4 * lane); }
#pragma unroll
            for (int r = 0; r < 4; ++r) { float a = 0.f;
#pragma unroll
                for (int j = 0; j < 4; ++j) a += (v[r][j][0] * v[r][j][0] + v[r][j][1] * v[r][j][1]) + (v[r][j][2] * v[r][j][2] + v[r][j][3] * v[r][j][3]);
                ss[r] = a; }
#pragma unroll
            for (int r = 0; r < 4; ++r) ss[r] = wave_sum(ss[r]);
#pragma unroll
            for (int r = 0; r < 4; ++r) { const float rstd = 1.f / sqrtf(ss[r] * (1.f / DM) + EPS);
#pragma unroll
                for (int j = 0; j < 4; ++j) { f32x4 o;
#pragma unroll
                    for (int i = 0; i < 4; ++i) o[i] = v[r][j][i] * rstd * gs[j][i] + sh[j][i];
                    v2u w; w.x = pk2(o[0], o[1]); w.y = pk2(o[2], o[3]); *(v2u*)(H + (size_t)(tb + r) * DM + 256 * j + 4 * lane) = w; } }
        }
        return;
    }
    for (int tok = gw; tok < NTOK; tok += NGW) {
        const float* xr = which ? F.out + O_Y + (size_t)tok * DM : x_row(F, tok);
        const float* mv = mods + (size_t)mod_index(tok) * MODW + (which ? 3 * DM : 0);
        f32x4 v[4]; float ss = 0.f;
#pragma unroll
        for (int j = 0; j < 4; ++j) { v[j] = *(const f32x4*)(xr + 256 * j + 4 * lane); ss += (v[j][0] * v[j][0] + v[j][1] * v[j][1]) + (v[j][2] * v[j][2] + v[j][3] * v[j][3]); }
        const float rstd = 1.f / sqrtf(wave_sum(ss) * (1.f / DM) + EPS);
#pragma unroll
        for (int j = 0; j < 4; ++j) { const int e = 256 * j + 4 * lane;
            const f32x4 gg = *(const f32x4*)(g + e), sh = *(const f32x4*)(mv + e), sc = *(const f32x4*)(mv + DM + e);
            f32x4 o;
#pragma unroll
            for (int i = 0; i < 4; ++i) o[i] = v[j][i] * rstd * gg[i] * (1.f + sc[i]) + sh[i];
            v2u w; w.x = pk2(o[0], o[1]); w.y = pk2(o[2], o[3]); *(v2u*)(H + (size_t)tok * DM + e) = w; }
    }
}

struct EpiInProj {
    static constexpr bool PERM = true;
    bf16 *q, *k, *vT, *xr, *yg; float *newk, *newv; const f32x4* rope4;
    __device__ __forceinline__ void operator()(const f32x4 (&acc)[2][2][4][2], const pg8::Unit& u, int wr, int wc, int fr, int fq) const {
        const bool lat = u.pm >= 32;
        const int pn = u.pn;
#pragma unroll
        for (int ai = 0; ai < 2; ++ai)
#pragma unroll
            for (int m = 0; m < 4; ++m) {
                const int row = u.pm * 256 + ai * 128 + wr * 64 + m * 16 + fr;
                const int pos = lat ? ((row - NCTX) & 1023) : (row & 255);
#pragma unroll
                for (int bj = 0; bj < 2; ++bj) {
                    const int c = pn * 256 + bj * 128 + wc * 32 + 8 * fq;
                    f32x4 v0 = acc[ai][bj][m][0], v1 = acc[ai][bj][m][1];
                    if (pn < 2 || (pn == 2 && bj == 0)) {
                        const int i = (c & 63) >> 1;
                        if (lat) { const f32x4 cs0 = rope4[(pos * 32 + i) >> 1], cs1 = rope4[((pos * 32 + i) >> 1) + 1];
                            const float a0 = v0[0] * cs0[0] - v0[1] * cs0[1], a1 = v0[1] * cs0[0] + v0[0] * cs0[1];
                            const float b0 = v0[2] * cs0[2] - v0[3] * cs0[3], b1 = v0[3] * cs0[2] + v0[2] * cs0[3];
                            const float c0 = v1[0] * cs1[0] - v1[1] * cs1[1], c1 = v1[1] * cs1[0] + v1[0] * cs1[1];
                            const float d0 = v1[2] * cs1[2] - v1[3] * cs1[3], d1 = v1[3] * cs1[2] + v1[2] * cs1[3];
                            v0[0] = a0; v0[1] = a1; v0[2] = b0; v0[3] = b1; v1[0] = c0; v1[1] = c1; v1[2] = d0; v1[3] = d1; }
                        if (pn < 2) { v4u w; w.x = pk2(v0[0] * QSCALE, v0[1] * QSCALE); w.y = pk2(v0[2] * QSCALE, v0[3] * QSCALE); w.z = pk2(v1[0] * QSCALE, v1[1] * QSCALE); w.w = pk2(v1[2] * QSCALE, v1[3] * QSCALE);
                            *(v4u*)(q + (size_t)row * 512 + c) = w; }
                        else { const int kc = c - 512; v4u w; w.x = pk2(v0[0], v0[1]); w.y = pk2(v0[2], v0[3]); w.z = pk2(v1[0], v1[1]); w.w = pk2(v1[2], v1[3]); *(v4u*)(k + (size_t)row * 128 + kc) = w;
                            if (!lat) { float* nk = newk + (size_t)row * 128 + (kc & 64) + i; f32x4 lo; lo[0] = v0[0]; lo[1] = v0[2]; lo[2] = v1[0]; lo[3] = v1[2]; f32x4 hi; hi[0] = v0[1]; hi[1] = v0[3]; hi[2] = v1[1]; hi[3] = v1[3];
                                *(f32x4*)nk = lo; *(f32x4*)(nk + 32) = hi; } }
                    } else if (pn == 2) {
                        const int vc = c - 640, kvh = vc >> 6, d = vc & 63;
                        if (!lat) { *(f32x4*)(newv + (size_t)row * 128 + vc) = v0; *(f32x4*)(newv + (size_t)row * 128 + vc + 4) = v1; }
                        bf16* vp; int S;
                        if (!lat) { S = SEQ_C; vp = vT + ((size_t)((row >> 8) * 2 + kvh) * 64 + d) * SEQ_C + pos; }
                        else { S = SEQ_L; vp = vT + VT_LAT_OFF + ((size_t)(((row - NCTX) >> 10) * 2 + kvh) * 64 + d) * SEQ_L + pos; }
                        vp[0] = (bf16)f2bf(v0[0]); vp[S] = (bf16)f2bf(v0[1]); vp[2 * S] = (bf16)f2bf(v0[2]); vp[3 * S] = (bf16)f2bf(v0[3]);
                        vp[4 * S] = (bf16)f2bf(v1[0]); vp[5 * S] = (bf16)f2bf(v1[1]); vp[6 * S] = (bf16)f2bf(v1[2]); vp[7 * S] = (bf16)f2bf(v1[3]);
                    } else {
                        v4u w; w.x = pk2(v0[0], v0[1]); w.y = pk2(v0[2], v0[3]); w.z = pk2(v1[0], v1[1]); w.w = pk2(v1[2], v1[3]);
                        if (pn < 5) *(v4u*)(xr + (size_t)row * 512 + (c - 768)) = w; else *(v4u*)(yg + (size_t)row * 512 + (c - 1280)) = w;
                    }
                }
            }
    }
};
struct EpiOutProj {
    static constexpr bool PERM = true;
    const float *xp, *xs, *mods, *gffn; bf16* x1; bf16* ap; float* ssp;
    __device__ __forceinline__ void operator()(const f32x4 (&acc)[2][2][4][2], const pg8::Unit& u, int wr, int wc, int fr, int fq) const {
        const int mi = u.pm < 32 ? 0 : 1 + ((u.pm - 32) >> 2);
        const float* mv = mods + (size_t)mi * MODW;
        const int row0 = u.pm * 256 + wr * 64 + fr;
        const float* xbase = (u.pm < 32 ? xp : xs - (size_t)NCTX * DM) + (size_t)row0 * DM;
        float ssq[2][4];
#pragma unroll
        for (int ai = 0; ai < 2; ++ai)
#pragma unroll
            for (int m = 0; m < 4; ++m) ssq[ai][m] = 0.f;
#pragma unroll
        for (int bj = 0; bj < 2; ++bj) {
            const int c = u.pn * 256 + bj * 128 + wc * 32 + 8 * fq;
            const f32x4 gv0 = *(const f32x4*)(mv + 2 * DM + c), gv1 = *(const f32x4*)(mv + 2 * DM + c + 4);
            const f32x4 g20 = *(const f32x4*)(gffn + c) * (1.f + *(const f32x4*)(mv + 4 * DM + c)), g21 = *(const f32x4*)(gffn + c + 4) * (1.f + *(const f32x4*)(mv + 4 * DM + c + 4));
#pragma unroll
            for (int h4 = 0; h4 < 4; ++h4) {
                const int ai = h4 >> 1;
                f32x4 xv[2][2];
#pragma unroll
                for (int mm = 0; mm < 2; ++mm) { const float* xr = xbase + (size_t)(ai * 128 + (2 * (h4 & 1) + mm) * 16) * DM + c; xv[mm][0] = *(const f32x4*)xr; xv[mm][1] = *(const f32x4*)(xr + 4); }
                asm volatile("" ::: "memory");
#pragma unroll
                for (int mm = 0; mm < 2; ++mm) {
                    const int m = 2 * (h4 & 1) + mm;
                    const size_t off = (size_t)(row0 + ai * 128 + m * 16) * DM + c;
                    const f32x4 o0 = xv[mm][0] + gv0 * acc[ai][bj][m][0], o1 = xv[mm][1] + gv1 * acc[ai][bj][m][1];
                    { v4u xw; xw.x = pk2(o0[0], o0[1]); xw.y = pk2(o0[2], o0[3]); xw.z = pk2(o1[0], o1[1]); xw.w = pk2(o1[2], o1[3]); *(v4u*)(x1 + off) = xw; }
                    ssq[ai][m] += ((o0[0] * o0[0] + o0[1] * o0[1]) + (o0[2] * o0[2] + o0[3] * o0[3])) + ((o1[0] * o1[0] + o1[1] * o1[1]) + (o1[2] * o1[2] + o1[3] * o1[3]));
                    const f32x4 t0 = o0 * g20, t1 = o1 * g21; v4u w; w.x = pk2(t0[0], t0[1]); w.y = pk2(t0[2], t0[3]); w.z = pk2(t1[0], t1[1]); w.w = pk2(t1[2], t1[3]);
                    *(v4u*)(ap + off) = w;
                }
                asm volatile("" ::: "memory");
            }
        }
#pragma unroll
        for (int ai = 0; ai < 2; ++ai)
#pragma unroll
            for (int m = 0; m < 4; ++m) { float v = ssq[ai][m]; v += xrow16_(v); v += xhalf32_(v);
                if (fq == 0) ssp[(size_t)(row0 + ai * 128 + m * 16) * 16 + u.pn * 4 + wc] = v; }
    }
};
struct EpiScores {
    static constexpr bool PERM = true;
    bf16* sc; const float* ssp; const float* bias;
    __device__ __forceinline__ void operator()(const f32x4 (&acc)[2][2][4][2], const pg8::Unit& u, int wr, int wc, int fr, int fq) const {
        const int mi = u.pm < 32 ? 0 : 1 + ((u.pm - 32) >> 2);
        const int row0 = u.pm * 256 + wr * 64 + fr;
        f32x4 b0[2], b1[2];
#pragma unroll
        for (int bj = 0; bj < 2; ++bj) { const int c = u.pn * 256 + bj * 128 + wc * 32 + 8 * fq; b0[bj] = *(const f32x4*)(bias + (size_t)mi * 2048 + c); b1[bj] = *(const f32x4*)(bias + (size_t)mi * 2048 + c + 4); }
#pragma unroll
        for (int h2 = 0; h2 < 4; ++h2) {
            const int ai = h2 >> 1;
            f32x4 sp[2][4];
#pragma unroll
            for (int mm = 0; mm < 2; ++mm)
#pragma unroll
                for (int q = 0; q < 4; ++q) sp[mm][q] = *((const f32x4*)(ssp + (size_t)(row0 + ai * 128 + (2 * (h2 & 1) + mm) * 16) * 16) + q);
            asm volatile("" ::: "memory");
#pragma unroll
            for (int mm = 0; mm < 2; ++mm) {
                const int m = 2 * (h2 & 1) + mm;
                const int row = row0 + ai * 128 + m * 16;
                const float ss = ((sp[mm][0][0] + sp[mm][0][1]) + (sp[mm][0][2] + sp[mm][0][3])) + ((sp[mm][1][0] + sp[mm][1][1]) + (sp[mm][1][2] + sp[mm][1][3]))
                               + ((sp[mm][2][0] + sp[mm][2][1]) + (sp[mm][2][2] + sp[mm][2][3])) + ((sp[mm][3][0] + sp[mm][3][1]) + (sp[mm][3][2] + sp[mm][3][3]));
                const float rstd = 1.f / sqrtf(ss * (1.f / DM) + EPS);
#pragma unroll
                for (int bj = 0; bj < 2; ++bj) {
                    const int c = u.pn * 256 + bj * 128 + wc * 32 + 8 * fq;
                    const f32x4 v0 = acc[ai][bj][m][0] * rstd + b0[bj], v1 = acc[ai][bj][m][1] * rstd + b1[bj];
                    v4u w; w.x = pk2(v0[0], v0[1]); w.y = pk2(v0[2], v0[3]); w.z = pk2(v1[0], v1[1]); w.w = pk2(v1[2], v1[3]);
                    *(v4u*)(sc + (size_t)row * 2048 + c) = w;
                }
            }
            asm volatile("" ::: "memory");
        }
    }
};

__device__ __forceinline__ void attn_unit(Frame& F, bool lat, int seq, int kvh, int qt) {
    const int tid = F.tid, lane = F.lane, wave = F.wave, r32 = lane & 31, hi = lane >> 5;
    const int g = wave >> 1, qs = wave & 1, head = kvh * 4 + g;
    const int S = lat ? SEQ_L : SEQ_C, tokbase = lat ? NCTX + seq * SEQ_L : seq * SEQ_C;
    const int q0 = qt * 64, qpos = q0 + 32 * qs + r32;
    const bf16* Q = (const bf16*)(F.ws + WS_Q); const bf16* Kb = (const bf16*)(F.ws + WS_K); const bf16* VT = (const bf16*)(F.ws + WS_VT);
    const bf16* CK = (const bf16*)(F.ws + WS_CK); const bf16* CVT = (const bf16*)(F.ws + WS_CVT);
    unsigned char* ldsK = F.lds; unsigned char* ldsV = F.lds + 8192;
    bf16x8 qf[4];
    { const bf16* qp = Q + (size_t)(tokbase + qpos) * 512 + head * 64;
#pragma unroll
      for (int ks = 0; ks < 4; ++ks) qf[ks] = *(const bf16x8*)(qp + 16 * ks + 8 * hi); }
    const float sinkl = F.in[I_SINK][head] * LOG2E;
    float mrun = sinkl, lrun = (hi == 0) ? 1.f : 0.f;
    f32x16 o0, o1;
#pragma unroll
    for (int r = 0; r < 16; ++r) { o0[r] = 0.f; o1[r] = 0.f; }
    int tlo, thi;
    if (lat) { tlo = (q0 >= 128 ? q0 - 128 : 0) >> 6; thi = ((q0 + 192 < S ? q0 + 192 : S)) >> 6; } else { tlo = 0; thi = 4; }
    const int nband = thi - tlo, ntile = nband + (lat ? 4 : 0);
    const int key_t = tid >> 3, ch_t = tid & 7;
    v4u kv, vv;
#define AT_LOAD(t_) do { const int tt_ = (t_); const bf16* kptr; const bf16* vptr; int vstride; \
        if (tt_ < nband) { const int kb_ = (tlo + tt_) * 64; kptr = Kb + (size_t)(tokbase + kb_) * 128 + kvh * 64; \
            vptr = VT + (lat ? (size_t)VT_LAT_OFF + (size_t)((seq * 2 + kvh) * 64) * SEQ_L : (size_t)((seq * 2 + kvh) * 64) * SEQ_C) + kb_; vstride = S; } \
        else { const int tc = tt_ - nband; kptr = CK + (size_t)(seq * 256 + tc * 64) * 128 + kvh * 64; vptr = CVT + (size_t)((seq * 2 + kvh) * 64) * 256 + tc * 64; vstride = 256; } \
        kv = *(const v4u*)(kptr + (size_t)key_t * 128 + ch_t * 8); vv = *(const v4u*)(vptr + (size_t)key_t * vstride + ch_t * 8); } while (0)
    AT_LOAD(0);
    for (int t = 0; t < ntile; ++t) {
        const bool band = t < nband;
        const int kbase = band ? (tlo + t) * 64 : 0;
        __syncthreads();
        *(v4u*)(ldsK + key_t * 128 + ((ch_t ^ (key_t & 7)) * 16)) = kv;
        *(v4u*)(ldsV + key_t * 128 + ((ch_t ^ (key_t & 7)) * 16)) = vv;
        __syncthreads();
        f32x16 p0, p1;
#pragma unroll
        for (int r = 0; r < 16; ++r) { p0[r] = 0.f; p1[r] = 0.f; }
#pragma unroll
        for (int ks = 0; ks < 4; ++ks) {
            const int sw = ((2 * ks + hi) ^ (r32 & 7)) * 16;
            const bf16x8 a0 = *(const bf16x8*)(ldsK + r32 * 128 + sw);
            const bf16x8 a1 = *(const bf16x8*)(ldsK + (32 + r32) * 128 + sw);
            p0 = __builtin_amdgcn_mfma_f32_32x32x16_bf16(a0, qf[ks], p0, 0, 0, 0);
            p1 = __builtin_amdgcn_mfma_f32_32x32x16_bf16(a1, qf[ks], p1, 0, 0, 0);
        }
        if (t + 1 < ntile) AT_LOAD(t + 1);
        if (band && lat && (kbase < q0 + 63 - 128 || kbase + 63 > q0 + 128)) {
#pragma unroll
            for (int r = 0; r < 16; ++r) { const int kp = kbase + crow(r, hi); int d0 = qpos - kp; d0 = d0 < 0 ? -d0 : d0; int d1 = qpos - kp - 32; d1 = d1 < 0 ? -d1 : d1;
                if (d0 > 128) p0[r] = -INFINITY; if (d1 > 128) p1[r] = -INFINITY; }
        }
        float tm = p0[0];
#pragma unroll
        for (int r = 1; r < 16; ++r) tm = fmaxf(tm, p0[r]);
#pragma unroll
        for (int r = 0; r < 16; ++r) tm = fmaxf(tm, p1[r]);
        tm = fmaxf(tm, xhalf32_(tm));
        const float mn = fmaxf(mrun, tm), alpha = __builtin_amdgcn_exp2f(mrun - mn); mrun = mn;
        float ls = 0.f;
#pragma unroll
        for (int r = 0; r < 16; ++r) { p0[r] = __builtin_amdgcn_exp2f(p0[r] - mn); p1[r] = __builtin_amdgcn_exp2f(p1[r] - mn); ls += p0[r] + p1[r]; o0[r] *= alpha; o1[r] *= alpha; }
        lrun = lrun * alpha + ls;
        bf16x8 pf[4];
#pragma unroll
        for (int s = 0; s < 2; ++s) {
            v4u w0, w1;
            w0.x = pk2(p0[8 * s + 0], p0[8 * s + 1]); w0.y = pk2(p0[8 * s + 2], p0[8 * s + 3]); w0.z = pk2(p0[8 * s + 4], p0[8 * s + 5]); w0.w = pk2(p0[8 * s + 6], p0[8 * s + 7]);
            w1.x = pk2(p1[8 * s + 0], p1[8 * s + 1]); w1.y = pk2(p1[8 * s + 2], p1[8 * s + 3]); w1.z = pk2(p1[8 * s + 4], p1[8 * s + 5]); w1.w = pk2(p1[8 * s + 6], p1[8 * s + 7]);
            pf[s] = __builtin_bit_cast(bf16x8, w0); pf[2 + s] = __builtin_bit_cast(bf16x8, w1);
        }
#pragma unroll
        for (int s4 = 0; s4 < 4; ++s4) {
#pragma unroll
            for (int dt = 0; dt < 2; ++dt) {
                const int d = 32 * dt + r32;
                const v2u lo = *(const v2u*)(ldsV + d * 128 + (((2 * s4) ^ (d & 7)) * 16) + 8 * hi);
                const v2u hi2 = *(const v2u*)(ldsV + d * 128 + (((2 * s4 + 1) ^ (d & 7)) * 16) + 8 * hi);
                v4u vf4; vf4.x = lo.x; vf4.y = lo.y; vf4.z = hi2.x; vf4.w = hi2.y;
                const bf16x8 vf = __builtin_bit_cast(bf16x8, vf4);
                if (dt == 0) o0 = __builtin_amdgcn_mfma_f32_32x32x16_bf16(vf, pf[s4], o0, 0, 0, 0);
                else o1 = __builtin_amdgcn_mfma_f32_32x32x16_bf16(vf, pf[s4], o1, 0, 0, 0);
            }
        }
    }
    const float ltot = lrun + xhalf32_(lrun), inv = 1.f / ltot;
    bf16* mix = (bf16*)(F.ws + WS_MIX) + (size_t)(tokbase + qpos) * DM + head * 64;
#pragma unroll
    for (int g4 = 0; g4 < 4; ++g4) {
        v2u w; w.x = pk2(o0[4 * g4] * inv, o0[4 * g4 + 1] * inv); w.y = pk2(o0[4 * g4 + 2] * inv, o0[4 * g4 + 3] * inv);
        *(v2u*)(mix + 8 * g4 + 4 * hi) = w;
        v2u w2; w2.x = pk2(o1[4 * g4] * inv, o1[4 * g4 + 1] * inv); w2.y = pk2(o1[4 * g4 + 2] * inv, o1[4 * g4 + 3] * inv);
        *(v2u*)(mix + 32 + 8 * g4 + 4 * hi) = w2;
    }
    __syncthreads();
}

constexpr int RL_HALF = 49152;
constexpr int RL_XCB = 32768;
constexpr int RL_AGG = 98304;
constexpr int RL_CARRY = RL_AGG + 8192;
constexpr int RL_CW = RL_CARRY + 512;
constexpr int RL_WG = RL_CW + 1280;
static_assert(RL_WG + 32768 <= LDSCTL_OFF, "RNN LDS map");
__device__ __forceinline__ float fsigmoid(float x) { return __builtin_amdgcn_rcpf(1.f + __expf(-x)); }
__device__ __forceinline__ float gelu_fast(float x) { const float y = 0.7978845608028654f * (x + 0.044715f * x * x * x); const float e = __expf(2.f * y); return x - x * __builtin_amdgcn_rcpf(1.f + e); }

template <bool REV>
__device__ __forceinline__ void scan_prep(const float (&a)[16], const float (&b)[16], int h, float (&Apre)[4], float (&Bpre)[4], float& At, float& Bt) {
    float Ao[4], Bo[4], Ap[4], Bp[4];
#pragma unroll
    for (int g = 0; g < 4; ++g) { float A = 1.f, B = 0.f;
#pragma unroll
        for (int ii = 0; ii < 4; ++ii) { const int r = 4 * g + (REV ? 3 - ii : ii); B = a[r] * B + b[r]; A = a[r] * A; }
        Ao[g] = A; Bo[g] = B; }
#pragma unroll
    for (int g = 0; g < 4; ++g) { Ap[g] = xhalf32_(Ao[g]); Bp[g] = xhalf32_(Bo[g]); }
    const bool ownfirst = REV ? (h == 1) : (h == 0);
    float Ac = 1.f, Bc = 0.f;
#pragma unroll
    for (int gi = 0; gi < 4; ++gi) { const int g = REV ? 3 - gi : gi;
        const float A1 = ownfirst ? Ao[g] : Ap[g], B1 = ownfirst ? Bo[g] : Bp[g], A2 = ownfirst ? Ap[g] : Ao[g], B2 = ownfirst ? Bp[g] : Bo[g];
        const float Ac1 = A1 * Ac, Bc1 = A1 * Bc + B1;
        Apre[g] = ownfirst ? Ac : Ac1; Bpre[g] = ownfirst ? Bc : Bc1;
        Ac = A2 * Ac1; Bc = A2 * Bc1 + B2; }
    At = Ac; Bt = Bc;
}
template <bool REV>
__device__ __forceinline__ void scan_finish(const float (&a)[16], const float (&b)[16], const float (&Apre)[4], const float (&Bpre)[4], float hin, float* hp, int hi) {
#pragma unroll
    for (int g = 0; g < 4; ++g) { float hc = Apre[g] * hin + Bpre[g];
#pragma unroll
        for (int ii = 0; ii < 4; ++ii) { const int r = 4 * g + (REV ? 3 - ii : ii); hc = a[r] * hc + b[r]; hp[(size_t)crow(r, hi) * 512] = hc; } }
}

template <bool REV>
__device__ __forceinline__ void rnn_dir(Frame& F, bool lat, int seq, int n) {
    const int lane = F.lane, w4 = F.wave & 3, r32 = lane & 31, hi = lane >> 5, dirh = REV ? 1 : 0;
    const int S = lat ? SEQ_L : SEQ_C, tokbase = lat ? NCTX + seq * SEQ_L : seq * SEQ_C, nchunk = S / 128;
    unsigned char* hb = F.lds + dirh * RL_HALF;
    float* XC32 = (float*)hb; unsigned char* XCB = hb + RL_XCB;
    f32x2* AGG = (f32x2*)(F.lds + RL_AGG) + dirh * 256; float* CARRY = (float*)(F.lds + RL_CARRY) + dirh * 64; const float* CW = (const float*)(F.lds + RL_CW);
    const unsigned char* WG = F.lds + RL_WG + dirh * 16384;
    const bf16* XR = (const bf16*)(F.ws + WS_XR) + (size_t)tokbase * 512 + n * 64;
    float* HX = (float*)(F.ws + (REV ? WS_H : WS_HF)) + (size_t)tokbase * 512 + n * 64;
    const int t = F.tid & 255, c8 = t & 7, tg = t >> 3;
    float ba[2], bi[2], sp8[2];
#pragma unroll
    for (int chh = 0; chh < 2; ++chh) { const int pe = dirh * 512 + n * 64 + chh * 32 + r32; ba[chh] = -LOG2E * F.in[I_RGBA][pe]; bi[chh] = -LOG2E * F.in[I_RGBI][pe];
        const float nl = -F.in[I_RGLAM][pe]; sp8[chh] = -8.f * LOG2E * (nl > 20.f ? nl : log1pf(__expf(nl))); }
    v4u xin[7];
#define RL_XLOAD(c0_) do { _Pragma("unroll") for (int i = 0; i < 7; ++i) { const int pos = (c0_) + 4 * tg - 2 + i; \
        xin[i] = (pos >= 0 && pos < S) ? *(const v4u*)(XR + (size_t)pos * 512 + 8 * c8) : (v4u){0u, 0u, 0u, 0u}; } } while (0)
    RL_XLOAD((REV ? nchunk - 1 : 0) * 128);
    float newcarry[2] = {0.f, 0.f};
    const bool last_tile = REV ? (w4 == 0) : (w4 == 3);
#pragma unroll 1
    for (int k = 0; k < nchunk; ++k) {
        const int c0 = (REV ? nchunk - 1 - k : k) * 128;
        {
            const f32x4 b0 = *(const f32x4*)(CW + 256 + 8 * c8), b1 = *(const f32x4*)(CW + 256 + 8 * c8 + 4);
            f32x4 wt0[4], wt1[4];
#pragma unroll
            for (int tap = 0; tap < 4; ++tap) { wt0[tap] = *(const f32x4*)(CW + tap * 64 + 8 * c8); wt1[tap] = *(const f32x4*)(CW + tap * 64 + 8 * c8 + 4); }
#pragma unroll
            for (int i = 0; i < 4; ++i) {
                f32x4 y0 = b0, y1 = b1;
#pragma unroll
                for (int tap = 0; tap < 4; ++tap) { const v4u x = xin[i + tap];
                    y0[0] += wt0[tap][0] * bflo(x.x); y0[1] += wt0[tap][1] * bfhi(x.x); y0[2] += wt0[tap][2] * bflo(x.y); y0[3] += wt0[tap][3] * bfhi(x.y);
                    y1[0] += wt1[tap][0] * bflo(x.z); y1[1] += wt1[tap][1] * bfhi(x.z); y1[2] += wt1[tap][2] * bflo(x.w); y1[3] += wt1[tap][3] * bfhi(x.w); }
                const int tk = 4 * tg + i;
                *(f32x4*)(XC32 + tk * 64 + 8 * c8) = y0; *(f32x4*)(XC32 + tk * 64 + 8 * c8 + 4) = y1;
                v4u w; w.x = pk2(y0[0], y0[1]); w.y = pk2(y0[2], y0[3]); w.z = pk2(y1[0], y1[1]); w.w = pk2(y1[2], y1[3]);
                *(v4u*)(XCB + tk * 128 + ((c8 ^ (tk & 7)) * 16)) = w; }
        }
        if (k + 1 < nchunk) RL_XLOAD((REV ? nchunk - 2 - k : k + 1) * 128);
        __syncthreads();
        if (k > 0 && last_tile && hi == 0) { CARRY[r32] = newcarry[0]; CARRY[32 + r32] = newcarry[1]; }
        const int tkA = 32 * w4 + r32;
#pragma unroll
        for (int chh = 0; chh < 2; ++chh) {
            const int che = chh * 32 + r32;
            float av[16], bv[16], Apre[4], Bpre[4];
            {
                f32x16 ga, gi;
#pragma unroll
                for (int r = 0; r < 16; ++r) { ga[r] = 0.f; gi[r] = 0.f; }
#pragma unroll
                for (int ks = 0; ks < 4; ++ks) {
                    const bf16x8 af = *(const bf16x8*)(XCB + tkA * 128 + (((2 * ks + hi) ^ (tkA & 7)) * 16));
                    const bf16x8 wa = *(const bf16x8*)(WG + che * 128 + (((2 * ks + hi) ^ (che & 7)) * 16));
                    const bf16x8 wi = *(const bf16x8*)(WG + 8192 + che * 128 + (((2 * ks + hi) ^ (che & 7)) * 16));
                    ga = __builtin_amdgcn_mfma_f32_32x32x16_bf16(af, wa, ga, 0, 0, 0);
                    gi = __builtin_amdgcn_mfma_f32_32x32x16_bf16(af, wi, gi, 0, 0, 0);
                }
#pragma unroll
                for (int r = 0; r < 16; ++r) { const int tk2 = 32 * w4 + crow(r, hi); const float x = XC32[tk2 * 64 + che];
                    const float rg = __builtin_amdgcn_rcpf(1.f + __builtin_amdgcn_exp2f(ga[r] + ba[chh])), ig = __builtin_amdgcn_rcpf(1.f + __builtin_amdgcn_exp2f(gi[r] + bi[chh])), a = __builtin_amdgcn_exp2f(rg * sp8[chh]);
                    av[r] = a; bv[r] = __builtin_amdgcn_sqrtf(fmaxf(1.f - a * a, 0.f)) * ig * x;
                    if ((r & 3) == 3) __builtin_amdgcn_sched_barrier(0); }
                float At, Bt;
                scan_prep<REV>(av, bv, hi, Apre, Bpre, At, Bt);
                if (hi == 0) { f32x2 ab; ab.x = At; ab.y = Bt; AGG[chh * 512 + w4 * 64 + che] = ab; }
            }
            __syncthreads();
            {
                float hin = CARRY[che];
                if (!REV) { for (int t2 = 0; t2 < w4; ++t2) { const f32x2 ab = AGG[chh * 512 + t2 * 64 + che]; hin = ab.x * hin + ab.y; } }
                else { for (int t2 = 3; t2 > w4; --t2) { const f32x2 ab = AGG[chh * 512 + t2 * 64 + che]; hin = ab.x * hin + ab.y; } }
                scan_finish<REV>(av, bv, Apre, Bpre, hin, HX + (size_t)(c0 + 32 * w4) * 512 + che, hi);
                if (last_tile) { const f32x2 ab = AGG[chh * 512 + w4 * 64 + che]; newcarry[chh] = ab.x * hin + ab.y; }
            }
        }
    }
#undef RL_XLOAD
    if (!lat && last_tile && hi == 0) { float* o = F.out + O_NEWRNN + (size_t)(seq * 2 + dirh) * 512 + n * 64; o[r32] = newcarry[0]; o[32 + r32] = newcarry[1]; }
}

__device__ __forceinline__ void rnn_unit(Frame& F, bool lat, int seq, int n) {
    const int tid = F.tid;
    const int S = lat ? SEQ_L : SEQ_C, tokbase = lat ? NCTX + seq * SEQ_L : seq * SEQ_C;
    __syncthreads();
    { float* CW = (float*)(F.lds + RL_CW); float* CARRY = (float*)(F.lds + RL_CARRY);
      if (tid < 320) CW[tid] = tid < 256 ? F.in[I_CONVW][(tid >> 6) * 512 + n * 64 + (tid & 63)] : F.in[I_CONVB][n * 64 + (tid - 256)];
      if (tid < 128) CARRY[tid] = lat ? F.in[I_SRNN][(size_t)(seq * 2 + (tid >> 6)) * 512 + n * 64 + (tid & 63)] : 0.f;
      const bf16* rgw = (const bf16*)(F.ws + WS_RGW);
#pragma unroll
      for (int i = 0; i < 4; ++i) { const int q = tid + 512 * i, ch = q & 7, d = (q >> 3) & 63, gate = (q >> 9) & 1, dir = q >> 10;
          const v4u w = *(const v4u*)(rgw + (size_t)((dir * 8 + n) * 2 + gate) * 4096 + d * 64 + ch * 8);
          *(v4u*)(F.lds + RL_WG + dir * 16384 + gate * 8192 + d * 128 + ((ch ^ (d & 7)) * 16)) = w; } }
    __syncthreads();
    if (F.wave < 4) rnn_dir<false>(F, lat, seq, n); else rnn_dir<true>(F, lat, seq, n);
    __syncthreads();
    { const int c4 = tid & 15, tk = tid >> 4;
      const float* HF = (const float*)(F.ws + WS_HF) + (size_t)tokbase * 512 + n * 64 + 4 * c4;
      const float* HB = (const float*)(F.ws + WS_H) + (size_t)tokbase * 512 + n * 64 + 4 * c4;
      const bf16* YG = (const bf16*)(F.ws + WS_YG) + (size_t)tokbase * 512 + n * 64 + 4 * c4;
      bf16* MIX = (bf16*)(F.ws + WS_MIX) + (size_t)tokbase * DM + 512 + n * 64 + 4 * c4;
#pragma unroll 1
      for (int t0 = tk; t0 < S; t0 += 256) {
          f32x4 a[8], b[8]; v2u y[8];
#pragma unroll
          for (int u = 0; u < 8; ++u) { const size_t t = (size_t)(t0 + 32 * u); a[u] = *(const f32x4*)(HF + t * 512); b[u] = *(const f32x4*)(HB + t * 512); y[u] = *(const v2u*)(YG + t * 512); }
#pragma unroll
          for (int u = 0; u < 8; ++u) { v2u o; o.x = pk2((a[u][0] + b[u][0]) * gelu_fast(bflo(y[u].x)), (a[u][1] + b[u][1]) * gelu_fast(bfhi(y[u].x)));
              o.y = pk2((a[u][2] + b[u][2]) * gelu_fast(bflo(y[u].y)), (a[u][3] + b[u][3]) * gelu_fast(bfhi(y[u].y)));
              *(v2u*)(MIX + (size_t)(t0 + 32 * u) * DM) = o; } } }
    __syncthreads();
}

#ifndef MK_P3_TYPES
#define MK_P3_TYPES 15
#endif
__device__ __forceinline__ void p3_phase(Frame& F, int types = 15) {
    const int v = F.vcu;
#pragma unroll 1
    for (int i = 0; i < 832; ++i) {
        int type, idx;
        if (F.G == 256) {
            if (v < 64) { if (i > 0) break; type = 0; idx = v; }
            else { if (i >= 6) break; const int j = v - 64, sl = i >> 1, rep = i & 1; type = 1 + sl;
                const bool extra = sl == 0 ? (j < 64) : (sl == 1 ? (j >= 64 && j < 128) : (j >= 128));
                if (rep && !extra) continue; idx = rep ? 192 + (j - 64 * sl) : j; }
        } else { const int it = v + i * F.G; if (it >= 832) break;
            if (it < 64) { type = 0; idx = it; } else if (it < 320) { type = 1; idx = it - 64; } else if (it < 576) { type = 2; idx = it - 320; } else { type = 3; idx = it - 576; } }
        if (!((types >> type) & 1)) continue;
        const bool lat = type < 2;
        Frame L = F; asm volatile("" : "+v"(L.tid)); L.lane = L.tid & 63;
        asm volatile("" : "+s"(L.ws), "+s"(L.out));
        if ((type & 1) == 0) rnn_unit(L, lat, idx >> 3, idx & 7);
        else { if (lat) attn_unit(L, true, idx >> 5, (idx >> 4) & 1, idx & 15); else attn_unit(L, false, idx >> 3, (idx >> 2) & 1, idx & 3); }
    }
}

__device__ __forceinline__ unsigned key16(unsigned b, unsigned idx) { const unsigned s = (b & 0x8000u) ? (~b & 0xffffu) : (b | 0x8000u); return (s << 16) | idx; }
__device__ __forceinline__ float keyval16(unsigned k) { const unsigned s = k >> 16; const unsigned b = (s & 0x8000u) ? (s & 0x7fffu) : (~s & 0xffffu); return bf2f(b); }
__device__ __forceinline__ unsigned sortable32(float f) { const unsigned u = __builtin_bit_cast(unsigned, f); return (u & 0x80000000u) ? ~u : (u | 0x80000000u); }
template <int CTRL> __device__ __forceinline__ unsigned dppu(unsigned v) { return (unsigned)__builtin_amdgcn_update_dpp(0, (int)v, CTRL, 0xf, 0xf, true); }
template <int CTRL> __device__ __forceinline__ float dppf(float v) { return __builtin_bit_cast(float, __builtin_amdgcn_update_dpp(0, __builtin_bit_cast(int, v), CTRL, 0xf, 0xf, true)); }
__device__ __forceinline__ unsigned umax_(unsigned a, unsigned b) { return a > b ? a : b; }
__device__ __forceinline__ unsigned umin_(unsigned a, unsigned b) { return a < b ? a : b; }
__device__ __forceinline__ unsigned rowmax16u(unsigned x) { x = umax_(x, dppu<0xB1>(x)); x = umax_(x, dppu<0x4E>(x)); x = umax_(x, dppu<0x141>(x)); x = umax_(x, dppu<0x140>(x)); return x; }
__device__ __forceinline__ float rowmax16f(float x) { x = fmaxf(x, dppf<0xB1>(x)); x = fmaxf(x, dppf<0x4E>(x)); x = fmaxf(x, dppf<0x141>(x)); x = fmaxf(x, dppf<0x140>(x)); return x; }
__device__ __forceinline__ float rowsum16f(float x) { x += dppf<0xB1>(x); x += dppf<0x4E>(x); x += dppf<0x141>(x); x += dppf<0x140>(x); return x; }
__device__ __forceinline__ int rowsum16i(int x) { x += (int)dppu<0xB1>((unsigned)x); x += (int)dppu<0x4E>((unsigned)x); x += (int)dppu<0x141>((unsigned)x); x += (int)dppu<0x140>((unsigned)x); return x; }
#define CEX(a, b) do { const unsigned _h = umax_(a, b), _l = umin_(a, b); a = _h; b = _l; } while (0)

#ifndef P7_NCH
#define P7_NCH 8
#endif
constexpr int P7_CSH = (P7_NCH == 4 ? 12 : (P7_NCH == 8 ? 11 : (P7_NCH == 16 ? 10 : 9)));
constexpr int P7_WL = 16384;
constexpr int P7_TL = 0, P7_TE = 1024, P7_TG = 3072, P7_LE = 5120, P7_LG = 7168, P7_LSU = 9216, P7_LQ = 11264, P7_H2Q = 12160, P7_HST = 16256;
static_assert(P7_LQ + 512 <= P7_H2Q && (P7_H2Q % 16) == 0 && P7_HST + 16 <= P7_WL && P7_WL * 8 <= RING_BYTES, "P7 LDS map");

__device__ __forceinline__ float tkval(unsigned k) { return __builtin_bit_cast(float, k & 0xffff0000u); }
#define TKX(a, b) do { unsigned hi_, lo_; asm("v_max_f32 %0, %1, %2" : "=v"(hi_) : "v"(a), "v"(b)); asm("v_min_f32 %0, %1, %2" : "=v"(lo_) : "v"(a), "v"(b)); a = hi_; b = lo_; } while (0)
#define TK_SORT16(c) do { TKX(c[0], c[1]); TKX(c[2], c[3]); TKX(c[0], c[2]); TKX(c[1], c[3]); TKX(c[1], c[2]); TKX(c[4], c[5]); TKX(c[6], c[7]); TKX(c[4], c[6]); TKX(c[5], c[7]); TKX(c[5], c[6]); TKX(c[0], c[4]); TKX(c[2], c[6]); TKX(c[2], c[4]); TKX(c[1], c[5]); TKX(c[3], c[7]); TKX(c[3], c[5]); TKX(c[1], c[2]); TKX(c[3], c[4]); TKX(c[5], c[6]); TKX(c[8], c[9]); TKX(c[10], c[11]); TKX(c[8], c[10]); TKX(c[9], c[11]); TKX(c[9], c[10]); TKX(c[12], c[13]); TKX(c[14], c[15]); TKX(c[12], c[14]); TKX(c[13], c[15]); TKX(c[13], c[14]); TKX(c[8], c[12]); TKX(c[10], c[14]); TKX(c[10], c[12]); TKX(c[9], c[13]); TKX(c[11], c[15]); TKX(c[11], c[13]); TKX(c[9], c[10]); TKX(c[11], c[12]); TKX(c[13], c[14]); TKX(c[0], c[8]); TKX(c[4], c[12]); TKX(c[4], c[8]); TKX(c[2], c[10]); TKX(c[6], c[14]); TKX(c[6], c[10]); TKX(c[2], c[4]); TKX(c[6], c[8]); TKX(c[10], c[12]); TKX(c[1], c[9]); TKX(c[5], c[13]); TKX(c[5], c[9]); TKX(c[3], c[11]); TKX(c[7], c[15]); TKX(c[7], c[11]); TKX(c[3], c[5]); TKX(c[7], c[9]); TKX(c[11], c[13]); TKX(c[1], c[2]); TKX(c[3], c[4]); TKX(c[5], c[6]); TKX(c[7], c[8]); TKX(c[9], c[10]); TKX(c[11], c[12]); TKX(c[13], c[14]); } while (0)
#define TK_BITONIC16(c) do { TKX(c[0], c[8]); TKX(c[1], c[9]); TKX(c[2], c[10]); TKX(c[3], c[11]); TKX(c[4], c[12]); TKX(c[5], c[13]); TKX(c[6], c[14]); TKX(c[7], c[15]); TKX(c[0], c[4]); TKX(c[1], c[5]); TKX(c[2], c[6]); TKX(c[3], c[7]); TKX(c[8], c[12]); TKX(c[9], c[13]); TKX(c[10], c[14]); TKX(c[11], c[15]); TKX(c[0], c[2]); TKX(c[1], c[3]); TKX(c[4], c[6]); TKX(c[5], c[7]); TKX(c[8], c[10]); TKX(c[9], c[11]); TKX(c[12], c[14]); TKX(c[13], c[15]); TKX(c[0], c[1]); TKX(c[2], c[3]); TKX(c[4], c[5]); TKX(c[6], c[7]); TKX(c[8], c[9]); TKX(c[10], c[11]); TKX(c[12], c[13]); TKX(c[14], c[15]); } while (0)
__device__ __forceinline__ void topk_stage1(const bf16* SC, int tok0, int lane, unsigned* TL4) {
    const v4u* src = (const v4u*)(SC + (size_t)(tok0 + (lane >> 4)) * 2048 + (lane & 15) * 128);
    unsigned T[16];
#pragma unroll
    for (int ch = 0; ch < 8; ++ch) {
        const v4u r0 = src[2 * ch], r1 = src[2 * ch + 1];
        unsigned c[16];
#pragma unroll
        for (int m = 0; m < 4; ++m) { c[2 * m] = (r0[m] << 16) | (unsigned)(16 * ch + 2 * m); c[2 * m + 1] = (r0[m] & 0xffff0000u) | (unsigned)(16 * ch + 2 * m + 1);
                                      c[8 + 2 * m] = (r1[m] << 16) | (unsigned)(16 * ch + 8 + 2 * m); c[8 + 2 * m + 1] = (r1[m] & 0xffff0000u) | (unsigned)(16 * ch + 8 + 2 * m + 1); }
        TK_SORT16(c);
        if (ch == 0) {
#pragma unroll
            for (int i = 0; i < 16; ++i) T[i] = c[i];
        } else {
#pragma unroll
            for (int i = 0; i < 16; ++i) { unsigned m_; asm("v_max_f32 %0, %1, %2" : "=v"(m_) : "v"(T[i]), "v"(c[15 - i])); T[i] = m_; }
            TK_BITONIC16(T);
        }
    }
    v4u* dst = (v4u*)(TL4 + lane * 16);
#pragma unroll
    for (int q = 0; q < 4; ++q) { v4u o; o.x = T[4 * q]; o.y = T[4 * q + 1]; o.z = T[4 * q + 2]; o.w = T[4 * q + 3]; dst[q] = o; }
}
__device__ __forceinline__ void topk_stage2x4(const unsigned* TL4, int lane, int* TE, float* TG) {
    const int x = lane & 1, lh = lane >> 1;
    const unsigned long long xm = __ballot(x != 0);
#define TKSEL(a1, a0) ({ unsigned r_; asm("v_cndmask_b32_e64 %0, %1, %2, %3" : "=v"(r_) : "v"(a0), "v"(a1), "s"(xm)); r_; })
    const unsigned* LA = TL4 + (2 * lh) * 16; const unsigned* LB = LA + 16;
    float av[16], bs[8];
    {
        unsigned ka[16], kb[16];
#pragma unroll
        for (int q = 0; q < 4; ++q) { const v4u a = *(const v4u*)(LA + 4 * q), b = *(const v4u*)(LB + 4 * q);
            ka[4 * q] = a.x; ka[4 * q + 1] = a.y; ka[4 * q + 2] = a.z; ka[4 * q + 3] = a.w; kb[4 * q] = b.x; kb[4 * q + 1] = b.y; kb[4 * q + 2] = b.z; kb[4 * q + 3] = b.w; }
#pragma unroll
        for (int i = 0; i < 16; ++i) av[i] = tkval(ka[i]);
#pragma unroll
        for (int m = 0; m < 8; ++m) bs[m] = tkval(TKSEL(kb[2 * m + 1], kb[2 * m]));
    }
    const unsigned NEGK = 0xff7fff00u;
#define TKC(i, m) ((__builtin_bit_cast(unsigned, av[i] + bs[m]) & 0xffffff00u) | (unsigned)(16 * (i) + 2 * (m)) | (unsigned)x)
    unsigned c[16], d[16];
    c[0] = TKC(0, 0);
    c[1] = TKC(0, 1);
    c[2] = TKC(0, 2);
    c[3] = TKC(0, 3);
    c[4] = TKC(0, 4);
    c[5] = TKC(0, 5);
    c[6] = TKC(0, 6);
    c[7] = TKC(0, 7);
    c[8] = TKC(1, 0);
    c[9] = TKC(1, 1);
    c[10] = TKC(1, 2);
    c[11] = TKC(1, 3);
    c[12] = TKC(2, 0);
    c[13] = TKC(2, 1);
    c[14] = TKSEL(NEGK, TKC(2, 2));
    c[15] = TKC(3, 0);
    d[0] = TKC(3, 1);
    d[1] = TKC(4, 0);
    d[2] = TKSEL(NEGK, TKC(4, 1));
    d[3] = TKC(5, 0);
    d[4] = TKC(6, 0);
    d[5] = TKC(7, 0);
    d[6] = TKSEL(NEGK, TKC(8, 0));
    d[7] = TKSEL(NEGK, TKC(9, 0));
    d[8] = TKSEL(NEGK, TKC(10, 0));
    d[9] = TKSEL(NEGK, TKC(11, 0));
    d[10] = TKSEL(NEGK, TKC(12, 0));
    d[11] = TKSEL(NEGK, TKC(13, 0));
    d[12] = TKSEL(NEGK, TKC(14, 0));
    d[13] = TKSEL(NEGK, TKC(15, 0));
    d[14] = NEGK; d[15] = NEGK;
#undef TKC
    TK_SORT16(c); TK_SORT16(d);
    unsigned T[16], U[16];
#pragma unroll
    for (int i = 0; i < 16; ++i) { unsigned m_; asm("v_max_f32 %0, %1, %2" : "=v"(m_) : "v"(c[i]), "v"(d[15 - i])); T[i] = m_; }
    TK_BITONIC16(T);
#pragma unroll
    for (int i = 0; i < 16; ++i) { const unsigned p_ = dppu<0xB1>(T[15 - i]); unsigned m_; asm("v_max_f32 %0, %1, %2" : "=v"(m_) : "v"(T[i]), "v"(p_)); U[i] = m_; }
    TK_BITONIC16(U);
    const float vmax = __builtin_bit_cast(float, U[0] & 0xffffff00u);
    float ex[8]; unsigned code[8]; float sum = 0.f;
#pragma unroll
    for (int m = 0; m < 8; ++m) { const unsigned k_ = TKSEL(U[8 + m], U[m]); code[m] = k_ & 0xffu; ex[m] = __expf(__builtin_bit_cast(float, k_ & 0xffffff00u) - vmax); sum += ex[m]; }
    sum += dppf<0xB1>(sum);
    const float inv = 1.f / sum;
    int eo[8]; float go[8];
#pragma unroll
    for (int m = 0; m < 8; ++m) { const unsigned ka_ = LA[code[m] >> 4], kb_ = LB[code[m] & 15u]; eo[m] = (int)((ka_ & 127u) * 128u + (kb_ & 127u)); go[m] = ex[m] * inv; }
    int* te = TE + 8 * lane; float* tg = TG + 8 * lane;
    *(v4u*)te = (v4u){(unsigned)eo[0], (unsigned)eo[1], (unsigned)eo[2], (unsigned)eo[3]}; *(v4u*)(te + 4) = (v4u){(unsigned)eo[4], (unsigned)eo[5], (unsigned)eo[6], (unsigned)eo[7]};
    *(f32x4*)tg = (f32x4){go[0], go[1], go[2], go[3]}; *(f32x4*)(tg + 4) = (f32x4){go[4], go[5], go[6], go[7]};
#undef TKSEL
}

__device__ __forceinline__ void gl16x4(v4u (&r)[4], unsigned voff, const unsigned char* b0, const unsigned char* b1, const unsigned char* b2, const unsigned char* b3) {
    asm volatile("s_nop 4\n\tglobal_load_dwordx4 %0, %4, %5\n\tglobal_load_dwordx4 %1, %4, %6\n\tglobal_load_dwordx4 %2, %4, %7\n\tglobal_load_dwordx4 %3, %4, %8"
                 : "=&v"(r[0]), "=&v"(r[1]), "=&v"(r[2]), "=&v"(r[3]) : "v"(voff), "s"(b0), "s"(b1), "s"(b2), "s"(b3) : "memory");
}
#define P7_VMWAIT(N, R) asm volatile("s_waitcnt vmcnt(" #N ")" : "+v"(R[0]), "+v"(R[1]), "+v"(R[2]), "+v"(R[3]) :: "memory")
__device__ __forceinline__ int mbcnt64(unsigned long long m) { return (int)__builtin_amdgcn_mbcnt_hi((unsigned)(m >> 32), __builtin_amdgcn_mbcnt_lo((unsigned)m, 0u)); }
__device__ __forceinline__ int rfl(int v) { return __builtin_amdgcn_readfirstlane(v); }
__device__ __forceinline__ float rflf(float v) { return __builtin_bit_cast(float, __builtin_amdgcn_readfirstlane(__builtin_bit_cast(int, v))); }

__device__ __forceinline__ void p7_phase(Frame& F, bool dry) {
    const int lane0 = hw_lane(), wave = F.wave;
    if (dry && (MK_DRY_SKIP & 16) && wave >= 4) return;
    unsigned char* wl = F.lds + wave * P7_WL;
    int* TE = (int*)(wl + P7_TE); float* TG = (float*)(wl + P7_TG);
    float* LG = (float*)(wl + P7_LG); float* LSU = (float*)(wl + P7_LSU); unsigned char* H2Q = wl + P7_H2Q; float* HST = (float*)(wl + P7_HST);
    const bf16* SC = (const bf16*)(F.ws + WS_SC); const bf16* H2 = (const bf16*)(F.ws + WS_H);
    const unsigned char* U8 = F.ws + WS_U; const unsigned char* V8 = F.ws + WS_V;
    const float* SU = (const float*)(F.ws + WS_SU); const float* SV = (const float*)(F.ws + WS_SV);
    const float* mods = (const float*)(F.ws + WS_MODS); const float* SSP = (const float*)(F.ws + WS_SSP);
    const int ntg = NTOK / (F.G * NWAVES * 4);
#pragma unroll 1
    for (int tg = 0; tg < ntg; ++tg) {
        const int tok0 = (F.vcu * ntg + tg) * (NWAVES * 4) + wave * 4;
        int lane = hw_lane(); asm volatile("" : "+v"(lane));
        {
            unsigned* TL4 = (unsigned*)(wl + P7_LE);
            topk_stage1(SC, tok0, lane, TL4);
            topk_stage2x4(TL4, lane, TE, TG);
            v4u ch0, ch1, nh0, nh1;
#define P7_TLOAD(H0, H1, tk) do { H0 = *(const v4u*)(H2 + (size_t)(tk) * DM + 16 * lane); H1 = *(const v4u*)(H2 + (size_t)(tk) * DM + 16 * lane + 8); } while (0)
            P7_TLOAD(ch0, ch1, tok0);
#pragma unroll 1
            for (int s = 0; s < 4; ++s) {
                if (s < 3) P7_TLOAD(nh0, nh1, tok0 + s + 1);
                const int tokc = tok0 + s;
                const f32x4* spp = (const f32x4*)(SSP + (size_t)tokc * 16); const f32x4 q0 = spp[0], q1 = spp[1], q2 = spp[2], q3 = spp[3];
                const float* shp = mods + (size_t)mod_index(tokc) * MODW + 3 * DM + 16 * lane;
                const f32x4 sh0 = *(const f32x4*)(shp), sh1 = *(const f32x4*)(shp + 4), sh2v = *(const f32x4*)(shp + 8), sh3 = *(const f32x4*)(shp + 12);
                const v4u a = ch0, b = ch1;
                const float ssr = ((q0[0] + q0[1]) + (q0[2] + q0[3])) + ((q1[0] + q1[1]) + (q1[2] + q1[3])) + ((q2[0] + q2[1]) + (q2[2] + q2[3])) + ((q3[0] + q3[1]) + (q3[2] + q3[3]));
                const float rstd = 1.f / sqrtf(ssr * (1.f / DM) + EPS);
                float hv[16];
                hv[0] = bflo(a.x); hv[1] = bfhi(a.x); hv[2] = bflo(a.y); hv[3] = bfhi(a.y); hv[4] = bflo(a.z); hv[5] = bfhi(a.z); hv[6] = bflo(a.w); hv[7] = bfhi(a.w);
                hv[8] = bflo(b.x); hv[9] = bfhi(b.x); hv[10] = bflo(b.y); hv[11] = bfhi(b.y); hv[12] = bflo(b.z); hv[13] = bfhi(b.z); hv[14] = bflo(b.w); hv[15] = bfhi(b.w);
#pragma unroll
                for (int i = 0; i < 4; ++i) { hv[i] = hv[i] * rstd + sh0[i]; hv[4 + i] = hv[4 + i] * rstd + sh1[i]; hv[8 + i] = hv[8 + i] * rstd + sh2v[i]; hv[12 + i] = hv[12 + i] * rstd + sh3[i]; }
                float am = 0.f;
#pragma unroll
                for (int i = 0; i < 16; ++i) am = fmaxf(am, fabsf(hv[i]));
                am = wave_max(am);
                const float inv = am > 0.f ? 119.f / am : 0.f;
                if (lane == 0) HST[s] = am * (1.f / 119.f);
                v4u qv;
#pragma unroll
                for (int j = 0; j < 4; ++j) { unsigned w = 0;
#pragma unroll
                    for (int i = 0; i < 4; ++i) { int q = (int)rintf(hv[4 * j + i] * inv); w |= ((unsigned)q & 0xffu) << (8 * i); }
                    qv[j] = w; }
                *(v4u*)(H2Q + s * 1024 + 16 * lane) = qv;
                ch0 = nh0; ch1 = nh1;
            }
#undef P7_TLOAD
        }
        {
            unsigned* LEO = (unsigned*)(wl + P7_LE);
            int ee0[4], ee1[4]; float gg0[4], gg1[4], us0[4], us1[4], vs0[4], vs1[4];
#pragma unroll
            for (int s = 0; s < 4; ++s) { ee0[s] = TE[s * 128 + lane]; ee1[s] = TE[s * 128 + 64 + lane]; gg0[s] = TG[s * 128 + lane]; gg1[s] = TG[s * 128 + 64 + lane]; }
#pragma unroll
            for (int s = 0; s < 4; ++s) { us0[s] = SU[ee0[s]]; us1[s] = SU[ee1[s]]; vs0[s] = SV[ee0[s]]; vs1[s] = SV[ee1[s]]; }
#pragma unroll
            for (int s = 0; s < 4; ++s) { const int e0 = ee0[s], e1 = ee1[s]; const int c0 = e0 >> P7_CSH, c1 = e1 >> P7_CSH; int base = s * 128;
#pragma unroll
                for (int c = 0; c < P7_NCH; ++c) {
                    const unsigned long long m0 = __ballot(c0 == c), m1 = __ballot(c1 == c);
                    const int n0 = __popcll(m0), n = n0 + __popcll(m1);
                    if (c0 == c) { const int p = base + mbcnt64(m0); LEO[p] = (unsigned)e0 << 9; LG[p] = gg0[s] * vs0[s]; LSU[p] = us0[s]; }
                    if (c1 == c) { const int p = base + n0 + mbcnt64(m1); LEO[p] = (unsigned)e1 << 9; LG[p] = gg1[s] * vs1[s]; LSU[p] = us1[s]; }
                    base += n;
                } }
        }
        typedef __attribute__((address_space(1))) v4u GV4;
        if (!(dry && (MK_DRY_SKIP & 1))) {
            int lane_u = hw_lane(); asm volatile("" : "+v"(lane_u));
            const int su = lane_u >> 4, ju = lane_u & 15; const unsigned j16 = 16u * (unsigned)ju;
            const unsigned* LEOs = (const unsigned*)(wl + P7_LE) + su * 128; float* LGs = LG + su * 128; const float* LSUs = LSU + su * 128;
            const unsigned long long u8i = (unsigned long long)U8;
            unsigned hh[2][4], hl[2][4];
#pragma unroll
            for (int i = 0; i < 2; ++i) { const v4u ha = *(const v4u*)(H2Q + su * 1024 + 512 * i + 32 * ju), hb = *(const v4u*)(H2Q + su * 1024 + 512 * i + 32 * ju + 16);
#pragma unroll
                for (int w = 0; w < 4; ++w) { unsigned lo16[2], hi16[2];
#pragma unroll
                    for (int h = 0; h < 2; ++h) { const unsigned d = (w < 2 ? ha : hb)[2 * (w & 1) + h];
                        const unsigned t = ((d & 0x7f7f7f7fu) + 0x08080808u) ^ (d & 0x80808080u);
                        unsigned l = (t & 0x0f0f0f0fu) ^ 0x08080808u, g = (t >> 4) & 0x0f0f0f0fu;
                        l = (l | (l >> 4)) & 0x00ff00ffu; l = (l | (l >> 8)) & 0xffffu; g = (g | (g >> 4)) & 0x00ff00ffu; g = (g | (g >> 8)) & 0xffffu;
                        lo16[h] = l; hi16[h] = g; }
                    hl[i][w] = lo16[0] | (lo16[1] << 16); hh[i][w] = hi16[0] | (hi16[1] << 16); } }
            const float hs = HST[su];
            const bool b0 = (ju & 1) != 0, b1 = (ju & 2) != 0; const int rr = ju & 3;
            v4u A[4][2], B[4][2], C[4][2], D[4][2];
#define P7_ULOAD(R, t) do { const v4u eo_ = *(const v4u*)(LEOs + 4 * (t)); \
            _Pragma("unroll") for (int r = 0; r < 4; ++r) { unsigned o_ = eo_[r] + j16; asm volatile("" : "+v"(o_)); \
                R[r][0] = *(const GV4*)(u8i + o_); R[r][1] = *(const GV4*)(u8i + o_ + 256); } \
            __builtin_amdgcn_sched_barrier(0); } while (0)
#define P7_SCOMP_U(R, t) do { const float su_ = LSUs[4 * (t) + rr], g_ = LGs[4 * (t) + rr]; int p_[4]; \
                _Pragma("unroll") for (int r = 0; r < 4; ++r) { int ah = 0, al = 0; \
                    _Pragma("unroll") for (int i = 0; i < 2; ++i) { _Pragma("unroll") for (int w = 0; w < 4; ++w) { \
                        ah = __builtin_amdgcn_sdot8((int)hh[i][w], (int)R[r][i][w], ah, false); al = __builtin_amdgcn_sdot8((int)hl[i][w], (int)R[r][i][w], al, false); } } \
                    p_[r] = 16 * ah + al; } \
                const int q01 = (b0 ? p_[1] : p_[0]) + (int)dppu<0xB1>((unsigned)(b0 ? p_[0] : p_[1])); const int q23 = (b0 ? p_[3] : p_[2]) + (int)dppu<0xB1>((unsigned)(b0 ? p_[2] : p_[3])); \
                int q_ = (b1 ? q23 : q01) + (int)dppu<0x4E>((unsigned)(b1 ? q01 : q23)); q_ += (int)dppu<0x128>((unsigned)q_); q_ += (int)dppu<0x124>((unsigned)q_); \
                const float dotf = (float)q_ * (hs * su_); LGs[4 * (t) + rr] = g_ * gelu_fast(dotf); } while (0)
            P7_ULOAD(A, 0); P7_ULOAD(B, 1); P7_ULOAD(C, 2);
#pragma unroll 1
            for (int t = 0; t < 28; t += 4) {
                P7_ULOAD(D, t + 3); P7_SCOMP_U(A, t);
                P7_ULOAD(A, t + 4); P7_SCOMP_U(B, t + 1);
                P7_ULOAD(B, t + 5); P7_SCOMP_U(C, t + 2);
                P7_ULOAD(C, t + 6); P7_SCOMP_U(D, t + 3);
                asm volatile("" ::: "memory");
            }
            P7_ULOAD(D, 31); P7_SCOMP_U(A, 28); P7_SCOMP_U(B, 29); P7_SCOMP_U(C, 30); P7_SCOMP_U(D, 31);
#undef P7_SCOMP_U
#undef P7_ULOAD
        }
        float cscale; int sumq8;
        {
            int lane_q = hw_lane(); asm volatile("" : "+v"(lane_q));
            const int sq = lane_q >> 4, jq = lane_q & 15;
            const float* lg = LG + sq * 128 + 8 * jq; const f32x4 c0 = *(const f32x4*)lg, c1 = *(const f32x4*)(lg + 4);
            float m = fmaxf(fmaxf(fmaxf(fabsf(c0[0]), fabsf(c0[1])), fmaxf(fabsf(c0[2]), fabsf(c0[3]))), fmaxf(fmaxf(fabsf(c1[0]), fabsf(c1[1])), fmaxf(fabsf(c1[2]), fabsf(c1[3]))));
            m = rowmax16f(m);
            cscale = m * (1.f / 127.f); const float iv = m > 0.f ? 127.f / m : 0.f;
            v2u w; w.x = 0u; w.y = 0u;
#pragma unroll
            for (int k = 0; k < 4; ++k) { w.x |= ((unsigned)(int)rintf(c0[k] * iv) & 0xffu) << (8 * k); w.y |= ((unsigned)(int)rintf(c1[k] * iv) & 0xffu) << (8 * k); }
            *(v2u*)(wl + P7_LQ + (sq * 32 + 2 * jq) * 4) = w;
            int sq8 = 0;
#pragma unroll
            for (int k = 0; k < 4; ++k) sq8 += (int)rintf(c0[k] * iv) + (int)rintf(c1[k] * iv);
            sumq8 = 8 * rowsum16i(sq8);
        }
        int acc[64];
#pragma unroll
        for (int i = 0; i < 64; ++i) acc[i] = 0;
        if (!(dry && (MK_DRY_SKIP & 2))) {
            int lane_v = hw_lane(); asm volatile("" : "+v"(lane_v));
            const int sv_ = lane_v >> 4, jv = lane_v & 15; const unsigned j16 = 16u * (unsigned)jv;
            const unsigned* LEOs = (const unsigned*)(wl + P7_LE) + sv_ * 128; const int* LQs = (const int*)(wl + P7_LQ) + sv_ * 32;
            const unsigned long long v8i = (unsigned long long)V8;
            v4u A[4][2], B[4][2], C[4][2];
#define P7_VLOAD(R, t) do { const v4u eo_ = *(const v4u*)(LEOs + 4 * (t)); \
            _Pragma("unroll") for (int r = 0; r < 4; ++r) { unsigned o_ = eo_[r] + j16; asm volatile("" : "+v"(o_)); \
                R[r][0] = *(const GV4*)(v8i + o_); R[r][1] = *(const GV4*)(v8i + o_ + 256); } \
            __builtin_amdgcn_sched_barrier(0); } while (0)
#define P7_SCOMP_V(R, t) do { const int cq_ = LQs[(t)]; \
                _Pragma("unroll") for (int i = 0; i < 2; ++i) { _Pragma("unroll") for (int w = 0; w < 4; ++w) { \
                    const unsigned x_ = __builtin_amdgcn_perm(R[1][i][w], R[0][i][w], 0x05010400u), y_ = __builtin_amdgcn_perm(R[1][i][w], R[0][i][w], 0x07030602u); \
                    const unsigned c_ = __builtin_amdgcn_perm(R[3][i][w], R[2][i][w], 0x05010400u), e_ = __builtin_amdgcn_perm(R[3][i][w], R[2][i][w], 0x07030602u); \
                    unsigned tb_[4]; tb_[0] = __builtin_amdgcn_perm(c_, x_, 0x05040100u); tb_[1] = __builtin_amdgcn_perm(c_, x_, 0x07060302u); tb_[2] = __builtin_amdgcn_perm(e_, y_, 0x05040100u); tb_[3] = __builtin_amdgcn_perm(e_, y_, 0x07060302u); \
                    _Pragma("unroll") for (int b = 0; b < 4; ++b) {     \
                        acc[32 * i + 8 * w + 2 * b]     = __builtin_amdgcn_sdot4((int)(tb_[b] & 0x0f0f0f0fu), cq_, acc[32 * i + 8 * w + 2 * b], false); \
                        acc[32 * i + 8 * w + 2 * b + 1] = __builtin_amdgcn_sdot4((int)tb_[b], cq_, acc[32 * i + 8 * w + 2 * b + 1], false); } } } } while (0)
            P7_VLOAD(A, 0); P7_VLOAD(B, 1);
#pragma unroll 1
            for (int t = 0; t < 30; t += 3) {
                P7_VLOAD(C, t + 2); P7_SCOMP_V(A, t);
                P7_VLOAD(A, t + 3); P7_SCOMP_V(B, t + 1);
                P7_VLOAD(B, t + 4); P7_SCOMP_V(C, t + 2);
                asm volatile("" ::: "memory");
            }
            P7_SCOMP_V(A, 30); P7_SCOMP_V(B, 31);
#undef P7_SCOMP_V
#undef P7_VLOAD
        }
        {
            int lane_f = hw_lane(); asm volatile("" : "+v"(lane_f));
            const int sf = lane_f >> 4, jf = lane_f & 15; const int tok = tok0 + sf;
            const bf16* xrow = (const bf16*)(F.ws + WS_X1) + (size_t)tok * DM + 32 * jf;
            const float* ga2 = mods + (size_t)mod_index(tok0) * MODW + 5 * DM + 32 * jf;
            const float* gf = F.in[I_GFINAL] + 32 * jf;
            float xs[64]; float ss = 0.f;
#pragma unroll
            for (int i = 0; i < 2; ++i) {
#pragma unroll
                for (int hh_ = 0; hh_ < 2; ++hh_) { f32x4 gv[4];
                    const v4u xa = *(const v4u*)(xrow + 512 * i + 16 * hh_), xb = *(const v4u*)(xrow + 512 * i + 16 * hh_ + 8);
#pragma unroll
                    for (int q = 0; q < 4; ++q) gv[q] = *(const f32x4*)(ga2 + 512 * i + 16 * hh_ + 4 * q);
                    float xv[16];
                    xv[0] = bflo(xa.x); xv[1] = bfhi(xa.x); xv[2] = bflo(xa.y); xv[3] = bfhi(xa.y); xv[4] = bflo(xa.z); xv[5] = bfhi(xa.z); xv[6] = bflo(xa.w); xv[7] = bfhi(xa.w);
                    xv[8] = bflo(xb.x); xv[9] = bfhi(xb.x); xv[10] = bflo(xb.y); xv[11] = bfhi(xb.y); xv[12] = bflo(xb.z); xv[13] = bfhi(xb.z); xv[14] = bflo(xb.w); xv[15] = bfhi(xb.w);
#pragma unroll
                    for (int q = 0; q < 4; ++q)
#pragma unroll
                        for (int k = 0; k < 4; ++k) { const int ci = 32 * i + 16 * hh_ + 4 * q + k;
                            const float pv = (k & 1) ? (float)(acc[ci] - acc[ci - 1]) * (cscale * (1.f / 16.f)) : (float)(acc[ci] - sumq8) * cscale;
                            const float t = xv[4 * q + k] + gv[q][k] * pv; xs[ci] = t; ss += t * t; }
                    asm volatile("" ::: "memory"); } }
            const float rstd = 1.f / sqrtf(rowsum16f(ss) * (1.f / DM) + EPS);
#pragma unroll
            for (int i = 0; i < 2; ++i) {
#pragma unroll
                for (int hh_ = 0; hh_ < 2; ++hh_) { f32x4 gfv[4];
#pragma unroll
                    for (int q = 0; q < 4; ++q) gfv[q] = *(const f32x4*)(gf + 512 * i + 16 * hh_ + 4 * q);
#pragma unroll
                    for (int q = 0; q < 4; ++q) { f32x4 o;
#pragma unroll
                        for (int k = 0; k < 4; ++k) o[k] = xs[32 * i + 16 * hh_ + 4 * q + k] * rstd * gfv[q][k];
                        *(f32x4*)(wl + sf * 4096 + 2048 * i + 128 * jf + 16 * ((4 * hh_ + q) ^ (jf & 7))) = o; }
                    asm volatile("" ::: "memory"); } }
            float* ybase = dry ? (float*)(F.ws + WS_MIX) : F.out + O_Y;
#pragma unroll
            for (int m = 0; m < 16; ++m) { const int sr = m >> 2, f = (m & 3) * 64 + lane_f, jr = (f >> 3) & 15;
                const f32x4 o = *(const f32x4*)(wl + sr * 4096 + 2048 * (f >> 7) + 128 * jr + 16 * ((f & 7) ^ (jr & 7)));
                const int tr = tok0 + sr; *(f32x4*)(ybase + (size_t)(dry ? (tr & 8191) : tr) * DM + 4 * f) = o; }
        }
    }
}

__global__ void __launch_bounds__(NWAVES * 64, 2) mk_fwd(Args args) {
    extern __shared__ __attribute__((aligned(16))) unsigned char lds[];
    Frame F;
    F.lds = lds;
    F.tid = threadIdx.x; F.lane = F.tid & 63; F.wave = __builtin_amdgcn_readfirstlane(F.tid >> 6);
    F.G = gridDim.x; { const int bx = blockIdx.x; F.vcu = (F.G % 8 == 0) ? (bx % 8) * (F.G / 8) + bx / 8 : bx; }
    F.in = args.in; F.out = args.out; F.ws = args.ws;
    LAS unsigned char* lds3 = (LAS unsigned char*)lds;
    volatile LAS unsigned* MISC = (volatile LAS unsigned*)(lds3 + MISC_OFF);
    for (int u = F.tid; u < (LDS_BYTES - LDSCTL_OFF) / 4; u += NWAVES * 64) ((LAS unsigned*)(lds3 + LDSCTL_OFF))[u] = 0u;
    __syncthreads();
    unsigned* ctl = (unsigned*)(args.ws + WS_CTL);
    XcdBarrier bar; bar.bar = ctl + CW_BAR; bar.x = 0; bar.st = nullptr;
    const bool one_launch = (args.ph_hi - args.ph_lo) > 1;
    if (one_launch) bar = xcd_barrier_post(ctl + CW_BAR, MISC + 8);
    const int lo = args.ph_lo, hi = args.ph_hi;
#ifndef MK_PHASE_MASK
#define MK_PHASE_MASK 0xff
#endif
#define IN(k) (((MK_PHASE_MASK >> (k)) & 1) && lo <= (k) && (k) < hi)
#define SEAM(k) do { if (IN(k) && IN((k) + 1)) xcd_barrier(bar); } while (0)

#define DUPQ(k) (MK_DUP == (k))
    if (IN(0)) { if (DUPQ(0)) { p0_phase(F); xcd_barrier(bar); } p0_phase(F); SEAM(0); }
    if (IN(1)) { REFRESH_IDS(F); if (DUPQ(1)) { norm_phase(F, 0); xcd_barrier(bar); } norm_phase(F, 0); bias_items(F); SEAM(1); }
    if (IN(2)) { REFRESH_IDS(F);
        pg8::Gemm g{(const pg8::bf16_t*)(F.ws + WS_H), (const pg8::bf16_t*)(F.ws + WS_WIN), NTOK, D_IN, DM}; pg8::StaticOrder S; S.init(NTOK, D_IN, F.G, (int)blockIdx.x);
        EpiInProj E{(bf16*)(F.ws + WS_Q), (bf16*)(F.ws + WS_K), (bf16*)(F.ws + WS_VT), (bf16*)(F.ws + WS_XR), (bf16*)(F.ws + WS_YG), F.out + O_NEWK, F.out + O_NEWV, (const f32x4*)(F.ws + WS_ROPE)};
        if (DUPQ(2)) { pg8::gemm_phase<EpiInProj, pg8::StaticOrder, true, true>(lds3, g, S, E); xcd_barrier(bar); }
        pg8::gemm_phase<EpiInProj, pg8::StaticOrder, true, true>(lds3, g, S, E);
        if (u_in_p2(F.G) && (int)blockIdx.x >= 192) quant_rows(F, 0, 16384, ((int)blockIdx.x - 192) * NWAVES + F.wave, 64 * NWAVES);
        SEAM(2);
    }
    if (IN(3)) { REFRESH_IDS(F); if (DUPQ(3)) { p3_phase(F, MK_P3_TYPES); xcd_barrier(bar); } p3_phase(F); SEAM(3); }
    if (IN(4)) { REFRESH_IDS(F);
        pg8::Gemm g{(const pg8::bf16_t*)(F.ws + WS_MIX), (const pg8::bf16_t*)(F.ws + WS_WOUT), NTOK, DM, DM}; pg8::StaticOrder S; S.init(NTOK, DM, F.G, (int)blockIdx.x);
        EpiOutProj E{F.in[I_XP], F.in[I_XS], (const float*)(F.ws + WS_MODS), F.in[I_GFFN], (bf16*)(F.ws + WS_X1), (bf16*)(F.ws + WS_H), (float*)(F.ws + WS_SSP)};
        if (DUPQ(4)) { pg8::gemm_phase<EpiOutProj, pg8::StaticOrder, true, true>(lds3, g, S, E); xcd_barrier(bar); }
        pg8::gemm_phase<EpiOutProj, pg8::StaticOrder, true, true>(lds3, g, S, E);
        SEAM(4);
    }
    if (IN(6)) { REFRESH_IDS(F);
        pg8::Gemm g{(const pg8::bf16_t*)(F.ws + WS_H), (const pg8::bf16_t*)(F.ws + WS_WC), NTOK, 2048, DM}; pg8::StaticOrder S; S.init(NTOK, 2048, F.G, (int)blockIdx.x);
        EpiScores E{(bf16*)(F.ws + WS_SC), (const float*)(F.ws + WS_SSP), (const float*)(F.ws + WS_BIAS)};
        if (DUPQ(6)) { pg8::gemm_phase<EpiScores, pg8::StaticOrder, true, true>(lds3, g, S, E); xcd_barrier(bar); }
        pg8::gemm_phase<EpiScores, pg8::StaticOrder, true, true>(lds3, g, S, E);
        SEAM(6);
    }
    if (IN(7)) { REFRESH_IDS(F); if (DUPQ(7)) { p7_phase(F, true); xcd_barrier(bar); } p7_phase(F, false); }
#undef IN
#undef SEAM
}

extern "C" void kernel_launch(void* const* d_in, const int* in_sizes, int n_in, void* d_out, int out_size, void* d_ws, size_t ws_size, hipStream_t stream) {
    static int grid = 0;
    if (grid == 0) {
        if (n_in != 26 || ws_size < WS_END) { fprintf(stderr, "kernel_launch: unexpected n_in %d / ws %zu\n", n_in, ws_size); grid = -1; return; }
        int dev = 0, cus = 0, per_cu = 0;
        if (hipGetDevice(&dev) != hipSuccess || hipDeviceGetAttribute(&cus, hipDeviceAttributeMultiprocessorCount, dev) != hipSuccess) { grid = -1; return; }
        if (hipFuncSetAttribute((const void*)mk_fwd, hipFuncAttributeMaxDynamicSharedMemorySize, LDS_BYTES) != hipSuccess) { fprintf(stderr, "kernel_launch: hipFuncSetAttribute failed\n"); grid = -1; return; }
        if (hipOccupancyMaxActiveBlocksPerMultiprocessor(&per_cu, (const void*)mk_fwd, NWAVES * 64, LDS_BYTES) != hipSuccess || per_cu < 1)
            fprintf(stderr, "kernel_launch: occupancy query reports %d blocks per CU\n", per_cu);
        (void)hipGetLastError();
        grid = cus;
        if (grid != 256) fprintf(stderr, "kernel_launch: note: %d CUs\n", grid);
    }
    if (grid < 0) return;
    (void)hipMemsetAsync((char*)d_ws + WS_CTL, 0, CTL_ZERO_BYTES, stream);
    Args a{};
    for (int i = 0; i < 26; ++i) a.in[i] = (const float*)d_in[i];
    a.out = (float*)d_out; a.ws = (unsigned char*)d_ws;
    if (MK_N_LAUNCHES == 1) {
        a.ph_lo = 0; a.ph_hi = N_PHASES; a.li = 0;
        hipLaunchKernelGGL(mk_fwd, dim3(grid), dim3(NWAVES * 64), LDS_BYTES, stream, a);
    } else {
        for (int li = 0; li < N_PHASES; ++li) { a.ph_lo = li; a.ph_hi = li + 1; a.li = li;
            hipLaunchKernelGGL(mk_fwd, dim3(grid), dim3(NWAVES * 64), LDS_BYTES, stream, a); }
    }
}
```
